# Optimizing an MI355X kernel written in HIP

```python
import jax, jax.numpy as jnp
from jax import lax
import numpy as np

D_MODEL = 1024
BATCH = 32
SEQ = 2048
DEPTH = 4

N_MIXERS = 2
N_HEADS = 8
QK_NOPE_DIM = 128
QK_ROPE_DIM = 64
V_HEAD_DIM = 128
Q_LORA_RANK = 512
KV_LORA_RANK = 256
ROPE_THETA = 10000.0
Q_BLOCK = 128
POOL_WINDOWS = (2, 4, 8, 16)
N_POOL_GROUPS = len(POOL_WINDOWS)
POOL_GROUP_DIM = D_MODEL // N_POOL_GROUPS
D_FF_DENSE = 2688
N_EXPERTS = 8
TOP_K = 2
D_FF_EXPERT = 1344
MOE_BLOCK = 256
RMS_EPS = 1e-6
N_MLA_LAYERS = (DEPTH + 1) // 2
N_POOL_LAYERS = DEPTH // 2

kernel_name = "hybrid_mla_pool_moe_decoder"


def rms_norm(x, g):
    xf = x.astype(jnp.float32)
    y = xf * lax.rsqrt(jnp.mean(xf * xf, axis=-1, keepdims=True) + RMS_EPS)
    return (y * g.astype(jnp.float32)).astype(x.dtype)


def rope_tables(positions):
    inv_freq = ROPE_THETA ** (-jnp.arange(0, QK_ROPE_DIM, 2, dtype=jnp.float32) / QK_ROPE_DIM)
    ang = positions.astype(jnp.float32)[..., None] * inv_freq
    return jnp.cos(ang), jnp.sin(ang)


def apply_rope(x, cos, sin):
    xf = x.astype(jnp.float32)
    x1, x2 = jnp.split(xf, 2, axis=-1)
    return jnp.concatenate([x1 * cos - x2 * sin, x2 * cos + x1 * sin], axis=-1).astype(x.dtype)


def mla(h, cos, sin, w_down, q_norm, w_uq, kv_norm, w_ukv, w_o):
    B, S, _ = h.shape
    down = h @ w_down
    c_q, c_kv, k_rope = jnp.split(down, [Q_LORA_RANK, Q_LORA_RANK + KV_LORA_RANK], axis=-1)
    q = (rms_norm(c_q, q_norm) @ w_uq).reshape(B, S, N_HEADS, QK_NOPE_DIM + QK_ROPE_DIM)
    q_nope, q_rope = q[..., :QK_NOPE_DIM], q[..., QK_NOPE_DIM:]
    q_rope = apply_rope(q_rope, cos[:, :, None, :], sin[:, :, None, :])
    k_rope = apply_rope(k_rope, cos, sin)
    kv = (rms_norm(c_kv, kv_norm) @ w_ukv).reshape(B, S, N_HEADS, QK_NOPE_DIM + V_HEAD_DIM)
    k_nope, v = kv[..., :QK_NOPE_DIM], kv[..., QK_NOPE_DIM:]
    scale = (QK_NOPE_DIM + QK_ROPE_DIM) ** -0.5
    q_nope = q_nope * scale
    q_rope = q_rope * scale
    outs = []
    for i in range(S // Q_BLOCK):
        q0, q1 = i * Q_BLOCK, (i + 1) * Q_BLOCK
        s = (jnp.einsum('bqhd,bkhd->bhqk', q_nope[:, q0:q1], k_nope[:, :q1])
             + jnp.einsum('bqhr,bkr->bhqk', q_rope[:, q0:q1], k_rope[:, :q1]))
        mask = jnp.arange(q0, q1)[:, None] >= jnp.arange(q1)[None, :]
        s = jnp.where(mask, s.astype(jnp.float32), -jnp.inf)
        p = jax.nn.softmax(s, axis=-1).astype(v.dtype)
        outs.append(jnp.einsum('bhqk,bkhd->bqhd', p, v[:, :q1]))
    o = jnp.concatenate(outs, axis=1).reshape(B, S, N_HEADS * V_HEAD_DIM)
    return o @ w_o


def multiscale_pool(h, pool_w, pool_scale):
    B, S, D = h.shape
    hf = h.astype(jnp.float32)
    t = jnp.arange(1, S + 1, dtype=jnp.float32)
    groups = []
    for g, w in enumerate(POOL_WINDOWS):
        hg = hf[..., g * POOL_GROUP_DIM:(g + 1) * POOL_GROUP_DIM]
        cs = jnp.cumsum(hg, axis=1)
        cs_lag = jnp.pad(cs[:, :S - w], ((0, 0), (w, 0), (0, 0)))
        cnt = jnp.minimum(t, float(w))[None, :, None]
        groups.append((cs - cs_lag) / cnt - hg)
    z = jnp.stack(groups, axis=2).astype(h.dtype)
    y = jnp.einsum('bsgc,gcd->bsgd', z, pool_w).reshape(B, S, D)
    return y * pool_scale


def swiglu(h, w_gate, w_up, w_down):
    return (jax.nn.silu(h @ w_gate) * (h @ w_up)) @ w_down


def moe_swiglu(h, router, w_gate, w_up, w_down):
    B, S, D = h.shape
    N = B * S
    NK = N * TOP_K
    xf = h.reshape(N, D)
    logits = (xf @ router).astype(jnp.float32)
    top_v, top_i = lax.top_k(logits, TOP_K)
    gates = jax.nn.softmax(top_v, axis=-1)
    flat_e = top_i.reshape(-1).astype(jnp.int32)
    flat_tok = jnp.arange(NK, dtype=jnp.int32) // TOP_K
    flat_g = gates.reshape(-1)
    order = jnp.argsort(flat_e)
    sorted_e = flat_e[order]
    counts = jnp.bincount(flat_e, length=N_EXPERTS).astype(jnp.int32)
    padded = (counts + MOE_BLOCK - 1) // MOE_BLOCK * MOE_BLOCK
    pad_end = jnp.cumsum(padded)
    pad_start = pad_end - padded
    start = jnp.cumsum(counts) - counts
    rank = jnp.arange(NK, dtype=jnp.int32) - start[sorted_e]
    dest = pad_start[sorted_e] + rank
    n_blocks = -(-NK // MOE_BLOCK) + N_EXPERTS
    P = n_blocks * MOE_BLOCK
    buf_tok = jnp.zeros((P,), jnp.int32).at[dest].set(flat_tok[order])
    buf_gate = jnp.zeros((P,), jnp.float32).at[dest].set(flat_g[order])
    block_e = jnp.clip(jnp.searchsorted(pad_end, jnp.arange(n_blocks, dtype=jnp.int32) * MOE_BLOCK,
                                        side='right'), 0, N_EXPERTS - 1).astype(jnp.int32)
    xb = xf[buf_tok].reshape(n_blocks, MOE_BLOCK, D)

    def expert_block(args):
        xblk, e = args
        return swiglu(xblk, w_gate[e], w_up[e], w_down[e])

    yb = lax.map(expert_block, (xb, block_e)).reshape(P, D)
    y = jnp.zeros((N, D), h.dtype).at[buf_tok].add(yb * buf_gate[:, None].astype(yb.dtype))
    return y.reshape(B, S, D)


def setup_inputs(seed: int = 0) -> dict:
    key = jax.random.key(seed)
    ks = iter(jax.random.split(key, 32))

    def w(shape, fan_in):
        return jax.random.normal(next(ks), shape, jnp.float32) * (fan_in ** -0.5)

    def gain(shape):
        return 1.0 + 0.05 * jax.random.normal(next(ks), shape, jnp.float32)

    LA, LB = N_MLA_LAYERS, N_POOL_LAYERS
    x = jax.random.normal(next(ks), (BATCH, SEQ, D_MODEL), jnp.float32)
    positions = (jnp.arange(SEQ, dtype=jnp.int32)[None, :]
                 + jax.random.randint(next(ks), (BATCH, 1), 0, 1024, dtype=jnp.int32))
    return {
        "x": x,
        "positions": positions,
        "attn_norm": gain((DEPTH, D_MODEL)),
        "ffn_norm": gain((DEPTH, D_MODEL)),
        "mla_w_down": w((LA, D_MODEL, Q_LORA_RANK + KV_LORA_RANK + QK_ROPE_DIM), D_MODEL),
        "mla_q_norm": gain((LA, Q_LORA_RANK)),
        "mla_w_uq": w((LA, Q_LORA_RANK, N_HEADS * (QK_NOPE_DIM + QK_ROPE_DIM)), Q_LORA_RANK),
        "mla_kv_norm": gain((LA, KV_LORA_RANK)),
        "mla_w_ukv": w((LA, KV_LORA_RANK, N_HEADS * (QK_NOPE_DIM + V_HEAD_DIM)), KV_LORA_RANK),
        "mla_w_o": w((LA, N_HEADS * V_HEAD_DIM, D_MODEL), N_HEADS * V_HEAD_DIM),
        "pool_w": w((LB, N_POOL_GROUPS, POOL_GROUP_DIM, POOL_GROUP_DIM), POOL_GROUP_DIM),
        "pool_scale": gain((LB, D_MODEL)),
        "ffn_w_gate": w((LA, D_MODEL, D_FF_DENSE), D_MODEL),
        "ffn_w_up": w((LA, D_MODEL, D_FF_DENSE), D_MODEL),
        "ffn_w_down": w((LA, D_FF_DENSE, D_MODEL), D_FF_DENSE),
        "moe_router": w((LB, D_MODEL, N_EXPERTS), D_MODEL),
        "moe_w_gate": w((LB, N_EXPERTS, D_MODEL, D_FF_EXPERT), D_MODEL),
        "moe_w_up": w((LB, N_EXPERTS, D_MODEL, D_FF_EXPERT), D_MODEL),
        "moe_w_down": w((LB, N_EXPERTS, D_FF_EXPERT, D_MODEL), D_FF_EXPERT),
        "final_norm": gain((D_MODEL,)),
    }


def reference(x, positions, attn_norm, ffn_norm, mla_w_down, mla_q_norm, mla_w_uq, mla_kv_norm,
              mla_w_ukv, mla_w_o, pool_w, pool_scale, ffn_w_gate, ffn_w_up, ffn_w_down,
              moe_router, moe_w_gate, moe_w_up, moe_w_down, final_norm):
    h = x
    cos, sin = rope_tables(positions)
    for layer in range(DEPTH):
        a = layer // 2
        hn = rms_norm(h, attn_norm[layer])
        if layer % N_MIXERS == 0:
            h = h + mla(hn, cos, sin, mla_w_down[a], mla_q_norm[a], mla_w_uq[a], mla_kv_norm[a],
                        mla_w_ukv[a], mla_w_o[a])
        else:
            h = h + multiscale_pool(hn, pool_w[a], pool_scale[a])
        hn = rms_norm(h, ffn_norm[layer])
        if layer % 2 == 0:
            h = h + swiglu(hn, ffn_w_gate[a], ffn_w_up[a], ffn_w_down[a])
        else:
            h = h + moe_swiglu(hn, moe_router[a], moe_w_gate[a], moe_w_up[a], moe_w_down[a])
    return rms_norm(h, final_norm)
```

```cpp
#include <hip/hip_runtime.h>
#include <cstdio>
#include <cstdint>

#define GAS __attribute__((address_space(1)))
#define LAS __attribute__((address_space(3)))
typedef unsigned short bf16_t;
typedef short bf16x8 __attribute__((ext_vector_type(8)));
typedef short s16x4 __attribute__((ext_vector_type(4)));
typedef float f32x2 __attribute__((ext_vector_type(2)));
typedef float f32x4 __attribute__((ext_vector_type(4)));
typedef float f32x16 __attribute__((ext_vector_type(16)));
typedef unsigned u32x2 __attribute__((ext_vector_type(2)));
typedef unsigned u32x4 __attribute__((ext_vector_type(4)));

constexpr int DM = 1024, NBATCH = 32, SEQ = 2048, NTOK = NBATCH * SEQ;
constexpr int NHEAD = 8, DNOPE = 128, DROPE = 64, DVH = 128, DQH = DNOPE + DROPE, QLR = 512, KVLR = 256;
constexpr int NDOWN = QLR + KVLR + DROPE  , NDOWNP = 1024;
constexpr int NQ = NHEAD * DQH  , NKV = NHEAD * (DNOPE + DVH)  ;
constexpr int FFD = 2688, NEXP = 8, FFE = 1344, FFEP = 1408;
constexpr int PSLOT = (NTOK * 2 / 256 + NEXP) * 256;
constexpr float RMS_EPS = 1e-6f;

__device__ __forceinline__ unsigned cvt_pk_bf16(float lo, float hi) { unsigned r; asm volatile("v_cvt_pk_bf16_f32 %0, %1, %2" : "=v"(r) : "v"(lo), "v"(hi)); return r; }
__device__ __forceinline__ int launder_v(int v) { asm volatile("" : "+v"(v)); return v; }
__device__ __forceinline__ float bf2f(unsigned short b) { return __uint_as_float((unsigned)b << 16); }
__device__ __forceinline__ float bflo(unsigned w) { return __uint_as_float(w << 16); }
__device__ __forceinline__ float bfhi(unsigned w) { return __uint_as_float(w & 0xffff0000u); }

namespace pg8 {
constexpr int BM = 256, BK = 64, HALF = 128, HTB = HALF * BK * 2  , STAGE_BYTES = 8 * HTB, NXCD = 8, WGM = 8;
__host__ __device__ __forceinline__ int lds_byte(int r, int c) { const int st = (r >> 4) * 2 + (c >> 5), rr = r & 15, cc = c & 31, ob = rr * 64 + cc * 2; return st * 1024 + (ob ^ (((ob >> 9) & 1) << 5)); }
__host__ __device__ __forceinline__ void stage_rc(int b, int& R, int& C) { const int st = b / 1024, sb = b % 1024, swz = sb ^ (((sb >> 9) & 1) << 5); R = (st >> 1) * 16 + swz / 64; C = (st & 1) * 32 + (swz % 64) / 2; }
__host__ __device__ __forceinline__ int perm32(int rho) { const int n = rho >> 4, i = rho & 15; return 8 * (i >> 2) + 4 * n + (i & 3); }

struct Unit { const char* a; const char* b; const int* rows; int nrows; int orow; int pn; int aux; };

struct RegOrder {
    const char* A; const char* B; size_t a_tile, b_tile, a_colstep; int nM, nN, nwg, G, c;
    __device__ __forceinline__ void init(const void* A_, size_t lda_b, const void* B_, size_t ldb_b, int M, int N, int G_, int c_, size_t a_colstep_ = 0) {
        A = (const char*)A_; B = (const char*)B_; a_tile = 256 * lda_b; b_tile = 256 * ldb_b; a_colstep = a_colstep_; nM = M / BM; nN = N / BM; nwg = nM * nN; G = G_; c = c_; }
    __device__ __forceinline__ bool next(int i, Unit& u) const {
        const long L = (long)i * G + c; if (L >= nwg) return false;
        int wgid = (int)L; { const int q = nwg / NXCD, r = nwg % NXCD, xcd = wgid % NXCD, off = wgid / NXCD; wgid = (xcd < r ? xcd * (q + 1) : r * (q + 1) + (xcd - r) * q) + off; }
        const int nig = WGM * nN, gid = wgid / nig, fm = gid * WGM, gsz = (nM - fm) < WGM ? (nM - fm) : WGM;
        const int pm = fm + ((wgid % nig) % gsz), pn = (wgid % nig) / gsz;
        u.a = A + (size_t)pm * a_tile + (size_t)pn * a_colstep; u.b = B + (size_t)pn * b_tile; u.rows = nullptr; u.nrows = 256; u.orow = pm * BM; u.pn = pn; u.aux = 0; return true;
    }
};

struct EpiBf16 {
    static constexpr bool PERM = true;
    bf16_t* O; int ldc;
    __device__ __forceinline__ void operator()(const f32x4 (&acc)[2][2][4][2], const Unit& u, int wr, int wc, int fr, int fq) const {
        const int row0 = u.orow + wr * 64 + fr, col0 = u.pn * BM + wc * 32 + 8 * fq;
#pragma unroll
        for (int ai = 0; ai < 2; ++ai)
#pragma unroll
            for (int m = 0; m < 4; ++m) { bf16_t* rowp = O + (size_t)(row0 + ai * HALF + m * 16) * ldc + col0;
#pragma unroll
                for (int bj = 0; bj < 2; ++bj) { const f32x4 v0 = acc[ai][bj][m][0], v1 = acc[ai][bj][m][1];
                    u32x4 w; w.x = cvt_pk_bf16(v0[0], v0[1]); w.y = cvt_pk_bf16(v0[2], v0[3]); w.z = cvt_pk_bf16(v1[0], v1[1]); w.w = cvt_pk_bf16(v1[2], v1[3]);
                    *(u32x4*)(rowp + bj * HALF) = w; } }
    }
};
__device__ __forceinline__ float silu_mul(float g, float u) { return g * u * __builtin_amdgcn_rcpf(1.0f + __builtin_amdgcn_exp2f(-1.4426950408889634f * g)); }
struct EpiSwiglu {
    static constexpr bool PERM = true;
    bf16_t* H; int ldh;
    __device__ __forceinline__ void operator()(const f32x4 (&acc)[2][2][4][2], const Unit& u, int wr, int wc, int fr, int fq) const {
        const int row0 = u.orow + wr * 64 + fr, col0 = u.pn * HALF + wc * 32 + 8 * fq;
#pragma unroll
        for (int ai = 0; ai < 2; ++ai)
#pragma unroll
            for (int m = 0; m < 4; ++m) { bf16_t* rowp = H + (size_t)(row0 + ai * HALF + m * 16) * ldh + col0;
                const f32x4 g0 = acc[ai][0][m][0], g1 = acc[ai][0][m][1], u0 = acc[ai][1][m][0], u1 = acc[ai][1][m][1];
                u32x4 w; w.x = cvt_pk_bf16(silu_mul(g0[0], u0[0]), silu_mul(g0[1], u0[1])); w.y = cvt_pk_bf16(silu_mul(g0[2], u0[2]), silu_mul(g0[3], u0[3]));
                w.z = cvt_pk_bf16(silu_mul(g1[0], u1[0]), silu_mul(g1[1], u1[1])); w.w = cvt_pk_bf16(silu_mul(g1[2], u1[2]), silu_mul(g1[3], u1[3]));
                *(u32x4*)rowp = w; }
    }
};
struct EpiResid {
    static constexpr bool PERM = false;
    const float* in; float* out; int ldc;
    __device__ __forceinline__ void operator()(const f32x4 (&acc)[2][2][4][2], const Unit& u, int wr, int wc, int fr, int fq) const {
        const int row0 = u.orow + wr * 64 + fr, col0 = u.pn * BM + wc * 32 + 4 * fq;
#pragma unroll
        for (int ai = 0; ai < 2; ++ai)
#pragma unroll
            for (int m = 0; m < 4; ++m) { const size_t off = (size_t)(row0 + ai * HALF + m * 16) * ldc + col0;
#pragma unroll
                for (int bj = 0; bj < 2; ++bj)
#pragma unroll
                    for (int n = 0; n < 2; ++n) { const f32x4 bs = *(const f32x4*)(in + off + bj * HALF + n * 16); *(f32x4*)(out + off + bj * HALF + n * 16) = bs + acc[ai][bj][m][n]; }
                if (m & 1) asm volatile("" ::: "memory"); }
    }
};
struct EpiQ {
    static constexpr bool PERM = true;
    bf16_t* Q; const float* cosT; const float* sinT;
    __device__ __forceinline__ void operator()(const f32x4 (&acc)[2][2][4][2], const Unit& u, int wr, int wc, int fr, int fq) const {
        const int row0 = u.orow + wr * 64 + fr;
        if (u.pn < 2) {
            const int h = 4 * u.pn + wc;
#pragma unroll
            for (int ai = 0; ai < 2; ++ai)
#pragma unroll
                for (int m = 0; m < 4; ++m) { const int row = row0 + ai * HALF + m * 16;
                    const f32x4 c0 = *(const f32x4*)(cosT + (size_t)row * 32 + 8 * fq), c1 = *(const f32x4*)(cosT + (size_t)row * 32 + 8 * fq + 4);
                    const f32x4 s0 = *(const f32x4*)(sinT + (size_t)row * 32 + 8 * fq), s1 = *(const f32x4*)(sinT + (size_t)row * 32 + 8 * fq + 4);
                    const f32x4 a0 = acc[ai][0][m][0], a1 = acc[ai][0][m][1], b0 = acc[ai][1][m][0], b1 = acc[ai][1][m][1];
                    const f32x4 x0 = a0 * c0 - b0 * s0, x1 = a1 * c1 - b1 * s1, y0 = b0 * c0 + a0 * s0, y1 = b1 * c1 + a1 * s1;
                    bf16_t* rp = Q + (size_t)row * NQ + h * DQH + DNOPE + 8 * fq;
                    u32x4 w; w.x = cvt_pk_bf16(x0[0], x0[1]); w.y = cvt_pk_bf16(x0[2], x0[3]); w.z = cvt_pk_bf16(x1[0], x1[1]); w.w = cvt_pk_bf16(x1[2], x1[3]);
                    *(u32x4*)rp = w;
                    w.x = cvt_pk_bf16(y0[0], y0[1]); w.y = cvt_pk_bf16(y0[2], y0[3]); w.z = cvt_pk_bf16(y1[0], y1[1]); w.w = cvt_pk_bf16(y1[2], y1[3]);
                    *(u32x4*)(rp + 32) = w; }
        } else {
#pragma unroll
            for (int ai = 0; ai < 2; ++ai)
#pragma unroll
                for (int m = 0; m < 4; ++m) { const int row = row0 + ai * HALF + m * 16;
#pragma unroll
                    for (int bj = 0; bj < 2; ++bj) { const int h = 2 * (u.pn - 2) + bj; const f32x4 v0 = acc[ai][bj][m][0], v1 = acc[ai][bj][m][1];
                        u32x4 w; w.x = cvt_pk_bf16(v0[0], v0[1]); w.y = cvt_pk_bf16(v0[2], v0[3]); w.z = cvt_pk_bf16(v1[0], v1[1]); w.w = cvt_pk_bf16(v1[2], v1[3]);
                        *(u32x4*)(Q + (size_t)row * NQ + h * DQH + wc * 32 + 8 * fq) = w; } }
        }
    }
};

__device__ __forceinline__ unsigned gather_off(const Unit& u, int idx, unsigned lda_b, unsigned cb) { const int tok = idx < u.nrows ? u.rows[idx] : 0; return (unsigned)tok * lda_b + cb; }
template <class Epi, class Sched, bool GATHER>
__device__ __forceinline__ void gemm_phase(LAS unsigned char* lds, const unsigned lda_b, const unsigned ldb_b, const int K, const Sched& S, const Epi& E) {
    const int tid = launder_v((int)threadIdx.x), wid = __builtin_amdgcn_readfirstlane(tid >> 6), lane = tid & 63, wr = wid >> 2, wc = wid & 3, fr = lane & 15, fq = lane >> 4;
    const int nt = K / BK;
    unsigned voffA[2], voffB[2]; int Rr[2]; unsigned Cb[2];
#pragma unroll
    for (int i = 0; i < 2; ++i) { int R, C; stage_rc(tid * 16 + i * 8192, R, C); const int Rb = Epi::PERM ? ((R & ~31) + perm32(R & 31)) : R;
        Rr[i] = R; Cb[i] = (unsigned)C * 2u; voffA[i] = (unsigned)R * lda_b + (unsigned)C * 2u; voffB[i] = (unsigned)Rb * ldb_b + (unsigned)C * 2u; }
    const size_t kstep = (size_t)(BK * 2);
    const size_t hstepA = (size_t)HALF * lda_b, hstepB = (size_t)HALF * ldb_b;
    const unsigned ldsw = (unsigned)wid * 1024u;
    const int aoff = lds_byte(wr * 64 + fr, fq * 8), boff = lds_byte(wc * 32 + fr, fq * 8);
    unsigned cv0[2] = {0u, 0u}, cv1[2] = {0u, 0u}, nv0[2] = {0u, 0u}, nv1[2] = {0u, 0u};
#define PG8_SA(b, h) (((b) * 2 + (h)) * HTB)
#define PG8_SB(b, h) ((4 + (b) * 2 + (h)) * HTB)
#define PG8_LOAD16(gp, ldsoff) __builtin_amdgcn_global_load_lds((const unsigned*)(gp), (LAS unsigned*)(lds + (ldsoff)), 16, 0, 0)
#define PG8_STAGE_B(bufoff, gbase, h) do { _Pragma("unroll") for (int _i = 0; _i < 2; ++_i) PG8_LOAD16((gbase) + (h) * hstepB + voffB[_i], (bufoff) + ldsw + _i * 8192); } while (0)
#define PG8_STAGE_A(bufoff, gbase, h, usenext) do { _Pragma("unroll") for (int _i = 0; _i < 2; ++_i) { unsigned _vo; \
        if constexpr (GATHER) { _vo = (usenext) ? ((h) ? nv1[_i] : nv0[_i]) : ((h) ? cv1[_i] : cv0[_i]); } else { _vo = voffA[_i] + (unsigned)((h) * hstepA); } \
        PG8_LOAD16((gbase) + _vo, (bufoff) + ldsw + _i * 8192); } } while (0)
#define PG8_LDA(dst, b, h) do { _Pragma("unroll") for (int m = 0; m < 4; ++m) _Pragma("unroll") for (int k = 0; k < 2; ++k) dst[m][k] = *(const LAS bf16x8*)(lds + PG8_SA(b, h) + aoff + m * 2048 + k * 1024); } while (0)
#define PG8_LDB(dst, b, h) do { _Pragma("unroll") for (int n = 0; n < 2; ++n) _Pragma("unroll") for (int k = 0; k < 2; ++k) dst[n][k] = *(const LAS bf16x8*)(lds + PG8_SB(b, h) + boff + n * 2048 + k * 1024); } while (0)
#define PG8_MMA(ai, bj, At, Bt) do { __builtin_amdgcn_s_setprio(1); _Pragma("unroll") for (int m = 0; m < 4; ++m) _Pragma("unroll") for (int n = 0; n < 2; ++n) _Pragma("unroll") for (int k = 0; k < 2; ++k) \
        acc[ai][bj][m][n] = __builtin_amdgcn_mfma_f32_16x16x32_bf16(Bt[n][k], At[m][k], acc[ai][bj][m][n], 0, 0, 0); __builtin_amdgcn_s_setprio(0); } while (0)
#define PG8_WAIT_V(n) asm volatile("s_waitcnt vmcnt(" #n ")" ::: "memory")
#define PG8_WAIT_L(n) asm volatile("s_waitcnt lgkmcnt(" #n ")" ::: "memory")
#define PG8_BAR __builtin_amdgcn_s_barrier()
#define PG8_SCHED __builtin_amdgcn_sched_barrier(0)
    Unit cur, nxt; int ui = 0;
    if (!S.next(0, cur)) return;
    f32x4 acc[2][2][4][2];
#pragma unroll
    for (int a = 0; a < 2; ++a)
#pragma unroll
        for (int b = 0; b < 2; ++b)
#pragma unroll
            for (int m = 0; m < 4; ++m)
#pragma unroll
                for (int n = 0; n < 2; ++n) acc[a][b][m][n] = (f32x4){0.f, 0.f, 0.f, 0.f};
    bf16x8 At[4][2], B0[2][2], B1[2][2];
    const char* cA = cur.a; const char* cB = cur.b;
    if constexpr (GATHER) {
#pragma unroll
        for (int i = 0; i < 2; ++i) { cv0[i] = gather_off(cur, Rr[i], lda_b, Cb[i]); cv1[i] = gather_off(cur, HALF + Rr[i], lda_b, Cb[i]); }
    }
    PG8_STAGE_B(PG8_SB(0, 0), cB, 0); PG8_STAGE_B(PG8_SB(0, 1), cB, 1); PG8_STAGE_A(PG8_SA(0, 0), cA, 0, false); PG8_STAGE_A(PG8_SA(0, 1), cA, 1, false);
    if (wr == 1) PG8_BAR;
    PG8_WAIT_V(2); PG8_BAR;
    PG8_STAGE_B(PG8_SB(1, 0), cB + kstep, 0); PG8_STAGE_A(PG8_SA(1, 0), cA + kstep, 0, false); PG8_STAGE_B(PG8_SB(1, 1), cB + kstep, 1);
    PG8_WAIT_V(6); PG8_BAR;
    for (;;) {
        const bool has_next = S.next(ui + 1, nxt);
        const char* nA = has_next ? nxt.a : cA; const char* nB = has_next ? nxt.b : cB;
        if constexpr (GATHER) {
#pragma unroll
            for (int i = 0; i < 2; ++i) { nv0[i] = has_next ? gather_off(nxt, Rr[i], lda_b, Cb[i]) : cv0[i]; nv1[i] = has_next ? gather_off(nxt, HALF + Rr[i], lda_b, Cb[i]) : cv1[i]; }
        }
        for (int t = 0; t < nt; t += 2) {
            const bool last = (t == nt - 2);
            const char* a1 = cA + (size_t)(t + 1) * kstep;
            const char* a2 = last ? nA : cA + (size_t)(t + 2) * kstep; const char* b2 = last ? nB : cB + (size_t)(t + 2) * kstep;
            const char* a3 = a2 + kstep; const char* b3 = b2 + kstep;
            PG8_LDB(B0, 0, 0); PG8_LDB(B1, 0, 1); PG8_SCHED; PG8_LDA(At, 0, 0); PG8_STAGE_A(PG8_SA(1, 1), a1, 1, false);
            PG8_WAIT_V(8); PG8_WAIT_L(0); PG8_BAR; PG8_MMA(0, 0, At, B0); PG8_MMA(0, 1, At, B1); PG8_BAR; PG8_SCHED;
            PG8_LDA(At, 0, 1); PG8_STAGE_B(PG8_SB(0, 0), b2, 0); PG8_STAGE_B(PG8_SB(0, 1), b2, 1); PG8_STAGE_A(PG8_SA(0, 0), a2, 0, last);
            PG8_WAIT_V(8); PG8_WAIT_L(0); PG8_BAR; PG8_MMA(1, 0, At, B0); PG8_MMA(1, 1, At, B1); PG8_BAR; PG8_SCHED;
            PG8_LDB(B0, 1, 0); PG8_LDB(B1, 1, 1); PG8_SCHED; PG8_LDA(At, 1, 0); PG8_STAGE_A(PG8_SA(0, 1), a2, 1, last);
            PG8_WAIT_V(8); PG8_WAIT_L(0); PG8_BAR; PG8_MMA(0, 0, At, B0); PG8_MMA(0, 1, At, B1); PG8_BAR; PG8_SCHED;
            PG8_LDA(At, 1, 1); PG8_STAGE_B(PG8_SB(1, 0), b3, 0); PG8_STAGE_B(PG8_SB(1, 1), b3, 1); PG8_STAGE_A(PG8_SA(1, 0), a3, 0, last);
            PG8_WAIT_V(8); PG8_WAIT_L(0); PG8_BAR; PG8_MMA(1, 0, At, B0); PG8_MMA(1, 1, At, B1); PG8_BAR; PG8_SCHED;
        }
        if (wr == 0) PG8_BAR;
        E(acc, cur, wr, wc, fr, fq);
        if (!has_next) break;
#pragma unroll
        for (int a = 0; a < 2; ++a)
#pragma unroll
            for (int b = 0; b < 2; ++b)
#pragma unroll
                for (int m = 0; m < 4; ++m)
#pragma unroll
                    for (int n = 0; n < 2; ++n) acc[a][b][m][n] = (f32x4){0.f, 0.f, 0.f, 0.f};
        cur = nxt; cA = nA; cB = nB; ++ui;
        if constexpr (GATHER) {
#pragma unroll
            for (int i = 0; i < 2; ++i) { cv0[i] = nv0[i]; cv1[i] = nv1[i]; }
        }
        if (wr == 1) PG8_BAR;
    }
    PG8_WAIT_V(0);
    PG8_BAR;
#undef PG8_SA
#undef PG8_SB
#undef PG8_LOAD16
#undef PG8_STAGE_A
#undef PG8_STAGE_B
#undef PG8_LDA
#undef PG8_LDB
#undef PG8_MMA
#undef PG8_WAIT_V
#undef PG8_WAIT_L
#undef PG8_BAR
#undef PG8_SCHED
}
}
namespace att {
constexpr int NW = 8, QBLK = 32, KVBLK = 64, QB = NW * QBLK;
constexpr int DQK = 192, DV = 128;
constexpr int QS = NQ, KNS = NKV, KRS = DROPE, OS = DM;
constexpr int SHM_V = KVBLK * DV * 2, SHM_K = KVBLK * DQK * 2;
constexpr int LDS_QR = 2 * SHM_V + 2 * SHM_K + NW * 64 * 4;
constexpr int LDS_BYTES = LDS_QR + NW * 4096;
constexpr float SCALE = 0.07216878364870322f;
constexpr float THR = 8.f;
#define KSWZ(row, ch) ((row) * 384 + ((((ch) ^ (((row) >> 1) & 7))) << 4))
#define SBAR() __builtin_amdgcn_sched_barrier(0)
__device__ __forceinline__ int v_st(int k, int c) { const int kk = (k & ~0xC) | ((k & 4) << 1) | ((k & 8) >> 1); return ((kk >> 3) * 4 + (c >> 5)) * 512 + ((kk & 7) * 32 + (c & 31)) * 2; }
__device__ __forceinline__ int v_rd_base(int lane) { return ((lane & 3) << 3) | (((lane >> 2) & 3) << 6) | (((lane >> 4) & 1) << 5) | (((lane >> 5) & 1) << 8); }
constexpr int v_rd_off(int d0, int ks, int half) { return d0 * 512 + ks * 4096 + half * 2048; }
__device__ __forceinline__ int crow(int r, int hi) { return (r & 3) + 8 * (r >> 2) + 4 * hi; }
__device__ __forceinline__ void mask_tile(f32x16& p0, f32x16& p1, int dq) {
    const float NEG = -__builtin_inff();
#pragma unroll
    for (int r = 0; r < 16; ++r) {
        const int c = (r & 3) + 8 * (r >> 2);
        if (dq - c < 0) p0[r] = NEG;
        if (dq - c - 32 < 0) p1[r] = NEG;
    }
}
__device__ __forceinline__ void partialSM(f32x16& p0, f32x16& p1, float& m_reg, float& mn, float& alpha) {
    float pmax = p0[0]; for (int r = 1; r < 16; ++r) pmax = fmaxf(pmax, p0[r]); for (int r = 0; r < 16; ++r) pmax = fmaxf(pmax, p1[r]);
    { auto rr = __builtin_amdgcn_permlane32_swap(__float_as_uint(pmax), __float_as_uint(pmax), false, false);
      pmax = fmaxf(__uint_as_float(rr[0]), __uint_as_float(rr[1])); }
    constexpr float C2 = 1.4426950408889634f * SCALE;
    if (__builtin_expect(__all((pmax - m_reg) * SCALE <= THR), 1)) { mn = m_reg; alpha = 1.f; }
    else { mn = fmaxf(m_reg, pmax); alpha = __builtin_amdgcn_exp2f((m_reg - mn) * C2); m_reg = mn; }
    const float mnL = -mn * C2;
    for (int r = 0; r < 16; ++r) p0[r] = fmaf(p0[r], C2, mnL); for (int r = 0; r < 16; ++r) p1[r] = fmaf(p1[r], C2, mnL);
    for (int r = 0; r < 16; ++r) p0[r] = __builtin_amdgcn_exp2f(p0[r]);
}
__device__ __forceinline__ void finishSM(f32x16& p0, f32x16& p1, float alpha, float& l_reg, bf16x8& pa0, bf16x8& pa1, bf16x8& pa2, bf16x8& pa3) {
    for (int r = 0; r < 16; ++r) p1[r] = __builtin_amdgcn_exp2f(p1[r]);
    float ps = 0; for (int r = 0; r < 16; ++r) ps += p0[r]; for (int r = 0; r < 16; ++r) ps += p1[r];
    { auto rr = __builtin_amdgcn_permlane32_swap(__float_as_uint(ps), __float_as_uint(ps), false, false);
      ps = __uint_as_float(rr[0]) + __uint_as_float(rr[1]); }
    l_reg = l_reg * alpha + ps;
#define PK4(P, B_, OUT) do { unsigned a0 = cvt_pk_bf16(P[B_+0], P[B_+1]), a1 = cvt_pk_bf16(P[B_+2], P[B_+3]);                          \
        unsigned b0 = cvt_pk_bf16(P[B_+4], P[B_+5]), b1 = cvt_pk_bf16(P[B_+6], P[B_+7]);                                             \
        auto r0 = __builtin_amdgcn_permlane32_swap(a0, b0, false, false); auto r1 = __builtin_amdgcn_permlane32_swap(a1, b1, false, false); \
        u32x4 w = {r0[0], r1[0], r0[1], r1[1]}; OUT = *reinterpret_cast<bf16x8*>(&w); } while (0)
    PK4(p0, 0, pa0); PK4(p0, 8, pa1); PK4(p1, 0, pa2); PK4(p1, 8, pa3);
#undef PK4
}
template <int KB>
__device__ __forceinline__ void qkt(f32x16& p0, f32x16& p1, const char* K_lds, int r32, int hi, const bf16x8* qr, const char* qrl) {
    p0 = f32x16{}; p1 = f32x16{};
    const char* kb[4];
#pragma unroll
    for (int dd = 0; dd < 4; ++dd) kb[dd] = K_lds + KB * SHM_K + KSWZ(r32, dd * 2 + hi);
#pragma unroll
    for (int d0 = 0; d0 < 12; ++d0) { const char* a = kb[d0 & 3] + (d0 >> 2) * 128;
        bf16x8 b0 = *reinterpret_cast<const bf16x8*>(a);
        bf16x8 b1 = *reinterpret_cast<const bf16x8*>(a + 32 * 384);
        const bf16x8 qf = d0 < 8 ? qr[d0 & 7] : *reinterpret_cast<const bf16x8*>(qrl + (d0 - 8) * 1024);
        p0 = __builtin_amdgcn_mfma_f32_32x32x16_bf16(b0, qf, p0, 0, 0, 0);
        p1 = __builtin_amdgcn_mfma_f32_32x32x16_bf16(b1, qf, p1, 0, 0, 0);
        if ((d0 & 3) == 3 && d0 < 11) SBAR(); }
}
template <int VB>
__device__ __forceinline__ void pv_tile(f32x16* o, int vb0, bf16x8 pa0, bf16x8 pa1, bf16x8 pa2, bf16x8 pa3) {
#define TRRD(dst, off) asm volatile("ds_read_b64_tr_b16 %0, %1 offset:%2" : "=&v"(dst) : "v"(vb0), "i"(off) : "memory")
#define PV_D0(d0) do { s16x4 l0, l1, l2, l3, h0, h1, h2, h3; constexpr int b_ = VB * SHM_V + v_rd_off(d0, 0, 0); \
        TRRD(l0, b_); TRRD(h0, b_ + 2048); TRRD(l1, b_ + 4096); TRRD(h1, b_ + 6144); TRRD(l2, b_ + 8192); TRRD(h2, b_ + 10240); TRRD(l3, b_ + 12288); TRRD(h3, b_ + 14336); \
        asm volatile("s_waitcnt lgkmcnt(0)" ::: "memory"); SBAR();   \
        o[d0] = __builtin_amdgcn_mfma_f32_32x32x16_bf16(pa0, (bf16x8){l0[0], l0[1], l0[2], l0[3], h0[0], h0[1], h0[2], h0[3]}, o[d0], 0, 0, 0);   \
        o[d0] = __builtin_amdgcn_mfma_f32_32x32x16_bf16(pa1, (bf16x8){l1[0], l1[1], l1[2], l1[3], h1[0], h1[1], h1[2], h1[3]}, o[d0], 0, 0, 0);   \
        o[d0] = __builtin_amdgcn_mfma_f32_32x32x16_bf16(pa2, (bf16x8){l2[0], l2[1], l2[2], l2[3], h2[0], h2[1], h2[2], h2[3]}, o[d0], 0, 0, 0);   \
        o[d0] = __builtin_amdgcn_mfma_f32_32x32x16_bf16(pa3, (bf16x8){l3[0], l3[1], l3[2], l3[3], h3[0], h3[1], h3[2], h3[3]}, o[d0], 0, 0, 0); } while (0)
    PV_D0(0); PV_D0(1); PV_D0(2); PV_D0(3);
#undef PV_D0
#undef TRRD
}
struct BlockRef { const bf16_t* Q; const bf16_t* Kn; const bf16_t* Kr; const bf16_t* V; bf16_t* O; int P0; };
struct Seam { bf16x8 qr[8]; bf16x8 st_v0, st_v1, st_k0, st_k1, st_k2; };
#define VMW() asm volatile("s_waitcnt vmcnt(0)" ::: "memory")
#define VMWN(n) asm volatile("s_waitcnt vmcnt(%0)" :: "i"(n) : "memory")
#define LD8(p) (*reinterpret_cast<const bf16x8*>(p))
#define SLOAD_H(R_, k0) do { S.st_v0 = LD8((R_).V + (size_t)((k0) + sr) * KNS + sc); S.st_v1 = LD8((R_).V + (size_t)((k0) + 32 + sr) * KNS + sc);              \
                             S.st_k0 = LD8((R_).Kn + (size_t)((k0) + sr) * KNS + sc); S.st_k1 = LD8((R_).Kn + (size_t)((k0) + 32 + sr) * KNS + sc);            \
                             S.st_k2 = LD8((R_).Kr + (size_t)((k0) + rr) * KRS + rc); } while (0)
#define SWRITE_HK(bf) do { *(bf16x8*)(K_lds + (bf) * SHM_K + kws) = S.st_k0; *(bf16x8*)(K_lds + (bf) * SHM_K + kws + 32 * 384) = S.st_k1; *(bf16x8*)(K_lds + (bf) * SHM_K + kws2) = S.st_k2; } while (0)
#define SWRITE_HV(bf) do { *(bf16x8*)(V_lds + (bf) * SHM_V + vst0) = S.st_v0; *(bf16x8*)(V_lds + (bf) * SHM_V + vst1) = S.st_v1; } while (0)
#define SWRITE_H(bf) do { SWRITE_HV(bf); SWRITE_HK(bf); } while (0)
#define ATT_IDX const int tid = launder_v((int)threadIdx.x), wid = __builtin_amdgcn_readfirstlane(tid >> 6), lane = tid & 63, r32 = lane & 31, hi = lane >> 5; \
    const int sr = tid >> 4, sc = (tid & 15) * 8, rr = tid >> 3, rc = (tid & 7) * 8, kws = KSWZ(sr, (tid & 15)), kws2 = KSWZ(rr, 16 + (tid & 7));
__device__ __forceinline__ void attn_block(const BlockRef& cur, char* lds) {
    ATT_IDX;
    Seam S;
    const int NT = cur.P0 / KVBLK + QB / KVBLK;
    const int qlo = cur.P0 + wid * QBLK, qm = qlo + r32 - 4 * hi;
    char* V_lds = lds; char* K_lds = lds + 2 * SHM_V;
    float* ws = (float*)(lds + 2 * SHM_V + 2 * SHM_K) + wid * 64; float* li_l = ws, * al_l = ws + 32;
    float m_reg = -1e30f, l_reg = 0; f32x16 o[4] = {};
    const int vst0 = v_st(sr, sc), vst1 = v_st(32 + sr, sc);
    const int vb0 = (int)(uintptr_t)V_lds + v_rd_base(lane);
    char* qrl = lds + LDS_QR + wid * 4096 + lane * 16;
#define RESC(a) do { if (__any((a) < 1.f)) { if (hi == 0) al_l[r32] = (a); asm volatile("s_waitcnt lgkmcnt(0)" ::: "memory");              \
                     for (int d_ = 0; d_ < 4; ++d_) for (int r = 0; r < 16; ++r) o[d_][r] *= al_l[crow(r, hi)]; } } while (0)
#define KBASE(t) ((t) * KVBLK)
#define MASKT(P0_, P1_, t) do { const int kb_ = KBASE(t); if (kb_ + KVBLK - 1 > qlo) mask_tile(P0_, P1_, qm - kb_); } while (0)
    SLOAD_H(cur, 0);
#pragma unroll
    for (int d0 = 0; d0 < 8; ++d0) S.qr[d0] = LD8(cur.Q + (size_t)(wid * QBLK + r32) * QS + d0 * 16 + hi * 8);
    { bf16x8 t0 = LD8(cur.Q + (size_t)(wid * QBLK + r32) * QS + 128 + hi * 8), t1 = LD8(cur.Q + (size_t)(wid * QBLK + r32) * QS + 144 + hi * 8),
             t2 = LD8(cur.Q + (size_t)(wid * QBLK + r32) * QS + 160 + hi * 8), t3 = LD8(cur.Q + (size_t)(wid * QBLK + r32) * QS + 176 + hi * 8);
      *(bf16x8*)(qrl) = t0; *(bf16x8*)(qrl + 1024) = t1; *(bf16x8*)(qrl + 2048) = t2; *(bf16x8*)(qrl + 3072) = t3; }
    VMW(); SWRITE_H(0);
    __syncthreads();
    f32x16 p0, p1; float mn, al; bf16x8 pa0, pa1, pa2, pa3;
#define TILE_STEP(t, BF) do {                                                                                                 \
        if ((t) + 1 < NT) { SLOAD_H(cur, KBASE((t) + 1)); }                                                                    \
        SBAR(); qkt<BF>(p0, p1, K_lds, r32, hi, S.qr, qrl);                                                                   \
        MASKT(p0, p1, (t)); partialSM(p0, p1, m_reg, mn, al); RESC(al);                                                        \
        finishSM(p0, p1, al, l_reg, pa0, pa1, pa2, pa3); SBAR();                                                              \
        pv_tile<BF>(o, vb0, pa0, pa1, pa2, pa3);                                                                              \
        if ((t) + 1 < NT) { VMW(); SWRITE_H(1 - BF); }                                                                         \
        __syncthreads(); } while (0)
    for (int t = 0; t < NT; t += 2) { TILE_STEP(t, 0); TILE_STEP(t + 1, 1); }
    if (hi == 0) li_l[r32] = l_reg; asm volatile("s_waitcnt lgkmcnt(0)" ::: "memory");
    float rli[16];
#pragma unroll
    for (int r = 0; r < 16; ++r) rli[r] = __builtin_amdgcn_rcpf(li_l[crow(r, hi)]);
    bf16_t* Ow = cur.O + (size_t)(wid * QBLK) * OS;
#pragma unroll
    for (int r = 0; r < 16; ++r) { const int orow = crow(r, hi);
#pragma unroll
        for (int d0 = 0; d0 < 4; ++d0) { const float v = o[d0][r] * rli[r];
            const float vn = __shfl_xor(v, 1);
            if ((r32 & 1) == 0) *(unsigned*)(Ow + (size_t)orow * OS + d0 * 32 + r32) = cvt_pk_bf16(v, vn); } }
    __syncthreads();
#undef RESC
#undef KBASE
#undef MASKT
#undef TILE_STEP
}
#undef VMW
#undef VMWN
#undef LD8
#undef SLOAD_H
#undef SWRITE_HK
#undef SWRITE_HV
#undef SWRITE_H
#undef ATT_IDX
#undef KSWZ
#undef SBAR

__device__ __forceinline__ BlockRef make_ref(int L, int pass, const bf16_t* Qb, const bf16_t* KNVb, const bf16_t* KRb, bf16_t* Ob) {
    const int bh = L >> 2, x = L & 3, qb = pass ? 7 - x : x, b = bh >> 3, h = bh & 7; const size_t rb = (size_t)b * SEQ;
    BlockRef r; r.Q = Qb + (rb + (size_t)qb * QB) * QS + h * DQH; r.Kn = KNVb + rb * KNS + h * (DNOPE + DVH); r.Kr = KRb + rb * KRS; r.V = KNVb + rb * KNS + h * (DNOPE + DVH) + DNOPE;
    r.O = Ob + (rb + (size_t)qb * QB) * OS + h * DVH; r.P0 = qb * QB; return r;
}
__device__ __forceinline__ void attn_phase(char* lds, const bf16_t* Qb, const bf16_t* KNVb, const bf16_t* KRb, bf16_t* Ob, int first, int stride) {
    constexpr int total = NBATCH * NHEAD * 4;
    for (int L = first; L < total; L += stride) {
        for (int pass = 0; pass < 2; ++pass) { const BlockRef cur = make_ref(L, pass, Qb, KNVb, KRb, Ob); attn_block(cur, lds); }
    }
}
}
constexpr int NWAVES = 8;
constexpr size_t MiB = 1u << 20;
constexpr size_t WS_CTL = 0, CTL_ZERO_BYTES = 1 * MiB;
constexpr size_t WS_COS = 1 * MiB, WS_SIN = 9 * MiB;
constexpr size_t WS_LIST = 17 * MiB;
constexpr size_t WS_TOKINFO = 19 * MiB;
constexpr size_t WS_DBG = 21 * MiB;
constexpr size_t WS_WDN = 24 * MiB, WS_WUQ = 28 * MiB, WS_WUKV = 31 * MiB, WS_WO = 33 * MiB, WS_WPOOL = 37 * MiB, WS_WGU = 38 * MiB, WS_WD = 59 * MiB, WS_MWGU = 70 * MiB, WS_MWD = 158 * MiB;
constexpr size_t WS_ACT = 202 * MiB;
constexpr size_t WS_XN = WS_ACT;
constexpr size_t WS_DOWN = WS_ACT + 128 * MiB, WS_CQN = WS_ACT + 256 * MiB, WS_CKVN = WS_ACT + 320 * MiB, WS_KR = WS_ACT + 352 * MiB, WS_Q = WS_ACT + 360 * MiB, WS_KNV = WS_ACT + 552 * MiB;
constexpr size_t WS_HID = WS_ACT + 128 * MiB;
constexpr size_t WS_YB = WS_ACT + 486 * MiB;
constexpr size_t WS_END = WS_ACT + 808 * MiB;
static_assert(WS_MWD + (size_t)16 * 1024 * FFEP * 2 <= WS_ACT && WS_MWGU + (size_t)16 * 2 * FFEP * 1024 * 2 <= WS_MWD && WS_WD + (size_t)2 * 1024 * FFD * 2 <= WS_MWGU && WS_WGU + (size_t)2 * 2 * FFD * 1024 * 2 <= WS_WD, "weights map");
static_assert(WS_HID + (size_t)PSLOT * FFEP * 2 <= WS_YB && WS_YB + (size_t)PSLOT * 1024 * 2 <= WS_END && WS_HID + (size_t)NTOK * FFD * 2 <= WS_END && WS_KNV + (size_t)NTOK * NKV * 2 <= WS_END && WS_Q + (size_t)NTOK * NQ * 2 <= WS_KNV, "activation map");
constexpr int CW_TMO = 0, CW_CODE = 1, CW_CNT = 1024  , CW_DBG = 2048, CW_BAR = 4096  ;
constexpr int RING_OFF = 0, RING_BYTES = 131072, LDSCTL_OFF = RING_BYTES, MISC_OFF = LDSCTL_OFF + 320, LDS_BYTES = 147456;

typedef GAS unsigned gu32;
#define RLX_AGENT __ATOMIC_RELAXED, __HIP_MEMORY_SCOPE_AGENT
#define LDS_WAIT() asm volatile("s_waitcnt lgkmcnt(0)" ::: "memory")
#define VM_WAIT() asm volatile("s_waitcnt vmcnt(0)" ::: "memory")

#define XB_TMO      128
#define XB_XCNT(j)  (256  + 64 * (j))
#define XB_XSUB(j)  (1280 + 64 * (j))
#define XB_XGEN(j)  (2304 + 64 * (j))
#define XB_TOP      3328
#define XB_TOPGEN   3392
#define XCD_BAR_WORDS 3456
#define XB_SPIN_CAP (1u << 18)
__device__ __forceinline__ unsigned xb_ld(unsigned* p)              { return __hip_atomic_load(p, __ATOMIC_RELAXED, __HIP_MEMORY_SCOPE_AGENT); }
__device__ __forceinline__ unsigned xb_add(unsigned* p, unsigned v) { return __hip_atomic_fetch_add(p, v, __ATOMIC_RELAXED, __HIP_MEMORY_SCOPE_AGENT); }
__device__ __forceinline__ unsigned xb_xcc_id() { return (unsigned)__builtin_amdgcn_s_getreg((3 << 11) | 20) & 0xFu; }
#define XB_SPIN(cond, bar) do { unsigned _sp = 0; while (cond) { __builtin_amdgcn_s_sleep(1); \
    if ((++_sp & 255u) == 0u) { if (xb_ld(&(bar)[XB_TMO])) break; if (_sp > XB_SPIN_CAP) { atomicAdd(&(bar)[XB_TMO], 1u); break; } } } } while (0)
struct XcdBarrier { unsigned* bar; unsigned x; volatile LAS unsigned* st; };
__device__ __forceinline__ XcdBarrier xcd_barrier_post(unsigned* bar, volatile LAS unsigned* st) {
    XcdBarrier b; b.bar = bar; b.x = xb_xcc_id(); b.st = st;
    if (threadIdx.x == 0) (void)xb_add(&bar[XB_XCNT(b.x)], 1u);
    return b;
}
__device__ __forceinline__ void xcd_barrier_complete(unsigned* bar, unsigned x, unsigned& nloc, unsigned& nx) {
    const unsigned G = gridDim.x * gridDim.y * gridDim.z;
    unsigned sum, cnt, mine, sp = 0u;
    for (;;) {
        sum = 0u; cnt = 0u; mine = 0u;
#pragma unroll
        for (unsigned j = 0; j < 16; ++j) { const unsigned c = xb_ld(&bar[XB_XCNT(j)]); sum += c; cnt += (c > 0u) ? 1u : 0u; mine = (j == x) ? c : mine; }
        if (sum == G) break;
        __builtin_amdgcn_s_sleep(1);
        if ((++sp & 255u) == 0u) { if (xb_ld(&bar[XB_TMO])) break; if (sp > XB_SPIN_CAP) { atomicAdd(&bar[XB_TMO], 1u); break; } }
    }
    nloc = mine > 0u ? mine : 1u; nx = cnt > 0u ? cnt : 1u;
}
__device__ __forceinline__ void xcd_barrier(const XcdBarrier& b) {
    asm volatile("s_waitcnt vmcnt(0)" ::: "memory");
    __syncthreads();
    if (threadIdx.x == 0) {
        unsigned* bar = b.bar;
        __builtin_amdgcn_s_waitcnt(0);
        unsigned nloc = b.st[0], nx = b.st[1];
        if (nloc == 0u) { xcd_barrier_complete(bar, b.x, nloc, nx); b.st[0] = nloc; b.st[1] = nx; }
        const unsigned old = xb_add(&bar[XB_XSUB(b.x)], 1u);
        const unsigned gen = old / nloc;
        if (old + 1u == (gen + 1u) * nloc) {
            __builtin_amdgcn_fence(__ATOMIC_RELEASE, "agent");
            asm volatile("s_waitcnt vmcnt(0)" ::: "memory");
            const unsigned og = xb_add(&bar[XB_TOP], 1u);
            const unsigned tg = og / nx;
            if (og + 1u == (tg + 1u) * nx) xb_add(&bar[XB_TOPGEN], 1u);
            else XB_SPIN(xb_ld(&bar[XB_TOPGEN]) == tg, bar);
            __builtin_amdgcn_fence(__ATOMIC_ACQUIRE, "agent");
            xb_add(&bar[XB_XGEN(b.x)], 1u);
            asm volatile("s_waitcnt vmcnt(0)" ::: "memory");
        } else {
            XB_SPIN(xb_ld(&bar[XB_XGEN(b.x)]) == gen, bar);
            __builtin_amdgcn_fence(__ATOMIC_ACQUIRE, "agent");
            asm volatile("s_waitcnt vmcnt(0)" ::: "memory");
        }
    }
    __syncthreads();
}

constexpr int PT_OFF_ = LDSCTL_OFF + 512;
__device__ __forceinline__ unsigned rfl(unsigned v);
__device__ __forceinline__ const float* ptab(LAS unsigned char* L, int i);
struct Frame { LAS unsigned char* lds; volatile LAS unsigned* MISC; gu32* ctl; unsigned char* ws; int tid, lane, wave, vcu, G; };

__device__ __forceinline__ float wave_sum(float v) {
#pragma unroll
    for (int o = 1; o < 64; o <<= 1) v += __shfl_xor(v, o);
    return v;
}
__device__ __forceinline__ unsigned rfl(unsigned v) { return (unsigned)__builtin_amdgcn_readfirstlane((int)v); }

__device__ __forceinline__ int rowmap(int mode, int n) {
    if (mode == 0) return n;
    if (mode == 1) return (n >> 7) * 256 + (n & 127);
    if (mode == 2) return (n >> 7) * 256 + 128 + (n & 127);
    const int h = n / DQH, d = n - h * DQH;
    if (d < DNOPE) return 512 + h * DNOPE + d;
    if (d < DNOPE + 32) return (h >> 2) * 256 + (h & 3) * 32 + (d - DNOPE);
    return (h >> 2) * 256 + 128 + (h & 3) * 32 + (d - DNOPE - 32);
}
__device__ __forceinline__ void transpose_item(const float* W, int N, bf16_t* WT, int ldd, int mode, const float* nscale, LAS float* scr, int item, int lane) {
    const int nblk = N / 32, kb = item / nblk, nb = item % nblk, k0 = 64 * kb, n0 = 32 * nb;
    const float sc = nscale ? nscale[n0 + (lane & 31)] : 1.0f;
#pragma unroll 8
    for (int i = 0; i < 32; ++i) { const int kk = 2 * i + (lane >> 5); scr[kk * 33 + (lane & 31)] = W[(size_t)(k0 + kk) * N + n0 + (lane & 31)] * sc; }
    LDS_WAIT(); asm volatile("" ::: "memory");
    const int c = lane & 7;
#pragma unroll
    for (int j = 0; j < 4; ++j) { const int n = (lane >> 3) + 8 * j; const LAS float* s = scr + (8 * c) * 33 + n;
        u32x4 o; o.x = cvt_pk_bf16(s[0 * 33], s[1 * 33]); o.y = cvt_pk_bf16(s[2 * 33], s[3 * 33]); o.z = cvt_pk_bf16(s[4 * 33], s[5 * 33]); o.w = cvt_pk_bf16(s[6 * 33], s[7 * 33]);
        *(GAS u32x4*)(WT + (size_t)rowmap(mode, n0 + n) * ldd + k0 + 8 * c) = o; }
    LDS_WAIT(); asm volatile("" ::: "memory");
}
struct MatDesc { const float* src; bf16_t* dst; const float* nscale; int K, N, ldd, mode; };
struct InPtrs { const float* p[20]; };
constexpr int N_MATS = 70;
__device__ __forceinline__ MatDesc mat_desc(int m, LAS unsigned char* L, unsigned char* ws) {
    MatDesc d; d.nscale = nullptr; d.mode = 0;
    if (m < 2)       { const int a = m;      d.src = ptab(L, 4) + (size_t)a * DM * NDOWN;    d.K = DM;   d.N = NDOWN; d.dst = (bf16_t*)(ws + WS_WDN) + (size_t)a * NDOWNP * DM;  d.ldd = DM; }
    else if (m < 4)  { const int a = m - 2;  d.src = ptab(L, 6) + (size_t)a * QLR * NQ;      d.K = QLR;  d.N = NQ;    d.dst = (bf16_t*)(ws + WS_WUQ) + (size_t)a * NQ * QLR;     d.ldd = QLR; d.mode = 3; }
    else if (m < 6)  { const int a = m - 4;  d.src = ptab(L, 8) + (size_t)a * KVLR * NKV;    d.K = KVLR; d.N = NKV;   d.dst = (bf16_t*)(ws + WS_WUKV) + (size_t)a * NKV * KVLR;  d.ldd = KVLR; }
    else if (m < 8)  { const int a = m - 6;  d.src = ptab(L, 9) + (size_t)a * DM * DM;       d.K = DM;   d.N = DM;    d.dst = (bf16_t*)(ws + WS_WO) + (size_t)a * DM * DM;       d.ldd = DM; }
    else if (m < 16) { const int i = m - 8;  d.src = ptab(L, 10) + (size_t)i * 256 * 256;    d.K = 256;  d.N = 256;   d.dst = (bf16_t*)(ws + WS_WPOOL) + (size_t)i * 256 * 256;  d.ldd = 256; d.nscale = ptab(L, 11) + i * 256; }
    else if (m < 18) { const int a = m - 16; d.src = ptab(L, 12) + (size_t)a * DM * FFD;     d.K = DM;   d.N = FFD;   d.dst = (bf16_t*)(ws + WS_WGU) + (size_t)a * 2 * FFD * DM; d.ldd = DM; d.mode = 1; }
    else if (m < 20) { const int a = m - 18; d.src = ptab(L, 13) + (size_t)a * DM * FFD;     d.K = DM;   d.N = FFD;   d.dst = (bf16_t*)(ws + WS_WGU) + (size_t)a * 2 * FFD * DM; d.ldd = DM; d.mode = 2; }
    else if (m < 22) { const int a = m - 20; d.src = ptab(L, 14) + (size_t)a * FFD * DM;     d.K = FFD;  d.N = DM;    d.dst = (bf16_t*)(ws + WS_WD) + (size_t)a * DM * FFD;      d.ldd = FFD; }
    else if (m < 38) { const int i = m - 22; d.src = ptab(L, 16) + (size_t)i * DM * FFE;     d.K = DM;   d.N = FFE;   d.dst = (bf16_t*)(ws + WS_MWGU) + (size_t)i * 2 * FFEP * DM; d.ldd = DM; d.mode = 1; }
    else if (m < 54) { const int i = m - 38; d.src = ptab(L, 17) + (size_t)i * DM * FFE;     d.K = DM;   d.N = FFE;   d.dst = (bf16_t*)(ws + WS_MWGU) + (size_t)i * 2 * FFEP * DM; d.ldd = DM; d.mode = 2; }
    else             { const int i = m - 54; d.src = ptab(L, 18) + (size_t)i * FFE * DM;     d.K = FFE;  d.N = DM;    d.dst = (bf16_t*)(ws + WS_MWD) + (size_t)i * DM * FFEP;    d.ldd = FFEP; }
    return d;
}
__device__ __forceinline__ void p0_prologue(Frame& F) {
    const int* positions = (const int*)ptab(F.lds, 1);
    LAS float* scr = (LAS float*)(F.lds + RING_OFF + F.wave * 16384);
    const int gw = F.vcu * NWAVES + F.wave, NGW = F.G * NWAVES;
    int cum = 0;
    for (int m = 0; m < N_MATS; ++m) {
        const MatDesc d = mat_desc(m, F.lds, F.ws);
        const int nitems = (d.K / 64) * (d.N / 32);
        int first = gw - (cum % NGW); if (first < 0) first += NGW;
        for (int it = first; it < nitems; it += NGW) transpose_item(d.src, d.N, d.dst, d.ldd, d.mode, d.nscale, scr, it, F.lane);
        cum += nitems;
    }
    const int gt = gw * 64 + F.lane, NGT = NGW * 64; const u32x4 z4 = (u32x4){0u, 0u, 0u, 0u};
    for (int i = gt; i < 2 * 192 * 128; i += NGT) { const int a = i / (192 * 128), r = i % (192 * 128); *(GAS u32x4*)((bf16_t*)(F.ws + WS_WDN) + (size_t)a * NDOWNP * DM + (size_t)NDOWN * DM + (size_t)r * 8) = z4; }
    for (int i = gt; i < 16 * 128 * 128; i += NGT) { const int e = i / (128 * 128), r = (i / 128) % 128, c = i % 128; const int row = 2560 + (r < 64 ? 64 + r : 192 + (r - 64));
        *(GAS u32x4*)((bf16_t*)(F.ws + WS_MWGU) + (size_t)e * 2 * FFEP * DM + (size_t)row * DM + c * 8) = z4; }
    for (int i = gt; i < 16 * 1024 * 8; i += NGT) { const int row = i / 8, c = i % 8; *(GAS u32x4*)((bf16_t*)(F.ws + WS_MWD) + (size_t)row * FFEP + FFE + c * 8) = z4; }
    float* cosT = (float*)(F.ws + WS_COS); float* sinT = (float*)(F.ws + WS_SIN);
    for (int i = gt; i < NTOK * 32; i += NGT) { const int row = i >> 5, k = i & 31; const float inv = powf(10000.0f, -(float)(2 * k) / 64.0f); const float ang = (float)positions[row] * inv;
        cosT[i] = cosf(ang); sinT[i] = sinf(ang); }
}

template <bool COMBINE, bool FINAL>
__device__ __forceinline__ void norm_phase(Frame& F, const float* hin, float* hout, const float* gain, bf16_t* XN, const bf16_t* YB, const unsigned* tokinfo, const unsigned* cntw) {
    const int gw = F.vcu * NWAVES + F.wave, NGW = F.G * NWAVES;
    f32x4 g[4];
#pragma unroll
    for (int j = 0; j < 4; ++j) g[j] = *(const f32x4*)(gain + F.lane * 4 + 256 * j);
    unsigned nb[8];
    if constexpr (COMBINE) {
#pragma unroll
        for (int e = 0; e < 8; ++e) nb[e] = (rfl(__hip_atomic_load((unsigned*)cntw + 64 * e, RLX_AGENT)) + 255u) >> 8;
    }
    for (int m = gw; m < NTOK; m += NGW) {
        const GAS f32x4* xr = (const GAS f32x4*)(hin + (size_t)m * DM) + F.lane;
        f32x4 v[4];
#pragma unroll
        for (int j = 0; j < 4; ++j) v[j] = xr[64 * j];
        if constexpr (COMBINE) {
            const u32x4 t0 = *(const u32x4*)(tokinfo + (size_t)m * 8), t1 = *(const u32x4*)(tokinfo + (size_t)m * 8 + 4);
            const unsigned e0 = rfl(t0.x), r0 = rfl(t0.y), e1 = rfl(t1.x), r1 = rfl(t1.y); const float g0 = __uint_as_float(rfl(t0.z)), g1 = __uint_as_float(rfl(t1.z));
            unsigned b0 = 0u, b1 = 0u;
#pragma unroll
            for (int e = 0; e < 8; ++e) { b0 += ((unsigned)e < e0) ? nb[e] : 0u; b1 += ((unsigned)e < e1) ? nb[e] : 0u; }
            const GAS u32x2* y0 = (const GAS u32x2*)(YB + ((size_t)b0 * 256 + r0) * DM) + F.lane; const GAS u32x2* y1 = (const GAS u32x2*)(YB + ((size_t)b1 * 256 + r1) * DM) + F.lane;
#pragma unroll
            for (int j = 0; j < 4; ++j) { const u32x2 a = y0[64 * j], b = y1[64 * j];
                v[j].x += g0 * bflo(a.x) + g1 * bflo(b.x); v[j].y += g0 * bfhi(a.x) + g1 * bfhi(b.x); v[j].z += g0 * bflo(a.y) + g1 * bflo(b.y); v[j].w += g0 * bfhi(a.y) + g1 * bfhi(b.y); }
            if constexpr (!FINAL) { GAS f32x4* ho = (GAS f32x4*)(hout + (size_t)m * DM) + F.lane;
#pragma unroll
                for (int j = 0; j < 4; ++j) ho[64 * j] = v[j]; }
        }
        float s = 0.f;
#pragma unroll
        for (int j = 0; j < 4; ++j) s += (v[j].x * v[j].x + v[j].y * v[j].y) + (v[j].z * v[j].z + v[j].w * v[j].w);
        const float rstd = 1.0f / sqrtf(wave_sum(s) * (1.0f / DM) + RMS_EPS);
        if constexpr (FINAL) { GAS f32x4* ho = (GAS f32x4*)(hout + (size_t)m * DM) + F.lane;
#pragma unroll
            for (int j = 0; j < 4; ++j) ho[64 * j] = v[j] * rstd * g[j];
        } else { GAS u32x2* o8 = (GAS u32x2*)(XN + (size_t)m * DM) + F.lane;
#pragma unroll
            for (int j = 0; j < 4; ++j) { const f32x4 y = v[j] * rstd * g[j]; u32x2 w; w.x = cvt_pk_bf16(y.x, y.y); w.y = cvt_pk_bf16(y.z, y.w); o8[64 * j] = w; } }
    }
}
__device__ __forceinline__ void mid_phase(Frame& F, const bf16_t* DOWN, const float* qn, const float* kvn, const float* cosT, const float* sinT, bf16_t* CQN, bf16_t* CKVN, bf16_t* KR) {
    const int gw = F.vcu * NWAVES + F.wave, NGW = F.G * NWAVES, lane = F.lane;
    const f32x4 q0 = *(const f32x4*)(qn + lane * 8), q1 = *(const f32x4*)(qn + lane * 8 + 4), k0 = *(const f32x4*)(kvn + lane * 4);
    for (int m = gw; m < NTOK; m += NGW) {
        const bf16_t* dr = DOWN + (size_t)m * NDOWNP;
        const u32x4 cq = *(const GAS u32x4*)(dr + lane * 8); const u32x2 ck = *(const GAS u32x2*)(dr + QLR + lane * 4);
        const float x1 = bf2f(dr[QLR + KVLR + (lane & 31)]), x2 = bf2f(dr[QLR + KVLR + 32 + (lane & 31)]);
        const f32x4 a0 = (f32x4){bflo(cq.x), bfhi(cq.x), bflo(cq.y), bfhi(cq.y)}, a1 = (f32x4){bflo(cq.z), bfhi(cq.z), bflo(cq.w), bfhi(cq.w)}, c0 = (f32x4){bflo(ck.x), bfhi(ck.x), bflo(ck.y), bfhi(ck.y)};
        const float sq = wave_sum((a0.x * a0.x + a0.y * a0.y) + (a0.z * a0.z + a0.w * a0.w) + (a1.x * a1.x + a1.y * a1.y) + (a1.z * a1.z + a1.w * a1.w));
        const float sk = wave_sum((c0.x * c0.x + c0.y * c0.y) + (c0.z * c0.z + c0.w * c0.w));
        const float rq = 1.0f / sqrtf(sq * (1.0f / QLR) + RMS_EPS), rk = 1.0f / sqrtf(sk * (1.0f / KVLR) + RMS_EPS);
        const f32x4 y0 = a0 * rq * q0, y1 = a1 * rq * q1, z0 = c0 * rk * k0;
        u32x4 w; w.x = cvt_pk_bf16(y0.x, y0.y); w.y = cvt_pk_bf16(y0.z, y0.w); w.z = cvt_pk_bf16(y1.x, y1.y); w.w = cvt_pk_bf16(y1.z, y1.w);
        *(GAS u32x4*)(CQN + (size_t)m * QLR + lane * 8) = w;
        u32x2 w2; w2.x = cvt_pk_bf16(z0.x, z0.y); w2.y = cvt_pk_bf16(z0.z, z0.w);
        *(GAS u32x2*)(CKVN + (size_t)m * KVLR + lane * 4) = w2;
        const float c = cosT[(size_t)m * 32 + (lane & 31)], s = sinT[(size_t)m * 32 + (lane & 31)];
        const float o = lane < 32 ? x1 * c - x2 * s : x2 * c + x1 * s;
        KR[(size_t)m * DROPE + lane] = (bf16_t)(cvt_pk_bf16(o, o) & 0xffffu);
    }
}
template <int W>
__device__ __forceinline__ void pool_walk(const float* h, const LAS float* rs, const f32x2 g2, bf16_t* Z, size_t rowbase, int t_start, int c0, int nrows, int col) {
    f32x2 ring[W]; f32x2 sum = (f32x2){0.f, 0.f};
#pragma unroll
    for (int j = 0; j < W; ++j) ring[j] = (f32x2){0.f, 0.f};
    for (int r = 0; r < nrows; r += 16) {
#pragma unroll
        for (int j = 0; j < 16; ++j) {
            const int t = t_start + r + j; const size_t row = rowbase + t;
            const f32x2 x = *(const GAS f32x2*)(h + row * DM + col);
            const f32x2 v = x * rs[r + j] * g2;
            sum = sum + (v - ring[j % W]); ring[j % W] = v;
            if (t >= c0) { const float inv = 1.0f / (float)(t + 1 < W ? t + 1 : W); const f32x2 z = sum * inv - v; *(GAS unsigned*)(Z + row * DM + col) = cvt_pk_bf16(z.x, z.y); }
        }
    }
}
__device__ __forceinline__ void pool_phase(Frame& F, const float* h, const float* gain, bf16_t* Z) {
    LAS float* rs = (LAS float*)(F.lds + RING_OFF);
    const int col = F.tid * 2; const f32x2 g2 = *(const f32x2*)(gain + col);
    for (int chunk = F.vcu; chunk < NBATCH * 16; chunk += F.G) {
        const int b = chunk >> 4, c0 = (chunk & 15) * 128, t_start = c0 ? c0 - 16 : 0, nrows = c0 + 128 - t_start; const size_t rowbase = (size_t)b * SEQ;
        __syncthreads();
        for (int r = F.wave; r < nrows; r += NWAVES) {
            const GAS f32x4* xr = (const GAS f32x4*)(h + (rowbase + t_start + r) * DM) + F.lane; float s = 0.f;
#pragma unroll
            for (int j = 0; j < 4; ++j) { const f32x4 v = xr[64 * j]; s += (v.x * v.x + v.y * v.y) + (v.z * v.z + v.w * v.w); }
            s = wave_sum(s); if (F.lane == 0) rs[r] = 1.0f / sqrtf(s * (1.0f / DM) + RMS_EPS);
        }
        __syncthreads();
        const int grp = F.wave >> 1;
        if (grp == 0) pool_walk<2>(h, rs, g2, Z, rowbase, t_start, c0, nrows, col);
        else if (grp == 1) pool_walk<4>(h, rs, g2, Z, rowbase, t_start, c0, nrows, col);
        else if (grp == 2) pool_walk<8>(h, rs, g2, Z, rowbase, t_start, c0, nrows, col);
        else pool_walk<16>(h, rs, g2, Z, rowbase, t_start, c0, nrows, col);
    }
}
__device__ __forceinline__ void router_phase(Frame& F, const float* h, const float* gain, const float* router, bf16_t* XN, int* list, unsigned* tokinfo, unsigned* cntw) {
    LAS float* rt = (LAS float*)(F.lds + RING_OFF);
    LAS int* esel = (LAS int*)(F.lds + RING_OFF + 32768);
    LAS int* wt = (LAS int*)(F.lds + RING_OFF + 32768 + 2048);
    LAS int* base = (LAS int*)(F.lds + RING_OFF + 32768 + 2048 + 256);
    const int lane = F.lane;
    for (int idx = F.tid; idx < DM * NEXP; idx += NWAVES * 64) rt[(idx & 7) * DM + (idx >> 3)] = router[idx];
    f32x4 g[4];
#pragma unroll
    for (int j = 0; j < 4; ++j) g[j] = *(const f32x4*)(gain + lane * 4 + 256 * j);
    for (int chunk = F.vcu; chunk < NTOK / 256; chunk += F.G) {
        const int T0 = chunk * 256;
        __syncthreads();
        for (int i = 0; i < 32; ++i) {
            const int tl = F.wave * 32 + i, m = T0 + tl;
            const GAS f32x4* xr = (const GAS f32x4*)(h + (size_t)m * DM) + lane;
            f32x4 v[4]; float s = 0.f;
#pragma unroll
            for (int j = 0; j < 4; ++j) { v[j] = xr[64 * j]; s += (v[j].x * v[j].x + v[j].y * v[j].y) + (v[j].z * v[j].z + v[j].w * v[j].w); }
            const float rstd = 1.0f / sqrtf(wave_sum(s) * (1.0f / DM) + RMS_EPS);
            GAS u32x2* o8 = (GAS u32x2*)(XN + (size_t)m * DM) + lane;
#pragma unroll
            for (int j = 0; j < 4; ++j) { v[j] = v[j] * rstd * g[j]; u32x2 w; w.x = cvt_pk_bf16(v[j].x, v[j].y); w.y = cvt_pk_bf16(v[j].z, v[j].w); o8[64 * j] = w; }
            float lg[8];
#pragma unroll
            for (int e = 0; e < 8; ++e) { float p = 0.f;
#pragma unroll
                for (int j = 0; j < 4; ++j) { const f32x4 r4 = *(const LAS f32x4*)(rt + e * DM + lane * 4 + 256 * j); p += (v[j].x * r4.x + v[j].y * r4.y) + (v[j].z * r4.z + v[j].w * r4.w); }
                lg[e] = wave_sum(p); }
            int e0 = 0; float l0 = lg[0];
#pragma unroll
            for (int e = 1; e < 8; ++e) if (lg[e] > l0) { l0 = lg[e]; e0 = e; }
            int e1 = -1; float l1 = -__builtin_inff();
#pragma unroll
            for (int e = 0; e < 8; ++e) if (e != e0 && lg[e] > l1) { l1 = lg[e]; e1 = e; }
            const float g0 = 1.0f / (1.0f + __expf(l1 - l0)), g1 = 1.0f - g0;
            if (lane == 0) { esel[2 * tl] = e0; esel[2 * tl + 1] = e1; unsigned* ti = tokinfo + (size_t)m * 8;
                ti[0] = (unsigned)e0; ti[2] = __float_as_uint(g0); ti[4] = (unsigned)e1; ti[6] = __float_as_uint(g1); }
        }
        VM_WAIT(); __syncthreads();
        const int me = esel[F.tid]; int myrank = 0;
#pragma unroll
        for (int e = 0; e < 8; ++e) { const unsigned long long mask = __ballot(me == e); if (me == e) myrank = __popcll(mask & ((1ull << lane) - 1ull)); if (lane == 0) wt[F.wave * 8 + e] = __popcll(mask); }
        __syncthreads();
        int off = 0;
        for (int w = 0; w < F.wave; ++w) off += wt[w * 8 + me];
        if (F.tid < 8) { int tot = 0; for (int w = 0; w < 8; ++w) tot += wt[w * 8 + F.tid]; base[F.tid] = (int)__hip_atomic_fetch_add(cntw + 64 * F.tid, (unsigned)tot, RLX_AGENT); }
        __syncthreads();
        const int rank = base[me] + off + myrank, tok = T0 + (F.tid >> 1);
        list[(size_t)me * NTOK + rank] = tok;
        tokinfo[(size_t)tok * 8 + (F.tid & 1) * 4 + 1] = (unsigned)rank;
    }
}
template <bool GATHER>
struct MoeOrder {
    static constexpr size_t A_BLK = GATHER ? 0 : (size_t)256 * FFEP * 2, B_EXP = GATHER ? (size_t)2 * FFEP * DM * 2 : (size_t)DM * FFEP * 2, B_TILE = GATHER ? (size_t)256 * DM * 2 : (size_t)256 * FFEP * 2;
    static constexpr int NT = GATHER ? 2 * FFEP / 256 : DM / 256;
    const char* A; const char* B; const int* list; const unsigned* cntw; int G, c; unsigned bs[9];
    __device__ __forceinline__ void init(const unsigned* cntw_, const void* A_, const void* B_, const int* list_, int G_, int c_) {
        A = (const char*)A_; B = (const char*)B_; list = list_; cntw = cntw_; G = G_; c = c_; bs[0] = 0u;
#pragma unroll
        for (int e = 0; e < 8; ++e) { const unsigned ce = rfl(__hip_atomic_load((unsigned*)cntw + 64 * e, RLX_AGENT)); bs[e + 1] = bs[e] + ((ce + 255u) >> 8); }
    }
    __device__ __forceinline__ bool next(int i, pg8::Unit& u) const {
        const long L = (long)i * G + c; if (L >= (long)bs[8] * NT) return false;
        const unsigned blk = (unsigned)(L / NT); const int pn = (int)(L % NT);
        unsigned e = 0u, st = 0u;
#pragma unroll
        for (int k = 1; k < 8; ++k) if (blk >= bs[k]) { e = (unsigned)k; st = bs[k]; }
        const unsigned j = blk - st;
        u.b = B + (size_t)e * B_EXP + (size_t)pn * B_TILE; u.orow = (int)(blk * 256u); u.pn = pn; u.aux = (int)e;
        if constexpr (GATHER) { const unsigned ce = rfl(__hip_atomic_load((unsigned*)cntw + 64 * e, RLX_AGENT));
            u.a = A; u.rows = list + (size_t)e * NTOK + (size_t)j * 256; const unsigned rem = ce - j * 256u; u.nrows = rem < 256u ? (int)rem : 256; }
        else { u.a = A + (size_t)blk * A_BLK; u.rows = nullptr; u.nrows = 256; }
        return true;
    }
};
constexpr int NPHASE = 32;
struct Args { const float* in[20]; float* out; unsigned char* ws; int ph_lo, ph_hi, li, pad; };
constexpr int PT_OFF = LDSCTL_OFF + 512;
__device__ __forceinline__ unsigned long long ptab_u64(LAS unsigned char* L, int i) {
    const volatile LAS unsigned* p = (const volatile LAS unsigned*)(L + PT_OFF + 8 * i); const unsigned lo = rfl(p[0]), hi = rfl(p[1]); return ((unsigned long long)hi << 32) | lo; }
__device__ __forceinline__ const float* ptab(LAS unsigned char* L, int i) { return (const float*)ptab_u64(L, i); }
__device__ __forceinline__ Frame make_frame(LAS unsigned char* L) {
    Frame F; F.lds = L; F.MISC = (volatile LAS unsigned*)(L + MISC_OFF); F.tid = launder_v((int)threadIdx.x); F.lane = F.tid & 63; F.wave = __builtin_amdgcn_readfirstlane(F.tid >> 6);
    F.G = gridDim.x; { const int bx = blockIdx.x; F.vcu = (F.G % 8 == 0) ? (bx % 8) * (F.G / 8) + bx / 8 : bx; }
    F.ws = (unsigned char*)ptab_u64(L, 21); F.ctl = (gu32*)(F.ws + WS_CTL); return F;
}
__global__ void __launch_bounds__(NWAVES * 64, 2) fwd(Args args) {
    extern __shared__ __attribute__((aligned(16))) unsigned char lds[];
    LAS unsigned char* L = (LAS unsigned char*)lds;
    { const int tid = threadIdx.x;
      for (int u = tid; u < (LDS_BYTES - LDSCTL_OFF) / 4; u += NWAVES * 64) ((LAS unsigned*)(L + LDSCTL_OFF))[u] = 0u;
      __syncthreads();
      if (tid < 20) *(LAS unsigned long long*)(L + PT_OFF + 8 * tid) = (unsigned long long)args.in[tid];
      if (tid == 20) *(LAS unsigned long long*)(L + PT_OFF + 8 * 20) = (unsigned long long)args.out;
      if (tid == 21) *(LAS unsigned long long*)(L + PT_OFF + 8 * 21) = (unsigned long long)args.ws;
      __syncthreads(); }
    const int lo = args.ph_lo, hi = args.ph_hi;
    XcdBarrier bar; { gu32* ctl = (gu32*)(args.ws + WS_CTL); bar.bar = (unsigned*)(ctl + CW_BAR) + args.li * XCD_BAR_WORDS; bar.x = 0; bar.st = nullptr;
      if (hi - lo > 1) bar = xcd_barrier_post((unsigned*)(ctl + CW_BAR) + args.li * XCD_BAR_WORDS, (volatile LAS unsigned*)(L + MISC_OFF) + 8); }
#ifndef MK_ONLY
#define MK_ONLY (-1)
#endif
#define KIND(k) ((k) == 0 ? 0 : (k) == 31 ? 16 : 1 + ((k) - 1) % 15)
#define IN(k) ((MK_ONLY < 0 || KIND(k) == MK_ONLY) && lo <= (k) && (k) < hi)
#define SEAM(k) do { if ((k) + 1 < hi) xcd_barrier(bar); } while (0)
#define WSP(off) ((bf16_t*)(F.ws + (off)))
    LAS unsigned char* ring = L + RING_OFF;

    if (IN(0)) { Frame F = make_frame(L); p0_prologue(F); SEAM(0); }

    for (int lp = 0; lp < 2; ++lp) {
        const int pb = 1 + 15 * lp;
        if (IN(pb + 0)) { Frame F = make_frame(L); float* out = (float*)ptab(L, 20);
            if (lp == 0) norm_phase<false, false>(F, ptab(L, 0), nullptr, ptab(L, 2) + (size_t)(2 * lp) * DM, WSP(WS_XN), nullptr, nullptr, nullptr);
            else norm_phase<true, false>(F, out, out, ptab(L, 2) + (size_t)(2 * lp) * DM, WSP(WS_XN), WSP(WS_YB), (const unsigned*)(F.ws + WS_TOKINFO), (unsigned*)(F.ctl + CW_CNT) + (lp ? lp - 1 : 0) * 8 * 64);
            SEAM(pb + 0);
        }
        if (IN(pb + 1)) { Frame F = make_frame(L);
            pg8::RegOrder S; S.init(WSP(WS_XN), DM * 2, WSP(WS_WDN) + (size_t)lp * NDOWNP * DM, DM * 2, NTOK, NDOWNP, F.G, (int)blockIdx.x);
            pg8::EpiBf16 E{WSP(WS_DOWN), NDOWNP};
            pg8::gemm_phase<pg8::EpiBf16, pg8::RegOrder, false>(ring, DM * 2, DM * 2, DM, S, E);
            SEAM(pb + 1);
        }
        if (IN(pb + 2)) { Frame F = make_frame(L);
            mid_phase(F, WSP(WS_DOWN), ptab(L, 5) + (size_t)lp * QLR, ptab(L, 7) + (size_t)lp * KVLR, (const float*)(F.ws + WS_COS), (const float*)(F.ws + WS_SIN), WSP(WS_CQN), WSP(WS_CKVN), WSP(WS_KR)); SEAM(pb + 2); }
        if (IN(pb + 3)) { Frame F = make_frame(L);
            pg8::RegOrder S; S.init(WSP(WS_CQN), QLR * 2, WSP(WS_WUQ) + (size_t)lp * NQ * QLR, QLR * 2, NTOK, NQ, F.G, (int)blockIdx.x);
            pg8::EpiQ E{WSP(WS_Q), (const float*)(F.ws + WS_COS), (const float*)(F.ws + WS_SIN)};
            pg8::gemm_phase<pg8::EpiQ, pg8::RegOrder, false>(ring, QLR * 2, QLR * 2, QLR, S, E);
            SEAM(pb + 3);
        }
        if (IN(pb + 4)) { Frame F = make_frame(L);
            pg8::RegOrder S; S.init(WSP(WS_CKVN), KVLR * 2, WSP(WS_WUKV) + (size_t)lp * NKV * KVLR, KVLR * 2, NTOK, NKV, F.G, (int)blockIdx.x);
            pg8::EpiBf16 E{WSP(WS_KNV), NKV};
            pg8::gemm_phase<pg8::EpiBf16, pg8::RegOrder, false>(ring, KVLR * 2, KVLR * 2, KVLR, S, E);
            SEAM(pb + 4);
        }
        if (IN(pb + 5)) { Frame F = make_frame(L); att::attn_phase((char*)lds + RING_OFF, WSP(WS_Q), WSP(WS_KNV), WSP(WS_KR), WSP(WS_XN), F.vcu, F.G); SEAM(pb + 5); }
        if (IN(pb + 6)) { Frame F = make_frame(L); float* out = (float*)ptab(L, 20);
            pg8::RegOrder S; S.init(WSP(WS_XN), DM * 2, WSP(WS_WO) + (size_t)lp * DM * DM, DM * 2, NTOK, DM, F.G, (int)blockIdx.x);
            pg8::EpiResid E{lp == 0 ? ptab(L, 0) : (const float*)out, out, DM};
            pg8::gemm_phase<pg8::EpiResid, pg8::RegOrder, false>(ring, DM * 2, DM * 2, DM, S, E);
            SEAM(pb + 6);
        }
        if (IN(pb + 7)) { Frame F = make_frame(L); norm_phase<false, false>(F, ptab(L, 20), nullptr, ptab(L, 3) + (size_t)(2 * lp) * DM, WSP(WS_XN), nullptr, nullptr, nullptr); SEAM(pb + 7); }
        if (IN(pb + 8)) { Frame F = make_frame(L);
            pg8::RegOrder S; S.init(WSP(WS_XN), DM * 2, WSP(WS_WGU) + (size_t)lp * 2 * FFD * DM, DM * 2, NTOK, 2 * FFD, F.G, (int)blockIdx.x);
            pg8::EpiSwiglu E{WSP(WS_HID), FFD};
            pg8::gemm_phase<pg8::EpiSwiglu, pg8::RegOrder, false>(ring, DM * 2, DM * 2, DM, S, E);
            SEAM(pb + 8);
        }
        if (IN(pb + 9)) { Frame F = make_frame(L); float* out = (float*)ptab(L, 20);
            pg8::RegOrder S; S.init(WSP(WS_HID), FFD * 2, WSP(WS_WD) + (size_t)lp * DM * FFD, FFD * 2, NTOK, DM, F.G, (int)blockIdx.x);
            pg8::EpiResid E{out, out, DM};
            pg8::gemm_phase<pg8::EpiResid, pg8::RegOrder, false>(ring, FFD * 2, FFD * 2, FFD, S, E);
            SEAM(pb + 9);
        }
        if (IN(pb + 10)) { Frame F = make_frame(L); pool_phase(F, ptab(L, 20), ptab(L, 2) + (size_t)(2 * lp + 1) * DM, WSP(WS_XN)); SEAM(pb + 10); }
        if (IN(pb + 11)) { Frame F = make_frame(L); float* out = (float*)ptab(L, 20);
            pg8::RegOrder S; S.init(WSP(WS_XN), DM * 2, WSP(WS_WPOOL) + (size_t)lp * 4 * 256 * 256, 256 * 2, NTOK, DM, F.G, (int)blockIdx.x, 256 * 2);
            pg8::EpiResid E{out, out, DM};
            pg8::gemm_phase<pg8::EpiResid, pg8::RegOrder, false>(ring, DM * 2, 256 * 2, 256, S, E);
            SEAM(pb + 11);
        }
        if (IN(pb + 12)) { Frame F = make_frame(L);
            router_phase(F, ptab(L, 20), ptab(L, 3) + (size_t)(2 * lp + 1) * DM, ptab(L, 15) + (size_t)lp * DM * NEXP, WSP(WS_XN), (int*)(F.ws + WS_LIST), (unsigned*)(F.ws + WS_TOKINFO), (unsigned*)(F.ctl + CW_CNT) + lp * 8 * 64); SEAM(pb + 12); }
        if (IN(pb + 13)) { Frame F = make_frame(L);
            MoeOrder<true> S; S.init((unsigned*)(F.ctl + CW_CNT) + lp * 8 * 64, WSP(WS_XN), WSP(WS_MWGU) + (size_t)lp * 8 * 2 * FFEP * DM, (const int*)(F.ws + WS_LIST), F.G, (int)blockIdx.x);
            pg8::EpiSwiglu E{WSP(WS_HID), FFEP};
            pg8::gemm_phase<pg8::EpiSwiglu, MoeOrder<true>, true>(ring, DM * 2, DM * 2, DM, S, E);
            SEAM(pb + 13);
        }
        if (IN(pb + 14)) { Frame F = make_frame(L);
            MoeOrder<false> S; S.init((unsigned*)(F.ctl + CW_CNT) + lp * 8 * 64, WSP(WS_HID), WSP(WS_MWD) + (size_t)lp * 8 * DM * FFEP, (const int*)(F.ws + WS_LIST), F.G, (int)blockIdx.x);
            pg8::EpiBf16 E{WSP(WS_YB), DM};
            pg8::gemm_phase<pg8::EpiBf16, MoeOrder<false>, false>(ring, FFEP * 2, FFEP * 2, FFEP, S, E);
            SEAM(pb + 14);
        }
    }
    if (IN(31)) { Frame F = make_frame(L); float* out = (float*)ptab(L, 20);
        norm_phase<true, true>(F, out, out, ptab(L, 19), nullptr, WSP(WS_YB), (const unsigned*)(F.ws + WS_TOKINFO), (unsigned*)(F.ctl + CW_CNT) + 8 * 64); }
#undef IN
#undef SEAM
#undef WSP
}

#ifndef MK_PER_PHASE
#define MK_PER_PHASE 1
#endif
extern "C" void kernel_launch(void* const* d_in, const int* in_sizes, int n_in, void* d_out, int out_size, void* d_ws, size_t ws_size, hipStream_t stream) {
    static int grid = 0;
    if (grid == 0) {
        if (n_in != 20 || in_sizes[0] != NTOK * DM || out_size != NTOK * DM || ws_size < WS_END) { fprintf(stderr, "kernel_launch: unexpected shapes (n_in %d, in0 %d, out %d, ws %zu < %zu)\n", n_in, n_in > 0 ? in_sizes[0] : -1, out_size, ws_size, (size_t)WS_END); grid = -1; return; }
        int dev = 0, cus = 0, per_cu = 0;
        if (hipGetDevice(&dev) != hipSuccess || hipDeviceGetAttribute(&cus, hipDeviceAttributeMultiprocessorCount, dev) != hipSuccess) { grid = -1; return; }
        if (hipFuncSetAttribute((const void*)fwd, hipFuncAttributeMaxDynamicSharedMemorySize, LDS_BYTES) != hipSuccess) { fprintf(stderr, "kernel_launch: hipFuncSetAttribute failed\n"); grid = -1; return; }
        if (hipOccupancyMaxActiveBlocksPerMultiprocessor(&per_cu, (const void*)fwd, NWAVES * 64, LDS_BYTES) != hipSuccess || per_cu < 1) fprintf(stderr, "kernel_launch: occupancy query reports %d\n", per_cu);
        (void)hipGetLastError();
        grid = cus;
    }
    if (grid < 0) return;
    if (hipMemsetAsync((char*)d_ws + WS_CTL, 0, CTL_ZERO_BYTES, stream) != hipSuccess) return;
    Args a{};
    for (int i = 0; i < 20; ++i) a.in[i] = (const float*)d_in[i];
    a.out = (float*)d_out; a.ws = (unsigned char*)d_ws;
#if MK_PER_PHASE
    for (int p = 0; p < NPHASE; ++p) { a.ph_lo = p; a.ph_hi = p + 1; a.li = 0; hipLaunchKernelGGL(fwd, dim3(grid), dim3(NWAVES * 64), LDS_BYTES, stream, a); }
#else
    a.ph_lo = 0; a.ph_hi = NPHASE; a.li = 0;
    hipLaunchKernelGGL(fwd, dim3(grid), dim3(NWAVES * 64), LDS_BYTES, stream, a);
#endif
}
```

```cpp
#include <hip/hip_runtime.h>
#include <cstdio>
#include <cstdint>

#define GAS __attribute__((address_space(1)))
#define LAS __attribute__((address_space(3)))
typedef unsigned short bf16_t;
typedef short bf16x8 __attribute__((ext_vector_type(8)));
typedef short s16x4 __attribute__((ext_vector_type(4)));
typedef float f32x2 __attribute__((ext_vector_type(2)));
typedef float f32x4 __attribute__((ext_vector_type(4)));
typedef float f32x16 __attribute__((ext_vector_type(16)));
typedef unsigned u32x2 __attribute__((ext_vector_type(2)));
typedef unsigned u32x4 __attribute__((ext_vector_type(4)));

constexpr int DM = 1024, NBATCH = 32, SEQ = 2048, NTOK = NBATCH * SEQ;
constexpr int NHEAD = 8, DNOPE = 128, DROPE = 64, DVH = 128, DQH = DNOPE + DROPE, QLR = 512, KVLR = 256;
constexpr int NDOWN = QLR + KVLR + DROPE  , NDOWNP = 1024;
constexpr int NQ = NHEAD * DQH  , NKV = NHEAD * (DNOPE + DVH)  ;
constexpr int FFD = 2688, NEXP = 8, FFE = 1344, FFEP = 1408;
constexpr int PSLOT = (NTOK * 2 / 256 + NEXP) * 256;
constexpr float RMS_EPS = 1e-6f;

__device__ __forceinline__ unsigned cvt_pk_bf16(float lo, float hi) { unsigned r; asm volatile("v_cvt_pk_bf16_f32 %0, %1, %2" : "=v"(r) : "v"(lo), "v"(hi)); return r; }
__device__ __forceinline__ int launder_v(int v) { asm volatile("" : "+v"(v)); return v; }
__device__ __forceinline__ float bf2f(unsigned short b) { return __uint_as_float((unsigned)b << 16); }
__device__ __forceinline__ float bflo(unsigned w) { return __uint_as_float(w << 16); }
__device__ __forceinline__ float bfhi(unsigned w) { return __uint_as_float(w & 0xffff0000u); }

namespace pg8 {
constexpr int BM = 256, BK = 64, HALF = 128, HTB = HALF * BK * 2  , STAGE_BYTES = 8 * HTB, NXCD = 8, WGM = 8;
__host__ __device__ __forceinline__ int lds_byte(int r, int c) { const int st = (r >> 4) * 2 + (c >> 5), rr = r & 15, cc = c & 31, ob = rr * 64 + cc * 2; return st * 1024 + (ob ^ (((ob >> 9) & 1) << 5)); }
__host__ __device__ __forceinline__ void stage_rc(int b, int& R, int& C) { const int st = b / 1024, sb = b % 1024, swz = sb ^ (((sb >> 9) & 1) << 5); R = (st >> 1) * 16 + swz / 64; C = (st & 1) * 32 + (swz % 64) / 2; }
__host__ __device__ __forceinline__ int perm32(int rho) { const int n = rho >> 4, i = rho & 15; return 8 * (i >> 2) + 4 * n + (i & 3); }

struct Unit { const char* a; const char* b; const int* rows; int nrows; int orow; int pn; int aux; };

struct RegOrder {
    const char* A; const char* B; size_t a_tile, b_tile, a_colstep; int nM, nN, nwg, G, c;
    __device__ __forceinline__ void init(const void* A_, size_t lda_b, const void* B_, size_t ldb_b, int M, int N, int G_, int c_, size_t a_colstep_ = 0) {
        A = (const char*)A_; B = (const char*)B_; a_tile = 256 * lda_b; b_tile = 256 * ldb_b; a_colstep = a_colstep_; nM = M / BM; nN = N / BM; nwg = nM * nN; G = G_; c = c_; }
    __device__ __forceinline__ bool next(int i, Unit& u) const {
        const long L = (long)i * G + c; if (L >= nwg) return false;
        int wgid = (int)L; { const int q = nwg / NXCD, r = nwg % NXCD, xcd = wgid % NXCD, off = wgid / NXCD; wgid = (xcd < r ? xcd * (q + 1) : r * (q + 1) + (xcd - r) * q) + off; }
        const int nig = WGM * nN, gid = wgid / nig, fm = gid * WGM, gsz = (nM - fm) < WGM ? (nM - fm) : WGM;
        const int pm = fm + ((wgid % nig) % gsz), pn = (wgid % nig) / gsz;
        u.a = A + (size_t)pm * a_tile + (size_t)pn * a_colstep; u.b = B + (size_t)pn * b_tile; u.rows = nullptr; u.nrows = 256; u.orow = pm * BM; u.pn = pn; u.aux = 0; return true;
    }
};

struct EpiBf16 {
    static constexpr bool PERM = true;
    bf16_t* O; int ldc;
    __device__ __forceinline__ void operator()(const f32x4 (&acc)[2][2][4][2], const Unit& u, int wr, int wc, int fr, int fq) const {
        const int row0 = u.orow + wr * 64 + fr, col0 = u.pn * BM + wc * 32 + 8 * fq;
#pragma unroll
        for (int ai = 0; ai < 2; ++ai)
#pragma unroll
            for (int m = 0; m < 4; ++m) { bf16_t* rowp = O + (size_t)(row0 + ai * HALF + m * 16) * ldc + col0;
#pragma unroll
                for (int bj = 0; bj < 2; ++bj) { const f32x4 v0 = acc[ai][bj][m][0], v1 = acc[ai][bj][m][1];
                    u32x4 w; w.x = cvt_pk_bf16(v0[0], v0[1]); w.y = cvt_pk_bf16(v0[2], v0[3]); w.z = cvt_pk_bf16(v1[0], v1[1]); w.w = cvt_pk_bf16(v1[2], v1[3]);
                    *(u32x4*)(rowp + bj * HALF) = w; } }
    }
};
__device__ __forceinline__ float silu_mul(float g, float u) { return g * u * __builtin_amdgcn_rcpf(1.0f + __builtin_amdgcn_exp2f(-1.4426950408889634f * g)); }
struct EpiSwiglu {
    static constexpr bool PERM = true;
    bf16_t* H; int ldh;
    __device__ __forceinline__ void operator()(const f32x4 (&acc)[2][2][4][2], const Unit& u, int wr, int wc, int fr, int fq) const {
        const int row0 = u.orow + wr * 64 + fr, col0 = u.pn * HALF + wc * 32 + 8 * fq;
#pragma unroll
        for (int ai = 0; ai < 2; ++ai)
#pragma unroll
            for (int m = 0; m < 4; ++m) { bf16_t* rowp = H + (size_t)(row0 + ai * HALF + m * 16) * ldh + col0;
                const f32x4 g0 = acc[ai][0][m][0], g1 = acc[ai][0][m][1], u0 = acc[ai][1][m][0], u1 = acc[ai][1][m][1];
                u32x4 w; w.x = cvt_pk_bf16(silu_mul(g0[0], u0[0]), silu_mul(g0[1], u0[1])); w.y = cvt_pk_bf16(silu_mul(g0[2], u0[2]), silu_mul(g0[3], u0[3]));
                w.z = cvt_pk_bf16(silu_mul(g1[0], u1[0]), silu_mul(g1[1], u1[1])); w.w = cvt_pk_bf16(silu_mul(g1[2], u1[2]), silu_mul(g1[3], u1[3]));
                *(u32x4*)rowp = w; }
    }
};
struct EpiResid {
    static constexpr bool PERM = false;
    const float* in; float* out; int ldc;
    __device__ __forceinline__ void operator()(const f32x4 (&acc)[2][2][4][2], const Unit& u, int wr, int wc, int fr, int fq) const {
        const int row0 = u.orow + wr * 64 + fr, col0 = u.pn * BM + wc * 32 + 4 * fq;
#pragma unroll
        for (int ai = 0; ai < 2; ++ai)
#pragma unroll
            for (int m = 0; m < 4; ++m) { const size_t off = (size_t)(row0 + ai * HALF + m * 16) * ldc + col0;
#pragma unroll
                for (int bj = 0; bj < 2; ++bj)
#pragma unroll
                    for (int n = 0; n < 2; ++n) { const f32x4 bs = *(const f32x4*)(in + off + bj * HALF + n * 16); *(f32x4*)(out + off + bj * HALF + n * 16) = bs + acc[ai][bj][m][n]; }
                if (m & 1) asm volatile("" ::: "memory"); }
    }
};
struct EpiQ {
    static constexpr bool PERM = true;
    bf16_t* Q; const float* cosT; const float* sinT;
    __device__ __forceinline__ void operator()(const f32x4 (&acc)[2][2][4][2], const Unit& u, int wr, int wc, int fr, int fq) const {
        const int row0 = u.orow + wr * 64 + fr;
        if (u.pn < 2) {
            const int h = 4 * u.pn + wc;
#pragma unroll
            for (int ai = 0; ai < 2; ++ai)
#pragma unroll
                for (int m = 0; m < 4; ++m) { const int row = row0 + ai * HALF + m * 16;
                    const f32x4 c0 = *(const f32x4*)(cosT + (size_t)row * 32 + 8 * fq), c1 = *(const f32x4*)(cosT + (size_t)row * 32 + 8 * fq + 4);
                    const f32x4 s0 = *(const f32x4*)(sinT + (size_t)row * 32 + 8 * fq), s1 = *(const f32x4*)(sinT + (size_t)row * 32 + 8 * fq + 4);
                    const f32x4 a0 = acc[ai][0][m][0], a1 = acc[ai][0][m][1], b0 = acc[ai][1][m][0], b1 = acc[ai][1][m][1];
                    const f32x4 x0 = a0 * c0 - b0 * s0, x1 = a1 * c1 - b1 * s1, y0 = b0 * c0 + a0 * s0, y1 = b1 * c1 + a1 * s1;
                    bf16_t* rp = Q + (size_t)row * NQ + h * DQH + DNOPE + 8 * fq;
                    u32x4 w; w.x = cvt_pk_bf16(x0[0], x0[1]); w.y = cvt_pk_bf16(x0[2], x0[3]); w.z = cvt_pk_bf16(x1[0], x1[1]); w.w = cvt_pk_bf16(x1[2], x1[3]);
                    *(u32x4*)rp = w;
                    w.x = cvt_pk_bf16(y0[0], y0[1]); w.y = cvt_pk_bf16(y0[2], y0[3]); w.z = cvt_pk_bf16(y1[0], y1[1]); w.w = cvt_pk_bf16(y1[2], y1[3]);
                    *(u32x4*)(rp + 32) = w; }
        } else {
#pragma unroll
            for (int ai = 0; ai < 2; ++ai)
#pragma unroll
                for (int m = 0; m < 4; ++m) { const int row = row0 + ai * HALF + m * 16;
#pragma unroll
                    for (int bj = 0; bj < 2; ++bj) { const int h = 2 * (u.pn - 2) + bj; const f32x4 v0 = acc[ai][bj][m][0], v1 = acc[ai][bj][m][1];
                        u32x4 w; w.x = cvt_pk_bf16(v0[0], v0[1]); w.y = cvt_pk_bf16(v0[2], v0[3]); w.z = cvt_pk_bf16(v1[0], v1[1]); w.w = cvt_pk_bf16(v1[2], v1[3]);
                        *(u32x4*)(Q + (size_t)row * NQ + h * DQH + wc * 32 + 8 * fq) = w; } }
        }
    }
};

__device__ __forceinline__ unsigned gather_off(const Unit& u, int idx, unsigned lda_b, unsigned cb) { const int tok = idx < u.nrows ? u.rows[idx] : 0; return (unsigned)tok * lda_b + cb; }
template <class Epi, class Sched, bool GATHER>
__device__ __forceinline__ void gemm_phase(LAS unsigned char* lds, const unsigned lda_b, const unsigned ldb_b, const int K, const Sched& S, const Epi& E) {
    const int tid = launder_v((int)threadIdx.x), wid = __builtin_amdgcn_readfirstlane(tid >> 6), lane = tid & 63, wr = wid >> 2, wc = wid & 3, fr = lane & 15, fq = lane >> 4;
    const int nt = K / BK;
    unsigned voffA[2], voffB[2]; int Rr[2]; unsigned Cb[2];
#pragma unroll
    for (int i = 0; i < 2; ++i) { int R, C; stage_rc(tid * 16 + i * 8192, R, C); const int Rb = Epi::PERM ? ((R & ~31) + perm32(R & 31)) : R;
        Rr[i] = R; Cb[i] = (unsigned)C * 2u; voffA[i] = (unsigned)R * lda_b + (unsigned)C * 2u; voffB[i] = (unsigned)Rb * ldb_b + (unsigned)C * 2u; }
    const size_t kstep = (size_t)(BK * 2);
    const size_t hstepA = (size_t)HALF * lda_b, hstepB = (size_t)HALF * ldb_b;
    const unsigned ldsw = (unsigned)wid * 1024u;
    const int aoff = lds_byte(wr * 64 + fr, fq * 8), boff = lds_byte(wc * 32 + fr, fq * 8);
    unsigned cv0[2] = {0u, 0u}, cv1[2] = {0u, 0u}, nv0[2] = {0u, 0u}, nv1[2] = {0u, 0u};
#define PG8_SA(b, h) (((b) * 2 + (h)) * HTB)
#define PG8_SB(b, h) ((4 + (b) * 2 + (h)) * HTB)
#define PG8_LOAD16(gp, ldsoff) __builtin_amdgcn_global_load_lds((const unsigned*)(gp), (LAS unsigned*)(lds + (ldsoff)), 16, 0, 0)
#define PG8_STAGE_B(bufoff, gbase, h) do { _Pragma("unroll") for (int _i = 0; _i < 2; ++_i) PG8_LOAD16((gbase) + (h) * hstepB + voffB[_i], (bufoff) + ldsw + _i * 8192); } while (0)
#define PG8_STAGE_A(bufoff, gbase, h, usenext) do { _Pragma("unroll") for (int _i = 0; _i < 2; ++_i) { unsigned _vo; \
        if constexpr (GATHER) { _vo = (usenext) ? ((h) ? nv1[_i] : nv0[_i]) : ((h) ? cv1[_i] : cv0[_i]); } else { _vo = voffA[_i] + (unsigned)((h) * hstepA); } \
        PG8_LOAD16((gbase) + _vo, (bufoff) + ldsw + _i * 8192); } } while (0)
#define PG8_LDA(dst, b, h) do { _Pragma("unroll") for (int m = 0; m < 4; ++m) _Pragma("unroll") for (int k = 0; k < 2; ++k) dst[m][k] = *(const LAS bf16x8*)(lds + PG8_SA(b, h) + aoff + m * 2048 + k * 1024); } while (0)
#define PG8_LDB(dst, b, h) do { _Pragma("unroll") for (int n = 0; n < 2; ++n) _Pragma("unroll") for (int k = 0; k < 2; ++k) dst[n][k] = *(const LAS bf16x8*)(lds + PG8_SB(b, h) + boff + n * 2048 + k * 1024); } while (0)
#define PG8_MMA(ai, bj, At, Bt) do { __builtin_amdgcn_s_setprio(1); _Pragma("unroll") for (int m = 0; m < 4; ++m) _Pragma("unroll") for (int n = 0; n < 2; ++n) _Pragma("unroll") for (int k = 0; k < 2; ++k) \
        acc[ai][bj][m][n] = __builtin_amdgcn_mfma_f32_16x16x32_bf16(Bt[n][k], At[m][k], acc[ai][bj][m][n], 0, 0, 0); __builtin_amdgcn_s_setprio(0); } while (0)
#define PG8_WAIT_V(n) asm volatile("s_waitcnt vmcnt(" #n ")" ::: "memory")
#define PG8_WAIT_L(n) asm volatile("s_waitcnt lgkmcnt(" #n ")" ::: "memory")
#define PG8_BAR __builtin_amdgcn_s_barrier()
#define PG8_SCHED __builtin_amdgcn_sched_barrier(0)
    Unit cur, nxt; int ui = 0;
    if (!S.next(0, cur)) return;
    f32x4 acc[2][2][4][2];
#pragma unroll
    for (int a = 0; a < 2; ++a)
#pragma unroll
        for (int b = 0; b < 2; ++b)
#pragma unroll
            for (int m = 0; m < 4; ++m)
#pragma unroll
                for (int n = 0; n < 2; ++n) acc[a][b][m][n] = (f32x4){0.f, 0.f, 0.f, 0.f};
    bf16x8 At[4][2], B0[2][2], B1[2][2];
    const char* cA = cur.a; const char* cB = cur.b;
    if constexpr (GATHER) {
#pragma unroll
        for (int i = 0; i < 2; ++i) { cv0[i] = gather_off(cur, Rr[i], lda_b, Cb[i]); cv1[i] = gather_off(cur, HALF + Rr[i], lda_b, Cb[i]); }
    }
    PG8_STAGE_B(PG8_SB(0, 0), cB, 0); PG8_STAGE_B(PG8_SB(0, 1), cB, 1); PG8_STAGE_A(PG8_SA(0, 0), cA, 0, false); PG8_STAGE_A(PG8_SA(0, 1), cA, 1, false);
    if (wr == 1) PG8_BAR;
    PG8_WAIT_V(2); PG8_BAR;
    PG8_STAGE_B(PG8_SB(1, 0), cB + kstep, 0); PG8_STAGE_A(PG8_SA(1, 0), cA + kstep, 0, false); PG8_STAGE_B(PG8_SB(1, 1), cB + kstep, 1);
    PG8_WAIT_V(6); PG8_BAR;
    for (;;) {
        const bool has_next = S.next(ui + 1, nxt);
        const char* nA = has_next ? nxt.a : cA; const char* nB = has_next ? nxt.b : cB;
        if constexpr (GATHER) {
#pragma unroll
            for (int i = 0; i < 2; ++i) { nv0[i] = has_next ? gather_off(nxt, Rr[i], lda_b, Cb[i]) : cv0[i]; nv1[i] = has_next ? gather_off(nxt, HALF + Rr[i], lda_b, Cb[i]) : cv1[i]; }
        }
        for (int t = 0; t < nt; t += 2) {
            const bool last = (t == nt - 2);
            const char* a1 = cA + (size_t)(t + 1) * kstep;
            const char* a2 = last ? nA : cA + (size_t)(t + 2) * kstep; const char* b2 = last ? nB : cB + (size_t)(t + 2) * kstep;
            const char* a3 = a2 + kstep; const char* b3 = b2 + kstep;
            PG8_LDB(B0, 0, 0); PG8_LDB(B1, 0, 1); PG8_SCHED; PG8_LDA(At, 0, 0); PG8_STAGE_A(PG8_SA(1, 1), a1, 1, false);
            PG8_WAIT_V(8); PG8_WAIT_L(0); PG8_BAR; PG8_MMA(0, 0, At, B0); PG8_MMA(0, 1, At, B1); PG8_BAR; PG8_SCHED;
            PG8_LDA(At, 0, 1); PG8_STAGE_B(PG8_SB(0, 0), b2, 0); PG8_STAGE_B(PG8_SB(0, 1), b2, 1); PG8_STAGE_A(PG8_SA(0, 0), a2, 0, last);
            PG8_WAIT_V(8); PG8_WAIT_L(0); PG8_BAR; PG8_MMA(1, 0, At, B0); PG8_MMA(1, 1, At, B1); PG8_BAR; PG8_SCHED;
            PG8_LDB(B0, 1, 0); PG8_LDB(B1, 1, 1); PG8_SCHED; PG8_LDA(At, 1, 0); PG8_STAGE_A(PG8_SA(0, 1), a2, 1, last);
            PG8_WAIT_V(8); PG8_WAIT_L(0); PG8_BAR; PG8_MMA(0, 0, At, B0); PG8_MMA(0, 1, At, B1); PG8_BAR; PG8_SCHED;
            PG8_LDA(At, 1, 1); PG8_STAGE_B(PG8_SB(1, 0), b3, 0); PG8_STAGE_B(PG8_SB(1, 1), b3, 1); PG8_STAGE_A(PG8_SA(1, 0), a3, 0, last);
            PG8_WAIT_V(8); PG8_WAIT_L(0); PG8_BAR; PG8_MMA(1, 0, At, B0); PG8_MMA(1, 1, At, B1); PG8_BAR; PG8_SCHED;
        }
        if (wr == 0) PG8_BAR;
        E(acc, cur, wr, wc, fr, fq);
        if (!has_next) break;
#pragma unroll
        for (int a = 0; a < 2; ++a)
#pragma unroll
            for (int b = 0; b < 2; ++b)
#pragma unroll
                for (int m = 0; m < 4; ++m)
#pragma unroll
                    for (int n = 0; n < 2; ++n) acc[a][b][m][n] = (f32x4){0.f, 0.f, 0.f, 0.f};
        cur = nxt; cA = nA; cB = nB; ++ui;
        if constexpr (GATHER) {
#pragma unroll
            for (int i = 0; i < 2; ++i) { cv0[i] = nv0[i]; cv1[i] = nv1[i]; }
        }
        if (wr == 1) PG8_BAR;
    }
    PG8_WAIT_V(0);
    PG8_BAR;
#undef PG8_SA
#undef PG8_SB
#undef PG8_LOAD16
#undef PG8_STAGE_A
#undef PG8_STAGE_B
#undef PG8_LDA
#undef PG8_LDB
#undef PG8_MMA
#undef PG8_WAIT_V
#undef PG8_WAIT_L
#undef PG8_BAR
#undef PG8_SCHED
}
}
namespace att {
constexpr int NW = 8, QBLK = 32, KVBLK = 64, QB = NW * QBLK;
constexpr int DQK = 192, DV = 128;
constexpr int QS = NQ, KNS = NKV, KRS = DROPE, OS = DM;
constexpr int SHM_V = KVBLK * DV * 2, SHM_K = KVBLK * DQK * 2;
constexpr int LDS_QR = 2 * SHM_V + 2 * SHM_K + NW * 64 * 4;
constexpr int LDS_BYTES = LDS_QR + NW * 4096;
constexpr float SCALE = 0.07216878364870322f;
constexpr float THR = 8.f;
#define KSWZ(row, ch) ((row) * 384 + ((((ch) ^ (((row) >> 1) & 7))) << 4))
#define SBAR() __builtin_amdgcn_sched_barrier(0)
__device__ __forceinline__ int v_st(int k, int c) { const int kk = (k & ~0xC) | ((k & 4) << 1) | ((k & 8) >> 1); return ((kk >> 3) * 4 + (c >> 5)) * 512 + ((kk & 7) * 32 + (c & 31)) * 2; }
__device__ __forceinline__ int v_rd_base(int lane) { return ((lane & 3) << 3) | (((lane >> 2) & 3) << 6) | (((lane >> 4) & 1) << 5) | (((lane >> 5) & 1) << 8); }
constexpr int v_rd_off(int d0, int ks, int half) { return d0 * 512 + ks * 4096 + half * 2048; }
__device__ __forceinline__ int crow(int r, int hi) { return (r & 3) + 8 * (r >> 2) + 4 * hi; }
__device__ __forceinline__ void mask_tile(f32x16& p0, f32x16& p1, int dq) {
    const float NEG = -__builtin_inff();
#pragma unroll
    for (int r = 0; r < 16; ++r) {
        const int c = (r & 3) + 8 * (r >> 2);
        if (dq - c < 0) p0[r] = NEG;
        if (dq - c - 32 < 0) p1[r] = NEG;
    }
}
__device__ __forceinline__ void partialSM(f32x16& p0, f32x16& p1, float& m_reg, float& mn, float& alpha) {
    float pmax = p0[0]; for (int r = 1; r < 16; ++r) pmax = fmaxf(pmax, p0[r]); for (int r = 0; r < 16; ++r) pmax = fmaxf(pmax, p1[r]);
    { auto rr = __builtin_amdgcn_permlane32_swap(__float_as_uint(pmax), __float_as_uint(pmax), false, false);
      pmax = fmaxf(__uint_as_float(rr[0]), __uint_as_float(rr[1])); }
    constexpr float C2 = 1.4426950408889634f * SCALE;
    if (__builtin_expect(__all((pmax - m_reg) * SCALE <= THR), 1)) { mn = m_reg; alpha = 1.f; }
    else { mn = fmaxf(m_reg, pmax); alpha = __builtin_amdgcn_exp2f((m_reg - mn) * C2); m_reg = mn; }
    const float mnL = -mn * C2;
    for (int r = 0; r < 16; ++r) p0[r] = fmaf(p0[r], C2, mnL); for (int r = 0; r < 16; ++r) p1[r] = fmaf(p1[r], C2, mnL);
    for (int r = 0; r < 16; ++r) p0[r] = __builtin_amdgcn_exp2f(p0[r]);
}
__device__ __forceinline__ void finishSM(f32x16& p0, f32x16& p1, float alpha, float& l_reg, bf16x8& pa0, bf16x8& pa1, bf16x8& pa2, bf16x8& pa3) {
    for (int r = 0; r < 16; ++r) p1[r] = __builtin_amdgcn_exp2f(p1[r]);
    float ps = 0; for (int r = 0; r < 16; ++r) ps += p0[r]; for (int r = 0; r < 16; ++r) ps += p1[r];
    { auto rr = __builtin_amdgcn_permlane32_swap(__float_as_uint(ps), __float_as_uint(ps), false, false);
      ps = __uint_as_float(rr[0]) + __uint_as_float(rr[1]); }
    l_reg = l_reg * alpha + ps;
#define PK4(P, B_, OUT) do { unsigned a0 = cvt_pk_bf16(P[B_+0], P[B_+1]), a1 = cvt_pk_bf16(P[B_+2], P[B_+3]);                          \
        unsigned b0 = cvt_pk_bf16(P[B_+4], P[B_+5]), b1 = cvt_pk_bf16(P[B_+6], P[B_+7]);                                             \
        auto r0 = __builtin_amdgcn_permlane32_swap(a0, b0, false, false); auto r1 = __builtin_amdgcn_permlane32_swap(a1, b1, false, false); \
        u32x4 w = {r0[0], r1[0], r0[1], r1[1]}; OUT = *reinterpret_cast<bf16x8*>(&w); } while (0)
    PK4(p0, 0, pa0); PK4(p0, 8, pa1); PK4(p1, 0, pa2); PK4(p1, 8, pa3);
#undef PK4
}
template <int KB>
__device__ __forceinline__ void qkt(f32x16& p0, f32x16& p1, const char* K_lds, int r32, int hi, const bf16x8* qr, const char* qrl) {
    p0 = f32x16{}; p1 = f32x16{};
    const char* kb[4];
#pragma unroll
    for (int dd = 0; dd < 4; ++dd) kb[dd] = K_lds + KB * SHM_K + KSWZ(r32, dd * 2 + hi);
#pragma unroll
    for (int d0 = 0; d0 < 12; ++d0) { const char* a = kb[d0 & 3] + (d0 >> 2) * 128;
        bf16x8 b0 = *reinterpret_cast<const bf16x8*>(a);
        bf16x8 b1 = *reinterpret_cast<const bf16x8*>(a + 32 * 384);
        const bf16x8 qf = d0 < 8 ? qr[d0 & 7] : *reinterpret_cast<const bf16x8*>(qrl + (d0 - 8) * 1024);
        p0 = __builtin_amdgcn_mfma_f32_32x32x16_bf16(b0, qf, p0, 0, 0, 0);
        p1 = __builtin_amdgcn_mfma_f32_32x32x16_bf16(b1, qf, p1, 0, 0, 0);
        if ((d0 & 3) == 3 && d0 < 11) SBAR(); }
}
template <int VB>
__device__ __forceinline__ void pv_tile(f32x16* o, int vb0, bf16x8 pa0, bf16x8 pa1, bf16x8 pa2, bf16x8 pa3) {
#define TRRD(dst, off) asm volatile("ds_read_b64_tr_b16 %0, %1 offset:%2" : "=&v"(dst) : "v"(vb0), "i"(off) : "memory")
#define PV_D0(d0) do { s16x4 l0, l1, l2, l3, h0, h1, h2, h3; constexpr int b_ = VB * SHM_V + v_rd_off(d0, 0, 0); \
        TRRD(l0, b_); TRRD(h0, b_ + 2048); TRRD(l1, b_ + 4096); TRRD(h1, b_ + 6144); TRRD(l2, b_ + 8192); TRRD(h2, b_ + 10240); TRRD(l3, b_ + 12288); TRRD(h3, b_ + 14336); \
        asm volatile("s_waitcnt lgkmcnt(0)" ::: "memory"); SBAR();   \
        o[d0] = __builtin_amdgcn_mfma_f32_32x32x16_bf16(pa0, (bf16x8){l0[0], l0[1], l0[2], l0[3], h0[0], h0[1], h0[2], h0[3]}, o[d0], 0, 0, 0);   \
        o[d0] = __builtin_amdgcn_mfma_f32_32x32x16_bf16(pa1, (bf16x8){l1[0], l1[1], l1[2], l1[3], h1[0], h1[1], h1[2], h1[3]}, o[d0], 0, 0, 0);   \
        o[d0] = __builtin_amdgcn_mfma_f32_32x32x16_bf16(pa2, (bf16x8){l2[0], l2[1], l2[2], l2[3], h2[0], h2[1], h2[2], h2[3]}, o[d0], 0, 0, 0);   \
        o[d0] = __builtin_amdgcn_mfma_f32_32x32x16_bf16(pa3, (bf16x8){l3[0], l3[1], l3[2], l3[3], h3[0], h3[1], h3[2], h3[3]}, o[d0], 0, 0, 0); } while (0)
    PV_D0(0); PV_D0(1); PV_D0(2); PV_D0(3);
#undef PV_D0
#undef TRRD
}
struct BlockRef { const bf16_t* Q; const bf16_t* Kn; const bf16_t* Kr; const bf16_t* V; bf16_t* O; int P0; };
struct Seam { bf16x8 qr[8]; bf16x8 st_v0, st_v1, st_k0, st_k1, st_k2; };
#define VMW() asm volatile("s_waitcnt vmcnt(0)" ::: "memory")
#define VMWN(n) asm volatile("s_waitcnt vmcnt(%0)" :: "i"(n) : "memory")
#define LD8(p) (*reinterpret_cast<const bf16x8*>(p))
#define SLOAD_H(R_, k0) do { S.st_v0 = LD8((R_).V + (size_t)((k0) + sr) * KNS + sc); S.st_v1 = LD8((R_).V + (size_t)((k0) + 32 + sr) * KNS + sc);              \
                             S.st_k0 = LD8((R_).Kn + (size_t)((k0) + sr) * KNS + sc); S.st_k1 = LD8((R_).Kn + (size_t)((k0) + 32 + sr) * KNS + sc);            \
                             S.st_k2 = LD8((R_).Kr + (size_t)((k0) + rr) * KRS + rc); } while (0)
#define SWRITE_HK(bf) do { *(bf16x8*)(K_lds + (bf) * SHM_K + kws) = S.st_k0; *(bf16x8*)(K_lds + (bf) * SHM_K + kws + 32 * 384) = S.st_k1; *(bf16x8*)(K_lds + (bf) * SHM_K + kws2) = S.st_k2; } while (0)
#define SWRITE_HV(bf) do { *(bf16x8*)(V_lds + (bf) * SHM_V + vst0) = S.st_v0; *(bf16x8*)(V_lds + (bf) * SHM_V + vst1) = S.st_v1; } while (0)
#define SWRITE_H(bf) do { SWRITE_HV(bf); SWRITE_HK(bf); } while (0)
#define ATT_IDX const int tid = launder_v((int)threadIdx.x), wid = __builtin_amdgcn_readfirstlane(tid >> 6), lane = tid & 63, r32 = lane & 31, hi = lane >> 5; \
    const int sr = tid >> 4, sc = (tid & 15) * 8, rr = tid >> 3, rc = (tid & 7) * 8, kws = KSWZ(sr, (tid & 15)), kws2 = KSWZ(rr, 16 + (tid & 7));
__device__ __forceinline__ void attn_block(const BlockRef& cur, char* lds) {
    ATT_IDX;
    Seam S;
    const int NT = cur.P0 / KVBLK + QB / KVBLK;
    const int qlo = cur.P0 + wid * QBLK, qm = qlo + r32 - 4 * hi;
    char* V_lds = lds; char* K_lds = lds + 2 * SHM_V;
    float* ws = (float*)(lds + 2 * SHM_V + 2 * SHM_K) + wid * 64; float* li_l = ws, * al_l = ws + 32;
    float m_reg = -1e30f, l_reg = 0; f32x16 o[4] = {};
    const int vst0 = v_st(sr, sc), vst1 = v_st(32 + sr, sc);
    const int vb0 = (int)(uintptr_t)V_lds + v_rd_base(lane);
    char* qrl = lds + LDS_QR + wid * 4096 + lane * 16;
#define RESC(a) do { if (__any((a) < 1.f)) { if (hi == 0) al_l[r32] = (a); asm volatile("s_waitcnt lgkmcnt(0)" ::: "memory");              \
                     for (int d_ = 0; d_ < 4; ++d_) for (int r = 0; r < 16; ++r) o[d_][r] *= al_l[crow(r, hi)]; } } while (0)
#define KBASE(t) ((t) * KVBLK)
#define MASKT(P0_, P1_, t) do { const int kb_ = KBASE(t); if (kb_ + KVBLK - 1 > qlo) mask_tile(P0_, P1_, qm - kb_); } while (0)
    SLOAD_H(cur, 0);
#pragma unroll
    for (int d0 = 0; d0 < 8; ++d0) S.qr[d0] = LD8(cur.Q + (size_t)(wid * QBLK + r32) * QS + d0 * 16 + hi * 8);
    { bf16x8 t0 = LD8(cur.Q + (size_t)(wid * QBLK + r32) * QS + 128 + hi * 8), t1 = LD8(cur.Q + (size_t)(wid * QBLK + r32) * QS + 144 + hi * 8),
             t2 = LD8(cur.Q + (size_t)(wid * QBLK + r32) * QS + 160 + hi * 8), t3 = LD8(cur.Q + (size_t)(wid * QBLK + r32) * QS + 176 + hi * 8);
      *(bf16x8*)(qrl) = t0; *(bf16x8*)(qrl + 1024) = t1; *(bf16x8*)(qrl + 2048) = t2; *(bf16x8*)(qrl + 3072) = t3; }
    VMW(); SWRITE_H(0);
    __syncthreads();
    f32x16 p0, p1; float mn, al; bf16x8 pa0, pa1, pa2, pa3;
#define TILE_STEP(t, BF) do {                                                                                                 \
        if ((t) + 1 < NT) { SLOAD_H(cur, KBASE((t) + 1)); }                                                                    \
        SBAR(); qkt<BF>(p0, p1, K_lds, r32, hi, S.qr, qrl);                                                                   \
        MASKT(p0, p1, (t)); partialSM(p0, p1, m_reg, mn, al); RESC(al);                                                        \
        finishSM(p0, p1, al, l_reg, pa0, pa1, pa2, pa3); SBAR();                                                              \
        pv_tile<BF>(o, vb0, pa0, pa1, pa2, pa3);                                                                              \
        if ((t) + 1 < NT) { VMW(); SWRITE_H(1 - BF); }                                                                         \
        __syncthreads(); } while (0)
    for (int t = 0; t < NT; t += 2) { TILE_STEP(t, 0); TILE_STEP(t + 1, 1); }
    if (hi == 0) li_l[r32] = l_reg; asm volatile("s_waitcnt lgkmcnt(0)" ::: "memory");
    float rli[16];
#pragma unroll
    for (int r = 0; r < 16; ++r) rli[r] = __builtin_amdgcn_rcpf(li_l[crow(r, hi)]);
    bf16_t* Ow = cur.O + (size_t)(wid * QBLK) * OS;
#pragma unroll
    for (int r = 0; r < 16; ++r) { const int orow = crow(r, hi);
#pragma unroll
        for (int d0 = 0; d0 < 4; ++d0) { const float v = o[d0][r] * rli[r];
            const float vn = __shfl_xor(v, 1);
            if ((r32 & 1) == 0) *(unsigned*)(Ow + (size_t)orow * OS + d0 * 32 + r32) = cvt_pk_bf16(v, vn); } }
    __syncthreads();
#undef RESC
#undef KBASE
#undef MASKT
#undef TILE_STEP
}
#undef VMW
#undef VMWN
#undef LD8
#undef SLOAD_H
#undef SWRITE_HK
#undef SWRITE_HV
#undef SWRITE_H
#undef ATT_IDX
#undef KSWZ
#undef SBAR

__device__ __forceinline__ BlockRef make_ref(int L, int pass, const bf16_t* Qb, const bf16_t* KNVb, const bf16_t* KRb, bf16_t* Ob) {
    const int bh = L >> 2, x = L & 3, qb = pass ? 7 - x : x, b = bh >> 3, h = bh & 7; const size_t rb = (size_t)b * SEQ;
    BlockRef r; r.Q = Qb + (rb + (size_t)qb * QB) * QS + h * DQH; r.Kn = KNVb + rb * KNS + h * (DNOPE + DVH); r.Kr = KRb + rb * KRS; r.V = KNVb + rb * KNS + h * (DNOPE + DVH) + DNOPE;
    r.O = Ob + (rb + (size_t)qb * QB) * OS + h * DVH; r.P0 = qb * QB; return r;
}
__device__ __forceinline__ void attn_phase(char* lds, const bf16_t* Qb, const bf16_t* KNVb, const bf16_t* KRb, bf16_t* Ob, int first, int stride) {
    constexpr int total = NBATCH * NHEAD * 4;
    for (int L = first; L < total; L += stride) {
        for (int pass = 0; pass < 2; ++pass) { const BlockRef cur = make_ref(L, pass, Qb, KNVb, KRb, Ob); attn_block(cur, lds); }
    }
}
}
constexpr int NWAVES = 8;
constexpr size_t MiB = 1u << 20;
constexpr size_t WS_CTL = 0, CTL_ZERO_BYTES = 1 * MiB;
constexpr size_t WS_COS = 1 * MiB, WS_SIN = 9 * MiB;
constexpr size_t WS_LIST = 17 * MiB;
constexpr size_t WS_TOKINFO = 19 * MiB;
constexpr size_t WS_DBG = 21 * MiB;
constexpr size_t WS_WDN = 24 * MiB, WS_WUQ = 28 * MiB, WS_WUKV = 31 * MiB, WS_WO = 33 * MiB, WS_WPOOL = 37 * MiB, WS_WGU = 38 * MiB, WS_WD = 59 * MiB, WS_MWGU = 70 * MiB, WS_MWD = 158 * MiB;
constexpr size_t WS_ACT = 202 * MiB;
constexpr size_t WS_XN = WS_ACT;
constexpr size_t WS_DOWN = WS_ACT + 128 * MiB, WS_CQN = WS_ACT + 256 * MiB, WS_CKVN = WS_ACT + 320 * MiB, WS_KR = WS_ACT + 352 * MiB, WS_Q = WS_ACT + 360 * MiB, WS_KNV = WS_ACT + 552 * MiB;
constexpr size_t WS_HID = WS_ACT + 128 * MiB;
constexpr size_t WS_YB = WS_ACT + 486 * MiB;
constexpr size_t WS_END = WS_ACT + 808 * MiB;
static_assert(WS_MWD + (size_t)16 * 1024 * FFEP * 2 <= WS_ACT && WS_MWGU + (size_t)16 * 2 * FFEP * 1024 * 2 <= WS_MWD && WS_WD + (size_t)2 * 1024 * FFD * 2 <= WS_MWGU && WS_WGU + (size_t)2 * 2 * FFD * 1024 * 2 <= WS_WD, "weights map");
static_assert(WS_HID + (size_t)PSLOT * FFEP * 2 <= WS_YB && WS_YB + (size_t)PSLOT * 1024 * 2 <= WS_END && WS_HID + (size_t)NTOK * FFD * 2 <= WS_END && WS_KNV + (size_t)NTOK * NKV * 2 <= WS_END && WS_Q + (size_t)NTOK * NQ * 2 <= WS_KNV, "activation map");
constexpr int CW_TMO = 0, CW_CODE = 1, CW_CNT = 1024  , CW_DBG = 2048, CW_BAR = 4096  ;
constexpr int RING_OFF = 0, RING_BYTES = 131072, LDSCTL_OFF = RING_BYTES, MISC_OFF = LDSCTL_OFF + 320, LDS_BYTES = 147456;

typedef GAS unsigned gu32;
#define RLX_AGENT __ATOMIC_RELAXED, __HIP_MEMORY_SCOPE_AGENT
#define LDS_WAIT() asm volatile("s_waitcnt lgkmcnt(0)" ::: "memory")
#define VM_WAIT() asm volatile("s_waitcnt vmcnt(0)" ::: "memory")

#define XB_TMO      128
#define XB_XCNT(j)  (256  + 64 * (j))
#define XB_XSUB(j)  (1280 + 64 * (j))
#define XB_XGEN(j)  (2304 + 64 * (j))
#define XB_TOP      3328
#define XB_TOPGEN   3392
#define XCD_BAR_WORDS 3456
#define XB_SPIN_CAP (1u << 18)
__device__ __forceinline__ unsigned xb_ld(unsigned* p)              { return __hip_atomic_load(p, __ATOMIC_RELAXED, __HIP_MEMORY_SCOPE_AGENT); }
__device__ __forceinline__ unsigned xb_add(unsigned* p, unsigned v) { return __hip_atomic_fetch_add(p, v, __ATOMIC_RELAXED, __HIP_MEMORY_SCOPE_AGENT); }
__device__ __forceinline__ unsigned xb_xcc_id() { return (unsigned)__builtin_amdgcn_s_getreg((3 << 11) | 20) & 0xFu; }
#define XB_SPIN(cond, bar) do { unsigned _sp = 0; while (cond) { __builtin_amdgcn_s_sleep(1); \
    if ((++_sp & 255u) == 0u) { if (xb_ld(&(bar)[XB_TMO])) break; if (_sp > XB_SPIN_CAP) { atomicAdd(&(bar)[XB_TMO], 1u); break; } } } } while (0)
struct XcdBarrier { unsigned* bar; unsigned x; volatile LAS unsigned* st; };
__device__ __forceinline__ XcdBarrier xcd_barrier_post(unsigned* bar, volatile LAS unsigned* st) {
    XcdBarrier b; b.bar = bar; b.x = xb_xcc_id(); b.st = st;
    if (threadIdx.x == 0) (void)xb_add(&bar[XB_XCNT(b.x)], 1u);
    return b;
}
__device__ __forceinline__ void xcd_barrier_complete(unsigned* bar, unsigned x, unsigned& nloc, unsigned& nx) {
    const unsigned G = gridDim.x * gridDim.y * gridDim.z;
    unsigned sum, cnt, mine, sp = 0u;
    for (;;) {
        sum = 0u; cnt = 0u; mine = 0u;
#pragma unroll
        for (unsigned j = 0; j < 16; ++j) { const unsigned c = xb_ld(&bar[XB_XCNT(j)]); sum += c; cnt += (c > 0u) ? 1u : 0u; mine = (j == x) ? c : mine; }
        if (sum == G) break;
        __builtin_amdgcn_s_sleep(1);
        if ((++sp & 255u) == 0u) { if (xb_ld(&bar[XB_TMO])) break; if (sp > XB_SPIN_CAP) { atomicAdd(&bar[XB_TMO], 1u); break; } }
    }
    nloc = mine > 0u ? mine : 1u; nx = cnt > 0u ? cnt : 1u;
}
__device__ __forceinline__ void xcd_barrier(const XcdBarrier& b) {
    asm volatile("s_waitcnt vmcnt(0)" ::: "memory");
    __syncthreads();
    if (threadIdx.x == 0) {
        unsigned* bar = b.bar;
        __builtin_amdgcn_s_waitcnt(0);
        unsigned nloc = b.st[0], nx = b.st[1];
        if (nloc == 0u) { xcd_barrier_complete(bar, b.x, nloc, nx); b.st[0] = nloc; b.st[1] = nx; }
        const unsigned old = xb_add(&bar[XB_XSUB(b.x)], 1u);
        const unsigned gen = old / nloc;
        if (old + 1u == (gen + 1u) * nloc) {
            __builtin_amdgcn_fence(__ATOMIC_RELEASE, "agent");
            asm volatile("s_waitcnt vmcnt(0)" ::: "memory");
            const unsigned og = xb_add(&bar[XB_TOP], 1u);
            const unsigned tg = og / nx;
            if (og + 1u == (tg + 1u) * nx) xb_add(&bar[XB_TOPGEN], 1u);
            else XB_SPIN(xb_ld(&bar[XB_TOPGEN]) == tg, bar);
            __builtin_amdgcn_fence(__ATOMIC_ACQUIRE, "agent");
            xb_add(&bar[XB_XGEN(b.x)], 1u);
            asm volatile("s_waitcnt vmcnt(0)" ::: "memory");
        } else {
            XB_SPIN(xb_ld(&bar[XB_XGEN(b.x)]) == gen, bar);
            __builtin_amdgcn_fence(__ATOMIC_ACQUIRE, "agent");
            asm volatile("s_waitcnt vmcnt(0)" ::: "memory");
        }
    }
    __syncthreads();
}

constexpr int PT_OFF_ = LDSCTL_OFF + 512;
__device__ __forceinline__ unsigned rfl(unsigned v);
__device__ __forceinline__ const float* ptab(LAS unsigned char* L, int i);
struct Frame { LAS unsigned char* lds; volatile LAS unsigned* MISC; gu32* ctl; unsigned char* ws; int tid, lane, wave, vcu, G; };

__device__ __forceinline__ float wave_sum(float v) {
#pragma unroll
    for (int o = 1; o < 64; o <<= 1) v += __shfl_xor(v, o);
    return v;
}
__device__ __forceinline__ unsigned rfl(unsigned v) { return (unsigned)__builtin_amdgcn_readfirstlane((int)v); }

__device__ __forceinline__ int rowmap(int mode, int n) {
    if (mode == 0) return n;
    if (mode == 1) return (n >> 7) * 256 + (n & 127);
    if (mode == 2) return (n >> 7) * 256 + 128 + (n & 127);
    const int h = n / DQH, d = n - h * DQH;
    if (d < DNOPE) return 512 + h * DNOPE + d;
    if (d < DNOPE + 32) return (h >> 2) * 256 + (h & 3) * 32 + (d - DNOPE);
    return (h >> 2) * 256 + 128 + (h & 3) * 32 + (d - DNOPE - 32);
}
__device__ __forceinline__ void transpose_item(const float* W, int N, bf16_t* WT, int ldd, int mode, const float* nscale, LAS float* scr, int item, int lane) {
    const int nblk = N / 32, kb = item / nblk, nb = item % nblk, k0 = 64 * kb, n0 = 32 * nb;
    const float sc = nscale ? nscale[n0 + (lane & 31)] : 1.0f;
#pragma unroll 8
    for (int i = 0; i < 32; ++i) { const int kk = 2 * i + (lane >> 5); scr[kk * 33 + (lane & 31)] = W[(size_t)(k0 + kk) * N + n0 + (lane & 31)] * sc; }
    LDS_WAIT(); asm volatile("" ::: "memory");
    const int c = lane & 7;
#pragma unroll
    for (int j = 0; j < 4; ++j) { const int n = (lane >> 3) + 8 * j; const LAS float* s = scr + (8 * c) * 33 + n;
        u32x4 o; o.x = cvt_pk_bf16(s[0 * 33], s[1 * 33]); o.y = cvt_pk_bf16(s[2 * 33], s[3 * 33]); o.z = cvt_pk_bf16(s[4 * 33], s[5 * 33]); o.w = cvt_pk_bf16(s[6 * 33], s[7 * 33]);
        *(GAS u32x4*)(WT + (size_t)rowmap(mode, n0 + n) * ldd + k0 + 8 * c) = o; }
    LDS_WAIT(); asm volatile("" ::: "memory");
}
struct MatDesc { const float* src; bf16_t* dst; const float* nscale; int K, N, ldd, mode; };
struct InPtrs { const float* p[20]; };
constexpr int N_MATS = 70;
__device__ __forceinline__ MatDesc mat_desc(int m, LAS unsigned char* L, unsigned char* ws) {
    MatDesc d; d.nscale = nullptr; d.mode = 0;
    if (m < 2)       { const int a = m;      d.src = ptab(L, 4) + (size_t)a * DM * NDOWN;    d.K = DM;   d.N = NDOWN; d.dst = (bf16_t*)(ws + WS_WDN) + (size_t)a * NDOWNP * DM;  d.ldd = DM; }
    else if (m < 4)  { const int a = m - 2;  d.src = ptab(L, 6) + (size_t)a * QLR * NQ;      d.K = QLR;  d.N = NQ;    d.dst = (bf16_t*)(ws + WS_WUQ) + (size_t)a * NQ * QLR;     d.ldd = QLR; d.mode = 3; }
    else if (m < 6)  { const int a = m - 4;  d.src = ptab(L, 8) + (size_t)a * KVLR * NKV;    d.K = KVLR; d.N = NKV;   d.dst = (bf16_t*)(ws + WS_WUKV) + (size_t)a * NKV * KVLR;  d.ldd = KVLR; }
    else if (m < 8)  { const int a = m - 6;  d.src = ptab(L, 9) + (size_t)a * DM * DM;       d.K = DM;   d.N = DM;    d.dst = (bf16_t*)(ws + WS_WO) + (size_t)a * DM * DM;       d.ldd = DM; }
    else if (m < 16) { const int i = m - 8;  d.src = ptab(L, 10) + (size_t)i * 256 * 256;    d.K = 256;  d.N = 256;   d.dst = (bf16_t*)(ws + WS_WPOOL) + (size_t)i * 256 * 256;  d.ldd = 256; d.nscale = ptab(L, 11) + i * 256; }
    else if (m < 18) { const int a = m - 16; d.src = ptab(L, 12) + (size_t)a * DM * FFD;     d.K = DM;   d.N = FFD;   d.dst = (bf16_t*)(ws + WS_WGU) + (size_t)a * 2 * FFD * DM; d.ldd = DM; d.mode = 1; }
    else if (m < 20) { const int a = m - 18; d.src = ptab(L, 13) + (size_t)a * DM * FFD;     d.K = DM;   d.N = FFD;   d.dst = (bf16_t*)(ws + WS_WGU) + (size_t)a * 2 * FFD * DM; d.ldd = DM; d.mode = 2; }
    else if (m < 22) { const int a = m - 20; d.src = ptab(L, 14) + (size_t)a * FFD * DM;     d.K = FFD;  d.N = DM;    d.dst = (bf16_t*)(ws + WS_WD) + (size_t)a * DM * FFD;      d.ldd = FFD; }
    else if (m < 38) { const int i = m - 22; d.src = ptab(L, 16) + (size_t)i * DM * FFE;     d.K = DM;   d.N = FFE;   d.dst = (bf16_t*)(ws + WS_MWGU) + (size_t)i * 2 * FFEP * DM; d.ldd = DM; d.mode = 1; }
    else if (m < 54) { const int i = m - 38; d.src = ptab(L, 17) + (size_t)i * DM * FFE;     d.K = DM;   d.N = FFE;   d.dst = (bf16_t*)(ws + WS_MWGU) + (size_t)i * 2 * FFEP * DM; d.ldd = DM; d.mode = 2; }
    else             { const int i = m - 54; d.src = ptab(L, 18) + (size_t)i * FFE * DM;     d.K = FFE;  d.N = DM;    d.dst = (bf16_t*)(ws + WS_MWD) + (size_t)i * DM * FFEP;    d.ldd = FFEP; }
    return d;
}
__device__ __forceinline__ void p0_prologue(Frame& F) {
    const int* positions = (const int*)ptab(F.lds, 1);
    LAS float* scr = (LAS float*)(F.lds + RING_OFF + F.wave * 16384);
    const int gw = F.vcu * NWAVES + F.wave, NGW = F.G * NWAVES;
    int cum = 0;
    for (int m = 0; m < N_MATS; ++m) {
        const MatDesc d = mat_desc(m, F.lds, F.ws);
        const int nitems = (d.K / 64) * (d.N / 32);
        int first = gw - (cum % NGW); if (first < 0) first += NGW;
        for (int it = first; it < nitems; it += NGW) transpose_item(d.src, d.N, d.dst, d.ldd, d.mode, d.nscale, scr, it, F.lane);
        cum += nitems;
    }
    const int gt = gw * 64 + F.lane, NGT = NGW * 64; const u32x4 z4 = (u32x4){0u, 0u, 0u, 0u};
    for (int i = gt; i < 2 * 192 * 128; i += NGT) { const int a = i / (192 * 128), r = i % (192 * 128); *(GAS u32x4*)((bf16_t*)(F.ws + WS_WDN) + (size_t)a * NDOWNP * DM + (size_t)NDOWN * DM + (size_t)r * 8) = z4; }
    for (int i = gt; i < 16 * 128 * 128; i += NGT) { const int e = i / (128 * 128), r = (i / 128) % 128, c = i % 128; const int row = 2560 + (r < 64 ? 64 + r : 192 + (r - 64));
        *(GAS u32x4*)((bf16_t*)(F.ws + WS_MWGU) + (size_t)e * 2 * FFEP * DM + (size_t)row * DM + c * 8) = z4; }
    for (int i = gt; i < 16 * 1024 * 8; i += NGT) { const int row = i / 8, c = i % 8; *(GAS u32x4*)((bf16_t*)(F.ws + WS_MWD) + (size_t)row * FFEP + FFE + c * 8) = z4; }
    float* cosT = (float*)(F.ws + WS_COS); float* sinT = (float*)(F.ws + WS_SIN);
    for (int i = gt; i < NTOK * 32; i += NGT) { const int row = i >> 5, k = i & 31; const float inv = powf(10000.0f, -(float)(2 * k) / 64.0f); const float ang = (float)positions[row] * inv;
        cosT[i] = cosf(ang); sinT[i] = sinf(ang); }
}

template <bool COMBINE, bool FINAL>
__device__ __forceinline__ void norm_phase(Frame& F, const float* hin, float* hout, const float* gain, bf16_t* XN, const bf16_t* YB, const unsigned* tokinfo, const unsigned* cntw) {
    const int gw = F.vcu * NWAVES + F.wave, NGW = F.G * NWAVES;
    f32x4 g[4];
#pragma unroll
    for (int j = 0; j < 4; ++j) g[j] = *(const f32x4*)(gain + F.lane * 4 + 256 * j);
    unsigned nb[8];
    if constexpr (COMBINE) {
#pragma unroll
        for (int e = 0; e < 8; ++e) nb[e] = (rfl(__hip_atomic_load((unsigned*)cntw + 64 * e, RLX_AGENT)) + 255u) >> 8;
    }
    for (int m = gw; m < NTOK; m += NGW) {
        const GAS f32x4* xr = (const GAS f32x4*)(hin + (size_t)m * DM) + F.lane;
        f32x4 v[4];
#pragma unroll
        for (int j = 0; j < 4; ++j) v[j] = xr[64 * j];
        if constexpr (COMBINE) {
            const u32x4 t0 = *(const u32x4*)(tokinfo + (size_t)m * 8), t1 = *(const u32x4*)(tokinfo + (size_t)m * 8 + 4);
            const unsigned e0 = rfl(t0.x), r0 = rfl(t0.y), e1 = rfl(t1.x), r1 = rfl(t1.y); const float g0 = __uint_as_float(rfl(t0.z)), g1 = __uint_as_float(rfl(t1.z));
            unsigned b0 = 0u, b1 = 0u;
#pragma unroll
            for (int e = 0; e < 8; ++e) { b0 += ((unsigned)e < e0) ? nb[e] : 0u; b1 += ((unsigned)e < e1) ? nb[e] : 0u; }
            const GAS u32x2* y0 = (const GAS u32x2*)(YB + ((size_t)b0 * 256 + r0) * DM) + F.lane; const GAS u32x2* y1 = (const GAS u32x2*)(YB + ((size_t)b1 * 256 + r1) * DM) + F.lane;
#pragma unroll
            for (int j = 0; j < 4; ++j) { const u32x2 a = y0[64 * j], b = y1[64 * j];
                v[j].x += g0 * bflo(a.x) + g1 * bflo(b.x); v[j].y += g0 * bfhi(a.x) + g1 * bfhi(b.x); v[j].z += g0 * bflo(a.y) + g1 * bflo(b.y); v[j].w += g0 * bfhi(a.y) + g1 * bfhi(b.y); }
            if constexpr (!FINAL) { GAS f32x4* ho = (GAS f32x4*)(hout + (size_t)m * DM) + F.lane;
#pragma unroll
                for (int j = 0; j < 4; ++j) ho[64 * j] = v[j]; }
        }
        float s = 0.f;
#pragma unroll
        for (int j = 0; j < 4; ++j) s += (v[j].x * v[j].x + v[j].y * v[j].y) + (v[j].z * v[j].z + v[j].w * v[j].w);
        const float rstd = 1.0f / sqrtf(wave_sum(s) * (1.0f / DM) + RMS_EPS);
        if constexpr (FINAL) { GAS f32x4* ho = (GAS f32x4*)(hout + (size_t)m * DM) + F.lane;
#pragma unroll
            for (int j = 0; j < 4; ++j) ho[64 * j] = v[j] * rstd * g[j];
        } else { GAS u32x2* o8 = (GAS u32x2*)(XN + (size_t)m * DM) + F.lane;
#pragma unroll
            for (int j = 0; j < 4; ++j) { const f32x4 y = v[j] * rstd * g[j]; u32x2 w; w.x = cvt_pk_bf16(y.x, y.y); w.y = cvt_pk_bf16(y.z, y.w); o8[64 * j] = w; } }
    }
}
__device__ __forceinline__ void mid_phase(Frame& F, const bf16_t* DOWN, const float* qn, const float* kvn, const float* cosT, const float* sinT, bf16_t* CQN, bf16_t* CKVN, bf16_t* KR) {
    const int gw = F.vcu * NWAVES + F.wave, NGW = F.G * NWAVES, lane = F.lane;
    const f32x4 q0 = *(const f32x4*)(qn + lane * 8), q1 = *(const f32x4*)(qn + lane * 8 + 4), k0 = *(const f32x4*)(kvn + lane * 4);
    for (int m = gw; m < NTOK; m += NGW) {
        const bf16_t* dr = DOWN + (size_t)m * NDOWNP;
        const u32x4 cq = *(const GAS u32x4*)(dr + lane * 8); const u32x2 ck = *(const GAS u32x2*)(dr + QLR + lane * 4);
        const float x1 = bf2f(dr[QLR + KVLR + (lane & 31)]), x2 = bf2f(dr[QLR + KVLR + 32 + (lane & 31)]);
        const f32x4 a0 = (f32x4){bflo(cq.x), bfhi(cq.x), bflo(cq.y), bfhi(cq.y)}, a1 = (f32x4){bflo(cq.z), bfhi(cq.z), bflo(cq.w), bfhi(cq.w)}, c0 = (f32x4){bflo(ck.x), bfhi(ck.x), bflo(ck.y), bfhi(ck.y)};
        const float sq = wave_sum((a0.x * a0.x + a0.y * a0.y) + (a0.z * a0.z + a0.w * a0.w) + (a1.x * a1.x + a1.y * a1.y) + (a1.z * a1.z + a1.w * a1.w));
        const float sk = wave_sum((c0.x * c0.x + c0.y * c0.y) + (c0.z * c0.z + c0.w * c0.w));
        const float rq = 1.0f / sqrtf(sq * (1.0f / QLR) + RMS_EPS), rk = 1.0f / sqrtf(sk * (1.0f / KVLR) + RMS_EPS);
        const f32x4 y0 = a0 * rq * q0, y1 = a1 * rq * q1, z0 = c0 * rk * k0;
        u32x4 w; w.x = cvt_pk_bf16(y0.x, y0.y); w.y = cvt_pk_bf16(y0.z, y0.w); w.z = cvt_pk_bf16(y1.x, y1.y); w.w = cvt_pk_bf16(y1.z, y1.w);
        *(GAS u32x4*)(CQN + (size_t)m * QLR + lane * 8) = w;
        u32x2 w2; w2.x = cvt_pk_bf16(z0.x, z0.y); w2.y = cvt_pk_bf16(z0.z, z0.w);
        *(GAS u32x2*)(CKVN + (size_t)m * KVLR + lane * 4) = w2;
        const float c = cosT[(size_t)m * 32 + (lane & 31)], s = sinT[(size_t)m * 32 + (lane & 31)];
        const float o = lane < 32 ? x1 * c - x2 * s : x2 * c + x1 * s;
        KR[(size_t)m * DROPE + lane] = (bf16_t)(cvt_pk_bf16(o, o) & 0xffffu);
    }
}
template <int W>
__device__ __forceinline__ void pool_walk(const float* h, const LAS float* rs, const f32x2 g2, bf16_t* Z, size_t rowbase, int t_start, int c0, int nrows, int col) {
    f32x2 ring[W]; f32x2 sum = (f32x2){0.f, 0.f};
#pragma unroll
    for (int j = 0; j < W; ++j) ring[j] = (f32x2){0.f, 0.f};
    for (int r = 0; r < nrows; r += 16) {
#pragma unroll
        for (int j = 0; j < 16; ++j) {
            const int t = t_start + r + j; const size_t row = rowbase + t;
            const f32x2 x = *(const GAS f32x2*)(h + row * DM + col);
            const f32x2 v = x * rs[r + j] * g2;
            sum = sum + (v - ring[j % W]); ring[j % W] = v;
            if (t >= c0) { const float inv = 1.0f / (float)(t + 1 < W ? t + 1 : W); const f32x2 z = sum * inv - v; *(GAS unsigned*)(Z + row * DM + col) = cvt_pk_bf16(z.x, z.y); }
        }
    }
}
__device__ __forceinline__ void pool_phase(Frame& F, const float* h, const float* gain, bf16_t* Z) {
    LAS float* rs = (LAS float*)(F.lds + RING_OFF);
    const int col = F.tid * 2; const f32x2 g2 = *(const f32x2*)(gain + col);
    for (int chunk = F.vcu; chunk < NBATCH * 16; chunk += F.G) {
        const int b = chunk >> 4, c0 = (chunk & 15) * 128, t_start = c0 ? c0 - 16 : 0, nrows = c0 + 128 - t_start; const size_t rowbase = (size_t)b * SEQ;
        __syncthreads();
        for (int r = F.wave; r < nrows; r += NWAVES) {
            const GAS f32x4* xr = (const GAS f32x4*)(h + (rowbase + t_start + r) * DM) + F.lane; float s = 0.f;
#pragma unroll
            for (int j = 0; j < 4; ++j) { const f32x4 v = xr[64 * j]; s += (v.x * v.x + v.y * v.y) + (v.z * v.z + v.w * v.w); }
            s = wave_sum(s); if (F.lane == 0) rs[r] = 1.0f / sqrtf(s * (1.0f / DM) + RMS_EPS);
        }
        __syncthreads();
        const int grp = F.wave >> 1;
        if (grp == 0) pool_walk<2>(h, rs, g2, Z, rowbase, t_start, c0, nrows, col);
        else if (grp == 1) pool_walk<4>(h, rs, g2, Z, rowbase, t_start, c0, nrows, col);
        else if (grp == 2) pool_walk<8>(h, rs, g2, Z, rowbase, t_start, c0, nrows, col);
        else pool_walk<16>(h, rs, g2, Z, rowbase, t_start, c0, nrows, col);
    }
}
__device__ __forceinline__ void router_phase(Frame& F, const float* h, const float* gain, const float* router, bf16_t* XN, int* list, unsigned* tokinfo, unsigned* cntw) {
    LAS float* rt = (LAS float*)(F.lds + RING_OFF);
    LAS int* esel = (LAS int*)(F.lds + RING_OFF + 32768);
    LAS int* wt = (LAS int*)(F.lds + RING_OFF + 32768 + 2048);
    LAS int* base = (LAS int*)(F.lds + RING_OFF + 32768 + 2048 + 256);
    const int lane = F.lane;
    for (int idx = F.tid; idx < DM * NEXP; idx += NWAVES * 64) rt[(idx & 7) * DM + (idx >> 3)] = router[idx];
    f32x4 g[4];
#pragma unroll
    for (int j = 0; j < 4; ++j) g[j] = *(const f32x4*)(gain + lane * 4 + 256 * j);
    for (int chunk = F.vcu; chunk < NTOK / 256; chunk += F.G) {
        const int T0 = chunk * 256;
        __syncthreads();
        for (int i = 0; i < 32; ++i) {
            const int tl = F.wave * 32 + i, m = T0 + tl;
            const GAS f32x4* xr = (const GAS f32x4*)(h + (size_t)m * DM) + lane;
            f32x4 v[4]; float s = 0.f;
#pragma unroll
            for (int j = 0; j < 4; ++j) { v[j] = xr[64 * j]; s += (v[j].x * v[j].x + v[j].y * v[j].y) + (v[j].z * v[j].z + v[j].w * v[j].w); }
            const float rstd = 1.0f / sqrtf(wave_sum(s) * (1.0f / DM) + RMS_EPS);
            GAS u32x2* o8 = (GAS u32x2*)(XN + (size_t)m * DM) + lane;
#pragma unroll
            for (int j = 0; j < 4; ++j) { v[j] = v[j] * rstd * g[j]; u32x2 w; w.x = cvt_pk_bf16(v[j].x, v[j].y); w.y = cvt_pk_bf16(v[j].z, v[j].w); o8[64 * j] = w; }
            float lg[8];
#pragma unroll
            for (int e = 0; e < 8; ++e) { float p = 0.f;
#pragma unroll
                for (int j = 0; j < 4; ++j) { const f32x4 r4 = *(const LAS f32x4*)(rt + e * DM + lane * 4 + 256 * j); p += (v[j].x * r4.x + v[j].y * r4.y) + (v[j].z * r4.z + v[j].w * r4.w); }
                lg[e] = wave_sum(p); }
            int e0 = 0; float l0 = lg[0];
#pragma unroll
            for (int e = 1; e < 8; ++e) if (lg[e] > l0) { l0 = lg[e]; e0 = e; }
            int e1 = -1; float l1 = -__builtin_inff();
#pragma unroll
            for (int e = 0; e < 8; ++e) if (e != e0 && lg[e] > l1) { l1 = lg[e]; e1 = e; }
            const float g0 = 1.0f / (1.0f + __expf(l1 - l0)), g1 = 1.0f - g0;
            if (lane == 0) { esel[2 * tl] = e0; esel[2 * tl + 1] = e1; unsigned* ti = tokinfo + (size_t)m * 8;
                ti[0] = (unsigned)e0; ti[2] = __float_as_uint(g0); ti[4] = (unsigned)e1; ti[6] = __float_as_uint(g1); }
        }
        VM_WAIT(); __syncthreads();
        const int me = esel[F.tid]; int myrank = 0;
#pragma unroll
        for (int e = 0; e < 8; ++e) { const unsigned long long mask = __ballot(me == e); if (me == e) myrank = __popcll(mask & ((1ull << lane) - 1ull)); if (lane == 0) wt[F.wave * 8 + e] = __popcll(mask); }
        __syncthreads();
        int off = 0;
        for (int w = 0; w < F.wave; ++w) off += wt[w * 8 + me];
        if (F.tid < 8) { int tot = 0; for (int w = 0; w < 8; ++w) tot += wt[w * 8 + F.tid]; base[F.tid] = (int)__hip_atomic_fetch_add(cntw + 64 * F.tid, (unsigned)tot, RLX_AGENT); }
        __syncthreads();
        const int rank = base[me] + off + myrank, tok = T0 + (F.tid >> 1);
        list[(size_t)me * NTOK + rank] = tok;
        tokinfo[(size_t)tok * 8 + (F.tid & 1) * 4 + 1] = (unsigned)rank;
    }
}
template <bool GATHER>
struct MoeOrder {
    static constexpr size_t A_BLK = GATHER ? 0 : (size_t)256 * FFEP * 2, B_EXP = GATHER ? (size_t)2 * FFEP * DM * 2 : (size_t)DM * FFEP * 2, B_TILE = GATHER ? (size_t)256 * DM * 2 : (size_t)256 * FFEP * 2;
    static constexpr int NT = GATHER ? 2 * FFEP / 256 : DM / 256;
    const char* A; const char* B; const int* list; const unsigned* cntw; int G, c; unsigned bs[9];
    __device__ __forceinline__ void init(const unsigned* cntw_, const void* A_, const void* B_, const int* list_, int G_, int c_) {
        A = (const char*)A_; B = (const char*)B_; list = list_; cntw = cntw_; G = G_; c = c_; bs[0] = 0u;
#pragma unroll
        for (int e = 0; e < 8; ++e) { const unsigned ce = rfl(__hip_atomic_load((unsigned*)cntw + 64 * e, RLX_AGENT)); bs[e + 1] = bs[e] + ((ce + 255u) >> 8); }
    }
    __device__ __forceinline__ bool next(int i, pg8::Unit& u) const {
        const long L = (long)i * G + c; if (L >= (long)bs[8] * NT) return false;
        const unsigned blk = (unsigned)(L / NT); const int pn = (int)(L % NT);
        unsigned e = 0u, st = 0u;
#pragma unroll
        for (int k = 1; k < 8; ++k) if (blk >= bs[k]) { e = (unsigned)k; st = bs[k]; }
        const unsigned j = blk - st;
        u.b = B + (size_t)e * B_EXP + (size_t)pn * B_TILE; u.orow = (int)(blk * 256u); u.pn = pn; u.aux = (int)e;
        if constexpr (GATHER) { const unsigned ce = rfl(__hip_atomic_load((unsigned*)cntw + 64 * e, RLX_AGENT));
            u.a = A; u.rows = list + (size_t)e * NTOK + (size_t)j * 256; const unsigned rem = ce - j * 256u; u.nrows = rem < 256u ? (int)rem : 256; }
        else { u.a = A + (size_t)blk * A_BLK; u.rows = nullptr; u.nrows = 256; }
        return true;
    }
};
constexpr int NPHASE = 32;
struct Args { const float* in[20]; float* out; unsigned char* ws; int ph_lo, ph_hi, li, pad; };
constexpr int PT_OFF = LDSCTL_OFF + 512;
__device__ __forceinline__ unsigned long long ptab_u64(LAS unsigned char* L, int i) {
    const volatile LAS unsigned* p = (const volatile LAS unsigned*)(L + PT_OFF + 8 * i); const unsigned lo = rfl(p[0]), hi = rfl(p[1]); return ((unsigned long long)hi << 32) | lo; }
__device__ __forceinline__ const float* ptab(LAS unsigned char* L, int i) { return (const float*)ptab_u64(L, i); }
__device__ __forceinline__ Frame make_frame(LAS unsigned char* L) {
    Frame F; F.lds = L; F.MISC = (volatile LAS unsigned*)(L + MISC_OFF); F.tid = launder_v((int)threadIdx.x); F.lane = F.tid & 63; F.wave = __builtin_amdgcn_readfirstlane(F.tid >> 6);
    F.G = gridDim.x; { const int bx = blockIdx.x; F.vcu = (F.G % 8 == 0) ? (bx % 8) * (F.G / 8) + bx / 8 : bx; }
    F.ws = (unsigned char*)ptab_u64(L, 21); F.ctl = (gu32*)(F.ws + WS_CTL); return F;
}
__global__ void __launch_bounds__(NWAVES * 64, 2) fwd(Args args) {
    extern __shared__ __attribute__((aligned(16))) unsigned char lds[];
    LAS unsigned char* L = (LAS unsigned char*)lds;
    { const int tid = threadIdx.x;
      for (int u = tid; u < (LDS_BYTES - LDSCTL_OFF) / 4; u += NWAVES * 64) ((LAS unsigned*)(L + LDSCTL_OFF))[u] = 0u;
      __syncthreads();
      if (tid < 20) *(LAS unsigned long long*)(L + PT_OFF + 8 * tid) = (unsigned long long)args.in[tid];
      if (tid == 20) *(LAS unsigned long long*)(L + PT_OFF + 8 * 20) = (unsigned long long)args.out;
      if (tid == 21) *(LAS unsigned long long*)(L + PT_OFF + 8 * 21) = (unsigned long long)args.ws;
      __syncthreads(); }
    const int lo = args.ph_lo, hi = args.ph_hi;
    XcdBarrier bar; { gu32* ctl = (gu32*)(args.ws + WS_CTL); bar.bar = (unsigned*)(ctl + CW_BAR) + args.li * XCD_BAR_WORDS; bar.x = 0; bar.st = nullptr;
      if (hi - lo > 1) bar = xcd_barrier_post((unsigned*)(ctl + CW_BAR) + args.li * XCD_BAR_WORDS, (volatile LAS unsigned*)(L + MISC_OFF) + 8); }
#ifndef MK_ONLY
#define MK_ONLY (-1)
#endif
#define KIND(k) ((k) == 0 ? 0 : (k) == 31 ? 16 : 1 + ((k) - 1) % 15)
#define IN(k) ((MK_ONLY < 0 || KIND(k) == MK_ONLY) && lo <= (k) && (k) < hi)
#define SEAM(k) do { if ((k) + 1 < hi) xcd_barrier(bar); } while (0)
#define WSP(off) ((bf16_t*)(F.ws + (off)))
    LAS unsigned char* ring = L + RING_OFF;

    if (IN(0)) { Frame F = make_frame(L); p0_prologue(F); SEAM(0); }

    for (int lp = 0; lp < 2; ++lp) {
        const int pb = 1 + 15 * lp;
        if (IN(pb + 0)) { Frame F = make_frame(L); float* out = (float*)ptab(L, 20);
            if (lp == 0) norm_phase<false, false>(F, ptab(L, 0), nullptr, ptab(L, 2) + (size_t)(2 * lp) * DM, WSP(WS_XN), nullptr, nullptr, nullptr);
            else norm_phase<true, false>(F, out, out, ptab(L, 2) + (size_t)(2 * lp) * DM, WSP(WS_XN), WSP(WS_YB), (const unsigned*)(F.ws + WS_TOKINFO), (unsigned*)(F.ctl + CW_CNT) + (lp ? lp - 1 : 0) * 8 * 64);
            SEAM(pb + 0);
        }
        if (IN(pb + 1)) { Frame F = make_frame(L);
            pg8::RegOrder S; S.init(WSP(WS_XN), DM * 2, WSP(WS_WDN) + (size_t)lp * NDOWNP * DM, DM * 2, NTOK, NDOWNP, F.G, (int)blockIdx.x);
            pg8::EpiBf16 E{WSP(WS_DOWN), NDOWNP};
            pg8::gemm_phase<pg8::EpiBf16, pg8::RegOrder, false>(ring, DM * 2, DM * 2, DM, S, E);
            SEAM(pb + 1);
        }
        if (IN(pb + 2)) { Frame F = make_frame(L);
            mid_phase(F, WSP(WS_DOWN), ptab(L, 5) + (size_t)lp * QLR, ptab(L, 7) + (size_t)lp * KVLR, (const float*)(F.ws + WS_COS), (const float*)(F.ws + WS_SIN), WSP(WS_CQN), WSP(WS_CKVN), WSP(WS_KR)); SEAM(pb + 2); }
        if (IN(pb + 3)) { Frame F = make_frame(L);
            pg8::RegOrder S; S.init(WSP(WS_CQN), QLR * 2, WSP(WS_WUQ) + (size_t)lp * NQ * QLR, QLR * 2, NTOK, NQ, F.G, (int)blockIdx.x);
            pg8::EpiQ E{WSP(WS_Q), (const float*)(F.ws + WS_COS), (const float*)(F.ws + WS_SIN)};
            pg8::gemm_phase<pg8::EpiQ, pg8::RegOrder, false>(ring, QLR * 2, QLR * 2, QLR, S, E);
            SEAM(pb + 3);
        }
        if (IN(pb + 4)) { Frame F = make_frame(L);
            pg8::RegOrder S; S.init(WSP(WS_CKVN), KVLR * 2, WSP(WS_WUKV) + (size_t)lp * NKV * KVLR, KVLR * 2, NTOK, NKV, F.G, (int)blockIdx.x);
            pg8::EpiBf16 E{WSP(WS_KNV), NKV};
            pg8::gemm_phase<pg8::EpiBf16, pg8::RegOrder, false>(ring, KVLR * 2, KVLR * 2, KVLR, S, E);
            SEAM(pb + 4);
        }
        if (IN(pb + 5)) { Frame F = make_frame(L); att::attn_phase((char*)lds + RING_OFF, WSP(WS_Q), WSP(WS_KNV), WSP(WS_KR), WSP(WS_XN), F.vcu, F.G); SEAM(pb + 5); }
        if (IN(pb + 6)) { Frame F = make_frame(L); float* out = (float*)ptab(L, 20);
            pg8::RegOrder S; S.init(WSP(WS_XN), DM * 2, WSP(WS_WO) + (size_t)lp * DM * DM, DM * 2, NTOK, DM, F.G, (int)blockIdx.x);
            pg8::EpiResid E{lp == 0 ? ptab(L, 0) : (const float*)out, out, DM};
            pg8::gemm_phase<pg8::EpiResid, pg8::RegOrder, false>(ring, DM * 2, DM * 2, DM, S, E);
            SEAM(pb + 6);
        }
        if (IN(pb + 7)) { Frame F = make_frame(L); norm_phase<false, false>(F, ptab(L, 20), nullptr, ptab(L, 3) + (size_t)(2 * lp) * DM, WSP(WS_XN), nullptr, nullptr, nullptr); SEAM(pb + 7); }
        if (IN(pb + 8)) { Frame F = make_frame(L);
            pg8::RegOrder S; S.init(WSP(WS_XN), DM * 2, WSP(WS_WGU) + (size_t)lp * 2 * FFD * DM, DM * 2, NTOK, 2 * FFD, F.G, (int)blockIdx.x);
            pg8::EpiSwiglu E{WSP(WS_HID), FFD};
            pg8::gemm_phase<pg8::EpiSwiglu, pg8::RegOrder, false>(ring, DM * 2, DM * 2, DM, S, E);
            SEAM(pb + 8);
        }
        if (IN(pb + 9)) { Frame F = make_frame(L); float* out = (float*)ptab(L, 20);
            pg8::RegOrder S; S.init(WSP(WS_HID), FFD * 2, WSP(WS_WD) + (size_t)lp * DM * FFD, FFD * 2, NTOK, DM, F.G, (int)blockIdx.x);
            pg8::EpiResid E{out, out, DM};
            pg8::gemm_phase<pg8::EpiResid, pg8::RegOrder, false>(ring, FFD * 2, FFD * 2, FFD, S, E);
            SEAM(pb + 9);
        }
        if (IN(pb + 10)) { Frame F = make_frame(L); pool_phase(F, ptab(L, 20), ptab(L, 2) + (size_t)(2 * lp + 1) * DM, WSP(WS_XN)); SEAM(pb + 10); }
        if (IN(pb + 11)) { Frame F = make_frame(L); float* out = (float*)ptab(L, 20);
            pg8::RegOrder S; S.init(WSP(WS_XN), DM * 2, WSP(WS_WPOOL) + (size_t)lp * 4 * 256 * 256, 256 * 2, NTOK, DM, F.G, (int)blockIdx.x, 256 * 2);
            pg8::EpiResid E{out, out, DM};
            pg8::gemm_phase<pg8::EpiResid, pg8::RegOrder, false>(ring, DM * 2, 256 * 2, 256, S, E);
            SEAM(pb + 11);
        }
        if (IN(pb + 12)) { Frame F = make_frame(L);
            router_phase(F, ptab(L, 20), ptab(L, 3) + (size_t)(2 * lp + 1) * DM, ptab(L, 15) + (size_t)lp * DM * NEXP, WSP(WS_XN), (int*)(F.ws + WS_LIST), (unsigned*)(F.ws + WS_TOKINFO), (unsigned*)(F.ctl + CW_CNT) + lp * 8 * 64); SEAM(pb + 12); }
        if (IN(pb + 13)) { Frame F = make_frame(L);
            MoeOrder<true> S; S.init((unsigned*)(F.ctl + CW_CNT) + lp * 8 * 64, WSP(WS_XN), WSP(WS_MWGU) + (size_t)lp * 8 * 2 * FFEP * DM, (const int*)(F.ws + WS_LIST), F.G, (int)blockIdx.x);
            pg8::EpiSwiglu E{WSP(WS_HID), FFEP};
            pg8::gemm_phase<pg8::EpiSwiglu, MoeOrder<true>, true>(ring, DM * 2, DM * 2, DM, S, E);
            SEAM(pb + 13);
        }
        if (IN(pb + 14)) { Frame F = make_frame(L);
            MoeOrder<false> S; S.init((unsigned*)(F.ctl + CW_CNT) + lp * 8 * 64, WSP(WS_HID), WSP(WS_MWD) + (size_t)lp * 8 * DM * FFEP, (const int*)(F.ws + WS_LIST), F.G, (int)blockIdx.x);
            pg8::EpiBf16 E{WSP(WS_YB), DM};
            pg8::gemm_phase<pg8::EpiBf16, MoeOrder<false>, false>(ring, FFEP * 2, FFEP * 2, FFEP, S, E);
            SEAM(pb + 14);
        }
    }
    if (IN(31)) { Frame F = make_frame(L); float* out = (float*)ptab(L, 20);
        norm_phase<true, true>(F, out, out, ptab(L, 19), nullptr, WSP(WS_YB), (const unsigned*)(F.ws + WS_TOKINFO), (unsigned*)(F.ctl + CW_CNT) + 8 * 64); }
#undef IN
#undef SEAM
#undef WSP
}

#ifndef MK_PER_PHASE
#define MK_PER_PHASE 0
#endif
extern "C" void kernel_launch(void* const* d_in, const int* in_sizes, int n_in, void* d_out, int out_size, void* d_ws, size_t ws_size, hipStream_t stream) {
    static int grid = 0;
    if (grid == 0) {
        if (n_in != 20 || in_sizes[0] != NTOK * DM || out_size != NTOK * DM || ws_size < WS_END) { fprintf(stderr, "kernel_launch: unexpected shapes (n_in %d, in0 %d, out %d, ws %zu < %zu)\n", n_in, n_in > 0 ? in_sizes[0] : -1, out_size, ws_size, (size_t)WS_END); grid = -1; return; }
        int dev = 0, cus = 0, per_cu = 0;
        if (hipGetDevice(&dev) != hipSuccess || hipDeviceGetAttribute(&cus, hipDeviceAttributeMultiprocessorCount, dev) != hipSuccess) { grid = -1; return; }
        if (hipFuncSetAttribute((const void*)fwd, hipFuncAttributeMaxDynamicSharedMemorySize, LDS_BYTES) != hipSuccess) { fprintf(stderr, "kernel_launch: hipFuncSetAttribute failed\n"); grid = -1; return; }
        if (hipOccupancyMaxActiveBlocksPerMultiprocessor(&per_cu, (const void*)fwd, NWAVES * 64, LDS_BYTES) != hipSuccess || per_cu < 1) fprintf(stderr, "kernel_launch: occupancy query reports %d\n", per_cu);
        (void)hipGetLastError();
        grid = cus;
    }
    if (grid < 0) return;
    if (hipMemsetAsync((char*)d_ws + WS_CTL, 0, CTL_ZERO_BYTES, stream) != hipSuccess) return;
    Args a{};
    for (int i = 0; i < 20; ++i) a.in[i] = (const float*)d_in[i];
    a.out = (float*)d_out; a.ws = (unsigned char*)d_ws;
#if MK_PER_PHASE
    for (int p = 0; p < NPHASE; ++p) { a.ph_lo = p; a.ph_hi = p + 1; a.li = 0; hipLaunchKernelGGL(fwd, dim3(grid), dim3(NWAVES * 64), LDS_BYTES, stream, a); }
#else
    a.ph_lo = 0; a.ph_hi = NPHASE; a.li = 0;
    hipLaunchKernelGGL(fwd, dim3(grid), dim3(NWAVES * 64), LDS_BYTES, stream, a);
#endif
}
```

```cpp
#include <hip/hip_runtime.h>
#include <cstdio>
#include <cstdint>

#define GAS __attribute__((address_space(1)))
#define LAS __attribute__((address_space(3)))
typedef unsigned short bf16_t;
typedef short bf16x8 __attribute__((ext_vector_type(8)));
typedef short s16x4 __attribute__((ext_vector_type(4)));
typedef float f32x2 __attribute__((ext_vector_type(2)));
typedef float f32x4 __attribute__((ext_vector_type(4)));
typedef float f32x16 __attribute__((ext_vector_type(16)));
typedef unsigned u32x2 __attribute__((ext_vector_type(2)));
typedef unsigned u32x4 __attribute__((ext_vector_type(4)));

constexpr int DM = 1024, NBATCH = 32, SEQ = 2048, NTOK = NBATCH * SEQ;
constexpr int NHEAD = 8, DNOPE = 128, DROPE = 64, DVH = 128, DQH = DNOPE + DROPE, QLR = 512, KVLR = 256;
constexpr int NDOWN = QLR + KVLR + DROPE  , NDOWNP = 1024;
constexpr int NQ = NHEAD * DQH  , NKV = NHEAD * (DNOPE + DVH)  ;
constexpr int FFD = 2688, NEXP = 8, FFE = 1344, FFEP = 1408;
constexpr int PSLOT = (NTOK * 2 / 256 + NEXP) * 256;
constexpr float RMS_EPS = 1e-6f;

__device__ __forceinline__ unsigned cvt_pk_bf16(float lo, float hi) { unsigned r; asm volatile("v_cvt_pk_bf16_f32 %0, %1, %2" : "=v"(r) : "v"(lo), "v"(hi)); return r; }
__device__ __forceinline__ int launder_v(int v) { asm volatile("" : "+v"(v)); return v; }
__device__ __forceinline__ float bf2f(unsigned short b) { return __uint_as_float((unsigned)b << 16); }
__device__ __forceinline__ float bflo(unsigned w) { return __uint_as_float(w << 16); }
__device__ __forceinline__ float bfhi(unsigned w) { return __uint_as_float(w & 0xffff0000u); }

typedef unsigned long long ssq_t;
__device__ __forceinline__ ssq_t ssq_fix(float s) { return (ssq_t)(s * 16777216.0f); }
__device__ __forceinline__ float rstd_of(ssq_t q) { return 1.0f / sqrtf((float)q * (1.0f / 16777216.0f) * (1.0f / DM) + RMS_EPS); }
__device__ __forceinline__ float rstd_f(float ssq) { return 1.0f / sqrtf(ssq * (1.0f / DM) + RMS_EPS); }

namespace pg8 {
constexpr int BM = 256, BK = 64, HALF = 128, HTB = HALF * BK * 2  , STAGE_BYTES = 8 * HTB, NXCD = 8, WGM = 8;
__host__ __device__ __forceinline__ int lds_byte(int r, int c) { const int st = (r >> 4) * 2 + (c >> 5), rr = r & 15, cc = c & 31, ob = rr * 64 + cc * 2; return st * 1024 + (ob ^ (((ob >> 9) & 1) << 5)); }
__host__ __device__ __forceinline__ void stage_rc(int b, int& R, int& C) { const int st = b / 1024, sb = b % 1024, swz = sb ^ (((sb >> 9) & 1) << 5); R = (st >> 1) * 16 + swz / 64; C = (st & 1) * 32 + (swz % 64) / 2; }
__host__ __device__ __forceinline__ int perm32(int rho) { const int n = rho >> 4, i = rho & 15; return 8 * (i >> 2) + 4 * n + (i & 3); }

struct Unit { const char* a; const char* b; const int* rows; int nrows; int orow; int pn; int aux; };

struct RegOrder {
    const char* A; const char* B; size_t a_tile, b_tile, a_colstep; int nM, nN, nwg, G, c;
    __device__ __forceinline__ void init(const void* A_, size_t lda_b, const void* B_, size_t ldb_b, int M, int N, int G_, int c_, size_t a_colstep_ = 0) {
        A = (const char*)A_; B = (const char*)B_; a_tile = 256 * lda_b; b_tile = 256 * ldb_b; a_colstep = a_colstep_; nM = M / BM; nN = N / BM; nwg = nM * nN; G = G_; c = c_; }
    __device__ __forceinline__ bool next(int i, Unit& u) const {
        const long L = (long)i * G + c; if (L >= nwg) return false;
        int wgid = (int)L; { const int q = nwg / NXCD, r = nwg % NXCD, xcd = wgid % NXCD, off = wgid / NXCD; wgid = (xcd < r ? xcd * (q + 1) : r * (q + 1) + (xcd - r) * q) + off; }
        const int nig = WGM * nN, gid = wgid / nig, fm = gid * WGM, gsz = (nM - fm) < WGM ? (nM - fm) : WGM;
        const int pm = fm + ((wgid % nig) % gsz), pn = (wgid % nig) / gsz;
        u.a = A + (size_t)pm * a_tile + (size_t)pn * a_colstep; u.b = B + (size_t)pn * b_tile; u.rows = nullptr; u.nrows = 256; u.orow = pm * BM; u.pn = pn; u.aux = 0; return true;
    }
};

template <int RS> struct EpiBf16 {
    static constexpr bool PERM = true;
    bf16_t* O; int ldc; const ssq_t* rs;
    __device__ __forceinline__ void operator()(const f32x4 (&acc)[2][2][4][2], const Unit& u, int wr, int wc, int fr, int fq) const {
        const int row0 = u.orow + wr * 64 + fr, col0 = u.pn * BM + wc * 32 + 8 * fq;
#pragma unroll
        for (int ai = 0; ai < 2; ++ai)
#pragma unroll
            for (int m = 0; m < 4; ++m) { const int row = row0 + ai * HALF + m * 16; bf16_t* rowp = O + (size_t)row * ldc + col0;
                float sc = 1.0f; if constexpr (RS == 1) sc = rstd_of(rs[row]);
#pragma unroll
                for (int bj = 0; bj < 2; ++bj) { const f32x4 v0 = acc[ai][bj][m][0] * sc, v1 = acc[ai][bj][m][1] * sc;
                    u32x4 w; w.x = cvt_pk_bf16(v0[0], v0[1]); w.y = cvt_pk_bf16(v0[2], v0[3]); w.z = cvt_pk_bf16(v1[0], v1[1]); w.w = cvt_pk_bf16(v1[2], v1[3]);
                    *(u32x4*)(rowp + bj * HALF) = w; } }
    }
};
__device__ __forceinline__ float silu_mul(float g, float u) { return g * u * __builtin_amdgcn_rcpf(1.0f + __builtin_amdgcn_exp2f(-1.4426950408889634f * g)); }
template <int RS> struct EpiSwiglu {
    static constexpr bool PERM = true;
    bf16_t* H; int ldh; const void* rs; const int* list;
    __device__ __forceinline__ void operator()(const f32x4 (&acc)[2][2][4][2], const Unit& u, int wr, int wc, int fr, int fq) const {
        const int r0 = wr * 64 + fr, col0 = u.pn * HALF + wc * 32 + 8 * fq;
        const ssq_t* rsq = (const ssq_t*)rs; const float* rsp = (const float*)rs; if constexpr (RS == 2) rsp = rsp + (u.rows - list);
#pragma unroll
        for (int ai = 0; ai < 2; ++ai)
#pragma unroll
            for (int m = 0; m < 4; ++m) { const int r = r0 + ai * HALF + m * 16; bf16_t* rowp = H + (size_t)(u.orow + r) * ldh + col0;
                float sc; if constexpr (RS == 1) sc = rstd_of(rsq[u.orow + r]); else sc = rsp[r];
                const f32x4 g0 = acc[ai][0][m][0] * sc, g1 = acc[ai][0][m][1] * sc, u0 = acc[ai][1][m][0] * sc, u1 = acc[ai][1][m][1] * sc;
                u32x4 w; w.x = cvt_pk_bf16(silu_mul(g0[0], u0[0]), silu_mul(g0[1], u0[1])); w.y = cvt_pk_bf16(silu_mul(g0[2], u0[2]), silu_mul(g0[3], u0[3]));
                w.z = cvt_pk_bf16(silu_mul(g1[0], u1[0]), silu_mul(g1[1], u1[1])); w.w = cvt_pk_bf16(silu_mul(g1[2], u1[2]), silu_mul(g1[3], u1[3]));
                *(u32x4*)rowp = w; }
    }
};
struct EpiResidH {
    static constexpr bool PERM = true;
    const bf16_t* hin; bf16_t* hout; ssq_t* ssq;
    __device__ __forceinline__ void operator()(const f32x4 (&acc)[2][2][4][2], const Unit& u, int wr, int wc, int fr, int fq) const {
        const int row0 = u.orow + wr * 64 + fr, col0 = u.pn * BM + wc * 32 + 8 * fq;
#pragma unroll
        for (int ai = 0; ai < 2; ++ai)
#pragma unroll
            for (int m = 0; m < 4; ++m) { const int row = row0 + ai * HALF + m * 16; const size_t off = (size_t)row * DM + col0; float part = 0.f;
#pragma unroll
                for (int bj = 0; bj < 2; ++bj) { const u32x4 hv = *(const u32x4*)(hin + off + bj * HALF); const f32x4 a0 = acc[ai][bj][m][0], a1 = acc[ai][bj][m][1];
                    const float y0 = bflo(hv.x) + a0[0], y1 = bfhi(hv.x) + a0[1], y2 = bflo(hv.y) + a0[2], y3 = bfhi(hv.y) + a0[3], y4 = bflo(hv.z) + a1[0], y5 = bfhi(hv.z) + a1[1], y6 = bflo(hv.w) + a1[2], y7 = bfhi(hv.w) + a1[3];
                    part += (y0 * y0 + y1 * y1) + (y2 * y2 + y3 * y3) + (y4 * y4 + y5 * y5) + (y6 * y6 + y7 * y7);
                    u32x4 w; w.x = cvt_pk_bf16(y0, y1); w.y = cvt_pk_bf16(y2, y3); w.z = cvt_pk_bf16(y4, y5); w.w = cvt_pk_bf16(y6, y7);
                    *(u32x4*)(hout + off + bj * HALF) = w; }
                part += __shfl_xor(part, 16); part += __shfl_xor(part, 32);
                if (fq == 0) atomicAdd(ssq + row, ssq_fix(part));
                if (m & 1) asm volatile("" ::: "memory"); }
    }
};
struct EpiQ {
    static constexpr bool PERM = true;
    bf16_t* Q; const float* cosT; const float* sinT;
    __device__ __forceinline__ void operator()(const f32x4 (&acc)[2][2][4][2], const Unit& u, int wr, int wc, int fr, int fq) const {
        const int row0 = u.orow + wr * 64 + fr;
        if (u.pn < 2) {
            const int h = 4 * u.pn + wc;
#pragma unroll
            for (int ai = 0; ai < 2; ++ai)
#pragma unroll
                for (int m = 0; m < 4; ++m) { const int row = row0 + ai * HALF + m * 16;
                    const f32x4 c0 = *(const f32x4*)(cosT + (size_t)row * 32 + 8 * fq), c1 = *(const f32x4*)(cosT + (size_t)row * 32 + 8 * fq + 4);
                    const f32x4 s0 = *(const f32x4*)(sinT + (size_t)row * 32 + 8 * fq), s1 = *(const f32x4*)(sinT + (size_t)row * 32 + 8 * fq + 4);
                    const f32x4 a0 = acc[ai][0][m][0], a1 = acc[ai][0][m][1], b0 = acc[ai][1][m][0], b1 = acc[ai][1][m][1];
                    const f32x4 x0 = a0 * c0 - b0 * s0, x1 = a1 * c1 - b1 * s1, y0 = b0 * c0 + a0 * s0, y1 = b1 * c1 + a1 * s1;
                    bf16_t* rp = Q + (size_t)row * NQ + h * DQH + DNOPE + 8 * fq;
                    u32x4 w; w.x = cvt_pk_bf16(x0[0], x0[1]); w.y = cvt_pk_bf16(x0[2], x0[3]); w.z = cvt_pk_bf16(x1[0], x1[1]); w.w = cvt_pk_bf16(x1[2], x1[3]);
                    *(u32x4*)rp = w;
                    w.x = cvt_pk_bf16(y0[0], y0[1]); w.y = cvt_pk_bf16(y0[2], y0[3]); w.z = cvt_pk_bf16(y1[0], y1[1]); w.w = cvt_pk_bf16(y1[2], y1[3]);
                    *(u32x4*)(rp + 32) = w; }
        } else {
#pragma unroll
            for (int ai = 0; ai < 2; ++ai)
#pragma unroll
                for (int m = 0; m < 4; ++m) { const int row = row0 + ai * HALF + m * 16;
#pragma unroll
                    for (int bj = 0; bj < 2; ++bj) { const int h = 2 * (u.pn - 2) + bj; const f32x4 v0 = acc[ai][bj][m][0], v1 = acc[ai][bj][m][1];
                        u32x4 w; w.x = cvt_pk_bf16(v0[0], v0[1]); w.y = cvt_pk_bf16(v0[2], v0[3]); w.z = cvt_pk_bf16(v1[0], v1[1]); w.w = cvt_pk_bf16(v1[2], v1[3]);
                        *(u32x4*)(Q + (size_t)row * NQ + h * DQH + wc * 32 + 8 * fq) = w; } }
        }
    }
};

__device__ __forceinline__ unsigned gather_off(const Unit& u, int idx, unsigned lda_b, unsigned cb) { const int tok = idx < u.nrows ? u.rows[idx] : 0; return (unsigned)tok * lda_b + cb; }
template <class Epi, class Sched, bool GATHER>
__device__ __forceinline__ void gemm_phase(LAS unsigned char* lds, const unsigned lda_b, const unsigned ldb_b, const int K, const Sched& S, const Epi& E) {
    const int tid = launder_v((int)threadIdx.x), wid = __builtin_amdgcn_readfirstlane(tid >> 6), lane = tid & 63, wr = wid >> 2, wc = wid & 3, fr = lane & 15, fq = lane >> 4;
    const int nt = K / BK;
    unsigned voffA[2], voffB[2]; int Rr[2]; unsigned Cb[2];
#pragma unroll
    for (int i = 0; i < 2; ++i) { int R, C; stage_rc(tid * 16 + i * 8192, R, C); const int Rb = Epi::PERM ? ((R & ~31) + perm32(R & 31)) : R;
        Rr[i] = R; Cb[i] = (unsigned)C * 2u; voffA[i] = (unsigned)R * lda_b + (unsigned)C * 2u; voffB[i] = (unsigned)Rb * ldb_b + (unsigned)C * 2u; }
    const size_t kstep = (size_t)(BK * 2);
    const size_t hstepA = (size_t)HALF * lda_b, hstepB = (size_t)HALF * ldb_b;
    const unsigned ldsw = (unsigned)wid * 1024u;
    const int aoff = lds_byte(wr * 64 + fr, fq * 8), boff = lds_byte(wc * 32 + fr, fq * 8);
    unsigned cv0[2] = {0u, 0u}, cv1[2] = {0u, 0u}, nv0[2] = {0u, 0u}, nv1[2] = {0u, 0u};
#define PG8_SA(b, h) (((b) * 2 + (h)) * HTB)
#define PG8_SB(b, h) ((4 + (b) * 2 + (h)) * HTB)
#define PG8_LOAD16(gp, ldsoff) __builtin_amdgcn_global_load_lds((const unsigned*)(gp), (LAS unsigned*)(lds + (ldsoff)), 16, 0, 0)
#define PG8_STAGE_B(bufoff, gbase, h) do { _Pragma("unroll") for (int _i = 0; _i < 2; ++_i) PG8_LOAD16((gbase) + (h) * hstepB + voffB[_i], (bufoff) + ldsw + _i * 8192); } while (0)
#define PG8_STAGE_A(bufoff, gbase, h, usenext) do { _Pragma("unroll") for (int _i = 0; _i < 2; ++_i) { unsigned _vo; \
        if constexpr (GATHER) { _vo = (usenext) ? ((h) ? nv1[_i] : nv0[_i]) : ((h) ? cv1[_i] : cv0[_i]); } else { _vo = voffA[_i] + (unsigned)((h) * hstepA); } \
        PG8_LOAD16((gbase) + _vo, (bufoff) + ldsw + _i * 8192); } } while (0)
#define PG8_LDA(dst, b, h) do { _Pragma("unroll") for (int m = 0; m < 4; ++m) _Pragma("unroll") for (int k = 0; k < 2; ++k) dst[m][k] = *(const LAS bf16x8*)(lds + PG8_SA(b, h) + aoff + m * 2048 + k * 1024); } while (0)
#define PG8_LDB(dst, b, h) do { _Pragma("unroll") for (int n = 0; n < 2; ++n) _Pragma("unroll") for (int k = 0; k < 2; ++k) dst[n][k] = *(const LAS bf16x8*)(lds + PG8_SB(b, h) + boff + n * 2048 + k * 1024); } while (0)
#define PG8_MMA(ai, bj, At, Bt) do { __builtin_amdgcn_s_setprio(1); _Pragma("unroll") for (int m = 0; m < 4; ++m) _Pragma("unroll") for (int n = 0; n < 2; ++n) _Pragma("unroll") for (int k = 0; k < 2; ++k) \
        acc[ai][bj][m][n] = __builtin_amdgcn_mfma_f32_16x16x32_bf16(Bt[n][k], At[m][k], acc[ai][bj][m][n], 0, 0, 0); __builtin_amdgcn_s_setprio(0); } while (0)
#define PG8_WAIT_V(n) asm volatile("s_waitcnt vmcnt(" #n ")" ::: "memory")
#define PG8_WAIT_L(n) asm volatile("s_waitcnt lgkmcnt(" #n ")" ::: "memory")
#define PG8_BAR __builtin_amdgcn_s_barrier()
#define PG8_SCHED __builtin_amdgcn_sched_barrier(0)
    Unit cur, nxt; int ui = 0;
    if (!S.next(0, cur)) return;
    f32x4 acc[2][2][4][2];
#pragma unroll
    for (int a = 0; a < 2; ++a)
#pragma unroll
        for (int b = 0; b < 2; ++b)
#pragma unroll
            for (int m = 0; m < 4; ++m)
#pragma unroll
                for (int n = 0; n < 2; ++n) acc[a][b][m][n] = (f32x4){0.f, 0.f, 0.f, 0.f};
    bf16x8 At[4][2], B0[2][2], B1[2][2];
    const char* cA = cur.a; const char* cB = cur.b;
    if constexpr (GATHER) {
#pragma unroll
        for (int i = 0; i < 2; ++i) { cv0[i] = gather_off(cur, Rr[i], lda_b, Cb[i]); cv1[i] = gather_off(cur, HALF + Rr[i], lda_b, Cb[i]); }
    }
    PG8_STAGE_B(PG8_SB(0, 0), cB, 0); PG8_STAGE_B(PG8_SB(0, 1), cB, 1); PG8_STAGE_A(PG8_SA(0, 0), cA, 0, false); PG8_STAGE_A(PG8_SA(0, 1), cA, 1, false);
    if (wr == 1) PG8_BAR;
    PG8_WAIT_V(2); PG8_BAR;
    PG8_STAGE_B(PG8_SB(1, 0), cB + kstep, 0); PG8_STAGE_A(PG8_SA(1, 0), cA + kstep, 0, false); PG8_STAGE_B(PG8_SB(1, 1), cB + kstep, 1);
    PG8_WAIT_V(6); PG8_BAR;
    for (;;) {
        const bool has_next = S.next(ui + 1, nxt);
        const char* nA = has_next ? nxt.a : cA; const char* nB = has_next ? nxt.b : cB;
        if constexpr (GATHER) {
#pragma unroll
            for (int i = 0; i < 2; ++i) { nv0[i] = has_next ? gather_off(nxt, Rr[i], lda_b, Cb[i]) : cv0[i]; nv1[i] = has_next ? gather_off(nxt, HALF + Rr[i], lda_b, Cb[i]) : cv1[i]; }
        }
#pragma nounroll
        for (int t = 0; t < nt; t += 2) {
            const bool last = (t == nt - 2);
            const char* a1 = cA + (size_t)(t + 1) * kstep;
            const char* a2 = last ? nA : cA + (size_t)(t + 2) * kstep; const char* b2 = last ? nB : cB + (size_t)(t + 2) * kstep;
            const char* a3 = a2 + kstep; const char* b3 = b2 + kstep;
            PG8_LDB(B0, 0, 0); PG8_LDB(B1, 0, 1); PG8_SCHED; PG8_LDA(At, 0, 0); PG8_STAGE_A(PG8_SA(1, 1), a1, 1, false);
            PG8_WAIT_V(8); PG8_WAIT_L(0); PG8_BAR; PG8_MMA(0, 0, At, B0); PG8_MMA(0, 1, At, B1); PG8_BAR; PG8_SCHED;
            PG8_LDA(At, 0, 1); PG8_STAGE_B(PG8_SB(0, 0), b2, 0); PG8_STAGE_B(PG8_SB(0, 1), b2, 1); PG8_STAGE_A(PG8_SA(0, 0), a2, 0, last);
            PG8_WAIT_V(8); PG8_WAIT_L(0); PG8_BAR; PG8_MMA(1, 0, At, B0); PG8_MMA(1, 1, At, B1); PG8_BAR; PG8_SCHED;
            PG8_LDB(B0, 1, 0); PG8_LDB(B1, 1, 1); PG8_SCHED; PG8_LDA(At, 1, 0); PG8_STAGE_A(PG8_SA(0, 1), a2, 1, last);
            PG8_WAIT_V(8); PG8_WAIT_L(0); PG8_BAR; PG8_MMA(0, 0, At, B0); PG8_MMA(0, 1, At, B1); PG8_BAR; PG8_SCHED;
            PG8_LDA(At, 1, 1); PG8_STAGE_B(PG8_SB(1, 0), b3, 0); PG8_STAGE_B(PG8_SB(1, 1), b3, 1); PG8_STAGE_A(PG8_SA(1, 0), a3, 0, last);
            PG8_WAIT_V(8); PG8_WAIT_L(0); PG8_BAR; PG8_MMA(1, 0, At, B0); PG8_MMA(1, 1, At, B1); PG8_BAR; PG8_SCHED;
        }
        if (wr == 0) PG8_BAR;
        E(acc, cur, wr, wc, fr, fq);
        if (!has_next) break;
#pragma unroll
        for (int a = 0; a < 2; ++a)
#pragma unroll
            for (int b = 0; b < 2; ++b)
#pragma unroll
                for (int m = 0; m < 4; ++m)
#pragma unroll
                    for (int n = 0; n < 2; ++n) acc[a][b][m][n] = (f32x4){0.f, 0.f, 0.f, 0.f};
        cur = nxt; cA = nA; cB = nB; ++ui;
        if constexpr (GATHER) {
#pragma unroll
            for (int i = 0; i < 2; ++i) { cv0[i] = nv0[i]; cv1[i] = nv1[i]; }
        }
        if (wr == 1) PG8_BAR;
    }
    PG8_WAIT_V(0);
    PG8_BAR;
#undef PG8_SA
#undef PG8_SB
#undef PG8_LOAD16
#undef PG8_STAGE_A
#undef PG8_STAGE_B
#undef PG8_LDA
#undef PG8_LDB
#undef PG8_MMA
#undef PG8_WAIT_V
#undef PG8_WAIT_L
#undef PG8_BAR
#undef PG8_SCHED
}
}
namespace att {
constexpr int NW = 8, QBLK = 32, KVBLK = 64, QB = NW * QBLK;
constexpr int DQK = 192, DV = 128;
constexpr int QS = NQ, KNS = NKV, KRS = DROPE, OS = DM;
constexpr int SHM_V = KVBLK * DV * 2, SHM_K = KVBLK * DQK * 2;
constexpr int LDS_QR = 2 * SHM_V + 2 * SHM_K + NW * 64 * 4;
constexpr int LDS_BYTES = LDS_QR + NW * 4096;
constexpr float SCALE = 0.07216878364870322f;
constexpr float THR = 8.f;
#define KSWZ(row, ch) ((row) * 384 + ((((ch) ^ (((row) >> 1) & 7))) << 4))
#define SBAR() __builtin_amdgcn_sched_barrier(0)
__device__ __forceinline__ int v_st(int k, int c) { const int kk = (k & ~0xC) | ((k & 4) << 1) | ((k & 8) >> 1); return ((kk >> 3) * 4 + (c >> 5)) * 512 + ((kk & 7) * 32 + (c & 31)) * 2; }
__device__ __forceinline__ int v_rd_base(int lane) { return ((lane & 3) << 3) | (((lane >> 2) & 3) << 6) | (((lane >> 4) & 1) << 5) | (((lane >> 5) & 1) << 8); }
constexpr int v_rd_off(int d0, int ks, int half) { return d0 * 512 + ks * 4096 + half * 2048; }
__device__ __forceinline__ int crow(int r, int hi) { return (r & 3) + 8 * (r >> 2) + 4 * hi; }
__device__ __forceinline__ void mask_tile(f32x16& p0, f32x16& p1, int dq) {
    const float NEG = -__builtin_inff();
#pragma unroll
    for (int r = 0; r < 16; ++r) {
        const int c = (r & 3) + 8 * (r >> 2);
        if (dq - c < 0) p0[r] = NEG;
        if (dq - c - 32 < 0) p1[r] = NEG;
    }
}
__device__ __forceinline__ void partialSM(f32x16& p0, f32x16& p1, float& m_reg, float& mn, float& alpha) {
    float pmax = p0[0]; for (int r = 1; r < 16; ++r) pmax = fmaxf(pmax, p0[r]); for (int r = 0; r < 16; ++r) pmax = fmaxf(pmax, p1[r]);
    { auto rr = __builtin_amdgcn_permlane32_swap(__float_as_uint(pmax), __float_as_uint(pmax), false, false);
      pmax = fmaxf(__uint_as_float(rr[0]), __uint_as_float(rr[1])); }
    constexpr float C2 = 1.4426950408889634f * SCALE;
    if (__builtin_expect(__all((pmax - m_reg) * SCALE <= THR), 1)) { mn = m_reg; alpha = 1.f; }
    else { mn = fmaxf(m_reg, pmax); alpha = __builtin_amdgcn_exp2f((m_reg - mn) * C2); m_reg = mn; }
    const float mnL = -mn * C2;
    for (int r = 0; r < 16; ++r) p0[r] = fmaf(p0[r], C2, mnL); for (int r = 0; r < 16; ++r) p1[r] = fmaf(p1[r], C2, mnL);
    for (int r = 0; r < 16; ++r) p0[r] = __builtin_amdgcn_exp2f(p0[r]);
}
__device__ __forceinline__ void finishSM(f32x16& p0, f32x16& p1, float alpha, float& l_reg, bf16x8& pa0, bf16x8& pa1, bf16x8& pa2, bf16x8& pa3) {
    for (int r = 0; r < 16; ++r) p1[r] = __builtin_amdgcn_exp2f(p1[r]);
    float ps = 0; for (int r = 0; r < 16; ++r) ps += p0[r]; for (int r = 0; r < 16; ++r) ps += p1[r];
    { auto rr = __builtin_amdgcn_permlane32_swap(__float_as_uint(ps), __float_as_uint(ps), false, false);
      ps = __uint_as_float(rr[0]) + __uint_as_float(rr[1]); }
    l_reg = l_reg * alpha + ps;
#define PK4(P, B_, OUT) do { unsigned a0 = cvt_pk_bf16(P[B_+0], P[B_+1]), a1 = cvt_pk_bf16(P[B_+2], P[B_+3]);                          \
        unsigned b0 = cvt_pk_bf16(P[B_+4], P[B_+5]), b1 = cvt_pk_bf16(P[B_+6], P[B_+7]);                                             \
        auto r0 = __builtin_amdgcn_permlane32_swap(a0, b0, false, false); auto r1 = __builtin_amdgcn_permlane32_swap(a1, b1, false, false); \
        u32x4 w = {r0[0], r1[0], r0[1], r1[1]}; OUT = *reinterpret_cast<bf16x8*>(&w); } while (0)
    PK4(p0, 0, pa0); PK4(p0, 8, pa1); PK4(p1, 0, pa2); PK4(p1, 8, pa3);
#undef PK4
}
template <int KB>
__device__ __forceinline__ void qkt(f32x16& p0, f32x16& p1, const char* K_lds, int r32, int hi, const bf16x8* qr, const char* qrl) {
    p0 = f32x16{}; p1 = f32x16{};
    const char* kb[4];
#pragma unroll
    for (int dd = 0; dd < 4; ++dd) kb[dd] = K_lds + KB * SHM_K + KSWZ(r32, dd * 2 + hi);
#pragma unroll
    for (int d0 = 0; d0 < 12; ++d0) { const char* a = kb[d0 & 3] + (d0 >> 2) * 128;
        bf16x8 b0 = *reinterpret_cast<const bf16x8*>(a);
        bf16x8 b1 = *reinterpret_cast<const bf16x8*>(a + 32 * 384);
        const bf16x8 qf = d0 < 8 ? qr[d0 & 7] : *reinterpret_cast<const bf16x8*>(qrl + (d0 - 8) * 1024);
        p0 = __builtin_amdgcn_mfma_f32_32x32x16_bf16(b0, qf, p0, 0, 0, 0);
        p1 = __builtin_amdgcn_mfma_f32_32x32x16_bf16(b1, qf, p1, 0, 0, 0);
        if ((d0 & 3) == 3 && d0 < 11) SBAR(); }
}
template <int VB>
__device__ __forceinline__ void pv_tile(f32x16* o, int vb0, bf16x8 pa0, bf16x8 pa1, bf16x8 pa2, bf16x8 pa3) {
#define TRRD(dst, off) asm volatile("ds_read_b64_tr_b16 %0, %1 offset:%2" : "=&v"(dst) : "v"(vb0), "i"(off) : "memory")
#define PV_D0(d0) do { s16x4 l0, l1, l2, l3, h0, h1, h2, h3; constexpr int b_ = VB * SHM_V + v_rd_off(d0, 0, 0); \
        TRRD(l0, b_); TRRD(h0, b_ + 2048); TRRD(l1, b_ + 4096); TRRD(h1, b_ + 6144); TRRD(l2, b_ + 8192); TRRD(h2, b_ + 10240); TRRD(l3, b_ + 12288); TRRD(h3, b_ + 14336); \
        asm volatile("s_waitcnt lgkmcnt(0)" ::: "memory"); SBAR();   \
        o[d0] = __builtin_amdgcn_mfma_f32_32x32x16_bf16(pa0, (bf16x8){l0[0], l0[1], l0[2], l0[3], h0[0], h0[1], h0[2], h0[3]}, o[d0], 0, 0, 0);   \
        o[d0] = __builtin_amdgcn_mfma_f32_32x32x16_bf16(pa1, (bf16x8){l1[0], l1[1], l1[2], l1[3], h1[0], h1[1], h1[2], h1[3]}, o[d0], 0, 0, 0);   \
        o[d0] = __builtin_amdgcn_mfma_f32_32x32x16_bf16(pa2, (bf16x8){l2[0], l2[1], l2[2], l2[3], h2[0], h2[1], h2[2], h2[3]}, o[d0], 0, 0, 0);   \
        o[d0] = __builtin_amdgcn_mfma_f32_32x32x16_bf16(pa3, (bf16x8){l3[0], l3[1], l3[2], l3[3], h3[0], h3[1], h3[2], h3[3]}, o[d0], 0, 0, 0); } while (0)
    PV_D0(0); PV_D0(1); PV_D0(2); PV_D0(3);
#undef PV_D0
#undef TRRD
}
struct BlockRef { const bf16_t* Q; const bf16_t* Kn; const bf16_t* Kr; const bf16_t* V; bf16_t* O; int P0; };
struct Seam { bf16x8 qr[8]; bf16x8 st_v0, st_v1, st_k0, st_k1, st_k2; };
#define VMW() asm volatile("s_waitcnt vmcnt(0)" ::: "memory")
#define VMWN(n) asm volatile("s_waitcnt vmcnt(%0)" :: "i"(n) : "memory")
#define LD8(p) (*reinterpret_cast<const bf16x8*>(p))
#define SLOAD_H(R_, k0) do { S.st_v0 = LD8((R_).V + (size_t)((k0) + sr) * KNS + sc); S.st_v1 = LD8((R_).V + (size_t)((k0) + 32 + sr) * KNS + sc);              \
                             S.st_k0 = LD8((R_).Kn + (size_t)((k0) + sr) * KNS + sc); S.st_k1 = LD8((R_).Kn + (size_t)((k0) + 32 + sr) * KNS + sc);            \
                             S.st_k2 = LD8((R_).Kr + (size_t)((k0) + rr) * KRS + rc); } while (0)
#define SWRITE_HK(bf) do { *(bf16x8*)(K_lds + (bf) * SHM_K + kws) = S.st_k0; *(bf16x8*)(K_lds + (bf) * SHM_K + kws + 32 * 384) = S.st_k1; *(bf16x8*)(K_lds + (bf) * SHM_K + kws2) = S.st_k2; } while (0)
#define SWRITE_HV(bf) do { *(bf16x8*)(V_lds + (bf) * SHM_V + vst0) = S.st_v0; *(bf16x8*)(V_lds + (bf) * SHM_V + vst1) = S.st_v1; } while (0)
#define SWRITE_H(bf) do { SWRITE_HV(bf); SWRITE_HK(bf); } while (0)
#define ATT_IDX const int tid = launder_v((int)threadIdx.x), wid = __builtin_amdgcn_readfirstlane(tid >> 6), lane = tid & 63, r32 = lane & 31, hi = lane >> 5; \
    const int sr = tid >> 4, sc = (tid & 15) * 8, rr = tid >> 3, rc = (tid & 7) * 8, kws = KSWZ(sr, (tid & 15)), kws2 = KSWZ(rr, 16 + (tid & 7));
__device__ __forceinline__ void attn_block(const BlockRef& cur, char* lds) {
    ATT_IDX;
    Seam S;
    const int NT = cur.P0 / KVBLK + QB / KVBLK;
    const int qlo = cur.P0 + wid * QBLK, qm = qlo + r32 - 4 * hi;
    char* V_lds = lds; char* K_lds = lds + 2 * SHM_V;
    float* ws = (float*)(lds + 2 * SHM_V + 2 * SHM_K) + wid * 64; float* li_l = ws, * al_l = ws + 32;
    float m_reg = -1e30f, l_reg = 0; f32x16 o[4] = {};
    const int vst0 = v_st(sr, sc), vst1 = v_st(32 + sr, sc);
    const int vb0 = (int)(uintptr_t)V_lds + v_rd_base(lane);
    char* qrl = lds + LDS_QR + wid * 4096 + lane * 16;
#define RESC(a) do { if (__any((a) < 1.f)) { if (hi == 0) al_l[r32] = (a); asm volatile("s_waitcnt lgkmcnt(0)" ::: "memory");              \
                     for (int d_ = 0; d_ < 4; ++d_) for (int r = 0; r < 16; ++r) o[d_][r] *= al_l[crow(r, hi)]; } } while (0)
#define KBASE(t) ((t) * KVBLK)
#define MASKT(P0_, P1_, t) do { const int kb_ = KBASE(t); if (kb_ + KVBLK - 1 > qlo) mask_tile(P0_, P1_, qm - kb_); } while (0)
    SLOAD_H(cur, 0);
#pragma unroll
    for (int d0 = 0; d0 < 8; ++d0) S.qr[d0] = LD8(cur.Q + (size_t)(wid * QBLK + r32) * QS + d0 * 16 + hi * 8);
    { bf16x8 t0 = LD8(cur.Q + (size_t)(wid * QBLK + r32) * QS + 128 + hi * 8), t1 = LD8(cur.Q + (size_t)(wid * QBLK + r32) * QS + 144 + hi * 8),
             t2 = LD8(cur.Q + (size_t)(wid * QBLK + r32) * QS + 160 + hi * 8), t3 = LD8(cur.Q + (size_t)(wid * QBLK + r32) * QS + 176 + hi * 8);
      *(bf16x8*)(qrl) = t0; *(bf16x8*)(qrl + 1024) = t1; *(bf16x8*)(qrl + 2048) = t2; *(bf16x8*)(qrl + 3072) = t3; }
    VMW(); SWRITE_H(0);
    __syncthreads();
    f32x16 p0, p1; float mn, al; bf16x8 pa0, pa1, pa2, pa3;
#define TILE_STEP(t, BF) do {                                                                                                 \
        if ((t) + 1 < NT) { SLOAD_H(cur, KBASE((t) + 1)); }                                                                    \
        SBAR(); qkt<BF>(p0, p1, K_lds, r32, hi, S.qr, qrl);                                                                   \
        MASKT(p0, p1, (t)); partialSM(p0, p1, m_reg, mn, al); RESC(al);                                                        \
        finishSM(p0, p1, al, l_reg, pa0, pa1, pa2, pa3); SBAR();                                                              \
        pv_tile<BF>(o, vb0, pa0, pa1, pa2, pa3);                                                                              \
        if ((t) + 1 < NT) { VMW(); SWRITE_H(1 - BF); }                                                                         \
        __syncthreads(); } while (0)
    for (int t = 0; t < NT; t += 2) { TILE_STEP(t, 0); TILE_STEP(t + 1, 1); }
    if (hi == 0) li_l[r32] = l_reg; asm volatile("s_waitcnt lgkmcnt(0)" ::: "memory");
    float rli[16];
#pragma unroll
    for (int r = 0; r < 16; ++r) rli[r] = __builtin_amdgcn_rcpf(li_l[crow(r, hi)]);
    bf16_t* Ow = cur.O + (size_t)(wid * QBLK) * OS;
#pragma unroll
    for (int r = 0; r < 16; ++r) { const int orow = crow(r, hi);
#pragma unroll
        for (int d0 = 0; d0 < 4; ++d0) { const float v = o[d0][r] * rli[r];
            const float vn = __shfl_xor(v, 1);
            if ((r32 & 1) == 0) *(unsigned*)(Ow + (size_t)orow * OS + d0 * 32 + r32) = cvt_pk_bf16(v, vn); } }
    __syncthreads();
#undef RESC
#undef KBASE
#undef MASKT
#undef TILE_STEP
}
#undef VMW
#undef VMWN
#undef LD8
#undef SLOAD_H
#undef SWRITE_HK
#undef SWRITE_HV
#undef SWRITE_H
#undef ATT_IDX
#undef KSWZ
#undef SBAR

__device__ __forceinline__ BlockRef make_ref(int L, int pass, const bf16_t* Qb, const bf16_t* KNVb, const bf16_t* KRb, bf16_t* Ob) {
    const int bh = L >> 2, x = L & 3, qb = pass ? 7 - x : x, b = bh >> 3, h = bh & 7; const size_t rb = (size_t)b * SEQ;
    BlockRef r; r.Q = Qb + (rb + (size_t)qb * QB) * QS + h * DQH; r.Kn = KNVb + rb * KNS + h * (DNOPE + DVH); r.Kr = KRb + rb * KRS; r.V = KNVb + rb * KNS + h * (DNOPE + DVH) + DNOPE;
    r.O = Ob + (rb + (size_t)qb * QB) * OS + h * DVH; r.P0 = qb * QB; return r;
}
__device__ __forceinline__ void attn_phase(char* lds, const bf16_t* Qb, const bf16_t* KNVb, const bf16_t* KRb, bf16_t* Ob, int first, int stride) {
    constexpr int total = NBATCH * NHEAD * 4;
    for (int L = first; L < total; L += stride) {
        for (int pass = 0; pass < 2; ++pass) { const BlockRef cur = make_ref(L, pass, Qb, KNVb, KRb, Ob); attn_block(cur, lds); }
    }
}
}
constexpr int NWAVES = 8;
constexpr size_t MiB = 1u << 20;
constexpr size_t WS_CTL = 0, CTL_ZERO_BYTES = 6 * MiB;
constexpr size_t WS_SSQ = 1 * MiB;
constexpr size_t WS_COS = 6 * MiB, WS_SIN = 14 * MiB;
constexpr size_t WS_LIST = 22 * MiB;
constexpr size_t WS_RSL = 24 * MiB;
constexpr size_t WS_TOKINFO = 26 * MiB;
constexpr size_t WS_WDN = 28 * MiB, WS_WUQ = 32 * MiB, WS_WUKV = 35 * MiB, WS_WO = 37 * MiB, WS_WPOOL = 41 * MiB, WS_WGU = 42 * MiB, WS_WD = 63 * MiB, WS_MWGU = 74 * MiB, WS_MWD = 162 * MiB;
constexpr size_t WS_H = 206 * MiB;
constexpr size_t WS_ACT = 334 * MiB;
constexpr size_t WS_DOWN = WS_ACT;
constexpr size_t WS_CQN = WS_ACT + 128 * MiB, WS_CKVN = WS_ACT + 192 * MiB, WS_KR = WS_ACT + 224 * MiB, WS_Q = WS_ACT + 232 * MiB, WS_KNV = WS_ACT + 424 * MiB;
constexpr size_t WS_HID = WS_ACT;
constexpr size_t WS_YB = WS_ACT + 358 * MiB;
constexpr size_t WS_DUMMY = WS_ACT + 424 * MiB;
constexpr size_t WS_END = WS_ACT + 680 * MiB;
static_assert(WS_MWD + (size_t)16 * 1024 * FFEP * 2 <= WS_H && WS_MWGU + (size_t)16 * 2 * FFEP * 1024 * 2 <= WS_MWD && WS_WD + (size_t)2 * 1024 * FFD * 2 <= WS_MWGU && WS_WGU + (size_t)2 * 2 * FFD * 1024 * 2 <= WS_WD, "weights map");
static_assert(WS_HID + (size_t)PSLOT * FFEP * 2 <= WS_YB && WS_YB + (size_t)PSLOT * 1024 * 2 <= WS_END && WS_HID + (size_t)NTOK * FFD * 2 <= WS_END && WS_KNV + (size_t)NTOK * NKV * 2 <= WS_END && WS_Q + (size_t)NTOK * NQ * 2 <= WS_KNV, "activation map");
static_assert(WS_SSQ + (size_t)10 * NTOK * 8 <= WS_COS && WS_COS <= CTL_ZERO_BYTES + WS_COS && WS_END <= 1024 * MiB, "map");
constexpr int CW_TMO = 0, CW_CODE = 1, CW_CNT = 1024  , CW_DBG = 2048, CW_BAR = 4096  ;
constexpr int RING_OFF = 0, RING_BYTES = 131072, LDSCTL_OFF = RING_BYTES, MISC_OFF = LDSCTL_OFF + 320, LDS_BYTES = 147456;

typedef GAS unsigned gu32;
#define RLX_AGENT __ATOMIC_RELAXED, __HIP_MEMORY_SCOPE_AGENT
#define LDS_WAIT() asm volatile("s_waitcnt lgkmcnt(0)" ::: "memory")
#define VM_WAIT() asm volatile("s_waitcnt vmcnt(0)" ::: "memory")

#define XB_TMO      128
#define XB_XCNT(j)  (256  + 64 * (j))
#define XB_XSUB(j)  (1280 + 64 * (j))
#define XB_XGEN(j)  (2304 + 64 * (j))
#define XB_TOP      3328
#define XB_TOPGEN   3392
#define XCD_BAR_WORDS 3456
#define XB_SPIN_CAP (1u << 18)
__device__ __forceinline__ unsigned xb_ld(unsigned* p)              { return __hip_atomic_load(p, __ATOMIC_RELAXED, __HIP_MEMORY_SCOPE_AGENT); }
__device__ __forceinline__ unsigned xb_add(unsigned* p, unsigned v) { return __hip_atomic_fetch_add(p, v, __ATOMIC_RELAXED, __HIP_MEMORY_SCOPE_AGENT); }
__device__ __forceinline__ unsigned xb_xcc_id() { return (unsigned)__builtin_amdgcn_s_getreg((3 << 11) | 20) & 0xFu; }
#define XB_SPIN(cond, bar) do { unsigned _sp = 0; while (cond) { __builtin_amdgcn_s_sleep(1); \
    if ((++_sp & 255u) == 0u) { if (xb_ld(&(bar)[XB_TMO])) break; if (_sp > XB_SPIN_CAP) { atomicAdd(&(bar)[XB_TMO], 1u); break; } } } } while (0)
struct XcdBarrier { unsigned* bar; unsigned x; volatile LAS unsigned* st; };
__device__ __forceinline__ XcdBarrier xcd_barrier_post(unsigned* bar, volatile LAS unsigned* st) {
    XcdBarrier b; b.bar = bar; b.x = xb_xcc_id(); b.st = st;
    if (threadIdx.x == 0) (void)xb_add(&bar[XB_XCNT(b.x)], 1u);
    return b;
}
__device__ __forceinline__ void xcd_barrier_complete(unsigned* bar, unsigned x, unsigned& nloc, unsigned& nx) {
    const unsigned G = gridDim.x * gridDim.y * gridDim.z;
    unsigned sum, cnt, mine, sp = 0u;
    for (;;) {
        sum = 0u; cnt = 0u; mine = 0u;
#pragma unroll
        for (unsigned j = 0; j < 16; ++j) { const unsigned c = xb_ld(&bar[XB_XCNT(j)]); sum += c; cnt += (c > 0u) ? 1u : 0u; mine = (j == x) ? c : mine; }
        if (sum == G) break;
        __builtin_amdgcn_s_sleep(1);
        if ((++sp & 255u) == 0u) { if (xb_ld(&bar[XB_TMO])) break; if (sp > XB_SPIN_CAP) { atomicAdd(&bar[XB_TMO], 1u); break; } }
    }
    nloc = mine > 0u ? mine : 1u; nx = cnt > 0u ? cnt : 1u;
}
__device__ __forceinline__ void xcd_barrier(const XcdBarrier& b) {
    asm volatile("s_waitcnt vmcnt(0)" ::: "memory");
    __syncthreads();
    if (threadIdx.x == 0) {
        unsigned* bar = b.bar;
        __builtin_amdgcn_s_waitcnt(0);
        unsigned nloc = b.st[0], nx = b.st[1];
        if (nloc == 0u) { xcd_barrier_complete(bar, b.x, nloc, nx); b.st[0] = nloc; b.st[1] = nx; }
        const unsigned old = xb_add(&bar[XB_XSUB(b.x)], 1u);
        const unsigned gen = old / nloc;
        if (old + 1u == (gen + 1u) * nloc) {
            __builtin_amdgcn_fence(__ATOMIC_RELEASE, "agent");
            asm volatile("s_waitcnt vmcnt(0)" ::: "memory");
            const unsigned og = xb_add(&bar[XB_TOP], 1u);
            const unsigned tg = og / nx;
            if (og + 1u == (tg + 1u) * nx) xb_add(&bar[XB_TOPGEN], 1u);
            else XB_SPIN(xb_ld(&bar[XB_TOPGEN]) == tg, bar);
            __builtin_amdgcn_fence(__ATOMIC_ACQUIRE, "agent");
            xb_add(&bar[XB_XGEN(b.x)], 1u);
            asm volatile("s_waitcnt vmcnt(0)" ::: "memory");
        } else {
            XB_SPIN(xb_ld(&bar[XB_XGEN(b.x)]) == gen, bar);
            __builtin_amdgcn_fence(__ATOMIC_ACQUIRE, "agent");
            asm volatile("s_waitcnt vmcnt(0)" ::: "memory");
        }
    }
    __syncthreads();
}

constexpr int PT_OFF_ = LDSCTL_OFF + 512;
__device__ __forceinline__ unsigned rfl(unsigned v);
__device__ __forceinline__ const float* ptab(LAS unsigned char* L, int i);
struct Frame { LAS unsigned char* lds; volatile LAS unsigned* MISC; gu32* ctl; unsigned char* ws; int tid, lane, wave, vcu, G; };

__device__ __forceinline__ float wave_sum(float v) {
#pragma unroll
    for (int o = 1; o < 64; o <<= 1) v += __shfl_xor(v, o);
    return v;
}
__device__ __forceinline__ unsigned rfl(unsigned v) { return (unsigned)__builtin_amdgcn_readfirstlane((int)v); }

__device__ __forceinline__ int rowmap(int mode, int n) {
    if (mode == 0) return n;
    if (mode == 1) return (n >> 7) * 256 + (n & 127);
    if (mode == 2) return (n >> 7) * 256 + 128 + (n & 127);
    const int h = n / DQH, d = n - h * DQH;
    if (d < DNOPE) return 512 + h * DNOPE + d;
    if (d < DNOPE + 32) return (h >> 2) * 256 + (h & 3) * 32 + (d - DNOPE);
    return (h >> 2) * 256 + 128 + (h & 3) * 32 + (d - DNOPE - 32);
}
__device__ __forceinline__ void transpose_item(const float* W, int N, bf16_t* WT, int ldd, int mode, const float* kscale, const float* nscale, int item, int lane) {
    const int nblk = N / 64, kb = item / nblk, nb = item % nblk, k0 = 64 * kb, n = 64 * nb + lane;
    const float sn = nscale ? nscale[n] : 1.0f;
    const float* wp = W + (size_t)k0 * N + n;
    bf16_t* op = WT + (size_t)rowmap(mode, n) * ldd + k0;
#pragma unroll
    for (int kg = 0; kg < 8; ++kg) { float v[8];
#pragma unroll
        for (int i = 0; i < 8; ++i) { const float sk = kscale ? kscale[k0 + 8 * kg + i] : 1.0f; v[i] = wp[(size_t)(8 * kg + i) * N] * (sk * sn); }
        u32x4 o; o.x = cvt_pk_bf16(v[0], v[1]); o.y = cvt_pk_bf16(v[2], v[3]); o.z = cvt_pk_bf16(v[4], v[5]); o.w = cvt_pk_bf16(v[6], v[7]);
        *(GAS u32x4*)(op + 8 * kg) = o; }
}
struct MatDesc { const float* src; bf16_t* dst; const float* kscale; const float* nscale; int K, N, ldd, mode; };
constexpr int N_MATS = 70;
__device__ __forceinline__ MatDesc mat_desc(int m, LAS unsigned char* L, unsigned char* ws) {
    MatDesc d; d.kscale = nullptr; d.nscale = nullptr; d.mode = 0;
    if (m < 2)       { const int a = m;      d.src = ptab(L, 4) + (size_t)a * DM * NDOWN;    d.K = DM;   d.N = NDOWN; d.dst = (bf16_t*)(ws + WS_WDN) + (size_t)a * NDOWNP * DM;  d.ldd = DM; d.kscale = ptab(L, 2) + (size_t)(2 * a) * DM; }
    else if (m < 4)  { const int a = m - 2;  d.src = ptab(L, 6) + (size_t)a * QLR * NQ;      d.K = QLR;  d.N = NQ;    d.dst = (bf16_t*)(ws + WS_WUQ) + (size_t)a * NQ * QLR;     d.ldd = QLR; d.mode = 3; }
    else if (m < 6)  { const int a = m - 4;  d.src = ptab(L, 8) + (size_t)a * KVLR * NKV;    d.K = KVLR; d.N = NKV;   d.dst = (bf16_t*)(ws + WS_WUKV) + (size_t)a * NKV * KVLR;  d.ldd = KVLR; }
    else if (m < 8)  { const int a = m - 6;  d.src = ptab(L, 9) + (size_t)a * DM * DM;       d.K = DM;   d.N = DM;    d.dst = (bf16_t*)(ws + WS_WO) + (size_t)a * DM * DM;       d.ldd = DM; }
    else if (m < 16) { const int i = m - 8;  d.src = ptab(L, 10) + (size_t)i * 256 * 256;    d.K = 256;  d.N = 256;   d.dst = (bf16_t*)(ws + WS_WPOOL) + (size_t)i * 256 * 256;  d.ldd = 256; d.nscale = ptab(L, 11) + i * 256; }
    else if (m < 18) { const int a = m - 16; d.src = ptab(L, 12) + (size_t)a * DM * FFD;     d.K = DM;   d.N = FFD;   d.dst = (bf16_t*)(ws + WS_WGU) + (size_t)a * 2 * FFD * DM; d.ldd = DM; d.mode = 1; d.kscale = ptab(L, 3) + (size_t)(2 * a) * DM; }
    else if (m < 20) { const int a = m - 18; d.src = ptab(L, 13) + (size_t)a * DM * FFD;     d.K = DM;   d.N = FFD;   d.dst = (bf16_t*)(ws + WS_WGU) + (size_t)a * 2 * FFD * DM; d.ldd = DM; d.mode = 2; d.kscale = ptab(L, 3) + (size_t)(2 * a) * DM; }
    else if (m < 22) { const int a = m - 20; d.src = ptab(L, 14) + (size_t)a * FFD * DM;     d.K = FFD;  d.N = DM;    d.dst = (bf16_t*)(ws + WS_WD) + (size_t)a * DM * FFD;      d.ldd = FFD; }
    else if (m < 38) { const int i = m - 22; d.src = ptab(L, 16) + (size_t)i * DM * FFE;     d.K = DM;   d.N = FFE;   d.dst = (bf16_t*)(ws + WS_MWGU) + (size_t)i * 2 * FFEP * DM; d.ldd = DM; d.mode = 1; d.kscale = ptab(L, 3) + (size_t)(2 * (i >> 3) + 1) * DM; }
    else if (m < 54) { const int i = m - 38; d.src = ptab(L, 17) + (size_t)i * DM * FFE;     d.K = DM;   d.N = FFE;   d.dst = (bf16_t*)(ws + WS_MWGU) + (size_t)i * 2 * FFEP * DM; d.ldd = DM; d.mode = 2; d.kscale = ptab(L, 3) + (size_t)(2 * (i >> 3) + 1) * DM; }
    else             { const int i = m - 54; d.src = ptab(L, 18) + (size_t)i * FFE * DM;     d.K = FFE;  d.N = DM;    d.dst = (bf16_t*)(ws + WS_MWD) + (size_t)i * DM * FFEP;    d.ldd = FFEP; }
    return d;
}
__device__ __forceinline__ void p0_prologue(Frame& F) {
    const int* positions = (const int*)ptab(F.lds, 1);
    const int gw = F.vcu * NWAVES + F.wave, NGW = F.G * NWAVES;
    int cum = 0;
    for (int m = 0; m < N_MATS; ++m) {
        const MatDesc d = mat_desc(m, F.lds, F.ws);
        const int nitems = (d.K / 64) * (d.N / 64);
        int first = gw - (cum % NGW); if (first < 0) first += NGW;
        for (int it = first; it < nitems; it += NGW) transpose_item(d.src, d.N, d.dst, d.ldd, d.mode, d.kscale, d.nscale, it, F.lane);
        cum += nitems;
    }
    const int gt = gw * 64 + F.lane, NGT = NGW * 64; const u32x4 z4 = (u32x4){0u, 0u, 0u, 0u};
    for (int i = gt; i < 2 * 192 * 128; i += NGT) { const int a = i / (192 * 128), r = i % (192 * 128); *(GAS u32x4*)((bf16_t*)(F.ws + WS_WDN) + (size_t)a * NDOWNP * DM + (size_t)NDOWN * DM + (size_t)r * 8) = z4; }
    for (int i = gt; i < 16 * 128 * 128; i += NGT) { const int e = i / (128 * 128), r = (i / 128) % 128, c = i % 128; const int row = 2560 + (r < 64 ? 64 + r : 192 + (r - 64));
        *(GAS u32x4*)((bf16_t*)(F.ws + WS_MWGU) + (size_t)e * 2 * FFEP * DM + (size_t)row * DM + c * 8) = z4; }
    for (int i = gt; i < 16 * 1024 * 8; i += NGT) { const int row = i / 8, c = i % 8; *(GAS u32x4*)((bf16_t*)(F.ws + WS_MWD) + (size_t)row * FFEP + FFE + c * 8) = z4; }
    float* cosT = (float*)(F.ws + WS_COS); float* sinT = (float*)(F.ws + WS_SIN);
    for (int i = gt; i < NTOK * 32; i += NGT) { const int row = i >> 5, k = i & 31; const float inv = powf(10000.0f, -(float)(2 * k) / 64.0f); const float ang = (float)positions[row] * inv;
        cosT[i] = cosf(ang); sinT[i] = sinf(ang); }
    const float* x = ptab(F.lds, 0); bf16_t* H = (bf16_t*)(F.ws + WS_H); ssq_t* ssq0 = (ssq_t*)(F.ws + WS_SSQ);
    for (int m = gw; m < NTOK; m += NGW) {
        const GAS f32x4* xr = (const GAS f32x4*)(x + (size_t)m * DM) + F.lane; GAS u32x2* o8 = (GAS u32x2*)(H + (size_t)m * DM) + F.lane; float s = 0.f;
#pragma unroll
        for (int j = 0; j < 4; ++j) { const f32x4 v = xr[64 * j]; s += (v.x * v.x + v.y * v.y) + (v.z * v.z + v.w * v.w); u32x2 w; w.x = cvt_pk_bf16(v.x, v.y); w.y = cvt_pk_bf16(v.z, v.w); o8[64 * j] = w; }
        s = wave_sum(s); if (F.lane == 0) ssq0[m] = ssq_fix(s);
    }
}

template <bool FINAL>
__device__ __forceinline__ void combine_phase(Frame& F, bf16_t* H, const bf16_t* YB, const unsigned* tokinfo, const unsigned* cntw, ssq_t* ssq_next, const float* gain, float* outF) {
    const int gw = F.vcu * NWAVES + F.wave, NGW = F.G * NWAVES;
    f32x4 g[4];
    if constexpr (FINAL) {
#pragma unroll
        for (int j = 0; j < 4; ++j) g[j] = *(const f32x4*)(gain + F.lane * 4 + 256 * j);
    }
    unsigned nb[8];
#pragma unroll
    for (int e = 0; e < 8; ++e) nb[e] = (rfl(__hip_atomic_load((unsigned*)cntw + 64 * e, RLX_AGENT)) + 255u) >> 8;
    for (int m = gw; m < NTOK; m += NGW) {
        GAS u32x2* hr = (GAS u32x2*)(H + (size_t)m * DM) + F.lane;
        const u32x4 t0 = *(const u32x4*)(tokinfo + (size_t)m * 8), t1 = *(const u32x4*)(tokinfo + (size_t)m * 8 + 4);
        const unsigned e0 = rfl(t0.x), r0 = rfl(t0.y), e1 = rfl(t1.x), r1 = rfl(t1.y); const float g0 = __uint_as_float(rfl(t0.z)), g1 = __uint_as_float(rfl(t1.z));
        unsigned b0 = 0u, b1 = 0u;
#pragma unroll
        for (int e = 0; e < 8; ++e) { b0 += ((unsigned)e < e0) ? nb[e] : 0u; b1 += ((unsigned)e < e1) ? nb[e] : 0u; }
        const GAS u32x2* y0 = (const GAS u32x2*)(YB + ((size_t)b0 * 256 + r0) * DM) + F.lane; const GAS u32x2* y1 = (const GAS u32x2*)(YB + ((size_t)b1 * 256 + r1) * DM) + F.lane;
        f32x4 v[4]; float s = 0.f;
#pragma unroll
        for (int j = 0; j < 4; ++j) { const u32x2 hh = hr[64 * j], a = y0[64 * j], b = y1[64 * j];
            v[j].x = bflo(hh.x) + g0 * bflo(a.x) + g1 * bflo(b.x); v[j].y = bfhi(hh.x) + g0 * bfhi(a.x) + g1 * bfhi(b.x); v[j].z = bflo(hh.y) + g0 * bflo(a.y) + g1 * bflo(b.y); v[j].w = bfhi(hh.y) + g0 * bfhi(a.y) + g1 * bfhi(b.y);
            s += (v[j].x * v[j].x + v[j].y * v[j].y) + (v[j].z * v[j].z + v[j].w * v[j].w); }
        s = wave_sum(s);
        if constexpr (FINAL) { const float rstd = rstd_f(s); GAS f32x4* ho = (GAS f32x4*)(outF + (size_t)m * DM) + F.lane;
#pragma unroll
            for (int j = 0; j < 4; ++j) ho[64 * j] = v[j] * rstd * g[j];
        } else {
#pragma unroll
            for (int j = 0; j < 4; ++j) { u32x2 w; w.x = cvt_pk_bf16(v[j].x, v[j].y); w.y = cvt_pk_bf16(v[j].z, v[j].w); hr[64 * j] = w; }
            if (F.lane == 0) ssq_next[m] = ssq_fix(s); }
    }
}
__device__ __forceinline__ void mid_phase(Frame& F, const bf16_t* DOWN, const float* qn, const float* kvn, const float* cosT, const float* sinT, bf16_t* CQN, bf16_t* CKVN, bf16_t* KR) {
    const int gw = F.vcu * NWAVES + F.wave, NGW = F.G * NWAVES, lane = F.lane;
    const f32x4 q0 = *(const f32x4*)(qn + lane * 8), q1 = *(const f32x4*)(qn + lane * 8 + 4), k0 = *(const f32x4*)(kvn + lane * 4);
    for (int m = gw; m < NTOK; m += NGW) {
        const bf16_t* dr = DOWN + (size_t)m * NDOWNP;
        const u32x4 cq = *(const GAS u32x4*)(dr + lane * 8); const u32x2 ck = *(const GAS u32x2*)(dr + QLR + lane * 4);
        const float x1 = bf2f(dr[QLR + KVLR + (lane & 31)]), x2 = bf2f(dr[QLR + KVLR + 32 + (lane & 31)]);
        const f32x4 a0 = (f32x4){bflo(cq.x), bfhi(cq.x), bflo(cq.y), bfhi(cq.y)}, a1 = (f32x4){bflo(cq.z), bfhi(cq.z), bflo(cq.w), bfhi(cq.w)}, c0 = (f32x4){bflo(ck.x), bfhi(ck.x), bflo(ck.y), bfhi(ck.y)};
        const float sq = wave_sum((a0.x * a0.x + a0.y * a0.y) + (a0.z * a0.z + a0.w * a0.w) + (a1.x * a1.x + a1.y * a1.y) + (a1.z * a1.z + a1.w * a1.w));
        const float sk = wave_sum((c0.x * c0.x + c0.y * c0.y) + (c0.z * c0.z + c0.w * c0.w));
        const float rq = 1.0f / sqrtf(sq * (1.0f / QLR) + RMS_EPS), rk = 1.0f / sqrtf(sk * (1.0f / KVLR) + RMS_EPS);
        const f32x4 y0 = a0 * rq * q0, y1 = a1 * rq * q1, z0 = c0 * rk * k0;
        u32x4 w; w.x = cvt_pk_bf16(y0.x, y0.y); w.y = cvt_pk_bf16(y0.z, y0.w); w.z = cvt_pk_bf16(y1.x, y1.y); w.w = cvt_pk_bf16(y1.z, y1.w);
        *(GAS u32x4*)(CQN + (size_t)m * QLR + lane * 8) = w;
        u32x2 w2; w2.x = cvt_pk_bf16(z0.x, z0.y); w2.y = cvt_pk_bf16(z0.z, z0.w);
        *(GAS u32x2*)(CKVN + (size_t)m * KVLR + lane * 4) = w2;
        const float c = cosT[(size_t)m * 32 + (lane & 31)], s = sinT[(size_t)m * 32 + (lane & 31)];
        const float o = lane < 32 ? x1 * c - x2 * s : x2 * c + x1 * s;
        KR[(size_t)m * DROPE + lane] = (bf16_t)(cvt_pk_bf16(o, o) & 0xffffu);
    }
}
template <int W>
__device__ __forceinline__ void pool_walk(const bf16_t* h, const ssq_t* ssq, const f32x2 g2, bf16_t* Z, size_t rowbase, int t_start, int c0, int nrows, int col) {
    f32x2 ring[W]; f32x2 sum = (f32x2){0.f, 0.f};
#pragma unroll
    for (int j = 0; j < W; ++j) ring[j] = (f32x2){0.f, 0.f};
    for (int r = 0; r < nrows; r += 16) {
#pragma unroll
        for (int j = 0; j < 16; ++j) {
            const int t = t_start + r + j; const size_t row = rowbase + t;
            const unsigned xw = *(const GAS unsigned*)(h + row * DM + col);
            const f32x2 v = (f32x2){bflo(xw), bfhi(xw)} * rstd_of(ssq[row]) * g2;
            sum = sum + (v - ring[j % W]); ring[j % W] = v;
            if (t >= c0) { const float inv = 1.0f / (float)(t + 1 < W ? t + 1 : W); const f32x2 z = sum * inv - v; *(GAS unsigned*)(Z + row * DM + col) = cvt_pk_bf16(z.x, z.y); }
        }
    }
}
__device__ __forceinline__ void pool_phase(Frame& F, const bf16_t* h, const ssq_t* ssq, const float* gain, bf16_t* Z) {
    const int col = F.tid * 2; const f32x2 g2 = *(const f32x2*)(gain + col);
    for (int chunk = F.vcu; chunk < NBATCH * 16; chunk += F.G) {
        const int b = chunk >> 4, c0 = (chunk & 15) * 128, t_start = c0 ? c0 - 16 : 0, nrows = c0 + 128 - t_start; const size_t rowbase = (size_t)b * SEQ;
        const int grp = F.wave >> 1;
        if (grp == 0) pool_walk<2>(h, ssq, g2, Z, rowbase, t_start, c0, nrows, col);
        else if (grp == 1) pool_walk<4>(h, ssq, g2, Z, rowbase, t_start, c0, nrows, col);
        else if (grp == 2) pool_walk<8>(h, ssq, g2, Z, rowbase, t_start, c0, nrows, col);
        else pool_walk<16>(h, ssq, g2, Z, rowbase, t_start, c0, nrows, col);
    }
}
__device__ __forceinline__ void router_phase(Frame& F, const bf16_t* h, const ssq_t* ssq, const float* gain, const float* router, int* list, float* rsl, unsigned* tokinfo, unsigned* cntw) {
    LAS float* rt = (LAS float*)(F.lds + RING_OFF);
    LAS int* esel = (LAS int*)(F.lds + RING_OFF + 32768);
    LAS int* wt = (LAS int*)(F.lds + RING_OFF + 32768 + 2048);
    LAS int* base = (LAS int*)(F.lds + RING_OFF + 32768 + 2048 + 256);
    LAS float* rsd = (LAS float*)(F.lds + RING_OFF + 32768 + 2048 + 512);
    const int lane = F.lane;
    for (int idx = F.tid; idx < DM * NEXP; idx += NWAVES * 64) rt[(idx & 7) * DM + (idx >> 3)] = router[idx];
    f32x4 g[4];
#pragma unroll
    for (int j = 0; j < 4; ++j) g[j] = *(const f32x4*)(gain + lane * 4 + 256 * j);
    for (int chunk = F.vcu; chunk < NTOK / 256; chunk += F.G) {
        const int T0 = chunk * 256;
        __syncthreads();
        for (int i = 0; i < 32; ++i) {
            const int tl = F.wave * 32 + i, m = T0 + tl;
            const GAS u32x2* xr = (const GAS u32x2*)(h + (size_t)m * DM) + lane;
            const float rstd = rstd_of(ssq[m]);
            f32x4 v[4];
#pragma unroll
            for (int j = 0; j < 4; ++j) { const u32x2 w = xr[64 * j]; v[j] = (f32x4){bflo(w.x), bfhi(w.x), bflo(w.y), bfhi(w.y)} * rstd * g[j]; }
            float lg[8];
#pragma unroll
            for (int e = 0; e < 8; ++e) { float p = 0.f;
#pragma unroll
                for (int j = 0; j < 4; ++j) { const f32x4 r4 = *(const LAS f32x4*)(rt + e * DM + lane * 4 + 256 * j); p += (v[j].x * r4.x + v[j].y * r4.y) + (v[j].z * r4.z + v[j].w * r4.w); }
                lg[e] = wave_sum(p); }
            int e0 = 0; float l0 = lg[0];
#pragma unroll
            for (int e = 1; e < 8; ++e) if (lg[e] > l0) { l0 = lg[e]; e0 = e; }
            int e1 = e0 == 0 ? 1 : 0; float l1 = lg[e0 == 0 ? 1 : 0];
#pragma unroll
            for (int e = 0; e < 8; ++e) if (e != e0 && lg[e] > l1) { l1 = lg[e]; e1 = e; }
            const float g0 = 1.0f / (1.0f + __expf(l1 - l0)), g1 = 1.0f - g0;
            if (lane == 0) { esel[2 * tl] = e0; esel[2 * tl + 1] = e1; rsd[tl] = rstd; unsigned* ti = tokinfo + (size_t)m * 8;
                ti[0] = (unsigned)e0; ti[2] = __float_as_uint(g0); ti[4] = (unsigned)e1; ti[6] = __float_as_uint(g1); }
        }
        __syncthreads();
        const int me = esel[F.tid]; int myrank = 0;
#pragma unroll
        for (int e = 0; e < 8; ++e) { const unsigned long long mask = __ballot(me == e); if (me == e) myrank = __popcll(mask & ((1ull << lane) - 1ull)); if (lane == 0) wt[F.wave * 8 + e] = __popcll(mask); }
        __syncthreads();
        int off = 0;
        for (int w = 0; w < F.wave; ++w) off += wt[w * 8 + me];
        if (F.tid < 8) { int tot = 0; for (int w = 0; w < 8; ++w) tot += wt[w * 8 + F.tid]; base[F.tid] = (int)__hip_atomic_fetch_add(cntw + 64 * F.tid, (unsigned)tot, RLX_AGENT); }
        __syncthreads();
        const int rank = base[me] + off + myrank, tok = T0 + (F.tid >> 1);
        list[(size_t)me * NTOK + rank] = tok; rsl[(size_t)me * NTOK + rank] = rsd[F.tid >> 1];
        tokinfo[(size_t)tok * 8 + (F.tid & 1) * 4 + 1] = (unsigned)rank;
    }
}
template <bool GATHER>
struct MoeOrder {
    static constexpr size_t A_BLK = GATHER ? 0 : (size_t)256 * FFEP * 2, B_EXP = GATHER ? (size_t)2 * FFEP * DM * 2 : (size_t)DM * FFEP * 2, B_TILE = GATHER ? (size_t)256 * DM * 2 : (size_t)256 * FFEP * 2;
    static constexpr int NT = GATHER ? 2 * FFEP / 256 : DM / 256;
    const char* A; const char* B; const int* list; const unsigned* cntw; int G, c; unsigned bs[9];
    __device__ __forceinline__ void init(const unsigned* cntw_, const void* A_, const void* B_, const int* list_, int G_, int c_) {
        A = (const char*)A_; B = (const char*)B_; list = list_; cntw = cntw_; G = G_; c = c_; bs[0] = 0u;
#pragma unroll
        for (int e = 0; e < 8; ++e) { const unsigned ce = rfl(__hip_atomic_load((unsigned*)cntw + 64 * e, RLX_AGENT)); bs[e + 1] = bs[e] + ((ce + 255u) >> 8); }
    }
    __device__ __forceinline__ bool next(int i, pg8::Unit& u) const {
        const long L = (long)i * G + c; if (L >= (long)bs[8] * NT) return false;
        const unsigned blk = (unsigned)(L / NT); const int pn = (int)(L % NT);
        unsigned e = 0u, st = 0u;
#pragma unroll
        for (int k = 1; k < 8; ++k) if (blk >= bs[k]) { e = (unsigned)k; st = bs[k]; }
        const unsigned j = blk - st;
        u.b = B + (size_t)e * B_EXP + (size_t)pn * B_TILE; u.orow = (int)(blk * 256u); u.pn = pn; u.aux = (int)e;
        if constexpr (GATHER) { const unsigned ce = rfl(__hip_atomic_load((unsigned*)cntw + 64 * e, RLX_AGENT));
            u.a = A; u.rows = list + (size_t)e * NTOK + (size_t)j * 256; const unsigned rem = ce - j * 256u; u.nrows = rem < 256u ? (int)rem : 256; }
        else { u.a = A + (size_t)blk * A_BLK; u.rows = nullptr; u.nrows = 256; }
        return true;
    }
};
constexpr int NPHASE = 29;
struct Args { const float* in[20]; float* out; unsigned char* ws; int ph_lo, ph_hi, li, pad; };
#ifndef MK_REP_MASK
#define MK_REP_MASK 0
#endif
#ifndef MK_REP_N
#define MK_REP_N 1
#endif
constexpr int PT_OFF = LDSCTL_OFF + 512;
__device__ __forceinline__ unsigned long long ptab_u64(LAS unsigned char* L, int i) {
    const volatile LAS unsigned* p = (const volatile LAS unsigned*)(L + PT_OFF + 8 * i); const unsigned lo = rfl(p[0]), hi = rfl(p[1]); return ((unsigned long long)hi << 32) | lo; }
__device__ __forceinline__ const float* ptab(LAS unsigned char* L, int i) { return (const float*)ptab_u64(L, i); }
__device__ __forceinline__ Frame make_frame(LAS unsigned char* L) {
    Frame F; F.lds = L; F.MISC = (volatile LAS unsigned*)(L + MISC_OFF); F.tid = launder_v((int)threadIdx.x); F.lane = F.tid & 63; F.wave = __builtin_amdgcn_readfirstlane(F.tid >> 6);
    F.G = gridDim.x; { const int bx = blockIdx.x; F.vcu = (F.G % 8 == 0) ? (bx % 8) * (F.G / 8) + bx / 8 : bx; }
    F.ws = (unsigned char*)ptab_u64(L, 21); F.ctl = (gu32*)(F.ws + WS_CTL); return F;
}
__global__ void __launch_bounds__(NWAVES * 64, 2) fwd(Args args) {
    extern __shared__ __attribute__((aligned(16))) unsigned char lds[];
    LAS unsigned char* L = (LAS unsigned char*)lds;
    { const int tid = threadIdx.x;
      for (int u = tid; u < (LDS_BYTES - LDSCTL_OFF) / 4; u += NWAVES * 64) ((LAS unsigned*)(L + LDSCTL_OFF))[u] = 0u;
      __syncthreads();
      if (tid < 20) *(LAS unsigned long long*)(L + PT_OFF + 8 * tid) = (unsigned long long)args.in[tid];
      if (tid == 20) *(LAS unsigned long long*)(L + PT_OFF + 8 * 20) = (unsigned long long)args.out;
      if (tid == 21) *(LAS unsigned long long*)(L + PT_OFF + 8 * 21) = (unsigned long long)args.ws;
      __syncthreads(); }
    const int lo = args.ph_lo, hi = args.ph_hi;
    XcdBarrier bar; { gu32* ctl = (gu32*)(args.ws + WS_CTL); bar.bar = (unsigned*)(ctl + CW_BAR) + args.li * XCD_BAR_WORDS; bar.x = 0; bar.st = nullptr;
      if (hi - lo > 1 || MK_REP_MASK) bar = xcd_barrier_post((unsigned*)(ctl + CW_BAR) + args.li * XCD_BAR_WORDS, (volatile LAS unsigned*)(L + MISC_OFF) + 8); }
#ifndef MK_ONLY
#define MK_ONLY (-1)
#endif
#define KIND(k) ((k) == 0 ? 0 : 1 + ((k) - 1) % 14)
#define IN(k) ((MK_ONLY < 0 || KIND(k) == MK_ONLY) && lo <= (k) && (k) < hi)
#define REPS(k) (((MK_REP_MASK >> KIND(k)) & 1) ? MK_REP_N : 1)
#define FORREP(k) for (int rep = 0, nrep = REPS(k); rep < nrep; ++rep)
#define LASTREP (rep + 1 == nrep)
#define SEAM(k) do { if ((k) + 1 < hi || !LASTREP) xcd_barrier(bar); } while (0)
#define WSP(off) ((bf16_t*)(F.ws + (off)))
#define SSQ(i) ((ssq_t*)(F.ws + WS_SSQ) + (size_t)(i) * NTOK)
    LAS unsigned char* ring = L + RING_OFF;

    if (IN(0)) FORREP(0) { Frame F = make_frame(L); p0_prologue(F); SEAM(0); }

    for (int lp = 0; lp < 2; ++lp) {
        const int pb = 1 + 14 * lp;
        if (IN(pb + 0)) FORREP(pb + 0) { Frame F = make_frame(L);
            pg8::RegOrder S; S.init(WSP(WS_H), DM * 2, WSP(WS_WDN) + (size_t)lp * NDOWNP * DM, DM * 2, NTOK, NDOWNP, F.G, (int)blockIdx.x);
            pg8::EpiBf16<1> E{WSP(WS_DOWN), NDOWNP, SSQ(4 * lp + 0)};
            pg8::gemm_phase<pg8::EpiBf16<1>, pg8::RegOrder, false>(ring, DM * 2, DM * 2, DM, S, E);
            SEAM(pb + 0);
        }
        if (IN(pb + 1)) FORREP(pb + 1) { Frame F = make_frame(L);
            mid_phase(F, WSP(WS_DOWN), ptab(L, 5) + (size_t)lp * QLR, ptab(L, 7) + (size_t)lp * KVLR, (const float*)(F.ws + WS_COS), (const float*)(F.ws + WS_SIN), WSP(WS_CQN), WSP(WS_CKVN), WSP(WS_KR)); SEAM(pb + 1); }
        if (IN(pb + 2)) FORREP(pb + 2) { Frame F = make_frame(L);
            pg8::RegOrder S; S.init(WSP(WS_CQN), QLR * 2, WSP(WS_WUQ) + (size_t)lp * NQ * QLR, QLR * 2, NTOK, NQ, F.G, (int)blockIdx.x);
            pg8::EpiQ E{WSP(WS_Q), (const float*)(F.ws + WS_COS), (const float*)(F.ws + WS_SIN)};
            pg8::gemm_phase<pg8::EpiQ, pg8::RegOrder, false>(ring, QLR * 2, QLR * 2, QLR, S, E);
            SEAM(pb + 2);
        }
        if (IN(pb + 3)) FORREP(pb + 3) { Frame F = make_frame(L);
            pg8::RegOrder S; S.init(WSP(WS_CKVN), KVLR * 2, WSP(WS_WUKV) + (size_t)lp * NKV * KVLR, KVLR * 2, NTOK, NKV, F.G, (int)blockIdx.x);
            pg8::EpiBf16<0> E{WSP(WS_KNV), NKV, nullptr};
            pg8::gemm_phase<pg8::EpiBf16<0>, pg8::RegOrder, false>(ring, KVLR * 2, KVLR * 2, KVLR, S, E);
            SEAM(pb + 3);
        }
        if (IN(pb + 4)) FORREP(pb + 4) { Frame F = make_frame(L); att::attn_phase((char*)lds + RING_OFF, WSP(WS_Q), WSP(WS_KNV), WSP(WS_KR), WSP(WS_DOWN), F.vcu, F.G); SEAM(pb + 4); }
        if (IN(pb + 5)) FORREP(pb + 5) { Frame F = make_frame(L);
            pg8::RegOrder S; S.init(WSP(WS_DOWN), DM * 2, WSP(WS_WO) + (size_t)lp * DM * DM, DM * 2, NTOK, DM, F.G, (int)blockIdx.x);
            pg8::EpiResidH E{WSP(WS_H), LASTREP ? WSP(WS_H) : WSP(WS_DUMMY), LASTREP ? SSQ(4 * lp + 1) : SSQ(9)};
            pg8::gemm_phase<pg8::EpiResidH, pg8::RegOrder, false>(ring, DM * 2, DM * 2, DM, S, E);
            SEAM(pb + 5);
        }
        if (IN(pb + 6)) FORREP(pb + 6) { Frame F = make_frame(L);
            pg8::RegOrder S; S.init(WSP(WS_H), DM * 2, WSP(WS_WGU) + (size_t)lp * 2 * FFD * DM, DM * 2, NTOK, 2 * FFD, F.G, (int)blockIdx.x);
            pg8::EpiSwiglu<1> E{WSP(WS_HID), FFD, SSQ(4 * lp + 1), nullptr};
            pg8::gemm_phase<pg8::EpiSwiglu<1>, pg8::RegOrder, false>(ring, DM * 2, DM * 2, DM, S, E);
            SEAM(pb + 6);
        }
        if (IN(pb + 7)) FORREP(pb + 7) { Frame F = make_frame(L);
            pg8::RegOrder S; S.init(WSP(WS_HID), FFD * 2, WSP(WS_WD) + (size_t)lp * DM * FFD, FFD * 2, NTOK, DM, F.G, (int)blockIdx.x);
            pg8::EpiResidH E{WSP(WS_H), LASTREP ? WSP(WS_H) : WSP(WS_DUMMY), LASTREP ? SSQ(4 * lp + 2) : SSQ(9)};
            pg8::gemm_phase<pg8::EpiResidH, pg8::RegOrder, false>(ring, FFD * 2, FFD * 2, FFD, S, E);
            SEAM(pb + 7);
        }
        if (IN(pb + 8)) FORREP(pb + 8) { Frame F = make_frame(L); pool_phase(F, WSP(WS_H), SSQ(4 * lp + 2), ptab(L, 2) + (size_t)(2 * lp + 1) * DM, WSP(WS_DOWN)); SEAM(pb + 8); }
        if (IN(pb + 9)) FORREP(pb + 9) { Frame F = make_frame(L);
            pg8::RegOrder S; S.init(WSP(WS_DOWN), DM * 2, WSP(WS_WPOOL) + (size_t)lp * 4 * 256 * 256, 256 * 2, NTOK, DM, F.G, (int)blockIdx.x, 256 * 2);
            pg8::EpiResidH E{WSP(WS_H), LASTREP ? WSP(WS_H) : WSP(WS_DUMMY), LASTREP ? SSQ(4 * lp + 3) : SSQ(9)};
            pg8::gemm_phase<pg8::EpiResidH, pg8::RegOrder, false>(ring, DM * 2, 256 * 2, 256, S, E);
            SEAM(pb + 9);
        }
        if (IN(pb + 10)) FORREP(pb + 10) { Frame F = make_frame(L);
            router_phase(F, WSP(WS_H), SSQ(4 * lp + 3), ptab(L, 3) + (size_t)(2 * lp + 1) * DM, ptab(L, 15) + (size_t)lp * DM * NEXP, (int*)(F.ws + WS_LIST), (float*)(F.ws + WS_RSL), (unsigned*)(F.ws + WS_TOKINFO), (unsigned*)(F.ctl + CW_CNT) + lp * 8 * 64); SEAM(pb + 10); }
        if (IN(pb + 11)) FORREP(pb + 11) { Frame F = make_frame(L);
            MoeOrder<true> S; S.init((unsigned*)(F.ctl + CW_CNT) + lp * 8 * 64, WSP(WS_H), WSP(WS_MWGU) + (size_t)lp * 8 * 2 * FFEP * DM, (const int*)(F.ws + WS_LIST), F.G, (int)blockIdx.x);
            pg8::EpiSwiglu<2> E{WSP(WS_HID), FFEP, (const float*)(F.ws + WS_RSL), (const int*)(F.ws + WS_LIST)};
            pg8::gemm_phase<pg8::EpiSwiglu<2>, MoeOrder<true>, true>(ring, DM * 2, DM * 2, DM, S, E);
            SEAM(pb + 11);
        }
        if (IN(pb + 12)) FORREP(pb + 12) { Frame F = make_frame(L);
            MoeOrder<false> S; S.init((unsigned*)(F.ctl + CW_CNT) + lp * 8 * 64, WSP(WS_HID), WSP(WS_MWD) + (size_t)lp * 8 * DM * FFEP, (const int*)(F.ws + WS_LIST), F.G, (int)blockIdx.x);
            pg8::EpiBf16<0> E{WSP(WS_YB), DM, nullptr};
            pg8::gemm_phase<pg8::EpiBf16<0>, MoeOrder<false>, false>(ring, FFEP * 2, FFEP * 2, FFEP, S, E);
            SEAM(pb + 12);
        }
        if (IN(pb + 13)) FORREP(pb + 13) { Frame F = make_frame(L);
            if (lp == 0) combine_phase<false>(F, WSP(WS_H), WSP(WS_YB), (const unsigned*)(F.ws + WS_TOKINFO), (unsigned*)(F.ctl + CW_CNT), SSQ(4), nullptr, nullptr);
            else combine_phase<true>(F, WSP(WS_H), WSP(WS_YB), (const unsigned*)(F.ws + WS_TOKINFO), (unsigned*)(F.ctl + CW_CNT) + 8 * 64, nullptr, ptab(L, 19), (float*)ptab(L, 20));
            SEAM(pb + 13);
        }
    }
#undef IN
#undef SEAM
#undef WSP
#undef SSQ
}

#ifndef MK_PER_PHASE
#define MK_PER_PHASE 0
#endif
extern "C" void kernel_launch(void* const* d_in, const int* in_sizes, int n_in, void* d_out, int out_size, void* d_ws, size_t ws_size, hipStream_t stream) {
    static int grid = 0;
    if (grid == 0) {
        if (n_in != 20 || in_sizes[0] != NTOK * DM || out_size != NTOK * DM || ws_size < WS_END) { fprintf(stderr, "kernel_launch: unexpected shapes (n_in %d, in0 %d, out %d, ws %zu < %zu)\n", n_in, n_in > 0 ? in_sizes[0] : -1, out_size, ws_size, (size_t)WS_END); grid = -1; return; }
        int dev = 0, cus = 0, per_cu = 0;
        if (hipGetDevice(&dev) != hipSuccess || hipDeviceGetAttribute(&cus, hipDeviceAttributeMultiprocessorCount, dev) != hipSuccess) { grid = -1; return; }
        if (hipFuncSetAttribute((const void*)fwd, hipFuncAttributeMaxDynamicSharedMemorySize, LDS_BYTES) != hipSuccess) { fprintf(stderr, "kernel_launch: hipFuncSetAttribute failed\n"); grid = -1; return; }
        if (hipOccupancyMaxActiveBlocksPerMultiprocessor(&per_cu, (const void*)fwd, NWAVES * 64, LDS_BYTES) != hipSuccess || per_cu < 1) fprintf(stderr, "kernel_launch: occupancy query reports %d\n", per_cu);
        (void)hipGetLastError();
        grid = cus;
    }
    if (grid < 0) return;
    if (hipMemsetAsync((char*)d_ws + WS_CTL, 0, CTL_ZERO_BYTES, stream) != hipSuccess) return;
    Args a{};
    for (int i = 0; i < 20; ++i) a.in[i] = (const float*)d_in[i];
    a.out = (float*)d_out; a.ws = (unsigned char*)d_ws;
#if MK_PER_PHASE
    for (int p = 0; p < NPHASE; ++p) { a.ph_lo = p; a.ph_hi = p + 1; a.li = 0; hipLaunchKernelGGL(fwd, dim3(grid), dim3(NWAVES * 64), LDS_BYTES, stream, a); }
#else
    a.ph_lo = 0; a.ph_hi = NPHASE; a.li = 0;
    hipLaunchKernelGGL(fwd, dim3(grid), dim3(NWAVES * 64), LDS_BYTES, stream, a);
#endif
}
```

```cpp
#include <hip/hip_runtime.h>
#include <cstdio>
#include <cstdint>

#define GAS __attribute__((address_space(1)))
#define LAS __attribute__((address_space(3)))
typedef unsigned short bf16_t;
typedef short bf16x8 __attribute__((ext_vector_type(8)));
typedef short s16x4 __attribute__((ext_vector_type(4)));
typedef float f32x2 __attribute__((ext_vector_type(2)));
typedef float f32x4 __attribute__((ext_vector_type(4)));
typedef float f32x16 __attribute__((ext_vector_type(16)));
typedef unsigned u32x2 __attribute__((ext_vector_type(2)));
typedef unsigned u32x4 __attribute__((ext_vector_type(4)));

constexpr int DM = 1024, NBATCH = 32, SEQ = 2048, NTOK = NBATCH * SEQ;
constexpr int NHEAD = 8, DNOPE = 128, DROPE = 64, DVH = 128, DQH = DNOPE + DROPE, QLR = 512, KVLR = 256;
constexpr int NDOWN = QLR + KVLR + DROPE  , NDOWNP = 1024;
constexpr int NQ = NHEAD * DQH  , NKV = NHEAD * (DNOPE + DVH)  ;
constexpr int FFD = 2688, NEXP = 8, FFE = 1344, FFEP = 1408;
constexpr int PSLOT = (NTOK * 2 / 256 + NEXP) * 256;
constexpr float RMS_EPS = 1e-6f;

__device__ __forceinline__ unsigned cvt_pk_bf16(float lo, float hi) { unsigned r; asm volatile("v_cvt_pk_bf16_f32 %0, %1, %2" : "=v"(r) : "v"(lo), "v"(hi)); return r; }
__device__ __forceinline__ int launder_v(int v) { asm volatile("" : "+v"(v)); return v; }
__device__ __forceinline__ float bf2f(unsigned short b) { return __uint_as_float((unsigned)b << 16); }
__device__ __forceinline__ float bflo(unsigned w) { return __uint_as_float(w << 16); }
__device__ __forceinline__ float bfhi(unsigned w) { return __uint_as_float(w & 0xffff0000u); }

typedef unsigned long long ssq_t;
__device__ __forceinline__ ssq_t ssq_fix(float s) { return (ssq_t)(s * 16777216.0f); }
__device__ __forceinline__ float rstd_n(ssq_t q, float invn) { return 1.0f / sqrtf((float)q * (1.0f / 16777216.0f) * invn + RMS_EPS); }
__device__ __forceinline__ float rstd_of(ssq_t q) { return rstd_n(q, 1.0f / DM); }
__device__ __forceinline__ float rstd_f(float ssq) { return 1.0f / sqrtf(ssq * (1.0f / DM) + RMS_EPS); }

namespace pg8 {
constexpr int BM = 256, BK = 64, HALF = 128, HTB = HALF * BK * 2  , STAGE_BYTES = 8 * HTB, NXCD = 8, WGM = 8;
__host__ __device__ __forceinline__ int lds_byte(int r, int c) { const int st = (r >> 4) * 2 + (c >> 5), rr = r & 15, cc = c & 31, ob = rr * 64 + cc * 2; return st * 1024 + (ob ^ (((ob >> 9) & 1) << 5)); }
__host__ __device__ __forceinline__ void stage_rc(int b, int& R, int& C) { const int st = b / 1024, sb = b % 1024, swz = sb ^ (((sb >> 9) & 1) << 5); R = (st >> 1) * 16 + swz / 64; C = (st & 1) * 32 + (swz % 64) / 2; }
__host__ __device__ __forceinline__ int perm32(int rho) { const int n = rho >> 4, i = rho & 15; return 8 * (i >> 2) + 4 * n + (i & 3); }

struct Unit { const char* a; const char* b; const int* rows; int nrows; int orow; int pn; int aux; };

struct RegOrder {
    const char* A; const char* B; unsigned a_tile, b_tile, a_colstep; int nM, nN, nwg, G, c;
    __device__ __forceinline__ void init(const void* A_, size_t lda_b, const void* B_, size_t ldb_b, int M, int N, int G_, int c_, size_t a_colstep_ = 0) {
        A = (const char*)A_; B = (const char*)B_; a_tile = (unsigned)(256 * lda_b); b_tile = (unsigned)(256 * ldb_b); a_colstep = (unsigned)a_colstep_; nM = M / BM; nN = N / BM; nwg = nM * nN; G = G_; c = c_; }
    __device__ __forceinline__ bool next(int i, Unit& u) const {
        const long L = (long)i * G + c; if (L >= nwg) return false;
        int wgid = (int)L; { const int q = nwg / NXCD, r = nwg % NXCD, xcd = wgid % NXCD, off = wgid / NXCD; wgid = (xcd < r ? xcd * (q + 1) : r * (q + 1) + (xcd - r) * q) + off; }
        const int nig = WGM * nN, gid = wgid / nig, fm = gid * WGM, gsz = (nM - fm) < WGM ? (nM - fm) : WGM;
        const int pm = fm + ((wgid % nig) % gsz), pn = (wgid % nig) / gsz;
        u.a = A + (size_t)pm * a_tile + (size_t)pn * a_colstep; u.b = B + (size_t)pn * b_tile; u.rows = nullptr; u.nrows = 256; u.orow = pm * BM; u.pn = pn; u.aux = 0; return true;
    }
};

template <int RS> struct EpiBf16 {
    static constexpr bool PERM = true;
    bf16_t* O; int ldc; const ssq_t* rs;
    __device__ __forceinline__ void operator()(const f32x4 (&acc)[2][2][4][2], const Unit& u, int wr, int wc, int fr, int fq) const {
        const int row0 = u.orow + wr * 64 + fr, col0 = u.pn * BM + wc * 32 + 8 * fq;
#pragma unroll
        for (int ai = 0; ai < 2; ++ai)
#pragma unroll
            for (int m = 0; m < 4; ++m) { const int row = row0 + ai * HALF + m * 16; bf16_t* rowp = O + (size_t)row * ldc + col0;
                float sc = 1.0f; if constexpr (RS == 1) sc = rstd_of(rs[row]); if constexpr (RS == 2) sc = rstd_n(rs[row], 1.0f / KVLR);
#pragma unroll
                for (int bj = 0; bj < 2; ++bj) { const f32x4 v0 = acc[ai][bj][m][0] * sc, v1 = acc[ai][bj][m][1] * sc;
                    u32x4 w; w.x = cvt_pk_bf16(v0[0], v0[1]); w.y = cvt_pk_bf16(v0[2], v0[3]); w.z = cvt_pk_bf16(v1[0], v1[1]); w.w = cvt_pk_bf16(v1[2], v1[3]);
                    *(u32x4*)(rowp + bj * HALF) = w; } }
    }
};
__device__ __forceinline__ float silu_mul(float g, float u) { return g * u * __builtin_amdgcn_rcpf(1.0f + __builtin_amdgcn_exp2f(-1.4426950408889634f * g)); }
template <int RS> struct EpiSwiglu {
    static constexpr bool PERM = true;
    bf16_t* H; int ldh; const void* rs; const int* list;
    __device__ __forceinline__ void operator()(const f32x4 (&acc)[2][2][4][2], const Unit& u, int wr, int wc, int fr, int fq) const {
        const int r0 = wr * 64 + fr, col0 = u.pn * HALF + wc * 32 + 8 * fq;
        const ssq_t* rsq = (const ssq_t*)rs; const float* rsp = (const float*)rs; if constexpr (RS == 2) rsp = rsp + (u.rows - list);
#pragma unroll
        for (int ai = 0; ai < 2; ++ai)
#pragma unroll
            for (int m = 0; m < 4; ++m) { const int r = r0 + ai * HALF + m * 16; bf16_t* rowp = H + (size_t)(u.orow + r) * ldh + col0;
                float sc; if constexpr (RS == 1) sc = rstd_of(rsq[u.orow + r]); else sc = rsp[r];
                const f32x4 g0 = acc[ai][0][m][0] * sc, g1 = acc[ai][0][m][1] * sc, u0 = acc[ai][1][m][0] * sc, u1 = acc[ai][1][m][1] * sc;
                u32x4 w; w.x = cvt_pk_bf16(silu_mul(g0[0], u0[0]), silu_mul(g0[1], u0[1])); w.y = cvt_pk_bf16(silu_mul(g0[2], u0[2]), silu_mul(g0[3], u0[3]));
                w.z = cvt_pk_bf16(silu_mul(g1[0], u1[0]), silu_mul(g1[1], u1[1])); w.w = cvt_pk_bf16(silu_mul(g1[2], u1[2]), silu_mul(g1[3], u1[3]));
                *(u32x4*)rowp = w; }
    }
};
struct EpiResidH {
    static constexpr bool PERM = true;
    const bf16_t* hin; bf16_t* hout; ssq_t* ssq;
    __device__ __forceinline__ void operator()(const f32x4 (&acc)[2][2][4][2], const Unit& u, int wr, int wc, int fr, int fq) const {
        const int row0 = u.orow + wr * 64 + fr, col0 = u.pn * BM + wc * 32 + 8 * fq;
#pragma unroll
        for (int ai = 0; ai < 2; ++ai)
#pragma unroll
            for (int m = 0; m < 4; ++m) { const int row = row0 + ai * HALF + m * 16; const size_t off = (size_t)row * DM + col0; float part = 0.f;
#pragma unroll
                for (int bj = 0; bj < 2; ++bj) { const u32x4 hv = *(const u32x4*)(hin + off + bj * HALF); const f32x4 a0 = acc[ai][bj][m][0], a1 = acc[ai][bj][m][1];
                    const float y0 = bflo(hv.x) + a0[0], y1 = bfhi(hv.x) + a0[1], y2 = bflo(hv.y) + a0[2], y3 = bfhi(hv.y) + a0[3], y4 = bflo(hv.z) + a1[0], y5 = bfhi(hv.z) + a1[1], y6 = bflo(hv.w) + a1[2], y7 = bfhi(hv.w) + a1[3];
                    part += (y0 * y0 + y1 * y1) + (y2 * y2 + y3 * y3) + (y4 * y4 + y5 * y5) + (y6 * y6 + y7 * y7);
                    u32x4 w; w.x = cvt_pk_bf16(y0, y1); w.y = cvt_pk_bf16(y2, y3); w.z = cvt_pk_bf16(y4, y5); w.w = cvt_pk_bf16(y6, y7);
                    *(u32x4*)(hout + off + bj * HALF) = w; }
                part += __shfl_xor(part, 16); part += __shfl_xor(part, 32);
                if (fq == 0) atomicAdd(ssq + row, ssq_fix(part));
                if (m & 1) asm volatile("" ::: "memory"); }
    }
};
struct EpiDown {
    static constexpr bool PERM = true;
    bf16_t* O; bf16_t* KR; const ssq_t* rs; ssq_t* ssq_q; ssq_t* ssq_kv; const float* cosT; const float* sinT;
    __device__ __forceinline__ void operator()(const f32x4 (&acc)[2][2][4][2], const Unit& u, int wr, int wc, int fr, int fq) const {
        const int row0 = u.orow + wr * 64 + fr;
        if (u.pn < 3) {
            ssq_t* sq = u.pn < 2 ? ssq_q : ssq_kv; const int col0 = u.pn * BM + wc * 32 + 8 * fq;
#pragma unroll
            for (int ai = 0; ai < 2; ++ai)
#pragma unroll
                for (int m = 0; m < 4; ++m) { const int row = row0 + ai * HALF + m * 16; bf16_t* rowp = O + (size_t)row * NDOWNP + col0; const float sc = rstd_of(rs[row]); float part = 0.f;
#pragma unroll
                    for (int bj = 0; bj < 2; ++bj) { const f32x4 v0 = acc[ai][bj][m][0] * sc, v1 = acc[ai][bj][m][1] * sc;
                        part += (v0[0] * v0[0] + v0[1] * v0[1]) + (v0[2] * v0[2] + v0[3] * v0[3]) + (v1[0] * v1[0] + v1[1] * v1[1]) + (v1[2] * v1[2] + v1[3] * v1[3]);
                        u32x4 w; w.x = cvt_pk_bf16(v0[0], v0[1]); w.y = cvt_pk_bf16(v0[2], v0[3]); w.z = cvt_pk_bf16(v1[0], v1[1]); w.w = cvt_pk_bf16(v1[2], v1[3]);
                        *(u32x4*)(rowp + bj * HALF) = w; }
                    part += __shfl_xor(part, 16); part += __shfl_xor(part, 32);
                    if (fq == 0) atomicAdd(sq + row, ssq_fix(part)); }
        } else if (wc == 0) {
#pragma unroll
            for (int ai = 0; ai < 2; ++ai)
#pragma unroll
                for (int m = 0; m < 4; ++m) { const int row = row0 + ai * HALF + m * 16; const float sc = rstd_of(rs[row]);
                    const f32x4 c0 = *(const f32x4*)(cosT + (size_t)row * 32 + 8 * fq), c1 = *(const f32x4*)(cosT + (size_t)row * 32 + 8 * fq + 4);
                    const f32x4 s0 = *(const f32x4*)(sinT + (size_t)row * 32 + 8 * fq), s1 = *(const f32x4*)(sinT + (size_t)row * 32 + 8 * fq + 4);
                    const f32x4 a0 = acc[ai][0][m][0] * sc, a1 = acc[ai][0][m][1] * sc, b0 = acc[ai][1][m][0] * sc, b1 = acc[ai][1][m][1] * sc;
                    const f32x4 x0 = a0 * c0 - b0 * s0, x1 = a1 * c1 - b1 * s1, y0 = b0 * c0 + a0 * s0, y1 = b1 * c1 + a1 * s1;
                    bf16_t* rp = KR + (size_t)row * DROPE + 8 * fq;
                    u32x4 w; w.x = cvt_pk_bf16(x0[0], x0[1]); w.y = cvt_pk_bf16(x0[2], x0[3]); w.z = cvt_pk_bf16(x1[0], x1[1]); w.w = cvt_pk_bf16(x1[2], x1[3]);
                    *(u32x4*)rp = w;
                    w.x = cvt_pk_bf16(y0[0], y0[1]); w.y = cvt_pk_bf16(y0[2], y0[3]); w.z = cvt_pk_bf16(y1[0], y1[1]); w.w = cvt_pk_bf16(y1[2], y1[3]);
                    *(u32x4*)(rp + 32) = w; }
        }
    }
};
struct EpiQ {
    static constexpr bool PERM = true;
    bf16_t* Q; const float* cosT; const float* sinT; const ssq_t* rs;
    __device__ __forceinline__ void operator()(const f32x4 (&acc)[2][2][4][2], const Unit& u, int wr, int wc, int fr, int fq) const {
        const int row0 = u.orow + wr * 64 + fr;
        if (u.pn < 2) {
            const int h = 4 * u.pn + wc;
#pragma unroll
            for (int ai = 0; ai < 2; ++ai)
#pragma unroll
                for (int m = 0; m < 4; ++m) { const int row = row0 + ai * HALF + m * 16;
                    const f32x4 c0 = *(const f32x4*)(cosT + (size_t)row * 32 + 8 * fq), c1 = *(const f32x4*)(cosT + (size_t)row * 32 + 8 * fq + 4);
                    const f32x4 s0 = *(const f32x4*)(sinT + (size_t)row * 32 + 8 * fq), s1 = *(const f32x4*)(sinT + (size_t)row * 32 + 8 * fq + 4);
                    const float sc = rstd_n(rs[row], 1.0f / QLR);
                    const f32x4 a0 = acc[ai][0][m][0] * sc, a1 = acc[ai][0][m][1] * sc, b0 = acc[ai][1][m][0] * sc, b1 = acc[ai][1][m][1] * sc;
                    const f32x4 x0 = a0 * c0 - b0 * s0, x1 = a1 * c1 - b1 * s1, y0 = b0 * c0 + a0 * s0, y1 = b1 * c1 + a1 * s1;
                    bf16_t* rp = Q + (size_t)row * NQ + h * DQH + DNOPE + 8 * fq;
                    u32x4 w; w.x = cvt_pk_bf16(x0[0], x0[1]); w.y = cvt_pk_bf16(x0[2], x0[3]); w.z = cvt_pk_bf16(x1[0], x1[1]); w.w = cvt_pk_bf16(x1[2], x1[3]);
                    *(u32x4*)rp = w;
                    w.x = cvt_pk_bf16(y0[0], y0[1]); w.y = cvt_pk_bf16(y0[2], y0[3]); w.z = cvt_pk_bf16(y1[0], y1[1]); w.w = cvt_pk_bf16(y1[2], y1[3]);
                    *(u32x4*)(rp + 32) = w; }
        } else {
#pragma unroll
            for (int ai = 0; ai < 2; ++ai)
#pragma unroll
                for (int m = 0; m < 4; ++m) { const int row = row0 + ai * HALF + m * 16; const float sc = rstd_n(rs[row], 1.0f / QLR);
#pragma unroll
                    for (int bj = 0; bj < 2; ++bj) { const int h = 2 * (u.pn - 2) + bj; const f32x4 v0 = acc[ai][bj][m][0] * sc, v1 = acc[ai][bj][m][1] * sc;
                        u32x4 w; w.x = cvt_pk_bf16(v0[0], v0[1]); w.y = cvt_pk_bf16(v0[2], v0[3]); w.z = cvt_pk_bf16(v1[0], v1[1]); w.w = cvt_pk_bf16(v1[2], v1[3]);
                        *(u32x4*)(Q + (size_t)row * NQ + h * DQH + wc * 32 + 8 * fq) = w; } }
        }
    }
};

__device__ __forceinline__ unsigned gather_off(const Unit& u, int idx, unsigned lda_b, unsigned cb) { const int tok = idx < u.nrows ? u.rows[idx] : 0; return (unsigned)tok * lda_b + cb; }
__device__ __forceinline__ u32x4 gather_offs(const Unit& u, int tid, unsigned lda_b) {
    const int t2 = launder_v(tid); int R0, C0, R1, C1; stage_rc(t2 * 16, R0, C0); stage_rc(t2 * 16 + 8192, R1, C1);
    u32x4 pk; pk.x = gather_off(u, R0, lda_b, (unsigned)C0 * 2u); pk.y = gather_off(u, R1, lda_b, (unsigned)C1 * 2u); pk.z = gather_off(u, HALF + R0, lda_b, (unsigned)C0 * 2u); pk.w = gather_off(u, HALF + R1, lda_b, (unsigned)C1 * 2u);
    return pk;
}
template <class Epi, class Sched, bool GATHER>
__device__ __forceinline__ void gemm_phase(LAS unsigned char* lds, const unsigned lda_b, const unsigned ldb_b, const int K, const Sched& S, const Epi& E) {
    const int tid = launder_v((int)threadIdx.x), wid = __builtin_amdgcn_readfirstlane(tid >> 6), lane = tid & 63, wr = wid >> 2, wc = wid & 3, fr = lane & 15, fq = lane >> 4;
    const int nt = K / BK;
    unsigned voffA[2], voffB[2];
#pragma unroll
    for (int i = 0; i < 2; ++i) { int R, C; stage_rc(tid * 16 + i * 8192, R, C); const int Rb = Epi::PERM ? ((R & ~31) + perm32(R & 31)) : R;
        voffA[i] = (unsigned)R * lda_b + (unsigned)C * 2u; voffB[i] = (unsigned)Rb * ldb_b + (unsigned)C * 2u; }
    const size_t kstep = (size_t)(BK * 2);
    const size_t hstepA = (size_t)HALF * lda_b, hstepB = (size_t)HALF * ldb_b;
    const unsigned ldsw = (unsigned)wid * 1024u;
    const int aoff = lds_byte(wr * 64 + fr, fq * 8), boff = lds_byte(wc * 32 + fr, fq * 8);
    unsigned cv0[2] = {0u, 0u}, cv1[2] = {0u, 0u}, nv0[2] = {0u, 0u}, nv1[2] = {0u, 0u};
#define PG8_SA(b, h) (((b) * 2 + (h)) * HTB)
#define PG8_SB(b, h) ((4 + (b) * 2 + (h)) * HTB)
#define PG8_LOAD16(gp, ldsoff) __builtin_amdgcn_global_load_lds((const unsigned*)(gp), (LAS unsigned*)(lds + (ldsoff)), 16, 0, 0)
#define PG8_STAGE_B(bufoff, gbase, h) do { _Pragma("unroll") for (int _i = 0; _i < 2; ++_i) PG8_LOAD16((gbase) + (h) * hstepB + voffB[_i], (bufoff) + ldsw + _i * 8192); } while (0)
#define PG8_STAGE_A(bufoff, gbase, h, usenext) do { _Pragma("unroll") for (int _i = 0; _i < 2; ++_i) { unsigned _vo; \
        if constexpr (GATHER) { _vo = (usenext) ? ((h) ? nv1[_i] : nv0[_i]) : ((h) ? cv1[_i] : cv0[_i]); } else { _vo = voffA[_i] + (unsigned)((h) * hstepA); } \
        PG8_LOAD16((gbase) + _vo, (bufoff) + ldsw + _i * 8192); } } while (0)
#define PG8_LDA(dst, b, h) do { _Pragma("unroll") for (int m = 0; m < 4; ++m) _Pragma("unroll") for (int k = 0; k < 2; ++k) dst[m][k] = *(const LAS bf16x8*)(lds + PG8_SA(b, h) + aoff + m * 2048 + k * 1024); } while (0)
#define PG8_LDB(dst, b, h) do { _Pragma("unroll") for (int n = 0; n < 2; ++n) _Pragma("unroll") for (int k = 0; k < 2; ++k) dst[n][k] = *(const LAS bf16x8*)(lds + PG8_SB(b, h) + boff + n * 2048 + k * 1024); } while (0)
#define PG8_MMA(ai, bj, At, Bt) do { __builtin_amdgcn_s_setprio(1); _Pragma("unroll") for (int m = 0; m < 4; ++m) _Pragma("unroll") for (int n = 0; n < 2; ++n) _Pragma("unroll") for (int k = 0; k < 2; ++k) \
        acc[ai][bj][m][n] = __builtin_amdgcn_mfma_f32_16x16x32_bf16(Bt[n][k], At[m][k], acc[ai][bj][m][n], 0, 0, 0); __builtin_amdgcn_s_setprio(0); } while (0)
#define PG8_WAIT_V(n) asm volatile("s_waitcnt vmcnt(" #n ")" ::: "memory")
#define PG8_WAIT_L(n) asm volatile("s_waitcnt lgkmcnt(" #n ")" ::: "memory")
#define PG8_BAR __builtin_amdgcn_s_barrier()
#define PG8_SCHED __builtin_amdgcn_sched_barrier(0)
    Unit cur, nxt; int ui = 0;
    if (!S.next(0, cur)) return;
    f32x4 acc[2][2][4][2];
#pragma unroll
    for (int a = 0; a < 2; ++a)
#pragma unroll
        for (int b = 0; b < 2; ++b)
#pragma unroll
            for (int m = 0; m < 4; ++m)
#pragma unroll
                for (int n = 0; n < 2; ++n) acc[a][b][m][n] = (f32x4){0.f, 0.f, 0.f, 0.f};
    bf16x8 At[4][2], B0[2][2], B1[2][2];
    const char* cA = cur.a; const char* cB = cur.b;
    if constexpr (GATHER) { const u32x4 pk = gather_offs(cur, tid, lda_b); cv0[0] = pk.x; cv0[1] = pk.y; cv1[0] = pk.z; cv1[1] = pk.w; }
    PG8_STAGE_B(PG8_SB(0, 0), cB, 0); PG8_STAGE_B(PG8_SB(0, 1), cB, 1); PG8_STAGE_A(PG8_SA(0, 0), cA, 0, false); PG8_STAGE_A(PG8_SA(0, 1), cA, 1, false);
    if (wr == 1) PG8_BAR;
    PG8_WAIT_V(2); PG8_BAR;
    PG8_STAGE_B(PG8_SB(1, 0), cB + kstep, 0); PG8_STAGE_A(PG8_SA(1, 0), cA + kstep, 0, false); PG8_STAGE_B(PG8_SB(1, 1), cB + kstep, 1);
    PG8_WAIT_V(6); PG8_BAR;
    for (;;) {
        const bool has_next = S.next(ui + 1, nxt);
        const char* nA = has_next ? nxt.a : cA; const char* nB = has_next ? nxt.b : cB;
        if constexpr (GATHER) {
            u32x4 pk = (u32x4){cv0[0], cv0[1], cv1[0], cv1[1]}; if (has_next) pk = gather_offs(nxt, tid, lda_b);
            *(LAS u32x4*)(lds + STAGE_BYTES + 1024 + tid * 16) = pk;
        }
#pragma nounroll
        for (int t = 0; t < nt; t += 2) {
            const bool last = (t == nt - 2);
            if constexpr (GATHER) { if (last) { const u32x4 pk = *(const LAS u32x4*)(lds + STAGE_BYTES + 1024 + tid * 16); nv0[0] = pk.x; nv0[1] = pk.y; nv1[0] = pk.z; nv1[1] = pk.w; } }
            const char* a1 = cA + (size_t)(t + 1) * kstep;
            const char* a2 = last ? nA : cA + (size_t)(t + 2) * kstep; const char* b2 = last ? nB : cB + (size_t)(t + 2) * kstep;
            const char* a3 = a2 + kstep; const char* b3 = b2 + kstep;
            PG8_LDB(B0, 0, 0); PG8_LDB(B1, 0, 1); PG8_SCHED; PG8_LDA(At, 0, 0); PG8_STAGE_A(PG8_SA(1, 1), a1, 1, false);
            PG8_WAIT_V(8); PG8_WAIT_L(0); PG8_BAR; PG8_MMA(0, 0, At, B0); PG8_MMA(0, 1, At, B1); PG8_BAR; PG8_SCHED;
            PG8_LDA(At, 0, 1); PG8_STAGE_B(PG8_SB(0, 0), b2, 0); PG8_STAGE_B(PG8_SB(0, 1), b2, 1); PG8_STAGE_A(PG8_SA(0, 0), a2, 0, last);
            PG8_WAIT_V(8); PG8_WAIT_L(0); PG8_BAR; PG8_MMA(1, 0, At, B0); PG8_MMA(1, 1, At, B1); PG8_BAR; PG8_SCHED;
            PG8_LDB(B0, 1, 0); PG8_LDB(B1, 1, 1); PG8_SCHED; PG8_LDA(At, 1, 0); PG8_STAGE_A(PG8_SA(0, 1), a2, 1, last);
            PG8_WAIT_V(8); PG8_WAIT_L(0); PG8_BAR; PG8_MMA(0, 0, At, B0); PG8_MMA(0, 1, At, B1); PG8_BAR; PG8_SCHED;
            PG8_LDA(At, 1, 1); PG8_STAGE_B(PG8_SB(1, 0), b3, 0); PG8_STAGE_B(PG8_SB(1, 1), b3, 1); PG8_STAGE_A(PG8_SA(1, 0), a3, 0, last);
            PG8_WAIT_V(8); PG8_WAIT_L(0); PG8_BAR; PG8_MMA(1, 0, At, B0); PG8_MMA(1, 1, At, B1); PG8_BAR; PG8_SCHED;
        }
        if (wr == 0) PG8_BAR;
        E(acc, cur, wr, wc, fr, fq);
        if (!has_next) break;
#pragma unroll
        for (int a = 0; a < 2; ++a)
#pragma unroll
            for (int b = 0; b < 2; ++b)
#pragma unroll
                for (int m = 0; m < 4; ++m)
#pragma unroll
                    for (int n = 0; n < 2; ++n) acc[a][b][m][n] = (f32x4){0.f, 0.f, 0.f, 0.f};
        cur = nxt; cA = nA; cB = nB; ++ui;
        if constexpr (GATHER) {
#pragma unroll
            for (int i = 0; i < 2; ++i) { cv0[i] = nv0[i]; cv1[i] = nv1[i]; }
        }
        if (wr == 1) PG8_BAR;
    }
    PG8_WAIT_V(0);
    PG8_BAR;
#undef PG8_SA
#undef PG8_SB
#undef PG8_LOAD16
#undef PG8_STAGE_A
#undef PG8_STAGE_B
#undef PG8_LDA
#undef PG8_LDB
#undef PG8_MMA
#undef PG8_WAIT_V
#undef PG8_WAIT_L
#undef PG8_BAR
#undef PG8_SCHED
}
}
namespace att {
constexpr int NW = 8, QBLK = 32, KVBLK = 64, QB = NW * QBLK;
constexpr int DQK = 192, DV = 128;
constexpr int QS = NQ, KNS = NKV, KRS = DROPE, OS = DM;
constexpr int SHM_V = KVBLK * DV * 2, SHM_K = KVBLK * DQK * 2;
constexpr int LDS_QR = 2 * SHM_V + 2 * SHM_K + NW * 64 * 4;
constexpr int LDS_BYTES = LDS_QR + NW * 4096;
constexpr float SCALE = 0.07216878364870322f;
constexpr float THR = 8.f;
#define KSWZ(row, ch) ((row) * 384 + ((((ch) ^ (((row) >> 1) & 7))) << 4))
#define SBAR() __builtin_amdgcn_sched_barrier(0)
__device__ __forceinline__ int v_st(int k, int c) { const int kk = (k & ~0xC) | ((k & 4) << 1) | ((k & 8) >> 1); return ((kk >> 3) * 4 + (c >> 5)) * 512 + ((kk & 7) * 32 + (c & 31)) * 2; }
__device__ __forceinline__ int v_rd_base(int lane) { return ((lane & 3) << 3) | (((lane >> 2) & 3) << 6) | (((lane >> 4) & 1) << 5) | (((lane >> 5) & 1) << 8); }
constexpr int v_rd_off(int d0, int ks, int half) { return d0 * 512 + ks * 4096 + half * 2048; }
__device__ __forceinline__ int crow(int r, int hi) { return (r & 3) + 8 * (r >> 2) + 4 * hi; }
__device__ __forceinline__ void mask_tile(f32x16& p0, f32x16& p1, int dq) {
    const float NEG = -__builtin_inff();
#pragma unroll
    for (int r = 0; r < 16; ++r) {
        const int c = (r & 3) + 8 * (r >> 2);
        if (dq - c < 0) p0[r] = NEG;
        if (dq - c - 32 < 0) p1[r] = NEG;
    }
}
__device__ __forceinline__ void partialSM(f32x16& p0, f32x16& p1, float& m_reg, float& mn, float& alpha) {
    float pmax = p0[0]; for (int r = 1; r < 16; ++r) pmax = fmaxf(pmax, p0[r]); for (int r = 0; r < 16; ++r) pmax = fmaxf(pmax, p1[r]);
    { auto rr = __builtin_amdgcn_permlane32_swap(__float_as_uint(pmax), __float_as_uint(pmax), false, false);
      pmax = fmaxf(__uint_as_float(rr[0]), __uint_as_float(rr[1])); }
    constexpr float C2 = 1.4426950408889634f * SCALE;
    if (__builtin_expect(__all((pmax - m_reg) * SCALE <= THR), 1)) { mn = m_reg; alpha = 1.f; }
    else { mn = fmaxf(m_reg, pmax); alpha = __builtin_amdgcn_exp2f((m_reg - mn) * C2); m_reg = mn; }
    const float mnL = -mn * C2;
    for (int r = 0; r < 16; ++r) p0[r] = fmaf(p0[r], C2, mnL); for (int r = 0; r < 16; ++r) p1[r] = fmaf(p1[r], C2, mnL);
    for (int r = 0; r < 16; ++r) p0[r] = __builtin_amdgcn_exp2f(p0[r]);
}
__device__ __forceinline__ void finishSM(f32x16& p0, f32x16& p1, float alpha, float& l_reg, bf16x8& pa0, bf16x8& pa1, bf16x8& pa2, bf16x8& pa3) {
    for (int r = 0; r < 16; ++r) p1[r] = __builtin_amdgcn_exp2f(p1[r]);
    float ps = 0; for (int r = 0; r < 16; ++r) ps += p0[r]; for (int r = 0; r < 16; ++r) ps += p1[r];
    { auto rr = __builtin_amdgcn_permlane32_swap(__float_as_uint(ps), __float_as_uint(ps), false, false);
      ps = __uint_as_float(rr[0]) + __uint_as_float(rr[1]); }
    l_reg = l_reg * alpha + ps;
#define PK4(P, B_, OUT) do { unsigned a0 = cvt_pk_bf16(P[B_+0], P[B_+1]), a1 = cvt_pk_bf16(P[B_+2], P[B_+3]);                          \
        unsigned b0 = cvt_pk_bf16(P[B_+4], P[B_+5]), b1 = cvt_pk_bf16(P[B_+6], P[B_+7]);                                             \
        auto r0 = __builtin_amdgcn_permlane32_swap(a0, b0, false, false); auto r1 = __builtin_amdgcn_permlane32_swap(a1, b1, false, false); \
        u32x4 w = {r0[0], r1[0], r0[1], r1[1]}; OUT = *reinterpret_cast<bf16x8*>(&w); } while (0)
    PK4(p0, 0, pa0); PK4(p0, 8, pa1); PK4(p1, 0, pa2); PK4(p1, 8, pa3);
#undef PK4
}
template <int KB>
__device__ __forceinline__ void qkt(f32x16& p0, f32x16& p1, const char* K_lds, int r32, int hi, const bf16x8* qr, const char* qrl) {
    p0 = f32x16{}; p1 = f32x16{};
    const char* kb[4];
#pragma unroll
    for (int dd = 0; dd < 4; ++dd) kb[dd] = K_lds + KB * SHM_K + KSWZ(r32, dd * 2 + hi);
#pragma unroll
    for (int d0 = 0; d0 < 12; ++d0) { const char* a = kb[d0 & 3] + (d0 >> 2) * 128;
        bf16x8 b0 = *reinterpret_cast<const bf16x8*>(a);
        bf16x8 b1 = *reinterpret_cast<const bf16x8*>(a + 32 * 384);
        const bf16x8 qf = d0 < 8 ? qr[d0 & 7] : *reinterpret_cast<const bf16x8*>(qrl + (d0 - 8) * 1024);
        p0 = __builtin_amdgcn_mfma_f32_32x32x16_bf16(b0, qf, p0, 0, 0, 0);
        p1 = __builtin_amdgcn_mfma_f32_32x32x16_bf16(b1, qf, p1, 0, 0, 0);
        if ((d0 & 3) == 3 && d0 < 11) SBAR(); }
}
template <int VB>
__device__ __forceinline__ void pv_tile(f32x16* o, int vb0, bf16x8 pa0, bf16x8 pa1, bf16x8 pa2, bf16x8 pa3) {
#define TRRD(dst, off) asm volatile("ds_read_b64_tr_b16 %0, %1 offset:%2" : "=&v"(dst) : "v"(vb0), "i"(off) : "memory")
#define PV_D0(d0) do { s16x4 l0, l1, l2, l3, h0, h1, h2, h3; constexpr int b_ = VB * SHM_V + v_rd_off(d0, 0, 0); \
        TRRD(l0, b_); TRRD(h0, b_ + 2048); TRRD(l1, b_ + 4096); TRRD(h1, b_ + 6144); TRRD(l2, b_ + 8192); TRRD(h2, b_ + 10240); TRRD(l3, b_ + 12288); TRRD(h3, b_ + 14336); \
        asm volatile("s_waitcnt lgkmcnt(0)" ::: "memory"); SBAR();   \
        o[d0] = __builtin_amdgcn_mfma_f32_32x32x16_bf16(pa0, (bf16x8){l0[0], l0[1], l0[2], l0[3], h0[0], h0[1], h0[2], h0[3]}, o[d0], 0, 0, 0);   \
        o[d0] = __builtin_amdgcn_mfma_f32_32x32x16_bf16(pa1, (bf16x8){l1[0], l1[1], l1[2], l1[3], h1[0], h1[1], h1[2], h1[3]}, o[d0], 0, 0, 0);   \
        o[d0] = __builtin_amdgcn_mfma_f32_32x32x16_bf16(pa2, (bf16x8){l2[0], l2[1], l2[2], l2[3], h2[0], h2[1], h2[2], h2[3]}, o[d0], 0, 0, 0);   \
        o[d0] = __builtin_amdgcn_mfma_f32_32x32x16_bf16(pa3, (bf16x8){l3[0], l3[1], l3[2], l3[3], h3[0], h3[1], h3[2], h3[3]}, o[d0], 0, 0, 0); } while (0)
    PV_D0(0); PV_D0(1); PV_D0(2); PV_D0(3);
#undef PV_D0
#undef TRRD
}
struct BlockRef { const bf16_t* Q; const bf16_t* Kn; const bf16_t* Kr; const bf16_t* V; bf16_t* O; int P0; };
struct Seam { bf16x8 qr[8]; bf16x8 st_v0, st_v1, st_k0, st_k1, st_k2; };
#define VMW() asm volatile("s_waitcnt vmcnt(0)" ::: "memory")
#define VMWN(n) asm volatile("s_waitcnt vmcnt(%0)" :: "i"(n) : "memory")
#define LD8(p) (*reinterpret_cast<const bf16x8*>(p))
#define SLOAD_H(R_, k0) do { S.st_v0 = LD8((R_).V + (size_t)((k0) + sr) * KNS + sc); S.st_v1 = LD8((R_).V + (size_t)((k0) + 32 + sr) * KNS + sc);              \
                             S.st_k0 = LD8((R_).Kn + (size_t)((k0) + sr) * KNS + sc); S.st_k1 = LD8((R_).Kn + (size_t)((k0) + 32 + sr) * KNS + sc);            \
                             S.st_k2 = LD8((R_).Kr + (size_t)((k0) + rr) * KRS + rc); } while (0)
#define SWRITE_HK(bf) do { *(bf16x8*)(K_lds + (bf) * SHM_K + kws) = S.st_k0; *(bf16x8*)(K_lds + (bf) * SHM_K + kws + 32 * 384) = S.st_k1; *(bf16x8*)(K_lds + (bf) * SHM_K + kws2) = S.st_k2; } while (0)
#define SWRITE_HV(bf) do { *(bf16x8*)(V_lds + (bf) * SHM_V + vst0) = S.st_v0; *(bf16x8*)(V_lds + (bf) * SHM_V + vst1) = S.st_v1; } while (0)
#define SWRITE_H(bf) do { SWRITE_HV(bf); SWRITE_HK(bf); } while (0)
#define ATT_IDX const int tid = launder_v((int)threadIdx.x), wid = __builtin_amdgcn_readfirstlane(tid >> 6), lane = tid & 63, r32 = lane & 31, hi = lane >> 5; \
    const int sr = tid >> 4, sc = (tid & 15) * 8, rr = tid >> 3, rc = (tid & 7) * 8, kws = KSWZ(sr, (tid & 15)), kws2 = KSWZ(rr, 16 + (tid & 7));
__device__ __forceinline__ void attn_block(const BlockRef& cur, char* lds) {
    ATT_IDX;
    Seam S;
    const int NT = cur.P0 / KVBLK + QB / KVBLK;
    const int qlo = cur.P0 + wid * QBLK, qm = qlo + r32 - 4 * hi;
    char* V_lds = lds; char* K_lds = lds + 2 * SHM_V;
    float* ws = (float*)(lds + 2 * SHM_V + 2 * SHM_K) + wid * 64; float* li_l = ws, * al_l = ws + 32;
    float m_reg = -1e30f, l_reg = 0; f32x16 o[4] = {};
    const int vst0 = v_st(sr, sc), vst1 = v_st(32 + sr, sc);
    const int vb0 = (int)(uintptr_t)V_lds + v_rd_base(lane);
    char* qrl = lds + LDS_QR + wid * 4096 + lane * 16;
#define RESC(a) do { if (__any((a) < 1.f)) { if (hi == 0) al_l[r32] = (a); asm volatile("s_waitcnt lgkmcnt(0)" ::: "memory");              \
                     for (int d_ = 0; d_ < 4; ++d_) for (int r = 0; r < 16; ++r) o[d_][r] *= al_l[crow(r, hi)]; } } while (0)
#define KBASE(t) ((t) * KVBLK)
#define MASKT(P0_, P1_, t) do { const int kb_ = KBASE(t); if (kb_ + KVBLK - 1 > qlo) mask_tile(P0_, P1_, qm - kb_); } while (0)
    SLOAD_H(cur, 0);
#pragma unroll
    for (int d0 = 0; d0 < 8; ++d0) S.qr[d0] = LD8(cur.Q + (size_t)(wid * QBLK + r32) * QS + d0 * 16 + hi * 8);
    { bf16x8 t0 = LD8(cur.Q + (size_t)(wid * QBLK + r32) * QS + 128 + hi * 8), t1 = LD8(cur.Q + (size_t)(wid * QBLK + r32) * QS + 144 + hi * 8),
             t2 = LD8(cur.Q + (size_t)(wid * QBLK + r32) * QS + 160 + hi * 8), t3 = LD8(cur.Q + (size_t)(wid * QBLK + r32) * QS + 176 + hi * 8);
      *(bf16x8*)(qrl) = t0; *(bf16x8*)(qrl + 1024) = t1; *(bf16x8*)(qrl + 2048) = t2; *(bf16x8*)(qrl + 3072) = t3; }
    VMW(); SWRITE_H(0);
    __syncthreads();
    f32x16 p0, p1; float mn, al; bf16x8 pa0, pa1, pa2, pa3;
#define TILE_STEP(t, BF) do {                                                                                                 \
        if ((t) + 1 < NT) { SLOAD_H(cur, KBASE((t) + 1)); }                                                                    \
        SBAR();                                                                                                               \
        if (KBASE(t) <= qlo + QBLK - 1) {     \
        qkt<BF>(p0, p1, K_lds, r32, hi, S.qr, qrl);                                                                           \
        MASKT(p0, p1, (t)); partialSM(p0, p1, m_reg, mn, al); RESC(al);                                                        \
        finishSM(p0, p1, al, l_reg, pa0, pa1, pa2, pa3); SBAR();                                                              \
        pv_tile<BF>(o, vb0, pa0, pa1, pa2, pa3); }                                                                            \
        if ((t) + 1 < NT) { VMW(); SWRITE_H(1 - BF); }                                                                         \
        __syncthreads(); } while (0)
    for (int t = 0; t < NT; t += 2) { TILE_STEP(t, 0); TILE_STEP(t + 1, 1); }
    if (hi == 0) li_l[r32] = l_reg; asm volatile("s_waitcnt lgkmcnt(0)" ::: "memory");
    float rli[16];
#pragma unroll
    for (int r = 0; r < 16; ++r) rli[r] = __builtin_amdgcn_rcpf(li_l[crow(r, hi)]);
    bf16_t* Ow = cur.O + (size_t)(wid * QBLK) * OS;
#pragma unroll
    for (int r = 0; r < 16; ++r) { const int orow = crow(r, hi);
#pragma unroll
        for (int d0 = 0; d0 < 4; ++d0) { const float v = o[d0][r] * rli[r];
            const float vn = __shfl_xor(v, 1);
            if ((r32 & 1) == 0) *(unsigned*)(Ow + (size_t)orow * OS + d0 * 32 + r32) = cvt_pk_bf16(v, vn); } }
    __syncthreads();
#undef RESC
#undef KBASE
#undef MASKT
#undef TILE_STEP
}
#undef VMW
#undef VMWN
#undef LD8
#undef SLOAD_H
#undef SWRITE_HK
#undef SWRITE_HV
#undef SWRITE_H
#undef ATT_IDX
#undef KSWZ
#undef SBAR

__device__ __forceinline__ BlockRef make_ref(int L, int pass, const bf16_t* Qb, const bf16_t* KNVb, const bf16_t* KRb, bf16_t* Ob) {
    const int bh = L >> 2, x = L & 3, qb = pass ? 7 - x : x, b = bh >> 3, h = bh & 7; const size_t rb = (size_t)b * SEQ;
    BlockRef r; r.Q = Qb + (rb + (size_t)qb * QB) * QS + h * DQH; r.Kn = KNVb + rb * KNS + h * (DNOPE + DVH); r.Kr = KRb + rb * KRS; r.V = KNVb + rb * KNS + h * (DNOPE + DVH) + DNOPE;
    r.O = Ob + (rb + (size_t)qb * QB) * OS + h * DVH; r.P0 = qb * QB; return r;
}
__device__ __forceinline__ void attn_phase(char* lds, const bf16_t* Qb, const bf16_t* KNVb, const bf16_t* KRb, bf16_t* Ob, int first, int stride) {
    constexpr int total = NBATCH * NHEAD * 4;
    for (int L = first; L < total; L += stride) {
        for (int pass = 0; pass < 2; ++pass) { const BlockRef cur = make_ref(L, pass, Qb, KNVb, KRb, Ob); attn_block(cur, lds); }
    }
}
}
constexpr int NWAVES = 8;
constexpr size_t MiB = 1u << 20;
constexpr size_t WS_CTL = 0, CTL_ZERO_BYTES = 8 * MiB;
constexpr size_t WS_SSQ = 1 * MiB;
constexpr size_t WS_COS = 8 * MiB, WS_SIN = 16 * MiB;
constexpr size_t WS_LIST = 24 * MiB;
constexpr size_t WS_RSL = 26 * MiB;
constexpr size_t WS_TOKINFO = 28 * MiB;
constexpr size_t WS_WDN = 30 * MiB, WS_WUQ = 34 * MiB, WS_WUKV = 37 * MiB, WS_WO = 39 * MiB, WS_WPOOL = 43 * MiB, WS_WGU = 44 * MiB, WS_WD = 65 * MiB, WS_MWGU = 76 * MiB, WS_MWD = 164 * MiB;
constexpr size_t WS_H = 208 * MiB;
constexpr size_t WS_ACT = 336 * MiB;
constexpr size_t WS_DOWN = WS_ACT;
constexpr size_t WS_CQN = WS_ACT + 128 * MiB, WS_CKVN = WS_ACT + 192 * MiB, WS_KR = WS_ACT + 224 * MiB, WS_Q = WS_ACT + 232 * MiB, WS_KNV = WS_ACT + 424 * MiB;
constexpr size_t WS_HID = WS_ACT;
constexpr size_t WS_YB = WS_ACT + 358 * MiB;
constexpr size_t WS_DUMMY = WS_ACT + 424 * MiB;
constexpr size_t WS_END = WS_ACT + 680 * MiB;
static_assert(WS_MWD + (size_t)16 * 1024 * FFEP * 2 <= WS_H && WS_MWGU + (size_t)16 * 2 * FFEP * 1024 * 2 <= WS_MWD && WS_WD + (size_t)2 * 1024 * FFD * 2 <= WS_MWGU && WS_WGU + (size_t)2 * 2 * FFD * 1024 * 2 <= WS_WD, "weights map");
static_assert(WS_HID + (size_t)PSLOT * FFEP * 2 <= WS_YB && WS_YB + (size_t)PSLOT * 1024 * 2 <= WS_END && WS_HID + (size_t)NTOK * FFD * 2 <= WS_END && WS_KNV + (size_t)NTOK * NKV * 2 <= WS_END && WS_Q + (size_t)NTOK * NQ * 2 <= WS_KNV, "activation map");
static_assert(WS_SSQ + (size_t)14 * NTOK * 8 <= WS_COS && WS_COS <= CTL_ZERO_BYTES + WS_COS && WS_END <= 1024 * MiB, "map");
constexpr int CW_TMO = 0, CW_CODE = 1, CW_CNT = 1024  , CW_DBG = 2048, CW_BAR = 4096  ;
constexpr int RING_OFF = 0, RING_BYTES = 131072, LDSCTL_OFF = RING_BYTES, MISC_OFF = LDSCTL_OFF + 320, LDS_BYTES = 147456;

typedef GAS unsigned gu32;
#define RLX_AGENT __ATOMIC_RELAXED, __HIP_MEMORY_SCOPE_AGENT
#define LDS_WAIT() asm volatile("s_waitcnt lgkmcnt(0)" ::: "memory")
#define VM_WAIT() asm volatile("s_waitcnt vmcnt(0)" ::: "memory")

#define XB_TMO      128
#define XB_XCNT(j)  (256  + 64 * (j))
#define XB_XSUB(j)  (1280 + 64 * (j))
#define XB_XGEN(j)  (2304 + 64 * (j))
#define XB_TOP      3328
#define XB_TOPGEN   3392
#define XCD_BAR_WORDS 3456
#define XB_SPIN_CAP (1u << 18)
__device__ __forceinline__ unsigned xb_ld(unsigned* p)              { return __hip_atomic_load(p, __ATOMIC_RELAXED, __HIP_MEMORY_SCOPE_AGENT); }
__device__ __forceinline__ unsigned xb_add(unsigned* p, unsigned v) { return __hip_atomic_fetch_add(p, v, __ATOMIC_RELAXED, __HIP_MEMORY_SCOPE_AGENT); }
__device__ __forceinline__ unsigned xb_xcc_id() { return (unsigned)__builtin_amdgcn_s_getreg((3 << 11) | 20) & 0xFu; }
#define XB_SPIN(cond, bar) do { unsigned _sp = 0; while (cond) { __builtin_amdgcn_s_sleep(1); \
    if ((++_sp & 255u) == 0u) { if (xb_ld(&(bar)[XB_TMO])) break; if (_sp > XB_SPIN_CAP) { atomicAdd(&(bar)[XB_TMO], 1u); break; } } } } while (0)
__device__ __forceinline__ unsigned rfl(unsigned v);
struct XcdBarrier { unsigned* bar; unsigned x; volatile LAS unsigned* st; };
__device__ __forceinline__ XcdBarrier xcd_barrier_post(unsigned* bar, volatile LAS unsigned* st) {
    XcdBarrier b; b.bar = bar; b.x = xb_xcc_id(); b.st = st;
    if (threadIdx.x == 0) (void)xb_add(&bar[XB_XCNT(b.x)], 1u);
    return b;
}
__device__ __forceinline__ void xcd_barrier_complete(unsigned* bar, unsigned x, unsigned& nloc, unsigned& nx) {
    const unsigned G = gridDim.x * gridDim.y * gridDim.z;
    unsigned sum, cnt, mine, sp = 0u;
    for (;;) {
        sum = 0u; cnt = 0u; mine = 0u;
#pragma unroll
        for (unsigned j = 0; j < 16; ++j) { const unsigned c = xb_ld(&bar[XB_XCNT(j)]); sum += c; cnt += (c > 0u) ? 1u : 0u; mine = (j == x) ? c : mine; }
        if (sum == G) break;
        __builtin_amdgcn_s_sleep(1);
        if ((++sp & 255u) == 0u) { if (xb_ld(&bar[XB_TMO])) break; if (sp > XB_SPIN_CAP) { atomicAdd(&bar[XB_TMO], 1u); break; } }
    }
    nloc = mine > 0u ? mine : 1u; nx = cnt > 0u ? cnt : 1u;
}
__device__ __forceinline__ void xcd_barrier(const XcdBarrier& b) {
    unsigned* bar; { const volatile LAS unsigned* p_ = b.st + 2; const unsigned lo_ = rfl(p_[0]), hi_ = rfl(p_[1]); bar = (unsigned*)(((unsigned long long)hi_ << 32) | lo_); }
    asm volatile("s_waitcnt vmcnt(0)" ::: "memory");
    __syncthreads();
    if (threadIdx.x == 0) {
        __builtin_amdgcn_s_waitcnt(0);
        unsigned nloc = b.st[0], nx = b.st[1];
        if (nloc == 0u) { xcd_barrier_complete(bar, b.x, nloc, nx); b.st[0] = nloc; b.st[1] = nx; }
        const unsigned old = xb_add(&bar[XB_XSUB(b.x)], 1u);
        const unsigned gen = old / nloc;
        if (old + 1u == (gen + 1u) * nloc) {
            __builtin_amdgcn_fence(__ATOMIC_RELEASE, "agent");
            asm volatile("s_waitcnt vmcnt(0)" ::: "memory");
            const unsigned og = xb_add(&bar[XB_TOP], 1u);
            const unsigned tg = og / nx;
            if (og + 1u == (tg + 1u) * nx) xb_add(&bar[XB_TOPGEN], 1u);
            else XB_SPIN(xb_ld(&bar[XB_TOPGEN]) == tg, bar);
            __builtin_amdgcn_fence(__ATOMIC_ACQUIRE, "agent");
            xb_add(&bar[XB_XGEN(b.x)], 1u);
            asm volatile("s_waitcnt vmcnt(0)" ::: "memory");
        } else {
            XB_SPIN(xb_ld(&bar[XB_XGEN(b.x)]) == gen, bar);
            __builtin_amdgcn_fence(__ATOMIC_ACQUIRE, "agent");
            asm volatile("s_waitcnt vmcnt(0)" ::: "memory");
        }
    }
    __syncthreads();
}

constexpr int PT_OFF_ = LDSCTL_OFF + 512;
__device__ __forceinline__ unsigned rfl(unsigned v);
__device__ __forceinline__ const float* ptab(LAS unsigned char* L, int i);
struct Frame { LAS unsigned char* lds; volatile LAS unsigned* MISC; gu32* ctl; unsigned char* ws; int tid, lane, wave, vcu, G; };

__device__ __forceinline__ float wave_sum(float v) {
#pragma unroll
    for (int o = 1; o < 64; o <<= 1) v += __shfl_xor(v, o);
    return v;
}
__device__ __forceinline__ unsigned rfl(unsigned v) { return (unsigned)__builtin_amdgcn_readfirstlane((int)v); }

__device__ __forceinline__ int rowmap(int mode, int n) {
    if (mode == 0) return n;
    if (mode == 1) return (n >> 7) * 256 + (n & 127);
    if (mode == 2) return (n >> 7) * 256 + 128 + (n & 127);
    if (mode == 4) return n < 800 ? n : 896 + (n - 800);
    const int h = n / DQH, d = n - h * DQH;
    if (d < DNOPE) return 512 + h * DNOPE + d;
    if (d < DNOPE + 32) return (h >> 2) * 256 + (h & 3) * 32 + (d - DNOPE);
    return (h >> 2) * 256 + 128 + (h & 3) * 32 + (d - DNOPE - 32);
}
__device__ __forceinline__ void transpose_item(const float* W, int N, bf16_t* WT, int ldd, int mode, const float* kscale, const float* nscale, int item, int lane) {
    const int nblk = N / 64, kb = item / nblk, nb = item % nblk, k0 = 64 * kb, n = 64 * nb + lane;
    const float sn = nscale ? nscale[n] : 1.0f;
    const float* wp = W + (size_t)k0 * N + n;
    bf16_t* op = WT + (size_t)rowmap(mode, n) * ldd + k0;
#pragma unroll
    for (int kg = 0; kg < 8; ++kg) { float v[8];
#pragma unroll
        for (int i = 0; i < 8; ++i) { const float sk = kscale ? kscale[k0 + 8 * kg + i] : 1.0f; v[i] = wp[(size_t)(8 * kg + i) * N] * (sk * sn); }
        u32x4 o; o.x = cvt_pk_bf16(v[0], v[1]); o.y = cvt_pk_bf16(v[2], v[3]); o.z = cvt_pk_bf16(v[4], v[5]); o.w = cvt_pk_bf16(v[6], v[7]);
        *(GAS u32x4*)(op + 8 * kg) = o; }
}
struct MatDesc { const float* src; bf16_t* dst; const float* kscale; const float* nscale; int K, N, ldd, mode; };
constexpr int N_MATS = 70;
__device__ __forceinline__ MatDesc mat_desc(int m, LAS unsigned char* L, unsigned char* ws) {
    MatDesc d; d.kscale = nullptr; d.nscale = nullptr; d.mode = 0;
    if (m < 2)       { const int a = m;      d.src = ptab(L, 4) + (size_t)a * DM * NDOWN;    d.K = DM;   d.N = NDOWN; d.dst = (bf16_t*)(ws + WS_WDN) + (size_t)a * NDOWNP * DM;  d.ldd = DM; d.mode = 4; d.kscale = ptab(L, 2) + (size_t)(2 * a) * DM; }
    else if (m < 4)  { const int a = m - 2;  d.src = ptab(L, 6) + (size_t)a * QLR * NQ;      d.K = QLR;  d.N = NQ;    d.dst = (bf16_t*)(ws + WS_WUQ) + (size_t)a * NQ * QLR;     d.ldd = QLR; d.mode = 3; d.kscale = ptab(L, 5) + (size_t)a * QLR; }
    else if (m < 6)  { const int a = m - 4;  d.src = ptab(L, 8) + (size_t)a * KVLR * NKV;    d.K = KVLR; d.N = NKV;   d.dst = (bf16_t*)(ws + WS_WUKV) + (size_t)a * NKV * KVLR;  d.ldd = KVLR; d.kscale = ptab(L, 7) + (size_t)a * KVLR; }
    else if (m < 8)  { const int a = m - 6;  d.src = ptab(L, 9) + (size_t)a * DM * DM;       d.K = DM;   d.N = DM;    d.dst = (bf16_t*)(ws + WS_WO) + (size_t)a * DM * DM;       d.ldd = DM; }
    else if (m < 16) { const int i = m - 8;  d.src = ptab(L, 10) + (size_t)i * 256 * 256;    d.K = 256;  d.N = 256;   d.dst = (bf16_t*)(ws + WS_WPOOL) + (size_t)i * 256 * 256;  d.ldd = 256; d.nscale = ptab(L, 11) + i * 256; }
    else if (m < 18) { const int a = m - 16; d.src = ptab(L, 12) + (size_t)a * DM * FFD;     d.K = DM;   d.N = FFD;   d.dst = (bf16_t*)(ws + WS_WGU) + (size_t)a * 2 * FFD * DM; d.ldd = DM; d.mode = 1; d.kscale = ptab(L, 3) + (size_t)(2 * a) * DM; }
    else if (m < 20) { const int a = m - 18; d.src = ptab(L, 13) + (size_t)a * DM * FFD;     d.K = DM;   d.N = FFD;   d.dst = (bf16_t*)(ws + WS_WGU) + (size_t)a * 2 * FFD * DM; d.ldd = DM; d.mode = 2; d.kscale = ptab(L, 3) + (size_t)(2 * a) * DM; }
    else if (m < 22) { const int a = m - 20; d.src = ptab(L, 14) + (size_t)a * FFD * DM;     d.K = FFD;  d.N = DM;    d.dst = (bf16_t*)(ws + WS_WD) + (size_t)a * DM * FFD;      d.ldd = FFD; }
    else if (m < 38) { const int i = m - 22; d.src = ptab(L, 16) + (size_t)i * DM * FFE;     d.K = DM;   d.N = FFE;   d.dst = (bf16_t*)(ws + WS_MWGU) + (size_t)i * 2 * FFEP * DM; d.ldd = DM; d.mode = 1; d.kscale = ptab(L, 3) + (size_t)(2 * (i >> 3) + 1) * DM; }
    else if (m < 54) { const int i = m - 38; d.src = ptab(L, 17) + (size_t)i * DM * FFE;     d.K = DM;   d.N = FFE;   d.dst = (bf16_t*)(ws + WS_MWGU) + (size_t)i * 2 * FFEP * DM; d.ldd = DM; d.mode = 2; d.kscale = ptab(L, 3) + (size_t)(2 * (i >> 3) + 1) * DM; }
    else             { const int i = m - 54; d.src = ptab(L, 18) + (size_t)i * FFE * DM;     d.K = FFE;  d.N = DM;    d.dst = (bf16_t*)(ws + WS_MWD) + (size_t)i * DM * FFEP;    d.ldd = FFEP; }
    return d;
}
__device__ __forceinline__ void p0_prologue(Frame& F) {
    const int* positions = (const int*)ptab(F.lds, 1);
    const int gw = F.vcu * NWAVES + F.wave, NGW = F.G * NWAVES;
    int cum = 0;
    for (int m = 0; m < N_MATS; ++m) {
        const MatDesc d = mat_desc(m, F.lds, F.ws);
        const int nitems = (d.K / 64) * (d.N / 64);
        int first = gw - (cum % NGW); if (first < 0) first += NGW;
        for (int it = first; it < nitems; it += NGW) transpose_item(d.src, d.N, d.dst, d.ldd, d.mode, d.kscale, d.nscale, it, F.lane);
        cum += nitems;
    }
    const int gt = gw * 64 + F.lane, NGT = NGW * 64; const u32x4 z4 = (u32x4){0u, 0u, 0u, 0u};
    for (int i = gt; i < 2 * 192 * 128; i += NGT) { const int a = i / (192 * 128), r = (i / 128) % 192, c = i % 128; const int row = r < 96 ? 800 + r : 928 + (r - 96); *(GAS u32x4*)((bf16_t*)(F.ws + WS_WDN) + (size_t)a * NDOWNP * DM + (size_t)row * DM + c * 8) = z4; }
    for (int i = gt; i < 16 * 128 * 128; i += NGT) { const int e = i / (128 * 128), r = (i / 128) % 128, c = i % 128; const int row = 2560 + (r < 64 ? 64 + r : 192 + (r - 64));
        *(GAS u32x4*)((bf16_t*)(F.ws + WS_MWGU) + (size_t)e * 2 * FFEP * DM + (size_t)row * DM + c * 8) = z4; }
    for (int i = gt; i < 16 * 1024 * 8; i += NGT) { const int row = i / 8, c = i % 8; *(GAS u32x4*)((bf16_t*)(F.ws + WS_MWD) + (size_t)row * FFEP + FFE + c * 8) = z4; }
    float* cosT = (float*)(F.ws + WS_COS); float* sinT = (float*)(F.ws + WS_SIN);
    for (int i = gt; i < NTOK * 32; i += NGT) { const int row = i >> 5, k = i & 31; const float inv = powf(10000.0f, -(float)(2 * k) / 64.0f); const float ang = (float)positions[row] * inv;
        cosT[i] = cosf(ang); sinT[i] = sinf(ang); }
    const float* x = ptab(F.lds, 0); bf16_t* H = (bf16_t*)(F.ws + WS_H); ssq_t* ssq0 = (ssq_t*)(F.ws + WS_SSQ);
    for (int m = gw; m < NTOK; m += NGW) {
        const GAS f32x4* xr = (const GAS f32x4*)(x + (size_t)m * DM) + F.lane; GAS u32x2* o8 = (GAS u32x2*)(H + (size_t)m * DM) + F.lane; float s = 0.f;
#pragma unroll
        for (int j = 0; j < 4; ++j) { const f32x4 v = xr[64 * j]; s += (v.x * v.x + v.y * v.y) + (v.z * v.z + v.w * v.w); u32x2 w; w.x = cvt_pk_bf16(v.x, v.y); w.y = cvt_pk_bf16(v.z, v.w); o8[64 * j] = w; }
        s = wave_sum(s); if (F.lane == 0) ssq0[m] = ssq_fix(s);
    }
}

template <bool FINAL>
__device__ __forceinline__ void combine_phase(Frame& F, bf16_t* H, const bf16_t* YB, const unsigned* tokinfo, const unsigned* cntw, ssq_t* ssq_next, const float* gain, float* outF) {
    const int gw = F.vcu * NWAVES + F.wave, NGW = F.G * NWAVES;
    f32x4 g[4];
    if constexpr (FINAL) {
#pragma unroll
        for (int j = 0; j < 4; ++j) g[j] = *(const f32x4*)(gain + F.lane * 4 + 256 * j);
    }
    unsigned nb[8];
#pragma unroll
    for (int e = 0; e < 8; ++e) nb[e] = (rfl(__hip_atomic_load((unsigned*)cntw + 64 * e, RLX_AGENT)) + 255u) >> 8;
    for (int m = gw; m < NTOK; m += NGW) {
        GAS u32x2* hr = (GAS u32x2*)(H + (size_t)m * DM) + F.lane;
        const u32x4 t0 = *(const u32x4*)(tokinfo + (size_t)m * 8), t1 = *(const u32x4*)(tokinfo + (size_t)m * 8 + 4);
        const unsigned e0 = rfl(t0.x), r0 = rfl(t0.y), e1 = rfl(t1.x), r1 = rfl(t1.y); const float g0 = __uint_as_float(rfl(t0.z)), g1 = __uint_as_float(rfl(t1.z));
        unsigned b0 = 0u, b1 = 0u;
#pragma unroll
        for (int e = 0; e < 8; ++e) { b0 += ((unsigned)e < e0) ? nb[e] : 0u; b1 += ((unsigned)e < e1) ? nb[e] : 0u; }
        const GAS u32x2* y0 = (const GAS u32x2*)(YB + ((size_t)b0 * 256 + r0) * DM) + F.lane; const GAS u32x2* y1 = (const GAS u32x2*)(YB + ((size_t)b1 * 256 + r1) * DM) + F.lane;
        f32x4 v[4]; float s = 0.f;
#pragma unroll
        for (int j = 0; j < 4; ++j) { const u32x2 hh = hr[64 * j], a = y0[64 * j], b = y1[64 * j];
            v[j].x = bflo(hh.x) + g0 * bflo(a.x) + g1 * bflo(b.x); v[j].y = bfhi(hh.x) + g0 * bfhi(a.x) + g1 * bfhi(b.x); v[j].z = bflo(hh.y) + g0 * bflo(a.y) + g1 * bflo(b.y); v[j].w = bfhi(hh.y) + g0 * bfhi(a.y) + g1 * bfhi(b.y);
            s += (v[j].x * v[j].x + v[j].y * v[j].y) + (v[j].z * v[j].z + v[j].w * v[j].w); }
        s = wave_sum(s);
        if constexpr (FINAL) { const float rstd = rstd_f(s); GAS f32x4* ho = (GAS f32x4*)(outF + (size_t)m * DM) + F.lane;
#pragma unroll
            for (int j = 0; j < 4; ++j) ho[64 * j] = v[j] * rstd * g[j];
        } else {
#pragma unroll
            for (int j = 0; j < 4; ++j) { u32x2 w; w.x = cvt_pk_bf16(v[j].x, v[j].y); w.y = cvt_pk_bf16(v[j].z, v[j].w); hr[64 * j] = w; }
            if (F.lane == 0) ssq_next[m] = ssq_fix(s); }
    }
}
__device__ __forceinline__ void mid_phase(Frame& F, const bf16_t* DOWN, const float* qn, const float* kvn, const float* cosT, const float* sinT, bf16_t* CQN, bf16_t* CKVN, bf16_t* KR) {
    const int gw = F.vcu * NWAVES + F.wave, NGW = F.G * NWAVES, lane = F.lane;
    const f32x4 q0 = *(const f32x4*)(qn + lane * 8), q1 = *(const f32x4*)(qn + lane * 8 + 4), k0 = *(const f32x4*)(kvn + lane * 4);
    for (int m = gw; m < NTOK; m += NGW) {
        const bf16_t* dr = DOWN + (size_t)m * NDOWNP;
        const u32x4 cq = *(const GAS u32x4*)(dr + lane * 8); const u32x2 ck = *(const GAS u32x2*)(dr + QLR + lane * 4);
        const float x1 = bf2f(dr[QLR + KVLR + (lane & 31)]), x2 = bf2f(dr[QLR + KVLR + 32 + (lane & 31)]);
        const f32x4 a0 = (f32x4){bflo(cq.x), bfhi(cq.x), bflo(cq.y), bfhi(cq.y)}, a1 = (f32x4){bflo(cq.z), bfhi(cq.z), bflo(cq.w), bfhi(cq.w)}, c0 = (f32x4){bflo(ck.x), bfhi(ck.x), bflo(ck.y), bfhi(ck.y)};
        const float sq = wave_sum((a0.x * a0.x + a0.y * a0.y) + (a0.z * a0.z + a0.w * a0.w) + (a1.x * a1.x + a1.y * a1.y) + (a1.z * a1.z + a1.w * a1.w));
        const float sk = wave_sum((c0.x * c0.x + c0.y * c0.y) + (c0.z * c0.z + c0.w * c0.w));
        const float rq = 1.0f / sqrtf(sq * (1.0f / QLR) + RMS_EPS), rk = 1.0f / sqrtf(sk * (1.0f / KVLR) + RMS_EPS);
        const f32x4 y0 = a0 * rq * q0, y1 = a1 * rq * q1, z0 = c0 * rk * k0;
        u32x4 w; w.x = cvt_pk_bf16(y0.x, y0.y); w.y = cvt_pk_bf16(y0.z, y0.w); w.z = cvt_pk_bf16(y1.x, y1.y); w.w = cvt_pk_bf16(y1.z, y1.w);
        *(GAS u32x4*)(CQN + (size_t)m * QLR + lane * 8) = w;
        u32x2 w2; w2.x = cvt_pk_bf16(z0.x, z0.y); w2.y = cvt_pk_bf16(z0.z, z0.w);
        *(GAS u32x2*)(CKVN + (size_t)m * KVLR + lane * 4) = w2;
        const float c = cosT[(size_t)m * 32 + (lane & 31)], s = sinT[(size_t)m * 32 + (lane & 31)];
        const float o = lane < 32 ? x1 * c - x2 * s : x2 * c + x1 * s;
        KR[(size_t)m * DROPE + lane] = (bf16_t)(cvt_pk_bf16(o, o) & 0xffffu);
    }
}
template <int W>
__device__ __forceinline__ void pool_walk(const bf16_t* h, const ssq_t* ssq, const f32x2 g2, bf16_t* Z, size_t rowbase, int t_start, int c0, int nrows, int col) {
    f32x2 ring[W]; f32x2 sum = (f32x2){0.f, 0.f};
#pragma unroll
    for (int j = 0; j < W; ++j) ring[j] = (f32x2){0.f, 0.f};
    for (int r = 0; r < nrows; r += 16) {
#pragma unroll
        for (int j = 0; j < 16; ++j) {
            const int t = t_start + r + j; const size_t row = rowbase + t;
            const unsigned xw = *(const GAS unsigned*)(h + row * DM + col);
            const f32x2 v = (f32x2){bflo(xw), bfhi(xw)} * rstd_of(ssq[row]) * g2;
            sum = sum + (v - ring[j % W]); ring[j % W] = v;
            if (t >= c0) { const float inv = 1.0f / (float)(t + 1 < W ? t + 1 : W); const f32x2 z = sum * inv - v; *(GAS unsigned*)(Z + row * DM + col) = cvt_pk_bf16(z.x, z.y); }
        }
    }
}
__device__ __forceinline__ void pool_phase(Frame& F, const bf16_t* h, const ssq_t* ssq, const float* gain, bf16_t* Z) {
    const int col = F.tid * 2; const f32x2 g2 = *(const f32x2*)(gain + col);
    for (int chunk = F.vcu; chunk < NBATCH * 16; chunk += F.G) {
        const int b = chunk >> 4, c0 = (chunk & 15) * 128, t_start = c0 ? c0 - 16 : 0, nrows = c0 + 128 - t_start; const size_t rowbase = (size_t)b * SEQ;
        const int grp = F.wave >> 1;
        if (grp == 0) pool_walk<2>(h, ssq, g2, Z, rowbase, t_start, c0, nrows, col);
        else if (grp == 1) pool_walk<4>(h, ssq, g2, Z, rowbase, t_start, c0, nrows, col);
        else if (grp == 2) pool_walk<8>(h, ssq, g2, Z, rowbase, t_start, c0, nrows, col);
        else pool_walk<16>(h, ssq, g2, Z, rowbase, t_start, c0, nrows, col);
    }
}
__device__ __forceinline__ void router_phase(Frame& F, const bf16_t* h, const ssq_t* ssq, const float* gain, const float* router, int* list, float* rsl, unsigned* tokinfo, unsigned* cntw) {
    LAS float* rt = (LAS float*)(F.lds + RING_OFF);
    LAS int* esel = (LAS int*)(F.lds + RING_OFF + 32768);
    LAS int* wt = (LAS int*)(F.lds + RING_OFF + 32768 + 2048);
    LAS int* base = (LAS int*)(F.lds + RING_OFF + 32768 + 2048 + 256);
    LAS float* rsd = (LAS float*)(F.lds + RING_OFF + 32768 + 2048 + 512);
    const int lane = F.lane;
    for (int idx = F.tid; idx < DM * NEXP; idx += NWAVES * 64) rt[(idx & 7) * DM + (idx >> 3)] = router[idx];
    f32x4 g[4];
#pragma unroll
    for (int j = 0; j < 4; ++j) g[j] = *(const f32x4*)(gain + lane * 4 + 256 * j);
    for (int chunk = F.vcu; chunk < NTOK / 256; chunk += F.G) {
        const int T0 = chunk * 256;
        __syncthreads();
        for (int i = 0; i < 32; ++i) {
            const int tl = F.wave * 32 + i, m = T0 + tl;
            const GAS u32x2* xr = (const GAS u32x2*)(h + (size_t)m * DM) + lane;
            const float rstd = rstd_of(ssq[m]);
            f32x4 v[4];
#pragma unroll
            for (int j = 0; j < 4; ++j) { const u32x2 w = xr[64 * j]; v[j] = (f32x4){bflo(w.x), bfhi(w.x), bflo(w.y), bfhi(w.y)} * rstd * g[j]; }
            float lg[8];
#pragma unroll
            for (int e = 0; e < 8; ++e) { float p = 0.f;
#pragma unroll
                for (int j = 0; j < 4; ++j) { const f32x4 r4 = *(const LAS f32x4*)(rt + e * DM + lane * 4 + 256 * j); p += (v[j].x * r4.x + v[j].y * r4.y) + (v[j].z * r4.z + v[j].w * r4.w); }
                lg[e] = wave_sum(p); }
            int e0 = 0; float l0 = lg[0];
#pragma unroll
            for (int e = 1; e < 8; ++e) if (lg[e] > l0) { l0 = lg[e]; e0 = e; }
            int e1 = e0 == 0 ? 1 : 0; float l1 = lg[e0 == 0 ? 1 : 0];
#pragma unroll
            for (int e = 0; e < 8; ++e) if (e != e0 && lg[e] > l1) { l1 = lg[e]; e1 = e; }
            const float g0 = 1.0f / (1.0f + __expf(l1 - l0)), g1 = 1.0f - g0;
            if (lane == 0) { esel[2 * tl] = e0; esel[2 * tl + 1] = e1; rsd[tl] = rstd; unsigned* ti = tokinfo + (size_t)m * 8;
                ti[0] = (unsigned)e0; ti[2] = __float_as_uint(g0); ti[4] = (unsigned)e1; ti[6] = __float_as_uint(g1); }
        }
        __syncthreads();
        const int me = esel[F.tid]; int myrank = 0;
#pragma unroll
        for (int e = 0; e < 8; ++e) { const unsigned long long mask = __ballot(me == e); if (me == e) myrank = __popcll(mask & ((1ull << lane) - 1ull)); if (lane == 0) wt[F.wave * 8 + e] = __popcll(mask); }
        __syncthreads();
        int off = 0;
        for (int w = 0; w < F.wave; ++w) off += wt[w * 8 + me];
        if (F.tid < 8) { int tot = 0; for (int w = 0; w < 8; ++w) tot += wt[w * 8 + F.tid]; base[F.tid] = (int)__hip_atomic_fetch_add(cntw + 64 * F.tid, (unsigned)tot, RLX_AGENT); }
        __syncthreads();
        const int rank = base[me] + off + myrank, tok = T0 + (F.tid >> 1);
        list[(size_t)me * NTOK + rank] = tok; rsl[(size_t)me * NTOK + rank] = rsd[F.tid >> 1];
        tokinfo[(size_t)tok * 8 + (F.tid & 1) * 4 + 1] = (unsigned)rank;
    }
}
template <bool GATHER>
struct MoeOrder {
    static constexpr size_t A_BLK = GATHER ? 0 : (size_t)256 * FFEP * 2, B_EXP = GATHER ? (size_t)2 * FFEP * DM * 2 : (size_t)DM * FFEP * 2, B_TILE = GATHER ? (size_t)256 * DM * 2 : (size_t)256 * FFEP * 2;
    static constexpr int NT = GATHER ? 2 * FFEP / 256 : DM / 256;
    const char* A; const char* B; const int* list; const unsigned* cntw; int G, c; unsigned bs[9];
    __device__ __forceinline__ void init(const unsigned* cntw_, const void* A_, const void* B_, const int* list_, int G_, int c_) {
        A = (const char*)A_; B = (const char*)B_; list = list_; cntw = cntw_; G = G_; c = c_; bs[0] = 0u;
#pragma unroll
        for (int e = 0; e < 8; ++e) { const unsigned ce = rfl(__hip_atomic_load((unsigned*)cntw + 64 * e, RLX_AGENT)); bs[e + 1] = bs[e] + ((ce + 255u) >> 8); }
    }
    __device__ __forceinline__ bool next(int i, pg8::Unit& u) const {
        const long L = (long)i * G + c; if (L >= (long)bs[8] * NT) return false;
        const unsigned blk = (unsigned)(L / NT); const int pn = (int)(L % NT);
        unsigned e = 0u, st = 0u;
#pragma unroll
        for (int k = 1; k < 8; ++k) if (blk >= bs[k]) { e = (unsigned)k; st = bs[k]; }
        const unsigned j = blk - st;
        u.b = B + (size_t)e * B_EXP + (size_t)pn * B_TILE; u.orow = (int)(blk * 256u); u.pn = pn; u.aux = (int)e;
        if constexpr (GATHER) { const unsigned ce = rfl(__hip_atomic_load((unsigned*)cntw + 64 * e, RLX_AGENT));
            u.a = A; u.rows = list + (size_t)e * NTOK + (size_t)j * 256; const unsigned rem = ce - j * 256u; u.nrows = rem < 256u ? (int)rem : 256; }
        else { u.a = A + (size_t)blk * A_BLK; u.rows = nullptr; u.nrows = 256; }
        return true;
    }
};
constexpr int NPHASE = 27;
struct Args { const float* in[20]; float* out; unsigned char* ws; int ph_lo, ph_hi, li, pad; };
#ifndef MK_REP_MASK
#define MK_REP_MASK 0
#endif
#ifndef MK_REP_N
#define MK_REP_N 1
#endif
constexpr int PT_OFF = LDSCTL_OFF + 512;
__device__ __forceinline__ unsigned long long ptab_u64(LAS unsigned char* L, int i) {
    const volatile LAS unsigned* p = (const volatile LAS unsigned*)(L + PT_OFF + 8 * i); const unsigned lo = rfl(p[0]), hi = rfl(p[1]); return ((unsigned long long)hi << 32) | lo; }
__device__ __forceinline__ const float* ptab(LAS unsigned char* L, int i) { return (const float*)ptab_u64(L, i); }
__device__ __forceinline__ Frame make_frame(LAS unsigned char* L) {
    Frame F; F.lds = L; F.MISC = (volatile LAS unsigned*)(L + MISC_OFF); F.tid = launder_v((int)threadIdx.x); F.lane = F.tid & 63; F.wave = __builtin_amdgcn_readfirstlane(F.tid >> 6);
    F.G = gridDim.x; { const int bx = blockIdx.x; F.vcu = (F.G % 8 == 0) ? (bx % 8) * (F.G / 8) + bx / 8 : bx; }
    F.ws = (unsigned char*)ptab_u64(L, 21); F.ctl = (gu32*)(F.ws + WS_CTL); return F;
}
__global__ void __launch_bounds__(NWAVES * 64, 2) fwd(Args args) {
    extern __shared__ __attribute__((aligned(16))) unsigned char lds[];
    LAS unsigned char* L = (LAS unsigned char*)lds;
    { const int tid = threadIdx.x;
      for (int u = tid; u < (LDS_BYTES - LDSCTL_OFF) / 4; u += NWAVES * 64) ((LAS unsigned*)(L + LDSCTL_OFF))[u] = 0u;
      __syncthreads();
      if (tid < 20) *(LAS unsigned long long*)(L + PT_OFF + 8 * tid) = (unsigned long long)args.in[tid];
      if (tid == 20) *(LAS unsigned long long*)(L + PT_OFF + 8 * 20) = (unsigned long long)args.out;
      if (tid == 21) *(LAS unsigned long long*)(L + PT_OFF + 8 * 21) = (unsigned long long)args.ws;
      if (tid == 22) *(LAS unsigned long long*)(L + PT_OFF + 8 * 22) = (unsigned long long)args.pad;
      __syncthreads(); }
    const int lo = args.ph_lo, hi = args.ph_hi;
    XcdBarrier bar; { gu32* ctl = (gu32*)(args.ws + WS_CTL); bar.bar = (unsigned*)(ctl + CW_BAR) + args.li * XCD_BAR_WORDS; bar.x = 0; bar.st = nullptr;
      if (threadIdx.x == 0) { const unsigned long long ba = (unsigned long long)((unsigned*)(ctl + CW_BAR) + args.li * XCD_BAR_WORDS); ((volatile LAS unsigned*)(L + MISC_OFF))[10] = (unsigned)ba; ((volatile LAS unsigned*)(L + MISC_OFF))[11] = (unsigned)(ba >> 32); }
      if (hi - lo > 1) bar = xcd_barrier_post((unsigned*)(ctl + CW_BAR) + args.li * XCD_BAR_WORDS, (volatile LAS unsigned*)(L + MISC_OFF) + 8);
      __syncthreads(); }
#ifndef MK_ONLY
#define MK_ONLY (-1)
#endif
#define KIND(k) ((k) == 0 ? 0 : 1 + ((k) - 1) % 13)
#ifndef MK_SKIPMASK
#define MK_SKIPMASK 0
#endif
#define IN(k) ((MK_ONLY < 0 || KIND(k) == MK_ONLY) && !((MK_SKIPMASK >> KIND(k)) & 1) && lo <= (k) && (k) < hi)
#define FORREP(k)
#if MK_REP_MASK
#define LASTREP (ptab_u64(L, 22) == 0ull)
#else
#define LASTREP true
#endif
#define SEAM(k) do { if ((k) + 1 < hi) xcd_barrier(bar); } while (0)
#define WSP(off) ((bf16_t*)(F.ws + (off)))
#define SSQ(i) ((ssq_t*)(F.ws + WS_SSQ) + (size_t)(i) * NTOK)
    LAS unsigned char* ring = L + RING_OFF;

    if (IN(0)) FORREP(0) { Frame F = make_frame(L); p0_prologue(F); SEAM(0); }

    for (int lp = 0; lp < 2; ++lp) {
        const int pb = 1 + 13 * lp;
        if (IN(pb + 0)) FORREP(pb + 0) { Frame F = make_frame(L);
            pg8::RegOrder S; S.init(WSP(WS_H), DM * 2, WSP(WS_WDN) + (size_t)lp * NDOWNP * DM, DM * 2, NTOK, NDOWNP, F.G, (int)blockIdx.x);
            pg8::EpiDown E{WSP(WS_DOWN), WSP(WS_KR), SSQ(4 * lp + 0), SSQ(10 + 2 * lp), SSQ(11 + 2 * lp), (const float*)(F.ws + WS_COS), (const float*)(F.ws + WS_SIN)};
            pg8::gemm_phase<pg8::EpiDown, pg8::RegOrder, false>(ring, DM * 2, DM * 2, DM, S, E);
            SEAM(pb + 0);
        }
        if (IN(pb + 1)) FORREP(pb + 1) { Frame F = make_frame(L);
            pg8::RegOrder S; S.init(WSP(WS_DOWN), NDOWNP * 2, WSP(WS_WUQ) + (size_t)lp * NQ * QLR, QLR * 2, NTOK, NQ, F.G, (int)blockIdx.x);
            pg8::EpiQ E{WSP(WS_Q), (const float*)(F.ws + WS_COS), (const float*)(F.ws + WS_SIN), SSQ(10 + 2 * lp)};
            pg8::gemm_phase<pg8::EpiQ, pg8::RegOrder, false>(ring, NDOWNP * 2, QLR * 2, QLR, S, E);
            SEAM(pb + 1);
        }
        if (IN(pb + 2)) FORREP(pb + 2) { Frame F = make_frame(L);
            pg8::RegOrder S; S.init(WSP(WS_DOWN) + QLR, NDOWNP * 2, WSP(WS_WUKV) + (size_t)lp * NKV * KVLR, KVLR * 2, NTOK, NKV, F.G, (int)blockIdx.x);
            pg8::EpiBf16<2> E{WSP(WS_KNV), NKV, SSQ(11 + 2 * lp)};
            pg8::gemm_phase<pg8::EpiBf16<2>, pg8::RegOrder, false>(ring, NDOWNP * 2, KVLR * 2, KVLR, S, E);
            SEAM(pb + 2);
        }
        if (IN(pb + 3)) FORREP(pb + 3) { Frame F = make_frame(L); att::attn_phase((char*)lds + RING_OFF, WSP(WS_Q), WSP(WS_KNV), WSP(WS_KR), WSP(WS_DOWN), F.vcu, F.G); SEAM(pb + 3); }
        if (IN(pb + 4)) FORREP(pb + 4) { Frame F = make_frame(L);
            pg8::RegOrder S; S.init(WSP(WS_DOWN), DM * 2, WSP(WS_WO) + (size_t)lp * DM * DM, DM * 2, NTOK, DM, F.G, (int)blockIdx.x);
            pg8::EpiResidH E{WSP(WS_H), LASTREP ? WSP(WS_H) : WSP(WS_DUMMY), LASTREP ? SSQ(4 * lp + 1) : SSQ(9)};
            pg8::gemm_phase<pg8::EpiResidH, pg8::RegOrder, false>(ring, DM * 2, DM * 2, DM, S, E);
            SEAM(pb + 4);
        }
        if (IN(pb + 5)) FORREP(pb + 5) { Frame F = make_frame(L);
            pg8::RegOrder S; S.init(WSP(WS_H), DM * 2, WSP(WS_WGU) + (size_t)lp * 2 * FFD * DM, DM * 2, NTOK, 2 * FFD, F.G, (int)blockIdx.x);
            pg8::EpiSwiglu<1> E{WSP(WS_HID), FFD, SSQ(4 * lp + 1), nullptr};
            pg8::gemm_phase<pg8::EpiSwiglu<1>, pg8::RegOrder, false>(ring, DM * 2, DM * 2, DM, S, E);
            SEAM(pb + 5);
        }
        if (IN(pb + 6)) FORREP(pb + 6) { Frame F = make_frame(L);
            pg8::RegOrder S; S.init(WSP(WS_HID), FFD * 2, WSP(WS_WD) + (size_t)lp * DM * FFD, FFD * 2, NTOK, DM, F.G, (int)blockIdx.x);
            pg8::EpiResidH E{WSP(WS_H), LASTREP ? WSP(WS_H) : WSP(WS_DUMMY), LASTREP ? SSQ(4 * lp + 2) : SSQ(9)};
            pg8::gemm_phase<pg8::EpiResidH, pg8::RegOrder, false>(ring, FFD * 2, FFD * 2, FFD, S, E);
            SEAM(pb + 6);
        }
        if (IN(pb + 7)) FORREP(pb + 7) { Frame F = make_frame(L); pool_phase(F, WSP(WS_H), SSQ(4 * lp + 2), ptab(L, 2) + (size_t)(2 * lp + 1) * DM, WSP(WS_DOWN)); SEAM(pb + 7); }
        if (IN(pb + 8)) FORREP(pb + 8) { Frame F = make_frame(L);
            pg8::RegOrder S; S.init(WSP(WS_DOWN), DM * 2, WSP(WS_WPOOL) + (size_t)lp * 4 * 256 * 256, 256 * 2, NTOK, DM, F.G, (int)blockIdx.x, 256 * 2);
            pg8::EpiResidH E{WSP(WS_H), LASTREP ? WSP(WS_H) : WSP(WS_DUMMY), LASTREP ? SSQ(4 * lp + 3) : SSQ(9)};
            pg8::gemm_phase<pg8::EpiResidH, pg8::RegOrder, false>(ring, DM * 2, 256 * 2, 256, S, E);
            SEAM(pb + 8);
        }
        if (IN(pb + 9)) FORREP(pb + 9) { Frame F = make_frame(L);
            router_phase(F, WSP(WS_H), SSQ(4 * lp + 3), ptab(L, 3) + (size_t)(2 * lp + 1) * DM, ptab(L, 15) + (size_t)lp * DM * NEXP, (int*)(F.ws + WS_LIST), (float*)(F.ws + WS_RSL), (unsigned*)(F.ws + WS_TOKINFO), (unsigned*)(F.ctl + CW_CNT) + lp * 8 * 64); SEAM(pb + 9); }
        if (IN(pb + 10)) FORREP(pb + 10) { Frame F = make_frame(L);
            MoeOrder<true> S; S.init((unsigned*)(F.ctl + CW_CNT) + lp * 8 * 64, WSP(WS_H), WSP(WS_MWGU) + (size_t)lp * 8 * 2 * FFEP * DM, (const int*)(F.ws + WS_LIST), F.G, (int)blockIdx.x);
            pg8::EpiSwiglu<2> E{WSP(WS_HID), FFEP, (const float*)(F.ws + WS_RSL), (const int*)(F.ws + WS_LIST)};
            pg8::gemm_phase<pg8::EpiSwiglu<2>, MoeOrder<true>, true>(ring, DM * 2, DM * 2, DM, S, E);
            SEAM(pb + 10);
        }
        if (IN(pb + 11)) FORREP(pb + 11) { Frame F = make_frame(L);
            MoeOrder<false> S; S.init((unsigned*)(F.ctl + CW_CNT) + lp * 8 * 64, WSP(WS_HID), WSP(WS_MWD) + (size_t)lp * 8 * DM * FFEP, (const int*)(F.ws + WS_LIST), F.G, (int)blockIdx.x);
            pg8::EpiBf16<0> E{WSP(WS_YB), DM, nullptr};
            pg8::gemm_phase<pg8::EpiBf16<0>, MoeOrder<false>, false>(ring, FFEP * 2, FFEP * 2, FFEP, S, E);
            SEAM(pb + 11);
        }
        if (IN(pb + 12)) FORREP(pb + 12) { Frame F = make_frame(L);
            if (lp == 0) combine_phase<false>(F, WSP(WS_H), WSP(WS_YB), (const unsigned*)(F.ws + WS_TOKINFO), (unsigned*)(F.ctl + CW_CNT), SSQ(4), nullptr, nullptr);
            else combine_phase<true>(F, WSP(WS_H), WSP(WS_YB), (const unsigned*)(F.ws + WS_TOKINFO), (unsigned*)(F.ctl + CW_CNT) + 8 * 64, nullptr, ptab(L, 19), (float*)ptab(L, 20));
            SEAM(pb + 12);
        }
    }
#undef IN
#undef SEAM
#undef WSP
#undef SSQ
}

#ifndef MK_PER_PHASE
#define MK_PER_PHASE 0
#endif
extern "C" void kernel_launch(void* const* d_in, const int* in_sizes, int n_in, void* d_out, int out_size, void* d_ws, size_t ws_size, hipStream_t stream) {
    static int grid = 0;
    if (grid == 0) {
        if (n_in != 20 || in_sizes[0] != NTOK * DM || out_size != NTOK * DM || ws_size < WS_END) { fprintf(stderr, "kernel_launch: unexpected shapes (n_in %d, in0 %d, out %d, ws %zu < %zu)\n", n_in, n_in > 0 ? in_sizes[0] : -1, out_size, ws_size, (size_t)WS_END); grid = -1; return; }
        int dev = 0, cus = 0, per_cu = 0;
        if (hipGetDevice(&dev) != hipSuccess || hipDeviceGetAttribute(&cus, hipDeviceAttributeMultiprocessorCount, dev) != hipSuccess) { grid = -1; return; }
        if (hipFuncSetAttribute((const void*)fwd, hipFuncAttributeMaxDynamicSharedMemorySize, LDS_BYTES) != hipSuccess) { fprintf(stderr, "kernel_launch: hipFuncSetAttribute failed\n"); grid = -1; return; }
        if (hipOccupancyMaxActiveBlocksPerMultiprocessor(&per_cu, (const void*)fwd, NWAVES * 64, LDS_BYTES) != hipSuccess || per_cu < 1) fprintf(stderr, "kernel_launch: occupancy query reports %d\n", per_cu);
        (void)hipGetLastError();
        grid = cus;
    }
    if (grid < 0) return;
    if (hipMemsetAsync((char*)d_ws + WS_CTL, 0, CTL_ZERO_BYTES, stream) != hipSuccess) return;
    Args a{};
    for (int i = 0; i < 20; ++i) a.in[i] = (const float*)d_in[i];
    a.out = (float*)d_out; a.ws = (unsigned char*)d_ws;
#if MK_PER_PHASE
    for (int p = 0; p < NPHASE; ++p) { a.ph_lo = p; a.ph_hi = p + 1; a.li = 0; hipLaunchKernelGGL(fwd, dim3(grid), dim3(NWAVES * 64), LDS_BYTES, stream, a); }
#elif MK_REP_MASK
    { int cur = 0, li = 0;
      for (int k = 0; k < NPHASE; ++k) if ((MK_REP_MASK >> (k == 0 ? 0 : 1 + (k - 1) % 13)) & 1) {
          if (k > cur) { a.ph_lo = cur; a.ph_hi = k; a.li = li++; a.pad = 0; hipLaunchKernelGGL(fwd, dim3(grid), dim3(NWAVES * 64), LDS_BYTES, stream, a); }
          for (int r = 1; r < MK_REP_N; ++r) { a.ph_lo = k; a.ph_hi = k + 1; a.li = li++; a.pad = 1; hipLaunchKernelGGL(fwd, dim3(grid), dim3(NWAVES * 64), LDS_BYTES, stream, a); }
          cur = k; }
      a.ph_lo = cur; a.ph_hi = NPHASE; a.li = li++; a.pad = 0; hipLaunchKernelGGL(fwd, dim3(grid), dim3(NWAVES * 64), LDS_BYTES, stream, a); }
#else
    a.ph_lo = 0; a.ph_hi = NPHASE; a.li = 0;
    hipLaunchKernelGGL(fwd, dim3(grid), dim3(NWAVES * 64), LDS_BYTES, stream, a);
#endif
}
```

```cpp
#include <hip/hip_runtime.h>
#include <cstdio>
#include <cstdint>

#define GAS __attribute__((address_space(1)))
#define LAS __attribute__((address_space(3)))
typedef unsigned short bf16_t;
typedef short bf16x8 __attribute__((ext_vector_type(8)));
typedef short s16x4 __attribute__((ext_vector_type(4)));
typedef float f32x2 __attribute__((ext_vector_type(2)));
typedef float f32x4 __attribute__((ext_vector_type(4)));
typedef float f32x16 __attribute__((ext_vector_type(16)));
typedef unsigned u32x2 __attribute__((ext_vector_type(2)));
typedef unsigned u32x4 __attribute__((ext_vector_type(4)));

constexpr int DM = 1024, NBATCH = 32, SEQ = 2048, NTOK = NBATCH * SEQ;
constexpr int NHEAD = 8, DNOPE = 128, DROPE = 64, DVH = 128, DQH = DNOPE + DROPE, QLR = 512, KVLR = 256;
constexpr int NDOWN = QLR + KVLR + DROPE  , NDOWNP = 1024;
constexpr int NQ = NHEAD * DQH  , NKV = NHEAD * (DNOPE + DVH)  ;
constexpr int FFD = 2688, NEXP = 8, FFE = 1344, FFEP = 1408;
constexpr int PSLOT = (NTOK * 2 / 256 + NEXP) * 256;
constexpr float RMS_EPS = 1e-6f;

__device__ __forceinline__ unsigned cvt_pk_bf16(float lo, float hi) { unsigned r; asm volatile("v_cvt_pk_bf16_f32 %0, %1, %2" : "=v"(r) : "v"(lo), "v"(hi)); return r; }
__device__ __forceinline__ int launder_v(int v) { asm volatile("" : "+v"(v)); return v; }
__device__ __forceinline__ float bf2f(unsigned short b) { return __uint_as_float((unsigned)b << 16); }
__device__ __forceinline__ float bflo(unsigned w) { return __uint_as_float(w << 16); }
__device__ __forceinline__ float bfhi(unsigned w) { return __uint_as_float(w & 0xffff0000u); }

typedef unsigned long long ssq_t;
__device__ __forceinline__ ssq_t ssq_fix(float s) { return (ssq_t)(s * 16777216.0f); }
__device__ __forceinline__ float rstd_n(ssq_t q, float invn) { return 1.0f / sqrtf((float)q * (1.0f / 16777216.0f) * invn + RMS_EPS); }
__device__ __forceinline__ float rstd_of(ssq_t q) { return rstd_n(q, 1.0f / DM); }
__device__ __forceinline__ float rstd_f(float ssq) { return 1.0f / sqrtf(ssq * (1.0f / DM) + RMS_EPS); }

namespace pg8 {
constexpr int BM = 256, BK = 64, HALF = 128, HTB = HALF * BK * 2  , STAGE_BYTES = 8 * HTB, NXCD = 8, WGM = 8;
__host__ __device__ __forceinline__ int lds_byte(int r, int c) { const int st = (r >> 4) * 2 + (c >> 5), rr = r & 15, cc = c & 31, ob = rr * 64 + cc * 2; return st * 1024 + (ob ^ (((ob >> 9) & 1) << 5)); }
__host__ __device__ __forceinline__ void stage_rc(int b, int& R, int& C) { const int st = b / 1024, sb = b % 1024, swz = sb ^ (((sb >> 9) & 1) << 5); R = (st >> 1) * 16 + swz / 64; C = (st & 1) * 32 + (swz % 64) / 2; }
__host__ __device__ __forceinline__ int perm32(int rho) { const int n = rho >> 4, i = rho & 15; return 8 * (i >> 2) + 4 * n + (i & 3); }

struct Unit { const char* a; const char* b; const int* rows; int nrows; int orow; int pn; int aux; };

struct RegOrder {
    const char* A; const char* B; unsigned a_tile, b_tile, a_colstep; int nM, nN, nwg, G, c;
    __device__ __forceinline__ void init(const void* A_, size_t lda_b, const void* B_, size_t ldb_b, int M, int N, int G_, int c_, size_t a_colstep_ = 0) {
        A = (const char*)A_; B = (const char*)B_; a_tile = (unsigned)(256 * lda_b); b_tile = (unsigned)(256 * ldb_b); a_colstep = (unsigned)a_colstep_; nM = M / BM; nN = N / BM; nwg = nM * nN; G = G_; c = c_; }
    __device__ __forceinline__ bool next(int i, Unit& u) const {
        const long L = (long)i * G + c; if (L >= nwg) return false;
        int wgid = (int)L; { const int q = nwg / NXCD, r = nwg % NXCD, xcd = wgid % NXCD, off = wgid / NXCD; wgid = (xcd < r ? xcd * (q + 1) : r * (q + 1) + (xcd - r) * q) + off; }
        const int nig = WGM * nN, gid = wgid / nig, fm = gid * WGM, gsz = (nM - fm) < WGM ? (nM - fm) : WGM;
        const int pm = fm + ((wgid % nig) % gsz), pn = (wgid % nig) / gsz;
        u.a = A + (size_t)pm * a_tile + (size_t)pn * a_colstep; u.b = B + (size_t)pn * b_tile; u.rows = nullptr; u.nrows = 256; u.orow = pm * BM; u.pn = pn; u.aux = 0; return true;
    }
};

template <int RS> struct EpiBf16 {
    static constexpr bool PERM = true;
    bf16_t* O; int ldc; const ssq_t* rs;
    __device__ __forceinline__ void operator()(const f32x4 (&acc)[2][2][4][2], const Unit& u, int wr, int wc, int fr, int fq) const {
        const int row0 = u.orow + wr * 64 + fr, col0 = u.pn * BM + wc * 32 + 8 * fq;
        float sc[2][4];
#pragma unroll
        for (int ai = 0; ai < 2; ++ai)
#pragma unroll
            for (int m = 0; m < 4; ++m) { const int row = row0 + ai * HALF + m * 16; sc[ai][m] = 1.0f; if constexpr (RS == 1) sc[ai][m] = rstd_of(rs[row]); if constexpr (RS == 2) sc[ai][m] = rstd_n(rs[row], 1.0f / KVLR); }
#pragma unroll
        for (int ai = 0; ai < 2; ++ai)
#pragma unroll
            for (int m = 0; m < 4; ++m) { const int row = row0 + ai * HALF + m * 16; bf16_t* rowp = O + (size_t)row * ldc + col0;
#pragma unroll
                for (int bj = 0; bj < 2; ++bj) { const f32x4 v0 = acc[ai][bj][m][0] * sc[ai][m], v1 = acc[ai][bj][m][1] * sc[ai][m];
                    u32x4 w; w.x = cvt_pk_bf16(v0[0], v0[1]); w.y = cvt_pk_bf16(v0[2], v0[3]); w.z = cvt_pk_bf16(v1[0], v1[1]); w.w = cvt_pk_bf16(v1[2], v1[3]);
                    *(u32x4*)(rowp + bj * HALF) = w; } }
    }
};
__device__ __forceinline__ float silu_mul(float g, float u) { return g * u * __builtin_amdgcn_rcpf(1.0f + __builtin_amdgcn_exp2f(-1.4426950408889634f * g)); }
template <int RS> struct EpiSwiglu {
    static constexpr bool PERM = true;
    bf16_t* H; int ldh; const void* rs; const int* list;
    __device__ __forceinline__ void operator()(const f32x4 (&acc)[2][2][4][2], const Unit& u, int wr, int wc, int fr, int fq) const {
        const int r0 = wr * 64 + fr, col0 = u.pn * HALF + wc * 32 + 8 * fq;
        const ssq_t* rsq = (const ssq_t*)rs; const float* rsp = (const float*)rs; if constexpr (RS == 2) rsp = rsp + (u.rows - list);
        float sc[2][4];
#pragma unroll
        for (int ai = 0; ai < 2; ++ai)
#pragma unroll
            for (int m = 0; m < 4; ++m) { const int r = r0 + ai * HALF + m * 16; if constexpr (RS == 1) sc[ai][m] = rstd_of(rsq[u.orow + r]); else sc[ai][m] = rsp[r]; }
#pragma unroll
        for (int ai = 0; ai < 2; ++ai)
#pragma unroll
            for (int m = 0; m < 4; ++m) { const int r = r0 + ai * HALF + m * 16; bf16_t* rowp = H + (size_t)(u.orow + r) * ldh + col0; const float s = sc[ai][m];
                const f32x4 g0 = acc[ai][0][m][0] * s, g1 = acc[ai][0][m][1] * s, u0 = acc[ai][1][m][0] * s, u1 = acc[ai][1][m][1] * s;
                u32x4 w; w.x = cvt_pk_bf16(silu_mul(g0[0], u0[0]), silu_mul(g0[1], u0[1])); w.y = cvt_pk_bf16(silu_mul(g0[2], u0[2]), silu_mul(g0[3], u0[3]));
                w.z = cvt_pk_bf16(silu_mul(g1[0], u1[0]), silu_mul(g1[1], u1[1])); w.w = cvt_pk_bf16(silu_mul(g1[2], u1[2]), silu_mul(g1[3], u1[3]));
                *(u32x4*)rowp = w; }
    }
};
struct EpiResidH {
    static constexpr bool PERM = true;
    const bf16_t* hin; bf16_t* hout; ssq_t* ssq;
    __device__ __forceinline__ void operator()(const f32x4 (&acc)[2][2][4][2], const Unit& u, int wr, int wc, int fr, int fq) const {
        const int row0 = u.orow + wr * 64 + fr, col0 = u.pn * BM + wc * 32 + 8 * fq;
#pragma unroll
        for (int ai = 0; ai < 2; ++ai) {
            u32x4 hv[4][2];
#pragma unroll
            for (int m = 0; m < 4; ++m)
#pragma unroll
                for (int bj = 0; bj < 2; ++bj) hv[m][bj] = *(const u32x4*)(hin + (size_t)(row0 + ai * HALF + m * 16) * DM + col0 + bj * HALF);
#pragma unroll
            for (int m = 0; m < 4; ++m) { const int row = row0 + ai * HALF + m * 16; const size_t off = (size_t)row * DM + col0; float part = 0.f;
#pragma unroll
                for (int bj = 0; bj < 2; ++bj) { const u32x4 h4 = hv[m][bj]; const f32x4 a0 = acc[ai][bj][m][0], a1 = acc[ai][bj][m][1];
                    const float y0 = bflo(h4.x) + a0[0], y1 = bfhi(h4.x) + a0[1], y2 = bflo(h4.y) + a0[2], y3 = bfhi(h4.y) + a0[3], y4 = bflo(h4.z) + a1[0], y5 = bfhi(h4.z) + a1[1], y6 = bflo(h4.w) + a1[2], y7 = bfhi(h4.w) + a1[3];
                    part += (y0 * y0 + y1 * y1) + (y2 * y2 + y3 * y3) + (y4 * y4 + y5 * y5) + (y6 * y6 + y7 * y7);
                    u32x4 w; w.x = cvt_pk_bf16(y0, y1); w.y = cvt_pk_bf16(y2, y3); w.z = cvt_pk_bf16(y4, y5); w.w = cvt_pk_bf16(y6, y7);
                    *(u32x4*)(hout + off + bj * HALF) = w; }
                part += __shfl_xor(part, 16); part += __shfl_xor(part, 32);
                if (fq == 0) atomicAdd(ssq + row, ssq_fix(part)); }
        }
    }
};
struct EpiDown {
    static constexpr bool PERM = true;
    bf16_t* O; bf16_t* KR; const ssq_t* rs; ssq_t* ssq_q; ssq_t* ssq_kv; const float* cosT; const float* sinT;
    __device__ __forceinline__ void operator()(const f32x4 (&acc)[2][2][4][2], const Unit& u, int wr, int wc, int fr, int fq) const {
        const int row0 = u.orow + wr * 64 + fr;
        float sc[2][4];
#pragma unroll
        for (int ai = 0; ai < 2; ++ai)
#pragma unroll
            for (int m = 0; m < 4; ++m) sc[ai][m] = rstd_of(rs[row0 + ai * HALF + m * 16]);
        if (u.pn < 3) {
            ssq_t* sq = u.pn < 2 ? ssq_q : ssq_kv; const int col0 = u.pn * BM + wc * 32 + 8 * fq;
#pragma unroll
            for (int ai = 0; ai < 2; ++ai)
#pragma unroll
                for (int m = 0; m < 4; ++m) { const int row = row0 + ai * HALF + m * 16; bf16_t* rowp = O + (size_t)row * NDOWNP + col0; const float s = sc[ai][m]; float part = 0.f;
#pragma unroll
                    for (int bj = 0; bj < 2; ++bj) { const f32x4 v0 = acc[ai][bj][m][0] * s, v1 = acc[ai][bj][m][1] * s;
                        part += (v0[0] * v0[0] + v0[1] * v0[1]) + (v0[2] * v0[2] + v0[3] * v0[3]) + (v1[0] * v1[0] + v1[1] * v1[1]) + (v1[2] * v1[2] + v1[3] * v1[3]);
                        u32x4 w; w.x = cvt_pk_bf16(v0[0], v0[1]); w.y = cvt_pk_bf16(v0[2], v0[3]); w.z = cvt_pk_bf16(v1[0], v1[1]); w.w = cvt_pk_bf16(v1[2], v1[3]);
                        *(u32x4*)(rowp + bj * HALF) = w; }
                    part += __shfl_xor(part, 16); part += __shfl_xor(part, 32);
                    if (fq == 0) atomicAdd(sq + row, ssq_fix(part)); }
        } else if (wc == 0) {
#pragma unroll
            for (int aq = 0; aq < 4; ++aq) { const int ai = aq >> 1, mb = (aq & 1) * 2; f32x4 ct[4][2], st[4][2];
#pragma unroll
                for (int m = mb; m < mb + 2; ++m) { const size_t to = (size_t)(row0 + ai * HALF + m * 16) * 32 + 8 * fq;
                    ct[m][0] = *(const f32x4*)(cosT + to); ct[m][1] = *(const f32x4*)(cosT + to + 4); st[m][0] = *(const f32x4*)(sinT + to); st[m][1] = *(const f32x4*)(sinT + to + 4); }
#pragma unroll
                for (int m = mb; m < mb + 2; ++m) { const int row = row0 + ai * HALF + m * 16; const float s = sc[ai][m];
                    const f32x4 a0 = acc[ai][0][m][0] * s, a1 = acc[ai][0][m][1] * s, b0 = acc[ai][1][m][0] * s, b1 = acc[ai][1][m][1] * s;
                    const f32x4 x0 = a0 * ct[m][0] - b0 * st[m][0], x1 = a1 * ct[m][1] - b1 * st[m][1], y0 = b0 * ct[m][0] + a0 * st[m][0], y1 = b1 * ct[m][1] + a1 * st[m][1];
                    bf16_t* rp = KR + (size_t)row * DROPE + 8 * fq;
                    u32x4 w; w.x = cvt_pk_bf16(x0[0], x0[1]); w.y = cvt_pk_bf16(x0[2], x0[3]); w.z = cvt_pk_bf16(x1[0], x1[1]); w.w = cvt_pk_bf16(x1[2], x1[3]);
                    *(u32x4*)rp = w;
                    w.x = cvt_pk_bf16(y0[0], y0[1]); w.y = cvt_pk_bf16(y0[2], y0[3]); w.z = cvt_pk_bf16(y1[0], y1[1]); w.w = cvt_pk_bf16(y1[2], y1[3]);
                    *(u32x4*)(rp + 32) = w; } }
        }
    }
};
struct EpiQ {
    static constexpr bool PERM = true;
    bf16_t* Q; const float* cosT; const float* sinT; const ssq_t* rs;
    __device__ __forceinline__ void operator()(const f32x4 (&acc)[2][2][4][2], const Unit& u, int wr, int wc, int fr, int fq) const {
        const int row0 = u.orow + wr * 64 + fr;
        float sc[2][4];
#pragma unroll
        for (int ai = 0; ai < 2; ++ai)
#pragma unroll
            for (int m = 0; m < 4; ++m) sc[ai][m] = rstd_n(rs[row0 + ai * HALF + m * 16], 1.0f / QLR);
        if (u.pn < 2) {
            const int h = 4 * u.pn + wc;
#pragma unroll
            for (int aq = 0; aq < 4; ++aq) { const int ai = aq >> 1, mb = (aq & 1) * 2; f32x4 ct[4][2], st[4][2];
#pragma unroll
                for (int m = mb; m < mb + 2; ++m) { const size_t to = (size_t)(row0 + ai * HALF + m * 16) * 32 + 8 * fq;
                    ct[m][0] = *(const f32x4*)(cosT + to); ct[m][1] = *(const f32x4*)(cosT + to + 4); st[m][0] = *(const f32x4*)(sinT + to); st[m][1] = *(const f32x4*)(sinT + to + 4); }
#pragma unroll
                for (int m = mb; m < mb + 2; ++m) { const int row = row0 + ai * HALF + m * 16; const float s = sc[ai][m];
                    const f32x4 a0 = acc[ai][0][m][0] * s, a1 = acc[ai][0][m][1] * s, b0 = acc[ai][1][m][0] * s, b1 = acc[ai][1][m][1] * s;
                    const f32x4 x0 = a0 * ct[m][0] - b0 * st[m][0], x1 = a1 * ct[m][1] - b1 * st[m][1], y0 = b0 * ct[m][0] + a0 * st[m][0], y1 = b1 * ct[m][1] + a1 * st[m][1];
                    bf16_t* rp = Q + (size_t)row * NQ + h * DQH + DNOPE + 8 * fq;
                    u32x4 w; w.x = cvt_pk_bf16(x0[0], x0[1]); w.y = cvt_pk_bf16(x0[2], x0[3]); w.z = cvt_pk_bf16(x1[0], x1[1]); w.w = cvt_pk_bf16(x1[2], x1[3]);
                    *(u32x4*)rp = w;
                    w.x = cvt_pk_bf16(y0[0], y0[1]); w.y = cvt_pk_bf16(y0[2], y0[3]); w.z = cvt_pk_bf16(y1[0], y1[1]); w.w = cvt_pk_bf16(y1[2], y1[3]);
                    *(u32x4*)(rp + 32) = w; } }
        } else {
#pragma unroll
            for (int ai = 0; ai < 2; ++ai)
#pragma unroll
                for (int m = 0; m < 4; ++m) { const int row = row0 + ai * HALF + m * 16; const float s = sc[ai][m];
#pragma unroll
                    for (int bj = 0; bj < 2; ++bj) { const int h = 2 * (u.pn - 2) + bj; const f32x4 v0 = acc[ai][bj][m][0] * s, v1 = acc[ai][bj][m][1] * s;
                        u32x4 w; w.x = cvt_pk_bf16(v0[0], v0[1]); w.y = cvt_pk_bf16(v0[2], v0[3]); w.z = cvt_pk_bf16(v1[0], v1[1]); w.w = cvt_pk_bf16(v1[2], v1[3]);
                        *(u32x4*)(Q + (size_t)row * NQ + h * DQH + wc * 32 + 8 * fq) = w; } }
        }
    }
};

__device__ __forceinline__ unsigned gather_off(const Unit& u, int idx, unsigned lda_b, unsigned cb) { const int tok = idx < u.nrows ? u.rows[idx] : 0; return (unsigned)tok * lda_b + cb; }
__device__ __forceinline__ u32x4 gather_offs(const Unit& u, int tid, unsigned lda_b) {
    const int t2 = launder_v(tid); int R0, C0, R1, C1; stage_rc(t2 * 16, R0, C0); stage_rc(t2 * 16 + 8192, R1, C1);
    u32x4 pk; pk.x = gather_off(u, R0, lda_b, (unsigned)C0 * 2u); pk.y = gather_off(u, R1, lda_b, (unsigned)C1 * 2u); pk.z = gather_off(u, HALF + R0, lda_b, (unsigned)C0 * 2u); pk.w = gather_off(u, HALF + R1, lda_b, (unsigned)C1 * 2u);
    return pk;
}
template <class Epi, class Sched, bool GATHER>
__device__ __forceinline__ void gemm_phase(LAS unsigned char* lds, const unsigned lda_b, const unsigned ldb_b, const int K, const Sched& S, const Epi& E) {
    const int tid = launder_v((int)threadIdx.x), wid = __builtin_amdgcn_readfirstlane(tid >> 6), lane = tid & 63, wr = wid >> 2, wc = wid & 3, fr = lane & 15, fq = lane >> 4;
    const int nt = K / BK;
    unsigned voffA[2], voffB[2];
#pragma unroll
    for (int i = 0; i < 2; ++i) { int R, C; stage_rc(tid * 16 + i * 8192, R, C); const int Rb = Epi::PERM ? ((R & ~31) + perm32(R & 31)) : R;
        voffA[i] = (unsigned)R * lda_b + (unsigned)C * 2u; voffB[i] = (unsigned)Rb * ldb_b + (unsigned)C * 2u; }
    const size_t kstep = (size_t)(BK * 2);
    const size_t hstepA = (size_t)HALF * lda_b, hstepB = (size_t)HALF * ldb_b;
    const unsigned ldsw = (unsigned)wid * 1024u;
    const int aoff = lds_byte(wr * 64 + fr, fq * 8), boff = lds_byte(wc * 32 + fr, fq * 8);
    unsigned cv0[2] = {0u, 0u}, cv1[2] = {0u, 0u}, nv0[2] = {0u, 0u}, nv1[2] = {0u, 0u};
#define PG8_SA(b, h) (((b) * 2 + (h)) * HTB)
#define PG8_SB(b, h) ((4 + (b) * 2 + (h)) * HTB)
#define PG8_LOAD16(gp, ldsoff) __builtin_amdgcn_global_load_lds((const unsigned*)(gp), (LAS unsigned*)(lds + (ldsoff)), 16, 0, 0)
#define PG8_STAGE_B(bufoff, gbase, h) do { _Pragma("unroll") for (int _i = 0; _i < 2; ++_i) PG8_LOAD16((gbase) + (h) * hstepB + voffB[_i], (bufoff) + ldsw + _i * 8192); } while (0)
#define PG8_STAGE_A(bufoff, gbase, h, usenext) do { _Pragma("unroll") for (int _i = 0; _i < 2; ++_i) { unsigned _vo; \
        if constexpr (GATHER) { _vo = (usenext) ? ((h) ? nv1[_i] : nv0[_i]) : ((h) ? cv1[_i] : cv0[_i]); } else { _vo = voffA[_i] + (unsigned)((h) * hstepA); } \
        PG8_LOAD16((gbase) + _vo, (bufoff) + ldsw + _i * 8192); } } while (0)
#define PG8_LDA(dst, b, h) do { _Pragma("unroll") for (int m = 0; m < 4; ++m) _Pragma("unroll") for (int k = 0; k < 2; ++k) dst[m][k] = *(const LAS bf16x8*)(lds + PG8_SA(b, h) + aoff + m * 2048 + k * 1024); } while (0)
#define PG8_LDB(dst, b, h) do { _Pragma("unroll") for (int n = 0; n < 2; ++n) _Pragma("unroll") for (int k = 0; k < 2; ++k) dst[n][k] = *(const LAS bf16x8*)(lds + PG8_SB(b, h) + boff + n * 2048 + k * 1024); } while (0)
#define PG8_MMA(ai, bj, At, Bt) do { __builtin_amdgcn_s_setprio(1); _Pragma("unroll") for (int m = 0; m < 4; ++m) _Pragma("unroll") for (int n = 0; n < 2; ++n) _Pragma("unroll") for (int k = 0; k < 2; ++k) \
        acc[ai][bj][m][n] = __builtin_amdgcn_mfma_f32_16x16x32_bf16(Bt[n][k], At[m][k], acc[ai][bj][m][n], 0, 0, 0); __builtin_amdgcn_s_setprio(0); } while (0)
#define PG8_WAIT_V(n) asm volatile("s_waitcnt vmcnt(" #n ")" ::: "memory")
#define PG8_WAIT_L(n) asm volatile("s_waitcnt lgkmcnt(" #n ")" ::: "memory")
#define PG8_BAR __builtin_amdgcn_s_barrier()
#define PG8_SCHED __builtin_amdgcn_sched_barrier(0)
    Unit cur, nxt; int ui = 0;
    if (!S.next(0, cur)) return;
    f32x4 acc[2][2][4][2];
#pragma unroll
    for (int a = 0; a < 2; ++a)
#pragma unroll
        for (int b = 0; b < 2; ++b)
#pragma unroll
            for (int m = 0; m < 4; ++m)
#pragma unroll
                for (int n = 0; n < 2; ++n) acc[a][b][m][n] = (f32x4){0.f, 0.f, 0.f, 0.f};
    bf16x8 At[4][2], B0[2][2], B1[2][2];
    const char* cA = cur.a; const char* cB = cur.b;
    if constexpr (GATHER) { const u32x4 pk = gather_offs(cur, tid, lda_b); cv0[0] = pk.x; cv0[1] = pk.y; cv1[0] = pk.z; cv1[1] = pk.w; }
    PG8_STAGE_B(PG8_SB(0, 0), cB, 0); PG8_STAGE_B(PG8_SB(0, 1), cB, 1); PG8_STAGE_A(PG8_SA(0, 0), cA, 0, false); PG8_STAGE_A(PG8_SA(0, 1), cA, 1, false);
    if (wr == 1) PG8_BAR;
    PG8_WAIT_V(2); PG8_BAR;
    PG8_STAGE_B(PG8_SB(1, 0), cB + kstep, 0); PG8_STAGE_A(PG8_SA(1, 0), cA + kstep, 0, false); PG8_STAGE_B(PG8_SB(1, 1), cB + kstep, 1);
    PG8_WAIT_V(6); PG8_BAR;
    for (;;) {
        const bool has_next = S.next(ui + 1, nxt);
        const char* nA = has_next ? nxt.a : cA; const char* nB = has_next ? nxt.b : cB;
        if constexpr (GATHER) {
            u32x4 pk = (u32x4){cv0[0], cv0[1], cv1[0], cv1[1]}; if (has_next) pk = gather_offs(nxt, tid, lda_b);
            *(LAS u32x4*)(lds + STAGE_BYTES + 1024 + tid * 16) = pk;
        }
#pragma nounroll
        for (int t = 0; t < nt; t += 2) {
            const bool last = (t == nt - 2);
            if constexpr (GATHER) { if (last) { const u32x4 pk = *(const LAS u32x4*)(lds + STAGE_BYTES + 1024 + tid * 16); nv0[0] = pk.x; nv0[1] = pk.y; nv1[0] = pk.z; nv1[1] = pk.w; } }
            const char* a1 = cA + (size_t)(t + 1) * kstep;
            const char* a2 = last ? nA : cA + (size_t)(t + 2) * kstep; const char* b2 = last ? nB : cB + (size_t)(t + 2) * kstep;
            const char* a3 = a2 + kstep; const char* b3 = b2 + kstep;
            PG8_LDB(B0, 0, 0); PG8_LDB(B1, 0, 1); PG8_SCHED; PG8_LDA(At, 0, 0); PG8_STAGE_A(PG8_SA(1, 1), a1, 1, false);
            PG8_WAIT_V(8); PG8_WAIT_L(0); PG8_BAR; PG8_MMA(0, 0, At, B0); PG8_MMA(0, 1, At, B1); PG8_BAR; PG8_SCHED;
            PG8_LDA(At, 0, 1); PG8_STAGE_B(PG8_SB(0, 0), b2, 0); PG8_STAGE_B(PG8_SB(0, 1), b2, 1); PG8_STAGE_A(PG8_SA(0, 0), a2, 0, last);
            PG8_WAIT_V(8); PG8_WAIT_L(0); PG8_BAR; PG8_MMA(1, 0, At, B0); PG8_MMA(1, 1, At, B1); PG8_BAR; PG8_SCHED;
            PG8_LDB(B0, 1, 0); PG8_LDB(B1, 1, 1); PG8_SCHED; PG8_LDA(At, 1, 0); PG8_STAGE_A(PG8_SA(0, 1), a2, 1, last);
            PG8_WAIT_V(8); PG8_WAIT_L(0); PG8_BAR; PG8_MMA(0, 0, At, B0); PG8_MMA(0, 1, At, B1); PG8_BAR; PG8_SCHED;
            PG8_LDA(At, 1, 1); PG8_STAGE_B(PG8_SB(1, 0), b3, 0); PG8_STAGE_B(PG8_SB(1, 1), b3, 1); PG8_STAGE_A(PG8_SA(1, 0), a3, 0, last);
            PG8_WAIT_V(8); PG8_WAIT_L(0); PG8_BAR; PG8_MMA(1, 0, At, B0); PG8_MMA(1, 1, At, B1); PG8_BAR; PG8_SCHED;
        }
        if (wr == 0) PG8_BAR;
        E(acc, cur, wr, wc, fr, fq);
        if (!has_next) break;
#pragma unroll
        for (int a = 0; a < 2; ++a)
#pragma unroll
            for (int b = 0; b < 2; ++b)
#pragma unroll
                for (int m = 0; m < 4; ++m)
#pragma unroll
                    for (int n = 0; n < 2; ++n) acc[a][b][m][n] = (f32x4){0.f, 0.f, 0.f, 0.f};
        cur = nxt; cA = nA; cB = nB; ++ui;
        if constexpr (GATHER) {
#pragma unroll
            for (int i = 0; i < 2; ++i) { cv0[i] = nv0[i]; cv1[i] = nv1[i]; }
        }
        if (wr == 1) PG8_BAR;
    }
    PG8_WAIT_V(0);
    PG8_BAR;
#undef PG8_SA
#undef PG8_SB
#undef PG8_LOAD16
#undef PG8_STAGE_A
#undef PG8_STAGE_B
#undef PG8_LDA
#undef PG8_LDB
#undef PG8_MMA
#undef PG8_WAIT_V
#undef PG8_WAIT_L
#undef PG8_BAR
#undef PG8_SCHED
}
}
namespace att {
constexpr int NW = 8, QBLK = 32, KVBLK = 64, QB = NW * QBLK;
constexpr int DQK = 192, DV = 128;
constexpr int QS = NQ, KNS = NKV, KRS = DROPE, OS = DM;
constexpr int SHM_V = KVBLK * DV * 2, SHM_K = KVBLK * DQK * 2;
constexpr int LDS_QR = 2 * SHM_V + 2 * SHM_K + NW * 64 * 4;
constexpr int LDS_BYTES = LDS_QR + NW * 4096;
constexpr float SCALE = 0.07216878364870322f;
constexpr float THR = 8.f;
#define KSWZ(row, ch) ((row) * 384 + ((((ch) ^ (((row) >> 1) & 7))) << 4))
#define SBAR() __builtin_amdgcn_sched_barrier(0)
__device__ __forceinline__ int v_st(int k, int c) { const int kk = (k & ~0xC) | ((k & 4) << 1) | ((k & 8) >> 1); return ((kk >> 3) * 4 + (c >> 5)) * 512 + ((kk & 7) * 32 + (c & 31)) * 2; }
__device__ __forceinline__ int v_rd_base(int lane) { return ((lane & 3) << 3) | (((lane >> 2) & 3) << 6) | (((lane >> 4) & 1) << 5) | (((lane >> 5) & 1) << 8); }
constexpr int v_rd_off(int d0, int ks, int half) { return d0 * 512 + ks * 4096 + half * 2048; }
__device__ __forceinline__ int crow(int r, int hi) { return (r & 3) + 8 * (r >> 2) + 4 * hi; }
__device__ __forceinline__ void mask_tile(f32x16& p0, f32x16& p1, int dq) {
    const float NEG = -__builtin_inff();
#pragma unroll
    for (int r = 0; r < 16; ++r) {
        const int c = (r & 3) + 8 * (r >> 2);
        if (dq - c < 0) p0[r] = NEG;
        if (dq - c - 32 < 0) p1[r] = NEG;
    }
}
__device__ __forceinline__ void partialSM(f32x16& p0, f32x16& p1, float& m_reg, float& mn, float& alpha) {
    float pmax = p0[0]; for (int r = 1; r < 16; ++r) pmax = fmaxf(pmax, p0[r]); for (int r = 0; r < 16; ++r) pmax = fmaxf(pmax, p1[r]);
    { auto rr = __builtin_amdgcn_permlane32_swap(__float_as_uint(pmax), __float_as_uint(pmax), false, false);
      pmax = fmaxf(__uint_as_float(rr[0]), __uint_as_float(rr[1])); }
    constexpr float C2 = 1.4426950408889634f * SCALE;
    if (__builtin_expect(__all((pmax - m_reg) * SCALE <= THR), 1)) { mn = m_reg; alpha = 1.f; }
    else { mn = fmaxf(m_reg, pmax); alpha = __builtin_amdgcn_exp2f((m_reg - mn) * C2); m_reg = mn; }
    const float mnL = -mn * C2;
    for (int r = 0; r < 16; ++r) p0[r] = fmaf(p0[r], C2, mnL); for (int r = 0; r < 16; ++r) p1[r] = fmaf(p1[r], C2, mnL);
    for (int r = 0; r < 16; ++r) p0[r] = __builtin_amdgcn_exp2f(p0[r]);
}
__device__ __forceinline__ void finishSM(f32x16& p0, f32x16& p1, float alpha, float& l_reg, bf16x8& pa0, bf16x8& pa1, bf16x8& pa2, bf16x8& pa3) {
    for (int r = 0; r < 16; ++r) p1[r] = __builtin_amdgcn_exp2f(p1[r]);
    float ps = 0; for (int r = 0; r < 16; ++r) ps += p0[r]; for (int r = 0; r < 16; ++r) ps += p1[r];
    { auto rr = __builtin_amdgcn_permlane32_swap(__float_as_uint(ps), __float_as_uint(ps), false, false);
      ps = __uint_as_float(rr[0]) + __uint_as_float(rr[1]); }
    l_reg = l_reg * alpha + ps;
#define PK4(P, B_, OUT) do { unsigned a0 = cvt_pk_bf16(P[B_+0], P[B_+1]), a1 = cvt_pk_bf16(P[B_+2], P[B_+3]);                          \
        unsigned b0 = cvt_pk_bf16(P[B_+4], P[B_+5]), b1 = cvt_pk_bf16(P[B_+6], P[B_+7]);                                             \
        auto r0 = __builtin_amdgcn_permlane32_swap(a0, b0, false, false); auto r1 = __builtin_amdgcn_permlane32_swap(a1, b1, false, false); \
        u32x4 w = {r0[0], r1[0], r0[1], r1[1]}; OUT = *reinterpret_cast<bf16x8*>(&w); } while (0)
    PK4(p0, 0, pa0); PK4(p0, 8, pa1); PK4(p1, 0, pa2); PK4(p1, 8, pa3);
#undef PK4
}
template <int KB>
__device__ __forceinline__ void qkt(f32x16& p0, f32x16& p1, const char* K_lds, int r32, int hi, const bf16x8* qr, const char* qrl) {
    p0 = f32x16{}; p1 = f32x16{};
    const char* kb[4];
#pragma unroll
    for (int dd = 0; dd < 4; ++dd) kb[dd] = K_lds + KB * SHM_K + KSWZ(r32, dd * 2 + hi);
#pragma unroll
    for (int d0 = 0; d0 < 12; ++d0) { const char* a = kb[d0 & 3] + (d0 >> 2) * 128;
        bf16x8 b0 = *reinterpret_cast<const bf16x8*>(a);
        bf16x8 b1 = *reinterpret_cast<const bf16x8*>(a + 32 * 384);
        const bf16x8 qf = d0 < 8 ? qr[d0 & 7] : *reinterpret_cast<const bf16x8*>(qrl + (d0 - 8) * 1024);
        p0 = __builtin_amdgcn_mfma_f32_32x32x16_bf16(b0, qf, p0, 0, 0, 0);
        p1 = __builtin_amdgcn_mfma_f32_32x32x16_bf16(b1, qf, p1, 0, 0, 0);
        if ((d0 & 3) == 3 && d0 < 11) SBAR(); }
}
template <int VB>
__device__ __forceinline__ void pv_tile(f32x16* o, int vb0, bf16x8 pa0, bf16x8 pa1, bf16x8 pa2, bf16x8 pa3) {
#define TRRD(dst, off) asm volatile("ds_read_b64_tr_b16 %0, %1 offset:%2" : "=&v"(dst) : "v"(vb0), "i"(off) : "memory")
#define PV_D0(d0) do { s16x4 l0, l1, l2, l3, h0, h1, h2, h3; constexpr int b_ = VB * SHM_V + v_rd_off(d0, 0, 0); \
        TRRD(l0, b_); TRRD(h0, b_ + 2048); TRRD(l1, b_ + 4096); TRRD(h1, b_ + 6144); TRRD(l2, b_ + 8192); TRRD(h2, b_ + 10240); TRRD(l3, b_ + 12288); TRRD(h3, b_ + 14336); \
        asm volatile("s_waitcnt lgkmcnt(0)" ::: "memory"); SBAR();   \
        o[d0] = __builtin_amdgcn_mfma_f32_32x32x16_bf16(pa0, (bf16x8){l0[0], l0[1], l0[2], l0[3], h0[0], h0[1], h0[2], h0[3]}, o[d0], 0, 0, 0);   \
        o[d0] = __builtin_amdgcn_mfma_f32_32x32x16_bf16(pa1, (bf16x8){l1[0], l1[1], l1[2], l1[3], h1[0], h1[1], h1[2], h1[3]}, o[d0], 0, 0, 0);   \
        o[d0] = __builtin_amdgcn_mfma_f32_32x32x16_bf16(pa2, (bf16x8){l2[0], l2[1], l2[2], l2[3], h2[0], h2[1], h2[2], h2[3]}, o[d0], 0, 0, 0);   \
        o[d0] = __builtin_amdgcn_mfma_f32_32x32x16_bf16(pa3, (bf16x8){l3[0], l3[1], l3[2], l3[3], h3[0], h3[1], h3[2], h3[3]}, o[d0], 0, 0, 0); } while (0)
    PV_D0(0); PV_D0(1); PV_D0(2); PV_D0(3);
#undef PV_D0
#undef TRRD
}
struct BlockRef { const bf16_t* Q; const bf16_t* Kn; const bf16_t* Kr; const bf16_t* V; bf16_t* O; int P0; };
struct Seam { bf16x8 qr[8]; bf16x8 st_v0, st_v1, st_k0, st_k1, st_k2; };
#define VMW() asm volatile("s_waitcnt vmcnt(0)" ::: "memory")
#define VMWN(n) asm volatile("s_waitcnt vmcnt(%0)" :: "i"(n) : "memory")
#define LD8(p) (*reinterpret_cast<const bf16x8*>(p))
#define SLOAD_H(R_, k0) do { S.st_v0 = LD8((R_).V + (size_t)((k0) + sr) * KNS + sc); S.st_v1 = LD8((R_).V + (size_t)((k0) + 32 + sr) * KNS + sc);              \
                             S.st_k0 = LD8((R_).Kn + (size_t)((k0) + sr) * KNS + sc); S.st_k1 = LD8((R_).Kn + (size_t)((k0) + 32 + sr) * KNS + sc);            \
                             S.st_k2 = LD8((R_).Kr + (size_t)((k0) + rr) * KRS + rc); } while (0)
#define SWRITE_HK(bf) do { *(bf16x8*)(K_lds + (bf) * SHM_K + kws) = S.st_k0; *(bf16x8*)(K_lds + (bf) * SHM_K + kws + 32 * 384) = S.st_k1; *(bf16x8*)(K_lds + (bf) * SHM_K + kws2) = S.st_k2; } while (0)
#define SWRITE_HV(bf) do { *(bf16x8*)(V_lds + (bf) * SHM_V + vst0) = S.st_v0; *(bf16x8*)(V_lds + (bf) * SHM_V + vst1) = S.st_v1; } while (0)
#define SWRITE_H(bf) do { SWRITE_HV(bf); SWRITE_HK(bf); } while (0)
#define ATT_IDX const int tid = launder_v((int)threadIdx.x), wid = __builtin_amdgcn_readfirstlane(tid >> 6), lane = tid & 63, r32 = lane & 31, hi = lane >> 5; \
    const int sr = tid >> 4, sc = (tid & 15) * 8, rr = tid >> 3, rc = (tid & 7) * 8, kws = KSWZ(sr, (tid & 15)), kws2 = KSWZ(rr, 16 + (tid & 7));
__device__ __forceinline__ void attn_block(const BlockRef& cur, char* lds) {
    ATT_IDX;
    Seam S;
    const int NT = cur.P0 / KVBLK + QB / KVBLK;
    const int qlo = cur.P0 + wid * QBLK, qm = qlo + r32 - 4 * hi;
    char* V_lds = lds; char* K_lds = lds + 2 * SHM_V;
    float* ws = (float*)(lds + 2 * SHM_V + 2 * SHM_K) + wid * 64; float* li_l = ws, * al_l = ws + 32;
    float m_reg = -1e30f, l_reg = 0; f32x16 o[4] = {};
    const int vst0 = v_st(sr, sc), vst1 = v_st(32 + sr, sc);
    const int vb0 = (int)(uintptr_t)V_lds + v_rd_base(lane);
    char* qrl = lds + LDS_QR + wid * 4096 + lane * 16;
#define RESC(a) do { if (__any((a) < 1.f)) { if (hi == 0) al_l[r32] = (a); asm volatile("s_waitcnt lgkmcnt(0)" ::: "memory");              \
                     for (int d_ = 0; d_ < 4; ++d_) for (int r = 0; r < 16; ++r) o[d_][r] *= al_l[crow(r, hi)]; } } while (0)
#define KBASE(t) ((t) * KVBLK)
#define MASKT(P0_, P1_, t) do { const int kb_ = KBASE(t); if (kb_ + KVBLK - 1 > qlo) mask_tile(P0_, P1_, qm - kb_); } while (0)
    SLOAD_H(cur, 0);
#pragma unroll
    for (int d0 = 0; d0 < 8; ++d0) S.qr[d0] = LD8(cur.Q + (size_t)(wid * QBLK + r32) * QS + d0 * 16 + hi * 8);
    { bf16x8 t0 = LD8(cur.Q + (size_t)(wid * QBLK + r32) * QS + 128 + hi * 8), t1 = LD8(cur.Q + (size_t)(wid * QBLK + r32) * QS + 144 + hi * 8),
             t2 = LD8(cur.Q + (size_t)(wid * QBLK + r32) * QS + 160 + hi * 8), t3 = LD8(cur.Q + (size_t)(wid * QBLK + r32) * QS + 176 + hi * 8);
      *(bf16x8*)(qrl) = t0; *(bf16x8*)(qrl + 1024) = t1; *(bf16x8*)(qrl + 2048) = t2; *(bf16x8*)(qrl + 3072) = t3; }
    VMW(); SWRITE_H(0);
    __syncthreads();
    f32x16 p0, p1; float mn, al; bf16x8 pa0, pa1, pa2, pa3;
#define TILE_STEP(t, BF) do {                                                                                                 \
        if ((t) + 1 < NT) { SLOAD_H(cur, KBASE((t) + 1)); }                                                                    \
        SBAR();                                                                                                               \
        if (KBASE(t) <= qlo + QBLK - 1) {     \
        qkt<BF>(p0, p1, K_lds, r32, hi, S.qr, qrl);                                                                           \
        MASKT(p0, p1, (t)); partialSM(p0, p1, m_reg, mn, al); RESC(al);                                                        \
        finishSM(p0, p1, al, l_reg, pa0, pa1, pa2, pa3); SBAR();                                                              \
        pv_tile<BF>(o, vb0, pa0, pa1, pa2, pa3); }                                                                            \
        if ((t) + 1 < NT) { VMW(); SWRITE_H(1 - BF); }                                                                         \
        __syncthreads(); } while (0)
    for (int t = 0; t < NT; t += 2) { TILE_STEP(t, 0); TILE_STEP(t + 1, 1); }
    if (hi == 0) li_l[r32] = l_reg; asm volatile("s_waitcnt lgkmcnt(0)" ::: "memory");
    float rli[16];
#pragma unroll
    for (int r = 0; r < 16; ++r) rli[r] = __builtin_amdgcn_rcpf(li_l[crow(r, hi)]);
    bf16_t* Ow = cur.O + (size_t)(wid * QBLK) * OS;
#pragma unroll
    for (int r = 0; r < 16; ++r) { const int orow = crow(r, hi);
#pragma unroll
        for (int d0 = 0; d0 < 4; ++d0) { const float v = o[d0][r] * rli[r];
            const float vn = __shfl_xor(v, 1);
            if ((r32 & 1) == 0) *(unsigned*)(Ow + (size_t)orow * OS + d0 * 32 + r32) = cvt_pk_bf16(v, vn); } }
    __syncthreads();
#undef RESC
#undef KBASE
#undef MASKT
#undef TILE_STEP
}
#undef VMW
#undef VMWN
#undef LD8
#undef SLOAD_H
#undef SWRITE_HK
#undef SWRITE_HV
#undef SWRITE_H
#undef ATT_IDX
#undef KSWZ
#undef SBAR

__device__ __forceinline__ BlockRef make_ref(int L, int pass, const bf16_t* Qb, const bf16_t* KNVb, const bf16_t* KRb, bf16_t* Ob) {
    const int bh = L >> 2, x = L & 3, qb = pass ? 7 - x : x, b = bh >> 3, h = bh & 7; const size_t rb = (size_t)b * SEQ;
    BlockRef r; r.Q = Qb + (rb + (size_t)qb * QB) * QS + h * DQH; r.Kn = KNVb + rb * KNS + h * (DNOPE + DVH); r.Kr = KRb + rb * KRS; r.V = KNVb + rb * KNS + h * (DNOPE + DVH) + DNOPE;
    r.O = Ob + (rb + (size_t)qb * QB) * OS + h * DVH; r.P0 = qb * QB; return r;
}
__device__ __forceinline__ void attn_phase(char* lds, const bf16_t* Qb, const bf16_t* KNVb, const bf16_t* KRb, bf16_t* Ob, int first, int stride) {
    constexpr int total = NBATCH * NHEAD * 4;
    for (int L = first; L < total; L += stride) {
        for (int pass = 0; pass < 2; ++pass) { const BlockRef cur = make_ref(L, pass, Qb, KNVb, KRb, Ob); attn_block(cur, lds); }
    }
}
}
constexpr int NWAVES = 8;
constexpr size_t MiB = 1u << 20;
constexpr size_t WS_CTL = 0, CTL_ZERO_BYTES = 8 * MiB;
constexpr size_t WS_SSQ = 1 * MiB;
constexpr size_t WS_COS = 8 * MiB, WS_SIN = 16 * MiB;
constexpr size_t WS_LIST = 24 * MiB;
constexpr size_t WS_RSL = 26 * MiB;
constexpr size_t WS_TOKINFO = 28 * MiB;
constexpr size_t WS_WDN = 30 * MiB, WS_WUQ = 34 * MiB, WS_WUKV = 37 * MiB, WS_WO = 39 * MiB, WS_WPOOL = 43 * MiB, WS_WGU = 44 * MiB, WS_WD = 65 * MiB, WS_MWGU = 76 * MiB, WS_MWD = 164 * MiB;
constexpr size_t WS_H = 208 * MiB;
constexpr size_t WS_ACT = 336 * MiB;
constexpr size_t WS_DOWN = WS_ACT;
constexpr size_t WS_CQN = WS_ACT + 128 * MiB, WS_CKVN = WS_ACT + 192 * MiB, WS_KR = WS_ACT + 224 * MiB, WS_Q = WS_ACT + 232 * MiB, WS_KNV = WS_ACT + 424 * MiB;
constexpr size_t WS_HID = WS_ACT;
constexpr size_t WS_YB = WS_ACT + 358 * MiB;
constexpr size_t WS_DUMMY = WS_ACT + 424 * MiB;
constexpr size_t WS_END = WS_ACT + 680 * MiB;
static_assert(WS_MWD + (size_t)16 * 1024 * FFEP * 2 <= WS_H && WS_MWGU + (size_t)16 * 2 * FFEP * 1024 * 2 <= WS_MWD && WS_WD + (size_t)2 * 1024 * FFD * 2 <= WS_MWGU && WS_WGU + (size_t)2 * 2 * FFD * 1024 * 2 <= WS_WD, "weights map");
static_assert(WS_HID + (size_t)PSLOT * FFEP * 2 <= WS_YB && WS_YB + (size_t)PSLOT * 1024 * 2 <= WS_END && WS_HID + (size_t)NTOK * FFD * 2 <= WS_END && WS_KNV + (size_t)NTOK * NKV * 2 <= WS_END && WS_Q + (size_t)NTOK * NQ * 2 <= WS_KNV, "activation map");
static_assert(WS_SSQ + (size_t)14 * NTOK * 8 <= WS_COS && WS_COS <= CTL_ZERO_BYTES + WS_COS && WS_END <= 1024 * MiB, "map");
constexpr int CW_TMO = 0, CW_CODE = 1, CW_CNT = 1024  , CW_DBG = 2048, CW_BAR = 4096  ;
constexpr int RING_OFF = 0, RING_BYTES = 131072, LDSCTL_OFF = RING_BYTES, MISC_OFF = LDSCTL_OFF + 320, LDS_BYTES = 147456;

typedef GAS unsigned gu32;
#define RLX_AGENT __ATOMIC_RELAXED, __HIP_MEMORY_SCOPE_AGENT
#define LDS_WAIT() asm volatile("s_waitcnt lgkmcnt(0)" ::: "memory")
#define VM_WAIT() asm volatile("s_waitcnt vmcnt(0)" ::: "memory")

#define XB_TMO      128
#define XB_XCNT(j)  (256  + 64 * (j))
#define XB_XSUB(j)  (1280 + 64 * (j))
#define XB_XGEN(j)  (2304 + 64 * (j))
#define XB_TOP      3328
#define XB_TOPGEN   3392
#define XCD_BAR_WORDS 3456
#define XB_SPIN_CAP (1u << 18)
__device__ __forceinline__ unsigned xb_ld(unsigned* p)              { return __hip_atomic_load(p, __ATOMIC_RELAXED, __HIP_MEMORY_SCOPE_AGENT); }
__device__ __forceinline__ unsigned xb_add(unsigned* p, unsigned v) { return __hip_atomic_fetch_add(p, v, __ATOMIC_RELAXED, __HIP_MEMORY_SCOPE_AGENT); }
__device__ __forceinline__ unsigned xb_xcc_id() { return (unsigned)__builtin_amdgcn_s_getreg((3 << 11) | 20) & 0xFu; }
#define XB_SPIN(cond, bar) do { unsigned _sp = 0; while (cond) { __builtin_amdgcn_s_sleep(1); \
    if ((++_sp & 255u) == 0u) { if (xb_ld(&(bar)[XB_TMO])) break; if (_sp > XB_SPIN_CAP) { atomicAdd(&(bar)[XB_TMO], 1u); break; } } } } while (0)
__device__ __forceinline__ unsigned rfl(unsigned v);
struct XcdBarrier { unsigned* bar; unsigned x; volatile LAS unsigned* st; };
__device__ __forceinline__ XcdBarrier xcd_barrier_post(unsigned* bar, volatile LAS unsigned* st) {
    XcdBarrier b; b.bar = bar; b.x = xb_xcc_id(); b.st = st;
    if (threadIdx.x == 0) (void)xb_add(&bar[XB_XCNT(b.x)], 1u);
    return b;
}
__device__ __forceinline__ void xcd_barrier_complete(unsigned* bar, unsigned x, unsigned& nloc, unsigned& nx) {
    const unsigned G = gridDim.x * gridDim.y * gridDim.z;
    unsigned sum, cnt, mine, sp = 0u;
    for (;;) {
        sum = 0u; cnt = 0u; mine = 0u;
#pragma unroll
        for (unsigned j = 0; j < 16; ++j) { const unsigned c = xb_ld(&bar[XB_XCNT(j)]); sum += c; cnt += (c > 0u) ? 1u : 0u; mine = (j == x) ? c : mine; }
        if (sum == G) break;
        __builtin_amdgcn_s_sleep(1);
        if ((++sp & 255u) == 0u) { if (xb_ld(&bar[XB_TMO])) break; if (sp > XB_SPIN_CAP) { atomicAdd(&bar[XB_TMO], 1u); break; } }
    }
    nloc = mine > 0u ? mine : 1u; nx = cnt > 0u ? cnt : 1u;
}
__device__ __forceinline__ void xcd_barrier(const XcdBarrier& b) {
    unsigned* bar; { const volatile LAS unsigned* p_ = b.st + 2; const unsigned lo_ = rfl(p_[0]), hi_ = rfl(p_[1]); bar = (unsigned*)(((unsigned long long)hi_ << 32) | lo_); }
    asm volatile("s_waitcnt vmcnt(0)" ::: "memory");
    __syncthreads();
    if (threadIdx.x == 0) {
        __builtin_amdgcn_s_waitcnt(0);
        unsigned nloc = b.st[0], nx = b.st[1];
        if (nloc == 0u) { xcd_barrier_complete(bar, b.x, nloc, nx); b.st[0] = nloc; b.st[1] = nx; }
        const unsigned old = xb_add(&bar[XB_XSUB(b.x)], 1u);
        const unsigned gen = old / nloc;
        if (old + 1u == (gen + 1u) * nloc) {
            __builtin_amdgcn_fence(__ATOMIC_RELEASE, "agent");
            asm volatile("s_waitcnt vmcnt(0)" ::: "memory");
            const unsigned og = xb_add(&bar[XB_TOP], 1u);
            const unsigned tg = og / nx;
            if (og + 1u == (tg + 1u) * nx) xb_add(&bar[XB_TOPGEN], 1u);
            else XB_SPIN(xb_ld(&bar[XB_TOPGEN]) == tg, bar);
            __builtin_amdgcn_fence(__ATOMIC_ACQUIRE, "agent");
            xb_add(&bar[XB_XGEN(b.x)], 1u);
            asm volatile("s_waitcnt vmcnt(0)" ::: "memory");
        } else {
            XB_SPIN(xb_ld(&bar[XB_XGEN(b.x)]) == gen, bar);
            __builtin_amdgcn_fence(__ATOMIC_ACQUIRE, "agent");
            asm volatile("s_waitcnt vmcnt(0)" ::: "memory");
        }
    }
    __syncthreads();
}

constexpr int PT_OFF_ = LDSCTL_OFF + 512;
__device__ __forceinline__ unsigned rfl(unsigned v);
__device__ __forceinline__ const float* ptab(LAS unsigned char* L, int i);
struct Frame { LAS unsigned char* lds; volatile LAS unsigned* MISC; gu32* ctl; unsigned char* ws; int tid, lane, wave, vcu, G; };

__device__ __forceinline__ float wave_sum(float v) {
#pragma unroll
    for (int o = 1; o < 64; o <<= 1) v += __shfl_xor(v, o);
    return v;
}
__device__ __forceinline__ unsigned rfl(unsigned v) { return (unsigned)__builtin_amdgcn_readfirstlane((int)v); }

__device__ __forceinline__ int rowmap(int mode, int n) {
    if (mode == 0) return n;
    if (mode == 1) return (n >> 7) * 256 + (n & 127);
    if (mode == 2) return (n >> 7) * 256 + 128 + (n & 127);
    if (mode == 4) return n < 800 ? n : 896 + (n - 800);
    const int h = n / DQH, d = n - h * DQH;
    if (d < DNOPE) return 512 + h * DNOPE + d;
    if (d < DNOPE + 32) return (h >> 2) * 256 + (h & 3) * 32 + (d - DNOPE);
    return (h >> 2) * 256 + 128 + (h & 3) * 32 + (d - DNOPE - 32);
}
__device__ __forceinline__ void transpose_item(const float* W, int N, bf16_t* WT, int ldd, int mode, const float* kscale, const float* nscale, int item, int lane) {
    const int nblk = N / 64, kb = item / nblk, nb = item % nblk, k0 = 64 * kb, n = 64 * nb + lane;
    const float sn = nscale ? nscale[n] : 1.0f;
    const int ksv = __float_as_int(kscale ? kscale[k0 + lane] : 1.0f);
    const float* wp = W + (size_t)k0 * N + n;
    bf16_t* op = WT + (size_t)rowmap(mode, n) * ldd + k0;
#pragma unroll
    for (int kg = 0; kg < 8; ++kg) { float v[8];
#pragma unroll
        for (int i = 0; i < 8; ++i) { const float sk = __int_as_float(__builtin_amdgcn_readlane(ksv, 8 * kg + i)); v[i] = wp[(size_t)(8 * kg + i) * N] * (sk * sn); }
        u32x4 o; o.x = cvt_pk_bf16(v[0], v[1]); o.y = cvt_pk_bf16(v[2], v[3]); o.z = cvt_pk_bf16(v[4], v[5]); o.w = cvt_pk_bf16(v[6], v[7]);
        *(GAS u32x4*)(op + 8 * kg) = o; }
}
struct MatDesc { const float* src; bf16_t* dst; const float* kscale; const float* nscale; int K, N, ldd, mode; };
constexpr int N_MATS = 70;
__device__ __forceinline__ MatDesc mat_desc(int m, LAS unsigned char* L, unsigned char* ws) {
    MatDesc d; d.kscale = nullptr; d.nscale = nullptr; d.mode = 0;
    if (m < 2)       { const int a = m;      d.src = ptab(L, 4) + (size_t)a * DM * NDOWN;    d.K = DM;   d.N = NDOWN; d.dst = (bf16_t*)(ws + WS_WDN) + (size_t)a * NDOWNP * DM;  d.ldd = DM; d.mode = 4; d.kscale = ptab(L, 2) + (size_t)(2 * a) * DM; }
    else if (m < 4)  { const int a = m - 2;  d.src = ptab(L, 6) + (size_t)a * QLR * NQ;      d.K = QLR;  d.N = NQ;    d.dst = (bf16_t*)(ws + WS_WUQ) + (size_t)a * NQ * QLR;     d.ldd = QLR; d.mode = 3; d.kscale = ptab(L, 5) + (size_t)a * QLR; }
    else if (m < 6)  { const int a = m - 4;  d.src = ptab(L, 8) + (size_t)a * KVLR * NKV;    d.K = KVLR; d.N = NKV;   d.dst = (bf16_t*)(ws + WS_WUKV) + (size_t)a * NKV * KVLR;  d.ldd = KVLR; d.kscale = ptab(L, 7) + (size_t)a * KVLR; }
    else if (m < 8)  { const int a = m - 6;  d.src = ptab(L, 9) + (size_t)a * DM * DM;       d.K = DM;   d.N = DM;    d.dst = (bf16_t*)(ws + WS_WO) + (size_t)a * DM * DM;       d.ldd = DM; }
    else if (m < 16) { const int i = m - 8;  d.src = ptab(L, 10) + (size_t)i * 256 * 256;    d.K = 256;  d.N = 256;   d.dst = (bf16_t*)(ws + WS_WPOOL) + (size_t)i * 256 * 256;  d.ldd = 256; d.nscale = ptab(L, 11) + i * 256; }
    else if (m < 18) { const int a = m - 16; d.src = ptab(L, 12) + (size_t)a * DM * FFD;     d.K = DM;   d.N = FFD;   d.dst = (bf16_t*)(ws + WS_WGU) + (size_t)a * 2 * FFD * DM; d.ldd = DM; d.mode = 1; d.kscale = ptab(L, 3) + (size_t)(2 * a) * DM; }
    else if (m < 20) { const int a = m - 18; d.src = ptab(L, 13) + (size_t)a * DM * FFD;     d.K = DM;   d.N = FFD;   d.dst = (bf16_t*)(ws + WS_WGU) + (size_t)a * 2 * FFD * DM; d.ldd = DM; d.mode = 2; d.kscale = ptab(L, 3) + (size_t)(2 * a) * DM; }
    else if (m < 22) { const int a = m - 20; d.src = ptab(L, 14) + (size_t)a * FFD * DM;     d.K = FFD;  d.N = DM;    d.dst = (bf16_t*)(ws + WS_WD) + (size_t)a * DM * FFD;      d.ldd = FFD; }
    else if (m < 38) { const int i = m - 22; d.src = ptab(L, 16) + (size_t)i * DM * FFE;     d.K = DM;   d.N = FFE;   d.dst = (bf16_t*)(ws + WS_MWGU) + (size_t)i * 2 * FFEP * DM; d.ldd = DM; d.mode = 1; d.kscale = ptab(L, 3) + (size_t)(2 * (i >> 3) + 1) * DM; }
    else if (m < 54) { const int i = m - 38; d.src = ptab(L, 17) + (size_t)i * DM * FFE;     d.K = DM;   d.N = FFE;   d.dst = (bf16_t*)(ws + WS_MWGU) + (size_t)i * 2 * FFEP * DM; d.ldd = DM; d.mode = 2; d.kscale = ptab(L, 3) + (size_t)(2 * (i >> 3) + 1) * DM; }
    else             { const int i = m - 54; d.src = ptab(L, 18) + (size_t)i * FFE * DM;     d.K = FFE;  d.N = DM;    d.dst = (bf16_t*)(ws + WS_MWD) + (size_t)i * DM * FFEP;    d.ldd = FFEP; }
    return d;
}
__device__ __forceinline__ void p0_prologue(Frame& F) {
    const int* positions = (const int*)ptab(F.lds, 1);
    const int gw = F.vcu * NWAVES + F.wave, NGW = F.G * NWAVES;
    int cum = 0;
    for (int m = 0; m < N_MATS; ++m) {
        const MatDesc d = mat_desc(m, F.lds, F.ws);
        const int nitems = (d.K / 64) * (d.N / 64);
        int first = gw - (cum % NGW); if (first < 0) first += NGW;
        for (int it = first; it < nitems; it += NGW) transpose_item(d.src, d.N, d.dst, d.ldd, d.mode, d.kscale, d.nscale, it, F.lane);
        cum += nitems;
    }
    const int gt = gw * 64 + F.lane, NGT = NGW * 64; const u32x4 z4 = (u32x4){0u, 0u, 0u, 0u};
    for (int i = gt; i < 2 * 192 * 128; i += NGT) { const int a = i / (192 * 128), r = (i / 128) % 192, c = i % 128; const int row = r < 96 ? 800 + r : 928 + (r - 96); *(GAS u32x4*)((bf16_t*)(F.ws + WS_WDN) + (size_t)a * NDOWNP * DM + (size_t)row * DM + c * 8) = z4; }
    for (int i = gt; i < 16 * 128 * 128; i += NGT) { const int e = i / (128 * 128), r = (i / 128) % 128, c = i % 128; const int row = 2560 + (r < 64 ? 64 + r : 192 + (r - 64));
        *(GAS u32x4*)((bf16_t*)(F.ws + WS_MWGU) + (size_t)e * 2 * FFEP * DM + (size_t)row * DM + c * 8) = z4; }
    for (int i = gt; i < 16 * 1024 * 8; i += NGT) { const int row = i / 8, c = i % 8; *(GAS u32x4*)((bf16_t*)(F.ws + WS_MWD) + (size_t)row * FFEP + FFE + c * 8) = z4; }
    float* cosT = (float*)(F.ws + WS_COS); float* sinT = (float*)(F.ws + WS_SIN);
    for (int i = gt; i < NTOK * 32; i += NGT) { const int row = i >> 5, k = i & 31; const float inv = powf(10000.0f, -(float)(2 * k) / 64.0f); const float ang = (float)positions[row] * inv;
        cosT[i] = cosf(ang); sinT[i] = sinf(ang); }
    const float* x = ptab(F.lds, 0); bf16_t* H = (bf16_t*)(F.ws + WS_H); ssq_t* ssq0 = (ssq_t*)(F.ws + WS_SSQ);
    for (int m0 = gw * 4; m0 < NTOK; m0 += NGW * 4) {
        f32x4 v[4][4];
#pragma unroll
        for (int r = 0; r < 4; ++r) { const GAS f32x4* xr = (const GAS f32x4*)(x + (size_t)(m0 + r) * DM) + F.lane;
#pragma unroll
            for (int j = 0; j < 4; ++j) v[r][j] = xr[64 * j]; }
#pragma unroll
        for (int r = 0; r < 4; ++r) { GAS u32x2* o8 = (GAS u32x2*)(H + (size_t)(m0 + r) * DM) + F.lane; float s = 0.f;
#pragma unroll
            for (int j = 0; j < 4; ++j) { const f32x4 t = v[r][j]; s += (t.x * t.x + t.y * t.y) + (t.z * t.z + t.w * t.w); u32x2 w; w.x = cvt_pk_bf16(t.x, t.y); w.y = cvt_pk_bf16(t.z, t.w); o8[64 * j] = w; }
            s = wave_sum(s); if (F.lane == 0) ssq0[m0 + r] = ssq_fix(s); }
    }
}

template <bool FINAL>
__device__ __forceinline__ void combine_phase(Frame& F, bf16_t* H, const bf16_t* YB, const unsigned* tokinfo, const unsigned* cntw, ssq_t* ssq_next, const float* gain, float* outF) {
    const int gw = F.vcu * NWAVES + F.wave, NGW = F.G * NWAVES;
    f32x4 g[4];
    if constexpr (FINAL) {
#pragma unroll
        for (int j = 0; j < 4; ++j) g[j] = *(const f32x4*)(gain + F.lane * 4 + 256 * j);
    }
    unsigned nb[8];
#pragma unroll
    for (int e = 0; e < 8; ++e) nb[e] = (rfl(__hip_atomic_load((unsigned*)cntw + 64 * e, RLX_AGENT)) + 255u) >> 8;
    for (int m0 = gw * 2; m0 < NTOK; m0 += NGW * 2) {
        u32x4 t0[2], t1[2];
#pragma unroll
        for (int r = 0; r < 2; ++r) { t0[r] = *(const u32x4*)(tokinfo + (size_t)(m0 + r) * 8); t1[r] = *(const u32x4*)(tokinfo + (size_t)(m0 + r) * 8 + 4); }
        u32x2 hh[2][4], ya[2][4], yb[2][4]; float g0[2], g1[2];
#pragma unroll
        for (int r = 0; r < 2; ++r) {
            const unsigned e0 = rfl(t0[r].x), r0 = rfl(t0[r].y), e1 = rfl(t1[r].x), r1 = rfl(t1[r].y); g0[r] = __uint_as_float(rfl(t0[r].z)); g1[r] = __uint_as_float(rfl(t1[r].z));
            unsigned b0 = 0u, b1 = 0u;
#pragma unroll
            for (int e = 0; e < 8; ++e) { b0 += ((unsigned)e < e0) ? nb[e] : 0u; b1 += ((unsigned)e < e1) ? nb[e] : 0u; }
            const GAS u32x2* hr = (const GAS u32x2*)(H + (size_t)(m0 + r) * DM) + F.lane;
            const GAS u32x2* y0 = (const GAS u32x2*)(YB + ((size_t)b0 * 256 + r0) * DM) + F.lane; const GAS u32x2* y1 = (const GAS u32x2*)(YB + ((size_t)b1 * 256 + r1) * DM) + F.lane;
#pragma unroll
            for (int j = 0; j < 4; ++j) { hh[r][j] = hr[64 * j]; ya[r][j] = y0[64 * j]; yb[r][j] = y1[64 * j]; }
        }
#pragma unroll
        for (int r = 0; r < 2; ++r) { const int m = m0 + r;
            f32x4 v[4]; float s = 0.f;
#pragma unroll
            for (int j = 0; j < 4; ++j) { const u32x2 h2 = hh[r][j], a = ya[r][j], b = yb[r][j];
                v[j].x = bflo(h2.x) + g0[r] * bflo(a.x) + g1[r] * bflo(b.x); v[j].y = bfhi(h2.x) + g0[r] * bfhi(a.x) + g1[r] * bfhi(b.x); v[j].z = bflo(h2.y) + g0[r] * bflo(a.y) + g1[r] * bflo(b.y); v[j].w = bfhi(h2.y) + g0[r] * bfhi(a.y) + g1[r] * bfhi(b.y);
                s += (v[j].x * v[j].x + v[j].y * v[j].y) + (v[j].z * v[j].z + v[j].w * v[j].w); }
            s = wave_sum(s);
            if constexpr (FINAL) { const float rstd = rstd_f(s); GAS f32x4* ho = (GAS f32x4*)(outF + (size_t)m * DM) + F.lane;
#pragma unroll
                for (int j = 0; j < 4; ++j) ho[64 * j] = v[j] * rstd * g[j];
            } else { GAS u32x2* hw = (GAS u32x2*)(H + (size_t)m * DM) + F.lane;
#pragma unroll
                for (int j = 0; j < 4; ++j) { u32x2 w; w.x = cvt_pk_bf16(v[j].x, v[j].y); w.y = cvt_pk_bf16(v[j].z, v[j].w); hw[64 * j] = w; }
                if (F.lane == 0) ssq_next[m] = ssq_fix(s); }
        }
    }
}
__device__ __forceinline__ void mid_phase(Frame& F, const bf16_t* DOWN, const float* qn, const float* kvn, const float* cosT, const float* sinT, bf16_t* CQN, bf16_t* CKVN, bf16_t* KR) {
    const int gw = F.vcu * NWAVES + F.wave, NGW = F.G * NWAVES, lane = F.lane;
    const f32x4 q0 = *(const f32x4*)(qn + lane * 8), q1 = *(const f32x4*)(qn + lane * 8 + 4), k0 = *(const f32x4*)(kvn + lane * 4);
    for (int m = gw; m < NTOK; m += NGW) {
        const bf16_t* dr = DOWN + (size_t)m * NDOWNP;
        const u32x4 cq = *(const GAS u32x4*)(dr + lane * 8); const u32x2 ck = *(const GAS u32x2*)(dr + QLR + lane * 4);
        const float x1 = bf2f(dr[QLR + KVLR + (lane & 31)]), x2 = bf2f(dr[QLR + KVLR + 32 + (lane & 31)]);
        const f32x4 a0 = (f32x4){bflo(cq.x), bfhi(cq.x), bflo(cq.y), bfhi(cq.y)}, a1 = (f32x4){bflo(cq.z), bfhi(cq.z), bflo(cq.w), bfhi(cq.w)}, c0 = (f32x4){bflo(ck.x), bfhi(ck.x), bflo(ck.y), bfhi(ck.y)};
        const float sq = wave_sum((a0.x * a0.x + a0.y * a0.y) + (a0.z * a0.z + a0.w * a0.w) + (a1.x * a1.x + a1.y * a1.y) + (a1.z * a1.z + a1.w * a1.w));
        const float sk = wave_sum((c0.x * c0.x + c0.y * c0.y) + (c0.z * c0.z + c0.w * c0.w));
        const float rq = 1.0f / sqrtf(sq * (1.0f / QLR) + RMS_EPS), rk = 1.0f / sqrtf(sk * (1.0f / KVLR) + RMS_EPS);
        const f32x4 y0 = a0 * rq * q0, y1 = a1 * rq * q1, z0 = c0 * rk * k0;
        u32x4 w; w.x = cvt_pk_bf16(y0.x, y0.y); w.y = cvt_pk_bf16(y0.z, y0.w); w.z = cvt_pk_bf16(y1.x, y1.y); w.w = cvt_pk_bf16(y1.z, y1.w);
        *(GAS u32x4*)(CQN + (size_t)m * QLR + lane * 8) = w;
        u32x2 w2; w2.x = cvt_pk_bf16(z0.x, z0.y); w2.y = cvt_pk_bf16(z0.z, z0.w);
        *(GAS u32x2*)(CKVN + (size_t)m * KVLR + lane * 4) = w2;
        const float c = cosT[(size_t)m * 32 + (lane & 31)], s = sinT[(size_t)m * 32 + (lane & 31)];
        const float o = lane < 32 ? x1 * c - x2 * s : x2 * c + x1 * s;
        KR[(size_t)m * DROPE + lane] = (bf16_t)(cvt_pk_bf16(o, o) & 0xffffu);
    }
}
template <int W>
__device__ __forceinline__ void pool_walk(const bf16_t* h, const ssq_t* ssq, const f32x2 g2, bf16_t* Z, size_t rowbase, int t_start, int c0, int nrows, int col) {
    f32x2 ring[W]; f32x2 sum = (f32x2){0.f, 0.f};
#pragma unroll
    for (int j = 0; j < W; ++j) ring[j] = (f32x2){0.f, 0.f};
    for (int r = 0; r < nrows; r += 16) {
        unsigned xw[16]; ssq_t q[16];
#pragma unroll
        for (int j = 0; j < 16; ++j) { const size_t row = rowbase + t_start + r + j; xw[j] = *(const GAS unsigned*)(h + row * DM + col); q[j] = ssq[row]; }
#pragma unroll
        for (int j = 0; j < 16; ++j) {
            const int t = t_start + r + j; const size_t row = rowbase + t;
            const f32x2 v = (f32x2){bflo(xw[j]), bfhi(xw[j])} * rstd_of(q[j]) * g2;
            sum = sum + (v - ring[j % W]); ring[j % W] = v;
            if (t >= c0) { const float inv = 1.0f / (float)(t + 1 < W ? t + 1 : W); const f32x2 z = sum * inv - v; *(GAS unsigned*)(Z + row * DM + col) = cvt_pk_bf16(z.x, z.y); }
        }
    }
}
__device__ __forceinline__ void pool_phase(Frame& F, const bf16_t* h, const ssq_t* ssq, const float* gain, bf16_t* Z) {
    const int col = F.tid * 2; const f32x2 g2 = *(const f32x2*)(gain + col);
    for (int chunk = F.vcu; chunk < NBATCH * 16; chunk += F.G) {
        const int b = chunk >> 4, c0 = (chunk & 15) * 128, t_start = c0 ? c0 - 16 : 0, nrows = c0 + 128 - t_start; const size_t rowbase = (size_t)b * SEQ;
        const int grp = F.wave >> 1;
        if (grp == 0) pool_walk<2>(h, ssq, g2, Z, rowbase, t_start, c0, nrows, col);
        else if (grp == 1) pool_walk<4>(h, ssq, g2, Z, rowbase, t_start, c0, nrows, col);
        else if (grp == 2) pool_walk<8>(h, ssq, g2, Z, rowbase, t_start, c0, nrows, col);
        else pool_walk<16>(h, ssq, g2, Z, rowbase, t_start, c0, nrows, col);
    }
}
__device__ __forceinline__ void router_phase(Frame& F, const bf16_t* h, const ssq_t* ssq, const float* gain, const float* router, int* list, float* rsl, unsigned* tokinfo, unsigned* cntw) {
    LAS float* rt = (LAS float*)(F.lds + RING_OFF);
    LAS int* esel = (LAS int*)(F.lds + RING_OFF + 32768);
    LAS int* wt = (LAS int*)(F.lds + RING_OFF + 32768 + 2048);
    LAS int* base = (LAS int*)(F.lds + RING_OFF + 32768 + 2048 + 256);
    LAS float* rsd = (LAS float*)(F.lds + RING_OFF + 32768 + 2048 + 512);
    const int lane = F.lane;
    for (int idx = F.tid; idx < DM * NEXP; idx += NWAVES * 64) rt[(idx & 7) * DM + (idx >> 3)] = router[idx];
    f32x4 g[4];
#pragma unroll
    for (int j = 0; j < 4; ++j) g[j] = *(const f32x4*)(gain + lane * 4 + 256 * j);
    for (int chunk = F.vcu; chunk < NTOK / 256; chunk += F.G) {
        const int T0 = chunk * 256;
        __syncthreads();
        u32x2 nx[4]; ssq_t nq;
        { const GAS u32x2* xr = (const GAS u32x2*)(h + (size_t)(T0 + F.wave * 32) * DM) + lane;
#pragma unroll
          for (int j = 0; j < 4; ++j) nx[j] = xr[64 * j];
          nq = ssq[T0 + F.wave * 32]; }
        for (int i = 0; i < 32; ++i) {
            const int tl = F.wave * 32 + i, m = T0 + tl;
            u32x2 cw[4];
#pragma unroll
            for (int j = 0; j < 4; ++j) cw[j] = nx[j];
            const float rstd = rstd_of(nq);
            if (i + 1 < 32) { const GAS u32x2* xr = (const GAS u32x2*)(h + (size_t)(m + 1) * DM) + lane;
#pragma unroll
                for (int j = 0; j < 4; ++j) nx[j] = xr[64 * j];
                nq = ssq[m + 1]; }
            f32x4 v[4];
#pragma unroll
            for (int j = 0; j < 4; ++j) { const u32x2 w = cw[j]; v[j] = (f32x4){bflo(w.x), bfhi(w.x), bflo(w.y), bfhi(w.y)} * rstd * g[j]; }
            float lg[8];
#pragma unroll
            for (int e = 0; e < 8; ++e) { float p = 0.f;
#pragma unroll
                for (int j = 0; j < 4; ++j) { const f32x4 r4 = *(const LAS f32x4*)(rt + e * DM + lane * 4 + 256 * j); p += (v[j].x * r4.x + v[j].y * r4.y) + (v[j].z * r4.z + v[j].w * r4.w); }
                lg[e] = wave_sum(p); }
            int e0 = 0; float l0 = lg[0];
#pragma unroll
            for (int e = 1; e < 8; ++e) if (lg[e] > l0) { l0 = lg[e]; e0 = e; }
            int e1 = e0 == 0 ? 1 : 0; float l1 = lg[e0 == 0 ? 1 : 0];
#pragma unroll
            for (int e = 0; e < 8; ++e) if (e != e0 && lg[e] > l1) { l1 = lg[e]; e1 = e; }
            const float g0 = 1.0f / (1.0f + __expf(l1 - l0)), g1 = 1.0f - g0;
            if (lane == 0) { esel[2 * tl] = e0; esel[2 * tl + 1] = e1; rsd[tl] = rstd; unsigned* ti = tokinfo + (size_t)m * 8;
                ti[0] = (unsigned)e0; ti[2] = __float_as_uint(g0); ti[4] = (unsigned)e1; ti[6] = __float_as_uint(g1); }
        }
        __syncthreads();
        const int me = esel[F.tid]; int myrank = 0;
#pragma unroll
        for (int e = 0; e < 8; ++e) { const unsigned long long mask = __ballot(me == e); if (me == e) myrank = __popcll(mask & ((1ull << lane) - 1ull)); if (lane == 0) wt[F.wave * 8 + e] = __popcll(mask); }
        __syncthreads();
        int off = 0;
        for (int w = 0; w < F.wave; ++w) off += wt[w * 8 + me];
        if (F.tid < 8) { int tot = 0; for (int w = 0; w < 8; ++w) tot += wt[w * 8 + F.tid]; base[F.tid] = (int)__hip_atomic_fetch_add(cntw + 64 * F.tid, (unsigned)tot, RLX_AGENT); }
        __syncthreads();
        const int rank = base[me] + off + myrank, tok = T0 + (F.tid >> 1);
        list[(size_t)me * NTOK + rank] = tok; rsl[(size_t)me * NTOK + rank] = rsd[F.tid >> 1];
        tokinfo[(size_t)tok * 8 + (F.tid & 1) * 4 + 1] = (unsigned)rank;
    }
}
template <bool GATHER>
struct MoeOrder {
    static constexpr size_t A_BLK = GATHER ? 0 : (size_t)256 * FFEP * 2, B_EXP = GATHER ? (size_t)2 * FFEP * DM * 2 : (size_t)DM * FFEP * 2, B_TILE = GATHER ? (size_t)256 * DM * 2 : (size_t)256 * FFEP * 2;
    static constexpr int NT = GATHER ? 2 * FFEP / 256 : DM / 256;
    const char* A; const char* B; const int* list; const unsigned* cntw; int G, c; unsigned bs[9];
    __device__ __forceinline__ void init(const unsigned* cntw_, const void* A_, const void* B_, const int* list_, int G_, int c_) {
        A = (const char*)A_; B = (const char*)B_; list = list_; cntw = cntw_; G = G_; c = c_; bs[0] = 0u;
#pragma unroll
        for (int e = 0; e < 8; ++e) { const unsigned ce = rfl(__hip_atomic_load((unsigned*)cntw + 64 * e, RLX_AGENT)); bs[e + 1] = bs[e] + ((ce + 255u) >> 8); }
    }
    __device__ __forceinline__ bool next(int i, pg8::Unit& u) const {
        const long L = (long)i * G + c; if (L >= (long)bs[8] * NT) return false;
        const unsigned blk = (unsigned)(L / NT); const int pn = (int)(L % NT);
        unsigned e = 0u, st = 0u;
#pragma unroll
        for (int k = 1; k < 8; ++k) if (blk >= bs[k]) { e = (unsigned)k; st = bs[k]; }
        const unsigned j = blk - st;
        u.b = B + (size_t)e * B_EXP + (size_t)pn * B_TILE; u.orow = (int)(blk * 256u); u.pn = pn; u.aux = (int)e;
        if constexpr (GATHER) { const unsigned ce = rfl(__hip_atomic_load((unsigned*)cntw + 64 * e, RLX_AGENT));
            u.a = A; u.rows = list + (size_t)e * NTOK + (size_t)j * 256; const unsigned rem = ce - j * 256u; u.nrows = rem < 256u ? (int)rem : 256; }
        else { u.a = A + (size_t)blk * A_BLK; u.rows = nullptr; u.nrows = 256; }
        return true;
    }
};
constexpr int NPHASE = 27;
struct Args { const float* in[20]; float* out; unsigned char* ws; int ph_lo, ph_hi, li, pad; };
#ifndef MK_REP_MASK
#define MK_REP_MASK 0
#endif
#ifndef MK_REP_N
#define MK_REP_N 1
#endif
constexpr int PT_OFF = LDSCTL_OFF + 512;
__device__ __forceinline__ unsigned long long ptab_u64(LAS unsigned char* L, int i) {
    const volatile LAS unsigned* p = (const volatile LAS unsigned*)(L + PT_OFF + 8 * i); const unsigned lo = rfl(p[0]), hi = rfl(p[1]); return ((unsigned long long)hi << 32) | lo; }
__device__ __forceinline__ const float* ptab(LAS unsigned char* L, int i) { return (const float*)ptab_u64(L, i); }
__device__ __forceinline__ Frame make_frame(LAS unsigned char* L) {
    Frame F; F.lds = L; F.MISC = (volatile LAS unsigned*)(L + MISC_OFF); F.tid = launder_v((int)threadIdx.x); F.lane = F.tid & 63; F.wave = __builtin_amdgcn_readfirstlane(F.tid >> 6);
    F.G = gridDim.x; { const int bx = blockIdx.x; F.vcu = (F.G % 8 == 0) ? (bx % 8) * (F.G / 8) + bx / 8 : bx; }
    F.ws = (unsigned char*)ptab_u64(L, 21); F.ctl = (gu32*)(F.ws + WS_CTL); return F;
}
__global__ void __launch_bounds__(NWAVES * 64, 2) fwd(Args args) {
    extern __shared__ __attribute__((aligned(16))) unsigned char lds[];
    LAS unsigned char* L = (LAS unsigned char*)lds;
    { const int tid = threadIdx.x;
      for (int u = tid; u < (LDS_BYTES - LDSCTL_OFF) / 4; u += NWAVES * 64) ((LAS unsigned*)(L + LDSCTL_OFF))[u] = 0u;
      __syncthreads();
      if (tid < 20) *(LAS unsigned long long*)(L + PT_OFF + 8 * tid) = (unsigned long long)args.in[tid];
      if (tid == 20) *(LAS unsigned long long*)(L + PT_OFF + 8 * 20) = (unsigned long long)args.out;
      if (tid == 21) *(LAS unsigned long long*)(L + PT_OFF + 8 * 21) = (unsigned long long)args.ws;
      if (tid == 22) *(LAS unsigned long long*)(L + PT_OFF + 8 * 22) = (unsigned long long)args.pad;
      __syncthreads(); }
    const int lo = args.ph_lo, hi = args.ph_hi;
    XcdBarrier bar; { gu32* ctl = (gu32*)(args.ws + WS_CTL); bar.bar = (unsigned*)(ctl + CW_BAR) + args.li * XCD_BAR_WORDS; bar.x = 0; bar.st = nullptr;
      if (threadIdx.x == 0) { const unsigned long long ba = (unsigned long long)((unsigned*)(ctl + CW_BAR) + args.li * XCD_BAR_WORDS); ((volatile LAS unsigned*)(L + MISC_OFF))[10] = (unsigned)ba; ((volatile LAS unsigned*)(L + MISC_OFF))[11] = (unsigned)(ba >> 32); }
      if (hi - lo > 1) bar = xcd_barrier_post((unsigned*)(ctl + CW_BAR) + args.li * XCD_BAR_WORDS, (volatile LAS unsigned*)(L + MISC_OFF) + 8);
      __syncthreads(); }
#ifndef MK_ONLY
#define MK_ONLY (-1)
#endif
#define KIND(k) ((k) == 0 ? 0 : 1 + ((k) - 1) % 13)
#ifndef MK_SKIPMASK
#define MK_SKIPMASK 0
#endif
#define IN(k) ((MK_ONLY < 0 || KIND(k) == MK_ONLY) && !((MK_SKIPMASK >> KIND(k)) & 1) && lo <= (k) && (k) < hi)
#define FORREP(k)
#if MK_REP_MASK
#define LASTREP (ptab_u64(L, 22) == 0ull)
#else
#define LASTREP true
#endif
#define SEAM(k) do { if ((k) + 1 < hi) xcd_barrier(bar); } while (0)
#define WSP(off) ((bf16_t*)(F.ws + (off)))
#define SSQ(i) ((ssq_t*)(F.ws + WS_SSQ) + (size_t)(i) * NTOK)
    LAS unsigned char* ring = L + RING_OFF;

    if (IN(0)) FORREP(0) { Frame F = make_frame(L); p0_prologue(F); SEAM(0); }

    for (int lp = 0; lp < 2; ++lp) {
        const int pb = 1 + 13 * lp;
        if (IN(pb + 0)) FORREP(pb + 0) { Frame F = make_frame(L);
            pg8::RegOrder S; S.init(WSP(WS_H), DM * 2, WSP(WS_WDN) + (size_t)lp * NDOWNP * DM, DM * 2, NTOK, NDOWNP, F.G, (int)blockIdx.x);
            pg8::EpiDown E{WSP(WS_DOWN), WSP(WS_KR), SSQ(4 * lp + 0), SSQ(10 + 2 * lp), SSQ(11 + 2 * lp), (const float*)(F.ws + WS_COS), (const float*)(F.ws + WS_SIN)};
            pg8::gemm_phase<pg8::EpiDown, pg8::RegOrder, false>(ring, DM * 2, DM * 2, DM, S, E);
            SEAM(pb + 0);
        }
        if (IN(pb + 1)) FORREP(pb + 1) { Frame F = make_frame(L);
            pg8::RegOrder S; S.init(WSP(WS_DOWN), NDOWNP * 2, WSP(WS_WUQ) + (size_t)lp * NQ * QLR, QLR * 2, NTOK, NQ, F.G, (int)blockIdx.x);
            pg8::EpiQ E{WSP(WS_Q), (const float*)(F.ws + WS_COS), (const float*)(F.ws + WS_SIN), SSQ(10 + 2 * lp)};
            pg8::gemm_phase<pg8::EpiQ, pg8::RegOrder, false>(ring, NDOWNP * 2, QLR * 2, QLR, S, E);
            SEAM(pb + 1);
        }
        if (IN(pb + 2)) FORREP(pb + 2) { Frame F = make_frame(L);
            pg8::RegOrder S; S.init(WSP(WS_DOWN) + QLR, NDOWNP * 2, WSP(WS_WUKV) + (size_t)lp * NKV * KVLR, KVLR * 2, NTOK, NKV, F.G, (int)blockIdx.x);
            pg8::EpiBf16<2> E{WSP(WS_KNV), NKV, SSQ(11 + 2 * lp)};
            pg8::gemm_phase<pg8::EpiBf16<2>, pg8::RegOrder, false>(ring, NDOWNP * 2, KVLR * 2, KVLR, S, E);
            SEAM(pb + 2);
        }
        if (IN(pb + 3)) FORREP(pb + 3) { Frame F = make_frame(L); att::attn_phase((char*)lds + RING_OFF, WSP(WS_Q), WSP(WS_KNV), WSP(WS_KR), WSP(WS_DOWN), F.vcu, F.G); SEAM(pb + 3); }
        if (IN(pb + 4)) FORREP(pb + 4) { Frame F = make_frame(L);
            pg8::RegOrder S; S.init(WSP(WS_DOWN), DM * 2, WSP(WS_WO) + (size_t)lp * DM * DM, DM * 2, NTOK, DM, F.G, (int)blockIdx.x);
            pg8::EpiResidH E{WSP(WS_H), LASTREP ? WSP(WS_H) : WSP(WS_DUMMY), LASTREP ? SSQ(4 * lp + 1) : SSQ(9)};
            pg8::gemm_phase<pg8::EpiResidH, pg8::RegOrder, false>(ring, DM * 2, DM * 2, DM, S, E);
            SEAM(pb + 4);
        }
        if (IN(pb + 5)) FORREP(pb + 5) { Frame F = make_frame(L);
            pg8::RegOrder S; S.init(WSP(WS_H), DM * 2, WSP(WS_WGU) + (size_t)lp * 2 * FFD * DM, DM * 2, NTOK, 2 * FFD, F.G, (int)blockIdx.x);
            pg8::EpiSwiglu<1> E{WSP(WS_HID), FFD, SSQ(4 * lp + 1), nullptr};
            pg8::gemm_phase<pg8::EpiSwiglu<1>, pg8::RegOrder, false>(ring, DM * 2, DM * 2, DM, S, E);
            SEAM(pb + 5);
        }
        if (IN(pb + 6)) FORREP(pb + 6) { Frame F = make_frame(L);
            pg8::RegOrder S; S.init(WSP(WS_HID), FFD * 2, WSP(WS_WD) + (size_t)lp * DM * FFD, FFD * 2, NTOK, DM, F.G, (int)blockIdx.x);
            pg8::EpiResidH E{WSP(WS_H), LASTREP ? WSP(WS_H) : WSP(WS_DUMMY), LASTREP ? SSQ(4 * lp + 2) : SSQ(9)};
            pg8::gemm_phase<pg8::EpiResidH, pg8::RegOrder, false>(ring, FFD * 2, FFD * 2, FFD, S, E);
            SEAM(pb + 6);
        }
        if (IN(pb + 7)) FORREP(pb + 7) { Frame F = make_frame(L); pool_phase(F, WSP(WS_H), SSQ(4 * lp + 2), ptab(L, 2) + (size_t)(2 * lp + 1) * DM, WSP(WS_DOWN)); SEAM(pb + 7); }
        if (IN(pb + 8)) FORREP(pb + 8) { Frame F = make_frame(L);
            pg8::RegOrder S; S.init(WSP(WS_DOWN), DM * 2, WSP(WS_WPOOL) + (size_t)lp * 4 * 256 * 256, 256 * 2, NTOK, DM, F.G, (int)blockIdx.x, 256 * 2);
            pg8::EpiResidH E{WSP(WS_H), LASTREP ? WSP(WS_H) : WSP(WS_DUMMY), LASTREP ? SSQ(4 * lp + 3) : SSQ(9)};
            pg8::gemm_phase<pg8::EpiResidH, pg8::RegOrder, false>(ring, DM * 2, 256 * 2, 256, S, E);
            SEAM(pb + 8);
        }
        if (IN(pb + 9)) FORREP(pb + 9) { Frame F = make_frame(L);
            router_phase(F, WSP(WS_H), SSQ(4 * lp + 3), ptab(L, 3) + (size_t)(2 * lp + 1) * DM, ptab(L, 15) + (size_t)lp * DM * NEXP, (int*)(F.ws + WS_LIST), (float*)(F.ws + WS_RSL), (unsigned*)(F.ws + WS_TOKINFO), (unsigned*)(F.ctl + CW_CNT) + lp * 8 * 64); SEAM(pb + 9); }
        if (IN(pb + 10)) FORREP(pb + 10) { Frame F = make_frame(L);
            MoeOrder<true> S; S.init((unsigned*)(F.ctl + CW_CNT) + lp * 8 * 64, WSP(WS_H), WSP(WS_MWGU) + (size_t)lp * 8 * 2 * FFEP * DM, (const int*)(F.ws + WS_LIST), F.G, (int)blockIdx.x);
            pg8::EpiSwiglu<2> E{WSP(WS_HID), FFEP, (const float*)(F.ws + WS_RSL), (const int*)(F.ws + WS_LIST)};
            pg8::gemm_phase<pg8::EpiSwiglu<2>, MoeOrder<true>, true>(ring, DM * 2, DM * 2, DM, S, E);
            SEAM(pb + 10);
        }
        if (IN(pb + 11)) FORREP(pb + 11) { Frame F = make_frame(L);
            MoeOrder<false> S; S.init((unsigned*)(F.ctl + CW_CNT) + lp * 8 * 64, WSP(WS_HID), WSP(WS_MWD) + (size_t)lp * 8 * DM * FFEP, (const int*)(F.ws + WS_LIST), F.G, (int)blockIdx.x);
            pg8::EpiBf16<0> E{WSP(WS_YB), DM, nullptr};
            pg8::gemm_phase<pg8::EpiBf16<0>, MoeOrder<false>, false>(ring, FFEP * 2, FFEP * 2, FFEP, S, E);
            SEAM(pb + 11);
        }
        if (IN(pb + 12)) FORREP(pb + 12) { Frame F = make_frame(L);
            if (lp == 0) combine_phase<false>(F, WSP(WS_H), WSP(WS_YB), (const unsigned*)(F.ws + WS_TOKINFO), (unsigned*)(F.ctl + CW_CNT), SSQ(4), nullptr, nullptr);
            else combine_phase<true>(F, WSP(WS_H), WSP(WS_YB), (const unsigned*)(F.ws + WS_TOKINFO), (unsigned*)(F.ctl + CW_CNT) + 8 * 64, nullptr, ptab(L, 19), (float*)ptab(L, 20));
            SEAM(pb + 12);
        }
    }
#undef IN
#undef SEAM
#undef WSP
#undef SSQ
}

#ifndef MK_PER_PHASE
#define MK_PER_PHASE 0
#endif
extern "C" void kernel_launch(void* const* d_in, const int* in_sizes, int n_in, void* d_out, int out_size, void* d_ws, size_t ws_size, hipStream_t stream) {
    static int grid = 0;
    if (grid == 0) {
        if (n_in != 20 || in_sizes[0] != NTOK * DM || out_size != NTOK * DM || ws_size < WS_END) { fprintf(stderr, "kernel_launch: unexpected shapes (n_in %d, in0 %d, out %d, ws %zu < %zu)\n", n_in, n_in > 0 ? in_sizes[0] : -1, out_size, ws_size, (size_t)WS_END); grid = -1; return; }
        int dev = 0, cus = 0, per_cu = 0;
        if (hipGetDevice(&dev) != hipSuccess || hipDeviceGetAttribute(&cus, hipDeviceAttributeMultiprocessorCount, dev) != hipSuccess) { grid = -1; return; }
        if (hipFuncSetAttribute((const void*)fwd, hipFuncAttributeMaxDynamicSharedMemorySize, LDS_BYTES) != hipSuccess) { fprintf(stderr, "kernel_launch: hipFuncSetAttribute failed\n"); grid = -1; return; }
        if (hipOccupancyMaxActiveBlocksPerMultiprocessor(&per_cu, (const void*)fwd, NWAVES * 64, LDS_BYTES) != hipSuccess || per_cu < 1) fprintf(stderr, "kernel_launch: occupancy query reports %d\n", per_cu);
        (void)hipGetLastError();
        grid = cus;
    }
    if (grid < 0) return;
    if (hipMemsetAsync((char*)d_ws + WS_CTL, 0, CTL_ZERO_BYTES, stream) != hipSuccess) return;
    Args a{};
    for (int i = 0; i < 20; ++i) a.in[i] = (const float*)d_in[i];
    a.out = (float*)d_out; a.ws = (unsigned char*)d_ws;
#if MK_PER_PHASE
    for (int p = 0; p < NPHASE; ++p) { a.ph_lo = p; a.ph_hi = p + 1; a.li = 0; hipLaunchKernelGGL(fwd, dim3(grid), dim3(NWAVES * 64), LDS_BYTES, stream, a); }
#elif MK_REP_MASK
    { int cur = 0, li = 0;
      for (int k = 0; k < NPHASE; ++k) if ((MK_REP_MASK >> (k == 0 ? 0 : 1 + (k - 1) % 13)) & 1) {
          if (k > cur) { a.ph_lo = cur; a.ph_hi = k; a.li = li++; a.pad = 0; hipLaunchKernelGGL(fwd, dim3(grid), dim3(NWAVES * 64), LDS_BYTES, stream, a); }
          for (int r = 1; r < MK_REP_N; ++r) { a.ph_lo = k; a.ph_hi = k + 1; a.li = li++; a.pad = 1; hipLaunchKernelGGL(fwd, dim3(grid), dim3(NWAVES * 64), LDS_BYTES, stream, a); }
          cur = k; }
      a.ph_lo = cur; a.ph_hi = NPHASE; a.li = li++; a.pad = 0; hipLaunchKernelGGL(fwd, dim3(grid), dim3(NWAVES * 64), LDS_BYTES, stream, a); }
#else
    a.ph_lo = 0; a.ph_hi = NPHASE; a.li = 0;
    hipLaunchKernelGGL(fwd, dim3(grid), dim3(NWAVES * 64), LDS_BYTES, stream, a);
#endif
}
```

```cpp
#include <hip/hip_runtime.h>
#include <cstdio>
#include <cstdint>

#define GAS __attribute__((address_space(1)))
#define LAS __attribute__((address_space(3)))
typedef unsigned short bf16_t;
typedef short bf16x8 __attribute__((ext_vector_type(8)));
typedef short s16x4 __attribute__((ext_vector_type(4)));
typedef float f32x2 __attribute__((ext_vector_type(2)));
typedef float f32x4 __attribute__((ext_vector_type(4)));
typedef float f32x16 __attribute__((ext_vector_type(16)));
typedef unsigned u32x2 __attribute__((ext_vector_type(2)));
typedef unsigned u32x4 __attribute__((ext_vector_type(4)));

constexpr int DM = 1024, NBATCH = 32, SEQ = 2048, NTOK = NBATCH * SEQ;
constexpr int NHEAD = 8, DNOPE = 128, DROPE = 64, DVH = 128, DQH = DNOPE + DROPE, QLR = 512, KVLR = 256;
constexpr int NDOWN = QLR + KVLR + DROPE  , NDOWNP = 1024;
constexpr int NQ = NHEAD * DQH  , NKV = NHEAD * (DNOPE + DVH)  ;
constexpr int FFD = 2688, NEXP = 8, FFE = 1344, FFEP = 1408;
constexpr int PSLOT = (NTOK * 2 / 256 + NEXP) * 256;
constexpr float RMS_EPS = 1e-6f;

__device__ __forceinline__ unsigned cvt_pk_bf16(float lo, float hi) { unsigned r; asm volatile("v_cvt_pk_bf16_f32 %0, %1, %2" : "=v"(r) : "v"(lo), "v"(hi)); return r; }
__device__ __forceinline__ int launder_v(int v) { asm volatile("" : "+v"(v)); return v; }
__device__ __forceinline__ float fp8_rt(float x, float s) { const int p = __builtin_amdgcn_cvt_pk_fp8_f32(x * s, 0.f, 0, false); return __builtin_amdgcn_cvt_f32_fp8(p, 0) * (1.0f / s); }
__device__ __forceinline__ float bf2f(unsigned short b) { return __uint_as_float((unsigned)b << 16); }
__device__ __forceinline__ float bflo(unsigned w) { return __uint_as_float(w << 16); }
__device__ __forceinline__ float bfhi(unsigned w) { return __uint_as_float(w & 0xffff0000u); }

typedef unsigned long long ssq_t;
__device__ __forceinline__ ssq_t ssq_fix(float s) { return (ssq_t)(s * 16777216.0f); }
__device__ __forceinline__ float rstd_n(ssq_t q, float invn) { return 1.0f / sqrtf((float)q * (1.0f / 16777216.0f) * invn + RMS_EPS); }
__device__ __forceinline__ float rstd_of(ssq_t q) { return rstd_n(q, 1.0f / DM); }
__device__ __forceinline__ float rstd_f(float ssq) { return 1.0f / sqrtf(ssq * (1.0f / DM) + RMS_EPS); }

namespace pg8 {
constexpr int BM = 256, BK = 64, HALF = 128, HTB = HALF * BK * 2  , STAGE_BYTES = 8 * HTB, NXCD = 8, WGM = 8;
__host__ __device__ __forceinline__ int lds_byte(int r, int c) { const int st = (r >> 4) * 2 + (c >> 5), rr = r & 15, cc = c & 31, ob = rr * 64 + cc * 2; return st * 1024 + (ob ^ (((ob >> 9) & 1) << 5)); }
__host__ __device__ __forceinline__ void stage_rc(int b, int& R, int& C) { const int st = b / 1024, sb = b % 1024, swz = sb ^ (((sb >> 9) & 1) << 5); R = (st >> 1) * 16 + swz / 64; C = (st & 1) * 32 + (swz % 64) / 2; }
__host__ __device__ __forceinline__ int perm32(int rho) { const int n = rho >> 4, i = rho & 15; return 8 * (i >> 2) + 4 * n + (i & 3); }

struct Unit { const char* a; const char* b; const int* rows; int nrows; int orow; int pn; int aux; };

struct RegOrder {
    const char* A; const char* B; unsigned a_tile, b_tile, a_colstep; int nM, nN, nwg, G, c;
    __device__ __forceinline__ void init(const void* A_, size_t lda_b, const void* B_, size_t ldb_b, int M, int N, int G_, int c_, size_t a_colstep_ = 0) {
        A = (const char*)A_; B = (const char*)B_; a_tile = (unsigned)(256 * lda_b); b_tile = (unsigned)(256 * ldb_b); a_colstep = (unsigned)a_colstep_; nM = M / BM; nN = N / BM; nwg = nM * nN; G = G_; c = c_; }
    __device__ __forceinline__ bool next(int i, Unit& u) const {
        const long L = (long)i * G + c; if (L >= nwg) return false;
        int wgid = (int)L; { const int q = nwg / NXCD, r = nwg % NXCD, xcd = wgid % NXCD, off = wgid / NXCD; wgid = (xcd < r ? xcd * (q + 1) : r * (q + 1) + (xcd - r) * q) + off; }
        const int nig = WGM * nN, gid = wgid / nig, fm = gid * WGM, gsz = (nM - fm) < WGM ? (nM - fm) : WGM;
        const int pm = fm + ((wgid % nig) % gsz), pn = (wgid % nig) / gsz;
        u.a = A + (size_t)pm * a_tile + (size_t)pn * a_colstep; u.b = B + (size_t)pn * b_tile; u.rows = nullptr; u.nrows = 256; u.orow = pm * BM; u.pn = pn; u.aux = 0; return true;
    }
};

template <int RS> struct EpiBf16 {
    static constexpr bool PERM = true;
    bf16_t* O; int ldc; const ssq_t* rs;
    __device__ __forceinline__ void operator()(const f32x4 (&acc)[2][2][4][2], const Unit& u, int wr, int wc, int fr, int fq) const {
        const int row0 = u.orow + wr * 64 + fr, col0 = u.pn * BM + wc * 32 + 8 * fq;
        float sc[2][4];
#pragma unroll
        for (int ai = 0; ai < 2; ++ai)
#pragma unroll
            for (int m = 0; m < 4; ++m) { const int row = row0 + ai * HALF + m * 16; sc[ai][m] = 1.0f; if constexpr (RS == 1) sc[ai][m] = rstd_of(rs[row]); if constexpr (RS == 2) sc[ai][m] = rstd_n(rs[row], 1.0f / KVLR); }
#pragma unroll
        for (int ai = 0; ai < 2; ++ai)
#pragma unroll
            for (int m = 0; m < 4; ++m) { const int row = row0 + ai * HALF + m * 16; bf16_t* rowp = O + (size_t)row * ldc + col0;
#pragma unroll
                for (int bj = 0; bj < 2; ++bj) { const f32x4 v0 = acc[ai][bj][m][0] * sc[ai][m], v1 = acc[ai][bj][m][1] * sc[ai][m];
                    u32x4 w; w.x = cvt_pk_bf16(v0[0], v0[1]); w.y = cvt_pk_bf16(v0[2], v0[3]); w.z = cvt_pk_bf16(v1[0], v1[1]); w.w = cvt_pk_bf16(v1[2], v1[3]);
                    *(u32x4*)(rowp + bj * HALF) = w; } }
    }
};
__device__ __forceinline__ float silu_mul(float g, float u) { return g * u * __builtin_amdgcn_rcpf(1.0f + __builtin_amdgcn_exp2f(-1.4426950408889634f * g)); }
template <int RS> struct EpiSwiglu {
    static constexpr bool PERM = true;
    bf16_t* H; int ldh; const void* rs; const int* list;
    __device__ __forceinline__ void operator()(const f32x4 (&acc)[2][2][4][2], const Unit& u, int wr, int wc, int fr, int fq) const {
        const int r0 = wr * 64 + fr, col0 = u.pn * HALF + wc * 32 + 8 * fq;
        const ssq_t* rsq = (const ssq_t*)rs; const float* rsp = (const float*)rs; if constexpr (RS == 2) rsp = rsp + (u.rows - list);
        float sc[2][4];
#pragma unroll
        for (int ai = 0; ai < 2; ++ai)
#pragma unroll
            for (int m = 0; m < 4; ++m) { const int r = r0 + ai * HALF + m * 16; if constexpr (RS == 1) sc[ai][m] = rstd_of(rsq[u.orow + r]); else sc[ai][m] = rsp[r]; }
#pragma unroll
        for (int ai = 0; ai < 2; ++ai)
#pragma unroll
            for (int m = 0; m < 4; ++m) { const int r = r0 + ai * HALF + m * 16; bf16_t* rowp = H + (size_t)(u.orow + r) * ldh + col0; const float s = sc[ai][m];
                const f32x4 g0 = acc[ai][0][m][0] * s, g1 = acc[ai][0][m][1] * s, u0 = acc[ai][1][m][0] * s, u1 = acc[ai][1][m][1] * s;
                u32x4 w; w.x = cvt_pk_bf16(silu_mul(g0[0], u0[0]), silu_mul(g0[1], u0[1])); w.y = cvt_pk_bf16(silu_mul(g0[2], u0[2]), silu_mul(g0[3], u0[3]));
                w.z = cvt_pk_bf16(silu_mul(g1[0], u1[0]), silu_mul(g1[1], u1[1])); w.w = cvt_pk_bf16(silu_mul(g1[2], u1[2]), silu_mul(g1[3], u1[3]));
                *(u32x4*)rowp = w; }
    }
};
constexpr float FP8_SA = 16.0f, FP8_SW = 256.0f, FP8_SH = 16.0f;
__device__ __forceinline__ unsigned pk4_fp8(float a, float b, float c, float d) { int p = __builtin_amdgcn_cvt_pk_fp8_f32(a, b, 0, false); p = __builtin_amdgcn_cvt_pk_fp8_f32(c, d, p, true); return (unsigned)p; }
struct EpiSwigluF8 {
    static constexpr bool PERM = true;
    unsigned char* H8; int ldh; int pad_tile;
    __device__ __forceinline__ void operator()(const f32x4 (&acc)[2][2][4][2], const Unit& u, int wr, int wc, int fr, int fq) const {
        const int r0 = wr * 64 + fr, col0 = u.pn * HALF + wc * 32 + 8 * fq; constexpr float s = 1.0f / (FP8_SA * FP8_SW);
#pragma unroll
        for (int ai = 0; ai < 2; ++ai)
#pragma unroll
            for (int m = 0; m < 4; ++m) { const int r = r0 + ai * HALF + m * 16; unsigned char* rowp = H8 + (size_t)(u.orow + r) * ldh + col0;
                const f32x4 g0 = acc[ai][0][m][0] * s, g1 = acc[ai][0][m][1] * s, u0 = acc[ai][1][m][0] * s, u1 = acc[ai][1][m][1] * s;
                u32x2 w; w.x = pk4_fp8(silu_mul(g0[0], u0[0]) * FP8_SH, silu_mul(g0[1], u0[1]) * FP8_SH, silu_mul(g0[2], u0[2]) * FP8_SH, silu_mul(g0[3], u0[3]) * FP8_SH);
                w.y = pk4_fp8(silu_mul(g1[0], u1[0]) * FP8_SH, silu_mul(g1[1], u1[1]) * FP8_SH, silu_mul(g1[2], u1[2]) * FP8_SH, silu_mul(g1[3], u1[3]) * FP8_SH);
                *(u32x2*)rowp = w;
                if (u.pn == pad_tile) *(u32x2*)(rowp + HALF) = (u32x2){0u, 0u}; }
    }
};
struct EpiBf16Scaled {
    static constexpr bool PERM = true;
    bf16_t* O; int ldc; float scale;
    __device__ __forceinline__ void operator()(const f32x4 (&acc)[2][2][4][2], const Unit& u, int wr, int wc, int fr, int fq) const {
        const int row0 = u.orow + wr * 64 + fr, col0 = u.pn * BM + wc * 32 + 8 * fq;
#pragma unroll
        for (int ai = 0; ai < 2; ++ai)
#pragma unroll
            for (int m = 0; m < 4; ++m) { bf16_t* rowp = O + (size_t)(row0 + ai * HALF + m * 16) * ldc + col0;
#pragma unroll
                for (int bj = 0; bj < 2; ++bj) { const f32x4 v0 = acc[ai][bj][m][0] * scale, v1 = acc[ai][bj][m][1] * scale;
                    u32x4 w; w.x = cvt_pk_bf16(v0[0], v0[1]); w.y = cvt_pk_bf16(v0[2], v0[3]); w.z = cvt_pk_bf16(v1[0], v1[1]); w.w = cvt_pk_bf16(v1[2], v1[3]);
                    *(u32x4*)(rowp + bj * HALF) = w; } }
    }
};
struct EpiResidH {
    static constexpr bool PERM = true;
    const bf16_t* hin; bf16_t* hout; ssq_t* ssq;
    __device__ __forceinline__ void operator()(const f32x4 (&acc)[2][2][4][2], const Unit& u, int wr, int wc, int fr, int fq) const {
        const int row0 = u.orow + wr * 64 + fr, col0 = u.pn * BM + wc * 32 + 8 * fq;
#pragma unroll
        for (int ai = 0; ai < 2; ++ai) {
            u32x4 hv[4][2];
#pragma unroll
            for (int m = 0; m < 4; ++m)
#pragma unroll
                for (int bj = 0; bj < 2; ++bj) hv[m][bj] = *(const u32x4*)(hin + (size_t)(row0 + ai * HALF + m * 16) * DM + col0 + bj * HALF);
#pragma unroll
            for (int m = 0; m < 4; ++m) { const int row = row0 + ai * HALF + m * 16; const size_t off = (size_t)row * DM + col0; float part = 0.f;
#pragma unroll
                for (int bj = 0; bj < 2; ++bj) { const u32x4 h4 = hv[m][bj]; const f32x4 a0 = acc[ai][bj][m][0], a1 = acc[ai][bj][m][1];
                    const float y0 = bflo(h4.x) + a0[0], y1 = bfhi(h4.x) + a0[1], y2 = bflo(h4.y) + a0[2], y3 = bfhi(h4.y) + a0[3], y4 = bflo(h4.z) + a1[0], y5 = bfhi(h4.z) + a1[1], y6 = bflo(h4.w) + a1[2], y7 = bfhi(h4.w) + a1[3];
                    part += (y0 * y0 + y1 * y1) + (y2 * y2 + y3 * y3) + (y4 * y4 + y5 * y5) + (y6 * y6 + y7 * y7);
                    u32x4 w; w.x = cvt_pk_bf16(y0, y1); w.y = cvt_pk_bf16(y2, y3); w.z = cvt_pk_bf16(y4, y5); w.w = cvt_pk_bf16(y6, y7);
                    *(u32x4*)(hout + off + bj * HALF) = w; }
                part += __shfl_xor(part, 16); part += __shfl_xor(part, 32);
                if (fq == 0) atomicAdd(ssq + row, ssq_fix(part)); }
        }
    }
};
struct EpiDown {
    static constexpr bool PERM = true;
    bf16_t* O; bf16_t* KR; const ssq_t* rs; ssq_t* ssq_q; ssq_t* ssq_kv; const float* cosT; const float* sinT;
    __device__ __forceinline__ void operator()(const f32x4 (&acc)[2][2][4][2], const Unit& u, int wr, int wc, int fr, int fq) const {
        const int row0 = u.orow + wr * 64 + fr;
        float sc[2][4];
#pragma unroll
        for (int ai = 0; ai < 2; ++ai)
#pragma unroll
            for (int m = 0; m < 4; ++m) sc[ai][m] = rstd_of(rs[row0 + ai * HALF + m * 16]);
        if (u.pn < 3) {
            ssq_t* sq = u.pn < 2 ? ssq_q : ssq_kv; const int col0 = u.pn * BM + wc * 32 + 8 * fq;
#pragma unroll
            for (int ai = 0; ai < 2; ++ai)
#pragma unroll
                for (int m = 0; m < 4; ++m) { const int row = row0 + ai * HALF + m * 16; bf16_t* rowp = O + (size_t)row * NDOWNP + col0; const float s = sc[ai][m]; float part = 0.f;
#pragma unroll
                    for (int bj = 0; bj < 2; ++bj) { const f32x4 v0 = acc[ai][bj][m][0] * s, v1 = acc[ai][bj][m][1] * s;
                        part += (v0[0] * v0[0] + v0[1] * v0[1]) + (v0[2] * v0[2] + v0[3] * v0[3]) + (v1[0] * v1[0] + v1[1] * v1[1]) + (v1[2] * v1[2] + v1[3] * v1[3]);
                        u32x4 w; w.x = cvt_pk_bf16(v0[0], v0[1]); w.y = cvt_pk_bf16(v0[2], v0[3]); w.z = cvt_pk_bf16(v1[0], v1[1]); w.w = cvt_pk_bf16(v1[2], v1[3]);
                        *(u32x4*)(rowp + bj * HALF) = w; }
                    part += __shfl_xor(part, 16); part += __shfl_xor(part, 32);
                    if (fq == 0) atomicAdd(sq + row, ssq_fix(part)); }
        } else if (wc == 0) {
#pragma unroll
            for (int aq = 0; aq < 4; ++aq) { const int ai = aq >> 1, mb = (aq & 1) * 2; f32x4 ct[4][2], st[4][2];
#pragma unroll
                for (int m = mb; m < mb + 2; ++m) { const size_t to = (size_t)(row0 + ai * HALF + m * 16) * 32 + 8 * fq;
                    ct[m][0] = *(const f32x4*)(cosT + to); ct[m][1] = *(const f32x4*)(cosT + to + 4); st[m][0] = *(const f32x4*)(sinT + to); st[m][1] = *(const f32x4*)(sinT + to + 4); }
#pragma unroll
                for (int m = mb; m < mb + 2; ++m) { const int row = row0 + ai * HALF + m * 16; const float s = sc[ai][m];
                    const f32x4 a0 = acc[ai][0][m][0] * s, a1 = acc[ai][0][m][1] * s, b0 = acc[ai][1][m][0] * s, b1 = acc[ai][1][m][1] * s;
                    const f32x4 x0 = a0 * ct[m][0] - b0 * st[m][0], x1 = a1 * ct[m][1] - b1 * st[m][1], y0 = b0 * ct[m][0] + a0 * st[m][0], y1 = b1 * ct[m][1] + a1 * st[m][1];
                    bf16_t* rp = KR + (size_t)row * DROPE + 8 * fq;
                    u32x4 w; w.x = cvt_pk_bf16(x0[0], x0[1]); w.y = cvt_pk_bf16(x0[2], x0[3]); w.z = cvt_pk_bf16(x1[0], x1[1]); w.w = cvt_pk_bf16(x1[2], x1[3]);
                    *(u32x4*)rp = w;
                    w.x = cvt_pk_bf16(y0[0], y0[1]); w.y = cvt_pk_bf16(y0[2], y0[3]); w.z = cvt_pk_bf16(y1[0], y1[1]); w.w = cvt_pk_bf16(y1[2], y1[3]);
                    *(u32x4*)(rp + 32) = w; } }
        }
    }
};
struct EpiQ {
    static constexpr bool PERM = true;
    bf16_t* Q; const float* cosT; const float* sinT; const ssq_t* rs;
    __device__ __forceinline__ void operator()(const f32x4 (&acc)[2][2][4][2], const Unit& u, int wr, int wc, int fr, int fq) const {
        const int row0 = u.orow + wr * 64 + fr;
        float sc[2][4];
#pragma unroll
        for (int ai = 0; ai < 2; ++ai)
#pragma unroll
            for (int m = 0; m < 4; ++m) sc[ai][m] = rstd_n(rs[row0 + ai * HALF + m * 16], 1.0f / QLR);
        if (u.pn < 2) {
            const int h = 4 * u.pn + wc;
#pragma unroll
            for (int aq = 0; aq < 4; ++aq) { const int ai = aq >> 1, mb = (aq & 1) * 2; f32x4 ct[4][2], st[4][2];
#pragma unroll
                for (int m = mb; m < mb + 2; ++m) { const size_t to = (size_t)(row0 + ai * HALF + m * 16) * 32 + 8 * fq;
                    ct[m][0] = *(const f32x4*)(cosT + to); ct[m][1] = *(const f32x4*)(cosT + to + 4); st[m][0] = *(const f32x4*)(sinT + to); st[m][1] = *(const f32x4*)(sinT + to + 4); }
#pragma unroll
                for (int m = mb; m < mb + 2; ++m) { const int row = row0 + ai * HALF + m * 16; const float s = sc[ai][m];
                    const f32x4 a0 = acc[ai][0][m][0] * s, a1 = acc[ai][0][m][1] * s, b0 = acc[ai][1][m][0] * s, b1 = acc[ai][1][m][1] * s;
                    const f32x4 x0 = a0 * ct[m][0] - b0 * st[m][0], x1 = a1 * ct[m][1] - b1 * st[m][1], y0 = b0 * ct[m][0] + a0 * st[m][0], y1 = b1 * ct[m][1] + a1 * st[m][1];
                    bf16_t* rp = Q + (size_t)row * NQ + h * DQH + DNOPE + 8 * fq;
                    u32x4 w; w.x = cvt_pk_bf16(x0[0], x0[1]); w.y = cvt_pk_bf16(x0[2], x0[3]); w.z = cvt_pk_bf16(x1[0], x1[1]); w.w = cvt_pk_bf16(x1[2], x1[3]);
                    *(u32x4*)rp = w;
                    w.x = cvt_pk_bf16(y0[0], y0[1]); w.y = cvt_pk_bf16(y0[2], y0[3]); w.z = cvt_pk_bf16(y1[0], y1[1]); w.w = cvt_pk_bf16(y1[2], y1[3]);
                    *(u32x4*)(rp + 32) = w; } }
        } else {
#pragma unroll
            for (int ai = 0; ai < 2; ++ai)
#pragma unroll
                for (int m = 0; m < 4; ++m) { const int row = row0 + ai * HALF + m * 16; const float s = sc[ai][m];
#pragma unroll
                    for (int bj = 0; bj < 2; ++bj) { const int h = 2 * (u.pn - 2) + bj; const f32x4 v0 = acc[ai][bj][m][0] * s, v1 = acc[ai][bj][m][1] * s;
                        u32x4 w; w.x = cvt_pk_bf16(v0[0], v0[1]); w.y = cvt_pk_bf16(v0[2], v0[3]); w.z = cvt_pk_bf16(v1[0], v1[1]); w.w = cvt_pk_bf16(v1[2], v1[3]);
                        *(u32x4*)(Q + (size_t)row * NQ + h * DQH + wc * 32 + 8 * fq) = w; } }
        }
    }
};

__device__ __forceinline__ unsigned gather_off(const Unit& u, int idx, unsigned lda_b, unsigned cb) { const int tok = idx < u.nrows ? u.rows[idx] : 0; return (unsigned)tok * lda_b + cb; }
__device__ __forceinline__ u32x4 gather_offs(const Unit& u, int tid, unsigned lda_b) {
    const int t2 = launder_v(tid); int R0, C0, R1, C1; stage_rc(t2 * 16, R0, C0); stage_rc(t2 * 16 + 8192, R1, C1);
    u32x4 pk; pk.x = gather_off(u, R0, lda_b, (unsigned)C0 * 2u); pk.y = gather_off(u, R1, lda_b, (unsigned)C1 * 2u); pk.z = gather_off(u, HALF + R0, lda_b, (unsigned)C0 * 2u); pk.w = gather_off(u, HALF + R1, lda_b, (unsigned)C1 * 2u);
    return pk;
}
typedef int i32x4 __attribute__((ext_vector_type(4)));
typedef int i32x8 __attribute__((ext_vector_type(8)));
template <class Epi, class Sched, bool GATHER, bool FP8 = false>
__device__ __forceinline__ void gemm_phase(LAS unsigned char* lds, const unsigned lda_b, const unsigned ldb_b, const int Kb, const Sched& S, const Epi& E) {
    const int tid = launder_v((int)threadIdx.x), wid = __builtin_amdgcn_readfirstlane(tid >> 6), lane = tid & 63, wr = wid >> 2, wc = wid & 3, fr = lane & 15, fq = lane >> 4;
    int nt = Kb / (BK * 2); asm volatile("" : "+s"(nt));
    unsigned voffA[2], voffB[2];
#pragma unroll
    for (int i = 0; i < 2; ++i) { int R, C; stage_rc(tid * 16 + i * 8192, R, C); const int Rb = Epi::PERM ? ((R & ~31) + perm32(R & 31)) : R;
        voffA[i] = (unsigned)R * lda_b + (unsigned)C * 2u; voffB[i] = (unsigned)Rb * ldb_b + (unsigned)C * 2u; }
    const size_t kstep = (size_t)(BK * 2);
    const size_t hstepA = (size_t)HALF * lda_b, hstepB = (size_t)HALF * ldb_b;
    const unsigned ldsw = (unsigned)wid * 1024u;
    const int aoff = lds_byte(wr * 64 + fr, fq * 8), boff = lds_byte(wc * 32 + fr, fq * 8);
    unsigned cv0[2] = {0u, 0u}, cv1[2] = {0u, 0u}, nv0[2] = {0u, 0u}, nv1[2] = {0u, 0u};
#define PG8_SA(b, h) (((b) * 2 + (h)) * HTB)
#define PG8_SB(b, h) ((4 + (b) * 2 + (h)) * HTB)
#define PG8_LOAD16(gp, ldsoff) __builtin_amdgcn_global_load_lds((const unsigned*)(gp), (LAS unsigned*)(lds + (ldsoff)), 16, 0, 0)
#define PG8_STAGE_B(bufoff, gbase, h) do { _Pragma("unroll") for (int _i = 0; _i < 2; ++_i) PG8_LOAD16((gbase) + (h) * hstepB + voffB[_i], (bufoff) + ldsw + _i * 8192); } while (0)
#define PG8_STAGE_A(bufoff, gbase, h, usenext) do { _Pragma("unroll") for (int _i = 0; _i < 2; ++_i) { unsigned _vo; \
        if constexpr (GATHER) { _vo = (usenext) ? ((h) ? nv1[_i] : nv0[_i]) : ((h) ? cv1[_i] : cv0[_i]); } else { _vo = voffA[_i] + (unsigned)((h) * hstepA); } \
        PG8_LOAD16((gbase) + _vo, (bufoff) + ldsw + _i * 8192); } } while (0)
#define PG8_LD32(off) __builtin_shufflevector(*(const LAS i32x4*)(lds + (off)), *(const LAS i32x4*)(lds + (off) + 1024), 0, 1, 2, 3, 4, 5, 6, 7)
#define PG8_LDA(dst, b, h) do { _Pragma("unroll") for (int m = 0; m < 4; ++m) { if constexpr (FP8) { dst##8[m] = PG8_LD32(PG8_SA(b, h) + aoff + m * 2048); } else { _Pragma("unroll") for (int k = 0; k < 2; ++k) dst[m][k] = *(const LAS bf16x8*)(lds + PG8_SA(b, h) + aoff + m * 2048 + k * 1024); } } } while (0)
#define PG8_LDB(dst, b, h) do { _Pragma("unroll") for (int n = 0; n < 2; ++n) { if constexpr (FP8) { dst##8[n] = PG8_LD32(PG8_SB(b, h) + boff + n * 2048); } else { _Pragma("unroll") for (int k = 0; k < 2; ++k) dst[n][k] = *(const LAS bf16x8*)(lds + PG8_SB(b, h) + boff + n * 2048 + k * 1024); } } } while (0)
#define PG8_MMA(ai, bj, At, Bt) do { __builtin_amdgcn_s_setprio(1); _Pragma("unroll") for (int m = 0; m < 4; ++m) _Pragma("unroll") for (int n = 0; n < 2; ++n) { \
        if constexpr (FP8) { asm volatile("v_mfma_f32_16x16x128_f8f6f4 %0, %1, %2, %0" : "+v"(acc[ai][bj][m][n]) : "v"(Bt##8[n]), "v"(At##8[m])); }     \
        else { _Pragma("unroll") for (int k = 0; k < 2; ++k) acc[ai][bj][m][n] = __builtin_amdgcn_mfma_f32_16x16x32_bf16(Bt[n][k], At[m][k], acc[ai][bj][m][n], 0, 0, 0); } } \
        __builtin_amdgcn_s_setprio(0); } while (0)
#define PG8_WAIT_V(n) asm volatile("s_waitcnt vmcnt(" #n ")" ::: "memory")
#define PG8_WAIT_L(n) asm volatile("s_waitcnt lgkmcnt(" #n ")" ::: "memory")
#define PG8_BAR __builtin_amdgcn_s_barrier()
#define PG8_SCHED __builtin_amdgcn_sched_barrier(0)
    Unit cur, nxt; int ui = 0;
    if (!S.next(0, cur)) return;
    f32x4 acc[2][2][4][2];
#pragma unroll
    for (int a = 0; a < 2; ++a)
#pragma unroll
        for (int b = 0; b < 2; ++b)
#pragma unroll
            for (int m = 0; m < 4; ++m)
#pragma unroll
                for (int n = 0; n < 2; ++n) acc[a][b][m][n] = (f32x4){0.f, 0.f, 0.f, 0.f};
    bf16x8 At[4][2], B0[2][2], B1[2][2]; i32x8 At8[4], B08[2], B18[2];
    const char* cA = cur.a; const char* cB = cur.b;
    if constexpr (GATHER) { const u32x4 pk = gather_offs(cur, tid, lda_b); cv0[0] = pk.x; cv0[1] = pk.y; cv1[0] = pk.z; cv1[1] = pk.w; }
    PG8_STAGE_B(PG8_SB(0, 0), cB, 0); PG8_STAGE_B(PG8_SB(0, 1), cB, 1); PG8_STAGE_A(PG8_SA(0, 0), cA, 0, false); PG8_STAGE_A(PG8_SA(0, 1), cA, 1, false);
    if (wr == 1) PG8_BAR;
    PG8_WAIT_V(2); PG8_BAR;
    PG8_STAGE_B(PG8_SB(1, 0), cB + kstep, 0); PG8_STAGE_A(PG8_SA(1, 0), cA + kstep, 0, false); PG8_STAGE_B(PG8_SB(1, 1), cB + kstep, 1);
    PG8_WAIT_V(6); PG8_BAR;
    for (;;) {
        const bool has_next = S.next(ui + 1, nxt);
        const char* nA = has_next ? nxt.a : cA; const char* nB = has_next ? nxt.b : cB;
        if constexpr (GATHER) {
            u32x4 pk = (u32x4){cv0[0], cv0[1], cv1[0], cv1[1]}; if (has_next) pk = gather_offs(nxt, tid, lda_b);
            *(LAS u32x4*)(lds + STAGE_BYTES + 1024 + tid * 16) = pk;
        }
#pragma nounroll
        for (int t = 0; t < nt; t += 2) {
            const bool last = (t == nt - 2);
            if constexpr (GATHER) { if (last) { const u32x4 pk = *(const LAS u32x4*)(lds + STAGE_BYTES + 1024 + tid * 16); nv0[0] = pk.x; nv0[1] = pk.y; nv1[0] = pk.z; nv1[1] = pk.w; } }
            const char* a1 = cA + (size_t)(t + 1) * kstep;
            const char* a2 = last ? nA : cA + (size_t)(t + 2) * kstep; const char* b2 = last ? nB : cB + (size_t)(t + 2) * kstep;
            const char* a3 = a2 + kstep; const char* b3 = b2 + kstep;
            PG8_LDB(B0, 0, 0); PG8_LDB(B1, 0, 1); PG8_SCHED; PG8_LDA(At, 0, 0); PG8_STAGE_A(PG8_SA(1, 1), a1, 1, false);
            PG8_WAIT_V(8); PG8_WAIT_L(0); PG8_BAR; PG8_MMA(0, 0, At, B0); PG8_MMA(0, 1, At, B1); PG8_BAR; PG8_SCHED;
            PG8_LDA(At, 0, 1); PG8_STAGE_B(PG8_SB(0, 0), b2, 0); PG8_STAGE_B(PG8_SB(0, 1), b2, 1); PG8_STAGE_A(PG8_SA(0, 0), a2, 0, last);
            PG8_WAIT_V(8); PG8_WAIT_L(0); PG8_BAR; PG8_MMA(1, 0, At, B0); PG8_MMA(1, 1, At, B1); PG8_BAR; PG8_SCHED;
            PG8_LDB(B0, 1, 0); PG8_LDB(B1, 1, 1); PG8_SCHED; PG8_LDA(At, 1, 0); PG8_STAGE_A(PG8_SA(0, 1), a2, 1, last);
            PG8_WAIT_V(8); PG8_WAIT_L(0); PG8_BAR; PG8_MMA(0, 0, At, B0); PG8_MMA(0, 1, At, B1); PG8_BAR; PG8_SCHED;
            PG8_LDA(At, 1, 1); PG8_STAGE_B(PG8_SB(1, 0), b3, 0); PG8_STAGE_B(PG8_SB(1, 1), b3, 1); PG8_STAGE_A(PG8_SA(1, 0), a3, 0, last);
            PG8_WAIT_V(8); PG8_WAIT_L(0); PG8_BAR; PG8_MMA(1, 0, At, B0); PG8_MMA(1, 1, At, B1); PG8_BAR; PG8_SCHED;
        }
        if (wr == 0) PG8_BAR;
        if constexpr (FP8) asm volatile("s_nop 15\n\ts_nop 15" ::: "memory");
        E(acc, cur, wr, wc, fr, fq);
        if (!has_next) break;
#pragma unroll
        for (int a = 0; a < 2; ++a)
#pragma unroll
            for (int b = 0; b < 2; ++b)
#pragma unroll
                for (int m = 0; m < 4; ++m)
#pragma unroll
                    for (int n = 0; n < 2; ++n) acc[a][b][m][n] = (f32x4){0.f, 0.f, 0.f, 0.f};
        cur = nxt; cA = nA; cB = nB; ++ui;
        if constexpr (GATHER) {
#pragma unroll
            for (int i = 0; i < 2; ++i) { cv0[i] = nv0[i]; cv1[i] = nv1[i]; }
        }
        if (wr == 1) PG8_BAR;
    }
    PG8_WAIT_V(0);
    PG8_BAR;
#undef PG8_SA
#undef PG8_SB
#undef PG8_LOAD16
#undef PG8_STAGE_A
#undef PG8_STAGE_B
#undef PG8_LDA
#undef PG8_LDB
#undef PG8_LD32
#undef PG8_MMA
#undef PG8_WAIT_V
#undef PG8_WAIT_L
#undef PG8_BAR
#undef PG8_SCHED
}
}
namespace att {
constexpr int NW = 8, QBLK = 32, KVBLK = 64, QB = NW * QBLK;
constexpr int DQK = 192, DV = 128;
constexpr int QS = NQ, KNS = NKV, KRS = DROPE, OS = DM;
constexpr int SHM_V = KVBLK * DV * 2, SHM_K = KVBLK * DQK * 2;
constexpr int LDS_QR = 2 * SHM_V + 2 * SHM_K + NW * 64 * 4;
constexpr int LDS_BYTES = LDS_QR + NW * 4096;
constexpr float SCALE = 0.07216878364870322f;
constexpr float THR = 8.f;
#define KSWZ(row, ch) ((row) * 384 + ((((ch) ^ (((row) >> 1) & 7))) << 4))
#define SBAR() __builtin_amdgcn_sched_barrier(0)
__device__ __forceinline__ int v_st(int k, int c) { const int kk = (k & ~0xC) | ((k & 4) << 1) | ((k & 8) >> 1); return ((kk >> 3) * 4 + (c >> 5)) * 512 + ((kk & 7) * 32 + (c & 31)) * 2; }
__device__ __forceinline__ int v_rd_base(int lane) { return ((lane & 3) << 3) | (((lane >> 2) & 3) << 6) | (((lane >> 4) & 1) << 5) | (((lane >> 5) & 1) << 8); }
constexpr int v_rd_off(int d0, int ks, int half) { return d0 * 512 + ks * 4096 + half * 2048; }
__device__ __forceinline__ int crow(int r, int hi) { return (r & 3) + 8 * (r >> 2) + 4 * hi; }
__device__ __forceinline__ void mask_tile(f32x16& p0, f32x16& p1, int dq) {
    const float NEG = -__builtin_inff();
#pragma unroll
    for (int r = 0; r < 16; ++r) {
        const int c = (r & 3) + 8 * (r >> 2);
        if (dq - c < 0) p0[r] = NEG;
        if (dq - c - 32 < 0) p1[r] = NEG;
    }
}
__device__ __forceinline__ void partialSM(f32x16& p0, f32x16& p1, float& m_reg, float& mn, float& alpha) {
    float pmax = p0[0]; for (int r = 1; r < 16; ++r) pmax = fmaxf(pmax, p0[r]); for (int r = 0; r < 16; ++r) pmax = fmaxf(pmax, p1[r]);
    { auto rr = __builtin_amdgcn_permlane32_swap(__float_as_uint(pmax), __float_as_uint(pmax), false, false);
      pmax = fmaxf(__uint_as_float(rr[0]), __uint_as_float(rr[1])); }
    constexpr float C2 = 1.4426950408889634f * SCALE;
    if (__builtin_expect(__all((pmax - m_reg) * SCALE <= THR), 1)) { mn = m_reg; alpha = 1.f; }
    else { mn = fmaxf(m_reg, pmax); alpha = __builtin_amdgcn_exp2f((m_reg - mn) * C2); m_reg = mn; }
    const float mnL = -mn * C2;
    for (int r = 0; r < 16; ++r) p0[r] = fmaf(p0[r], C2, mnL); for (int r = 0; r < 16; ++r) p1[r] = fmaf(p1[r], C2, mnL);
    for (int r = 0; r < 16; ++r) p0[r] = __builtin_amdgcn_exp2f(p0[r]);
}
__device__ __forceinline__ void finishSM(f32x16& p0, f32x16& p1, float alpha, float& l_reg, bf16x8& pa0, bf16x8& pa1, bf16x8& pa2, bf16x8& pa3) {
    for (int r = 0; r < 16; ++r) p1[r] = __builtin_amdgcn_exp2f(p1[r]);
    float ps = 0; for (int r = 0; r < 16; ++r) ps += p0[r]; for (int r = 0; r < 16; ++r) ps += p1[r];
    { auto rr = __builtin_amdgcn_permlane32_swap(__float_as_uint(ps), __float_as_uint(ps), false, false);
      ps = __uint_as_float(rr[0]) + __uint_as_float(rr[1]); }
    l_reg = l_reg * alpha + ps;
#define PK4(P, B_, OUT) do { unsigned a0 = cvt_pk_bf16(P[B_+0], P[B_+1]), a1 = cvt_pk_bf16(P[B_+2], P[B_+3]);                          \
        unsigned b0 = cvt_pk_bf16(P[B_+4], P[B_+5]), b1 = cvt_pk_bf16(P[B_+6], P[B_+7]);                                             \
        auto r0 = __builtin_amdgcn_permlane32_swap(a0, b0, false, false); auto r1 = __builtin_amdgcn_permlane32_swap(a1, b1, false, false); \
        u32x4 w = {r0[0], r1[0], r0[1], r1[1]}; OUT = *reinterpret_cast<bf16x8*>(&w); } while (0)
    PK4(p0, 0, pa0); PK4(p0, 8, pa1); PK4(p1, 0, pa2); PK4(p1, 8, pa3);
#undef PK4
}
template <int KB>
__device__ __forceinline__ void qkt(f32x16& p0, f32x16& p1, const char* K_lds, int r32, int hi, const bf16x8* qr, const char* qrl) {
    p0 = f32x16{}; p1 = f32x16{};
    const char* kb[4];
#pragma unroll
    for (int dd = 0; dd < 4; ++dd) kb[dd] = K_lds + KB * SHM_K + KSWZ(r32, dd * 2 + hi);
#pragma unroll
    for (int d0 = 0; d0 < 12; ++d0) { const char* a = kb[d0 & 3] + (d0 >> 2) * 128;
        bf16x8 b0 = *reinterpret_cast<const bf16x8*>(a);
        bf16x8 b1 = *reinterpret_cast<const bf16x8*>(a + 32 * 384);
        const bf16x8 qf = d0 < 8 ? qr[d0 & 7] : *reinterpret_cast<const bf16x8*>(qrl + (d0 - 8) * 1024);
        p0 = __builtin_amdgcn_mfma_f32_32x32x16_bf16(b0, qf, p0, 0, 0, 0);
        p1 = __builtin_amdgcn_mfma_f32_32x32x16_bf16(b1, qf, p1, 0, 0, 0);
        if ((d0 & 3) == 3 && d0 < 11) SBAR(); }
}
template <int VB>
__device__ __forceinline__ void pv_tile(f32x16* o, int vb0, bf16x8 pa0, bf16x8 pa1, bf16x8 pa2, bf16x8 pa3) {
#define TRRD(dst, off) asm volatile("ds_read_b64_tr_b16 %0, %1 offset:%2" : "=&v"(dst) : "v"(vb0), "i"(off) : "memory")
#define PV_D0(d0) do { s16x4 l0, l1, l2, l3, h0, h1, h2, h3; constexpr int b_ = VB * SHM_V + v_rd_off(d0, 0, 0); \
        TRRD(l0, b_); TRRD(h0, b_ + 2048); TRRD(l1, b_ + 4096); TRRD(h1, b_ + 6144); TRRD(l2, b_ + 8192); TRRD(h2, b_ + 10240); TRRD(l3, b_ + 12288); TRRD(h3, b_ + 14336); \
        asm volatile("s_waitcnt lgkmcnt(0)" ::: "memory"); SBAR();   \
        o[d0] = __builtin_amdgcn_mfma_f32_32x32x16_bf16(pa0, (bf16x8){l0[0], l0[1], l0[2], l0[3], h0[0], h0[1], h0[2], h0[3]}, o[d0], 0, 0, 0);   \
        o[d0] = __builtin_amdgcn_mfma_f32_32x32x16_bf16(pa1, (bf16x8){l1[0], l1[1], l1[2], l1[3], h1[0], h1[1], h1[2], h1[3]}, o[d0], 0, 0, 0);   \
        o[d0] = __builtin_amdgcn_mfma_f32_32x32x16_bf16(pa2, (bf16x8){l2[0], l2[1], l2[2], l2[3], h2[0], h2[1], h2[2], h2[3]}, o[d0], 0, 0, 0);   \
        o[d0] = __builtin_amdgcn_mfma_f32_32x32x16_bf16(pa3, (bf16x8){l3[0], l3[1], l3[2], l3[3], h3[0], h3[1], h3[2], h3[3]}, o[d0], 0, 0, 0); } while (0)
    PV_D0(0); PV_D0(1); PV_D0(2); PV_D0(3);
#undef PV_D0
#undef TRRD
}
struct BlockRef { const bf16_t* Q; const bf16_t* Kn; const bf16_t* Kr; const bf16_t* V; bf16_t* O; int P0; };
struct Seam { bf16x8 qr[8]; bf16x8 st_v0, st_v1, st_k0, st_k1, st_k2; };
#define VMW() asm volatile("s_waitcnt vmcnt(0)" ::: "memory")
#define VMWN(n) asm volatile("s_waitcnt vmcnt(%0)" :: "i"(n) : "memory")
#define LD8(p) (*reinterpret_cast<const bf16x8*>(p))
#define SLOAD_H(R_, k0) do { S.st_v0 = LD8((R_).V + (size_t)((k0) + sr) * KNS + sc); S.st_v1 = LD8((R_).V + (size_t)((k0) + 32 + sr) * KNS + sc);              \
                             S.st_k0 = LD8((R_).Kn + (size_t)((k0) + sr) * KNS + sc); S.st_k1 = LD8((R_).Kn + (size_t)((k0) + 32 + sr) * KNS + sc);            \
                             S.st_k2 = LD8((R_).Kr + (size_t)((k0) + rr) * KRS + rc); } while (0)
#define SWRITE_HK(bf) do { *(bf16x8*)(K_lds + (bf) * SHM_K + kws) = S.st_k0; *(bf16x8*)(K_lds + (bf) * SHM_K + kws + 32 * 384) = S.st_k1; *(bf16x8*)(K_lds + (bf) * SHM_K + kws2) = S.st_k2; } while (0)
#define SWRITE_HV(bf) do { *(bf16x8*)(V_lds + (bf) * SHM_V + vst0) = S.st_v0; *(bf16x8*)(V_lds + (bf) * SHM_V + vst1) = S.st_v1; } while (0)
#define SWRITE_H(bf) do { SWRITE_HV(bf); SWRITE_HK(bf); } while (0)
#define ATT_IDX const int tid = launder_v((int)threadIdx.x), wid = __builtin_amdgcn_readfirstlane(tid >> 6), lane = tid & 63, r32 = lane & 31, hi = lane >> 5; \
    const int sr = tid >> 4, sc = (tid & 15) * 8, rr = tid >> 3, rc = (tid & 7) * 8, kws = KSWZ(sr, (tid & 15)), kws2 = KSWZ(rr, 16 + (tid & 7));
__device__ __forceinline__ void attn_block(const BlockRef& cur, char* lds) {
    ATT_IDX;
    Seam S;
    const int NT = cur.P0 / KVBLK + QB / KVBLK;
    const int qlo = cur.P0 + wid * QBLK, qm = qlo + r32 - 4 * hi;
    char* V_lds = lds; char* K_lds = lds + 2 * SHM_V;
    float* ws = (float*)(lds + 2 * SHM_V + 2 * SHM_K) + wid * 64; float* li_l = ws, * al_l = ws + 32;
    float m_reg = -1e30f, l_reg = 0; f32x16 o[4] = {};
    const int vst0 = v_st(sr, sc), vst1 = v_st(32 + sr, sc);
    const int vb0 = (int)(uintptr_t)V_lds + v_rd_base(lane);
    char* qrl = lds + LDS_QR + wid * 4096 + lane * 16;
#define RESC(a) do { if (__any((a) < 1.f)) { if (hi == 0) al_l[r32] = (a); asm volatile("s_waitcnt lgkmcnt(0)" ::: "memory");              \
                     for (int d_ = 0; d_ < 4; ++d_) for (int r = 0; r < 16; ++r) o[d_][r] *= al_l[crow(r, hi)]; } } while (0)
#define KBASE(t) ((t) * KVBLK)
#define MASKT(P0_, P1_, t) do { const int kb_ = KBASE(t); if (kb_ + KVBLK - 1 > qlo) mask_tile(P0_, P1_, qm - kb_); } while (0)
    SLOAD_H(cur, 0);
#pragma unroll
    for (int d0 = 0; d0 < 8; ++d0) S.qr[d0] = LD8(cur.Q + (size_t)(wid * QBLK + r32) * QS + d0 * 16 + hi * 8);
    { bf16x8 t0 = LD8(cur.Q + (size_t)(wid * QBLK + r32) * QS + 128 + hi * 8), t1 = LD8(cur.Q + (size_t)(wid * QBLK + r32) * QS + 144 + hi * 8),
             t2 = LD8(cur.Q + (size_t)(wid * QBLK + r32) * QS + 160 + hi * 8), t3 = LD8(cur.Q + (size_t)(wid * QBLK + r32) * QS + 176 + hi * 8);
      *(bf16x8*)(qrl) = t0; *(bf16x8*)(qrl + 1024) = t1; *(bf16x8*)(qrl + 2048) = t2; *(bf16x8*)(qrl + 3072) = t3; }
    VMW(); SWRITE_H(0);
    __syncthreads();
    f32x16 p0, p1; float mn, al; bf16x8 pa0, pa1, pa2, pa3;
#define TILE_STEP(t, BF) do {                                                                                                 \
        if ((t) + 1 < NT) { SLOAD_H(cur, KBASE((t) + 1)); }                                                                    \
        SBAR();                                                                                                               \
        if (KBASE(t) <= qlo + QBLK - 1) {     \
        qkt<BF>(p0, p1, K_lds, r32, hi, S.qr, qrl);                                                                           \
        MASKT(p0, p1, (t)); partialSM(p0, p1, m_reg, mn, al); RESC(al);                                                        \
        finishSM(p0, p1, al, l_reg, pa0, pa1, pa2, pa3); SBAR();                                                              \
        pv_tile<BF>(o, vb0, pa0, pa1, pa2, pa3); }                                                                            \
        if ((t) + 1 < NT) { VMW(); SWRITE_H(1 - BF); }                                                                         \
        __syncthreads(); } while (0)
    for (int t = 0; t < NT; t += 2) { TILE_STEP(t, 0); TILE_STEP(t + 1, 1); }
    if (hi == 0) li_l[r32] = l_reg; asm volatile("s_waitcnt lgkmcnt(0)" ::: "memory");
    float rli[16];
#pragma unroll
    for (int r = 0; r < 16; ++r) rli[r] = __builtin_amdgcn_rcpf(li_l[crow(r, hi)]);
    bf16_t* Ow = cur.O + (size_t)(wid * QBLK) * OS;
#pragma unroll
    for (int r = 0; r < 16; ++r) { const int orow = crow(r, hi);
#pragma unroll
        for (int d0 = 0; d0 < 4; ++d0) { const float v = o[d0][r] * rli[r];
            const float vn = __shfl_xor(v, 1);
            if ((r32 & 1) == 0) *(unsigned*)(Ow + (size_t)orow * OS + d0 * 32 + r32) = cvt_pk_bf16(v, vn); } }
    __syncthreads();
#undef RESC
#undef KBASE
#undef MASKT
#undef TILE_STEP
}
#undef VMW
#undef VMWN
#undef LD8
#undef SLOAD_H
#undef SWRITE_HK
#undef SWRITE_HV
#undef SWRITE_H
#undef ATT_IDX
#undef KSWZ
#undef SBAR

__device__ __forceinline__ BlockRef make_ref(int L, int pass, const bf16_t* Qb, const bf16_t* KNVb, const bf16_t* KRb, bf16_t* Ob) {
    const int bh = L >> 2, x = L & 3, qb = pass ? 7 - x : x, b = bh >> 3, h = bh & 7; const size_t rb = (size_t)b * SEQ;
    BlockRef r; r.Q = Qb + (rb + (size_t)qb * QB) * QS + h * DQH; r.Kn = KNVb + rb * KNS + h * (DNOPE + DVH); r.Kr = KRb + rb * KRS; r.V = KNVb + rb * KNS + h * (DNOPE + DVH) + DNOPE;
    r.O = Ob + (rb + (size_t)qb * QB) * OS + h * DVH; r.P0 = qb * QB; return r;
}
__device__ __forceinline__ void attn_phase(char* lds, const bf16_t* Qb, const bf16_t* KNVb, const bf16_t* KRb, bf16_t* Ob, int first, int stride) {
    constexpr int total = NBATCH * NHEAD * 4;
    for (int L = first; L < total; L += stride) {
        for (int pass = 0; pass < 2; ++pass) { const BlockRef cur = make_ref(L, pass, Qb, KNVb, KRb, Ob); attn_block(cur, lds); }
    }
}
}
constexpr int NWAVES = 8;
constexpr size_t MiB = 1u << 20;
constexpr size_t WS_CTL = 0, CTL_ZERO_BYTES = 8 * MiB;
constexpr size_t WS_SSQ = 1 * MiB;
constexpr size_t WS_COS = 8 * MiB, WS_SIN = 16 * MiB;
constexpr size_t WS_LIST = 24 * MiB;
constexpr size_t WS_RSL = 26 * MiB;
constexpr size_t WS_TOKINFO = 28 * MiB;
constexpr size_t WS_WDN = 30 * MiB, WS_WUQ = 34 * MiB, WS_WUKV = 37 * MiB, WS_WO = 39 * MiB, WS_WPOOL = 43 * MiB, WS_WGU = 44 * MiB, WS_WD = 65 * MiB, WS_MWGU = 76 * MiB, WS_MWD = 164 * MiB;
constexpr size_t WS_H = 208 * MiB;
constexpr size_t WS_ACT = 336 * MiB;
constexpr size_t WS_DOWN = WS_ACT;
constexpr size_t WS_CQN = WS_ACT + 128 * MiB, WS_CKVN = WS_ACT + 192 * MiB, WS_KR = WS_ACT + 224 * MiB, WS_Q = WS_ACT + 232 * MiB, WS_KNV = WS_ACT + 424 * MiB;
constexpr size_t WS_HID = WS_ACT;
constexpr size_t WS_YB = WS_ACT + 358 * MiB;
constexpr size_t WS_DUMMY = WS_ACT + 424 * MiB;
constexpr size_t WS_H8 = WS_ACT + 618 * MiB;
constexpr int FFE8 = 1536;
constexpr size_t WS_END = WS_ACT + 682 * MiB;
static_assert(WS_MWD + (size_t)16 * 1024 * FFEP * 2 <= WS_H && WS_MWGU + (size_t)16 * 2 * FFEP * 1024 * 2 <= WS_MWD && WS_WD + (size_t)2 * 1024 * FFD * 2 <= WS_MWGU && WS_WGU + (size_t)2 * 2 * FFD * 1024 * 2 <= WS_WD, "weights map");
static_assert(WS_HID + (size_t)PSLOT * FFEP * 2 <= WS_YB && WS_YB + (size_t)PSLOT * 1024 * 2 <= WS_END && WS_HID + (size_t)NTOK * FFD * 2 <= WS_END && WS_KNV + (size_t)NTOK * NKV * 2 <= WS_END && WS_Q + (size_t)NTOK * NQ * 2 <= WS_KNV, "activation map");
static_assert(WS_SSQ + (size_t)14 * NTOK * 8 <= WS_COS && WS_COS <= CTL_ZERO_BYTES + WS_COS && WS_END <= 1024 * MiB, "map");
constexpr int CW_TMO = 0, CW_CODE = 1, CW_CNT = 1024  , CW_DBG = 2048, CW_BAR = 4096  ;
constexpr int RING_OFF = 0, RING_BYTES = 131072, LDSCTL_OFF = RING_BYTES, MISC_OFF = LDSCTL_OFF + 320, LDS_BYTES = 147456;

typedef GAS unsigned gu32;
#define RLX_AGENT __ATOMIC_RELAXED, __HIP_MEMORY_SCOPE_AGENT
#define LDS_WAIT() asm volatile("s_waitcnt lgkmcnt(0)" ::: "memory")
#define VM_WAIT() asm volatile("s_waitcnt vmcnt(0)" ::: "memory")

#define XB_TMO      128
#define XB_XCNT(j)  (256  + 64 * (j))
#define XB_XSUB(j)  (1280 + 64 * (j))
#define XB_XGEN(j)  (2304 + 64 * (j))
#define XB_TOP      3328
#define XB_TOPGEN   3392
#define XCD_BAR_WORDS 3456
#define XB_SPIN_CAP (1u << 18)
__device__ __forceinline__ unsigned xb_ld(unsigned* p)              { return __hip_atomic_load(p, __ATOMIC_RELAXED, __HIP_MEMORY_SCOPE_AGENT); }
__device__ __forceinline__ unsigned xb_add(unsigned* p, unsigned v) { return __hip_atomic_fetch_add(p, v, __ATOMIC_RELAXED, __HIP_MEMORY_SCOPE_AGENT); }
__device__ __forceinline__ unsigned xb_xcc_id() { return (unsigned)__builtin_amdgcn_s_getreg((3 << 11) | 20) & 0xFu; }
#define XB_SPIN(cond, bar) do { unsigned _sp = 0; while (cond) { __builtin_amdgcn_s_sleep(1); \
    if ((++_sp & 255u) == 0u) { if (xb_ld(&(bar)[XB_TMO])) break; if (_sp > XB_SPIN_CAP) { atomicAdd(&(bar)[XB_TMO], 1u); break; } } } } while (0)
__device__ __forceinline__ unsigned rfl(unsigned v);
struct XcdBarrier { unsigned* bar; unsigned x; volatile LAS unsigned* st; };
__device__ __forceinline__ XcdBarrier xcd_barrier_post(unsigned* bar, volatile LAS unsigned* st) {
    XcdBarrier b; b.bar = bar; b.x = xb_xcc_id(); b.st = st;
    if (threadIdx.x == 0) (void)xb_add(&bar[XB_XCNT(b.x)], 1u);
    return b;
}
__device__ __forceinline__ void xcd_barrier_complete(unsigned* bar, unsigned x, unsigned& nloc, unsigned& nx) {
    const unsigned G = gridDim.x * gridDim.y * gridDim.z;
    unsigned sum, cnt, mine, sp = 0u;
    for (;;) {
        sum = 0u; cnt = 0u; mine = 0u;
#pragma unroll
        for (unsigned j = 0; j < 16; ++j) { const unsigned c = xb_ld(&bar[XB_XCNT(j)]); sum += c; cnt += (c > 0u) ? 1u : 0u; mine = (j == x) ? c : mine; }
        if (sum == G) break;
        __builtin_amdgcn_s_sleep(1);
        if ((++sp & 255u) == 0u) { if (xb_ld(&bar[XB_TMO])) break; if (sp > XB_SPIN_CAP) { atomicAdd(&bar[XB_TMO], 1u); break; } }
    }
    nloc = mine > 0u ? mine : 1u; nx = cnt > 0u ? cnt : 1u;
}
__device__ __forceinline__ void xcd_barrier(const XcdBarrier& b) {
    unsigned* bar; { const volatile LAS unsigned* p_ = b.st + 2; const unsigned lo_ = rfl(p_[0]), hi_ = rfl(p_[1]); bar = (unsigned*)(((unsigned long long)hi_ << 32) | lo_); }
    asm volatile("s_waitcnt vmcnt(0)" ::: "memory");
    __syncthreads();
    if (threadIdx.x == 0) {
        __builtin_amdgcn_s_waitcnt(0);
        unsigned nloc = b.st[0], nx = b.st[1];
        if (nloc == 0u) { xcd_barrier_complete(bar, b.x, nloc, nx); b.st[0] = nloc; b.st[1] = nx; }
        const unsigned old = xb_add(&bar[XB_XSUB(b.x)], 1u);
        const unsigned gen = old / nloc;
        if (old + 1u == (gen + 1u) * nloc) {
            __builtin_amdgcn_fence(__ATOMIC_RELEASE, "agent");
            asm volatile("s_waitcnt vmcnt(0)" ::: "memory");
            const unsigned og = xb_add(&bar[XB_TOP], 1u);
            const unsigned tg = og / nx;
            if (og + 1u == (tg + 1u) * nx) xb_add(&bar[XB_TOPGEN], 1u);
            else XB_SPIN(xb_ld(&bar[XB_TOPGEN]) == tg, bar);
            __builtin_amdgcn_fence(__ATOMIC_ACQUIRE, "agent");
            xb_add(&bar[XB_XGEN(b.x)], 1u);
            asm volatile("s_waitcnt vmcnt(0)" ::: "memory");
        } else {
            XB_SPIN(xb_ld(&bar[XB_XGEN(b.x)]) == gen, bar);
            __builtin_amdgcn_fence(__ATOMIC_ACQUIRE, "agent");
            asm volatile("s_waitcnt vmcnt(0)" ::: "memory");
        }
    }
    __syncthreads();
}

constexpr int PT_OFF_ = LDSCTL_OFF + 512;
__device__ __forceinline__ unsigned rfl(unsigned v);
__device__ __forceinline__ const float* ptab(LAS unsigned char* L, int i);
struct Frame { LAS unsigned char* lds; volatile LAS unsigned* MISC; gu32* ctl; unsigned char* ws; int tid, lane, wave, vcu, G; };

__device__ __forceinline__ float wave_sum(float v) {
#pragma unroll
    for (int o = 1; o < 64; o <<= 1) v += __shfl_xor(v, o);
    return v;
}
__device__ __forceinline__ unsigned rfl(unsigned v) { return (unsigned)__builtin_amdgcn_readfirstlane((int)v); }

__device__ __forceinline__ int rowmap(int mode, int n) {
    if (mode == 0) return n;
    if (mode == 1) return (n >> 7) * 256 + (n & 127);
    if (mode == 2) return (n >> 7) * 256 + 128 + (n & 127);
    if (mode == 4) return n < 800 ? n : 896 + (n - 800);
    const int h = n / DQH, d = n - h * DQH;
    if (d < DNOPE) return 512 + h * DNOPE + d;
    if (d < DNOPE + 32) return (h >> 2) * 256 + (h & 3) * 32 + (d - DNOPE);
    return (h >> 2) * 256 + 128 + (h & 3) * 32 + (d - DNOPE - 32);
}
__device__ __forceinline__ void transpose_item(const float* W, int N, bf16_t* WT, int ldd, int mode, const float* kscale, const float* nscale, int item, int lane) {
    const int nblk = N / 64, kb = item / nblk, nb = item % nblk, k0 = 64 * kb, n = 64 * nb + lane;
    const float sn = nscale ? nscale[n] : 1.0f;
    const int ksv = __float_as_int(kscale ? kscale[k0 + lane] : 1.0f);
    const float* wp = W + (size_t)k0 * N + n;
    bf16_t* op = WT + (size_t)rowmap(mode, n) * ldd + k0;
#pragma unroll
    for (int kg = 0; kg < 8; ++kg) { float v[8];
#pragma unroll
        for (int i = 0; i < 8; ++i) { const float sk = __int_as_float(__builtin_amdgcn_readlane(ksv, 8 * kg + i)); v[i] = wp[(size_t)(8 * kg + i) * N] * (sk * sn); }
        u32x4 o; o.x = cvt_pk_bf16(v[0], v[1]); o.y = cvt_pk_bf16(v[2], v[3]); o.z = cvt_pk_bf16(v[4], v[5]); o.w = cvt_pk_bf16(v[6], v[7]);
        *(GAS u32x4*)(op + 8 * kg) = o; }
}
__device__ __forceinline__ void transpose_item_f8(const float* W, int N, unsigned char* WT, int ldd, int mode, const float* kscale, int item, int lane) {
    const int nblk = N / 64, kb = item / nblk, nb = item % nblk, k0 = 64 * kb, n = 64 * nb + lane;
    const int ksv = __float_as_int(kscale ? kscale[k0 + lane] : 1.0f);
    const float* wp = W + (size_t)k0 * N + n;
    unsigned char* op = WT + (size_t)rowmap(mode, n) * ldd + k0;
#pragma unroll
    for (int kg = 0; kg < 4; ++kg) { float v[16];
#pragma unroll
        for (int i = 0; i < 16; ++i) { const float sk = __int_as_float(__builtin_amdgcn_readlane(ksv, 16 * kg + i)); v[i] = wp[(size_t)(16 * kg + i) * N] * (sk * pg8::FP8_SW); }
        u32x4 o; o.x = pg8::pk4_fp8(v[0], v[1], v[2], v[3]); o.y = pg8::pk4_fp8(v[4], v[5], v[6], v[7]); o.z = pg8::pk4_fp8(v[8], v[9], v[10], v[11]); o.w = pg8::pk4_fp8(v[12], v[13], v[14], v[15]);
        *(GAS u32x4*)(op + 16 * kg) = o; }
}
struct MatDesc { const float* src; bf16_t* dst; const float* kscale; const float* nscale; int K, N, ldd, mode, f8; };
constexpr int N_MATS = 70;
__device__ __forceinline__ MatDesc mat_desc(int m, LAS unsigned char* L, unsigned char* ws) {
    MatDesc d; d.kscale = nullptr; d.nscale = nullptr; d.mode = 0; d.f8 = 0;
    if (m < 2)       { const int a = m;      d.src = ptab(L, 4) + (size_t)a * DM * NDOWN;    d.K = DM;   d.N = NDOWN; d.dst = (bf16_t*)(ws + WS_WDN) + (size_t)a * NDOWNP * DM;  d.ldd = DM; d.mode = 4; d.kscale = ptab(L, 2) + (size_t)(2 * a) * DM; }
    else if (m < 4)  { const int a = m - 2;  d.src = ptab(L, 6) + (size_t)a * QLR * NQ;      d.K = QLR;  d.N = NQ;    d.dst = (bf16_t*)(ws + WS_WUQ) + (size_t)a * NQ * QLR;     d.ldd = QLR; d.mode = 3; d.kscale = ptab(L, 5) + (size_t)a * QLR; }
    else if (m < 6)  { const int a = m - 4;  d.src = ptab(L, 8) + (size_t)a * KVLR * NKV;    d.K = KVLR; d.N = NKV;   d.dst = (bf16_t*)(ws + WS_WUKV) + (size_t)a * NKV * KVLR;  d.ldd = KVLR; d.kscale = ptab(L, 7) + (size_t)a * KVLR; }
    else if (m < 8)  { const int a = m - 6;  d.src = ptab(L, 9) + (size_t)a * DM * DM;       d.K = DM;   d.N = DM;    d.dst = (bf16_t*)(ws + WS_WO) + (size_t)a * DM * DM;       d.ldd = DM; }
    else if (m < 16) { const int i = m - 8;  d.src = ptab(L, 10) + (size_t)i * 256 * 256;    d.K = 256;  d.N = 256;   d.dst = (bf16_t*)(ws + WS_WPOOL) + (size_t)i * 256 * 256;  d.ldd = 256; d.nscale = ptab(L, 11) + i * 256; }
    else if (m < 18) { const int a = m - 16; d.src = ptab(L, 12) + (size_t)a * DM * FFD;     d.K = DM;   d.N = FFD;   d.dst = (bf16_t*)(ws + WS_WGU) + (size_t)a * 2 * FFD * DM; d.ldd = DM; d.mode = 1; d.kscale = ptab(L, 3) + (size_t)(2 * a) * DM; }
    else if (m < 20) { const int a = m - 18; d.src = ptab(L, 13) + (size_t)a * DM * FFD;     d.K = DM;   d.N = FFD;   d.dst = (bf16_t*)(ws + WS_WGU) + (size_t)a * 2 * FFD * DM; d.ldd = DM; d.mode = 2; d.kscale = ptab(L, 3) + (size_t)(2 * a) * DM; }
    else if (m < 22) { const int a = m - 20; d.src = ptab(L, 14) + (size_t)a * FFD * DM;     d.K = FFD;  d.N = DM;    d.dst = (bf16_t*)(ws + WS_WD) + (size_t)a * DM * FFD;      d.ldd = FFD; }
    else if (m < 38) { const int i = m - 22; d.src = ptab(L, 16) + (size_t)i * DM * FFE;     d.K = DM;   d.N = FFE;   d.dst = (bf16_t*)(ws + WS_MWGU) + (size_t)i * 2 * FFEP * DM; d.ldd = DM; d.mode = 1; d.kscale = ptab(L, 3) + (size_t)(2 * (i >> 3) + 1) * DM; }
    else if (m < 54) { const int i = m - 38; d.src = ptab(L, 17) + (size_t)i * DM * FFE;     d.K = DM;   d.N = FFE;   d.dst = (bf16_t*)(ws + WS_MWGU) + (size_t)i * 2 * FFEP * DM; d.ldd = DM; d.mode = 2; d.kscale = ptab(L, 3) + (size_t)(2 * (i >> 3) + 1) * DM; }
    else             { const int i = m - 54; d.src = ptab(L, 18) + (size_t)i * FFE * DM;     d.K = FFE;  d.N = DM;    d.dst = (bf16_t*)(ws + WS_MWD) + (size_t)i * DM * FFEP;    d.ldd = FFEP; }
    if (m >= 22 && ((m - 22) & 15) >= 8) {
        const int e = (m - 22) & 7; d.f8 = 1;
        if (m < 54) { d.dst = (bf16_t*)(ws + WS_MWGU + (size_t)8 * 2 * FFEP * DM * 2 + (size_t)e * 2 * FFEP * DM); d.ldd = DM; }
        else        { d.dst = (bf16_t*)(ws + WS_MWD + (size_t)8 * DM * FFEP * 2 + (size_t)e * DM * FFE8); d.ldd = FFE8; } }
    return d;
}
__device__ __forceinline__ void p0_prologue(Frame& F) {
    const int* positions = (const int*)ptab(F.lds, 1);
    const int gw = F.vcu * NWAVES + F.wave, NGW = F.G * NWAVES;
    int cum = 0;
    for (int m = 0; m < N_MATS; ++m) {
        const MatDesc d = mat_desc(m, F.lds, F.ws);
        const int nitems = (d.K / 64) * (d.N / 64);
        int first = gw - (cum % NGW); if (first < 0) first += NGW;
        if (d.f8) { for (int it = first; it < nitems; it += NGW) transpose_item_f8(d.src, d.N, (unsigned char*)d.dst, d.ldd, d.mode, d.kscale, it, F.lane); }
        else { for (int it = first; it < nitems; it += NGW) transpose_item(d.src, d.N, d.dst, d.ldd, d.mode, d.kscale, d.nscale, it, F.lane); }
        cum += nitems;
    }
    const int gt = gw * 64 + F.lane, NGT = NGW * 64; const u32x4 z4 = (u32x4){0u, 0u, 0u, 0u};
    for (int i = gt; i < 2 * 192 * 128; i += NGT) { const int a = i / (192 * 128), r = (i / 128) % 192, c = i % 128; const int row = r < 96 ? 800 + r : 928 + (r - 96); *(GAS u32x4*)((bf16_t*)(F.ws + WS_WDN) + (size_t)a * NDOWNP * DM + (size_t)row * DM + c * 8) = z4; }
    for (int i = gt; i < 8 * 128 * 128; i += NGT) { const int e = i / (128 * 128), r = (i / 128) % 128, c = i % 128; const int row = 2560 + (r < 64 ? 64 + r : 192 + (r - 64));
        *(GAS u32x4*)((bf16_t*)(F.ws + WS_MWGU) + (size_t)e * 2 * FFEP * DM + (size_t)row * DM + c * 8) = z4; }
    for (int i = gt; i < 8 * 1024 * 8; i += NGT) { const int row = i / 8, c = i % 8; *(GAS u32x4*)((bf16_t*)(F.ws + WS_MWD) + (size_t)row * FFEP + FFE + c * 8) = z4; }
    for (int i = gt; i < 8 * 128 * 64; i += NGT) { const int e = i / (128 * 64), r = (i / 64) % 128, c = i % 64; const int row = 2560 + (r < 64 ? 64 + r : 192 + (r - 64));
        *(GAS u32x4*)(F.ws + WS_MWGU + (size_t)8 * 2 * FFEP * DM * 2 + (size_t)e * 2 * FFEP * DM + (size_t)row * DM + c * 16) = z4; }
    for (int i = gt; i < 8 * 1024 * 12; i += NGT) { const int row = i / 12, c = i % 12; *(GAS u32x4*)(F.ws + WS_MWD + (size_t)8 * DM * FFEP * 2 + (size_t)row * FFE8 + FFE + c * 16) = z4; }
    float* cosT = (float*)(F.ws + WS_COS); float* sinT = (float*)(F.ws + WS_SIN);
    for (int i = gt; i < NTOK * 32; i += NGT) { const int row = i >> 5, k = i & 31; const float inv = powf(10000.0f, -(float)(2 * k) / 64.0f); const float ang = (float)positions[row] * inv;
        cosT[i] = cosf(ang); sinT[i] = sinf(ang); }
    const float* x = ptab(F.lds, 0); bf16_t* H = (bf16_t*)(F.ws + WS_H); ssq_t* ssq0 = (ssq_t*)(F.ws + WS_SSQ);
    for (int m0 = gw * 4; m0 < NTOK; m0 += NGW * 4) {
        f32x4 v[4][4];
#pragma unroll
        for (int r = 0; r < 4; ++r) { const GAS f32x4* xr = (const GAS f32x4*)(x + (size_t)(m0 + r) * DM) + F.lane;
#pragma unroll
            for (int j = 0; j < 4; ++j) v[r][j] = xr[64 * j]; }
#pragma unroll
        for (int r = 0; r < 4; ++r) { GAS u32x2* o8 = (GAS u32x2*)(H + (size_t)(m0 + r) * DM) + F.lane; float s = 0.f;
#pragma unroll
            for (int j = 0; j < 4; ++j) { const f32x4 t = v[r][j]; s += (t.x * t.x + t.y * t.y) + (t.z * t.z + t.w * t.w); u32x2 w; w.x = cvt_pk_bf16(t.x, t.y); w.y = cvt_pk_bf16(t.z, t.w); o8[64 * j] = w; }
            s = wave_sum(s); if (F.lane == 0) ssq0[m0 + r] = ssq_fix(s); }
    }
}

template <bool FINAL>
__device__ __forceinline__ void combine_phase(Frame& F, const bf16_t* H, bf16_t* Hout, const bf16_t* YB, const unsigned* tokinfo, const unsigned* cntw, ssq_t* ssq_next, const float* gain, float* outF) {
    const int gw = F.vcu * NWAVES + F.wave, NGW = F.G * NWAVES;
    f32x4 g[4];
    if constexpr (FINAL) {
#pragma unroll
        for (int j = 0; j < 4; ++j) g[j] = *(const f32x4*)(gain + F.lane * 4 + 256 * j);
    }
    unsigned nb[8];
#pragma unroll
    for (int e = 0; e < 8; ++e) nb[e] = (rfl(__hip_atomic_load((unsigned*)cntw + 64 * e, RLX_AGENT)) + 255u) >> 8;
    for (int m0 = gw * 2; m0 < NTOK; m0 += NGW * 2) {
        u32x4 t0[2], t1[2];
#pragma unroll
        for (int r = 0; r < 2; ++r) { t0[r] = *(const u32x4*)(tokinfo + (size_t)(m0 + r) * 8); t1[r] = *(const u32x4*)(tokinfo + (size_t)(m0 + r) * 8 + 4); }
        u32x2 hh[2][4], ya[2][4], yb[2][4]; float g0[2], g1[2];
#pragma unroll
        for (int r = 0; r < 2; ++r) {
            const unsigned e0 = rfl(t0[r].x), r0 = rfl(t0[r].y), e1 = rfl(t1[r].x), r1 = rfl(t1[r].y); g0[r] = __uint_as_float(rfl(t0[r].z)); g1[r] = __uint_as_float(rfl(t1[r].z));
            unsigned b0 = 0u, b1 = 0u;
#pragma unroll
            for (int e = 0; e < 8; ++e) { b0 += ((unsigned)e < e0) ? nb[e] : 0u; b1 += ((unsigned)e < e1) ? nb[e] : 0u; }
            const GAS u32x2* hr = (const GAS u32x2*)(H + (size_t)(m0 + r) * DM) + F.lane;
            const GAS u32x2* y0 = (const GAS u32x2*)(YB + ((size_t)b0 * 256 + r0) * DM) + F.lane; const GAS u32x2* y1 = (const GAS u32x2*)(YB + ((size_t)b1 * 256 + r1) * DM) + F.lane;
#pragma unroll
            for (int j = 0; j < 4; ++j) { hh[r][j] = hr[64 * j]; ya[r][j] = y0[64 * j]; yb[r][j] = y1[64 * j]; }
        }
#pragma unroll
        for (int r = 0; r < 2; ++r) { const int m = m0 + r;
            f32x4 v[4]; float s = 0.f;
#pragma unroll
            for (int j = 0; j < 4; ++j) { const u32x2 h2 = hh[r][j], a = ya[r][j], b = yb[r][j];
                v[j].x = bflo(h2.x) + g0[r] * bflo(a.x) + g1[r] * bflo(b.x); v[j].y = bfhi(h2.x) + g0[r] * bfhi(a.x) + g1[r] * bfhi(b.x); v[j].z = bflo(h2.y) + g0[r] * bflo(a.y) + g1[r] * bflo(b.y); v[j].w = bfhi(h2.y) + g0[r] * bfhi(a.y) + g1[r] * bfhi(b.y);
                s += (v[j].x * v[j].x + v[j].y * v[j].y) + (v[j].z * v[j].z + v[j].w * v[j].w); }
            s = wave_sum(s);
            if constexpr (FINAL) { const float rstd = rstd_f(s); GAS f32x4* ho = (GAS f32x4*)(outF + (size_t)m * DM) + F.lane;
#pragma unroll
                for (int j = 0; j < 4; ++j) ho[64 * j] = v[j] * rstd * g[j];
            } else { GAS u32x2* hw = (GAS u32x2*)(Hout + (size_t)m * DM) + F.lane;
#pragma unroll
                for (int j = 0; j < 4; ++j) { u32x2 w; w.x = cvt_pk_bf16(v[j].x, v[j].y); w.y = cvt_pk_bf16(v[j].z, v[j].w); hw[64 * j] = w; }
                if (F.lane == 0) ssq_next[m] = ssq_fix(s); }
        }
    }
}
__device__ __forceinline__ void mid_phase(Frame& F, const bf16_t* DOWN, const float* qn, const float* kvn, const float* cosT, const float* sinT, bf16_t* CQN, bf16_t* CKVN, bf16_t* KR) {
    const int gw = F.vcu * NWAVES + F.wave, NGW = F.G * NWAVES, lane = F.lane;
    const f32x4 q0 = *(const f32x4*)(qn + lane * 8), q1 = *(const f32x4*)(qn + lane * 8 + 4), k0 = *(const f32x4*)(kvn + lane * 4);
    for (int m = gw; m < NTOK; m += NGW) {
        const bf16_t* dr = DOWN + (size_t)m * NDOWNP;
        const u32x4 cq = *(const GAS u32x4*)(dr + lane * 8); const u32x2 ck = *(const GAS u32x2*)(dr + QLR + lane * 4);
        const float x1 = bf2f(dr[QLR + KVLR + (lane & 31)]), x2 = bf2f(dr[QLR + KVLR + 32 + (lane & 31)]);
        const f32x4 a0 = (f32x4){bflo(cq.x), bfhi(cq.x), bflo(cq.y), bfhi(cq.y)}, a1 = (f32x4){bflo(cq.z), bfhi(cq.z), bflo(cq.w), bfhi(cq.w)}, c0 = (f32x4){bflo(ck.x), bfhi(ck.x), bflo(ck.y), bfhi(ck.y)};
        const float sq = wave_sum((a0.x * a0.x + a0.y * a0.y) + (a0.z * a0.z + a0.w * a0.w) + (a1.x * a1.x + a1.y * a1.y) + (a1.z * a1.z + a1.w * a1.w));
        const float sk = wave_sum((c0.x * c0.x + c0.y * c0.y) + (c0.z * c0.z + c0.w * c0.w));
        const float rq = 1.0f / sqrtf(sq * (1.0f / QLR) + RMS_EPS), rk = 1.0f / sqrtf(sk * (1.0f / KVLR) + RMS_EPS);
        const f32x4 y0 = a0 * rq * q0, y1 = a1 * rq * q1, z0 = c0 * rk * k0;
        u32x4 w; w.x = cvt_pk_bf16(y0.x, y0.y); w.y = cvt_pk_bf16(y0.z, y0.w); w.z = cvt_pk_bf16(y1.x, y1.y); w.w = cvt_pk_bf16(y1.z, y1.w);
        *(GAS u32x4*)(CQN + (size_t)m * QLR + lane * 8) = w;
        u32x2 w2; w2.x = cvt_pk_bf16(z0.x, z0.y); w2.y = cvt_pk_bf16(z0.z, z0.w);
        *(GAS u32x2*)(CKVN + (size_t)m * KVLR + lane * 4) = w2;
        const float c = cosT[(size_t)m * 32 + (lane & 31)], s = sinT[(size_t)m * 32 + (lane & 31)];
        const float o = lane < 32 ? x1 * c - x2 * s : x2 * c + x1 * s;
        KR[(size_t)m * DROPE + lane] = (bf16_t)(cvt_pk_bf16(o, o) & 0xffffu);
    }
}
template <int W>
__device__ __forceinline__ void pool_walk(const bf16_t* h, const ssq_t* ssq, const f32x2 g2, bf16_t* Z, size_t rowbase, int t_start, int c0, int nrows, int col) {
    f32x2 ring[W]; f32x2 sum = (f32x2){0.f, 0.f};
#pragma unroll
    for (int j = 0; j < W; ++j) ring[j] = (f32x2){0.f, 0.f};
    for (int r = 0; r < nrows; r += 16) {
        unsigned xw[16]; ssq_t q[16];
#pragma unroll
        for (int j = 0; j < 16; ++j) { const size_t row = rowbase + t_start + r + j; xw[j] = *(const GAS unsigned*)(h + row * DM + col); q[j] = ssq[row]; }
#pragma unroll
        for (int j = 0; j < 16; ++j) {
            const int t = t_start + r + j; const size_t row = rowbase + t;
            const f32x2 v = (f32x2){bflo(xw[j]), bfhi(xw[j])} * rstd_of(q[j]) * g2;
            sum = sum + (v - ring[j % W]); ring[j % W] = v;
            if (t >= c0) { const float inv = 1.0f / (float)(t + 1 < W ? t + 1 : W); const f32x2 z = sum * inv - v; *(GAS unsigned*)(Z + row * DM + col) = cvt_pk_bf16(z.x, z.y); }
        }
    }
}
__device__ __forceinline__ void pool_phase(Frame& F, const bf16_t* h, const ssq_t* ssq, const float* gain, bf16_t* Z) {
    const int col = F.tid * 2; const f32x2 g2 = *(const f32x2*)(gain + col);
    for (int chunk = F.vcu; chunk < NBATCH * 16; chunk += F.G) {
        const int b = chunk >> 4, c0 = (chunk & 15) * 128, t_start = c0 ? c0 - 16 : 0, nrows = c0 + 128 - t_start; const size_t rowbase = (size_t)b * SEQ;
        const int grp = F.wave >> 1;
        if (grp == 0) pool_walk<2>(h, ssq, g2, Z, rowbase, t_start, c0, nrows, col);
        else if (grp == 1) pool_walk<4>(h, ssq, g2, Z, rowbase, t_start, c0, nrows, col);
        else if (grp == 2) pool_walk<8>(h, ssq, g2, Z, rowbase, t_start, c0, nrows, col);
        else pool_walk<16>(h, ssq, g2, Z, rowbase, t_start, c0, nrows, col);
    }
}
template <bool WRITE_H8>
__device__ __forceinline__ void router_phase(Frame& F, const bf16_t* h, const ssq_t* ssq, const float* gain, const float* router, int* list, float* rsl, unsigned* tokinfo, unsigned* cntw, unsigned char* H8) {
    LAS float* rt = (LAS float*)(F.lds + RING_OFF);
    LAS int* esel = (LAS int*)(F.lds + RING_OFF + 32768);
    LAS int* wt = (LAS int*)(F.lds + RING_OFF + 32768 + 2048);
    LAS int* base = (LAS int*)(F.lds + RING_OFF + 32768 + 2048 + 256);
    LAS float* rsd = (LAS float*)(F.lds + RING_OFF + 32768 + 2048 + 512);
    const int lane = F.lane;
    for (int idx = F.tid; idx < DM * NEXP; idx += NWAVES * 64) rt[(idx & 7) * DM + (idx >> 3)] = router[idx];
    f32x4 g[4];
#pragma unroll
    for (int j = 0; j < 4; ++j) g[j] = *(const f32x4*)(gain + lane * 4 + 256 * j);
    for (int chunk = F.vcu; chunk < NTOK / 256; chunk += F.G) {
        const int T0 = chunk * 256;
        __syncthreads();
        u32x2 nx[4]; ssq_t nq;
        { const GAS u32x2* xr = (const GAS u32x2*)(h + (size_t)(T0 + F.wave * 32) * DM) + lane;
#pragma unroll
          for (int j = 0; j < 4; ++j) nx[j] = xr[64 * j];
          nq = ssq[T0 + F.wave * 32]; }
        for (int i = 0; i < 32; ++i) {
            const int tl = F.wave * 32 + i, m = T0 + tl;
            u32x2 cw[4];
#pragma unroll
            for (int j = 0; j < 4; ++j) cw[j] = nx[j];
            const float rstd = rstd_of(nq);
            if (i + 1 < 32) { const GAS u32x2* xr = (const GAS u32x2*)(h + (size_t)(m + 1) * DM) + lane;
#pragma unroll
                for (int j = 0; j < 4; ++j) nx[j] = xr[64 * j];
                nq = ssq[m + 1]; }
            f32x4 v[4];
#pragma unroll
            for (int j = 0; j < 4; ++j) { const u32x2 w = cw[j]; f32x4 xn = (f32x4){bflo(w.x), bfhi(w.x), bflo(w.y), bfhi(w.y)} * rstd;
                if constexpr (WRITE_H8) { const f32x4 q = xn * pg8::FP8_SA; *(GAS unsigned*)(H8 + (size_t)m * DM + lane * 4 + 256 * j) = pg8::pk4_fp8(q.x, q.y, q.z, q.w); }
                v[j] = xn * g[j]; }
            float lg[8];
#pragma unroll
            for (int e = 0; e < 8; ++e) { float p = 0.f;
#pragma unroll
                for (int j = 0; j < 4; ++j) { const f32x4 r4 = *(const LAS f32x4*)(rt + e * DM + lane * 4 + 256 * j); p += (v[j].x * r4.x + v[j].y * r4.y) + (v[j].z * r4.z + v[j].w * r4.w); }
                lg[e] = wave_sum(p); }
            int e0 = 0; float l0 = lg[0];
#pragma unroll
            for (int e = 1; e < 8; ++e) if (lg[e] > l0) { l0 = lg[e]; e0 = e; }
            int e1 = e0 == 0 ? 1 : 0; float l1 = lg[e0 == 0 ? 1 : 0];
#pragma unroll
            for (int e = 0; e < 8; ++e) if (e != e0 && lg[e] > l1) { l1 = lg[e]; e1 = e; }
            const float g0 = 1.0f / (1.0f + __expf(l1 - l0)), g1 = 1.0f - g0;
            if (lane == 0) { esel[2 * tl] = e0; esel[2 * tl + 1] = e1; rsd[tl] = rstd; unsigned* ti = tokinfo + (size_t)m * 8;
                ti[0] = (unsigned)e0; ti[2] = __float_as_uint(g0); ti[4] = (unsigned)e1; ti[6] = __float_as_uint(g1); }
        }
        __syncthreads();
        const int me = esel[F.tid]; int myrank = 0;
#pragma unroll
        for (int e = 0; e < 8; ++e) { const unsigned long long mask = __ballot(me == e); if (me == e) myrank = __popcll(mask & ((1ull << lane) - 1ull)); if (lane == 0) wt[F.wave * 8 + e] = __popcll(mask); }
        __syncthreads();
        int off = 0;
        for (int w = 0; w < F.wave; ++w) off += wt[w * 8 + me];
        if (F.tid < 8) { int tot = 0; for (int w = 0; w < 8; ++w) tot += wt[w * 8 + F.tid]; base[F.tid] = (int)__hip_atomic_fetch_add(cntw + 64 * F.tid, (unsigned)tot, RLX_AGENT); }
        __syncthreads();
        const int rank = base[me] + off + myrank, tok = T0 + (F.tid >> 1);
        list[(size_t)me * NTOK + rank] = tok; rsl[(size_t)me * NTOK + rank] = rsd[F.tid >> 1];
        tokinfo[(size_t)tok * 8 + (F.tid & 1) * 4 + 1] = (unsigned)rank;
    }
}
template <bool GATHER, bool FP8 = false>
struct MoeOrder {
    static constexpr size_t A_BLK = GATHER ? 0 : (FP8 ? (size_t)256 * FFE8 : (size_t)256 * FFEP * 2), B_EXP = GATHER ? (FP8 ? (size_t)2 * FFEP * DM : (size_t)2 * FFEP * DM * 2) : (FP8 ? (size_t)DM * FFE8 : (size_t)DM * FFEP * 2),
                            B_TILE = GATHER ? (FP8 ? (size_t)256 * DM : (size_t)256 * DM * 2) : (FP8 ? (size_t)256 * FFE8 : (size_t)256 * FFEP * 2);
    static constexpr int NT = GATHER ? 2 * FFEP / 256 : DM / 256;
    const char* A; const char* B; const int* list; const unsigned* cntw; int G, c; unsigned bs[9];
    __device__ __forceinline__ void init(const unsigned* cntw_, const void* A_, const void* B_, const int* list_, int G_, int c_) {
        A = (const char*)A_; B = (const char*)B_; list = list_; cntw = cntw_; G = G_; c = c_; bs[0] = 0u;
#pragma unroll
        for (int e = 0; e < 8; ++e) { const unsigned ce = rfl(__hip_atomic_load((unsigned*)cntw + 64 * e, RLX_AGENT)); bs[e + 1] = bs[e] + ((ce + 255u) >> 8); }
    }
    __device__ __forceinline__ bool next(int i, pg8::Unit& u) const {
        const long L = (long)i * G + c; if (L >= (long)bs[8] * NT) return false;
        const unsigned blk = (unsigned)(L / NT); const int pn = (int)(L % NT);
        unsigned e = 0u, st = 0u;
#pragma unroll
        for (int k = 1; k < 8; ++k) if (blk >= bs[k]) { e = (unsigned)k; st = bs[k]; }
        const unsigned j = blk - st;
        u.b = B + (size_t)e * B_EXP + (size_t)pn * B_TILE; u.orow = (int)(blk * 256u); u.pn = pn; u.aux = (int)e;
        if constexpr (GATHER) { const unsigned ce = rfl(__hip_atomic_load((unsigned*)cntw + 64 * e, RLX_AGENT));
            u.a = A; u.rows = list + (size_t)e * NTOK + (size_t)j * 256; const unsigned rem = ce - j * 256u; u.nrows = rem < 256u ? (int)rem : 256; }
        else { u.a = A + (size_t)blk * A_BLK; u.rows = nullptr; u.nrows = 256; }
        return true;
    }
};
constexpr int NPHASE = 27;
struct Args { const float* in[20]; float* out; unsigned char* ws; int ph_lo, ph_hi, li, pad; };
#ifndef MK_REP_MASK
#define MK_REP_MASK 0
#endif
#ifndef MK_REP_N
#define MK_REP_N 1
#endif
constexpr int PT_OFF = LDSCTL_OFF + 512;
__device__ __forceinline__ unsigned long long ptab_u64(LAS unsigned char* L, int i) {
    const volatile LAS unsigned* p = (const volatile LAS unsigned*)(L + PT_OFF + 8 * i); const unsigned lo = rfl(p[0]), hi = rfl(p[1]); return ((unsigned long long)hi << 32) | lo; }
__device__ __forceinline__ const float* ptab(LAS unsigned char* L, int i) { return (const float*)ptab_u64(L, i); }
__device__ __forceinline__ Frame make_frame(LAS unsigned char* L) {
    Frame F; F.lds = L; F.MISC = (volatile LAS unsigned*)(L + MISC_OFF); F.tid = launder_v((int)threadIdx.x); F.lane = F.tid & 63; F.wave = __builtin_amdgcn_readfirstlane(F.tid >> 6);
    F.G = gridDim.x; { const int bx = blockIdx.x; F.vcu = (F.G % 8 == 0) ? (bx % 8) * (F.G / 8) + bx / 8 : bx; }
    F.ws = (unsigned char*)ptab_u64(L, 21); F.ctl = (gu32*)(F.ws + WS_CTL); return F;
}
__global__ void __launch_bounds__(NWAVES * 64, 2) fwd(Args args) {
    extern __shared__ __attribute__((aligned(16))) unsigned char lds[];
    LAS unsigned char* L = (LAS unsigned char*)lds;
    { const int tid = threadIdx.x;
      for (int u = tid; u < (LDS_BYTES - LDSCTL_OFF) / 4; u += NWAVES * 64) ((LAS unsigned*)(L + LDSCTL_OFF))[u] = 0u;
      __syncthreads();
      if (tid < 20) *(LAS unsigned long long*)(L + PT_OFF + 8 * tid) = (unsigned long long)args.in[tid];
      if (tid == 20) *(LAS unsigned long long*)(L + PT_OFF + 8 * 20) = (unsigned long long)args.out;
      if (tid == 21) *(LAS unsigned long long*)(L + PT_OFF + 8 * 21) = (unsigned long long)args.ws;
      if (tid == 22) *(LAS unsigned long long*)(L + PT_OFF + 8 * 22) = (unsigned long long)args.pad;
      __syncthreads(); }
    const int lo = args.ph_lo, hi = args.ph_hi;
    XcdBarrier bar; { gu32* ctl = (gu32*)(args.ws + WS_CTL); bar.bar = (unsigned*)(ctl + CW_BAR) + args.li * XCD_BAR_WORDS; bar.x = 0; bar.st = nullptr;
      if (threadIdx.x == 0) { const unsigned long long ba = (unsigned long long)((unsigned*)(ctl + CW_BAR) + args.li * XCD_BAR_WORDS); ((volatile LAS unsigned*)(L + MISC_OFF))[10] = (unsigned)ba; ((volatile LAS unsigned*)(L + MISC_OFF))[11] = (unsigned)(ba >> 32); }
      if (hi - lo > 1) bar = xcd_barrier_post((unsigned*)(ctl + CW_BAR) + args.li * XCD_BAR_WORDS, (volatile LAS unsigned*)(L + MISC_OFF) + 8);
      __syncthreads(); }
#ifndef MK_ONLY
#define MK_ONLY (-1)
#endif
#define KIND(k) ((k) == 0 ? 0 : 1 + ((k) - 1) % 13)
#ifndef MK_SKIPMASK
#define MK_SKIPMASK 0
#endif
#define IN(k) ((MK_ONLY < 0 || KIND(k) == MK_ONLY) && !((MK_SKIPMASK >> KIND(k)) & 1) && lo <= (k) && (k) < hi)
#define FORREP(k)
#if MK_REP_MASK
#define LASTREP (ptab_u64(L, 22) == 0ull)
#else
#define LASTREP true
#endif
#ifdef MK_DOUBLE_BAR
#define SEAM(k) do { if ((k) + 1 < hi) { xcd_barrier(bar); xcd_barrier(bar); } } while (0)
#else
#define SEAM(k) do { if ((k) + 1 < hi) xcd_barrier(bar); } while (0)
#endif
#define WSP(off) ((bf16_t*)(F.ws + (off)))
#define SSQ(i) ((ssq_t*)(F.ws + WS_SSQ) + (size_t)(i) * NTOK)
    LAS unsigned char* ring = L + RING_OFF;

    if (IN(0)) FORREP(0) { Frame F = make_frame(L); p0_prologue(F); SEAM(0); }

    for (int lp = 0; lp < 2; ++lp) {
        const int pb = 1 + 13 * lp;
        if (IN(pb + 0)) FORREP(pb + 0) { Frame F = make_frame(L);
            pg8::RegOrder S; S.init(WSP(WS_H), DM * 2, WSP(WS_WDN) + (size_t)lp * NDOWNP * DM, DM * 2, NTOK, NDOWNP, F.G, (int)blockIdx.x);
            pg8::EpiDown E{WSP(WS_DOWN), WSP(WS_KR), SSQ(4 * lp + 0), LASTREP ? SSQ(10 + 2 * lp) : SSQ(9), LASTREP ? SSQ(11 + 2 * lp) : SSQ(9), (const float*)(F.ws + WS_COS), (const float*)(F.ws + WS_SIN)};
            pg8::gemm_phase<pg8::EpiDown, pg8::RegOrder, false>(ring, DM * 2, DM * 2, DM * 2, S, E);
            SEAM(pb + 0);
        }
        if (IN(pb + 1)) FORREP(pb + 1) { Frame F = make_frame(L);
            pg8::RegOrder S; S.init(WSP(WS_DOWN), NDOWNP * 2, WSP(WS_WUQ) + (size_t)lp * NQ * QLR, QLR * 2, NTOK, NQ, F.G, (int)blockIdx.x);
            pg8::EpiQ E{WSP(WS_Q), (const float*)(F.ws + WS_COS), (const float*)(F.ws + WS_SIN), SSQ(10 + 2 * lp)};
            pg8::gemm_phase<pg8::EpiQ, pg8::RegOrder, false>(ring, NDOWNP * 2, QLR * 2, QLR * 2, S, E);
            SEAM(pb + 1);
        }
        if (IN(pb + 2)) FORREP(pb + 2) { Frame F = make_frame(L);
            pg8::RegOrder S; S.init(WSP(WS_DOWN) + QLR, NDOWNP * 2, WSP(WS_WUKV) + (size_t)lp * NKV * KVLR, KVLR * 2, NTOK, NKV, F.G, (int)blockIdx.x);
            pg8::EpiBf16<2> E{WSP(WS_KNV), NKV, SSQ(11 + 2 * lp)};
            pg8::gemm_phase<pg8::EpiBf16<2>, pg8::RegOrder, false>(ring, NDOWNP * 2, KVLR * 2, KVLR * 2, S, E);
            SEAM(pb + 2);
        }
        if (IN(pb + 3)) FORREP(pb + 3) { Frame F = make_frame(L); att::attn_phase((char*)lds + RING_OFF, WSP(WS_Q), WSP(WS_KNV), WSP(WS_KR), WSP(WS_DOWN), F.vcu, F.G); SEAM(pb + 3); }
        if (IN(pb + 4)) FORREP(pb + 4) { Frame F = make_frame(L);
            pg8::RegOrder S; S.init(WSP(WS_DOWN), DM * 2, WSP(WS_WO) + (size_t)lp * DM * DM, DM * 2, NTOK, DM, F.G, (int)blockIdx.x);
            pg8::EpiResidH E{WSP(WS_H), LASTREP ? WSP(WS_H) : WSP(WS_DUMMY), LASTREP ? SSQ(4 * lp + 1) : SSQ(9)};
            pg8::gemm_phase<pg8::EpiResidH, pg8::RegOrder, false>(ring, DM * 2, DM * 2, DM * 2, S, E);
            SEAM(pb + 4);
        }
        if (IN(pb + 5)) FORREP(pb + 5) { Frame F = make_frame(L);
            pg8::RegOrder S; S.init(WSP(WS_H), DM * 2, WSP(WS_WGU) + (size_t)lp * 2 * FFD * DM, DM * 2, NTOK, 2 * FFD, F.G, (int)blockIdx.x);
            pg8::EpiSwiglu<1> E{WSP(WS_HID), FFD, SSQ(4 * lp + 1), nullptr};
            pg8::gemm_phase<pg8::EpiSwiglu<1>, pg8::RegOrder, false>(ring, DM * 2, DM * 2, DM * 2, S, E);
            SEAM(pb + 5);
        }
        if (IN(pb + 6)) FORREP(pb + 6) { Frame F = make_frame(L);
            pg8::RegOrder S; S.init(WSP(WS_HID), FFD * 2, WSP(WS_WD) + (size_t)lp * DM * FFD, FFD * 2, NTOK, DM, F.G, (int)blockIdx.x);
            pg8::EpiResidH E{WSP(WS_H), LASTREP ? WSP(WS_H) : WSP(WS_DUMMY), LASTREP ? SSQ(4 * lp + 2) : SSQ(9)};
            pg8::gemm_phase<pg8::EpiResidH, pg8::RegOrder, false>(ring, FFD * 2, FFD * 2, FFD * 2, S, E);
            SEAM(pb + 6);
        }
        if (IN(pb + 7)) FORREP(pb + 7) { Frame F = make_frame(L); pool_phase(F, WSP(WS_H), SSQ(4 * lp + 2), ptab(L, 2) + (size_t)(2 * lp + 1) * DM, WSP(WS_DOWN)); SEAM(pb + 7); }
        if (IN(pb + 8)) FORREP(pb + 8) { Frame F = make_frame(L);
            pg8::RegOrder S; S.init(WSP(WS_DOWN), DM * 2, WSP(WS_WPOOL) + (size_t)lp * 4 * 256 * 256, 256 * 2, NTOK, DM, F.G, (int)blockIdx.x, 256 * 2);
            pg8::EpiResidH E{WSP(WS_H), LASTREP ? WSP(WS_H) : WSP(WS_DUMMY), LASTREP ? SSQ(4 * lp + 3) : SSQ(9)};
            pg8::gemm_phase<pg8::EpiResidH, pg8::RegOrder, false>(ring, DM * 2, 256 * 2, 256 * 2, S, E);
            SEAM(pb + 8);
        }
        if (IN(pb + 9)) FORREP(pb + 9) { Frame F = make_frame(L);
            if (lp == 0) router_phase<false>(F, WSP(WS_H), SSQ(4 * lp + 3), ptab(L, 3) + (size_t)(2 * lp + 1) * DM, ptab(L, 15) + (size_t)lp * DM * NEXP, (int*)(F.ws + WS_LIST), (float*)(F.ws + WS_RSL), (unsigned*)(F.ws + WS_TOKINFO), (unsigned*)(F.ctl + CW_CNT) + (LASTREP ? lp : 2 + lp) * 8 * 64, nullptr);
            else router_phase<true>(F, WSP(WS_H), SSQ(4 * lp + 3), ptab(L, 3) + (size_t)(2 * lp + 1) * DM, ptab(L, 15) + (size_t)lp * DM * NEXP, (int*)(F.ws + WS_LIST), (float*)(F.ws + WS_RSL), (unsigned*)(F.ws + WS_TOKINFO), (unsigned*)(F.ctl + CW_CNT) + (LASTREP ? lp : 2 + lp) * 8 * 64, F.ws + WS_H8);
            SEAM(pb + 9); }
#ifndef TEST_NO_BF16MOE
        if (IN(pb + 10) && lp == 0) FORREP(pb + 10) { Frame F = make_frame(L);
            MoeOrder<true> S; S.init((unsigned*)(F.ctl + CW_CNT) + lp * 8 * 64, WSP(WS_H), WSP(WS_MWGU), (const int*)(F.ws + WS_LIST), F.G, (int)blockIdx.x);
            pg8::EpiSwiglu<2> E{WSP(WS_HID), FFEP, (const float*)(F.ws + WS_RSL), (const int*)(F.ws + WS_LIST)};
            pg8::gemm_phase<pg8::EpiSwiglu<2>, MoeOrder<true>, true>(ring, DM * 2, DM * 2, DM * 2, S, E);
            SEAM(pb + 10);
        }
#endif
#ifndef TEST_NO_F8MOE
        if (IN(pb + 10) && lp == 1) FORREP(pb + 10) { Frame F = make_frame(L);
            MoeOrder<true, true> S; S.init((unsigned*)(F.ctl + CW_CNT) + lp * 8 * 64, F.ws + WS_H8, F.ws + WS_MWGU + (size_t)8 * 2 * FFEP * DM * 2, (const int*)(F.ws + WS_LIST), F.G, (int)blockIdx.x);
            pg8::EpiSwigluF8 E{F.ws + WS_HID, FFE8, 2 * FFEP / 256 - 1};
            pg8::gemm_phase<pg8::EpiSwigluF8, MoeOrder<true, true>, true, true>(ring, DM, DM, DM, S, E);
            SEAM(pb + 10);
        }
#endif
#ifndef TEST_NO_BF16MOE
        if (IN(pb + 11) && lp == 0) FORREP(pb + 11) { Frame F = make_frame(L);
            MoeOrder<false> S; S.init((unsigned*)(F.ctl + CW_CNT) + lp * 8 * 64, WSP(WS_HID), WSP(WS_MWD), (const int*)(F.ws + WS_LIST), F.G, (int)blockIdx.x);
            pg8::EpiBf16<0> E{WSP(WS_YB), DM, nullptr};
            pg8::gemm_phase<pg8::EpiBf16<0>, MoeOrder<false>, false>(ring, FFEP * 2, FFEP * 2, FFEP * 2, S, E);
            SEAM(pb + 11);
        }
#endif
#ifndef TEST_NO_F8MOE
        if (IN(pb + 11) && lp == 1) FORREP(pb + 11) { Frame F = make_frame(L);
            MoeOrder<false, true> S; S.init((unsigned*)(F.ctl + CW_CNT) + lp * 8 * 64, F.ws + WS_HID, F.ws + WS_MWD + (size_t)8 * DM * FFEP * 2, (const int*)(F.ws + WS_LIST), F.G, (int)blockIdx.x);
            pg8::EpiBf16Scaled E{WSP(WS_YB), DM, 1.0f / (pg8::FP8_SH * pg8::FP8_SW)};
            pg8::gemm_phase<pg8::EpiBf16Scaled, MoeOrder<false, true>, false, true>(ring, FFE8, FFE8, FFE8, S, E);
            SEAM(pb + 11);
        }
#endif
        if (IN(pb + 12)) FORREP(pb + 12) { Frame F = make_frame(L);
            if (lp == 0) combine_phase<false>(F, WSP(WS_H), LASTREP ? WSP(WS_H) : WSP(WS_DUMMY), WSP(WS_YB), (const unsigned*)(F.ws + WS_TOKINFO), (unsigned*)(F.ctl + CW_CNT), LASTREP ? SSQ(4) : SSQ(9), nullptr, nullptr);
            else combine_phase<true>(F, WSP(WS_H), nullptr, WSP(WS_YB), (const unsigned*)(F.ws + WS_TOKINFO), (unsigned*)(F.ctl + CW_CNT) + 8 * 64, nullptr, ptab(L, 19), (float*)ptab(L, 20));
            SEAM(pb + 12);
        }
    }
#undef IN
#undef SEAM
#undef WSP
#undef SSQ
}

#ifndef MK_PER_PHASE
#define MK_PER_PHASE 0
#endif
extern "C" void kernel_launch(void* const* d_in, const int* in_sizes, int n_in, void* d_out, int out_size, void* d_ws, size_t ws_size, hipStream_t stream) {
    static int grid = 0;
    if (grid == 0) {
        if (n_in != 20 || in_sizes[0] != NTOK * DM || out_size != NTOK * DM || ws_size < WS_END) { fprintf(stderr, "kernel_launch: unexpected shapes (n_in %d, in0 %d, out %d, ws %zu < %zu)\n", n_in, n_in > 0 ? in_sizes[0] : -1, out_size, ws_size, (size_t)WS_END); grid = -1; return; }
        int dev = 0, cus = 0, per_cu = 0;
        if (hipGetDevice(&dev) != hipSuccess || hipDeviceGetAttribute(&cus, hipDeviceAttributeMultiprocessorCount, dev) != hipSuccess) { grid = -1; return; }
        if (hipFuncSetAttribute((const void*)fwd, hipFuncAttributeMaxDynamicSharedMemorySize, LDS_BYTES) != hipSuccess) { fprintf(stderr, "kernel_launch: hipFuncSetAttribute failed\n"); grid = -1; return; }
        if (hipOccupancyMaxActiveBlocksPerMultiprocessor(&per_cu, (const void*)fwd, NWAVES * 64, LDS_BYTES) != hipSuccess || per_cu < 1) fprintf(stderr, "kernel_launch: occupancy query reports %d\n", per_cu);
        (void)hipGetLastError();
        grid = cus;
    }
    if (grid < 0) return;
    if (hipMemsetAsync((char*)d_ws + WS_CTL, 0, CTL_ZERO_BYTES, stream) != hipSuccess) return;
    Args a{};
    for (int i = 0; i < 20; ++i) a.in[i] = (const float*)d_in[i];
    a.out = (float*)d_out; a.ws = (unsigned char*)d_ws;
#if MK_PER_PHASE
    for (int p = 0; p < NPHASE; ++p) { a.ph_lo = p; a.ph_hi = p + 1; a.li = 0; hipLaunchKernelGGL(fwd, dim3(grid), dim3(NWAVES * 64), LDS_BYTES, stream, a); }
#elif MK_REP_MASK
    { int cur = 0, li = 0;
      for (int k = 0; k < NPHASE; ++k) if ((MK_REP_MASK >> (k == 0 ? 0 : 1 + (k - 1) % 13)) & 1) {
          if (k > cur) { a.ph_lo = cur; a.ph_hi = k; a.li = li++; a.pad = 0; hipLaunchKernelGGL(fwd, dim3(grid), dim3(NWAVES * 64), LDS_BYTES, stream, a); }
          for (int r = 1; r < MK_REP_N; ++r) { a.ph_lo = k; a.ph_hi = k + 1; a.li = li++; a.pad = 1; hipLaunchKernelGGL(fwd, dim3(grid), dim3(NWAVES * 64), LDS_BYTES, stream, a); }
          cur = k; }
      a.ph_lo = cur; a.ph_hi = NPHASE; a.li = li++; a.pad = 0; hipLaunchKernelGGL(fwd, dim3(grid), dim3(NWAVES * 64), LDS_BYTES, stream, a); }
#elif defined(MK_TWICE)
    a.ph_lo = 0; a.ph_hi = NPHASE; a.li = 0;
    hipLaunchKernelGGL(fwd, dim3(grid), dim3(NWAVES * 64), LDS_BYTES, stream, a);
    (void)hipMemsetAsync((char*)d_ws + WS_CTL, 0, CTL_ZERO_BYTES, stream);
    hipLaunchKernelGGL(fwd, dim3(grid), dim3(NWAVES * 64), LDS_BYTES, stream, a);
#else
    a.ph_lo = 0; a.ph_hi = NPHASE; a.li = 0;
    hipLaunchKernelGGL(fwd, dim3(grid), dim3(NWAVES * 64), LDS_BYTES, stream, a);
#endif
}
```

```cpp
#include <hip/hip_runtime.h>
#include <cstdio>
#include <cstdint>

#define GAS __attribute__((address_space(1)))
#define LAS __attribute__((address_space(3)))
typedef unsigned short bf16_t;
typedef short bf16x8 __attribute__((ext_vector_type(8)));
typedef short s16x4 __attribute__((ext_vector_type(4)));
typedef float f32x2 __attribute__((ext_vector_type(2)));
typedef float f32x4 __attribute__((ext_vector_type(4)));
typedef float f32x16 __attribute__((ext_vector_type(16)));
typedef unsigned u32x2 __attribute__((ext_vector_type(2)));
typedef unsigned u32x4 __attribute__((ext_vector_type(4)));

constexpr int DM = 1024, NBATCH = 32, SEQ = 2048, NTOK = NBATCH * SEQ;
constexpr int NHEAD = 8, DNOPE = 128, DROPE = 64, DVH = 128, DQH = DNOPE + DROPE, QLR = 512, KVLR = 256;
constexpr int NDOWN = QLR + KVLR + DROPE  , NDOWNP = 1024;
constexpr int NQ = NHEAD * DQH  , NKV = NHEAD * (DNOPE + DVH)  ;
constexpr int FFD = 2688, NEXP = 8, FFE = 1344, FFEP = 1408;
constexpr int PSLOT = (NTOK * 2 / 256 + NEXP) * 256;
constexpr float RMS_EPS = 1e-6f;

__device__ __forceinline__ unsigned cvt_pk_bf16(float lo, float hi) { unsigned r; asm volatile("v_cvt_pk_bf16_f32 %0, %1, %2" : "=v"(r) : "v"(lo), "v"(hi)); return r; }
__device__ __forceinline__ int launder_v(int v) { asm volatile("" : "+v"(v)); return v; }
__device__ __forceinline__ float fp8_rt(float x, float s) { const int p = __builtin_amdgcn_cvt_pk_fp8_f32(x * s, 0.f, 0, false); return __builtin_amdgcn_cvt_f32_fp8(p, 0) * (1.0f / s); }
__device__ __forceinline__ float bf2f(unsigned short b) { return __uint_as_float((unsigned)b << 16); }
__device__ __forceinline__ float bflo(unsigned w) { return __uint_as_float(w << 16); }
__device__ __forceinline__ float bfhi(unsigned w) { return __uint_as_float(w & 0xffff0000u); }

typedef unsigned long long ssq_t;
__device__ __forceinline__ ssq_t ssq_fix(float s) { return (ssq_t)(s * 16777216.0f); }
__device__ __forceinline__ float rstd_n(ssq_t q, float invn) { return 1.0f / sqrtf((float)q * (1.0f / 16777216.0f) * invn + RMS_EPS); }
__device__ __forceinline__ float rstd_of(ssq_t q) { return rstd_n(q, 1.0f / DM); }
__device__ __forceinline__ float rstd_f(float ssq) { return 1.0f / sqrtf(ssq * (1.0f / DM) + RMS_EPS); }

namespace pg8 {
constexpr int BM = 256, BK = 64, HALF = 128, HTB = HALF * BK * 2  , STAGE_BYTES = 8 * HTB, NXCD = 8, WGM = 8;
__host__ __device__ __forceinline__ int lds_byte(int r, int c) { const int st = (r >> 4) * 2 + (c >> 5), rr = r & 15, cc = c & 31, ob = rr * 64 + cc * 2; return st * 1024 + (ob ^ (((ob >> 9) & 1) << 5)); }
__host__ __device__ __forceinline__ void stage_rc(int b, int& R, int& C) { const int st = b / 1024, sb = b % 1024, swz = sb ^ (((sb >> 9) & 1) << 5); R = (st >> 1) * 16 + swz / 64; C = (st & 1) * 32 + (swz % 64) / 2; }
__host__ __device__ __forceinline__ int perm32(int rho) { const int n = rho >> 4, i = rho & 15; return 8 * (i >> 2) + 4 * n + (i & 3); }

struct Unit { const char* a; const char* b; const int* rows; int nrows; int orow; int pn; int aux; };

struct RegOrder {
    const char* A; const char* B; unsigned a_tile, b_tile, a_colstep; int nM, nN, nwg, G, c;
    __device__ __forceinline__ void init(const void* A_, size_t lda_b, const void* B_, size_t ldb_b, int M, int N, int G_, int c_, size_t a_colstep_ = 0) {
        A = (const char*)A_; B = (const char*)B_; a_tile = (unsigned)(256 * lda_b); b_tile = (unsigned)(256 * ldb_b); a_colstep = (unsigned)a_colstep_; nM = M / BM; nN = N / BM; nwg = nM * nN; G = G_; c = c_; }
    __device__ __forceinline__ bool next(int i, Unit& u) const {
        const long L = (long)i * G + c; if (L >= nwg) return false;
        int wgid = (int)L; { const int q = nwg / NXCD, r = nwg % NXCD, xcd = wgid % NXCD, off = wgid / NXCD; wgid = (xcd < r ? xcd * (q + 1) : r * (q + 1) + (xcd - r) * q) + off; }
        const int nig = WGM * nN, gid = wgid / nig, fm = gid * WGM, gsz = (nM - fm) < WGM ? (nM - fm) : WGM;
        const int pm = fm + ((wgid % nig) % gsz), pn = (wgid % nig) / gsz;
        u.a = A + (size_t)pm * a_tile + (size_t)pn * a_colstep; u.b = B + (size_t)pn * b_tile; u.rows = nullptr; u.nrows = 256; u.orow = pm * BM; u.pn = pn; u.aux = 0; return true;
    }
};

template <int RS> struct EpiBf16 {
    static constexpr bool PERM = true;
    bf16_t* O; int ldc; const ssq_t* rs;
    __device__ __forceinline__ void operator()(const f32x4 (&acc)[2][2][4][2], const Unit& u, int wr, int wc, int fr, int fq) const {
        const int row0 = u.orow + wr * 64 + fr, col0 = u.pn * BM + wc * 32 + 8 * fq;
        float sc[2][4];
#pragma unroll
        for (int ai = 0; ai < 2; ++ai)
#pragma unroll
            for (int m = 0; m < 4; ++m) { const int row = row0 + ai * HALF + m * 16; sc[ai][m] = 1.0f; if constexpr (RS == 1) sc[ai][m] = rstd_of(rs[row]); if constexpr (RS == 2) sc[ai][m] = rstd_n(rs[row], 1.0f / KVLR); }
#pragma unroll
        for (int ai = 0; ai < 2; ++ai)
#pragma unroll
            for (int m = 0; m < 4; ++m) { const int row = row0 + ai * HALF + m * 16; bf16_t* rowp = O + (size_t)row * ldc + col0;
#pragma unroll
                for (int bj = 0; bj < 2; ++bj) { const f32x4 v0 = acc[ai][bj][m][0] * sc[ai][m], v1 = acc[ai][bj][m][1] * sc[ai][m];
                    u32x4 w; w.x = cvt_pk_bf16(v0[0], v0[1]); w.y = cvt_pk_bf16(v0[2], v0[3]); w.z = cvt_pk_bf16(v1[0], v1[1]); w.w = cvt_pk_bf16(v1[2], v1[3]);
                    *(u32x4*)(rowp + bj * HALF) = w; } }
    }
};
__device__ __forceinline__ float silu_mul(float g, float u) { return g * u * __builtin_amdgcn_rcpf(1.0f + __builtin_amdgcn_exp2f(-1.4426950408889634f * g)); }
template <int RS> struct EpiSwiglu {
    static constexpr bool PERM = true;
    bf16_t* H; int ldh; const void* rs; const int* list;
    __device__ __forceinline__ void operator()(const f32x4 (&acc)[2][2][4][2], const Unit& u, int wr, int wc, int fr, int fq) const {
        const int r0 = wr * 64 + fr, col0 = u.pn * HALF + wc * 32 + 8 * fq;
        const ssq_t* rsq = (const ssq_t*)rs; const float* rsp = (const float*)rs; if constexpr (RS == 2) rsp = rsp + (u.rows - list);
        float sc[2][4];
#pragma unroll
        for (int ai = 0; ai < 2; ++ai)
#pragma unroll
            for (int m = 0; m < 4; ++m) { const int r = r0 + ai * HALF + m * 16; if constexpr (RS == 1) sc[ai][m] = rstd_of(rsq[u.orow + r]); else sc[ai][m] = rsp[r]; }
#pragma unroll
        for (int ai = 0; ai < 2; ++ai)
#pragma unroll
            for (int m = 0; m < 4; ++m) { const int r = r0 + ai * HALF + m * 16; bf16_t* rowp = H + (size_t)(u.orow + r) * ldh + col0; const float s = sc[ai][m];
                const f32x4 g0 = acc[ai][0][m][0] * s, g1 = acc[ai][0][m][1] * s, u0 = acc[ai][1][m][0] * s, u1 = acc[ai][1][m][1] * s;
                u32x4 w; w.x = cvt_pk_bf16(silu_mul(g0[0], u0[0]), silu_mul(g0[1], u0[1])); w.y = cvt_pk_bf16(silu_mul(g0[2], u0[2]), silu_mul(g0[3], u0[3]));
                w.z = cvt_pk_bf16(silu_mul(g1[0], u1[0]), silu_mul(g1[1], u1[1])); w.w = cvt_pk_bf16(silu_mul(g1[2], u1[2]), silu_mul(g1[3], u1[3]));
                *(u32x4*)rowp = w; }
    }
};
constexpr float FP8_SA = 16.0f, FP8_SW = 256.0f, FP8_SH = 16.0f, FP8_SX = 8.0f;
__device__ __forceinline__ unsigned pk4_fp8(float a, float b, float c, float d) { int p = __builtin_amdgcn_cvt_pk_fp8_f32(a, b, 0, false); p = __builtin_amdgcn_cvt_pk_fp8_f32(c, d, p, true); return (unsigned)p; }
template <int RS> struct EpiSwigluF8 {
    static constexpr bool PERM = true;
    unsigned char* H8; int ldh; int pad_tile; const ssq_t* rs;
    __device__ __forceinline__ void operator()(const f32x4 (&acc)[2][2][4][2], const Unit& u, int wr, int wc, int fr, int fq) const {
        const int r0 = wr * 64 + fr, col0 = u.pn * HALF + wc * 32 + 8 * fq;
        float sc[2][4];
#pragma unroll
        for (int ai = 0; ai < 2; ++ai)
#pragma unroll
            for (int m = 0; m < 4; ++m) { if constexpr (RS == 1) sc[ai][m] = rstd_of(rs[u.orow + r0 + ai * HALF + m * 16]) * (1.0f / (FP8_SX * FP8_SW)); else sc[ai][m] = 1.0f / (FP8_SA * FP8_SW); }
#pragma unroll
        for (int ai = 0; ai < 2; ++ai)
#pragma unroll
            for (int m = 0; m < 4; ++m) { const int r = r0 + ai * HALF + m * 16; unsigned char* rowp = H8 + (size_t)(u.orow + r) * ldh + col0; const float s = sc[ai][m];
                const f32x4 g0 = acc[ai][0][m][0] * s, g1 = acc[ai][0][m][1] * s, u0 = acc[ai][1][m][0] * s, u1 = acc[ai][1][m][1] * s;
                u32x2 w; w.x = pk4_fp8(silu_mul(g0[0], u0[0]) * FP8_SH, silu_mul(g0[1], u0[1]) * FP8_SH, silu_mul(g0[2], u0[2]) * FP8_SH, silu_mul(g0[3], u0[3]) * FP8_SH);
                w.y = pk4_fp8(silu_mul(g1[0], u1[0]) * FP8_SH, silu_mul(g1[1], u1[1]) * FP8_SH, silu_mul(g1[2], u1[2]) * FP8_SH, silu_mul(g1[3], u1[3]) * FP8_SH);
                *(u32x2*)rowp = w;
                if (u.pn == pad_tile) *(u32x2*)(rowp + HALF) = (u32x2){0u, 0u}; }
    }
};
struct EpiBf16Scaled {
    static constexpr bool PERM = true;
    bf16_t* O; int ldc; float scale;
    __device__ __forceinline__ void operator()(const f32x4 (&acc)[2][2][4][2], const Unit& u, int wr, int wc, int fr, int fq) const {
        const int row0 = u.orow + wr * 64 + fr, col0 = u.pn * BM + wc * 32 + 8 * fq;
#pragma unroll
        for (int ai = 0; ai < 2; ++ai)
#pragma unroll
            for (int m = 0; m < 4; ++m) { bf16_t* rowp = O + (size_t)(row0 + ai * HALF + m * 16) * ldc + col0;
#pragma unroll
                for (int bj = 0; bj < 2; ++bj) { const f32x4 v0 = acc[ai][bj][m][0] * scale, v1 = acc[ai][bj][m][1] * scale;
                    u32x4 w; w.x = cvt_pk_bf16(v0[0], v0[1]); w.y = cvt_pk_bf16(v0[2], v0[3]); w.z = cvt_pk_bf16(v1[0], v1[1]); w.w = cvt_pk_bf16(v1[2], v1[3]);
                    *(u32x4*)(rowp + bj * HALF) = w; } }
    }
};
template <bool W8> struct EpiResidH {
    static constexpr bool PERM = true;
    const bf16_t* hin; bf16_t* hout; ssq_t* ssq; unsigned char* h8; float scale;
    __device__ __forceinline__ void operator()(const f32x4 (&acc)[2][2][4][2], const Unit& u, int wr, int wc, int fr, int fq) const {
        const int row0 = u.orow + wr * 64 + fr, col0 = u.pn * BM + wc * 32 + 8 * fq;
#pragma unroll
        for (int ai = 0; ai < 2; ++ai) {
            u32x4 hv[4][2];
#pragma unroll
            for (int m = 0; m < 4; ++m)
#pragma unroll
                for (int bj = 0; bj < 2; ++bj) hv[m][bj] = *(const u32x4*)(hin + (size_t)(row0 + ai * HALF + m * 16) * DM + col0 + bj * HALF);
#pragma unroll
            for (int m = 0; m < 4; ++m) { const int row = row0 + ai * HALF + m * 16; const size_t off = (size_t)row * DM + col0; float part = 0.f;
#pragma unroll
                for (int bj = 0; bj < 2; ++bj) { const u32x4 h4 = hv[m][bj]; const f32x4 a0 = acc[ai][bj][m][0] * scale, a1 = acc[ai][bj][m][1] * scale;
                    const float y0 = bflo(h4.x) + a0[0], y1 = bfhi(h4.x) + a0[1], y2 = bflo(h4.y) + a0[2], y3 = bfhi(h4.y) + a0[3], y4 = bflo(h4.z) + a1[0], y5 = bfhi(h4.z) + a1[1], y6 = bflo(h4.w) + a1[2], y7 = bfhi(h4.w) + a1[3];
                    part += (y0 * y0 + y1 * y1) + (y2 * y2 + y3 * y3) + (y4 * y4 + y5 * y5) + (y6 * y6 + y7 * y7);
                    u32x4 w; w.x = cvt_pk_bf16(y0, y1); w.y = cvt_pk_bf16(y2, y3); w.z = cvt_pk_bf16(y4, y5); w.w = cvt_pk_bf16(y6, y7);
                    *(u32x4*)(hout + off + bj * HALF) = w;
                    if constexpr (W8) { u32x2 q; q.x = pk4_fp8(y0 * FP8_SX, y1 * FP8_SX, y2 * FP8_SX, y3 * FP8_SX); q.y = pk4_fp8(y4 * FP8_SX, y5 * FP8_SX, y6 * FP8_SX, y7 * FP8_SX); *(u32x2*)(h8 + off + bj * HALF) = q; } }
                part += __shfl_xor(part, 16); part += __shfl_xor(part, 32);
                if (fq == 0) atomicAdd(ssq + row, ssq_fix(part)); }
        }
    }
};
struct EpiDown {
    static constexpr bool PERM = true;
    bf16_t* O; bf16_t* KR; const ssq_t* rs; ssq_t* ssq_q; ssq_t* ssq_kv; const float* cosT; const float* sinT;
    __device__ __forceinline__ void operator()(const f32x4 (&acc)[2][2][4][2], const Unit& u, int wr, int wc, int fr, int fq) const {
        const int row0 = u.orow + wr * 64 + fr;
        float sc[2][4];
#pragma unroll
        for (int ai = 0; ai < 2; ++ai)
#pragma unroll
            for (int m = 0; m < 4; ++m) sc[ai][m] = rstd_of(rs[row0 + ai * HALF + m * 16]);
        if (u.pn < 3) {
            ssq_t* sq = u.pn < 2 ? ssq_q : ssq_kv; const int col0 = u.pn * BM + wc * 32 + 8 * fq;
#pragma unroll
            for (int ai = 0; ai < 2; ++ai)
#pragma unroll
                for (int m = 0; m < 4; ++m) { const int row = row0 + ai * HALF + m * 16; bf16_t* rowp = O + (size_t)row * NDOWNP + col0; const float s = sc[ai][m]; float part = 0.f;
#pragma unroll
                    for (int bj = 0; bj < 2; ++bj) { const f32x4 v0 = acc[ai][bj][m][0] * s, v1 = acc[ai][bj][m][1] * s;
                        part += (v0[0] * v0[0] + v0[1] * v0[1]) + (v0[2] * v0[2] + v0[3] * v0[3]) + (v1[0] * v1[0] + v1[1] * v1[1]) + (v1[2] * v1[2] + v1[3] * v1[3]);
                        u32x4 w; w.x = cvt_pk_bf16(v0[0], v0[1]); w.y = cvt_pk_bf16(v0[2], v0[3]); w.z = cvt_pk_bf16(v1[0], v1[1]); w.w = cvt_pk_bf16(v1[2], v1[3]);
                        *(u32x4*)(rowp + bj * HALF) = w; }
                    part += __shfl_xor(part, 16); part += __shfl_xor(part, 32);
                    if (fq == 0) atomicAdd(sq + row, ssq_fix(part)); }
        } else if (wc == 0) {
#pragma unroll
            for (int aq = 0; aq < 4; ++aq) { const int ai = aq >> 1, mb = (aq & 1) * 2; f32x4 ct[4][2], st[4][2];
#pragma unroll
                for (int m = mb; m < mb + 2; ++m) { const size_t to = (size_t)(row0 + ai * HALF + m * 16) * 32 + 8 * fq;
                    ct[m][0] = *(const f32x4*)(cosT + to); ct[m][1] = *(const f32x4*)(cosT + to + 4); st[m][0] = *(const f32x4*)(sinT + to); st[m][1] = *(const f32x4*)(sinT + to + 4); }
#pragma unroll
                for (int m = mb; m < mb + 2; ++m) { const int row = row0 + ai * HALF + m * 16; const float s = sc[ai][m];
                    const f32x4 a0 = acc[ai][0][m][0] * s, a1 = acc[ai][0][m][1] * s, b0 = acc[ai][1][m][0] * s, b1 = acc[ai][1][m][1] * s;
                    const f32x4 x0 = a0 * ct[m][0] - b0 * st[m][0], x1 = a1 * ct[m][1] - b1 * st[m][1], y0 = b0 * ct[m][0] + a0 * st[m][0], y1 = b1 * ct[m][1] + a1 * st[m][1];
                    bf16_t* rp = KR + (size_t)row * DROPE + 8 * fq;
                    u32x4 w; w.x = cvt_pk_bf16(x0[0], x0[1]); w.y = cvt_pk_bf16(x0[2], x0[3]); w.z = cvt_pk_bf16(x1[0], x1[1]); w.w = cvt_pk_bf16(x1[2], x1[3]);
                    *(u32x4*)rp = w;
                    w.x = cvt_pk_bf16(y0[0], y0[1]); w.y = cvt_pk_bf16(y0[2], y0[3]); w.z = cvt_pk_bf16(y1[0], y1[1]); w.w = cvt_pk_bf16(y1[2], y1[3]);
                    *(u32x4*)(rp + 32) = w; } }
        }
    }
};
struct EpiQ {
    static constexpr bool PERM = true;
    bf16_t* Q; const float* cosT; const float* sinT; const ssq_t* rs;
    __device__ __forceinline__ void operator()(const f32x4 (&acc)[2][2][4][2], const Unit& u, int wr, int wc, int fr, int fq) const {
        const int row0 = u.orow + wr * 64 + fr;
        float sc[2][4];
#pragma unroll
        for (int ai = 0; ai < 2; ++ai)
#pragma unroll
            for (int m = 0; m < 4; ++m) sc[ai][m] = rstd_n(rs[row0 + ai * HALF + m * 16], 1.0f / QLR);
        if (u.pn < 2) {
            const int h = 4 * u.pn + wc;
#pragma unroll
            for (int aq = 0; aq < 4; ++aq) { const int ai = aq >> 1, mb = (aq & 1) * 2; f32x4 ct[4][2], st[4][2];
#pragma unroll
                for (int m = mb; m < mb + 2; ++m) { const size_t to = (size_t)(row0 + ai * HALF + m * 16) * 32 + 8 * fq;
                    ct[m][0] = *(const f32x4*)(cosT + to); ct[m][1] = *(const f32x4*)(cosT + to + 4); st[m][0] = *(const f32x4*)(sinT + to); st[m][1] = *(const f32x4*)(sinT + to + 4); }
#pragma unroll
                for (int m = mb; m < mb + 2; ++m) { const int row = row0 + ai * HALF + m * 16; const float s = sc[ai][m];
                    const f32x4 a0 = acc[ai][0][m][0] * s, a1 = acc[ai][0][m][1] * s, b0 = acc[ai][1][m][0] * s, b1 = acc[ai][1][m][1] * s;
                    const f32x4 x0 = a0 * ct[m][0] - b0 * st[m][0], x1 = a1 * ct[m][1] - b1 * st[m][1], y0 = b0 * ct[m][0] + a0 * st[m][0], y1 = b1 * ct[m][1] + a1 * st[m][1];
                    bf16_t* rp = Q + (size_t)row * NQ + h * DQH + DNOPE + 8 * fq;
                    u32x4 w; w.x = cvt_pk_bf16(x0[0], x0[1]); w.y = cvt_pk_bf16(x0[2], x0[3]); w.z = cvt_pk_bf16(x1[0], x1[1]); w.w = cvt_pk_bf16(x1[2], x1[3]);
                    *(u32x4*)rp = w;
                    w.x = cvt_pk_bf16(y0[0], y0[1]); w.y = cvt_pk_bf16(y0[2], y0[3]); w.z = cvt_pk_bf16(y1[0], y1[1]); w.w = cvt_pk_bf16(y1[2], y1[3]);
                    *(u32x4*)(rp + 32) = w; } }
        } else {
#pragma unroll
            for (int ai = 0; ai < 2; ++ai)
#pragma unroll
                for (int m = 0; m < 4; ++m) { const int row = row0 + ai * HALF + m * 16; const float s = sc[ai][m];
#pragma unroll
                    for (int bj = 0; bj < 2; ++bj) { const int h = 2 * (u.pn - 2) + bj; const f32x4 v0 = acc[ai][bj][m][0] * s, v1 = acc[ai][bj][m][1] * s;
                        u32x4 w; w.x = cvt_pk_bf16(v0[0], v0[1]); w.y = cvt_pk_bf16(v0[2], v0[3]); w.z = cvt_pk_bf16(v1[0], v1[1]); w.w = cvt_pk_bf16(v1[2], v1[3]);
                        *(u32x4*)(Q + (size_t)row * NQ + h * DQH + wc * 32 + 8 * fq) = w; } }
        }
    }
};

__device__ __forceinline__ unsigned gather_off(const Unit& u, int idx, unsigned lda_b, unsigned cb) { const int tok = idx < u.nrows ? u.rows[idx] : 0; return (unsigned)tok * lda_b + cb; }
__device__ __forceinline__ u32x4 gather_offs(const Unit& u, int tid, unsigned lda_b) {
    const int t2 = launder_v(tid); int R0, C0, R1, C1; stage_rc(t2 * 16, R0, C0); stage_rc(t2 * 16 + 8192, R1, C1);
    u32x4 pk; pk.x = gather_off(u, R0, lda_b, (unsigned)C0 * 2u); pk.y = gather_off(u, R1, lda_b, (unsigned)C1 * 2u); pk.z = gather_off(u, HALF + R0, lda_b, (unsigned)C0 * 2u); pk.w = gather_off(u, HALF + R1, lda_b, (unsigned)C1 * 2u);
    return pk;
}
typedef int i32x4 __attribute__((ext_vector_type(4)));
typedef int i32x8 __attribute__((ext_vector_type(8)));
template <class Epi, class Sched, bool GATHER, bool FP8 = false>
__device__ __forceinline__ void gemm_phase(LAS unsigned char* lds, const unsigned lda_b, const unsigned ldb_b, const int Kb, const Sched& S, const Epi& E) {
    const int tid = launder_v((int)threadIdx.x), wid = __builtin_amdgcn_readfirstlane(tid >> 6), lane = tid & 63, wr = wid >> 2, wc = wid & 3, fr = lane & 15, fq = lane >> 4;
    int nt = Kb / (BK * 2); asm volatile("" : "+s"(nt));
    unsigned voffA[2], voffB[2];
#pragma unroll
    for (int i = 0; i < 2; ++i) { int R, C; stage_rc(tid * 16 + i * 8192, R, C); const int Rb = Epi::PERM ? ((R & ~31) + perm32(R & 31)) : R;
        voffA[i] = (unsigned)R * lda_b + (unsigned)C * 2u; voffB[i] = (unsigned)Rb * ldb_b + (unsigned)C * 2u; }
    const size_t kstep = (size_t)(BK * 2);
    const size_t hstepA = (size_t)HALF * lda_b, hstepB = (size_t)HALF * ldb_b;
    const unsigned ldsw = (unsigned)wid * 1024u;
    const int aoff = lds_byte(wr * 64 + fr, fq * 8), boff = lds_byte(wc * 32 + fr, fq * 8);
    unsigned cv0[2] = {0u, 0u}, cv1[2] = {0u, 0u}, nv0[2] = {0u, 0u}, nv1[2] = {0u, 0u};
#define PG8_SA(b, h) (((b) * 2 + (h)) * HTB)
#define PG8_SB(b, h) ((4 + (b) * 2 + (h)) * HTB)
#define PG8_LOAD16(gp, ldsoff) __builtin_amdgcn_global_load_lds((const unsigned*)(gp), (LAS unsigned*)(lds + (ldsoff)), 16, 0, 0)
#define PG8_STAGE_B(bufoff, gbase, h) do { _Pragma("unroll") for (int _i = 0; _i < 2; ++_i) PG8_LOAD16((gbase) + (h) * hstepB + voffB[_i], (bufoff) + ldsw + _i * 8192); } while (0)
#define PG8_STAGE_A(bufoff, gbase, h, usenext) do { _Pragma("unroll") for (int _i = 0; _i < 2; ++_i) { unsigned _vo; \
        if constexpr (GATHER) { _vo = (usenext) ? ((h) ? nv1[_i] : nv0[_i]) : ((h) ? cv1[_i] : cv0[_i]); } else { _vo = voffA[_i] + (unsigned)((h) * hstepA); } \
        PG8_LOAD16((gbase) + _vo, (bufoff) + ldsw + _i * 8192); } } while (0)
#define PG8_LD32(off) __builtin_shufflevector(*(const LAS i32x4*)(lds + (off)), *(const LAS i32x4*)(lds + (off) + 1024), 0, 1, 2, 3, 4, 5, 6, 7)
#define PG8_LDA(dst, b, h) do { _Pragma("unroll") for (int m = 0; m < 4; ++m) { if constexpr (FP8) { dst##8[m] = PG8_LD32(PG8_SA(b, h) + aoff + m * 2048); } else { _Pragma("unroll") for (int k = 0; k < 2; ++k) dst[m][k] = *(const LAS bf16x8*)(lds + PG8_SA(b, h) + aoff + m * 2048 + k * 1024); } } } while (0)
#define PG8_LDB(dst, b, h) do { _Pragma("unroll") for (int n = 0; n < 2; ++n) { if constexpr (FP8) { dst##8[n] = PG8_LD32(PG8_SB(b, h) + boff + n * 2048); } else { _Pragma("unroll") for (int k = 0; k < 2; ++k) dst[n][k] = *(const LAS bf16x8*)(lds + PG8_SB(b, h) + boff + n * 2048 + k * 1024); } } } while (0)
#define PG8_MMA(ai, bj, At, Bt) do { __builtin_amdgcn_s_setprio(1); _Pragma("unroll") for (int m = 0; m < 4; ++m) _Pragma("unroll") for (int n = 0; n < 2; ++n) { \
        if constexpr (FP8) { asm volatile("v_mfma_f32_16x16x128_f8f6f4 %0, %1, %2, %0" : "+v"(acc[ai][bj][m][n]) : "v"(Bt##8[n]), "v"(At##8[m])); }     \
        else { _Pragma("unroll") for (int k = 0; k < 2; ++k) acc[ai][bj][m][n] = __builtin_amdgcn_mfma_f32_16x16x32_bf16(Bt[n][k], At[m][k], acc[ai][bj][m][n], 0, 0, 0); } } \
        __builtin_amdgcn_s_setprio(0); } while (0)
#define PG8_WAIT_V(n) asm volatile("s_waitcnt vmcnt(" #n ")" ::: "memory")
#define PG8_WAIT_L(n) asm volatile("s_waitcnt lgkmcnt(" #n ")" ::: "memory")
#define PG8_BAR __builtin_amdgcn_s_barrier()
#define PG8_SCHED __builtin_amdgcn_sched_barrier(0)
    Unit cur, nxt; int ui = 0;
    if (!S.next(0, cur)) return;
    f32x4 acc[2][2][4][2];
#pragma unroll
    for (int a = 0; a < 2; ++a)
#pragma unroll
        for (int b = 0; b < 2; ++b)
#pragma unroll
            for (int m = 0; m < 4; ++m)
#pragma unroll
                for (int n = 0; n < 2; ++n) acc[a][b][m][n] = (f32x4){0.f, 0.f, 0.f, 0.f};
    bf16x8 At[4][2], B0[2][2], B1[2][2]; i32x8 At8[4], B08[2], B18[2];
    const char* cA = cur.a; const char* cB = cur.b;
    if constexpr (GATHER) { const u32x4 pk = gather_offs(cur, tid, lda_b); cv0[0] = pk.x; cv0[1] = pk.y; cv1[0] = pk.z; cv1[1] = pk.w; }
    PG8_STAGE_B(PG8_SB(0, 0), cB, 0); PG8_STAGE_B(PG8_SB(0, 1), cB, 1); PG8_STAGE_A(PG8_SA(0, 0), cA, 0, false); PG8_STAGE_A(PG8_SA(0, 1), cA, 1, false);
    if (wr == 1) PG8_BAR;
    PG8_WAIT_V(2); PG8_BAR;
    PG8_STAGE_B(PG8_SB(1, 0), cB + kstep, 0); PG8_STAGE_A(PG8_SA(1, 0), cA + kstep, 0, false); PG8_STAGE_B(PG8_SB(1, 1), cB + kstep, 1);
    PG8_WAIT_V(6); PG8_BAR;
    for (;;) {
        const bool has_next = S.next(ui + 1, nxt);
        const char* nA = has_next ? nxt.a : cA; const char* nB = has_next ? nxt.b : cB;
        if constexpr (GATHER) {
            u32x4 pk = (u32x4){cv0[0], cv0[1], cv1[0], cv1[1]}; if (has_next) pk = gather_offs(nxt, tid, lda_b);
            *(LAS u32x4*)(lds + STAGE_BYTES + 1024 + tid * 16) = pk;
        }
#pragma nounroll
        for (int t = 0; t < nt; t += 2) {
            const bool last = (t == nt - 2);
            if constexpr (GATHER) { if (last) { const u32x4 pk = *(const LAS u32x4*)(lds + STAGE_BYTES + 1024 + tid * 16); nv0[0] = pk.x; nv0[1] = pk.y; nv1[0] = pk.z; nv1[1] = pk.w; } }
            const char* a1 = cA + (size_t)(t + 1) * kstep;
            const char* a2 = last ? nA : cA + (size_t)(t + 2) * kstep; const char* b2 = last ? nB : cB + (size_t)(t + 2) * kstep;
            const char* a3 = a2 + kstep; const char* b3 = b2 + kstep;
            PG8_LDB(B0, 0, 0); PG8_LDB(B1, 0, 1); PG8_SCHED; PG8_LDA(At, 0, 0); PG8_STAGE_A(PG8_SA(1, 1), a1, 1, false);
            PG8_WAIT_V(8); PG8_WAIT_L(0); PG8_BAR; PG8_MMA(0, 0, At, B0); PG8_MMA(0, 1, At, B1); PG8_BAR; PG8_SCHED;
            PG8_LDA(At, 0, 1); PG8_STAGE_B(PG8_SB(0, 0), b2, 0); PG8_STAGE_B(PG8_SB(0, 1), b2, 1); PG8_STAGE_A(PG8_SA(0, 0), a2, 0, last);
            PG8_WAIT_V(8); PG8_WAIT_L(0); PG8_BAR; PG8_MMA(1, 0, At, B0); PG8_MMA(1, 1, At, B1); PG8_BAR; PG8_SCHED;
            PG8_LDB(B0, 1, 0); PG8_LDB(B1, 1, 1); PG8_SCHED; PG8_LDA(At, 1, 0); PG8_STAGE_A(PG8_SA(0, 1), a2, 1, last);
            PG8_WAIT_V(8); PG8_WAIT_L(0); PG8_BAR; PG8_MMA(0, 0, At, B0); PG8_MMA(0, 1, At, B1); PG8_BAR; PG8_SCHED;
            PG8_LDA(At, 1, 1); PG8_STAGE_B(PG8_SB(1, 0), b3, 0); PG8_STAGE_B(PG8_SB(1, 1), b3, 1); PG8_STAGE_A(PG8_SA(1, 0), a3, 0, last);
            PG8_WAIT_V(8); PG8_WAIT_L(0); PG8_BAR; PG8_MMA(1, 0, At, B0); PG8_MMA(1, 1, At, B1); PG8_BAR; PG8_SCHED;
        }
        if (wr == 0) PG8_BAR;
        if constexpr (FP8) asm volatile("s_nop 15\n\ts_nop 15" ::: "memory");
        E(acc, cur, wr, wc, fr, fq);
        if (!has_next) break;
#pragma unroll
        for (int a = 0; a < 2; ++a)
#pragma unroll
            for (int b = 0; b < 2; ++b)
#pragma unroll
                for (int m = 0; m < 4; ++m)
#pragma unroll
                    for (int n = 0; n < 2; ++n) acc[a][b][m][n] = (f32x4){0.f, 0.f, 0.f, 0.f};
        cur = nxt; cA = nA; cB = nB; ++ui;
        if constexpr (GATHER) {
#pragma unroll
            for (int i = 0; i < 2; ++i) { cv0[i] = nv0[i]; cv1[i] = nv1[i]; }
        }
        if (wr == 1) PG8_BAR;
    }
    PG8_WAIT_V(0);
    PG8_BAR;
#undef PG8_SA
#undef PG8_SB
#undef PG8_LOAD16
#undef PG8_STAGE_A
#undef PG8_STAGE_B
#undef PG8_LDA
#undef PG8_LDB
#undef PG8_LD32
#undef PG8_MMA
#undef PG8_WAIT_V
#undef PG8_WAIT_L
#undef PG8_BAR
#undef PG8_SCHED
}
}
namespace att {
constexpr int NW = 8, QBLK = 32, KVBLK = 64, QB = NW * QBLK;
constexpr int DQK = 192, DV = 128;
constexpr int QS = NQ, KNS = NKV, KRS = DROPE, OS = DM;
constexpr int SHM_V = KVBLK * DV * 2, SHM_K = KVBLK * DQK * 2;
constexpr int LDS_QR = 2 * SHM_V + 2 * SHM_K + NW * 64 * 4;
constexpr int LDS_BYTES = LDS_QR + NW * 4096;
constexpr float SCALE = 0.07216878364870322f;
constexpr float THR = 8.f;
#define KSWZ(row, ch) ((row) * 384 + ((((ch) ^ (((row) >> 1) & 7))) << 4))
#define SBAR() __builtin_amdgcn_sched_barrier(0)
__device__ __forceinline__ int v_st(int k, int c) { const int kk = (k & ~0xC) | ((k & 4) << 1) | ((k & 8) >> 1); return ((kk >> 3) * 4 + (c >> 5)) * 512 + ((kk & 7) * 32 + (c & 31)) * 2; }
__device__ __forceinline__ int v_rd_base(int lane) { return ((lane & 3) << 3) | (((lane >> 2) & 3) << 6) | (((lane >> 4) & 1) << 5) | (((lane >> 5) & 1) << 8); }
constexpr int v_rd_off(int d0, int ks, int half) { return d0 * 512 + ks * 4096 + half * 2048; }
__device__ __forceinline__ int crow(int r, int hi) { return (r & 3) + 8 * (r >> 2) + 4 * hi; }
__device__ __forceinline__ void mask_tile(f32x16& p0, f32x16& p1, int dq) {
    const float NEG = -__builtin_inff();
#pragma unroll
    for (int r = 0; r < 16; ++r) {
        const int c = (r & 3) + 8 * (r >> 2);
        if (dq - c < 0) p0[r] = NEG;
        if (dq - c - 32 < 0) p1[r] = NEG;
    }
}
__device__ __forceinline__ void partialSM(f32x16& p0, f32x16& p1, float& m_reg, float& mn, float& alpha) {
    float pmax = p0[0]; for (int r = 1; r < 16; ++r) pmax = fmaxf(pmax, p0[r]); for (int r = 0; r < 16; ++r) pmax = fmaxf(pmax, p1[r]);
    { auto rr = __builtin_amdgcn_permlane32_swap(__float_as_uint(pmax), __float_as_uint(pmax), false, false);
      pmax = fmaxf(__uint_as_float(rr[0]), __uint_as_float(rr[1])); }
    constexpr float C2 = 1.4426950408889634f * SCALE;
    if (__builtin_expect(__all((pmax - m_reg) * SCALE <= THR), 1)) { mn = m_reg; alpha = 1.f; }
    else { mn = fmaxf(m_reg, pmax); alpha = __builtin_amdgcn_exp2f((m_reg - mn) * C2); m_reg = mn; }
    const float mnL = -mn * C2;
    for (int r = 0; r < 16; ++r) p0[r] = fmaf(p0[r], C2, mnL); for (int r = 0; r < 16; ++r) p1[r] = fmaf(p1[r], C2, mnL);
    for (int r = 0; r < 16; ++r) p0[r] = __builtin_amdgcn_exp2f(p0[r]);
}
__device__ __forceinline__ void finishSM(f32x16& p0, f32x16& p1, float alpha, float& l_reg, bf16x8& pa0, bf16x8& pa1, bf16x8& pa2, bf16x8& pa3) {
    for (int r = 0; r < 16; ++r) p1[r] = __builtin_amdgcn_exp2f(p1[r]);
    float ps = 0; for (int r = 0; r < 16; ++r) ps += p0[r]; for (int r = 0; r < 16; ++r) ps += p1[r];
    { auto rr = __builtin_amdgcn_permlane32_swap(__float_as_uint(ps), __float_as_uint(ps), false, false);
      ps = __uint_as_float(rr[0]) + __uint_as_float(rr[1]); }
    l_reg = l_reg * alpha + ps;
#define PK4(P, B_, OUT) do { unsigned a0 = cvt_pk_bf16(P[B_+0], P[B_+1]), a1 = cvt_pk_bf16(P[B_+2], P[B_+3]);                          \
        unsigned b0 = cvt_pk_bf16(P[B_+4], P[B_+5]), b1 = cvt_pk_bf16(P[B_+6], P[B_+7]);                                             \
        auto r0 = __builtin_amdgcn_permlane32_swap(a0, b0, false, false); auto r1 = __builtin_amdgcn_permlane32_swap(a1, b1, false, false); \
        u32x4 w = {r0[0], r1[0], r0[1], r1[1]}; OUT = *reinterpret_cast<bf16x8*>(&w); } while (0)
    PK4(p0, 0, pa0); PK4(p0, 8, pa1); PK4(p1, 0, pa2); PK4(p1, 8, pa3);
#undef PK4
}
template <int KB>
__device__ __forceinline__ void qkt(f32x16& p0, f32x16& p1, const char* K_lds, int r32, int hi, const bf16x8* qr, const char* qrl) {
    p0 = f32x16{}; p1 = f32x16{};
    const char* kb[4];
#pragma unroll
    for (int dd = 0; dd < 4; ++dd) kb[dd] = K_lds + KB * SHM_K + KSWZ(r32, dd * 2 + hi);
#pragma unroll
    for (int d0 = 0; d0 < 12; ++d0) { const char* a = kb[d0 & 3] + (d0 >> 2) * 128;
        bf16x8 b0 = *reinterpret_cast<const bf16x8*>(a);
        bf16x8 b1 = *reinterpret_cast<const bf16x8*>(a + 32 * 384);
        const bf16x8 qf = d0 < 8 ? qr[d0 & 7] : *reinterpret_cast<const bf16x8*>(qrl + (d0 - 8) * 1024);
        p0 = __builtin_amdgcn_mfma_f32_32x32x16_bf16(b0, qf, p0, 0, 0, 0);
        p1 = __builtin_amdgcn_mfma_f32_32x32x16_bf16(b1, qf, p1, 0, 0, 0);
        if ((d0 & 3) == 3 && d0 < 11) SBAR(); }
}
template <int VB>
__device__ __forceinline__ void pv_tile(f32x16* o, int vb0, bf16x8 pa0, bf16x8 pa1, bf16x8 pa2, bf16x8 pa3) {
#define TRRD(dst, off) asm volatile("ds_read_b64_tr_b16 %0, %1 offset:%2" : "=&v"(dst) : "v"(vb0), "i"(off) : "memory")
#define PV_D0(d0) do { s16x4 l0, l1, l2, l3, h0, h1, h2, h3; constexpr int b_ = VB * SHM_V + v_rd_off(d0, 0, 0); \
        TRRD(l0, b_); TRRD(h0, b_ + 2048); TRRD(l1, b_ + 4096); TRRD(h1, b_ + 6144); TRRD(l2, b_ + 8192); TRRD(h2, b_ + 10240); TRRD(l3, b_ + 12288); TRRD(h3, b_ + 14336); \
        asm volatile("s_waitcnt lgkmcnt(0)" ::: "memory"); SBAR();   \
        o[d0] = __builtin_amdgcn_mfma_f32_32x32x16_bf16(pa0, (bf16x8){l0[0], l0[1], l0[2], l0[3], h0[0], h0[1], h0[2], h0[3]}, o[d0], 0, 0, 0);   \
        o[d0] = __builtin_amdgcn_mfma_f32_32x32x16_bf16(pa1, (bf16x8){l1[0], l1[1], l1[2], l1[3], h1[0], h1[1], h1[2], h1[3]}, o[d0], 0, 0, 0);   \
        o[d0] = __builtin_amdgcn_mfma_f32_32x32x16_bf16(pa2, (bf16x8){l2[0], l2[1], l2[2], l2[3], h2[0], h2[1], h2[2], h2[3]}, o[d0], 0, 0, 0);   \
        o[d0] = __builtin_amdgcn_mfma_f32_32x32x16_bf16(pa3, (bf16x8){l3[0], l3[1], l3[2], l3[3], h3[0], h3[1], h3[2], h3[3]}, o[d0], 0, 0, 0); } while (0)
    PV_D0(0); PV_D0(1); PV_D0(2); PV_D0(3);
#undef PV_D0
#undef TRRD
}
struct BlockRef { const bf16_t* Q; const bf16_t* Kn; const bf16_t* Kr; const bf16_t* V; bf16_t* O; int P0; };
struct Seam { bf16x8 qr[8]; bf16x8 st_v0, st_v1, st_k0, st_k1, st_k2; };
#define VMW() asm volatile("s_waitcnt vmcnt(0)" ::: "memory")
#define VMWN(n) asm volatile("s_waitcnt vmcnt(%0)" :: "i"(n) : "memory")
#define LD8(p) (*reinterpret_cast<const bf16x8*>(p))
#define SLOAD_H(R_, k0) do { S.st_v0 = LD8((R_).V + (size_t)((k0) + sr) * KNS + sc); S.st_v1 = LD8((R_).V + (size_t)((k0) + 32 + sr) * KNS + sc);              \
                             S.st_k0 = LD8((R_).Kn + (size_t)((k0) + sr) * KNS + sc); S.st_k1 = LD8((R_).Kn + (size_t)((k0) + 32 + sr) * KNS + sc);            \
                             S.st_k2 = LD8((R_).Kr + (size_t)((k0) + rr) * KRS + rc); } while (0)
#define SWRITE_HK(bf) do { *(bf16x8*)(K_lds + (bf) * SHM_K + kws) = S.st_k0; *(bf16x8*)(K_lds + (bf) * SHM_K + kws + 32 * 384) = S.st_k1; *(bf16x8*)(K_lds + (bf) * SHM_K + kws2) = S.st_k2; } while (0)
#define SWRITE_HV(bf) do { *(bf16x8*)(V_lds + (bf) * SHM_V + vst0) = S.st_v0; *(bf16x8*)(V_lds + (bf) * SHM_V + vst1) = S.st_v1; } while (0)
#define SWRITE_H(bf) do { SWRITE_HV(bf); SWRITE_HK(bf); } while (0)
#define ATT_IDX const int tid = launder_v((int)threadIdx.x), wid = __builtin_amdgcn_readfirstlane(tid >> 6), lane = tid & 63, r32 = lane & 31, hi = lane >> 5; \
    const int sr = tid >> 4, sc = (tid & 15) * 8, rr = tid >> 3, rc = (tid & 7) * 8, kws = KSWZ(sr, (tid & 15)), kws2 = KSWZ(rr, 16 + (tid & 7));
__device__ __forceinline__ void attn_block(const BlockRef& cur, char* lds) {
    ATT_IDX;
    Seam S;
    const int NT = cur.P0 / KVBLK + QB / KVBLK;
    const int qlo = cur.P0 + wid * QBLK, qm = qlo + r32 - 4 * hi;
    char* V_lds = lds; char* K_lds = lds + 2 * SHM_V;
    float* ws = (float*)(lds + 2 * SHM_V + 2 * SHM_K) + wid * 64; float* li_l = ws, * al_l = ws + 32;
    float m_reg = -1e30f, l_reg = 0; f32x16 o[4] = {};
    const int vst0 = v_st(sr, sc), vst1 = v_st(32 + sr, sc);
    const int vb0 = (int)(uintptr_t)V_lds + v_rd_base(lane);
    char* qrl = lds + LDS_QR + wid * 4096 + lane * 16;
#define RESC(a) do { if (__any((a) < 1.f)) { if (hi == 0) al_l[r32] = (a); asm volatile("s_waitcnt lgkmcnt(0)" ::: "memory");              \
                     for (int d_ = 0; d_ < 4; ++d_) for (int r = 0; r < 16; ++r) o[d_][r] *= al_l[crow(r, hi)]; } } while (0)
#define KBASE(t) ((t) * KVBLK)
#define MASKT(P0_, P1_, t) do { const int kb_ = KBASE(t); if (kb_ + KVBLK - 1 > qlo) mask_tile(P0_, P1_, qm - kb_); } while (0)
    SLOAD_H(cur, 0);
#pragma unroll
    for (int d0 = 0; d0 < 8; ++d0) S.qr[d0] = LD8(cur.Q + (size_t)(wid * QBLK + r32) * QS + d0 * 16 + hi * 8);
    { bf16x8 t0 = LD8(cur.Q + (size_t)(wid * QBLK + r32) * QS + 128 + hi * 8), t1 = LD8(cur.Q + (size_t)(wid * QBLK + r32) * QS + 144 + hi * 8),
             t2 = LD8(cur.Q + (size_t)(wid * QBLK + r32) * QS + 160 + hi * 8), t3 = LD8(cur.Q + (size_t)(wid * QBLK + r32) * QS + 176 + hi * 8);
      *(bf16x8*)(qrl) = t0; *(bf16x8*)(qrl + 1024) = t1; *(bf16x8*)(qrl + 2048) = t2; *(bf16x8*)(qrl + 3072) = t3; }
    VMW(); SWRITE_H(0);
    __syncthreads();
    f32x16 p0, p1; float mn, al; bf16x8 pa0, pa1, pa2, pa3;
#define TILE_STEP(t, BF) do {                                                                                                 \
        if ((t) + 1 < NT) { SLOAD_H(cur, KBASE((t) + 1)); }                                                                    \
        SBAR();                                                                                                               \
        if (KBASE(t) <= qlo + QBLK - 1) {     \
        qkt<BF>(p0, p1, K_lds, r32, hi, S.qr, qrl);                                                                           \
        MASKT(p0, p1, (t)); partialSM(p0, p1, m_reg, mn, al); RESC(al);                                                        \
        finishSM(p0, p1, al, l_reg, pa0, pa1, pa2, pa3); SBAR();                                                              \
        pv_tile<BF>(o, vb0, pa0, pa1, pa2, pa3); }                                                                            \
        if ((t) + 1 < NT) { VMW(); SWRITE_H(1 - BF); }                                                                         \
        __syncthreads(); } while (0)
    for (int t = 0; t < NT; t += 2) { TILE_STEP(t, 0); TILE_STEP(t + 1, 1); }
    if (hi == 0) li_l[r32] = l_reg; asm volatile("s_waitcnt lgkmcnt(0)" ::: "memory");
    float rli[16];
#pragma unroll
    for (int r = 0; r < 16; ++r) rli[r] = __builtin_amdgcn_rcpf(li_l[crow(r, hi)]);
    bf16_t* Ow = cur.O + (size_t)(wid * QBLK) * OS;
#pragma unroll
    for (int r = 0; r < 16; ++r) { const int orow = crow(r, hi);
#pragma unroll
        for (int d0 = 0; d0 < 4; ++d0) { const float v = o[d0][r] * rli[r];
            const float vn = __shfl_xor(v, 1);
            if ((r32 & 1) == 0) *(unsigned*)(Ow + (size_t)orow * OS + d0 * 32 + r32) = cvt_pk_bf16(v, vn); } }
    __syncthreads();
#undef RESC
#undef KBASE
#undef MASKT
#undef TILE_STEP
}
#undef VMW
#undef VMWN
#undef LD8
#undef SLOAD_H
#undef SWRITE_HK
#undef SWRITE_HV
#undef SWRITE_H
#undef ATT_IDX
#undef KSWZ
#undef SBAR

__device__ __forceinline__ BlockRef make_ref(int L, int pass, const bf16_t* Qb, const bf16_t* KNVb, const bf16_t* KRb, bf16_t* Ob) {
    const int bh = L >> 2, x = L & 3, qb = pass ? 7 - x : x, b = bh >> 3, h = bh & 7; const size_t rb = (size_t)b * SEQ;
    BlockRef r; r.Q = Qb + (rb + (size_t)qb * QB) * QS + h * DQH; r.Kn = KNVb + rb * KNS + h * (DNOPE + DVH); r.Kr = KRb + rb * KRS; r.V = KNVb + rb * KNS + h * (DNOPE + DVH) + DNOPE;
    r.O = Ob + (rb + (size_t)qb * QB) * OS + h * DVH; r.P0 = qb * QB; return r;
}
__device__ __forceinline__ void attn_phase(char* lds, const bf16_t* Qb, const bf16_t* KNVb, const bf16_t* KRb, bf16_t* Ob, int first, int stride) {
    constexpr int total = NBATCH * NHEAD * 4;
    for (int L = first; L < total; L += stride) {
        for (int pass = 0; pass < 2; ++pass) { const BlockRef cur = make_ref(L, pass, Qb, KNVb, KRb, Ob); attn_block(cur, lds); }
    }
}
}
constexpr int NWAVES = 8;
constexpr size_t MiB = 1u << 20;
constexpr size_t WS_CTL = 0, CTL_ZERO_BYTES = 8 * MiB;
constexpr size_t WS_SSQ = 1 * MiB;
constexpr size_t WS_COS = 8 * MiB, WS_SIN = 16 * MiB;
constexpr size_t WS_LIST = 24 * MiB;
constexpr size_t WS_RSL = 26 * MiB;
constexpr size_t WS_TOKINFO = 28 * MiB;
constexpr size_t WS_WDN = 30 * MiB, WS_WUQ = 34 * MiB, WS_WUKV = 37 * MiB, WS_WO = 39 * MiB, WS_WPOOL = 43 * MiB, WS_WGU = 44 * MiB, WS_WD = 65 * MiB, WS_MWGU = 76 * MiB, WS_MWD = 164 * MiB;
constexpr size_t WS_H = 208 * MiB;
constexpr size_t WS_ACT = 336 * MiB;
constexpr size_t WS_DOWN = WS_ACT;
constexpr size_t WS_CQN = WS_ACT + 128 * MiB, WS_CKVN = WS_ACT + 192 * MiB, WS_KR = WS_ACT + 224 * MiB, WS_Q = WS_ACT + 232 * MiB, WS_KNV = WS_ACT + 424 * MiB;
constexpr size_t WS_HID = WS_ACT;
constexpr size_t WS_YB = WS_ACT + 358 * MiB;
constexpr size_t WS_DUMMY = WS_ACT + 424 * MiB;
constexpr size_t WS_H8 = WS_ACT + 618 * MiB;
constexpr int FFD8 = 2816;
constexpr int FFE8 = 1536;
constexpr size_t WS_END = WS_ACT + 682 * MiB;
static_assert(WS_MWD + (size_t)16 * 1024 * FFEP * 2 <= WS_H && WS_MWGU + (size_t)16 * 2 * FFEP * 1024 * 2 <= WS_MWD && WS_WD + (size_t)2 * 1024 * FFD * 2 <= WS_MWGU && WS_WGU + (size_t)2 * 2 * FFD * 1024 * 2 <= WS_WD, "weights map");
static_assert(WS_HID + (size_t)PSLOT * FFEP * 2 <= WS_YB && WS_YB + (size_t)PSLOT * 1024 * 2 <= WS_END && WS_HID + (size_t)NTOK * FFD * 2 <= WS_END && WS_KNV + (size_t)NTOK * NKV * 2 <= WS_END && WS_Q + (size_t)NTOK * NQ * 2 <= WS_KNV, "activation map");
static_assert(WS_SSQ + (size_t)14 * NTOK * 8 <= WS_COS && WS_COS <= CTL_ZERO_BYTES + WS_COS && WS_END <= 1024 * MiB, "map");
constexpr int CW_TMO = 0, CW_CODE = 1, CW_CNT = 1024  , CW_DBG = 2048, CW_BAR = 4096  ;
constexpr int RING_OFF = 0, RING_BYTES = 131072, LDSCTL_OFF = RING_BYTES, MISC_OFF = LDSCTL_OFF + 320, LDS_BYTES = 147456;

typedef GAS unsigned gu32;
#define RLX_AGENT __ATOMIC_RELAXED, __HIP_MEMORY_SCOPE_AGENT
#define LDS_WAIT() asm volatile("s_waitcnt lgkmcnt(0)" ::: "memory")
#define VM_WAIT() asm volatile("s_waitcnt vmcnt(0)" ::: "memory")

#define XB_TMO      128
#define XB_XCNT(j)  (256  + 64 * (j))
#define XB_XSUB(j)  (1280 + 64 * (j))
#define XB_XGEN(j)  (2304 + 64 * (j))
#define XB_TOP      3328
#define XB_TOPGEN   3392
#define XCD_BAR_WORDS 3456
#define XB_SPIN_CAP (1u << 18)
__device__ __forceinline__ unsigned xb_ld(unsigned* p)              { return __hip_atomic_load(p, __ATOMIC_RELAXED, __HIP_MEMORY_SCOPE_AGENT); }
__device__ __forceinline__ unsigned xb_add(unsigned* p, unsigned v) { return __hip_atomic_fetch_add(p, v, __ATOMIC_RELAXED, __HIP_MEMORY_SCOPE_AGENT); }
__device__ __forceinline__ unsigned xb_xcc_id() { return (unsigned)__builtin_amdgcn_s_getreg((3 << 11) | 20) & 0xFu; }
#define XB_SPIN(cond, bar) do { unsigned _sp = 0; while (cond) { __builtin_amdgcn_s_sleep(1); \
    if ((++_sp & 255u) == 0u) { if (xb_ld(&(bar)[XB_TMO])) break; if (_sp > XB_SPIN_CAP) { atomicAdd(&(bar)[XB_TMO], 1u); break; } } } } while (0)
__device__ __forceinline__ unsigned rfl(unsigned v);
struct XcdBarrier { unsigned* bar; unsigned x; volatile LAS unsigned* st; };
__device__ __forceinline__ XcdBarrier xcd_barrier_post(unsigned* bar, volatile LAS unsigned* st) {
    XcdBarrier b; b.bar = bar; b.x = xb_xcc_id(); b.st = st;
    if (threadIdx.x == 0) (void)xb_add(&bar[XB_XCNT(b.x)], 1u);
    return b;
}
__device__ __forceinline__ void xcd_barrier_complete(unsigned* bar, unsigned x, unsigned& nloc, unsigned& nx) {
    const unsigned G = gridDim.x * gridDim.y * gridDim.z;
    unsigned sum, cnt, mine, sp = 0u;
    for (;;) {
        sum = 0u; cnt = 0u; mine = 0u;
#pragma unroll
        for (unsigned j = 0; j < 16; ++j) { const unsigned c = xb_ld(&bar[XB_XCNT(j)]); sum += c; cnt += (c > 0u) ? 1u : 0u; mine = (j == x) ? c : mine; }
        if (sum == G) break;
        __builtin_amdgcn_s_sleep(1);
        if ((++sp & 255u) == 0u) { if (xb_ld(&bar[XB_TMO])) break; if (sp > XB_SPIN_CAP) { atomicAdd(&bar[XB_TMO], 1u); break; } }
    }
    nloc = mine > 0u ? mine : 1u; nx = cnt > 0u ? cnt : 1u;
}
__device__ __forceinline__ void xcd_barrier(const XcdBarrier& b) {
    unsigned* bar; { const volatile LAS unsigned* p_ = b.st + 2; const unsigned lo_ = rfl(p_[0]), hi_ = rfl(p_[1]); bar = (unsigned*)(((unsigned long long)hi_ << 32) | lo_); }
    asm volatile("s_waitcnt vmcnt(0)" ::: "memory");
    __syncthreads();
    if (threadIdx.x == 0) {
        __builtin_amdgcn_s_waitcnt(0);
        unsigned nloc = b.st[0], nx = b.st[1];
        if (nloc == 0u) { xcd_barrier_complete(bar, b.x, nloc, nx); b.st[0] = nloc; b.st[1] = nx; }
        const unsigned old = xb_add(&bar[XB_XSUB(b.x)], 1u);
        const unsigned gen = old / nloc;
        if (old + 1u == (gen + 1u) * nloc) {
            __builtin_amdgcn_fence(__ATOMIC_RELEASE, "agent");
            asm volatile("s_waitcnt vmcnt(0)" ::: "memory");
            const unsigned og = xb_add(&bar[XB_TOP], 1u);
            const unsigned tg = og / nx;
            if (og + 1u == (tg + 1u) * nx) xb_add(&bar[XB_TOPGEN], 1u);
            else XB_SPIN(xb_ld(&bar[XB_TOPGEN]) == tg, bar);
            __builtin_amdgcn_fence(__ATOMIC_ACQUIRE, "agent");
            xb_add(&bar[XB_XGEN(b.x)], 1u);
            asm volatile("s_waitcnt vmcnt(0)" ::: "memory");
        } else {
            XB_SPIN(xb_ld(&bar[XB_XGEN(b.x)]) == gen, bar);
            __builtin_amdgcn_fence(__ATOMIC_ACQUIRE, "agent");
            asm volatile("s_waitcnt vmcnt(0)" ::: "memory");
        }
    }
    __syncthreads();
}

constexpr int PT_OFF_ = LDSCTL_OFF + 512;
__device__ __forceinline__ unsigned rfl(unsigned v);
__device__ __forceinline__ const float* ptab(LAS unsigned char* L, int i);
struct Frame { LAS unsigned char* lds; volatile LAS unsigned* MISC; gu32* ctl; unsigned char* ws; int tid, lane, wave, vcu, G; };

__device__ __forceinline__ float wave_sum(float v) {
#pragma unroll
    for (int o = 1; o < 64; o <<= 1) v += __shfl_xor(v, o);
    return v;
}
__device__ __forceinline__ unsigned rfl(unsigned v) { return (unsigned)__builtin_amdgcn_readfirstlane((int)v); }

__device__ __forceinline__ int rowmap(int mode, int n) {
    if (mode == 0) return n;
    if (mode == 1) return (n >> 7) * 256 + (n & 127);
    if (mode == 2) return (n >> 7) * 256 + 128 + (n & 127);
    if (mode == 4) return n < 800 ? n : 896 + (n - 800);
    const int h = n / DQH, d = n - h * DQH;
    if (d < DNOPE) return 512 + h * DNOPE + d;
    if (d < DNOPE + 32) return (h >> 2) * 256 + (h & 3) * 32 + (d - DNOPE);
    return (h >> 2) * 256 + 128 + (h & 3) * 32 + (d - DNOPE - 32);
}
__device__ __forceinline__ void transpose_item(const float* W, int N, bf16_t* WT, int ldd, int mode, const float* kscale, const float* nscale, int item, int lane) {
    const int nblk = N / 64, kb = item / nblk, nb = item % nblk, k0 = 64 * kb, n = 64 * nb + lane;
    const float sn = nscale ? nscale[n] : 1.0f;
    const int ksv = __float_as_int(kscale ? kscale[k0 + lane] : 1.0f);
    const float* wp = W + (size_t)k0 * N + n;
    bf16_t* op = WT + (size_t)rowmap(mode, n) * ldd + k0;
#pragma unroll
    for (int kg = 0; kg < 8; ++kg) { float v[8];
#pragma unroll
        for (int i = 0; i < 8; ++i) { const float sk = __int_as_float(__builtin_amdgcn_readlane(ksv, 8 * kg + i)); v[i] = wp[(size_t)(8 * kg + i) * N] * (sk * sn); }
        u32x4 o; o.x = cvt_pk_bf16(v[0], v[1]); o.y = cvt_pk_bf16(v[2], v[3]); o.z = cvt_pk_bf16(v[4], v[5]); o.w = cvt_pk_bf16(v[6], v[7]);
        *(GAS u32x4*)(op + 8 * kg) = o; }
}
__device__ __forceinline__ void transpose_item_f8(const float* W, int N, unsigned char* WT, int ldd, int mode, const float* kscale, int item, int lane) {
    const int nblk = N / 64, kb = item / nblk, nb = item % nblk, k0 = 64 * kb, n = 64 * nb + lane;
    const int ksv = __float_as_int(kscale ? kscale[k0 + lane] : 1.0f);
    const float* wp = W + (size_t)k0 * N + n;
    unsigned char* op = WT + (size_t)rowmap(mode, n) * ldd + k0;
#pragma unroll
    for (int kg = 0; kg < 4; ++kg) { float v[16];
#pragma unroll
        for (int i = 0; i < 16; ++i) { const float sk = __int_as_float(__builtin_amdgcn_readlane(ksv, 16 * kg + i)); v[i] = wp[(size_t)(16 * kg + i) * N] * (sk * pg8::FP8_SW); }
        u32x4 o; o.x = pg8::pk4_fp8(v[0], v[1], v[2], v[3]); o.y = pg8::pk4_fp8(v[4], v[5], v[6], v[7]); o.z = pg8::pk4_fp8(v[8], v[9], v[10], v[11]); o.w = pg8::pk4_fp8(v[12], v[13], v[14], v[15]);
        *(GAS u32x4*)(op + 16 * kg) = o; }
}
struct MatDesc { const float* src; bf16_t* dst; const float* kscale; const float* nscale; int K, N, ldd, mode, f8; };
constexpr int N_MATS = 70;
__device__ __forceinline__ MatDesc mat_desc(int m, LAS unsigned char* L, unsigned char* ws) {
    MatDesc d; d.kscale = nullptr; d.nscale = nullptr; d.mode = 0; d.f8 = 0;
    if (m < 2)       { const int a = m;      d.src = ptab(L, 4) + (size_t)a * DM * NDOWN;    d.K = DM;   d.N = NDOWN; d.dst = (bf16_t*)(ws + WS_WDN) + (size_t)a * NDOWNP * DM;  d.ldd = DM; d.mode = 4; d.kscale = ptab(L, 2) + (size_t)(2 * a) * DM; }
    else if (m < 4)  { const int a = m - 2;  d.src = ptab(L, 6) + (size_t)a * QLR * NQ;      d.K = QLR;  d.N = NQ;    d.dst = (bf16_t*)(ws + WS_WUQ) + (size_t)a * NQ * QLR;     d.ldd = QLR; d.mode = 3; d.kscale = ptab(L, 5) + (size_t)a * QLR; }
    else if (m < 6)  { const int a = m - 4;  d.src = ptab(L, 8) + (size_t)a * KVLR * NKV;    d.K = KVLR; d.N = NKV;   d.dst = (bf16_t*)(ws + WS_WUKV) + (size_t)a * NKV * KVLR;  d.ldd = KVLR; d.kscale = ptab(L, 7) + (size_t)a * KVLR; }
    else if (m < 8)  { const int a = m - 6;  d.src = ptab(L, 9) + (size_t)a * DM * DM;       d.K = DM;   d.N = DM;    d.dst = (bf16_t*)(ws + WS_WO) + (size_t)a * DM * DM;       d.ldd = DM; }
    else if (m < 16) { const int i = m - 8;  d.src = ptab(L, 10) + (size_t)i * 256 * 256;    d.K = 256;  d.N = 256;   d.dst = (bf16_t*)(ws + WS_WPOOL) + (size_t)i * 256 * 256;  d.ldd = 256; d.nscale = ptab(L, 11) + i * 256; }
    else if (m < 18) { const int a = m - 16; d.src = ptab(L, 12) + (size_t)a * DM * FFD;     d.K = DM;   d.N = FFD;   d.dst = (bf16_t*)(ws + WS_WGU) + (size_t)a * 2 * FFD * DM; d.ldd = DM; d.mode = 1; d.kscale = ptab(L, 3) + (size_t)(2 * a) * DM; }
    else if (m < 20) { const int a = m - 18; d.src = ptab(L, 13) + (size_t)a * DM * FFD;     d.K = DM;   d.N = FFD;   d.dst = (bf16_t*)(ws + WS_WGU) + (size_t)a * 2 * FFD * DM; d.ldd = DM; d.mode = 2; d.kscale = ptab(L, 3) + (size_t)(2 * a) * DM; }
    else if (m < 22) { const int a = m - 20; d.src = ptab(L, 14) + (size_t)a * FFD * DM;     d.K = FFD;  d.N = DM;    d.dst = (bf16_t*)(ws + WS_WD) + (size_t)a * DM * FFD;      d.ldd = FFD; }
    else if (m < 38) { const int i = m - 22; d.src = ptab(L, 16) + (size_t)i * DM * FFE;     d.K = DM;   d.N = FFE;   d.dst = (bf16_t*)(ws + WS_MWGU) + (size_t)i * 2 * FFEP * DM; d.ldd = DM; d.mode = 1; d.kscale = ptab(L, 3) + (size_t)(2 * (i >> 3) + 1) * DM; }
    else if (m < 54) { const int i = m - 38; d.src = ptab(L, 17) + (size_t)i * DM * FFE;     d.K = DM;   d.N = FFE;   d.dst = (bf16_t*)(ws + WS_MWGU) + (size_t)i * 2 * FFEP * DM; d.ldd = DM; d.mode = 2; d.kscale = ptab(L, 3) + (size_t)(2 * (i >> 3) + 1) * DM; }
    else             { const int i = m - 54; d.src = ptab(L, 18) + (size_t)i * FFE * DM;     d.K = FFE;  d.N = DM;    d.dst = (bf16_t*)(ws + WS_MWD) + (size_t)i * DM * FFEP;    d.ldd = FFEP; }
    if (m == 17 || m == 19) { d.f8 = 1; d.dst = (bf16_t*)(ws + WS_WGU + (size_t)2 * FFD * DM * 2); d.ldd = DM; }
    if (m == 21) { d.f8 = 1; d.dst = (bf16_t*)(ws + WS_WD + (size_t)DM * FFD * 2); d.ldd = FFD8; }
    if (m >= 22 && ((m - 22) & 15) >= 8) {
        const int e = (m - 22) & 7; d.f8 = 1;
        if (m < 54) { d.dst = (bf16_t*)(ws + WS_MWGU + (size_t)8 * 2 * FFEP * DM * 2 + (size_t)e * 2 * FFEP * DM); d.ldd = DM; }
        else        { d.dst = (bf16_t*)(ws + WS_MWD + (size_t)8 * DM * FFEP * 2 + (size_t)e * DM * FFE8); d.ldd = FFE8; } }
    return d;
}
__device__ __forceinline__ void p0_prologue(Frame& F) {
    const int* positions = (const int*)ptab(F.lds, 1);
    const int gw = F.vcu * NWAVES + F.wave, NGW = F.G * NWAVES;
    int cum = 0;
    for (int m = 0; m < N_MATS; ++m) {
        const MatDesc d = mat_desc(m, F.lds, F.ws);
        const int nitems = (d.K / 64) * (d.N / 64);
        int first = gw - (cum % NGW); if (first < 0) first += NGW;
        if (d.f8) { for (int it = first; it < nitems; it += NGW) transpose_item_f8(d.src, d.N, (unsigned char*)d.dst, d.ldd, d.mode, d.kscale, it, F.lane); }
        else { for (int it = first; it < nitems; it += NGW) transpose_item(d.src, d.N, d.dst, d.ldd, d.mode, d.kscale, d.nscale, it, F.lane); }
        cum += nitems;
    }
    const int gt = gw * 64 + F.lane, NGT = NGW * 64; const u32x4 z4 = (u32x4){0u, 0u, 0u, 0u};
    for (int i = gt; i < 2 * 192 * 128; i += NGT) { const int a = i / (192 * 128), r = (i / 128) % 192, c = i % 128; const int row = r < 96 ? 800 + r : 928 + (r - 96); *(GAS u32x4*)((bf16_t*)(F.ws + WS_WDN) + (size_t)a * NDOWNP * DM + (size_t)row * DM + c * 8) = z4; }
    for (int i = gt; i < 8 * 128 * 128; i += NGT) { const int e = i / (128 * 128), r = (i / 128) % 128, c = i % 128; const int row = 2560 + (r < 64 ? 64 + r : 192 + (r - 64));
        *(GAS u32x4*)((bf16_t*)(F.ws + WS_MWGU) + (size_t)e * 2 * FFEP * DM + (size_t)row * DM + c * 8) = z4; }
    for (int i = gt; i < 8 * 1024 * 8; i += NGT) { const int row = i / 8, c = i % 8; *(GAS u32x4*)((bf16_t*)(F.ws + WS_MWD) + (size_t)row * FFEP + FFE + c * 8) = z4; }
    for (int i = gt; i < 1024 * 8; i += NGT) { const int row = i / 8, c = i % 8; *(GAS u32x4*)(F.ws + WS_WD + (size_t)DM * FFD * 2 + (size_t)row * FFD8 + FFD + c * 16) = z4; }
    for (int i = gt; i < 8 * 128 * 64; i += NGT) { const int e = i / (128 * 64), r = (i / 64) % 128, c = i % 64; const int row = 2560 + (r < 64 ? 64 + r : 192 + (r - 64));
        *(GAS u32x4*)(F.ws + WS_MWGU + (size_t)8 * 2 * FFEP * DM * 2 + (size_t)e * 2 * FFEP * DM + (size_t)row * DM + c * 16) = z4; }
    for (int i = gt; i < 8 * 1024 * 12; i += NGT) { const int row = i / 12, c = i % 12; *(GAS u32x4*)(F.ws + WS_MWD + (size_t)8 * DM * FFEP * 2 + (size_t)row * FFE8 + FFE + c * 16) = z4; }
    float* cosT = (float*)(F.ws + WS_COS); float* sinT = (float*)(F.ws + WS_SIN);
    for (int i = gt; i < NTOK * 32; i += NGT) { const int row = i >> 5, k = i & 31; const float inv = powf(10000.0f, -(float)(2 * k) / 64.0f); const float ang = (float)positions[row] * inv;
        cosT[i] = cosf(ang); sinT[i] = sinf(ang); }
    const float* x = ptab(F.lds, 0); bf16_t* H = (bf16_t*)(F.ws + WS_H); ssq_t* ssq0 = (ssq_t*)(F.ws + WS_SSQ);
    for (int m0 = gw * 4; m0 < NTOK; m0 += NGW * 4) {
        f32x4 v[4][4];
#pragma unroll
        for (int r = 0; r < 4; ++r) { const GAS f32x4* xr = (const GAS f32x4*)(x + (size_t)(m0 + r) * DM) + F.lane;
#pragma unroll
            for (int j = 0; j < 4; ++j) v[r][j] = xr[64 * j]; }
#pragma unroll
        for (int r = 0; r < 4; ++r) { GAS u32x2* o8 = (GAS u32x2*)(H + (size_t)(m0 + r) * DM) + F.lane; float s = 0.f;
#pragma unroll
            for (int j = 0; j < 4; ++j) { const f32x4 t = v[r][j]; s += (t.x * t.x + t.y * t.y) + (t.z * t.z + t.w * t.w); u32x2 w; w.x = cvt_pk_bf16(t.x, t.y); w.y = cvt_pk_bf16(t.z, t.w); o8[64 * j] = w; }
            s = wave_sum(s); if (F.lane == 0) ssq0[m0 + r] = ssq_fix(s); }
    }
}

template <bool FINAL>
__device__ __forceinline__ void combine_phase(Frame& F, const bf16_t* H, bf16_t* Hout, const bf16_t* YB, const unsigned* tokinfo, const unsigned* cntw, ssq_t* ssq_next, const float* gain, float* outF) {
    const int gw = F.vcu * NWAVES + F.wave, NGW = F.G * NWAVES;
    f32x4 g[4];
    if constexpr (FINAL) {
#pragma unroll
        for (int j = 0; j < 4; ++j) g[j] = *(const f32x4*)(gain + F.lane * 4 + 256 * j);
    }
    unsigned nb[8];
#pragma unroll
    for (int e = 0; e < 8; ++e) nb[e] = (rfl(__hip_atomic_load((unsigned*)cntw + 64 * e, RLX_AGENT)) + 255u) >> 8;
    for (int m0 = gw * 2; m0 < NTOK; m0 += NGW * 2) {
        u32x4 t0[2], t1[2];
#pragma unroll
        for (int r = 0; r < 2; ++r) { t0[r] = *(const u32x4*)(tokinfo + (size_t)(m0 + r) * 8); t1[r] = *(const u32x4*)(tokinfo + (size_t)(m0 + r) * 8 + 4); }
        u32x2 hh[2][4], ya[2][4], yb[2][4]; float g0[2], g1[2];
#pragma unroll
        for (int r = 0; r < 2; ++r) {
            const unsigned e0 = rfl(t0[r].x), r0 = rfl(t0[r].y), e1 = rfl(t1[r].x), r1 = rfl(t1[r].y); g0[r] = __uint_as_float(rfl(t0[r].z)); g1[r] = __uint_as_float(rfl(t1[r].z));
            unsigned b0 = 0u, b1 = 0u;
#pragma unroll
            for (int e = 0; e < 8; ++e) { b0 += ((unsigned)e < e0) ? nb[e] : 0u; b1 += ((unsigned)e < e1) ? nb[e] : 0u; }
            const GAS u32x2* hr = (const GAS u32x2*)(H + (size_t)(m0 + r) * DM) + F.lane;
            const GAS u32x2* y0 = (const GAS u32x2*)(YB + ((size_t)b0 * 256 + r0) * DM) + F.lane; const GAS u32x2* y1 = (const GAS u32x2*)(YB + ((size_t)b1 * 256 + r1) * DM) + F.lane;
#pragma unroll
            for (int j = 0; j < 4; ++j) { hh[r][j] = hr[64 * j]; ya[r][j] = y0[64 * j]; yb[r][j] = y1[64 * j]; }
        }
#pragma unroll
        for (int r = 0; r < 2; ++r) { const int m = m0 + r;
            f32x4 v[4]; float s = 0.f;
#pragma unroll
            for (int j = 0; j < 4; ++j) { const u32x2 h2 = hh[r][j], a = ya[r][j], b = yb[r][j];
                v[j].x = bflo(h2.x) + g0[r] * bflo(a.x) + g1[r] * bflo(b.x); v[j].y = bfhi(h2.x) + g0[r] * bfhi(a.x) + g1[r] * bfhi(b.x); v[j].z = bflo(h2.y) + g0[r] * bflo(a.y) + g1[r] * bflo(b.y); v[j].w = bfhi(h2.y) + g0[r] * bfhi(a.y) + g1[r] * bfhi(b.y);
                s += (v[j].x * v[j].x + v[j].y * v[j].y) + (v[j].z * v[j].z + v[j].w * v[j].w); }
            s = wave_sum(s);
            if constexpr (FINAL) { const float rstd = rstd_f(s); GAS f32x4* ho = (GAS f32x4*)(outF + (size_t)m * DM) + F.lane;
#pragma unroll
                for (int j = 0; j < 4; ++j) ho[64 * j] = v[j] * rstd * g[j];
            } else { GAS u32x2* hw = (GAS u32x2*)(Hout + (size_t)m * DM) + F.lane;
#pragma unroll
                for (int j = 0; j < 4; ++j) { u32x2 w; w.x = cvt_pk_bf16(v[j].x, v[j].y); w.y = cvt_pk_bf16(v[j].z, v[j].w); hw[64 * j] = w; }
                if (F.lane == 0) ssq_next[m] = ssq_fix(s); }
        }
    }
}
__device__ __forceinline__ void mid_phase(Frame& F, const bf16_t* DOWN, const float* qn, const float* kvn, const float* cosT, const float* sinT, bf16_t* CQN, bf16_t* CKVN, bf16_t* KR) {
    const int gw = F.vcu * NWAVES + F.wave, NGW = F.G * NWAVES, lane = F.lane;
    const f32x4 q0 = *(const f32x4*)(qn + lane * 8), q1 = *(const f32x4*)(qn + lane * 8 + 4), k0 = *(const f32x4*)(kvn + lane * 4);
    for (int m = gw; m < NTOK; m += NGW) {
        const bf16_t* dr = DOWN + (size_t)m * NDOWNP;
        const u32x4 cq = *(const GAS u32x4*)(dr + lane * 8); const u32x2 ck = *(const GAS u32x2*)(dr + QLR + lane * 4);
        const float x1 = bf2f(dr[QLR + KVLR + (lane & 31)]), x2 = bf2f(dr[QLR + KVLR + 32 + (lane & 31)]);
        const f32x4 a0 = (f32x4){bflo(cq.x), bfhi(cq.x), bflo(cq.y), bfhi(cq.y)}, a1 = (f32x4){bflo(cq.z), bfhi(cq.z), bflo(cq.w), bfhi(cq.w)}, c0 = (f32x4){bflo(ck.x), bfhi(ck.x), bflo(ck.y), bfhi(ck.y)};
        const float sq = wave_sum((a0.x * a0.x + a0.y * a0.y) + (a0.z * a0.z + a0.w * a0.w) + (a1.x * a1.x + a1.y * a1.y) + (a1.z * a1.z + a1.w * a1.w));
        const float sk = wave_sum((c0.x * c0.x + c0.y * c0.y) + (c0.z * c0.z + c0.w * c0.w));
        const float rq = 1.0f / sqrtf(sq * (1.0f / QLR) + RMS_EPS), rk = 1.0f / sqrtf(sk * (1.0f / KVLR) + RMS_EPS);
        const f32x4 y0 = a0 * rq * q0, y1 = a1 * rq * q1, z0 = c0 * rk * k0;
        u32x4 w; w.x = cvt_pk_bf16(y0.x, y0.y); w.y = cvt_pk_bf16(y0.z, y0.w); w.z = cvt_pk_bf16(y1.x, y1.y); w.w = cvt_pk_bf16(y1.z, y1.w);
        *(GAS u32x4*)(CQN + (size_t)m * QLR + lane * 8) = w;
        u32x2 w2; w2.x = cvt_pk_bf16(z0.x, z0.y); w2.y = cvt_pk_bf16(z0.z, z0.w);
        *(GAS u32x2*)(CKVN + (size_t)m * KVLR + lane * 4) = w2;
        const float c = cosT[(size_t)m * 32 + (lane & 31)], s = sinT[(size_t)m * 32 + (lane & 31)];
        const float o = lane < 32 ? x1 * c - x2 * s : x2 * c + x1 * s;
        KR[(size_t)m * DROPE + lane] = (bf16_t)(cvt_pk_bf16(o, o) & 0xffffu);
    }
}
template <int W>
__device__ __forceinline__ void pool_walk(const bf16_t* h, const ssq_t* ssq, const f32x2 g2, bf16_t* Z, size_t rowbase, int t_start, int c0, int nrows, int col) {
    f32x2 ring[W]; f32x2 sum = (f32x2){0.f, 0.f};
#pragma unroll
    for (int j = 0; j < W; ++j) ring[j] = (f32x2){0.f, 0.f};
    for (int r = 0; r < nrows; r += 16) {
        unsigned xw[16]; ssq_t q[16];
#pragma unroll
        for (int j = 0; j < 16; ++j) { const size_t row = rowbase + t_start + r + j; xw[j] = *(const GAS unsigned*)(h + row * DM + col); q[j] = ssq[row]; }
#pragma unroll
        for (int j = 0; j < 16; ++j) {
            const int t = t_start + r + j; const size_t row = rowbase + t;
            const f32x2 v = (f32x2){bflo(xw[j]), bfhi(xw[j])} * rstd_of(q[j]) * g2;
            sum = sum + (v - ring[j % W]); ring[j % W] = v;
            if (t >= c0) { const float inv = 1.0f / (float)(t + 1 < W ? t + 1 : W); const f32x2 z = sum * inv - v; *(GAS unsigned*)(Z + row * DM + col) = cvt_pk_bf16(z.x, z.y); }
        }
    }
}
__device__ __forceinline__ void pool_phase(Frame& F, const bf16_t* h, const ssq_t* ssq, const float* gain, bf16_t* Z) {
    const int col = F.tid * 2; const f32x2 g2 = *(const f32x2*)(gain + col);
    for (int chunk = F.vcu; chunk < NBATCH * 16; chunk += F.G) {
        const int b = chunk >> 4, c0 = (chunk & 15) * 128, t_start = c0 ? c0 - 16 : 0, nrows = c0 + 128 - t_start; const size_t rowbase = (size_t)b * SEQ;
        const int grp = F.wave >> 1;
        if (grp == 0) pool_walk<2>(h, ssq, g2, Z, rowbase, t_start, c0, nrows, col);
        else if (grp == 1) pool_walk<4>(h, ssq, g2, Z, rowbase, t_start, c0, nrows, col);
        else if (grp == 2) pool_walk<8>(h, ssq, g2, Z, rowbase, t_start, c0, nrows, col);
        else pool_walk<16>(h, ssq, g2, Z, rowbase, t_start, c0, nrows, col);
    }
}
template <bool WRITE_H8>
__device__ __forceinline__ void router_phase(Frame& F, const bf16_t* h, const ssq_t* ssq, const float* gain, const float* router, int* list, float* rsl, unsigned* tokinfo, unsigned* cntw, unsigned char* H8) {
    LAS float* rt = (LAS float*)(F.lds + RING_OFF);
    LAS int* esel = (LAS int*)(F.lds + RING_OFF + 32768);
    LAS int* wt = (LAS int*)(F.lds + RING_OFF + 32768 + 2048);
    LAS int* base = (LAS int*)(F.lds + RING_OFF + 32768 + 2048 + 256);
    LAS float* rsd = (LAS float*)(F.lds + RING_OFF + 32768 + 2048 + 512);
    const int lane = F.lane;
    for (int idx = F.tid; idx < DM * NEXP; idx += NWAVES * 64) rt[(idx & 7) * DM + (idx >> 3)] = router[idx];
    f32x4 g[4];
#pragma unroll
    for (int j = 0; j < 4; ++j) g[j] = *(const f32x4*)(gain + lane * 4 + 256 * j);
    for (int chunk = F.vcu; chunk < NTOK / 256; chunk += F.G) {
        const int T0 = chunk * 256;
        __syncthreads();
        u32x2 nx[4]; ssq_t nq;
        { const GAS u32x2* xr = (const GAS u32x2*)(h + (size_t)(T0 + F.wave * 32) * DM) + lane;
#pragma unroll
          for (int j = 0; j < 4; ++j) nx[j] = xr[64 * j];
          nq = ssq[T0 + F.wave * 32]; }
        for (int i = 0; i < 32; ++i) {
            const int tl = F.wave * 32 + i, m = T0 + tl;
            u32x2 cw[4];
#pragma unroll
            for (int j = 0; j < 4; ++j) cw[j] = nx[j];
            const float rstd = rstd_of(nq);
            if (i + 1 < 32) { const GAS u32x2* xr = (const GAS u32x2*)(h + (size_t)(m + 1) * DM) + lane;
#pragma unroll
                for (int j = 0; j < 4; ++j) nx[j] = xr[64 * j];
                nq = ssq[m + 1]; }
            f32x4 v[4];
#pragma unroll
            for (int j = 0; j < 4; ++j) { const u32x2 w = cw[j]; f32x4 xn = (f32x4){bflo(w.x), bfhi(w.x), bflo(w.y), bfhi(w.y)} * rstd;
                if constexpr (WRITE_H8) { const f32x4 q = xn * pg8::FP8_SA; *(GAS unsigned*)(H8 + (size_t)m * DM + lane * 4 + 256 * j) = pg8::pk4_fp8(q.x, q.y, q.z, q.w); }
                v[j] = xn * g[j]; }
            float lg[8];
#pragma unroll
            for (int e = 0; e < 8; ++e) { float p = 0.f;
#pragma unroll
                for (int j = 0; j < 4; ++j) { const f32x4 r4 = *(const LAS f32x4*)(rt + e * DM + lane * 4 + 256 * j); p += (v[j].x * r4.x + v[j].y * r4.y) + (v[j].z * r4.z + v[j].w * r4.w); }
                lg[e] = wave_sum(p); }
            int e0 = 0; float l0 = lg[0];
#pragma unroll
            for (int e = 1; e < 8; ++e) if (lg[e] > l0) { l0 = lg[e]; e0 = e; }
            int e1 = e0 == 0 ? 1 : 0; float l1 = lg[e0 == 0 ? 1 : 0];
#pragma unroll
            for (int e = 0; e < 8; ++e) if (e != e0 && lg[e] > l1) { l1 = lg[e]; e1 = e; }
            const float g0 = 1.0f / (1.0f + __expf(l1 - l0)), g1 = 1.0f - g0;
            if (lane == 0) { esel[2 * tl] = e0; esel[2 * tl + 1] = e1; rsd[tl] = rstd; unsigned* ti = tokinfo + (size_t)m * 8;
                ti[0] = (unsigned)e0; ti[2] = __float_as_uint(g0); ti[4] = (unsigned)e1; ti[6] = __float_as_uint(g1); }
        }
        __syncthreads();
        const int me = esel[F.tid]; int myrank = 0;
#pragma unroll
        for (int e = 0; e < 8; ++e) { const unsigned long long mask = __ballot(me == e); if (me == e) myrank = __popcll(mask & ((1ull << lane) - 1ull)); if (lane == 0) wt[F.wave * 8 + e] = __popcll(mask); }
        __syncthreads();
        int off = 0;
        for (int w = 0; w < F.wave; ++w) off += wt[w * 8 + me];
        if (F.tid < 8) { int tot = 0; for (int w = 0; w < 8; ++w) tot += wt[w * 8 + F.tid]; base[F.tid] = (int)__hip_atomic_fetch_add(cntw + 64 * F.tid, (unsigned)tot, RLX_AGENT); }
        __syncthreads();
        const int rank = base[me] + off + myrank, tok = T0 + (F.tid >> 1);
        list[(size_t)me * NTOK + rank] = tok; rsl[(size_t)me * NTOK + rank] = rsd[F.tid >> 1];
        tokinfo[(size_t)tok * 8 + (F.tid & 1) * 4 + 1] = (unsigned)rank;
    }
}
template <bool GATHER, bool FP8 = false>
struct MoeOrder {
    static constexpr size_t A_BLK = GATHER ? 0 : (FP8 ? (size_t)256 * FFE8 : (size_t)256 * FFEP * 2), B_EXP = GATHER ? (FP8 ? (size_t)2 * FFEP * DM : (size_t)2 * FFEP * DM * 2) : (FP8 ? (size_t)DM * FFE8 : (size_t)DM * FFEP * 2),
                            B_TILE = GATHER ? (FP8 ? (size_t)256 * DM : (size_t)256 * DM * 2) : (FP8 ? (size_t)256 * FFE8 : (size_t)256 * FFEP * 2);
    static constexpr int NT = GATHER ? 2 * FFEP / 256 : DM / 256;
    const char* A; const char* B; const int* list; const unsigned* cntw; int G, c; unsigned bs[9];
    __device__ __forceinline__ void init(const unsigned* cntw_, const void* A_, const void* B_, const int* list_, int G_, int c_) {
        A = (const char*)A_; B = (const char*)B_; list = list_; cntw = cntw_; G = G_; c = c_; bs[0] = 0u;
#pragma unroll
        for (int e = 0; e < 8; ++e) { const unsigned ce = rfl(__hip_atomic_load((unsigned*)cntw + 64 * e, RLX_AGENT)); bs[e + 1] = bs[e] + ((ce + 255u) >> 8); }
    }
    __device__ __forceinline__ bool next(int i, pg8::Unit& u) const {
        const long L = (long)i * G + c; if (L >= (long)bs[8] * NT) return false;
        const unsigned blk = (unsigned)(L / NT); const int pn = (int)(L % NT);
        unsigned e = 0u, st = 0u;
#pragma unroll
        for (int k = 1; k < 8; ++k) if (blk >= bs[k]) { e = (unsigned)k; st = bs[k]; }
        const unsigned j = blk - st;
        u.b = B + (size_t)e * B_EXP + (size_t)pn * B_TILE; u.orow = (int)(blk * 256u); u.pn = pn; u.aux = (int)e;
        if constexpr (GATHER) { const unsigned ce = rfl(__hip_atomic_load((unsigned*)cntw + 64 * e, RLX_AGENT));
            u.a = A; u.rows = list + (size_t)e * NTOK + (size_t)j * 256; const unsigned rem = ce - j * 256u; u.nrows = rem < 256u ? (int)rem : 256; }
        else { u.a = A + (size_t)blk * A_BLK; u.rows = nullptr; u.nrows = 256; }
        return true;
    }
};
constexpr int NPHASE = 27;
struct Args { const float* in[20]; float* out; unsigned char* ws; int ph_lo, ph_hi, li, pad; };
#ifndef MK_REP_MASK
#define MK_REP_MASK 0
#endif
#ifndef MK_REP_N
#define MK_REP_N 1
#endif
constexpr int PT_OFF = LDSCTL_OFF + 512;
__device__ __forceinline__ unsigned long long ptab_u64(LAS unsigned char* L, int i) {
    const volatile LAS unsigned* p = (const volatile LAS unsigned*)(L + PT_OFF + 8 * i); const unsigned lo = rfl(p[0]), hi = rfl(p[1]); return ((unsigned long long)hi << 32) | lo; }
__device__ __forceinline__ const float* ptab(LAS unsigned char* L, int i) { return (const float*)ptab_u64(L, i); }
__device__ __forceinline__ Frame make_frame(LAS unsigned char* L) {
    Frame F; F.lds = L; F.MISC = (volatile LAS unsigned*)(L + MISC_OFF); F.tid = launder_v((int)threadIdx.x); F.lane = F.tid & 63; F.wave = __builtin_amdgcn_readfirstlane(F.tid >> 6);
    F.G = gridDim.x; { const int bx = blockIdx.x; F.vcu = (F.G % 8 == 0) ? (bx % 8) * (F.G / 8) + bx / 8 : bx; }
    F.ws = (unsigned char*)ptab_u64(L, 21); F.ctl = (gu32*)(F.ws + WS_CTL); return F;
}
__global__ void __launch_bounds__(NWAVES * 64, 2) fwd(Args args) {
    extern __shared__ __attribute__((aligned(16))) unsigned char lds[];
    LAS unsigned char* L = (LAS unsigned char*)lds;
    { const int tid = threadIdx.x;
      for (int u = tid; u < (LDS_BYTES - LDSCTL_OFF) / 4; u += NWAVES * 64) ((LAS unsigned*)(L + LDSCTL_OFF))[u] = 0u;
      __syncthreads();
      if (tid < 20) *(LAS unsigned long long*)(L + PT_OFF + 8 * tid) = (unsigned long long)args.in[tid];
      if (tid == 20) *(LAS unsigned long long*)(L + PT_OFF + 8 * 20) = (unsigned long long)args.out;
      if (tid == 21) *(LAS unsigned long long*)(L + PT_OFF + 8 * 21) = (unsigned long long)args.ws;
      if (tid == 22) *(LAS unsigned long long*)(L + PT_OFF + 8 * 22) = (unsigned long long)args.pad;
      __syncthreads(); }
    const int lo = args.ph_lo, hi = args.ph_hi;
    XcdBarrier bar; { gu32* ctl = (gu32*)(args.ws + WS_CTL); bar.bar = (unsigned*)(ctl + CW_BAR) + args.li * XCD_BAR_WORDS; bar.x = 0; bar.st = nullptr;
      if (threadIdx.x == 0) { const unsigned long long ba = (unsigned long long)((unsigned*)(ctl + CW_BAR) + args.li * XCD_BAR_WORDS); ((volatile LAS unsigned*)(L + MISC_OFF))[10] = (unsigned)ba; ((volatile LAS unsigned*)(L + MISC_OFF))[11] = (unsigned)(ba >> 32); }
      if (hi - lo > 1) bar = xcd_barrier_post((unsigned*)(ctl + CW_BAR) + args.li * XCD_BAR_WORDS, (volatile LAS unsigned*)(L + MISC_OFF) + 8);
      __syncthreads(); }
#ifndef MK_ONLY
#define MK_ONLY (-1)
#endif
#define KIND(k) ((k) == 0 ? 0 : 1 + ((k) - 1) % 13)
#ifndef MK_SKIPMASK
#define MK_SKIPMASK 0
#endif
#define IN(k) ((MK_ONLY < 0 || KIND(k) == MK_ONLY) && !((MK_SKIPMASK >> KIND(k)) & 1) && lo <= (k) && (k) < hi)
#define FORREP(k)
#if MK_REP_MASK
#define LASTREP (ptab_u64(L, 22) == 0ull)
#else
#define LASTREP true
#endif
#ifdef MK_DOUBLE_BAR
#define SEAM(k) do { if ((k) + 1 < hi) { xcd_barrier(bar); xcd_barrier(bar); } } while (0)
#else
#define SEAM(k) do { if ((k) + 1 < hi) xcd_barrier(bar); } while (0)
#endif
#define WSP(off) ((bf16_t*)(F.ws + (off)))
#define SSQ(i) ((ssq_t*)(F.ws + WS_SSQ) + (size_t)(i) * NTOK)
    LAS unsigned char* ring = L + RING_OFF;

    if (IN(0)) FORREP(0) { Frame F = make_frame(L); p0_prologue(F); SEAM(0); }

    for (int lp = 0; lp < 2; ++lp) {
        const int pb = 1 + 13 * lp;
        if (IN(pb + 0)) FORREP(pb + 0) { Frame F = make_frame(L);
            pg8::RegOrder S; S.init(WSP(WS_H), DM * 2, WSP(WS_WDN) + (size_t)lp * NDOWNP * DM, DM * 2, NTOK, NDOWNP, F.G, (int)blockIdx.x);
            pg8::EpiDown E{WSP(WS_DOWN), WSP(WS_KR), SSQ(4 * lp + 0), LASTREP ? SSQ(10 + 2 * lp) : SSQ(9), LASTREP ? SSQ(11 + 2 * lp) : SSQ(9), (const float*)(F.ws + WS_COS), (const float*)(F.ws + WS_SIN)};
            pg8::gemm_phase<pg8::EpiDown, pg8::RegOrder, false>(ring, DM * 2, DM * 2, DM * 2, S, E);
            SEAM(pb + 0);
        }
        if (IN(pb + 1)) FORREP(pb + 1) { Frame F = make_frame(L);
            pg8::RegOrder S; S.init(WSP(WS_DOWN), NDOWNP * 2, WSP(WS_WUQ) + (size_t)lp * NQ * QLR, QLR * 2, NTOK, NQ, F.G, (int)blockIdx.x);
            pg8::EpiQ E{WSP(WS_Q), (const float*)(F.ws + WS_COS), (const float*)(F.ws + WS_SIN), SSQ(10 + 2 * lp)};
            pg8::gemm_phase<pg8::EpiQ, pg8::RegOrder, false>(ring, NDOWNP * 2, QLR * 2, QLR * 2, S, E);
            SEAM(pb + 1);
        }
        if (IN(pb + 2)) FORREP(pb + 2) { Frame F = make_frame(L);
            pg8::RegOrder S; S.init(WSP(WS_DOWN) + QLR, NDOWNP * 2, WSP(WS_WUKV) + (size_t)lp * NKV * KVLR, KVLR * 2, NTOK, NKV, F.G, (int)blockIdx.x);
            pg8::EpiBf16<2> E{WSP(WS_KNV), NKV, SSQ(11 + 2 * lp)};
            pg8::gemm_phase<pg8::EpiBf16<2>, pg8::RegOrder, false>(ring, NDOWNP * 2, KVLR * 2, KVLR * 2, S, E);
            SEAM(pb + 2);
        }
        if (IN(pb + 3)) FORREP(pb + 3) { Frame F = make_frame(L); att::attn_phase((char*)lds + RING_OFF, WSP(WS_Q), WSP(WS_KNV), WSP(WS_KR), WSP(WS_DOWN), F.vcu, F.G); SEAM(pb + 3); }
        if (IN(pb + 4) && lp == 0) FORREP(pb + 4) { Frame F = make_frame(L);
            pg8::RegOrder S; S.init(WSP(WS_DOWN), DM * 2, WSP(WS_WO) + (size_t)lp * DM * DM, DM * 2, NTOK, DM, F.G, (int)blockIdx.x);
            pg8::EpiResidH<false> E{WSP(WS_H), LASTREP ? WSP(WS_H) : WSP(WS_DUMMY), LASTREP ? SSQ(4 * lp + 1) : SSQ(9), nullptr, 1.0f};
            pg8::gemm_phase<pg8::EpiResidH<false>, pg8::RegOrder, false>(ring, DM * 2, DM * 2, DM * 2, S, E);
            SEAM(pb + 4);
        }
        if (IN(pb + 4) && lp == 1) FORREP(pb + 4) { Frame F = make_frame(L);
            pg8::RegOrder S; S.init(WSP(WS_DOWN), DM * 2, WSP(WS_WO) + (size_t)lp * DM * DM, DM * 2, NTOK, DM, F.G, (int)blockIdx.x);
            pg8::EpiResidH<true> E{WSP(WS_H), LASTREP ? WSP(WS_H) : WSP(WS_DUMMY), LASTREP ? SSQ(4 * lp + 1) : SSQ(9), F.ws + WS_H8, 1.0f};
            pg8::gemm_phase<pg8::EpiResidH<true>, pg8::RegOrder, false>(ring, DM * 2, DM * 2, DM * 2, S, E);
            SEAM(pb + 4);
        }
        if (IN(pb + 5) && lp == 0) FORREP(pb + 5) { Frame F = make_frame(L);
            pg8::RegOrder S; S.init(WSP(WS_H), DM * 2, WSP(WS_WGU) + (size_t)lp * 2 * FFD * DM, DM * 2, NTOK, 2 * FFD, F.G, (int)blockIdx.x);
            pg8::EpiSwiglu<1> E{WSP(WS_HID), FFD, SSQ(4 * lp + 1), nullptr};
            pg8::gemm_phase<pg8::EpiSwiglu<1>, pg8::RegOrder, false>(ring, DM * 2, DM * 2, DM * 2, S, E);
            SEAM(pb + 5);
        }
        if (IN(pb + 5) && lp == 1) FORREP(pb + 5) { Frame F = make_frame(L);
            pg8::RegOrder S; S.init(F.ws + WS_H8, DM, F.ws + WS_WGU + (size_t)2 * FFD * DM * 2, DM, NTOK, 2 * FFD, F.G, (int)blockIdx.x);
            pg8::EpiSwigluF8<1> E{F.ws + WS_HID, FFD8, 2 * FFD / 256 - 1, SSQ(4 * lp + 1)};
            pg8::gemm_phase<pg8::EpiSwigluF8<1>, pg8::RegOrder, false, true>(ring, DM, DM, DM, S, E);
            SEAM(pb + 5);
        }
        if (IN(pb + 6) && lp == 0) FORREP(pb + 6) { Frame F = make_frame(L);
            pg8::RegOrder S; S.init(WSP(WS_HID), FFD * 2, WSP(WS_WD) + (size_t)lp * DM * FFD, FFD * 2, NTOK, DM, F.G, (int)blockIdx.x);
            pg8::EpiResidH<false> E{WSP(WS_H), LASTREP ? WSP(WS_H) : WSP(WS_DUMMY), LASTREP ? SSQ(4 * lp + 2) : SSQ(9), nullptr, 1.0f};
            pg8::gemm_phase<pg8::EpiResidH<false>, pg8::RegOrder, false>(ring, FFD * 2, FFD * 2, FFD * 2, S, E);
            SEAM(pb + 6);
        }
        if (IN(pb + 6) && lp == 1) FORREP(pb + 6) { Frame F = make_frame(L);
            pg8::RegOrder S; S.init(F.ws + WS_HID, FFD8, F.ws + WS_WD + (size_t)DM * FFD * 2, FFD8, NTOK, DM, F.G, (int)blockIdx.x);
            pg8::EpiResidH<false> E{WSP(WS_H), LASTREP ? WSP(WS_H) : WSP(WS_DUMMY), LASTREP ? SSQ(4 * lp + 2) : SSQ(9), nullptr, 1.0f / (pg8::FP8_SH * pg8::FP8_SW)};
            pg8::gemm_phase<pg8::EpiResidH<false>, pg8::RegOrder, false, true>(ring, FFD8, FFD8, FFD8, S, E);
            SEAM(pb + 6);
        }
        if (IN(pb + 7)) FORREP(pb + 7) { Frame F = make_frame(L); pool_phase(F, WSP(WS_H), SSQ(4 * lp + 2), ptab(L, 2) + (size_t)(2 * lp + 1) * DM, WSP(WS_DOWN)); SEAM(pb + 7); }
        if (IN(pb + 8)) FORREP(pb + 8) { Frame F = make_frame(L);
            pg8::RegOrder S; S.init(WSP(WS_DOWN), DM * 2, WSP(WS_WPOOL) + (size_t)lp * 4 * 256 * 256, 256 * 2, NTOK, DM, F.G, (int)blockIdx.x, 256 * 2);
            pg8::EpiResidH<false> E{WSP(WS_H), LASTREP ? WSP(WS_H) : WSP(WS_DUMMY), LASTREP ? SSQ(4 * lp + 3) : SSQ(9), nullptr, 1.0f};
            pg8::gemm_phase<pg8::EpiResidH<false>, pg8::RegOrder, false>(ring, DM * 2, 256 * 2, 256 * 2, S, E);
            SEAM(pb + 8);
        }
        if (IN(pb + 9)) FORREP(pb + 9) { Frame F = make_frame(L);
            if (lp == 0) router_phase<false>(F, WSP(WS_H), SSQ(4 * lp + 3), ptab(L, 3) + (size_t)(2 * lp + 1) * DM, ptab(L, 15) + (size_t)lp * DM * NEXP, (int*)(F.ws + WS_LIST), (float*)(F.ws + WS_RSL), (unsigned*)(F.ws + WS_TOKINFO), (unsigned*)(F.ctl + CW_CNT) + (LASTREP ? lp : 2 + lp) * 8 * 64, nullptr);
            else router_phase<true>(F, WSP(WS_H), SSQ(4 * lp + 3), ptab(L, 3) + (size_t)(2 * lp + 1) * DM, ptab(L, 15) + (size_t)lp * DM * NEXP, (int*)(F.ws + WS_LIST), (float*)(F.ws + WS_RSL), (unsigned*)(F.ws + WS_TOKINFO), (unsigned*)(F.ctl + CW_CNT) + (LASTREP ? lp : 2 + lp) * 8 * 64, F.ws + WS_H8);
            SEAM(pb + 9); }
#ifndef TEST_NO_BF16MOE
        if (IN(pb + 10) && lp == 0) FORREP(pb + 10) { Frame F = make_frame(L);
            MoeOrder<true> S; S.init((unsigned*)(F.ctl + CW_CNT) + lp * 8 * 64, WSP(WS_H), WSP(WS_MWGU), (const int*)(F.ws + WS_LIST), F.G, (int)blockIdx.x);
            pg8::EpiSwiglu<2> E{WSP(WS_HID), FFEP, (const float*)(F.ws + WS_RSL), (const int*)(F.ws + WS_LIST)};
            pg8::gemm_phase<pg8::EpiSwiglu<2>, MoeOrder<true>, true>(ring, DM * 2, DM * 2, DM * 2, S, E);
            SEAM(pb + 10);
        }
#endif
#ifndef TEST_NO_F8MOE
        if (IN(pb + 10) && lp == 1) FORREP(pb + 10) { Frame F = make_frame(L);
            MoeOrder<true, true> S; S.init((unsigned*)(F.ctl + CW_CNT) + lp * 8 * 64, F.ws + WS_H8, F.ws + WS_MWGU + (size_t)8 * 2 * FFEP * DM * 2, (const int*)(F.ws + WS_LIST), F.G, (int)blockIdx.x);
            pg8::EpiSwigluF8<0> E{F.ws + WS_HID, FFE8, 2 * FFEP / 256 - 1, nullptr};
            pg8::gemm_phase<pg8::EpiSwigluF8<0>, MoeOrder<true, true>, true, true>(ring, DM, DM, DM, S, E);
            SEAM(pb + 10);
        }
#endif
#ifndef TEST_NO_BF16MOE
        if (IN(pb + 11) && lp == 0) FORREP(pb + 11) { Frame F = make_frame(L);
            MoeOrder<false> S; S.init((unsigned*)(F.ctl + CW_CNT) + lp * 8 * 64, WSP(WS_HID), WSP(WS_MWD), (const int*)(F.ws + WS_LIST), F.G, (int)blockIdx.x);
            pg8::EpiBf16<0> E{WSP(WS_YB), DM, nullptr};
            pg8::gemm_phase<pg8::EpiBf16<0>, MoeOrder<false>, false>(ring, FFEP * 2, FFEP * 2, FFEP * 2, S, E);
            SEAM(pb + 11);
        }
#endif
#ifndef TEST_NO_F8MOE
        if (IN(pb + 11) && lp == 1) FORREP(pb + 11) { Frame F = make_frame(L);
            MoeOrder<false, true> S; S.init((unsigned*)(F.ctl + CW_CNT) + lp * 8 * 64, F.ws + WS_HID, F.ws + WS_MWD + (size_t)8 * DM * FFEP * 2, (const int*)(F.ws + WS_LIST), F.G, (int)blockIdx.x);
            pg8::EpiBf16Scaled E{WSP(WS_YB), DM, 1.0f / (pg8::FP8_SH * pg8::FP8_SW)};
            pg8::gemm_phase<pg8::EpiBf16Scaled, MoeOrder<false, true>, false, true>(ring, FFE8, FFE8, FFE8, S, E);
            SEAM(pb + 11);
        }
#endif
        if (IN(pb + 12)) FORREP(pb + 12) { Frame F = make_frame(L);
            if (lp == 0) combine_phase<false>(F, WSP(WS_H), LASTREP ? WSP(WS_H) : WSP(WS_DUMMY), WSP(WS_YB), (const unsigned*)(F.ws + WS_TOKINFO), (unsigned*)(F.ctl + CW_CNT), LASTREP ? SSQ(4) : SSQ(9), nullptr, nullptr);
            else combine_phase<true>(F, WSP(WS_H), nullptr, WSP(WS_YB), (const unsigned*)(F.ws + WS_TOKINFO), (unsigned*)(F.ctl + CW_CNT) + 8 * 64, nullptr, ptab(L, 19), (float*)ptab(L, 20));
            SEAM(pb + 12);
        }
    }
#undef IN
#undef SEAM
#undef WSP
#undef SSQ
}

#ifndef MK_PER_PHASE
#define MK_PER_PHASE 0
#endif
extern "C" void kernel_launch(void* const* d_in, const int* in_sizes, int n_in, void* d_out, int out_size, void* d_ws, size_t ws_size, hipStream_t stream) {
    static int grid = 0;
    if (grid == 0) {
        if (n_in != 20 || in_sizes[0] != NTOK * DM || out_size != NTOK * DM || ws_size < WS_END) { fprintf(stderr, "kernel_launch: unexpected shapes (n_in %d, in0 %d, out %d, ws %zu < %zu)\n", n_in, n_in > 0 ? in_sizes[0] : -1, out_size, ws_size, (size_t)WS_END); grid = -1; return; }
        int dev = 0, cus = 0, per_cu = 0;
        if (hipGetDevice(&dev) != hipSuccess || hipDeviceGetAttribute(&cus, hipDeviceAttributeMultiprocessorCount, dev) != hipSuccess) { grid = -1; return; }
        if (hipFuncSetAttribute((const void*)fwd, hipFuncAttributeMaxDynamicSharedMemorySize, LDS_BYTES) != hipSuccess) { fprintf(stderr, "kernel_launch: hipFuncSetAttribute failed\n"); grid = -1; return; }
        if (hipOccupancyMaxActiveBlocksPerMultiprocessor(&per_cu, (const void*)fwd, NWAVES * 64, LDS_BYTES) != hipSuccess || per_cu < 1) fprintf(stderr, "kernel_launch: occupancy query reports %d\n", per_cu);
        (void)hipGetLastError();
        grid = cus;
    }
    if (grid < 0) return;
    if (hipMemsetAsync((char*)d_ws + WS_CTL, 0, CTL_ZERO_BYTES, stream) != hipSuccess) return;
    Args a{};
    for (int i = 0; i < 20; ++i) a.in[i] = (const float*)d_in[i];
    a.out = (float*)d_out; a.ws = (unsigned char*)d_ws;
#if MK_PER_PHASE
    for (int p = 0; p < NPHASE; ++p) { a.ph_lo = p; a.ph_hi = p + 1; a.li = 0; hipLaunchKernelGGL(fwd, dim3(grid), dim3(NWAVES * 64), LDS_BYTES, stream, a); }
#elif MK_REP_MASK
    { int cur = 0, li = 0;
      for (int k = 0; k < NPHASE; ++k) if ((MK_REP_MASK >> (k == 0 ? 0 : 1 + (k - 1) % 13)) & 1) {
          if (k > cur) { a.ph_lo = cur; a.ph_hi = k; a.li = li++; a.pad = 0; hipLaunchKernelGGL(fwd, dim3(grid), dim3(NWAVES * 64), LDS_BYTES, stream, a); }
          for (int r = 1; r < MK_REP_N; ++r) { a.ph_lo = k; a.ph_hi = k + 1; a.li = li++; a.pad = 1; hipLaunchKernelGGL(fwd, dim3(grid), dim3(NWAVES * 64), LDS_BYTES, stream, a); }
          cur = k; }
      a.ph_lo = cur; a.ph_hi = NPHASE; a.li = li++; a.pad = 0; hipLaunchKernelGGL(fwd, dim3(grid), dim3(NWAVES * 64), LDS_BYTES, stream, a); }
#elif defined(MK_TWICE)
    a.ph_lo = 0; a.ph_hi = NPHASE; a.li = 0;
    hipLaunchKernelGGL(fwd, dim3(grid), dim3(NWAVES * 64), LDS_BYTES, stream, a);
    (void)hipMemsetAsync((char*)d_ws + WS_CTL, 0, CTL_ZERO_BYTES, stream);
    hipLaunchKernelGGL(fwd, dim3(grid), dim3(NWAVES * 64), LDS_BYTES, stream, a);
#else
    a.ph_lo = 0; a.ph_hi = NPHASE; a.li = 0;
    hipLaunchKernelGGL(fwd, dim3(grid), dim3(NWAVES * 64), LDS_BYTES, stream, a);
#endif
}
```

```cpp
#include <hip/hip_runtime.h>
#include <cstdio>
#include <cstdint>

#define GAS __attribute__((address_space(1)))
#define LAS __attribute__((address_space(3)))
typedef unsigned short bf16_t;
typedef short bf16x8 __attribute__((ext_vector_type(8)));
typedef short s16x4 __attribute__((ext_vector_type(4)));
typedef float f32x2 __attribute__((ext_vector_type(2)));
typedef float f32x4 __attribute__((ext_vector_type(4)));
typedef float f32x16 __attribute__((ext_vector_type(16)));
typedef unsigned u32x2 __attribute__((ext_vector_type(2)));
typedef unsigned u32x4 __attribute__((ext_vector_type(4)));

constexpr int DM = 1024, NBATCH = 32, SEQ = 2048, NTOK = NBATCH * SEQ;
constexpr int NHEAD = 8, DNOPE = 128, DROPE = 64, DVH = 128, DQH = DNOPE + DROPE, QLR = 512, KVLR = 256;
constexpr int NDOWN = QLR + KVLR + DROPE  , NDOWNP = 1024;
constexpr int NQ = NHEAD * DQH  , NKV = NHEAD * (DNOPE + DVH)  ;
constexpr int FFD = 2688, NEXP = 8, FFE = 1344, FFEP = 1408;
constexpr int PSLOT = (NTOK * 2 / 256 + NEXP) * 256;
constexpr float RMS_EPS = 1e-6f;

__device__ __forceinline__ unsigned cvt_pk_bf16(float lo, float hi) { unsigned r; asm volatile("v_cvt_pk_bf16_f32 %0, %1, %2" : "=v"(r) : "v"(lo), "v"(hi)); return r; }
__device__ __forceinline__ int launder_v(int v) { asm volatile("" : "+v"(v)); return v; }
__device__ __forceinline__ float fp8_rt(float x, float s) { const int p = __builtin_amdgcn_cvt_pk_fp8_f32(x * s, 0.f, 0, false); return __builtin_amdgcn_cvt_f32_fp8(p, 0) * (1.0f / s); }
__device__ __forceinline__ float bf2f(unsigned short b) { return __uint_as_float((unsigned)b << 16); }
__device__ __forceinline__ float bflo(unsigned w) { return __uint_as_float(w << 16); }
__device__ __forceinline__ float bfhi(unsigned w) { return __uint_as_float(w & 0xffff0000u); }

typedef unsigned long long ssq_t;
__device__ __forceinline__ ssq_t ssq_fix(float s) { return (ssq_t)(s * 16777216.0f); }
__device__ __forceinline__ float rstd_n(ssq_t q, float invn) { return __builtin_amdgcn_rsqf(((float)(unsigned)(q >> 32) * 4294967296.0f + (float)(unsigned)q) * (1.0f / 16777216.0f) * invn + RMS_EPS); }
__device__ __forceinline__ float rstd_of(ssq_t q) { return rstd_n(q, 1.0f / DM); }
__device__ __forceinline__ float rstd_f(float ssq) { return __builtin_amdgcn_rsqf(ssq * (1.0f / DM) + RMS_EPS); }

namespace pg8 {
constexpr int BM = 256, BK = 64, HALF = 128, HTB = HALF * BK * 2  , STAGE_BYTES = 8 * HTB, NXCD = 8, WGM = 8;
__host__ __device__ __forceinline__ int lds_byte(int r, int c) { const int st = (r >> 4) * 2 + (c >> 5), rr = r & 15, cc = c & 31, ob = rr * 64 + cc * 2; return st * 1024 + (ob ^ (((ob >> 9) & 1) << 5)); }
__host__ __device__ __forceinline__ void stage_rc(int b, int& R, int& C) { const int st = b / 1024, sb = b % 1024, swz = sb ^ (((sb >> 9) & 1) << 5); R = (st >> 1) * 16 + swz / 64; C = (st & 1) * 32 + (swz % 64) / 2; }
__host__ __device__ __forceinline__ int perm32(int rho) { const int n = rho >> 4, i = rho & 15; return 8 * (i >> 2) + 4 * n + (i & 3); }

struct Unit { const char* a; const char* b; const int* rows; int nrows; int orow; int pn; int aux; };

struct RegOrder {
    const char* A; const char* B; unsigned a_tile, b_tile, a_colstep; int nM, nN, nwg, G, c, rev;
    __device__ __forceinline__ void init(const void* A_, size_t lda_b, const void* B_, size_t ldb_b, int M, int N, int G_, int c_, size_t a_colstep_ = 0) {
        A = (const char*)A_; B = (const char*)B_; a_tile = (unsigned)(256 * lda_b); b_tile = (unsigned)(256 * ldb_b); a_colstep = (unsigned)a_colstep_; nM = M / BM; nN = N / BM; nwg = nM * nN; G = G_; c = c_; rev = 0; }
    __device__ __forceinline__ bool next(int i, Unit& u) const {
        long L = (long)i * G + c; if (L >= nwg) return false;
        if (rev) L = nwg - 1 - L;
        int wgid = (int)L; { const int q = nwg / NXCD, r = nwg % NXCD, xcd = wgid % NXCD, off = wgid / NXCD; wgid = (xcd < r ? xcd * (q + 1) : r * (q + 1) + (xcd - r) * q) + off; }
        const int nig = WGM * nN, gid = wgid / nig, fm = gid * WGM, gsz = (nM - fm) < WGM ? (nM - fm) : WGM;
        const int pm = fm + ((wgid % nig) % gsz), pn = (wgid % nig) / gsz;
        u.a = A + (size_t)pm * a_tile + (size_t)pn * a_colstep; u.b = B + (size_t)pn * b_tile; u.rows = nullptr; u.nrows = 256; u.orow = pm * BM; u.pn = pn; u.aux = 0; return true;
    }
};

template <int RS> struct EpiBf16 {
    static constexpr bool PERM = true;
    bf16_t* O; int ldc; const ssq_t* rs;
    __device__ __forceinline__ void operator()(const f32x4 (&acc)[2][2][4][2], const Unit& u, int wr, int wc, int fr, int fq) const {
        const int row0 = u.orow + wr * 64 + fr, col0 = u.pn * BM + wc * 32 + 8 * fq;
        float sc[2][4];
#pragma unroll
        for (int ai = 0; ai < 2; ++ai)
#pragma unroll
            for (int m = 0; m < 4; ++m) { const int row = row0 + ai * HALF + m * 16; sc[ai][m] = 1.0f; if constexpr (RS == 1) sc[ai][m] = rstd_of(rs[row]); if constexpr (RS == 2) sc[ai][m] = rstd_n(rs[row], 1.0f / KVLR); }
#pragma unroll
        for (int ai = 0; ai < 2; ++ai)
#pragma unroll
            for (int m = 0; m < 4; ++m) { const int row = row0 + ai * HALF + m * 16; bf16_t* rowp = O + (size_t)row * ldc + col0;
#pragma unroll
                for (int bj = 0; bj < 2; ++bj) { const f32x4 v0 = acc[ai][bj][m][0] * sc[ai][m], v1 = acc[ai][bj][m][1] * sc[ai][m];
                    u32x4 w; w.x = cvt_pk_bf16(v0[0], v0[1]); w.y = cvt_pk_bf16(v0[2], v0[3]); w.z = cvt_pk_bf16(v1[0], v1[1]); w.w = cvt_pk_bf16(v1[2], v1[3]);
                    *(u32x4*)(rowp + bj * HALF) = w; } }
    }
};
__device__ __forceinline__ float silu_mul(float g, float u) { return g * u * __builtin_amdgcn_rcpf(1.0f + __builtin_amdgcn_exp2f(-1.4426950408889634f * g)); }
template <int RS> struct EpiSwiglu {
    static constexpr bool PERM = true;
    bf16_t* H; int ldh; const void* rs; const int* list;
    __device__ __forceinline__ void operator()(const f32x4 (&acc)[2][2][4][2], const Unit& u, int wr, int wc, int fr, int fq) const {
        const int r0 = wr * 64 + fr, col0 = u.pn * HALF + wc * 32 + 8 * fq;
        const ssq_t* rsq = (const ssq_t*)rs; const float* rsp = (const float*)rs; if constexpr (RS == 2) rsp = rsp + (u.rows - list);
        float sc[2][4];
#pragma unroll
        for (int ai = 0; ai < 2; ++ai)
#pragma unroll
            for (int m = 0; m < 4; ++m) { const int r = r0 + ai * HALF + m * 16; if constexpr (RS == 1) sc[ai][m] = rstd_of(rsq[u.orow + r]); else sc[ai][m] = rsp[r]; }
#pragma unroll
        for (int ai = 0; ai < 2; ++ai)
#pragma unroll
            for (int m = 0; m < 4; ++m) { const int r = r0 + ai * HALF + m * 16; bf16_t* rowp = H + (size_t)(u.orow + r) * ldh + col0; const float s = sc[ai][m];
                const f32x4 g0 = acc[ai][0][m][0] * s, g1 = acc[ai][0][m][1] * s, u0 = acc[ai][1][m][0] * s, u1 = acc[ai][1][m][1] * s;
                u32x4 w; w.x = cvt_pk_bf16(silu_mul(g0[0], u0[0]), silu_mul(g0[1], u0[1])); w.y = cvt_pk_bf16(silu_mul(g0[2], u0[2]), silu_mul(g0[3], u0[3]));
                w.z = cvt_pk_bf16(silu_mul(g1[0], u1[0]), silu_mul(g1[1], u1[1])); w.w = cvt_pk_bf16(silu_mul(g1[2], u1[2]), silu_mul(g1[3], u1[3]));
                __builtin_nontemporal_store(w, (u32x4*)rowp); }
    }
};
constexpr float FP8_SA = 16.0f, FP8_SW = 256.0f, FP8_SH = 16.0f, FP8_SX = 8.0f;
__device__ __forceinline__ unsigned pk4_fp8(float a, float b, float c, float d) { int p = __builtin_amdgcn_cvt_pk_fp8_f32(a, b, 0, false); p = __builtin_amdgcn_cvt_pk_fp8_f32(c, d, p, true); return (unsigned)p; }
template <int RS> struct EpiSwigluF8 {
    static constexpr bool PERM = true;
    unsigned char* H8; int ldh; int pad_tile; const ssq_t* rs;
    __device__ __forceinline__ void operator()(const f32x4 (&acc)[2][2][4][2], const Unit& u, int wr, int wc, int fr, int fq) const {
        const int r0 = wr * 64 + fr, col0 = u.pn * HALF + wc * 32 + 8 * fq;
        float sc[2][4];
#pragma unroll
        for (int ai = 0; ai < 2; ++ai)
#pragma unroll
            for (int m = 0; m < 4; ++m) { if constexpr (RS == 1) sc[ai][m] = rstd_of(rs[u.orow + r0 + ai * HALF + m * 16]) * (1.0f / (FP8_SX * FP8_SW)); else sc[ai][m] = 1.0f / (FP8_SA * FP8_SW); }
#pragma unroll
        for (int ai = 0; ai < 2; ++ai)
#pragma unroll
            for (int m = 0; m < 4; ++m) { const int r = r0 + ai * HALF + m * 16; unsigned char* rowp = H8 + (size_t)(u.orow + r) * ldh + col0; const float s = sc[ai][m];
                const f32x4 g0 = acc[ai][0][m][0] * s, g1 = acc[ai][0][m][1] * s, u0 = acc[ai][1][m][0] * s, u1 = acc[ai][1][m][1] * s;
                u32x2 w; w.x = pk4_fp8(silu_mul(g0[0], u0[0]) * FP8_SH, silu_mul(g0[1], u0[1]) * FP8_SH, silu_mul(g0[2], u0[2]) * FP8_SH, silu_mul(g0[3], u0[3]) * FP8_SH);
                w.y = pk4_fp8(silu_mul(g1[0], u1[0]) * FP8_SH, silu_mul(g1[1], u1[1]) * FP8_SH, silu_mul(g1[2], u1[2]) * FP8_SH, silu_mul(g1[3], u1[3]) * FP8_SH);
                __builtin_nontemporal_store(w, (u32x2*)rowp);
                if (u.pn == pad_tile) *(u32x2*)(rowp + HALF) = (u32x2){0u, 0u}; }
    }
};
struct EpiBf16Scaled {
    static constexpr bool PERM = true;
    bf16_t* O; int ldc; float scale;
    __device__ __forceinline__ void operator()(const f32x4 (&acc)[2][2][4][2], const Unit& u, int wr, int wc, int fr, int fq) const {
        const int row0 = u.orow + wr * 64 + fr, col0 = u.pn * BM + wc * 32 + 8 * fq;
#pragma unroll
        for (int ai = 0; ai < 2; ++ai)
#pragma unroll
            for (int m = 0; m < 4; ++m) { bf16_t* rowp = O + (size_t)(row0 + ai * HALF + m * 16) * ldc + col0;
#pragma unroll
                for (int bj = 0; bj < 2; ++bj) { const f32x4 v0 = acc[ai][bj][m][0] * scale, v1 = acc[ai][bj][m][1] * scale;
                    u32x4 w; w.x = cvt_pk_bf16(v0[0], v0[1]); w.y = cvt_pk_bf16(v0[2], v0[3]); w.z = cvt_pk_bf16(v1[0], v1[1]); w.w = cvt_pk_bf16(v1[2], v1[3]);
                    *(u32x4*)(rowp + bj * HALF) = w; } }
    }
};
struct EpiNull {
    static constexpr bool PERM = true;
    float* sink;
    __device__ __forceinline__ void operator()(const f32x4 (&acc)[2][2][4][2], const Unit& u, int wr, int wc, int fr, int fq) const {
        float s = 0.f;
#pragma unroll
        for (int ai = 0; ai < 2; ++ai)
#pragma unroll
            for (int bj = 0; bj < 2; ++bj)
#pragma unroll
                for (int m = 0; m < 4; ++m)
#pragma unroll
                    for (int n = 0; n < 2; ++n) s += acc[ai][bj][m][n][0];
        if (s == 12345.678f) sink[0] = s;
    }
};
template <bool W8> struct EpiResidH {
    static constexpr bool PERM = true;
    const bf16_t* hin; bf16_t* hout; ssq_t* ssq; unsigned char* h8; float scale;
    __device__ __forceinline__ void operator()(const f32x4 (&acc)[2][2][4][2], const Unit& u, int wr, int wc, int fr, int fq) const {
        const int row0 = u.orow + wr * 64 + fr, col0 = u.pn * BM + wc * 32 + 8 * fq;
        float part[2][4];
#pragma unroll
        for (int ai = 0; ai < 2; ++ai) {
            u32x4 hv[4][2];
#pragma unroll
            for (int m = 0; m < 4; ++m)
#pragma unroll
                for (int bj = 0; bj < 2; ++bj) hv[m][bj] = *(const u32x4*)(hin + (size_t)(row0 + ai * HALF + m * 16) * DM + col0 + bj * HALF);
#pragma unroll
            for (int m = 0; m < 4; ++m) { const int row = row0 + ai * HALF + m * 16; const size_t off = (size_t)row * DM + col0; float pt = 0.f;
#pragma unroll
                for (int bj = 0; bj < 2; ++bj) { const u32x4 h4 = hv[m][bj]; const f32x4 a0 = acc[ai][bj][m][0] * scale, a1 = acc[ai][bj][m][1] * scale;
                    const float y0 = bflo(h4.x) + a0[0], y1 = bfhi(h4.x) + a0[1], y2 = bflo(h4.y) + a0[2], y3 = bfhi(h4.y) + a0[3], y4 = bflo(h4.z) + a1[0], y5 = bfhi(h4.z) + a1[1], y6 = bflo(h4.w) + a1[2], y7 = bfhi(h4.w) + a1[3];
                    pt += (y0 * y0 + y1 * y1) + (y2 * y2 + y3 * y3) + (y4 * y4 + y5 * y5) + (y6 * y6 + y7 * y7);
                    u32x4 w; w.x = cvt_pk_bf16(y0, y1); w.y = cvt_pk_bf16(y2, y3); w.z = cvt_pk_bf16(y4, y5); w.w = cvt_pk_bf16(y6, y7);
                    *(u32x4*)(hout + off + bj * HALF) = w;
                    if constexpr (W8) { u32x2 q; q.x = pk4_fp8(y0 * FP8_SX, y1 * FP8_SX, y2 * FP8_SX, y3 * FP8_SX); q.y = pk4_fp8(y4 * FP8_SX, y5 * FP8_SX, y6 * FP8_SX, y7 * FP8_SX); *(u32x2*)(h8 + off + bj * HALF) = q; } }
                pt += __shfl_xor(pt, 16); pt += __shfl_xor(pt, 32); part[ai][m] = pt; }
        }
        if (fq == 0) {
#pragma unroll
            for (int ai = 0; ai < 2; ++ai)
#pragma unroll
                for (int m = 0; m < 4; ++m) atomicAdd(ssq + row0 + ai * HALF + m * 16, ssq_fix(part[ai][m])); }
    }
};
struct EpiDown {
    static constexpr bool PERM = true;
    bf16_t* O; bf16_t* KR; const ssq_t* rs; ssq_t* ssq_q; ssq_t* ssq_kv; const float* cosT; const float* sinT;
    __device__ __forceinline__ void operator()(const f32x4 (&acc)[2][2][4][2], const Unit& u, int wr, int wc, int fr, int fq) const {
        const int row0 = u.orow + wr * 64 + fr;
        float sc[2][4];
#pragma unroll
        for (int ai = 0; ai < 2; ++ai)
#pragma unroll
            for (int m = 0; m < 4; ++m) sc[ai][m] = rstd_of(rs[row0 + ai * HALF + m * 16]);
        if (u.pn < 3) {
            ssq_t* sq = u.pn < 2 ? ssq_q : ssq_kv; const int col0 = u.pn * BM + wc * 32 + 8 * fq; float pts[2][4];
#pragma unroll
            for (int ai = 0; ai < 2; ++ai)
#pragma unroll
                for (int m = 0; m < 4; ++m) { const int row = row0 + ai * HALF + m * 16; bf16_t* rowp = O + (size_t)row * NDOWNP + col0; const float s = sc[ai][m]; float part = 0.f;
#pragma unroll
                    for (int bj = 0; bj < 2; ++bj) { const f32x4 v0 = acc[ai][bj][m][0] * s, v1 = acc[ai][bj][m][1] * s;
                        part += (v0[0] * v0[0] + v0[1] * v0[1]) + (v0[2] * v0[2] + v0[3] * v0[3]) + (v1[0] * v1[0] + v1[1] * v1[1]) + (v1[2] * v1[2] + v1[3] * v1[3]);
                        u32x4 w; w.x = cvt_pk_bf16(v0[0], v0[1]); w.y = cvt_pk_bf16(v0[2], v0[3]); w.z = cvt_pk_bf16(v1[0], v1[1]); w.w = cvt_pk_bf16(v1[2], v1[3]);
                        *(u32x4*)(rowp + bj * HALF) = w; }
                    part += __shfl_xor(part, 16); part += __shfl_xor(part, 32); pts[ai][m] = part; }
            if (fq == 0) {
#pragma unroll
                for (int ai = 0; ai < 2; ++ai)
#pragma unroll
                    for (int m = 0; m < 4; ++m) atomicAdd(sq + row0 + ai * HALF + m * 16, ssq_fix(pts[ai][m])); }
        } else if (wc == 0) {
#pragma unroll
            for (int aq = 0; aq < 4; ++aq) { const int ai = aq >> 1, mb = (aq & 1) * 2; f32x4 ct[4][2], st[4][2];
#pragma unroll
                for (int m = mb; m < mb + 2; ++m) { const size_t to = (size_t)(row0 + ai * HALF + m * 16) * 32 + 8 * fq;
                    ct[m][0] = *(const f32x4*)(cosT + to); ct[m][1] = *(const f32x4*)(cosT + to + 4); st[m][0] = *(const f32x4*)(sinT + to); st[m][1] = *(const f32x4*)(sinT + to + 4); }
#pragma unroll
                for (int m = mb; m < mb + 2; ++m) { const int row = row0 + ai * HALF + m * 16; const float s = sc[ai][m];
                    const f32x4 a0 = acc[ai][0][m][0] * s, a1 = acc[ai][0][m][1] * s, b0 = acc[ai][1][m][0] * s, b1 = acc[ai][1][m][1] * s;
                    const f32x4 x0 = a0 * ct[m][0] - b0 * st[m][0], x1 = a1 * ct[m][1] - b1 * st[m][1], y0 = b0 * ct[m][0] + a0 * st[m][0], y1 = b1 * ct[m][1] + a1 * st[m][1];
                    bf16_t* rp = KR + (size_t)row * DROPE + 8 * fq;
                    u32x4 w; w.x = cvt_pk_bf16(x0[0], x0[1]); w.y = cvt_pk_bf16(x0[2], x0[3]); w.z = cvt_pk_bf16(x1[0], x1[1]); w.w = cvt_pk_bf16(x1[2], x1[3]);
                    *(u32x4*)rp = w;
                    w.x = cvt_pk_bf16(y0[0], y0[1]); w.y = cvt_pk_bf16(y0[2], y0[3]); w.z = cvt_pk_bf16(y1[0], y1[1]); w.w = cvt_pk_bf16(y1[2], y1[3]);
                    *(u32x4*)(rp + 32) = w; } }
        }
    }
};
struct EpiQ {
    static constexpr bool PERM = true;
    bf16_t* Q; const float* cosT; const float* sinT; const ssq_t* rs;
    __device__ __forceinline__ void operator()(const f32x4 (&acc)[2][2][4][2], const Unit& u, int wr, int wc, int fr, int fq) const {
        const int row0 = u.orow + wr * 64 + fr;
        float sc[2][4];
#pragma unroll
        for (int ai = 0; ai < 2; ++ai)
#pragma unroll
            for (int m = 0; m < 4; ++m) sc[ai][m] = rstd_n(rs[row0 + ai * HALF + m * 16], 1.0f / QLR);
        if (u.pn < 2) {
            const int h = 4 * u.pn + wc;
#pragma unroll
            for (int aq = 0; aq < 4; ++aq) { const int ai = aq >> 1, mb = (aq & 1) * 2; f32x4 ct[4][2], st[4][2];
#pragma unroll
                for (int m = mb; m < mb + 2; ++m) { const size_t to = (size_t)(row0 + ai * HALF + m * 16) * 32 + 8 * fq;
                    ct[m][0] = *(const f32x4*)(cosT + to); ct[m][1] = *(const f32x4*)(cosT + to + 4); st[m][0] = *(const f32x4*)(sinT + to); st[m][1] = *(const f32x4*)(sinT + to + 4); }
#pragma unroll
                for (int m = mb; m < mb + 2; ++m) { const int row = row0 + ai * HALF + m * 16; const float s = sc[ai][m];
                    const f32x4 a0 = acc[ai][0][m][0] * s, a1 = acc[ai][0][m][1] * s, b0 = acc[ai][1][m][0] * s, b1 = acc[ai][1][m][1] * s;
                    const f32x4 x0 = a0 * ct[m][0] - b0 * st[m][0], x1 = a1 * ct[m][1] - b1 * st[m][1], y0 = b0 * ct[m][0] + a0 * st[m][0], y1 = b1 * ct[m][1] + a1 * st[m][1];
                    bf16_t* rp = Q + (size_t)row * NQ + h * DQH + DNOPE + 8 * fq;
                    u32x4 w; w.x = cvt_pk_bf16(x0[0], x0[1]); w.y = cvt_pk_bf16(x0[2], x0[3]); w.z = cvt_pk_bf16(x1[0], x1[1]); w.w = cvt_pk_bf16(x1[2], x1[3]);
                    *(u32x4*)rp = w;
                    w.x = cvt_pk_bf16(y0[0], y0[1]); w.y = cvt_pk_bf16(y0[2], y0[3]); w.z = cvt_pk_bf16(y1[0], y1[1]); w.w = cvt_pk_bf16(y1[2], y1[3]);
                    *(u32x4*)(rp + 32) = w; } }
        } else {
#pragma unroll
            for (int ai = 0; ai < 2; ++ai)
#pragma unroll
                for (int m = 0; m < 4; ++m) { const int row = row0 + ai * HALF + m * 16; const float s = sc[ai][m];
#pragma unroll
                    for (int bj = 0; bj < 2; ++bj) { const int h = 2 * (u.pn - 2) + bj; const f32x4 v0 = acc[ai][bj][m][0] * s, v1 = acc[ai][bj][m][1] * s;
                        u32x4 w; w.x = cvt_pk_bf16(v0[0], v0[1]); w.y = cvt_pk_bf16(v0[2], v0[3]); w.z = cvt_pk_bf16(v1[0], v1[1]); w.w = cvt_pk_bf16(v1[2], v1[3]);
                        *(u32x4*)(Q + (size_t)row * NQ + h * DQH + wc * 32 + 8 * fq) = w; } }
        }
    }
};

__device__ __forceinline__ unsigned gather_off(const Unit& u, int idx, unsigned lda_b, unsigned cb) { const int tok = idx < u.nrows ? u.rows[idx] : 0; return (unsigned)tok * lda_b + cb; }
__device__ __forceinline__ u32x4 gather_offs(const Unit& u, int tid, unsigned lda_b) {
    const int t2 = launder_v(tid); int R0, C0, R1, C1; stage_rc(t2 * 16, R0, C0); stage_rc(t2 * 16 + 8192, R1, C1);
    u32x4 pk; pk.x = gather_off(u, R0, lda_b, (unsigned)C0 * 2u); pk.y = gather_off(u, R1, lda_b, (unsigned)C1 * 2u); pk.z = gather_off(u, HALF + R0, lda_b, (unsigned)C0 * 2u); pk.w = gather_off(u, HALF + R1, lda_b, (unsigned)C1 * 2u);
    return pk;
}
typedef int i32x4 __attribute__((ext_vector_type(4)));
typedef int i32x8 __attribute__((ext_vector_type(8)));
template <class Epi, class Sched, bool GATHER, bool FP8 = false>
__device__ __forceinline__ void gemm_phase(LAS unsigned char* lds, const unsigned lda_b, const unsigned ldb_b, const int Kb, const Sched& S, const Epi& E, const unsigned stag_ticks = 0u) {
    if (stag_ticks) { const unsigned long long t0 = __builtin_amdgcn_s_memrealtime(), dl = (unsigned long long)((blockIdx.x >> 3) & 3u) * stag_ticks;
        while (__builtin_amdgcn_s_memrealtime() - t0 < dl) __builtin_amdgcn_s_sleep(8); }
    const int tid = launder_v((int)threadIdx.x), wid = __builtin_amdgcn_readfirstlane(tid >> 6), lane = tid & 63, wr = wid >> 2, wc = wid & 3, fr = lane & 15, fq = lane >> 4;
    int nt = Kb / (BK * 2); asm volatile("" : "+s"(nt));
    unsigned voffA[2], voffB[2];
#pragma unroll
    for (int i = 0; i < 2; ++i) { int R, C; stage_rc(tid * 16 + i * 8192, R, C); const int Rb = Epi::PERM ? ((R & ~31) + perm32(R & 31)) : R;
        voffA[i] = (unsigned)R * lda_b + (unsigned)C * 2u; voffB[i] = (unsigned)Rb * ldb_b + (unsigned)C * 2u; }
    const size_t kstep = (size_t)(BK * 2);
    const size_t hstepA = (size_t)HALF * lda_b, hstepB = (size_t)HALF * ldb_b;
    const unsigned ldsw = (unsigned)wid * 1024u;
    const int aoff = lds_byte(wr * 64 + fr, fq * 8), boff = lds_byte(wc * 32 + fr, fq * 8);
    unsigned cv0[2] = {0u, 0u}, cv1[2] = {0u, 0u}, nv0[2] = {0u, 0u}, nv1[2] = {0u, 0u};
#define PG8_SA(b, h) (((b) * 2 + (h)) * HTB)
#define PG8_SB(b, h) ((4 + (b) * 2 + (h)) * HTB)
#define PG8_LOAD16(gp, ldsoff) __builtin_amdgcn_global_load_lds((const unsigned*)(gp), (LAS unsigned*)(lds + (ldsoff)), 16, 0, 0)
#define PG8_STAGE_B(bufoff, gbase, h) do { _Pragma("unroll") for (int _i = 0; _i < 2; ++_i) PG8_LOAD16((gbase) + (h) * hstepB + voffB[_i], (bufoff) + ldsw + _i * 8192); } while (0)
#define PG8_STAGE_A(bufoff, gbase, h, usenext) do { _Pragma("unroll") for (int _i = 0; _i < 2; ++_i) { unsigned _vo; \
        if constexpr (GATHER) { _vo = (usenext) ? ((h) ? nv1[_i] : nv0[_i]) : ((h) ? cv1[_i] : cv0[_i]); } else { _vo = voffA[_i] + (unsigned)((h) * hstepA); } \
        PG8_LOAD16((gbase) + _vo, (bufoff) + ldsw + _i * 8192); } } while (0)
#define PG8_LD32(off) __builtin_shufflevector(*(const LAS i32x4*)(lds + (off)), *(const LAS i32x4*)(lds + (off) + 1024), 0, 1, 2, 3, 4, 5, 6, 7)
#define PG8_LDA(dst, b, h) do { _Pragma("unroll") for (int m = 0; m < 4; ++m) { if constexpr (FP8) { dst##8[m] = PG8_LD32(PG8_SA(b, h) + aoff + m * 2048); } else { _Pragma("unroll") for (int k = 0; k < 2; ++k) dst[m][k] = *(const LAS bf16x8*)(lds + PG8_SA(b, h) + aoff + m * 2048 + k * 1024); } } } while (0)
#define PG8_LDB(dst, b, h) do { _Pragma("unroll") for (int n = 0; n < 2; ++n) { if constexpr (FP8) { dst##8[n] = PG8_LD32(PG8_SB(b, h) + boff + n * 2048); } else { _Pragma("unroll") for (int k = 0; k < 2; ++k) dst[n][k] = *(const LAS bf16x8*)(lds + PG8_SB(b, h) + boff + n * 2048 + k * 1024); } } } while (0)
#define PG8_MMA(ai, bj, At, Bt) do { __builtin_amdgcn_s_setprio(1); _Pragma("unroll") for (int m = 0; m < 4; ++m) _Pragma("unroll") for (int n = 0; n < 2; ++n) { \
        if constexpr (FP8) { asm volatile("v_mfma_f32_16x16x128_f8f6f4 %0, %1, %2, %0" : "+v"(acc[ai][bj][m][n]) : "v"(Bt##8[n]), "v"(At##8[m])); }     \
        else { _Pragma("unroll") for (int k = 0; k < 2; ++k) acc[ai][bj][m][n] = __builtin_amdgcn_mfma_f32_16x16x32_bf16(Bt[n][k], At[m][k], acc[ai][bj][m][n], 0, 0, 0); } } \
        __builtin_amdgcn_s_setprio(0); } while (0)
#define PG8_WAIT_V(n) asm volatile("s_waitcnt vmcnt(" #n ")" ::: "memory")
#define PG8_WAIT_L(n) asm volatile("s_waitcnt lgkmcnt(" #n ")" ::: "memory")
#define PG8_BAR __builtin_amdgcn_s_barrier()
#define PG8_SCHED __builtin_amdgcn_sched_barrier(0)
    Unit cur, nxt; int ui = 0;
    if (!S.next(0, cur)) return;
    f32x4 acc[2][2][4][2];
#pragma unroll
    for (int a = 0; a < 2; ++a)
#pragma unroll
        for (int b = 0; b < 2; ++b)
#pragma unroll
            for (int m = 0; m < 4; ++m)
#pragma unroll
                for (int n = 0; n < 2; ++n) acc[a][b][m][n] = (f32x4){0.f, 0.f, 0.f, 0.f};
    bf16x8 At[4][2], B0[2][2], B1[2][2]; i32x8 At8[4], B08[2], B18[2];
    const char* cA = cur.a; const char* cB = cur.b;
    if constexpr (GATHER) { const u32x4 pk = gather_offs(cur, tid, lda_b); cv0[0] = pk.x; cv0[1] = pk.y; cv1[0] = pk.z; cv1[1] = pk.w; }
    PG8_STAGE_B(PG8_SB(0, 0), cB, 0); PG8_STAGE_B(PG8_SB(0, 1), cB, 1); PG8_STAGE_A(PG8_SA(0, 0), cA, 0, false); PG8_STAGE_A(PG8_SA(0, 1), cA, 1, false);
    if (wr == 1) PG8_BAR;
    PG8_WAIT_V(2); PG8_BAR;
    PG8_STAGE_B(PG8_SB(1, 0), cB + kstep, 0); PG8_STAGE_A(PG8_SA(1, 0), cA + kstep, 0, false); PG8_STAGE_B(PG8_SB(1, 1), cB + kstep, 1);
    PG8_WAIT_V(6); PG8_BAR;
    for (;;) {
        const bool has_next = S.next(ui + 1, nxt);
        const char* nA = has_next ? nxt.a : cA; const char* nB = has_next ? nxt.b : cB;
        if constexpr (GATHER) {
            u32x4 pk = (u32x4){cv0[0], cv0[1], cv1[0], cv1[1]}; if (has_next) pk = gather_offs(nxt, tid, lda_b);
            *(LAS u32x4*)(lds + STAGE_BYTES + 1024 + tid * 16) = pk;
        }
#pragma nounroll
        for (int t = 0; t < nt; t += 2) {
            const bool last = (t == nt - 2);
            if constexpr (GATHER) { if (last) { const u32x4 pk = *(const LAS u32x4*)(lds + STAGE_BYTES + 1024 + tid * 16); nv0[0] = pk.x; nv0[1] = pk.y; nv1[0] = pk.z; nv1[1] = pk.w; } }
            const char* a1 = cA + (size_t)(t + 1) * kstep;
            const char* a2 = last ? nA : cA + (size_t)(t + 2) * kstep; const char* b2 = last ? nB : cB + (size_t)(t + 2) * kstep;
            const char* a3 = a2 + kstep; const char* b3 = b2 + kstep;
            PG8_LDB(B0, 0, 0); PG8_LDB(B1, 0, 1); PG8_SCHED; PG8_LDA(At, 0, 0); PG8_STAGE_A(PG8_SA(1, 1), a1, 1, false);
            PG8_WAIT_V(8); PG8_WAIT_L(0); PG8_BAR; PG8_MMA(0, 0, At, B0); PG8_MMA(0, 1, At, B1); PG8_BAR; PG8_SCHED;
            PG8_LDA(At, 0, 1); PG8_STAGE_B(PG8_SB(0, 0), b2, 0); PG8_STAGE_B(PG8_SB(0, 1), b2, 1); PG8_STAGE_A(PG8_SA(0, 0), a2, 0, last);
            PG8_WAIT_V(8); PG8_WAIT_L(0); PG8_BAR; PG8_MMA(1, 0, At, B0); PG8_MMA(1, 1, At, B1); PG8_BAR; PG8_SCHED;
            PG8_LDB(B0, 1, 0); PG8_LDB(B1, 1, 1); PG8_SCHED; PG8_LDA(At, 1, 0); PG8_STAGE_A(PG8_SA(0, 1), a2, 1, last);
            PG8_WAIT_V(8); PG8_WAIT_L(0); PG8_BAR; PG8_MMA(0, 0, At, B0); PG8_MMA(0, 1, At, B1); PG8_BAR; PG8_SCHED;
            PG8_LDA(At, 1, 1); PG8_STAGE_B(PG8_SB(1, 0), b3, 0); PG8_STAGE_B(PG8_SB(1, 1), b3, 1); PG8_STAGE_A(PG8_SA(1, 0), a3, 0, last);
            PG8_WAIT_V(8); PG8_WAIT_L(0); PG8_BAR; PG8_MMA(1, 0, At, B0); PG8_MMA(1, 1, At, B1); PG8_BAR; PG8_SCHED;
        }
        if (wr == 0) PG8_BAR;
        if constexpr (FP8) asm volatile("s_nop 15\n\ts_nop 15" ::: "memory");
        E(acc, cur, wr, wc, fr, fq);
        if (!has_next) break;
#pragma unroll
        for (int a = 0; a < 2; ++a)
#pragma unroll
            for (int b = 0; b < 2; ++b)
#pragma unroll
                for (int m = 0; m < 4; ++m)
#pragma unroll
                    for (int n = 0; n < 2; ++n) acc[a][b][m][n] = (f32x4){0.f, 0.f, 0.f, 0.f};
        cur = nxt; cA = nA; cB = nB; ++ui;
        if constexpr (GATHER) {
#pragma unroll
            for (int i = 0; i < 2; ++i) { cv0[i] = nv0[i]; cv1[i] = nv1[i]; }
        }
        if (wr == 1) PG8_BAR;
    }
    PG8_WAIT_V(0);
    PG8_BAR;
#undef PG8_SA
#undef PG8_SB
#undef PG8_LOAD16
#undef PG8_STAGE_A
#undef PG8_STAGE_B
#undef PG8_LDA
#undef PG8_LDB
#undef PG8_LD32
#undef PG8_MMA
#undef PG8_WAIT_V
#undef PG8_WAIT_L
#undef PG8_BAR
#undef PG8_SCHED
}
}
namespace att {
constexpr int NW = 8, QBLK = 32, KVBLK = 64, QB = NW * QBLK;
constexpr int DQK = 192, DV = 128;
constexpr int QS = NQ, KNS = NKV, KRS = DROPE, OS = DM;
constexpr int SHM_V = KVBLK * DV * 2, SHM_K = KVBLK * DQK * 2;
constexpr int LDS_QR = 2 * SHM_V + 2 * SHM_K + NW * 64 * 4;
constexpr int LDS_BYTES = LDS_QR + NW * 4096;
constexpr float SCALE = 0.07216878364870322f;
constexpr float THR = 8.f;
#define KSWZ(row, ch) ((row) * 384 + ((((ch) ^ (((row) >> 1) & 7))) << 4))
#define SBAR() __builtin_amdgcn_sched_barrier(0)
__device__ __forceinline__ int v_st(int k, int c) { const int kk = (k & ~0xC) | ((k & 4) << 1) | ((k & 8) >> 1); return ((kk >> 3) * 4 + (c >> 5)) * 512 + ((kk & 7) * 32 + (c & 31)) * 2; }
__device__ __forceinline__ int v_rd_base(int lane) { return ((lane & 3) << 3) | (((lane >> 2) & 3) << 6) | (((lane >> 4) & 1) << 5) | (((lane >> 5) & 1) << 8); }
constexpr int v_rd_off(int d0, int ks, int half) { return d0 * 512 + ks * 4096 + half * 2048; }
__device__ __forceinline__ int crow(int r, int hi) { return (r & 3) + 8 * (r >> 2) + 4 * hi; }
__device__ __forceinline__ void mask_tile(f32x16& p0, f32x16& p1, int dq) {
    const float NEG = -__builtin_inff();
#pragma unroll
    for (int r = 0; r < 16; ++r) {
        const int c = (r & 3) + 8 * (r >> 2);
        if (dq - c < 0) p0[r] = NEG;
        if (dq - c - 32 < 0) p1[r] = NEG;
    }
}
__device__ __forceinline__ void partialSM(f32x16& p0, f32x16& p1, float& m_reg, float& mn, float& alpha) {
    float pmax = p0[0]; for (int r = 1; r < 16; ++r) pmax = fmaxf(pmax, p0[r]); for (int r = 0; r < 16; ++r) pmax = fmaxf(pmax, p1[r]);
    { auto rr = __builtin_amdgcn_permlane32_swap(__float_as_uint(pmax), __float_as_uint(pmax), false, false);
      pmax = fmaxf(__uint_as_float(rr[0]), __uint_as_float(rr[1])); }
    constexpr float C2 = 1.4426950408889634f * SCALE;
    if (__builtin_expect(__all((pmax - m_reg) * SCALE <= THR), 1)) { mn = m_reg; alpha = 1.f; }
    else { mn = fmaxf(m_reg, pmax); alpha = __builtin_amdgcn_exp2f((m_reg - mn) * C2); m_reg = mn; }
    const float mnL = -mn * C2;
    for (int r = 0; r < 16; ++r) p0[r] = fmaf(p0[r], C2, mnL); for (int r = 0; r < 16; ++r) p1[r] = fmaf(p1[r], C2, mnL);
    for (int r = 0; r < 16; ++r) p0[r] = __builtin_amdgcn_exp2f(p0[r]);
}
__device__ __forceinline__ void finishSM(f32x16& p0, f32x16& p1, float alpha, float& l_reg, bf16x8& pa0, bf16x8& pa1, bf16x8& pa2, bf16x8& pa3) {
    for (int r = 0; r < 16; ++r) p1[r] = __builtin_amdgcn_exp2f(p1[r]);
    float ps = 0; for (int r = 0; r < 16; ++r) ps += p0[r]; for (int r = 0; r < 16; ++r) ps += p1[r];
    { auto rr = __builtin_amdgcn_permlane32_swap(__float_as_uint(ps), __float_as_uint(ps), false, false);
      ps = __uint_as_float(rr[0]) + __uint_as_float(rr[1]); }
    l_reg = l_reg * alpha + ps;
#define PK4(P, B_, OUT) do { unsigned a0 = cvt_pk_bf16(P[B_+0], P[B_+1]), a1 = cvt_pk_bf16(P[B_+2], P[B_+3]);                          \
        unsigned b0 = cvt_pk_bf16(P[B_+4], P[B_+5]), b1 = cvt_pk_bf16(P[B_+6], P[B_+7]);                                             \
        auto r0 = __builtin_amdgcn_permlane32_swap(a0, b0, false, false); auto r1 = __builtin_amdgcn_permlane32_swap(a1, b1, false, false); \
        u32x4 w = {r0[0], r1[0], r0[1], r1[1]}; OUT = *reinterpret_cast<bf16x8*>(&w); } while (0)
    PK4(p0, 0, pa0); PK4(p0, 8, pa1); PK4(p1, 0, pa2); PK4(p1, 8, pa3);
#undef PK4
}
template <int KB>
__device__ __forceinline__ void qkt(f32x16& p0, f32x16& p1, const char* K_lds, int r32, int hi, const bf16x8* qr, const char* qrl) {
    p0 = f32x16{}; p1 = f32x16{};
    const char* kb[4];
#pragma unroll
    for (int dd = 0; dd < 4; ++dd) kb[dd] = K_lds + KB * SHM_K + KSWZ(r32, dd * 2 + hi);
#pragma unroll
    for (int d0 = 0; d0 < 12; ++d0) { const char* a = kb[d0 & 3] + (d0 >> 2) * 128;
        bf16x8 b0 = *reinterpret_cast<const bf16x8*>(a);
        bf16x8 b1 = *reinterpret_cast<const bf16x8*>(a + 32 * 384);
        const bf16x8 qf = d0 < 8 ? qr[d0 & 7] : *reinterpret_cast<const bf16x8*>(qrl + (d0 - 8) * 1024);
        p0 = __builtin_amdgcn_mfma_f32_32x32x16_bf16(b0, qf, p0, 0, 0, 0);
        p1 = __builtin_amdgcn_mfma_f32_32x32x16_bf16(b1, qf, p1, 0, 0, 0);
        if ((d0 & 3) == 3 && d0 < 11) SBAR(); }
}
template <int VB>
__device__ __forceinline__ void pv_tile(f32x16* o, int vb0, bf16x8 pa0, bf16x8 pa1, bf16x8 pa2, bf16x8 pa3) {
#define TRRD(dst, off) asm volatile("ds_read_b64_tr_b16 %0, %1 offset:%2" : "=&v"(dst) : "v"(vb0), "i"(off) : "memory")
#define PV_D0(d0) do { s16x4 l0, l1, l2, l3, h0, h1, h2, h3; constexpr int b_ = VB * SHM_V + v_rd_off(d0, 0, 0); \
        TRRD(l0, b_); TRRD(h0, b_ + 2048); TRRD(l1, b_ + 4096); TRRD(h1, b_ + 6144); TRRD(l2, b_ + 8192); TRRD(h2, b_ + 10240); TRRD(l3, b_ + 12288); TRRD(h3, b_ + 14336); \
        asm volatile("s_waitcnt lgkmcnt(0)" ::: "memory"); SBAR();   \
        o[d0] = __builtin_amdgcn_mfma_f32_32x32x16_bf16(pa0, (bf16x8){l0[0], l0[1], l0[2], l0[3], h0[0], h0[1], h0[2], h0[3]}, o[d0], 0, 0, 0);   \
        o[d0] = __builtin_amdgcn_mfma_f32_32x32x16_bf16(pa1, (bf16x8){l1[0], l1[1], l1[2], l1[3], h1[0], h1[1], h1[2], h1[3]}, o[d0], 0, 0, 0);   \
        o[d0] = __builtin_amdgcn_mfma_f32_32x32x16_bf16(pa2, (bf16x8){l2[0], l2[1], l2[2], l2[3], h2[0], h2[1], h2[2], h2[3]}, o[d0], 0, 0, 0);   \
        o[d0] = __builtin_amdgcn_mfma_f32_32x32x16_bf16(pa3, (bf16x8){l3[0], l3[1], l3[2], l3[3], h3[0], h3[1], h3[2], h3[3]}, o[d0], 0, 0, 0); } while (0)
    PV_D0(0); PV_D0(1); PV_D0(2); PV_D0(3);
#undef PV_D0
#undef TRRD
}
struct BlockRef { const bf16_t* Q; const bf16_t* Kn; const bf16_t* Kr; const bf16_t* V; bf16_t* O; int P0; };
struct Seam { bf16x8 qr[8]; bf16x8 st_v0, st_v1, st_k0, st_k1, st_k2; };
#define VMW() asm volatile("s_waitcnt vmcnt(0)" ::: "memory")
#define VMWN(n) asm volatile("s_waitcnt vmcnt(%0)" :: "i"(n) : "memory")
#define LD8(p) (*reinterpret_cast<const bf16x8*>(p))
#define SLOAD_H(R_, k0) do { S.st_v0 = LD8((R_).V + (size_t)((k0) + sr) * KNS + sc); S.st_v1 = LD8((R_).V + (size_t)((k0) + 32 + sr) * KNS + sc);              \
                             S.st_k0 = LD8((R_).Kn + (size_t)((k0) + sr) * KNS + sc); S.st_k1 = LD8((R_).Kn + (size_t)((k0) + 32 + sr) * KNS + sc);            \
                             S.st_k2 = LD8((R_).Kr + (size_t)((k0) + rr) * KRS + rc); } while (0)
#define SWRITE_HK(bf) do { *(bf16x8*)(K_lds + (bf) * SHM_K + kws) = S.st_k0; *(bf16x8*)(K_lds + (bf) * SHM_K + kws + 32 * 384) = S.st_k1; *(bf16x8*)(K_lds + (bf) * SHM_K + kws2) = S.st_k2; } while (0)
#define SWRITE_HV(bf) do { *(bf16x8*)(V_lds + (bf) * SHM_V + vst0) = S.st_v0; *(bf16x8*)(V_lds + (bf) * SHM_V + vst1) = S.st_v1; } while (0)
#define SWRITE_H(bf) do { SWRITE_HV(bf); SWRITE_HK(bf); } while (0)
#define ATT_IDX const int tid = launder_v((int)threadIdx.x), wid = __builtin_amdgcn_readfirstlane(tid >> 6), lane = tid & 63, r32 = lane & 31, hi = lane >> 5; \
    const int sr = tid >> 4, sc = (tid & 15) * 8, rr = tid >> 3, rc = (tid & 7) * 8, kws = KSWZ(sr, (tid & 15)), kws2 = KSWZ(rr, 16 + (tid & 7));
__device__ __forceinline__ void attn_block(const BlockRef& cur, char* lds) {
    ATT_IDX;
    Seam S;
    const int NT = cur.P0 / KVBLK + QB / KVBLK;
    const int qlo = cur.P0 + wid * QBLK, qm = qlo + r32 - 4 * hi;
    char* V_lds = lds; char* K_lds = lds + 2 * SHM_V;
    float* ws = (float*)(lds + 2 * SHM_V + 2 * SHM_K) + wid * 64; float* li_l = ws, * al_l = ws + 32;
    float m_reg = -1e30f, l_reg = 0; f32x16 o[4] = {};
    const int vst0 = v_st(sr, sc), vst1 = v_st(32 + sr, sc);
    const int vb0 = (int)(uintptr_t)V_lds + v_rd_base(lane);
    char* qrl = lds + LDS_QR + wid * 4096 + lane * 16;
#define RESC(a) do { if (__any((a) < 1.f)) { if (hi == 0) al_l[r32] = (a); asm volatile("s_waitcnt lgkmcnt(0)" ::: "memory");              \
                     for (int d_ = 0; d_ < 4; ++d_) for (int r = 0; r < 16; ++r) o[d_][r] *= al_l[crow(r, hi)]; } } while (0)
#define KBASE(t) ((t) * KVBLK)
#define MASKT(P0_, P1_, t) do { const int kb_ = KBASE(t); if (kb_ + KVBLK - 1 > qlo) mask_tile(P0_, P1_, qm - kb_); } while (0)
    SLOAD_H(cur, 0);
#pragma unroll
    for (int d0 = 0; d0 < 8; ++d0) S.qr[d0] = LD8(cur.Q + (size_t)(wid * QBLK + r32) * QS + d0 * 16 + hi * 8);
    { bf16x8 t0 = LD8(cur.Q + (size_t)(wid * QBLK + r32) * QS + 128 + hi * 8), t1 = LD8(cur.Q + (size_t)(wid * QBLK + r32) * QS + 144 + hi * 8),
             t2 = LD8(cur.Q + (size_t)(wid * QBLK + r32) * QS + 160 + hi * 8), t3 = LD8(cur.Q + (size_t)(wid * QBLK + r32) * QS + 176 + hi * 8);
      *(bf16x8*)(qrl) = t0; *(bf16x8*)(qrl + 1024) = t1; *(bf16x8*)(qrl + 2048) = t2; *(bf16x8*)(qrl + 3072) = t3; }
    VMW(); SWRITE_H(0);
    __syncthreads();
    f32x16 p0, p1; float mn, al; bf16x8 pa0, pa1, pa2, pa3;
#define TILE_STEP(t, BF) do {                                                                                                 \
        if ((t) + 1 < NT) { SLOAD_H(cur, KBASE((t) + 1)); }                                                                    \
        SBAR();                                                                                                               \
        if (KBASE(t) <= qlo + QBLK - 1) {     \
        qkt<BF>(p0, p1, K_lds, r32, hi, S.qr, qrl);                                                                           \
        MASKT(p0, p1, (t)); partialSM(p0, p1, m_reg, mn, al); RESC(al);                                                        \
        finishSM(p0, p1, al, l_reg, pa0, pa1, pa2, pa3); SBAR();                                                              \
        pv_tile<BF>(o, vb0, pa0, pa1, pa2, pa3); }                                                                            \
        if ((t) + 1 < NT) { VMW(); SWRITE_H(1 - BF); }                                                                         \
        __syncthreads(); } while (0)
    for (int t = 0; t < NT; t += 2) { TILE_STEP(t, 0); TILE_STEP(t + 1, 1); }
    if (hi == 0) li_l[r32] = l_reg; asm volatile("s_waitcnt lgkmcnt(0)" ::: "memory");
    float rli[16];
#pragma unroll
    for (int r = 0; r < 16; ++r) rli[r] = __builtin_amdgcn_rcpf(li_l[crow(r, hi)]);
    bf16_t* Ow = cur.O + (size_t)(wid * QBLK) * OS;
#pragma unroll
    for (int r = 0; r < 16; ++r) { const int orow = crow(r, hi);
#pragma unroll
        for (int d0 = 0; d0 < 4; ++d0) { const float v = o[d0][r] * rli[r];
            const float vn = __shfl_xor(v, 1);
            if ((r32 & 1) == 0) *(unsigned*)(Ow + (size_t)orow * OS + d0 * 32 + r32) = cvt_pk_bf16(v, vn); } }
    __syncthreads();
#undef RESC
#undef KBASE
#undef MASKT
#undef TILE_STEP
}
#undef VMW
#undef VMWN
#undef LD8
#undef SLOAD_H
#undef SWRITE_HK
#undef SWRITE_HV
#undef SWRITE_H
#undef ATT_IDX
#undef KSWZ
#undef SBAR

__device__ __forceinline__ BlockRef make_ref(int L, int pass, const bf16_t* Qb, const bf16_t* KNVb, const bf16_t* KRb, bf16_t* Ob) {
    const int bh = L >> 2, x = L & 3, qb = pass ? 7 - x : x, b = bh >> 3, h = bh & 7; const size_t rb = (size_t)b * SEQ;
    BlockRef r; r.Q = Qb + (rb + (size_t)qb * QB) * QS + h * DQH; r.Kn = KNVb + rb * KNS + h * (DNOPE + DVH); r.Kr = KRb + rb * KRS; r.V = KNVb + rb * KNS + h * (DNOPE + DVH) + DNOPE;
    r.O = Ob + (rb + (size_t)qb * QB) * OS + h * DVH; r.P0 = qb * QB; return r;
}
__device__ __forceinline__ void attn_phase(char* lds, const bf16_t* Qb, const bf16_t* KNVb, const bf16_t* KRb, bf16_t* Ob, int first, int stride) {
    constexpr int total = NBATCH * NHEAD * 4;
    for (int L = first; L < total; L += stride) {
        for (int pass = 0; pass < 2; ++pass) { const BlockRef cur = make_ref(L, pass, Qb, KNVb, KRb, Ob); attn_block(cur, lds); }
    }
}
}
constexpr int NWAVES = 8;
constexpr size_t MiB = 1u << 20;
constexpr size_t WS_CTL = 0, CTL_ZERO_BYTES = 8 * MiB;
constexpr size_t WS_SSQ = 1 * MiB;
constexpr size_t WS_COS = 8 * MiB, WS_SIN = 16 * MiB;
constexpr size_t WS_LIST = 24 * MiB;
constexpr size_t WS_RSL = 26 * MiB;
constexpr size_t WS_TOKINFO = 28 * MiB;
constexpr size_t WS_WDN = 30 * MiB, WS_WUQ = 34 * MiB, WS_WUKV = 37 * MiB, WS_WO = 39 * MiB, WS_WPOOL = 43 * MiB, WS_WGU = 44 * MiB, WS_WD = 65 * MiB, WS_MWGU = 76 * MiB, WS_MWD = 164 * MiB;
constexpr size_t WS_H = 208 * MiB;
constexpr size_t WS_ACT = 336 * MiB;
constexpr size_t WS_DOWN = WS_ACT;
constexpr size_t WS_CQN = WS_ACT + 128 * MiB, WS_CKVN = WS_ACT + 192 * MiB, WS_KR = WS_ACT + 224 * MiB, WS_Q = WS_ACT + 232 * MiB, WS_KNV = WS_ACT + 424 * MiB;
constexpr size_t WS_HID = WS_ACT;
constexpr size_t WS_YB = WS_ACT + 358 * MiB;
constexpr size_t WS_DUMMY = WS_ACT + 424 * MiB;
constexpr size_t WS_H8 = WS_ACT + 618 * MiB;
constexpr int FFD8 = 2816;
constexpr int FFE8 = 1536;
constexpr size_t WS_END = WS_ACT + 682 * MiB;
static_assert(WS_MWD + (size_t)16 * 1024 * FFEP * 2 <= WS_H && WS_MWGU + (size_t)16 * 2 * FFEP * 1024 * 2 <= WS_MWD && WS_WD + (size_t)2 * 1024 * FFD * 2 <= WS_MWGU && WS_WGU + (size_t)2 * 2 * FFD * 1024 * 2 <= WS_WD, "weights map");
static_assert(WS_HID + (size_t)PSLOT * FFEP * 2 <= WS_YB && WS_YB + (size_t)PSLOT * 1024 * 2 <= WS_END && WS_HID + (size_t)NTOK * FFD * 2 <= WS_END && WS_KNV + (size_t)NTOK * NKV * 2 <= WS_END && WS_Q + (size_t)NTOK * NQ * 2 <= WS_KNV, "activation map");
static_assert(WS_SSQ + (size_t)14 * NTOK * 8 <= WS_COS && WS_COS <= CTL_ZERO_BYTES + WS_COS && WS_END <= 1024 * MiB, "map");
constexpr int CW_TMO = 0, CW_CODE = 1, CW_CNT = 1024  , CW_DBG = 2048, CW_BAR = 4096  ;
constexpr int RING_OFF = 0, RING_BYTES = 131072, LDSCTL_OFF = RING_BYTES, MISC_OFF = LDSCTL_OFF + 320, LDS_BYTES = 147456;

typedef GAS unsigned gu32;
#define RLX_AGENT __ATOMIC_RELAXED, __HIP_MEMORY_SCOPE_AGENT
#define LDS_WAIT() asm volatile("s_waitcnt lgkmcnt(0)" ::: "memory")
#define VM_WAIT() asm volatile("s_waitcnt vmcnt(0)" ::: "memory")

#define XB_TMO      128
#define XB_XCNT(j)  (256  + 64 * (j))
#define XB_XSUB(j)  (1280 + 64 * (j))
#define XB_XGEN(j)  (2304 + 64 * (j))
#define XB_TOP      3328
#define XB_TOPGEN   3392
#define XCD_BAR_WORDS 3456
#define XB_SPIN_CAP (1u << 18)
__device__ __forceinline__ unsigned xb_ld(unsigned* p)              { return __hip_atomic_load(p, __ATOMIC_RELAXED, __HIP_MEMORY_SCOPE_AGENT); }
__device__ __forceinline__ unsigned xb_add(unsigned* p, unsigned v) { return __hip_atomic_fetch_add(p, v, __ATOMIC_RELAXED, __HIP_MEMORY_SCOPE_AGENT); }
__device__ __forceinline__ unsigned xb_xcc_id() { return (unsigned)__builtin_amdgcn_s_getreg((3 << 11) | 20) & 0xFu; }
#define XB_SPIN(cond, bar) do { unsigned _sp = 0; while (cond) { __builtin_amdgcn_s_sleep(1); \
    if ((++_sp & 255u) == 0u) { if (xb_ld(&(bar)[XB_TMO])) break; if (_sp > XB_SPIN_CAP) { atomicAdd(&(bar)[XB_TMO], 1u); break; } } } } while (0)
__device__ __forceinline__ unsigned rfl(unsigned v);
struct XcdBarrier { unsigned* bar; unsigned x; volatile LAS unsigned* st; };
__device__ __forceinline__ XcdBarrier xcd_barrier_post(unsigned* bar, volatile LAS unsigned* st) {
    XcdBarrier b; b.bar = bar; b.x = xb_xcc_id(); b.st = st;
    if (threadIdx.x == 0) (void)xb_add(&bar[XB_XCNT(b.x)], 1u);
    return b;
}
__device__ __forceinline__ void xcd_barrier_complete(unsigned* bar, unsigned x, unsigned& nloc, unsigned& nx) {
    const unsigned G = gridDim.x * gridDim.y * gridDim.z;
    unsigned sum, cnt, mine, sp = 0u;
    for (;;) {
        sum = 0u; cnt = 0u; mine = 0u;
#pragma unroll
        for (unsigned j = 0; j < 16; ++j) { const unsigned c = xb_ld(&bar[XB_XCNT(j)]); sum += c; cnt += (c > 0u) ? 1u : 0u; mine = (j == x) ? c : mine; }
        if (sum == G) break;
        __builtin_amdgcn_s_sleep(1);
        if ((++sp & 255u) == 0u) { if (xb_ld(&bar[XB_TMO])) break; if (sp > XB_SPIN_CAP) { atomicAdd(&bar[XB_TMO], 1u); break; } }
    }
    nloc = mine > 0u ? mine : 1u; nx = cnt > 0u ? cnt : 1u;
}
__device__ __forceinline__ void xcd_barrier(const XcdBarrier& b) {
    unsigned* bar; { const volatile LAS unsigned* p_ = b.st + 2; const unsigned lo_ = rfl(p_[0]), hi_ = rfl(p_[1]); bar = (unsigned*)(((unsigned long long)hi_ << 32) | lo_); }
    asm volatile("s_waitcnt vmcnt(0)" ::: "memory");
    __syncthreads();
    if (threadIdx.x == 0) {
        __builtin_amdgcn_s_waitcnt(0);
        unsigned nloc = b.st[0], nx = b.st[1];
        if (nloc == 0u) { xcd_barrier_complete(bar, b.x, nloc, nx); b.st[0] = nloc; b.st[1] = nx; }
        const unsigned old = xb_add(&bar[XB_XSUB(b.x)], 1u);
        const unsigned gen = old / nloc;
        if (old + 1u == (gen + 1u) * nloc) {
            __builtin_amdgcn_fence(__ATOMIC_RELEASE, "agent");
            asm volatile("s_waitcnt vmcnt(0)" ::: "memory");
            const unsigned og = xb_add(&bar[XB_TOP], 1u);
            const unsigned tg = og / nx;
            if (og + 1u == (tg + 1u) * nx) xb_add(&bar[XB_TOPGEN], 1u);
            else XB_SPIN(xb_ld(&bar[XB_TOPGEN]) == tg, bar);
            __builtin_amdgcn_fence(__ATOMIC_ACQUIRE, "agent");
            xb_add(&bar[XB_XGEN(b.x)], 1u);
            asm volatile("s_waitcnt vmcnt(0)" ::: "memory");
        } else {
            XB_SPIN(xb_ld(&bar[XB_XGEN(b.x)]) == gen, bar);
            __builtin_amdgcn_fence(__ATOMIC_ACQUIRE, "agent");
            asm volatile("s_waitcnt vmcnt(0)" ::: "memory");
        }
    }
    __syncthreads();
}

constexpr int PT_OFF_ = LDSCTL_OFF + 512;
__device__ __forceinline__ unsigned rfl(unsigned v);
__device__ __forceinline__ const float* ptab(LAS unsigned char* L, int i);
struct Frame { LAS unsigned char* lds; volatile LAS unsigned* MISC; gu32* ctl; unsigned char* ws; int tid, lane, wave, vcu, G; };

__device__ __forceinline__ float wave_sum(float v) {
#pragma unroll
    for (int o = 1; o < 64; o <<= 1) v += __shfl_xor(v, o);
    return v;
}
__device__ __forceinline__ unsigned rfl(unsigned v) { return (unsigned)__builtin_amdgcn_readfirstlane((int)v); }

__device__ __forceinline__ int rowmap(int mode, int n) {
    if (mode == 0) return n;
    if (mode == 1) return (n >> 7) * 256 + (n & 127);
    if (mode == 2) return (n >> 7) * 256 + 128 + (n & 127);
    if (mode == 4) return n < 800 ? n : 896 + (n - 800);
    const int h = n / DQH, d = n - h * DQH;
    if (d < DNOPE) return 512 + h * DNOPE + d;
    if (d < DNOPE + 32) return (h >> 2) * 256 + (h & 3) * 32 + (d - DNOPE);
    return (h >> 2) * 256 + 128 + (h & 3) * 32 + (d - DNOPE - 32);
}
__device__ __forceinline__ void transpose_item(const float* W, int N, bf16_t* WT, int ldd, int mode, const float* kscale, const float* nscale, int item, int lane) {
    const int nblk = N / 64, kb = item / nblk, nb = item % nblk, k0 = 64 * kb, n = 64 * nb + lane;
    const float sn = nscale ? nscale[n] : 1.0f;
    const int ksv = __float_as_int(kscale ? kscale[k0 + lane] : 1.0f);
    const float* wp = W + (size_t)k0 * N + n;
    bf16_t* op = WT + (size_t)rowmap(mode, n) * ldd + k0;
#pragma unroll
    for (int kg = 0; kg < 8; ++kg) { float v[8];
#pragma unroll
        for (int i = 0; i < 8; ++i) { const float sk = __int_as_float(__builtin_amdgcn_readlane(ksv, 8 * kg + i)); v[i] = wp[(size_t)(8 * kg + i) * N] * (sk * sn); }
        u32x4 o; o.x = cvt_pk_bf16(v[0], v[1]); o.y = cvt_pk_bf16(v[2], v[3]); o.z = cvt_pk_bf16(v[4], v[5]); o.w = cvt_pk_bf16(v[6], v[7]);
        *(GAS u32x4*)(op + 8 * kg) = o; }
}
__device__ __forceinline__ void transpose_item_f8(const float* W, int N, unsigned char* WT, int ldd, int mode, const float* kscale, int item, int lane) {
    const int nblk = N / 64, kb = item / nblk, nb = item % nblk, k0 = 64 * kb, n = 64 * nb + lane;
    const int ksv = __float_as_int(kscale ? kscale[k0 + lane] : 1.0f);
    const float* wp = W + (size_t)k0 * N + n;
    unsigned char* op = WT + (size_t)rowmap(mode, n) * ldd + k0;
#pragma unroll
    for (int kg = 0; kg < 4; ++kg) { float v[16];
#pragma unroll
        for (int i = 0; i < 16; ++i) { const float sk = __int_as_float(__builtin_amdgcn_readlane(ksv, 16 * kg + i)); v[i] = wp[(size_t)(16 * kg + i) * N] * (sk * pg8::FP8_SW); }
        u32x4 o; o.x = pg8::pk4_fp8(v[0], v[1], v[2], v[3]); o.y = pg8::pk4_fp8(v[4], v[5], v[6], v[7]); o.z = pg8::pk4_fp8(v[8], v[9], v[10], v[11]); o.w = pg8::pk4_fp8(v[12], v[13], v[14], v[15]);
        *(GAS u32x4*)(op + 16 * kg) = o; }
}
struct MatDesc { const float* src; bf16_t* dst; const float* kscale; const float* nscale; int K, N, ldd, mode, f8; };
constexpr int N_MATS = 70;
__device__ __forceinline__ MatDesc mat_desc(int m, LAS unsigned char* L, unsigned char* ws) {
    MatDesc d; d.kscale = nullptr; d.nscale = nullptr; d.mode = 0; d.f8 = 0;
    if (m < 2)       { const int a = m;      d.src = ptab(L, 4) + (size_t)a * DM * NDOWN;    d.K = DM;   d.N = NDOWN; d.dst = (bf16_t*)(ws + WS_WDN) + (size_t)a * NDOWNP * DM;  d.ldd = DM; d.mode = 4; d.kscale = ptab(L, 2) + (size_t)(2 * a) * DM; }
    else if (m < 4)  { const int a = m - 2;  d.src = ptab(L, 6) + (size_t)a * QLR * NQ;      d.K = QLR;  d.N = NQ;    d.dst = (bf16_t*)(ws + WS_WUQ) + (size_t)a * NQ * QLR;     d.ldd = QLR; d.mode = 3; d.kscale = ptab(L, 5) + (size_t)a * QLR; }
    else if (m < 6)  { const int a = m - 4;  d.src = ptab(L, 8) + (size_t)a * KVLR * NKV;    d.K = KVLR; d.N = NKV;   d.dst = (bf16_t*)(ws + WS_WUKV) + (size_t)a * NKV * KVLR;  d.ldd = KVLR; d.kscale = ptab(L, 7) + (size_t)a * KVLR; }
    else if (m < 8)  { const int a = m - 6;  d.src = ptab(L, 9) + (size_t)a * DM * DM;       d.K = DM;   d.N = DM;    d.dst = (bf16_t*)(ws + WS_WO) + (size_t)a * DM * DM;       d.ldd = DM; }
    else if (m < 16) { const int i = m - 8;  d.src = ptab(L, 10) + (size_t)i * 256 * 256;    d.K = 256;  d.N = 256;   d.dst = (bf16_t*)(ws + WS_WPOOL) + (size_t)i * 256 * 256;  d.ldd = 256; d.nscale = ptab(L, 11) + i * 256; }
    else if (m < 18) { const int a = m - 16; d.src = ptab(L, 12) + (size_t)a * DM * FFD;     d.K = DM;   d.N = FFD;   d.dst = (bf16_t*)(ws + WS_WGU) + (size_t)a * 2 * FFD * DM; d.ldd = DM; d.mode = 1; d.kscale = ptab(L, 3) + (size_t)(2 * a) * DM; }
    else if (m < 20) { const int a = m - 18; d.src = ptab(L, 13) + (size_t)a * DM * FFD;     d.K = DM;   d.N = FFD;   d.dst = (bf16_t*)(ws + WS_WGU) + (size_t)a * 2 * FFD * DM; d.ldd = DM; d.mode = 2; d.kscale = ptab(L, 3) + (size_t)(2 * a) * DM; }
    else if (m < 22) { const int a = m - 20; d.src = ptab(L, 14) + (size_t)a * FFD * DM;     d.K = FFD;  d.N = DM;    d.dst = (bf16_t*)(ws + WS_WD) + (size_t)a * DM * FFD;      d.ldd = FFD; }
    else if (m < 38) { const int i = m - 22; d.src = ptab(L, 16) + (size_t)i * DM * FFE;     d.K = DM;   d.N = FFE;   d.dst = (bf16_t*)(ws + WS_MWGU) + (size_t)i * 2 * FFEP * DM; d.ldd = DM; d.mode = 1; d.kscale = ptab(L, 3) + (size_t)(2 * (i >> 3) + 1) * DM; }
    else if (m < 54) { const int i = m - 38; d.src = ptab(L, 17) + (size_t)i * DM * FFE;     d.K = DM;   d.N = FFE;   d.dst = (bf16_t*)(ws + WS_MWGU) + (size_t)i * 2 * FFEP * DM; d.ldd = DM; d.mode = 2; d.kscale = ptab(L, 3) + (size_t)(2 * (i >> 3) + 1) * DM; }
    else             { const int i = m - 54; d.src = ptab(L, 18) + (size_t)i * FFE * DM;     d.K = FFE;  d.N = DM;    d.dst = (bf16_t*)(ws + WS_MWD) + (size_t)i * DM * FFEP;    d.ldd = FFEP; }
    if (m == 17 || m == 19) { d.f8 = 1; d.dst = (bf16_t*)(ws + WS_WGU + (size_t)2 * FFD * DM * 2); d.ldd = DM; }
    if (m == 21) { d.f8 = 1; d.dst = (bf16_t*)(ws + WS_WD + (size_t)DM * FFD * 2); d.ldd = FFD8; }
    if (m >= 22 && ((m - 22) & 15) >= 8) {
        const int e = (m - 22) & 7; d.f8 = 1;
        if (m < 54) { d.dst = (bf16_t*)(ws + WS_MWGU + (size_t)8 * 2 * FFEP * DM * 2 + (size_t)e * 2 * FFEP * DM); d.ldd = DM; }
        else        { d.dst = (bf16_t*)(ws + WS_MWD + (size_t)8 * DM * FFEP * 2 + (size_t)e * DM * FFE8); d.ldd = FFE8; } }
    return d;
}
__device__ __forceinline__ void p0_prologue(Frame& F) {
    const int* positions = (const int*)ptab(F.lds, 1);
    const int gw = F.vcu * NWAVES + F.wave, NGW = F.G * NWAVES;
    int cum = 0;
    for (int m = 0; m < N_MATS; ++m) {
        const MatDesc d = mat_desc(m, F.lds, F.ws);
        const int nitems = (d.K / 64) * (d.N / 64);
        int first = gw - (cum % NGW); if (first < 0) first += NGW;
        if (d.f8) { for (int it = first; it < nitems; it += NGW) transpose_item_f8(d.src, d.N, (unsigned char*)d.dst, d.ldd, d.mode, d.kscale, it, F.lane); }
        else { for (int it = first; it < nitems; it += NGW) transpose_item(d.src, d.N, d.dst, d.ldd, d.mode, d.kscale, d.nscale, it, F.lane); }
        cum += nitems;
    }
    const int gt = gw * 64 + F.lane, NGT = NGW * 64; const u32x4 z4 = (u32x4){0u, 0u, 0u, 0u};
    for (int i = gt; i < 2 * 192 * 128; i += NGT) { const int a = i / (192 * 128), r = (i / 128) % 192, c = i % 128; const int row = r < 96 ? 800 + r : 928 + (r - 96); *(GAS u32x4*)((bf16_t*)(F.ws + WS_WDN) + (size_t)a * NDOWNP * DM + (size_t)row * DM + c * 8) = z4; }
    for (int i = gt; i < 8 * 128 * 128; i += NGT) { const int e = i / (128 * 128), r = (i / 128) % 128, c = i % 128; const int row = 2560 + (r < 64 ? 64 + r : 192 + (r - 64));
        *(GAS u32x4*)((bf16_t*)(F.ws + WS_MWGU) + (size_t)e * 2 * FFEP * DM + (size_t)row * DM + c * 8) = z4; }
    for (int i = gt; i < 8 * 1024 * 8; i += NGT) { const int row = i / 8, c = i % 8; *(GAS u32x4*)((bf16_t*)(F.ws + WS_MWD) + (size_t)row * FFEP + FFE + c * 8) = z4; }
    for (int i = gt; i < 1024 * 8; i += NGT) { const int row = i / 8, c = i % 8; *(GAS u32x4*)(F.ws + WS_WD + (size_t)DM * FFD * 2 + (size_t)row * FFD8 + FFD + c * 16) = z4; }
    for (int i = gt; i < 8 * 128 * 64; i += NGT) { const int e = i / (128 * 64), r = (i / 64) % 128, c = i % 64; const int row = 2560 + (r < 64 ? 64 + r : 192 + (r - 64));
        *(GAS u32x4*)(F.ws + WS_MWGU + (size_t)8 * 2 * FFEP * DM * 2 + (size_t)e * 2 * FFEP * DM + (size_t)row * DM + c * 16) = z4; }
    for (int i = gt; i < 8 * 1024 * 12; i += NGT) { const int row = i / 12, c = i % 12; *(GAS u32x4*)(F.ws + WS_MWD + (size_t)8 * DM * FFEP * 2 + (size_t)row * FFE8 + FFE + c * 16) = z4; }
    float* cosT = (float*)(F.ws + WS_COS); float* sinT = (float*)(F.ws + WS_SIN);
    { const float inv = powf(10000.0f, -(float)(2 * (gt & 31)) / 64.0f);
      for (int i = gt; i < NTOK * 32; i += NGT) { const float ang = (float)positions[i >> 5] * inv; float sn, cs; sincosf(ang, &sn, &cs); cosT[i] = cs; sinT[i] = sn; } }
    const float* x = ptab(F.lds, 0); bf16_t* H = (bf16_t*)(F.ws + WS_H); ssq_t* ssq0 = (ssq_t*)(F.ws + WS_SSQ);
    for (int m0 = gw * 4; m0 < NTOK; m0 += NGW * 4) {
        f32x4 v[4][4];
#pragma unroll
        for (int r = 0; r < 4; ++r) { const GAS f32x4* xr = (const GAS f32x4*)(x + (size_t)(m0 + r) * DM) + F.lane;
#pragma unroll
            for (int j = 0; j < 4; ++j) v[r][j] = xr[64 * j]; }
#pragma unroll
        for (int r = 0; r < 4; ++r) { GAS u32x2* o8 = (GAS u32x2*)(H + (size_t)(m0 + r) * DM) + F.lane; float s = 0.f;
#pragma unroll
            for (int j = 0; j < 4; ++j) { const f32x4 t = v[r][j]; s += (t.x * t.x + t.y * t.y) + (t.z * t.z + t.w * t.w); u32x2 w; w.x = cvt_pk_bf16(t.x, t.y); w.y = cvt_pk_bf16(t.z, t.w); o8[64 * j] = w; }
            s = wave_sum(s); if (F.lane == 0) ssq0[m0 + r] = ssq_fix(s); }
    }
}

template <bool FINAL>
__device__ __forceinline__ void combine_phase(Frame& F, const bf16_t* H, bf16_t* Hout, const bf16_t* YB, const unsigned* tokinfo, const unsigned* cntw, ssq_t* ssq_next, const float* gain, float* outF) {
    const int gw = F.vcu * NWAVES + F.wave, NGW = F.G * NWAVES;
    f32x4 g[4];
    if constexpr (FINAL) {
#pragma unroll
        for (int j = 0; j < 4; ++j) g[j] = *(const f32x4*)(gain + F.lane * 4 + 256 * j);
    }
    unsigned nb[8];
#pragma unroll
    for (int e = 0; e < 8; ++e) nb[e] = (rfl(__hip_atomic_load((unsigned*)cntw + 64 * e, RLX_AGENT)) + 255u) >> 8;
    for (int m0 = gw * 2; m0 < NTOK; m0 += NGW * 2) {
        u32x4 t0[2], t1[2];
#pragma unroll
        for (int r = 0; r < 2; ++r) { t0[r] = *(const u32x4*)(tokinfo + (size_t)(m0 + r) * 8); t1[r] = *(const u32x4*)(tokinfo + (size_t)(m0 + r) * 8 + 4); }
        u32x2 hh[2][4], ya[2][4], yb[2][4]; float g0[2], g1[2];
#pragma unroll
        for (int r = 0; r < 2; ++r) {
            const unsigned e0 = rfl(t0[r].x), r0 = rfl(t0[r].y), e1 = rfl(t1[r].x), r1 = rfl(t1[r].y); g0[r] = __uint_as_float(rfl(t0[r].z)); g1[r] = __uint_as_float(rfl(t1[r].z));
            unsigned b0 = 0u, b1 = 0u;
#pragma unroll
            for (int e = 0; e < 8; ++e) { b0 += ((unsigned)e < e0) ? nb[e] : 0u; b1 += ((unsigned)e < e1) ? nb[e] : 0u; }
            const GAS u32x2* hr = (const GAS u32x2*)(H + (size_t)(m0 + r) * DM) + F.lane;
            const GAS u32x2* y0 = (const GAS u32x2*)(YB + ((size_t)b0 * 256 + r0) * DM) + F.lane; const GAS u32x2* y1 = (const GAS u32x2*)(YB + ((size_t)b1 * 256 + r1) * DM) + F.lane;
#pragma unroll
            for (int j = 0; j < 4; ++j) { hh[r][j] = hr[64 * j]; ya[r][j] = y0[64 * j]; yb[r][j] = y1[64 * j]; }
        }
#pragma unroll
        for (int r = 0; r < 2; ++r) { const int m = m0 + r;
            f32x4 v[4]; float s = 0.f;
#pragma unroll
            for (int j = 0; j < 4; ++j) { const u32x2 h2 = hh[r][j], a = ya[r][j], b = yb[r][j];
                v[j].x = bflo(h2.x) + g0[r] * bflo(a.x) + g1[r] * bflo(b.x); v[j].y = bfhi(h2.x) + g0[r] * bfhi(a.x) + g1[r] * bfhi(b.x); v[j].z = bflo(h2.y) + g0[r] * bflo(a.y) + g1[r] * bflo(b.y); v[j].w = bfhi(h2.y) + g0[r] * bfhi(a.y) + g1[r] * bfhi(b.y);
                s += (v[j].x * v[j].x + v[j].y * v[j].y) + (v[j].z * v[j].z + v[j].w * v[j].w); }
            s = wave_sum(s);
            if constexpr (FINAL) { const float rstd = rstd_f(s); GAS f32x4* ho = (GAS f32x4*)(outF + (size_t)m * DM) + F.lane;
#pragma unroll
                for (int j = 0; j < 4; ++j) ho[64 * j] = v[j] * rstd * g[j];
            } else { GAS u32x2* hw = (GAS u32x2*)(Hout + (size_t)m * DM) + F.lane;
#pragma unroll
                for (int j = 0; j < 4; ++j) { u32x2 w; w.x = cvt_pk_bf16(v[j].x, v[j].y); w.y = cvt_pk_bf16(v[j].z, v[j].w); hw[64 * j] = w; }
                if (F.lane == 0) ssq_next[m] = ssq_fix(s); }
        }
    }
}
__device__ __forceinline__ void mid_phase(Frame& F, const bf16_t* DOWN, const float* qn, const float* kvn, const float* cosT, const float* sinT, bf16_t* CQN, bf16_t* CKVN, bf16_t* KR) {
    const int gw = F.vcu * NWAVES + F.wave, NGW = F.G * NWAVES, lane = F.lane;
    const f32x4 q0 = *(const f32x4*)(qn + lane * 8), q1 = *(const f32x4*)(qn + lane * 8 + 4), k0 = *(const f32x4*)(kvn + lane * 4);
    for (int m = gw; m < NTOK; m += NGW) {
        const bf16_t* dr = DOWN + (size_t)m * NDOWNP;
        const u32x4 cq = *(const GAS u32x4*)(dr + lane * 8); const u32x2 ck = *(const GAS u32x2*)(dr + QLR + lane * 4);
        const float x1 = bf2f(dr[QLR + KVLR + (lane & 31)]), x2 = bf2f(dr[QLR + KVLR + 32 + (lane & 31)]);
        const f32x4 a0 = (f32x4){bflo(cq.x), bfhi(cq.x), bflo(cq.y), bfhi(cq.y)}, a1 = (f32x4){bflo(cq.z), bfhi(cq.z), bflo(cq.w), bfhi(cq.w)}, c0 = (f32x4){bflo(ck.x), bfhi(ck.x), bflo(ck.y), bfhi(ck.y)};
        const float sq = wave_sum((a0.x * a0.x + a0.y * a0.y) + (a0.z * a0.z + a0.w * a0.w) + (a1.x * a1.x + a1.y * a1.y) + (a1.z * a1.z + a1.w * a1.w));
        const float sk = wave_sum((c0.x * c0.x + c0.y * c0.y) + (c0.z * c0.z + c0.w * c0.w));
        const float rq = 1.0f / sqrtf(sq * (1.0f / QLR) + RMS_EPS), rk = 1.0f / sqrtf(sk * (1.0f / KVLR) + RMS_EPS);
        const f32x4 y0 = a0 * rq * q0, y1 = a1 * rq * q1, z0 = c0 * rk * k0;
        u32x4 w; w.x = cvt_pk_bf16(y0.x, y0.y); w.y = cvt_pk_bf16(y0.z, y0.w); w.z = cvt_pk_bf16(y1.x, y1.y); w.w = cvt_pk_bf16(y1.z, y1.w);
        *(GAS u32x4*)(CQN + (size_t)m * QLR + lane * 8) = w;
        u32x2 w2; w2.x = cvt_pk_bf16(z0.x, z0.y); w2.y = cvt_pk_bf16(z0.z, z0.w);
        *(GAS u32x2*)(CKVN + (size_t)m * KVLR + lane * 4) = w2;
        const float c = cosT[(size_t)m * 32 + (lane & 31)], s = sinT[(size_t)m * 32 + (lane & 31)];
        const float o = lane < 32 ? x1 * c - x2 * s : x2 * c + x1 * s;
        KR[(size_t)m * DROPE + lane] = (bf16_t)(cvt_pk_bf16(o, o) & 0xffffu);
    }
}
template <int W>
__device__ __forceinline__ void pool_walk(const bf16_t* h, const ssq_t* ssq, const f32x2 g2, bf16_t* Z, size_t rowbase, int t_start, int c0, int nrows, int col) {
    f32x2 ring[W]; f32x2 sum = (f32x2){0.f, 0.f};
#pragma unroll
    for (int j = 0; j < W; ++j) ring[j] = (f32x2){0.f, 0.f};
    for (int r = 0; r < nrows; r += 16) {
        unsigned xw[16]; ssq_t q[16];
#pragma unroll
        for (int j = 0; j < 16; ++j) { const size_t row = rowbase + t_start + r + j; xw[j] = *(const GAS unsigned*)(h + row * DM + col); q[j] = ssq[row]; }
#pragma unroll
        for (int j = 0; j < 16; ++j) {
            const int t = t_start + r + j; const size_t row = rowbase + t;
            const f32x2 v = (f32x2){bflo(xw[j]), bfhi(xw[j])} * rstd_of(q[j]) * g2;
            sum = sum + (v - ring[j % W]); ring[j % W] = v;
            if (t >= c0) { const float inv = 1.0f / (float)(t + 1 < W ? t + 1 : W); const f32x2 z = sum * inv - v; *(GAS unsigned*)(Z + row * DM + col) = cvt_pk_bf16(z.x, z.y); }
        }
    }
}
__device__ __forceinline__ void pool_phase(Frame& F, const bf16_t* h, const ssq_t* ssq, const float* gain, bf16_t* Z) {
    const int col = F.tid * 2; const f32x2 g2 = *(const f32x2*)(gain + col);
    for (int chunk = F.vcu; chunk < NBATCH * 16; chunk += F.G) {
        const int b = chunk >> 4, c0 = (chunk & 15) * 128, t_start = c0 ? c0 - 16 : 0, nrows = c0 + 128 - t_start; const size_t rowbase = (size_t)b * SEQ;
        const int grp = F.wave >> 1;
        if (grp == 0) pool_walk<2>(h, ssq, g2, Z, rowbase, t_start, c0, nrows, col);
        else if (grp == 1) pool_walk<4>(h, ssq, g2, Z, rowbase, t_start, c0, nrows, col);
        else if (grp == 2) pool_walk<8>(h, ssq, g2, Z, rowbase, t_start, c0, nrows, col);
        else pool_walk<16>(h, ssq, g2, Z, rowbase, t_start, c0, nrows, col);
    }
}
template <bool WRITE_H8>
__device__ __forceinline__ void router_phase(Frame& F, const bf16_t* h, const ssq_t* ssq, const float* gain, const float* router, int* list, float* rsl, unsigned* tokinfo, unsigned* cntw, unsigned char* H8) {
    LAS float* rt = (LAS float*)(F.lds + RING_OFF);
    LAS int* esel = (LAS int*)(F.lds + RING_OFF + 32768);
    LAS int* wt = (LAS int*)(F.lds + RING_OFF + 32768 + 2048);
    LAS int* base = (LAS int*)(F.lds + RING_OFF + 32768 + 2048 + 256);
    LAS float* rsd = (LAS float*)(F.lds + RING_OFF + 32768 + 2048 + 512);
    const int lane = F.lane;
    for (int idx = F.tid; idx < DM * NEXP; idx += NWAVES * 64) rt[(idx & 7) * DM + (idx >> 3)] = router[idx];
    f32x4 g[4];
#pragma unroll
    for (int j = 0; j < 4; ++j) g[j] = *(const f32x4*)(gain + lane * 4 + 256 * j);
    for (int chunk = F.vcu; chunk < NTOK / 256; chunk += F.G) {
        const int T0 = chunk * 256;
        __syncthreads();
        u32x2 nx[4]; ssq_t nq;
        { const GAS u32x2* xr = (const GAS u32x2*)(h + (size_t)(T0 + F.wave * 32) * DM) + lane;
#pragma unroll
          for (int j = 0; j < 4; ++j) nx[j] = xr[64 * j];
          nq = ssq[T0 + F.wave * 32]; }
        for (int i = 0; i < 32; ++i) {
            const int tl = F.wave * 32 + i, m = T0 + tl;
            u32x2 cw[4];
#pragma unroll
            for (int j = 0; j < 4; ++j) cw[j] = nx[j];
            const float rstd = rstd_of(nq);
            if (i + 1 < 32) { const GAS u32x2* xr = (const GAS u32x2*)(h + (size_t)(m + 1) * DM) + lane;
#pragma unroll
                for (int j = 0; j < 4; ++j) nx[j] = xr[64 * j];
                nq = ssq[m + 1]; }
            f32x4 v[4];
#pragma unroll
            for (int j = 0; j < 4; ++j) { const u32x2 w = cw[j]; f32x4 xn = (f32x4){bflo(w.x), bfhi(w.x), bflo(w.y), bfhi(w.y)} * rstd;
                if constexpr (WRITE_H8) { const f32x4 q = xn * pg8::FP8_SA; *(GAS unsigned*)(H8 + (size_t)m * DM + lane * 4 + 256 * j) = pg8::pk4_fp8(q.x, q.y, q.z, q.w); }
                v[j] = xn * g[j]; }
            float lg[8];
#pragma unroll
            for (int e = 0; e < 8; ++e) { float p = 0.f;
#pragma unroll
                for (int j = 0; j < 4; ++j) { const f32x4 r4 = *(const LAS f32x4*)(rt + e * DM + lane * 4 + 256 * j); p += (v[j].x * r4.x + v[j].y * r4.y) + (v[j].z * r4.z + v[j].w * r4.w); }
                lg[e] = wave_sum(p); }
            int e0 = 0; float l0 = lg[0];
#pragma unroll
            for (int e = 1; e < 8; ++e) if (lg[e] > l0) { l0 = lg[e]; e0 = e; }
            int e1 = e0 == 0 ? 1 : 0; float l1 = lg[e0 == 0 ? 1 : 0];
#pragma unroll
            for (int e = 0; e < 8; ++e) if (e != e0 && lg[e] > l1) { l1 = lg[e]; e1 = e; }
            const float g0 = 1.0f / (1.0f + __expf(l1 - l0)), g1 = 1.0f - g0;
            if (lane == 0) { esel[2 * tl] = e0; esel[2 * tl + 1] = e1; rsd[tl] = rstd; unsigned* ti = tokinfo + (size_t)m * 8;
                ti[0] = (unsigned)e0; ti[2] = __float_as_uint(g0); ti[4] = (unsigned)e1; ti[6] = __float_as_uint(g1); }
        }
        __syncthreads();
        const int me = esel[F.tid]; int myrank = 0;
#pragma unroll
        for (int e = 0; e < 8; ++e) { const unsigned long long mask = __ballot(me == e); if (me == e) myrank = __popcll(mask & ((1ull << lane) - 1ull)); if (lane == 0) wt[F.wave * 8 + e] = __popcll(mask); }
        __syncthreads();
        int off = 0;
        for (int w = 0; w < F.wave; ++w) off += wt[w * 8 + me];
        if (F.tid < 8) { int tot = 0; for (int w = 0; w < 8; ++w) tot += wt[w * 8 + F.tid]; base[F.tid] = (int)__hip_atomic_fetch_add(cntw + 64 * F.tid, (unsigned)tot, RLX_AGENT); }
        __syncthreads();
        const int rank = base[me] + off + myrank, tok = T0 + (F.tid >> 1);
        list[(size_t)me * NTOK + rank] = tok; rsl[(size_t)me * NTOK + rank] = rsd[F.tid >> 1];
        tokinfo[(size_t)tok * 8 + (F.tid & 1) * 4 + 1] = (unsigned)rank;
    }
}
template <bool GATHER, bool FP8 = false>
struct MoeOrder {
    static constexpr size_t A_BLK = GATHER ? 0 : (FP8 ? (size_t)256 * FFE8 : (size_t)256 * FFEP * 2), B_EXP = GATHER ? (FP8 ? (size_t)2 * FFEP * DM : (size_t)2 * FFEP * DM * 2) : (FP8 ? (size_t)DM * FFE8 : (size_t)DM * FFEP * 2),
                            B_TILE = GATHER ? (FP8 ? (size_t)256 * DM : (size_t)256 * DM * 2) : (FP8 ? (size_t)256 * FFE8 : (size_t)256 * FFEP * 2);
    static constexpr int NT = GATHER ? 2 * FFEP / 256 : DM / 256;
    const char* A; const char* B; const int* list; const unsigned* cntw; int G, c, rev; unsigned bs[9];
    __device__ __forceinline__ void init(const unsigned* cntw_, const void* A_, const void* B_, const int* list_, int G_, int c_) {
        A = (const char*)A_; B = (const char*)B_; list = list_; cntw = cntw_; G = G_; c = c_; rev = 0; bs[0] = 0u;
#pragma unroll
        for (int e = 0; e < 8; ++e) { const unsigned ce = rfl(__hip_atomic_load((unsigned*)cntw + 64 * e, RLX_AGENT)); bs[e + 1] = bs[e] + ((ce + 255u) >> 8); }
    }
    __device__ __forceinline__ bool next(int i, pg8::Unit& u) const {
        long L = (long)i * G + c; if (L >= (long)bs[8] * NT) return false;
        if (rev) L = (long)bs[8] * NT - 1 - L;
        const unsigned blk = (unsigned)(L / NT); const int pn = (int)(L % NT);
        unsigned e = 0u, st = 0u;
#pragma unroll
        for (int k = 1; k < 8; ++k) if (blk >= bs[k]) { e = (unsigned)k; st = bs[k]; }
        const unsigned j = blk - st;
        u.b = B + (size_t)e * B_EXP + (size_t)pn * B_TILE; u.orow = (int)(blk * 256u); u.pn = pn; u.aux = (int)e;
        if constexpr (GATHER) { const unsigned ce = rfl(__hip_atomic_load((unsigned*)cntw + 64 * e, RLX_AGENT));
            u.a = A; u.rows = list + (size_t)e * NTOK + (size_t)j * 256; const unsigned rem = ce - j * 256u; u.nrows = rem < 256u ? (int)rem : 256; }
        else { u.a = A + (size_t)blk * A_BLK; u.rows = nullptr; u.nrows = 256; }
        return true;
    }
};
constexpr int NPHASE = 27;
struct Args { const float* in[20]; float* out; unsigned char* ws; int ph_lo, ph_hi, li, pad; };
#ifndef MK_REP_MASK
#define MK_REP_MASK 0
#endif
#ifndef MK_REP_N
#define MK_REP_N 1
#endif
#ifndef MK_REV
#define MK_REV 1
#endif
#ifndef MK_STAG_BF
#define MK_STAG_BF 0u
#define MK_STAG_F8 0u
#endif
constexpr int PT_OFF = LDSCTL_OFF + 512;
__device__ __forceinline__ unsigned long long ptab_u64(LAS unsigned char* L, int i) {
    const volatile LAS unsigned* p = (const volatile LAS unsigned*)(L + PT_OFF + 8 * i); const unsigned lo = rfl(p[0]), hi = rfl(p[1]); return ((unsigned long long)hi << 32) | lo; }
__device__ __forceinline__ const float* ptab(LAS unsigned char* L, int i) { return (const float*)ptab_u64(L, i); }
__device__ __forceinline__ Frame make_frame(LAS unsigned char* L) {
    Frame F; F.lds = L; F.MISC = (volatile LAS unsigned*)(L + MISC_OFF); F.tid = launder_v((int)threadIdx.x); F.lane = F.tid & 63; F.wave = __builtin_amdgcn_readfirstlane(F.tid >> 6);
    F.G = gridDim.x; { const int bx = blockIdx.x; F.vcu = (F.G % 8 == 0) ? (bx % 8) * (F.G / 8) + bx / 8 : bx; }
    F.ws = (unsigned char*)ptab_u64(L, 21); F.ctl = (gu32*)(F.ws + WS_CTL); return F;
}
__global__ void __launch_bounds__(NWAVES * 64, 2) fwd(Args args) {
    extern __shared__ __attribute__((aligned(16))) unsigned char lds[];
    LAS unsigned char* L = (LAS unsigned char*)lds;
    { const int tid = threadIdx.x;
      for (int u = tid; u < (LDS_BYTES - LDSCTL_OFF) / 4; u += NWAVES * 64) ((LAS unsigned*)(L + LDSCTL_OFF))[u] = 0u;
      __syncthreads();
      if (tid < 20) *(LAS unsigned long long*)(L + PT_OFF + 8 * tid) = (unsigned long long)args.in[tid];
      if (tid == 20) *(LAS unsigned long long*)(L + PT_OFF + 8 * 20) = (unsigned long long)args.out;
      if (tid == 21) *(LAS unsigned long long*)(L + PT_OFF + 8 * 21) = (unsigned long long)args.ws;
      if (tid == 22) *(LAS unsigned long long*)(L + PT_OFF + 8 * 22) = (unsigned long long)args.pad;
      __syncthreads(); }
    const int lo = args.ph_lo, hi = args.ph_hi;
    XcdBarrier bar; { gu32* ctl = (gu32*)(args.ws + WS_CTL); bar.bar = (unsigned*)(ctl + CW_BAR) + args.li * XCD_BAR_WORDS; bar.x = 0; bar.st = nullptr;
      if (threadIdx.x == 0) { const unsigned long long ba = (unsigned long long)((unsigned*)(ctl + CW_BAR) + args.li * XCD_BAR_WORDS); ((volatile LAS unsigned*)(L + MISC_OFF))[10] = (unsigned)ba; ((volatile LAS unsigned*)(L + MISC_OFF))[11] = (unsigned)(ba >> 32); }
      if (hi - lo > 1) bar = xcd_barrier_post((unsigned*)(ctl + CW_BAR) + args.li * XCD_BAR_WORDS, (volatile LAS unsigned*)(L + MISC_OFF) + 8);
      __syncthreads(); }
#ifndef MK_ONLY
#define MK_ONLY (-1)
#endif
#define KIND(k) ((k) == 0 ? 0 : 1 + ((k) - 1) % 13)
#ifndef MK_SKIPMASK
#define MK_SKIPMASK 0
#endif
#define IN(k) ((MK_ONLY < 0 || KIND(k) == MK_ONLY) && !((MK_SKIPMASK >> KIND(k)) & 1) && lo <= (k) && (k) < hi)
#define FORREP(k)
#if MK_REP_MASK
#define LASTREP (ptab_u64(L, 22) == 0ull)
#else
#define LASTREP true
#endif
#ifdef MK_DOUBLE_BAR
#define SEAM(k) do { if ((k) + 1 < hi) { xcd_barrier(bar); xcd_barrier(bar); } } while (0)
#else
#define SEAM(k) do { if ((k) + 1 < hi) xcd_barrier(bar); } while (0)
#endif
#define WSP(off) ((bf16_t*)(F.ws + (off)))
#define SSQ(i) ((ssq_t*)(F.ws + WS_SSQ) + (size_t)(i) * NTOK)
    LAS unsigned char* ring = L + RING_OFF;

    if (IN(0)) FORREP(0) { Frame F = make_frame(L); p0_prologue(F); SEAM(0); }

    for (int lp = 0; lp < 2; ++lp) {
        const int pb = 1 + 13 * lp;
        if (IN(pb + 0)) FORREP(pb + 0) { Frame F = make_frame(L);
            pg8::RegOrder S; S.init(WSP(WS_H), DM * 2, WSP(WS_WDN) + (size_t)lp * NDOWNP * DM, DM * 2, NTOK, NDOWNP, F.G, (int)blockIdx.x);
            pg8::EpiDown E{WSP(WS_DOWN), WSP(WS_KR), SSQ(4 * lp + 0), LASTREP ? SSQ(10 + 2 * lp) : SSQ(9), LASTREP ? SSQ(11 + 2 * lp) : SSQ(9), (const float*)(F.ws + WS_COS), (const float*)(F.ws + WS_SIN)};
            pg8::gemm_phase<pg8::EpiDown, pg8::RegOrder, false>(ring, DM * 2, DM * 2, DM * 2, S, E);
            SEAM(pb + 0);
        }
        if (IN(pb + 1)) FORREP(pb + 1) { Frame F = make_frame(L);
            pg8::RegOrder S; S.init(WSP(WS_DOWN), NDOWNP * 2, WSP(WS_WUQ) + (size_t)lp * NQ * QLR, QLR * 2, NTOK, NQ, F.G, (int)blockIdx.x);
            pg8::EpiQ E{WSP(WS_Q), (const float*)(F.ws + WS_COS), (const float*)(F.ws + WS_SIN), SSQ(10 + 2 * lp)};
            pg8::gemm_phase<pg8::EpiQ, pg8::RegOrder, false>(ring, NDOWNP * 2, QLR * 2, QLR * 2, S, E);
            SEAM(pb + 1);
        }
        if (IN(pb + 2)) FORREP(pb + 2) { Frame F = make_frame(L);
            pg8::RegOrder S; S.init(WSP(WS_DOWN) + QLR, NDOWNP * 2, WSP(WS_WUKV) + (size_t)lp * NKV * KVLR, KVLR * 2, NTOK, NKV, F.G, (int)blockIdx.x);
            pg8::EpiBf16<2> E{WSP(WS_KNV), NKV, SSQ(11 + 2 * lp)};
            pg8::gemm_phase<pg8::EpiBf16<2>, pg8::RegOrder, false>(ring, NDOWNP * 2, KVLR * 2, KVLR * 2, S, E);
            SEAM(pb + 2);
        }
        if (IN(pb + 3)) FORREP(pb + 3) { Frame F = make_frame(L); att::attn_phase((char*)lds + RING_OFF, WSP(WS_Q), WSP(WS_KNV), WSP(WS_KR), WSP(WS_DOWN), F.vcu, F.G); SEAM(pb + 3); }
        if (IN(pb + 4) && lp == 0) FORREP(pb + 4) { Frame F = make_frame(L);
            pg8::RegOrder S; S.init(WSP(WS_DOWN), DM * 2, WSP(WS_WO) + (size_t)lp * DM * DM, DM * 2, NTOK, DM, F.G, (int)blockIdx.x);
            pg8::EpiResidH<false> E{WSP(WS_H), LASTREP ? WSP(WS_H) : WSP(WS_DUMMY), LASTREP ? SSQ(4 * lp + 1) : SSQ(9), nullptr, 1.0f};
            pg8::gemm_phase<pg8::EpiResidH<false>, pg8::RegOrder, false>(ring, DM * 2, DM * 2, DM * 2, S, E);
            SEAM(pb + 4);
        }
        if (IN(pb + 4) && lp == 1) FORREP(pb + 4) { Frame F = make_frame(L);
            pg8::RegOrder S; S.init(WSP(WS_DOWN), DM * 2, WSP(WS_WO) + (size_t)lp * DM * DM, DM * 2, NTOK, DM, F.G, (int)blockIdx.x);
            pg8::EpiResidH<true> E{WSP(WS_H), LASTREP ? WSP(WS_H) : WSP(WS_DUMMY), LASTREP ? SSQ(4 * lp + 1) : SSQ(9), F.ws + WS_H8, 1.0f};
            pg8::gemm_phase<pg8::EpiResidH<true>, pg8::RegOrder, false>(ring, DM * 2, DM * 2, DM * 2, S, E);
            SEAM(pb + 4);
        }
#if defined(MK_EPI_PROBE)
        if (IN(pb + 5) && lp == 0 && !LASTREP) { Frame F = make_frame(L);
            pg8::RegOrder S; S.init(WSP(WS_H), DM * 2, WSP(WS_WGU) + (size_t)lp * 2 * FFD * DM, DM * 2, NTOK, 2 * FFD, F.G, (int)blockIdx.x);
#if MK_EPI_PROBE == 1
            pg8::EpiNull E{(float*)(F.ws + WS_DUMMY)};
            pg8::gemm_phase<pg8::EpiNull, pg8::RegOrder, false>(ring, DM * 2, DM * 2, DM * 2, S, E);
#else
            pg8::EpiBf16<0> E{WSP(WS_HID), FFD, nullptr};
            S.nN = FFD / 256; S.nwg = S.nM * S.nN;
            pg8::gemm_phase<pg8::EpiBf16<0>, pg8::RegOrder, false>(ring, DM * 2, DM * 2, DM * 2, S, E);
#endif
        }
        if (IN(pb + 5) && lp == 0 && LASTREP) FORREP(pb + 5) { Frame F = make_frame(L);
#else
        if (IN(pb + 5) && lp == 0) FORREP(pb + 5) { Frame F = make_frame(L);
#endif
            pg8::RegOrder S; S.init(WSP(WS_H), DM * 2, WSP(WS_WGU) + (size_t)lp * 2 * FFD * DM, DM * 2, NTOK, 2 * FFD, F.G, (int)blockIdx.x);
            pg8::EpiSwiglu<1> E{WSP(WS_HID), FFD, SSQ(4 * lp + 1), nullptr};
            pg8::gemm_phase<pg8::EpiSwiglu<1>, pg8::RegOrder, false>(ring, DM * 2, DM * 2, DM * 2, S, E, MK_STAG_BF);
            SEAM(pb + 5);
        }
        if (IN(pb + 5) && lp == 1) FORREP(pb + 5) { Frame F = make_frame(L);
            pg8::RegOrder S; S.init(F.ws + WS_H8, DM, F.ws + WS_WGU + (size_t)2 * FFD * DM * 2, DM, NTOK, 2 * FFD, F.G, (int)blockIdx.x);
            pg8::EpiSwigluF8<1> E{F.ws + WS_HID, FFD8, 2 * FFD / 256 - 1, SSQ(4 * lp + 1)};
            pg8::gemm_phase<pg8::EpiSwigluF8<1>, pg8::RegOrder, false, true>(ring, DM, DM, DM, S, E, MK_STAG_F8);
            SEAM(pb + 5);
        }
        if (IN(pb + 6) && lp == 0) FORREP(pb + 6) { Frame F = make_frame(L);
            pg8::RegOrder S; S.init(WSP(WS_HID), FFD * 2, WSP(WS_WD) + (size_t)lp * DM * FFD, FFD * 2, NTOK, DM, F.G, (int)blockIdx.x); S.rev = MK_REV;
            pg8::EpiResidH<false> E{WSP(WS_H), LASTREP ? WSP(WS_H) : WSP(WS_DUMMY), LASTREP ? SSQ(4 * lp + 2) : SSQ(9), nullptr, 1.0f};
            pg8::gemm_phase<pg8::EpiResidH<false>, pg8::RegOrder, false>(ring, FFD * 2, FFD * 2, FFD * 2, S, E);
            SEAM(pb + 6);
        }
        if (IN(pb + 6) && lp == 1) FORREP(pb + 6) { Frame F = make_frame(L);
            pg8::RegOrder S; S.init(F.ws + WS_HID, FFD8, F.ws + WS_WD + (size_t)DM * FFD * 2, FFD8, NTOK, DM, F.G, (int)blockIdx.x); S.rev = MK_REV;
            pg8::EpiResidH<false> E{WSP(WS_H), LASTREP ? WSP(WS_H) : WSP(WS_DUMMY), LASTREP ? SSQ(4 * lp + 2) : SSQ(9), nullptr, 1.0f / (pg8::FP8_SH * pg8::FP8_SW)};
            pg8::gemm_phase<pg8::EpiResidH<false>, pg8::RegOrder, false, true>(ring, FFD8, FFD8, FFD8, S, E);
            SEAM(pb + 6);
        }
        if (IN(pb + 7)) FORREP(pb + 7) { Frame F = make_frame(L); pool_phase(F, WSP(WS_H), SSQ(4 * lp + 2), ptab(L, 2) + (size_t)(2 * lp + 1) * DM, WSP(WS_DOWN)); SEAM(pb + 7); }
        if (IN(pb + 8)) FORREP(pb + 8) { Frame F = make_frame(L);
            pg8::RegOrder S; S.init(WSP(WS_DOWN), DM * 2, WSP(WS_WPOOL) + (size_t)lp * 4 * 256 * 256, 256 * 2, NTOK, DM, F.G, (int)blockIdx.x, 256 * 2);
            pg8::EpiResidH<false> E{WSP(WS_H), LASTREP ? WSP(WS_H) : WSP(WS_DUMMY), LASTREP ? SSQ(4 * lp + 3) : SSQ(9), nullptr, 1.0f};
            pg8::gemm_phase<pg8::EpiResidH<false>, pg8::RegOrder, false>(ring, DM * 2, 256 * 2, 256 * 2, S, E);
            SEAM(pb + 8);
        }
        if (IN(pb + 9)) FORREP(pb + 9) { Frame F = make_frame(L);
            if (lp == 0) router_phase<false>(F, WSP(WS_H), SSQ(4 * lp + 3), ptab(L, 3) + (size_t)(2 * lp + 1) * DM, ptab(L, 15) + (size_t)lp * DM * NEXP, (int*)(F.ws + WS_LIST), (float*)(F.ws + WS_RSL), (unsigned*)(F.ws + WS_TOKINFO), (unsigned*)(F.ctl + CW_CNT) + (LASTREP ? lp : 2 + lp) * 8 * 64, nullptr);
            else router_phase<true>(F, WSP(WS_H), SSQ(4 * lp + 3), ptab(L, 3) + (size_t)(2 * lp + 1) * DM, ptab(L, 15) + (size_t)lp * DM * NEXP, (int*)(F.ws + WS_LIST), (float*)(F.ws + WS_RSL), (unsigned*)(F.ws + WS_TOKINFO), (unsigned*)(F.ctl + CW_CNT) + (LASTREP ? lp : 2 + lp) * 8 * 64, F.ws + WS_H8);
            SEAM(pb + 9); }
#ifndef TEST_NO_BF16MOE
        if (IN(pb + 10) && lp == 0) FORREP(pb + 10) { Frame F = make_frame(L);
            MoeOrder<true> S; S.init((unsigned*)(F.ctl + CW_CNT) + lp * 8 * 64, WSP(WS_H), WSP(WS_MWGU), (const int*)(F.ws + WS_LIST), F.G, (int)blockIdx.x);
            pg8::EpiSwiglu<2> E{WSP(WS_HID), FFEP, (const float*)(F.ws + WS_RSL), (const int*)(F.ws + WS_LIST)};
            pg8::gemm_phase<pg8::EpiSwiglu<2>, MoeOrder<true>, true>(ring, DM * 2, DM * 2, DM * 2, S, E, MK_STAG_BF);
            SEAM(pb + 10);
        }
#endif
#ifndef TEST_NO_F8MOE
        if (IN(pb + 10) && lp == 1) FORREP(pb + 10) { Frame F = make_frame(L);
            MoeOrder<true, true> S; S.init((unsigned*)(F.ctl + CW_CNT) + lp * 8 * 64, F.ws + WS_H8, F.ws + WS_MWGU + (size_t)8 * 2 * FFEP * DM * 2, (const int*)(F.ws + WS_LIST), F.G, (int)blockIdx.x);
            pg8::EpiSwigluF8<0> E{F.ws + WS_HID, FFE8, 2 * FFEP / 256 - 1, nullptr};
            pg8::gemm_phase<pg8::EpiSwigluF8<0>, MoeOrder<true, true>, true, true>(ring, DM, DM, DM, S, E, MK_STAG_F8);
            SEAM(pb + 10);
        }
#endif
#ifndef TEST_NO_BF16MOE
        if (IN(pb + 11) && lp == 0) FORREP(pb + 11) { Frame F = make_frame(L);
            MoeOrder<false> S; S.init((unsigned*)(F.ctl + CW_CNT) + lp * 8 * 64, WSP(WS_HID), WSP(WS_MWD), (const int*)(F.ws + WS_LIST), F.G, (int)blockIdx.x); S.rev = MK_REV;
            pg8::EpiBf16<0> E{WSP(WS_YB), DM, nullptr};
            pg8::gemm_phase<pg8::EpiBf16<0>, MoeOrder<false>, false>(ring, FFEP * 2, FFEP * 2, FFEP * 2, S, E);
            SEAM(pb + 11);
        }
#endif
#ifndef TEST_NO_F8MOE
        if (IN(pb + 11) && lp == 1) FORREP(pb + 11) { Frame F = make_frame(L);
            MoeOrder<false, true> S; S.init((unsigned*)(F.ctl + CW_CNT) + lp * 8 * 64, F.ws + WS_HID, F.ws + WS_MWD + (size_t)8 * DM * FFEP * 2, (const int*)(F.ws + WS_LIST), F.G, (int)blockIdx.x); S.rev = MK_REV;
            pg8::EpiBf16Scaled E{WSP(WS_YB), DM, 1.0f / (pg8::FP8_SH * pg8::FP8_SW)};
            pg8::gemm_phase<pg8::EpiBf16Scaled, MoeOrder<false, true>, false, true>(ring, FFE8, FFE8, FFE8, S, E);
            SEAM(pb + 11);
        }
#endif
        if (IN(pb + 12)) FORREP(pb + 12) { Frame F = make_frame(L);
            if (lp == 0) combine_phase<false>(F, WSP(WS_H), LASTREP ? WSP(WS_H) : WSP(WS_DOWN), WSP(WS_YB), (const unsigned*)(F.ws + WS_TOKINFO), (unsigned*)(F.ctl + CW_CNT), LASTREP ? SSQ(4) : SSQ(9), nullptr, nullptr);
            else combine_phase<true>(F, WSP(WS_H), nullptr, WSP(WS_YB), (const unsigned*)(F.ws + WS_TOKINFO), (unsigned*)(F.ctl + CW_CNT) + 8 * 64, nullptr, ptab(L, 19), (float*)ptab(L, 20));
            SEAM(pb + 12);
        }
    }
#undef IN
#undef SEAM
#undef WSP
#undef SSQ
}

#ifndef MK_PER_PHASE
#define MK_PER_PHASE 0
#endif
extern "C" void kernel_launch(void* const* d_in, const int* in_sizes, int n_in, void* d_out, int out_size, void* d_ws, size_t ws_size, hipStream_t stream) {
    static int grid = 0;
    if (grid == 0) {
        if (n_in != 20 || in_sizes[0] != NTOK * DM || out_size != NTOK * DM || ws_size < WS_END) { fprintf(stderr, "kernel_launch: unexpected shapes (n_in %d, in0 %d, out %d, ws %zu < %zu)\n", n_in, n_in > 0 ? in_sizes[0] : -1, out_size, ws_size, (size_t)WS_END); grid = -1; return; }
        int dev = 0, cus = 0, per_cu = 0;
        if (hipGetDevice(&dev) != hipSuccess || hipDeviceGetAttribute(&cus, hipDeviceAttributeMultiprocessorCount, dev) != hipSuccess) { grid = -1; return; }
        if (hipFuncSetAttribute((const void*)fwd, hipFuncAttributeMaxDynamicSharedMemorySize, LDS_BYTES) != hipSuccess) { fprintf(stderr, "kernel_launch: hipFuncSetAttribute failed\n"); grid = -1; return; }
        if (hipOccupancyMaxActiveBlocksPerMultiprocessor(&per_cu, (const void*)fwd, NWAVES * 64, LDS_BYTES) != hipSuccess || per_cu < 1) fprintf(stderr, "kernel_launch: occupancy query reports %d\n", per_cu);
        (void)hipGetLastError();
        grid = cus;
    }
    if (grid < 0) return;
    if (hipMemsetAsync((char*)d_ws + WS_CTL, 0, CTL_ZERO_BYTES, stream) != hipSuccess) return;
    Args a{};
    for (int i = 0; i < 20; ++i) a.in[i] = (const float*)d_in[i];
    a.out = (float*)d_out; a.ws = (unsigned char*)d_ws;
#if MK_PER_PHASE
    for (int p = 0; p < NPHASE; ++p) { a.ph_lo = p; a.ph_hi = p + 1; a.li = 0; hipLaunchKernelGGL(fwd, dim3(grid), dim3(NWAVES * 64), LDS_BYTES, stream, a); }
#elif MK_REP_MASK
    { int cur = 0, li = 0;
      for (int k = 0; k < NPHASE; ++k) if ((MK_REP_MASK >> (k == 0 ? 0 : 1 + (k - 1) % 13)) & 1) {
          if (k > cur) { a.ph_lo = cur; a.ph_hi = k; a.li = li++; a.pad = 0; hipLaunchKernelGGL(fwd, dim3(grid), dim3(NWAVES * 64), LDS_BYTES, stream, a); }
          for (int r = 1; r < MK_REP_N; ++r) { a.ph_lo = k; a.ph_hi = k + 1; a.li = li++; a.pad = 1; hipLaunchKernelGGL(fwd, dim3(grid), dim3(NWAVES * 64), LDS_BYTES, stream, a); }
          cur = k; }
      a.ph_lo = cur; a.ph_hi = NPHASE; a.li = li++; a.pad = 0; hipLaunchKernelGGL(fwd, dim3(grid), dim3(NWAVES * 64), LDS_BYTES, stream, a); }
#elif defined(MK_TWICE)
    a.ph_lo = 0; a.ph_hi = NPHASE; a.li = 0;
    hipLaunchKernelGGL(fwd, dim3(grid), dim3(NWAVES * 64), LDS_BYTES, stream, a);
    (void)hipMemsetAsync((char*)d_ws + WS_CTL, 0, CTL_ZERO_BYTES, stream);
    hipLaunchKernelGGL(fwd, dim3(grid), dim3(NWAVES * 64), LDS_BYTES, stream, a);
#else
    a.ph_lo = 0; a.ph_hi = NPHASE; a.li = 0;
    hipLaunchKernelGGL(fwd, dim3(grid), dim3(NWAVES * 64), LDS_BYTES, stream, a);
#endif
}
```

```cpp
#include <hip/hip_runtime.h>
#include <cstdio>
#include <cstdint>

#define GAS __attribute__((address_space(1)))
#define LAS __attribute__((address_space(3)))
typedef unsigned short bf16_t;
typedef short bf16x8 __attribute__((ext_vector_type(8)));
typedef short s16x4 __attribute__((ext_vector_type(4)));
typedef float f32x2 __attribute__((ext_vector_type(2)));
typedef float f32x4 __attribute__((ext_vector_type(4)));
typedef float f32x16 __attribute__((ext_vector_type(16)));
typedef unsigned u32x2 __attribute__((ext_vector_type(2)));
typedef unsigned u32x4 __attribute__((ext_vector_type(4)));

constexpr int DM = 1024, NBATCH = 32, SEQ = 2048, NTOK = NBATCH * SEQ;
constexpr int NHEAD = 8, DNOPE = 128, DROPE = 64, DVH = 128, DQH = DNOPE + DROPE, QLR = 512, KVLR = 256;
constexpr int NDOWN = QLR + KVLR + DROPE  , NDOWNP = 1024;
constexpr int NQ = NHEAD * DQH  , NKV = NHEAD * (DNOPE + DVH)  ;
constexpr int FFD = 2688, NEXP = 8, FFE = 1344, FFEP = 1408;
constexpr int PSLOT = (NTOK * 2 / 256 + NEXP) * 256;
constexpr float RMS_EPS = 1e-6f;

__device__ __forceinline__ unsigned cvt_pk_bf16(float lo, float hi) { unsigned r; asm volatile("v_cvt_pk_bf16_f32 %0, %1, %2" : "=v"(r) : "v"(lo), "v"(hi)); return r; }
__device__ __forceinline__ int launder_v(int v) { asm volatile("" : "+v"(v)); return v; }
__device__ __forceinline__ float fp8_rt(float x, float s) { const int p = __builtin_amdgcn_cvt_pk_fp8_f32(x * s, 0.f, 0, false); return __builtin_amdgcn_cvt_f32_fp8(p, 0) * (1.0f / s); }
__device__ __forceinline__ float bf2f(unsigned short b) { return __uint_as_float((unsigned)b << 16); }
__device__ __forceinline__ float bflo(unsigned w) { return __uint_as_float(w << 16); }
__device__ __forceinline__ float bfhi(unsigned w) { return __uint_as_float(w & 0xffff0000u); }

typedef unsigned long long ssq_t;
__device__ __forceinline__ ssq_t ssq_fix(float s) { return (ssq_t)(s * 16777216.0f); }
__device__ __forceinline__ float rstd_n(ssq_t q, float invn) { return __builtin_amdgcn_rsqf(((float)(unsigned)(q >> 32) * 4294967296.0f + (float)(unsigned)q) * (1.0f / 16777216.0f) * invn + RMS_EPS); }
__device__ __forceinline__ float rstd_of(ssq_t q) { return rstd_n(q, 1.0f / DM); }
__device__ __forceinline__ float rstd_f(float ssq) { return __builtin_amdgcn_rsqf(ssq * (1.0f / DM) + RMS_EPS); }

namespace pg8 {
constexpr int BM = 256, BK = 64, HALF = 128, HTB = HALF * BK * 2  , STAGE_BYTES = 8 * HTB, NXCD = 8, WGM = 8;
__host__ __device__ __forceinline__ int lds_byte(int r, int c) { const int st = (r >> 4) * 2 + (c >> 5), rr = r & 15, cc = c & 31, ob = rr * 64 + cc * 2; return st * 1024 + (ob ^ (((ob >> 9) & 1) << 5)); }
__host__ __device__ __forceinline__ void stage_rc(int b, int& R, int& C) { const int st = b / 1024, sb = b % 1024, swz = sb ^ (((sb >> 9) & 1) << 5); R = (st >> 1) * 16 + swz / 64; C = (st & 1) * 32 + (swz % 64) / 2; }
__host__ __device__ __forceinline__ int perm32(int rho) { const int n = rho >> 4, i = rho & 15; return 8 * (i >> 2) + 4 * n + (i & 3); }

struct Unit { const char* a; const char* b; const int* rows; int nrows; int orow; int pn; int aux; };

struct RegOrder {
    const char* A; const char* B; unsigned a_tile, b_tile, a_colstep; int nM, nN, nwg, G, c, rev;
    __device__ __forceinline__ void init(const void* A_, size_t lda_b, const void* B_, size_t ldb_b, int M, int N, int G_, int c_, size_t a_colstep_ = 0) {
        A = (const char*)A_; B = (const char*)B_; a_tile = (unsigned)(256 * lda_b); b_tile = (unsigned)(256 * ldb_b); a_colstep = (unsigned)a_colstep_; nM = M / BM; nN = N / BM; nwg = nM * nN; G = G_; c = c_; rev = 0; }
    __device__ __forceinline__ bool next(int i, Unit& u) const {
        long L = (long)i * G + c; if (L >= nwg) return false;
        if (rev) L = nwg - 1 - L;
        int wgid = (int)L; { const int q = nwg / NXCD, r = nwg % NXCD, xcd = wgid % NXCD, off = wgid / NXCD; wgid = (xcd < r ? xcd * (q + 1) : r * (q + 1) + (xcd - r) * q) + off; }
        const int nig = WGM * nN, gid = wgid / nig, fm = gid * WGM, gsz = (nM - fm) < WGM ? (nM - fm) : WGM;
        const int pm = fm + ((wgid % nig) % gsz), pn = (wgid % nig) / gsz;
        u.a = A + (size_t)pm * a_tile + (size_t)pn * a_colstep; u.b = B + (size_t)pn * b_tile; u.rows = nullptr; u.nrows = 256; u.orow = pm * BM; u.pn = pn; u.aux = 0; return true;
    }
};

template <int RS> struct EpiBf16 {
    static constexpr bool PERM = true;
    bf16_t* O; int ldc; const ssq_t* rs;
    __device__ __forceinline__ void operator()(const f32x4 (&acc)[2][2][4][2], const Unit& u, int wr, int wc, int fr, int fq) const {
        const int row0 = u.orow + wr * 64 + fr, col0 = u.pn * BM + wc * 32 + 8 * fq;
        float sc[2][4]; ssq_t rq[2][4];
#pragma unroll
        for (int ai = 0; ai < 2; ++ai)
#pragma unroll
            for (int m = 0; m < 4; ++m) { const int row = row0 + ai * HALF + m * 16; if constexpr (RS != 0) rq[ai][m] = rs[row]; }
#pragma unroll
        for (int ai = 0; ai < 2; ++ai)
#pragma unroll
            for (int m = 0; m < 4; ++m) { sc[ai][m] = 1.0f; if constexpr (RS == 1) sc[ai][m] = rstd_of(rq[ai][m]); if constexpr (RS == 2) sc[ai][m] = rstd_n(rq[ai][m], 1.0f / KVLR); }
#pragma unroll
        for (int ai = 0; ai < 2; ++ai)
#pragma unroll
            for (int m = 0; m < 4; ++m) { const int row = row0 + ai * HALF + m * 16; bf16_t* rowp = O + (size_t)row * ldc + col0;
#pragma unroll
                for (int bj = 0; bj < 2; ++bj) { const f32x4 v0 = acc[ai][bj][m][0] * sc[ai][m], v1 = acc[ai][bj][m][1] * sc[ai][m];
                    u32x4 w; w.x = cvt_pk_bf16(v0[0], v0[1]); w.y = cvt_pk_bf16(v0[2], v0[3]); w.z = cvt_pk_bf16(v1[0], v1[1]); w.w = cvt_pk_bf16(v1[2], v1[3]);
                    *(u32x4*)(rowp + bj * HALF) = w; } }
    }
};
__device__ __forceinline__ float silu_mul(float g, float u) { return g * u * __builtin_amdgcn_rcpf(1.0f + __builtin_amdgcn_exp2f(-1.4426950408889634f * g)); }
template <int RS> struct EpiSwiglu {
    static constexpr bool PERM = true;
    bf16_t* H; int ldh; const void* rs; const int* list;
    __device__ __forceinline__ void operator()(const f32x4 (&acc)[2][2][4][2], const Unit& u, int wr, int wc, int fr, int fq) const {
        const int r0 = wr * 64 + fr, col0 = u.pn * HALF + wc * 32 + 8 * fq;
        const ssq_t* rsq = (const ssq_t*)rs; const float* rsp = (const float*)rs; if constexpr (RS == 2) rsp = rsp + (u.rows - list);
        float sc[2][4]; ssq_t rq[2][4];
#pragma unroll
        for (int ai = 0; ai < 2; ++ai)
#pragma unroll
            for (int m = 0; m < 4; ++m) { const int r = r0 + ai * HALF + m * 16; if constexpr (RS == 1) rq[ai][m] = rsq[u.orow + r]; else sc[ai][m] = rsp[r]; }
        if constexpr (RS == 1) {
#pragma unroll
            for (int ai = 0; ai < 2; ++ai)
#pragma unroll
                for (int m = 0; m < 4; ++m) sc[ai][m] = rstd_of(rq[ai][m]); }
#pragma unroll
        for (int ai = 0; ai < 2; ++ai)
#pragma unroll
            for (int m = 0; m < 4; ++m) { const int r = r0 + ai * HALF + m * 16; bf16_t* rowp = H + (size_t)(u.orow + r) * ldh + col0; const float s = sc[ai][m];
                const f32x4 g0 = acc[ai][0][m][0] * s, g1 = acc[ai][0][m][1] * s, u0 = acc[ai][1][m][0] * s, u1 = acc[ai][1][m][1] * s;
                u32x4 w; w.x = cvt_pk_bf16(silu_mul(g0[0], u0[0]), silu_mul(g0[1], u0[1])); w.y = cvt_pk_bf16(silu_mul(g0[2], u0[2]), silu_mul(g0[3], u0[3]));
                w.z = cvt_pk_bf16(silu_mul(g1[0], u1[0]), silu_mul(g1[1], u1[1])); w.w = cvt_pk_bf16(silu_mul(g1[2], u1[2]), silu_mul(g1[3], u1[3]));
                __builtin_nontemporal_store(w, (u32x4*)rowp); }
    }
};
constexpr float FP8_SA = 16.0f, FP8_SW = 256.0f, FP8_SH = 16.0f, FP8_SX = 8.0f;
__device__ __forceinline__ unsigned pk4_fp8(float a, float b, float c, float d) { int p = __builtin_amdgcn_cvt_pk_fp8_f32(a, b, 0, false); p = __builtin_amdgcn_cvt_pk_fp8_f32(c, d, p, true); return (unsigned)p; }
template <int RS> struct EpiSwigluF8 {
    static constexpr bool PERM = true;
    unsigned char* H8; int ldh; int pad_tile; const ssq_t* rs;
    __device__ __forceinline__ void operator()(const f32x4 (&acc)[2][2][4][2], const Unit& u, int wr, int wc, int fr, int fq) const {
        const int r0 = wr * 64 + fr, col0 = u.pn * HALF + wc * 32 + 8 * fq;
        float sc[2][4]; ssq_t rq[2][4];
#pragma unroll
        for (int ai = 0; ai < 2; ++ai)
#pragma unroll
            for (int m = 0; m < 4; ++m) { if constexpr (RS == 1) rq[ai][m] = rs[u.orow + r0 + ai * HALF + m * 16]; }
#pragma unroll
        for (int ai = 0; ai < 2; ++ai)
#pragma unroll
            for (int m = 0; m < 4; ++m) { if constexpr (RS == 1) sc[ai][m] = rstd_of(rq[ai][m]) * (1.0f / (FP8_SX * FP8_SW)); else sc[ai][m] = 1.0f / (FP8_SA * FP8_SW); }
#pragma unroll
        for (int ai = 0; ai < 2; ++ai)
#pragma unroll
            for (int m = 0; m < 4; ++m) { const int r = r0 + ai * HALF + m * 16; unsigned char* rowp = H8 + (size_t)(u.orow + r) * ldh + col0; const float s = sc[ai][m];
                const f32x4 g0 = acc[ai][0][m][0] * s, g1 = acc[ai][0][m][1] * s, u0 = acc[ai][1][m][0] * s, u1 = acc[ai][1][m][1] * s;
                u32x2 w; w.x = pk4_fp8(silu_mul(g0[0], u0[0]) * FP8_SH, silu_mul(g0[1], u0[1]) * FP8_SH, silu_mul(g0[2], u0[2]) * FP8_SH, silu_mul(g0[3], u0[3]) * FP8_SH);
                w.y = pk4_fp8(silu_mul(g1[0], u1[0]) * FP8_SH, silu_mul(g1[1], u1[1]) * FP8_SH, silu_mul(g1[2], u1[2]) * FP8_SH, silu_mul(g1[3], u1[3]) * FP8_SH);
                __builtin_nontemporal_store(w, (u32x2*)rowp);
                if (u.pn == pad_tile) *(u32x2*)(rowp + HALF) = (u32x2){0u, 0u}; }
    }
};
struct EpiBf16Scaled {
    static constexpr bool PERM = true;
    bf16_t* O; int ldc; float scale;
    __device__ __forceinline__ void operator()(const f32x4 (&acc)[2][2][4][2], const Unit& u, int wr, int wc, int fr, int fq) const {
        const int row0 = u.orow + wr * 64 + fr, col0 = u.pn * BM + wc * 32 + 8 * fq;
#pragma unroll
        for (int ai = 0; ai < 2; ++ai)
#pragma unroll
            for (int m = 0; m < 4; ++m) { bf16_t* rowp = O + (size_t)(row0 + ai * HALF + m * 16) * ldc + col0;
#pragma unroll
                for (int bj = 0; bj < 2; ++bj) { const f32x4 v0 = acc[ai][bj][m][0] * scale, v1 = acc[ai][bj][m][1] * scale;
                    u32x4 w; w.x = cvt_pk_bf16(v0[0], v0[1]); w.y = cvt_pk_bf16(v0[2], v0[3]); w.z = cvt_pk_bf16(v1[0], v1[1]); w.w = cvt_pk_bf16(v1[2], v1[3]);
                    *(u32x4*)(rowp + bj * HALF) = w; } }
    }
};
struct EpiNull {
    static constexpr bool PERM = true;
    float* sink;
    __device__ __forceinline__ void operator()(const f32x4 (&acc)[2][2][4][2], const Unit& u, int wr, int wc, int fr, int fq) const {
        float s = 0.f;
#pragma unroll
        for (int ai = 0; ai < 2; ++ai)
#pragma unroll
            for (int bj = 0; bj < 2; ++bj)
#pragma unroll
                for (int m = 0; m < 4; ++m)
#pragma unroll
                    for (int n = 0; n < 2; ++n) s += acc[ai][bj][m][n][0];
        if (s == 12345.678f) sink[0] = s;
    }
};
template <bool W8> struct EpiResidH {
    static constexpr bool PERM = true;
    const bf16_t* hin; bf16_t* hout; ssq_t* ssq; unsigned char* h8; float scale;
    __device__ __forceinline__ void operator()(const f32x4 (&acc)[2][2][4][2], const Unit& u, int wr, int wc, int fr, int fq) const {
        const int row0 = u.orow + wr * 64 + fr, col0 = u.pn * BM + wc * 32 + 8 * fq;
        float part[2][4];
#pragma unroll
        for (int ai = 0; ai < 2; ++ai) {
            u32x4 hv[4][2];
#pragma unroll
            for (int m = 0; m < 4; ++m)
#pragma unroll
                for (int bj = 0; bj < 2; ++bj) hv[m][bj] = *(const u32x4*)(hin + (size_t)(row0 + ai * HALF + m * 16) * DM + col0 + bj * HALF);
#pragma unroll
            for (int m = 0; m < 4; ++m) { const int row = row0 + ai * HALF + m * 16; const size_t off = (size_t)row * DM + col0; float pt = 0.f;
#pragma unroll
                for (int bj = 0; bj < 2; ++bj) { const u32x4 h4 = hv[m][bj]; const f32x4 a0 = acc[ai][bj][m][0] * scale, a1 = acc[ai][bj][m][1] * scale;
                    const float y0 = bflo(h4.x) + a0[0], y1 = bfhi(h4.x) + a0[1], y2 = bflo(h4.y) + a0[2], y3 = bfhi(h4.y) + a0[3], y4 = bflo(h4.z) + a1[0], y5 = bfhi(h4.z) + a1[1], y6 = bflo(h4.w) + a1[2], y7 = bfhi(h4.w) + a1[3];
                    pt += (y0 * y0 + y1 * y1) + (y2 * y2 + y3 * y3) + (y4 * y4 + y5 * y5) + (y6 * y6 + y7 * y7);
                    u32x4 w; w.x = cvt_pk_bf16(y0, y1); w.y = cvt_pk_bf16(y2, y3); w.z = cvt_pk_bf16(y4, y5); w.w = cvt_pk_bf16(y6, y7);
                    *(u32x4*)(hout + off + bj * HALF) = w;
                    if constexpr (W8) { u32x2 q; q.x = pk4_fp8(y0 * FP8_SX, y1 * FP8_SX, y2 * FP8_SX, y3 * FP8_SX); q.y = pk4_fp8(y4 * FP8_SX, y5 * FP8_SX, y6 * FP8_SX, y7 * FP8_SX); *(u32x2*)(h8 + off + bj * HALF) = q; } }
                pt += __shfl_xor(pt, 16); pt += __shfl_xor(pt, 32); part[ai][m] = pt; }
        }
        if (fq == 0) {
#pragma unroll
            for (int ai = 0; ai < 2; ++ai)
#pragma unroll
                for (int m = 0; m < 4; ++m) atomicAdd(ssq + row0 + ai * HALF + m * 16, ssq_fix(part[ai][m])); }
    }
};
struct EpiDown {
    static constexpr bool PERM = true;
    bf16_t* O; bf16_t* KR; const ssq_t* rs; ssq_t* ssq_q; ssq_t* ssq_kv; const float* cosT; const float* sinT;
    __device__ __forceinline__ void operator()(const f32x4 (&acc)[2][2][4][2], const Unit& u, int wr, int wc, int fr, int fq) const {
        const int row0 = u.orow + wr * 64 + fr;
        float sc[2][4]; ssq_t rq[2][4];
#pragma unroll
        for (int ai = 0; ai < 2; ++ai)
#pragma unroll
            for (int m = 0; m < 4; ++m) rq[ai][m] = rs[row0 + ai * HALF + m * 16];
#pragma unroll
        for (int ai = 0; ai < 2; ++ai)
#pragma unroll
            for (int m = 0; m < 4; ++m) sc[ai][m] = rstd_of(rq[ai][m]);
        if (u.pn < 3) {
            ssq_t* sq = u.pn < 2 ? ssq_q : ssq_kv; const int col0 = u.pn * BM + wc * 32 + 8 * fq; float pts[2][4];
#pragma unroll
            for (int ai = 0; ai < 2; ++ai)
#pragma unroll
                for (int m = 0; m < 4; ++m) { const int row = row0 + ai * HALF + m * 16; bf16_t* rowp = O + (size_t)row * NDOWNP + col0; const float s = sc[ai][m]; float part = 0.f;
#pragma unroll
                    for (int bj = 0; bj < 2; ++bj) { const f32x4 v0 = acc[ai][bj][m][0] * s, v1 = acc[ai][bj][m][1] * s;
                        part += (v0[0] * v0[0] + v0[1] * v0[1]) + (v0[2] * v0[2] + v0[3] * v0[3]) + (v1[0] * v1[0] + v1[1] * v1[1]) + (v1[2] * v1[2] + v1[3] * v1[3]);
                        u32x4 w; w.x = cvt_pk_bf16(v0[0], v0[1]); w.y = cvt_pk_bf16(v0[2], v0[3]); w.z = cvt_pk_bf16(v1[0], v1[1]); w.w = cvt_pk_bf16(v1[2], v1[3]);
                        *(u32x4*)(rowp + bj * HALF) = w; }
                    part += __shfl_xor(part, 16); part += __shfl_xor(part, 32); pts[ai][m] = part; }
            if (fq == 0) {
#pragma unroll
                for (int ai = 0; ai < 2; ++ai)
#pragma unroll
                    for (int m = 0; m < 4; ++m) atomicAdd(sq + row0 + ai * HALF + m * 16, ssq_fix(pts[ai][m])); }
        } else if (wc == 0) {
#pragma unroll
            for (int aq = 0; aq < 4; ++aq) { const int ai = aq >> 1, mb = (aq & 1) * 2; f32x4 ct[4][2], st[4][2];
#pragma unroll
                for (int m = mb; m < mb + 2; ++m) { const size_t to = (size_t)(row0 + ai * HALF + m * 16) * 32 + 8 * fq;
                    ct[m][0] = *(const f32x4*)(cosT + to); ct[m][1] = *(const f32x4*)(cosT + to + 4); st[m][0] = *(const f32x4*)(sinT + to); st[m][1] = *(const f32x4*)(sinT + to + 4); }
#pragma unroll
                for (int m = mb; m < mb + 2; ++m) { const int row = row0 + ai * HALF + m * 16; const float s = sc[ai][m];
                    const f32x4 a0 = acc[ai][0][m][0] * s, a1 = acc[ai][0][m][1] * s, b0 = acc[ai][1][m][0] * s, b1 = acc[ai][1][m][1] * s;
                    const f32x4 x0 = a0 * ct[m][0] - b0 * st[m][0], x1 = a1 * ct[m][1] - b1 * st[m][1], y0 = b0 * ct[m][0] + a0 * st[m][0], y1 = b1 * ct[m][1] + a1 * st[m][1];
                    bf16_t* rp = KR + (size_t)row * DROPE + 8 * fq;
                    u32x4 w; w.x = cvt_pk_bf16(x0[0], x0[1]); w.y = cvt_pk_bf16(x0[2], x0[3]); w.z = cvt_pk_bf16(x1[0], x1[1]); w.w = cvt_pk_bf16(x1[2], x1[3]);
                    *(u32x4*)rp = w;
                    w.x = cvt_pk_bf16(y0[0], y0[1]); w.y = cvt_pk_bf16(y0[2], y0[3]); w.z = cvt_pk_bf16(y1[0], y1[1]); w.w = cvt_pk_bf16(y1[2], y1[3]);
                    *(u32x4*)(rp + 32) = w; } }
        }
    }
};
struct EpiQ {
    static constexpr bool PERM = true;
    bf16_t* Q; const float* cosT; const float* sinT; const ssq_t* rs;
    __device__ __forceinline__ void operator()(const f32x4 (&acc)[2][2][4][2], const Unit& u, int wr, int wc, int fr, int fq) const {
        const int row0 = u.orow + wr * 64 + fr;
        float sc[2][4]; ssq_t rq[2][4];
#pragma unroll
        for (int ai = 0; ai < 2; ++ai)
#pragma unroll
            for (int m = 0; m < 4; ++m) rq[ai][m] = rs[row0 + ai * HALF + m * 16];
#pragma unroll
        for (int ai = 0; ai < 2; ++ai)
#pragma unroll
            for (int m = 0; m < 4; ++m) sc[ai][m] = rstd_n(rq[ai][m], 1.0f / QLR);
        if (u.pn < 2) {
            const int h = 4 * u.pn + wc;
#pragma unroll
            for (int aq = 0; aq < 4; ++aq) { const int ai = aq >> 1, mb = (aq & 1) * 2; f32x4 ct[4][2], st[4][2];
#pragma unroll
                for (int m = mb; m < mb + 2; ++m) { const size_t to = (size_t)(row0 + ai * HALF + m * 16) * 32 + 8 * fq;
                    ct[m][0] = *(const f32x4*)(cosT + to); ct[m][1] = *(const f32x4*)(cosT + to + 4); st[m][0] = *(const f32x4*)(sinT + to); st[m][1] = *(const f32x4*)(sinT + to + 4); }
#pragma unroll
                for (int m = mb; m < mb + 2; ++m) { const int row = row0 + ai * HALF + m * 16; const float s = sc[ai][m];
                    const f32x4 a0 = acc[ai][0][m][0] * s, a1 = acc[ai][0][m][1] * s, b0 = acc[ai][1][m][0] * s, b1 = acc[ai][1][m][1] * s;
                    const f32x4 x0 = a0 * ct[m][0] - b0 * st[m][0], x1 = a1 * ct[m][1] - b1 * st[m][1], y0 = b0 * ct[m][0] + a0 * st[m][0], y1 = b1 * ct[m][1] + a1 * st[m][1];
                    bf16_t* rp = Q + (size_t)row * NQ + h * DQH + DNOPE + 8 * fq;
                    u32x4 w; w.x = cvt_pk_bf16(x0[0], x0[1]); w.y = cvt_pk_bf16(x0[2], x0[3]); w.z = cvt_pk_bf16(x1[0], x1[1]); w.w = cvt_pk_bf16(x1[2], x1[3]);
                    *(u32x4*)rp = w;
                    w.x = cvt_pk_bf16(y0[0], y0[1]); w.y = cvt_pk_bf16(y0[2], y0[3]); w.z = cvt_pk_bf16(y1[0], y1[1]); w.w = cvt_pk_bf16(y1[2], y1[3]);
                    *(u32x4*)(rp + 32) = w; } }
        } else {
#pragma unroll
            for (int ai = 0; ai < 2; ++ai)
#pragma unroll
                for (int m = 0; m < 4; ++m) { const int row = row0 + ai * HALF + m * 16; const float s = sc[ai][m];
#pragma unroll
                    for (int bj = 0; bj < 2; ++bj) { const int h = 2 * (u.pn - 2) + bj; const f32x4 v0 = acc[ai][bj][m][0] * s, v1 = acc[ai][bj][m][1] * s;
                        u32x4 w; w.x = cvt_pk_bf16(v0[0], v0[1]); w.y = cvt_pk_bf16(v0[2], v0[3]); w.z = cvt_pk_bf16(v1[0], v1[1]); w.w = cvt_pk_bf16(v1[2], v1[3]);
                        *(u32x4*)(Q + (size_t)row * NQ + h * DQH + wc * 32 + 8 * fq) = w; } }
        }
    }
};

__device__ __forceinline__ unsigned gather_off(const Unit& u, int idx, unsigned lda_b, unsigned cb) { const int tok = idx < u.nrows ? u.rows[idx] : 0; return (unsigned)tok * lda_b + cb; }
__device__ __forceinline__ u32x4 gather_offs(const Unit& u, int tid, unsigned lda_b) {
    const int t2 = launder_v(tid); int R0, C0, R1, C1; stage_rc(t2 * 16, R0, C0); stage_rc(t2 * 16 + 8192, R1, C1);
    u32x4 pk; pk.x = gather_off(u, R0, lda_b, (unsigned)C0 * 2u); pk.y = gather_off(u, R1, lda_b, (unsigned)C1 * 2u); pk.z = gather_off(u, HALF + R0, lda_b, (unsigned)C0 * 2u); pk.w = gather_off(u, HALF + R1, lda_b, (unsigned)C1 * 2u);
    return pk;
}
typedef int i32x4 __attribute__((ext_vector_type(4)));
typedef int i32x8 __attribute__((ext_vector_type(8)));
template <class Epi, class Sched, bool GATHER, bool FP8 = false>
__device__ __forceinline__ void gemm_phase(LAS unsigned char* lds, const unsigned lda_b, const unsigned ldb_b, const int Kb, const Sched& S, const Epi& E, const unsigned stag_ticks = 0u) {
    if (stag_ticks) { const unsigned long long t0 = __builtin_amdgcn_s_memrealtime(), dl = (unsigned long long)((blockIdx.x >> 3) & 3u) * stag_ticks;
        while (__builtin_amdgcn_s_memrealtime() - t0 < dl) __builtin_amdgcn_s_sleep(8); }
    const int tid = launder_v((int)threadIdx.x), wid = __builtin_amdgcn_readfirstlane(tid >> 6), lane = tid & 63, wr = wid >> 2, wc = wid & 3, fr = lane & 15, fq = lane >> 4;
    int nt = Kb / (BK * 2); asm volatile("" : "+s"(nt));
    unsigned voffA[2], voffB[2];
#pragma unroll
    for (int i = 0; i < 2; ++i) { int R, C; stage_rc(tid * 16 + i * 8192, R, C); const int Rb = Epi::PERM ? ((R & ~31) + perm32(R & 31)) : R;
        voffA[i] = (unsigned)R * lda_b + (unsigned)C * 2u; voffB[i] = (unsigned)Rb * ldb_b + (unsigned)C * 2u; }
    const size_t kstep = (size_t)(BK * 2);
    const size_t hstepA = (size_t)HALF * lda_b, hstepB = (size_t)HALF * ldb_b;
    const unsigned ldsw = (unsigned)wid * 1024u;
    const int aoff = lds_byte(wr * 64 + fr, fq * 8), boff = lds_byte(wc * 32 + fr, fq * 8);
    unsigned cv0[2] = {0u, 0u}, cv1[2] = {0u, 0u}, nv0[2] = {0u, 0u}, nv1[2] = {0u, 0u};
#define PG8_SA(b, h) (((b) * 2 + (h)) * HTB)
#define PG8_SB(b, h) ((4 + (b) * 2 + (h)) * HTB)
#define PG8_LOAD16(gp, ldsoff) __builtin_amdgcn_global_load_lds((const unsigned*)(gp), (LAS unsigned*)(lds + (ldsoff)), 16, 0, 0)
#define PG8_STAGE_B(bufoff, gbase, h) do { _Pragma("unroll") for (int _i = 0; _i < 2; ++_i) PG8_LOAD16((gbase) + (h) * hstepB + voffB[_i], (bufoff) + ldsw + _i * 8192); } while (0)
#define PG8_STAGE_A(bufoff, gbase, h, usenext) do { _Pragma("unroll") for (int _i = 0; _i < 2; ++_i) { unsigned _vo; \
        if constexpr (GATHER) { _vo = (usenext) ? ((h) ? nv1[_i] : nv0[_i]) : ((h) ? cv1[_i] : cv0[_i]); } else { _vo = voffA[_i] + (unsigned)((h) * hstepA); } \
        PG8_LOAD16((gbase) + _vo, (bufoff) + ldsw + _i * 8192); } } while (0)
#define PG8_LD32(off) __builtin_shufflevector(*(const LAS i32x4*)(lds + (off)), *(const LAS i32x4*)(lds + (off) + 1024), 0, 1, 2, 3, 4, 5, 6, 7)
#define PG8_LDA(dst, b, h) do { _Pragma("unroll") for (int m = 0; m < 4; ++m) { if constexpr (FP8) { dst##8[m] = PG8_LD32(PG8_SA(b, h) + aoff + m * 2048); } else { _Pragma("unroll") for (int k = 0; k < 2; ++k) dst[m][k] = *(const LAS bf16x8*)(lds + PG8_SA(b, h) + aoff + m * 2048 + k * 1024); } } } while (0)
#define PG8_LDB(dst, b, h) do { _Pragma("unroll") for (int n = 0; n < 2; ++n) { if constexpr (FP8) { dst##8[n] = PG8_LD32(PG8_SB(b, h) + boff + n * 2048); } else { _Pragma("unroll") for (int k = 0; k < 2; ++k) dst[n][k] = *(const LAS bf16x8*)(lds + PG8_SB(b, h) + boff + n * 2048 + k * 1024); } } } while (0)
#define PG8_MMA(ai, bj, At, Bt) do { __builtin_amdgcn_s_setprio(1); _Pragma("unroll") for (int m = 0; m < 4; ++m) _Pragma("unroll") for (int n = 0; n < 2; ++n) { \
        if constexpr (FP8) { asm volatile("v_mfma_f32_16x16x128_f8f6f4 %0, %1, %2, %0" : "+v"(acc[ai][bj][m][n]) : "v"(Bt##8[n]), "v"(At##8[m])); }     \
        else { _Pragma("unroll") for (int k = 0; k < 2; ++k) acc[ai][bj][m][n] = __builtin_amdgcn_mfma_f32_16x16x32_bf16(Bt[n][k], At[m][k], acc[ai][bj][m][n], 0, 0, 0); } } \
        __builtin_amdgcn_s_setprio(0); } while (0)
#define PG8_WAIT_V(n) asm volatile("s_waitcnt vmcnt(" #n ")" ::: "memory")
#define PG8_WAIT_L(n) asm volatile("s_waitcnt lgkmcnt(" #n ")" ::: "memory")
#define PG8_BAR __builtin_amdgcn_s_barrier()
#define PG8_SCHED __builtin_amdgcn_sched_barrier(0)
    Unit cur, nxt; int ui = 0;
    if (!S.next(0, cur)) return;
    f32x4 acc[2][2][4][2];
#pragma unroll
    for (int a = 0; a < 2; ++a)
#pragma unroll
        for (int b = 0; b < 2; ++b)
#pragma unroll
            for (int m = 0; m < 4; ++m)
#pragma unroll
                for (int n = 0; n < 2; ++n) acc[a][b][m][n] = (f32x4){0.f, 0.f, 0.f, 0.f};
    bf16x8 At[4][2], B0[2][2], B1[2][2]; i32x8 At8[4], B08[2], B18[2];
    const char* cA = cur.a; const char* cB = cur.b;
    if constexpr (GATHER) { const u32x4 pk = gather_offs(cur, tid, lda_b); cv0[0] = pk.x; cv0[1] = pk.y; cv1[0] = pk.z; cv1[1] = pk.w; }
    PG8_STAGE_B(PG8_SB(0, 0), cB, 0); PG8_STAGE_B(PG8_SB(0, 1), cB, 1); PG8_STAGE_A(PG8_SA(0, 0), cA, 0, false); PG8_STAGE_A(PG8_SA(0, 1), cA, 1, false);
    if (wr == 1) PG8_BAR;
    PG8_WAIT_V(2); PG8_BAR;
    PG8_STAGE_B(PG8_SB(1, 0), cB + kstep, 0); PG8_STAGE_A(PG8_SA(1, 0), cA + kstep, 0, false); PG8_STAGE_B(PG8_SB(1, 1), cB + kstep, 1);
    PG8_WAIT_V(6); PG8_BAR;
    for (;;) {
        const bool has_next = S.next(ui + 1, nxt);
        const char* nA = has_next ? nxt.a : cA; const char* nB = has_next ? nxt.b : cB;
        if constexpr (GATHER) {
            u32x4 pk = (u32x4){cv0[0], cv0[1], cv1[0], cv1[1]}; if (has_next) pk = gather_offs(nxt, tid, lda_b);
            *(LAS u32x4*)(lds + STAGE_BYTES + 1024 + tid * 16) = pk;
        }
#pragma nounroll
        for (int t = 0; t < nt; t += 2) {
            const bool last = (t == nt - 2);
            if constexpr (GATHER) { if (last) { const u32x4 pk = *(const LAS u32x4*)(lds + STAGE_BYTES + 1024 + tid * 16); nv0[0] = pk.x; nv0[1] = pk.y; nv1[0] = pk.z; nv1[1] = pk.w; } }
            const char* a1 = cA + (size_t)(t + 1) * kstep;
            const char* a2 = last ? nA : cA + (size_t)(t + 2) * kstep; const char* b2 = last ? nB : cB + (size_t)(t + 2) * kstep;
            const char* a3 = a2 + kstep; const char* b3 = b2 + kstep;
            PG8_LDB(B0, 0, 0); PG8_LDB(B1, 0, 1); PG8_SCHED; PG8_LDA(At, 0, 0); PG8_STAGE_A(PG8_SA(1, 1), a1, 1, false);
            PG8_WAIT_V(8); PG8_WAIT_L(0); PG8_BAR; PG8_MMA(0, 0, At, B0); PG8_MMA(0, 1, At, B1); PG8_BAR; PG8_SCHED;
            PG8_LDA(At, 0, 1); PG8_STAGE_B(PG8_SB(0, 0), b2, 0); PG8_STAGE_B(PG8_SB(0, 1), b2, 1); PG8_STAGE_A(PG8_SA(0, 0), a2, 0, last);
            PG8_WAIT_V(8); PG8_WAIT_L(0); PG8_BAR; PG8_MMA(1, 0, At, B0); PG8_MMA(1, 1, At, B1); PG8_BAR; PG8_SCHED;
            PG8_LDB(B0, 1, 0); PG8_LDB(B1, 1, 1); PG8_SCHED; PG8_LDA(At, 1, 0); PG8_STAGE_A(PG8_SA(0, 1), a2, 1, last);
            PG8_WAIT_V(8); PG8_WAIT_L(0); PG8_BAR; PG8_MMA(0, 0, At, B0); PG8_MMA(0, 1, At, B1); PG8_BAR; PG8_SCHED;
            PG8_LDA(At, 1, 1); PG8_STAGE_B(PG8_SB(1, 0), b3, 0); PG8_STAGE_B(PG8_SB(1, 1), b3, 1); PG8_STAGE_A(PG8_SA(1, 0), a3, 0, last);
            PG8_WAIT_V(8); PG8_WAIT_L(0); PG8_BAR; PG8_MMA(1, 0, At, B0); PG8_MMA(1, 1, At, B1); PG8_BAR; PG8_SCHED;
        }
        if (wr == 0) PG8_BAR;
        if constexpr (FP8) asm volatile("s_nop 15\n\ts_nop 15" ::: "memory");
        E(acc, cur, wr, wc, fr, fq);
        if (!has_next) break;
#pragma unroll
        for (int a = 0; a < 2; ++a)
#pragma unroll
            for (int b = 0; b < 2; ++b)
#pragma unroll
                for (int m = 0; m < 4; ++m)
#pragma unroll
                    for (int n = 0; n < 2; ++n) acc[a][b][m][n] = (f32x4){0.f, 0.f, 0.f, 0.f};
        cur = nxt; cA = nA; cB = nB; ++ui;
        if constexpr (GATHER) {
#pragma unroll
            for (int i = 0; i < 2; ++i) { cv0[i] = nv0[i]; cv1[i] = nv1[i]; }
        }
        if (wr == 1) PG8_BAR;
    }
    PG8_WAIT_V(0);
    PG8_BAR;
#undef PG8_SA
#undef PG8_SB
#undef PG8_LOAD16
#undef PG8_STAGE_A
#undef PG8_STAGE_B
#undef PG8_LDA
#undef PG8_LDB
#undef PG8_LD32
#undef PG8_MMA
#undef PG8_WAIT_V
#undef PG8_WAIT_L
#undef PG8_BAR
#undef PG8_SCHED
}
}
namespace att {
constexpr int NW = 8, QBLK = 32, KVBLK = 64, QB = NW * QBLK;
constexpr int DQK = 192, DV = 128;
constexpr int QS = NQ, KNS = NKV, KRS = DROPE, OS = DM;
constexpr int SHM_V = KVBLK * DV * 2, SHM_K = KVBLK * DQK * 2;
constexpr int LDS_QR = 2 * SHM_V + 2 * SHM_K + NW * 64 * 4;
constexpr int LDS_BYTES = LDS_QR + NW * 4096;
constexpr float SCALE = 0.07216878364870322f;
constexpr float THR = 8.f;
#define KSWZ(row, ch) ((row) * 384 + ((((ch) ^ (((row) >> 1) & 7))) << 4))
#define SBAR() __builtin_amdgcn_sched_barrier(0)
__device__ __forceinline__ int v_st(int k, int c) { const int kk = (k & ~0xC) | ((k & 4) << 1) | ((k & 8) >> 1); return ((kk >> 3) * 4 + (c >> 5)) * 512 + ((kk & 7) * 32 + (c & 31)) * 2; }
__device__ __forceinline__ int v_rd_base(int lane) { return ((lane & 3) << 3) | (((lane >> 2) & 3) << 6) | (((lane >> 4) & 1) << 5) | (((lane >> 5) & 1) << 8); }
constexpr int v_rd_off(int d0, int ks, int half) { return d0 * 512 + ks * 4096 + half * 2048; }
__device__ __forceinline__ int crow(int r, int hi) { return (r & 3) + 8 * (r >> 2) + 4 * hi; }
__device__ __forceinline__ void mask_tile(f32x16& p0, f32x16& p1, int dq) {
    const float NEG = -__builtin_inff();
#pragma unroll
    for (int r = 0; r < 16; ++r) {
        const int c = (r & 3) + 8 * (r >> 2);
        if (dq - c < 0) p0[r] = NEG;
        if (dq - c - 32 < 0) p1[r] = NEG;
    }
}
__device__ __forceinline__ void partialSM(f32x16& p0, f32x16& p1, float& m_reg, float& mn, float& alpha) {
    float pmax = p0[0]; for (int r = 1; r < 16; ++r) pmax = fmaxf(pmax, p0[r]); for (int r = 0; r < 16; ++r) pmax = fmaxf(pmax, p1[r]);
    { auto rr = __builtin_amdgcn_permlane32_swap(__float_as_uint(pmax), __float_as_uint(pmax), false, false);
      pmax = fmaxf(__uint_as_float(rr[0]), __uint_as_float(rr[1])); }
    constexpr float C2 = 1.4426950408889634f * SCALE;
    if (__builtin_expect(__all((pmax - m_reg) * SCALE <= THR), 1)) { mn = m_reg; alpha = 1.f; }
    else { mn = fmaxf(m_reg, pmax); alpha = __builtin_amdgcn_exp2f((m_reg - mn) * C2); m_reg = mn; }
    const float mnL = -mn * C2;
    for (int r = 0; r < 16; ++r) p0[r] = fmaf(p0[r], C2, mnL); for (int r = 0; r < 16; ++r) p1[r] = fmaf(p1[r], C2, mnL);
    for (int r = 0; r < 16; ++r) p0[r] = __builtin_amdgcn_exp2f(p0[r]);
}
__device__ __forceinline__ void finishSM(f32x16& p0, f32x16& p1, float alpha, float& l_reg, bf16x8& pa0, bf16x8& pa1, bf16x8& pa2, bf16x8& pa3) {
    for (int r = 0; r < 16; ++r) p1[r] = __builtin_amdgcn_exp2f(p1[r]);
    float ps = 0; for (int r = 0; r < 16; ++r) ps += p0[r]; for (int r = 0; r < 16; ++r) ps += p1[r];
    { auto rr = __builtin_amdgcn_permlane32_swap(__float_as_uint(ps), __float_as_uint(ps), false, false);
      ps = __uint_as_float(rr[0]) + __uint_as_float(rr[1]); }
    l_reg = l_reg * alpha + ps;
#define PK4(P, B_, OUT) do { unsigned a0 = cvt_pk_bf16(P[B_+0], P[B_+1]), a1 = cvt_pk_bf16(P[B_+2], P[B_+3]);                          \
        unsigned b0 = cvt_pk_bf16(P[B_+4], P[B_+5]), b1 = cvt_pk_bf16(P[B_+6], P[B_+7]);                                             \
        auto r0 = __builtin_amdgcn_permlane32_swap(a0, b0, false, false); auto r1 = __builtin_amdgcn_permlane32_swap(a1, b1, false, false); \
        u32x4 w = {r0[0], r1[0], r0[1], r1[1]}; OUT = *reinterpret_cast<bf16x8*>(&w); } while (0)
    PK4(p0, 0, pa0); PK4(p0, 8, pa1); PK4(p1, 0, pa2); PK4(p1, 8, pa3);
#undef PK4
}
template <int KB>
__device__ __forceinline__ void qkt(f32x16& p0, f32x16& p1, const char* K_lds, int r32, int hi, const bf16x8* qr, const char* qrl) {
    p0 = f32x16{}; p1 = f32x16{};
    const char* kb[4];
#pragma unroll
    for (int dd = 0; dd < 4; ++dd) kb[dd] = K_lds + KB * SHM_K + KSWZ(r32, dd * 2 + hi);
#pragma unroll
    for (int d0 = 0; d0 < 12; ++d0) { const char* a = kb[d0 & 3] + (d0 >> 2) * 128;
        bf16x8 b0 = *reinterpret_cast<const bf16x8*>(a);
        bf16x8 b1 = *reinterpret_cast<const bf16x8*>(a + 32 * 384);
        const bf16x8 qf = d0 < 8 ? qr[d0 & 7] : *reinterpret_cast<const bf16x8*>(qrl + (d0 - 8) * 1024);
        p0 = __builtin_amdgcn_mfma_f32_32x32x16_bf16(b0, qf, p0, 0, 0, 0);
        p1 = __builtin_amdgcn_mfma_f32_32x32x16_bf16(b1, qf, p1, 0, 0, 0);
        if ((d0 & 3) == 3 && d0 < 11) SBAR(); }
}
template <int VB>
__device__ __forceinline__ void pv_tile(f32x16* o, int vb0, bf16x8 pa0, bf16x8 pa1, bf16x8 pa2, bf16x8 pa3) {
#define TRRD(dst, off) asm volatile("ds_read_b64_tr_b16 %0, %1 offset:%2" : "=&v"(dst) : "v"(vb0), "i"(off) : "memory")
#define PV_D0(d0) do { s16x4 l0, l1, l2, l3, h0, h1, h2, h3; constexpr int b_ = VB * SHM_V + v_rd_off(d0, 0, 0); \
        TRRD(l0, b_); TRRD(h0, b_ + 2048); TRRD(l1, b_ + 4096); TRRD(h1, b_ + 6144); TRRD(l2, b_ + 8192); TRRD(h2, b_ + 10240); TRRD(l3, b_ + 12288); TRRD(h3, b_ + 14336); \
        asm volatile("s_waitcnt lgkmcnt(0)" ::: "memory"); SBAR();   \
        o[d0] = __builtin_amdgcn_mfma_f32_32x32x16_bf16(pa0, (bf16x8){l0[0], l0[1], l0[2], l0[3], h0[0], h0[1], h0[2], h0[3]}, o[d0], 0, 0, 0);   \
        o[d0] = __builtin_amdgcn_mfma_f32_32x32x16_bf16(pa1, (bf16x8){l1[0], l1[1], l1[2], l1[3], h1[0], h1[1], h1[2], h1[3]}, o[d0], 0, 0, 0);   \
        o[d0] = __builtin_amdgcn_mfma_f32_32x32x16_bf16(pa2, (bf16x8){l2[0], l2[1], l2[2], l2[3], h2[0], h2[1], h2[2], h2[3]}, o[d0], 0, 0, 0);   \
        o[d0] = __builtin_amdgcn_mfma_f32_32x32x16_bf16(pa3, (bf16x8){l3[0], l3[1], l3[2], l3[3], h3[0], h3[1], h3[2], h3[3]}, o[d0], 0, 0, 0); } while (0)
    PV_D0(0); PV_D0(1); PV_D0(2); PV_D0(3);
#undef PV_D0
#undef TRRD
}
struct BlockRef { const bf16_t* Q; const bf16_t* Kn; const bf16_t* Kr; const bf16_t* V; bf16_t* O; int P0; };
struct Seam { bf16x8 qr[8]; bf16x8 st_v0, st_v1, st_k0, st_k1, st_k2; };
#define VMW() asm volatile("s_waitcnt vmcnt(0)" ::: "memory")
#define VMWN(n) asm volatile("s_waitcnt vmcnt(%0)" :: "i"(n) : "memory")
#define LD8(p) (*reinterpret_cast<const bf16x8*>(p))
#define SLOAD_H(R_, k0) do { S.st_v0 = LD8((R_).V + (size_t)((k0) + sr) * KNS + sc); S.st_v1 = LD8((R_).V + (size_t)((k0) + 32 + sr) * KNS + sc);              \
                             S.st_k0 = LD8((R_).Kn + (size_t)((k0) + sr) * KNS + sc); S.st_k1 = LD8((R_).Kn + (size_t)((k0) + 32 + sr) * KNS + sc);            \
                             S.st_k2 = LD8((R_).Kr + (size_t)((k0) + rr) * KRS + rc); } while (0)
#define SWRITE_HK(bf) do { *(bf16x8*)(K_lds + (bf) * SHM_K + kws) = S.st_k0; *(bf16x8*)(K_lds + (bf) * SHM_K + kws + 32 * 384) = S.st_k1; *(bf16x8*)(K_lds + (bf) * SHM_K + kws2) = S.st_k2; } while (0)
#define SWRITE_HV(bf) do { *(bf16x8*)(V_lds + (bf) * SHM_V + vst0) = S.st_v0; *(bf16x8*)(V_lds + (bf) * SHM_V + vst1) = S.st_v1; } while (0)
#define SWRITE_H(bf) do { SWRITE_HV(bf); SWRITE_HK(bf); } while (0)
#define ATT_IDX const int tid = launder_v((int)threadIdx.x), wid = __builtin_amdgcn_readfirstlane(tid >> 6), lane = tid & 63, r32 = lane & 31, hi = lane >> 5; \
    const int sr = tid >> 4, sc = (tid & 15) * 8, rr = tid >> 3, rc = (tid & 7) * 8, kws = KSWZ(sr, (tid & 15)), kws2 = KSWZ(rr, 16 + (tid & 7));
__device__ __forceinline__ void attn_block(const BlockRef& cur, char* lds) {
    ATT_IDX;
    Seam S;
    const int NT = cur.P0 / KVBLK + QB / KVBLK;
    const int qlo = cur.P0 + wid * QBLK, qm = qlo + r32 - 4 * hi;
    char* V_lds = lds; char* K_lds = lds + 2 * SHM_V;
    float* ws = (float*)(lds + 2 * SHM_V + 2 * SHM_K) + wid * 64; float* li_l = ws, * al_l = ws + 32;
    float m_reg = -1e30f, l_reg = 0; f32x16 o[4] = {};
    const int vst0 = v_st(sr, sc), vst1 = v_st(32 + sr, sc);
    const int vb0 = (int)(uintptr_t)V_lds + v_rd_base(lane);
    char* qrl = lds + LDS_QR + wid * 4096 + lane * 16;
#define RESC(a) do { if (__any((a) < 1.f)) { if (hi == 0) al_l[r32] = (a); asm volatile("s_waitcnt lgkmcnt(0)" ::: "memory");              \
                     for (int d_ = 0; d_ < 4; ++d_) for (int r = 0; r < 16; ++r) o[d_][r] *= al_l[crow(r, hi)]; } } while (0)
#define KBASE(t) ((t) * KVBLK)
#define MASKT(P0_, P1_, t) do { const int kb_ = KBASE(t); if (kb_ + KVBLK - 1 > qlo) mask_tile(P0_, P1_, qm - kb_); } while (0)
    SLOAD_H(cur, 0);
#pragma unroll
    for (int d0 = 0; d0 < 8; ++d0) S.qr[d0] = LD8(cur.Q + (size_t)(wid * QBLK + r32) * QS + d0 * 16 + hi * 8);
    { bf16x8 t0 = LD8(cur.Q + (size_t)(wid * QBLK + r32) * QS + 128 + hi * 8), t1 = LD8(cur.Q + (size_t)(wid * QBLK + r32) * QS + 144 + hi * 8),
             t2 = LD8(cur.Q + (size_t)(wid * QBLK + r32) * QS + 160 + hi * 8), t3 = LD8(cur.Q + (size_t)(wid * QBLK + r32) * QS + 176 + hi * 8);
      *(bf16x8*)(qrl) = t0; *(bf16x8*)(qrl + 1024) = t1; *(bf16x8*)(qrl + 2048) = t2; *(bf16x8*)(qrl + 3072) = t3; }
    VMW(); SWRITE_H(0);
    __syncthreads();
    f32x16 p0, p1; float mn, al; bf16x8 pa0, pa1, pa2, pa3;
#define TILE_STEP(t, BF) do {                                                                                                 \
        if ((t) + 1 < NT) { SLOAD_H(cur, KBASE((t) + 1)); }                                                                    \
        SBAR();                                                                                                               \
        if (KBASE(t) <= qlo + QBLK - 1) {     \
        qkt<BF>(p0, p1, K_lds, r32, hi, S.qr, qrl);                                                                           \
        MASKT(p0, p1, (t)); partialSM(p0, p1, m_reg, mn, al); RESC(al);                                                        \
        finishSM(p0, p1, al, l_reg, pa0, pa1, pa2, pa3); SBAR();                                                              \
        pv_tile<BF>(o, vb0, pa0, pa1, pa2, pa3); }                                                                            \
        if ((t) + 1 < NT) { VMW(); SWRITE_H(1 - BF); }                                                                         \
        __syncthreads(); } while (0)
    for (int t = 0; t < NT; t += 2) { TILE_STEP(t, 0); TILE_STEP(t + 1, 1); }
    if (hi == 0) li_l[r32] = l_reg; asm volatile("s_waitcnt lgkmcnt(0)" ::: "memory");
    float rli[16];
#pragma unroll
    for (int r = 0; r < 16; ++r) rli[r] = __builtin_amdgcn_rcpf(li_l[crow(r, hi)]);
    bf16_t* Ow = cur.O + (size_t)(wid * QBLK) * OS;
#pragma unroll
    for (int r = 0; r < 16; ++r) { const int orow = crow(r, hi);
#pragma unroll
        for (int d0 = 0; d0 < 4; ++d0) { const float v = o[d0][r] * rli[r];
            const float vn = __shfl_xor(v, 1);
            if ((r32 & 1) == 0) *(unsigned*)(Ow + (size_t)orow * OS + d0 * 32 + r32) = cvt_pk_bf16(v, vn); } }
    __syncthreads();
#undef RESC
#undef KBASE
#undef MASKT
#undef TILE_STEP
}
#undef VMW
#undef VMWN
#undef LD8
#undef SLOAD_H
#undef SWRITE_HK
#undef SWRITE_HV
#undef SWRITE_H
#undef ATT_IDX
#undef KSWZ
#undef SBAR

__device__ __forceinline__ BlockRef make_ref(int L, int pass, const bf16_t* Qb, const bf16_t* KNVb, const bf16_t* KRb, bf16_t* Ob) {
    const int bh = L >> 2, x = L & 3, qb = pass ? 7 - x : x, b = bh >> 3, h = bh & 7; const size_t rb = (size_t)b * SEQ;
    BlockRef r; r.Q = Qb + (rb + (size_t)qb * QB) * QS + h * DQH; r.Kn = KNVb + rb * KNS + h * (DNOPE + DVH); r.Kr = KRb + rb * KRS; r.V = KNVb + rb * KNS + h * (DNOPE + DVH) + DNOPE;
    r.O = Ob + (rb + (size_t)qb * QB) * OS + h * DVH; r.P0 = qb * QB; return r;
}
__device__ __forceinline__ void attn_phase(char* lds, const bf16_t* Qb, const bf16_t* KNVb, const bf16_t* KRb, bf16_t* Ob, int first, int stride) {
    constexpr int total = NBATCH * NHEAD * 4;
    for (int L = first; L < total; L += stride) {
        for (int pass = 0; pass < 2; ++pass) { const BlockRef cur = make_ref(L, pass, Qb, KNVb, KRb, Ob); attn_block(cur, lds); }
    }
}
}
constexpr int NWAVES = 8;
constexpr size_t MiB = 1u << 20;
constexpr size_t WS_CTL = 0, CTL_ZERO_BYTES = 8 * MiB;
constexpr size_t WS_SSQ = 1 * MiB;
constexpr size_t WS_COS = 8 * MiB, WS_SIN = 16 * MiB;
constexpr size_t WS_LIST = 24 * MiB;
constexpr size_t WS_RSL = 26 * MiB;
constexpr size_t WS_TOKINFO = 28 * MiB;
constexpr size_t WS_WDN = 30 * MiB, WS_WUQ = 34 * MiB, WS_WUKV = 37 * MiB, WS_WO = 39 * MiB, WS_WPOOL = 43 * MiB, WS_WGU = 44 * MiB, WS_WD = 65 * MiB, WS_MWGU = 76 * MiB, WS_MWD = 164 * MiB;
constexpr size_t WS_H = 208 * MiB;
constexpr size_t WS_ACT = 336 * MiB;
constexpr size_t WS_DOWN = WS_ACT;
constexpr size_t WS_CQN = WS_ACT + 128 * MiB, WS_CKVN = WS_ACT + 192 * MiB, WS_KR = WS_ACT + 224 * MiB, WS_Q = WS_ACT + 232 * MiB, WS_KNV = WS_ACT + 424 * MiB;
constexpr size_t WS_HID = WS_ACT;
constexpr size_t WS_YB = WS_ACT + 358 * MiB;
constexpr size_t WS_DUMMY = WS_ACT + 424 * MiB;
constexpr size_t WS_H8 = WS_ACT + 618 * MiB;
constexpr int FFD8 = 2816;
constexpr int FFE8 = 1536;
constexpr size_t WS_END = WS_ACT + 682 * MiB;
static_assert(WS_MWD + (size_t)16 * 1024 * FFEP * 2 <= WS_H && WS_MWGU + (size_t)16 * 2 * FFEP * 1024 * 2 <= WS_MWD && WS_WD + (size_t)2 * 1024 * FFD * 2 <= WS_MWGU && WS_WGU + (size_t)2 * 2 * FFD * 1024 * 2 <= WS_WD, "weights map");
static_assert(WS_HID + (size_t)PSLOT * FFEP * 2 <= WS_YB && WS_YB + (size_t)PSLOT * 1024 * 2 <= WS_END && WS_HID + (size_t)NTOK * FFD * 2 <= WS_END && WS_KNV + (size_t)NTOK * NKV * 2 <= WS_END && WS_Q + (size_t)NTOK * NQ * 2 <= WS_KNV, "activation map");
static_assert(WS_SSQ + (size_t)14 * NTOK * 8 <= WS_COS && WS_COS <= CTL_ZERO_BYTES + WS_COS && WS_END <= 1024 * MiB, "map");
constexpr int CW_TMO = 0, CW_CODE = 1, CW_CNT = 1024  , CW_DBG = 2048, CW_BAR = 4096  ;
constexpr int RING_OFF = 0, RING_BYTES = 131072, LDSCTL_OFF = RING_BYTES, MISC_OFF = LDSCTL_OFF + 320, LDS_BYTES = 147456;

typedef GAS unsigned gu32;
#define RLX_AGENT __ATOMIC_RELAXED, __HIP_MEMORY_SCOPE_AGENT
#define LDS_WAIT() asm volatile("s_waitcnt lgkmcnt(0)" ::: "memory")
#define VM_WAIT() asm volatile("s_waitcnt vmcnt(0)" ::: "memory")

#define XB_TMO      128
#define XB_XCNT(j)  (256  + 64 * (j))
#define XB_XSUB(j)  (1280 + 64 * (j))
#define XB_XGEN(j)  (2304 + 64 * (j))
#define XB_TOP      3328
#define XB_TOPGEN   3392
#define XCD_BAR_WORDS 3456
#define XB_SPIN_CAP (1u << 18)
__device__ __forceinline__ unsigned xb_ld(unsigned* p)              { return __hip_atomic_load(p, __ATOMIC_RELAXED, __HIP_MEMORY_SCOPE_AGENT); }
__device__ __forceinline__ unsigned xb_add(unsigned* p, unsigned v) { return __hip_atomic_fetch_add(p, v, __ATOMIC_RELAXED, __HIP_MEMORY_SCOPE_AGENT); }
__device__ __forceinline__ unsigned xb_xcc_id() { return (unsigned)__builtin_amdgcn_s_getreg((3 << 11) | 20) & 0xFu; }
#define XB_SPIN(cond, bar) do { unsigned _sp = 0; while (cond) { __builtin_amdgcn_s_sleep(1); \
    if ((++_sp & 255u) == 0u) { if (xb_ld(&(bar)[XB_TMO])) break; if (_sp > XB_SPIN_CAP) { atomicAdd(&(bar)[XB_TMO], 1u); break; } } } } while (0)
__device__ __forceinline__ unsigned rfl(unsigned v);
struct XcdBarrier { unsigned* bar; unsigned x; volatile LAS unsigned* st; };
__device__ __forceinline__ XcdBarrier xcd_barrier_post(unsigned* bar, volatile LAS unsigned* st) {
    XcdBarrier b; b.bar = bar; b.x = xb_xcc_id(); b.st = st;
    if (threadIdx.x == 0) (void)xb_add(&bar[XB_XCNT(b.x)], 1u);
    return b;
}
__device__ __forceinline__ void xcd_barrier_complete(unsigned* bar, unsigned x, unsigned& nloc, unsigned& nx) {
    const unsigned G = gridDim.x * gridDim.y * gridDim.z;
    unsigned sum, cnt, mine, sp = 0u;
    for (;;) {
        sum = 0u; cnt = 0u; mine = 0u;
#pragma unroll
        for (unsigned j = 0; j < 16; ++j) { const unsigned c = xb_ld(&bar[XB_XCNT(j)]); sum += c; cnt += (c > 0u) ? 1u : 0u; mine = (j == x) ? c : mine; }
        if (sum == G) break;
        __builtin_amdgcn_s_sleep(1);
        if ((++sp & 255u) == 0u) { if (xb_ld(&bar[XB_TMO])) break; if (sp > XB_SPIN_CAP) { atomicAdd(&bar[XB_TMO], 1u); break; } }
    }
    nloc = mine > 0u ? mine : 1u; nx = cnt > 0u ? cnt : 1u;
}
__device__ __forceinline__ void xcd_barrier(const XcdBarrier& b) {
    unsigned* bar; { const volatile LAS unsigned* p_ = b.st + 2; const unsigned lo_ = rfl(p_[0]), hi_ = rfl(p_[1]); bar = (unsigned*)(((unsigned long long)hi_ << 32) | lo_); }
    asm volatile("s_waitcnt vmcnt(0)" ::: "memory");
    __syncthreads();
    if (threadIdx.x == 0) {
        __builtin_amdgcn_s_waitcnt(0);
        unsigned nloc = b.st[0], nx = b.st[1];
        if (nloc == 0u) { xcd_barrier_complete(bar, b.x, nloc, nx); b.st[0] = nloc; b.st[1] = nx; }
        const unsigned old = xb_add(&bar[XB_XSUB(b.x)], 1u);
        const unsigned gen = old / nloc;
        if (old + 1u == (gen + 1u) * nloc) {
            __builtin_amdgcn_fence(__ATOMIC_RELEASE, "agent");
            asm volatile("s_waitcnt vmcnt(0)" ::: "memory");
            const unsigned og = xb_add(&bar[XB_TOP], 1u);
            const unsigned tg = og / nx;
            if (og + 1u == (tg + 1u) * nx) xb_add(&bar[XB_TOPGEN], 1u);
            else XB_SPIN(xb_ld(&bar[XB_TOPGEN]) == tg, bar);
            __builtin_amdgcn_fence(__ATOMIC_ACQUIRE, "agent");
            xb_add(&bar[XB_XGEN(b.x)], 1u);
            asm volatile("s_waitcnt vmcnt(0)" ::: "memory");
        } else {
            XB_SPIN(xb_ld(&bar[XB_XGEN(b.x)]) == gen, bar);
            __builtin_amdgcn_fence(__ATOMIC_ACQUIRE, "agent");
            asm volatile("s_waitcnt vmcnt(0)" ::: "memory");
        }
    }
    __syncthreads();
}

constexpr int PT_OFF_ = LDSCTL_OFF + 512;
__device__ __forceinline__ unsigned rfl(unsigned v);
__device__ __forceinline__ const float* ptab(LAS unsigned char* L, int i);
struct Frame { LAS unsigned char* lds; volatile LAS unsigned* MISC; gu32* ctl; unsigned char* ws; int tid, lane, wave, vcu, G; };

__device__ __forceinline__ float wave_sum(float v) {
#pragma unroll
    for (int o = 1; o < 64; o <<= 1) v += __shfl_xor(v, o);
    return v;
}
__device__ __forceinline__ unsigned rfl(unsigned v) { return (unsigned)__builtin_amdgcn_readfirstlane((int)v); }

__device__ __forceinline__ int rowmap(int mode, int n) {
    if (mode == 0) return n;
    if (mode == 1) return (n >> 7) * 256 + (n & 127);
    if (mode == 2) return (n >> 7) * 256 + 128 + (n & 127);
    if (mode == 4) return n < 800 ? n : 896 + (n - 800);
    const int h = n / DQH, d = n - h * DQH;
    if (d < DNOPE) return 512 + h * DNOPE + d;
    if (d < DNOPE + 32) return (h >> 2) * 256 + (h & 3) * 32 + (d - DNOPE);
    return (h >> 2) * 256 + 128 + (h & 3) * 32 + (d - DNOPE - 32);
}
__device__ __forceinline__ void transpose_item(const float* W, int N, bf16_t* WT, int ldd, int mode, const float* kscale, const float* nscale, int item, int lane) {
    const int nblk = N / 64, kb = item / nblk, nb = item % nblk, k0 = 64 * kb, n = 64 * nb + lane;
    const float sn = nscale ? nscale[n] : 1.0f;
    const int ksv = __float_as_int(kscale ? kscale[k0 + lane] : 1.0f);
    const float* wp = W + (size_t)k0 * N + n;
    bf16_t* op = WT + (size_t)rowmap(mode, n) * ldd + k0;
#pragma unroll
    for (int kg = 0; kg < 8; ++kg) { float v[8];
#pragma unroll
        for (int i = 0; i < 8; ++i) { const float sk = __int_as_float(__builtin_amdgcn_readlane(ksv, 8 * kg + i)); v[i] = wp[(size_t)(8 * kg + i) * N] * (sk * sn); }
        u32x4 o; o.x = cvt_pk_bf16(v[0], v[1]); o.y = cvt_pk_bf16(v[2], v[3]); o.z = cvt_pk_bf16(v[4], v[5]); o.w = cvt_pk_bf16(v[6], v[7]);
        *(GAS u32x4*)(op + 8 * kg) = o; }
}
__device__ __forceinline__ void transpose_item_f8(const float* W, int N, unsigned char* WT, int ldd, int mode, const float* kscale, int item, int lane) {
    const int nblk = N / 64, kb = item / nblk, nb = item % nblk, k0 = 64 * kb, n = 64 * nb + lane;
    const int ksv = __float_as_int(kscale ? kscale[k0 + lane] : 1.0f);
    const float* wp = W + (size_t)k0 * N + n;
    unsigned char* op = WT + (size_t)rowmap(mode, n) * ldd + k0;
#pragma unroll
    for (int kg = 0; kg < 4; ++kg) { float v[16];
#pragma unroll
        for (int i = 0; i < 16; ++i) { const float sk = __int_as_float(__builtin_amdgcn_readlane(ksv, 16 * kg + i)); v[i] = wp[(size_t)(16 * kg + i) * N] * (sk * pg8::FP8_SW); }
        u32x4 o; o.x = pg8::pk4_fp8(v[0], v[1], v[2], v[3]); o.y = pg8::pk4_fp8(v[4], v[5], v[6], v[7]); o.z = pg8::pk4_fp8(v[8], v[9], v[10], v[11]); o.w = pg8::pk4_fp8(v[12], v[13], v[14], v[15]);
        *(GAS u32x4*)(op + 16 * kg) = o; }
}
struct MatDesc { const float* src; bf16_t* dst; const float* kscale; const float* nscale; int K, N, ldd, mode, f8; };
constexpr int N_MATS = 70;
__device__ __forceinline__ MatDesc mat_desc(int m, LAS unsigned char* L, unsigned char* ws) {
    MatDesc d; d.kscale = nullptr; d.nscale = nullptr; d.mode = 0; d.f8 = 0;
    if (m < 2)       { const int a = m;      d.src = ptab(L, 4) + (size_t)a * DM * NDOWN;    d.K = DM;   d.N = NDOWN; d.dst = (bf16_t*)(ws + WS_WDN) + (size_t)a * NDOWNP * DM;  d.ldd = DM; d.mode = 4; d.kscale = ptab(L, 2) + (size_t)(2 * a) * DM; }
    else if (m < 4)  { const int a = m - 2;  d.src = ptab(L, 6) + (size_t)a * QLR * NQ;      d.K = QLR;  d.N = NQ;    d.dst = (bf16_t*)(ws + WS_WUQ) + (size_t)a * NQ * QLR;     d.ldd = QLR; d.mode = 3; d.kscale = ptab(L, 5) + (size_t)a * QLR; }
    else if (m < 6)  { const int a = m - 4;  d.src = ptab(L, 8) + (size_t)a * KVLR * NKV;    d.K = KVLR; d.N = NKV;   d.dst = (bf16_t*)(ws + WS_WUKV) + (size_t)a * NKV * KVLR;  d.ldd = KVLR; d.kscale = ptab(L, 7) + (size_t)a * KVLR; }
    else if (m < 8)  { const int a = m - 6;  d.src = ptab(L, 9) + (size_t)a * DM * DM;       d.K = DM;   d.N = DM;    d.dst = (bf16_t*)(ws + WS_WO) + (size_t)a * DM * DM;       d.ldd = DM; }
    else if (m < 16) { const int i = m - 8;  d.src = ptab(L, 10) + (size_t)i * 256 * 256;    d.K = 256;  d.N = 256;   d.dst = (bf16_t*)(ws + WS_WPOOL) + (size_t)i * 256 * 256;  d.ldd = 256; d.nscale = ptab(L, 11) + i * 256; }
    else if (m < 18) { const int a = m - 16; d.src = ptab(L, 12) + (size_t)a * DM * FFD;     d.K = DM;   d.N = FFD;   d.dst = (bf16_t*)(ws + WS_WGU) + (size_t)a * 2 * FFD * DM; d.ldd = DM; d.mode = 1; d.kscale = ptab(L, 3) + (size_t)(2 * a) * DM; }
    else if (m < 20) { const int a = m - 18; d.src = ptab(L, 13) + (size_t)a * DM * FFD;     d.K = DM;   d.N = FFD;   d.dst = (bf16_t*)(ws + WS_WGU) + (size_t)a * 2 * FFD * DM; d.ldd = DM; d.mode = 2; d.kscale = ptab(L, 3) + (size_t)(2 * a) * DM; }
    else if (m < 22) { const int a = m - 20; d.src = ptab(L, 14) + (size_t)a * FFD * DM;     d.K = FFD;  d.N = DM;    d.dst = (bf16_t*)(ws + WS_WD) + (size_t)a * DM * FFD;      d.ldd = FFD; }
    else if (m < 38) { const int i = m - 22; d.src = ptab(L, 16) + (size_t)i * DM * FFE;     d.K = DM;   d.N = FFE;   d.dst = (bf16_t*)(ws + WS_MWGU) + (size_t)i * 2 * FFEP * DM; d.ldd = DM; d.mode = 1; d.kscale = ptab(L, 3) + (size_t)(2 * (i >> 3) + 1) * DM; }
    else if (m < 54) { const int i = m - 38; d.src = ptab(L, 17) + (size_t)i * DM * FFE;     d.K = DM;   d.N = FFE;   d.dst = (bf16_t*)(ws + WS_MWGU) + (size_t)i * 2 * FFEP * DM; d.ldd = DM; d.mode = 2; d.kscale = ptab(L, 3) + (size_t)(2 * (i >> 3) + 1) * DM; }
    else             { const int i = m - 54; d.src = ptab(L, 18) + (size_t)i * FFE * DM;     d.K = FFE;  d.N = DM;    d.dst = (bf16_t*)(ws + WS_MWD) + (size_t)i * DM * FFEP;    d.ldd = FFEP; }
    if (m == 17 || m == 19) { d.f8 = 1; d.dst = (bf16_t*)(ws + WS_WGU + (size_t)2 * FFD * DM * 2); d.ldd = DM; }
    if (m == 21) { d.f8 = 1; d.dst = (bf16_t*)(ws + WS_WD + (size_t)DM * FFD * 2); d.ldd = FFD8; }
    if (m >= 22 && ((m - 22) & 15) >= 8) {
        const int e = (m - 22) & 7; d.f8 = 1;
        if (m < 54) { d.dst = (bf16_t*)(ws + WS_MWGU + (size_t)8 * 2 * FFEP * DM * 2 + (size_t)e * 2 * FFEP * DM); d.ldd = DM; }
        else        { d.dst = (bf16_t*)(ws + WS_MWD + (size_t)8 * DM * FFEP * 2 + (size_t)e * DM * FFE8); d.ldd = FFE8; } }
    return d;
}
__device__ __forceinline__ void p0_prologue(Frame& F) {
    const int* positions = (const int*)ptab(F.lds, 1);
    const int gw = F.vcu * NWAVES + F.wave, NGW = F.G * NWAVES;
    int cum = 0;
    for (int m = 0; m < N_MATS; ++m) {
        const MatDesc d = mat_desc(m, F.lds, F.ws);
        const int nitems = (d.K / 64) * (d.N / 64);
        int first = gw - (cum % NGW); if (first < 0) first += NGW;
        if (d.f8) { for (int it = first; it < nitems; it += NGW) transpose_item_f8(d.src, d.N, (unsigned char*)d.dst, d.ldd, d.mode, d.kscale, it, F.lane); }
        else { for (int it = first; it < nitems; it += NGW) transpose_item(d.src, d.N, d.dst, d.ldd, d.mode, d.kscale, d.nscale, it, F.lane); }
        cum += nitems;
    }
    const int gt = gw * 64 + F.lane, NGT = NGW * 64; const u32x4 z4 = (u32x4){0u, 0u, 0u, 0u};
    for (int i = gt; i < 2 * 192 * 128; i += NGT) { const int a = i / (192 * 128), r = (i / 128) % 192, c = i % 128; const int row = r < 96 ? 800 + r : 928 + (r - 96); *(GAS u32x4*)((bf16_t*)(F.ws + WS_WDN) + (size_t)a * NDOWNP * DM + (size_t)row * DM + c * 8) = z4; }
    for (int i = gt; i < 8 * 128 * 128; i += NGT) { const int e = i / (128 * 128), r = (i / 128) % 128, c = i % 128; const int row = 2560 + (r < 64 ? 64 + r : 192 + (r - 64));
        *(GAS u32x4*)((bf16_t*)(F.ws + WS_MWGU) + (size_t)e * 2 * FFEP * DM + (size_t)row * DM + c * 8) = z4; }
    for (int i = gt; i < 8 * 1024 * 8; i += NGT) { const int row = i / 8, c = i % 8; *(GAS u32x4*)((bf16_t*)(F.ws + WS_MWD) + (size_t)row * FFEP + FFE + c * 8) = z4; }
    for (int i = gt; i < 1024 * 8; i += NGT) { const int row = i / 8, c = i % 8; *(GAS u32x4*)(F.ws + WS_WD + (size_t)DM * FFD * 2 + (size_t)row * FFD8 + FFD + c * 16) = z4; }
    for (int i = gt; i < 8 * 128 * 64; i += NGT) { const int e = i / (128 * 64), r = (i / 64) % 128, c = i % 64; const int row = 2560 + (r < 64 ? 64 + r : 192 + (r - 64));
        *(GAS u32x4*)(F.ws + WS_MWGU + (size_t)8 * 2 * FFEP * DM * 2 + (size_t)e * 2 * FFEP * DM + (size_t)row * DM + c * 16) = z4; }
    for (int i = gt; i < 8 * 1024 * 12; i += NGT) { const int row = i / 12, c = i % 12; *(GAS u32x4*)(F.ws + WS_MWD + (size_t)8 * DM * FFEP * 2 + (size_t)row * FFE8 + FFE + c * 16) = z4; }
    float* cosT = (float*)(F.ws + WS_COS); float* sinT = (float*)(F.ws + WS_SIN);
    { const float inv = powf(10000.0f, -(float)(2 * (gt & 31)) / 64.0f);
      for (int i = gt; i < NTOK * 32; i += NGT) { const float ang = (float)positions[i >> 5] * inv; float sn, cs; sincosf(ang, &sn, &cs); cosT[i] = cs; sinT[i] = sn; } }
    const float* x = ptab(F.lds, 0); bf16_t* H = (bf16_t*)(F.ws + WS_H); ssq_t* ssq0 = (ssq_t*)(F.ws + WS_SSQ);
    for (int m0 = gw * 4; m0 < NTOK; m0 += NGW * 4) {
        f32x4 v[4][4];
#pragma unroll
        for (int r = 0; r < 4; ++r) { const GAS f32x4* xr = (const GAS f32x4*)(x + (size_t)(m0 + r) * DM) + F.lane;
#pragma unroll
            for (int j = 0; j < 4; ++j) v[r][j] = xr[64 * j]; }
#pragma unroll
        for (int r = 0; r < 4; ++r) { GAS u32x2* o8 = (GAS u32x2*)(H + (size_t)(m0 + r) * DM) + F.lane; float s = 0.f;
#pragma unroll
            for (int j = 0; j < 4; ++j) { const f32x4 t = v[r][j]; s += (t.x * t.x + t.y * t.y) + (t.z * t.z + t.w * t.w); u32x2 w; w.x = cvt_pk_bf16(t.x, t.y); w.y = cvt_pk_bf16(t.z, t.w); o8[64 * j] = w; }
            s = wave_sum(s); if (F.lane == 0) ssq0[m0 + r] = ssq_fix(s); }
    }
}

template <bool FINAL>
__device__ __forceinline__ void combine_phase(Frame& F, const bf16_t* H, bf16_t* Hout, const bf16_t* YB, const unsigned* tokinfo, const unsigned* cntw, ssq_t* ssq_next, const float* gain, float* outF) {
    const int gw = F.vcu * NWAVES + F.wave, NGW = F.G * NWAVES;
    f32x4 g[4];
    if constexpr (FINAL) {
#pragma unroll
        for (int j = 0; j < 4; ++j) g[j] = *(const f32x4*)(gain + F.lane * 4 + 256 * j);
    }
    unsigned nb[8];
#pragma unroll
    for (int e = 0; e < 8; ++e) nb[e] = (rfl(__hip_atomic_load((unsigned*)cntw + 64 * e, RLX_AGENT)) + 255u) >> 8;
    for (int m0 = gw * 2; m0 < NTOK; m0 += NGW * 2) {
        u32x4 t0[2], t1[2];
#pragma unroll
        for (int r = 0; r < 2; ++r) { t0[r] = *(const u32x4*)(tokinfo + (size_t)(m0 + r) * 8); t1[r] = *(const u32x4*)(tokinfo + (size_t)(m0 + r) * 8 + 4); }
        u32x2 hh[2][4], ya[2][4], yb[2][4]; float g0[2], g1[2];
#pragma unroll
        for (int r = 0; r < 2; ++r) {
            const unsigned e0 = rfl(t0[r].x), r0 = rfl(t0[r].y), e1 = rfl(t1[r].x), r1 = rfl(t1[r].y); g0[r] = __uint_as_float(rfl(t0[r].z)); g1[r] = __uint_as_float(rfl(t1[r].z));
            unsigned b0 = 0u, b1 = 0u;
#pragma unroll
            for (int e = 0; e < 8; ++e) { b0 += ((unsigned)e < e0) ? nb[e] : 0u; b1 += ((unsigned)e < e1) ? nb[e] : 0u; }
            const GAS u32x2* hr = (const GAS u32x2*)(H + (size_t)(m0 + r) * DM) + F.lane;
            const GAS u32x2* y0 = (const GAS u32x2*)(YB + ((size_t)b0 * 256 + r0) * DM) + F.lane; const GAS u32x2* y1 = (const GAS u32x2*)(YB + ((size_t)b1 * 256 + r1) * DM) + F.lane;
#pragma unroll
            for (int j = 0; j < 4; ++j) { hh[r][j] = hr[64 * j]; ya[r][j] = y0[64 * j]; yb[r][j] = y1[64 * j]; }
        }
#pragma unroll
        for (int r = 0; r < 2; ++r) { const int m = m0 + r;
            f32x4 v[4]; float s = 0.f;
#pragma unroll
            for (int j = 0; j < 4; ++j) { const u32x2 h2 = hh[r][j], a = ya[r][j], b = yb[r][j];
                v[j].x = bflo(h2.x) + g0[r] * bflo(a.x) + g1[r] * bflo(b.x); v[j].y = bfhi(h2.x) + g0[r] * bfhi(a.x) + g1[r] * bfhi(b.x); v[j].z = bflo(h2.y) + g0[r] * bflo(a.y) + g1[r] * bflo(b.y); v[j].w = bfhi(h2.y) + g0[r] * bfhi(a.y) + g1[r] * bfhi(b.y);
                s += (v[j].x * v[j].x + v[j].y * v[j].y) + (v[j].z * v[j].z + v[j].w * v[j].w); }
            s = wave_sum(s);
            if constexpr (FINAL) { const float rstd = rstd_f(s); GAS f32x4* ho = (GAS f32x4*)(outF + (size_t)m * DM) + F.lane;
#pragma unroll
                for (int j = 0; j < 4; ++j) ho[64 * j] = v[j] * rstd * g[j];
            } else { GAS u32x2* hw = (GAS u32x2*)(Hout + (size_t)m * DM) + F.lane;
#pragma unroll
                for (int j = 0; j < 4; ++j) { u32x2 w; w.x = cvt_pk_bf16(v[j].x, v[j].y); w.y = cvt_pk_bf16(v[j].z, v[j].w); hw[64 * j] = w; }
                if (F.lane == 0) ssq_next[m] = ssq_fix(s); }
        }
    }
}
__device__ __forceinline__ void mid_phase(Frame& F, const bf16_t* DOWN, const float* qn, const float* kvn, const float* cosT, const float* sinT, bf16_t* CQN, bf16_t* CKVN, bf16_t* KR) {
    const int gw = F.vcu * NWAVES + F.wave, NGW = F.G * NWAVES, lane = F.lane;
    const f32x4 q0 = *(const f32x4*)(qn + lane * 8), q1 = *(const f32x4*)(qn + lane * 8 + 4), k0 = *(const f32x4*)(kvn + lane * 4);
    for (int m = gw; m < NTOK; m += NGW) {
        const bf16_t* dr = DOWN + (size_t)m * NDOWNP;
        const u32x4 cq = *(const GAS u32x4*)(dr + lane * 8); const u32x2 ck = *(const GAS u32x2*)(dr + QLR + lane * 4);
        const float x1 = bf2f(dr[QLR + KVLR + (lane & 31)]), x2 = bf2f(dr[QLR + KVLR + 32 + (lane & 31)]);
        const f32x4 a0 = (f32x4){bflo(cq.x), bfhi(cq.x), bflo(cq.y), bfhi(cq.y)}, a1 = (f32x4){bflo(cq.z), bfhi(cq.z), bflo(cq.w), bfhi(cq.w)}, c0 = (f32x4){bflo(ck.x), bfhi(ck.x), bflo(ck.y), bfhi(ck.y)};
        const float sq = wave_sum((a0.x * a0.x + a0.y * a0.y) + (a0.z * a0.z + a0.w * a0.w) + (a1.x * a1.x + a1.y * a1.y) + (a1.z * a1.z + a1.w * a1.w));
        const float sk = wave_sum((c0.x * c0.x + c0.y * c0.y) + (c0.z * c0.z + c0.w * c0.w));
        const float rq = 1.0f / sqrtf(sq * (1.0f / QLR) + RMS_EPS), rk = 1.0f / sqrtf(sk * (1.0f / KVLR) + RMS_EPS);
        const f32x4 y0 = a0 * rq * q0, y1 = a1 * rq * q1, z0 = c0 * rk * k0;
        u32x4 w; w.x = cvt_pk_bf16(y0.x, y0.y); w.y = cvt_pk_bf16(y0.z, y0.w); w.z = cvt_pk_bf16(y1.x, y1.y); w.w = cvt_pk_bf16(y1.z, y1.w);
        *(GAS u32x4*)(CQN + (size_t)m * QLR + lane * 8) = w;
        u32x2 w2; w2.x = cvt_pk_bf16(z0.x, z0.y); w2.y = cvt_pk_bf16(z0.z, z0.w);
        *(GAS u32x2*)(CKVN + (size_t)m * KVLR + lane * 4) = w2;
        const float c = cosT[(size_t)m * 32 + (lane & 31)], s = sinT[(size_t)m * 32 + (lane & 31)];
        const float o = lane < 32 ? x1 * c - x2 * s : x2 * c + x1 * s;
        KR[(size_t)m * DROPE + lane] = (bf16_t)(cvt_pk_bf16(o, o) & 0xffffu);
    }
}
template <int W>
__device__ __forceinline__ void pool_walk(const bf16_t* h, const ssq_t* ssq, const f32x2 g2, bf16_t* Z, size_t rowbase, int t_start, int c0, int nrows, int col) {
    f32x2 ring[W]; f32x2 sum = (f32x2){0.f, 0.f};
#pragma unroll
    for (int j = 0; j < W; ++j) ring[j] = (f32x2){0.f, 0.f};
    for (int r = 0; r < nrows; r += 16) {
        unsigned xw[16]; ssq_t q[16];
#pragma unroll
        for (int j = 0; j < 16; ++j) { const size_t row = rowbase + t_start + r + j; xw[j] = *(const GAS unsigned*)(h + row * DM + col); q[j] = ssq[row]; }
#pragma unroll
        for (int j = 0; j < 16; ++j) {
            const int t = t_start + r + j; const size_t row = rowbase + t;
            const f32x2 v = (f32x2){bflo(xw[j]), bfhi(xw[j])} * rstd_of(q[j]) * g2;
            sum = sum + (v - ring[j % W]); ring[j % W] = v;
            if (t >= c0) { const float inv = 1.0f / (float)(t + 1 < W ? t + 1 : W); const f32x2 z = sum * inv - v; *(GAS unsigned*)(Z + row * DM + col) = cvt_pk_bf16(z.x, z.y); }
        }
    }
}
__device__ __forceinline__ void pool_phase(Frame& F, const bf16_t* h, const ssq_t* ssq, const float* gain, bf16_t* Z) {
    const int col = F.tid * 2; const f32x2 g2 = *(const f32x2*)(gain + col);
    for (int chunk = F.vcu; chunk < NBATCH * 16; chunk += F.G) {
        const int b = chunk >> 4, c0 = (chunk & 15) * 128, t_start = c0 ? c0 - 16 : 0, nrows = c0 + 128 - t_start; const size_t rowbase = (size_t)b * SEQ;
        const int grp = F.wave >> 1;
        if (grp == 0) pool_walk<2>(h, ssq, g2, Z, rowbase, t_start, c0, nrows, col);
        else if (grp == 1) pool_walk<4>(h, ssq, g2, Z, rowbase, t_start, c0, nrows, col);
        else if (grp == 2) pool_walk<8>(h, ssq, g2, Z, rowbase, t_start, c0, nrows, col);
        else pool_walk<16>(h, ssq, g2, Z, rowbase, t_start, c0, nrows, col);
    }
}
template <bool WRITE_H8>
__device__ __forceinline__ void router_phase(Frame& F, const bf16_t* h, const ssq_t* ssq, const float* gain, const float* router, int* list, float* rsl, unsigned* tokinfo, unsigned* cntw, unsigned char* H8) {
    LAS float* rt = (LAS float*)(F.lds + RING_OFF);
    LAS int* esel = (LAS int*)(F.lds + RING_OFF + 32768);
    LAS int* wt = (LAS int*)(F.lds + RING_OFF + 32768 + 2048);
    LAS int* base = (LAS int*)(F.lds + RING_OFF + 32768 + 2048 + 256);
    LAS float* rsd = (LAS float*)(F.lds + RING_OFF + 32768 + 2048 + 512);
    const int lane = F.lane;
    for (int idx = F.tid; idx < DM * NEXP; idx += NWAVES * 64) rt[(idx & 7) * DM + (idx >> 3)] = router[idx];
    f32x4 g[4];
#pragma unroll
    for (int j = 0; j < 4; ++j) g[j] = *(const f32x4*)(gain + lane * 4 + 256 * j);
    for (int chunk = F.vcu; chunk < NTOK / 256; chunk += F.G) {
        const int T0 = chunk * 256;
        __syncthreads();
        u32x2 nx[4]; ssq_t nq;
        { const GAS u32x2* xr = (const GAS u32x2*)(h + (size_t)(T0 + F.wave * 32) * DM) + lane;
#pragma unroll
          for (int j = 0; j < 4; ++j) nx[j] = xr[64 * j];
          nq = ssq[T0 + F.wave * 32]; }
        for (int i = 0; i < 32; ++i) {
            const int tl = F.wave * 32 + i, m = T0 + tl;
            u32x2 cw[4];
#pragma unroll
            for (int j = 0; j < 4; ++j) cw[j] = nx[j];
            const float rstd = rstd_of(nq);
            if (i + 1 < 32) { const GAS u32x2* xr = (const GAS u32x2*)(h + (size_t)(m + 1) * DM) + lane;
#pragma unroll
                for (int j = 0; j < 4; ++j) nx[j] = xr[64 * j];
                nq = ssq[m + 1]; }
            f32x4 v[4];
#pragma unroll
            for (int j = 0; j < 4; ++j) { const u32x2 w = cw[j]; f32x4 xn = (f32x4){bflo(w.x), bfhi(w.x), bflo(w.y), bfhi(w.y)} * rstd;
                if constexpr (WRITE_H8) { const f32x4 q = xn * pg8::FP8_SA; *(GAS unsigned*)(H8 + (size_t)m * DM + lane * 4 + 256 * j) = pg8::pk4_fp8(q.x, q.y, q.z, q.w); }
                v[j] = xn * g[j]; }
            float lg[8];
#pragma unroll
            for (int e = 0; e < 8; ++e) { float p = 0.f;
#pragma unroll
                for (int j = 0; j < 4; ++j) { const f32x4 r4 = *(const LAS f32x4*)(rt + e * DM + lane * 4 + 256 * j); p += (v[j].x * r4.x + v[j].y * r4.y) + (v[j].z * r4.z + v[j].w * r4.w); }
                lg[e] = wave_sum(p); }
            int e0 = 0; float l0 = lg[0];
#pragma unroll
            for (int e = 1; e < 8; ++e) if (lg[e] > l0) { l0 = lg[e]; e0 = e; }
            int e1 = e0 == 0 ? 1 : 0; float l1 = lg[e0 == 0 ? 1 : 0];
#pragma unroll
            for (int e = 0; e < 8; ++e) if (e != e0 && lg[e] > l1) { l1 = lg[e]; e1 = e; }
            const float g0 = 1.0f / (1.0f + __expf(l1 - l0)), g1 = 1.0f - g0;
            if (lane == 0) { esel[2 * tl] = e0; esel[2 * tl + 1] = e1; rsd[tl] = rstd; unsigned* ti = tokinfo + (size_t)m * 8;
                ti[0] = (unsigned)e0; ti[2] = __float_as_uint(g0); ti[4] = (unsigned)e1; ti[6] = __float_as_uint(g1); }
        }
        __syncthreads();
        const int me = esel[F.tid]; int myrank = 0;
#pragma unroll
        for (int e = 0; e < 8; ++e) { const unsigned long long mask = __ballot(me == e); if (me == e) myrank = __popcll(mask & ((1ull << lane) - 1ull)); if (lane == 0) wt[F.wave * 8 + e] = __popcll(mask); }
        __syncthreads();
        int off = 0;
        for (int w = 0; w < F.wave; ++w) off += wt[w * 8 + me];
        if (F.tid < 8) { int tot = 0; for (int w = 0; w < 8; ++w) tot += wt[w * 8 + F.tid]; base[F.tid] = (int)__hip_atomic_fetch_add(cntw + 64 * F.tid, (unsigned)tot, RLX_AGENT); }
        __syncthreads();
        const int rank = base[me] + off + myrank, tok = T0 + (F.tid >> 1);
        list[(size_t)me * NTOK + rank] = tok; rsl[(size_t)me * NTOK + rank] = rsd[F.tid >> 1];
        tokinfo[(size_t)tok * 8 + (F.tid & 1) * 4 + 1] = (unsigned)rank;
    }
}
template <bool GATHER, bool FP8 = false>
struct MoeOrder {
    static constexpr size_t A_BLK = GATHER ? 0 : (FP8 ? (size_t)256 * FFE8 : (size_t)256 * FFEP * 2), B_EXP = GATHER ? (FP8 ? (size_t)2 * FFEP * DM : (size_t)2 * FFEP * DM * 2) : (FP8 ? (size_t)DM * FFE8 : (size_t)DM * FFEP * 2),
                            B_TILE = GATHER ? (FP8 ? (size_t)256 * DM : (size_t)256 * DM * 2) : (FP8 ? (size_t)256 * FFE8 : (size_t)256 * FFEP * 2);
    static constexpr int NT = GATHER ? 2 * FFEP / 256 : DM / 256;
    const char* A; const char* B; const int* list; const unsigned* cntw; int G, c, rev; unsigned bs[9];
    __device__ __forceinline__ void init(const unsigned* cntw_, const void* A_, const void* B_, const int* list_, int G_, int c_) {
        A = (const char*)A_; B = (const char*)B_; list = list_; cntw = cntw_; G = G_; c = c_; rev = 0; bs[0] = 0u;
#pragma unroll
        for (int e = 0; e < 8; ++e) { const unsigned ce = rfl(__hip_atomic_load((unsigned*)cntw + 64 * e, RLX_AGENT)); bs[e + 1] = bs[e] + ((ce + 255u) >> 8); }
    }
    __device__ __forceinline__ bool next(int i, pg8::Unit& u) const {
        long L = (long)i * G + c; if (L >= (long)bs[8] * NT) return false;
        if (rev) L = (long)bs[8] * NT - 1 - L;
        const unsigned blk = (unsigned)(L / NT); const int pn = (int)(L % NT);
        unsigned e = 0u, st = 0u;
#pragma unroll
        for (int k = 1; k < 8; ++k) if (blk >= bs[k]) { e = (unsigned)k; st = bs[k]; }
        const unsigned j = blk - st;
        u.b = B + (size_t)e * B_EXP + (size_t)pn * B_TILE; u.orow = (int)(blk * 256u); u.pn = pn; u.aux = (int)e;
        if constexpr (GATHER) { const unsigned ce = rfl(__hip_atomic_load((unsigned*)cntw + 64 * e, RLX_AGENT));
            u.a = A; u.rows = list + (size_t)e * NTOK + (size_t)j * 256; const unsigned rem = ce - j * 256u; u.nrows = rem < 256u ? (int)rem : 256; }
        else { u.a = A + (size_t)blk * A_BLK; u.rows = nullptr; u.nrows = 256; }
        return true;
    }
};
constexpr int NPHASE = 27;
struct Args { const float* in[20]; float* out; unsigned char* ws; int ph_lo, ph_hi, li, pad; };
#ifndef MK_REP_MASK
#define MK_REP_MASK 0
#endif
#ifndef MK_REP_N
#define MK_REP_N 1
#endif
#ifndef MK_REV
#define MK_REV 1
#endif
#ifndef MK_STAG_BF
#define MK_STAG_BF 0u
#define MK_STAG_F8 0u
#endif
constexpr int PT_OFF = LDSCTL_OFF + 512;
__device__ __forceinline__ unsigned long long ptab_u64(LAS unsigned char* L, int i) {
    const volatile LAS unsigned* p = (const volatile LAS unsigned*)(L + PT_OFF + 8 * i); const unsigned lo = rfl(p[0]), hi = rfl(p[1]); return ((unsigned long long)hi << 32) | lo; }
__device__ __forceinline__ const float* ptab(LAS unsigned char* L, int i) { return (const float*)ptab_u64(L, i); }
__device__ __forceinline__ Frame make_frame(LAS unsigned char* L) {
    Frame F; F.lds = L; F.MISC = (volatile LAS unsigned*)(L + MISC_OFF); F.tid = launder_v((int)threadIdx.x); F.lane = F.tid & 63; F.wave = __builtin_amdgcn_readfirstlane(F.tid >> 6);
    F.G = gridDim.x; { const int bx = blockIdx.x; F.vcu = (F.G % 8 == 0) ? (bx % 8) * (F.G / 8) + bx / 8 : bx; }
    F.ws = (unsigned char*)ptab_u64(L, 21); F.ctl = (gu32*)(F.ws + WS_CTL); return F;
}
__global__ void __launch_bounds__(NWAVES * 64, 2) fwd(Args args) {
    extern __shared__ __attribute__((aligned(16))) unsigned char lds[];
    LAS unsigned char* L = (LAS unsigned char*)lds;
    { const int tid = threadIdx.x;
      for (int u = tid; u < (LDS_BYTES - LDSCTL_OFF) / 4; u += NWAVES * 64) ((LAS unsigned*)(L + LDSCTL_OFF))[u] = 0u;
      __syncthreads();
      if (tid < 20) *(LAS unsigned long long*)(L + PT_OFF + 8 * tid) = (unsigned long long)args.in[tid];
      if (tid == 20) *(LAS unsigned long long*)(L + PT_OFF + 8 * 20) = (unsigned long long)args.out;
      if (tid == 21) *(LAS unsigned long long*)(L + PT_OFF + 8 * 21) = (unsigned long long)args.ws;
      if (tid == 22) *(LAS unsigned long long*)(L + PT_OFF + 8 * 22) = (unsigned long long)args.pad;
      __syncthreads(); }
    const int lo = args.ph_lo, hi = args.ph_hi;
    XcdBarrier bar; { gu32* ctl = (gu32*)(args.ws + WS_CTL); bar.bar = (unsigned*)(ctl + CW_BAR) + args.li * XCD_BAR_WORDS; bar.x = 0; bar.st = nullptr;
      if (threadIdx.x == 0) { const unsigned long long ba = (unsigned long long)((unsigned*)(ctl + CW_BAR) + args.li * XCD_BAR_WORDS); ((volatile LAS unsigned*)(L + MISC_OFF))[10] = (unsigned)ba; ((volatile LAS unsigned*)(L + MISC_OFF))[11] = (unsigned)(ba >> 32); }
      if (hi - lo > 1) bar = xcd_barrier_post((unsigned*)(ctl + CW_BAR) + args.li * XCD_BAR_WORDS, (volatile LAS unsigned*)(L + MISC_OFF) + 8);
      __syncthreads(); }
#ifndef MK_ONLY
#define MK_ONLY (-1)
#endif
#define KIND(k) ((k) == 0 ? 0 : 1 + ((k) - 1) % 13)
#ifndef MK_SKIPMASK
#define MK_SKIPMASK 0
#endif
#define IN(k) ((MK_ONLY < 0 || KIND(k) == MK_ONLY) && !((MK_SKIPMASK >> KIND(k)) & 1) && lo <= (k) && (k) < hi)
#define FORREP(k)
#if MK_REP_MASK
#define LASTREP (ptab_u64(L, 22) == 0ull)
#else
#define LASTREP true
#endif
#ifdef MK_DOUBLE_BAR
#define SEAM(k) do { if ((k) + 1 < hi) { xcd_barrier(bar); xcd_barrier(bar); } } while (0)
#else
#define SEAM(k) do { if ((k) + 1 < hi) xcd_barrier(bar); } while (0)
#endif
#define WSP(off) ((bf16_t*)(F.ws + (off)))
#define SSQ(i) ((ssq_t*)(F.ws + WS_SSQ) + (size_t)(i) * NTOK)
    LAS unsigned char* ring = L + RING_OFF;

    if (IN(0)) FORREP(0) { Frame F = make_frame(L); p0_prologue(F); SEAM(0); }

    for (int lp = 0; lp < 2; ++lp) {
        const int pb = 1 + 13 * lp;
        if (IN(pb + 0)) FORREP(pb + 0) { Frame F = make_frame(L);
            pg8::RegOrder S; S.init(WSP(WS_H), DM * 2, WSP(WS_WDN) + (size_t)lp * NDOWNP * DM, DM * 2, NTOK, NDOWNP, F.G, (int)blockIdx.x);
            pg8::EpiDown E{WSP(WS_DOWN), WSP(WS_KR), SSQ(4 * lp + 0), LASTREP ? SSQ(10 + 2 * lp) : SSQ(9), LASTREP ? SSQ(11 + 2 * lp) : SSQ(9), (const float*)(F.ws + WS_COS), (const float*)(F.ws + WS_SIN)};
            pg8::gemm_phase<pg8::EpiDown, pg8::RegOrder, false>(ring, DM * 2, DM * 2, DM * 2, S, E);
            SEAM(pb + 0);
        }
        if (IN(pb + 1)) FORREP(pb + 1) { Frame F = make_frame(L);
            pg8::RegOrder S; S.init(WSP(WS_DOWN), NDOWNP * 2, WSP(WS_WUQ) + (size_t)lp * NQ * QLR, QLR * 2, NTOK, NQ, F.G, (int)blockIdx.x);
            pg8::EpiQ E{WSP(WS_Q), (const float*)(F.ws + WS_COS), (const float*)(F.ws + WS_SIN), SSQ(10 + 2 * lp)};
            pg8::gemm_phase<pg8::EpiQ, pg8::RegOrder, false>(ring, NDOWNP * 2, QLR * 2, QLR * 2, S, E);
            SEAM(pb + 1);
        }
        if (IN(pb + 2)) FORREP(pb + 2) { Frame F = make_frame(L);
            pg8::RegOrder S; S.init(WSP(WS_DOWN) + QLR, NDOWNP * 2, WSP(WS_WUKV) + (size_t)lp * NKV * KVLR, KVLR * 2, NTOK, NKV, F.G, (int)blockIdx.x);
            pg8::EpiBf16<2> E{WSP(WS_KNV), NKV, SSQ(11 + 2 * lp)};
            pg8::gemm_phase<pg8::EpiBf16<2>, pg8::RegOrder, false>(ring, NDOWNP * 2, KVLR * 2, KVLR * 2, S, E);
            SEAM(pb + 2);
        }
        if (IN(pb + 3)) FORREP(pb + 3) { Frame F = make_frame(L); att::attn_phase((char*)lds + RING_OFF, WSP(WS_Q), WSP(WS_KNV), WSP(WS_KR), WSP(WS_DOWN), F.vcu, F.G); SEAM(pb + 3); }
        if (IN(pb + 4) && lp == 0) FORREP(pb + 4) { Frame F = make_frame(L);
            pg8::RegOrder S; S.init(WSP(WS_DOWN), DM * 2, WSP(WS_WO) + (size_t)lp * DM * DM, DM * 2, NTOK, DM, F.G, (int)blockIdx.x);
            pg8::EpiResidH<false> E{WSP(WS_H), LASTREP ? WSP(WS_H) : WSP(WS_DUMMY), LASTREP ? SSQ(4 * lp + 1) : SSQ(9), nullptr, 1.0f};
            pg8::gemm_phase<pg8::EpiResidH<false>, pg8::RegOrder, false>(ring, DM * 2, DM * 2, DM * 2, S, E);
            SEAM(pb + 4);
        }
        if (IN(pb + 4) && lp == 1) FORREP(pb + 4) { Frame F = make_frame(L);
            pg8::RegOrder S; S.init(WSP(WS_DOWN), DM * 2, WSP(WS_WO) + (size_t)lp * DM * DM, DM * 2, NTOK, DM, F.G, (int)blockIdx.x);
            pg8::EpiResidH<true> E{WSP(WS_H), LASTREP ? WSP(WS_H) : WSP(WS_DUMMY), LASTREP ? SSQ(4 * lp + 1) : SSQ(9), F.ws + WS_H8, 1.0f};
            pg8::gemm_phase<pg8::EpiResidH<true>, pg8::RegOrder, false>(ring, DM * 2, DM * 2, DM * 2, S, E);
            SEAM(pb + 4);
        }
#if defined(MK_EPI_PROBE)
        if (IN(pb + 5) && lp == 0 && !LASTREP) { Frame F = make_frame(L);
            pg8::RegOrder S; S.init(WSP(WS_H), DM * 2, WSP(WS_WGU) + (size_t)lp * 2 * FFD * DM, DM * 2, NTOK, 2 * FFD, F.G, (int)blockIdx.x);
#if MK_EPI_PROBE == 1
            pg8::EpiNull E{(float*)(F.ws + WS_DUMMY)};
            pg8::gemm_phase<pg8::EpiNull, pg8::RegOrder, false>(ring, DM * 2, DM * 2, DM * 2, S, E);
#else
            pg8::EpiBf16<0> E{WSP(WS_HID), FFD, nullptr};
            S.nN = FFD / 256; S.nwg = S.nM * S.nN;
            pg8::gemm_phase<pg8::EpiBf16<0>, pg8::RegOrder, false>(ring, DM * 2, DM * 2, DM * 2, S, E);
#endif
        }
        if (IN(pb + 5) && lp == 0 && LASTREP) FORREP(pb + 5) { Frame F = make_frame(L);
#else
        if (IN(pb + 5) && lp == 0) FORREP(pb + 5) { Frame F = make_frame(L);
#endif
            pg8::RegOrder S; S.init(WSP(WS_H), DM * 2, WSP(WS_WGU) + (size_t)lp * 2 * FFD * DM, DM * 2, NTOK, 2 * FFD, F.G, (int)blockIdx.x);
            pg8::EpiSwiglu<1> E{WSP(WS_HID), FFD, SSQ(4 * lp + 1), nullptr};
            pg8::gemm_phase<pg8::EpiSwiglu<1>, pg8::RegOrder, false>(ring, DM * 2, DM * 2, DM * 2, S, E, MK_STAG_BF);
            SEAM(pb + 5);
        }
        if (IN(pb + 5) && lp == 1) FORREP(pb + 5) { Frame F = make_frame(L);
            pg8::RegOrder S; S.init(F.ws + WS_H8, DM, F.ws + WS_WGU + (size_t)2 * FFD * DM * 2, DM, NTOK, 2 * FFD, F.G, (int)blockIdx.x);
            pg8::EpiSwigluF8<1> E{F.ws + WS_HID, FFD8, 2 * FFD / 256 - 1, SSQ(4 * lp + 1)};
            pg8::gemm_phase<pg8::EpiSwigluF8<1>, pg8::RegOrder, false, true>(ring, DM, DM, DM, S, E, MK_STAG_F8);
            SEAM(pb + 5);
        }
        if (IN(pb + 6) && lp == 0) FORREP(pb + 6) { Frame F = make_frame(L);
            pg8::RegOrder S; S.init(WSP(WS_HID), FFD * 2, WSP(WS_WD) + (size_t)lp * DM * FFD, FFD * 2, NTOK, DM, F.G, (int)blockIdx.x); S.rev = MK_REV;
            pg8::EpiResidH<false> E{WSP(WS_H), LASTREP ? WSP(WS_H) : WSP(WS_DUMMY), LASTREP ? SSQ(4 * lp + 2) : SSQ(9), nullptr, 1.0f};
            pg8::gemm_phase<pg8::EpiResidH<false>, pg8::RegOrder, false>(ring, FFD * 2, FFD * 2, FFD * 2, S, E);
            SEAM(pb + 6);
        }
        if (IN(pb + 6) && lp == 1) FORREP(pb + 6) { Frame F = make_frame(L);
            pg8::RegOrder S; S.init(F.ws + WS_HID, FFD8, F.ws + WS_WD + (size_t)DM * FFD * 2, FFD8, NTOK, DM, F.G, (int)blockIdx.x); S.rev = MK_REV;
            pg8::EpiResidH<false> E{WSP(WS_H), LASTREP ? WSP(WS_H) : WSP(WS_DUMMY), LASTREP ? SSQ(4 * lp + 2) : SSQ(9), nullptr, 1.0f / (pg8::FP8_SH * pg8::FP8_SW)};
            pg8::gemm_phase<pg8::EpiResidH<false>, pg8::RegOrder, false, true>(ring, FFD8, FFD8, FFD8, S, E);
            SEAM(pb + 6);
        }
        if (IN(pb + 7)) FORREP(pb + 7) { Frame F = make_frame(L); pool_phase(F, WSP(WS_H), SSQ(4 * lp + 2), ptab(L, 2) + (size_t)(2 * lp + 1) * DM, WSP(WS_DOWN)); SEAM(pb + 7); }
        if (IN(pb + 8)) FORREP(pb + 8) { Frame F = make_frame(L);
            pg8::RegOrder S; S.init(WSP(WS_DOWN), DM * 2, WSP(WS_WPOOL) + (size_t)lp * 4 * 256 * 256, 256 * 2, NTOK, DM, F.G, (int)blockIdx.x, 256 * 2);
            pg8::EpiResidH<false> E{WSP(WS_H), LASTREP ? WSP(WS_H) : WSP(WS_DUMMY), LASTREP ? SSQ(4 * lp + 3) : SSQ(9), nullptr, 1.0f};
            pg8::gemm_phase<pg8::EpiResidH<false>, pg8::RegOrder, false>(ring, DM * 2, 256 * 2, 256 * 2, S, E);
            SEAM(pb + 8);
        }
        if (IN(pb + 9)) FORREP(pb + 9) { Frame F = make_frame(L);
            if (lp == 0) router_phase<false>(F, WSP(WS_H), SSQ(4 * lp + 3), ptab(L, 3) + (size_t)(2 * lp + 1) * DM, ptab(L, 15) + (size_t)lp * DM * NEXP, (int*)(F.ws + WS_LIST), (float*)(F.ws + WS_RSL), (unsigned*)(F.ws + WS_TOKINFO), (unsigned*)(F.ctl + CW_CNT) + (LASTREP ? lp : 2 + lp) * 8 * 64, nullptr);
            else router_phase<true>(F, WSP(WS_H), SSQ(4 * lp + 3), ptab(L, 3) + (size_t)(2 * lp + 1) * DM, ptab(L, 15) + (size_t)lp * DM * NEXP, (int*)(F.ws + WS_LIST), (float*)(F.ws + WS_RSL), (unsigned*)(F.ws + WS_TOKINFO), (unsigned*)(F.ctl + CW_CNT) + (LASTREP ? lp : 2 + lp) * 8 * 64, F.ws + WS_H8);
            SEAM(pb + 9); }
#ifndef TEST_NO_BF16MOE
        if (IN(pb + 10) && lp == 0) FORREP(pb + 10) { Frame F = make_frame(L);
            MoeOrder<true> S; S.init((unsigned*)(F.ctl + CW_CNT) + lp * 8 * 64, WSP(WS_H), WSP(WS_MWGU), (const int*)(F.ws + WS_LIST), F.G, (int)blockIdx.x);
            pg8::EpiSwiglu<2> E{WSP(WS_HID), FFEP, (const float*)(F.ws + WS_RSL), (const int*)(F.ws + WS_LIST)};
            pg8::gemm_phase<pg8::EpiSwiglu<2>, MoeOrder<true>, true>(ring, DM * 2, DM * 2, DM * 2, S, E, MK_STAG_BF);
            SEAM(pb + 10);
        }
#endif
#ifndef TEST_NO_F8MOE
        if (IN(pb + 10) && lp == 1) FORREP(pb + 10) { Frame F = make_frame(L);
            MoeOrder<true, true> S; S.init((unsigned*)(F.ctl + CW_CNT) + lp * 8 * 64, F.ws + WS_H8, F.ws + WS_MWGU + (size_t)8 * 2 * FFEP * DM * 2, (const int*)(F.ws + WS_LIST), F.G, (int)blockIdx.x);
            pg8::EpiSwigluF8<0> E{F.ws + WS_HID, FFE8, 2 * FFEP / 256 - 1, nullptr};
            pg8::gemm_phase<pg8::EpiSwigluF8<0>, MoeOrder<true, true>, true, true>(ring, DM, DM, DM, S, E, MK_STAG_F8);
            SEAM(pb + 10);
        }
#endif
#ifndef TEST_NO_BF16MOE
        if (IN(pb + 11) && lp == 0) FORREP(pb + 11) { Frame F = make_frame(L);
            MoeOrder<false> S; S.init((unsigned*)(F.ctl + CW_CNT) + lp * 8 * 64, WSP(WS_HID), WSP(WS_MWD), (const int*)(F.ws + WS_LIST), F.G, (int)blockIdx.x); S.rev = MK_REV;
            pg8::EpiBf16<0> E{WSP(WS_YB), DM, nullptr};
            pg8::gemm_phase<pg8::EpiBf16<0>, MoeOrder<false>, false>(ring, FFEP * 2, FFEP * 2, FFEP * 2, S, E);
            SEAM(pb + 11);
        }
#endif
#ifndef TEST_NO_F8MOE
        if (IN(pb + 11) && lp == 1) FORREP(pb + 11) { Frame F = make_frame(L);
            MoeOrder<false, true> S; S.init((unsigned*)(F.ctl + CW_CNT) + lp * 8 * 64, F.ws + WS_HID, F.ws + WS_MWD + (size_t)8 * DM * FFEP * 2, (const int*)(F.ws + WS_LIST), F.G, (int)blockIdx.x); S.rev = MK_REV;
            pg8::EpiBf16Scaled E{WSP(WS_YB), DM, 1.0f / (pg8::FP8_SH * pg8::FP8_SW)};
            pg8::gemm_phase<pg8::EpiBf16Scaled, MoeOrder<false, true>, false, true>(ring, FFE8, FFE8, FFE8, S, E);
            SEAM(pb + 11);
        }
#endif
        if (IN(pb + 12)) FORREP(pb + 12) { Frame F = make_frame(L);
            if (lp == 0) combine_phase<false>(F, WSP(WS_H), LASTREP ? WSP(WS_H) : WSP(WS_DOWN), WSP(WS_YB), (const unsigned*)(F.ws + WS_TOKINFO), (unsigned*)(F.ctl + CW_CNT), LASTREP ? SSQ(4) : SSQ(9), nullptr, nullptr);
            else combine_phase<true>(F, WSP(WS_H), nullptr, WSP(WS_YB), (const unsigned*)(F.ws + WS_TOKINFO), (unsigned*)(F.ctl + CW_CNT) + 8 * 64, nullptr, ptab(L, 19), (float*)ptab(L, 20));
            SEAM(pb + 12);
        }
    }
#undef IN
#undef SEAM
#undef WSP
#undef SSQ
}

#ifndef MK_PER_PHASE
#define MK_PER_PHASE 0
#endif
extern "C" void kernel_launch(void* const* d_in, const int* in_sizes, int n_in, void* d_out, int out_size, void* d_ws, size_t ws_size, hipStream_t stream) {
    static int grid = 0;
    if (grid == 0) {
        if (n_in != 20 || in_sizes[0] != NTOK * DM || out_size != NTOK * DM || ws_size < WS_END) { fprintf(stderr, "kernel_launch: unexpected shapes (n_in %d, in0 %d, out %d, ws %zu < %zu)\n", n_in, n_in > 0 ? in_sizes[0] : -1, out_size, ws_size, (size_t)WS_END); grid = -1; return; }
        int dev = 0, cus = 0, per_cu = 0;
        if (hipGetDevice(&dev) != hipSuccess || hipDeviceGetAttribute(&cus, hipDeviceAttributeMultiprocessorCount, dev) != hipSuccess) { grid = -1; return; }
        if (hipFuncSetAttribute((const void*)fwd, hipFuncAttributeMaxDynamicSharedMemorySize, LDS_BYTES) != hipSuccess) { fprintf(stderr, "kernel_launch: hipFuncSetAttribute failed\n"); grid = -1; return; }
        if (hipOccupancyMaxActiveBlocksPerMultiprocessor(&per_cu, (const void*)fwd, NWAVES * 64, LDS_BYTES) != hipSuccess || per_cu < 1) fprintf(stderr, "kernel_launch: occupancy query reports %d\n", per_cu);
        (void)hipGetLastError();
        grid = cus;
    }
    if (grid < 0) return;
    if (hipMemsetAsync((char*)d_ws + WS_CTL, 0, CTL_ZERO_BYTES, stream) != hipSuccess) return;
    Args a{};
    for (int i = 0; i < 20; ++i) a.in[i] = (const float*)d_in[i];
    a.out = (float*)d_out; a.ws = (unsigned char*)d_ws;
#if MK_PER_PHASE
    for (int p = 0; p < NPHASE; ++p) { a.ph_lo = p; a.ph_hi = p + 1; a.li = 0; hipLaunchKernelGGL(fwd, dim3(grid), dim3(NWAVES * 64), LDS_BYTES, stream, a); }
#elif MK_REP_MASK
    { int cur = 0, li = 0;
      for (int k = 0; k < NPHASE; ++k) if ((MK_REP_MASK >> (k == 0 ? 0 : 1 + (k - 1) % 13)) & 1) {
          if (k > cur) { a.ph_lo = cur; a.ph_hi = k; a.li = li++; a.pad = 0; hipLaunchKernelGGL(fwd, dim3(grid), dim3(NWAVES * 64), LDS_BYTES, stream, a); }
          for (int r = 1; r < MK_REP_N; ++r) { a.ph_lo = k; a.ph_hi = k + 1; a.li = li++; a.pad = 1; hipLaunchKernelGGL(fwd, dim3(grid), dim3(NWAVES * 64), LDS_BYTES, stream, a); }
          cur = k; }
      a.ph_lo = cur; a.ph_hi = NPHASE; a.li = li++; a.pad = 0; hipLaunchKernelGGL(fwd, dim3(grid), dim3(NWAVES * 64), LDS_BYTES, stream, a); }
#elif defined(MK_TWICE)
    a.ph_lo = 0; a.ph_hi = NPHASE; a.li = 0;
    hipLaunchKernelGGL(fwd, dim3(grid), dim3(NWAVES * 64), LDS_BYTES, stream, a);
    (void)hipMemsetAsync((char*)d_ws + WS_CTL, 0, CTL_ZERO_BYTES, stream);
    hipLaunchKernelGGL(fwd, dim3(grid), dim3(NWAVES * 64), LDS_BYTES, stream, a);
#else
    a.ph_lo = 0; a.ph_hi = NPHASE; a.li = 0;
    hipLaunchKernelGGL(fwd, dim3(grid), dim3(NWAVES * 64), LDS_BYTES, stream, a);
#endif
}
```

```cpp
#include <hip/hip_runtime.h>
#include <cstdio>
#include <cstdint>

#define GAS __attribute__((address_space(1)))
#define LAS __attribute__((address_space(3)))
typedef unsigned short bf16_t;
typedef short bf16x8 __attribute__((ext_vector_type(8)));
typedef short s16x4 __attribute__((ext_vector_type(4)));
typedef float f32x2 __attribute__((ext_vector_type(2)));
typedef float f32x4 __attribute__((ext_vector_type(4)));
typedef float f32x16 __attribute__((ext_vector_type(16)));
typedef unsigned u32x2 __attribute__((ext_vector_type(2)));
typedef unsigned u32x4 __attribute__((ext_vector_type(4)));

constexpr int DM = 1024, NBATCH = 32, SEQ = 2048, NTOK = NBATCH * SEQ;
constexpr int NHEAD = 8, DNOPE = 128, DROPE = 64, DVH = 128, DQH = DNOPE + DROPE, QLR = 512, KVLR = 256;
constexpr int NDOWN = QLR + KVLR + DROPE  , NDOWNP = 1024;
constexpr int NQ = NHEAD * DQH  , NKV = NHEAD * (DNOPE + DVH)  ;
constexpr int FFD = 2688, NEXP = 8, FFE = 1344, FFEP = 1408;
constexpr int PSLOT = (NTOK * 2 / 256 + NEXP) * 256;
constexpr float RMS_EPS = 1e-6f;

__device__ __forceinline__ unsigned cvt_pk_bf16(float lo, float hi) { unsigned r; asm volatile("v_cvt_pk_bf16_f32 %0, %1, %2" : "=v"(r) : "v"(lo), "v"(hi)); return r; }
__device__ __forceinline__ int launder_v(int v) { asm volatile("" : "+v"(v)); return v; }
__device__ __forceinline__ float fp8_rt(float x, float s) { const int p = __builtin_amdgcn_cvt_pk_fp8_f32(x * s, 0.f, 0, false); return __builtin_amdgcn_cvt_f32_fp8(p, 0) * (1.0f / s); }
__device__ __forceinline__ float bf2f(unsigned short b) { return __uint_as_float((unsigned)b << 16); }
__device__ __forceinline__ float bflo(unsigned w) { return __uint_as_float(w << 16); }
__device__ __forceinline__ float bfhi(unsigned w) { return __uint_as_float(w & 0xffff0000u); }

typedef unsigned long long ssq_t;
__device__ __forceinline__ ssq_t ssq_fix(float s) { return (ssq_t)(s * 16777216.0f); }
__device__ __forceinline__ float rstd_n(ssq_t q, float invn) { return __builtin_amdgcn_rsqf(((float)(unsigned)(q >> 32) * 4294967296.0f + (float)(unsigned)q) * (1.0f / 16777216.0f) * invn + RMS_EPS); }
__device__ __forceinline__ float rstd_of(ssq_t q) { return rstd_n(q, 1.0f / DM); }
__device__ __forceinline__ float rstd_f(float ssq) { return __builtin_amdgcn_rsqf(ssq * (1.0f / DM) + RMS_EPS); }

namespace pg8 {
constexpr int BM = 256, BK = 64, HALF = 128, HTB = HALF * BK * 2  , STAGE_BYTES = 8 * HTB, NXCD = 8, WGM = 8;
__host__ __device__ __forceinline__ int lds_byte(int r, int c) { const int st = (r >> 4) * 2 + (c >> 5), rr = r & 15, cc = c & 31, ob = rr * 64 + cc * 2; return st * 1024 + (ob ^ (((ob >> 9) & 1) << 5)); }
__host__ __device__ __forceinline__ void stage_rc(int b, int& R, int& C) { const int st = b / 1024, sb = b % 1024, swz = sb ^ (((sb >> 9) & 1) << 5); R = (st >> 1) * 16 + swz / 64; C = (st & 1) * 32 + (swz % 64) / 2; }
__host__ __device__ __forceinline__ int perm32(int rho) { const int n = rho >> 4, i = rho & 15; return 8 * (i >> 2) + 4 * n + (i & 3); }

struct Unit { const char* a; const char* b; const int* rows; int nrows; int orow; int pn; int aux; };

struct RegOrder {
    const char* A; const char* B; unsigned a_tile, b_tile, a_colstep; int nM, nN, nwg, G, c, rev;
    __device__ __forceinline__ void init(const void* A_, size_t lda_b, const void* B_, size_t ldb_b, int M, int N, int G_, int c_, size_t a_colstep_ = 0) {
        A = (const char*)A_; B = (const char*)B_; a_tile = (unsigned)(256 * lda_b); b_tile = (unsigned)(256 * ldb_b); a_colstep = (unsigned)a_colstep_; nM = M / BM; nN = N / BM; nwg = nM * nN; G = G_; c = c_; rev = 0; }
    __device__ __forceinline__ bool next(int i, Unit& u) const {
        long L = (long)i * G + c; if (L >= nwg) return false;
        if (rev) L = nwg - 1 - L;
        int wgid = (int)L; { const int q = nwg / NXCD, r = nwg % NXCD, xcd = wgid % NXCD, off = wgid / NXCD; wgid = (xcd < r ? xcd * (q + 1) : r * (q + 1) + (xcd - r) * q) + off; }
        const int nig = WGM * nN, gid = wgid / nig, fm = gid * WGM, gsz = (nM - fm) < WGM ? (nM - fm) : WGM;
        const int pm = fm + ((wgid % nig) % gsz), pn = (wgid % nig) / gsz;
        u.a = A + (size_t)pm * a_tile + (size_t)pn * a_colstep; u.b = B + (size_t)pn * b_tile; u.rows = nullptr; u.nrows = 256; u.orow = pm * BM; u.pn = pn; u.aux = 0; return true;
    }
};

template <int RS> struct EpiBf16 {
    static constexpr bool PERM = true;
    bf16_t* O; int ldc; const ssq_t* rs;
    __device__ __forceinline__ void operator()(const f32x4 (&acc)[2][2][4][2], const Unit& u, int wr, int wc, int fr, int fq) const {
        const int row0 = u.orow + launder_v(wr * 64 + fr), col0 = u.pn * BM + wc * 32 + 8 * fq;
        float sc[2][4]; ssq_t rq[2][4];
#pragma unroll
        for (int ai = 0; ai < 2; ++ai)
#pragma unroll
            for (int m = 0; m < 4; ++m) { const int row = row0 + ai * HALF + m * 16; if constexpr (RS != 0) rq[ai][m] = rs[row]; }
#pragma unroll
        for (int ai = 0; ai < 2; ++ai)
#pragma unroll
            for (int m = 0; m < 4; ++m) { sc[ai][m] = 1.0f; if constexpr (RS == 1) sc[ai][m] = rstd_of(rq[ai][m]); if constexpr (RS == 2) sc[ai][m] = rstd_n(rq[ai][m], 1.0f / KVLR); }
#pragma unroll
        for (int ai = 0; ai < 2; ++ai)
#pragma unroll
            for (int m = 0; m < 4; ++m) { const int row = row0 + ai * HALF + m * 16; bf16_t* rowp = O + (size_t)row * ldc + col0;
#pragma unroll
                for (int bj = 0; bj < 2; ++bj) { const f32x4 v0 = acc[ai][bj][m][0] * sc[ai][m], v1 = acc[ai][bj][m][1] * sc[ai][m];
                    u32x4 w; w.x = cvt_pk_bf16(v0[0], v0[1]); w.y = cvt_pk_bf16(v0[2], v0[3]); w.z = cvt_pk_bf16(v1[0], v1[1]); w.w = cvt_pk_bf16(v1[2], v1[3]);
                    *(u32x4*)(rowp + bj * HALF) = w; } }
    }
};
__device__ __forceinline__ float silu_mul(float g, float u) { return g * u * __builtin_amdgcn_rcpf(1.0f + __builtin_amdgcn_exp2f(-1.4426950408889634f * g)); }
template <int RS> struct EpiSwiglu {
    static constexpr bool PERM = true;
    bf16_t* H; int ldh; const void* rs; const int* list;
    __device__ __forceinline__ void operator()(const f32x4 (&acc)[2][2][4][2], const Unit& u, int wr, int wc, int fr, int fq) const {
        const int r0 = launder_v(wr * 64 + fr), col0 = u.pn * HALF + wc * 32 + 8 * fq;
        const ssq_t* rsq = (const ssq_t*)rs; const float* rsp = (const float*)rs; if constexpr (RS == 2) rsp = rsp + (u.rows - list);
        float sc[2][4]; ssq_t rq[2][4];
#pragma unroll
        for (int ai = 0; ai < 2; ++ai)
#pragma unroll
            for (int m = 0; m < 4; ++m) { const int r = r0 + ai * HALF + m * 16; if constexpr (RS == 1) rq[ai][m] = rsq[u.orow + r]; else sc[ai][m] = rsp[r]; }
        if constexpr (RS == 1) {
#pragma unroll
            for (int ai = 0; ai < 2; ++ai)
#pragma unroll
                for (int m = 0; m < 4; ++m) sc[ai][m] = rstd_of(rq[ai][m]); }
#pragma unroll
        for (int ai = 0; ai < 2; ++ai)
#pragma unroll
            for (int m = 0; m < 4; ++m) { const int r = r0 + ai * HALF + m * 16; bf16_t* rowp = H + (size_t)(u.orow + r) * ldh + col0; const float s = sc[ai][m];
                const f32x4 g0 = acc[ai][0][m][0] * s, g1 = acc[ai][0][m][1] * s, u0 = acc[ai][1][m][0] * s, u1 = acc[ai][1][m][1] * s;
                u32x4 w; w.x = cvt_pk_bf16(silu_mul(g0[0], u0[0]), silu_mul(g0[1], u0[1])); w.y = cvt_pk_bf16(silu_mul(g0[2], u0[2]), silu_mul(g0[3], u0[3]));
                w.z = cvt_pk_bf16(silu_mul(g1[0], u1[0]), silu_mul(g1[1], u1[1])); w.w = cvt_pk_bf16(silu_mul(g1[2], u1[2]), silu_mul(g1[3], u1[3]));
                __builtin_nontemporal_store(w, (u32x4*)rowp); }
    }
};
constexpr float FP8_SA = 16.0f, FP8_SW = 256.0f, FP8_SH = 16.0f, FP8_SX = 8.0f;
__device__ __forceinline__ unsigned pk4_fp8(float a, float b, float c, float d) { int p = __builtin_amdgcn_cvt_pk_fp8_f32(a, b, 0, false); p = __builtin_amdgcn_cvt_pk_fp8_f32(c, d, p, true); return (unsigned)p; }
template <int RS> struct EpiSwigluF8 {
    static constexpr bool PERM = true;
    unsigned char* H8; int ldh; int pad_tile; const ssq_t* rs;
    __device__ __forceinline__ void operator()(const f32x4 (&acc)[2][2][4][2], const Unit& u, int wr, int wc, int fr, int fq) const {
        const int r0 = launder_v(wr * 64 + fr), col0 = u.pn * HALF + wc * 32 + 8 * fq;
        float sc[2][4]; ssq_t rq[2][4];
#pragma unroll
        for (int ai = 0; ai < 2; ++ai)
#pragma unroll
            for (int m = 0; m < 4; ++m) { if constexpr (RS == 1) rq[ai][m] = rs[u.orow + r0 + ai * HALF + m * 16]; }
#pragma unroll
        for (int ai = 0; ai < 2; ++ai)
#pragma unroll
            for (int m = 0; m < 4; ++m) { if constexpr (RS == 1) sc[ai][m] = rstd_of(rq[ai][m]) * (1.0f / (FP8_SX * FP8_SW)); else sc[ai][m] = 1.0f / (FP8_SA * FP8_SW); }
#pragma unroll
        for (int ai = 0; ai < 2; ++ai)
#pragma unroll
            for (int m = 0; m < 4; ++m) { const int r = r0 + ai * HALF + m * 16; unsigned char* rowp = H8 + (size_t)(u.orow + r) * ldh + col0; const float s = sc[ai][m];
                const f32x4 g0 = acc[ai][0][m][0] * s, g1 = acc[ai][0][m][1] * s, u0 = acc[ai][1][m][0] * s, u1 = acc[ai][1][m][1] * s;
                u32x2 w; w.x = pk4_fp8(silu_mul(g0[0], u0[0]) * FP8_SH, silu_mul(g0[1], u0[1]) * FP8_SH, silu_mul(g0[2], u0[2]) * FP8_SH, silu_mul(g0[3], u0[3]) * FP8_SH);
                w.y = pk4_fp8(silu_mul(g1[0], u1[0]) * FP8_SH, silu_mul(g1[1], u1[1]) * FP8_SH, silu_mul(g1[2], u1[2]) * FP8_SH, silu_mul(g1[3], u1[3]) * FP8_SH);
                __builtin_nontemporal_store(w, (u32x2*)rowp);
                if (u.pn == pad_tile) { u32x2 z; asm volatile("v_mov_b32 %0, 0\n\tv_mov_b32 %1, 0" : "=v"(z.x), "=v"(z.y)); *(u32x2*)(rowp + HALF) = z; } }
    }
};
struct EpiBf16Scaled {
    static constexpr bool PERM = true;
    bf16_t* O; int ldc; float scale;
    __device__ __forceinline__ void operator()(const f32x4 (&acc)[2][2][4][2], const Unit& u, int wr, int wc, int fr, int fq) const {
        const int row0 = u.orow + launder_v(wr * 64 + fr), col0 = u.pn * BM + wc * 32 + 8 * fq;
#pragma unroll
        for (int ai = 0; ai < 2; ++ai)
#pragma unroll
            for (int m = 0; m < 4; ++m) { bf16_t* rowp = O + (size_t)(row0 + ai * HALF + m * 16) * ldc + col0;
#pragma unroll
                for (int bj = 0; bj < 2; ++bj) { const f32x4 v0 = acc[ai][bj][m][0] * scale, v1 = acc[ai][bj][m][1] * scale;
                    u32x4 w; w.x = cvt_pk_bf16(v0[0], v0[1]); w.y = cvt_pk_bf16(v0[2], v0[3]); w.z = cvt_pk_bf16(v1[0], v1[1]); w.w = cvt_pk_bf16(v1[2], v1[3]);
                    *(u32x4*)(rowp + bj * HALF) = w; } }
    }
};
struct EpiNull {
    static constexpr bool PERM = true;
    float* sink;
    __device__ __forceinline__ void operator()(const f32x4 (&acc)[2][2][4][2], const Unit& u, int wr, int wc, int fr, int fq) const {
        float s = 0.f;
#pragma unroll
        for (int ai = 0; ai < 2; ++ai)
#pragma unroll
            for (int bj = 0; bj < 2; ++bj)
#pragma unroll
                for (int m = 0; m < 4; ++m)
#pragma unroll
                    for (int n = 0; n < 2; ++n) s += acc[ai][bj][m][n][0];
        if (s == 12345.678f) sink[0] = s;
    }
};
template <bool W8> struct EpiResidH {
    static constexpr bool PERM = true;
    const bf16_t* hin; bf16_t* hout; ssq_t* ssq; unsigned char* h8; float scale;
    __device__ __forceinline__ void operator()(const f32x4 (&acc)[2][2][4][2], const Unit& u, int wr, int wc, int fr, int fq) const {
        const int row0 = u.orow + launder_v(wr * 64 + fr), col0 = u.pn * BM + wc * 32 + 8 * fq;
        float part[2][4];
#pragma unroll
        for (int ai = 0; ai < 2; ++ai) {
            u32x4 hv[4][2];
#pragma unroll
            for (int m = 0; m < 4; ++m)
#pragma unroll
                for (int bj = 0; bj < 2; ++bj) hv[m][bj] = *(const u32x4*)(hin + (size_t)(row0 + ai * HALF + m * 16) * DM + col0 + bj * HALF);
#pragma unroll
            for (int m = 0; m < 4; ++m) { const int row = row0 + ai * HALF + m * 16; const size_t off = (size_t)row * DM + col0; float pt = 0.f;
#pragma unroll
                for (int bj = 0; bj < 2; ++bj) { const u32x4 h4 = hv[m][bj]; const f32x4 a0 = acc[ai][bj][m][0] * scale, a1 = acc[ai][bj][m][1] * scale;
                    const float y0 = bflo(h4.x) + a0[0], y1 = bfhi(h4.x) + a0[1], y2 = bflo(h4.y) + a0[2], y3 = bfhi(h4.y) + a0[3], y4 = bflo(h4.z) + a1[0], y5 = bfhi(h4.z) + a1[1], y6 = bflo(h4.w) + a1[2], y7 = bfhi(h4.w) + a1[3];
                    pt += (y0 * y0 + y1 * y1) + (y2 * y2 + y3 * y3) + (y4 * y4 + y5 * y5) + (y6 * y6 + y7 * y7);
                    u32x4 w; w.x = cvt_pk_bf16(y0, y1); w.y = cvt_pk_bf16(y2, y3); w.z = cvt_pk_bf16(y4, y5); w.w = cvt_pk_bf16(y6, y7);
                    *(u32x4*)(hout + off + bj * HALF) = w;
                    if constexpr (W8) { u32x2 q; q.x = pk4_fp8(y0 * FP8_SX, y1 * FP8_SX, y2 * FP8_SX, y3 * FP8_SX); q.y = pk4_fp8(y4 * FP8_SX, y5 * FP8_SX, y6 * FP8_SX, y7 * FP8_SX); *(u32x2*)(h8 + off + bj * HALF) = q; } }
                pt += __shfl_xor(pt, 16); pt += __shfl_xor(pt, 32); part[ai][m] = pt; }
        }
        if (fq == 0) {
#pragma unroll
            for (int ai = 0; ai < 2; ++ai)
#pragma unroll
                for (int m = 0; m < 4; ++m) atomicAdd(ssq + row0 + ai * HALF + m * 16, ssq_fix(part[ai][m])); }
    }
};
struct EpiDown {
    static constexpr bool PERM = true;
    bf16_t* O; bf16_t* KR; const ssq_t* rs; ssq_t* ssq_q; ssq_t* ssq_kv; const float* cosT; const float* sinT;
    __device__ __forceinline__ void operator()(const f32x4 (&acc)[2][2][4][2], const Unit& u, int wr, int wc, int fr, int fq) const {
        const int row0 = u.orow + launder_v(wr * 64 + fr);
        float sc[2][4]; ssq_t rq[2][4];
#pragma unroll
        for (int ai = 0; ai < 2; ++ai)
#pragma unroll
            for (int m = 0; m < 4; ++m) rq[ai][m] = rs[row0 + ai * HALF + m * 16];
#pragma unroll
        for (int ai = 0; ai < 2; ++ai)
#pragma unroll
            for (int m = 0; m < 4; ++m) sc[ai][m] = rstd_of(rq[ai][m]);
        if (u.pn < 3) {
            ssq_t* sq = u.pn < 2 ? ssq_q : ssq_kv; const int col0 = u.pn * BM + wc * 32 + 8 * fq; float pts[2][4];
#pragma unroll
            for (int ai = 0; ai < 2; ++ai)
#pragma unroll
                for (int m = 0; m < 4; ++m) { const int row = row0 + ai * HALF + m * 16; bf16_t* rowp = O + (size_t)row * NDOWNP + col0; const float s = sc[ai][m]; float part = 0.f;
#pragma unroll
                    for (int bj = 0; bj < 2; ++bj) { const f32x4 v0 = acc[ai][bj][m][0] * s, v1 = acc[ai][bj][m][1] * s;
                        part += (v0[0] * v0[0] + v0[1] * v0[1]) + (v0[2] * v0[2] + v0[3] * v0[3]) + (v1[0] * v1[0] + v1[1] * v1[1]) + (v1[2] * v1[2] + v1[3] * v1[3]);
                        u32x4 w; w.x = cvt_pk_bf16(v0[0], v0[1]); w.y = cvt_pk_bf16(v0[2], v0[3]); w.z = cvt_pk_bf16(v1[0], v1[1]); w.w = cvt_pk_bf16(v1[2], v1[3]);
                        *(u32x4*)(rowp + bj * HALF) = w; }
                    part += __shfl_xor(part, 16); part += __shfl_xor(part, 32); pts[ai][m] = part; }
            if (fq == 0) {
#pragma unroll
                for (int ai = 0; ai < 2; ++ai)
#pragma unroll
                    for (int m = 0; m < 4; ++m) atomicAdd(sq + row0 + ai * HALF + m * 16, ssq_fix(pts[ai][m])); }
        } else if (wc == 0) {
#pragma unroll
            for (int aq = 0; aq < 4; ++aq) { const int ai = aq >> 1, mb = (aq & 1) * 2; f32x4 ct[4][2], st[4][2];
#pragma unroll
                for (int m = mb; m < mb + 2; ++m) { const size_t to = (size_t)(row0 + ai * HALF + m * 16) * 32 + 8 * fq;
                    ct[m][0] = *(const f32x4*)(cosT + to); ct[m][1] = *(const f32x4*)(cosT + to + 4); st[m][0] = *(const f32x4*)(sinT + to); st[m][1] = *(const f32x4*)(sinT + to + 4); }
#pragma unroll
                for (int m = mb; m < mb + 2; ++m) { const int row = row0 + ai * HALF + m * 16; const float s = sc[ai][m];
                    const f32x4 a0 = acc[ai][0][m][0] * s, a1 = acc[ai][0][m][1] * s, b0 = acc[ai][1][m][0] * s, b1 = acc[ai][1][m][1] * s;
                    const f32x4 x0 = a0 * ct[m][0] - b0 * st[m][0], x1 = a1 * ct[m][1] - b1 * st[m][1], y0 = b0 * ct[m][0] + a0 * st[m][0], y1 = b1 * ct[m][1] + a1 * st[m][1];
                    bf16_t* rp = KR + (size_t)row * DROPE + 8 * fq;
                    u32x4 w; w.x = cvt_pk_bf16(x0[0], x0[1]); w.y = cvt_pk_bf16(x0[2], x0[3]); w.z = cvt_pk_bf16(x1[0], x1[1]); w.w = cvt_pk_bf16(x1[2], x1[3]);
                    *(u32x4*)rp = w;
                    w.x = cvt_pk_bf16(y0[0], y0[1]); w.y = cvt_pk_bf16(y0[2], y0[3]); w.z = cvt_pk_bf16(y1[0], y1[1]); w.w = cvt_pk_bf16(y1[2], y1[3]);
                    *(u32x4*)(rp + 32) = w; } }
        }
    }
};
struct EpiQ {
    static constexpr bool PERM = true;
    bf16_t* Q; const float* cosT; const float* sinT; const ssq_t* rs;
    __device__ __forceinline__ void operator()(const f32x4 (&acc)[2][2][4][2], const Unit& u, int wr, int wc, int fr, int fq) const {
        const int row0 = u.orow + launder_v(wr * 64 + fr);
        float sc[2][4]; ssq_t rq[2][4];
#pragma unroll
        for (int ai = 0; ai < 2; ++ai)
#pragma unroll
            for (int m = 0; m < 4; ++m) rq[ai][m] = rs[row0 + ai * HALF + m * 16];
#pragma unroll
        for (int ai = 0; ai < 2; ++ai)
#pragma unroll
            for (int m = 0; m < 4; ++m) sc[ai][m] = rstd_n(rq[ai][m], 1.0f / QLR);
        if (u.pn < 2) {
            const int h = 4 * u.pn + wc;
#pragma unroll
            for (int aq = 0; aq < 4; ++aq) { const int ai = aq >> 1, mb = (aq & 1) * 2; f32x4 ct[4][2], st[4][2];
#pragma unroll
                for (int m = mb; m < mb + 2; ++m) { const size_t to = (size_t)(row0 + ai * HALF + m * 16) * 32 + 8 * fq;
                    ct[m][0] = *(const f32x4*)(cosT + to); ct[m][1] = *(const f32x4*)(cosT + to + 4); st[m][0] = *(const f32x4*)(sinT + to); st[m][1] = *(const f32x4*)(sinT + to + 4); }
#pragma unroll
                for (int m = mb; m < mb + 2; ++m) { const int row = row0 + ai * HALF + m * 16; const float s = sc[ai][m];
                    const f32x4 a0 = acc[ai][0][m][0] * s, a1 = acc[ai][0][m][1] * s, b0 = acc[ai][1][m][0] * s, b1 = acc[ai][1][m][1] * s;
                    const f32x4 x0 = a0 * ct[m][0] - b0 * st[m][0], x1 = a1 * ct[m][1] - b1 * st[m][1], y0 = b0 * ct[m][0] + a0 * st[m][0], y1 = b1 * ct[m][1] + a1 * st[m][1];
                    bf16_t* rp = Q + (size_t)row * NQ + h * DQH + DNOPE + 8 * fq;
                    u32x4 w; w.x = cvt_pk_bf16(x0[0], x0[1]); w.y = cvt_pk_bf16(x0[2], x0[3]); w.z = cvt_pk_bf16(x1[0], x1[1]); w.w = cvt_pk_bf16(x1[2], x1[3]);
                    *(u32x4*)rp = w;
                    w.x = cvt_pk_bf16(y0[0], y0[1]); w.y = cvt_pk_bf16(y0[2], y0[3]); w.z = cvt_pk_bf16(y1[0], y1[1]); w.w = cvt_pk_bf16(y1[2], y1[3]);
                    *(u32x4*)(rp + 32) = w; } }
        } else {
#pragma unroll
            for (int ai = 0; ai < 2; ++ai)
#pragma unroll
                for (int m = 0; m < 4; ++m) { const int row = row0 + ai * HALF + m * 16; const float s = sc[ai][m];
#pragma unroll
                    for (int bj = 0; bj < 2; ++bj) { const int h = 2 * (u.pn - 2) + bj; const f32x4 v0 = acc[ai][bj][m][0] * s, v1 = acc[ai][bj][m][1] * s;
                        u32x4 w; w.x = cvt_pk_bf16(v0[0], v0[1]); w.y = cvt_pk_bf16(v0[2], v0[3]); w.z = cvt_pk_bf16(v1[0], v1[1]); w.w = cvt_pk_bf16(v1[2], v1[3]);
                        *(u32x4*)(Q + (size_t)row * NQ + h * DQH + wc * 32 + 8 * fq) = w; } }
        }
    }
};

__device__ __forceinline__ unsigned gather_off(const Unit& u, int idx, unsigned lda_b, unsigned cb) { const int tok = idx < u.nrows ? u.rows[idx] : 0; return (unsigned)tok * lda_b + cb; }
__device__ __forceinline__ u32x4 gather_offs(const Unit& u, int tid, unsigned lda_b) {
    const int t2 = launder_v(tid); int R0, C0, R1, C1; stage_rc(t2 * 16, R0, C0); stage_rc(t2 * 16 + 8192, R1, C1);
    u32x4 pk; pk.x = gather_off(u, R0, lda_b, (unsigned)C0 * 2u); pk.y = gather_off(u, R1, lda_b, (unsigned)C1 * 2u); pk.z = gather_off(u, HALF + R0, lda_b, (unsigned)C0 * 2u); pk.w = gather_off(u, HALF + R1, lda_b, (unsigned)C1 * 2u);
    return pk;
}
typedef int i32x4 __attribute__((ext_vector_type(4)));
typedef int i32x8 __attribute__((ext_vector_type(8)));
template <class Epi, class Sched, bool GATHER, bool FP8 = false>
__device__ __forceinline__ void gemm_phase(LAS unsigned char* lds, const unsigned lda_b, const unsigned ldb_b, const int Kb, const Sched& S, const Epi& E, const unsigned stag_ticks = 0u) {
    if (stag_ticks) { const unsigned long long t0 = __builtin_amdgcn_s_memrealtime(), dl = (unsigned long long)((blockIdx.x >> 3) & 3u) * stag_ticks;
        while (__builtin_amdgcn_s_memrealtime() - t0 < dl) __builtin_amdgcn_s_sleep(8); }
    const int tid = launder_v((int)threadIdx.x), wid = __builtin_amdgcn_readfirstlane(tid >> 6), lane = tid & 63, wr = wid >> 2, wc = wid & 3, fr = lane & 15, fq = lane >> 4;
    int nt = Kb / (BK * 2); asm volatile("" : "+s"(nt));
    unsigned voffA[2], voffB[2];
#pragma unroll
    for (int i = 0; i < 2; ++i) { int R, C; stage_rc(tid * 16 + i * 8192, R, C); const int Rb = Epi::PERM ? ((R & ~31) + perm32(R & 31)) : R;
        voffA[i] = (unsigned)R * lda_b + (unsigned)C * 2u; voffB[i] = (unsigned)Rb * ldb_b + (unsigned)C * 2u; }
    const size_t kstep = (size_t)(BK * 2);
    const size_t hstepA = (size_t)HALF * lda_b, hstepB = (size_t)HALF * ldb_b;
    const unsigned ldsw = (unsigned)wid * 1024u, ldsbase = (unsigned)__builtin_amdgcn_readfirstlane((int)(unsigned)(size_t)lds);
    const int aoff = lds_byte(wr * 64 + fr, fq * 8), boff = lds_byte(wc * 32 + fr, fq * 8);
    unsigned cv0[2] = {0u, 0u}, cv1[2] = {0u, 0u}, nv0[2] = {0u, 0u}, nv1[2] = {0u, 0u};
#define PG8_SA(b, h) (((b) * 2 + (h)) * HTB)
#define PG8_SB(b, h) ((4 + (b) * 2 + (h)) * HTB)
#define PG8_LOAD16(sbase, voff, ldsoff) do { unsigned _keep; asm volatile("s_mov_b32 %0, m0\n\ts_mov_b32 m0, %3\n\ts_nop 0\n\tglobal_load_lds_dwordx4 %1, %2\n\ts_mov_b32 m0, %0" \
        : "=&s"(_keep) : "v"(voff), "s"(sbase), "s"(ldsbase + (unsigned)(ldsoff)) : "memory"); } while (0)
#define PG8_STAGE_B(bufoff, gbase, h) do { _Pragma("unroll") for (int _i = 0; _i < 2; ++_i) PG8_LOAD16((gbase) + (h) * hstepB, voffB[_i], (bufoff) + ldsw + _i * 8192); } while (0)
#define PG8_STAGE_A(bufoff, gbase, h, usenext) do { _Pragma("unroll") for (int _i = 0; _i < 2; ++_i) { unsigned _vo; \
        if constexpr (GATHER) { _vo = (usenext) ? ((h) ? nv1[_i] : nv0[_i]) : ((h) ? cv1[_i] : cv0[_i]); PG8_LOAD16((gbase), _vo, (bufoff) + ldsw + _i * 8192); } \
        else { PG8_LOAD16((gbase) + (h) * hstepA, voffA[_i], (bufoff) + ldsw + _i * 8192); } } } while (0)
#define PG8_LD32(off) __builtin_shufflevector(*(const LAS i32x4*)(lds + (off)), *(const LAS i32x4*)(lds + (off) + 1024), 0, 1, 2, 3, 4, 5, 6, 7)
#define PG8_LDA(dst, b, h) do { _Pragma("unroll") for (int m = 0; m < 4; ++m) { if constexpr (FP8) { dst##8[m] = PG8_LD32(PG8_SA(b, h) + aoff + m * 2048); } else { _Pragma("unroll") for (int k = 0; k < 2; ++k) dst[m][k] = *(const LAS bf16x8*)(lds + PG8_SA(b, h) + aoff + m * 2048 + k * 1024); } } } while (0)
#define PG8_LDB(dst, b, h) do { _Pragma("unroll") for (int n = 0; n < 2; ++n) { if constexpr (FP8) { dst##8[n] = PG8_LD32(PG8_SB(b, h) + boff + n * 2048); } else { _Pragma("unroll") for (int k = 0; k < 2; ++k) dst[n][k] = *(const LAS bf16x8*)(lds + PG8_SB(b, h) + boff + n * 2048 + k * 1024); } } } while (0)
#define PG8_MMA(ai, bj, At, Bt) do { __builtin_amdgcn_s_setprio(1); _Pragma("unroll") for (int m = 0; m < 4; ++m) _Pragma("unroll") for (int n = 0; n < 2; ++n) { \
        if constexpr (FP8) { asm volatile("v_mfma_f32_16x16x128_f8f6f4 %0, %1, %2, %0" : "+v"(acc[ai][bj][m][n]) : "v"(Bt##8[n]), "v"(At##8[m])); }     \
        else { _Pragma("unroll") for (int k = 0; k < 2; ++k) acc[ai][bj][m][n] = __builtin_amdgcn_mfma_f32_16x16x32_bf16(Bt[n][k], At[m][k], acc[ai][bj][m][n], 0, 0, 0); } } \
        __builtin_amdgcn_s_setprio(0); } while (0)
#define PG8_WAIT_V(n) asm volatile("s_waitcnt vmcnt(" #n ")" ::: "memory")
#define PG8_WAIT_L(n) asm volatile("s_waitcnt lgkmcnt(" #n ")" ::: "memory")
#define PG8_BAR __builtin_amdgcn_s_barrier()
#define PG8_SCHED __builtin_amdgcn_sched_barrier(0)
    Unit cur, nxt; int ui = 0;
    (void)S.next(0, cur);
    f32x4 acc[2][2][4][2];
#pragma unroll
    for (int a = 0; a < 2; ++a)
#pragma unroll
        for (int b = 0; b < 2; ++b)
#pragma unroll
            for (int m = 0; m < 4; ++m)
#pragma unroll
                for (int n = 0; n < 2; ++n) acc[a][b][m][n] = (f32x4){0.f, 0.f, 0.f, 0.f};
    bf16x8 At[4][2], B0[2][2], B1[2][2]; i32x8 At8[4], B08[2], B18[2];
    const char* cA = cur.a; const char* cB = cur.b;
    if constexpr (GATHER) { const u32x4 pk = gather_offs(cur, tid, lda_b); cv0[0] = pk.x; cv0[1] = pk.y; cv1[0] = pk.z; cv1[1] = pk.w; }
    PG8_STAGE_B(PG8_SB(0, 0), cB, 0); PG8_SCHED; PG8_STAGE_B(PG8_SB(0, 1), cB, 1); PG8_SCHED; PG8_STAGE_A(PG8_SA(0, 0), cA, 0, false); PG8_SCHED; PG8_STAGE_A(PG8_SA(0, 1), cA, 1, false);
    if (wr == 1) PG8_BAR;
    PG8_WAIT_V(2); PG8_BAR;
    PG8_STAGE_B(PG8_SB(1, 0), cB + kstep, 0); PG8_SCHED; PG8_STAGE_A(PG8_SA(1, 0), cA + kstep, 0, false); PG8_SCHED; PG8_STAGE_B(PG8_SB(1, 1), cB + kstep, 1);
    PG8_WAIT_V(6); PG8_BAR;
    for (;;) {
        int has_next = 0; const char* nA = cA; const char* nB = cB;
        if constexpr (GATHER) { has_next = __builtin_amdgcn_readfirstlane(S.next(ui + 1, nxt) ? 1 : 0); nA = has_next ? nxt.a : cA; nB = has_next ? nxt.b : cB; }
        if constexpr (GATHER) {
            u32x4 pk = (u32x4){cv0[0], cv0[1], cv1[0], cv1[1]}; if (has_next) pk = gather_offs(nxt, tid, lda_b);
            *(LAS u32x4*)(lds + STAGE_BYTES + 1024 + tid * 16) = pk;
        }
#pragma nounroll
        for (int t = 0; t < nt; t += 2) {
            const bool last = (t == nt - 2);
            if constexpr (!GATHER) { if (last) { int uin = ui + 1; asm volatile("" : "+s"(uin)); has_next = __builtin_amdgcn_readfirstlane(S.next(uin, nxt) ? 1 : 0); nA = has_next ? nxt.a : cA; nB = has_next ? nxt.b : cB; } }
            if constexpr (GATHER) { if (last) { const u32x4 pk = *(const LAS u32x4*)(lds + STAGE_BYTES + 1024 + tid * 16); nv0[0] = pk.x; nv0[1] = pk.y; nv1[0] = pk.z; nv1[1] = pk.w; } }
            const char* a1 = cA + (size_t)(t + 1) * kstep;
            const char* a2 = last ? nA : cA + (size_t)(t + 2) * kstep; const char* b2 = last ? nB : cB + (size_t)(t + 2) * kstep;
            const char* a3 = a2 + kstep; const char* b3 = b2 + kstep;
            PG8_LDB(B0, 0, 0); PG8_LDB(B1, 0, 1); PG8_SCHED; PG8_LDA(At, 0, 0); PG8_STAGE_A(PG8_SA(1, 1), a1, 1, false);
            PG8_WAIT_V(8); PG8_WAIT_L(0); PG8_BAR; PG8_MMA(0, 0, At, B0); PG8_MMA(0, 1, At, B1); PG8_BAR; PG8_SCHED;
            PG8_LDA(At, 0, 1); PG8_STAGE_B(PG8_SB(0, 0), b2, 0); PG8_STAGE_B(PG8_SB(0, 1), b2, 1); PG8_STAGE_A(PG8_SA(0, 0), a2, 0, last);
            PG8_WAIT_V(8); PG8_WAIT_L(0); PG8_BAR; PG8_MMA(1, 0, At, B0); PG8_MMA(1, 1, At, B1); PG8_BAR; PG8_SCHED;
            PG8_LDB(B0, 1, 0); PG8_LDB(B1, 1, 1); PG8_SCHED; PG8_LDA(At, 1, 0); PG8_STAGE_A(PG8_SA(0, 1), a2, 1, last);
            PG8_WAIT_V(8); PG8_WAIT_L(0); PG8_BAR; PG8_MMA(0, 0, At, B0); PG8_MMA(0, 1, At, B1); PG8_BAR; PG8_SCHED;
            PG8_LDA(At, 1, 1); PG8_STAGE_B(PG8_SB(1, 0), b3, 0); PG8_STAGE_B(PG8_SB(1, 1), b3, 1); PG8_STAGE_A(PG8_SA(1, 0), a3, 0, last);
            PG8_WAIT_V(8); PG8_WAIT_L(0); PG8_BAR; PG8_MMA(1, 0, At, B0); PG8_MMA(1, 1, At, B1); PG8_BAR; PG8_SCHED;
        }
        if (wr == 0) PG8_BAR;
        if constexpr (FP8) asm volatile("s_nop 15\n\ts_nop 15" ::: "memory");
        E(acc, cur, wr, wc, fr, fq);
        if (!has_next) break;
#pragma unroll
        for (int a = 0; a < 2; ++a)
#pragma unroll
            for (int b = 0; b < 2; ++b)
#pragma unroll
                for (int m = 0; m < 4; ++m)
#pragma unroll
                    for (int n = 0; n < 2; ++n) acc[a][b][m][n] = (f32x4){0.f, 0.f, 0.f, 0.f};
        cur = nxt; cA = nA; cB = nB; ++ui;
        if constexpr (GATHER) {
#pragma unroll
            for (int i = 0; i < 2; ++i) { cv0[i] = nv0[i]; cv1[i] = nv1[i]; }
        }
        if (wr == 1) PG8_BAR;
    }
    PG8_WAIT_V(0);
    PG8_BAR;
#undef PG8_SA
#undef PG8_SB
#undef PG8_LOAD16
#undef PG8_STAGE_A
#undef PG8_STAGE_B
#undef PG8_LDA
#undef PG8_LDB
#undef PG8_LD32
#undef PG8_MMA
#undef PG8_WAIT_V
#undef PG8_WAIT_L
#undef PG8_BAR
#undef PG8_SCHED
}
}
namespace att {
constexpr int NW = 8, QBLK = 32, KVBLK = 64, QB = NW * QBLK;
constexpr int DQK = 192, DV = 128;
constexpr int QS = NQ, KNS = NKV, KRS = DROPE, OS = DM;
constexpr int SHM_V = KVBLK * DV * 2, SHM_K = KVBLK * DQK * 2;
constexpr int LDS_QR = 2 * SHM_V + 2 * SHM_K + NW * 64 * 4;
constexpr int LDS_BYTES = LDS_QR + NW * 4096;
constexpr float SCALE = 0.07216878364870322f;
constexpr float THR = 8.f;
#define KSWZ(row, ch) ((row) * 384 + ((((ch) ^ (((row) >> 1) & 7))) << 4))
#define SBAR() __builtin_amdgcn_sched_barrier(0)
__device__ __forceinline__ int v_st(int k, int c) { const int kk = (k & ~0xC) | ((k & 4) << 1) | ((k & 8) >> 1); return ((kk >> 3) * 4 + (c >> 5)) * 512 + ((kk & 7) * 32 + (c & 31)) * 2; }
__device__ __forceinline__ int v_rd_base(int lane) { return ((lane & 3) << 3) | (((lane >> 2) & 3) << 6) | (((lane >> 4) & 1) << 5) | (((lane >> 5) & 1) << 8); }
constexpr int v_rd_off(int d0, int ks, int half) { return d0 * 512 + ks * 4096 + half * 2048; }
__device__ __forceinline__ int crow(int r, int hi) { return (r & 3) + 8 * (r >> 2) + 4 * hi; }
__device__ __forceinline__ void mask_tile(f32x16& p0, f32x16& p1, int dq) {
    const float NEG = -__builtin_inff();
#pragma unroll
    for (int r = 0; r < 16; ++r) {
        const int c = (r & 3) + 8 * (r >> 2);
        if (dq - c < 0) p0[r] = NEG;
        if (dq - c - 32 < 0) p1[r] = NEG;
    }
}
__device__ __forceinline__ void partialSM(f32x16& p0, f32x16& p1, float& m_reg, float& mn, float& alpha) {
    float pmax = p0[0]; for (int r = 1; r < 16; ++r) pmax = fmaxf(pmax, p0[r]); for (int r = 0; r < 16; ++r) pmax = fmaxf(pmax, p1[r]);
    { auto rr = __builtin_amdgcn_permlane32_swap(__float_as_uint(pmax), __float_as_uint(pmax), false, false);
      pmax = fmaxf(__uint_as_float(rr[0]), __uint_as_float(rr[1])); }
    constexpr float C2 = 1.4426950408889634f * SCALE;
    if (__builtin_expect(__all((pmax - m_reg) * SCALE <= THR), 1)) { mn = m_reg; alpha = 1.f; }
    else { mn = fmaxf(m_reg, pmax); alpha = __builtin_amdgcn_exp2f((m_reg - mn) * C2); m_reg = mn; }
    const float mnL = -mn * C2;
    for (int r = 0; r < 16; ++r) p0[r] = fmaf(p0[r], C2, mnL); for (int r = 0; r < 16; ++r) p1[r] = fmaf(p1[r], C2, mnL);
    for (int r = 0; r < 16; ++r) p0[r] = __builtin_amdgcn_exp2f(p0[r]);
}
__device__ __forceinline__ void finishSM(f32x16& p0, f32x16& p1, float alpha, float& l_reg, bf16x8& pa0, bf16x8& pa1, bf16x8& pa2, bf16x8& pa3) {
    for (int r = 0; r < 16; ++r) p1[r] = __builtin_amdgcn_exp2f(p1[r]);
    float ps = 0; for (int r = 0; r < 16; ++r) ps += p0[r]; for (int r = 0; r < 16; ++r) ps += p1[r];
    { auto rr = __builtin_amdgcn_permlane32_swap(__float_as_uint(ps), __float_as_uint(ps), false, false);
      ps = __uint_as_float(rr[0]) + __uint_as_float(rr[1]); }
    l_reg = l_reg * alpha + ps;
#define PK4(P, B_, OUT) do { unsigned a0 = cvt_pk_bf16(P[B_+0], P[B_+1]), a1 = cvt_pk_bf16(P[B_+2], P[B_+3]);                          \
        unsigned b0 = cvt_pk_bf16(P[B_+4], P[B_+5]), b1 = cvt_pk_bf16(P[B_+6], P[B_+7]);                                             \
        auto r0 = __builtin_amdgcn_permlane32_swap(a0, b0, false, false); auto r1 = __builtin_amdgcn_permlane32_swap(a1, b1, false, false); \
        u32x4 w = {r0[0], r1[0], r0[1], r1[1]}; OUT = *reinterpret_cast<bf16x8*>(&w); } while (0)
    PK4(p0, 0, pa0); PK4(p0, 8, pa1); PK4(p1, 0, pa2); PK4(p1, 8, pa3);
#undef PK4
}
template <int KB>
__device__ __forceinline__ void qkt(f32x16& p0, f32x16& p1, const char* K_lds, int r32, int hi, const bf16x8* qr, const char* qrl) {
    p0 = f32x16{}; p1 = f32x16{};
    const char* kb[4];
#pragma unroll
    for (int dd = 0; dd < 4; ++dd) kb[dd] = K_lds + KB * SHM_K + KSWZ(r32, dd * 2 + hi);
#pragma unroll
    for (int d0 = 0; d0 < 12; ++d0) { const char* a = kb[d0 & 3] + (d0 >> 2) * 128;
        bf16x8 b0 = *reinterpret_cast<const bf16x8*>(a);
        bf16x8 b1 = *reinterpret_cast<const bf16x8*>(a + 32 * 384);
        const bf16x8 qf = d0 < 8 ? qr[d0 & 7] : *reinterpret_cast<const bf16x8*>(qrl + (d0 - 8) * 1024);
        p0 = __builtin_amdgcn_mfma_f32_32x32x16_bf16(b0, qf, p0, 0, 0, 0);
        p1 = __builtin_amdgcn_mfma_f32_32x32x16_bf16(b1, qf, p1, 0, 0, 0);
        if ((d0 & 3) == 3 && d0 < 11) SBAR(); }
}
template <int VB>
__device__ __forceinline__ void pv_tile(f32x16* o, int vb0, bf16x8 pa0, bf16x8 pa1, bf16x8 pa2, bf16x8 pa3) {
#define TRRD(dst, off) asm volatile("ds_read_b64_tr_b16 %0, %1 offset:%2" : "=&v"(dst) : "v"(vb0), "i"(off) : "memory")
#define PV_D0(d0) do { s16x4 l0, l1, l2, l3, h0, h1, h2, h3; constexpr int b_ = VB * SHM_V + v_rd_off(d0, 0, 0); \
        TRRD(l0, b_); TRRD(h0, b_ + 2048); TRRD(l1, b_ + 4096); TRRD(h1, b_ + 6144); TRRD(l2, b_ + 8192); TRRD(h2, b_ + 10240); TRRD(l3, b_ + 12288); TRRD(h3, b_ + 14336); \
        asm volatile("s_waitcnt lgkmcnt(0)" ::: "memory"); SBAR();   \
        o[d0] = __builtin_amdgcn_mfma_f32_32x32x16_bf16(pa0, (bf16x8){l0[0], l0[1], l0[2], l0[3], h0[0], h0[1], h0[2], h0[3]}, o[d0], 0, 0, 0);   \
        o[d0] = __builtin_amdgcn_mfma_f32_32x32x16_bf16(pa1, (bf16x8){l1[0], l1[1], l1[2], l1[3], h1[0], h1[1], h1[2], h1[3]}, o[d0], 0, 0, 0);   \
        o[d0] = __builtin_amdgcn_mfma_f32_32x32x16_bf16(pa2, (bf16x8){l2[0], l2[1], l2[2], l2[3], h2[0], h2[1], h2[2], h2[3]}, o[d0], 0, 0, 0);   \
        o[d0] = __builtin_amdgcn_mfma_f32_32x32x16_bf16(pa3, (bf16x8){l3[0], l3[1], l3[2], l3[3], h3[0], h3[1], h3[2], h3[3]}, o[d0], 0, 0, 0); } while (0)
    PV_D0(0); PV_D0(1); PV_D0(2); PV_D0(3);
#undef PV_D0
#undef TRRD
}
struct BlockRef { const bf16_t* Q; const bf16_t* Kn; const bf16_t* Kr; const bf16_t* V; bf16_t* O; int P0; };
struct Seam { bf16x8 qr[8]; bf16x8 st_v0, st_v1, st_k0, st_k1, st_k2; };
#define VMW() asm volatile("s_waitcnt vmcnt(0)" ::: "memory")
#define VMWN(n) asm volatile("s_waitcnt vmcnt(%0)" :: "i"(n) : "memory")
#define LD8(p) (*reinterpret_cast<const bf16x8*>(p))
#define SLOAD_H(R_, k0) do { S.st_v0 = LD8((R_).V + (size_t)((k0) + sr) * KNS + sc); S.st_v1 = LD8((R_).V + (size_t)((k0) + 32 + sr) * KNS + sc);              \
                             S.st_k0 = LD8((R_).Kn + (size_t)((k0) + sr) * KNS + sc); S.st_k1 = LD8((R_).Kn + (size_t)((k0) + 32 + sr) * KNS + sc);            \
                             S.st_k2 = LD8((R_).Kr + (size_t)((k0) + rr) * KRS + rc); } while (0)
#define SWRITE_HK(bf) do { *(bf16x8*)(K_lds + (bf) * SHM_K + kws) = S.st_k0; *(bf16x8*)(K_lds + (bf) * SHM_K + kws + 32 * 384) = S.st_k1; *(bf16x8*)(K_lds + (bf) * SHM_K + kws2) = S.st_k2; } while (0)
#define SWRITE_HV(bf) do { *(bf16x8*)(V_lds + (bf) * SHM_V + vst0) = S.st_v0; *(bf16x8*)(V_lds + (bf) * SHM_V + vst1) = S.st_v1; } while (0)
#define SWRITE_H(bf) do { SWRITE_HV(bf); SWRITE_HK(bf); } while (0)
#define ATT_IDX const int tid = launder_v((int)threadIdx.x), wid = __builtin_amdgcn_readfirstlane(tid >> 6), lane = tid & 63, r32 = lane & 31, hi = lane >> 5; \
    const int sr = tid >> 4, sc = (tid & 15) * 8, rr = tid >> 3, rc = (tid & 7) * 8, kws = KSWZ(sr, (tid & 15)), kws2 = KSWZ(rr, 16 + (tid & 7));
__device__ __forceinline__ void attn_block(const BlockRef& cur, char* lds) {
    ATT_IDX;
    Seam S;
    const int NT = cur.P0 / KVBLK + QB / KVBLK;
    const int qlo = cur.P0 + wid * QBLK, qm = qlo + r32 - 4 * hi;
    char* V_lds = lds; char* K_lds = lds + 2 * SHM_V;
    float* ws = (float*)(lds + 2 * SHM_V + 2 * SHM_K) + wid * 64; float* li_l = ws, * al_l = ws + 32;
    float m_reg = -1e30f, l_reg = 0; f32x16 o[4] = {};
    const int vst0 = v_st(sr, sc), vst1 = v_st(32 + sr, sc);
    const int vb0 = (int)(uintptr_t)V_lds + v_rd_base(lane);
    char* qrl = lds + LDS_QR + wid * 4096 + lane * 16;
#define RESC(a) do { if (__any((a) < 1.f)) { if (hi == 0) al_l[r32] = (a); asm volatile("s_waitcnt lgkmcnt(0)" ::: "memory");              \
                     for (int d_ = 0; d_ < 4; ++d_) for (int r = 0; r < 16; ++r) o[d_][r] *= al_l[crow(r, hi)]; } } while (0)
#define KBASE(t) ((t) * KVBLK)
#define MASKT(P0_, P1_, t) do { const int kb_ = KBASE(t); if (kb_ + KVBLK - 1 > qlo) mask_tile(P0_, P1_, qm - kb_); } while (0)
    SLOAD_H(cur, 0);
#pragma unroll
    for (int d0 = 0; d0 < 8; ++d0) S.qr[d0] = LD8(cur.Q + (size_t)(wid * QBLK + r32) * QS + d0 * 16 + hi * 8);
    { bf16x8 t0 = LD8(cur.Q + (size_t)(wid * QBLK + r32) * QS + 128 + hi * 8), t1 = LD8(cur.Q + (size_t)(wid * QBLK + r32) * QS + 144 + hi * 8),
             t2 = LD8(cur.Q + (size_t)(wid * QBLK + r32) * QS + 160 + hi * 8), t3 = LD8(cur.Q + (size_t)(wid * QBLK + r32) * QS + 176 + hi * 8);
      *(bf16x8*)(qrl) = t0; *(bf16x8*)(qrl + 1024) = t1; *(bf16x8*)(qrl + 2048) = t2; *(bf16x8*)(qrl + 3072) = t3; }
    VMW(); SWRITE_H(0);
    __syncthreads();
    f32x16 p0, p1; float mn, al; bf16x8 pa0, pa1, pa2, pa3;
#define TILE_STEP(t, BF) do {                                                                                                 \
        if ((t) + 1 < NT) { SLOAD_H(cur, KBASE((t) + 1)); }                                                                    \
        SBAR();                                                                                                               \
        if (KBASE(t) <= qlo + QBLK - 1) {     \
        qkt<BF>(p0, p1, K_lds, r32, hi, S.qr, qrl);                                                                           \
        MASKT(p0, p1, (t)); partialSM(p0, p1, m_reg, mn, al); RESC(al);                                                        \
        finishSM(p0, p1, al, l_reg, pa0, pa1, pa2, pa3); SBAR();                                                              \
        pv_tile<BF>(o, vb0, pa0, pa1, pa2, pa3); }                                                                            \
        if ((t) + 1 < NT) { VMW(); SWRITE_H(1 - BF); }                                                                         \
        __syncthreads(); } while (0)
    for (int t = 0; t < NT; t += 2) { TILE_STEP(t, 0); TILE_STEP(t + 1, 1); }
    if (hi == 0) li_l[r32] = l_reg; asm volatile("s_waitcnt lgkmcnt(0)" ::: "memory");
    float rli[16];
#pragma unroll
    for (int r = 0; r < 16; ++r) rli[r] = __builtin_amdgcn_rcpf(li_l[crow(r, hi)]);
    bf16_t* Ow = cur.O + (size_t)(wid * QBLK) * OS;
#pragma unroll
    for (int r = 0; r < 16; ++r) { const int orow = crow(r, hi);
#pragma unroll
        for (int d0 = 0; d0 < 4; ++d0) { const float v = o[d0][r] * rli[r];
            const float vn = __shfl_xor(v, 1);
            if ((r32 & 1) == 0) *(unsigned*)(Ow + (size_t)orow * OS + d0 * 32 + r32) = cvt_pk_bf16(v, vn); } }
    __syncthreads();
#undef RESC
#undef KBASE
#undef MASKT
#undef TILE_STEP
}
#undef VMW
#undef VMWN
#undef LD8
#undef SLOAD_H
#undef SWRITE_HK
#undef SWRITE_HV
#undef SWRITE_H
#undef ATT_IDX
#undef KSWZ
#undef SBAR

__device__ __forceinline__ BlockRef make_ref(int L, int pass, const bf16_t* Qb, const bf16_t* KNVb, const bf16_t* KRb, bf16_t* Ob) {
    const int bh = L >> 2, x = L & 3, qb = pass ? 7 - x : x, b = bh >> 3, h = bh & 7; const size_t rb = (size_t)b * SEQ;
    BlockRef r; r.Q = Qb + (rb + (size_t)qb * QB) * QS + h * DQH; r.Kn = KNVb + rb * KNS + h * (DNOPE + DVH); r.Kr = KRb + rb * KRS; r.V = KNVb + rb * KNS + h * (DNOPE + DVH) + DNOPE;
    r.O = Ob + (rb + (size_t)qb * QB) * OS + h * DVH; r.P0 = qb * QB; return r;
}
__device__ __forceinline__ void attn_phase(char* lds, const bf16_t* Qb, const bf16_t* KNVb, const bf16_t* KRb, bf16_t* Ob, int first, int stride) {
    constexpr int total = NBATCH * NHEAD * 4;
    for (int L = first; L < total; L += stride) {
        for (int pass = 0; pass < 2; ++pass) { const BlockRef cur = make_ref(L, pass, Qb, KNVb, KRb, Ob); attn_block(cur, lds); }
    }
}
}
constexpr int NWAVES = 8;
constexpr size_t MiB = 1u << 20;
constexpr size_t WS_CTL = 0, CTL_ZERO_BYTES = 8 * MiB;
constexpr size_t WS_SSQ = 1 * MiB;
constexpr size_t WS_COS = 8 * MiB, WS_SIN = 16 * MiB;
constexpr size_t WS_LIST = 24 * MiB;
constexpr size_t WS_RSL = 26 * MiB;
constexpr size_t WS_TOKINFO = 28 * MiB;
constexpr size_t WS_WDN = 30 * MiB, WS_WUQ = 34 * MiB, WS_WUKV = 37 * MiB, WS_WO = 39 * MiB, WS_WPOOL = 43 * MiB, WS_WGU = 44 * MiB, WS_WD = 65 * MiB, WS_MWGU = 76 * MiB, WS_MWD = 164 * MiB;
constexpr size_t WS_H = 208 * MiB;
constexpr size_t WS_ACT = 336 * MiB;
constexpr size_t WS_DOWN = WS_ACT;
constexpr size_t WS_CQN = WS_ACT + 128 * MiB, WS_CKVN = WS_ACT + 192 * MiB, WS_KR = WS_ACT + 224 * MiB, WS_Q = WS_ACT + 232 * MiB, WS_KNV = WS_ACT + 424 * MiB;
constexpr size_t WS_HID = WS_ACT;
constexpr size_t WS_YB = WS_ACT + 358 * MiB;
constexpr size_t WS_DUMMY = WS_ACT + 424 * MiB;
constexpr size_t WS_H8 = WS_ACT + 618 * MiB;
constexpr int FFD8 = 2816;
constexpr int FFE8 = 1536;
constexpr size_t WS_END = WS_ACT + 682 * MiB;
static_assert(WS_MWD + (size_t)16 * 1024 * FFEP * 2 <= WS_H && WS_MWGU + (size_t)16 * 2 * FFEP * 1024 * 2 <= WS_MWD && WS_WD + (size_t)2 * 1024 * FFD * 2 <= WS_MWGU && WS_WGU + (size_t)2 * 2 * FFD * 1024 * 2 <= WS_WD, "weights map");
static_assert(WS_HID + (size_t)PSLOT * FFEP * 2 <= WS_YB && WS_YB + (size_t)PSLOT * 1024 * 2 <= WS_END && WS_HID + (size_t)NTOK * FFD * 2 <= WS_END && WS_KNV + (size_t)NTOK * NKV * 2 <= WS_END && WS_Q + (size_t)NTOK * NQ * 2 <= WS_KNV, "activation map");
static_assert(WS_SSQ + (size_t)14 * NTOK * 8 <= WS_COS && WS_COS <= CTL_ZERO_BYTES + WS_COS && WS_END <= 1024 * MiB, "map");
constexpr int CW_TMO = 0, CW_CODE = 1, CW_CNT = 1024  , CW_DBG = 2048, CW_BAR = 4096  ;
constexpr int LDSCTL_OFF = 0, LDSCTL_BYTES = 1024, MISC_OFF = LDSCTL_OFF + 320, RING_OFF = LDSCTL_BYTES, RING_BYTES = 131072, LDS_BYTES = 147456;

typedef GAS unsigned gu32;
#define RLX_AGENT __ATOMIC_RELAXED, __HIP_MEMORY_SCOPE_AGENT
#define LDS_WAIT() asm volatile("s_waitcnt lgkmcnt(0)" ::: "memory")
#define VM_WAIT() asm volatile("s_waitcnt vmcnt(0)" ::: "memory")

#define XB_TMO      128
#define XB_XCNT(j)  (256  + 64 * (j))
#define XB_XSUB(j)  (1280 + 64 * (j))
#define XB_XGEN(j)  (2304 + 64 * (j))
#define XB_TOP      3328
#define XB_TOPGEN   3392
#define XCD_BAR_WORDS 3456
#define XB_SPIN_CAP (1u << 18)
__device__ __forceinline__ unsigned xb_ld(unsigned* p)              { return __hip_atomic_load(p, __ATOMIC_RELAXED, __HIP_MEMORY_SCOPE_AGENT); }
__device__ __forceinline__ unsigned xb_add(unsigned* p, unsigned v) { return __hip_atomic_fetch_add(p, v, __ATOMIC_RELAXED, __HIP_MEMORY_SCOPE_AGENT); }
__device__ __forceinline__ unsigned xb_xcc_id() { return (unsigned)__builtin_amdgcn_s_getreg((3 << 11) | 20) & 0xFu; }
#define XB_SPIN(cond, bar) do { unsigned _sp = 0; while (cond) { __builtin_amdgcn_s_sleep(1); \
    if ((++_sp & 255u) == 0u) { if (xb_ld(&(bar)[XB_TMO])) break; if (_sp > XB_SPIN_CAP) { atomicAdd(&(bar)[XB_TMO], 1u); break; } } } } while (0)
__device__ __forceinline__ unsigned rfl(unsigned v);
struct XcdBarrier { unsigned* bar; unsigned x; volatile LAS unsigned* st; };
__device__ __forceinline__ XcdBarrier xcd_barrier_post(unsigned* bar, volatile LAS unsigned* st) {
    XcdBarrier b; b.bar = bar; b.x = xb_xcc_id(); b.st = st;
    if (threadIdx.x == 0) (void)xb_add(&bar[XB_XCNT(b.x)], 1u);
    return b;
}
__device__ __forceinline__ void xcd_barrier_complete(unsigned* bar, unsigned x, unsigned& nloc, unsigned& nx) {
    const unsigned G = gridDim.x * gridDim.y * gridDim.z;
    unsigned sum, cnt, mine, sp = 0u;
    for (;;) {
        sum = 0u; cnt = 0u; mine = 0u;
#pragma unroll
        for (unsigned j = 0; j < 16; ++j) { const unsigned c = xb_ld(&bar[XB_XCNT(j)]); sum += c; cnt += (c > 0u) ? 1u : 0u; mine = (j == x) ? c : mine; }
        if (sum == G) break;
        __builtin_amdgcn_s_sleep(1);
        if ((++sp & 255u) == 0u) { if (xb_ld(&bar[XB_TMO])) break; if (sp > XB_SPIN_CAP) { atomicAdd(&bar[XB_TMO], 1u); break; } }
    }
    nloc = mine > 0u ? mine : 1u; nx = cnt > 0u ? cnt : 1u;
}
__device__ __forceinline__ void xcd_barrier(const XcdBarrier& b) {
    unsigned* bar; { const volatile LAS unsigned* p_ = b.st + 2; const unsigned lo_ = rfl(p_[0]), hi_ = rfl(p_[1]); bar = (unsigned*)(((unsigned long long)hi_ << 32) | lo_); }
    asm volatile("s_waitcnt vmcnt(0)" ::: "memory");
    __syncthreads();
    if (threadIdx.x == 0) {
        __builtin_amdgcn_s_waitcnt(0);
        unsigned nloc = b.st[0], nx = b.st[1];
        if (nloc == 0u) { xcd_barrier_complete(bar, b.x, nloc, nx); b.st[0] = nloc; b.st[1] = nx; }
        const unsigned old = xb_add(&bar[XB_XSUB(b.x)], 1u);
        const unsigned gen = old / nloc;
        if (old + 1u == (gen + 1u) * nloc) {
            __builtin_amdgcn_fence(__ATOMIC_RELEASE, "agent");
            asm volatile("s_waitcnt vmcnt(0)" ::: "memory");
            const unsigned og = xb_add(&bar[XB_TOP], 1u);
            const unsigned tg = og / nx;
            if (og + 1u == (tg + 1u) * nx) xb_add(&bar[XB_TOPGEN], 1u);
            else XB_SPIN(xb_ld(&bar[XB_TOPGEN]) == tg, bar);
            __builtin_amdgcn_fence(__ATOMIC_ACQUIRE, "agent");
            xb_add(&bar[XB_XGEN(b.x)], 1u);
            asm volatile("s_waitcnt vmcnt(0)" ::: "memory");
        } else {
            XB_SPIN(xb_ld(&bar[XB_XGEN(b.x)]) == gen, bar);
            __builtin_amdgcn_fence(__ATOMIC_ACQUIRE, "agent");
            asm volatile("s_waitcnt vmcnt(0)" ::: "memory");
        }
    }
    __syncthreads();
}

__device__ __forceinline__ unsigned rfl(unsigned v);
__device__ __forceinline__ const float* ptab(LAS unsigned char* L, int i);
struct Frame { LAS unsigned char* lds; volatile LAS unsigned* MISC; gu32* ctl; unsigned char* ws; int tid, lane, wave, vcu, G, bx; };

__device__ __forceinline__ float wave_sum(float v) {
#pragma unroll
    for (int o = 1; o < 64; o <<= 1) v += __shfl_xor(v, o);
    return v;
}
__device__ __forceinline__ unsigned rfl(unsigned v) { return (unsigned)__builtin_amdgcn_readfirstlane((int)v); }

__device__ __forceinline__ int rowmap(int mode, int n) {
    if (mode == 0) return n;
    if (mode == 1) return (n >> 7) * 256 + (n & 127);
    if (mode == 2) return (n >> 7) * 256 + 128 + (n & 127);
    if (mode == 4) return n < 800 ? n : 896 + (n - 800);
    const int h = n / DQH, d = n - h * DQH;
    if (d < DNOPE) return 512 + h * DNOPE + d;
    if (d < DNOPE + 32) return (h >> 2) * 256 + (h & 3) * 32 + (d - DNOPE);
    return (h >> 2) * 256 + 128 + (h & 3) * 32 + (d - DNOPE - 32);
}
__device__ __forceinline__ void transpose_item(const float* W, int N, bf16_t* WT, int ldd, int mode, const float* kscale, const float* nscale, int item, int lane) {
    const int nblk = N / 64, kb = item / nblk, nb = item % nblk, k0 = 64 * kb, n = 64 * nb + lane;
    const float sn = nscale ? nscale[n] : 1.0f;
    const int ksv = __float_as_int(kscale ? kscale[k0 + lane] : 1.0f);
    const float* wp = W + (size_t)k0 * N + n;
    bf16_t* op = WT + (size_t)rowmap(mode, n) * ldd + k0;
#pragma unroll
    for (int kg = 0; kg < 8; ++kg) { float v[8];
#pragma unroll
        for (int i = 0; i < 8; ++i) { const float sk = __int_as_float(__builtin_amdgcn_readlane(ksv, 8 * kg + i)); v[i] = wp[(size_t)(8 * kg + i) * N] * (sk * sn); }
        u32x4 o; o.x = cvt_pk_bf16(v[0], v[1]); o.y = cvt_pk_bf16(v[2], v[3]); o.z = cvt_pk_bf16(v[4], v[5]); o.w = cvt_pk_bf16(v[6], v[7]);
        *(GAS u32x4*)(op + 8 * kg) = o; }
}
__device__ __forceinline__ void transpose_item_f8(const float* W, int N, unsigned char* WT, int ldd, int mode, const float* kscale, int item, int lane) {
    const int nblk = N / 64, kb = item / nblk, nb = item % nblk, k0 = 64 * kb, n = 64 * nb + lane;
    const int ksv = __float_as_int(kscale ? kscale[k0 + lane] : 1.0f);
    const float* wp = W + (size_t)k0 * N + n;
    unsigned char* op = WT + (size_t)rowmap(mode, n) * ldd + k0;
#pragma unroll
    for (int kg = 0; kg < 4; ++kg) { float v[16];
#pragma unroll
        for (int i = 0; i < 16; ++i) { const float sk = __int_as_float(__builtin_amdgcn_readlane(ksv, 16 * kg + i)); v[i] = wp[(size_t)(16 * kg + i) * N] * (sk * pg8::FP8_SW); }
        u32x4 o; o.x = pg8::pk4_fp8(v[0], v[1], v[2], v[3]); o.y = pg8::pk4_fp8(v[4], v[5], v[6], v[7]); o.z = pg8::pk4_fp8(v[8], v[9], v[10], v[11]); o.w = pg8::pk4_fp8(v[12], v[13], v[14], v[15]);
        *(GAS u32x4*)(op + 16 * kg) = o; }
}
struct MatDesc { const float* src; bf16_t* dst; const float* kscale; const float* nscale; int K, N, ldd, mode, f8; };
constexpr int N_MATS = 70;
__device__ __forceinline__ MatDesc mat_desc(int m, LAS unsigned char* L, unsigned char* ws) {
    MatDesc d; d.kscale = nullptr; d.nscale = nullptr; d.mode = 0; d.f8 = 0;
    if (m < 2)       { const int a = m;      d.src = ptab(L, 4) + (size_t)a * DM * NDOWN;    d.K = DM;   d.N = NDOWN; d.dst = (bf16_t*)(ws + WS_WDN) + (size_t)a * NDOWNP * DM;  d.ldd = DM; d.mode = 4; d.kscale = ptab(L, 2) + (size_t)(2 * a) * DM; }
    else if (m < 4)  { const int a = m - 2;  d.src = ptab(L, 6) + (size_t)a * QLR * NQ;      d.K = QLR;  d.N = NQ;    d.dst = (bf16_t*)(ws + WS_WUQ) + (size_t)a * NQ * QLR;     d.ldd = QLR; d.mode = 3; d.kscale = ptab(L, 5) + (size_t)a * QLR; }
    else if (m < 6)  { const int a = m - 4;  d.src = ptab(L, 8) + (size_t)a * KVLR * NKV;    d.K = KVLR; d.N = NKV;   d.dst = (bf16_t*)(ws + WS_WUKV) + (size_t)a * NKV * KVLR;  d.ldd = KVLR; d.kscale = ptab(L, 7) + (size_t)a * KVLR; }
    else if (m < 8)  { const int a = m - 6;  d.src = ptab(L, 9) + (size_t)a * DM * DM;       d.K = DM;   d.N = DM;    d.dst = (bf16_t*)(ws + WS_WO) + (size_t)a * DM * DM;       d.ldd = DM; }
    else if (m < 16) { const int i = m - 8;  d.src = ptab(L, 10) + (size_t)i * 256 * 256;    d.K = 256;  d.N = 256;   d.dst = (bf16_t*)(ws + WS_WPOOL) + (size_t)i * 256 * 256;  d.ldd = 256; d.nscale = ptab(L, 11) + i * 256; }
    else if (m < 18) { const int a = m - 16; d.src = ptab(L, 12) + (size_t)a * DM * FFD;     d.K = DM;   d.N = FFD;   d.dst = (bf16_t*)(ws + WS_WGU) + (size_t)a * 2 * FFD * DM; d.ldd = DM; d.mode = 1; d.kscale = ptab(L, 3) + (size_t)(2 * a) * DM; }
    else if (m < 20) { const int a = m - 18; d.src = ptab(L, 13) + (size_t)a * DM * FFD;     d.K = DM;   d.N = FFD;   d.dst = (bf16_t*)(ws + WS_WGU) + (size_t)a * 2 * FFD * DM; d.ldd = DM; d.mode = 2; d.kscale = ptab(L, 3) + (size_t)(2 * a) * DM; }
    else if (m < 22) { const int a = m - 20; d.src = ptab(L, 14) + (size_t)a * FFD * DM;     d.K = FFD;  d.N = DM;    d.dst = (bf16_t*)(ws + WS_WD) + (size_t)a * DM * FFD;      d.ldd = FFD; }
    else if (m < 38) { const int i = m - 22; d.src = ptab(L, 16) + (size_t)i * DM * FFE;     d.K = DM;   d.N = FFE;   d.dst = (bf16_t*)(ws + WS_MWGU) + (size_t)i * 2 * FFEP * DM; d.ldd = DM; d.mode = 1; d.kscale = ptab(L, 3) + (size_t)(2 * (i >> 3) + 1) * DM; }
    else if (m < 54) { const int i = m - 38; d.src = ptab(L, 17) + (size_t)i * DM * FFE;     d.K = DM;   d.N = FFE;   d.dst = (bf16_t*)(ws + WS_MWGU) + (size_t)i * 2 * FFEP * DM; d.ldd = DM; d.mode = 2; d.kscale = ptab(L, 3) + (size_t)(2 * (i >> 3) + 1) * DM; }
    else             { const int i = m - 54; d.src = ptab(L, 18) + (size_t)i * FFE * DM;     d.K = FFE;  d.N = DM;    d.dst = (bf16_t*)(ws + WS_MWD) + (size_t)i * DM * FFEP;    d.ldd = FFEP; }
    if (m == 17 || m == 19) { d.f8 = 1; d.dst = (bf16_t*)(ws + WS_WGU + (size_t)2 * FFD * DM * 2); d.ldd = DM; }
    if (m == 21) { d.f8 = 1; d.dst = (bf16_t*)(ws + WS_WD + (size_t)DM * FFD * 2); d.ldd = FFD8; }
    if (m >= 22 && ((m - 22) & 15) >= 8) {
        const int e = (m - 22) & 7; d.f8 = 1;
        if (m < 54) { d.dst = (bf16_t*)(ws + WS_MWGU + (size_t)8 * 2 * FFEP * DM * 2 + (size_t)e * 2 * FFEP * DM); d.ldd = DM; }
        else        { d.dst = (bf16_t*)(ws + WS_MWD + (size_t)8 * DM * FFEP * 2 + (size_t)e * DM * FFE8); d.ldd = FFE8; } }
    return d;
}
__device__ __forceinline__ void p0_prologue(Frame& F) {
    const int* positions = (const int*)ptab(F.lds, 1);
    const int gw = F.vcu * NWAVES + F.wave, NGW = F.G * NWAVES;
    int cum = 0;
    for (int m = 0; m < N_MATS; ++m) {
        const MatDesc d = mat_desc(m, F.lds, F.ws);
        const int nitems = (d.K / 64) * (d.N / 64);
        int first = gw - (cum % NGW); if (first < 0) first += NGW;
        if (d.f8) { for (int it = first; it < nitems; it += NGW) transpose_item_f8(d.src, d.N, (unsigned char*)d.dst, d.ldd, d.mode, d.kscale, it, F.lane); }
        else { for (int it = first; it < nitems; it += NGW) transpose_item(d.src, d.N, d.dst, d.ldd, d.mode, d.kscale, d.nscale, it, F.lane); }
        cum += nitems;
    }
    const int gt = gw * 64 + F.lane, NGT = NGW * 64; const u32x4 z4 = (u32x4){0u, 0u, 0u, 0u};
    for (int i = gt; i < 2 * 192 * 128; i += NGT) { const int a = i / (192 * 128), r = (i / 128) % 192, c = i % 128; const int row = r < 96 ? 800 + r : 928 + (r - 96); *(GAS u32x4*)((bf16_t*)(F.ws + WS_WDN) + (size_t)a * NDOWNP * DM + (size_t)row * DM + c * 8) = z4; }
    for (int i = gt; i < 8 * 128 * 128; i += NGT) { const int e = i / (128 * 128), r = (i / 128) % 128, c = i % 128; const int row = 2560 + (r < 64 ? 64 + r : 192 + (r - 64));
        *(GAS u32x4*)((bf16_t*)(F.ws + WS_MWGU) + (size_t)e * 2 * FFEP * DM + (size_t)row * DM + c * 8) = z4; }
    for (int i = gt; i < 8 * 1024 * 8; i += NGT) { const int row = i / 8, c = i % 8; *(GAS u32x4*)((bf16_t*)(F.ws + WS_MWD) + (size_t)row * FFEP + FFE + c * 8) = z4; }
    for (int i = gt; i < 1024 * 8; i += NGT) { const int row = i / 8, c = i % 8; *(GAS u32x4*)(F.ws + WS_WD + (size_t)DM * FFD * 2 + (size_t)row * FFD8 + FFD + c * 16) = z4; }
    for (int i = gt; i < 8 * 128 * 64; i += NGT) { const int e = i / (128 * 64), r = (i / 64) % 128, c = i % 64; const int row = 2560 + (r < 64 ? 64 + r : 192 + (r - 64));
        *(GAS u32x4*)(F.ws + WS_MWGU + (size_t)8 * 2 * FFEP * DM * 2 + (size_t)e * 2 * FFEP * DM + (size_t)row * DM + c * 16) = z4; }
    for (int i = gt; i < 8 * 1024 * 12; i += NGT) { const int row = i / 12, c = i % 12; *(GAS u32x4*)(F.ws + WS_MWD + (size_t)8 * DM * FFEP * 2 + (size_t)row * FFE8 + FFE + c * 16) = z4; }
    float* cosT = (float*)(F.ws + WS_COS); float* sinT = (float*)(F.ws + WS_SIN);
    { const float inv = powf(10000.0f, -(float)(2 * (gt & 31)) / 64.0f);
      for (int i = gt; i < NTOK * 32; i += NGT) { const float ang = (float)positions[i >> 5] * inv; float sn, cs; sincosf(ang, &sn, &cs); cosT[i] = cs; sinT[i] = sn; } }
    const float* x = ptab(F.lds, 0); bf16_t* H = (bf16_t*)(F.ws + WS_H); ssq_t* ssq0 = (ssq_t*)(F.ws + WS_SSQ);
    for (int m0 = gw * 4; m0 < NTOK; m0 += NGW * 4) {
        f32x4 v[4][4];
#pragma unroll
        for (int r = 0; r < 4; ++r) { const GAS f32x4* xr = (const GAS f32x4*)(x + (size_t)(m0 + r) * DM) + F.lane;
#pragma unroll
            for (int j = 0; j < 4; ++j) v[r][j] = xr[64 * j]; }
#pragma unroll
        for (int r = 0; r < 4; ++r) { GAS u32x2* o8 = (GAS u32x2*)(H + (size_t)(m0 + r) * DM) + F.lane; float s = 0.f;
#pragma unroll
            for (int j = 0; j < 4; ++j) { const f32x4 t = v[r][j]; s += (t.x * t.x + t.y * t.y) + (t.z * t.z + t.w * t.w); u32x2 w; w.x = cvt_pk_bf16(t.x, t.y); w.y = cvt_pk_bf16(t.z, t.w); o8[64 * j] = w; }
            s = wave_sum(s); if (F.lane == 0) ssq0[m0 + r] = ssq_fix(s); }
    }
}

template <bool FINAL>
__device__ __forceinline__ void combine_phase(Frame& F, const bf16_t* H, bf16_t* Hout, const bf16_t* YB, const unsigned* tokinfo, const unsigned* cntw, ssq_t* ssq_next, const float* gain, float* outF) {
    const int gw = F.vcu * NWAVES + F.wave, NGW = F.G * NWAVES;
    f32x4 g[4];
    if constexpr (FINAL) {
#pragma unroll
        for (int j = 0; j < 4; ++j) g[j] = *(const f32x4*)(gain + F.lane * 4 + 256 * j);
    }
    unsigned nb[8];
#pragma unroll
    for (int e = 0; e < 8; ++e) nb[e] = (rfl(__hip_atomic_load((unsigned*)cntw + 64 * e, RLX_AGENT)) + 255u) >> 8;
    for (int m0 = gw * 2; m0 < NTOK; m0 += NGW * 2) {
        u32x4 t0[2], t1[2];
#pragma unroll
        for (int r = 0; r < 2; ++r) { t0[r] = *(const u32x4*)(tokinfo + (size_t)(m0 + r) * 8); t1[r] = *(const u32x4*)(tokinfo + (size_t)(m0 + r) * 8 + 4); }
        u32x2 hh[2][4], ya[2][4], yb[2][4]; float g0[2], g1[2];
#pragma unroll
        for (int r = 0; r < 2; ++r) {
            const unsigned e0 = rfl(t0[r].x), r0 = rfl(t0[r].y), e1 = rfl(t1[r].x), r1 = rfl(t1[r].y); g0[r] = __uint_as_float(rfl(t0[r].z)); g1[r] = __uint_as_float(rfl(t1[r].z));
            unsigned b0 = 0u, b1 = 0u;
#pragma unroll
            for (int e = 0; e < 8; ++e) { b0 += ((unsigned)e < e0) ? nb[e] : 0u; b1 += ((unsigned)e < e1) ? nb[e] : 0u; }
            const GAS u32x2* hr = (const GAS u32x2*)(H + (size_t)(m0 + r) * DM) + F.lane;
            const GAS u32x2* y0 = (const GAS u32x2*)(YB + ((size_t)b0 * 256 + r0) * DM) + F.lane; const GAS u32x2* y1 = (const GAS u32x2*)(YB + ((size_t)b1 * 256 + r1) * DM) + F.lane;
#pragma unroll
            for (int j = 0; j < 4; ++j) { hh[r][j] = hr[64 * j]; ya[r][j] = y0[64 * j]; yb[r][j] = y1[64 * j]; }
        }
#pragma unroll
        for (int r = 0; r < 2; ++r) { const int m = m0 + r;
            f32x4 v[4]; float s = 0.f;
#pragma unroll
            for (int j = 0; j < 4; ++j) { const u32x2 h2 = hh[r][j], a = ya[r][j], b = yb[r][j];
                v[j].x = bflo(h2.x) + g0[r] * bflo(a.x) + g1[r] * bflo(b.x); v[j].y = bfhi(h2.x) + g0[r] * bfhi(a.x) + g1[r] * bfhi(b.x); v[j].z = bflo(h2.y) + g0[r] * bflo(a.y) + g1[r] * bflo(b.y); v[j].w = bfhi(h2.y) + g0[r] * bfhi(a.y) + g1[r] * bfhi(b.y);
                s += (v[j].x * v[j].x + v[j].y * v[j].y) + (v[j].z * v[j].z + v[j].w * v[j].w); }
            s = wave_sum(s);
            if constexpr (FINAL) { const float rstd = rstd_f(s); GAS f32x4* ho = (GAS f32x4*)(outF + (size_t)m * DM) + F.lane;
#pragma unroll
                for (int j = 0; j < 4; ++j) ho[64 * j] = v[j] * rstd * g[j];
            } else { GAS u32x2* hw = (GAS u32x2*)(Hout + (size_t)m * DM) + F.lane;
#pragma unroll
                for (int j = 0; j < 4; ++j) { u32x2 w; w.x = cvt_pk_bf16(v[j].x, v[j].y); w.y = cvt_pk_bf16(v[j].z, v[j].w); hw[64 * j] = w; }
                if (F.lane == 0) ssq_next[m] = ssq_fix(s); }
        }
    }
}
__device__ __forceinline__ void mid_phase(Frame& F, const bf16_t* DOWN, const float* qn, const float* kvn, const float* cosT, const float* sinT, bf16_t* CQN, bf16_t* CKVN, bf16_t* KR) {
    const int gw = F.vcu * NWAVES + F.wave, NGW = F.G * NWAVES, lane = F.lane;
    const f32x4 q0 = *(const f32x4*)(qn + lane * 8), q1 = *(const f32x4*)(qn + lane * 8 + 4), k0 = *(const f32x4*)(kvn + lane * 4);
    for (int m = gw; m < NTOK; m += NGW) {
        const bf16_t* dr = DOWN + (size_t)m * NDOWNP;
        const u32x4 cq = *(const GAS u32x4*)(dr + lane * 8); const u32x2 ck = *(const GAS u32x2*)(dr + QLR + lane * 4);
        const float x1 = bf2f(dr[QLR + KVLR + (lane & 31)]), x2 = bf2f(dr[QLR + KVLR + 32 + (lane & 31)]);
        const f32x4 a0 = (f32x4){bflo(cq.x), bfhi(cq.x), bflo(cq.y), bfhi(cq.y)}, a1 = (f32x4){bflo(cq.z), bfhi(cq.z), bflo(cq.w), bfhi(cq.w)}, c0 = (f32x4){bflo(ck.x), bfhi(ck.x), bflo(ck.y), bfhi(ck.y)};
        const float sq = wave_sum((a0.x * a0.x + a0.y * a0.y) + (a0.z * a0.z + a0.w * a0.w) + (a1.x * a1.x + a1.y * a1.y) + (a1.z * a1.z + a1.w * a1.w));
        const float sk = wave_sum((c0.x * c0.x + c0.y * c0.y) + (c0.z * c0.z + c0.w * c0.w));
        const float rq = 1.0f / sqrtf(sq * (1.0f / QLR) + RMS_EPS), rk = 1.0f / sqrtf(sk * (1.0f / KVLR) + RMS_EPS);
        const f32x4 y0 = a0 * rq * q0, y1 = a1 * rq * q1, z0 = c0 * rk * k0;
        u32x4 w; w.x = cvt_pk_bf16(y0.x, y0.y); w.y = cvt_pk_bf16(y0.z, y0.w); w.z = cvt_pk_bf16(y1.x, y1.y); w.w = cvt_pk_bf16(y1.z, y1.w);
        *(GAS u32x4*)(CQN + (size_t)m * QLR + lane * 8) = w;
        u32x2 w2; w2.x = cvt_pk_bf16(z0.x, z0.y); w2.y = cvt_pk_bf16(z0.z, z0.w);
        *(GAS u32x2*)(CKVN + (size_t)m * KVLR + lane * 4) = w2;
        const float c = cosT[(size_t)m * 32 + (lane & 31)], s = sinT[(size_t)m * 32 + (lane & 31)];
        const float o = lane < 32 ? x1 * c - x2 * s : x2 * c + x1 * s;
        KR[(size_t)m * DROPE + lane] = (bf16_t)(cvt_pk_bf16(o, o) & 0xffffu);
    }
}
template <int W>
__device__ __forceinline__ void pool_walk(const bf16_t* h, const ssq_t* ssq, const f32x2 g2, bf16_t* Z, size_t rowbase, int t_start, int c0, int nrows, int col) {
    f32x2 ring[W]; f32x2 sum = (f32x2){0.f, 0.f};
#pragma unroll
    for (int j = 0; j < W; ++j) ring[j] = (f32x2){0.f, 0.f};
    for (int r = 0; r < nrows; r += 16) {
        unsigned xw[16]; ssq_t q[16];
#pragma unroll
        for (int j = 0; j < 16; ++j) { const size_t row = rowbase + t_start + r + j; xw[j] = *(const GAS unsigned*)(h + row * DM + col); q[j] = ssq[row]; }
#pragma unroll
        for (int j = 0; j < 16; ++j) {
            const int t = t_start + r + j; const size_t row = rowbase + t;
            const f32x2 v = (f32x2){bflo(xw[j]), bfhi(xw[j])} * rstd_of(q[j]) * g2;
            sum = sum + (v - ring[j % W]); ring[j % W] = v;
            if (t >= c0) { const float inv = 1.0f / (float)(t + 1 < W ? t + 1 : W); const f32x2 z = sum * inv - v; *(GAS unsigned*)(Z + row * DM + col) = cvt_pk_bf16(z.x, z.y); }
        }
    }
}
__device__ __forceinline__ void pool_phase(Frame& F, const bf16_t* h, const ssq_t* ssq, const float* gain, bf16_t* Z) {
    const int col = F.tid * 2; const f32x2 g2 = *(const f32x2*)(gain + col);
    for (int chunk = F.vcu; chunk < NBATCH * 16; chunk += F.G) {
        const int b = chunk >> 4, c0 = (chunk & 15) * 128, t_start = c0 ? c0 - 16 : 0, nrows = c0 + 128 - t_start; const size_t rowbase = (size_t)b * SEQ;
        const int grp = F.wave >> 1;
        if (grp == 0) pool_walk<2>(h, ssq, g2, Z, rowbase, t_start, c0, nrows, col);
        else if (grp == 1) pool_walk<4>(h, ssq, g2, Z, rowbase, t_start, c0, nrows, col);
        else if (grp == 2) pool_walk<8>(h, ssq, g2, Z, rowbase, t_start, c0, nrows, col);
        else pool_walk<16>(h, ssq, g2, Z, rowbase, t_start, c0, nrows, col);
    }
}
template <bool WRITE_H8>
__device__ __forceinline__ void router_phase(Frame& F, const bf16_t* h, const ssq_t* ssq, const float* gain, const float* router, int* list, float* rsl, unsigned* tokinfo, unsigned* cntw, unsigned char* H8) {
    LAS float* rt = (LAS float*)(F.lds + RING_OFF);
    LAS int* esel = (LAS int*)(F.lds + RING_OFF + 32768);
    LAS int* wt = (LAS int*)(F.lds + RING_OFF + 32768 + 2048);
    LAS int* base = (LAS int*)(F.lds + RING_OFF + 32768 + 2048 + 256);
    LAS float* rsd = (LAS float*)(F.lds + RING_OFF + 32768 + 2048 + 512);
    const int lane = F.lane;
    for (int idx = F.tid; idx < DM * NEXP; idx += NWAVES * 64) rt[(idx & 7) * DM + (idx >> 3)] = router[idx];
    f32x4 g[4];
#pragma unroll
    for (int j = 0; j < 4; ++j) g[j] = *(const f32x4*)(gain + lane * 4 + 256 * j);
    for (int chunk = F.vcu; chunk < NTOK / 256; chunk += F.G) {
        const int T0 = chunk * 256;
        __syncthreads();
        u32x2 nx[4]; ssq_t nq;
        { const GAS u32x2* xr = (const GAS u32x2*)(h + (size_t)(T0 + F.wave * 32) * DM) + lane;
#pragma unroll
          for (int j = 0; j < 4; ++j) nx[j] = xr[64 * j];
          nq = ssq[T0 + F.wave * 32]; }
        for (int i = 0; i < 32; ++i) {
            const int tl = F.wave * 32 + i, m = T0 + tl;
            u32x2 cw[4];
#pragma unroll
            for (int j = 0; j < 4; ++j) cw[j] = nx[j];
            const float rstd = rstd_of(nq);
            if (i + 1 < 32) { const GAS u32x2* xr = (const GAS u32x2*)(h + (size_t)(m + 1) * DM) + lane;
#pragma unroll
                for (int j = 0; j < 4; ++j) nx[j] = xr[64 * j];
                nq = ssq[m + 1]; }
            f32x4 v[4];
#pragma unroll
            for (int j = 0; j < 4; ++j) { const u32x2 w = cw[j]; f32x4 xn = (f32x4){bflo(w.x), bfhi(w.x), bflo(w.y), bfhi(w.y)} * rstd;
                if constexpr (WRITE_H8) { const f32x4 q = xn * pg8::FP8_SA; *(GAS unsigned*)(H8 + (size_t)m * DM + lane * 4 + 256 * j) = pg8::pk4_fp8(q.x, q.y, q.z, q.w); }
                v[j] = xn * g[j]; }
            float lg[8];
#pragma unroll
            for (int e = 0; e < 8; ++e) { float p = 0.f;
#pragma unroll
                for (int j = 0; j < 4; ++j) { const f32x4 r4 = *(const LAS f32x4*)(rt + e * DM + lane * 4 + 256 * j); p += (v[j].x * r4.x + v[j].y * r4.y) + (v[j].z * r4.z + v[j].w * r4.w); }
                lg[e] = wave_sum(p); }
            int e0 = 0; float l0 = lg[0];
#pragma unroll
            for (int e = 1; e < 8; ++e) if (lg[e] > l0) { l0 = lg[e]; e0 = e; }
            int e1 = e0 == 0 ? 1 : 0; float l1 = lg[e0 == 0 ? 1 : 0];
#pragma unroll
            for (int e = 0; e < 8; ++e) if (e != e0 && lg[e] > l1) { l1 = lg[e]; e1 = e; }
            const float g0 = 1.0f / (1.0f + __expf(l1 - l0)), g1 = 1.0f - g0;
            if (lane == 0) { esel[2 * tl] = e0; esel[2 * tl + 1] = e1; rsd[tl] = rstd; unsigned* ti = tokinfo + (size_t)m * 8;
                ti[0] = (unsigned)e0; ti[2] = __float_as_uint(g0); ti[4] = (unsigned)e1; ti[6] = __float_as_uint(g1); }
        }
        __syncthreads();
        const int me = esel[F.tid]; int myrank = 0;
#pragma unroll
        for (int e = 0; e < 8; ++e) { const unsigned long long mask = __ballot(me == e); if (me == e) myrank = __popcll(mask & ((1ull << lane) - 1ull)); if (lane == 0) wt[F.wave * 8 + e] = __popcll(mask); }
        __syncthreads();
        int off = 0;
        for (int w = 0; w < F.wave; ++w) off += wt[w * 8 + me];
        if (F.tid < 8) { int tot = 0; for (int w = 0; w < 8; ++w) tot += wt[w * 8 + F.tid]; base[F.tid] = (int)__hip_atomic_fetch_add(cntw + 64 * F.tid, (unsigned)tot, RLX_AGENT); }
        __syncthreads();
        const int rank = base[me] + off + myrank, tok = T0 + (F.tid >> 1);
        list[(size_t)me * NTOK + rank] = tok; rsl[(size_t)me * NTOK + rank] = rsd[F.tid >> 1];
        tokinfo[(size_t)tok * 8 + (F.tid & 1) * 4 + 1] = (unsigned)rank;
    }
}
template <bool GATHER, bool FP8 = false>
struct MoeOrder {
    static constexpr size_t A_BLK = GATHER ? 0 : (FP8 ? (size_t)256 * FFE8 : (size_t)256 * FFEP * 2), B_EXP = GATHER ? (FP8 ? (size_t)2 * FFEP * DM : (size_t)2 * FFEP * DM * 2) : (FP8 ? (size_t)DM * FFE8 : (size_t)DM * FFEP * 2),
                            B_TILE = GATHER ? (FP8 ? (size_t)256 * DM : (size_t)256 * DM * 2) : (FP8 ? (size_t)256 * FFE8 : (size_t)256 * FFEP * 2);
    static constexpr int NT = GATHER ? 2 * FFEP / 256 : DM / 256;
    const char* A; const char* B; const int* list; const unsigned* cntw; int G, c, rev; unsigned bs[9];
    __device__ __forceinline__ void init(const unsigned* cntw_, const void* A_, const void* B_, const int* list_, int G_, int c_) {
        A = (const char*)A_; B = (const char*)B_; list = list_; cntw = cntw_; G = G_; c = c_; rev = 0; bs[0] = 0u;
#pragma unroll
        for (int e = 0; e < 8; ++e) { const unsigned ce = rfl(__hip_atomic_load((unsigned*)cntw + 64 * e, RLX_AGENT)); bs[e + 1] = bs[e] + ((ce + 255u) >> 8); }
    }
    __device__ __forceinline__ bool next(int i, pg8::Unit& u) const {
        unsigned blk; int pn;
        if ((G & 7) == 0) {
            const int x = c & 7, cl = c >> 3, q = (int)bs[8] >> 3, r = (int)bs[8] & 7, nbx = q + (x < r ? 1 : 0), b0 = x * q + (x < r ? x : r);
            int U = i * (G >> 3) + cl; const int nwx = nbx * NT; if (U >= nwx) return false;
            if (rev) U = nwx - 1 - U;
            const int nig = pg8::WGM * NT, gid = U / nig, fm = gid * pg8::WGM, gsz = (nbx - fm) < pg8::WGM ? (nbx - fm) : pg8::WGM;
            blk = (unsigned)(b0 + fm + (U % nig) % gsz); pn = (U % nig) / gsz;
        } else {
            long L = (long)i * G + c; if (L >= (long)bs[8] * NT) return false;
            if (rev) L = (long)bs[8] * NT - 1 - L;
            blk = (unsigned)(L / NT); pn = (int)(L % NT);
        }
        unsigned e = 0u, st = 0u;
#pragma unroll
        for (int k = 1; k < 8; ++k) if (blk >= bs[k]) { e = (unsigned)k; st = bs[k]; }
        const unsigned j = blk - st;
        u.b = B + (size_t)e * B_EXP + (size_t)pn * B_TILE; u.orow = (int)(blk * 256u); u.pn = pn; u.aux = (int)e;
        if constexpr (GATHER) { const unsigned ce = rfl(__hip_atomic_load((unsigned*)cntw + 64 * e, RLX_AGENT));
            u.a = A; u.rows = list + (size_t)e * NTOK + (size_t)j * 256; const unsigned rem = ce - j * 256u; u.nrows = rem < 256u ? (int)rem : 256; }
        else { u.a = A + (size_t)blk * A_BLK; u.rows = nullptr; u.nrows = 256; }
        return true;
    }
};
constexpr int NPHASE = 27;
struct Args { const float* in[20]; float* out; unsigned char* ws; int ph_lo, ph_hi, li, pad; };
#ifndef MK_REP_MASK
#define MK_REP_MASK 0
#endif
#ifndef MK_REP_N
#define MK_REP_N 1
#endif
#ifndef MK_REV
#define MK_REV 1
#endif
#ifndef MK_STAG_BF
#define MK_STAG_BF 0u
#define MK_STAG_F8 0u
#endif
constexpr int PT_OFF = LDSCTL_OFF + 512;
__device__ __forceinline__ unsigned long long ptab_u64(LAS unsigned char* L, int i) {
    const volatile LAS unsigned* p = (const volatile LAS unsigned*)(L + PT_OFF + 8 * i); const unsigned lo = rfl(p[0]), hi = rfl(p[1]); return ((unsigned long long)hi << 32) | lo; }
__device__ __forceinline__ const float* ptab(LAS unsigned char* L, int i) { return (const float*)(GAS const float*)ptab_u64(L, i); }
__device__ __forceinline__ Frame make_frame(LAS unsigned char* L) {
    asm volatile("" : "+s"(L));
    Frame F; F.lds = L; F.MISC = (volatile LAS unsigned*)(L + MISC_OFF); F.tid = launder_v((int)threadIdx.x); F.lane = F.tid & 63; F.wave = __builtin_amdgcn_readfirstlane(F.tid >> 6);
    { int g_ = gridDim.x, bx = blockIdx.x; asm volatile("" : "+s"(g_), "+s"(bx)); F.G = g_; F.bx = bx;
      F.vcu = (F.G % 8 == 0) ? (bx % 8) * (F.G / 8) + bx / 8 : bx; }
    F.ws = (unsigned char*)(GAS unsigned char*)ptab_u64(L, 21); F.ctl = (gu32*)(F.ws + WS_CTL); return F;
}
__global__ void __launch_bounds__(NWAVES * 64, 2) fwd(Args args) {
    extern __shared__ __attribute__((aligned(16))) unsigned char lds[];
    LAS unsigned char* L = (LAS unsigned char*)lds;
    { const int tid = threadIdx.x;
      for (int u = tid; u < LDSCTL_BYTES / 4; u += NWAVES * 64) ((LAS unsigned*)(L + LDSCTL_OFF))[u] = 0u;
      __syncthreads();
      if (tid < 20) *(LAS unsigned long long*)(L + PT_OFF + 8 * tid) = (unsigned long long)args.in[tid];
      if (tid == 20) *(LAS unsigned long long*)(L + PT_OFF + 8 * 20) = (unsigned long long)args.out;
      if (tid == 21) *(LAS unsigned long long*)(L + PT_OFF + 8 * 21) = (unsigned long long)args.ws;
      if (tid == 22) *(LAS unsigned long long*)(L + PT_OFF + 8 * 22) = (unsigned long long)args.pad;
      __syncthreads(); }
    const int lo = args.ph_lo, hi = args.ph_hi;
    XcdBarrier bar; { gu32* ctl = (gu32*)(args.ws + WS_CTL); bar.bar = (unsigned*)(ctl + CW_BAR) + args.li * XCD_BAR_WORDS; bar.x = 0; bar.st = nullptr;
      if (threadIdx.x == 0) { const unsigned long long ba = (unsigned long long)((unsigned*)(ctl + CW_BAR) + args.li * XCD_BAR_WORDS); ((volatile LAS unsigned*)(L + MISC_OFF))[10] = (unsigned)ba; ((volatile LAS unsigned*)(L + MISC_OFF))[11] = (unsigned)(ba >> 32); }
      if (hi - lo > 1) bar = xcd_barrier_post((unsigned*)(ctl + CW_BAR) + args.li * XCD_BAR_WORDS, (volatile LAS unsigned*)(L + MISC_OFF) + 8);
      __syncthreads(); }
#ifndef MK_ONLY
#define MK_ONLY (-1)
#endif
#define KIND(k) ((k) == 0 ? 0 : 1 + ((k) - 1) % 13)
#ifndef MK_SKIPMASK
#define MK_SKIPMASK 0
#endif
#define IN(k) ((MK_ONLY < 0 || KIND(k) == MK_ONLY) && !((MK_SKIPMASK >> KIND(k)) & 1) && lo <= (k) && (k) < hi)
#define FORREP(k)
#if MK_REP_MASK
#define LASTREP (ptab_u64(F.lds, 22) == 0ull)
#else
#define LASTREP true
#endif
#ifdef MK_DOUBLE_BAR
#define SEAM(k) do { if ((k) + 1 < hi) { xcd_barrier(bar); xcd_barrier(bar); } } while (0)
#else
#define SEAM(k) do { if ((k) + 1 < hi) xcd_barrier(bar); } while (0)
#endif
#define WSP(off) ((bf16_t*)(F.ws + (off)))
#define SSQ(i) ((ssq_t*)(F.ws + WS_SSQ) + (size_t)(i) * NTOK)
    LAS unsigned char* ring = L + RING_OFF;

    if (IN(0)) FORREP(0) { Frame F = make_frame(L); p0_prologue(F); SEAM(0); }

    for (int lp = 0; lp < 2; ++lp) {
        const int pb = 1 + 13 * lp;
        if (IN(pb + 0)) FORREP(pb + 0) { Frame F = make_frame(L);
            pg8::RegOrder S; S.init(WSP(WS_H), DM * 2, WSP(WS_WDN) + (size_t)lp * NDOWNP * DM, DM * 2, NTOK, NDOWNP, F.G, F.bx);
            pg8::EpiDown E{WSP(WS_DOWN), WSP(WS_KR), SSQ(4 * lp + 0), LASTREP ? SSQ(10 + 2 * lp) : SSQ(9), LASTREP ? SSQ(11 + 2 * lp) : SSQ(9), (const float*)(F.ws + WS_COS), (const float*)(F.ws + WS_SIN)};
            pg8::gemm_phase<pg8::EpiDown, pg8::RegOrder, false>(ring, DM * 2, DM * 2, DM * 2, S, E);
            SEAM(pb + 0);
        }
        if (IN(pb + 1)) FORREP(pb + 1) { Frame F = make_frame(L);
            pg8::RegOrder S; S.init(WSP(WS_DOWN), NDOWNP * 2, WSP(WS_WUQ) + (size_t)lp * NQ * QLR, QLR * 2, NTOK, NQ, F.G, F.bx);
            pg8::EpiQ E{WSP(WS_Q), (const float*)(F.ws + WS_COS), (const float*)(F.ws + WS_SIN), SSQ(10 + 2 * lp)};
            pg8::gemm_phase<pg8::EpiQ, pg8::RegOrder, false>(ring, NDOWNP * 2, QLR * 2, QLR * 2, S, E);
            SEAM(pb + 1);
        }
        if (IN(pb + 2)) FORREP(pb + 2) { Frame F = make_frame(L);
            pg8::RegOrder S; S.init(WSP(WS_DOWN) + QLR, NDOWNP * 2, WSP(WS_WUKV) + (size_t)lp * NKV * KVLR, KVLR * 2, NTOK, NKV, F.G, F.bx);
            pg8::EpiBf16<2> E{WSP(WS_KNV), NKV, SSQ(11 + 2 * lp)};
            pg8::gemm_phase<pg8::EpiBf16<2>, pg8::RegOrder, false>(ring, NDOWNP * 2, KVLR * 2, KVLR * 2, S, E);
            SEAM(pb + 2);
        }
        if (IN(pb + 3)) FORREP(pb + 3) { Frame F = make_frame(L); att::attn_phase((char*)lds + RING_OFF, WSP(WS_Q), WSP(WS_KNV), WSP(WS_KR), WSP(WS_DOWN), F.vcu, F.G); SEAM(pb + 3); }
        if (IN(pb + 4) && lp == 0) FORREP(pb + 4) { Frame F = make_frame(L);
            pg8::RegOrder S; S.init(WSP(WS_DOWN), DM * 2, WSP(WS_WO) + (size_t)lp * DM * DM, DM * 2, NTOK, DM, F.G, F.bx);
            pg8::EpiResidH<false> E{WSP(WS_H), LASTREP ? WSP(WS_H) : WSP(WS_DUMMY), LASTREP ? SSQ(4 * lp + 1) : SSQ(9), nullptr, 1.0f};
            pg8::gemm_phase<pg8::EpiResidH<false>, pg8::RegOrder, false>(ring, DM * 2, DM * 2, DM * 2, S, E);
            SEAM(pb + 4);
        }
        if (IN(pb + 4) && lp == 1) FORREP(pb + 4) { Frame F = make_frame(L);
            pg8::RegOrder S; S.init(WSP(WS_DOWN), DM * 2, WSP(WS_WO) + (size_t)lp * DM * DM, DM * 2, NTOK, DM, F.G, F.bx);
            pg8::EpiResidH<true> E{WSP(WS_H), LASTREP ? WSP(WS_H) : WSP(WS_DUMMY), LASTREP ? SSQ(4 * lp + 1) : SSQ(9), F.ws + WS_H8, 1.0f};
            pg8::gemm_phase<pg8::EpiResidH<true>, pg8::RegOrder, false>(ring, DM * 2, DM * 2, DM * 2, S, E);
            SEAM(pb + 4);
        }
#if defined(MK_EPI_PROBE)
        if (IN(pb + 5) && lp == 0 && !LASTREP) { Frame F = make_frame(L);
            pg8::RegOrder S; S.init(WSP(WS_H), DM * 2, WSP(WS_WGU) + (size_t)lp * 2 * FFD * DM, DM * 2, NTOK, 2 * FFD, F.G, F.bx);
#if MK_EPI_PROBE == 1
            pg8::EpiNull E{(float*)(F.ws + WS_DUMMY)};
            pg8::gemm_phase<pg8::EpiNull, pg8::RegOrder, false>(ring, DM * 2, DM * 2, DM * 2, S, E);
#else
            pg8::EpiBf16<0> E{WSP(WS_HID), FFD, nullptr};
            S.nN = FFD / 256; S.nwg = S.nM * S.nN;
            pg8::gemm_phase<pg8::EpiBf16<0>, pg8::RegOrder, false>(ring, DM * 2, DM * 2, DM * 2, S, E);
#endif
        }
        if (IN(pb + 5) && lp == 0 && LASTREP) FORREP(pb + 5) { Frame F = make_frame(L);
#else
        if (IN(pb + 5) && lp == 0) FORREP(pb + 5) { Frame F = make_frame(L);
#endif
            pg8::RegOrder S; S.init(WSP(WS_H), DM * 2, WSP(WS_WGU) + (size_t)lp * 2 * FFD * DM, DM * 2, NTOK, 2 * FFD, F.G, F.bx);
            pg8::EpiSwiglu<1> E{WSP(WS_HID), FFD, SSQ(4 * lp + 1), nullptr};
            pg8::gemm_phase<pg8::EpiSwiglu<1>, pg8::RegOrder, false>(ring, DM * 2, DM * 2, DM * 2, S, E, MK_STAG_BF);
            SEAM(pb + 5);
        }
        if (IN(pb + 5) && lp == 1) FORREP(pb + 5) { Frame F = make_frame(L);
            pg8::RegOrder S; S.init(F.ws + WS_H8, DM, F.ws + WS_WGU + (size_t)2 * FFD * DM * 2, DM, NTOK, 2 * FFD, F.G, F.bx);
            pg8::EpiSwigluF8<1> E{F.ws + WS_HID, FFD8, 2 * FFD / 256 - 1, SSQ(4 * lp + 1)};
            pg8::gemm_phase<pg8::EpiSwigluF8<1>, pg8::RegOrder, false, true>(ring, DM, DM, DM, S, E, MK_STAG_F8);
            SEAM(pb + 5);
        }
        if (IN(pb + 6) && lp == 0) FORREP(pb + 6) { Frame F = make_frame(L);
            pg8::RegOrder S; S.init(WSP(WS_HID), FFD * 2, WSP(WS_WD) + (size_t)lp * DM * FFD, FFD * 2, NTOK, DM, F.G, F.bx); S.rev = MK_REV;
            pg8::EpiResidH<false> E{WSP(WS_H), LASTREP ? WSP(WS_H) : WSP(WS_DUMMY), LASTREP ? SSQ(4 * lp + 2) : SSQ(9), nullptr, 1.0f};
            pg8::gemm_phase<pg8::EpiResidH<false>, pg8::RegOrder, false>(ring, FFD * 2, FFD * 2, FFD * 2, S, E);
            SEAM(pb + 6);
        }
        if (IN(pb + 6) && lp == 1) FORREP(pb + 6) { Frame F = make_frame(L);
            pg8::RegOrder S; S.init(F.ws + WS_HID, FFD8, F.ws + WS_WD + (size_t)DM * FFD * 2, FFD8, NTOK, DM, F.G, F.bx); S.rev = MK_REV;
            pg8::EpiResidH<false> E{WSP(WS_H), LASTREP ? WSP(WS_H) : WSP(WS_DUMMY), LASTREP ? SSQ(4 * lp + 2) : SSQ(9), nullptr, 1.0f / (pg8::FP8_SH * pg8::FP8_SW)};
            pg8::gemm_phase<pg8::EpiResidH<false>, pg8::RegOrder, false, true>(ring, FFD8, FFD8, FFD8, S, E);
            SEAM(pb + 6);
        }
        if (IN(pb + 7)) FORREP(pb + 7) { Frame F = make_frame(L); pool_phase(F, WSP(WS_H), SSQ(4 * lp + 2), ptab(F.lds, 2) + (size_t)(2 * lp + 1) * DM, WSP(WS_DOWN)); SEAM(pb + 7); }
        if (IN(pb + 8)) FORREP(pb + 8) { Frame F = make_frame(L);
            pg8::RegOrder S; S.init(WSP(WS_DOWN), DM * 2, WSP(WS_WPOOL) + (size_t)lp * 4 * 256 * 256, 256 * 2, NTOK, DM, F.G, F.bx, 256 * 2);
            pg8::EpiResidH<false> E{WSP(WS_H), LASTREP ? WSP(WS_H) : WSP(WS_DUMMY), LASTREP ? SSQ(4 * lp + 3) : SSQ(9), nullptr, 1.0f};
            pg8::gemm_phase<pg8::EpiResidH<false>, pg8::RegOrder, false>(ring, DM * 2, 256 * 2, 256 * 2, S, E);
            SEAM(pb + 8);
        }
        if (IN(pb + 9)) FORREP(pb + 9) { Frame F = make_frame(L);
            if (lp == 0) router_phase<false>(F, WSP(WS_H), SSQ(4 * lp + 3), ptab(F.lds, 3) + (size_t)(2 * lp + 1) * DM, ptab(F.lds, 15) + (size_t)lp * DM * NEXP, (int*)(F.ws + WS_LIST), (float*)(F.ws + WS_RSL), (unsigned*)(F.ws + WS_TOKINFO), (unsigned*)(F.ctl + CW_CNT) + (LASTREP ? lp : 2 + lp) * 8 * 64, nullptr);
            else router_phase<true>(F, WSP(WS_H), SSQ(4 * lp + 3), ptab(F.lds, 3) + (size_t)(2 * lp + 1) * DM, ptab(F.lds, 15) + (size_t)lp * DM * NEXP, (int*)(F.ws + WS_LIST), (float*)(F.ws + WS_RSL), (unsigned*)(F.ws + WS_TOKINFO), (unsigned*)(F.ctl + CW_CNT) + (LASTREP ? lp : 2 + lp) * 8 * 64, F.ws + WS_H8);
            SEAM(pb + 9); }
#ifndef TEST_NO_BF16MOE
        if (IN(pb + 10) && lp == 0) FORREP(pb + 10) { Frame F = make_frame(L);
            MoeOrder<true> S; S.init((unsigned*)(F.ctl + CW_CNT) + lp * 8 * 64, WSP(WS_H), WSP(WS_MWGU), (const int*)(F.ws + WS_LIST), F.G, F.bx);
            pg8::EpiSwiglu<2> E{WSP(WS_HID), FFEP, (const float*)(F.ws + WS_RSL), (const int*)(F.ws + WS_LIST)};
            pg8::gemm_phase<pg8::EpiSwiglu<2>, MoeOrder<true>, true>(ring, DM * 2, DM * 2, DM * 2, S, E, MK_STAG_BF);
            SEAM(pb + 10);
        }
#endif
#ifndef TEST_NO_F8MOE
        if (IN(pb + 10) && lp == 1) FORREP(pb + 10) { Frame F = make_frame(L);
            MoeOrder<true, true> S; S.init((unsigned*)(F.ctl + CW_CNT) + lp * 8 * 64, F.ws + WS_H8, F.ws + WS_MWGU + (size_t)8 * 2 * FFEP * DM * 2, (const int*)(F.ws + WS_LIST), F.G, F.bx);
            pg8::EpiSwigluF8<0> E{F.ws + WS_HID, FFE8, 2 * FFEP / 256 - 1, nullptr};
            pg8::gemm_phase<pg8::EpiSwigluF8<0>, MoeOrder<true, true>, true, true>(ring, DM, DM, DM, S, E, MK_STAG_F8);
            SEAM(pb + 10);
        }
#endif
#ifndef TEST_NO_BF16MOE
        if (IN(pb + 11) && lp == 0) FORREP(pb + 11) { Frame F = make_frame(L);
            MoeOrder<false> S; S.init((unsigned*)(F.ctl + CW_CNT) + lp * 8 * 64, WSP(WS_HID), WSP(WS_MWD), (const int*)(F.ws + WS_LIST), F.G, F.bx); S.rev = MK_REV;
            pg8::EpiBf16<0> E{WSP(WS_YB), DM, nullptr};
            pg8::gemm_phase<pg8::EpiBf16<0>, MoeOrder<false>, false>(ring, FFEP * 2, FFEP * 2, FFEP * 2, S, E);
            SEAM(pb + 11);
        }
#endif
#ifndef TEST_NO_F8MOE
        if (IN(pb + 11) && lp == 1) FORREP(pb + 11) { Frame F = make_frame(L);
            MoeOrder<false, true> S; S.init((unsigned*)(F.ctl + CW_CNT) + lp * 8 * 64, F.ws + WS_HID, F.ws + WS_MWD + (size_t)8 * DM * FFEP * 2, (const int*)(F.ws + WS_LIST), F.G, F.bx); S.rev = MK_REV;
            pg8::EpiBf16Scaled E{WSP(WS_YB), DM, 1.0f / (pg8::FP8_SH * pg8::FP8_SW)};
            pg8::gemm_phase<pg8::EpiBf16Scaled, MoeOrder<false, true>, false, true>(ring, FFE8, FFE8, FFE8, S, E);
            SEAM(pb + 11);
        }
#endif
        if (IN(pb + 12)) FORREP(pb + 12) { Frame F = make_frame(L);
            if (lp == 0) combine_phase<false>(F, WSP(WS_H), LASTREP ? WSP(WS_H) : WSP(WS_DOWN), WSP(WS_YB), (const unsigned*)(F.ws + WS_TOKINFO), (unsigned*)(F.ctl + CW_CNT), LASTREP ? SSQ(4) : SSQ(9), nullptr, nullptr);
            else combine_phase<true>(F, WSP(WS_H), nullptr, WSP(WS_YB), (const unsigned*)(F.ws + WS_TOKINFO), (unsigned*)(F.ctl + CW_CNT) + 8 * 64, nullptr, ptab(F.lds, 19), (float*)ptab(F.lds, 20));
            SEAM(pb + 12);
        }
    }
#undef IN
#undef SEAM
#undef WSP
#undef SSQ
}

#ifndef MK_PER_PHASE
#define MK_PER_PHASE 0
#endif
extern "C" void kernel_launch(void* const* d_in, const int* in_sizes, int n_in, void* d_out, int out_size, void* d_ws, size_t ws_size, hipStream_t stream) {
    static int grid = 0;
    if (grid == 0) {
        if (n_in != 20 || in_sizes[0] != NTOK * DM || out_size != NTOK * DM || ws_size < WS_END) { fprintf(stderr, "kernel_launch: unexpected shapes (n_in %d, in0 %d, out %d, ws %zu < %zu)\n", n_in, n_in > 0 ? in_sizes[0] : -1, out_size, ws_size, (size_t)WS_END); grid = -1; return; }
        int dev = 0, cus = 0, per_cu = 0;
        if (hipGetDevice(&dev) != hipSuccess || hipDeviceGetAttribute(&cus, hipDeviceAttributeMultiprocessorCount, dev) != hipSuccess) { grid = -1; return; }
        if (hipFuncSetAttribute((const void*)fwd, hipFuncAttributeMaxDynamicSharedMemorySize, LDS_BYTES) != hipSuccess) { fprintf(stderr, "kernel_launch: hipFuncSetAttribute failed\n"); grid = -1; return; }
        if (hipOccupancyMaxActiveBlocksPerMultiprocessor(&per_cu, (const void*)fwd, NWAVES * 64, LDS_BYTES) != hipSuccess || per_cu < 1) fprintf(stderr, "kernel_launch: occupancy query reports %d\n", per_cu);
        (void)hipGetLastError();
        grid = cus < 256 ? cus : 256;
    }
    if (grid < 0) return;
    if (hipMemsetAsync((char*)d_ws + WS_CTL, 0, CTL_ZERO_BYTES, stream) != hipSuccess) return;
    Args a{};
    for (int i = 0; i < 20; ++i) a.in[i] = (const float*)d_in[i];
    a.out = (float*)d_out; a.ws = (unsigned char*)d_ws;
#if MK_PER_PHASE
    for (int p = 0; p < NPHASE; ++p) { a.ph_lo = p; a.ph_hi = p + 1; a.li = 0; hipLaunchKernelGGL(fwd, dim3(grid), dim3(NWAVES * 64), LDS_BYTES, stream, a); }
#elif MK_REP_MASK
    { int cur = 0, li = 0;
      for (int k = 0; k < NPHASE; ++k) if ((MK_REP_MASK >> (k == 0 ? 0 : 1 + (k - 1) % 13)) & 1) {
          if (k > cur) { a.ph_lo = cur; a.ph_hi = k; a.li = li++; a.pad = 0; hipLaunchKernelGGL(fwd, dim3(grid), dim3(NWAVES * 64), LDS_BYTES, stream, a); }
          for (int r = 1; r < MK_REP_N; ++r) { a.ph_lo = k; a.ph_hi = k + 1; a.li = li++; a.pad = 1; hipLaunchKernelGGL(fwd, dim3(grid), dim3(NWAVES * 64), LDS_BYTES, stream, a); }
          cur = k; }
      a.ph_lo = cur; a.ph_hi = NPHASE; a.li = li++; a.pad = 0; hipLaunchKernelGGL(fwd, dim3(grid), dim3(NWAVES * 64), LDS_BYTES, stream, a); }
#elif defined(MK_TWICE)
    a.ph_lo = 0; a.ph_hi = NPHASE; a.li = 0;
    hipLaunchKernelGGL(fwd, dim3(grid), dim3(NWAVES * 64), LDS_BYTES, stream, a);
    (void)hipMemsetAsync((char*)d_ws + WS_CTL, 0, CTL_ZERO_BYTES, stream);
    hipLaunchKernelGGL(fwd, dim3(grid), dim3(NWAVES * 64), LDS_BYTES, stream, a);
#else
    a.ph_lo = 0; a.ph_hi = NPHASE; a.li = 0;
    hipLaunchKernelGGL(fwd, dim3(grid), dim3(NWAVES * 64), LDS_BYTES, stream, a);
#endif
}
```

```cpp
#include <hip/hip_runtime.h>
#include <cstdio>
#include <cstdint>

#define GAS __attribute__((address_space(1)))
#define LAS __attribute__((address_space(3)))
typedef unsigned short bf16_t;
typedef short bf16x8 __attribute__((ext_vector_type(8)));
typedef short s16x4 __attribute__((ext_vector_type(4)));
typedef float f32x2 __attribute__((ext_vector_type(2)));
typedef float f32x4 __attribute__((ext_vector_type(4)));
typedef float f32x16 __attribute__((ext_vector_type(16)));
typedef unsigned u32x2 __attribute__((ext_vector_type(2)));
typedef unsigned u32x4 __attribute__((ext_vector_type(4)));

constexpr int DM = 1024, NBATCH = 32, SEQ = 2048, NTOK = NBATCH * SEQ;
constexpr int NHEAD = 8, DNOPE = 128, DROPE = 64, DVH = 128, DQH = DNOPE + DROPE, QLR = 512, KVLR = 256;
constexpr int NDOWN = QLR + KVLR + DROPE  , NDOWNP = 1024;
constexpr int NQ = NHEAD * DQH  , NKV = NHEAD * (DNOPE + DVH)  ;
constexpr int FFD = 2688, NEXP = 8, FFE = 1344, FFEP = 1408;
constexpr int PSLOT = (NTOK * 2 / 256 + NEXP) * 256;
constexpr float RMS_EPS = 1e-6f;

__device__ __forceinline__ unsigned cvt_pk_bf16(float lo, float hi) { unsigned r; asm volatile("v_cvt_pk_bf16_f32 %0, %1, %2" : "=v"(r) : "v"(lo), "v"(hi)); return r; }
__device__ __forceinline__ int launder_v(int v) { asm volatile("" : "+v"(v)); return v; }
__device__ __forceinline__ float fp8_rt(float x, float s) { const int p = __builtin_amdgcn_cvt_pk_fp8_f32(x * s, 0.f, 0, false); return __builtin_amdgcn_cvt_f32_fp8(p, 0) * (1.0f / s); }
__device__ __forceinline__ float bf2f(unsigned short b) { return __uint_as_float((unsigned)b << 16); }
__device__ __forceinline__ float bflo(unsigned w) { return __uint_as_float(w << 16); }
__device__ __forceinline__ float bfhi(unsigned w) { return __uint_as_float(w & 0xffff0000u); }

typedef unsigned long long ssq_t;
__device__ __forceinline__ ssq_t ssq_fix(float s) { return (ssq_t)(s * 16777216.0f); }
__device__ __forceinline__ float rstd_n(ssq_t q, float invn) { return __builtin_amdgcn_rsqf(((float)(unsigned)(q >> 32) * 4294967296.0f + (float)(unsigned)q) * (1.0f / 16777216.0f) * invn + RMS_EPS); }
__device__ __forceinline__ float rstd_of(ssq_t q) { return rstd_n(q, 1.0f / DM); }
__device__ __forceinline__ float rstd_f(float ssq) { return __builtin_amdgcn_rsqf(ssq * (1.0f / DM) + RMS_EPS); }

namespace pg8 {
constexpr int BM = 256, BK = 64, HALF = 128, HTB = HALF * BK * 2  , STAGE_BYTES = 8 * HTB, NXCD = 8, WGM = 8;
__host__ __device__ __forceinline__ int lds_byte(int r, int c) { const int st = (r >> 4) * 2 + (c >> 5), rr = r & 15, cc = c & 31, ob = rr * 64 + cc * 2; return st * 1024 + (ob ^ (((ob >> 9) & 1) << 5)); }
__host__ __device__ __forceinline__ void stage_rc(int b, int& R, int& C) { const int st = b / 1024, sb = b % 1024, swz = sb ^ (((sb >> 9) & 1) << 5); R = (st >> 1) * 16 + swz / 64; C = (st & 1) * 32 + (swz % 64) / 2; }
__host__ __device__ __forceinline__ int perm32(int rho) { const int n = rho >> 4, i = rho & 15; return 8 * (i >> 2) + 4 * n + (i & 3); }

struct Unit { const char* a; const char* b; const int* rows; int nrows; int orow; int pn; int aux; };

struct RegOrder {
    const char* A; const char* B; unsigned a_tile, b_tile, a_colstep; int nM, nN, nwg, G, c, rev;
    __device__ __forceinline__ void init(const void* A_, size_t lda_b, const void* B_, size_t ldb_b, int M, int N, int G_, int c_, size_t a_colstep_ = 0) {
        A = (const char*)A_; B = (const char*)B_; a_tile = (unsigned)(256 * lda_b); b_tile = (unsigned)(256 * ldb_b); a_colstep = (unsigned)a_colstep_; nM = M / BM; nN = N / BM; nwg = nM * nN; G = G_; c = c_; rev = 0; }
    __device__ __forceinline__ bool next(int i, Unit& u) const {
        long L = (long)i * G + c; if (L >= nwg) return false;
        if (rev) L = nwg - 1 - L;
        int wgid = (int)L; { const int q = nwg / NXCD, r = nwg % NXCD, xcd = wgid % NXCD, off = wgid / NXCD; wgid = (xcd < r ? xcd * (q + 1) : r * (q + 1) + (xcd - r) * q) + off; }
        const int nig = WGM * nN, gid = wgid / nig, fm = gid * WGM, gsz = (nM - fm) < WGM ? (nM - fm) : WGM;
        const int pm = fm + ((wgid % nig) % gsz), pn = (wgid % nig) / gsz;
        u.a = A + (size_t)pm * a_tile + (size_t)pn * a_colstep; u.b = B + (size_t)pn * b_tile; u.rows = nullptr; u.nrows = 256; u.orow = pm * BM; u.pn = pn; u.aux = 0; return true;
    }
};

template <int RS> struct EpiBf16 {
    static constexpr bool PERM = true;
    bf16_t* O; int ldc; const ssq_t* rs;
    __device__ __forceinline__ void operator()(const f32x4 (&acc)[2][2][4][2], const Unit& u, int wr, int wc, int fr, int fq) const {
        const int row0 = u.orow + launder_v(wr * 64 + fr), col0 = u.pn * BM + wc * 32 + 8 * fq;
        float sc[2][4]; ssq_t rq[2][4];
#pragma unroll
        for (int ai = 0; ai < 2; ++ai)
#pragma unroll
            for (int m = 0; m < 4; ++m) { const int row = row0 + ai * HALF + m * 16; if constexpr (RS != 0) rq[ai][m] = rs[row]; }
#pragma unroll
        for (int ai = 0; ai < 2; ++ai)
#pragma unroll
            for (int m = 0; m < 4; ++m) { sc[ai][m] = 1.0f; if constexpr (RS == 1) sc[ai][m] = rstd_of(rq[ai][m]); if constexpr (RS == 2) sc[ai][m] = rstd_n(rq[ai][m], 1.0f / KVLR); }
#pragma unroll
        for (int ai = 0; ai < 2; ++ai)
#pragma unroll
            for (int m = 0; m < 4; ++m) { const int row = row0 + ai * HALF + m * 16; bf16_t* rowp = O + (size_t)row * ldc + col0;
#pragma unroll
                for (int bj = 0; bj < 2; ++bj) { const f32x4 v0 = acc[ai][bj][m][0] * sc[ai][m], v1 = acc[ai][bj][m][1] * sc[ai][m];
                    u32x4 w; w.x = cvt_pk_bf16(v0[0], v0[1]); w.y = cvt_pk_bf16(v0[2], v0[3]); w.z = cvt_pk_bf16(v1[0], v1[1]); w.w = cvt_pk_bf16(v1[2], v1[3]);
                    *(u32x4*)(rowp + bj * HALF) = w; } }
    }
};
__device__ __forceinline__ float silu_mul(float g, float u) { return g * u * __builtin_amdgcn_rcpf(1.0f + __builtin_amdgcn_exp2f(-1.4426950408889634f * g)); }
template <int RS> struct EpiSwiglu {
    static constexpr bool PERM = true;
    bf16_t* H; int ldh; const void* rs; const int* list;
    __device__ __forceinline__ void operator()(const f32x4 (&acc)[2][2][4][2], const Unit& u, int wr, int wc, int fr, int fq) const {
        const int r0 = launder_v(wr * 64 + fr), col0 = u.pn * HALF + wc * 32 + 8 * fq;
        const ssq_t* rsq = (const ssq_t*)rs; const float* rsp = (const float*)rs; if constexpr (RS == 2) rsp = rsp + (u.rows - list);
        float sc[2][4]; ssq_t rq[2][4];
#pragma unroll
        for (int ai = 0; ai < 2; ++ai)
#pragma unroll
            for (int m = 0; m < 4; ++m) { const int r = r0 + ai * HALF + m * 16; if constexpr (RS == 1) rq[ai][m] = rsq[u.orow + r]; else sc[ai][m] = rsp[r]; }
        if constexpr (RS == 1) {
#pragma unroll
            for (int ai = 0; ai < 2; ++ai)
#pragma unroll
                for (int m = 0; m < 4; ++m) sc[ai][m] = rstd_of(rq[ai][m]); }
#pragma unroll
        for (int ai = 0; ai < 2; ++ai)
#pragma unroll
            for (int m = 0; m < 4; ++m) { const int r = r0 + ai * HALF + m * 16; bf16_t* rowp = H + (size_t)(u.orow + r) * ldh + col0; const float s = sc[ai][m];
                const f32x4 g0 = acc[ai][0][m][0] * s, g1 = acc[ai][0][m][1] * s, u0 = acc[ai][1][m][0] * s, u1 = acc[ai][1][m][1] * s;
                u32x4 w; w.x = cvt_pk_bf16(silu_mul(g0[0], u0[0]), silu_mul(g0[1], u0[1])); w.y = cvt_pk_bf16(silu_mul(g0[2], u0[2]), silu_mul(g0[3], u0[3]));
                w.z = cvt_pk_bf16(silu_mul(g1[0], u1[0]), silu_mul(g1[1], u1[1])); w.w = cvt_pk_bf16(silu_mul(g1[2], u1[2]), silu_mul(g1[3], u1[3]));
                __builtin_nontemporal_store(w, (u32x4*)rowp); }
    }
};
constexpr float FP8_SA = 16.0f, FP8_SW = 256.0f, FP8_SH = 16.0f, FP8_SX = 8.0f;
__device__ __forceinline__ unsigned pk4_fp8(float a, float b, float c, float d) { int p = __builtin_amdgcn_cvt_pk_fp8_f32(a, b, 0, false); p = __builtin_amdgcn_cvt_pk_fp8_f32(c, d, p, true); return (unsigned)p; }
template <int RS> struct EpiSwigluF8 {
    static constexpr bool PERM = true;
    unsigned char* H8; int ldh; int pad_tile; const ssq_t* rs;
    __device__ __forceinline__ void operator()(const f32x4 (&acc)[2][2][4][2], const Unit& u, int wr, int wc, int fr, int fq) const {
        const int r0 = launder_v(wr * 64 + fr), col0 = u.pn * HALF + wc * 32 + 8 * fq;
        float sc[2][4]; ssq_t rq[2][4];
#pragma unroll
        for (int ai = 0; ai < 2; ++ai)
#pragma unroll
            for (int m = 0; m < 4; ++m) { if constexpr (RS == 1) rq[ai][m] = rs[u.orow + r0 + ai * HALF + m * 16]; }
#pragma unroll
        for (int ai = 0; ai < 2; ++ai)
#pragma unroll
            for (int m = 0; m < 4; ++m) { if constexpr (RS == 1) sc[ai][m] = rstd_of(rq[ai][m]) * (1.0f / (FP8_SX * FP8_SW)); else sc[ai][m] = 1.0f / (FP8_SA * FP8_SW); }
#pragma unroll
        for (int ai = 0; ai < 2; ++ai)
#pragma unroll
            for (int m = 0; m < 4; ++m) { const int r = r0 + ai * HALF + m * 16; unsigned char* rowp = H8 + (size_t)(u.orow + r) * ldh + col0; const float s = sc[ai][m];
                const f32x4 g0 = acc[ai][0][m][0] * s, g1 = acc[ai][0][m][1] * s, u0 = acc[ai][1][m][0] * s, u1 = acc[ai][1][m][1] * s;
                u32x2 w; w.x = pk4_fp8(silu_mul(g0[0], u0[0]) * FP8_SH, silu_mul(g0[1], u0[1]) * FP8_SH, silu_mul(g0[2], u0[2]) * FP8_SH, silu_mul(g0[3], u0[3]) * FP8_SH);
                w.y = pk4_fp8(silu_mul(g1[0], u1[0]) * FP8_SH, silu_mul(g1[1], u1[1]) * FP8_SH, silu_mul(g1[2], u1[2]) * FP8_SH, silu_mul(g1[3], u1[3]) * FP8_SH);
                __builtin_nontemporal_store(w, (u32x2*)rowp);
                if (u.pn == pad_tile) { u32x2 z; asm volatile("v_mov_b32 %0, 0\n\tv_mov_b32 %1, 0" : "=v"(z.x), "=v"(z.y)); *(u32x2*)(rowp + HALF) = z; } }
    }
};
struct EpiBf16Scaled {
    static constexpr bool PERM = true;
    bf16_t* O; int ldc; float scale;
    __device__ __forceinline__ void operator()(const f32x4 (&acc)[2][2][4][2], const Unit& u, int wr, int wc, int fr, int fq) const {
        const int row0 = u.orow + launder_v(wr * 64 + fr), col0 = u.pn * BM + wc * 32 + 8 * fq;
#pragma unroll
        for (int ai = 0; ai < 2; ++ai)
#pragma unroll
            for (int m = 0; m < 4; ++m) { bf16_t* rowp = O + (size_t)(row0 + ai * HALF + m * 16) * ldc + col0;
#pragma unroll
                for (int bj = 0; bj < 2; ++bj) { const f32x4 v0 = acc[ai][bj][m][0] * scale, v1 = acc[ai][bj][m][1] * scale;
                    u32x4 w; w.x = cvt_pk_bf16(v0[0], v0[1]); w.y = cvt_pk_bf16(v0[2], v0[3]); w.z = cvt_pk_bf16(v1[0], v1[1]); w.w = cvt_pk_bf16(v1[2], v1[3]);
                    *(u32x4*)(rowp + bj * HALF) = w; } }
    }
};
struct EpiNull {
    static constexpr bool PERM = true;
    float* sink;
    __device__ __forceinline__ void operator()(const f32x4 (&acc)[2][2][4][2], const Unit& u, int wr, int wc, int fr, int fq) const {
        float s = 0.f;
#pragma unroll
        for (int ai = 0; ai < 2; ++ai)
#pragma unroll
            for (int bj = 0; bj < 2; ++bj)
#pragma unroll
                for (int m = 0; m < 4; ++m)
#pragma unroll
                    for (int n = 0; n < 2; ++n) s += acc[ai][bj][m][n][0];
        if (s == 12345.678f) sink[0] = s;
    }
};
template <bool W8> struct EpiResidH {
    static constexpr bool PERM = true;
    const bf16_t* hin; bf16_t* hout; ssq_t* ssq; unsigned char* h8; float scale;
    __device__ __forceinline__ void operator()(const f32x4 (&acc)[2][2][4][2], const Unit& u, int wr, int wc, int fr, int fq) const {
        const int row0 = u.orow + launder_v(wr * 64 + fr), col0 = u.pn * BM + wc * 32 + 8 * fq;
        float part[2][4];
#pragma unroll
        for (int ai = 0; ai < 2; ++ai) {
            u32x4 hv[4][2];
#pragma unroll
            for (int m = 0; m < 4; ++m)
#pragma unroll
                for (int bj = 0; bj < 2; ++bj) hv[m][bj] = *(const u32x4*)(hin + (size_t)(row0 + ai * HALF + m * 16) * DM + col0 + bj * HALF);
#pragma unroll
            for (int m = 0; m < 4; ++m) { const int row = row0 + ai * HALF + m * 16; const size_t off = (size_t)row * DM + col0; float pt = 0.f;
#pragma unroll
                for (int bj = 0; bj < 2; ++bj) { const u32x4 h4 = hv[m][bj]; const f32x4 a0 = acc[ai][bj][m][0] * scale, a1 = acc[ai][bj][m][1] * scale;
                    const float y0 = bflo(h4.x) + a0[0], y1 = bfhi(h4.x) + a0[1], y2 = bflo(h4.y) + a0[2], y3 = bfhi(h4.y) + a0[3], y4 = bflo(h4.z) + a1[0], y5 = bfhi(h4.z) + a1[1], y6 = bflo(h4.w) + a1[2], y7 = bfhi(h4.w) + a1[3];
                    pt += (y0 * y0 + y1 * y1) + (y2 * y2 + y3 * y3) + (y4 * y4 + y5 * y5) + (y6 * y6 + y7 * y7);
                    u32x4 w; w.x = cvt_pk_bf16(y0, y1); w.y = cvt_pk_bf16(y2, y3); w.z = cvt_pk_bf16(y4, y5); w.w = cvt_pk_bf16(y6, y7);
                    *(u32x4*)(hout + off + bj * HALF) = w;
                    if constexpr (W8) { u32x2 q; q.x = pk4_fp8(y0 * FP8_SX, y1 * FP8_SX, y2 * FP8_SX, y3 * FP8_SX); q.y = pk4_fp8(y4 * FP8_SX, y5 * FP8_SX, y6 * FP8_SX, y7 * FP8_SX); *(u32x2*)(h8 + off + bj * HALF) = q; } }
                pt += __shfl_xor(pt, 16); pt += __shfl_xor(pt, 32); part[ai][m] = pt; }
        }
        if (fq == 0) {
#pragma unroll
            for (int ai = 0; ai < 2; ++ai)
#pragma unroll
                for (int m = 0; m < 4; ++m) atomicAdd(ssq + row0 + ai * HALF + m * 16, ssq_fix(part[ai][m])); }
    }
};
struct EpiDown {
    static constexpr bool PERM = true;
    bf16_t* O; bf16_t* KR; const ssq_t* rs; ssq_t* ssq_q; ssq_t* ssq_kv; const float* cosT; const float* sinT;
    __device__ __forceinline__ void operator()(const f32x4 (&acc)[2][2][4][2], const Unit& u, int wr, int wc, int fr, int fq) const {
        const int row0 = u.orow + launder_v(wr * 64 + fr);
        float sc[2][4]; ssq_t rq[2][4];
#pragma unroll
        for (int ai = 0; ai < 2; ++ai)
#pragma unroll
            for (int m = 0; m < 4; ++m) rq[ai][m] = rs[row0 + ai * HALF + m * 16];
#pragma unroll
        for (int ai = 0; ai < 2; ++ai)
#pragma unroll
            for (int m = 0; m < 4; ++m) sc[ai][m] = rstd_of(rq[ai][m]);
        if (u.pn < 3) {
            ssq_t* sq = u.pn < 2 ? ssq_q : ssq_kv; const int col0 = u.pn * BM + wc * 32 + 8 * fq; float pts[2][4];
#pragma unroll
            for (int ai = 0; ai < 2; ++ai)
#pragma unroll
                for (int m = 0; m < 4; ++m) { const int row = row0 + ai * HALF + m * 16; bf16_t* rowp = O + (size_t)row * NDOWNP + col0; const float s = sc[ai][m]; float part = 0.f;
#pragma unroll
                    for (int bj = 0; bj < 2; ++bj) { const f32x4 v0 = acc[ai][bj][m][0] * s, v1 = acc[ai][bj][m][1] * s;
                        part += (v0[0] * v0[0] + v0[1] * v0[1]) + (v0[2] * v0[2] + v0[3] * v0[3]) + (v1[0] * v1[0] + v1[1] * v1[1]) + (v1[2] * v1[2] + v1[3] * v1[3]);
                        u32x4 w; w.x = cvt_pk_bf16(v0[0], v0[1]); w.y = cvt_pk_bf16(v0[2], v0[3]); w.z = cvt_pk_bf16(v1[0], v1[1]); w.w = cvt_pk_bf16(v1[2], v1[3]);
                        *(u32x4*)(rowp + bj * HALF) = w; }
                    part += __shfl_xor(part, 16); part += __shfl_xor(part, 32); pts[ai][m] = part; }
            if (fq == 0) {
#pragma unroll
                for (int ai = 0; ai < 2; ++ai)
#pragma unroll
                    for (int m = 0; m < 4; ++m) atomicAdd(sq + row0 + ai * HALF + m * 16, ssq_fix(pts[ai][m])); }
        } else if (wc == 0) {
#pragma unroll
            for (int aq = 0; aq < 4; ++aq) { const int ai = aq >> 1, mb = (aq & 1) * 2; f32x4 ct[4][2], st[4][2];
#pragma unroll
                for (int m = mb; m < mb + 2; ++m) { const size_t to = (size_t)(row0 + ai * HALF + m * 16) * 32 + 8 * fq;
                    ct[m][0] = *(const f32x4*)(cosT + to); ct[m][1] = *(const f32x4*)(cosT + to + 4); st[m][0] = *(const f32x4*)(sinT + to); st[m][1] = *(const f32x4*)(sinT + to + 4); }
#pragma unroll
                for (int m = mb; m < mb + 2; ++m) { const int row = row0 + ai * HALF + m * 16; const float s = sc[ai][m];
                    const f32x4 a0 = acc[ai][0][m][0] * s, a1 = acc[ai][0][m][1] * s, b0 = acc[ai][1][m][0] * s, b1 = acc[ai][1][m][1] * s;
                    const f32x4 x0 = a0 * ct[m][0] - b0 * st[m][0], x1 = a1 * ct[m][1] - b1 * st[m][1], y0 = b0 * ct[m][0] + a0 * st[m][0], y1 = b1 * ct[m][1] + a1 * st[m][1];
                    bf16_t* rp = KR + (size_t)row * DROPE + 8 * fq;
                    u32x4 w; w.x = cvt_pk_bf16(x0[0], x0[1]); w.y = cvt_pk_bf16(x0[2], x0[3]); w.z = cvt_pk_bf16(x1[0], x1[1]); w.w = cvt_pk_bf16(x1[2], x1[3]);
                    *(u32x4*)rp = w;
                    w.x = cvt_pk_bf16(y0[0], y0[1]); w.y = cvt_pk_bf16(y0[2], y0[3]); w.z = cvt_pk_bf16(y1[0], y1[1]); w.w = cvt_pk_bf16(y1[2], y1[3]);
                    *(u32x4*)(rp + 32) = w; } }
        }
    }
};
struct EpiQ {
    static constexpr bool PERM = true;
    bf16_t* Q; const float* cosT; const float* sinT; const ssq_t* rs;
    __device__ __forceinline__ void operator()(const f32x4 (&acc)[2][2][4][2], const Unit& u, int wr, int wc, int fr, int fq) const {
        const int row0 = u.orow + launder_v(wr * 64 + fr);
        float sc[2][4]; ssq_t rq[2][4];
#pragma unroll
        for (int ai = 0; ai < 2; ++ai)
#pragma unroll
            for (int m = 0; m < 4; ++m) rq[ai][m] = rs[row0 + ai * HALF + m * 16];
#pragma unroll
        for (int ai = 0; ai < 2; ++ai)
#pragma unroll
            for (int m = 0; m < 4; ++m) sc[ai][m] = rstd_n(rq[ai][m], 1.0f / QLR);
        if (u.pn < 2) {
            const int h = 4 * u.pn + wc;
#pragma unroll
            for (int aq = 0; aq < 4; ++aq) { const int ai = aq >> 1, mb = (aq & 1) * 2; f32x4 ct[4][2], st[4][2];
#pragma unroll
                for (int m = mb; m < mb + 2; ++m) { const size_t to = (size_t)(row0 + ai * HALF + m * 16) * 32 + 8 * fq;
                    ct[m][0] = *(const f32x4*)(cosT + to); ct[m][1] = *(const f32x4*)(cosT + to + 4); st[m][0] = *(const f32x4*)(sinT + to); st[m][1] = *(const f32x4*)(sinT + to + 4); }
#pragma unroll
                for (int m = mb; m < mb + 2; ++m) { const int row = row0 + ai * HALF + m * 16; const float s = sc[ai][m];
                    const f32x4 a0 = acc[ai][0][m][0] * s, a1 = acc[ai][0][m][1] * s, b0 = acc[ai][1][m][0] * s, b1 = acc[ai][1][m][1] * s;
                    const f32x4 x0 = a0 * ct[m][0] - b0 * st[m][0], x1 = a1 * ct[m][1] - b1 * st[m][1], y0 = b0 * ct[m][0] + a0 * st[m][0], y1 = b1 * ct[m][1] + a1 * st[m][1];
                    bf16_t* rp = Q + (size_t)row * NQ + h * DQH + DNOPE + 8 * fq;
                    u32x4 w; w.x = cvt_pk_bf16(x0[0], x0[1]); w.y = cvt_pk_bf16(x0[2], x0[3]); w.z = cvt_pk_bf16(x1[0], x1[1]); w.w = cvt_pk_bf16(x1[2], x1[3]);
                    *(u32x4*)rp = w;
                    w.x = cvt_pk_bf16(y0[0], y0[1]); w.y = cvt_pk_bf16(y0[2], y0[3]); w.z = cvt_pk_bf16(y1[0], y1[1]); w.w = cvt_pk_bf16(y1[2], y1[3]);
                    *(u32x4*)(rp + 32) = w; } }
        } else {
#pragma unroll
            for (int ai = 0; ai < 2; ++ai)
#pragma unroll
                for (int m = 0; m < 4; ++m) { const int row = row0 + ai * HALF + m * 16; const float s = sc[ai][m];
#pragma unroll
                    for (int bj = 0; bj < 2; ++bj) { const int h = 2 * (u.pn - 2) + bj; const f32x4 v0 = acc[ai][bj][m][0] * s, v1 = acc[ai][bj][m][1] * s;
                        u32x4 w; w.x = cvt_pk_bf16(v0[0], v0[1]); w.y = cvt_pk_bf16(v0[2], v0[3]); w.z = cvt_pk_bf16(v1[0], v1[1]); w.w = cvt_pk_bf16(v1[2], v1[3]);
                        *(u32x4*)(Q + (size_t)row * NQ + h * DQH + wc * 32 + 8 * fq) = w; } }
        }
    }
};

__device__ __forceinline__ unsigned gather_off(const Unit& u, int idx, unsigned lda_b, unsigned cb) { const int tok = idx < u.nrows ? u.rows[idx] : 0; return (unsigned)tok * lda_b + cb; }
__device__ __forceinline__ u32x4 gather_offs(const Unit& u, int tid, unsigned lda_b) {
    const int t2 = launder_v(tid); int R0, C0, R1, C1; stage_rc(t2 * 16, R0, C0); stage_rc(t2 * 16 + 8192, R1, C1);
    u32x4 pk; pk.x = gather_off(u, R0, lda_b, (unsigned)C0 * 2u); pk.y = gather_off(u, R1, lda_b, (unsigned)C1 * 2u); pk.z = gather_off(u, HALF + R0, lda_b, (unsigned)C0 * 2u); pk.w = gather_off(u, HALF + R1, lda_b, (unsigned)C1 * 2u);
    return pk;
}
typedef int i32x4 __attribute__((ext_vector_type(4)));
typedef int i32x8 __attribute__((ext_vector_type(8)));
template <class Epi, class Sched, bool GATHER, bool FP8 = false>
__device__ __forceinline__ void gemm_phase(LAS unsigned char* lds, const unsigned lda_b, const unsigned ldb_b, const int Kb, const Sched& S, const Epi& E, const unsigned stag_ticks = 0u) {
    if (stag_ticks) { const unsigned long long t0 = __builtin_amdgcn_s_memrealtime(), dl = (unsigned long long)((blockIdx.x >> 3) & 3u) * stag_ticks;
        while (__builtin_amdgcn_s_memrealtime() - t0 < dl) __builtin_amdgcn_s_sleep(8); }
    const int tid = launder_v((int)threadIdx.x), wid = __builtin_amdgcn_readfirstlane(tid >> 6), lane = tid & 63, wr = wid >> 2, wc = wid & 3, fr = lane & 15, fq = lane >> 4;
    int nt = Kb / (BK * 2); asm volatile("" : "+s"(nt));
    unsigned voffA[2], voffB[2];
#pragma unroll
    for (int i = 0; i < 2; ++i) { int R, C; stage_rc(tid * 16 + i * 8192, R, C); const int Rb = Epi::PERM ? ((R & ~31) + perm32(R & 31)) : R;
        voffA[i] = (unsigned)R * lda_b + (unsigned)C * 2u; voffB[i] = (unsigned)Rb * ldb_b + (unsigned)C * 2u; }
    const size_t kstep = (size_t)(BK * 2);
    const size_t hstepA = (size_t)HALF * lda_b, hstepB = (size_t)HALF * ldb_b;
    const unsigned ldsw = (unsigned)wid * 1024u, ldsbase = (unsigned)__builtin_amdgcn_readfirstlane((int)(unsigned)(size_t)lds);
    const int aoff = lds_byte(wr * 64 + fr, fq * 8), boff = lds_byte(wc * 32 + fr, fq * 8);
    unsigned cv0[2] = {0u, 0u}, cv1[2] = {0u, 0u}, nv0[2] = {0u, 0u}, nv1[2] = {0u, 0u};
#define PG8_SA(b, h) (((b) * 2 + (h)) * HTB)
#define PG8_SB(b, h) ((4 + (b) * 2 + (h)) * HTB)
#define PG8_LOAD16(sbase, voff, ldsoff) do { unsigned _keep; asm volatile("s_mov_b32 %0, m0\n\ts_mov_b32 m0, %3\n\ts_nop 0\n\tglobal_load_lds_dwordx4 %1, %2\n\ts_mov_b32 m0, %0" \
        : "=&s"(_keep) : "v"(voff), "s"(sbase), "s"(ldsbase + (unsigned)(ldsoff)) : "memory"); } while (0)
#define PG8_STAGE_B(bufoff, gbase, h) do { _Pragma("unroll") for (int _i = 0; _i < 2; ++_i) PG8_LOAD16((gbase) + (h) * hstepB, voffB[_i], (bufoff) + ldsw + _i * 8192); } while (0)
#define PG8_STAGE_A(bufoff, gbase, h, usenext) do { _Pragma("unroll") for (int _i = 0; _i < 2; ++_i) { unsigned _vo; \
        if constexpr (GATHER) { _vo = (usenext) ? ((h) ? nv1[_i] : nv0[_i]) : ((h) ? cv1[_i] : cv0[_i]); PG8_LOAD16((gbase), _vo, (bufoff) + ldsw + _i * 8192); } \
        else { PG8_LOAD16((gbase) + (h) * hstepA, voffA[_i], (bufoff) + ldsw + _i * 8192); } } } while (0)
#define PG8_LD32(off) __builtin_shufflevector(*(const LAS i32x4*)(lds + (off)), *(const LAS i32x4*)(lds + (off) + 1024), 0, 1, 2, 3, 4, 5, 6, 7)
#define PG8_LDA(dst, b, h) do { _Pragma("unroll") for (int m = 0; m < 4; ++m) { if constexpr (FP8) { dst##8[m] = PG8_LD32(PG8_SA(b, h) + aoff + m * 2048); } else { _Pragma("unroll") for (int k = 0; k < 2; ++k) dst[m][k] = *(const LAS bf16x8*)(lds + PG8_SA(b, h) + aoff + m * 2048 + k * 1024); } } } while (0)
#define PG8_LDB(dst, b, h) do { _Pragma("unroll") for (int n = 0; n < 2; ++n) { if constexpr (FP8) { dst##8[n] = PG8_LD32(PG8_SB(b, h) + boff + n * 2048); } else { _Pragma("unroll") for (int k = 0; k < 2; ++k) dst[n][k] = *(const LAS bf16x8*)(lds + PG8_SB(b, h) + boff + n * 2048 + k * 1024); } } } while (0)
#define PG8_MMA(ai, bj, At, Bt) do { __builtin_amdgcn_s_setprio(1); _Pragma("unroll") for (int m = 0; m < 4; ++m) _Pragma("unroll") for (int n = 0; n < 2; ++n) { \
        if constexpr (FP8) { asm volatile("v_mfma_f32_16x16x128_f8f6f4 %0, %1, %2, %0" : "+v"(acc[ai][bj][m][n]) : "v"(Bt##8[n]), "v"(At##8[m])); }     \
        else { _Pragma("unroll") for (int k = 0; k < 2; ++k) acc[ai][bj][m][n] = __builtin_amdgcn_mfma_f32_16x16x32_bf16(Bt[n][k], At[m][k], acc[ai][bj][m][n], 0, 0, 0); } } \
        __builtin_amdgcn_s_setprio(0); } while (0)
#define PG8_WAIT_V(n) asm volatile("s_waitcnt vmcnt(" #n ")" ::: "memory")
#define PG8_WAIT_L(n) asm volatile("s_waitcnt lgkmcnt(" #n ")" ::: "memory")
#define PG8_BAR __builtin_amdgcn_s_barrier()
#define PG8_SCHED __builtin_amdgcn_sched_barrier(0)
    Unit cur, nxt; int ui = 0;
    (void)S.next(0, cur);
    f32x4 acc[2][2][4][2];
#pragma unroll
    for (int a = 0; a < 2; ++a)
#pragma unroll
        for (int b = 0; b < 2; ++b)
#pragma unroll
            for (int m = 0; m < 4; ++m)
#pragma unroll
                for (int n = 0; n < 2; ++n) acc[a][b][m][n] = (f32x4){0.f, 0.f, 0.f, 0.f};
    bf16x8 At[4][2], B0[2][2], B1[2][2]; i32x8 At8[4], B08[2], B18[2];
    const char* cA = cur.a; const char* cB = cur.b;
    if constexpr (GATHER) { const u32x4 pk = gather_offs(cur, tid, lda_b); cv0[0] = pk.x; cv0[1] = pk.y; cv1[0] = pk.z; cv1[1] = pk.w; }
    PG8_STAGE_B(PG8_SB(0, 0), cB, 0); PG8_SCHED; PG8_STAGE_B(PG8_SB(0, 1), cB, 1); PG8_SCHED; PG8_STAGE_A(PG8_SA(0, 0), cA, 0, false); PG8_SCHED; PG8_STAGE_A(PG8_SA(0, 1), cA, 1, false);
    if (wr == 1) PG8_BAR;
    PG8_WAIT_V(2); PG8_BAR;
    PG8_STAGE_B(PG8_SB(1, 0), cB + kstep, 0); PG8_SCHED; PG8_STAGE_A(PG8_SA(1, 0), cA + kstep, 0, false); PG8_SCHED; PG8_STAGE_B(PG8_SB(1, 1), cB + kstep, 1);
    PG8_WAIT_V(6); PG8_BAR;
    for (;;) {
        int has_next = 0; const char* nA = cA; const char* nB = cB;
        if constexpr (GATHER) { has_next = __builtin_amdgcn_readfirstlane(S.next(ui + 1, nxt) ? 1 : 0); nA = has_next ? nxt.a : cA; nB = has_next ? nxt.b : cB; }
        if constexpr (GATHER) {
            u32x4 pk = (u32x4){cv0[0], cv0[1], cv1[0], cv1[1]}; if (has_next) pk = gather_offs(nxt, tid, lda_b);
            *(LAS u32x4*)(lds + STAGE_BYTES + 1024 + tid * 16) = pk;
        }
#pragma nounroll
        for (int t = 0; t < nt; t += 2) {
            const bool last = (t == nt - 2);
            if constexpr (!GATHER) { if (last) { int uin = ui + 1; asm volatile("" : "+s"(uin)); has_next = __builtin_amdgcn_readfirstlane(S.next(uin, nxt) ? 1 : 0); nA = has_next ? nxt.a : cA; nB = has_next ? nxt.b : cB; } }
            if constexpr (GATHER) { if (last) { const u32x4 pk = *(const LAS u32x4*)(lds + STAGE_BYTES + 1024 + tid * 16); nv0[0] = pk.x; nv0[1] = pk.y; nv1[0] = pk.z; nv1[1] = pk.w; } }
            const char* a1 = cA + (size_t)(t + 1) * kstep;
            const char* a2 = last ? nA : cA + (size_t)(t + 2) * kstep; const char* b2 = last ? nB : cB + (size_t)(t + 2) * kstep;
            const char* a3 = a2 + kstep; const char* b3 = b2 + kstep;
            PG8_LDB(B0, 0, 0); PG8_LDB(B1, 0, 1); PG8_SCHED; PG8_LDA(At, 0, 0); PG8_STAGE_A(PG8_SA(1, 1), a1, 1, false);
            PG8_WAIT_V(8); PG8_WAIT_L(0); PG8_BAR; PG8_MMA(0, 0, At, B0); PG8_MMA(0, 1, At, B1); PG8_BAR; PG8_SCHED;
            PG8_LDA(At, 0, 1); PG8_STAGE_B(PG8_SB(0, 0), b2, 0); PG8_STAGE_B(PG8_SB(0, 1), b2, 1); PG8_STAGE_A(PG8_SA(0, 0), a2, 0, last);
            PG8_WAIT_V(8); PG8_WAIT_L(0); PG8_BAR; PG8_MMA(1, 0, At, B0); PG8_MMA(1, 1, At, B1); PG8_BAR; PG8_SCHED;
            PG8_LDB(B0, 1, 0); PG8_LDB(B1, 1, 1); PG8_SCHED; PG8_LDA(At, 1, 0); PG8_STAGE_A(PG8_SA(0, 1), a2, 1, last);
            PG8_WAIT_V(8); PG8_WAIT_L(0); PG8_BAR; PG8_MMA(0, 0, At, B0); PG8_MMA(0, 1, At, B1); PG8_BAR; PG8_SCHED;
            PG8_LDA(At, 1, 1); PG8_STAGE_B(PG8_SB(1, 0), b3, 0); PG8_STAGE_B(PG8_SB(1, 1), b3, 1); PG8_STAGE_A(PG8_SA(1, 0), a3, 0, last);
            PG8_WAIT_V(8); PG8_WAIT_L(0); PG8_BAR; PG8_MMA(1, 0, At, B0); PG8_MMA(1, 1, At, B1); PG8_BAR; PG8_SCHED;
        }
        if (wr == 0) PG8_BAR;
        if constexpr (FP8) asm volatile("s_nop 15\n\ts_nop 15" ::: "memory");
        E(acc, cur, wr, wc, fr, fq);
        if (!has_next) break;
#pragma unroll
        for (int a = 0; a < 2; ++a)
#pragma unroll
            for (int b = 0; b < 2; ++b)
#pragma unroll
                for (int m = 0; m < 4; ++m)
#pragma unroll
                    for (int n = 0; n < 2; ++n) acc[a][b][m][n] = (f32x4){0.f, 0.f, 0.f, 0.f};
        cur = nxt; cA = nA; cB = nB; ++ui;
        if constexpr (GATHER) {
#pragma unroll
            for (int i = 0; i < 2; ++i) { cv0[i] = nv0[i]; cv1[i] = nv1[i]; }
        }
        if (wr == 1) PG8_BAR;
    }
    PG8_WAIT_V(0);
    PG8_BAR;
#undef PG8_SA
#undef PG8_SB
#undef PG8_LOAD16
#undef PG8_STAGE_A
#undef PG8_STAGE_B
#undef PG8_LDA
#undef PG8_LDB
#undef PG8_LD32
#undef PG8_MMA
#undef PG8_WAIT_V
#undef PG8_WAIT_L
#undef PG8_BAR
#undef PG8_SCHED
}
}
namespace att {
constexpr int NW = 8, QBLK = 32, KVBLK = 64, QB = NW * QBLK;
constexpr int DQK = 192, DV = 128;
constexpr int QS = NQ, KNS = NKV, KRS = DROPE, OS = DM;
constexpr int SHM_V = KVBLK * DV * 2, SHM_K = KVBLK * DQK * 2;
constexpr int LDS_QR = 2 * SHM_V + 2 * SHM_K + NW * 64 * 4;
constexpr int LDS_BYTES = LDS_QR + NW * 4096;
constexpr float SCALE = 0.07216878364870322f;
constexpr float THR = 8.f;
#define KSWZ(row, ch) ((row) * 384 + ((((ch) ^ (((row) >> 1) & 7))) << 4))
#define SBAR() __builtin_amdgcn_sched_barrier(0)
__device__ __forceinline__ int v_st(int k, int c) { const int kk = (k & ~0xC) | ((k & 4) << 1) | ((k & 8) >> 1); return ((kk >> 3) * 4 + (c >> 5)) * 512 + ((kk & 7) * 32 + (c & 31)) * 2; }
__device__ __forceinline__ int v_rd_base(int lane) { return ((lane & 3) << 3) | (((lane >> 2) & 3) << 6) | (((lane >> 4) & 1) << 5) | (((lane >> 5) & 1) << 8); }
constexpr int v_rd_off(int d0, int ks, int half) { return d0 * 512 + ks * 4096 + half * 2048; }
__device__ __forceinline__ int crow(int r, int hi) { return (r & 3) + 8 * (r >> 2) + 4 * hi; }
__device__ __forceinline__ void mask_tile(f32x16& p0, f32x16& p1, int dq) {
    const float NEG = -__builtin_inff();
#pragma unroll
    for (int r = 0; r < 16; ++r) {
        const int c = (r & 3) + 8 * (r >> 2);
        if (dq - c < 0) p0[r] = NEG;
        if (dq - c - 32 < 0) p1[r] = NEG;
    }
}
__device__ __forceinline__ void partialSM(f32x16& p0, f32x16& p1, float& m_reg, float& mn, float& alpha) {
    float pmax = p0[0]; for (int r = 1; r < 16; ++r) pmax = fmaxf(pmax, p0[r]); for (int r = 0; r < 16; ++r) pmax = fmaxf(pmax, p1[r]);
    { auto rr = __builtin_amdgcn_permlane32_swap(__float_as_uint(pmax), __float_as_uint(pmax), false, false);
      pmax = fmaxf(__uint_as_float(rr[0]), __uint_as_float(rr[1])); }
    constexpr float C2 = 1.4426950408889634f * SCALE;
    if (__builtin_expect(__all((pmax - m_reg) * SCALE <= THR), 1)) { mn = m_reg; alpha = 1.f; }
    else { mn = fmaxf(m_reg, pmax); alpha = __builtin_amdgcn_exp2f((m_reg - mn) * C2); m_reg = mn; }
    const float mnL = -mn * C2;
    for (int r = 0; r < 16; ++r) p0[r] = fmaf(p0[r], C2, mnL); for (int r = 0; r < 16; ++r) p1[r] = fmaf(p1[r], C2, mnL);
    for (int r = 0; r < 16; ++r) p0[r] = __builtin_amdgcn_exp2f(p0[r]);
}
__device__ __forceinline__ void finishSM(f32x16& p0, f32x16& p1, float alpha, float& l_reg, bf16x8& pa0, bf16x8& pa1, bf16x8& pa2, bf16x8& pa3) {
    for (int r = 0; r < 16; ++r) p1[r] = __builtin_amdgcn_exp2f(p1[r]);
    float ps = 0; for (int r = 0; r < 16; ++r) ps += p0[r]; for (int r = 0; r < 16; ++r) ps += p1[r];
    { auto rr = __builtin_amdgcn_permlane32_swap(__float_as_uint(ps), __float_as_uint(ps), false, false);
      ps = __uint_as_float(rr[0]) + __uint_as_float(rr[1]); }
    l_reg = l_reg * alpha + ps;
#define PK4(P, B_, OUT) do { unsigned a0 = cvt_pk_bf16(P[B_+0], P[B_+1]), a1 = cvt_pk_bf16(P[B_+2], P[B_+3]);                          \
        unsigned b0 = cvt_pk_bf16(P[B_+4], P[B_+5]), b1 = cvt_pk_bf16(P[B_+6], P[B_+7]);                                             \
        auto r0 = __builtin_amdgcn_permlane32_swap(a0, b0, false, false); auto r1 = __builtin_amdgcn_permlane32_swap(a1, b1, false, false); \
        u32x4 w = {r0[0], r1[0], r0[1], r1[1]}; OUT = *reinterpret_cast<bf16x8*>(&w); } while (0)
    PK4(p0, 0, pa0); PK4(p0, 8, pa1); PK4(p1, 0, pa2); PK4(p1, 8, pa3);
#undef PK4
}
template <int KB>
__device__ __forceinline__ void qkt(f32x16& p0, f32x16& p1, const char* K_lds, int r32, int hi, const bf16x8* qr, const char* qrl) {
    p0 = f32x16{}; p1 = f32x16{};
    const char* kb[4];
#pragma unroll
    for (int dd = 0; dd < 4; ++dd) kb[dd] = K_lds + KB * SHM_K + KSWZ(r32, dd * 2 + hi);
#pragma unroll
    for (int d0 = 0; d0 < 12; ++d0) { const char* a = kb[d0 & 3] + (d0 >> 2) * 128;
        bf16x8 b0 = *reinterpret_cast<const bf16x8*>(a);
        bf16x8 b1 = *reinterpret_cast<const bf16x8*>(a + 32 * 384);
        const bf16x8 qf = d0 < 8 ? qr[d0 & 7] : *reinterpret_cast<const bf16x8*>(qrl + (d0 - 8) * 1024);
        p0 = __builtin_amdgcn_mfma_f32_32x32x16_bf16(b0, qf, p0, 0, 0, 0);
        p1 = __builtin_amdgcn_mfma_f32_32x32x16_bf16(b1, qf, p1, 0, 0, 0);
        if ((d0 & 3) == 3 && d0 < 11) SBAR(); }
}
template <int VB>
__device__ __forceinline__ void pv_tile(f32x16* o, int vb0, bf16x8 pa0, bf16x8 pa1, bf16x8 pa2, bf16x8 pa3) {
#define TRRD(dst, off) asm volatile("ds_read_b64_tr_b16 %0, %1 offset:%2" : "=&v"(dst) : "v"(vb0), "i"(off) : "memory")
#define PV_D0(d0) do { s16x4 l0, l1, l2, l3, h0, h1, h2, h3; constexpr int b_ = VB * SHM_V + v_rd_off(d0, 0, 0); \
        TRRD(l0, b_); TRRD(h0, b_ + 2048); TRRD(l1, b_ + 4096); TRRD(h1, b_ + 6144); TRRD(l2, b_ + 8192); TRRD(h2, b_ + 10240); TRRD(l3, b_ + 12288); TRRD(h3, b_ + 14336); \
        asm volatile("s_waitcnt lgkmcnt(0)" ::: "memory"); SBAR();   \
        o[d0] = __builtin_amdgcn_mfma_f32_32x32x16_bf16(pa0, (bf16x8){l0[0], l0[1], l0[2], l0[3], h0[0], h0[1], h0[2], h0[3]}, o[d0], 0, 0, 0);   \
        o[d0] = __builtin_amdgcn_mfma_f32_32x32x16_bf16(pa1, (bf16x8){l1[0], l1[1], l1[2], l1[3], h1[0], h1[1], h1[2], h1[3]}, o[d0], 0, 0, 0);   \
        o[d0] = __builtin_amdgcn_mfma_f32_32x32x16_bf16(pa2, (bf16x8){l2[0], l2[1], l2[2], l2[3], h2[0], h2[1], h2[2], h2[3]}, o[d0], 0, 0, 0);   \
        o[d0] = __builtin_amdgcn_mfma_f32_32x32x16_bf16(pa3, (bf16x8){l3[0], l3[1], l3[2], l3[3], h3[0], h3[1], h3[2], h3[3]}, o[d0], 0, 0, 0); } while (0)
    PV_D0(0); PV_D0(1); PV_D0(2); PV_D0(3);
#undef PV_D0
#undef TRRD
}
struct BlockRef { const bf16_t* Q; const bf16_t* Kn; const bf16_t* Kr; const bf16_t* V; bf16_t* O; int P0; };
struct Seam { bf16x8 qr[8]; bf16x8 st_v0, st_v1, st_k0, st_k1, st_k2; };
#define VMW() asm volatile("s_waitcnt vmcnt(0)" ::: "memory")
#define VMWN(n) asm volatile("s_waitcnt vmcnt(%0)" :: "i"(n) : "memory")
#define LD8(p) (*reinterpret_cast<const bf16x8*>(p))
#define SLOAD_H(R_, k0) do { S.st_v0 = LD8((R_).V + (size_t)((k0) + sr) * KNS + sc); S.st_v1 = LD8((R_).V + (size_t)((k0) + 32 + sr) * KNS + sc);              \
                             S.st_k0 = LD8((R_).Kn + (size_t)((k0) + sr) * KNS + sc); S.st_k1 = LD8((R_).Kn + (size_t)((k0) + 32 + sr) * KNS + sc);            \
                             S.st_k2 = LD8((R_).Kr + (size_t)((k0) + rr) * KRS + rc); } while (0)
#define SWRITE_HK(bf) do { *(bf16x8*)(K_lds + (bf) * SHM_K + kws) = S.st_k0; *(bf16x8*)(K_lds + (bf) * SHM_K + kws + 32 * 384) = S.st_k1; *(bf16x8*)(K_lds + (bf) * SHM_K + kws2) = S.st_k2; } while (0)
#define SWRITE_HV(bf) do { *(bf16x8*)(V_lds + (bf) * SHM_V + vst0) = S.st_v0; *(bf16x8*)(V_lds + (bf) * SHM_V + vst1) = S.st_v1; } while (0)
#define SWRITE_H(bf) do { SWRITE_HV(bf); SWRITE_HK(bf); } while (0)
#define ATT_IDX const int tid = launder_v((int)threadIdx.x), wid = __builtin_amdgcn_readfirstlane(tid >> 6), lane = tid & 63, r32 = lane & 31, hi = lane >> 5; \
    const int sr = tid >> 4, sc = (tid & 15) * 8, rr = tid >> 3, rc = (tid & 7) * 8, kws = KSWZ(sr, (tid & 15)), kws2 = KSWZ(rr, 16 + (tid & 7));
__device__ __forceinline__ void attn_block(const BlockRef& cur, char* lds) {
    ATT_IDX;
    Seam S;
    const int NT = cur.P0 / KVBLK + QB / KVBLK;
    const int qlo = cur.P0 + wid * QBLK, qm = qlo + r32 - 4 * hi;
    char* V_lds = lds; char* K_lds = lds + 2 * SHM_V;
    float* ws = (float*)(lds + 2 * SHM_V + 2 * SHM_K) + wid * 64; float* li_l = ws, * al_l = ws + 32;
    float m_reg = -1e30f, l_reg = 0; f32x16 o[4] = {};
    const int vst0 = v_st(sr, sc), vst1 = v_st(32 + sr, sc);
    const int vb0 = (int)(uintptr_t)V_lds + v_rd_base(lane);
    char* qrl = lds + LDS_QR + wid * 4096 + lane * 16;
#define RESC(a) do { if (__any((a) < 1.f)) { if (hi == 0) al_l[r32] = (a); asm volatile("s_waitcnt lgkmcnt(0)" ::: "memory");              \
                     for (int d_ = 0; d_ < 4; ++d_) for (int r = 0; r < 16; ++r) o[d_][r] *= al_l[crow(r, hi)]; } } while (0)
#define KBASE(t) ((t) * KVBLK)
#define MASKT(P0_, P1_, t) do { const int kb_ = KBASE(t); if (kb_ + KVBLK - 1 > qlo) mask_tile(P0_, P1_, qm - kb_); } while (0)
    SLOAD_H(cur, 0);
#pragma unroll
    for (int d0 = 0; d0 < 8; ++d0) S.qr[d0] = LD8(cur.Q + (size_t)(wid * QBLK + r32) * QS + d0 * 16 + hi * 8);
    { bf16x8 t0 = LD8(cur.Q + (size_t)(wid * QBLK + r32) * QS + 128 + hi * 8), t1 = LD8(cur.Q + (size_t)(wid * QBLK + r32) * QS + 144 + hi * 8),
             t2 = LD8(cur.Q + (size_t)(wid * QBLK + r32) * QS + 160 + hi * 8), t3 = LD8(cur.Q + (size_t)(wid * QBLK + r32) * QS + 176 + hi * 8);
      *(bf16x8*)(qrl) = t0; *(bf16x8*)(qrl + 1024) = t1; *(bf16x8*)(qrl + 2048) = t2; *(bf16x8*)(qrl + 3072) = t3; }
    VMW(); SWRITE_H(0);
    __syncthreads();
    f32x16 p0, p1; float mn, al; bf16x8 pa0, pa1, pa2, pa3;
#define TILE_STEP(t, BF) do {                                                                                                 \
        if ((t) + 1 < NT) { SLOAD_H(cur, KBASE((t) + 1)); }                                                                    \
        SBAR();                                                                                                               \
        if (KBASE(t) <= qlo + QBLK - 1) {     \
        qkt<BF>(p0, p1, K_lds, r32, hi, S.qr, qrl);                                                                           \
        MASKT(p0, p1, (t)); partialSM(p0, p1, m_reg, mn, al); RESC(al);                                                        \
        finishSM(p0, p1, al, l_reg, pa0, pa1, pa2, pa3); SBAR();                                                              \
        pv_tile<BF>(o, vb0, pa0, pa1, pa2, pa3); }                                                                            \
        if ((t) + 1 < NT) { VMW(); SWRITE_H(1 - BF); }                                                                         \
        __syncthreads(); } while (0)
    for (int t = 0; t < NT; t += 2) { TILE_STEP(t, 0); TILE_STEP(t + 1, 1); }
    if (hi == 0) li_l[r32] = l_reg; asm volatile("s_waitcnt lgkmcnt(0)" ::: "memory");
    float rli[16];
#pragma unroll
    for (int r = 0; r < 16; ++r) rli[r] = __builtin_amdgcn_rcpf(li_l[crow(r, hi)]);
    bf16_t* Ow = cur.O + (size_t)(wid * QBLK) * OS;
#pragma unroll
    for (int r = 0; r < 16; ++r) { const int orow = crow(r, hi);
#pragma unroll
        for (int d0 = 0; d0 < 4; ++d0) { const float v = o[d0][r] * rli[r];
            const float vn = __shfl_xor(v, 1);
            if ((r32 & 1) == 0) *(unsigned*)(Ow + (size_t)orow * OS + d0 * 32 + r32) = cvt_pk_bf16(v, vn); } }
    __syncthreads();
#undef RESC
#undef KBASE
#undef MASKT
#undef TILE_STEP
}
#undef VMW
#undef VMWN
#undef LD8
#undef SLOAD_H
#undef SWRITE_HK
#undef SWRITE_HV
#undef SWRITE_H
#undef ATT_IDX
#undef KSWZ
#undef SBAR

__device__ __forceinline__ BlockRef make_ref(int L, int pass, const bf16_t* Qb, const bf16_t* KNVb, const bf16_t* KRb, bf16_t* Ob) {
    const int bh = L >> 2, x = L & 3, qb = pass ? 7 - x : x, b = bh >> 3, h = bh & 7; const size_t rb = (size_t)b * SEQ;
    BlockRef r; r.Q = Qb + (rb + (size_t)qb * QB) * QS + h * DQH; r.Kn = KNVb + rb * KNS + h * (DNOPE + DVH); r.Kr = KRb + rb * KRS; r.V = KNVb + rb * KNS + h * (DNOPE + DVH) + DNOPE;
    r.O = Ob + (rb + (size_t)qb * QB) * OS + h * DVH; r.P0 = qb * QB; return r;
}
__device__ __forceinline__ void attn_phase(char* lds, const bf16_t* Qb, const bf16_t* KNVb, const bf16_t* KRb, bf16_t* Ob, int first, int stride) {
    constexpr int total = NBATCH * NHEAD * 4;
    for (int L = first; L < total; L += stride) {
        for (int pass = 0; pass < 2; ++pass) { const BlockRef cur = make_ref(L, pass, Qb, KNVb, KRb, Ob); attn_block(cur, lds); }
    }
}
}
constexpr int NWAVES = 8;
constexpr size_t MiB = 1u << 20;
constexpr size_t WS_CTL = 0, CTL_ZERO_BYTES = 8 * MiB;
constexpr size_t WS_SSQ = 1 * MiB;
constexpr size_t WS_COS = 8 * MiB, WS_SIN = 16 * MiB;
constexpr size_t WS_LIST = 24 * MiB;
constexpr size_t WS_RSL = 26 * MiB;
constexpr size_t WS_TOKINFO = 28 * MiB;
constexpr size_t WS_WDN = 30 * MiB, WS_WUQ = 34 * MiB, WS_WUKV = 37 * MiB, WS_WO = 39 * MiB, WS_WPOOL = 43 * MiB, WS_WGU = 44 * MiB, WS_WD = 65 * MiB, WS_MWGU = 76 * MiB, WS_MWD = 164 * MiB;
constexpr size_t WS_H = 208 * MiB;
constexpr size_t WS_ACT = 336 * MiB;
constexpr size_t WS_DOWN = WS_ACT;
constexpr size_t WS_CQN = WS_ACT + 128 * MiB, WS_CKVN = WS_ACT + 192 * MiB, WS_KR = WS_ACT + 224 * MiB, WS_Q = WS_ACT + 232 * MiB, WS_KNV = WS_ACT + 424 * MiB;
constexpr size_t WS_HID = WS_ACT;
constexpr size_t WS_YB = WS_ACT + 358 * MiB;
constexpr size_t WS_DUMMY = WS_ACT + 424 * MiB;
constexpr size_t WS_H8 = WS_ACT + 618 * MiB;
constexpr int FFD8 = 2816;
constexpr int FFE8 = 1536;
constexpr size_t WS_END = WS_ACT + 682 * MiB;
static_assert(WS_MWD + (size_t)16 * 1024 * FFEP * 2 <= WS_H && WS_MWGU + (size_t)16 * 2 * FFEP * 1024 * 2 <= WS_MWD && WS_WD + (size_t)2 * 1024 * FFD * 2 <= WS_MWGU && WS_WGU + (size_t)2 * 2 * FFD * 1024 * 2 <= WS_WD, "weights map");
static_assert(WS_HID + (size_t)PSLOT * FFEP * 2 <= WS_YB && WS_YB + (size_t)PSLOT * 1024 * 2 <= WS_END && WS_HID + (size_t)NTOK * FFD * 2 <= WS_END && WS_KNV + (size_t)NTOK * NKV * 2 <= WS_END && WS_Q + (size_t)NTOK * NQ * 2 <= WS_KNV, "activation map");
static_assert(WS_SSQ + (size_t)14 * NTOK * 8 <= WS_COS && WS_COS <= CTL_ZERO_BYTES + WS_COS && WS_END <= 1024 * MiB, "map");
constexpr int CW_TMO = 0, CW_CODE = 1, CW_CNT = 1024  , CW_DBG = 2048, CW_BAR = 4096  ;
constexpr int LDSCTL_OFF = 0, LDSCTL_BYTES = 1024, MISC_OFF = LDSCTL_OFF + 320, RING_OFF = LDSCTL_BYTES, RING_BYTES = 131072, LDS_BYTES = 147456;

typedef GAS unsigned gu32;
#define RLX_AGENT __ATOMIC_RELAXED, __HIP_MEMORY_SCOPE_AGENT
#define LDS_WAIT() asm volatile("s_waitcnt lgkmcnt(0)" ::: "memory")
#define VM_WAIT() asm volatile("s_waitcnt vmcnt(0)" ::: "memory")

#define XB_TMO      128
#define XB_XCNT(j)  (256  + 64 * (j))
#define XB_XSUB(j)  (1280 + 64 * (j))
#define XB_XGEN(j)  (2304 + 64 * (j))
#define XB_TOP      3328
#define XB_TOPGEN   3392
#define XCD_BAR_WORDS 3456
#define XB_SPIN_CAP (1u << 18)
__device__ __forceinline__ unsigned xb_ld(unsigned* p)              { return __hip_atomic_load(p, __ATOMIC_RELAXED, __HIP_MEMORY_SCOPE_AGENT); }
__device__ __forceinline__ unsigned xb_add(unsigned* p, unsigned v) { return __hip_atomic_fetch_add(p, v, __ATOMIC_RELAXED, __HIP_MEMORY_SCOPE_AGENT); }
__device__ __forceinline__ unsigned xb_xcc_id() { return (unsigned)__builtin_amdgcn_s_getreg((3 << 11) | 20) & 0xFu; }
#define XB_SPIN(cond, bar) do { unsigned _sp = 0; while (cond) { __builtin_amdgcn_s_sleep(1); \
    if ((++_sp & 255u) == 0u) { if (xb_ld(&(bar)[XB_TMO])) break; if (_sp > XB_SPIN_CAP) { atomicAdd(&(bar)[XB_TMO], 1u); break; } } } } while (0)
__device__ __forceinline__ unsigned rfl(unsigned v);
struct XcdBarrier { unsigned* bar; unsigned x; volatile LAS unsigned* st; };
__device__ __forceinline__ XcdBarrier xcd_barrier_post(unsigned* bar, volatile LAS unsigned* st) {
    XcdBarrier b; b.bar = bar; b.x = xb_xcc_id(); b.st = st;
    if (threadIdx.x == 0) (void)xb_add(&bar[XB_XCNT(b.x)], 1u);
    return b;
}
__device__ __forceinline__ void xcd_barrier_complete(unsigned* bar, unsigned x, unsigned& nloc, unsigned& nx) {
    const unsigned G = gridDim.x * gridDim.y * gridDim.z;
    unsigned sum, cnt, mine, sp = 0u;
    for (;;) {
        sum = 0u; cnt = 0u; mine = 0u;
#pragma unroll
        for (unsigned j = 0; j < 16; ++j) { const unsigned c = xb_ld(&bar[XB_XCNT(j)]); sum += c; cnt += (c > 0u) ? 1u : 0u; mine = (j == x) ? c : mine; }
        if (sum == G) break;
        __builtin_amdgcn_s_sleep(1);
        if ((++sp & 255u) == 0u) { if (xb_ld(&bar[XB_TMO])) break; if (sp > XB_SPIN_CAP) { atomicAdd(&bar[XB_TMO], 1u); break; } }
    }
    nloc = mine > 0u ? mine : 1u; nx = cnt > 0u ? cnt : 1u;
}
__device__ __forceinline__ void xcd_barrier(const XcdBarrier& b) {
    unsigned* bar; { const volatile LAS unsigned* p_ = b.st + 2; const unsigned lo_ = rfl(p_[0]), hi_ = rfl(p_[1]); bar = (unsigned*)(((unsigned long long)hi_ << 32) | lo_); }
    asm volatile("s_waitcnt vmcnt(0)" ::: "memory");
    __syncthreads();
    if (threadIdx.x == 0) {
        __builtin_amdgcn_s_waitcnt(0);
        unsigned nloc = b.st[0], nx = b.st[1];
        if (nloc == 0u) { xcd_barrier_complete(bar, b.x, nloc, nx); b.st[0] = nloc; b.st[1] = nx; }
        const unsigned old = xb_add(&bar[XB_XSUB(b.x)], 1u);
        const unsigned gen = old / nloc;
        if (old + 1u == (gen + 1u) * nloc) {
            __builtin_amdgcn_fence(__ATOMIC_RELEASE, "agent");
            asm volatile("s_waitcnt vmcnt(0)" ::: "memory");
            const unsigned og = xb_add(&bar[XB_TOP], 1u);
            const unsigned tg = og / nx;
            if (og + 1u == (tg + 1u) * nx) xb_add(&bar[XB_TOPGEN], 1u);
            else XB_SPIN(xb_ld(&bar[XB_TOPGEN]) == tg, bar);
            __builtin_amdgcn_fence(__ATOMIC_ACQUIRE, "agent");
            xb_add(&bar[XB_XGEN(b.x)], 1u);
            asm volatile("s_waitcnt vmcnt(0)" ::: "memory");
        } else {
            XB_SPIN(xb_ld(&bar[XB_XGEN(b.x)]) == gen, bar);
            __builtin_amdgcn_fence(__ATOMIC_ACQUIRE, "agent");
            asm volatile("s_waitcnt vmcnt(0)" ::: "memory");
        }
    }
    __syncthreads();
}

__device__ __forceinline__ unsigned rfl(unsigned v);
__device__ __forceinline__ const float* ptab(LAS unsigned char* L, int i);
struct Frame { LAS unsigned char* lds; volatile LAS unsigned* MISC; gu32* ctl; unsigned char* ws; int tid, lane, wave, vcu, G, bx; };

__device__ __forceinline__ float wave_sum(float v) {
#pragma unroll
    for (int o = 1; o < 64; o <<= 1) v += __shfl_xor(v, o);
    return v;
}
__device__ __forceinline__ unsigned rfl(unsigned v) { return (unsigned)__builtin_amdgcn_readfirstlane((int)v); }

__device__ __forceinline__ int rowmap(int mode, int n) {
    if (mode == 0) return n;
    if (mode == 1) return (n >> 7) * 256 + (n & 127);
    if (mode == 2) return (n >> 7) * 256 + 128 + (n & 127);
    if (mode == 4) return n < 800 ? n : 896 + (n - 800);
    const int h = n / DQH, d = n - h * DQH;
    if (d < DNOPE) return 512 + h * DNOPE + d;
    if (d < DNOPE + 32) return (h >> 2) * 256 + (h & 3) * 32 + (d - DNOPE);
    return (h >> 2) * 256 + 128 + (h & 3) * 32 + (d - DNOPE - 32);
}
__device__ __forceinline__ void transpose_item(const float* W, int N, bf16_t* WT, int ldd, int mode, const float* kscale, const float* nscale, int item, int lane) {
    const int nblk = N / 64, kb = item / nblk, nb = item % nblk, k0 = 64 * kb, n = 64 * nb + lane;
    const float sn = nscale ? nscale[n] : 1.0f;
    const int ksv = __float_as_int(kscale ? kscale[k0 + lane] : 1.0f);
    const float* wp = W + (size_t)k0 * N + n;
    bf16_t* op = WT + (size_t)rowmap(mode, n) * ldd + k0;
#pragma unroll
    for (int kg = 0; kg < 8; ++kg) { float v[8];
#pragma unroll
        for (int i = 0; i < 8; ++i) { const float sk = __int_as_float(__builtin_amdgcn_readlane(ksv, 8 * kg + i)); v[i] = wp[(size_t)(8 * kg + i) * N] * (sk * sn); }
        u32x4 o; o.x = cvt_pk_bf16(v[0], v[1]); o.y = cvt_pk_bf16(v[2], v[3]); o.z = cvt_pk_bf16(v[4], v[5]); o.w = cvt_pk_bf16(v[6], v[7]);
        *(GAS u32x4*)(op + 8 * kg) = o; }
}
__device__ __forceinline__ void transpose_item_f8(const float* W, int N, unsigned char* WT, int ldd, int mode, const float* kscale, int item, int lane) {
    const int nblk = N / 64, kb = item / nblk, nb = item % nblk, k0 = 64 * kb, n = 64 * nb + lane;
    const int ksv = __float_as_int(kscale ? kscale[k0 + lane] : 1.0f);
    const float* wp = W + (size_t)k0 * N + n;
    unsigned char* op = WT + (size_t)rowmap(mode, n) * ldd + k0;
#pragma unroll
    for (int kg = 0; kg < 4; ++kg) { float v[16];
#pragma unroll
        for (int i = 0; i < 16; ++i) { const float sk = __int_as_float(__builtin_amdgcn_readlane(ksv, 16 * kg + i)); v[i] = wp[(size_t)(16 * kg + i) * N] * (sk * pg8::FP8_SW); }
        u32x4 o; o.x = pg8::pk4_fp8(v[0], v[1], v[2], v[3]); o.y = pg8::pk4_fp8(v[4], v[5], v[6], v[7]); o.z = pg8::pk4_fp8(v[8], v[9], v[10], v[11]); o.w = pg8::pk4_fp8(v[12], v[13], v[14], v[15]);
        *(GAS u32x4*)(op + 16 * kg) = o; }
}
struct MatDesc { const float* src; bf16_t* dst; const float* kscale; const float* nscale; int K, N, ldd, mode, f8; };
constexpr int N_MATS = 70;
__device__ __forceinline__ MatDesc mat_desc(int m, LAS unsigned char* L, unsigned char* ws) {
    MatDesc d; d.kscale = nullptr; d.nscale = nullptr; d.mode = 0; d.f8 = 0;
    if (m < 2)       { const int a = m;      d.src = ptab(L, 4) + (size_t)a * DM * NDOWN;    d.K = DM;   d.N = NDOWN; d.dst = (bf16_t*)(ws + WS_WDN) + (size_t)a * NDOWNP * DM;  d.ldd = DM; d.mode = 4; d.kscale = ptab(L, 2) + (size_t)(2 * a) * DM; }
    else if (m < 4)  { const int a = m - 2;  d.src = ptab(L, 6) + (size_t)a * QLR * NQ;      d.K = QLR;  d.N = NQ;    d.dst = (bf16_t*)(ws + WS_WUQ) + (size_t)a * NQ * QLR;     d.ldd = QLR; d.mode = 3; d.kscale = ptab(L, 5) + (size_t)a * QLR; }
    else if (m < 6)  { const int a = m - 4;  d.src = ptab(L, 8) + (size_t)a * KVLR * NKV;    d.K = KVLR; d.N = NKV;   d.dst = (bf16_t*)(ws + WS_WUKV) + (size_t)a * NKV * KVLR;  d.ldd = KVLR; d.kscale = ptab(L, 7) + (size_t)a * KVLR; }
    else if (m < 8)  { const int a = m - 6;  d.src = ptab(L, 9) + (size_t)a * DM * DM;       d.K = DM;   d.N = DM;    d.dst = (bf16_t*)(ws + WS_WO) + (size_t)a * DM * DM;       d.ldd = DM; }
    else if (m < 16) { const int i = m - 8;  d.src = ptab(L, 10) + (size_t)i * 256 * 256;    d.K = 256;  d.N = 256;   d.dst = (bf16_t*)(ws + WS_WPOOL) + (size_t)i * 256 * 256;  d.ldd = 256; d.nscale = ptab(L, 11) + i * 256; }
    else if (m < 18) { const int a = m - 16; d.src = ptab(L, 12) + (size_t)a * DM * FFD;     d.K = DM;   d.N = FFD;   d.dst = (bf16_t*)(ws + WS_WGU) + (size_t)a * 2 * FFD * DM; d.ldd = DM; d.mode = 1; d.kscale = ptab(L, 3) + (size_t)(2 * a) * DM; }
    else if (m < 20) { const int a = m - 18; d.src = ptab(L, 13) + (size_t)a * DM * FFD;     d.K = DM;   d.N = FFD;   d.dst = (bf16_t*)(ws + WS_WGU) + (size_t)a * 2 * FFD * DM; d.ldd = DM; d.mode = 2; d.kscale = ptab(L, 3) + (size_t)(2 * a) * DM; }
    else if (m < 22) { const int a = m - 20; d.src = ptab(L, 14) + (size_t)a * FFD * DM;     d.K = FFD;  d.N = DM;    d.dst = (bf16_t*)(ws + WS_WD) + (size_t)a * DM * FFD;      d.ldd = FFD; }
    else if (m < 38) { const int i = m - 22; d.src = ptab(L, 16) + (size_t)i * DM * FFE;     d.K = DM;   d.N = FFE;   d.dst = (bf16_t*)(ws + WS_MWGU) + (size_t)i * 2 * FFEP * DM; d.ldd = DM; d.mode = 1; d.kscale = ptab(L, 3) + (size_t)(2 * (i >> 3) + 1) * DM; }
    else if (m < 54) { const int i = m - 38; d.src = ptab(L, 17) + (size_t)i * DM * FFE;     d.K = DM;   d.N = FFE;   d.dst = (bf16_t*)(ws + WS_MWGU) + (size_t)i * 2 * FFEP * DM; d.ldd = DM; d.mode = 2; d.kscale = ptab(L, 3) + (size_t)(2 * (i >> 3) + 1) * DM; }
    else             { const int i = m - 54; d.src = ptab(L, 18) + (size_t)i * FFE * DM;     d.K = FFE;  d.N = DM;    d.dst = (bf16_t*)(ws + WS_MWD) + (size_t)i * DM * FFEP;    d.ldd = FFEP; }
    if (m == 17 || m == 19) { d.f8 = 1; d.dst = (bf16_t*)(ws + WS_WGU + (size_t)2 * FFD * DM * 2); d.ldd = DM; }
    if (m == 21) { d.f8 = 1; d.dst = (bf16_t*)(ws + WS_WD + (size_t)DM * FFD * 2); d.ldd = FFD8; }
    if (m >= 22) {
        const int e = (m - 22) & 7, lpi = ((m - 22) & 15) >> 3; d.f8 = 1;
        if (m < 54) { d.dst = (bf16_t*)(ws + WS_MWGU + (size_t)lpi * 8 * 2 * FFEP * DM * 2 + (size_t)e * 2 * FFEP * DM); d.ldd = DM; }
        else        { d.dst = (bf16_t*)(ws + WS_MWD + (size_t)lpi * 8 * DM * FFEP * 2 + (size_t)e * DM * FFE8); d.ldd = FFE8; } }
    return d;
}
__device__ __forceinline__ void p0_prologue(Frame& F) {
    const int* positions = (const int*)ptab(F.lds, 1);
    const int gw = F.vcu * NWAVES + F.wave, NGW = F.G * NWAVES;
    int cum = 0;
    for (int m = 0; m < N_MATS; ++m) {
        const MatDesc d = mat_desc(m, F.lds, F.ws);
        const int nitems = (d.K / 64) * (d.N / 64);
        int first = gw - (cum % NGW); if (first < 0) first += NGW;
        if (d.f8) { for (int it = first; it < nitems; it += NGW) transpose_item_f8(d.src, d.N, (unsigned char*)d.dst, d.ldd, d.mode, d.kscale, it, F.lane); }
        else { for (int it = first; it < nitems; it += NGW) transpose_item(d.src, d.N, d.dst, d.ldd, d.mode, d.kscale, d.nscale, it, F.lane); }
        cum += nitems;
    }
    const int gt = gw * 64 + F.lane, NGT = NGW * 64; const u32x4 z4 = (u32x4){0u, 0u, 0u, 0u};
    for (int i = gt; i < 2 * 192 * 128; i += NGT) { const int a = i / (192 * 128), r = (i / 128) % 192, c = i % 128; const int row = r < 96 ? 800 + r : 928 + (r - 96); *(GAS u32x4*)((bf16_t*)(F.ws + WS_WDN) + (size_t)a * NDOWNP * DM + (size_t)row * DM + c * 8) = z4; }
    for (int i = gt; i < 1024 * 8; i += NGT) { const int row = i / 8, c = i % 8; *(GAS u32x4*)(F.ws + WS_WD + (size_t)DM * FFD * 2 + (size_t)row * FFD8 + FFD + c * 16) = z4; }
    for (int i = gt; i < 16 * 128 * 64; i += NGT) { const int lpi = i / (8 * 128 * 64), e = (i / (128 * 64)) & 7, r = (i / 64) % 128, c = i % 64; const int row = 2560 + (r < 64 ? 64 + r : 192 + (r - 64));
        *(GAS u32x4*)(F.ws + WS_MWGU + (size_t)lpi * 8 * 2 * FFEP * DM * 2 + (size_t)e * 2 * FFEP * DM + (size_t)row * DM + c * 16) = z4; }
    for (int i = gt; i < 16 * 1024 * 12; i += NGT) { const int lpi = i / (8 * 1024 * 12), row = (i / 12) % (8 * 1024), c = i % 12; *(GAS u32x4*)(F.ws + WS_MWD + (size_t)lpi * 8 * DM * FFEP * 2 + (size_t)row * FFE8 + FFE + c * 16) = z4; }
    float* cosT = (float*)(F.ws + WS_COS); float* sinT = (float*)(F.ws + WS_SIN);
    { const float inv = powf(10000.0f, -(float)(2 * (gt & 31)) / 64.0f);
      for (int i = gt; i < NTOK * 32; i += NGT) { const float ang = (float)positions[i >> 5] * inv; float sn, cs; sincosf(ang, &sn, &cs); cosT[i] = cs; sinT[i] = sn; } }
    const float* x = ptab(F.lds, 0); bf16_t* H = (bf16_t*)(F.ws + WS_H); ssq_t* ssq0 = (ssq_t*)(F.ws + WS_SSQ);
    for (int m0 = gw * 4; m0 < NTOK; m0 += NGW * 4) {
        f32x4 v[4][4];
#pragma unroll
        for (int r = 0; r < 4; ++r) { const GAS f32x4* xr = (const GAS f32x4*)(x + (size_t)(m0 + r) * DM) + F.lane;
#pragma unroll
            for (int j = 0; j < 4; ++j) v[r][j] = xr[64 * j]; }
#pragma unroll
        for (int r = 0; r < 4; ++r) { GAS u32x2* o8 = (GAS u32x2*)(H + (size_t)(m0 + r) * DM) + F.lane; float s = 0.f;
#pragma unroll
            for (int j = 0; j < 4; ++j) { const f32x4 t = v[r][j]; s += (t.x * t.x + t.y * t.y) + (t.z * t.z + t.w * t.w); u32x2 w; w.x = cvt_pk_bf16(t.x, t.y); w.y = cvt_pk_bf16(t.z, t.w); o8[64 * j] = w; }
            s = wave_sum(s); if (F.lane == 0) ssq0[m0 + r] = ssq_fix(s); }
    }
}

template <bool FINAL>
__device__ __forceinline__ void combine_phase(Frame& F, const bf16_t* H, bf16_t* Hout, const bf16_t* YB, const unsigned* tokinfo, const unsigned* cntw, ssq_t* ssq_next, const float* gain, float* outF) {
    const int gw = F.vcu * NWAVES + F.wave, NGW = F.G * NWAVES;
    f32x4 g[4];
    if constexpr (FINAL) {
#pragma unroll
        for (int j = 0; j < 4; ++j) g[j] = *(const f32x4*)(gain + F.lane * 4 + 256 * j);
    }
    unsigned nb[8];
#pragma unroll
    for (int e = 0; e < 8; ++e) nb[e] = (rfl(__hip_atomic_load((unsigned*)cntw + 64 * e, RLX_AGENT)) + 255u) >> 8;
    for (int m0 = gw * 2; m0 < NTOK; m0 += NGW * 2) {
        u32x4 t0[2], t1[2];
#pragma unroll
        for (int r = 0; r < 2; ++r) { t0[r] = *(const u32x4*)(tokinfo + (size_t)(m0 + r) * 8); t1[r] = *(const u32x4*)(tokinfo + (size_t)(m0 + r) * 8 + 4); }
        u32x2 hh[2][4], ya[2][4], yb[2][4]; float g0[2], g1[2];
#pragma unroll
        for (int r = 0; r < 2; ++r) {
            const unsigned e0 = rfl(t0[r].x), r0 = rfl(t0[r].y), e1 = rfl(t1[r].x), r1 = rfl(t1[r].y); g0[r] = __uint_as_float(rfl(t0[r].z)); g1[r] = __uint_as_float(rfl(t1[r].z));
            unsigned b0 = 0u, b1 = 0u;
#pragma unroll
            for (int e = 0; e < 8; ++e) { b0 += ((unsigned)e < e0) ? nb[e] : 0u; b1 += ((unsigned)e < e1) ? nb[e] : 0u; }
            const GAS u32x2* hr = (const GAS u32x2*)(H + (size_t)(m0 + r) * DM) + F.lane;
            const GAS u32x2* y0 = (const GAS u32x2*)(YB + ((size_t)b0 * 256 + r0) * DM) + F.lane; const GAS u32x2* y1 = (const GAS u32x2*)(YB + ((size_t)b1 * 256 + r1) * DM) + F.lane;
#pragma unroll
            for (int j = 0; j < 4; ++j) { hh[r][j] = hr[64 * j]; ya[r][j] = y0[64 * j]; yb[r][j] = y1[64 * j]; }
        }
#pragma unroll
        for (int r = 0; r < 2; ++r) { const int m = m0 + r;
            f32x4 v[4]; float s = 0.f;
#pragma unroll
            for (int j = 0; j < 4; ++j) { const u32x2 h2 = hh[r][j], a = ya[r][j], b = yb[r][j];
                v[j].x = bflo(h2.x) + g0[r] * bflo(a.x) + g1[r] * bflo(b.x); v[j].y = bfhi(h2.x) + g0[r] * bfhi(a.x) + g1[r] * bfhi(b.x); v[j].z = bflo(h2.y) + g0[r] * bflo(a.y) + g1[r] * bflo(b.y); v[j].w = bfhi(h2.y) + g0[r] * bfhi(a.y) + g1[r] * bfhi(b.y);
                s += (v[j].x * v[j].x + v[j].y * v[j].y) + (v[j].z * v[j].z + v[j].w * v[j].w); }
            s = wave_sum(s);
            if constexpr (FINAL) { const float rstd = rstd_f(s); GAS f32x4* ho = (GAS f32x4*)(outF + (size_t)m * DM) + F.lane;
#pragma unroll
                for (int j = 0; j < 4; ++j) ho[64 * j] = v[j] * rstd * g[j];
            } else { GAS u32x2* hw = (GAS u32x2*)(Hout + (size_t)m * DM) + F.lane;
#pragma unroll
                for (int j = 0; j < 4; ++j) { u32x2 w; w.x = cvt_pk_bf16(v[j].x, v[j].y); w.y = cvt_pk_bf16(v[j].z, v[j].w); hw[64 * j] = w; }
                if (F.lane == 0) ssq_next[m] = ssq_fix(s); }
        }
    }
}
__device__ __forceinline__ void mid_phase(Frame& F, const bf16_t* DOWN, const float* qn, const float* kvn, const float* cosT, const float* sinT, bf16_t* CQN, bf16_t* CKVN, bf16_t* KR) {
    const int gw = F.vcu * NWAVES + F.wave, NGW = F.G * NWAVES, lane = F.lane;
    const f32x4 q0 = *(const f32x4*)(qn + lane * 8), q1 = *(const f32x4*)(qn + lane * 8 + 4), k0 = *(const f32x4*)(kvn + lane * 4);
    for (int m = gw; m < NTOK; m += NGW) {
        const bf16_t* dr = DOWN + (size_t)m * NDOWNP;
        const u32x4 cq = *(const GAS u32x4*)(dr + lane * 8); const u32x2 ck = *(const GAS u32x2*)(dr + QLR + lane * 4);
        const float x1 = bf2f(dr[QLR + KVLR + (lane & 31)]), x2 = bf2f(dr[QLR + KVLR + 32 + (lane & 31)]);
        const f32x4 a0 = (f32x4){bflo(cq.x), bfhi(cq.x), bflo(cq.y), bfhi(cq.y)}, a1 = (f32x4){bflo(cq.z), bfhi(cq.z), bflo(cq.w), bfhi(cq.w)}, c0 = (f32x4){bflo(ck.x), bfhi(ck.x), bflo(ck.y), bfhi(ck.y)};
        const float sq = wave_sum((a0.x * a0.x + a0.y * a0.y) + (a0.z * a0.z + a0.w * a0.w) + (a1.x * a1.x + a1.y * a1.y) + (a1.z * a1.z + a1.w * a1.w));
        const float sk = wave_sum((c0.x * c0.x + c0.y * c0.y) + (c0.z * c0.z + c0.w * c0.w));
        const float rq = 1.0f / sqrtf(sq * (1.0f / QLR) + RMS_EPS), rk = 1.0f / sqrtf(sk * (1.0f / KVLR) + RMS_EPS);
        const f32x4 y0 = a0 * rq * q0, y1 = a1 * rq * q1, z0 = c0 * rk * k0;
        u32x4 w; w.x = cvt_pk_bf16(y0.x, y0.y); w.y = cvt_pk_bf16(y0.z, y0.w); w.z = cvt_pk_bf16(y1.x, y1.y); w.w = cvt_pk_bf16(y1.z, y1.w);
        *(GAS u32x4*)(CQN + (size_t)m * QLR + lane * 8) = w;
        u32x2 w2; w2.x = cvt_pk_bf16(z0.x, z0.y); w2.y = cvt_pk_bf16(z0.z, z0.w);
        *(GAS u32x2*)(CKVN + (size_t)m * KVLR + lane * 4) = w2;
        const float c = cosT[(size_t)m * 32 + (lane & 31)], s = sinT[(size_t)m * 32 + (lane & 31)];
        const float o = lane < 32 ? x1 * c - x2 * s : x2 * c + x1 * s;
        KR[(size_t)m * DROPE + lane] = (bf16_t)(cvt_pk_bf16(o, o) & 0xffffu);
    }
}
template <int W>
__device__ __forceinline__ void pool_walk(const bf16_t* h, const ssq_t* ssq, const f32x2 g2, bf16_t* Z, size_t rowbase, int t_start, int c0, int nrows, int col) {
    f32x2 ring[W]; f32x2 sum = (f32x2){0.f, 0.f};
#pragma unroll
    for (int j = 0; j < W; ++j) ring[j] = (f32x2){0.f, 0.f};
    for (int r = 0; r < nrows; r += 16) {
        unsigned xw[16]; ssq_t q[16];
#pragma unroll
        for (int j = 0; j < 16; ++j) { const size_t row = rowbase + t_start + r + j; xw[j] = *(const GAS unsigned*)(h + row * DM + col); q[j] = ssq[row]; }
#pragma unroll
        for (int j = 0; j < 16; ++j) {
            const int t = t_start + r + j; const size_t row = rowbase + t;
            const f32x2 v = (f32x2){bflo(xw[j]), bfhi(xw[j])} * rstd_of(q[j]) * g2;
            sum = sum + (v - ring[j % W]); ring[j % W] = v;
            if (t >= c0) { const float inv = 1.0f / (float)(t + 1 < W ? t + 1 : W); const f32x2 z = sum * inv - v; *(GAS unsigned*)(Z + row * DM + col) = cvt_pk_bf16(z.x, z.y); }
        }
    }
}
__device__ __forceinline__ void pool_phase(Frame& F, const bf16_t* h, const ssq_t* ssq, const float* gain, bf16_t* Z) {
    const int col = F.tid * 2; const f32x2 g2 = *(const f32x2*)(gain + col);
    for (int chunk = F.vcu; chunk < NBATCH * 16; chunk += F.G) {
        const int b = chunk >> 4, c0 = (chunk & 15) * 128, t_start = c0 ? c0 - 16 : 0, nrows = c0 + 128 - t_start; const size_t rowbase = (size_t)b * SEQ;
        const int grp = F.wave >> 1;
        if (grp == 0) pool_walk<2>(h, ssq, g2, Z, rowbase, t_start, c0, nrows, col);
        else if (grp == 1) pool_walk<4>(h, ssq, g2, Z, rowbase, t_start, c0, nrows, col);
        else if (grp == 2) pool_walk<8>(h, ssq, g2, Z, rowbase, t_start, c0, nrows, col);
        else pool_walk<16>(h, ssq, g2, Z, rowbase, t_start, c0, nrows, col);
    }
}
template <bool WRITE_H8>
__device__ __forceinline__ void router_phase(Frame& F, const bf16_t* h, const ssq_t* ssq, const float* gain, const float* router, int* list, float* rsl, unsigned* tokinfo, unsigned* cntw, unsigned char* H8) {
    LAS float* rt = (LAS float*)(F.lds + RING_OFF);
    LAS int* esel = (LAS int*)(F.lds + RING_OFF + 32768);
    LAS int* wt = (LAS int*)(F.lds + RING_OFF + 32768 + 2048);
    LAS int* base = (LAS int*)(F.lds + RING_OFF + 32768 + 2048 + 256);
    LAS float* rsd = (LAS float*)(F.lds + RING_OFF + 32768 + 2048 + 512);
    const int lane = F.lane;
    for (int idx = F.tid; idx < DM * NEXP; idx += NWAVES * 64) rt[(idx & 7) * DM + (idx >> 3)] = router[idx];
    f32x4 g[4];
#pragma unroll
    for (int j = 0; j < 4; ++j) g[j] = *(const f32x4*)(gain + lane * 4 + 256 * j);
    for (int chunk = F.vcu; chunk < NTOK / 256; chunk += F.G) {
        const int T0 = chunk * 256;
        __syncthreads();
        u32x2 nx[4]; ssq_t nq;
        { const GAS u32x2* xr = (const GAS u32x2*)(h + (size_t)(T0 + F.wave * 32) * DM) + lane;
#pragma unroll
          for (int j = 0; j < 4; ++j) nx[j] = xr[64 * j];
          nq = ssq[T0 + F.wave * 32]; }
        for (int i = 0; i < 32; ++i) {
            const int tl = F.wave * 32 + i, m = T0 + tl;
            u32x2 cw[4];
#pragma unroll
            for (int j = 0; j < 4; ++j) cw[j] = nx[j];
            const float rstd = rstd_of(nq);
            if (i + 1 < 32) { const GAS u32x2* xr = (const GAS u32x2*)(h + (size_t)(m + 1) * DM) + lane;
#pragma unroll
                for (int j = 0; j < 4; ++j) nx[j] = xr[64 * j];
                nq = ssq[m + 1]; }
            f32x4 v[4];
#pragma unroll
            for (int j = 0; j < 4; ++j) { const u32x2 w = cw[j]; f32x4 xn = (f32x4){bflo(w.x), bfhi(w.x), bflo(w.y), bfhi(w.y)} * rstd;
                if constexpr (WRITE_H8) { const f32x4 q = xn * pg8::FP8_SA; *(GAS unsigned*)(H8 + (size_t)m * DM + lane * 4 + 256 * j) = pg8::pk4_fp8(q.x, q.y, q.z, q.w); }
                v[j] = xn * g[j]; }
            float lg[8];
#pragma unroll
            for (int e = 0; e < 8; ++e) { float p = 0.f;
#pragma unroll
                for (int j = 0; j < 4; ++j) { const f32x4 r4 = *(const LAS f32x4*)(rt + e * DM + lane * 4 + 256 * j); p += (v[j].x * r4.x + v[j].y * r4.y) + (v[j].z * r4.z + v[j].w * r4.w); }
                lg[e] = wave_sum(p); }
            int e0 = 0; float l0 = lg[0];
#pragma unroll
            for (int e = 1; e < 8; ++e) if (lg[e] > l0) { l0 = lg[e]; e0 = e; }
            int e1 = e0 == 0 ? 1 : 0; float l1 = lg[e0 == 0 ? 1 : 0];
#pragma unroll
            for (int e = 0; e < 8; ++e) if (e != e0 && lg[e] > l1) { l1 = lg[e]; e1 = e; }
            const float g0 = 1.0f / (1.0f + __expf(l1 - l0)), g1 = 1.0f - g0;
            if (lane == 0) { esel[2 * tl] = e0; esel[2 * tl + 1] = e1; rsd[tl] = rstd; unsigned* ti = tokinfo + (size_t)m * 8;
                ti[0] = (unsigned)e0; ti[2] = __float_as_uint(g0); ti[4] = (unsigned)e1; ti[6] = __float_as_uint(g1); }
        }
        __syncthreads();
        const int me = esel[F.tid]; int myrank = 0;
#pragma unroll
        for (int e = 0; e < 8; ++e) { const unsigned long long mask = __ballot(me == e); if (me == e) myrank = __popcll(mask & ((1ull << lane) - 1ull)); if (lane == 0) wt[F.wave * 8 + e] = __popcll(mask); }
        __syncthreads();
        int off = 0;
        for (int w = 0; w < F.wave; ++w) off += wt[w * 8 + me];
        if (F.tid < 8) { int tot = 0; for (int w = 0; w < 8; ++w) tot += wt[w * 8 + F.tid]; base[F.tid] = (int)__hip_atomic_fetch_add(cntw + 64 * F.tid, (unsigned)tot, RLX_AGENT); }
        __syncthreads();
        const int rank = base[me] + off + myrank, tok = T0 + (F.tid >> 1);
        list[(size_t)me * NTOK + rank] = tok; rsl[(size_t)me * NTOK + rank] = rsd[F.tid >> 1];
        tokinfo[(size_t)tok * 8 + (F.tid & 1) * 4 + 1] = (unsigned)rank;
    }
}
template <bool GATHER, bool FP8 = false>
struct MoeOrder {
    static constexpr size_t A_BLK = GATHER ? 0 : (FP8 ? (size_t)256 * FFE8 : (size_t)256 * FFEP * 2), B_EXP = GATHER ? (FP8 ? (size_t)2 * FFEP * DM : (size_t)2 * FFEP * DM * 2) : (FP8 ? (size_t)DM * FFE8 : (size_t)DM * FFEP * 2),
                            B_TILE = GATHER ? (FP8 ? (size_t)256 * DM : (size_t)256 * DM * 2) : (FP8 ? (size_t)256 * FFE8 : (size_t)256 * FFEP * 2);
    static constexpr int NT = GATHER ? 2 * FFEP / 256 : DM / 256;
    const char* A; const char* B; const int* list; const unsigned* cntw; int G, c, rev; unsigned bs[9];
    __device__ __forceinline__ void init(const unsigned* cntw_, const void* A_, const void* B_, const int* list_, int G_, int c_) {
        A = (const char*)A_; B = (const char*)B_; list = list_; cntw = cntw_; G = G_; c = c_; rev = 0; bs[0] = 0u;
#pragma unroll
        for (int e = 0; e < 8; ++e) { const unsigned ce = rfl(__hip_atomic_load((unsigned*)cntw + 64 * e, RLX_AGENT)); bs[e + 1] = bs[e] + ((ce + 255u) >> 8); }
    }
    __device__ __forceinline__ bool next(int i, pg8::Unit& u) const {
        unsigned blk; int pn;
        if ((G & 7) == 0) {
            const int x = c & 7, cl = c >> 3, q = (int)bs[8] >> 3, r = (int)bs[8] & 7, nbx = q + (x < r ? 1 : 0), b0 = x * q + (x < r ? x : r);
            int U = i * (G >> 3) + cl; const int nwx = nbx * NT; if (U >= nwx) return false;
            if (rev) U = nwx - 1 - U;
            const int nig = pg8::WGM * NT, gid = U / nig, fm = gid * pg8::WGM, gsz = (nbx - fm) < pg8::WGM ? (nbx - fm) : pg8::WGM;
            blk = (unsigned)(b0 + fm + (U % nig) % gsz); pn = (U % nig) / gsz;
        } else {
            long L = (long)i * G + c; if (L >= (long)bs[8] * NT) return false;
            if (rev) L = (long)bs[8] * NT - 1 - L;
            blk = (unsigned)(L / NT); pn = (int)(L % NT);
        }
        unsigned e = 0u, st = 0u;
#pragma unroll
        for (int k = 1; k < 8; ++k) if (blk >= bs[k]) { e = (unsigned)k; st = bs[k]; }
        const unsigned j = blk - st;
        u.b = B + (size_t)e * B_EXP + (size_t)pn * B_TILE; u.orow = (int)(blk * 256u); u.pn = pn; u.aux = (int)e;
        if constexpr (GATHER) { const unsigned ce = rfl(__hip_atomic_load((unsigned*)cntw + 64 * e, RLX_AGENT));
            u.a = A; u.rows = list + (size_t)e * NTOK + (size_t)j * 256; const unsigned rem = ce - j * 256u; u.nrows = rem < 256u ? (int)rem : 256; }
        else { u.a = A + (size_t)blk * A_BLK; u.rows = nullptr; u.nrows = 256; }
        return true;
    }
};
constexpr int NPHASE = 27;
struct Args { const float* in[20]; float* out; unsigned char* ws; int ph_lo, ph_hi, li, pad; };
#ifndef MK_REP_MASK
#define MK_REP_MASK 0
#endif
#ifndef MK_REP_N
#define MK_REP_N 1
#endif
#ifndef MK_REV
#define MK_REV 1
#endif
#ifndef MK_STAG_BF
#define MK_STAG_BF 0u
#define MK_STAG_F8 0u
#endif
constexpr int PT_OFF = LDSCTL_OFF + 512;
__device__ __forceinline__ unsigned long long ptab_u64(LAS unsigned char* L, int i) {
    const volatile LAS unsigned* p = (const volatile LAS unsigned*)(L + PT_OFF + 8 * i); const unsigned lo = rfl(p[0]), hi = rfl(p[1]); return ((unsigned long long)hi << 32) | lo; }
__device__ __forceinline__ const float* ptab(LAS unsigned char* L, int i) { return (const float*)(GAS const float*)ptab_u64(L, i); }
__device__ __forceinline__ Frame make_frame(LAS unsigned char* L) {
    asm volatile("" : "+s"(L));
    Frame F; F.lds = L; F.MISC = (volatile LAS unsigned*)(L + MISC_OFF); F.tid = launder_v((int)threadIdx.x); F.lane = F.tid & 63; F.wave = __builtin_amdgcn_readfirstlane(F.tid >> 6);
    { int g_ = gridDim.x, bx = blockIdx.x; asm volatile("" : "+s"(g_), "+s"(bx)); F.G = g_; F.bx = bx;
      F.vcu = (F.G % 8 == 0) ? (bx % 8) * (F.G / 8) + bx / 8 : bx; }
    F.ws = (unsigned char*)(GAS unsigned char*)ptab_u64(L, 21); F.ctl = (gu32*)(F.ws + WS_CTL); return F;
}
__global__ void __launch_bounds__(NWAVES * 64, 2) fwd(Args args) {
    extern __shared__ __attribute__((aligned(16))) unsigned char lds[];
    LAS unsigned char* L = (LAS unsigned char*)lds;
    { const int tid = threadIdx.x;
      for (int u = tid; u < LDSCTL_BYTES / 4; u += NWAVES * 64) ((LAS unsigned*)(L + LDSCTL_OFF))[u] = 0u;
      __syncthreads();
      if (tid < 20) *(LAS unsigned long long*)(L + PT_OFF + 8 * tid) = (unsigned long long)args.in[tid];
      if (tid == 20) *(LAS unsigned long long*)(L + PT_OFF + 8 * 20) = (unsigned long long)args.out;
      if (tid == 21) *(LAS unsigned long long*)(L + PT_OFF + 8 * 21) = (unsigned long long)args.ws;
      if (tid == 22) *(LAS unsigned long long*)(L + PT_OFF + 8 * 22) = (unsigned long long)args.pad;
      __syncthreads(); }
    const int lo = args.ph_lo, hi = args.ph_hi;
    XcdBarrier bar; { gu32* ctl = (gu32*)(args.ws + WS_CTL); bar.bar = (unsigned*)(ctl + CW_BAR) + args.li * XCD_BAR_WORDS; bar.x = 0; bar.st = nullptr;
      if (threadIdx.x == 0) { const unsigned long long ba = (unsigned long long)((unsigned*)(ctl + CW_BAR) + args.li * XCD_BAR_WORDS); ((volatile LAS unsigned*)(L + MISC_OFF))[10] = (unsigned)ba; ((volatile LAS unsigned*)(L + MISC_OFF))[11] = (unsigned)(ba >> 32); }
      if (hi - lo > 1) bar = xcd_barrier_post((unsigned*)(ctl + CW_BAR) + args.li * XCD_BAR_WORDS, (volatile LAS unsigned*)(L + MISC_OFF) + 8);
      __syncthreads(); }
#ifndef MK_ONLY
#define MK_ONLY (-1)
#endif
#define KIND(k) ((k) == 0 ? 0 : 1 + ((k) - 1) % 13)
#ifndef MK_SKIPMASK
#define MK_SKIPMASK 0
#endif
#define IN(k) ((MK_ONLY < 0 || KIND(k) == MK_ONLY) && !((MK_SKIPMASK >> KIND(k)) & 1) && lo <= (k) && (k) < hi)
#define FORREP(k)
#if MK_REP_MASK
#define LASTREP (ptab_u64(F.lds, 22) == 0ull)
#else
#define LASTREP true
#endif
#ifdef MK_DOUBLE_BAR
#define SEAM(k) do { if ((k) + 1 < hi) { xcd_barrier(bar); xcd_barrier(bar); } } while (0)
#else
#define SEAM(k) do { if ((k) + 1 < hi) xcd_barrier(bar); } while (0)
#endif
#define WSP(off) ((bf16_t*)(F.ws + (off)))
#define SSQ(i) ((ssq_t*)(F.ws + WS_SSQ) + (size_t)(i) * NTOK)
    LAS unsigned char* ring = L + RING_OFF;

    if (IN(0)) FORREP(0) { Frame F = make_frame(L); p0_prologue(F); SEAM(0); }

    for (int lp = 0; lp < 2; ++lp) {
        const int pb = 1 + 13 * lp;
        if (IN(pb + 0)) FORREP(pb + 0) { Frame F = make_frame(L);
            pg8::RegOrder S; S.init(WSP(WS_H), DM * 2, WSP(WS_WDN) + (size_t)lp * NDOWNP * DM, DM * 2, NTOK, NDOWNP, F.G, F.bx);
            pg8::EpiDown E{WSP(WS_DOWN), WSP(WS_KR), SSQ(4 * lp + 0), LASTREP ? SSQ(10 + 2 * lp) : SSQ(9), LASTREP ? SSQ(11 + 2 * lp) : SSQ(9), (const float*)(F.ws + WS_COS), (const float*)(F.ws + WS_SIN)};
            pg8::gemm_phase<pg8::EpiDown, pg8::RegOrder, false>(ring, DM * 2, DM * 2, DM * 2, S, E);
            SEAM(pb + 0);
        }
        if (IN(pb + 1)) FORREP(pb + 1) { Frame F = make_frame(L);
            pg8::RegOrder S; S.init(WSP(WS_DOWN), NDOWNP * 2, WSP(WS_WUQ) + (size_t)lp * NQ * QLR, QLR * 2, NTOK, NQ, F.G, F.bx);
            pg8::EpiQ E{WSP(WS_Q), (const float*)(F.ws + WS_COS), (const float*)(F.ws + WS_SIN), SSQ(10 + 2 * lp)};
            pg8::gemm_phase<pg8::EpiQ, pg8::RegOrder, false>(ring, NDOWNP * 2, QLR * 2, QLR * 2, S, E);
            SEAM(pb + 1);
        }
        if (IN(pb + 2)) FORREP(pb + 2) { Frame F = make_frame(L);
            pg8::RegOrder S; S.init(WSP(WS_DOWN) + QLR, NDOWNP * 2, WSP(WS_WUKV) + (size_t)lp * NKV * KVLR, KVLR * 2, NTOK, NKV, F.G, F.bx);
            pg8::EpiBf16<2> E{WSP(WS_KNV), NKV, SSQ(11 + 2 * lp)};
            pg8::gemm_phase<pg8::EpiBf16<2>, pg8::RegOrder, false>(ring, NDOWNP * 2, KVLR * 2, KVLR * 2, S, E);
            SEAM(pb + 2);
        }
        if (IN(pb + 3)) FORREP(pb + 3) { Frame F = make_frame(L); att::attn_phase((char*)lds + RING_OFF, WSP(WS_Q), WSP(WS_KNV), WSP(WS_KR), WSP(WS_DOWN), F.vcu, F.G); SEAM(pb + 3); }
        if (IN(pb + 4) && lp == 0) FORREP(pb + 4) { Frame F = make_frame(L);
            pg8::RegOrder S; S.init(WSP(WS_DOWN), DM * 2, WSP(WS_WO) + (size_t)lp * DM * DM, DM * 2, NTOK, DM, F.G, F.bx);
            pg8::EpiResidH<false> E{WSP(WS_H), LASTREP ? WSP(WS_H) : WSP(WS_DUMMY), LASTREP ? SSQ(4 * lp + 1) : SSQ(9), nullptr, 1.0f};
            pg8::gemm_phase<pg8::EpiResidH<false>, pg8::RegOrder, false>(ring, DM * 2, DM * 2, DM * 2, S, E);
            SEAM(pb + 4);
        }
        if (IN(pb + 4) && lp == 1) FORREP(pb + 4) { Frame F = make_frame(L);
            pg8::RegOrder S; S.init(WSP(WS_DOWN), DM * 2, WSP(WS_WO) + (size_t)lp * DM * DM, DM * 2, NTOK, DM, F.G, F.bx);
            pg8::EpiResidH<true> E{WSP(WS_H), LASTREP ? WSP(WS_H) : WSP(WS_DUMMY), LASTREP ? SSQ(4 * lp + 1) : SSQ(9), F.ws + WS_H8, 1.0f};
            pg8::gemm_phase<pg8::EpiResidH<true>, pg8::RegOrder, false>(ring, DM * 2, DM * 2, DM * 2, S, E);
            SEAM(pb + 4);
        }
#if defined(MK_EPI_PROBE)
        if (IN(pb + 5) && lp == 0 && !LASTREP) { Frame F = make_frame(L);
            pg8::RegOrder S; S.init(WSP(WS_H), DM * 2, WSP(WS_WGU) + (size_t)lp * 2 * FFD * DM, DM * 2, NTOK, 2 * FFD, F.G, F.bx);
#if MK_EPI_PROBE == 1
            pg8::EpiNull E{(float*)(F.ws + WS_DUMMY)};
            pg8::gemm_phase<pg8::EpiNull, pg8::RegOrder, false>(ring, DM * 2, DM * 2, DM * 2, S, E);
#else
            pg8::EpiBf16<0> E{WSP(WS_HID), FFD, nullptr};
            S.nN = FFD / 256; S.nwg = S.nM * S.nN;
            pg8::gemm_phase<pg8::EpiBf16<0>, pg8::RegOrder, false>(ring, DM * 2, DM * 2, DM * 2, S, E);
#endif
        }
        if (IN(pb + 5) && lp == 0 && LASTREP) FORREP(pb + 5) { Frame F = make_frame(L);
#else
        if (IN(pb + 5) && lp == 0) FORREP(pb + 5) { Frame F = make_frame(L);
#endif
            pg8::RegOrder S; S.init(WSP(WS_H), DM * 2, WSP(WS_WGU) + (size_t)lp * 2 * FFD * DM, DM * 2, NTOK, 2 * FFD, F.G, F.bx);
            pg8::EpiSwiglu<1> E{WSP(WS_HID), FFD, SSQ(4 * lp + 1), nullptr};
            pg8::gemm_phase<pg8::EpiSwiglu<1>, pg8::RegOrder, false>(ring, DM * 2, DM * 2, DM * 2, S, E, MK_STAG_BF);
            SEAM(pb + 5);
        }
        if (IN(pb + 5) && lp == 1) FORREP(pb + 5) { Frame F = make_frame(L);
            pg8::RegOrder S; S.init(F.ws + WS_H8, DM, F.ws + WS_WGU + (size_t)2 * FFD * DM * 2, DM, NTOK, 2 * FFD, F.G, F.bx);
            pg8::EpiSwigluF8<1> E{F.ws + WS_HID, FFD8, 2 * FFD / 256 - 1, SSQ(4 * lp + 1)};
            pg8::gemm_phase<pg8::EpiSwigluF8<1>, pg8::RegOrder, false, true>(ring, DM, DM, DM, S, E, MK_STAG_F8);
            SEAM(pb + 5);
        }
        if (IN(pb + 6) && lp == 0) FORREP(pb + 6) { Frame F = make_frame(L);
            pg8::RegOrder S; S.init(WSP(WS_HID), FFD * 2, WSP(WS_WD) + (size_t)lp * DM * FFD, FFD * 2, NTOK, DM, F.G, F.bx); S.rev = MK_REV;
            pg8::EpiResidH<false> E{WSP(WS_H), LASTREP ? WSP(WS_H) : WSP(WS_DUMMY), LASTREP ? SSQ(4 * lp + 2) : SSQ(9), nullptr, 1.0f};
            pg8::gemm_phase<pg8::EpiResidH<false>, pg8::RegOrder, false>(ring, FFD * 2, FFD * 2, FFD * 2, S, E);
            SEAM(pb + 6);
        }
        if (IN(pb + 6) && lp == 1) FORREP(pb + 6) { Frame F = make_frame(L);
            pg8::RegOrder S; S.init(F.ws + WS_HID, FFD8, F.ws + WS_WD + (size_t)DM * FFD * 2, FFD8, NTOK, DM, F.G, F.bx); S.rev = MK_REV;
            pg8::EpiResidH<false> E{WSP(WS_H), LASTREP ? WSP(WS_H) : WSP(WS_DUMMY), LASTREP ? SSQ(4 * lp + 2) : SSQ(9), nullptr, 1.0f / (pg8::FP8_SH * pg8::FP8_SW)};
            pg8::gemm_phase<pg8::EpiResidH<false>, pg8::RegOrder, false, true>(ring, FFD8, FFD8, FFD8, S, E);
            SEAM(pb + 6);
        }
        if (IN(pb + 7)) FORREP(pb + 7) { Frame F = make_frame(L); pool_phase(F, WSP(WS_H), SSQ(4 * lp + 2), ptab(F.lds, 2) + (size_t)(2 * lp + 1) * DM, WSP(WS_DOWN)); SEAM(pb + 7); }
        if (IN(pb + 8)) FORREP(pb + 8) { Frame F = make_frame(L);
            pg8::RegOrder S; S.init(WSP(WS_DOWN), DM * 2, WSP(WS_WPOOL) + (size_t)lp * 4 * 256 * 256, 256 * 2, NTOK, DM, F.G, F.bx, 256 * 2);
            pg8::EpiResidH<false> E{WSP(WS_H), LASTREP ? WSP(WS_H) : WSP(WS_DUMMY), LASTREP ? SSQ(4 * lp + 3) : SSQ(9), nullptr, 1.0f};
            pg8::gemm_phase<pg8::EpiResidH<false>, pg8::RegOrder, false>(ring, DM * 2, 256 * 2, 256 * 2, S, E);
            SEAM(pb + 8);
        }
        if (IN(pb + 9)) FORREP(pb + 9) { Frame F = make_frame(L);
            router_phase<true>(F, WSP(WS_H), SSQ(4 * lp + 3), ptab(F.lds, 3) + (size_t)(2 * lp + 1) * DM, ptab(F.lds, 15) + (size_t)lp * DM * NEXP, (int*)(F.ws + WS_LIST), (float*)(F.ws + WS_RSL), (unsigned*)(F.ws + WS_TOKINFO), (unsigned*)(F.ctl + CW_CNT) + (LASTREP ? lp : 2 + lp) * 8 * 64, F.ws + WS_H8);
            SEAM(pb + 9); }
#ifndef TEST_NO_F8MOE
        if (IN(pb + 10)) FORREP(pb + 10) { Frame F = make_frame(L);
            MoeOrder<true, true> S; S.init((unsigned*)(F.ctl + CW_CNT) + lp * 8 * 64, F.ws + WS_H8, F.ws + WS_MWGU + (size_t)lp * 8 * 2 * FFEP * DM * 2, (const int*)(F.ws + WS_LIST), F.G, F.bx);
            pg8::EpiSwigluF8<0> E{F.ws + WS_HID, FFE8, 2 * FFEP / 256 - 1, nullptr};
            pg8::gemm_phase<pg8::EpiSwigluF8<0>, MoeOrder<true, true>, true, true>(ring, DM, DM, DM, S, E, MK_STAG_F8);
            SEAM(pb + 10);
        }
#endif
#ifndef TEST_NO_F8MOE
        if (IN(pb + 11)) FORREP(pb + 11) { Frame F = make_frame(L);
            MoeOrder<false, true> S; S.init((unsigned*)(F.ctl + CW_CNT) + lp * 8 * 64, F.ws + WS_HID, F.ws + WS_MWD + (size_t)lp * 8 * DM * FFEP * 2, (const int*)(F.ws + WS_LIST), F.G, F.bx); S.rev = MK_REV;
            pg8::EpiBf16Scaled E{WSP(WS_YB), DM, 1.0f / (pg8::FP8_SH * pg8::FP8_SW)};
            pg8::gemm_phase<pg8::EpiBf16Scaled, MoeOrder<false, true>, false, true>(ring, FFE8, FFE8, FFE8, S, E);
            SEAM(pb + 11);
        }
#endif
        if (IN(pb + 12)) FORREP(pb + 12) { Frame F = make_frame(L);
            if (lp == 0) combine_phase<false>(F, WSP(WS_H), LASTREP ? WSP(WS_H) : WSP(WS_DOWN), WSP(WS_YB), (const unsigned*)(F.ws + WS_TOKINFO), (unsigned*)(F.ctl + CW_CNT), LASTREP ? SSQ(4) : SSQ(9), nullptr, nullptr);
            else combine_phase<true>(F, WSP(WS_H), nullptr, WSP(WS_YB), (const unsigned*)(F.ws + WS_TOKINFO), (unsigned*)(F.ctl + CW_CNT) + 8 * 64, nullptr, ptab(F.lds, 19), (float*)ptab(F.lds, 20));
            SEAM(pb + 12);
        }
    }
#undef IN
#undef SEAM
#undef WSP
#undef SSQ
}

#ifndef MK_PER_PHASE
#define MK_PER_PHASE 0
#endif
extern "C" void kernel_launch(void* const* d_in, const int* in_sizes, int n_in, void* d_out, int out_size, void* d_ws, size_t ws_size, hipStream_t stream) {
    static int grid = 0;
    if (grid == 0) {
        if (n_in != 20 || in_sizes[0] != NTOK * DM || out_size != NTOK * DM || ws_size < WS_END) { fprintf(stderr, "kernel_launch: unexpected shapes (n_in %d, in0 %d, out %d, ws %zu < %zu)\n", n_in, n_in > 0 ? in_sizes[0] : -1, out_size, ws_size, (size_t)WS_END); grid = -1; return; }
        int dev = 0, cus = 0, per_cu = 0;
        if (hipGetDevice(&dev) != hipSuccess || hipDeviceGetAttribute(&cus, hipDeviceAttributeMultiprocessorCount, dev) != hipSuccess) { grid = -1; return; }
        if (hipFuncSetAttribute((const void*)fwd, hipFuncAttributeMaxDynamicSharedMemorySize, LDS_BYTES) != hipSuccess) { fprintf(stderr, "kernel_launch: hipFuncSetAttribute failed\n"); grid = -1; return; }
        if (hipOccupancyMaxActiveBlocksPerMultiprocessor(&per_cu, (const void*)fwd, NWAVES * 64, LDS_BYTES) != hipSuccess || per_cu < 1) fprintf(stderr, "kernel_launch: occupancy query reports %d\n", per_cu);
        (void)hipGetLastError();
        grid = cus < 256 ? cus : 256;
    }
    if (grid < 0) return;
    if (hipMemsetAsync((char*)d_ws + WS_CTL, 0, CTL_ZERO_BYTES, stream) != hipSuccess) return;
    Args a{};
    for (int i = 0; i < 20; ++i) a.in[i] = (const float*)d_in[i];
    a.out = (float*)d_out; a.ws = (unsigned char*)d_ws;
#if MK_PER_PHASE
    for (int p = 0; p < NPHASE; ++p) { a.ph_lo = p; a.ph_hi = p + 1; a.li = 0; hipLaunchKernelGGL(fwd, dim3(grid), dim3(NWAVES * 64), LDS_BYTES, stream, a); }
#elif MK_REP_MASK
    { int cur = 0, li = 0;
      for (int k = 0; k < NPHASE; ++k) if ((MK_REP_MASK >> (k == 0 ? 0 : 1 + (k - 1) % 13)) & 1) {
          if (k > cur) { a.ph_lo = cur; a.ph_hi = k; a.li = li++; a.pad = 0; hipLaunchKernelGGL(fwd, dim3(grid), dim3(NWAVES * 64), LDS_BYTES, stream, a); }
          for (int r = 1; r < MK_REP_N; ++r) { a.ph_lo = k; a.ph_hi = k + 1; a.li = li++; a.pad = 1; hipLaunchKernelGGL(fwd, dim3(grid), dim3(NWAVES * 64), LDS_BYTES, stream, a); }
          cur = k; }
      a.ph_lo = cur; a.ph_hi = NPHASE; a.li = li++; a.pad = 0; hipLaunchKernelGGL(fwd, dim3(grid), dim3(NWAVES * 64), LDS_BYTES, stream, a); }
#elif defined(MK_TWICE)
    a.ph_lo = 0; a.ph_hi = NPHASE; a.li = 0;
    hipLaunchKernelGGL(fwd, dim3(grid), dim3(NWAVES * 64), LDS_BYTES, stream, a);
    (void)hipMemsetAsync((char*)d_ws + WS_CTL, 0, CTL_ZERO_BYTES, stream);
    hipLaunchKernelGGL(fwd, dim3(grid), dim3(NWAVES * 64), LDS_BYTES, stream, a);
#else
    a.ph_lo = 0; a.ph_hi = NPHASE; a.li = 0;
    hipLaunchKernelGGL(fwd, dim3(grid), dim3(NWAVES * 64), LDS_BYTES, stream, a);
#endif
}
```

```cpp
#include <hip/hip_runtime.h>
#include <cstdio>
#include <cstdint>

#define GAS __attribute__((address_space(1)))
#define LAS __attribute__((address_space(3)))
typedef unsigned short bf16_t;
typedef short bf16x8 __attribute__((ext_vector_type(8)));
typedef short s16x4 __attribute__((ext_vector_type(4)));
typedef float f32x2 __attribute__((ext_vector_type(2)));
typedef float f32x4 __attribute__((ext_vector_type(4)));
typedef float f32x16 __attribute__((ext_vector_type(16)));
typedef unsigned u32x2 __attribute__((ext_vector_type(2)));
typedef unsigned u32x4 __attribute__((ext_vector_type(4)));

constexpr int DM = 1024, NBATCH = 32, SEQ = 2048, NTOK = NBATCH * SEQ;
constexpr int NHEAD = 8, DNOPE = 128, DROPE = 64, DVH = 128, DQH = DNOPE + DROPE, QLR = 512, KVLR = 256;
constexpr int NDOWN = QLR + KVLR + DROPE  , NDOWNP = 1024;
constexpr int NQ = NHEAD * DQH  , NKV = NHEAD * (DNOPE + DVH)  ;
constexpr int FFD = 2688, NEXP = 8, FFE = 1344, FFEP = 1408;
constexpr int PSLOT = (NTOK * 2 / 256 + NEXP) * 256;
constexpr float RMS_EPS = 1e-6f;

__device__ __forceinline__ unsigned cvt_pk_bf16(float lo, float hi) { unsigned r; asm volatile("v_cvt_pk_bf16_f32 %0, %1, %2" : "=v"(r) : "v"(lo), "v"(hi)); return r; }
__device__ __forceinline__ int launder_v(int v) { asm volatile("" : "+v"(v)); return v; }
__device__ __forceinline__ float fp8_rt(float x, float s) { const int p = __builtin_amdgcn_cvt_pk_fp8_f32(x * s, 0.f, 0, false); return __builtin_amdgcn_cvt_f32_fp8(p, 0) * (1.0f / s); }
__device__ __forceinline__ float bf2f(unsigned short b) { return __uint_as_float((unsigned)b << 16); }
__device__ __forceinline__ float bflo(unsigned w) { return __uint_as_float(w << 16); }
__device__ __forceinline__ float bfhi(unsigned w) { return __uint_as_float(w & 0xffff0000u); }

typedef unsigned long long ssq_t;
__device__ __forceinline__ ssq_t ssq_fix(float s) { return (ssq_t)(s * 16777216.0f); }
__device__ __forceinline__ float rstd_n(ssq_t q, float invn) { return __builtin_amdgcn_rsqf(((float)(unsigned)(q >> 32) * 4294967296.0f + (float)(unsigned)q) * (1.0f / 16777216.0f) * invn + RMS_EPS); }
__device__ __forceinline__ float rstd_of(ssq_t q) { return rstd_n(q, 1.0f / DM); }
__device__ __forceinline__ float rstd_f(float ssq) { return __builtin_amdgcn_rsqf(ssq * (1.0f / DM) + RMS_EPS); }

namespace pg8 {
constexpr int BM = 256, BK = 64, HALF = 128, HTB = HALF * BK * 2  , STAGE_BYTES = 8 * HTB, NXCD = 8, WGM = 8;
__host__ __device__ __forceinline__ int lds_byte(int r, int c) { const int st = (r >> 4) * 2 + (c >> 5), rr = r & 15, cc = c & 31, ob = rr * 64 + cc * 2; return st * 1024 + (ob ^ (((ob >> 9) & 1) << 5)); }
__host__ __device__ __forceinline__ void stage_rc(int b, int& R, int& C) { const int st = b / 1024, sb = b % 1024, swz = sb ^ (((sb >> 9) & 1) << 5); R = (st >> 1) * 16 + swz / 64; C = (st & 1) * 32 + (swz % 64) / 2; }
__host__ __device__ __forceinline__ int perm32(int rho) { const int n = rho >> 4, i = rho & 15; return 8 * (i >> 2) + 4 * n + (i & 3); }

struct Unit { const char* a; const char* b; const int* rows; int nrows; int orow; int pn; int aux; };

struct RegOrder {
    const char* A; const char* B; unsigned a_tile, b_tile, a_colstep; int nM, nN, nwg, G, c, rev;
    __device__ __forceinline__ void init(const void* A_, size_t lda_b, const void* B_, size_t ldb_b, int M, int N, int G_, int c_, size_t a_colstep_ = 0) {
        A = (const char*)A_; B = (const char*)B_; a_tile = (unsigned)(256 * lda_b); b_tile = (unsigned)(256 * ldb_b); a_colstep = (unsigned)a_colstep_; nM = M / BM; nN = N / BM; nwg = nM * nN; G = G_; c = c_; rev = 0; }
    __device__ __forceinline__ bool next(int i, Unit& u) const {
        long L = (long)i * G + c; if (L >= nwg) return false;
        if (rev) L = nwg - 1 - L;
        int wgid = (int)L; { const int q = nwg / NXCD, r = nwg % NXCD, xcd = wgid % NXCD, off = wgid / NXCD; wgid = (xcd < r ? xcd * (q + 1) : r * (q + 1) + (xcd - r) * q) + off; }
        const int nig = WGM * nN, gid = wgid / nig, fm = gid * WGM, gsz = (nM - fm) < WGM ? (nM - fm) : WGM;
        const int pm = fm + ((wgid % nig) % gsz), pn = (wgid % nig) / gsz;
        u.a = A + (size_t)pm * a_tile + (size_t)pn * a_colstep; u.b = B + (size_t)pn * b_tile; u.rows = nullptr; u.nrows = 256; u.orow = pm * BM; u.pn = pn; u.aux = 0; return true;
    }
};

template <int RS> struct EpiBf16 {
    static constexpr bool PERM = true;
    bf16_t* O; int ldc; const ssq_t* rs;
    __device__ __forceinline__ void operator()(const f32x4 (&acc)[2][2][4][2], const Unit& u, int wr, int wc, int fr, int fq) const {
        const int row0 = u.orow + launder_v(wr * 64 + fr), col0 = u.pn * BM + wc * 32 + 8 * fq;
        float sc[2][4]; ssq_t rq[2][4];
#pragma unroll
        for (int ai = 0; ai < 2; ++ai)
#pragma unroll
            for (int m = 0; m < 4; ++m) { const int row = row0 + ai * HALF + m * 16; if constexpr (RS != 0) rq[ai][m] = rs[row]; }
#pragma unroll
        for (int ai = 0; ai < 2; ++ai)
#pragma unroll
            for (int m = 0; m < 4; ++m) { sc[ai][m] = 1.0f; if constexpr (RS == 1) sc[ai][m] = rstd_of(rq[ai][m]); if constexpr (RS == 2) sc[ai][m] = rstd_n(rq[ai][m], 1.0f / KVLR); }
#pragma unroll
        for (int ai = 0; ai < 2; ++ai)
#pragma unroll
            for (int m = 0; m < 4; ++m) { const int row = row0 + ai * HALF + m * 16; bf16_t* rowp = O + (size_t)row * ldc + col0;
#pragma unroll
                for (int bj = 0; bj < 2; ++bj) { const f32x4 v0 = acc[ai][bj][m][0] * sc[ai][m], v1 = acc[ai][bj][m][1] * sc[ai][m];
                    u32x4 w; w.x = cvt_pk_bf16(v0[0], v0[1]); w.y = cvt_pk_bf16(v0[2], v0[3]); w.z = cvt_pk_bf16(v1[0], v1[1]); w.w = cvt_pk_bf16(v1[2], v1[3]);
                    *(u32x4*)(rowp + bj * HALF) = w; } }
    }
};
__device__ __forceinline__ float silu_mul(float g, float u) { return g * u * __builtin_amdgcn_rcpf(1.0f + __builtin_amdgcn_exp2f(-1.4426950408889634f * g)); }
template <int RS> struct EpiSwiglu {
    static constexpr bool PERM = true;
    bf16_t* H; int ldh; const void* rs; const int* list;
    __device__ __forceinline__ void operator()(const f32x4 (&acc)[2][2][4][2], const Unit& u, int wr, int wc, int fr, int fq) const {
        const int r0 = launder_v(wr * 64 + fr), col0 = u.pn * HALF + wc * 32 + 8 * fq;
        const ssq_t* rsq = (const ssq_t*)rs; const float* rsp = (const float*)rs; if constexpr (RS == 2) rsp = rsp + (u.rows - list);
        float sc[2][4]; ssq_t rq[2][4];
#pragma unroll
        for (int ai = 0; ai < 2; ++ai)
#pragma unroll
            for (int m = 0; m < 4; ++m) { const int r = r0 + ai * HALF + m * 16; if constexpr (RS == 1) rq[ai][m] = rsq[u.orow + r]; else sc[ai][m] = rsp[r]; }
        if constexpr (RS == 1) {
#pragma unroll
            for (int ai = 0; ai < 2; ++ai)
#pragma unroll
                for (int m = 0; m < 4; ++m) sc[ai][m] = rstd_of(rq[ai][m]); }
#pragma unroll
        for (int ai = 0; ai < 2; ++ai)
#pragma unroll
            for (int m = 0; m < 4; ++m) { const int r = r0 + ai * HALF + m * 16; bf16_t* rowp = H + (size_t)(u.orow + r) * ldh + col0; const float s = sc[ai][m];
                const f32x4 g0 = acc[ai][0][m][0] * s, g1 = acc[ai][0][m][1] * s, u0 = acc[ai][1][m][0] * s, u1 = acc[ai][1][m][1] * s;
                u32x4 w; w.x = cvt_pk_bf16(silu_mul(g0[0], u0[0]), silu_mul(g0[1], u0[1])); w.y = cvt_pk_bf16(silu_mul(g0[2], u0[2]), silu_mul(g0[3], u0[3]));
                w.z = cvt_pk_bf16(silu_mul(g1[0], u1[0]), silu_mul(g1[1], u1[1])); w.w = cvt_pk_bf16(silu_mul(g1[2], u1[2]), silu_mul(g1[3], u1[3]));
                __builtin_nontemporal_store(w, (u32x4*)rowp); }
    }
};
constexpr float FP8_SA = 16.0f, FP8_SW = 256.0f, FP8_SH = 16.0f, FP8_SX = 8.0f;
__device__ __forceinline__ unsigned pk4_fp8(float a, float b, float c, float d) { int p = __builtin_amdgcn_cvt_pk_fp8_f32(a, b, 0, false); p = __builtin_amdgcn_cvt_pk_fp8_f32(c, d, p, true); return (unsigned)p; }
template <int RS> struct EpiSwigluF8 {
    static constexpr bool PERM = true;
    unsigned char* H8; int ldh; int pad_tile; const ssq_t* rs;
    __device__ __forceinline__ void operator()(const f32x4 (&acc)[2][2][4][2], const Unit& u, int wr, int wc, int fr, int fq) const {
        const int r0 = launder_v(wr * 64 + fr), col0 = u.pn * HALF + wc * 32 + 8 * fq;
        float sc[2][4]; ssq_t rq[2][4];
#pragma unroll
        for (int ai = 0; ai < 2; ++ai)
#pragma unroll
            for (int m = 0; m < 4; ++m) { if constexpr (RS == 1) rq[ai][m] = rs[u.orow + r0 + ai * HALF + m * 16]; }
#pragma unroll
        for (int ai = 0; ai < 2; ++ai)
#pragma unroll
            for (int m = 0; m < 4; ++m) { if constexpr (RS == 1) sc[ai][m] = rstd_of(rq[ai][m]) * (1.0f / (FP8_SX * FP8_SW)); else sc[ai][m] = 1.0f / (FP8_SA * FP8_SW); }
#pragma unroll
        for (int ai = 0; ai < 2; ++ai)
#pragma unroll
            for (int m = 0; m < 4; ++m) { const int r = r0 + ai * HALF + m * 16; unsigned char* rowp = H8 + (size_t)(u.orow + r) * ldh + col0; const float s = sc[ai][m];
                const f32x4 g0 = acc[ai][0][m][0] * s, g1 = acc[ai][0][m][1] * s, u0 = acc[ai][1][m][0] * s, u1 = acc[ai][1][m][1] * s;
                u32x2 w; w.x = pk4_fp8(silu_mul(g0[0], u0[0]) * FP8_SH, silu_mul(g0[1], u0[1]) * FP8_SH, silu_mul(g0[2], u0[2]) * FP8_SH, silu_mul(g0[3], u0[3]) * FP8_SH);
                w.y = pk4_fp8(silu_mul(g1[0], u1[0]) * FP8_SH, silu_mul(g1[1], u1[1]) * FP8_SH, silu_mul(g1[2], u1[2]) * FP8_SH, silu_mul(g1[3], u1[3]) * FP8_SH);
                __builtin_nontemporal_store(w, (u32x2*)rowp);
                if (u.pn == pad_tile) { u32x2 z; asm volatile("v_mov_b32 %0, 0\n\tv_mov_b32 %1, 0" : "=v"(z.x), "=v"(z.y)); *(u32x2*)(rowp + HALF) = z; } }
    }
};
struct EpiBf16Scaled {
    static constexpr bool PERM = true;
    bf16_t* O; int ldc; float scale;
    __device__ __forceinline__ void operator()(const f32x4 (&acc)[2][2][4][2], const Unit& u, int wr, int wc, int fr, int fq) const {
        const int row0 = u.orow + launder_v(wr * 64 + fr), col0 = u.pn * BM + wc * 32 + 8 * fq;
#pragma unroll
        for (int ai = 0; ai < 2; ++ai)
#pragma unroll
            for (int m = 0; m < 4; ++m) { bf16_t* rowp = O + (size_t)(row0 + ai * HALF + m * 16) * ldc + col0;
#pragma unroll
                for (int bj = 0; bj < 2; ++bj) { const f32x4 v0 = acc[ai][bj][m][0] * scale, v1 = acc[ai][bj][m][1] * scale;
                    u32x4 w; w.x = cvt_pk_bf16(v0[0], v0[1]); w.y = cvt_pk_bf16(v0[2], v0[3]); w.z = cvt_pk_bf16(v1[0], v1[1]); w.w = cvt_pk_bf16(v1[2], v1[3]);
                    *(u32x4*)(rowp + bj * HALF) = w; } }
    }
};
struct EpiNull {
    static constexpr bool PERM = true;
    float* sink;
    __device__ __forceinline__ void operator()(const f32x4 (&acc)[2][2][4][2], const Unit& u, int wr, int wc, int fr, int fq) const {
        float s = 0.f;
#pragma unroll
        for (int ai = 0; ai < 2; ++ai)
#pragma unroll
            for (int bj = 0; bj < 2; ++bj)
#pragma unroll
                for (int m = 0; m < 4; ++m)
#pragma unroll
                    for (int n = 0; n < 2; ++n) s += acc[ai][bj][m][n][0];
        if (s == 12345.678f) sink[0] = s;
    }
};
template <bool W8> struct EpiResidH {
    static constexpr bool PERM = true;
    const bf16_t* hin; bf16_t* hout; ssq_t* ssq; unsigned char* h8; float scale;
    __device__ __forceinline__ void operator()(const f32x4 (&acc)[2][2][4][2], const Unit& u, int wr, int wc, int fr, int fq) const {
        const int row0 = u.orow + launder_v(wr * 64 + fr), col0 = u.pn * BM + wc * 32 + 8 * fq;
        float part[2][4];
#pragma unroll
        for (int ai = 0; ai < 2; ++ai) {
            u32x4 hv[4][2];
#pragma unroll
            for (int m = 0; m < 4; ++m)
#pragma unroll
                for (int bj = 0; bj < 2; ++bj) hv[m][bj] = *(const u32x4*)(hin + (size_t)(row0 + ai * HALF + m * 16) * DM + col0 + bj * HALF);
#pragma unroll
            for (int m = 0; m < 4; ++m) { const int row = row0 + ai * HALF + m * 16; const size_t off = (size_t)row * DM + col0; float pt = 0.f;
#pragma unroll
                for (int bj = 0; bj < 2; ++bj) { const u32x4 h4 = hv[m][bj]; const f32x4 a0 = acc[ai][bj][m][0] * scale, a1 = acc[ai][bj][m][1] * scale;
                    const float y0 = bflo(h4.x) + a0[0], y1 = bfhi(h4.x) + a0[1], y2 = bflo(h4.y) + a0[2], y3 = bfhi(h4.y) + a0[3], y4 = bflo(h4.z) + a1[0], y5 = bfhi(h4.z) + a1[1], y6 = bflo(h4.w) + a1[2], y7 = bfhi(h4.w) + a1[3];
                    pt += (y0 * y0 + y1 * y1) + (y2 * y2 + y3 * y3) + (y4 * y4 + y5 * y5) + (y6 * y6 + y7 * y7);
                    u32x4 w; w.x = cvt_pk_bf16(y0, y1); w.y = cvt_pk_bf16(y2, y3); w.z = cvt_pk_bf16(y4, y5); w.w = cvt_pk_bf16(y6, y7);
                    *(u32x4*)(hout + off + bj * HALF) = w;
                    if constexpr (W8) { u32x2 q; q.x = pk4_fp8(y0 * FP8_SX, y1 * FP8_SX, y2 * FP8_SX, y3 * FP8_SX); q.y = pk4_fp8(y4 * FP8_SX, y5 * FP8_SX, y6 * FP8_SX, y7 * FP8_SX); *(u32x2*)(h8 + off + bj * HALF) = q; } }
                pt += __shfl_xor(pt, 16); pt += __shfl_xor(pt, 32); part[ai][m] = pt; }
        }
        if (fq == 0) {
#pragma unroll
            for (int ai = 0; ai < 2; ++ai)
#pragma unroll
                for (int m = 0; m < 4; ++m) atomicAdd(ssq + row0 + ai * HALF + m * 16, ssq_fix(part[ai][m])); }
    }
};
struct EpiDown {
    static constexpr bool PERM = true;
    bf16_t* O; bf16_t* KR; const ssq_t* rs; ssq_t* ssq_q; ssq_t* ssq_kv; const float* cosT; const float* sinT;
    __device__ __forceinline__ void operator()(const f32x4 (&acc)[2][2][4][2], const Unit& u, int wr, int wc, int fr, int fq) const {
        const int row0 = u.orow + launder_v(wr * 64 + fr);
        float sc[2][4]; ssq_t rq[2][4];
#pragma unroll
        for (int ai = 0; ai < 2; ++ai)
#pragma unroll
            for (int m = 0; m < 4; ++m) rq[ai][m] = rs[row0 + ai * HALF + m * 16];
#pragma unroll
        for (int ai = 0; ai < 2; ++ai)
#pragma unroll
            for (int m = 0; m < 4; ++m) sc[ai][m] = rstd_of(rq[ai][m]);
        if (u.pn < 3) {
            ssq_t* sq = u.pn < 2 ? ssq_q : ssq_kv; const int col0 = u.pn * BM + wc * 32 + 8 * fq; float pts[2][4];
#pragma unroll
            for (int ai = 0; ai < 2; ++ai)
#pragma unroll
                for (int m = 0; m < 4; ++m) { const int row = row0 + ai * HALF + m * 16; bf16_t* rowp = O + (size_t)row * NDOWNP + col0; const float s = sc[ai][m]; float part = 0.f;
#pragma unroll
                    for (int bj = 0; bj < 2; ++bj) { const f32x4 v0 = acc[ai][bj][m][0] * s, v1 = acc[ai][bj][m][1] * s;
                        part += (v0[0] * v0[0] + v0[1] * v0[1]) + (v0[2] * v0[2] + v0[3] * v0[3]) + (v1[0] * v1[0] + v1[1] * v1[1]) + (v1[2] * v1[2] + v1[3] * v1[3]);
                        u32x4 w; w.x = cvt_pk_bf16(v0[0], v0[1]); w.y = cvt_pk_bf16(v0[2], v0[3]); w.z = cvt_pk_bf16(v1[0], v1[1]); w.w = cvt_pk_bf16(v1[2], v1[3]);
                        *(u32x4*)(rowp + bj * HALF) = w; }
                    part += __shfl_xor(part, 16); part += __shfl_xor(part, 32); pts[ai][m] = part; }
            if (fq == 0) {
#pragma unroll
                for (int ai = 0; ai < 2; ++ai)
#pragma unroll
                    for (int m = 0; m < 4; ++m) atomicAdd(sq + row0 + ai * HALF + m * 16, ssq_fix(pts[ai][m])); }
        } else if (wc == 0) {
#pragma unroll
            for (int aq = 0; aq < 4; ++aq) { const int ai = aq >> 1, mb = (aq & 1) * 2; f32x4 ct[4][2], st[4][2];
#pragma unroll
                for (int m = mb; m < mb + 2; ++m) { const size_t to = (size_t)(row0 + ai * HALF + m * 16) * 32 + 8 * fq;
                    ct[m][0] = *(const f32x4*)(cosT + to); ct[m][1] = *(const f32x4*)(cosT + to + 4); st[m][0] = *(const f32x4*)(sinT + to); st[m][1] = *(const f32x4*)(sinT + to + 4); }
#pragma unroll
                for (int m = mb; m < mb + 2; ++m) { const int row = row0 + ai * HALF + m * 16; const float s = sc[ai][m];
                    const f32x4 a0 = acc[ai][0][m][0] * s, a1 = acc[ai][0][m][1] * s, b0 = acc[ai][1][m][0] * s, b1 = acc[ai][1][m][1] * s;
                    const f32x4 x0 = a0 * ct[m][0] - b0 * st[m][0], x1 = a1 * ct[m][1] - b1 * st[m][1], y0 = b0 * ct[m][0] + a0 * st[m][0], y1 = b1 * ct[m][1] + a1 * st[m][1];
                    bf16_t* rp = KR + (size_t)row * DROPE + 8 * fq;
                    u32x4 w; w.x = cvt_pk_bf16(x0[0], x0[1]); w.y = cvt_pk_bf16(x0[2], x0[3]); w.z = cvt_pk_bf16(x1[0], x1[1]); w.w = cvt_pk_bf16(x1[2], x1[3]);
                    *(u32x4*)rp = w;
                    w.x = cvt_pk_bf16(y0[0], y0[1]); w.y = cvt_pk_bf16(y0[2], y0[3]); w.z = cvt_pk_bf16(y1[0], y1[1]); w.w = cvt_pk_bf16(y1[2], y1[3]);
                    *(u32x4*)(rp + 32) = w; } }
        }
    }
};
struct EpiQ {
    static constexpr bool PERM = true;
    bf16_t* Q; const float* cosT; const float* sinT; const ssq_t* rs;
    __device__ __forceinline__ void operator()(const f32x4 (&acc)[2][2][4][2], const Unit& u, int wr, int wc, int fr, int fq) const {
        const int row0 = u.orow + launder_v(wr * 64 + fr);
        float sc[2][4]; ssq_t rq[2][4];
#pragma unroll
        for (int ai = 0; ai < 2; ++ai)
#pragma unroll
            for (int m = 0; m < 4; ++m) rq[ai][m] = rs[row0 + ai * HALF + m * 16];
#pragma unroll
        for (int ai = 0; ai < 2; ++ai)
#pragma unroll
            for (int m = 0; m < 4; ++m) sc[ai][m] = rstd_n(rq[ai][m], 1.0f / QLR);
        if (u.pn < 2) {
            const int h = 4 * u.pn + wc;
#pragma unroll
            for (int aq = 0; aq < 4; ++aq) { const int ai = aq >> 1, mb = (aq & 1) * 2; f32x4 ct[4][2], st[4][2];
#pragma unroll
                for (int m = mb; m < mb + 2; ++m) { const size_t to = (size_t)(row0 + ai * HALF + m * 16) * 32 + 8 * fq;
                    ct[m][0] = *(const f32x4*)(cosT + to); ct[m][1] = *(const f32x4*)(cosT + to + 4); st[m][0] = *(const f32x4*)(sinT + to); st[m][1] = *(const f32x4*)(sinT + to + 4); }
#pragma unroll
                for (int m = mb; m < mb + 2; ++m) { const int row = row0 + ai * HALF + m * 16; const float s = sc[ai][m];
                    const f32x4 a0 = acc[ai][0][m][0] * s, a1 = acc[ai][0][m][1] * s, b0 = acc[ai][1][m][0] * s, b1 = acc[ai][1][m][1] * s;
                    const f32x4 x0 = a0 * ct[m][0] - b0 * st[m][0], x1 = a1 * ct[m][1] - b1 * st[m][1], y0 = b0 * ct[m][0] + a0 * st[m][0], y1 = b1 * ct[m][1] + a1 * st[m][1];
                    bf16_t* rp = Q + (size_t)row * NQ + h * DQH + DNOPE + 8 * fq;
                    u32x4 w; w.x = cvt_pk_bf16(x0[0], x0[1]); w.y = cvt_pk_bf16(x0[2], x0[3]); w.z = cvt_pk_bf16(x1[0], x1[1]); w.w = cvt_pk_bf16(x1[2], x1[3]);
                    *(u32x4*)rp = w;
                    w.x = cvt_pk_bf16(y0[0], y0[1]); w.y = cvt_pk_bf16(y0[2], y0[3]); w.z = cvt_pk_bf16(y1[0], y1[1]); w.w = cvt_pk_bf16(y1[2], y1[3]);
                    *(u32x4*)(rp + 32) = w; } }
        } else {
#pragma unroll
            for (int ai = 0; ai < 2; ++ai)
#pragma unroll
                for (int m = 0; m < 4; ++m) { const int row = row0 + ai * HALF + m * 16; const float s = sc[ai][m];
#pragma unroll
                    for (int bj = 0; bj < 2; ++bj) { const int h = 2 * (u.pn - 2) + bj; const f32x4 v0 = acc[ai][bj][m][0] * s, v1 = acc[ai][bj][m][1] * s;
                        u32x4 w; w.x = cvt_pk_bf16(v0[0], v0[1]); w.y = cvt_pk_bf16(v0[2], v0[3]); w.z = cvt_pk_bf16(v1[0], v1[1]); w.w = cvt_pk_bf16(v1[2], v1[3]);
                        *(u32x4*)(Q + (size_t)row * NQ + h * DQH + wc * 32 + 8 * fq) = w; } }
        }
    }
};

__device__ __forceinline__ unsigned gather_off(const Unit& u, int idx, unsigned lda_b, unsigned cb) { const int tok = idx < u.nrows ? u.rows[idx] : 0; return (unsigned)tok * lda_b + cb; }
__device__ __forceinline__ u32x4 gather_offs(const Unit& u, int tid, unsigned lda_b) {
    const int t2 = launder_v(tid); int R0, C0, R1, C1; stage_rc(t2 * 16, R0, C0); stage_rc(t2 * 16 + 8192, R1, C1);
    u32x4 pk; pk.x = gather_off(u, R0, lda_b, (unsigned)C0 * 2u); pk.y = gather_off(u, R1, lda_b, (unsigned)C1 * 2u); pk.z = gather_off(u, HALF + R0, lda_b, (unsigned)C0 * 2u); pk.w = gather_off(u, HALF + R1, lda_b, (unsigned)C1 * 2u);
    return pk;
}
typedef int i32x4 __attribute__((ext_vector_type(4)));
typedef int i32x8 __attribute__((ext_vector_type(8)));
template <class Epi, class Sched, bool GATHER, bool FP8 = false>
__device__ __forceinline__ void gemm_phase(LAS unsigned char* lds, const unsigned lda_b, const unsigned ldb_b, const int Kb, const Sched& S, const Epi& E, const unsigned stag_ticks = 0u) {
    if (stag_ticks) { const unsigned long long t0 = __builtin_amdgcn_s_memrealtime(), dl = (unsigned long long)((blockIdx.x >> 3) & 3u) * stag_ticks;
        while (__builtin_amdgcn_s_memrealtime() - t0 < dl) __builtin_amdgcn_s_sleep(8); }
    const int tid = launder_v((int)threadIdx.x), wid = __builtin_amdgcn_readfirstlane(tid >> 6), lane = tid & 63, wr = wid >> 2, wc = wid & 3, fr = lane & 15, fq = lane >> 4;
    int nt = Kb / (BK * 2); asm volatile("" : "+s"(nt));
    unsigned voffA[2], voffB[2];
#pragma unroll
    for (int i = 0; i < 2; ++i) { int R, C; stage_rc(tid * 16 + i * 8192, R, C); const int Rb = Epi::PERM ? ((R & ~31) + perm32(R & 31)) : R;
        voffA[i] = (unsigned)R * lda_b + (unsigned)C * 2u; voffB[i] = (unsigned)Rb * ldb_b + (unsigned)C * 2u; }
    const size_t kstep = (size_t)(BK * 2);
    const size_t hstepA = (size_t)HALF * lda_b, hstepB = (size_t)HALF * ldb_b;
    const unsigned ldsw = (unsigned)wid * 1024u, ldsbase = (unsigned)__builtin_amdgcn_readfirstlane((int)(unsigned)(size_t)lds);
    const int aoff = lds_byte(wr * 64 + fr, fq * 8), boff = lds_byte(wc * 32 + fr, fq * 8);
    unsigned cv0[2] = {0u, 0u}, cv1[2] = {0u, 0u}, nv0[2] = {0u, 0u}, nv1[2] = {0u, 0u};
#define PG8_SA(b, h) (((b) * 2 + (h)) * HTB)
#define PG8_SB(b, h) ((4 + (b) * 2 + (h)) * HTB)
#define PG8_LOAD16(sbase, voff, ldsoff) do { unsigned _keep; asm volatile("s_mov_b32 %0, m0\n\ts_mov_b32 m0, %3\n\ts_nop 0\n\tglobal_load_lds_dwordx4 %1, %2\n\ts_mov_b32 m0, %0" \
        : "=&s"(_keep) : "v"(voff), "s"(sbase), "s"(ldsbase + (unsigned)(ldsoff)) : "memory"); } while (0)
#define PG8_STAGE_B(bufoff, gbase, h) do { _Pragma("unroll") for (int _i = 0; _i < 2; ++_i) PG8_LOAD16((gbase) + (h) * hstepB, voffB[_i], (bufoff) + ldsw + _i * 8192); } while (0)
#define PG8_STAGE_A(bufoff, gbase, h, usenext) do { _Pragma("unroll") for (int _i = 0; _i < 2; ++_i) { unsigned _vo; \
        if constexpr (GATHER) { _vo = (usenext) ? ((h) ? nv1[_i] : nv0[_i]) : ((h) ? cv1[_i] : cv0[_i]); PG8_LOAD16((gbase), _vo, (bufoff) + ldsw + _i * 8192); } \
        else { PG8_LOAD16((gbase) + (h) * hstepA, voffA[_i], (bufoff) + ldsw + _i * 8192); } } } while (0)
#define PG8_LD32(off) __builtin_shufflevector(*(const LAS i32x4*)(lds + (off)), *(const LAS i32x4*)(lds + (off) + 1024), 0, 1, 2, 3, 4, 5, 6, 7)
#define PG8_LDA(dst, b, h) do { _Pragma("unroll") for (int m = 0; m < 4; ++m) { if constexpr (FP8) { dst##8[m] = PG8_LD32(PG8_SA(b, h) + aoff + m * 2048); } else { _Pragma("unroll") for (int k = 0; k < 2; ++k) dst[m][k] = *(const LAS bf16x8*)(lds + PG8_SA(b, h) + aoff + m * 2048 + k * 1024); } } } while (0)
#define PG8_LDB(dst, b, h) do { _Pragma("unroll") for (int n = 0; n < 2; ++n) { if constexpr (FP8) { dst##8[n] = PG8_LD32(PG8_SB(b, h) + boff + n * 2048); } else { _Pragma("unroll") for (int k = 0; k < 2; ++k) dst[n][k] = *(const LAS bf16x8*)(lds + PG8_SB(b, h) + boff + n * 2048 + k * 1024); } } } while (0)
#define PG8_MMA(ai, bj, At, Bt) do { __builtin_amdgcn_s_setprio(1); _Pragma("unroll") for (int m = 0; m < 4; ++m) _Pragma("unroll") for (int n = 0; n < 2; ++n) { \
        if constexpr (FP8) { asm volatile("v_mfma_f32_16x16x128_f8f6f4 %0, %1, %2, %0" : "+v"(acc[ai][bj][m][n]) : "v"(Bt##8[n]), "v"(At##8[m])); }     \
        else { _Pragma("unroll") for (int k = 0; k < 2; ++k) acc[ai][bj][m][n] = __builtin_amdgcn_mfma_f32_16x16x32_bf16(Bt[n][k], At[m][k], acc[ai][bj][m][n], 0, 0, 0); } } \
        __builtin_amdgcn_s_setprio(0); } while (0)
#define PG8_WAIT_V(n) asm volatile("s_waitcnt vmcnt(" #n ")" ::: "memory")
#define PG8_WAIT_L(n) asm volatile("s_waitcnt lgkmcnt(" #n ")" ::: "memory")
#define PG8_BAR __builtin_amdgcn_s_barrier()
#define PG8_SCHED __builtin_amdgcn_sched_barrier(0)
    Unit cur, nxt; int ui = 0;
    (void)S.next(0, cur);
    f32x4 acc[2][2][4][2];
#pragma unroll
    for (int a = 0; a < 2; ++a)
#pragma unroll
        for (int b = 0; b < 2; ++b)
#pragma unroll
            for (int m = 0; m < 4; ++m)
#pragma unroll
                for (int n = 0; n < 2; ++n) acc[a][b][m][n] = (f32x4){0.f, 0.f, 0.f, 0.f};
    bf16x8 At[4][2], B0[2][2], B1[2][2]; i32x8 At8[4], B08[2], B18[2];
    const char* cA = cur.a; const char* cB = cur.b;
    if constexpr (GATHER) { const u32x4 pk = gather_offs(cur, tid, lda_b); cv0[0] = pk.x; cv0[1] = pk.y; cv1[0] = pk.z; cv1[1] = pk.w; }
    PG8_STAGE_B(PG8_SB(0, 0), cB, 0); PG8_SCHED; PG8_STAGE_B(PG8_SB(0, 1), cB, 1); PG8_SCHED; PG8_STAGE_A(PG8_SA(0, 0), cA, 0, false); PG8_SCHED; PG8_STAGE_A(PG8_SA(0, 1), cA, 1, false);
    if (wr == 1) PG8_BAR;
    PG8_WAIT_V(2); PG8_BAR;
    PG8_STAGE_B(PG8_SB(1, 0), cB + kstep, 0); PG8_SCHED; PG8_STAGE_A(PG8_SA(1, 0), cA + kstep, 0, false); PG8_SCHED; PG8_STAGE_B(PG8_SB(1, 1), cB + kstep, 1);
    PG8_WAIT_V(6); PG8_BAR;
    for (;;) {
        int has_next = 0; const char* nA = cA; const char* nB = cB;
        if constexpr (GATHER) { has_next = __builtin_amdgcn_readfirstlane(S.next(ui + 1, nxt) ? 1 : 0); nA = has_next ? nxt.a : cA; nB = has_next ? nxt.b : cB; }
        if constexpr (GATHER) {
            u32x4 pk = (u32x4){cv0[0], cv0[1], cv1[0], cv1[1]}; if (has_next) pk = gather_offs(nxt, tid, lda_b);
            *(LAS u32x4*)(lds + STAGE_BYTES + 1024 + tid * 16) = pk;
        }
#pragma nounroll
        for (int t = 0; t < nt; t += 2) {
            const bool last = (t == nt - 2);
            if constexpr (!GATHER) { if (last) { int uin = ui + 1; asm volatile("" : "+s"(uin)); has_next = __builtin_amdgcn_readfirstlane(S.next(uin, nxt) ? 1 : 0); nA = has_next ? nxt.a : cA; nB = has_next ? nxt.b : cB; } }
            if constexpr (GATHER) { if (last) { const u32x4 pk = *(const LAS u32x4*)(lds + STAGE_BYTES + 1024 + tid * 16); nv0[0] = pk.x; nv0[1] = pk.y; nv1[0] = pk.z; nv1[1] = pk.w; } }
            const char* a1 = cA + (size_t)(t + 1) * kstep;
            const char* a2 = last ? nA : cA + (size_t)(t + 2) * kstep; const char* b2 = last ? nB : cB + (size_t)(t + 2) * kstep;
            const char* a3 = a2 + kstep; const char* b3 = b2 + kstep;
            PG8_LDB(B0, 0, 0); PG8_LDB(B1, 0, 1); PG8_SCHED; PG8_LDA(At, 0, 0); PG8_STAGE_A(PG8_SA(1, 1), a1, 1, false);
            PG8_WAIT_V(8); PG8_WAIT_L(0); PG8_BAR; PG8_MMA(0, 0, At, B0); PG8_MMA(0, 1, At, B1); PG8_BAR; PG8_SCHED;
            PG8_LDA(At, 0, 1); PG8_STAGE_B(PG8_SB(0, 0), b2, 0); PG8_STAGE_B(PG8_SB(0, 1), b2, 1); PG8_STAGE_A(PG8_SA(0, 0), a2, 0, last);
            PG8_WAIT_V(8); PG8_WAIT_L(0); PG8_BAR; PG8_MMA(1, 0, At, B0); PG8_MMA(1, 1, At, B1); PG8_BAR; PG8_SCHED;
            PG8_LDB(B0, 1, 0); PG8_LDB(B1, 1, 1); PG8_SCHED; PG8_LDA(At, 1, 0); PG8_STAGE_A(PG8_SA(0, 1), a2, 1, last);
            PG8_WAIT_V(8); PG8_WAIT_L(0); PG8_BAR; PG8_MMA(0, 0, At, B0); PG8_MMA(0, 1, At, B1); PG8_BAR; PG8_SCHED;
            PG8_LDA(At, 1, 1); PG8_STAGE_B(PG8_SB(1, 0), b3, 0); PG8_STAGE_B(PG8_SB(1, 1), b3, 1); PG8_STAGE_A(PG8_SA(1, 0), a3, 0, last);
            PG8_WAIT_V(8); PG8_WAIT_L(0); PG8_BAR; PG8_MMA(1, 0, At, B0); PG8_MMA(1, 1, At, B1); PG8_BAR; PG8_SCHED;
        }
        if (wr == 0) PG8_BAR;
        if constexpr (FP8) asm volatile("s_nop 15\n\ts_nop 15" ::: "memory");
        E(acc, cur, wr, wc, fr, fq);
        if (!has_next) break;
#pragma unroll
        for (int a = 0; a < 2; ++a)
#pragma unroll
            for (int b = 0; b < 2; ++b)
#pragma unroll
                for (int m = 0; m < 4; ++m)
#pragma unroll
                    for (int n = 0; n < 2; ++n) acc[a][b][m][n] = (f32x4){0.f, 0.f, 0.f, 0.f};
        cur = nxt; cA = nA; cB = nB; ++ui;
        if constexpr (GATHER) {
#pragma unroll
            for (int i = 0; i < 2; ++i) { cv0[i] = nv0[i]; cv1[i] = nv1[i]; }
        }
        if (wr == 1) PG8_BAR;
    }
    PG8_WAIT_V(0);
    PG8_BAR;
#undef PG8_SA
#undef PG8_SB
#undef PG8_LOAD16
#undef PG8_STAGE_A
#undef PG8_STAGE_B
#undef PG8_LDA
#undef PG8_LDB
#undef PG8_LD32
#undef PG8_MMA
#undef PG8_WAIT_V
#undef PG8_WAIT_L
#undef PG8_BAR
#undef PG8_SCHED
}
}
namespace att {
constexpr int NW = 8, QBLK = 32, KVBLK = 64, QB = NW * QBLK;
constexpr int DQK = 192, DV = 128;
constexpr int QS = NQ, KNS = NKV, KRS = DROPE, OS = DM;
constexpr int SHM_V = KVBLK * DV * 2, SHM_K = KVBLK * DQK * 2;
constexpr int LDS_QR = 2 * SHM_V + 2 * SHM_K + NW * 64 * 4;
constexpr int LDS_BYTES = LDS_QR + NW * 4096;
constexpr float SCALE = 0.07216878364870322f;
constexpr float THR = 8.f;
#define KSWZ(row, ch) ((row) * 384 + ((((ch) ^ (((row) >> 1) & 7))) << 4))
#define SBAR() __builtin_amdgcn_sched_barrier(0)
__device__ __forceinline__ int v_st(int k, int c) { const int kk = (k & ~0xC) | ((k & 4) << 1) | ((k & 8) >> 1); return ((kk >> 3) * 4 + (c >> 5)) * 512 + ((kk & 7) * 32 + (c & 31)) * 2; }
__device__ __forceinline__ int v_rd_base(int lane) { return ((lane & 3) << 3) | (((lane >> 2) & 3) << 6) | (((lane >> 4) & 1) << 5) | (((lane >> 5) & 1) << 8); }
constexpr int v_rd_off(int d0, int ks, int half) { return d0 * 512 + ks * 4096 + half * 2048; }
__device__ __forceinline__ int crow(int r, int hi) { return (r & 3) + 8 * (r >> 2) + 4 * hi; }
__device__ __forceinline__ void mask_tile(f32x16& p0, f32x16& p1, int dq) {
    const float NEG = -__builtin_inff();
#pragma unroll
    for (int r = 0; r < 16; ++r) {
        const int c = (r & 3) + 8 * (r >> 2);
        if (dq - c < 0) p0[r] = NEG;
        if (dq - c - 32 < 0) p1[r] = NEG;
    }
}
__device__ __forceinline__ void partialSM(f32x16& p0, f32x16& p1, float& m_reg, float& mn, float& alpha) {
    float pmax = p0[0]; for (int r = 1; r < 16; ++r) pmax = fmaxf(pmax, p0[r]); for (int r = 0; r < 16; ++r) pmax = fmaxf(pmax, p1[r]);
    { auto rr = __builtin_amdgcn_permlane32_swap(__float_as_uint(pmax), __float_as_uint(pmax), false, false);
      pmax = fmaxf(__uint_as_float(rr[0]), __uint_as_float(rr[1])); }
    constexpr float C2 = 1.4426950408889634f * SCALE;
    if (__builtin_expect(__all((pmax - m_reg) * SCALE <= THR), 1)) { mn = m_reg; alpha = 1.f; }
    else { mn = fmaxf(m_reg, pmax); alpha = __builtin_amdgcn_exp2f((m_reg - mn) * C2); m_reg = mn; }
    const float mnL = -mn * C2;
    for (int r = 0; r < 16; ++r) p0[r] = fmaf(p0[r], C2, mnL); for (int r = 0; r < 16; ++r) p1[r] = fmaf(p1[r], C2, mnL);
    for (int r = 0; r < 16; ++r) p0[r] = __builtin_amdgcn_exp2f(p0[r]);
}
__device__ __forceinline__ void finishSM(f32x16& p0, f32x16& p1, float alpha, float& l_reg, bf16x8& pa0, bf16x8& pa1, bf16x8& pa2, bf16x8& pa3) {
    for (int r = 0; r < 16; ++r) p1[r] = __builtin_amdgcn_exp2f(p1[r]);
    float ps = 0; for (int r = 0; r < 16; ++r) ps += p0[r]; for (int r = 0; r < 16; ++r) ps += p1[r];
    { auto rr = __builtin_amdgcn_permlane32_swap(__float_as_uint(ps), __float_as_uint(ps), false, false);
      ps = __uint_as_float(rr[0]) + __uint_as_float(rr[1]); }
    l_reg = l_reg * alpha + ps;
#define PK4(P, B_, OUT) do { unsigned a0 = cvt_pk_bf16(P[B_+0], P[B_+1]), a1 = cvt_pk_bf16(P[B_+2], P[B_+3]);                          \
        unsigned b0 = cvt_pk_bf16(P[B_+4], P[B_+5]), b1 = cvt_pk_bf16(P[B_+6], P[B_+7]);                                             \
        auto r0 = __builtin_amdgcn_permlane32_swap(a0, b0, false, false); auto r1 = __builtin_amdgcn_permlane32_swap(a1, b1, false, false); \
        u32x4 w = {r0[0], r1[0], r0[1], r1[1]}; OUT = *reinterpret_cast<bf16x8*>(&w); } while (0)
    PK4(p0, 0, pa0); PK4(p0, 8, pa1); PK4(p1, 0, pa2); PK4(p1, 8, pa3);
#undef PK4
}
template <int KB>
__device__ __forceinline__ void qkt(f32x16& p0, f32x16& p1, const char* K_lds, int r32, int hi, const bf16x8* qr, const char* qrl) {
    p0 = f32x16{}; p1 = f32x16{};
    const char* kb[4];
#pragma unroll
    for (int dd = 0; dd < 4; ++dd) kb[dd] = K_lds + KB * SHM_K + KSWZ(r32, dd * 2 + hi);
#pragma unroll
    for (int d0 = 0; d0 < 12; ++d0) { const char* a = kb[d0 & 3] + (d0 >> 2) * 128;
        bf16x8 b0 = *reinterpret_cast<const bf16x8*>(a);
        bf16x8 b1 = *reinterpret_cast<const bf16x8*>(a + 32 * 384);
        const bf16x8 qf = d0 < 8 ? qr[d0 & 7] : *reinterpret_cast<const bf16x8*>(qrl + (d0 - 8) * 1024);
        p0 = __builtin_amdgcn_mfma_f32_32x32x16_bf16(b0, qf, p0, 0, 0, 0);
        p1 = __builtin_amdgcn_mfma_f32_32x32x16_bf16(b1, qf, p1, 0, 0, 0);
        if ((d0 & 3) == 3 && d0 < 11) SBAR(); }
}
template <int VB>
__device__ __forceinline__ void pv_tile(f32x16* o, int vb0, bf16x8 pa0, bf16x8 pa1, bf16x8 pa2, bf16x8 pa3) {
#define TRRD(dst, off) asm volatile("ds_read_b64_tr_b16 %0, %1 offset:%2" : "=&v"(dst) : "v"(vb0), "i"(off) : "memory")
#define PV_D0(d0) do { s16x4 l0, l1, l2, l3, h0, h1, h2, h3; constexpr int b_ = VB * SHM_V + v_rd_off(d0, 0, 0); \
        TRRD(l0, b_); TRRD(h0, b_ + 2048); TRRD(l1, b_ + 4096); TRRD(h1, b_ + 6144); TRRD(l2, b_ + 8192); TRRD(h2, b_ + 10240); TRRD(l3, b_ + 12288); TRRD(h3, b_ + 14336); \
        asm volatile("s_waitcnt lgkmcnt(0)" ::: "memory"); SBAR();   \
        o[d0] = __builtin_amdgcn_mfma_f32_32x32x16_bf16(pa0, (bf16x8){l0[0], l0[1], l0[2], l0[3], h0[0], h0[1], h0[2], h0[3]}, o[d0], 0, 0, 0);   \
        o[d0] = __builtin_amdgcn_mfma_f32_32x32x16_bf16(pa1, (bf16x8){l1[0], l1[1], l1[2], l1[3], h1[0], h1[1], h1[2], h1[3]}, o[d0], 0, 0, 0);   \
        o[d0] = __builtin_amdgcn_mfma_f32_32x32x16_bf16(pa2, (bf16x8){l2[0], l2[1], l2[2], l2[3], h2[0], h2[1], h2[2], h2[3]}, o[d0], 0, 0, 0);   \
        o[d0] = __builtin_amdgcn_mfma_f32_32x32x16_bf16(pa3, (bf16x8){l3[0], l3[1], l3[2], l3[3], h3[0], h3[1], h3[2], h3[3]}, o[d0], 0, 0, 0); } while (0)
    PV_D0(0); PV_D0(1); PV_D0(2); PV_D0(3);
#undef PV_D0
#undef TRRD
}
struct BlockRef { const bf16_t* Q; const bf16_t* Kn; const bf16_t* Kr; const bf16_t* V; bf16_t* O; int P0; };
struct Seam { bf16x8 qr[8]; bf16x8 st_v0, st_v1, st_k0, st_k1, st_k2; };
#define VMW() asm volatile("s_waitcnt vmcnt(0)" ::: "memory")
#define VMWN(n) asm volatile("s_waitcnt vmcnt(%0)" :: "i"(n) : "memory")
#define LD8(p) (*reinterpret_cast<const bf16x8*>(p))
#define SLOAD_H(R_, k0) do { S.st_v0 = LD8((R_).V + (size_t)((k0) + sr) * KNS + sc); S.st_v1 = LD8((R_).V + (size_t)((k0) + 32 + sr) * KNS + sc);              \
                             S.st_k0 = LD8((R_).Kn + (size_t)((k0) + sr) * KNS + sc); S.st_k1 = LD8((R_).Kn + (size_t)((k0) + 32 + sr) * KNS + sc);            \
                             S.st_k2 = LD8((R_).Kr + (size_t)((k0) + rr) * KRS + rc); } while (0)
#define SWRITE_HK(bf) do { *(bf16x8*)(K_lds + (bf) * SHM_K + kws) = S.st_k0; *(bf16x8*)(K_lds + (bf) * SHM_K + kws + 32 * 384) = S.st_k1; *(bf16x8*)(K_lds + (bf) * SHM_K + kws2) = S.st_k2; } while (0)
#define SWRITE_HV(bf) do { *(bf16x8*)(V_lds + (bf) * SHM_V + vst0) = S.st_v0; *(bf16x8*)(V_lds + (bf) * SHM_V + vst1) = S.st_v1; } while (0)
#define SWRITE_H(bf) do { SWRITE_HV(bf); SWRITE_HK(bf); } while (0)
#define ATT_IDX const int tid = launder_v((int)threadIdx.x), wid = __builtin_amdgcn_readfirstlane(tid >> 6), lane = tid & 63, r32 = lane & 31, hi = lane >> 5; \
    const int sr = tid >> 4, sc = (tid & 15) * 8, rr = tid >> 3, rc = (tid & 7) * 8, kws = KSWZ(sr, (tid & 15)), kws2 = KSWZ(rr, 16 + (tid & 7));
__device__ __forceinline__ void attn_block(const BlockRef& cur, char* lds) {
    ATT_IDX;
    Seam S;
    const int NT = cur.P0 / KVBLK + QB / KVBLK;
    const int qlo = cur.P0 + wid * QBLK, qm = qlo + r32 - 4 * hi;
    char* V_lds = lds; char* K_lds = lds + 2 * SHM_V;
    float* ws = (float*)(lds + 2 * SHM_V + 2 * SHM_K) + wid * 64; float* li_l = ws, * al_l = ws + 32;
    float m_reg = -1e30f, l_reg = 0; f32x16 o[4] = {};
    const int vst0 = v_st(sr, sc), vst1 = v_st(32 + sr, sc);
    const int vb0 = (int)(uintptr_t)V_lds + v_rd_base(lane);
    char* qrl = lds + LDS_QR + wid * 4096 + lane * 16;
#define RESC(a) do { if (__any((a) < 1.f)) { if (hi == 0) al_l[r32] = (a); asm volatile("s_waitcnt lgkmcnt(0)" ::: "memory");              \
                     for (int d_ = 0; d_ < 4; ++d_) for (int r = 0; r < 16; ++r) o[d_][r] *= al_l[crow(r, hi)]; } } while (0)
#define KBASE(t) ((t) * KVBLK)
#define MASKT(P0_, P1_, t) do { const int kb_ = KBASE(t); if (kb_ + KVBLK - 1 > qlo) mask_tile(P0_, P1_, qm - kb_); } while (0)
    SLOAD_H(cur, 0);
#pragma unroll
    for (int d0 = 0; d0 < 8; ++d0) S.qr[d0] = LD8(cur.Q + (size_t)(wid * QBLK + r32) * QS + d0 * 16 + hi * 8);
    { bf16x8 t0 = LD8(cur.Q + (size_t)(wid * QBLK + r32) * QS + 128 + hi * 8), t1 = LD8(cur.Q + (size_t)(wid * QBLK + r32) * QS + 144 + hi * 8),
             t2 = LD8(cur.Q + (size_t)(wid * QBLK + r32) * QS + 160 + hi * 8), t3 = LD8(cur.Q + (size_t)(wid * QBLK + r32) * QS + 176 + hi * 8);
      *(bf16x8*)(qrl) = t0; *(bf16x8*)(qrl + 1024) = t1; *(bf16x8*)(qrl + 2048) = t2; *(bf16x8*)(qrl + 3072) = t3; }
    VMW(); SWRITE_H(0);
    __syncthreads();
    f32x16 p0, p1; float mn, al; bf16x8 pa0, pa1, pa2, pa3;
#define TILE_STEP(t, BF) do {                                                                                                 \
        if ((t) + 1 < NT) { SLOAD_H(cur, KBASE((t) + 1)); }                                                                    \
        SBAR();                                                                                                               \
        if (KBASE(t) <= qlo + QBLK - 1) {     \
        qkt<BF>(p0, p1, K_lds, r32, hi, S.qr, qrl);                                                                           \
        MASKT(p0, p1, (t)); partialSM(p0, p1, m_reg, mn, al); RESC(al);                                                        \
        finishSM(p0, p1, al, l_reg, pa0, pa1, pa2, pa3); SBAR();                                                              \
        pv_tile<BF>(o, vb0, pa0, pa1, pa2, pa3); }                                                                            \
        if ((t) + 1 < NT) { VMW(); SWRITE_H(1 - BF); }                                                                         \
        __syncthreads(); } while (0)
    for (int t = 0; t < NT; t += 2) { TILE_STEP(t, 0); TILE_STEP(t + 1, 1); }
    if (hi == 0) li_l[r32] = l_reg; asm volatile("s_waitcnt lgkmcnt(0)" ::: "memory");
    float rli[16];
#pragma unroll
    for (int r = 0; r < 16; ++r) rli[r] = __builtin_amdgcn_rcpf(li_l[crow(r, hi)]);
    bf16_t* Ow = cur.O + (size_t)(wid * QBLK) * OS;
#pragma unroll
    for (int r = 0; r < 16; ++r) { const int orow = crow(r, hi);
#pragma unroll
        for (int d0 = 0; d0 < 4; ++d0) { const float v = o[d0][r] * rli[r];
            const float vn = __shfl_xor(v, 1);
            if ((r32 & 1) == 0) *(unsigned*)(Ow + (size_t)orow * OS + d0 * 32 + r32) = cvt_pk_bf16(v, vn); } }
    __syncthreads();
#undef RESC
#undef KBASE
#undef MASKT
#undef TILE_STEP
}
#undef VMW
#undef VMWN
#undef LD8
#undef SLOAD_H
#undef SWRITE_HK
#undef SWRITE_HV
#undef SWRITE_H
#undef ATT_IDX
#undef KSWZ
#undef SBAR

__device__ __forceinline__ BlockRef make_ref(int L, int pass, const bf16_t* Qb, const bf16_t* KNVb, const bf16_t* KRb, bf16_t* Ob) {
    const int bh = L >> 2, x = L & 3, qb = pass ? 7 - x : x, b = bh >> 3, h = bh & 7; const size_t rb = (size_t)b * SEQ;
    BlockRef r; r.Q = Qb + (rb + (size_t)qb * QB) * QS + h * DQH; r.Kn = KNVb + rb * KNS + h * (DNOPE + DVH); r.Kr = KRb + rb * KRS; r.V = KNVb + rb * KNS + h * (DNOPE + DVH) + DNOPE;
    r.O = Ob + (rb + (size_t)qb * QB) * OS + h * DVH; r.P0 = qb * QB; return r;
}
__device__ __forceinline__ void attn_phase(char* lds, const bf16_t* Qb, const bf16_t* KNVb, const bf16_t* KRb, bf16_t* Ob, int first, int stride) {
    constexpr int total = NBATCH * NHEAD * 4;
    for (int L = first; L < total; L += stride) {
        for (int pass = 0; pass < 2; ++pass) { const BlockRef cur = make_ref(L, pass, Qb, KNVb, KRb, Ob); attn_block(cur, lds); }
    }
}
}
constexpr int NWAVES = 8;
constexpr size_t MiB = 1u << 20;
constexpr size_t WS_CTL = 0, CTL_ZERO_BYTES = 8 * MiB;
constexpr size_t WS_SSQ = 1 * MiB;
constexpr size_t WS_COS = 8 * MiB, WS_SIN = 16 * MiB;
constexpr size_t WS_LIST = 24 * MiB;
constexpr size_t WS_RSL = 26 * MiB;
constexpr size_t WS_TOKINFO = 28 * MiB;
constexpr size_t WS_WDN = 30 * MiB, WS_WUQ = 34 * MiB, WS_WUKV = 37 * MiB, WS_WO = 39 * MiB, WS_WPOOL = 43 * MiB, WS_WGU = 44 * MiB, WS_WD = 65 * MiB, WS_MWGU = 76 * MiB, WS_MWD = 164 * MiB;
constexpr size_t WS_H = 208 * MiB;
constexpr size_t WS_ACT = 336 * MiB;
constexpr size_t WS_DOWN = WS_ACT;
constexpr size_t WS_CQN = WS_ACT + 128 * MiB, WS_CKVN = WS_ACT + 192 * MiB, WS_KR = WS_ACT + 224 * MiB, WS_Q = WS_ACT + 232 * MiB, WS_KNV = WS_ACT + 424 * MiB;
constexpr size_t WS_HID = WS_ACT;
constexpr size_t WS_YB = WS_ACT + 358 * MiB;
constexpr size_t WS_DUMMY = WS_ACT + 424 * MiB;
constexpr size_t WS_H8 = WS_ACT + 618 * MiB;
constexpr int FFD8 = 2816;
constexpr int FFE8 = 1536;
constexpr size_t WS_END = WS_ACT + 682 * MiB;
static_assert(WS_MWD + (size_t)16 * 1024 * FFEP * 2 <= WS_H && WS_MWGU + (size_t)16 * 2 * FFEP * 1024 * 2 <= WS_MWD && WS_WD + (size_t)2 * 1024 * FFD * 2 <= WS_MWGU && WS_WGU + (size_t)2 * 2 * FFD * 1024 * 2 <= WS_WD, "weights map");
static_assert(WS_HID + (size_t)PSLOT * FFEP * 2 <= WS_YB && WS_YB + (size_t)PSLOT * 1024 * 2 <= WS_END && WS_HID + (size_t)NTOK * FFD * 2 <= WS_END && WS_KNV + (size_t)NTOK * NKV * 2 <= WS_END && WS_Q + (size_t)NTOK * NQ * 2 <= WS_KNV, "activation map");
static_assert(WS_SSQ + (size_t)14 * NTOK * 8 <= WS_COS && WS_COS <= CTL_ZERO_BYTES + WS_COS && WS_END <= 1024 * MiB, "map");
constexpr int CW_TMO = 0, CW_CODE = 1, CW_CNT = 1024  , CW_DBG = 2048, CW_BAR = 4096  ;
constexpr int LDSCTL_OFF = 0, LDSCTL_BYTES = 1024, MISC_OFF = LDSCTL_OFF + 320, RING_OFF = LDSCTL_BYTES, RING_BYTES = 131072, LDS_BYTES = 147456;

typedef GAS unsigned gu32;
#define RLX_AGENT __ATOMIC_RELAXED, __HIP_MEMORY_SCOPE_AGENT
#define LDS_WAIT() asm volatile("s_waitcnt lgkmcnt(0)" ::: "memory")
#define VM_WAIT() asm volatile("s_waitcnt vmcnt(0)" ::: "memory")

#define XB_TMO      128
#define XB_XCNT(j)  (256  + 64 * (j))
#define XB_XSUB(j)  (1280 + 64 * (j))
#define XB_XGEN(j)  (2304 + 64 * (j))
#define XB_TOP      3328
#define XB_TOPGEN   3392
#define XCD_BAR_WORDS 3456
#define XB_SPIN_CAP (1u << 18)
__device__ __forceinline__ unsigned xb_ld(unsigned* p)              { return __hip_atomic_load(p, __ATOMIC_RELAXED, __HIP_MEMORY_SCOPE_AGENT); }
__device__ __forceinline__ unsigned xb_add(unsigned* p, unsigned v) { return __hip_atomic_fetch_add(p, v, __ATOMIC_RELAXED, __HIP_MEMORY_SCOPE_AGENT); }
__device__ __forceinline__ unsigned xb_xcc_id() { return (unsigned)__builtin_amdgcn_s_getreg((3 << 11) | 20) & 0xFu; }
#define XB_SPIN(cond, bar) do { unsigned _sp = 0; while (cond) { __builtin_amdgcn_s_sleep(1); \
    if ((++_sp & 255u) == 0u) { if (xb_ld(&(bar)[XB_TMO])) break; if (_sp > XB_SPIN_CAP) { atomicAdd(&(bar)[XB_TMO], 1u); break; } } } } while (0)
__device__ __forceinline__ unsigned rfl(unsigned v);
struct XcdBarrier { unsigned* bar; unsigned x; volatile LAS unsigned* st; };
__device__ __forceinline__ XcdBarrier xcd_barrier_post(unsigned* bar, volatile LAS unsigned* st) {
    XcdBarrier b; b.bar = bar; b.x = xb_xcc_id(); b.st = st;
    if (threadIdx.x == 0) (void)xb_add(&bar[XB_XCNT(b.x)], 1u);
    return b;
}
__device__ __forceinline__ void xcd_barrier_complete(unsigned* bar, unsigned x, unsigned& nloc, unsigned& nx) {
    const unsigned G = gridDim.x * gridDim.y * gridDim.z;
    unsigned sum, cnt, mine, sp = 0u;
    for (;;) {
        sum = 0u; cnt = 0u; mine = 0u;
#pragma unroll
        for (unsigned j = 0; j < 16; ++j) { const unsigned c = xb_ld(&bar[XB_XCNT(j)]); sum += c; cnt += (c > 0u) ? 1u : 0u; mine = (j == x) ? c : mine; }
        if (sum == G) break;
        __builtin_amdgcn_s_sleep(1);
        if ((++sp & 255u) == 0u) { if (xb_ld(&bar[XB_TMO])) break; if (sp > XB_SPIN_CAP) { atomicAdd(&bar[XB_TMO], 1u); break; } }
    }
    nloc = mine > 0u ? mine : 1u; nx = cnt > 0u ? cnt : 1u;
}
__device__ __forceinline__ void xcd_barrier(const XcdBarrier& b) {
    unsigned* bar; { const volatile LAS unsigned* p_ = b.st + 2; const unsigned lo_ = rfl(p_[0]), hi_ = rfl(p_[1]); bar = (unsigned*)(((unsigned long long)hi_ << 32) | lo_); }
    asm volatile("s_waitcnt vmcnt(0)" ::: "memory");
    __syncthreads();
    if (threadIdx.x == 0) {
        __builtin_amdgcn_s_waitcnt(0);
        unsigned nloc = b.st[0], nx = b.st[1];
        if (nloc == 0u) { xcd_barrier_complete(bar, b.x, nloc, nx); b.st[0] = nloc; b.st[1] = nx; }
        const unsigned old = xb_add(&bar[XB_XSUB(b.x)], 1u);
        const unsigned gen = old / nloc;
        if (old + 1u == (gen + 1u) * nloc) {
            __builtin_amdgcn_fence(__ATOMIC_RELEASE, "agent");
            asm volatile("s_waitcnt vmcnt(0)" ::: "memory");
            const unsigned og = xb_add(&bar[XB_TOP], 1u);
            const unsigned tg = og / nx;
            if (og + 1u == (tg + 1u) * nx) xb_add(&bar[XB_TOPGEN], 1u);
            else XB_SPIN(xb_ld(&bar[XB_TOPGEN]) == tg, bar);
            __builtin_amdgcn_fence(__ATOMIC_ACQUIRE, "agent");
            xb_add(&bar[XB_XGEN(b.x)], 1u);
            asm volatile("s_waitcnt vmcnt(0)" ::: "memory");
        } else {
            XB_SPIN(xb_ld(&bar[XB_XGEN(b.x)]) == gen, bar);
            __builtin_amdgcn_fence(__ATOMIC_ACQUIRE, "agent");
            asm volatile("s_waitcnt vmcnt(0)" ::: "memory");
        }
    }
    __syncthreads();
}

__device__ __forceinline__ unsigned rfl(unsigned v);
__device__ __forceinline__ const float* ptab(LAS unsigned char* L, int i);
struct Frame { LAS unsigned char* lds; volatile LAS unsigned* MISC; gu32* ctl; unsigned char* ws; int tid, lane, wave, vcu, G, bx; };

__device__ __forceinline__ float wave_sum(float v) {
#pragma unroll
    for (int o = 1; o < 64; o <<= 1) v += __shfl_xor(v, o);
    return v;
}
__device__ __forceinline__ unsigned rfl(unsigned v) { return (unsigned)__builtin_amdgcn_readfirstlane((int)v); }

__device__ __forceinline__ int rowmap(int mode, int n) {
    if (mode == 0) return n;
    if (mode == 1) return (n >> 7) * 256 + (n & 127);
    if (mode == 2) return (n >> 7) * 256 + 128 + (n & 127);
    if (mode == 4) return n < 800 ? n : 896 + (n - 800);
    const int h = n / DQH, d = n - h * DQH;
    if (d < DNOPE) return 512 + h * DNOPE + d;
    if (d < DNOPE + 32) return (h >> 2) * 256 + (h & 3) * 32 + (d - DNOPE);
    return (h >> 2) * 256 + 128 + (h & 3) * 32 + (d - DNOPE - 32);
}
__device__ __forceinline__ void transpose_item(const float* W, int N, bf16_t* WT, int ldd, int mode, const float* kscale, const float* nscale, int item, int lane) {
    const int nblk = N / 64, kb = item / nblk, nb = item % nblk, k0 = 64 * kb, n = 64 * nb + lane;
    const float sn = nscale ? nscale[n] : 1.0f;
    const int ksv = __float_as_int(kscale ? kscale[k0 + lane] : 1.0f);
    const float* wp = W + (size_t)k0 * N + n;
    bf16_t* op = WT + (size_t)rowmap(mode, n) * ldd + k0;
    float w[64];
#pragma unroll
    for (int i = 0; i < 64; ++i) w[i] = __builtin_nontemporal_load(wp + (size_t)i * N);
#pragma unroll
    for (int kg = 0; kg < 8; ++kg) { float v[8];
#pragma unroll
        for (int i = 0; i < 8; ++i) { const float sk = __int_as_float(__builtin_amdgcn_readlane(ksv, 8 * kg + i)); v[i] = w[8 * kg + i] * (sk * sn); }
        u32x4 o; o.x = cvt_pk_bf16(v[0], v[1]); o.y = cvt_pk_bf16(v[2], v[3]); o.z = cvt_pk_bf16(v[4], v[5]); o.w = cvt_pk_bf16(v[6], v[7]);
        *(GAS u32x4*)(op + 8 * kg) = o; }
}
__device__ __forceinline__ void transpose_item_f8(const float* W, int N, unsigned char* WT, int ldd, int mode, const float* kscale, int item, int lane) {
    const int nblk = N / 64, kb = item / nblk, nb = item % nblk, k0 = 64 * kb, n = 64 * nb + lane;
    const int ksv = __float_as_int(kscale ? kscale[k0 + lane] : 1.0f);
    const float* wp = W + (size_t)k0 * N + n;
    unsigned char* op = WT + (size_t)rowmap(mode, n) * ldd + k0;
    float w[64];
#pragma unroll
    for (int i = 0; i < 64; ++i) w[i] = __builtin_nontemporal_load(wp + (size_t)i * N);
#pragma unroll
    for (int kg = 0; kg < 4; ++kg) { float v[16];
#pragma unroll
        for (int i = 0; i < 16; ++i) { const float sk = __int_as_float(__builtin_amdgcn_readlane(ksv, 16 * kg + i)); v[i] = w[16 * kg + i] * (sk * pg8::FP8_SW); }
        u32x4 o; o.x = pg8::pk4_fp8(v[0], v[1], v[2], v[3]); o.y = pg8::pk4_fp8(v[4], v[5], v[6], v[7]); o.z = pg8::pk4_fp8(v[8], v[9], v[10], v[11]); o.w = pg8::pk4_fp8(v[12], v[13], v[14], v[15]);
        *(GAS u32x4*)(op + 16 * kg) = o; }
}
struct MatDesc { const float* src; bf16_t* dst; const float* kscale; const float* nscale; int K, N, ldd, mode, f8; };
constexpr int N_MATS = 70;
__device__ __forceinline__ MatDesc mat_desc(int m, LAS unsigned char* L, unsigned char* ws) {
    MatDesc d; d.kscale = nullptr; d.nscale = nullptr; d.mode = 0; d.f8 = 0;
    if (m < 2)       { const int a = m;      d.src = ptab(L, 4) + (size_t)a * DM * NDOWN;    d.K = DM;   d.N = NDOWN; d.dst = (bf16_t*)(ws + WS_WDN) + (size_t)a * NDOWNP * DM;  d.ldd = DM; d.mode = 4; d.kscale = ptab(L, 2) + (size_t)(2 * a) * DM; }
    else if (m < 4)  { const int a = m - 2;  d.src = ptab(L, 6) + (size_t)a * QLR * NQ;      d.K = QLR;  d.N = NQ;    d.dst = (bf16_t*)(ws + WS_WUQ) + (size_t)a * NQ * QLR;     d.ldd = QLR; d.mode = 3; d.kscale = ptab(L, 5) + (size_t)a * QLR; }
    else if (m < 6)  { const int a = m - 4;  d.src = ptab(L, 8) + (size_t)a * KVLR * NKV;    d.K = KVLR; d.N = NKV;   d.dst = (bf16_t*)(ws + WS_WUKV) + (size_t)a * NKV * KVLR;  d.ldd = KVLR; d.kscale = ptab(L, 7) + (size_t)a * KVLR; }
    else if (m < 8)  { const int a = m - 6;  d.src = ptab(L, 9) + (size_t)a * DM * DM;       d.K = DM;   d.N = DM;    d.dst = (bf16_t*)(ws + WS_WO) + (size_t)a * DM * DM;       d.ldd = DM; }
    else if (m < 16) { const int i = m - 8;  d.src = ptab(L, 10) + (size_t)i * 256 * 256;    d.K = 256;  d.N = 256;   d.dst = (bf16_t*)(ws + WS_WPOOL) + (size_t)i * 256 * 256;  d.ldd = 256; d.nscale = ptab(L, 11) + i * 256; }
    else if (m < 18) { const int a = m - 16; d.src = ptab(L, 12) + (size_t)a * DM * FFD;     d.K = DM;   d.N = FFD;   d.dst = (bf16_t*)(ws + WS_WGU) + (size_t)a * 2 * FFD * DM; d.ldd = DM; d.mode = 1; d.kscale = ptab(L, 3) + (size_t)(2 * a) * DM; }
    else if (m < 20) { const int a = m - 18; d.src = ptab(L, 13) + (size_t)a * DM * FFD;     d.K = DM;   d.N = FFD;   d.dst = (bf16_t*)(ws + WS_WGU) + (size_t)a * 2 * FFD * DM; d.ldd = DM; d.mode = 2; d.kscale = ptab(L, 3) + (size_t)(2 * a) * DM; }
    else if (m < 22) { const int a = m - 20; d.src = ptab(L, 14) + (size_t)a * FFD * DM;     d.K = FFD;  d.N = DM;    d.dst = (bf16_t*)(ws + WS_WD) + (size_t)a * DM * FFD;      d.ldd = FFD; }
    else if (m < 38) { const int i = m - 22; d.src = ptab(L, 16) + (size_t)i * DM * FFE;     d.K = DM;   d.N = FFE;   d.dst = (bf16_t*)(ws + WS_MWGU) + (size_t)i * 2 * FFEP * DM; d.ldd = DM; d.mode = 1; d.kscale = ptab(L, 3) + (size_t)(2 * (i >> 3) + 1) * DM; }
    else if (m < 54) { const int i = m - 38; d.src = ptab(L, 17) + (size_t)i * DM * FFE;     d.K = DM;   d.N = FFE;   d.dst = (bf16_t*)(ws + WS_MWGU) + (size_t)i * 2 * FFEP * DM; d.ldd = DM; d.mode = 2; d.kscale = ptab(L, 3) + (size_t)(2 * (i >> 3) + 1) * DM; }
    else             { const int i = m - 54; d.src = ptab(L, 18) + (size_t)i * FFE * DM;     d.K = FFE;  d.N = DM;    d.dst = (bf16_t*)(ws + WS_MWD) + (size_t)i * DM * FFEP;    d.ldd = FFEP; }
    if (m == 17 || m == 19) { d.f8 = 1; d.dst = (bf16_t*)(ws + WS_WGU + (size_t)2 * FFD * DM * 2); d.ldd = DM; }
    if (m == 21) { d.f8 = 1; d.dst = (bf16_t*)(ws + WS_WD + (size_t)DM * FFD * 2); d.ldd = FFD8; }
    if (m >= 22) {
        const int e = (m - 22) & 7, lpi = ((m - 22) & 15) >> 3; d.f8 = 1;
        if (m < 54) { d.dst = (bf16_t*)(ws + WS_MWGU + (size_t)lpi * 8 * 2 * FFEP * DM * 2 + (size_t)e * 2 * FFEP * DM); d.ldd = DM; }
        else        { d.dst = (bf16_t*)(ws + WS_MWD + (size_t)lpi * 8 * DM * FFEP * 2 + (size_t)e * DM * FFE8); d.ldd = FFE8; } }
    return d;
}
__device__ __forceinline__ void p0_prologue(Frame& F) {
    const int* positions = (const int*)ptab(F.lds, 1);
    const int gw = F.vcu * NWAVES + F.wave, NGW = F.G * NWAVES;
    int cum = 0;
    for (int m = 0; m < N_MATS; ++m) {
        const MatDesc d = mat_desc(m, F.lds, F.ws);
        const int nitems = (d.K / 64) * (d.N / 64);
        int first = gw - (cum % NGW); if (first < 0) first += NGW;
        if (d.f8) { for (int it = first; it < nitems; it += NGW) transpose_item_f8(d.src, d.N, (unsigned char*)d.dst, d.ldd, d.mode, d.kscale, it, F.lane); }
        else { for (int it = first; it < nitems; it += NGW) transpose_item(d.src, d.N, d.dst, d.ldd, d.mode, d.kscale, d.nscale, it, F.lane); }
        cum += nitems;
    }
    const int gt = gw * 64 + F.lane, NGT = NGW * 64; const u32x4 z4 = (u32x4){0u, 0u, 0u, 0u};
    for (int i = gt; i < 2 * 192 * 128; i += NGT) { const int a = i / (192 * 128), r = (i / 128) % 192, c = i % 128; const int row = r < 96 ? 800 + r : 928 + (r - 96); *(GAS u32x4*)((bf16_t*)(F.ws + WS_WDN) + (size_t)a * NDOWNP * DM + (size_t)row * DM + c * 8) = z4; }
    for (int i = gt; i < 1024 * 8; i += NGT) { const int row = i / 8, c = i % 8; *(GAS u32x4*)(F.ws + WS_WD + (size_t)DM * FFD * 2 + (size_t)row * FFD8 + FFD + c * 16) = z4; }
    for (int i = gt; i < 16 * 128 * 64; i += NGT) { const int lpi = i / (8 * 128 * 64), e = (i / (128 * 64)) & 7, r = (i / 64) % 128, c = i % 64; const int row = 2560 + (r < 64 ? 64 + r : 192 + (r - 64));
        *(GAS u32x4*)(F.ws + WS_MWGU + (size_t)lpi * 8 * 2 * FFEP * DM * 2 + (size_t)e * 2 * FFEP * DM + (size_t)row * DM + c * 16) = z4; }
    for (int i = gt; i < 16 * 1024 * 12; i += NGT) { const int lpi = i / (8 * 1024 * 12), row = (i / 12) % (8 * 1024), c = i % 12; *(GAS u32x4*)(F.ws + WS_MWD + (size_t)lpi * 8 * DM * FFEP * 2 + (size_t)row * FFE8 + FFE + c * 16) = z4; }
    float* cosT = (float*)(F.ws + WS_COS); float* sinT = (float*)(F.ws + WS_SIN);
    { const float inv = powf(10000.0f, -(float)(2 * (gt & 31)) / 64.0f);
      for (int i = gt; i < NTOK * 32; i += NGT) { const float ang = (float)positions[i >> 5] * inv; float sn, cs; sincosf(ang, &sn, &cs); cosT[i] = cs; sinT[i] = sn; } }
    const float* x = ptab(F.lds, 0); bf16_t* H = (bf16_t*)(F.ws + WS_H); ssq_t* ssq0 = (ssq_t*)(F.ws + WS_SSQ);
    for (int m0 = gw * 4; m0 < NTOK; m0 += NGW * 4) {
        f32x4 v[4][4];
#pragma unroll
        for (int r = 0; r < 4; ++r) { const GAS f32x4* xr = (const GAS f32x4*)(x + (size_t)(m0 + r) * DM) + F.lane;
#pragma unroll
            for (int j = 0; j < 4; ++j) v[r][j] = xr[64 * j]; }
#pragma unroll
        for (int r = 0; r < 4; ++r) { GAS u32x2* o8 = (GAS u32x2*)(H + (size_t)(m0 + r) * DM) + F.lane; float s = 0.f;
#pragma unroll
            for (int j = 0; j < 4; ++j) { const f32x4 t = v[r][j]; s += (t.x * t.x + t.y * t.y) + (t.z * t.z + t.w * t.w); u32x2 w; w.x = cvt_pk_bf16(t.x, t.y); w.y = cvt_pk_bf16(t.z, t.w); o8[64 * j] = w; }
            s = wave_sum(s); if (F.lane == 0) ssq0[m0 + r] = ssq_fix(s); }
    }
}

template <bool FINAL>
__device__ __forceinline__ void combine_phase(Frame& F, const bf16_t* H, bf16_t* Hout, const bf16_t* YB, const unsigned* tokinfo, const unsigned* cntw, ssq_t* ssq_next, const float* gain, float* outF) {
    const int gw = F.vcu * NWAVES + F.wave, NGW = F.G * NWAVES;
    f32x4 g[4];
    if constexpr (FINAL) {
#pragma unroll
        for (int j = 0; j < 4; ++j) g[j] = *(const f32x4*)(gain + F.lane * 4 + 256 * j);
    }
    unsigned nb[8];
#pragma unroll
    for (int e = 0; e < 8; ++e) nb[e] = (rfl(__hip_atomic_load((unsigned*)cntw + 64 * e, RLX_AGENT)) + 255u) >> 8;
    for (int m0 = gw * 2; m0 < NTOK; m0 += NGW * 2) {
        u32x4 t0[2], t1[2];
#pragma unroll
        for (int r = 0; r < 2; ++r) { t0[r] = *(const u32x4*)(tokinfo + (size_t)(m0 + r) * 8); t1[r] = *(const u32x4*)(tokinfo + (size_t)(m0 + r) * 8 + 4); }
        u32x2 hh[2][4], ya[2][4], yb[2][4]; float g0[2], g1[2];
#pragma unroll
        for (int r = 0; r < 2; ++r) {
            const unsigned e0 = rfl(t0[r].x), r0 = rfl(t0[r].y), e1 = rfl(t1[r].x), r1 = rfl(t1[r].y); g0[r] = __uint_as_float(rfl(t0[r].z)); g1[r] = __uint_as_float(rfl(t1[r].z));
            unsigned b0 = 0u, b1 = 0u;
#pragma unroll
            for (int e = 0; e < 8; ++e) { b0 += ((unsigned)e < e0) ? nb[e] : 0u; b1 += ((unsigned)e < e1) ? nb[e] : 0u; }
            const GAS u32x2* hr = (const GAS u32x2*)(H + (size_t)(m0 + r) * DM) + F.lane;
            const GAS u32x2* y0 = (const GAS u32x2*)(YB + ((size_t)b0 * 256 + r0) * DM) + F.lane; const GAS u32x2* y1 = (const GAS u32x2*)(YB + ((size_t)b1 * 256 + r1) * DM) + F.lane;
#pragma unroll
            for (int j = 0; j < 4; ++j) { hh[r][j] = hr[64 * j]; ya[r][j] = y0[64 * j]; yb[r][j] = y1[64 * j]; }
        }
#pragma unroll
        for (int r = 0; r < 2; ++r) { const int m = m0 + r;
            f32x4 v[4]; float s = 0.f;
#pragma unroll
            for (int j = 0; j < 4; ++j) { const u32x2 h2 = hh[r][j], a = ya[r][j], b = yb[r][j];
                v[j].x = bflo(h2.x) + g0[r] * bflo(a.x) + g1[r] * bflo(b.x); v[j].y = bfhi(h2.x) + g0[r] * bfhi(a.x) + g1[r] * bfhi(b.x); v[j].z = bflo(h2.y) + g0[r] * bflo(a.y) + g1[r] * bflo(b.y); v[j].w = bfhi(h2.y) + g0[r] * bfhi(a.y) + g1[r] * bfhi(b.y);
                s += (v[j].x * v[j].x + v[j].y * v[j].y) + (v[j].z * v[j].z + v[j].w * v[j].w); }
            s = wave_sum(s);
            if constexpr (FINAL) { const float rstd = rstd_f(s); GAS f32x4* ho = (GAS f32x4*)(outF + (size_t)m * DM) + F.lane;
#pragma unroll
                for (int j = 0; j < 4; ++j) ho[64 * j] = v[j] * rstd * g[j];
            } else { GAS u32x2* hw = (GAS u32x2*)(Hout + (size_t)m * DM) + F.lane;
#pragma unroll
                for (int j = 0; j < 4; ++j) { u32x2 w; w.x = cvt_pk_bf16(v[j].x, v[j].y); w.y = cvt_pk_bf16(v[j].z, v[j].w); hw[64 * j] = w; }
                if (F.lane == 0) ssq_next[m] = ssq_fix(s); }
        }
    }
}
__device__ __forceinline__ void mid_phase(Frame& F, const bf16_t* DOWN, const float* qn, const float* kvn, const float* cosT, const float* sinT, bf16_t* CQN, bf16_t* CKVN, bf16_t* KR) {
    const int gw = F.vcu * NWAVES + F.wave, NGW = F.G * NWAVES, lane = F.lane;
    const f32x4 q0 = *(const f32x4*)(qn + lane * 8), q1 = *(const f32x4*)(qn + lane * 8 + 4), k0 = *(const f32x4*)(kvn + lane * 4);
    for (int m = gw; m < NTOK; m += NGW) {
        const bf16_t* dr = DOWN + (size_t)m * NDOWNP;
        const u32x4 cq = *(const GAS u32x4*)(dr + lane * 8); const u32x2 ck = *(const GAS u32x2*)(dr + QLR + lane * 4);
        const float x1 = bf2f(dr[QLR + KVLR + (lane & 31)]), x2 = bf2f(dr[QLR + KVLR + 32 + (lane & 31)]);
        const f32x4 a0 = (f32x4){bflo(cq.x), bfhi(cq.x), bflo(cq.y), bfhi(cq.y)}, a1 = (f32x4){bflo(cq.z), bfhi(cq.z), bflo(cq.w), bfhi(cq.w)}, c0 = (f32x4){bflo(ck.x), bfhi(ck.x), bflo(ck.y), bfhi(ck.y)};
        const float sq = wave_sum((a0.x * a0.x + a0.y * a0.y) + (a0.z * a0.z + a0.w * a0.w) + (a1.x * a1.x + a1.y * a1.y) + (a1.z * a1.z + a1.w * a1.w));
        const float sk = wave_sum((c0.x * c0.x + c0.y * c0.y) + (c0.z * c0.z + c0.w * c0.w));
        const float rq = 1.0f / sqrtf(sq * (1.0f / QLR) + RMS_EPS), rk = 1.0f / sqrtf(sk * (1.0f / KVLR) + RMS_EPS);
        const f32x4 y0 = a0 * rq * q0, y1 = a1 * rq * q1, z0 = c0 * rk * k0;
        u32x4 w; w.x = cvt_pk_bf16(y0.x, y0.y); w.y = cvt_pk_bf16(y0.z, y0.w); w.z = cvt_pk_bf16(y1.x, y1.y); w.w = cvt_pk_bf16(y1.z, y1.w);
        *(GAS u32x4*)(CQN + (size_t)m * QLR + lane * 8) = w;
        u32x2 w2; w2.x = cvt_pk_bf16(z0.x, z0.y); w2.y = cvt_pk_bf16(z0.z, z0.w);
        *(GAS u32x2*)(CKVN + (size_t)m * KVLR + lane * 4) = w2;
        const float c = cosT[(size_t)m * 32 + (lane & 31)], s = sinT[(size_t)m * 32 + (lane & 31)];
        const float o = lane < 32 ? x1 * c - x2 * s : x2 * c + x1 * s;
        KR[(size_t)m * DROPE + lane] = (bf16_t)(cvt_pk_bf16(o, o) & 0xffffu);
    }
}
template <int W>
__device__ __forceinline__ void pool_walk(const bf16_t* h, const ssq_t* ssq, const f32x2 g2, bf16_t* Z, size_t rowbase, int t_start, int c0, int nrows, int col) {
    f32x2 ring[W]; f32x2 sum = (f32x2){0.f, 0.f};
#pragma unroll
    for (int j = 0; j < W; ++j) ring[j] = (f32x2){0.f, 0.f};
    for (int r = 0; r < nrows; r += 16) {
        unsigned xw[16]; ssq_t q[16];
#pragma unroll
        for (int j = 0; j < 16; ++j) { const size_t row = rowbase + t_start + r + j; xw[j] = *(const GAS unsigned*)(h + row * DM + col); q[j] = ssq[row]; }
#pragma unroll
        for (int j = 0; j < 16; ++j) {
            const int t = t_start + r + j; const size_t row = rowbase + t;
            const f32x2 v = (f32x2){bflo(xw[j]), bfhi(xw[j])} * rstd_of(q[j]) * g2;
            sum = sum + (v - ring[j % W]); ring[j % W] = v;
            if (t >= c0) { const float inv = 1.0f / (float)(t + 1 < W ? t + 1 : W); const f32x2 z = sum * inv - v; *(GAS unsigned*)(Z + row * DM + col) = cvt_pk_bf16(z.x, z.y); }
        }
    }
}
__device__ __forceinline__ void pool_phase(Frame& F, const bf16_t* h, const ssq_t* ssq, const float* gain, bf16_t* Z) {
    const int col = F.tid * 2; const f32x2 g2 = *(const f32x2*)(gain + col);
    for (int chunk = F.vcu; chunk < NBATCH * 16; chunk += F.G) {
        const int b = chunk >> 4, c0 = (chunk & 15) * 128, t_start = c0 ? c0 - 16 : 0, nrows = c0 + 128 - t_start; const size_t rowbase = (size_t)b * SEQ;
        const int grp = F.wave >> 1;
        if (grp == 0) pool_walk<2>(h, ssq, g2, Z, rowbase, t_start, c0, nrows, col);
        else if (grp == 1) pool_walk<4>(h, ssq, g2, Z, rowbase, t_start, c0, nrows, col);
        else if (grp == 2) pool_walk<8>(h, ssq, g2, Z, rowbase, t_start, c0, nrows, col);
        else pool_walk<16>(h, ssq, g2, Z, rowbase, t_start, c0, nrows, col);
    }
}
template <bool WRITE_H8>
__device__ __forceinline__ void router_phase(Frame& F, const bf16_t* h, const ssq_t* ssq, const float* gain, const float* router, int* list, float* rsl, unsigned* tokinfo, unsigned* cntw, unsigned char* H8) {
    LAS float* rt = (LAS float*)(F.lds + RING_OFF);
    LAS int* esel = (LAS int*)(F.lds + RING_OFF + 32768);
    LAS int* wt = (LAS int*)(F.lds + RING_OFF + 32768 + 2048);
    LAS int* base = (LAS int*)(F.lds + RING_OFF + 32768 + 2048 + 256);
    LAS float* rsd = (LAS float*)(F.lds + RING_OFF + 32768 + 2048 + 512);
    const int lane = F.lane;
    for (int idx = F.tid; idx < DM * NEXP; idx += NWAVES * 64) rt[(idx & 7) * DM + (idx >> 3)] = router[idx];
    f32x4 g[4];
#pragma unroll
    for (int j = 0; j < 4; ++j) g[j] = *(const f32x4*)(gain + lane * 4 + 256 * j);
    for (int chunk = F.vcu; chunk < NTOK / 256; chunk += F.G) {
        const int T0 = chunk * 256;
        __syncthreads();
        u32x2 nx[4][4]; ssq_t nq[4];
#pragma unroll
        for (int p = 0; p < 4; ++p) { const GAS u32x2* xr = (const GAS u32x2*)(h + (size_t)(T0 + F.wave * 32 + p) * DM) + lane;
#pragma unroll
          for (int j = 0; j < 4; ++j) nx[p][j] = xr[64 * j];
          nq[p] = ssq[T0 + F.wave * 32 + p]; }
        for (int i4 = 0; i4 < 32; i4 += 4) {
            const int tl0 = F.wave * 32 + i4, m0 = T0 + tl0;
            f32x4 v[4][4]; float rstd[4];
#pragma unroll
            for (int p = 0; p < 4; ++p) { rstd[p] = rstd_of(nq[p]);
#pragma unroll
                for (int j = 0; j < 4; ++j) { const u32x2 w = nx[p][j]; f32x4 xn = (f32x4){bflo(w.x), bfhi(w.x), bflo(w.y), bfhi(w.y)} * rstd[p];
                    if constexpr (WRITE_H8) { const f32x4 q = xn * pg8::FP8_SA; *(GAS unsigned*)(H8 + (size_t)(m0 + p) * DM + lane * 4 + 256 * j) = pg8::pk4_fp8(q.x, q.y, q.z, q.w); }
                    v[p][j] = xn * g[j]; } }
            if (i4 + 4 < 32) {
#pragma unroll
                for (int p = 0; p < 4; ++p) { const GAS u32x2* xr = (const GAS u32x2*)(h + (size_t)(m0 + 4 + p) * DM) + lane;
#pragma unroll
                    for (int j = 0; j < 4; ++j) nx[p][j] = xr[64 * j];
                    nq[p] = ssq[m0 + 4 + p]; } }
            float a[32];
#pragma unroll
            for (int e = 0; e < 8; ++e) {
#pragma unroll
                for (int p = 0; p < 4; ++p) a[8 * p + e] = 0.f;
#pragma unroll
                for (int j = 0; j < 4; ++j) { const f32x4 r4 = *(const LAS f32x4*)(rt + e * DM + lane * 4 + 256 * j);
#pragma unroll
                    for (int p = 0; p < 4; ++p) a[8 * p + e] += (v[p][j].x * r4.x + v[p][j].y * r4.y) + (v[p][j].z * r4.z + v[p][j].w * r4.w); } }
#define RSTEP(N, LM) _Pragma("unroll") for (int k = 0; k < (N); ++k) { const bool up = (lane & (LM)) != 0; const float send = up ? a[k] : a[k + (N)], keep = up ? a[k + (N)] : a[k]; a[k] = keep + __shfl_xor(send, (LM)); }
            RSTEP(16, 32) RSTEP(8, 16) RSTEP(4, 8) RSTEP(2, 4) RSTEP(1, 2)
#undef RSTEP
            const float tot = a[0] + __shfl_xor(a[0], 1);
#pragma unroll
            for (int p = 0; p < 4; ++p) {
                float lg[8];
#pragma unroll
                for (int e = 0; e < 8; ++e) lg[e] = __int_as_float(__builtin_amdgcn_readlane(__float_as_int(tot), 2 * (8 * p + e)));
                int e0 = 0; float l0 = lg[0];
#pragma unroll
                for (int e = 1; e < 8; ++e) if (lg[e] > l0) { l0 = lg[e]; e0 = e; }
                int e1 = e0 == 0 ? 1 : 0; float l1 = lg[e0 == 0 ? 1 : 0];
#pragma unroll
                for (int e = 0; e < 8; ++e) if (e != e0 && lg[e] > l1) { l1 = lg[e]; e1 = e; }
                const float g0 = 1.0f / (1.0f + __expf(l1 - l0)), g1 = 1.0f - g0;
                if (lane == 0) { const int tl = tl0 + p; esel[2 * tl] = e0; esel[2 * tl + 1] = e1; rsd[tl] = rstd[p]; unsigned* ti = tokinfo + (size_t)(m0 + p) * 8;
                    ti[0] = (unsigned)e0; ti[2] = __float_as_uint(g0); ti[4] = (unsigned)e1; ti[6] = __float_as_uint(g1); }
            }
        }
        __syncthreads();
        const int me = esel[F.tid]; int myrank = 0;
#pragma unroll
        for (int e = 0; e < 8; ++e) { const unsigned long long mask = __ballot(me == e); if (me == e) myrank = __popcll(mask & ((1ull << lane) - 1ull)); if (lane == 0) wt[F.wave * 8 + e] = __popcll(mask); }
        __syncthreads();
        int off = 0;
        for (int w = 0; w < F.wave; ++w) off += wt[w * 8 + me];
        if (F.tid < 8) { int tot = 0; for (int w = 0; w < 8; ++w) tot += wt[w * 8 + F.tid]; base[F.tid] = (int)__hip_atomic_fetch_add(cntw + 64 * F.tid, (unsigned)tot, RLX_AGENT); }
        __syncthreads();
        const int rank = base[me] + off + myrank, tok = T0 + (F.tid >> 1);
        list[(size_t)me * NTOK + rank] = tok; rsl[(size_t)me * NTOK + rank] = rsd[F.tid >> 1];
        tokinfo[(size_t)tok * 8 + (F.tid & 1) * 4 + 1] = (unsigned)rank;
    }
}
template <bool GATHER, bool FP8 = false>
struct MoeOrder {
    static constexpr size_t A_BLK = GATHER ? 0 : (FP8 ? (size_t)256 * FFE8 : (size_t)256 * FFEP * 2), B_EXP = GATHER ? (FP8 ? (size_t)2 * FFEP * DM : (size_t)2 * FFEP * DM * 2) : (FP8 ? (size_t)DM * FFE8 : (size_t)DM * FFEP * 2),
                            B_TILE = GATHER ? (FP8 ? (size_t)256 * DM : (size_t)256 * DM * 2) : (FP8 ? (size_t)256 * FFE8 : (size_t)256 * FFEP * 2);
    static constexpr int NT = GATHER ? 2 * FFEP / 256 : DM / 256;
    const char* A; const char* B; const int* list; const unsigned* cntw; int G, c, rev; unsigned bs[9];
    __device__ __forceinline__ void init(const unsigned* cntw_, const void* A_, const void* B_, const int* list_, int G_, int c_) {
        A = (const char*)A_; B = (const char*)B_; list = list_; cntw = cntw_; G = G_; c = c_; rev = 0; bs[0] = 0u;
#pragma unroll
        for (int e = 0; e < 8; ++e) { const unsigned ce = rfl(__hip_atomic_load((unsigned*)cntw + 64 * e, RLX_AGENT)); bs[e + 1] = bs[e] + ((ce + 255u) >> 8); }
    }
    __device__ __forceinline__ bool next(int i, pg8::Unit& u) const {
        unsigned blk; int pn;
        if ((G & 7) == 0) {
            const int x = c & 7, cl = c >> 3, q = (int)bs[8] >> 3, r = (int)bs[8] & 7, nbx = q + (x < r ? 1 : 0), b0 = x * q + (x < r ? x : r);
            int U = i * (G >> 3) + cl; const int nwx = nbx * NT; if (U >= nwx) return false;
            if (rev) U = nwx - 1 - U;
            const int nig = pg8::WGM * NT, gid = U / nig, fm = gid * pg8::WGM, gsz = (nbx - fm) < pg8::WGM ? (nbx - fm) : pg8::WGM;
            blk = (unsigned)(b0 + fm + (U % nig) % gsz); pn = (U % nig) / gsz;
        } else {
            long L = (long)i * G + c; if (L >= (long)bs[8] * NT) return false;
            if (rev) L = (long)bs[8] * NT - 1 - L;
            blk = (unsigned)(L / NT); pn = (int)(L % NT);
        }
        unsigned e = 0u, st = 0u;
#pragma unroll
        for (int k = 1; k < 8; ++k) if (blk >= bs[k]) { e = (unsigned)k; st = bs[k]; }
        const unsigned j = blk - st;
        u.b = B + (size_t)e * B_EXP + (size_t)pn * B_TILE; u.orow = (int)(blk * 256u); u.pn = pn; u.aux = (int)e;
        if constexpr (GATHER) { const unsigned ce = rfl(__hip_atomic_load((unsigned*)cntw + 64 * e, RLX_AGENT));
            u.a = A; u.rows = list + (size_t)e * NTOK + (size_t)j * 256; const unsigned rem = ce - j * 256u; u.nrows = rem < 256u ? (int)rem : 256; }
        else { u.a = A + (size_t)blk * A_BLK; u.rows = nullptr; u.nrows = 256; }
        return true;
    }
};
constexpr int NPHASE = 27;
struct Args { const float* in[20]; float* out; unsigned char* ws; int ph_lo, ph_hi, li, pad; };
#ifndef MK_REP_MASK
#define MK_REP_MASK 0
#endif
#ifndef MK_REP_N
#define MK_REP_N 1
#endif
#ifndef MK_REV
#define MK_REV 1
#endif
#ifndef MK_STAG_BF
#define MK_STAG_BF 0u
#define MK_STAG_F8 0u
#endif
constexpr int PT_OFF = LDSCTL_OFF + 512;
__device__ __forceinline__ unsigned long long ptab_u64(LAS unsigned char* L, int i) {
    const volatile LAS unsigned* p = (const volatile LAS unsigned*)(L + PT_OFF + 8 * i); const unsigned lo = rfl(p[0]), hi = rfl(p[1]); return ((unsigned long long)hi << 32) | lo; }
__device__ __forceinline__ const float* ptab(LAS unsigned char* L, int i) { return (const float*)(GAS const float*)ptab_u64(L, i); }
__device__ __forceinline__ Frame make_frame(LAS unsigned char* L) {
    asm volatile("" : "+s"(L));
    Frame F; F.lds = L; F.MISC = (volatile LAS unsigned*)(L + MISC_OFF); F.tid = launder_v((int)threadIdx.x); F.lane = F.tid & 63; F.wave = __builtin_amdgcn_readfirstlane(F.tid >> 6);
    { int g_ = gridDim.x, bx = blockIdx.x; asm volatile("" : "+s"(g_), "+s"(bx)); F.G = g_; F.bx = bx;
      F.vcu = (F.G % 8 == 0) ? (bx % 8) * (F.G / 8) + bx / 8 : bx; }
    F.ws = (unsigned char*)(GAS unsigned char*)ptab_u64(L, 21); F.ctl = (gu32*)(F.ws + WS_CTL); return F;
}
__global__ void __launch_bounds__(NWAVES * 64, 2) fwd(Args args) {
    extern __shared__ __attribute__((aligned(16))) unsigned char lds[];
    LAS unsigned char* L = (LAS unsigned char*)lds;
    { const int tid = threadIdx.x;
      for (int u = tid; u < LDSCTL_BYTES / 4; u += NWAVES * 64) ((LAS unsigned*)(L + LDSCTL_OFF))[u] = 0u;
      __syncthreads();
      if (tid < 20) *(LAS unsigned long long*)(L + PT_OFF + 8 * tid) = (unsigned long long)args.in[tid];
      if (tid == 20) *(LAS unsigned long long*)(L + PT_OFF + 8 * 20) = (unsigned long long)args.out;
      if (tid == 21) *(LAS unsigned long long*)(L + PT_OFF + 8 * 21) = (unsigned long long)args.ws;
      if (tid == 22) *(LAS unsigned long long*)(L + PT_OFF + 8 * 22) = (unsigned long long)args.pad;
      __syncthreads(); }
    const int lo = args.ph_lo, hi = args.ph_hi;
    XcdBarrier bar; { gu32* ctl = (gu32*)(args.ws + WS_CTL); bar.bar = (unsigned*)(ctl + CW_BAR) + args.li * XCD_BAR_WORDS; bar.x = 0; bar.st = nullptr;
      if (threadIdx.x == 0) { const unsigned long long ba = (unsigned long long)((unsigned*)(ctl + CW_BAR) + args.li * XCD_BAR_WORDS); ((volatile LAS unsigned*)(L + MISC_OFF))[10] = (unsigned)ba; ((volatile LAS unsigned*)(L + MISC_OFF))[11] = (unsigned)(ba >> 32); }
      if (hi - lo > 1) bar = xcd_barrier_post((unsigned*)(ctl + CW_BAR) + args.li * XCD_BAR_WORDS, (volatile LAS unsigned*)(L + MISC_OFF) + 8);
      __syncthreads(); }
#ifndef MK_ONLY
#define MK_ONLY (-1)
#endif
#define KIND(k) ((k) == 0 ? 0 : 1 + ((k) - 1) % 13)
#ifndef MK_SKIPMASK
#define MK_SKIPMASK 0
#endif
#define IN(k) ((MK_ONLY < 0 || KIND(k) == MK_ONLY) && !((MK_SKIPMASK >> KIND(k)) & 1) && lo <= (k) && (k) < hi)
#define FORREP(k)
#if MK_REP_MASK
#define LASTREP (ptab_u64(F.lds, 22) == 0ull)
#else
#define LASTREP true
#endif
#ifdef MK_DOUBLE_BAR
#define SEAM(k) do { if ((k) + 1 < hi) { xcd_barrier(bar); xcd_barrier(bar); } } while (0)
#else
#define SEAM(k) do { if ((k) + 1 < hi) xcd_barrier(bar); } while (0)
#endif
#define WSP(off) ((bf16_t*)(F.ws + (off)))
#define SSQ(i) ((ssq_t*)(F.ws + WS_SSQ) + (size_t)(i) * NTOK)
    LAS unsigned char* ring = L + RING_OFF;

    if (IN(0)) FORREP(0) { Frame F = make_frame(L); p0_prologue(F); SEAM(0); }

    for (int lp = 0; lp < 2; ++lp) {
        const int pb = 1 + 13 * lp;
        if (IN(pb + 0)) FORREP(pb + 0) { Frame F = make_frame(L);
            pg8::RegOrder S; S.init(WSP(WS_H), DM * 2, WSP(WS_WDN) + (size_t)lp * NDOWNP * DM, DM * 2, NTOK, NDOWNP, F.G, F.bx);
            pg8::EpiDown E{WSP(WS_DOWN), WSP(WS_KR), SSQ(4 * lp + 0), LASTREP ? SSQ(10 + 2 * lp) : SSQ(9), LASTREP ? SSQ(11 + 2 * lp) : SSQ(9), (const float*)(F.ws + WS_COS), (const float*)(F.ws + WS_SIN)};
            pg8::gemm_phase<pg8::EpiDown, pg8::RegOrder, false>(ring, DM * 2, DM * 2, DM * 2, S, E);
            SEAM(pb + 0);
        }
        if (IN(pb + 1)) FORREP(pb + 1) { Frame F = make_frame(L);
            pg8::RegOrder S; S.init(WSP(WS_DOWN), NDOWNP * 2, WSP(WS_WUQ) + (size_t)lp * NQ * QLR, QLR * 2, NTOK, NQ, F.G, F.bx);
            pg8::EpiQ E{WSP(WS_Q), (const float*)(F.ws + WS_COS), (const float*)(F.ws + WS_SIN), SSQ(10 + 2 * lp)};
            pg8::gemm_phase<pg8::EpiQ, pg8::RegOrder, false>(ring, NDOWNP * 2, QLR * 2, QLR * 2, S, E);
            SEAM(pb + 1);
        }
        if (IN(pb + 2)) FORREP(pb + 2) { Frame F = make_frame(L);
            pg8::RegOrder S; S.init(WSP(WS_DOWN) + QLR, NDOWNP * 2, WSP(WS_WUKV) + (size_t)lp * NKV * KVLR, KVLR * 2, NTOK, NKV, F.G, F.bx);
            pg8::EpiBf16<2> E{WSP(WS_KNV), NKV, SSQ(11 + 2 * lp)};
            pg8::gemm_phase<pg8::EpiBf16<2>, pg8::RegOrder, false>(ring, NDOWNP * 2, KVLR * 2, KVLR * 2, S, E);
            SEAM(pb + 2);
        }
        if (IN(pb + 3)) FORREP(pb + 3) { Frame F = make_frame(L); att::attn_phase((char*)lds + RING_OFF, WSP(WS_Q), WSP(WS_KNV), WSP(WS_KR), WSP(WS_DOWN), F.vcu, F.G); SEAM(pb + 3); }
        if (IN(pb + 4) && lp == 0) FORREP(pb + 4) { Frame F = make_frame(L);
            pg8::RegOrder S; S.init(WSP(WS_DOWN), DM * 2, WSP(WS_WO) + (size_t)lp * DM * DM, DM * 2, NTOK, DM, F.G, F.bx);
            pg8::EpiResidH<false> E{WSP(WS_H), LASTREP ? WSP(WS_H) : WSP(WS_DUMMY), LASTREP ? SSQ(4 * lp + 1) : SSQ(9), nullptr, 1.0f};
            pg8::gemm_phase<pg8::EpiResidH<false>, pg8::RegOrder, false>(ring, DM * 2, DM * 2, DM * 2, S, E);
            SEAM(pb + 4);
        }
        if (IN(pb + 4) && lp == 1) FORREP(pb + 4) { Frame F = make_frame(L);
            pg8::RegOrder S; S.init(WSP(WS_DOWN), DM * 2, WSP(WS_WO) + (size_t)lp * DM * DM, DM * 2, NTOK, DM, F.G, F.bx);
            pg8::EpiResidH<true> E{WSP(WS_H), LASTREP ? WSP(WS_H) : WSP(WS_DUMMY), LASTREP ? SSQ(4 * lp + 1) : SSQ(9), F.ws + WS_H8, 1.0f};
            pg8::gemm_phase<pg8::EpiResidH<true>, pg8::RegOrder, false>(ring, DM * 2, DM * 2, DM * 2, S, E);
            SEAM(pb + 4);
        }
#if defined(MK_EPI_PROBE)
        if (IN(pb + 5) && lp == 0 && !LASTREP) { Frame F = make_frame(L);
            pg8::RegOrder S; S.init(WSP(WS_H), DM * 2, WSP(WS_WGU) + (size_t)lp * 2 * FFD * DM, DM * 2, NTOK, 2 * FFD, F.G, F.bx);
#if MK_EPI_PROBE == 1
            pg8::EpiNull E{(float*)(F.ws + WS_DUMMY)};
            pg8::gemm_phase<pg8::EpiNull, pg8::RegOrder, false>(ring, DM * 2, DM * 2, DM * 2, S, E);
#else
            pg8::EpiBf16<0> E{WSP(WS_HID), FFD, nullptr};
            S.nN = FFD / 256; S.nwg = S.nM * S.nN;
            pg8::gemm_phase<pg8::EpiBf16<0>, pg8::RegOrder, false>(ring, DM * 2, DM * 2, DM * 2, S, E);
#endif
        }
        if (IN(pb + 5) && lp == 0 && LASTREP) FORREP(pb + 5) { Frame F = make_frame(L);
#else
        if (IN(pb + 5) && lp == 0) FORREP(pb + 5) { Frame F = make_frame(L);
#endif
            pg8::RegOrder S; S.init(WSP(WS_H), DM * 2, WSP(WS_WGU) + (size_t)lp * 2 * FFD * DM, DM * 2, NTOK, 2 * FFD, F.G, F.bx);
            pg8::EpiSwiglu<1> E{WSP(WS_HID), FFD, SSQ(4 * lp + 1), nullptr};
            pg8::gemm_phase<pg8::EpiSwiglu<1>, pg8::RegOrder, false>(ring, DM * 2, DM * 2, DM * 2, S, E, MK_STAG_BF);
            SEAM(pb + 5);
        }
        if (IN(pb + 5) && lp == 1) FORREP(pb + 5) { Frame F = make_frame(L);
            pg8::RegOrder S; S.init(F.ws + WS_H8, DM, F.ws + WS_WGU + (size_t)2 * FFD * DM * 2, DM, NTOK, 2 * FFD, F.G, F.bx);
            pg8::EpiSwigluF8<1> E{F.ws + WS_HID, FFD8, 2 * FFD / 256 - 1, SSQ(4 * lp + 1)};
            pg8::gemm_phase<pg8::EpiSwigluF8<1>, pg8::RegOrder, false, true>(ring, DM, DM, DM, S, E, MK_STAG_F8);
            SEAM(pb + 5);
        }
        if (IN(pb + 6) && lp == 0) FORREP(pb + 6) { Frame F = make_frame(L);
            pg8::RegOrder S; S.init(WSP(WS_HID), FFD * 2, WSP(WS_WD) + (size_t)lp * DM * FFD, FFD * 2, NTOK, DM, F.G, F.bx); S.rev = MK_REV;
            pg8::EpiResidH<false> E{WSP(WS_H), LASTREP ? WSP(WS_H) : WSP(WS_DUMMY), LASTREP ? SSQ(4 * lp + 2) : SSQ(9), nullptr, 1.0f};
            pg8::gemm_phase<pg8::EpiResidH<false>, pg8::RegOrder, false>(ring, FFD * 2, FFD * 2, FFD * 2, S, E);
            SEAM(pb + 6);
        }
        if (IN(pb + 6) && lp == 1) FORREP(pb + 6) { Frame F = make_frame(L);
            pg8::RegOrder S; S.init(F.ws + WS_HID, FFD8, F.ws + WS_WD + (size_t)DM * FFD * 2, FFD8, NTOK, DM, F.G, F.bx); S.rev = MK_REV;
            pg8::EpiResidH<false> E{WSP(WS_H), LASTREP ? WSP(WS_H) : WSP(WS_DUMMY), LASTREP ? SSQ(4 * lp + 2) : SSQ(9), nullptr, 1.0f / (pg8::FP8_SH * pg8::FP8_SW)};
            pg8::gemm_phase<pg8::EpiResidH<false>, pg8::RegOrder, false, true>(ring, FFD8, FFD8, FFD8, S, E);
            SEAM(pb + 6);
        }
        if (IN(pb + 7)) FORREP(pb + 7) { Frame F = make_frame(L); pool_phase(F, WSP(WS_H), SSQ(4 * lp + 2), ptab(F.lds, 2) + (size_t)(2 * lp + 1) * DM, WSP(WS_DOWN)); SEAM(pb + 7); }
        if (IN(pb + 8)) FORREP(pb + 8) { Frame F = make_frame(L);
            pg8::RegOrder S; S.init(WSP(WS_DOWN), DM * 2, WSP(WS_WPOOL) + (size_t)lp * 4 * 256 * 256, 256 * 2, NTOK, DM, F.G, F.bx, 256 * 2);
            pg8::EpiResidH<false> E{WSP(WS_H), LASTREP ? WSP(WS_H) : WSP(WS_DUMMY), LASTREP ? SSQ(4 * lp + 3) : SSQ(9), nullptr, 1.0f};
            pg8::gemm_phase<pg8::EpiResidH<false>, pg8::RegOrder, false>(ring, DM * 2, 256 * 2, 256 * 2, S, E);
            SEAM(pb + 8);
        }
        if (IN(pb + 9)) FORREP(pb + 9) { Frame F = make_frame(L);
            router_phase<true>(F, WSP(WS_H), SSQ(4 * lp + 3), ptab(F.lds, 3) + (size_t)(2 * lp + 1) * DM, ptab(F.lds, 15) + (size_t)lp * DM * NEXP, (int*)(F.ws + WS_LIST), (float*)(F.ws + WS_RSL), (unsigned*)(F.ws + WS_TOKINFO), (unsigned*)(F.ctl + CW_CNT) + (LASTREP ? lp : 2 + lp) * 8 * 64, F.ws + WS_H8);
            SEAM(pb + 9); }
#ifndef TEST_NO_F8MOE
        if (IN(pb + 10)) FORREP(pb + 10) { Frame F = make_frame(L);
            MoeOrder<true, true> S; S.init((unsigned*)(F.ctl + CW_CNT) + lp * 8 * 64, F.ws + WS_H8, F.ws + WS_MWGU + (size_t)lp * 8 * 2 * FFEP * DM * 2, (const int*)(F.ws + WS_LIST), F.G, F.bx);
            pg8::EpiSwigluF8<0> E{F.ws + WS_HID, FFE8, 2 * FFEP / 256 - 1, nullptr};
            pg8::gemm_phase<pg8::EpiSwigluF8<0>, MoeOrder<true, true>, true, true>(ring, DM, DM, DM, S, E, MK_STAG_F8);
            SEAM(pb + 10);
        }
#endif
#ifndef TEST_NO_F8MOE
        if (IN(pb + 11)) FORREP(pb + 11) { Frame F = make_frame(L);
            MoeOrder<false, true> S; S.init((unsigned*)(F.ctl + CW_CNT) + lp * 8 * 64, F.ws + WS_HID, F.ws + WS_MWD + (size_t)lp * 8 * DM * FFEP * 2, (const int*)(F.ws + WS_LIST), F.G, F.bx); S.rev = MK_REV;
            pg8::EpiBf16Scaled E{WSP(WS_YB), DM, 1.0f / (pg8::FP8_SH * pg8::FP8_SW)};
            pg8::gemm_phase<pg8::EpiBf16Scaled, MoeOrder<false, true>, false, true>(ring, FFE8, FFE8, FFE8, S, E);
            SEAM(pb + 11);
        }
#endif
        if (IN(pb + 12)) FORREP(pb + 12) { Frame F = make_frame(L);
            if (lp == 0) combine_phase<false>(F, WSP(WS_H), LASTREP ? WSP(WS_H) : WSP(WS_DOWN), WSP(WS_YB), (const unsigned*)(F.ws + WS_TOKINFO), (unsigned*)(F.ctl + CW_CNT), LASTREP ? SSQ(4) : SSQ(9), nullptr, nullptr);
            else combine_phase<true>(F, WSP(WS_H), nullptr, WSP(WS_YB), (const unsigned*)(F.ws + WS_TOKINFO), (unsigned*)(F.ctl + CW_CNT) + 8 * 64, nullptr, ptab(F.lds, 19), (float*)ptab(F.lds, 20));
            SEAM(pb + 12);
        }
    }
#undef IN
#undef SEAM
#undef WSP
#undef SSQ
}

#ifndef MK_PER_PHASE
#define MK_PER_PHASE 0
#endif
extern "C" void kernel_launch(void* const* d_in, const int* in_sizes, int n_in, void* d_out, int out_size, void* d_ws, size_t ws_size, hipStream_t stream) {
    static int grid = 0;
    if (grid == 0) {
        if (n_in != 20 || in_sizes[0] != NTOK * DM || out_size != NTOK * DM || ws_size < WS_END) { fprintf(stderr, "kernel_launch: unexpected shapes (n_in %d, in0 %d, out %d, ws %zu < %zu)\n", n_in, n_in > 0 ? in_sizes[0] : -1, out_size, ws_size, (size_t)WS_END); grid = -1; return; }
        int dev = 0, cus = 0, per_cu = 0;
        if (hipGetDevice(&dev) != hipSuccess || hipDeviceGetAttribute(&cus, hipDeviceAttributeMultiprocessorCount, dev) != hipSuccess) { grid = -1; return; }
        if (hipFuncSetAttribute((const void*)fwd, hipFuncAttributeMaxDynamicSharedMemorySize, LDS_BYTES) != hipSuccess) { fprintf(stderr, "kernel_launch: hipFuncSetAttribute failed\n"); grid = -1; return; }
        if (hipOccupancyMaxActiveBlocksPerMultiprocessor(&per_cu, (const void*)fwd, NWAVES * 64, LDS_BYTES) != hipSuccess || per_cu < 1) fprintf(stderr, "kernel_launch: occupancy query reports %d\n", per_cu);
        (void)hipGetLastError();
        grid = cus < 256 ? cus : 256;
    }
    if (grid < 0) return;
    if (hipMemsetAsync((char*)d_ws + WS_CTL, 0, CTL_ZERO_BYTES, stream) != hipSuccess) return;
    Args a{};
    for (int i = 0; i < 20; ++i) a.in[i] = (const float*)d_in[i];
    a.out = (float*)d_out; a.ws = (unsigned char*)d_ws;
#if MK_PER_PHASE
    for (int p = 0; p < NPHASE; ++p) { a.ph_lo = p; a.ph_hi = p + 1; a.li = 0; hipLaunchKernelGGL(fwd, dim3(grid), dim3(NWAVES * 64), LDS_BYTES, stream, a); }
#elif MK_REP_MASK
    { int cur = 0, li = 0;
      for (int k = 0; k < NPHASE; ++k) if ((MK_REP_MASK >> (k == 0 ? 0 : 1 + (k - 1) % 13)) & 1) {
          if (k > cur) { a.ph_lo = cur; a.ph_hi = k; a.li = li++; a.pad = 0; hipLaunchKernelGGL(fwd, dim3(grid), dim3(NWAVES * 64), LDS_BYTES, stream, a); }
          for (int r = 1; r < MK_REP_N; ++r) { a.ph_lo = k; a.ph_hi = k + 1; a.li = li++; a.pad = 1; hipLaunchKernelGGL(fwd, dim3(grid), dim3(NWAVES * 64), LDS_BYTES, stream, a); }
          cur = k; }
      a.ph_lo = cur; a.ph_hi = NPHASE; a.li = li++; a.pad = 0; hipLaunchKernelGGL(fwd, dim3(grid), dim3(NWAVES * 64), LDS_BYTES, stream, a); }
#elif defined(MK_TWICE)
    a.ph_lo = 0; a.ph_hi = NPHASE; a.li = 0;
    hipLaunchKernelGGL(fwd, dim3(grid), dim3(NWAVES * 64), LDS_BYTES, stream, a);
    (void)hipMemsetAsync((char*)d_ws + WS_CTL, 0, CTL_ZERO_BYTES, stream);
    hipLaunchKernelGGL(fwd, dim3(grid), dim3(NWAVES * 64), LDS_BYTES, stream, a);
#else
    a.ph_lo = 0; a.ph_hi = NPHASE; a.li = 0;
    hipLaunchKernelGGL(fwd, dim3(grid), dim3(NWAVES * 64), LDS_BYTES, stream, a);
#endif
}
```

```cpp
#include <hip/hip_runtime.h>
#include <cstdio>
#include <cstdint>

#define GAS __attribute__((address_space(1)))
#define LAS __attribute__((address_space(3)))
typedef unsigned short bf16_t;
typedef short bf16x8 __attribute__((ext_vector_type(8)));
typedef short s16x4 __attribute__((ext_vector_type(4)));
typedef float f32x2 __attribute__((ext_vector_type(2)));
typedef float f32x4 __attribute__((ext_vector_type(4)));
typedef float f32x16 __attribute__((ext_vector_type(16)));
typedef unsigned u32x2 __attribute__((ext_vector_type(2)));
typedef unsigned u32x4 __attribute__((ext_vector_type(4)));

constexpr int DM = 1024, NBATCH = 32, SEQ = 2048, NTOK = NBATCH * SEQ;
constexpr int NHEAD = 8, DNOPE = 128, DROPE = 64, DVH = 128, DQH = DNOPE + DROPE, QLR = 512, KVLR = 256;
constexpr int NDOWN = QLR + KVLR + DROPE  , NDOWNP = 1024;
constexpr int NQ = NHEAD * DQH  , NKV = NHEAD * (DNOPE + DVH)  ;
constexpr int FFD = 2688, NEXP = 8, FFE = 1344, FFEP = 1408;
constexpr int PSLOT = (NTOK * 2 / 256 + NEXP) * 256;
constexpr float RMS_EPS = 1e-6f;

__device__ __forceinline__ unsigned cvt_pk_bf16(float lo, float hi) { unsigned r; asm volatile("v_cvt_pk_bf16_f32 %0, %1, %2" : "=v"(r) : "v"(lo), "v"(hi)); return r; }
__device__ __forceinline__ int launder_v(int v) { asm volatile("" : "+v"(v)); return v; }
__device__ __forceinline__ float fp8_rt(float x, float s) { const int p = __builtin_amdgcn_cvt_pk_fp8_f32(x * s, 0.f, 0, false); return __builtin_amdgcn_cvt_f32_fp8(p, 0) * (1.0f / s); }
__device__ __forceinline__ float bf2f(unsigned short b) { return __uint_as_float((unsigned)b << 16); }
__device__ __forceinline__ float bflo(unsigned w) { return __uint_as_float(w << 16); }
__device__ __forceinline__ float bfhi(unsigned w) { return __uint_as_float(w & 0xffff0000u); }

typedef unsigned long long ssq_t;
__device__ __forceinline__ ssq_t ssq_fix(float s) { return (ssq_t)(s * 16777216.0f); }
__device__ __forceinline__ float rstd_n(ssq_t q, float invn) { return __builtin_amdgcn_rsqf(((float)(unsigned)(q >> 32) * 4294967296.0f + (float)(unsigned)q) * (1.0f / 16777216.0f) * invn + RMS_EPS); }
__device__ __forceinline__ float rstd_of(ssq_t q) { return rstd_n(q, 1.0f / DM); }
__device__ __forceinline__ float rstd_f(float ssq) { return __builtin_amdgcn_rsqf(ssq * (1.0f / DM) + RMS_EPS); }

namespace pg8 {
constexpr int BM = 256, BK = 64, HALF = 128, HTB = HALF * BK * 2  , STAGE_BYTES = 8 * HTB, NXCD = 8, WGM = 8;
__host__ __device__ __forceinline__ int lds_byte(int r, int c) { const int st = (r >> 4) * 2 + (c >> 5), rr = r & 15, cc = c & 31, ob = rr * 64 + cc * 2; return st * 1024 + (ob ^ (((ob >> 9) & 1) << 5)); }
__host__ __device__ __forceinline__ void stage_rc(int b, int& R, int& C) { const int st = b / 1024, sb = b % 1024, swz = sb ^ (((sb >> 9) & 1) << 5); R = (st >> 1) * 16 + swz / 64; C = (st & 1) * 32 + (swz % 64) / 2; }
__host__ __device__ __forceinline__ int perm32(int rho) { const int n = rho >> 4, i = rho & 15; return 8 * (i >> 2) + 4 * n + (i & 3); }

struct Unit { const char* a; const char* b; const int* rows; int nrows; int orow; int pn; int aux; };

struct RegOrder {
    const char* A; const char* B; unsigned a_tile, b_tile, a_colstep; int nM, nN, nwg, G, c, rev;
    __device__ __forceinline__ void init(const void* A_, size_t lda_b, const void* B_, size_t ldb_b, int M, int N, int G_, int c_, size_t a_colstep_ = 0) {
        A = (const char*)A_; B = (const char*)B_; a_tile = (unsigned)(256 * lda_b); b_tile = (unsigned)(256 * ldb_b); a_colstep = (unsigned)a_colstep_; nM = M / BM; nN = N / BM; nwg = nM * nN; G = G_; c = c_; rev = 0; }
    __device__ __forceinline__ bool next(int i, Unit& u) const {
        long L = (long)i * G + c; if (L >= nwg) return false;
        if (rev) L = nwg - 1 - L;
        int wgid = (int)L; { const int q = nwg / NXCD, r = nwg % NXCD, xcd = wgid % NXCD, off = wgid / NXCD; wgid = (xcd < r ? xcd * (q + 1) : r * (q + 1) + (xcd - r) * q) + off; }
        const int nig = WGM * nN, gid = wgid / nig, fm = gid * WGM, gsz = (nM - fm) < WGM ? (nM - fm) : WGM;
        const int pm = fm + ((wgid % nig) % gsz), pn = (wgid % nig) / gsz;
        u.a = A + (size_t)pm * a_tile + (size_t)pn * a_colstep; u.b = B + (size_t)pn * b_tile; u.rows = nullptr; u.nrows = 256; u.orow = pm * BM; u.pn = pn; u.aux = 0; return true;
    }
};

template <int RS> struct EpiBf16 {
    static constexpr bool PERM = true;
    bf16_t* O; int ldc; const ssq_t* rs;
    __device__ __forceinline__ void operator()(const f32x4 (&acc)[2][2][4][2], const Unit& u, int wr, int wc, int fr, int fq) const {
        const int row0 = u.orow + launder_v(wr * 64 + fr), col0 = u.pn * BM + wc * 32 + 8 * fq;
        float sc[2][4]; ssq_t rq[2][4];
#pragma unroll
        for (int ai = 0; ai < 2; ++ai)
#pragma unroll
            for (int m = 0; m < 4; ++m) { const int row = row0 + ai * HALF + m * 16; if constexpr (RS != 0) rq[ai][m] = rs[row]; }
#pragma unroll
        for (int ai = 0; ai < 2; ++ai)
#pragma unroll
            for (int m = 0; m < 4; ++m) { sc[ai][m] = 1.0f; if constexpr (RS == 1) sc[ai][m] = rstd_of(rq[ai][m]); if constexpr (RS == 2) sc[ai][m] = rstd_n(rq[ai][m], 1.0f / KVLR); }
#pragma unroll
        for (int ai = 0; ai < 2; ++ai)
#pragma unroll
            for (int m = 0; m < 4; ++m) { const int row = row0 + ai * HALF + m * 16; bf16_t* rowp = O + (size_t)row * ldc + col0;
#pragma unroll
                for (int bj = 0; bj < 2; ++bj) { const f32x4 v0 = acc[ai][bj][m][0] * sc[ai][m], v1 = acc[ai][bj][m][1] * sc[ai][m];
                    u32x4 w; w.x = cvt_pk_bf16(v0[0], v0[1]); w.y = cvt_pk_bf16(v0[2], v0[3]); w.z = cvt_pk_bf16(v1[0], v1[1]); w.w = cvt_pk_bf16(v1[2], v1[3]);
                    *(u32x4*)(rowp + bj * HALF) = w; } }
    }
};
__device__ __forceinline__ float silu_mul(float g, float u) { return g * u * __builtin_amdgcn_rcpf(1.0f + __builtin_amdgcn_exp2f(-1.4426950408889634f * g)); }
template <int RS> struct EpiSwiglu {
    static constexpr bool PERM = true;
    bf16_t* H; int ldh; const void* rs; const int* list;
    __device__ __forceinline__ void operator()(const f32x4 (&acc)[2][2][4][2], const Unit& u, int wr, int wc, int fr, int fq) const {
        const int r0 = launder_v(wr * 64 + fr), col0 = u.pn * HALF + wc * 32 + 8 * fq;
        const ssq_t* rsq = (const ssq_t*)rs; const float* rsp = (const float*)rs; if constexpr (RS == 2) rsp = rsp + (u.rows - list);
        float sc[2][4]; ssq_t rq[2][4];
#pragma unroll
        for (int ai = 0; ai < 2; ++ai)
#pragma unroll
            for (int m = 0; m < 4; ++m) { const int r = r0 + ai * HALF + m * 16; if constexpr (RS == 1) rq[ai][m] = rsq[u.orow + r]; else sc[ai][m] = rsp[r]; }
        if constexpr (RS == 1) {
#pragma unroll
            for (int ai = 0; ai < 2; ++ai)
#pragma unroll
                for (int m = 0; m < 4; ++m) sc[ai][m] = rstd_of(rq[ai][m]); }
#pragma unroll
        for (int ai = 0; ai < 2; ++ai)
#pragma unroll
            for (int m = 0; m < 4; ++m) { const int r = r0 + ai * HALF + m * 16; bf16_t* rowp = H + (size_t)(u.orow + r) * ldh + col0; const float s = sc[ai][m];
                const f32x4 g0 = acc[ai][0][m][0] * s, g1 = acc[ai][0][m][1] * s, u0 = acc[ai][1][m][0] * s, u1 = acc[ai][1][m][1] * s;
                u32x4 w; w.x = cvt_pk_bf16(silu_mul(g0[0], u0[0]), silu_mul(g0[1], u0[1])); w.y = cvt_pk_bf16(silu_mul(g0[2], u0[2]), silu_mul(g0[3], u0[3]));
                w.z = cvt_pk_bf16(silu_mul(g1[0], u1[0]), silu_mul(g1[1], u1[1])); w.w = cvt_pk_bf16(silu_mul(g1[2], u1[2]), silu_mul(g1[3], u1[3]));
                __builtin_nontemporal_store(w, (u32x4*)rowp); }
    }
};
constexpr float FP8_SA = 16.0f, FP8_SW = 256.0f, FP8_SH = 16.0f, FP8_SX = 8.0f;
__device__ __forceinline__ unsigned pk4_fp8(float a, float b, float c, float d) { int p = __builtin_amdgcn_cvt_pk_fp8_f32(a, b, 0, false); p = __builtin_amdgcn_cvt_pk_fp8_f32(c, d, p, true); return (unsigned)p; }
template <int RS> struct EpiSwigluF8 {
    static constexpr bool PERM = true;
    unsigned char* H8; int ldh; int pad_tile; const ssq_t* rs;
    __device__ __forceinline__ void operator()(const f32x4 (&acc)[2][2][4][2], const Unit& u, int wr, int wc, int fr, int fq) const {
        const int r0 = launder_v(wr * 64 + fr), col0 = u.pn * HALF + wc * 32 + 8 * fq;
        float sc[2][4]; ssq_t rq[2][4];
#pragma unroll
        for (int ai = 0; ai < 2; ++ai)
#pragma unroll
            for (int m = 0; m < 4; ++m) { if constexpr (RS == 1) rq[ai][m] = rs[u.orow + r0 + ai * HALF + m * 16]; }
#pragma unroll
        for (int ai = 0; ai < 2; ++ai)
#pragma unroll
            for (int m = 0; m < 4; ++m) { if constexpr (RS == 1) sc[ai][m] = rstd_of(rq[ai][m]) * (1.0f / (FP8_SX * FP8_SW)); else sc[ai][m] = 1.0f / (FP8_SA * FP8_SW); }
#pragma unroll
        for (int ai = 0; ai < 2; ++ai)
#pragma unroll
            for (int m = 0; m < 4; ++m) { const int r = r0 + ai * HALF + m * 16; unsigned char* rowp = H8 + (size_t)(u.orow + r) * ldh + col0; const float s = sc[ai][m];
                const f32x4 g0 = acc[ai][0][m][0] * s, g1 = acc[ai][0][m][1] * s, u0 = acc[ai][1][m][0] * s, u1 = acc[ai][1][m][1] * s;
                u32x2 w; w.x = pk4_fp8(silu_mul(g0[0], u0[0]) * FP8_SH, silu_mul(g0[1], u0[1]) * FP8_SH, silu_mul(g0[2], u0[2]) * FP8_SH, silu_mul(g0[3], u0[3]) * FP8_SH);
                w.y = pk4_fp8(silu_mul(g1[0], u1[0]) * FP8_SH, silu_mul(g1[1], u1[1]) * FP8_SH, silu_mul(g1[2], u1[2]) * FP8_SH, silu_mul(g1[3], u1[3]) * FP8_SH);
                __builtin_nontemporal_store(w, (u32x2*)rowp);
                if (u.pn == pad_tile) { u32x2 z; asm volatile("v_mov_b32 %0, 0\n\tv_mov_b32 %1, 0" : "=v"(z.x), "=v"(z.y)); *(u32x2*)(rowp + HALF) = z; } }
    }
};
struct EpiBf16Scaled {
    static constexpr bool PERM = true;
    bf16_t* O; int ldc; float scale;
    __device__ __forceinline__ void operator()(const f32x4 (&acc)[2][2][4][2], const Unit& u, int wr, int wc, int fr, int fq) const {
        const int row0 = u.orow + launder_v(wr * 64 + fr), col0 = u.pn * BM + wc * 32 + 8 * fq;
#pragma unroll
        for (int ai = 0; ai < 2; ++ai)
#pragma unroll
            for (int m = 0; m < 4; ++m) { bf16_t* rowp = O + (size_t)(row0 + ai * HALF + m * 16) * ldc + col0;
#pragma unroll
                for (int bj = 0; bj < 2; ++bj) { const f32x4 v0 = acc[ai][bj][m][0] * scale, v1 = acc[ai][bj][m][1] * scale;
                    u32x4 w; w.x = cvt_pk_bf16(v0[0], v0[1]); w.y = cvt_pk_bf16(v0[2], v0[3]); w.z = cvt_pk_bf16(v1[0], v1[1]); w.w = cvt_pk_bf16(v1[2], v1[3]);
                    *(u32x4*)(rowp + bj * HALF) = w; } }
    }
};
struct EpiNull {
    static constexpr bool PERM = true;
    float* sink;
    __device__ __forceinline__ void operator()(const f32x4 (&acc)[2][2][4][2], const Unit& u, int wr, int wc, int fr, int fq) const {
        float s = 0.f;
#pragma unroll
        for (int ai = 0; ai < 2; ++ai)
#pragma unroll
            for (int bj = 0; bj < 2; ++bj)
#pragma unroll
                for (int m = 0; m < 4; ++m)
#pragma unroll
                    for (int n = 0; n < 2; ++n) s += acc[ai][bj][m][n][0];
        if (s == 12345.678f) sink[0] = s;
    }
};
template <bool W8> struct EpiResidH {
    static constexpr bool PERM = true;
    const bf16_t* hin; bf16_t* hout; ssq_t* ssq; unsigned char* h8; float scale;
    __device__ __forceinline__ void operator()(const f32x4 (&acc)[2][2][4][2], const Unit& u, int wr, int wc, int fr, int fq) const {
        const int row0 = u.orow + launder_v(wr * 64 + fr), col0 = u.pn * BM + wc * 32 + 8 * fq;
        float part[2][4];
        u32x4 hv[2][4][2];
#pragma unroll
        for (int ai = 0; ai < 2; ++ai)
#pragma unroll
            for (int m = 0; m < 4; ++m)
#pragma unroll
                for (int bj = 0; bj < 2; ++bj) hv[ai][m][bj] = *(const u32x4*)(hin + (size_t)(row0 + ai * HALF + m * 16) * DM + col0 + bj * HALF);
#pragma unroll
        for (int ai = 0; ai < 2; ++ai) {
#pragma unroll
            for (int m = 0; m < 4; ++m) { const int row = row0 + ai * HALF + m * 16; const size_t off = (size_t)row * DM + col0; float pt = 0.f;
#pragma unroll
                for (int bj = 0; bj < 2; ++bj) { const u32x4 h4 = hv[ai][m][bj]; const f32x4 a0 = acc[ai][bj][m][0] * scale, a1 = acc[ai][bj][m][1] * scale;
                    const float y0 = bflo(h4.x) + a0[0], y1 = bfhi(h4.x) + a0[1], y2 = bflo(h4.y) + a0[2], y3 = bfhi(h4.y) + a0[3], y4 = bflo(h4.z) + a1[0], y5 = bfhi(h4.z) + a1[1], y6 = bflo(h4.w) + a1[2], y7 = bfhi(h4.w) + a1[3];
                    pt += (y0 * y0 + y1 * y1) + (y2 * y2 + y3 * y3) + (y4 * y4 + y5 * y5) + (y6 * y6 + y7 * y7);
                    u32x4 w; w.x = cvt_pk_bf16(y0, y1); w.y = cvt_pk_bf16(y2, y3); w.z = cvt_pk_bf16(y4, y5); w.w = cvt_pk_bf16(y6, y7);
                    *(u32x4*)(hout + off + bj * HALF) = w;
                    if constexpr (W8) { u32x2 q; q.x = pk4_fp8(y0 * FP8_SX, y1 * FP8_SX, y2 * FP8_SX, y3 * FP8_SX); q.y = pk4_fp8(y4 * FP8_SX, y5 * FP8_SX, y6 * FP8_SX, y7 * FP8_SX); *(u32x2*)(h8 + off + bj * HALF) = q; } }
                pt += __shfl_xor(pt, 16); pt += __shfl_xor(pt, 32); part[ai][m] = pt; }
        }
        if (fq == 0) {
#pragma unroll
            for (int ai = 0; ai < 2; ++ai)
#pragma unroll
                for (int m = 0; m < 4; ++m) atomicAdd(ssq + row0 + ai * HALF + m * 16, ssq_fix(part[ai][m])); }
    }
};
struct EpiDown {
    static constexpr bool PERM = true;
    bf16_t* O; bf16_t* KR; const ssq_t* rs; ssq_t* ssq_q; ssq_t* ssq_kv; const float* cosT; const float* sinT;
    __device__ __forceinline__ void operator()(const f32x4 (&acc)[2][2][4][2], const Unit& u, int wr, int wc, int fr, int fq) const {
        const int row0 = u.orow + launder_v(wr * 64 + fr);
        float sc[2][4]; ssq_t rq[2][4];
#pragma unroll
        for (int ai = 0; ai < 2; ++ai)
#pragma unroll
            for (int m = 0; m < 4; ++m) rq[ai][m] = rs[row0 + ai * HALF + m * 16];
#pragma unroll
        for (int ai = 0; ai < 2; ++ai)
#pragma unroll
            for (int m = 0; m < 4; ++m) sc[ai][m] = rstd_of(rq[ai][m]);
        if (u.pn < 3) {
            ssq_t* sq = u.pn < 2 ? ssq_q : ssq_kv; const int col0 = u.pn * BM + wc * 32 + 8 * fq; float pts[2][4];
#pragma unroll
            for (int ai = 0; ai < 2; ++ai)
#pragma unroll
                for (int m = 0; m < 4; ++m) { const int row = row0 + ai * HALF + m * 16; bf16_t* rowp = O + (size_t)row * NDOWNP + col0; const float s = sc[ai][m]; float part = 0.f;
#pragma unroll
                    for (int bj = 0; bj < 2; ++bj) { const f32x4 v0 = acc[ai][bj][m][0] * s, v1 = acc[ai][bj][m][1] * s;
                        part += (v0[0] * v0[0] + v0[1] * v0[1]) + (v0[2] * v0[2] + v0[3] * v0[3]) + (v1[0] * v1[0] + v1[1] * v1[1]) + (v1[2] * v1[2] + v1[3] * v1[3]);
                        u32x4 w; w.x = cvt_pk_bf16(v0[0], v0[1]); w.y = cvt_pk_bf16(v0[2], v0[3]); w.z = cvt_pk_bf16(v1[0], v1[1]); w.w = cvt_pk_bf16(v1[2], v1[3]);
                        *(u32x4*)(rowp + bj * HALF) = w; }
                    part += __shfl_xor(part, 16); part += __shfl_xor(part, 32); pts[ai][m] = part; }
            if (fq == 0) {
#pragma unroll
                for (int ai = 0; ai < 2; ++ai)
#pragma unroll
                    for (int m = 0; m < 4; ++m) atomicAdd(sq + row0 + ai * HALF + m * 16, ssq_fix(pts[ai][m])); }
        } else if (wc == 0) {
#pragma unroll
            for (int aq = 0; aq < 4; ++aq) { const int ai = aq >> 1, mb = (aq & 1) * 2; f32x4 ct[4][2], st[4][2];
#pragma unroll
                for (int m = mb; m < mb + 2; ++m) { const size_t to = (size_t)(row0 + ai * HALF + m * 16) * 32 + 8 * fq;
                    ct[m][0] = *(const f32x4*)(cosT + to); ct[m][1] = *(const f32x4*)(cosT + to + 4); st[m][0] = *(const f32x4*)(sinT + to); st[m][1] = *(const f32x4*)(sinT + to + 4); }
#pragma unroll
                for (int m = mb; m < mb + 2; ++m) { const int row = row0 + ai * HALF + m * 16; const float s = sc[ai][m];
                    const f32x4 a0 = acc[ai][0][m][0] * s, a1 = acc[ai][0][m][1] * s, b0 = acc[ai][1][m][0] * s, b1 = acc[ai][1][m][1] * s;
                    const f32x4 x0 = a0 * ct[m][0] - b0 * st[m][0], x1 = a1 * ct[m][1] - b1 * st[m][1], y0 = b0 * ct[m][0] + a0 * st[m][0], y1 = b1 * ct[m][1] + a1 * st[m][1];
                    bf16_t* rp = KR + (size_t)row * DROPE + 8 * fq;
                    u32x4 w; w.x = cvt_pk_bf16(x0[0], x0[1]); w.y = cvt_pk_bf16(x0[2], x0[3]); w.z = cvt_pk_bf16(x1[0], x1[1]); w.w = cvt_pk_bf16(x1[2], x1[3]);
                    *(u32x4*)rp = w;
                    w.x = cvt_pk_bf16(y0[0], y0[1]); w.y = cvt_pk_bf16(y0[2], y0[3]); w.z = cvt_pk_bf16(y1[0], y1[1]); w.w = cvt_pk_bf16(y1[2], y1[3]);
                    *(u32x4*)(rp + 32) = w; } }
        }
    }
};
struct EpiQ {
    static constexpr bool PERM = true;
    bf16_t* Q; const float* cosT; const float* sinT; const ssq_t* rs;
    __device__ __forceinline__ void operator()(const f32x4 (&acc)[2][2][4][2], const Unit& u, int wr, int wc, int fr, int fq) const {
        const int row0 = u.orow + launder_v(wr * 64 + fr);
        float sc[2][4]; ssq_t rq[2][4];
#pragma unroll
        for (int ai = 0; ai < 2; ++ai)
#pragma unroll
            for (int m = 0; m < 4; ++m) rq[ai][m] = rs[row0 + ai * HALF + m * 16];
#pragma unroll
        for (int ai = 0; ai < 2; ++ai)
#pragma unroll
            for (int m = 0; m < 4; ++m) sc[ai][m] = rstd_n(rq[ai][m], 1.0f / QLR);
        if (u.pn < 2) {
            const int h = 4 * u.pn + wc;
#pragma unroll
            for (int aq = 0; aq < 4; ++aq) { const int ai = aq >> 1, mb = (aq & 1) * 2; f32x4 ct[4][2], st[4][2];
#pragma unroll
                for (int m = mb; m < mb + 2; ++m) { const size_t to = (size_t)(row0 + ai * HALF + m * 16) * 32 + 8 * fq;
                    ct[m][0] = *(const f32x4*)(cosT + to); ct[m][1] = *(const f32x4*)(cosT + to + 4); st[m][0] = *(const f32x4*)(sinT + to); st[m][1] = *(const f32x4*)(sinT + to + 4); }
#pragma unroll
                for (int m = mb; m < mb + 2; ++m) { const int row = row0 + ai * HALF + m * 16; const float s = sc[ai][m];
                    const f32x4 a0 = acc[ai][0][m][0] * s, a1 = acc[ai][0][m][1] * s, b0 = acc[ai][1][m][0] * s, b1 = acc[ai][1][m][1] * s;
                    const f32x4 x0 = a0 * ct[m][0] - b0 * st[m][0], x1 = a1 * ct[m][1] - b1 * st[m][1], y0 = b0 * ct[m][0] + a0 * st[m][0], y1 = b1 * ct[m][1] + a1 * st[m][1];
                    bf16_t* rp = Q + (size_t)row * NQ + h * DQH + DNOPE + 8 * fq;
                    u32x4 w; w.x = cvt_pk_bf16(x0[0], x0[1]); w.y = cvt_pk_bf16(x0[2], x0[3]); w.z = cvt_pk_bf16(x1[0], x1[1]); w.w = cvt_pk_bf16(x1[2], x1[3]);
                    *(u32x4*)rp = w;
                    w.x = cvt_pk_bf16(y0[0], y0[1]); w.y = cvt_pk_bf16(y0[2], y0[3]); w.z = cvt_pk_bf16(y1[0], y1[1]); w.w = cvt_pk_bf16(y1[2], y1[3]);
                    *(u32x4*)(rp + 32) = w; } }
        } else {
#pragma unroll
            for (int ai = 0; ai < 2; ++ai)
#pragma unroll
                for (int m = 0; m < 4; ++m) { const int row = row0 + ai * HALF + m * 16; const float s = sc[ai][m];
#pragma unroll
                    for (int bj = 0; bj < 2; ++bj) { const int h = 2 * (u.pn - 2) + bj; const f32x4 v0 = acc[ai][bj][m][0] * s, v1 = acc[ai][bj][m][1] * s;
                        u32x4 w; w.x = cvt_pk_bf16(v0[0], v0[1]); w.y = cvt_pk_bf16(v0[2], v0[3]); w.z = cvt_pk_bf16(v1[0], v1[1]); w.w = cvt_pk_bf16(v1[2], v1[3]);
                        *(u32x4*)(Q + (size_t)row * NQ + h * DQH + wc * 32 + 8 * fq) = w; } }
        }
    }
};

__device__ __forceinline__ unsigned gather_off(const Unit& u, int idx, unsigned lda_b, unsigned cb) { const int tok = idx < u.nrows ? u.rows[idx] : 0; return (unsigned)tok * lda_b + cb; }
__device__ __forceinline__ u32x4 gather_offs(const Unit& u, int tid, unsigned lda_b) {
    const int t2 = launder_v(tid); int R0, C0, R1, C1; stage_rc(t2 * 16, R0, C0); stage_rc(t2 * 16 + 8192, R1, C1);
    u32x4 pk; pk.x = gather_off(u, R0, lda_b, (unsigned)C0 * 2u); pk.y = gather_off(u, R1, lda_b, (unsigned)C1 * 2u); pk.z = gather_off(u, HALF + R0, lda_b, (unsigned)C0 * 2u); pk.w = gather_off(u, HALF + R1, lda_b, (unsigned)C1 * 2u);
    return pk;
}
typedef int i32x4 __attribute__((ext_vector_type(4)));
typedef int i32x8 __attribute__((ext_vector_type(8)));
template <class Epi, class Sched, bool GATHER, bool FP8 = false>
__device__ __forceinline__ void gemm_phase(LAS unsigned char* lds, const unsigned lda_b, const unsigned ldb_b, const int Kb, const Sched& S, const Epi& E, const unsigned stag_ticks = 0u) {
    if (stag_ticks) { const unsigned long long t0 = __builtin_amdgcn_s_memrealtime(), dl = (unsigned long long)((blockIdx.x >> 3) & 3u) * stag_ticks;
        while (__builtin_amdgcn_s_memrealtime() - t0 < dl) __builtin_amdgcn_s_sleep(8); }
    const int tid = launder_v((int)threadIdx.x), wid = __builtin_amdgcn_readfirstlane(tid >> 6), lane = tid & 63, wr = wid >> 2, wc = wid & 3, fr = lane & 15, fq = lane >> 4;
    int nt = Kb / (BK * 2); asm volatile("" : "+s"(nt));
    unsigned voffA[2], voffB[2];
#pragma unroll
    for (int i = 0; i < 2; ++i) { int R, C; stage_rc(tid * 16 + i * 8192, R, C); const int Rb = Epi::PERM ? ((R & ~31) + perm32(R & 31)) : R;
        voffA[i] = (unsigned)R * lda_b + (unsigned)C * 2u; voffB[i] = (unsigned)Rb * ldb_b + (unsigned)C * 2u; }
    const size_t kstep = (size_t)(BK * 2);
    const size_t hstepA = (size_t)HALF * lda_b, hstepB = (size_t)HALF * ldb_b;
    const unsigned ldsw = (unsigned)wid * 1024u, ldsbase = (unsigned)__builtin_amdgcn_readfirstlane((int)(unsigned)(size_t)lds);
    const int aoff = lds_byte(wr * 64 + fr, fq * 8), boff = lds_byte(wc * 32 + fr, fq * 8);
    unsigned cv0[2] = {0u, 0u}, cv1[2] = {0u, 0u}, nv0[2] = {0u, 0u}, nv1[2] = {0u, 0u};
#define PG8_SA(b, h) (((b) * 2 + (h)) * HTB)
#define PG8_SB(b, h) ((4 + (b) * 2 + (h)) * HTB)
#define PG8_LOAD16(sbase, voff, ldsoff) do { unsigned _keep; asm volatile("s_mov_b32 %0, m0\n\ts_mov_b32 m0, %3\n\ts_nop 0\n\tglobal_load_lds_dwordx4 %1, %2\n\ts_mov_b32 m0, %0" \
        : "=&s"(_keep) : "v"(voff), "s"(sbase), "s"(ldsbase + (unsigned)(ldsoff)) : "memory"); } while (0)
#define PG8_STAGE_B(bufoff, gbase, h) do { _Pragma("unroll") for (int _i = 0; _i < 2; ++_i) PG8_LOAD16((gbase) + (h) * hstepB, voffB[_i], (bufoff) + ldsw + _i * 8192); } while (0)
#define PG8_STAGE_A(bufoff, gbase, h, usenext) do { _Pragma("unroll") for (int _i = 0; _i < 2; ++_i) { unsigned _vo; \
        if constexpr (GATHER) { _vo = (usenext) ? ((h) ? nv1[_i] : nv0[_i]) : ((h) ? cv1[_i] : cv0[_i]); PG8_LOAD16((gbase), _vo, (bufoff) + ldsw + _i * 8192); } \
        else { PG8_LOAD16((gbase) + (h) * hstepA, voffA[_i], (bufoff) + ldsw + _i * 8192); } } } while (0)
#define PG8_LD32(off) __builtin_shufflevector(*(const LAS i32x4*)(lds + (off)), *(const LAS i32x4*)(lds + (off) + 1024), 0, 1, 2, 3, 4, 5, 6, 7)
#define PG8_LDA(dst, b, h) do { _Pragma("unroll") for (int m = 0; m < 4; ++m) { if constexpr (FP8) { dst##8[m] = PG8_LD32(PG8_SA(b, h) + aoff + m * 2048); } else { _Pragma("unroll") for (int k = 0; k < 2; ++k) dst[m][k] = *(const LAS bf16x8*)(lds + PG8_SA(b, h) + aoff + m * 2048 + k * 1024); } } } while (0)
#define PG8_LDB(dst, b, h) do { _Pragma("unroll") for (int n = 0; n < 2; ++n) { if constexpr (FP8) { dst##8[n] = PG8_LD32(PG8_SB(b, h) + boff + n * 2048); } else { _Pragma("unroll") for (int k = 0; k < 2; ++k) dst[n][k] = *(const LAS bf16x8*)(lds + PG8_SB(b, h) + boff + n * 2048 + k * 1024); } } } while (0)
#define PG8_MMA(ai, bj, At, Bt) do { __builtin_amdgcn_s_setprio(1); _Pragma("unroll") for (int m = 0; m < 4; ++m) _Pragma("unroll") for (int n = 0; n < 2; ++n) { \
        if constexpr (FP8) { asm volatile("v_mfma_f32_16x16x128_f8f6f4 %0, %1, %2, %0" : "+v"(acc[ai][bj][m][n]) : "v"(Bt##8[n]), "v"(At##8[m])); }     \
        else { _Pragma("unroll") for (int k = 0; k < 2; ++k) acc[ai][bj][m][n] = __builtin_amdgcn_mfma_f32_16x16x32_bf16(Bt[n][k], At[m][k], acc[ai][bj][m][n], 0, 0, 0); } } \
        __builtin_amdgcn_s_setprio(0); } while (0)
#define PG8_WAIT_V(n) asm volatile("s_waitcnt vmcnt(" #n ")" ::: "memory")
#define PG8_WAIT_L(n) asm volatile("s_waitcnt lgkmcnt(" #n ")" ::: "memory")
#define PG8_BAR __builtin_amdgcn_s_barrier()
#define PG8_SCHED __builtin_amdgcn_sched_barrier(0)
    Unit cur, nxt; int ui = 0;
    (void)S.next(0, cur);
    f32x4 acc[2][2][4][2];
#pragma unroll
    for (int a = 0; a < 2; ++a)
#pragma unroll
        for (int b = 0; b < 2; ++b)
#pragma unroll
            for (int m = 0; m < 4; ++m)
#pragma unroll
                for (int n = 0; n < 2; ++n) acc[a][b][m][n] = (f32x4){0.f, 0.f, 0.f, 0.f};
    bf16x8 At[4][2], B0[2][2], B1[2][2]; i32x8 At8[4], B08[2], B18[2];
    const char* cA = cur.a; const char* cB = cur.b;
    if constexpr (GATHER) { const u32x4 pk = gather_offs(cur, tid, lda_b); cv0[0] = pk.x; cv0[1] = pk.y; cv1[0] = pk.z; cv1[1] = pk.w; }
    PG8_STAGE_B(PG8_SB(0, 0), cB, 0); PG8_SCHED; PG8_STAGE_B(PG8_SB(0, 1), cB, 1); PG8_SCHED; PG8_STAGE_A(PG8_SA(0, 0), cA, 0, false); PG8_SCHED; PG8_STAGE_A(PG8_SA(0, 1), cA, 1, false);
    if (wr == 1) PG8_BAR;
    PG8_WAIT_V(2); PG8_BAR;
    PG8_STAGE_B(PG8_SB(1, 0), cB + kstep, 0); PG8_SCHED; PG8_STAGE_A(PG8_SA(1, 0), cA + kstep, 0, false); PG8_SCHED; PG8_STAGE_B(PG8_SB(1, 1), cB + kstep, 1);
    PG8_WAIT_V(6); PG8_BAR;
    for (;;) {
        int has_next = 0; const char* nA = cA; const char* nB = cB;
        if constexpr (GATHER) { has_next = __builtin_amdgcn_readfirstlane(S.next(ui + 1, nxt) ? 1 : 0); nA = has_next ? nxt.a : cA; nB = has_next ? nxt.b : cB; }
        if constexpr (GATHER) {
            u32x4 pk = (u32x4){cv0[0], cv0[1], cv1[0], cv1[1]}; if (has_next) pk = gather_offs(nxt, tid, lda_b);
            *(LAS u32x4*)(lds + STAGE_BYTES + 1024 + tid * 16) = pk;
        }
#pragma nounroll
        for (int t = 0; t < nt; t += 2) {
            const bool last = (t == nt - 2);
            if constexpr (!GATHER) { if (last) { int uin = ui + 1; asm volatile("" : "+s"(uin)); has_next = __builtin_amdgcn_readfirstlane(S.next(uin, nxt) ? 1 : 0); nA = has_next ? nxt.a : cA; nB = has_next ? nxt.b : cB; } }
            if constexpr (GATHER) { if (last) { const u32x4 pk = *(const LAS u32x4*)(lds + STAGE_BYTES + 1024 + tid * 16); nv0[0] = pk.x; nv0[1] = pk.y; nv1[0] = pk.z; nv1[1] = pk.w; } }
            const char* a1 = cA + (size_t)(t + 1) * kstep;
            const char* a2 = last ? nA : cA + (size_t)(t + 2) * kstep; const char* b2 = last ? nB : cB + (size_t)(t + 2) * kstep;
            const char* a3 = a2 + kstep; const char* b3 = b2 + kstep;
            PG8_LDB(B0, 0, 0); PG8_LDB(B1, 0, 1); PG8_SCHED; PG8_LDA(At, 0, 0); PG8_STAGE_A(PG8_SA(1, 1), a1, 1, false);
            PG8_WAIT_V(8); PG8_WAIT_L(0); PG8_BAR; PG8_MMA(0, 0, At, B0); PG8_MMA(0, 1, At, B1); PG8_BAR; PG8_SCHED;
            PG8_LDA(At, 0, 1); PG8_STAGE_B(PG8_SB(0, 0), b2, 0); PG8_STAGE_B(PG8_SB(0, 1), b2, 1); PG8_STAGE_A(PG8_SA(0, 0), a2, 0, last);
            PG8_WAIT_V(8); PG8_WAIT_L(0); PG8_BAR; PG8_MMA(1, 0, At, B0); PG8_MMA(1, 1, At, B1); PG8_BAR; PG8_SCHED;
            PG8_LDB(B0, 1, 0); PG8_LDB(B1, 1, 1); PG8_SCHED; PG8_LDA(At, 1, 0); PG8_STAGE_A(PG8_SA(0, 1), a2, 1, last);
            PG8_WAIT_V(8); PG8_WAIT_L(0); PG8_BAR; PG8_MMA(0, 0, At, B0); PG8_MMA(0, 1, At, B1); PG8_BAR; PG8_SCHED;
            PG8_LDA(At, 1, 1); PG8_STAGE_B(PG8_SB(1, 0), b3, 0); PG8_STAGE_B(PG8_SB(1, 1), b3, 1); PG8_STAGE_A(PG8_SA(1, 0), a3, 0, last);
            PG8_WAIT_V(8); PG8_WAIT_L(0); PG8_BAR; PG8_MMA(1, 0, At, B0); PG8_MMA(1, 1, At, B1); PG8_BAR; PG8_SCHED;
        }
        if (wr == 0) PG8_BAR;
        if constexpr (FP8) asm volatile("s_nop 15\n\ts_nop 15" ::: "memory");
        E(acc, cur, wr, wc, fr, fq);
        if (!has_next) break;
#pragma unroll
        for (int a = 0; a < 2; ++a)
#pragma unroll
            for (int b = 0; b < 2; ++b)
#pragma unroll
                for (int m = 0; m < 4; ++m)
#pragma unroll
                    for (int n = 0; n < 2; ++n) acc[a][b][m][n] = (f32x4){0.f, 0.f, 0.f, 0.f};
        cur = nxt; cA = nA; cB = nB; ++ui;
        if constexpr (GATHER) {
#pragma unroll
            for (int i = 0; i < 2; ++i) { cv0[i] = nv0[i]; cv1[i] = nv1[i]; }
        }
        if (wr == 1) PG8_BAR;
    }
    PG8_WAIT_V(0);
    PG8_BAR;
#undef PG8_SA
#undef PG8_SB
#undef PG8_LOAD16
#undef PG8_STAGE_A
#undef PG8_STAGE_B
#undef PG8_LDA
#undef PG8_LDB
#undef PG8_LD32
#undef PG8_MMA
#undef PG8_WAIT_V
#undef PG8_WAIT_L
#undef PG8_BAR
#undef PG8_SCHED
}
}
namespace att {
constexpr int NW = 8, QBLK = 32, KVBLK = 64, QB = NW * QBLK;
constexpr int DQK = 192, DV = 128;
constexpr int QS = NQ, KNS = NKV, KRS = DROPE, OS = DM;
constexpr int SHM_V = KVBLK * DV * 2, SHM_K = KVBLK * DQK * 2;
constexpr int LDS_QR = 2 * SHM_V + 2 * SHM_K + NW * 64 * 4;
constexpr int LDS_BYTES = LDS_QR + NW * 4096;
constexpr float SCALE = 0.07216878364870322f;
constexpr float THR = 8.f;
#define KSWZ(row, ch) ((row) * 384 + ((((ch) ^ (((row) >> 1) & 7))) << 4))
#define SBAR() __builtin_amdgcn_sched_barrier(0)
__device__ __forceinline__ int v_st(int k, int c) { const int kk = (k & ~0xC) | ((k & 4) << 1) | ((k & 8) >> 1); return ((kk >> 3) * 4 + (c >> 5)) * 512 + ((kk & 7) * 32 + (c & 31)) * 2; }
__device__ __forceinline__ int v_rd_base(int lane) { return ((lane & 3) << 3) | (((lane >> 2) & 3) << 6) | (((lane >> 4) & 1) << 5) | (((lane >> 5) & 1) << 8); }
constexpr int v_rd_off(int d0, int ks, int half) { return d0 * 512 + ks * 4096 + half * 2048; }
__device__ __forceinline__ int crow(int r, int hi) { return (r & 3) + 8 * (r >> 2) + 4 * hi; }
__device__ __forceinline__ void mask_tile(f32x16& p0, f32x16& p1, int dq) {
    const float NEG = -__builtin_inff();
#pragma unroll
    for (int r = 0; r < 16; ++r) {
        const int c = (r & 3) + 8 * (r >> 2);
        if (dq - c < 0) p0[r] = NEG;
        if (dq - c - 32 < 0) p1[r] = NEG;
    }
}
__device__ __forceinline__ void partialSM(f32x16& p0, f32x16& p1, float& m_reg, float& mn, float& alpha) {
    float pmax = p0[0]; for (int r = 1; r < 16; ++r) pmax = fmaxf(pmax, p0[r]); for (int r = 0; r < 16; ++r) pmax = fmaxf(pmax, p1[r]);
    { auto rr = __builtin_amdgcn_permlane32_swap(__float_as_uint(pmax), __float_as_uint(pmax), false, false);
      pmax = fmaxf(__uint_as_float(rr[0]), __uint_as_float(rr[1])); }
    constexpr float C2 = 1.4426950408889634f * SCALE;
    if (__builtin_expect(__all((pmax - m_reg) * SCALE <= THR), 1)) { mn = m_reg; alpha = 1.f; }
    else { mn = fmaxf(m_reg, pmax); alpha = __builtin_amdgcn_exp2f((m_reg - mn) * C2); m_reg = mn; }
    const float mnL = -mn * C2;
    for (int r = 0; r < 16; ++r) p0[r] = fmaf(p0[r], C2, mnL); for (int r = 0; r < 16; ++r) p1[r] = fmaf(p1[r], C2, mnL);
    for (int r = 0; r < 16; ++r) p0[r] = __builtin_amdgcn_exp2f(p0[r]);
}
__device__ __forceinline__ void finishSM(f32x16& p0, f32x16& p1, float alpha, float& l_reg, bf16x8& pa0, bf16x8& pa1, bf16x8& pa2, bf16x8& pa3) {
    for (int r = 0; r < 16; ++r) p1[r] = __builtin_amdgcn_exp2f(p1[r]);
    float ps = 0; for (int r = 0; r < 16; ++r) ps += p0[r]; for (int r = 0; r < 16; ++r) ps += p1[r];
    { auto rr = __builtin_amdgcn_permlane32_swap(__float_as_uint(ps), __float_as_uint(ps), false, false);
      ps = __uint_as_float(rr[0]) + __uint_as_float(rr[1]); }
    l_reg = l_reg * alpha + ps;
#define PK4(P, B_, OUT) do { unsigned a0 = cvt_pk_bf16(P[B_+0], P[B_+1]), a1 = cvt_pk_bf16(P[B_+2], P[B_+3]);                          \
        unsigned b0 = cvt_pk_bf16(P[B_+4], P[B_+5]), b1 = cvt_pk_bf16(P[B_+6], P[B_+7]);                                             \
        auto r0 = __builtin_amdgcn_permlane32_swap(a0, b0, false, false); auto r1 = __builtin_amdgcn_permlane32_swap(a1, b1, false, false); \
        u32x4 w = {r0[0], r1[0], r0[1], r1[1]}; OUT = *reinterpret_cast<bf16x8*>(&w); } while (0)
    PK4(p0, 0, pa0); PK4(p0, 8, pa1); PK4(p1, 0, pa2); PK4(p1, 8, pa3);
#undef PK4
}
template <int KB>
__device__ __forceinline__ void qkt(f32x16& p0, f32x16& p1, const char* K_lds, int r32, int hi, const bf16x8* qr, const char* qrl) {
    p0 = f32x16{}; p1 = f32x16{};
    const char* kb[4];
#pragma unroll
    for (int dd = 0; dd < 4; ++dd) kb[dd] = K_lds + KB * SHM_K + KSWZ(r32, dd * 2 + hi);
#pragma unroll
    for (int d0 = 0; d0 < 12; ++d0) { const char* a = kb[d0 & 3] + (d0 >> 2) * 128;
        bf16x8 b0 = *reinterpret_cast<const bf16x8*>(a);
        bf16x8 b1 = *reinterpret_cast<const bf16x8*>(a + 32 * 384);
        const bf16x8 qf = d0 < 8 ? qr[d0 & 7] : *reinterpret_cast<const bf16x8*>(qrl + (d0 - 8) * 1024);
        p0 = __builtin_amdgcn_mfma_f32_32x32x16_bf16(b0, qf, p0, 0, 0, 0);
        p1 = __builtin_amdgcn_mfma_f32_32x32x16_bf16(b1, qf, p1, 0, 0, 0);
        if ((d0 & 3) == 3 && d0 < 11) SBAR(); }
}
template <int VB>
__device__ __forceinline__ void pv_tile(f32x16* o, int vb0, bf16x8 pa0, bf16x8 pa1, bf16x8 pa2, bf16x8 pa3) {
#define TRRD(dst, off) asm volatile("ds_read_b64_tr_b16 %0, %1 offset:%2" : "=&v"(dst) : "v"(vb0), "i"(off) : "memory")
#define PV_D0(d0) do { s16x4 l0, l1, l2, l3, h0, h1, h2, h3; constexpr int b_ = VB * SHM_V + v_rd_off(d0, 0, 0); \
        TRRD(l0, b_); TRRD(h0, b_ + 2048); TRRD(l1, b_ + 4096); TRRD(h1, b_ + 6144); TRRD(l2, b_ + 8192); TRRD(h2, b_ + 10240); TRRD(l3, b_ + 12288); TRRD(h3, b_ + 14336); \
        asm volatile("s_waitcnt lgkmcnt(0)" ::: "memory"); SBAR();   \
        o[d0] = __builtin_amdgcn_mfma_f32_32x32x16_bf16(pa0, (bf16x8){l0[0], l0[1], l0[2], l0[3], h0[0], h0[1], h0[2], h0[3]}, o[d0], 0, 0, 0);   \
        o[d0] = __builtin_amdgcn_mfma_f32_32x32x16_bf16(pa1, (bf16x8){l1[0], l1[1], l1[2], l1[3], h1[0], h1[1], h1[2], h1[3]}, o[d0], 0, 0, 0);   \
        o[d0] = __builtin_amdgcn_mfma_f32_32x32x16_bf16(pa2, (bf16x8){l2[0], l2[1], l2[2], l2[3], h2[0], h2[1], h2[2], h2[3]}, o[d0], 0, 0, 0);   \
        o[d0] = __builtin_amdgcn_mfma_f32_32x32x16_bf16(pa3, (bf16x8){l3[0], l3[1], l3[2], l3[3], h3[0], h3[1], h3[2], h3[3]}, o[d0], 0, 0, 0); } while (0)
    PV_D0(0); PV_D0(1); PV_D0(2); PV_D0(3);
#undef PV_D0
#undef TRRD
}
struct BlockRef { const bf16_t* Q; const bf16_t* Kn; const bf16_t* Kr; const bf16_t* V; bf16_t* O; int P0; };
struct Seam { bf16x8 qr[8]; bf16x8 st_v0, st_v1, st_k0, st_k1, st_k2; };
#define VMW() asm volatile("s_waitcnt vmcnt(0)" ::: "memory")
#define VMWN(n) asm volatile("s_waitcnt vmcnt(%0)" :: "i"(n) : "memory")
#define LD8(p) (*reinterpret_cast<const bf16x8*>(p))
#define SLOAD_H(R_, k0) do { S.st_v0 = LD8((R_).V + (size_t)((k0) + sr) * KNS + sc); S.st_v1 = LD8((R_).V + (size_t)((k0) + 32 + sr) * KNS + sc);              \
                             S.st_k0 = LD8((R_).Kn + (size_t)((k0) + sr) * KNS + sc); S.st_k1 = LD8((R_).Kn + (size_t)((k0) + 32 + sr) * KNS + sc);            \
                             S.st_k2 = LD8((R_).Kr + (size_t)((k0) + rr) * KRS + rc); } while (0)
#define SWRITE_HK(bf) do { *(bf16x8*)(K_lds + (bf) * SHM_K + kws) = S.st_k0; *(bf16x8*)(K_lds + (bf) * SHM_K + kws + 32 * 384) = S.st_k1; *(bf16x8*)(K_lds + (bf) * SHM_K + kws2) = S.st_k2; } while (0)
#define SWRITE_HV(bf) do { *(bf16x8*)(V_lds + (bf) * SHM_V + vst0) = S.st_v0; *(bf16x8*)(V_lds + (bf) * SHM_V + vst1) = S.st_v1; } while (0)
#define SWRITE_H(bf) do { SWRITE_HV(bf); SWRITE_HK(bf); } while (0)
#define ATT_IDX const int tid = launder_v((int)threadIdx.x), wid = __builtin_amdgcn_readfirstlane(tid >> 6), lane = tid & 63, r32 = lane & 31, hi = lane >> 5; \
    const int sr = tid >> 4, sc = (tid & 15) * 8, rr = tid >> 3, rc = (tid & 7) * 8, kws = KSWZ(sr, (tid & 15)), kws2 = KSWZ(rr, 16 + (tid & 7));
__device__ __forceinline__ void attn_block(const BlockRef& cur, char* lds) {
    ATT_IDX;
    Seam S;
    const int NT = cur.P0 / KVBLK + QB / KVBLK;
    const int qlo = cur.P0 + wid * QBLK, qm = qlo + r32 - 4 * hi;
    char* V_lds = lds; char* K_lds = lds + 2 * SHM_V;
    float* ws = (float*)(lds + 2 * SHM_V + 2 * SHM_K) + wid * 64; float* li_l = ws, * al_l = ws + 32;
    float m_reg = -1e30f, l_reg = 0; f32x16 o[4] = {};
    const int vst0 = v_st(sr, sc), vst1 = v_st(32 + sr, sc);
    const int vb0 = (int)(uintptr_t)V_lds + v_rd_base(lane);
    char* qrl = lds + LDS_QR + wid * 4096 + lane * 16;
#define RESC(a) do { if (__any((a) < 1.f)) { if (hi == 0) al_l[r32] = (a); asm volatile("s_waitcnt lgkmcnt(0)" ::: "memory");              \
                     for (int d_ = 0; d_ < 4; ++d_) for (int r = 0; r < 16; ++r) o[d_][r] *= al_l[crow(r, hi)]; } } while (0)
#define KBASE(t) ((t) * KVBLK)
#define MASKT(P0_, P1_, t) do { const int kb_ = KBASE(t); if (kb_ + KVBLK - 1 > qlo) mask_tile(P0_, P1_, qm - kb_); } while (0)
    SLOAD_H(cur, 0);
#pragma unroll
    for (int d0 = 0; d0 < 8; ++d0) S.qr[d0] = LD8(cur.Q + (size_t)(wid * QBLK + r32) * QS + d0 * 16 + hi * 8);
    { bf16x8 t0 = LD8(cur.Q + (size_t)(wid * QBLK + r32) * QS + 128 + hi * 8), t1 = LD8(cur.Q + (size_t)(wid * QBLK + r32) * QS + 144 + hi * 8),
             t2 = LD8(cur.Q + (size_t)(wid * QBLK + r32) * QS + 160 + hi * 8), t3 = LD8(cur.Q + (size_t)(wid * QBLK + r32) * QS + 176 + hi * 8);
      *(bf16x8*)(qrl) = t0; *(bf16x8*)(qrl + 1024) = t1; *(bf16x8*)(qrl + 2048) = t2; *(bf16x8*)(qrl + 3072) = t3; }
    VMW(); SWRITE_H(0);
    __syncthreads();
    f32x16 p0, p1; float mn, al; bf16x8 pa0, pa1, pa2, pa3;
#define TILE_STEP(t, BF) do {                                                                                                 \
        if ((t) + 1 < NT) { SLOAD_H(cur, KBASE((t) + 1)); }                                                                    \
        SBAR();                                                                                                               \
        if (KBASE(t) <= qlo + QBLK - 1) {     \
        qkt<BF>(p0, p1, K_lds, r32, hi, S.qr, qrl);                                                                           \
        MASKT(p0, p1, (t)); partialSM(p0, p1, m_reg, mn, al); RESC(al);                                                        \
        finishSM(p0, p1, al, l_reg, pa0, pa1, pa2, pa3); SBAR();                                                              \
        pv_tile<BF>(o, vb0, pa0, pa1, pa2, pa3); }                                                                            \
        if ((t) + 1 < NT) { VMW(); SWRITE_H(1 - BF); }                                                                         \
        __syncthreads(); } while (0)
    for (int t = 0; t < NT; t += 2) { TILE_STEP(t, 0); TILE_STEP(t + 1, 1); }
    if (hi == 0) li_l[r32] = l_reg; asm volatile("s_waitcnt lgkmcnt(0)" ::: "memory");
    float rli[16];
#pragma unroll
    for (int r = 0; r < 16; ++r) rli[r] = __builtin_amdgcn_rcpf(li_l[crow(r, hi)]);
    bf16_t* Ow = cur.O + (size_t)(wid * QBLK) * OS;
#pragma unroll
    for (int r = 0; r < 16; ++r) { const int orow = crow(r, hi);
#pragma unroll
        for (int d0 = 0; d0 < 4; ++d0) { const float v = o[d0][r] * rli[r];
            const float vn = __shfl_xor(v, 1);
            if ((r32 & 1) == 0) *(unsigned*)(Ow + (size_t)orow * OS + d0 * 32 + r32) = cvt_pk_bf16(v, vn); } }
    __syncthreads();
#undef RESC
#undef KBASE
#undef MASKT
#undef TILE_STEP
}
#undef VMW
#undef VMWN
#undef LD8
#undef SLOAD_H
#undef SWRITE_HK
#undef SWRITE_HV
#undef SWRITE_H
#undef ATT_IDX
#undef KSWZ
#undef SBAR

__device__ __forceinline__ BlockRef make_ref(int L, int pass, const bf16_t* Qb, const bf16_t* KNVb, const bf16_t* KRb, bf16_t* Ob) {
    const int bh = L >> 2, x = L & 3, qb = pass ? 7 - x : x, b = bh >> 3, h = bh & 7; const size_t rb = (size_t)b * SEQ;
    BlockRef r; r.Q = Qb + (rb + (size_t)qb * QB) * QS + h * DQH; r.Kn = KNVb + rb * KNS + h * (DNOPE + DVH); r.Kr = KRb + rb * KRS; r.V = KNVb + rb * KNS + h * (DNOPE + DVH) + DNOPE;
    r.O = Ob + (rb + (size_t)qb * QB) * OS + h * DVH; r.P0 = qb * QB; return r;
}
__device__ __forceinline__ void attn_phase(char* lds, const bf16_t* Qb, const bf16_t* KNVb, const bf16_t* KRb, bf16_t* Ob, int first, int stride) {
    constexpr int total = NBATCH * NHEAD * 4;
    for (int L = first; L < total; L += stride) {
        for (int pass = 0; pass < 2; ++pass) { const BlockRef cur = make_ref(L, pass, Qb, KNVb, KRb, Ob); attn_block(cur, lds); }
    }
}
}
constexpr int NWAVES = 8;
constexpr size_t MiB = 1u << 20;
constexpr size_t WS_CTL = 0, CTL_ZERO_BYTES = 8 * MiB;
constexpr size_t WS_SSQ = 1 * MiB;
constexpr size_t WS_COS = 8 * MiB, WS_SIN = 16 * MiB;
constexpr size_t WS_LIST = 24 * MiB;
constexpr size_t WS_RSL = 26 * MiB;
constexpr size_t WS_TOKINFO = 28 * MiB;
constexpr size_t WS_WDN = 30 * MiB, WS_WUQ = 34 * MiB, WS_WUKV = 37 * MiB, WS_WO = 39 * MiB, WS_WPOOL = 43 * MiB, WS_WGU = 44 * MiB, WS_WD = 65 * MiB, WS_MWGU = 76 * MiB, WS_MWD = 164 * MiB;
constexpr size_t WS_H = 208 * MiB;
constexpr size_t WS_ACT = 336 * MiB;
constexpr size_t WS_DOWN = WS_ACT;
constexpr size_t WS_CQN = WS_ACT + 128 * MiB, WS_CKVN = WS_ACT + 192 * MiB, WS_KR = WS_ACT + 224 * MiB, WS_Q = WS_ACT + 232 * MiB, WS_KNV = WS_ACT + 424 * MiB;
constexpr size_t WS_HID = WS_ACT;
constexpr size_t WS_YB = WS_ACT + 358 * MiB;
constexpr size_t WS_DUMMY = WS_ACT + 424 * MiB;
constexpr size_t WS_H8 = WS_ACT + 618 * MiB;
constexpr int FFD8 = 2816;
constexpr int FFE8 = 1536;
constexpr size_t WS_END = WS_ACT + 682 * MiB;
static_assert(WS_MWD + (size_t)16 * 1024 * FFEP * 2 <= WS_H && WS_MWGU + (size_t)16 * 2 * FFEP * 1024 * 2 <= WS_MWD && WS_WD + (size_t)2 * 1024 * FFD * 2 <= WS_MWGU && WS_WGU + (size_t)2 * 2 * FFD * 1024 * 2 <= WS_WD, "weights map");
static_assert(WS_HID + (size_t)PSLOT * FFEP * 2 <= WS_YB && WS_YB + (size_t)PSLOT * 1024 * 2 <= WS_END && WS_HID + (size_t)NTOK * FFD * 2 <= WS_END && WS_KNV + (size_t)NTOK * NKV * 2 <= WS_END && WS_Q + (size_t)NTOK * NQ * 2 <= WS_KNV, "activation map");
static_assert(WS_SSQ + (size_t)14 * NTOK * 8 <= WS_COS && WS_COS <= CTL_ZERO_BYTES + WS_COS && WS_END <= 1024 * MiB, "map");
constexpr int CW_TMO = 0, CW_CODE = 1, CW_CNT = 1024  , CW_DBG = 2048, CW_BAR = 4096  ;
constexpr int LDSCTL_OFF = 0, LDSCTL_BYTES = 1024, MISC_OFF = LDSCTL_OFF + 320, RING_OFF = LDSCTL_BYTES, RING_BYTES = 131072, LDS_BYTES = 147456;

typedef GAS unsigned gu32;
#define RLX_AGENT __ATOMIC_RELAXED, __HIP_MEMORY_SCOPE_AGENT
#define LDS_WAIT() asm volatile("s_waitcnt lgkmcnt(0)" ::: "memory")
#define VM_WAIT() asm volatile("s_waitcnt vmcnt(0)" ::: "memory")

#define XB_TMO      128
#define XB_XCNT(j)  (256  + 64 * (j))
#define XB_XSUB(j)  (1280 + 64 * (j))
#define XB_XGEN(j)  (2304 + 64 * (j))
#define XB_TOP      3328
#define XB_TOPGEN   3392
#define XCD_BAR_WORDS 3456
#define XB_SPIN_CAP (1u << 18)
__device__ __forceinline__ unsigned xb_ld(unsigned* p)              { return __hip_atomic_load(p, __ATOMIC_RELAXED, __HIP_MEMORY_SCOPE_AGENT); }
__device__ __forceinline__ unsigned xb_add(unsigned* p, unsigned v) { return __hip_atomic_fetch_add(p, v, __ATOMIC_RELAXED, __HIP_MEMORY_SCOPE_AGENT); }
__device__ __forceinline__ unsigned xb_xcc_id() { return (unsigned)__builtin_amdgcn_s_getreg((3 << 11) | 20) & 0xFu; }
#define XB_SPIN(cond, bar) do { unsigned _sp = 0; while (cond) { __builtin_amdgcn_s_sleep(1); \
    if ((++_sp & 255u) == 0u) { if (xb_ld(&(bar)[XB_TMO])) break; if (_sp > XB_SPIN_CAP) { atomicAdd(&(bar)[XB_TMO], 1u); break; } } } } while (0)
__device__ __forceinline__ unsigned rfl(unsigned v);
struct XcdBarrier { unsigned* bar; unsigned x; volatile LAS unsigned* st; };
__device__ __forceinline__ XcdBarrier xcd_barrier_post(unsigned* bar, volatile LAS unsigned* st) {
    XcdBarrier b; b.bar = bar; b.x = xb_xcc_id(); b.st = st;
    if (threadIdx.x == 0) (void)xb_add(&bar[XB_XCNT(b.x)], 1u);
    return b;
}
__device__ __forceinline__ void xcd_barrier_complete(unsigned* bar, unsigned x, unsigned& nloc, unsigned& nx) {
    const unsigned G = gridDim.x * gridDim.y * gridDim.z;
    unsigned sum, cnt, mine, sp = 0u;
    for (;;) {
        sum = 0u; cnt = 0u; mine = 0u;
#pragma unroll
        for (unsigned j = 0; j < 16; ++j) { const unsigned c = xb_ld(&bar[XB_XCNT(j)]); sum += c; cnt += (c > 0u) ? 1u : 0u; mine = (j == x) ? c : mine; }
        if (sum == G) break;
        __builtin_amdgcn_s_sleep(1);
        if ((++sp & 255u) == 0u) { if (xb_ld(&bar[XB_TMO])) break; if (sp > XB_SPIN_CAP) { atomicAdd(&bar[XB_TMO], 1u); break; } }
    }
    nloc = mine > 0u ? mine : 1u; nx = cnt > 0u ? cnt : 1u;
}
__device__ __forceinline__ void xcd_barrier(const XcdBarrier& b) {
    unsigned* bar; { const volatile LAS unsigned* p_ = b.st + 2; const unsigned lo_ = rfl(p_[0]), hi_ = rfl(p_[1]); bar = (unsigned*)(((unsigned long long)hi_ << 32) | lo_); }
    asm volatile("s_waitcnt vmcnt(0)" ::: "memory");
    __syncthreads();
    if (threadIdx.x == 0) {
        __builtin_amdgcn_s_waitcnt(0);
        unsigned nloc = b.st[0], nx = b.st[1];
        if (nloc == 0u) { xcd_barrier_complete(bar, b.x, nloc, nx); b.st[0] = nloc; b.st[1] = nx; }
        const unsigned old = xb_add(&bar[XB_XSUB(b.x)], 1u);
        const unsigned gen = old / nloc;
        if (old + 1u == (gen + 1u) * nloc) {
            __builtin_amdgcn_fence(__ATOMIC_RELEASE, "agent");
            asm volatile("s_waitcnt vmcnt(0)" ::: "memory");
            const unsigned og = xb_add(&bar[XB_TOP], 1u);
            const unsigned tg = og / nx;
            if (og + 1u == (tg + 1u) * nx) xb_add(&bar[XB_TOPGEN], 1u);
            else XB_SPIN(xb_ld(&bar[XB_TOPGEN]) == tg, bar);
            __builtin_amdgcn_fence(__ATOMIC_ACQUIRE, "agent");
            xb_add(&bar[XB_XGEN(b.x)], 1u);
            asm volatile("s_waitcnt vmcnt(0)" ::: "memory");
        } else {
            XB_SPIN(xb_ld(&bar[XB_XGEN(b.x)]) == gen, bar);
            __builtin_amdgcn_fence(__ATOMIC_ACQUIRE, "agent");
            asm volatile("s_waitcnt vmcnt(0)" ::: "memory");
        }
    }
    __syncthreads();
}

__device__ __forceinline__ unsigned rfl(unsigned v);
__device__ __forceinline__ const float* ptab(LAS unsigned char* L, int i);
struct Frame { LAS unsigned char* lds; volatile LAS unsigned* MISC; gu32* ctl; unsigned char* ws; int tid, lane, wave, vcu, G, bx; };

__device__ __forceinline__ float wave_sum(float v) {
#pragma unroll
    for (int o = 1; o < 64; o <<= 1) v += __shfl_xor(v, o);
    return v;
}
__device__ __forceinline__ unsigned rfl(unsigned v) { return (unsigned)__builtin_amdgcn_readfirstlane((int)v); }

__device__ __forceinline__ int rowmap(int mode, int n) {
    if (mode == 0) return n;
    if (mode == 1) return (n >> 7) * 256 + (n & 127);
    if (mode == 2) return (n >> 7) * 256 + 128 + (n & 127);
    if (mode == 4) return n < 800 ? n : 896 + (n - 800);
    const int h = n / DQH, d = n - h * DQH;
    if (d < DNOPE) return 512 + h * DNOPE + d;
    if (d < DNOPE + 32) return (h >> 2) * 256 + (h & 3) * 32 + (d - DNOPE);
    return (h >> 2) * 256 + 128 + (h & 3) * 32 + (d - DNOPE - 32);
}
__device__ __forceinline__ void transpose_item(const float* W, int N, bf16_t* WT, int ldd, int mode, const float* kscale, const float* nscale, int item, int lane) {
    const int nblk = N / 64, kb = item / nblk, nb = item % nblk, k0 = 64 * kb, n = 64 * nb + lane;
    const float sn = nscale ? nscale[n] : 1.0f;
    const int ksv = __float_as_int(kscale ? kscale[k0 + lane] : 1.0f);
    const float* wp = W + (size_t)k0 * N + n;
    bf16_t* op = WT + (size_t)rowmap(mode, n) * ldd + k0;
    float w[64];
#pragma unroll
    for (int i = 0; i < 64; ++i) w[i] = __builtin_nontemporal_load(wp + (size_t)i * N);
#pragma unroll
    for (int kg = 0; kg < 8; ++kg) { float v[8];
#pragma unroll
        for (int i = 0; i < 8; ++i) { const float sk = __int_as_float(__builtin_amdgcn_readlane(ksv, 8 * kg + i)); v[i] = w[8 * kg + i] * (sk * sn); }
        u32x4 o; o.x = cvt_pk_bf16(v[0], v[1]); o.y = cvt_pk_bf16(v[2], v[3]); o.z = cvt_pk_bf16(v[4], v[5]); o.w = cvt_pk_bf16(v[6], v[7]);
        *(GAS u32x4*)(op + 8 * kg) = o; }
}
__device__ __forceinline__ void transpose_item_f8(const float* W, int N, unsigned char* WT, int ldd, int mode, const float* kscale, int item, int lane) {
    const int nblk = N / 64, kb = item / nblk, nb = item % nblk, k0 = 64 * kb, n = 64 * nb + lane;
    const int ksv = __float_as_int(kscale ? kscale[k0 + lane] : 1.0f);
    const float* wp = W + (size_t)k0 * N + n;
    unsigned char* op = WT + (size_t)rowmap(mode, n) * ldd + k0;
    float w[64];
#pragma unroll
    for (int i = 0; i < 64; ++i) w[i] = __builtin_nontemporal_load(wp + (size_t)i * N);
#pragma unroll
    for (int kg = 0; kg < 4; ++kg) { float v[16];
#pragma unroll
        for (int i = 0; i < 16; ++i) { const float sk = __int_as_float(__builtin_amdgcn_readlane(ksv, 16 * kg + i)); v[i] = w[16 * kg + i] * (sk * pg8::FP8_SW); }
        u32x4 o; o.x = pg8::pk4_fp8(v[0], v[1], v[2], v[3]); o.y = pg8::pk4_fp8(v[4], v[5], v[6], v[7]); o.z = pg8::pk4_fp8(v[8], v[9], v[10], v[11]); o.w = pg8::pk4_fp8(v[12], v[13], v[14], v[15]);
        *(GAS u32x4*)(op + 16 * kg) = o; }
}
struct MatDesc { const float* src; bf16_t* dst; const float* kscale; const float* nscale; int K, N, ldd, mode, f8; };
constexpr int N_MATS = 70;
__device__ __forceinline__ MatDesc mat_desc(int m, LAS unsigned char* L, unsigned char* ws) {
    MatDesc d; d.kscale = nullptr; d.nscale = nullptr; d.mode = 0; d.f8 = 0;
    if (m < 2)       { const int a = m;      d.src = ptab(L, 4) + (size_t)a * DM * NDOWN;    d.K = DM;   d.N = NDOWN; d.dst = (bf16_t*)(ws + WS_WDN) + (size_t)a * NDOWNP * DM;  d.ldd = DM; d.mode = 4; d.kscale = ptab(L, 2) + (size_t)(2 * a) * DM; }
    else if (m < 4)  { const int a = m - 2;  d.src = ptab(L, 6) + (size_t)a * QLR * NQ;      d.K = QLR;  d.N = NQ;    d.dst = (bf16_t*)(ws + WS_WUQ) + (size_t)a * NQ * QLR;     d.ldd = QLR; d.mode = 3; d.kscale = ptab(L, 5) + (size_t)a * QLR; }
    else if (m < 6)  { const int a = m - 4;  d.src = ptab(L, 8) + (size_t)a * KVLR * NKV;    d.K = KVLR; d.N = NKV;   d.dst = (bf16_t*)(ws + WS_WUKV) + (size_t)a * NKV * KVLR;  d.ldd = KVLR; d.kscale = ptab(L, 7) + (size_t)a * KVLR; }
    else if (m < 8)  { const int a = m - 6;  d.src = ptab(L, 9) + (size_t)a * DM * DM;       d.K = DM;   d.N = DM;    d.dst = (bf16_t*)(ws + WS_WO) + (size_t)a * DM * DM;       d.ldd = DM; }
    else if (m < 16) { const int i = m - 8;  d.src = ptab(L, 10) + (size_t)i * 256 * 256;    d.K = 256;  d.N = 256;   d.dst = (bf16_t*)(ws + WS_WPOOL) + (size_t)i * 256 * 256;  d.ldd = 256; d.nscale = ptab(L, 11) + i * 256; }
    else if (m < 18) { const int a = m - 16; d.src = ptab(L, 12) + (size_t)a * DM * FFD;     d.K = DM;   d.N = FFD;   d.dst = (bf16_t*)(ws + WS_WGU) + (size_t)a * 2 * FFD * DM; d.ldd = DM; d.mode = 1; d.kscale = ptab(L, 3) + (size_t)(2 * a) * DM; }
    else if (m < 20) { const int a = m - 18; d.src = ptab(L, 13) + (size_t)a * DM * FFD;     d.K = DM;   d.N = FFD;   d.dst = (bf16_t*)(ws + WS_WGU) + (size_t)a * 2 * FFD * DM; d.ldd = DM; d.mode = 2; d.kscale = ptab(L, 3) + (size_t)(2 * a) * DM; }
    else if (m < 22) { const int a = m - 20; d.src = ptab(L, 14) + (size_t)a * FFD * DM;     d.K = FFD;  d.N = DM;    d.dst = (bf16_t*)(ws + WS_WD) + (size_t)a * DM * FFD;      d.ldd = FFD; }
    else if (m < 38) { const int i = m - 22; d.src = ptab(L, 16) + (size_t)i * DM * FFE;     d.K = DM;   d.N = FFE;   d.dst = (bf16_t*)(ws + WS_MWGU) + (size_t)i * 2 * FFEP * DM; d.ldd = DM; d.mode = 1; d.kscale = ptab(L, 3) + (size_t)(2 * (i >> 3) + 1) * DM; }
    else if (m < 54) { const int i = m - 38; d.src = ptab(L, 17) + (size_t)i * DM * FFE;     d.K = DM;   d.N = FFE;   d.dst = (bf16_t*)(ws + WS_MWGU) + (size_t)i * 2 * FFEP * DM; d.ldd = DM; d.mode = 2; d.kscale = ptab(L, 3) + (size_t)(2 * (i >> 3) + 1) * DM; }
    else             { const int i = m - 54; d.src = ptab(L, 18) + (size_t)i * FFE * DM;     d.K = FFE;  d.N = DM;    d.dst = (bf16_t*)(ws + WS_MWD) + (size_t)i * DM * FFEP;    d.ldd = FFEP; }
    if (m == 17 || m == 19) { d.f8 = 1; d.dst = (bf16_t*)(ws + WS_WGU + (size_t)2 * FFD * DM * 2); d.ldd = DM; }
    if (m == 21) { d.f8 = 1; d.dst = (bf16_t*)(ws + WS_WD + (size_t)DM * FFD * 2); d.ldd = FFD8; }
    if (m >= 22) {
        const int e = (m - 22) & 7, lpi = ((m - 22) & 15) >> 3; d.f8 = 1;
        if (m < 54) { d.dst = (bf16_t*)(ws + WS_MWGU + (size_t)lpi * 8 * 2 * FFEP * DM * 2 + (size_t)e * 2 * FFEP * DM); d.ldd = DM; }
        else        { d.dst = (bf16_t*)(ws + WS_MWD + (size_t)lpi * 8 * DM * FFEP * 2 + (size_t)e * DM * FFE8); d.ldd = FFE8; } }
    return d;
}
__device__ __forceinline__ void p0_prologue(Frame& F) {
    const int* positions = (const int*)ptab(F.lds, 1);
    const int gw = F.vcu * NWAVES + F.wave, NGW = F.G * NWAVES;
    int cum = 0;
    for (int m = 0; m < N_MATS; ++m) {
        const MatDesc d = mat_desc(m, F.lds, F.ws);
        const int nitems = (d.K / 64) * (d.N / 64);
        int first = gw - (cum % NGW); if (first < 0) first += NGW;
        if (d.f8) { for (int it = first; it < nitems; it += NGW) transpose_item_f8(d.src, d.N, (unsigned char*)d.dst, d.ldd, d.mode, d.kscale, it, F.lane); }
        else { for (int it = first; it < nitems; it += NGW) transpose_item(d.src, d.N, d.dst, d.ldd, d.mode, d.kscale, d.nscale, it, F.lane); }
        cum += nitems;
    }
    const int gt = gw * 64 + F.lane, NGT = NGW * 64; const u32x4 z4 = (u32x4){0u, 0u, 0u, 0u};
    for (int i = gt; i < 2 * 192 * 128; i += NGT) { const int a = i / (192 * 128), r = (i / 128) % 192, c = i % 128; const int row = r < 96 ? 800 + r : 928 + (r - 96); *(GAS u32x4*)((bf16_t*)(F.ws + WS_WDN) + (size_t)a * NDOWNP * DM + (size_t)row * DM + c * 8) = z4; }
    for (int i = gt; i < 1024 * 8; i += NGT) { const int row = i / 8, c = i % 8; *(GAS u32x4*)(F.ws + WS_WD + (size_t)DM * FFD * 2 + (size_t)row * FFD8 + FFD + c * 16) = z4; }
    for (int i = gt; i < 16 * 128 * 64; i += NGT) { const int lpi = i / (8 * 128 * 64), e = (i / (128 * 64)) & 7, r = (i / 64) % 128, c = i % 64; const int row = 2560 + (r < 64 ? 64 + r : 192 + (r - 64));
        *(GAS u32x4*)(F.ws + WS_MWGU + (size_t)lpi * 8 * 2 * FFEP * DM * 2 + (size_t)e * 2 * FFEP * DM + (size_t)row * DM + c * 16) = z4; }
    for (int i = gt; i < 16 * 1024 * 12; i += NGT) { const int lpi = i / (8 * 1024 * 12), row = (i / 12) % (8 * 1024), c = i % 12; *(GAS u32x4*)(F.ws + WS_MWD + (size_t)lpi * 8 * DM * FFEP * 2 + (size_t)row * FFE8 + FFE + c * 16) = z4; }
    float* cosT = (float*)(F.ws + WS_COS); float* sinT = (float*)(F.ws + WS_SIN);
    { const float inv = powf(10000.0f, -(float)(2 * (gt & 31)) / 64.0f);
      for (int i = gt; i < NTOK * 32; i += NGT) { const float ang = (float)positions[i >> 5] * inv; float sn, cs; sincosf(ang, &sn, &cs); cosT[i] = cs; sinT[i] = sn; } }
    const float* x = ptab(F.lds, 0); bf16_t* H = (bf16_t*)(F.ws + WS_H); ssq_t* ssq0 = (ssq_t*)(F.ws + WS_SSQ);
    for (int m0 = gw * 4; m0 < NTOK; m0 += NGW * 4) {
        f32x4 v[4][4];
#pragma unroll
        for (int r = 0; r < 4; ++r) { const GAS f32x4* xr = (const GAS f32x4*)(x + (size_t)(m0 + r) * DM) + F.lane;
#pragma unroll
            for (int j = 0; j < 4; ++j) v[r][j] = xr[64 * j]; }
#pragma unroll
        for (int r = 0; r < 4; ++r) { GAS u32x2* o8 = (GAS u32x2*)(H + (size_t)(m0 + r) * DM) + F.lane; float s = 0.f;
#pragma unroll
            for (int j = 0; j < 4; ++j) { const f32x4 t = v[r][j]; s += (t.x * t.x + t.y * t.y) + (t.z * t.z + t.w * t.w); u32x2 w; w.x = cvt_pk_bf16(t.x, t.y); w.y = cvt_pk_bf16(t.z, t.w); o8[64 * j] = w; }
            s = wave_sum(s); if (F.lane == 0) ssq0[m0 + r] = ssq_fix(s); }
    }
}

template <bool FINAL>
__device__ __forceinline__ void combine_phase(Frame& F, const bf16_t* H, bf16_t* Hout, const bf16_t* YB, const unsigned* tokinfo, const unsigned* cntw, ssq_t* ssq_next, const float* gain, float* outF) {
    const int gw = F.vcu * NWAVES + F.wave, NGW = F.G * NWAVES;
    f32x4 g[4];
    if constexpr (FINAL) {
#pragma unroll
        for (int j = 0; j < 4; ++j) g[j] = *(const f32x4*)(gain + F.lane * 4 + 256 * j);
    }
    unsigned nb[8];
#pragma unroll
    for (int e = 0; e < 8; ++e) nb[e] = (rfl(__hip_atomic_load((unsigned*)cntw + 64 * e, RLX_AGENT)) + 255u) >> 8;
    for (int m0 = gw * 2; m0 < NTOK; m0 += NGW * 2) {
        u32x4 t0[2], t1[2];
#pragma unroll
        for (int r = 0; r < 2; ++r) { t0[r] = *(const u32x4*)(tokinfo + (size_t)(m0 + r) * 8); t1[r] = *(const u32x4*)(tokinfo + (size_t)(m0 + r) * 8 + 4); }
        u32x2 hh[2][4], ya[2][4], yb[2][4]; float g0[2], g1[2];
#pragma unroll
        for (int r = 0; r < 2; ++r) {
            const unsigned e0 = rfl(t0[r].x), r0 = rfl(t0[r].y), e1 = rfl(t1[r].x), r1 = rfl(t1[r].y); g0[r] = __uint_as_float(rfl(t0[r].z)); g1[r] = __uint_as_float(rfl(t1[r].z));
            unsigned b0 = 0u, b1 = 0u;
#pragma unroll
            for (int e = 0; e < 8; ++e) { b0 += ((unsigned)e < e0) ? nb[e] : 0u; b1 += ((unsigned)e < e1) ? nb[e] : 0u; }
            const GAS u32x2* hr = (const GAS u32x2*)(H + (size_t)(m0 + r) * DM) + F.lane;
            const GAS u32x2* y0 = (const GAS u32x2*)(YB + ((size_t)b0 * 256 + r0) * DM) + F.lane; const GAS u32x2* y1 = (const GAS u32x2*)(YB + ((size_t)b1 * 256 + r1) * DM) + F.lane;
#pragma unroll
            for (int j = 0; j < 4; ++j) { hh[r][j] = hr[64 * j]; ya[r][j] = y0[64 * j]; yb[r][j] = y1[64 * j]; }
        }
#pragma unroll
        for (int r = 0; r < 2; ++r) { const int m = m0 + r;
            f32x4 v[4]; float s = 0.f;
#pragma unroll
            for (int j = 0; j < 4; ++j) { const u32x2 h2 = hh[r][j], a = ya[r][j], b = yb[r][j];
                v[j].x = bflo(h2.x) + g0[r] * bflo(a.x) + g1[r] * bflo(b.x); v[j].y = bfhi(h2.x) + g0[r] * bfhi(a.x) + g1[r] * bfhi(b.x); v[j].z = bflo(h2.y) + g0[r] * bflo(a.y) + g1[r] * bflo(b.y); v[j].w = bfhi(h2.y) + g0[r] * bfhi(a.y) + g1[r] * bfhi(b.y);
                s += (v[j].x * v[j].x + v[j].y * v[j].y) + (v[j].z * v[j].z + v[j].w * v[j].w); }
            s = wave_sum(s);
            if constexpr (FINAL) { const float rstd = rstd_f(s); GAS f32x4* ho = (GAS f32x4*)(outF + (size_t)m * DM) + F.lane;
#pragma unroll
                for (int j = 0; j < 4; ++j) ho[64 * j] = v[j] * rstd * g[j];
            } else { GAS u32x2* hw = (GAS u32x2*)(Hout + (size_t)m * DM) + F.lane;
#pragma unroll
                for (int j = 0; j < 4; ++j) { u32x2 w; w.x = cvt_pk_bf16(v[j].x, v[j].y); w.y = cvt_pk_bf16(v[j].z, v[j].w); hw[64 * j] = w; }
                if (F.lane == 0) ssq_next[m] = ssq_fix(s); }
        }
    }
}
__device__ __forceinline__ void mid_phase(Frame& F, const bf16_t* DOWN, const float* qn, const float* kvn, const float* cosT, const float* sinT, bf16_t* CQN, bf16_t* CKVN, bf16_t* KR) {
    const int gw = F.vcu * NWAVES + F.wave, NGW = F.G * NWAVES, lane = F.lane;
    const f32x4 q0 = *(const f32x4*)(qn + lane * 8), q1 = *(const f32x4*)(qn + lane * 8 + 4), k0 = *(const f32x4*)(kvn + lane * 4);
    for (int m = gw; m < NTOK; m += NGW) {
        const bf16_t* dr = DOWN + (size_t)m * NDOWNP;
        const u32x4 cq = *(const GAS u32x4*)(dr + lane * 8); const u32x2 ck = *(const GAS u32x2*)(dr + QLR + lane * 4);
        const float x1 = bf2f(dr[QLR + KVLR + (lane & 31)]), x2 = bf2f(dr[QLR + KVLR + 32 + (lane & 31)]);
        const f32x4 a0 = (f32x4){bflo(cq.x), bfhi(cq.x), bflo(cq.y), bfhi(cq.y)}, a1 = (f32x4){bflo(cq.z), bfhi(cq.z), bflo(cq.w), bfhi(cq.w)}, c0 = (f32x4){bflo(ck.x), bfhi(ck.x), bflo(ck.y), bfhi(ck.y)};
        const float sq = wave_sum((a0.x * a0.x + a0.y * a0.y) + (a0.z * a0.z + a0.w * a0.w) + (a1.x * a1.x + a1.y * a1.y) + (a1.z * a1.z + a1.w * a1.w));
        const float sk = wave_sum((c0.x * c0.x + c0.y * c0.y) + (c0.z * c0.z + c0.w * c0.w));
        const float rq = 1.0f / sqrtf(sq * (1.0f / QLR) + RMS_EPS), rk = 1.0f / sqrtf(sk * (1.0f / KVLR) + RMS_EPS);
        const f32x4 y0 = a0 * rq * q0, y1 = a1 * rq * q1, z0 = c0 * rk * k0;
        u32x4 w; w.x = cvt_pk_bf16(y0.x, y0.y); w.y = cvt_pk_bf16(y0.z, y0.w); w.z = cvt_pk_bf16(y1.x, y1.y); w.w = cvt_pk_bf16(y1.z, y1.w);
        *(GAS u32x4*)(CQN + (size_t)m * QLR + lane * 8) = w;
        u32x2 w2; w2.x = cvt_pk_bf16(z0.x, z0.y); w2.y = cvt_pk_bf16(z0.z, z0.w);
        *(GAS u32x2*)(CKVN + (size_t)m * KVLR + lane * 4) = w2;
        const float c = cosT[(size_t)m * 32 + (lane & 31)], s = sinT[(size_t)m * 32 + (lane & 31)];
        const float o = lane < 32 ? x1 * c - x2 * s : x2 * c + x1 * s;
        KR[(size_t)m * DROPE + lane] = (bf16_t)(cvt_pk_bf16(o, o) & 0xffffu);
    }
}
template <int W>
__device__ __forceinline__ void pool_walk(const bf16_t* h, const ssq_t* ssq, const f32x2 g2, bf16_t* Z, size_t rowbase, int t_start, int c0, int nrows, int col) {
    f32x2 ring[W]; f32x2 sum = (f32x2){0.f, 0.f};
#pragma unroll
    for (int j = 0; j < W; ++j) ring[j] = (f32x2){0.f, 0.f};
    unsigned xa[16], xb[16]; ssq_t qa[16], qb[16];
#define PW_LOAD(X, Q, r_) do { _Pragma("unroll") for (int j = 0; j < 16; ++j) { const size_t row = rowbase + t_start + (r_) + j; X[j] = *(const GAS unsigned*)(h + row * DM + col); Q[j] = ssq[row]; } } while (0)
#define PW_PROC(X, Q, r_) do { _Pragma("unroll") for (int j = 0; j < 16; ++j) { const int t = t_start + (r_) + j; const size_t row = rowbase + t; \
            const f32x2 v = (f32x2){bflo(X[j]), bfhi(X[j])} * rstd_of(Q[j]) * g2; \
            sum = sum + (v - ring[j % W]); ring[j % W] = v; \
            if (t >= c0) { const float inv = 1.0f / (float)(t + 1 < W ? t + 1 : W); const f32x2 z = sum * inv - v; *(GAS unsigned*)(Z + row * DM + col) = cvt_pk_bf16(z.x, z.y); } } } while (0)
    PW_LOAD(xa, qa, 0);
    for (int r = 0; r < nrows; r += 32) {
        if (r + 16 < nrows) PW_LOAD(xb, qb, r + 16);
        PW_PROC(xa, qa, r);
        if (r + 32 < nrows) PW_LOAD(xa, qa, r + 32);
        if (r + 16 < nrows) PW_PROC(xb, qb, r + 16);
    }
#undef PW_LOAD
#undef PW_PROC
}
__device__ __forceinline__ void pool_phase(Frame& F, const bf16_t* h, const ssq_t* ssq, const float* gain, bf16_t* Z) {
    const int col = F.tid * 2; const f32x2 g2 = *(const f32x2*)(gain + col);
    for (int chunk = F.vcu; chunk < NBATCH * 16; chunk += F.G) {
        const int b = chunk >> 4, c0 = (chunk & 15) * 128, t_start = c0 ? c0 - 16 : 0, nrows = c0 + 128 - t_start; const size_t rowbase = (size_t)b * SEQ;
        const int grp = F.wave >> 1;
        if (grp == 0) pool_walk<2>(h, ssq, g2, Z, rowbase, t_start, c0, nrows, col);
        else if (grp == 1) pool_walk<4>(h, ssq, g2, Z, rowbase, t_start, c0, nrows, col);
        else if (grp == 2) pool_walk<8>(h, ssq, g2, Z, rowbase, t_start, c0, nrows, col);
        else pool_walk<16>(h, ssq, g2, Z, rowbase, t_start, c0, nrows, col);
    }
}
template <bool WRITE_H8>
__device__ __forceinline__ void router_phase(Frame& F, const bf16_t* h, const ssq_t* ssq, const float* gain, const float* router, int* list, float* rsl, unsigned* tokinfo, unsigned* cntw, unsigned char* H8) {
    LAS float* rt = (LAS float*)(F.lds + RING_OFF);
    LAS int* esel = (LAS int*)(F.lds + RING_OFF + 32768);
    LAS int* wt = (LAS int*)(F.lds + RING_OFF + 32768 + 2048);
    LAS int* base = (LAS int*)(F.lds + RING_OFF + 32768 + 2048 + 256);
    LAS float* rsd = (LAS float*)(F.lds + RING_OFF + 32768 + 2048 + 512);
    const int lane = F.lane;
    for (int idx = F.tid; idx < DM * NEXP; idx += NWAVES * 64) rt[(idx & 7) * DM + (idx >> 3)] = router[idx];
    f32x4 g[4];
#pragma unroll
    for (int j = 0; j < 4; ++j) g[j] = *(const f32x4*)(gain + lane * 4 + 256 * j);
    for (int chunk = F.vcu; chunk < NTOK / 256; chunk += F.G) {
        const int T0 = chunk * 256;
        __syncthreads();
        u32x2 nx[4][4]; ssq_t nq[4];
#pragma unroll
        for (int p = 0; p < 4; ++p) { const GAS u32x2* xr = (const GAS u32x2*)(h + (size_t)(T0 + F.wave * 32 + p) * DM) + lane;
#pragma unroll
          for (int j = 0; j < 4; ++j) nx[p][j] = xr[64 * j];
          nq[p] = ssq[T0 + F.wave * 32 + p]; }
        for (int i4 = 0; i4 < 32; i4 += 4) {
            const int tl0 = F.wave * 32 + i4, m0 = T0 + tl0;
            f32x4 v[4][4]; float rstd[4];
#pragma unroll
            for (int p = 0; p < 4; ++p) { rstd[p] = rstd_of(nq[p]);
#pragma unroll
                for (int j = 0; j < 4; ++j) { const u32x2 w = nx[p][j]; f32x4 xn = (f32x4){bflo(w.x), bfhi(w.x), bflo(w.y), bfhi(w.y)} * rstd[p];
                    if constexpr (WRITE_H8) { const f32x4 q = xn * pg8::FP8_SA; *(GAS unsigned*)(H8 + (size_t)(m0 + p) * DM + lane * 4 + 256 * j) = pg8::pk4_fp8(q.x, q.y, q.z, q.w); }
                    v[p][j] = xn * g[j]; } }
            if (i4 + 4 < 32) {
#pragma unroll
                for (int p = 0; p < 4; ++p) { const GAS u32x2* xr = (const GAS u32x2*)(h + (size_t)(m0 + 4 + p) * DM) + lane;
#pragma unroll
                    for (int j = 0; j < 4; ++j) nx[p][j] = xr[64 * j];
                    nq[p] = ssq[m0 + 4 + p]; } }
            float a[32];
#pragma unroll
            for (int e = 0; e < 8; ++e) {
#pragma unroll
                for (int p = 0; p < 4; ++p) a[8 * p + e] = 0.f;
#pragma unroll
                for (int j = 0; j < 4; ++j) { const f32x4 r4 = *(const LAS f32x4*)(rt + e * DM + lane * 4 + 256 * j);
#pragma unroll
                    for (int p = 0; p < 4; ++p) a[8 * p + e] += (v[p][j].x * r4.x + v[p][j].y * r4.y) + (v[p][j].z * r4.z + v[p][j].w * r4.w); } }
#define RSTEP(N, LM) _Pragma("unroll") for (int k = 0; k < (N); ++k) { const bool up = (lane & (LM)) != 0; const float send = up ? a[k] : a[k + (N)], keep = up ? a[k + (N)] : a[k]; a[k] = keep + __shfl_xor(send, (LM)); }
            RSTEP(16, 32) RSTEP(8, 16) RSTEP(4, 8) RSTEP(2, 4) RSTEP(1, 2)
#undef RSTEP
            const float tot = a[0] + __shfl_xor(a[0], 1);
#pragma unroll
            for (int p = 0; p < 4; ++p) {
                float lg[8];
#pragma unroll
                for (int e = 0; e < 8; ++e) lg[e] = __int_as_float(__builtin_amdgcn_readlane(__float_as_int(tot), 2 * (8 * p + e)));
                int e0 = 0; float l0 = lg[0];
#pragma unroll
                for (int e = 1; e < 8; ++e) if (lg[e] > l0) { l0 = lg[e]; e0 = e; }
                int e1 = e0 == 0 ? 1 : 0; float l1 = lg[e0 == 0 ? 1 : 0];
#pragma unroll
                for (int e = 0; e < 8; ++e) if (e != e0 && lg[e] > l1) { l1 = lg[e]; e1 = e; }
                const float g0 = 1.0f / (1.0f + __expf(l1 - l0)), g1 = 1.0f - g0;
                if (lane == 0) { const int tl = tl0 + p; esel[2 * tl] = e0; esel[2 * tl + 1] = e1; rsd[tl] = rstd[p]; unsigned* ti = tokinfo + (size_t)(m0 + p) * 8;
                    ti[0] = (unsigned)e0; ti[2] = __float_as_uint(g0); ti[4] = (unsigned)e1; ti[6] = __float_as_uint(g1); }
            }
        }
        __syncthreads();
        const int me = esel[F.tid]; int myrank = 0;
#pragma unroll
        for (int e = 0; e < 8; ++e) { const unsigned long long mask = __ballot(me == e); if (me == e) myrank = __popcll(mask & ((1ull << lane) - 1ull)); if (lane == 0) wt[F.wave * 8 + e] = __popcll(mask); }
        __syncthreads();
        int off = 0;
        for (int w = 0; w < F.wave; ++w) off += wt[w * 8 + me];
        if (F.tid < 8) { int tot = 0; for (int w = 0; w < 8; ++w) tot += wt[w * 8 + F.tid]; base[F.tid] = (int)__hip_atomic_fetch_add(cntw + 64 * F.tid, (unsigned)tot, RLX_AGENT); }
        __syncthreads();
        const int rank = base[me] + off + myrank, tok = T0 + (F.tid >> 1);
        list[(size_t)me * NTOK + rank] = tok; rsl[(size_t)me * NTOK + rank] = rsd[F.tid >> 1];
        tokinfo[(size_t)tok * 8 + (F.tid & 1) * 4 + 1] = (unsigned)rank;
    }
}
template <bool GATHER, bool FP8 = false>
struct MoeOrder {
    static constexpr size_t A_BLK = GATHER ? 0 : (FP8 ? (size_t)256 * FFE8 : (size_t)256 * FFEP * 2), B_EXP = GATHER ? (FP8 ? (size_t)2 * FFEP * DM : (size_t)2 * FFEP * DM * 2) : (FP8 ? (size_t)DM * FFE8 : (size_t)DM * FFEP * 2),
                            B_TILE = GATHER ? (FP8 ? (size_t)256 * DM : (size_t)256 * DM * 2) : (FP8 ? (size_t)256 * FFE8 : (size_t)256 * FFEP * 2);
    static constexpr int NT = GATHER ? 2 * FFEP / 256 : DM / 256;
    const char* A; const char* B; const int* list; const unsigned* cntw; int G, c, rev; unsigned bs[9];
    __device__ __forceinline__ void init(const unsigned* cntw_, const void* A_, const void* B_, const int* list_, int G_, int c_) {
        A = (const char*)A_; B = (const char*)B_; list = list_; cntw = cntw_; G = G_; c = c_; rev = 0; bs[0] = 0u;
#pragma unroll
        for (int e = 0; e < 8; ++e) { const unsigned ce = rfl(__hip_atomic_load((unsigned*)cntw + 64 * e, RLX_AGENT)); bs[e + 1] = bs[e] + ((ce + 255u) >> 8); }
    }
    __device__ __forceinline__ bool next(int i, pg8::Unit& u) const {
        unsigned blk; int pn;
        if ((G & 7) == 0) {
            const int x = c & 7, cl = c >> 3, q = (int)bs[8] >> 3, r = (int)bs[8] & 7, nbx = q + (x < r ? 1 : 0), b0 = x * q + (x < r ? x : r);
            int U = i * (G >> 3) + cl; const int nwx = nbx * NT; if (U >= nwx) return false;
            if (rev) U = nwx - 1 - U;
            const int nig = pg8::WGM * NT, gid = U / nig, fm = gid * pg8::WGM, gsz = (nbx - fm) < pg8::WGM ? (nbx - fm) : pg8::WGM;
            blk = (unsigned)(b0 + fm + (U % nig) % gsz); pn = (U % nig) / gsz;
        } else {
            long L = (long)i * G + c; if (L >= (long)bs[8] * NT) return false;
            if (rev) L = (long)bs[8] * NT - 1 - L;
            blk = (unsigned)(L / NT); pn = (int)(L % NT);
        }
        unsigned e = 0u, st = 0u;
#pragma unroll
        for (int k = 1; k < 8; ++k) if (blk >= bs[k]) { e = (unsigned)k; st = bs[k]; }
        const unsigned j = blk - st;
        u.b = B + (size_t)e * B_EXP + (size_t)pn * B_TILE; u.orow = (int)(blk * 256u); u.pn = pn; u.aux = (int)e;
        if constexpr (GATHER) { const unsigned ce = rfl(__hip_atomic_load((unsigned*)cntw + 64 * e, RLX_AGENT));
            u.a = A; u.rows = list + (size_t)e * NTOK + (size_t)j * 256; const unsigned rem = ce - j * 256u; u.nrows = rem < 256u ? (int)rem : 256; }
        else { u.a = A + (size_t)blk * A_BLK; u.rows = nullptr; u.nrows = 256; }
        return true;
    }
};
constexpr int NPHASE = 27;
struct Args { const float* in[20]; float* out; unsigned char* ws; int ph_lo, ph_hi, li, pad; };
#ifndef MK_REP_MASK
#define MK_REP_MASK 0
#endif
#ifndef MK_REP_N
#define MK_REP_N 1
#endif
#ifndef MK_REV
#define MK_REV 1
#endif
#ifndef MK_STAG_BF
#define MK_STAG_BF 0u
#define MK_STAG_F8 0u
#endif
constexpr int PT_OFF = LDSCTL_OFF + 512;
__device__ __forceinline__ unsigned long long ptab_u64(LAS unsigned char* L, int i) {
    const volatile LAS unsigned* p = (const volatile LAS unsigned*)(L + PT_OFF + 8 * i); const unsigned lo = rfl(p[0]), hi = rfl(p[1]); return ((unsigned long long)hi << 32) | lo; }
__device__ __forceinline__ const float* ptab(LAS unsigned char* L, int i) { return (const float*)(GAS const float*)ptab_u64(L, i); }
__device__ __forceinline__ Frame make_frame(LAS unsigned char* L) {
    asm volatile("" : "+s"(L));
    Frame F; F.lds = L; F.MISC = (volatile LAS unsigned*)(L + MISC_OFF); F.tid = launder_v((int)threadIdx.x); F.lane = F.tid & 63; F.wave = __builtin_amdgcn_readfirstlane(F.tid >> 6);
    { int g_ = gridDim.x, bx = blockIdx.x; asm volatile("" : "+s"(g_), "+s"(bx)); F.G = g_; F.bx = bx;
      F.vcu = (F.G % 8 == 0) ? (bx % 8) * (F.G / 8) + bx / 8 : bx; }
    F.ws = (unsigned char*)(GAS unsigned char*)ptab_u64(L, 21); F.ctl = (gu32*)(F.ws + WS_CTL); return F;
}
__global__ void __launch_bounds__(NWAVES * 64, 2) fwd(Args args) {
    extern __shared__ __attribute__((aligned(16))) unsigned char lds[];
    LAS unsigned char* L = (LAS unsigned char*)lds;
    { const int tid = threadIdx.x;
      for (int u = tid; u < LDSCTL_BYTES / 4; u += NWAVES * 64) ((LAS unsigned*)(L + LDSCTL_OFF))[u] = 0u;
      __syncthreads();
      if (tid < 20) *(LAS unsigned long long*)(L + PT_OFF + 8 * tid) = (unsigned long long)args.in[tid];
      if (tid == 20) *(LAS unsigned long long*)(L + PT_OFF + 8 * 20) = (unsigned long long)args.out;
      if (tid == 21) *(LAS unsigned long long*)(L + PT_OFF + 8 * 21) = (unsigned long long)args.ws;
      if (tid == 22) *(LAS unsigned long long*)(L + PT_OFF + 8 * 22) = (unsigned long long)args.pad;
      __syncthreads(); }
    const int lo = args.ph_lo, hi = args.ph_hi;
    XcdBarrier bar; { gu32* ctl = (gu32*)(args.ws + WS_CTL); bar.bar = (unsigned*)(ctl + CW_BAR) + args.li * XCD_BAR_WORDS; bar.x = 0; bar.st = nullptr;
      if (threadIdx.x == 0) { const unsigned long long ba = (unsigned long long)((unsigned*)(ctl + CW_BAR) + args.li * XCD_BAR_WORDS); ((volatile LAS unsigned*)(L + MISC_OFF))[10] = (unsigned)ba; ((volatile LAS unsigned*)(L + MISC_OFF))[11] = (unsigned)(ba >> 32); }
      if (hi - lo > 1) bar = xcd_barrier_post((unsigned*)(ctl + CW_BAR) + args.li * XCD_BAR_WORDS, (volatile LAS unsigned*)(L + MISC_OFF) + 8);
      __syncthreads(); }
#ifndef MK_ONLY
#define MK_ONLY (-1)
#endif
#define KIND(k) ((k) == 0 ? 0 : 1 + ((k) - 1) % 13)
#ifndef MK_SKIPMASK
#define MK_SKIPMASK 0
#endif
#define IN(k) ((MK_ONLY < 0 || KIND(k) == MK_ONLY) && !((MK_SKIPMASK >> KIND(k)) & 1) && lo <= (k) && (k) < hi)
#define FORREP(k)
#if MK_REP_MASK
#define LASTREP (ptab_u64(F.lds, 22) == 0ull)
#else
#define LASTREP true
#endif
#ifdef MK_DOUBLE_BAR
#define SEAM(k) do { if ((k) + 1 < hi) { xcd_barrier(bar); xcd_barrier(bar); } } while (0)
#else
#define SEAM(k) do { if ((k) + 1 < hi) xcd_barrier(bar); } while (0)
#endif
#define WSP(off) ((bf16_t*)(F.ws + (off)))
#define SSQ(i) ((ssq_t*)(F.ws + WS_SSQ) + (size_t)(i) * NTOK)
    LAS unsigned char* ring = L + RING_OFF;

    if (IN(0)) FORREP(0) { Frame F = make_frame(L); p0_prologue(F); SEAM(0); }

    for (int lp = 0; lp < 2; ++lp) {
        const int pb = 1 + 13 * lp;
        if (IN(pb + 0)) FORREP(pb + 0) { Frame F = make_frame(L);
            pg8::RegOrder S; S.init(WSP(WS_H), DM * 2, WSP(WS_WDN) + (size_t)lp * NDOWNP * DM, DM * 2, NTOK, NDOWNP, F.G, F.bx);
            pg8::EpiDown E{WSP(WS_DOWN), WSP(WS_KR), SSQ(4 * lp + 0), LASTREP ? SSQ(10 + 2 * lp) : SSQ(9), LASTREP ? SSQ(11 + 2 * lp) : SSQ(9), (const float*)(F.ws + WS_COS), (const float*)(F.ws + WS_SIN)};
            pg8::gemm_phase<pg8::EpiDown, pg8::RegOrder, false>(ring, DM * 2, DM * 2, DM * 2, S, E);
            SEAM(pb + 0);
        }
        if (IN(pb + 1)) FORREP(pb + 1) { Frame F = make_frame(L);
            pg8::RegOrder S; S.init(WSP(WS_DOWN), NDOWNP * 2, WSP(WS_WUQ) + (size_t)lp * NQ * QLR, QLR * 2, NTOK, NQ, F.G, F.bx);
            pg8::EpiQ E{WSP(WS_Q), (const float*)(F.ws + WS_COS), (const float*)(F.ws + WS_SIN), SSQ(10 + 2 * lp)};
            pg8::gemm_phase<pg8::EpiQ, pg8::RegOrder, false>(ring, NDOWNP * 2, QLR * 2, QLR * 2, S, E);
            SEAM(pb + 1);
        }
        if (IN(pb + 2)) FORREP(pb + 2) { Frame F = make_frame(L);
            pg8::RegOrder S; S.init(WSP(WS_DOWN) + QLR, NDOWNP * 2, WSP(WS_WUKV) + (size_t)lp * NKV * KVLR, KVLR * 2, NTOK, NKV, F.G, F.bx);
            pg8::EpiBf16<2> E{WSP(WS_KNV), NKV, SSQ(11 + 2 * lp)};
            pg8::gemm_phase<pg8::EpiBf16<2>, pg8::RegOrder, false>(ring, NDOWNP * 2, KVLR * 2, KVLR * 2, S, E);
            SEAM(pb + 2);
        }
        if (IN(pb + 3)) FORREP(pb + 3) { Frame F = make_frame(L); att::attn_phase((char*)lds + RING_OFF, WSP(WS_Q), WSP(WS_KNV), WSP(WS_KR), WSP(WS_DOWN), F.vcu, F.G); SEAM(pb + 3); }
        if (IN(pb + 4) && lp == 0) FORREP(pb + 4) { Frame F = make_frame(L);
            pg8::RegOrder S; S.init(WSP(WS_DOWN), DM * 2, WSP(WS_WO) + (size_t)lp * DM * DM, DM * 2, NTOK, DM, F.G, F.bx);
            pg8::EpiResidH<false> E{WSP(WS_H), LASTREP ? WSP(WS_H) : WSP(WS_DUMMY), LASTREP ? SSQ(4 * lp + 1) : SSQ(9), nullptr, 1.0f};
            pg8::gemm_phase<pg8::EpiResidH<false>, pg8::RegOrder, false>(ring, DM * 2, DM * 2, DM * 2, S, E);
            SEAM(pb + 4);
        }
        if (IN(pb + 4) && lp == 1) FORREP(pb + 4) { Frame F = make_frame(L);
            pg8::RegOrder S; S.init(WSP(WS_DOWN), DM * 2, WSP(WS_WO) + (size_t)lp * DM * DM, DM * 2, NTOK, DM, F.G, F.bx);
            pg8::EpiResidH<true> E{WSP(WS_H), LASTREP ? WSP(WS_H) : WSP(WS_DUMMY), LASTREP ? SSQ(4 * lp + 1) : SSQ(9), F.ws + WS_H8, 1.0f};
            pg8::gemm_phase<pg8::EpiResidH<true>, pg8::RegOrder, false>(ring, DM * 2, DM * 2, DM * 2, S, E);
            SEAM(pb + 4);
        }
#if defined(MK_EPI_PROBE)
        if (IN(pb + 5) && lp == 0 && !LASTREP) { Frame F = make_frame(L);
            pg8::RegOrder S; S.init(WSP(WS_H), DM * 2, WSP(WS_WGU) + (size_t)lp * 2 * FFD * DM, DM * 2, NTOK, 2 * FFD, F.G, F.bx);
#if MK_EPI_PROBE == 1
            pg8::EpiNull E{(float*)(F.ws + WS_DUMMY)};
            pg8::gemm_phase<pg8::EpiNull, pg8::RegOrder, false>(ring, DM * 2, DM * 2, DM * 2, S, E);
#else
            pg8::EpiBf16<0> E{WSP(WS_HID), FFD, nullptr};
            S.nN = FFD / 256; S.nwg = S.nM * S.nN;
            pg8::gemm_phase<pg8::EpiBf16<0>, pg8::RegOrder, false>(ring, DM * 2, DM * 2, DM * 2, S, E);
#endif
        }
        if (IN(pb + 5) && lp == 0 && LASTREP) FORREP(pb + 5) { Frame F = make_frame(L);
#else
        if (IN(pb + 5) && lp == 0) FORREP(pb + 5) { Frame F = make_frame(L);
#endif
            pg8::RegOrder S; S.init(WSP(WS_H), DM * 2, WSP(WS_WGU) + (size_t)lp * 2 * FFD * DM, DM * 2, NTOK, 2 * FFD, F.G, F.bx);
            pg8::EpiSwiglu<1> E{WSP(WS_HID), FFD, SSQ(4 * lp + 1), nullptr};
            pg8::gemm_phase<pg8::EpiSwiglu<1>, pg8::RegOrder, false>(ring, DM * 2, DM * 2, DM * 2, S, E, MK_STAG_BF);
            SEAM(pb + 5);
        }
        if (IN(pb + 5) && lp == 1) FORREP(pb + 5) { Frame F = make_frame(L);
            pg8::RegOrder S; S.init(F.ws + WS_H8, DM, F.ws + WS_WGU + (size_t)2 * FFD * DM * 2, DM, NTOK, 2 * FFD, F.G, F.bx);
            pg8::EpiSwigluF8<1> E{F.ws + WS_HID, FFD8, 2 * FFD / 256 - 1, SSQ(4 * lp + 1)};
            pg8::gemm_phase<pg8::EpiSwigluF8<1>, pg8::RegOrder, false, true>(ring, DM, DM, DM, S, E, MK_STAG_F8);
            SEAM(pb + 5);
        }
        if (IN(pb + 6) && lp == 0) FORREP(pb + 6) { Frame F = make_frame(L);
            pg8::RegOrder S; S.init(WSP(WS_HID), FFD * 2, WSP(WS_WD) + (size_t)lp * DM * FFD, FFD * 2, NTOK, DM, F.G, F.bx); S.rev = MK_REV;
            pg8::EpiResidH<false> E{WSP(WS_H), LASTREP ? WSP(WS_H) : WSP(WS_DUMMY), LASTREP ? SSQ(4 * lp + 2) : SSQ(9), nullptr, 1.0f};
            pg8::gemm_phase<pg8::EpiResidH<false>, pg8::RegOrder, false>(ring, FFD * 2, FFD * 2, FFD * 2, S, E);
            SEAM(pb + 6);
        }
        if (IN(pb + 6) && lp == 1) FORREP(pb + 6) { Frame F = make_frame(L);
            pg8::RegOrder S; S.init(F.ws + WS_HID, FFD8, F.ws + WS_WD + (size_t)DM * FFD * 2, FFD8, NTOK, DM, F.G, F.bx); S.rev = MK_REV;
            pg8::EpiResidH<false> E{WSP(WS_H), LASTREP ? WSP(WS_H) : WSP(WS_DUMMY), LASTREP ? SSQ(4 * lp + 2) : SSQ(9), nullptr, 1.0f / (pg8::FP8_SH * pg8::FP8_SW)};
            pg8::gemm_phase<pg8::EpiResidH<false>, pg8::RegOrder, false, true>(ring, FFD8, FFD8, FFD8, S, E);
            SEAM(pb + 6);
        }
        if (IN(pb + 7)) FORREP(pb + 7) { Frame F = make_frame(L); pool_phase(F, WSP(WS_H), SSQ(4 * lp + 2), ptab(F.lds, 2) + (size_t)(2 * lp + 1) * DM, WSP(WS_DOWN)); SEAM(pb + 7); }
        if (IN(pb + 8)) FORREP(pb + 8) { Frame F = make_frame(L);
            pg8::RegOrder S; S.init(WSP(WS_DOWN), DM * 2, WSP(WS_WPOOL) + (size_t)lp * 4 * 256 * 256, 256 * 2, NTOK, DM, F.G, F.bx, 256 * 2);
            pg8::EpiResidH<false> E{WSP(WS_H), LASTREP ? WSP(WS_H) : WSP(WS_DUMMY), LASTREP ? SSQ(4 * lp + 3) : SSQ(9), nullptr, 1.0f};
            pg8::gemm_phase<pg8::EpiResidH<false>, pg8::RegOrder, false>(ring, DM * 2, 256 * 2, 256 * 2, S, E);
            SEAM(pb + 8);
        }
        if (IN(pb + 9)) FORREP(pb + 9) { Frame F = make_frame(L);
            router_phase<true>(F, WSP(WS_H), SSQ(4 * lp + 3), ptab(F.lds, 3) + (size_t)(2 * lp + 1) * DM, ptab(F.lds, 15) + (size_t)lp * DM * NEXP, (int*)(F.ws + WS_LIST), (float*)(F.ws + WS_RSL), (unsigned*)(F.ws + WS_TOKINFO), (unsigned*)(F.ctl + CW_CNT) + (LASTREP ? lp : 2 + lp) * 8 * 64, F.ws + WS_H8);
            SEAM(pb + 9); }
#ifndef TEST_NO_F8MOE
        if (IN(pb + 10)) FORREP(pb + 10) { Frame F = make_frame(L);
            MoeOrder<true, true> S; S.init((unsigned*)(F.ctl + CW_CNT) + lp * 8 * 64, F.ws + WS_H8, F.ws + WS_MWGU + (size_t)lp * 8 * 2 * FFEP * DM * 2, (const int*)(F.ws + WS_LIST), F.G, F.bx);
            pg8::EpiSwigluF8<0> E{F.ws + WS_HID, FFE8, 2 * FFEP / 256 - 1, nullptr};
            pg8::gemm_phase<pg8::EpiSwigluF8<0>, MoeOrder<true, true>, true, true>(ring, DM, DM, DM, S, E, MK_STAG_F8);
            SEAM(pb + 10);
        }
#endif
#ifndef TEST_NO_F8MOE
        if (IN(pb + 11)) FORREP(pb + 11) { Frame F = make_frame(L);
            MoeOrder<false, true> S; S.init((unsigned*)(F.ctl + CW_CNT) + lp * 8 * 64, F.ws + WS_HID, F.ws + WS_MWD + (size_t)lp * 8 * DM * FFEP * 2, (const int*)(F.ws + WS_LIST), F.G, F.bx); S.rev = MK_REV;
            pg8::EpiBf16Scaled E{WSP(WS_YB), DM, 1.0f / (pg8::FP8_SH * pg8::FP8_SW)};
            pg8::gemm_phase<pg8::EpiBf16Scaled, MoeOrder<false, true>, false, true>(ring, FFE8, FFE8, FFE8, S, E);
            SEAM(pb + 11);
        }
#endif
        if (IN(pb + 12)) FORREP(pb + 12) { Frame F = make_frame(L);
            if (lp == 0) combine_phase<false>(F, WSP(WS_H), LASTREP ? WSP(WS_H) : WSP(WS_DOWN), WSP(WS_YB), (const unsigned*)(F.ws + WS_TOKINFO), (unsigned*)(F.ctl + CW_CNT), LASTREP ? SSQ(4) : SSQ(9), nullptr, nullptr);
            else combine_phase<true>(F, WSP(WS_H), nullptr, WSP(WS_YB), (const unsigned*)(F.ws + WS_TOKINFO), (unsigned*)(F.ctl + CW_CNT) + 8 * 64, nullptr, ptab(F.lds, 19), (float*)ptab(F.lds, 20));
            SEAM(pb + 12);
        }
    }
#undef IN
#undef SEAM
#undef WSP
#undef SSQ
}

#ifndef MK_PER_PHASE
#define MK_PER_PHASE 0
#endif
extern "C" void kernel_launch(void* const* d_in, const int* in_sizes, int n_in, void* d_out, int out_size, void* d_ws, size_t ws_size, hipStream_t stream) {
    static int grid = 0;
    if (grid == 0) {
        if (n_in != 20 || in_sizes[0] != NTOK * DM || out_size != NTOK * DM || ws_size < WS_END) { fprintf(stderr, "kernel_launch: unexpected shapes (n_in %d, in0 %d, out %d, ws %zu < %zu)\n", n_in, n_in > 0 ? in_sizes[0] : -1, out_size, ws_size, (size_t)WS_END); grid = -1; return; }
        int dev = 0, cus = 0, per_cu = 0;
        if (hipGetDevice(&dev) != hipSuccess || hipDeviceGetAttribute(&cus, hipDeviceAttributeMultiprocessorCount, dev) != hipSuccess) { grid = -1; return; }
        if (hipFuncSetAttribute((const void*)fwd, hipFuncAttributeMaxDynamicSharedMemorySize, LDS_BYTES) != hipSuccess) { fprintf(stderr, "kernel_launch: hipFuncSetAttribute failed\n"); grid = -1; return; }
        if (hipOccupancyMaxActiveBlocksPerMultiprocessor(&per_cu, (const void*)fwd, NWAVES * 64, LDS_BYTES) != hipSuccess || per_cu < 1) fprintf(stderr, "kernel_launch: occupancy query reports %d\n", per_cu);
        (void)hipGetLastError();
        grid = cus < 256 ? cus : 256;
    }
    if (grid < 0) return;
    if (hipMemsetAsync((char*)d_ws + WS_CTL, 0, CTL_ZERO_BYTES, stream) != hipSuccess) return;
    Args a{};
    for (int i = 0; i < 20; ++i) a.in[i] = (const float*)d_in[i];
    a.out = (float*)d_out; a.ws = (unsigned char*)d_ws;
#if MK_PER_PHASE
    for (int p = 0; p < NPHASE; ++p) { a.ph_lo = p; a.ph_hi = p + 1; a.li = 0; hipLaunchKernelGGL(fwd, dim3(grid), dim3(NWAVES * 64), LDS_BYTES, stream, a); }
#elif MK_REP_MASK
    { int cur = 0, li = 0;
      for (int k = 0; k < NPHASE; ++k) if ((MK_REP_MASK >> (k == 0 ? 0 : 1 + (k - 1) % 13)) & 1) {
          if (k > cur) { a.ph_lo = cur; a.ph_hi = k; a.li = li++; a.pad = 0; hipLaunchKernelGGL(fwd, dim3(grid), dim3(NWAVES * 64), LDS_BYTES, stream, a); }
          for (int r = 1; r < MK_REP_N; ++r) { a.ph_lo = k; a.ph_hi = k + 1; a.li = li++; a.pad = 1; hipLaunchKernelGGL(fwd, dim3(grid), dim3(NWAVES * 64), LDS_BYTES, stream, a); }
          cur = k; }
      a.ph_lo = cur; a.ph_hi = NPHASE; a.li = li++; a.pad = 0; hipLaunchKernelGGL(fwd, dim3(grid), dim3(NWAVES * 64), LDS_BYTES, stream, a); }
#elif defined(MK_TWICE)
    a.ph_lo = 0; a.ph_hi = NPHASE; a.li = 0;
    hipLaunchKernelGGL(fwd, dim3(grid), dim3(NWAVES * 64), LDS_BYTES, stream, a);
    (void)hipMemsetAsync((char*)d_ws + WS_CTL, 0, CTL_ZERO_BYTES, stream);
    hipLaunchKernelGGL(fwd, dim3(grid), dim3(NWAVES * 64), LDS_BYTES, stream, a);
#else
    a.ph_lo = 0; a.ph_hi = NPHASE; a.li = 0;
    hipLaunchKernelGGL(fwd, dim3(grid), dim3(NWAVES * 64), LDS_BYTES, stream, a);
#endif
}
```

```cpp
#include <hip/hip_runtime.h>
#include <cstdio>
#include <cstdint>

#define GAS __attribute__((address_space(1)))
#define LAS __attribute__((address_space(3)))
typedef unsigned short bf16_t;
typedef short bf16x8 __attribute__((ext_vector_type(8)));
typedef short s16x4 __attribute__((ext_vector_type(4)));
typedef float f32x2 __attribute__((ext_vector_type(2)));
typedef float f32x4 __attribute__((ext_vector_type(4)));
typedef float f32x16 __attribute__((ext_vector_type(16)));
typedef unsigned u32x2 __attribute__((ext_vector_type(2)));
typedef unsigned u32x4 __attribute__((ext_vector_type(4)));

constexpr int DM = 1024, NBATCH = 32, SEQ = 2048, NTOK = NBATCH * SEQ;
constexpr int NHEAD = 8, DNOPE = 128, DROPE = 64, DVH = 128, DQH = DNOPE + DROPE, QLR = 512, KVLR = 256;
constexpr int NDOWN = QLR + KVLR + DROPE  , NDOWNP = 1024;
constexpr int NQ = NHEAD * DQH  , NKV = NHEAD * (DNOPE + DVH)  ;
constexpr int FFD = 2688, NEXP = 8, FFE = 1344, FFEP = 1408;
constexpr int PSLOT = (NTOK * 2 / 256 + NEXP) * 256;
constexpr float RMS_EPS = 1e-6f;

__device__ __forceinline__ unsigned cvt_pk_bf16(float lo, float hi) { unsigned r; asm volatile("v_cvt_pk_bf16_f32 %0, %1, %2" : "=v"(r) : "v"(lo), "v"(hi)); return r; }
__device__ __forceinline__ int launder_v(int v) { asm volatile("" : "+v"(v)); return v; }
__device__ __forceinline__ float fp8_rt(float x, float s) { const int p = __builtin_amdgcn_cvt_pk_fp8_f32(x * s, 0.f, 0, false); return __builtin_amdgcn_cvt_f32_fp8(p, 0) * (1.0f / s); }
__device__ __forceinline__ float bf2f(unsigned short b) { return __uint_as_float((unsigned)b << 16); }
__device__ __forceinline__ float bflo(unsigned w) { return __uint_as_float(w << 16); }
__device__ __forceinline__ float bfhi(unsigned w) { return __uint_as_float(w & 0xffff0000u); }

typedef unsigned long long ssq_t;
__device__ __forceinline__ ssq_t ssq_fix(float s) { return (ssq_t)(s * 16777216.0f); }
__device__ __forceinline__ float rstd_n(ssq_t q, float invn) { return __builtin_amdgcn_rsqf(((float)(unsigned)(q >> 32) * 4294967296.0f + (float)(unsigned)q) * (1.0f / 16777216.0f) * invn + RMS_EPS); }
__device__ __forceinline__ float rstd_of(ssq_t q) { return rstd_n(q, 1.0f / DM); }
__device__ __forceinline__ float rstd_f(float ssq) { return __builtin_amdgcn_rsqf(ssq * (1.0f / DM) + RMS_EPS); }

namespace pg8 {
constexpr int BM = 256, BK = 64, HALF = 128, HTB = HALF * BK * 2  , STAGE_BYTES = 8 * HTB, NXCD = 8, WGM = 8;
__host__ __device__ __forceinline__ int lds_byte(int r, int c) { const int st = (r >> 4) * 2 + (c >> 5), rr = r & 15, cc = c & 31, ob = rr * 64 + cc * 2; return st * 1024 + (ob ^ (((ob >> 9) & 1) << 5)); }
__host__ __device__ __forceinline__ void stage_rc(int b, int& R, int& C) { const int st = b / 1024, sb = b % 1024, swz = sb ^ (((sb >> 9) & 1) << 5); R = (st >> 1) * 16 + swz / 64; C = (st & 1) * 32 + (swz % 64) / 2; }
__host__ __device__ __forceinline__ int perm32(int rho) { const int n = rho >> 4, i = rho & 15; return 8 * (i >> 2) + 4 * n + (i & 3); }

struct Unit { const char* a; const char* b; const int* rows; int nrows; int orow; int pn; int aux; };

struct RegOrder {
    const char* A; const char* B; unsigned a_tile, b_tile, a_colstep; int nM, nN, nwg, G, c, rev;
    __device__ __forceinline__ void init(const void* A_, size_t lda_b, const void* B_, size_t ldb_b, int M, int N, int G_, int c_, size_t a_colstep_ = 0) {
        A = (const char*)A_; B = (const char*)B_; a_tile = (unsigned)(256 * lda_b); b_tile = (unsigned)(256 * ldb_b); a_colstep = (unsigned)a_colstep_; nM = M / BM; nN = N / BM; nwg = nM * nN; G = G_; c = c_; rev = 0; }
    __device__ __forceinline__ bool next(int i, Unit& u) const {
        long L = (long)i * G + c; if (L >= nwg) return false;
        if (rev) L = nwg - 1 - L;
        int wgid = (int)L; { const int q = nwg / NXCD, r = nwg % NXCD, xcd = wgid % NXCD, off = wgid / NXCD; wgid = (xcd < r ? xcd * (q + 1) : r * (q + 1) + (xcd - r) * q) + off; }
        const int nig = WGM * nN, gid = wgid / nig, fm = gid * WGM, gsz = (nM - fm) < WGM ? (nM - fm) : WGM;
        const int pm = fm + ((wgid % nig) % gsz), pn = (wgid % nig) / gsz;
        u.a = A + (size_t)pm * a_tile + (size_t)pn * a_colstep; u.b = B + (size_t)pn * b_tile; u.rows = nullptr; u.nrows = 256; u.orow = pm * BM; u.pn = pn; u.aux = 0; return true;
    }
};

template <int RS> struct EpiBf16 {
    static constexpr bool PERM = true;
    bf16_t* O; int ldc; const ssq_t* rs;
    __device__ __forceinline__ void operator()(const f32x4 (&acc)[2][2][4][2], const Unit& u, int wr, int wc, int fr, int fq) const {
        const int row0 = u.orow + launder_v(wr * 64 + fr), col0 = u.pn * BM + wc * 32 + 8 * fq;
        float sc[2][4]; ssq_t rq[2][4];
#pragma unroll
        for (int ai = 0; ai < 2; ++ai)
#pragma unroll
            for (int m = 0; m < 4; ++m) { const int row = row0 + ai * HALF + m * 16; if constexpr (RS != 0) rq[ai][m] = rs[row]; }
#pragma unroll
        for (int ai = 0; ai < 2; ++ai)
#pragma unroll
            for (int m = 0; m < 4; ++m) { sc[ai][m] = 1.0f; if constexpr (RS == 1) sc[ai][m] = rstd_of(rq[ai][m]); if constexpr (RS == 2) sc[ai][m] = rstd_n(rq[ai][m], 1.0f / KVLR); }
#pragma unroll
        for (int ai = 0; ai < 2; ++ai)
#pragma unroll
            for (int m = 0; m < 4; ++m) { const int row = row0 + ai * HALF + m * 16; bf16_t* rowp = O + (size_t)row * ldc + col0;
#pragma unroll
                for (int bj = 0; bj < 2; ++bj) { const f32x4 v0 = acc[ai][bj][m][0] * sc[ai][m], v1 = acc[ai][bj][m][1] * sc[ai][m];
                    u32x4 w; w.x = cvt_pk_bf16(v0[0], v0[1]); w.y = cvt_pk_bf16(v0[2], v0[3]); w.z = cvt_pk_bf16(v1[0], v1[1]); w.w = cvt_pk_bf16(v1[2], v1[3]);
                    *(u32x4*)(rowp + bj * HALF) = w; } }
    }
};
__device__ __forceinline__ float silu_mul(float g, float u) { return g * u * __builtin_amdgcn_rcpf(1.0f + __builtin_amdgcn_exp2f(-1.4426950408889634f * g)); }
template <int RS> struct EpiSwiglu {
    static constexpr bool PERM = true;
    bf16_t* H; int ldh; const void* rs; const int* list;
    __device__ __forceinline__ void operator()(const f32x4 (&acc)[2][2][4][2], const Unit& u, int wr, int wc, int fr, int fq) const {
        const int r0 = launder_v(wr * 64 + fr), col0 = u.pn * HALF + wc * 32 + 8 * fq;
        const ssq_t* rsq = (const ssq_t*)rs; const float* rsp = (const float*)rs; if constexpr (RS == 2) rsp = rsp + (u.rows - list);
        float sc[2][4]; ssq_t rq[2][4];
#pragma unroll
        for (int ai = 0; ai < 2; ++ai)
#pragma unroll
            for (int m = 0; m < 4; ++m) { const int r = r0 + ai * HALF + m * 16; if constexpr (RS == 1) rq[ai][m] = rsq[u.orow + r]; else sc[ai][m] = rsp[r]; }
        if constexpr (RS == 1) {
#pragma unroll
            for (int ai = 0; ai < 2; ++ai)
#pragma unroll
                for (int m = 0; m < 4; ++m) sc[ai][m] = rstd_of(rq[ai][m]); }
#pragma unroll
        for (int ai = 0; ai < 2; ++ai)
#pragma unroll
            for (int m = 0; m < 4; ++m) { const int r = r0 + ai * HALF + m * 16; bf16_t* rowp = H + (size_t)(u.orow + r) * ldh + col0; const float s = sc[ai][m];
                const f32x4 g0 = acc[ai][0][m][0] * s, g1 = acc[ai][0][m][1] * s, u0 = acc[ai][1][m][0] * s, u1 = acc[ai][1][m][1] * s;
                u32x4 w; w.x = cvt_pk_bf16(silu_mul(g0[0], u0[0]), silu_mul(g0[1], u0[1])); w.y = cvt_pk_bf16(silu_mul(g0[2], u0[2]), silu_mul(g0[3], u0[3]));
                w.z = cvt_pk_bf16(silu_mul(g1[0], u1[0]), silu_mul(g1[1], u1[1])); w.w = cvt_pk_bf16(silu_mul(g1[2], u1[2]), silu_mul(g1[3], u1[3]));
                __builtin_nontemporal_store(w, (u32x4*)rowp); }
    }
};
constexpr float FP8_SA = 16.0f, FP8_SW = 256.0f, FP8_SH = 16.0f, FP8_SX = 8.0f;
__device__ __forceinline__ unsigned pk4_fp8(float a, float b, float c, float d) { int p = __builtin_amdgcn_cvt_pk_fp8_f32(a, b, 0, false); p = __builtin_amdgcn_cvt_pk_fp8_f32(c, d, p, true); return (unsigned)p; }
template <int RS> struct EpiSwigluF8 {
    static constexpr bool PERM = true;
    unsigned char* H8; int ldh; int pad_tile; const ssq_t* rs;
    __device__ __forceinline__ void operator()(const f32x4 (&acc)[2][2][4][2], const Unit& u, int wr, int wc, int fr, int fq) const {
        const int r0 = launder_v(wr * 64 + fr), col0 = u.pn * HALF + wc * 32 + 8 * fq;
        float sc[2][4]; ssq_t rq[2][4];
#pragma unroll
        for (int ai = 0; ai < 2; ++ai)
#pragma unroll
            for (int m = 0; m < 4; ++m) { if constexpr (RS == 1) rq[ai][m] = rs[u.orow + r0 + ai * HALF + m * 16]; }
#pragma unroll
        for (int ai = 0; ai < 2; ++ai)
#pragma unroll
            for (int m = 0; m < 4; ++m) { if constexpr (RS == 1) sc[ai][m] = rstd_of(rq[ai][m]) * (1.0f / (FP8_SX * FP8_SW)); else sc[ai][m] = 1.0f / (FP8_SA * FP8_SW); }
#pragma unroll
        for (int ai = 0; ai < 2; ++ai)
#pragma unroll
            for (int m = 0; m < 4; ++m) { const int r = r0 + ai * HALF + m * 16; unsigned char* rowp = H8 + (size_t)(u.orow + r) * ldh + col0; const float s = sc[ai][m];
                const f32x4 g0 = acc[ai][0][m][0] * s, g1 = acc[ai][0][m][1] * s, u0 = acc[ai][1][m][0] * s, u1 = acc[ai][1][m][1] * s;
                u32x2 w; w.x = pk4_fp8(silu_mul(g0[0], u0[0]) * FP8_SH, silu_mul(g0[1], u0[1]) * FP8_SH, silu_mul(g0[2], u0[2]) * FP8_SH, silu_mul(g0[3], u0[3]) * FP8_SH);
                w.y = pk4_fp8(silu_mul(g1[0], u1[0]) * FP8_SH, silu_mul(g1[1], u1[1]) * FP8_SH, silu_mul(g1[2], u1[2]) * FP8_SH, silu_mul(g1[3], u1[3]) * FP8_SH);
                __builtin_nontemporal_store(w, (u32x2*)rowp);
                if (u.pn == pad_tile) { u32x2 z; asm volatile("v_mov_b32 %0, 0\n\tv_mov_b32 %1, 0" : "=v"(z.x), "=v"(z.y)); *(u32x2*)(rowp + HALF) = z; } }
    }
};
struct EpiBf16Scaled {
    static constexpr bool PERM = true;
    bf16_t* O; int ldc; float scale;
    __device__ __forceinline__ void operator()(const f32x4 (&acc)[2][2][4][2], const Unit& u, int wr, int wc, int fr, int fq) const {
        const int row0 = u.orow + launder_v(wr * 64 + fr), col0 = u.pn * BM + wc * 32 + 8 * fq;
#pragma unroll
        for (int ai = 0; ai < 2; ++ai)
#pragma unroll
            for (int m = 0; m < 4; ++m) { bf16_t* rowp = O + (size_t)(row0 + ai * HALF + m * 16) * ldc + col0;
#pragma unroll
                for (int bj = 0; bj < 2; ++bj) { const f32x4 v0 = acc[ai][bj][m][0] * scale, v1 = acc[ai][bj][m][1] * scale;
                    u32x4 w; w.x = cvt_pk_bf16(v0[0], v0[1]); w.y = cvt_pk_bf16(v0[2], v0[3]); w.z = cvt_pk_bf16(v1[0], v1[1]); w.w = cvt_pk_bf16(v1[2], v1[3]);
                    *(u32x4*)(rowp + bj * HALF) = w; } }
    }
};
struct EpiNull {
    static constexpr bool PERM = true;
    float* sink;
    __device__ __forceinline__ void operator()(const f32x4 (&acc)[2][2][4][2], const Unit& u, int wr, int wc, int fr, int fq) const {
        float s = 0.f;
#pragma unroll
        for (int ai = 0; ai < 2; ++ai)
#pragma unroll
            for (int bj = 0; bj < 2; ++bj)
#pragma unroll
                for (int m = 0; m < 4; ++m)
#pragma unroll
                    for (int n = 0; n < 2; ++n) s += acc[ai][bj][m][n][0];
        if (s == 12345.678f) sink[0] = s;
    }
};
template <bool W8> struct EpiResidH {
    static constexpr bool PERM = true;
    const bf16_t* hin; bf16_t* hout; ssq_t* ssq; unsigned char* h8; float scale;
    __device__ __forceinline__ void operator()(const f32x4 (&acc)[2][2][4][2], const Unit& u, int wr, int wc, int fr, int fq) const {
        const int row0 = u.orow + launder_v(wr * 64 + fr), col0 = u.pn * BM + wc * 32 + 8 * fq;
        float part[2][4];
        u32x4 hv[2][4][2];
#pragma unroll
        for (int ai = 0; ai < 2; ++ai)
#pragma unroll
            for (int m = 0; m < 4; ++m)
#pragma unroll
                for (int bj = 0; bj < 2; ++bj) hv[ai][m][bj] = *(const u32x4*)(hin + (size_t)(row0 + ai * HALF + m * 16) * DM + col0 + bj * HALF);
#pragma unroll
        for (int ai = 0; ai < 2; ++ai) {
#pragma unroll
            for (int m = 0; m < 4; ++m) { const int row = row0 + ai * HALF + m * 16; const size_t off = (size_t)row * DM + col0; float pt = 0.f;
#pragma unroll
                for (int bj = 0; bj < 2; ++bj) { const u32x4 h4 = hv[ai][m][bj]; const f32x4 a0 = acc[ai][bj][m][0] * scale, a1 = acc[ai][bj][m][1] * scale;
                    const float y0 = bflo(h4.x) + a0[0], y1 = bfhi(h4.x) + a0[1], y2 = bflo(h4.y) + a0[2], y3 = bfhi(h4.y) + a0[3], y4 = bflo(h4.z) + a1[0], y5 = bfhi(h4.z) + a1[1], y6 = bflo(h4.w) + a1[2], y7 = bfhi(h4.w) + a1[3];
                    pt += (y0 * y0 + y1 * y1) + (y2 * y2 + y3 * y3) + (y4 * y4 + y5 * y5) + (y6 * y6 + y7 * y7);
                    u32x4 w; w.x = cvt_pk_bf16(y0, y1); w.y = cvt_pk_bf16(y2, y3); w.z = cvt_pk_bf16(y4, y5); w.w = cvt_pk_bf16(y6, y7);
                    *(u32x4*)(hout + off + bj * HALF) = w;
                    if constexpr (W8) { u32x2 q; q.x = pk4_fp8(y0 * FP8_SX, y1 * FP8_SX, y2 * FP8_SX, y3 * FP8_SX); q.y = pk4_fp8(y4 * FP8_SX, y5 * FP8_SX, y6 * FP8_SX, y7 * FP8_SX); *(u32x2*)(h8 + off + bj * HALF) = q; } }
                pt += __shfl_xor(pt, 16); pt += __shfl_xor(pt, 32); part[ai][m] = pt; }
        }
        if (fq == 0) {
#pragma unroll
            for (int ai = 0; ai < 2; ++ai)
#pragma unroll
                for (int m = 0; m < 4; ++m) atomicAdd(ssq + row0 + ai * HALF + m * 16, ssq_fix(part[ai][m])); }
    }
};
struct EpiDown {
    static constexpr bool PERM = true;
    bf16_t* O; bf16_t* KR; const ssq_t* rs; ssq_t* ssq_q; ssq_t* ssq_kv; const float* cosT; const float* sinT;
    __device__ __forceinline__ void operator()(const f32x4 (&acc)[2][2][4][2], const Unit& u, int wr, int wc, int fr, int fq) const {
        const int row0 = u.orow + launder_v(wr * 64 + fr);
        float sc[2][4]; ssq_t rq[2][4];
#pragma unroll
        for (int ai = 0; ai < 2; ++ai)
#pragma unroll
            for (int m = 0; m < 4; ++m) rq[ai][m] = rs[row0 + ai * HALF + m * 16];
#pragma unroll
        for (int ai = 0; ai < 2; ++ai)
#pragma unroll
            for (int m = 0; m < 4; ++m) sc[ai][m] = rstd_of(rq[ai][m]);
        if (u.pn < 3) {
            ssq_t* sq = u.pn < 2 ? ssq_q : ssq_kv; const int col0 = u.pn * BM + wc * 32 + 8 * fq; float pts[2][4];
#pragma unroll
            for (int ai = 0; ai < 2; ++ai)
#pragma unroll
                for (int m = 0; m < 4; ++m) { const int row = row0 + ai * HALF + m * 16; bf16_t* rowp = O + (size_t)row * NDOWNP + col0; const float s = sc[ai][m]; float part = 0.f;
#pragma unroll
                    for (int bj = 0; bj < 2; ++bj) { const f32x4 v0 = acc[ai][bj][m][0] * s, v1 = acc[ai][bj][m][1] * s;
                        part += (v0[0] * v0[0] + v0[1] * v0[1]) + (v0[2] * v0[2] + v0[3] * v0[3]) + (v1[0] * v1[0] + v1[1] * v1[1]) + (v1[2] * v1[2] + v1[3] * v1[3]);
                        u32x4 w; w.x = cvt_pk_bf16(v0[0], v0[1]); w.y = cvt_pk_bf16(v0[2], v0[3]); w.z = cvt_pk_bf16(v1[0], v1[1]); w.w = cvt_pk_bf16(v1[2], v1[3]);
                        *(u32x4*)(rowp + bj * HALF) = w; }
                    part += __shfl_xor(part, 16); part += __shfl_xor(part, 32); pts[ai][m] = part; }
            if (fq == 0) {
#pragma unroll
                for (int ai = 0; ai < 2; ++ai)
#pragma unroll
                    for (int m = 0; m < 4; ++m) atomicAdd(sq + row0 + ai * HALF + m * 16, ssq_fix(pts[ai][m])); }
        } else if (wc == 0) {
#pragma unroll
            for (int aq = 0; aq < 4; ++aq) { const int ai = aq >> 1, mb = (aq & 1) * 2; f32x4 ct[4][2], st[4][2];
#pragma unroll
                for (int m = mb; m < mb + 2; ++m) { const size_t to = (size_t)(row0 + ai * HALF + m * 16) * 32 + 8 * fq;
                    ct[m][0] = *(const f32x4*)(cosT + to); ct[m][1] = *(const f32x4*)(cosT + to + 4); st[m][0] = *(const f32x4*)(sinT + to); st[m][1] = *(const f32x4*)(sinT + to + 4); }
#pragma unroll
                for (int m = mb; m < mb + 2; ++m) { const int row = row0 + ai * HALF + m * 16; const float s = sc[ai][m];
                    const f32x4 a0 = acc[ai][0][m][0] * s, a1 = acc[ai][0][m][1] * s, b0 = acc[ai][1][m][0] * s, b1 = acc[ai][1][m][1] * s;
                    const f32x4 x0 = a0 * ct[m][0] - b0 * st[m][0], x1 = a1 * ct[m][1] - b1 * st[m][1], y0 = b0 * ct[m][0] + a0 * st[m][0], y1 = b1 * ct[m][1] + a1 * st[m][1];
                    bf16_t* rp = KR + (size_t)row * DROPE + 8 * fq;
                    u32x4 w; w.x = cvt_pk_bf16(x0[0], x0[1]); w.y = cvt_pk_bf16(x0[2], x0[3]); w.z = cvt_pk_bf16(x1[0], x1[1]); w.w = cvt_pk_bf16(x1[2], x1[3]);
                    *(u32x4*)rp = w;
                    w.x = cvt_pk_bf16(y0[0], y0[1]); w.y = cvt_pk_bf16(y0[2], y0[3]); w.z = cvt_pk_bf16(y1[0], y1[1]); w.w = cvt_pk_bf16(y1[2], y1[3]);
                    *(u32x4*)(rp + 32) = w; } }
        }
    }
};
struct EpiQ {
    static constexpr bool PERM = true;
    bf16_t* Q; const float* cosT; const float* sinT; const ssq_t* rs;
    __device__ __forceinline__ void operator()(const f32x4 (&acc)[2][2][4][2], const Unit& u, int wr, int wc, int fr, int fq) const {
        const int row0 = u.orow + launder_v(wr * 64 + fr);
        float sc[2][4]; ssq_t rq[2][4];
#pragma unroll
        for (int ai = 0; ai < 2; ++ai)
#pragma unroll
            for (int m = 0; m < 4; ++m) rq[ai][m] = rs[row0 + ai * HALF + m * 16];
#pragma unroll
        for (int ai = 0; ai < 2; ++ai)
#pragma unroll
            for (int m = 0; m < 4; ++m) sc[ai][m] = rstd_n(rq[ai][m], 1.0f / QLR);
        if (u.pn < 2) {
            const int h = 4 * u.pn + wc;
#pragma unroll
            for (int aq = 0; aq < 4; ++aq) { const int ai = aq >> 1, mb = (aq & 1) * 2; f32x4 ct[4][2], st[4][2];
#pragma unroll
                for (int m = mb; m < mb + 2; ++m) { const size_t to = (size_t)(row0 + ai * HALF + m * 16) * 32 + 8 * fq;
                    ct[m][0] = *(const f32x4*)(cosT + to); ct[m][1] = *(const f32x4*)(cosT + to + 4); st[m][0] = *(const f32x4*)(sinT + to); st[m][1] = *(const f32x4*)(sinT + to + 4); }
#pragma unroll
                for (int m = mb; m < mb + 2; ++m) { const int row = row0 + ai * HALF + m * 16; const float s = sc[ai][m];
                    const f32x4 a0 = acc[ai][0][m][0] * s, a1 = acc[ai][0][m][1] * s, b0 = acc[ai][1][m][0] * s, b1 = acc[ai][1][m][1] * s;
                    const f32x4 x0 = a0 * ct[m][0] - b0 * st[m][0], x1 = a1 * ct[m][1] - b1 * st[m][1], y0 = b0 * ct[m][0] + a0 * st[m][0], y1 = b1 * ct[m][1] + a1 * st[m][1];
                    bf16_t* rp = Q + (size_t)row * NQ + h * DQH + DNOPE + 8 * fq;
                    u32x4 w; w.x = cvt_pk_bf16(x0[0], x0[1]); w.y = cvt_pk_bf16(x0[2], x0[3]); w.z = cvt_pk_bf16(x1[0], x1[1]); w.w = cvt_pk_bf16(x1[2], x1[3]);
                    *(u32x4*)rp = w;
                    w.x = cvt_pk_bf16(y0[0], y0[1]); w.y = cvt_pk_bf16(y0[2], y0[3]); w.z = cvt_pk_bf16(y1[0], y1[1]); w.w = cvt_pk_bf16(y1[2], y1[3]);
                    *(u32x4*)(rp + 32) = w; } }
        } else {
#pragma unroll
            for (int ai = 0; ai < 2; ++ai)
#pragma unroll
                for (int m = 0; m < 4; ++m) { const int row = row0 + ai * HALF + m * 16; const float s = sc[ai][m];
#pragma unroll
                    for (int bj = 0; bj < 2; ++bj) { const int h = 2 * (u.pn - 2) + bj; const f32x4 v0 = acc[ai][bj][m][0] * s, v1 = acc[ai][bj][m][1] * s;
                        u32x4 w; w.x = cvt_pk_bf16(v0[0], v0[1]); w.y = cvt_pk_bf16(v0[2], v0[3]); w.z = cvt_pk_bf16(v1[0], v1[1]); w.w = cvt_pk_bf16(v1[2], v1[3]);
                        *(u32x4*)(Q + (size_t)row * NQ + h * DQH + wc * 32 + 8 * fq) = w; } }
        }
    }
};

__device__ __forceinline__ unsigned gather_off(const Unit& u, int idx, unsigned lda_b, unsigned cb) { const int tok = idx < u.nrows ? u.rows[idx] : 0; return (unsigned)tok * lda_b + cb; }
__device__ __forceinline__ u32x4 gather_offs(const Unit& u, int tid, unsigned lda_b) {
    const int t2 = launder_v(tid); int R0, C0, R1, C1; stage_rc(t2 * 16, R0, C0); stage_rc(t2 * 16 + 8192, R1, C1);
    u32x4 pk; pk.x = gather_off(u, R0, lda_b, (unsigned)C0 * 2u); pk.y = gather_off(u, R1, lda_b, (unsigned)C1 * 2u); pk.z = gather_off(u, HALF + R0, lda_b, (unsigned)C0 * 2u); pk.w = gather_off(u, HALF + R1, lda_b, (unsigned)C1 * 2u);
    return pk;
}
typedef int i32x4 __attribute__((ext_vector_type(4)));
typedef int i32x8 __attribute__((ext_vector_type(8)));
template <class Epi, class Sched, bool GATHER, bool FP8 = false>
__device__ __forceinline__ void gemm_phase(LAS unsigned char* lds, const unsigned lda_b, const unsigned ldb_b, const int Kb, const Sched& S, const Epi& E, const unsigned stag_ticks = 0u) {
    if (stag_ticks) { const unsigned long long t0 = __builtin_amdgcn_s_memrealtime(), dl = (unsigned long long)((blockIdx.x >> 3) & 3u) * stag_ticks;
        while (__builtin_amdgcn_s_memrealtime() - t0 < dl) __builtin_amdgcn_s_sleep(8); }
    const int tid = launder_v((int)threadIdx.x), wid = __builtin_amdgcn_readfirstlane(tid >> 6), lane = tid & 63, wr = wid >> 2, wc = wid & 3, fr = lane & 15, fq = lane >> 4;
    int nt = Kb / (BK * 2); asm volatile("" : "+s"(nt));
    unsigned voffA[2], voffB[2];
#pragma unroll
    for (int i = 0; i < 2; ++i) { int R, C; stage_rc(tid * 16 + i * 8192, R, C); const int Rb = Epi::PERM ? ((R & ~31) + perm32(R & 31)) : R;
        voffA[i] = (unsigned)R * lda_b + (unsigned)C * 2u; voffB[i] = (unsigned)Rb * ldb_b + (unsigned)C * 2u; }
    const size_t kstep = (size_t)(BK * 2);
    const size_t hstepA = (size_t)HALF * lda_b, hstepB = (size_t)HALF * ldb_b;
    const unsigned ldsw = (unsigned)wid * 1024u, ldsbase = (unsigned)__builtin_amdgcn_readfirstlane((int)(unsigned)(size_t)lds);
    const int aoff = lds_byte(wr * 64 + fr, fq * 8), boff = lds_byte(wc * 32 + fr, fq * 8);
    unsigned cv0[2] = {0u, 0u}, cv1[2] = {0u, 0u}, nv0[2] = {0u, 0u}, nv1[2] = {0u, 0u};
#define PG8_SA(b, h) (((b) * 2 + (h)) * HTB)
#define PG8_SB(b, h) ((4 + (b) * 2 + (h)) * HTB)
#define PG8_LOAD16(sbase, voff, ldsoff) do { unsigned _keep; asm volatile("s_mov_b32 %0, m0\n\ts_mov_b32 m0, %3\n\ts_nop 0\n\tglobal_load_lds_dwordx4 %1, %2\n\ts_mov_b32 m0, %0" \
        : "=&s"(_keep) : "v"(voff), "s"(sbase), "s"(ldsbase + (unsigned)(ldsoff)) : "memory"); } while (0)
#define PG8_STAGE_B(bufoff, gbase, h) do { _Pragma("unroll") for (int _i = 0; _i < 2; ++_i) PG8_LOAD16((gbase) + (h) * hstepB, voffB[_i], (bufoff) + ldsw + _i * 8192); } while (0)
#define PG8_STAGE_A(bufoff, gbase, h, usenext) do { _Pragma("unroll") for (int _i = 0; _i < 2; ++_i) { unsigned _vo; \
        if constexpr (GATHER) { _vo = (usenext) ? ((h) ? nv1[_i] : nv0[_i]) : ((h) ? cv1[_i] : cv0[_i]); PG8_LOAD16((gbase), _vo, (bufoff) + ldsw + _i * 8192); } \
        else { PG8_LOAD16((gbase) + (h) * hstepA, voffA[_i], (bufoff) + ldsw + _i * 8192); } } } while (0)
#define PG8_LD32(off) __builtin_shufflevector(*(const LAS i32x4*)(lds + (off)), *(const LAS i32x4*)(lds + (off) + 1024), 0, 1, 2, 3, 4, 5, 6, 7)
#define PG8_LDA(dst, b, h) do { _Pragma("unroll") for (int m = 0; m < 4; ++m) { if constexpr (FP8) { dst##8[m] = PG8_LD32(PG8_SA(b, h) + aoff + m * 2048); } else { _Pragma("unroll") for (int k = 0; k < 2; ++k) dst[m][k] = *(const LAS bf16x8*)(lds + PG8_SA(b, h) + aoff + m * 2048 + k * 1024); } } } while (0)
#define PG8_LDB(dst, b, h) do { _Pragma("unroll") for (int n = 0; n < 2; ++n) { if constexpr (FP8) { dst##8[n] = PG8_LD32(PG8_SB(b, h) + boff + n * 2048); } else { _Pragma("unroll") for (int k = 0; k < 2; ++k) dst[n][k] = *(const LAS bf16x8*)(lds + PG8_SB(b, h) + boff + n * 2048 + k * 1024); } } } while (0)
#define PG8_MMA(ai, bj, At, Bt) do { __builtin_amdgcn_s_setprio(1); _Pragma("unroll") for (int m = 0; m < 4; ++m) _Pragma("unroll") for (int n = 0; n < 2; ++n) { \
        if constexpr (FP8) { asm volatile("v_mfma_f32_16x16x128_f8f6f4 %0, %1, %2, %0" : "+v"(acc[ai][bj][m][n]) : "v"(Bt##8[n]), "v"(At##8[m])); }     \
        else { _Pragma("unroll") for (int k = 0; k < 2; ++k) acc[ai][bj][m][n] = __builtin_amdgcn_mfma_f32_16x16x32_bf16(Bt[n][k], At[m][k], acc[ai][bj][m][n], 0, 0, 0); } } \
        __builtin_amdgcn_s_setprio(0); } while (0)
#define PG8_WAIT_V(n) asm volatile("s_waitcnt vmcnt(" #n ")" ::: "memory")
#define PG8_WAIT_L(n) asm volatile("s_waitcnt lgkmcnt(" #n ")" ::: "memory")
#define PG8_BAR __builtin_amdgcn_s_barrier()
#define PG8_SCHED __builtin_amdgcn_sched_barrier(0)
    Unit cur, nxt; int ui = 0;
    (void)S.next(0, cur);
    f32x4 acc[2][2][4][2];
#pragma unroll
    for (int a = 0; a < 2; ++a)
#pragma unroll
        for (int b = 0; b < 2; ++b)
#pragma unroll
            for (int m = 0; m < 4; ++m)
#pragma unroll
                for (int n = 0; n < 2; ++n) acc[a][b][m][n] = (f32x4){0.f, 0.f, 0.f, 0.f};
    bf16x8 At[4][2], B0[2][2], B1[2][2]; i32x8 At8[4], B08[2], B18[2];
    const char* cA = cur.a; const char* cB = cur.b;
    if constexpr (GATHER) { const u32x4 pk = gather_offs(cur, tid, lda_b); cv0[0] = pk.x; cv0[1] = pk.y; cv1[0] = pk.z; cv1[1] = pk.w; }
    PG8_STAGE_B(PG8_SB(0, 0), cB, 0); PG8_SCHED; PG8_STAGE_B(PG8_SB(0, 1), cB, 1); PG8_SCHED; PG8_STAGE_A(PG8_SA(0, 0), cA, 0, false); PG8_SCHED; PG8_STAGE_A(PG8_SA(0, 1), cA, 1, false);
    if (wr == 1) PG8_BAR;
    PG8_WAIT_V(2); PG8_BAR;
    PG8_STAGE_B(PG8_SB(1, 0), cB + kstep, 0); PG8_SCHED; PG8_STAGE_A(PG8_SA(1, 0), cA + kstep, 0, false); PG8_SCHED; PG8_STAGE_B(PG8_SB(1, 1), cB + kstep, 1);
    PG8_WAIT_V(6); PG8_BAR;
    for (;;) {
        int has_next = 0; const char* nA = cA; const char* nB = cB;
        if constexpr (GATHER) { has_next = __builtin_amdgcn_readfirstlane(S.next(ui + 1, nxt) ? 1 : 0); nA = has_next ? nxt.a : cA; nB = has_next ? nxt.b : cB; }
        if constexpr (GATHER) {
            u32x4 pk = (u32x4){cv0[0], cv0[1], cv1[0], cv1[1]}; if (has_next) pk = gather_offs(nxt, tid, lda_b);
            *(LAS u32x4*)(lds + STAGE_BYTES + 1024 + tid * 16) = pk;
        }
#pragma nounroll
        for (int t = 0; t < nt; t += 2) {
            const bool last = (t == nt - 2);
            if constexpr (!GATHER) { if (last) { int uin = ui + 1; asm volatile("" : "+s"(uin)); has_next = __builtin_amdgcn_readfirstlane(S.next(uin, nxt) ? 1 : 0); nA = has_next ? nxt.a : cA; nB = has_next ? nxt.b : cB; } }
            if constexpr (GATHER) { if (last) { const u32x4 pk = *(const LAS u32x4*)(lds + STAGE_BYTES + 1024 + tid * 16); nv0[0] = pk.x; nv0[1] = pk.y; nv1[0] = pk.z; nv1[1] = pk.w; } }
            const char* a1 = cA + (size_t)(t + 1) * kstep;
            const char* a2 = last ? nA : cA + (size_t)(t + 2) * kstep; const char* b2 = last ? nB : cB + (size_t)(t + 2) * kstep;
            const char* a3 = a2 + kstep; const char* b3 = b2 + kstep;
            PG8_LDB(B0, 0, 0); PG8_LDB(B1, 0, 1); PG8_SCHED; PG8_LDA(At, 0, 0); PG8_STAGE_A(PG8_SA(1, 1), a1, 1, false);
            PG8_WAIT_V(8); PG8_WAIT_L(0); PG8_BAR; PG8_MMA(0, 0, At, B0); PG8_MMA(0, 1, At, B1); PG8_BAR; PG8_SCHED;
            PG8_LDA(At, 0, 1); PG8_STAGE_B(PG8_SB(0, 0), b2, 0); PG8_STAGE_B(PG8_SB(0, 1), b2, 1); PG8_STAGE_A(PG8_SA(0, 0), a2, 0, last);
            PG8_WAIT_V(8); PG8_WAIT_L(0); PG8_BAR; PG8_MMA(1, 0, At, B0); PG8_MMA(1, 1, At, B1); PG8_BAR; PG8_SCHED;
            PG8_LDB(B0, 1, 0); PG8_LDB(B1, 1, 1); PG8_SCHED; PG8_LDA(At, 1, 0); PG8_STAGE_A(PG8_SA(0, 1), a2, 1, last);
            PG8_WAIT_V(8); PG8_WAIT_L(0); PG8_BAR; PG8_MMA(0, 0, At, B0); PG8_MMA(0, 1, At, B1); PG8_BAR; PG8_SCHED;
            PG8_LDA(At, 1, 1); PG8_STAGE_B(PG8_SB(1, 0), b3, 0); PG8_STAGE_B(PG8_SB(1, 1), b3, 1); PG8_STAGE_A(PG8_SA(1, 0), a3, 0, last);
            PG8_WAIT_V(8); PG8_WAIT_L(0); PG8_BAR; PG8_MMA(1, 0, At, B0); PG8_MMA(1, 1, At, B1); PG8_BAR; PG8_SCHED;
        }
        if (wr == 0) PG8_BAR;
        if constexpr (FP8) asm volatile("s_nop 15\n\ts_nop 15" ::: "memory");
        E(acc, cur, wr, wc, fr, fq);
        if (!has_next) break;
#pragma unroll
        for (int a = 0; a < 2; ++a)
#pragma unroll
            for (int b = 0; b < 2; ++b)
#pragma unroll
                for (int m = 0; m < 4; ++m)
#pragma unroll
                    for (int n = 0; n < 2; ++n) acc[a][b][m][n] = (f32x4){0.f, 0.f, 0.f, 0.f};
        cur = nxt; cA = nA; cB = nB; ++ui;
        if constexpr (GATHER) {
#pragma unroll
            for (int i = 0; i < 2; ++i) { cv0[i] = nv0[i]; cv1[i] = nv1[i]; }
        }
        if (wr == 1) PG8_BAR;
    }
    PG8_WAIT_V(0);
    PG8_BAR;
#undef PG8_SA
#undef PG8_SB
#undef PG8_LOAD16
#undef PG8_STAGE_A
#undef PG8_STAGE_B
#undef PG8_LDA
#undef PG8_LDB
#undef PG8_LD32
#undef PG8_MMA
#undef PG8_WAIT_V
#undef PG8_WAIT_L
#undef PG8_BAR
#undef PG8_SCHED
}
}
namespace att {
constexpr int NW = 8, QBLK = 32, KVBLK = 64, QB = NW * QBLK;
constexpr int DQK = 192, DV = 128;
constexpr int QS = NQ, KNS = NKV, KRS = DROPE, OS = DM;
constexpr int SHM_V = KVBLK * DV * 2, SHM_K = KVBLK * DQK * 2;
constexpr int LDS_QR = 2 * SHM_V + 2 * SHM_K + NW * 64 * 4;
constexpr int LDS_BYTES = LDS_QR + NW * 4096;
constexpr float SCALE = 0.07216878364870322f;
constexpr float THR = 8.f;
#define KSWZ(row, ch) ((row) * 384 + ((((ch) ^ (((row) >> 1) & 7))) << 4))
#define SBAR() __builtin_amdgcn_sched_barrier(0)
__device__ __forceinline__ int v_st(int k, int c) { const int kk = (k & ~0xC) | ((k & 4) << 1) | ((k & 8) >> 1); return ((kk >> 3) * 4 + (c >> 5)) * 512 + ((kk & 7) * 32 + (c & 31)) * 2; }
__device__ __forceinline__ int v_rd_base(int lane) { return ((lane & 3) << 3) | (((lane >> 2) & 3) << 6) | (((lane >> 4) & 1) << 5) | (((lane >> 5) & 1) << 8); }
constexpr int v_rd_off(int d0, int ks, int half) { return d0 * 512 + ks * 4096 + half * 2048; }
__device__ __forceinline__ int crow(int r, int hi) { return (r & 3) + 8 * (r >> 2) + 4 * hi; }
__device__ __forceinline__ void mask_tile(f32x16& p0, f32x16& p1, int dq) {
    const float NEG = -__builtin_inff();
#pragma unroll
    for (int r = 0; r < 16; ++r) {
        const int c = (r & 3) + 8 * (r >> 2);
        if (dq - c < 0) p0[r] = NEG;
        if (dq - c - 32 < 0) p1[r] = NEG;
    }
}
__device__ __forceinline__ void partialSM(f32x16& p0, f32x16& p1, float& m_reg, float& mn, float& alpha) {
    float pmax = p0[0]; for (int r = 1; r < 16; ++r) pmax = fmaxf(pmax, p0[r]); for (int r = 0; r < 16; ++r) pmax = fmaxf(pmax, p1[r]);
    { auto rr = __builtin_amdgcn_permlane32_swap(__float_as_uint(pmax), __float_as_uint(pmax), false, false);
      pmax = fmaxf(__uint_as_float(rr[0]), __uint_as_float(rr[1])); }
    constexpr float C2 = 1.4426950408889634f * SCALE;
    if (__builtin_expect(__all((pmax - m_reg) * SCALE <= THR), 1)) { mn = m_reg; alpha = 1.f; }
    else { mn = fmaxf(m_reg, pmax); alpha = __builtin_amdgcn_exp2f((m_reg - mn) * C2); m_reg = mn; }
    const float mnL = -mn * C2;
    for (int r = 0; r < 16; ++r) p0[r] = fmaf(p0[r], C2, mnL); for (int r = 0; r < 16; ++r) p1[r] = fmaf(p1[r], C2, mnL);
    for (int r = 0; r < 16; ++r) p0[r] = __builtin_amdgcn_exp2f(p0[r]);
}
__device__ __forceinline__ void finishSM(f32x16& p0, f32x16& p1, float alpha, float& l_reg, bf16x8& pa0, bf16x8& pa1, bf16x8& pa2, bf16x8& pa3) {
    for (int r = 0; r < 16; ++r) p1[r] = __builtin_amdgcn_exp2f(p1[r]);
    float ps = 0; for (int r = 0; r < 16; ++r) ps += p0[r]; for (int r = 0; r < 16; ++r) ps += p1[r];
    { auto rr = __builtin_amdgcn_permlane32_swap(__float_as_uint(ps), __float_as_uint(ps), false, false);
      ps = __uint_as_float(rr[0]) + __uint_as_float(rr[1]); }
    l_reg = l_reg * alpha + ps;
#define PK4(P, B_, OUT) do { unsigned a0 = cvt_pk_bf16(P[B_+0], P[B_+1]), a1 = cvt_pk_bf16(P[B_+2], P[B_+3]);                          \
        unsigned b0 = cvt_pk_bf16(P[B_+4], P[B_+5]), b1 = cvt_pk_bf16(P[B_+6], P[B_+7]);                                             \
        auto r0 = __builtin_amdgcn_permlane32_swap(a0, b0, false, false); auto r1 = __builtin_amdgcn_permlane32_swap(a1, b1, false, false); \
        u32x4 w = {r0[0], r1[0], r0[1], r1[1]}; OUT = *reinterpret_cast<bf16x8*>(&w); } while (0)
    PK4(p0, 0, pa0); PK4(p0, 8, pa1); PK4(p1, 0, pa2); PK4(p1, 8, pa3);
#undef PK4
}
template <int KB>
__device__ __forceinline__ void qkt(f32x16& p0, f32x16& p1, const char* K_lds, int r32, int hi, const bf16x8* qr, const char* qrl) {
    p0 = f32x16{}; p1 = f32x16{};
    const char* kb[4];
#pragma unroll
    for (int dd = 0; dd < 4; ++dd) kb[dd] = K_lds + KB * SHM_K + KSWZ(r32, dd * 2 + hi);
    bf16x8 k0[3], k1[3], qx[4];
#define QK_LDK(d0_, s_) do { const char* a_ = kb[(d0_) & 3] + ((d0_) >> 2) * 128; k0[s_] = *reinterpret_cast<const bf16x8*>(a_); k1[s_] = *reinterpret_cast<const bf16x8*>(a_ + 32 * 384); } while (0)
    QK_LDK(0, 0); QK_LDK(1, 1);
#pragma unroll
    for (int d0 = 0; d0 < 12; ++d0) {
        if (d0 + 2 < 12) QK_LDK(d0 + 2, (d0 + 2) % 3);
        if (d0 >= 4 && d0 < 8) qx[d0 - 4] = *reinterpret_cast<const bf16x8*>(qrl + (d0 - 4) * 1024);
        SBAR();
        const bf16x8 qf = d0 < 8 ? qr[d0 & 7] : qx[(d0 - 8) & 3];
        p0 = __builtin_amdgcn_mfma_f32_32x32x16_bf16(k0[d0 % 3], qf, p0, 0, 0, 0);
        p1 = __builtin_amdgcn_mfma_f32_32x32x16_bf16(k1[d0 % 3], qf, p1, 0, 0, 0);
        SBAR(); }
#undef QK_LDK
}
template <int VB>
__device__ __forceinline__ void pv_tile(f32x16* o, int vb0, bf16x8 pa0, bf16x8 pa1, bf16x8 pa2, bf16x8 pa3) {
#define TRRD(dst, off) asm volatile("ds_read_b64_tr_b16 %0, %1 offset:%2" : "=&v"(dst) : "v"(vb0), "i"(off) : "memory")
#define PV_D0(d0) do { s16x4 l0, l1, l2, l3, h0, h1, h2, h3; constexpr int b_ = VB * SHM_V + v_rd_off(d0, 0, 0); \
        TRRD(l0, b_); TRRD(h0, b_ + 2048); TRRD(l1, b_ + 4096); TRRD(h1, b_ + 6144); TRRD(l2, b_ + 8192); TRRD(h2, b_ + 10240); TRRD(l3, b_ + 12288); TRRD(h3, b_ + 14336); \
        asm volatile("s_waitcnt lgkmcnt(0)" ::: "memory"); SBAR();   \
        o[d0] = __builtin_amdgcn_mfma_f32_32x32x16_bf16(pa0, (bf16x8){l0[0], l0[1], l0[2], l0[3], h0[0], h0[1], h0[2], h0[3]}, o[d0], 0, 0, 0);   \
        o[d0] = __builtin_amdgcn_mfma_f32_32x32x16_bf16(pa1, (bf16x8){l1[0], l1[1], l1[2], l1[3], h1[0], h1[1], h1[2], h1[3]}, o[d0], 0, 0, 0);   \
        o[d0] = __builtin_amdgcn_mfma_f32_32x32x16_bf16(pa2, (bf16x8){l2[0], l2[1], l2[2], l2[3], h2[0], h2[1], h2[2], h2[3]}, o[d0], 0, 0, 0);   \
        o[d0] = __builtin_amdgcn_mfma_f32_32x32x16_bf16(pa3, (bf16x8){l3[0], l3[1], l3[2], l3[3], h3[0], h3[1], h3[2], h3[3]}, o[d0], 0, 0, 0); } while (0)
    PV_D0(0); PV_D0(1); PV_D0(2); PV_D0(3);
#undef PV_D0
#undef TRRD
}
struct BlockRef { const bf16_t* Q; const bf16_t* Kn; const bf16_t* Kr; const bf16_t* V; bf16_t* O; int P0; };
struct Seam { bf16x8 qr[8]; bf16x8 st_v0, st_v1, st_k0, st_k1, st_k2; };
#define VMW() asm volatile("s_waitcnt vmcnt(0)" ::: "memory")
#define VMWN(n) asm volatile("s_waitcnt vmcnt(%0)" :: "i"(n) : "memory")
#define LD8(p) (*reinterpret_cast<const bf16x8*>(p))
#define SLOAD_H(R_, k0) do { S.st_v0 = LD8((R_).V + (size_t)((k0) + sr) * KNS + sc); S.st_v1 = LD8((R_).V + (size_t)((k0) + 32 + sr) * KNS + sc);              \
                             S.st_k0 = LD8((R_).Kn + (size_t)((k0) + sr) * KNS + sc); S.st_k1 = LD8((R_).Kn + (size_t)((k0) + 32 + sr) * KNS + sc);            \
                             S.st_k2 = LD8((R_).Kr + (size_t)((k0) + rr) * KRS + rc); } while (0)
#define SWRITE_HK(bf) do { *(bf16x8*)(K_lds + (bf) * SHM_K + kws) = S.st_k0; *(bf16x8*)(K_lds + (bf) * SHM_K + kws + 32 * 384) = S.st_k1; *(bf16x8*)(K_lds + (bf) * SHM_K + kws2) = S.st_k2; } while (0)
#define SWRITE_HV(bf) do { *(bf16x8*)(V_lds + (bf) * SHM_V + vst0) = S.st_v0; *(bf16x8*)(V_lds + (bf) * SHM_V + vst1) = S.st_v1; } while (0)
#define SWRITE_H(bf) do { SWRITE_HV(bf); SWRITE_HK(bf); } while (0)
#define ATT_IDX const int tid = launder_v((int)threadIdx.x), wid = __builtin_amdgcn_readfirstlane(tid >> 6), lane = tid & 63, r32 = lane & 31, hi = lane >> 5; \
    const int sr = tid >> 4, sc = (tid & 15) * 8, rr = tid >> 3, rc = (tid & 7) * 8, kws = KSWZ(sr, (tid & 15)), kws2 = KSWZ(rr, 16 + (tid & 7));
__device__ __forceinline__ void attn_block(const BlockRef& cur, char* lds) {
    ATT_IDX;
    Seam S;
    const int NT = cur.P0 / KVBLK + QB / KVBLK;
    const int qlo = cur.P0 + wid * QBLK, qm = qlo + r32 - 4 * hi;
    char* V_lds = lds; char* K_lds = lds + 2 * SHM_V;
    float* ws = (float*)(lds + 2 * SHM_V + 2 * SHM_K) + wid * 64; float* li_l = ws, * al_l = ws + 32;
    float m_reg = -1e30f, l_reg = 0; f32x16 o[4] = {};
    const int vst0 = v_st(sr, sc), vst1 = v_st(32 + sr, sc);
    const int vb0 = (int)(uintptr_t)V_lds + v_rd_base(lane);
    char* qrl = lds + LDS_QR + wid * 4096 + lane * 16;
#define RESC(a) do { if (__any((a) < 1.f)) { if (hi == 0) al_l[r32] = (a); asm volatile("s_waitcnt lgkmcnt(0)" ::: "memory");              \
                     for (int d_ = 0; d_ < 4; ++d_) for (int r = 0; r < 16; ++r) o[d_][r] *= al_l[crow(r, hi)]; } } while (0)
#define KBASE(t) ((t) * KVBLK)
#define MASKT(P0_, P1_, t) do { const int kb_ = KBASE(t); if (kb_ + KVBLK - 1 > qlo) mask_tile(P0_, P1_, qm - kb_); } while (0)
    SLOAD_H(cur, 0);
#pragma unroll
    for (int d0 = 0; d0 < 8; ++d0) S.qr[d0] = LD8(cur.Q + (size_t)(wid * QBLK + r32) * QS + d0 * 16 + hi * 8);
    { bf16x8 t0 = LD8(cur.Q + (size_t)(wid * QBLK + r32) * QS + 128 + hi * 8), t1 = LD8(cur.Q + (size_t)(wid * QBLK + r32) * QS + 144 + hi * 8),
             t2 = LD8(cur.Q + (size_t)(wid * QBLK + r32) * QS + 160 + hi * 8), t3 = LD8(cur.Q + (size_t)(wid * QBLK + r32) * QS + 176 + hi * 8);
      *(bf16x8*)(qrl) = t0; *(bf16x8*)(qrl + 1024) = t1; *(bf16x8*)(qrl + 2048) = t2; *(bf16x8*)(qrl + 3072) = t3; }
    VMW(); SWRITE_H(0);
    __syncthreads();
    f32x16 p0, p1; float mn, al; bf16x8 pa0, pa1, pa2, pa3;
#define TILE_STEP(t, BF) do {                                                                                                 \
        if ((t) + 1 < NT) { SLOAD_H(cur, KBASE((t) + 1)); }                                                                    \
        SBAR();                                                                                                               \
        if (KBASE(t) <= qlo + QBLK - 1) {     \
        qkt<BF>(p0, p1, K_lds, r32, hi, S.qr, qrl);                                                                           \
        MASKT(p0, p1, (t)); partialSM(p0, p1, m_reg, mn, al); RESC(al);                                                        \
        finishSM(p0, p1, al, l_reg, pa0, pa1, pa2, pa3); SBAR();                                                              \
        pv_tile<BF>(o, vb0, pa0, pa1, pa2, pa3); }                                                                            \
        if ((t) + 1 < NT) { VMW(); SWRITE_H(1 - BF); }                                                                         \
        __syncthreads(); } while (0)
    for (int t = 0; t < NT; t += 2) { TILE_STEP(t, 0); TILE_STEP(t + 1, 1); }
    if (hi == 0) li_l[r32] = l_reg; asm volatile("s_waitcnt lgkmcnt(0)" ::: "memory");
    float rli[16];
#pragma unroll
    for (int r = 0; r < 16; ++r) rli[r] = __builtin_amdgcn_rcpf(li_l[crow(r, hi)]);
    bf16_t* Ow = cur.O + (size_t)(wid * QBLK) * OS;
#pragma unroll
    for (int r = 0; r < 16; ++r) { const int orow = crow(r, hi);
#pragma unroll
        for (int d0 = 0; d0 < 4; ++d0) { const float v = o[d0][r] * rli[r];
            const float vn = __shfl_xor(v, 1);
            if ((r32 & 1) == 0) *(unsigned*)(Ow + (size_t)orow * OS + d0 * 32 + r32) = cvt_pk_bf16(v, vn); } }
    __syncthreads();
#undef RESC
#undef KBASE
#undef MASKT
#undef TILE_STEP
}
#undef VMW
#undef VMWN
#undef LD8
#undef SLOAD_H
#undef SWRITE_HK
#undef SWRITE_HV
#undef SWRITE_H
#undef ATT_IDX
#undef KSWZ
#undef SBAR

__device__ __forceinline__ BlockRef make_ref(int L, int pass, const bf16_t* Qb, const bf16_t* KNVb, const bf16_t* KRb, bf16_t* Ob) {
    const int bh = L >> 2, x = L & 3, qb = pass ? 7 - x : x, b = bh >> 3, h = bh & 7; const size_t rb = (size_t)b * SEQ;
    BlockRef r; r.Q = Qb + (rb + (size_t)qb * QB) * QS + h * DQH; r.Kn = KNVb + rb * KNS + h * (DNOPE + DVH); r.Kr = KRb + rb * KRS; r.V = KNVb + rb * KNS + h * (DNOPE + DVH) + DNOPE;
    r.O = Ob + (rb + (size_t)qb * QB) * OS + h * DVH; r.P0 = qb * QB; return r;
}
__device__ __forceinline__ void attn_phase(char* lds, const bf16_t* Qb, const bf16_t* KNVb, const bf16_t* KRb, bf16_t* Ob, int first, int stride) {
    constexpr int total = NBATCH * NHEAD * 4;
    for (int L = first; L < total; L += stride) {
        for (int pass = 0; pass < 2; ++pass) { const BlockRef cur = make_ref(L, pass, Qb, KNVb, KRb, Ob); attn_block(cur, lds); }
    }
}
}
constexpr int NWAVES = 8;
constexpr size_t MiB = 1u << 20;
constexpr size_t WS_CTL = 0, CTL_ZERO_BYTES = 8 * MiB;
constexpr size_t WS_SSQ = 1 * MiB;
constexpr size_t WS_COS = 8 * MiB, WS_SIN = 16 * MiB;
constexpr size_t WS_LIST = 24 * MiB;
constexpr size_t WS_RSL = 26 * MiB;
constexpr size_t WS_TOKINFO = 28 * MiB;
constexpr size_t WS_WDN = 30 * MiB, WS_WUQ = 34 * MiB, WS_WUKV = 37 * MiB, WS_WO = 39 * MiB, WS_WPOOL = 43 * MiB, WS_WGU = 44 * MiB, WS_WD = 65 * MiB, WS_MWGU = 76 * MiB, WS_MWD = 164 * MiB;
constexpr size_t WS_H = 208 * MiB;
constexpr size_t WS_ACT = 336 * MiB;
constexpr size_t WS_DOWN = WS_ACT;
constexpr size_t WS_CQN = WS_ACT + 128 * MiB, WS_CKVN = WS_ACT + 192 * MiB, WS_KR = WS_ACT + 224 * MiB, WS_Q = WS_ACT + 232 * MiB, WS_KNV = WS_ACT + 424 * MiB;
constexpr size_t WS_HID = WS_ACT;
constexpr size_t WS_YB = WS_ACT + 358 * MiB;
constexpr size_t WS_DUMMY = WS_ACT + 424 * MiB;
constexpr size_t WS_H8 = WS_ACT + 618 * MiB;
constexpr int FFD8 = 2816;
constexpr int FFE8 = 1536;
constexpr size_t WS_END = WS_ACT + 682 * MiB;
static_assert(WS_MWD + (size_t)16 * 1024 * FFEP * 2 <= WS_H && WS_MWGU + (size_t)16 * 2 * FFEP * 1024 * 2 <= WS_MWD && WS_WD + (size_t)2 * 1024 * FFD * 2 <= WS_MWGU && WS_WGU + (size_t)2 * 2 * FFD * 1024 * 2 <= WS_WD, "weights map");
static_assert(WS_HID + (size_t)PSLOT * FFEP * 2 <= WS_YB && WS_YB + (size_t)PSLOT * 1024 * 2 <= WS_END && WS_HID + (size_t)NTOK * FFD * 2 <= WS_END && WS_KNV + (size_t)NTOK * NKV * 2 <= WS_END && WS_Q + (size_t)NTOK * NQ * 2 <= WS_KNV, "activation map");
static_assert(WS_SSQ + (size_t)14 * NTOK * 8 <= WS_COS && WS_COS <= CTL_ZERO_BYTES + WS_COS && WS_END <= 1024 * MiB, "map");
constexpr int CW_TMO = 0, CW_CODE = 1, CW_CNT = 1024  , CW_DBG = 2048, CW_BAR = 4096  ;
constexpr int LDSCTL_OFF = 0, LDSCTL_BYTES = 1024, MISC_OFF = LDSCTL_OFF + 320, RING_OFF = LDSCTL_BYTES, RING_BYTES = 131072, LDS_BYTES = 147456;

typedef GAS unsigned gu32;
#define RLX_AGENT __ATOMIC_RELAXED, __HIP_MEMORY_SCOPE_AGENT
#define LDS_WAIT() asm volatile("s_waitcnt lgkmcnt(0)" ::: "memory")
#define VM_WAIT() asm volatile("s_waitcnt vmcnt(0)" ::: "memory")

#define XB_TMO      128
#define XB_XCNT(j)  (256  + 64 * (j))
#define XB_XSUB(j)  (1280 + 64 * (j))
#define XB_XGEN(j)  (2304 + 64 * (j))
#define XB_TOP      3328
#define XB_TOPGEN   3392
#define XCD_BAR_WORDS 3456
#define XB_SPIN_CAP (1u << 18)
__device__ __forceinline__ unsigned xb_ld(unsigned* p)              { return __hip_atomic_load(p, __ATOMIC_RELAXED, __HIP_MEMORY_SCOPE_AGENT); }
__device__ __forceinline__ unsigned xb_add(unsigned* p, unsigned v) { return __hip_atomic_fetch_add(p, v, __ATOMIC_RELAXED, __HIP_MEMORY_SCOPE_AGENT); }
__device__ __forceinline__ unsigned xb_xcc_id() { return (unsigned)__builtin_amdgcn_s_getreg((3 << 11) | 20) & 0xFu; }
#define XB_SPIN(cond, bar) do { unsigned _sp = 0; while (cond) { __builtin_amdgcn_s_sleep(1); \
    if ((++_sp & 255u) == 0u) { if (xb_ld(&(bar)[XB_TMO])) break; if (_sp > XB_SPIN_CAP) { atomicAdd(&(bar)[XB_TMO], 1u); break; } } } } while (0)
__device__ __forceinline__ unsigned rfl(unsigned v);
struct XcdBarrier { unsigned* bar; unsigned x; volatile LAS unsigned* st; };
__device__ __forceinline__ XcdBarrier xcd_barrier_post(unsigned* bar, volatile LAS unsigned* st) {
    XcdBarrier b; b.bar = bar; b.x = xb_xcc_id(); b.st = st;
    if (threadIdx.x == 0) (void)xb_add(&bar[XB_XCNT(b.x)], 1u);
    return b;
}
__device__ __forceinline__ void xcd_barrier_complete(unsigned* bar, unsigned x, unsigned& nloc, unsigned& nx) {
    const unsigned G = gridDim.x * gridDim.y * gridDim.z;
    unsigned sum, cnt, mine, sp = 0u;
    for (;;) {
        sum = 0u; cnt = 0u; mine = 0u;
#pragma unroll
        for (unsigned j = 0; j < 16; ++j) { const unsigned c = xb_ld(&bar[XB_XCNT(j)]); sum += c; cnt += (c > 0u) ? 1u : 0u; mine = (j == x) ? c : mine; }
        if (sum == G) break;
        __builtin_amdgcn_s_sleep(1);
        if ((++sp & 255u) == 0u) { if (xb_ld(&bar[XB_TMO])) break; if (sp > XB_SPIN_CAP) { atomicAdd(&bar[XB_TMO], 1u); break; } }
    }
    nloc = mine > 0u ? mine : 1u; nx = cnt > 0u ? cnt : 1u;
}
__device__ __forceinline__ void xcd_barrier(const XcdBarrier& b) {
    unsigned* bar; { const volatile LAS unsigned* p_ = b.st + 2; const unsigned lo_ = rfl(p_[0]), hi_ = rfl(p_[1]); bar = (unsigned*)(((unsigned long long)hi_ << 32) | lo_); }
    asm volatile("s_waitcnt vmcnt(0)" ::: "memory");
    __syncthreads();
    if (threadIdx.x == 0) {
        __builtin_amdgcn_s_waitcnt(0);
        unsigned nloc = b.st[0], nx = b.st[1];
        if (nloc == 0u) { xcd_barrier_complete(bar, b.x, nloc, nx); b.st[0] = nloc; b.st[1] = nx; }
        const unsigned old = xb_add(&bar[XB_XSUB(b.x)], 1u);
        const unsigned gen = old / nloc;
        if (old + 1u == (gen + 1u) * nloc) {
            __builtin_amdgcn_fence(__ATOMIC_RELEASE, "agent");
            asm volatile("s_waitcnt vmcnt(0)" ::: "memory");
            const unsigned og = xb_add(&bar[XB_TOP], 1u);
            const unsigned tg = og / nx;
            if (og + 1u == (tg + 1u) * nx) xb_add(&bar[XB_TOPGEN], 1u);
            else XB_SPIN(xb_ld(&bar[XB_TOPGEN]) == tg, bar);
            __builtin_amdgcn_fence(__ATOMIC_ACQUIRE, "agent");
            xb_add(&bar[XB_XGEN(b.x)], 1u);
            asm volatile("s_waitcnt vmcnt(0)" ::: "memory");
        } else {
            XB_SPIN(xb_ld(&bar[XB_XGEN(b.x)]) == gen, bar);
            __builtin_amdgcn_fence(__ATOMIC_ACQUIRE, "agent");
            asm volatile("s_waitcnt vmcnt(0)" ::: "memory");
        }
    }
    __syncthreads();
}

__device__ __forceinline__ unsigned rfl(unsigned v);
__device__ __forceinline__ const float* ptab(LAS unsigned char* L, int i);
struct Frame { LAS unsigned char* lds; volatile LAS unsigned* MISC; gu32* ctl; unsigned char* ws; int tid, lane, wave, vcu, G, bx; };

__device__ __forceinline__ float wave_sum(float v) {
#pragma unroll
    for (int o = 1; o < 64; o <<= 1) v += __shfl_xor(v, o);
    return v;
}
__device__ __forceinline__ unsigned rfl(unsigned v) { return (unsigned)__builtin_amdgcn_readfirstlane((int)v); }

__device__ __forceinline__ int rowmap(int mode, int n) {
    if (mode == 0) return n;
    if (mode == 1) return (n >> 7) * 256 + (n & 127);
    if (mode == 2) return (n >> 7) * 256 + 128 + (n & 127);
    if (mode == 4) return n < 800 ? n : 896 + (n - 800);
    const int h = n / DQH, d = n - h * DQH;
    if (d < DNOPE) return 512 + h * DNOPE + d;
    if (d < DNOPE + 32) return (h >> 2) * 256 + (h & 3) * 32 + (d - DNOPE);
    return (h >> 2) * 256 + 128 + (h & 3) * 32 + (d - DNOPE - 32);
}
__device__ __forceinline__ void transpose_item(const float* W, int N, bf16_t* WT, int ldd, int mode, const float* kscale, const float* nscale, int item, int lane) {
    const int nblk = N / 64, kb = item / nblk, nb = item % nblk, k0 = 64 * kb, n = 64 * nb + lane;
    const float sn = nscale ? nscale[n] : 1.0f;
    const int ksv = __float_as_int(kscale ? kscale[k0 + lane] : 1.0f);
    const float* wp = W + (size_t)k0 * N + n;
    bf16_t* op = WT + (size_t)rowmap(mode, n) * ldd + k0;
    float w[64];
#pragma unroll
    for (int i = 0; i < 64; ++i) w[i] = __builtin_nontemporal_load(wp + (size_t)i * N);
#pragma unroll
    for (int kg = 0; kg < 8; ++kg) { float v[8];
#pragma unroll
        for (int i = 0; i < 8; ++i) { const float sk = __int_as_float(__builtin_amdgcn_readlane(ksv, 8 * kg + i)); v[i] = w[8 * kg + i] * (sk * sn); }
        u32x4 o; o.x = cvt_pk_bf16(v[0], v[1]); o.y = cvt_pk_bf16(v[2], v[3]); o.z = cvt_pk_bf16(v[4], v[5]); o.w = cvt_pk_bf16(v[6], v[7]);
        *(GAS u32x4*)(op + 8 * kg) = o; }
}
__device__ __forceinline__ void transpose_item_f8(const float* W, int N, unsigned char* WT, int ldd, int mode, const float* kscale, int item, int lane) {
    const int nblk = N / 64, kb = item / nblk, nb = item % nblk, k0 = 64 * kb, n = 64 * nb + lane;
    const int ksv = __float_as_int(kscale ? kscale[k0 + lane] : 1.0f);
    const float* wp = W + (size_t)k0 * N + n;
    unsigned char* op = WT + (size_t)rowmap(mode, n) * ldd + k0;
    float w[64];
#pragma unroll
    for (int i = 0; i < 64; ++i) w[i] = __builtin_nontemporal_load(wp + (size_t)i * N);
#pragma unroll
    for (int kg = 0; kg < 4; ++kg) { float v[16];
#pragma unroll
        for (int i = 0; i < 16; ++i) { const float sk = __int_as_float(__builtin_amdgcn_readlane(ksv, 16 * kg + i)); v[i] = w[16 * kg + i] * (sk * pg8::FP8_SW); }
        u32x4 o; o.x = pg8::pk4_fp8(v[0], v[1], v[2], v[3]); o.y = pg8::pk4_fp8(v[4], v[5], v[6], v[7]); o.z = pg8::pk4_fp8(v[8], v[9], v[10], v[11]); o.w = pg8::pk4_fp8(v[12], v[13], v[14], v[15]);
        *(GAS u32x4*)(op + 16 * kg) = o; }
}
struct MatDesc { const float* src; bf16_t* dst; const float* kscale; const float* nscale; int K, N, ldd, mode, f8; };
constexpr int N_MATS = 70;
__device__ __forceinline__ MatDesc mat_desc(int m, LAS unsigned char* L, unsigned char* ws) {
    MatDesc d; d.kscale = nullptr; d.nscale = nullptr; d.mode = 0; d.f8 = 0;
    if (m < 2)       { const int a = m;      d.src = ptab(L, 4) + (size_t)a * DM * NDOWN;    d.K = DM;   d.N = NDOWN; d.dst = (bf16_t*)(ws + WS_WDN) + (size_t)a * NDOWNP * DM;  d.ldd = DM; d.mode = 4; d.kscale = ptab(L, 2) + (size_t)(2 * a) * DM; }
    else if (m < 4)  { const int a = m - 2;  d.src = ptab(L, 6) + (size_t)a * QLR * NQ;      d.K = QLR;  d.N = NQ;    d.dst = (bf16_t*)(ws + WS_WUQ) + (size_t)a * NQ * QLR;     d.ldd = QLR; d.mode = 3; d.kscale = ptab(L, 5) + (size_t)a * QLR; }
    else if (m < 6)  { const int a = m - 4;  d.src = ptab(L, 8) + (size_t)a * KVLR * NKV;    d.K = KVLR; d.N = NKV;   d.dst = (bf16_t*)(ws + WS_WUKV) + (size_t)a * NKV * KVLR;  d.ldd = KVLR; d.kscale = ptab(L, 7) + (size_t)a * KVLR; }
    else if (m < 8)  { const int a = m - 6;  d.src = ptab(L, 9) + (size_t)a * DM * DM;       d.K = DM;   d.N = DM;    d.dst = (bf16_t*)(ws + WS_WO) + (size_t)a * DM * DM;       d.ldd = DM; }
    else if (m < 16) { const int i = m - 8;  d.src = ptab(L, 10) + (size_t)i * 256 * 256;    d.K = 256;  d.N = 256;   d.dst = (bf16_t*)(ws + WS_WPOOL) + (size_t)i * 256 * 256;  d.ldd = 256; d.nscale = ptab(L, 11) + i * 256; }
    else if (m < 18) { const int a = m - 16; d.src = ptab(L, 12) + (size_t)a * DM * FFD;     d.K = DM;   d.N = FFD;   d.dst = (bf16_t*)(ws + WS_WGU) + (size_t)a * 2 * FFD * DM; d.ldd = DM; d.mode = 1; d.kscale = ptab(L, 3) + (size_t)(2 * a) * DM; }
    else if (m < 20) { const int a = m - 18; d.src = ptab(L, 13) + (size_t)a * DM * FFD;     d.K = DM;   d.N = FFD;   d.dst = (bf16_t*)(ws + WS_WGU) + (size_t)a * 2 * FFD * DM; d.ldd = DM; d.mode = 2; d.kscale = ptab(L, 3) + (size_t)(2 * a) * DM; }
    else if (m < 22) { const int a = m - 20; d.src = ptab(L, 14) + (size_t)a * FFD * DM;     d.K = FFD;  d.N = DM;    d.dst = (bf16_t*)(ws + WS_WD) + (size_t)a * DM * FFD;      d.ldd = FFD; }
    else if (m < 38) { const int i = m - 22; d.src = ptab(L, 16) + (size_t)i * DM * FFE;     d.K = DM;   d.N = FFE;   d.dst = (bf16_t*)(ws + WS_MWGU) + (size_t)i * 2 * FFEP * DM; d.ldd = DM; d.mode = 1; d.kscale = ptab(L, 3) + (size_t)(2 * (i >> 3) + 1) * DM; }
    else if (m < 54) { const int i = m - 38; d.src = ptab(L, 17) + (size_t)i * DM * FFE;     d.K = DM;   d.N = FFE;   d.dst = (bf16_t*)(ws + WS_MWGU) + (size_t)i * 2 * FFEP * DM; d.ldd = DM; d.mode = 2; d.kscale = ptab(L, 3) + (size_t)(2 * (i >> 3) + 1) * DM; }
    else             { const int i = m - 54; d.src = ptab(L, 18) + (size_t)i * FFE * DM;     d.K = FFE;  d.N = DM;    d.dst = (bf16_t*)(ws + WS_MWD) + (size_t)i * DM * FFEP;    d.ldd = FFEP; }
    if (m == 17 || m == 19) { d.f8 = 1; d.dst = (bf16_t*)(ws + WS_WGU + (size_t)2 * FFD * DM * 2); d.ldd = DM; }
    if (m == 21) { d.f8 = 1; d.dst = (bf16_t*)(ws + WS_WD + (size_t)DM * FFD * 2); d.ldd = FFD8; }
    if (m >= 22) {
        const int e = (m - 22) & 7, lpi = ((m - 22) & 15) >> 3; d.f8 = 1;
        if (m < 54) { d.dst = (bf16_t*)(ws + WS_MWGU + (size_t)lpi * 8 * 2 * FFEP * DM * 2 + (size_t)e * 2 * FFEP * DM); d.ldd = DM; }
        else        { d.dst = (bf16_t*)(ws + WS_MWD + (size_t)lpi * 8 * DM * FFEP * 2 + (size_t)e * DM * FFE8); d.ldd = FFE8; } }
    return d;
}
__device__ __forceinline__ void p0_prologue(Frame& F) {
    const int* positions = (const int*)ptab(F.lds, 1);
    const int gw = F.vcu * NWAVES + F.wave, NGW = F.G * NWAVES;
    int cum = 0;
    for (int m = 0; m < N_MATS; ++m) {
        const MatDesc d = mat_desc(m, F.lds, F.ws);
        const int nitems = (d.K / 64) * (d.N / 64);
        int first = gw - (cum % NGW); if (first < 0) first += NGW;
        if (d.f8) { for (int it = first; it < nitems; it += NGW) transpose_item_f8(d.src, d.N, (unsigned char*)d.dst, d.ldd, d.mode, d.kscale, it, F.lane); }
        else { for (int it = first; it < nitems; it += NGW) transpose_item(d.src, d.N, d.dst, d.ldd, d.mode, d.kscale, d.nscale, it, F.lane); }
        cum += nitems;
    }
    const int gt = gw * 64 + F.lane, NGT = NGW * 64; const u32x4 z4 = (u32x4){0u, 0u, 0u, 0u};
    for (int i = gt; i < 2 * 192 * 128; i += NGT) { const int a = i / (192 * 128), r = (i / 128) % 192, c = i % 128; const int row = r < 96 ? 800 + r : 928 + (r - 96); *(GAS u32x4*)((bf16_t*)(F.ws + WS_WDN) + (size_t)a * NDOWNP * DM + (size_t)row * DM + c * 8) = z4; }
    for (int i = gt; i < 1024 * 8; i += NGT) { const int row = i / 8, c = i % 8; *(GAS u32x4*)(F.ws + WS_WD + (size_t)DM * FFD * 2 + (size_t)row * FFD8 + FFD + c * 16) = z4; }
    for (int i = gt; i < 16 * 128 * 64; i += NGT) { const int lpi = i / (8 * 128 * 64), e = (i / (128 * 64)) & 7, r = (i / 64) % 128, c = i % 64; const int row = 2560 + (r < 64 ? 64 + r : 192 + (r - 64));
        *(GAS u32x4*)(F.ws + WS_MWGU + (size_t)lpi * 8 * 2 * FFEP * DM * 2 + (size_t)e * 2 * FFEP * DM + (size_t)row * DM + c * 16) = z4; }
    for (int i = gt; i < 16 * 1024 * 12; i += NGT) { const int lpi = i / (8 * 1024 * 12), row = (i / 12) % (8 * 1024), c = i % 12; *(GAS u32x4*)(F.ws + WS_MWD + (size_t)lpi * 8 * DM * FFEP * 2 + (size_t)row * FFE8 + FFE + c * 16) = z4; }
    float* cosT = (float*)(F.ws + WS_COS); float* sinT = (float*)(F.ws + WS_SIN);
    { const float inv = powf(10000.0f, -(float)(2 * (gt & 31)) / 64.0f);
      for (int i = gt; i < NTOK * 32; i += NGT) { const float ang = (float)positions[i >> 5] * inv; float sn, cs; sincosf(ang, &sn, &cs); cosT[i] = cs; sinT[i] = sn; } }
    const float* x = ptab(F.lds, 0); bf16_t* H = (bf16_t*)(F.ws + WS_H); ssq_t* ssq0 = (ssq_t*)(F.ws + WS_SSQ);
    for (int m0 = gw * 4; m0 < NTOK; m0 += NGW * 4) {
        f32x4 v[4][4];
#pragma unroll
        for (int r = 0; r < 4; ++r) { const GAS f32x4* xr = (const GAS f32x4*)(x + (size_t)(m0 + r) * DM) + F.lane;
#pragma unroll
            for (int j = 0; j < 4; ++j) v[r][j] = xr[64 * j]; }
#pragma unroll
        for (int r = 0; r < 4; ++r) { GAS u32x2* o8 = (GAS u32x2*)(H + (size_t)(m0 + r) * DM) + F.lane; float s = 0.f;
#pragma unroll
            for (int j = 0; j < 4; ++j) { const f32x4 t = v[r][j]; s += (t.x * t.x + t.y * t.y) + (t.z * t.z + t.w * t.w); u32x2 w; w.x = cvt_pk_bf16(t.x, t.y); w.y = cvt_pk_bf16(t.z, t.w); o8[64 * j] = w; }
            s = wave_sum(s); if (F.lane == 0) ssq0[m0 + r] = ssq_fix(s); }
    }
}

template <bool FINAL>
__device__ __forceinline__ void combine_phase(Frame& F, const bf16_t* H, bf16_t* Hout, const bf16_t* YB, const unsigned* tokinfo, const unsigned* cntw, ssq_t* ssq_next, const float* gain, float* outF) {
    const int gw = F.vcu * NWAVES + F.wave, NGW = F.G * NWAVES;
    f32x4 g[4];
    if constexpr (FINAL) {
#pragma unroll
        for (int j = 0; j < 4; ++j) g[j] = *(const f32x4*)(gain + F.lane * 4 + 256 * j);
    }
    unsigned nb[8];
#pragma unroll
    for (int e = 0; e < 8; ++e) nb[e] = (rfl(__hip_atomic_load((unsigned*)cntw + 64 * e, RLX_AGENT)) + 255u) >> 8;
    for (int m0 = gw * 2; m0 < NTOK; m0 += NGW * 2) {
        u32x4 t0[2], t1[2];
#pragma unroll
        for (int r = 0; r < 2; ++r) { t0[r] = *(const u32x4*)(tokinfo + (size_t)(m0 + r) * 8); t1[r] = *(const u32x4*)(tokinfo + (size_t)(m0 + r) * 8 + 4); }
        u32x2 hh[2][4], ya[2][4], yb[2][4]; float g0[2], g1[2];
#pragma unroll
        for (int r = 0; r < 2; ++r) {
            const unsigned e0 = rfl(t0[r].x), r0 = rfl(t0[r].y), e1 = rfl(t1[r].x), r1 = rfl(t1[r].y); g0[r] = __uint_as_float(rfl(t0[r].z)); g1[r] = __uint_as_float(rfl(t1[r].z));
            unsigned b0 = 0u, b1 = 0u;
#pragma unroll
            for (int e = 0; e < 8; ++e) { b0 += ((unsigned)e < e0) ? nb[e] : 0u; b1 += ((unsigned)e < e1) ? nb[e] : 0u; }
            const GAS u32x2* hr = (const GAS u32x2*)(H + (size_t)(m0 + r) * DM) + F.lane;
            const GAS u32x2* y0 = (const GAS u32x2*)(YB + ((size_t)b0 * 256 + r0) * DM) + F.lane; const GAS u32x2* y1 = (const GAS u32x2*)(YB + ((size_t)b1 * 256 + r1) * DM) + F.lane;
#pragma unroll
            for (int j = 0; j < 4; ++j) { hh[r][j] = hr[64 * j]; ya[r][j] = y0[64 * j]; yb[r][j] = y1[64 * j]; }
        }
#pragma unroll
        for (int r = 0; r < 2; ++r) { const int m = m0 + r;
            f32x4 v[4]; float s = 0.f;
#pragma unroll
            for (int j = 0; j < 4; ++j) { const u32x2 h2 = hh[r][j], a = ya[r][j], b = yb[r][j];
                v[j].x = bflo(h2.x) + g0[r] * bflo(a.x) + g1[r] * bflo(b.x); v[j].y = bfhi(h2.x) + g0[r] * bfhi(a.x) + g1[r] * bfhi(b.x); v[j].z = bflo(h2.y) + g0[r] * bflo(a.y) + g1[r] * bflo(b.y); v[j].w = bfhi(h2.y) + g0[r] * bfhi(a.y) + g1[r] * bfhi(b.y);
                s += (v[j].x * v[j].x + v[j].y * v[j].y) + (v[j].z * v[j].z + v[j].w * v[j].w); }
            s = wave_sum(s);
            if constexpr (FINAL) { const float rstd = rstd_f(s); GAS f32x4* ho = (GAS f32x4*)(outF + (size_t)m * DM) + F.lane;
#pragma unroll
                for (int j = 0; j < 4; ++j) ho[64 * j] = v[j] * rstd * g[j];
            } else { GAS u32x2* hw = (GAS u32x2*)(Hout + (size_t)m * DM) + F.lane;
#pragma unroll
                for (int j = 0; j < 4; ++j) { u32x2 w; w.x = cvt_pk_bf16(v[j].x, v[j].y); w.y = cvt_pk_bf16(v[j].z, v[j].w); hw[64 * j] = w; }
                if (F.lane == 0) ssq_next[m] = ssq_fix(s); }
        }
    }
}
__device__ __forceinline__ void mid_phase(Frame& F, const bf16_t* DOWN, const float* qn, const float* kvn, const float* cosT, const float* sinT, bf16_t* CQN, bf16_t* CKVN, bf16_t* KR) {
    const int gw = F.vcu * NWAVES + F.wave, NGW = F.G * NWAVES, lane = F.lane;
    const f32x4 q0 = *(const f32x4*)(qn + lane * 8), q1 = *(const f32x4*)(qn + lane * 8 + 4), k0 = *(const f32x4*)(kvn + lane * 4);
    for (int m = gw; m < NTOK; m += NGW) {
        const bf16_t* dr = DOWN + (size_t)m * NDOWNP;
        const u32x4 cq = *(const GAS u32x4*)(dr + lane * 8); const u32x2 ck = *(const GAS u32x2*)(dr + QLR + lane * 4);
        const float x1 = bf2f(dr[QLR + KVLR + (lane & 31)]), x2 = bf2f(dr[QLR + KVLR + 32 + (lane & 31)]);
        const f32x4 a0 = (f32x4){bflo(cq.x), bfhi(cq.x), bflo(cq.y), bfhi(cq.y)}, a1 = (f32x4){bflo(cq.z), bfhi(cq.z), bflo(cq.w), bfhi(cq.w)}, c0 = (f32x4){bflo(ck.x), bfhi(ck.x), bflo(ck.y), bfhi(ck.y)};
        const float sq = wave_sum((a0.x * a0.x + a0.y * a0.y) + (a0.z * a0.z + a0.w * a0.w) + (a1.x * a1.x + a1.y * a1.y) + (a1.z * a1.z + a1.w * a1.w));
        const float sk = wave_sum((c0.x * c0.x + c0.y * c0.y) + (c0.z * c0.z + c0.w * c0.w));
        const float rq = 1.0f / sqrtf(sq * (1.0f / QLR) + RMS_EPS), rk = 1.0f / sqrtf(sk * (1.0f / KVLR) + RMS_EPS);
        const f32x4 y0 = a0 * rq * q0, y1 = a1 * rq * q1, z0 = c0 * rk * k0;
        u32x4 w; w.x = cvt_pk_bf16(y0.x, y0.y); w.y = cvt_pk_bf16(y0.z, y0.w); w.z = cvt_pk_bf16(y1.x, y1.y); w.w = cvt_pk_bf16(y1.z, y1.w);
        *(GAS u32x4*)(CQN + (size_t)m * QLR + lane * 8) = w;
        u32x2 w2; w2.x = cvt_pk_bf16(z0.x, z0.y); w2.y = cvt_pk_bf16(z0.z, z0.w);
        *(GAS u32x2*)(CKVN + (size_t)m * KVLR + lane * 4) = w2;
        const float c = cosT[(size_t)m * 32 + (lane & 31)], s = sinT[(size_t)m * 32 + (lane & 31)];
        const float o = lane < 32 ? x1 * c - x2 * s : x2 * c + x1 * s;
        KR[(size_t)m * DROPE + lane] = (bf16_t)(cvt_pk_bf16(o, o) & 0xffffu);
    }
}
template <int W>
__device__ __forceinline__ void pool_walk(const bf16_t* h, const ssq_t* ssq, const f32x2 g2, bf16_t* Z, size_t rowbase, int t_start, int c0, int nrows, int col) {
    f32x2 ring[W]; f32x2 sum = (f32x2){0.f, 0.f};
#pragma unroll
    for (int j = 0; j < W; ++j) ring[j] = (f32x2){0.f, 0.f};
    unsigned xa[16], xb[16]; ssq_t qa[16], qb[16];
#define PW_LOAD(X, Q, r_) do { _Pragma("unroll") for (int j = 0; j < 16; ++j) { const size_t row = rowbase + t_start + (r_) + j; X[j] = *(const GAS unsigned*)(h + row * DM + col); Q[j] = ssq[row]; } } while (0)
#define PW_PROC(X, Q, r_) do { _Pragma("unroll") for (int j = 0; j < 16; ++j) { const int t = t_start + (r_) + j; const size_t row = rowbase + t; \
            const f32x2 v = (f32x2){bflo(X[j]), bfhi(X[j])} * rstd_of(Q[j]) * g2; \
            sum = sum + (v - ring[j % W]); ring[j % W] = v; \
            if (t >= c0) { const float inv = 1.0f / (float)(t + 1 < W ? t + 1 : W); const f32x2 z = sum * inv - v; *(GAS unsigned*)(Z + row * DM + col) = cvt_pk_bf16(z.x, z.y); } } } while (0)
    PW_LOAD(xa, qa, 0);
    for (int r = 0; r < nrows; r += 32) {
        if (r + 16 < nrows) PW_LOAD(xb, qb, r + 16);
        PW_PROC(xa, qa, r);
        if (r + 32 < nrows) PW_LOAD(xa, qa, r + 32);
        if (r + 16 < nrows) PW_PROC(xb, qb, r + 16);
    }
#undef PW_LOAD
#undef PW_PROC
}
__device__ __forceinline__ void pool_phase(Frame& F, const bf16_t* h, const ssq_t* ssq, const float* gain, bf16_t* Z) {
    const int col = F.tid * 2; const f32x2 g2 = *(const f32x2*)(gain + col);
    for (int chunk = F.vcu; chunk < NBATCH * 16; chunk += F.G) {
        const int b = chunk >> 4, c0 = (chunk & 15) * 128, t_start = c0 ? c0 - 16 : 0, nrows = c0 + 128 - t_start; const size_t rowbase = (size_t)b * SEQ;
        const int grp = F.wave >> 1;
        if (grp == 0) pool_walk<2>(h, ssq, g2, Z, rowbase, t_start, c0, nrows, col);
        else if (grp == 1) pool_walk<4>(h, ssq, g2, Z, rowbase, t_start, c0, nrows, col);
        else if (grp == 2) pool_walk<8>(h, ssq, g2, Z, rowbase, t_start, c0, nrows, col);
        else pool_walk<16>(h, ssq, g2, Z, rowbase, t_start, c0, nrows, col);
    }
}
template <bool WRITE_H8>
__device__ __forceinline__ void router_phase(Frame& F, const bf16_t* h, const ssq_t* ssq, const float* gain, const float* router, int* list, float* rsl, unsigned* tokinfo, unsigned* cntw, unsigned char* H8) {
    LAS float* rt = (LAS float*)(F.lds + RING_OFF);
    LAS int* esel = (LAS int*)(F.lds + RING_OFF + 32768);
    LAS int* wt = (LAS int*)(F.lds + RING_OFF + 32768 + 2048);
    LAS int* base = (LAS int*)(F.lds + RING_OFF + 32768 + 2048 + 256);
    LAS float* rsd = (LAS float*)(F.lds + RING_OFF + 32768 + 2048 + 512);
    const int lane = F.lane;
    for (int idx = F.tid; idx < DM * NEXP; idx += NWAVES * 64) rt[(idx & 7) * DM + (idx >> 3)] = router[idx];
    f32x4 g[4];
#pragma unroll
    for (int j = 0; j < 4; ++j) g[j] = *(const f32x4*)(gain + lane * 4 + 256 * j);
    for (int chunk = F.vcu; chunk < NTOK / 256; chunk += F.G) {
        const int T0 = chunk * 256;
        __syncthreads();
        u32x2 nx[4][4]; ssq_t nq[4];
#pragma unroll
        for (int p = 0; p < 4; ++p) { const GAS u32x2* xr = (const GAS u32x2*)(h + (size_t)(T0 + F.wave * 32 + p) * DM) + lane;
#pragma unroll
          for (int j = 0; j < 4; ++j) nx[p][j] = xr[64 * j];
          nq[p] = ssq[T0 + F.wave * 32 + p]; }
        for (int i4 = 0; i4 < 32; i4 += 4) {
            const int tl0 = F.wave * 32 + i4, m0 = T0 + tl0;
            f32x4 v[4][4]; float rstd[4];
#pragma unroll
            for (int p = 0; p < 4; ++p) { rstd[p] = rstd_of(nq[p]);
#pragma unroll
                for (int j = 0; j < 4; ++j) { const u32x2 w = nx[p][j]; f32x4 xn = (f32x4){bflo(w.x), bfhi(w.x), bflo(w.y), bfhi(w.y)} * rstd[p];
                    if constexpr (WRITE_H8) { const f32x4 q = xn * pg8::FP8_SA; *(GAS unsigned*)(H8 + (size_t)(m0 + p) * DM + lane * 4 + 256 * j) = pg8::pk4_fp8(q.x, q.y, q.z, q.w); }
                    v[p][j] = xn * g[j]; } }
            if (i4 + 4 < 32) {
#pragma unroll
                for (int p = 0; p < 4; ++p) { const GAS u32x2* xr = (const GAS u32x2*)(h + (size_t)(m0 + 4 + p) * DM) + lane;
#pragma unroll
                    for (int j = 0; j < 4; ++j) nx[p][j] = xr[64 * j];
                    nq[p] = ssq[m0 + 4 + p]; } }
            float a[32];
#pragma unroll
            for (int e = 0; e < 8; ++e) {
#pragma unroll
                for (int p = 0; p < 4; ++p) a[8 * p + e] = 0.f;
#pragma unroll
                for (int j = 0; j < 4; ++j) { const f32x4 r4 = *(const LAS f32x4*)(rt + e * DM + lane * 4 + 256 * j);
#pragma unroll
                    for (int p = 0; p < 4; ++p) a[8 * p + e] += (v[p][j].x * r4.x + v[p][j].y * r4.y) + (v[p][j].z * r4.z + v[p][j].w * r4.w); } }
#define RSTEP(N, LM) _Pragma("unroll") for (int k = 0; k < (N); ++k) { const bool up = (lane & (LM)) != 0; const float send = up ? a[k] : a[k + (N)], keep = up ? a[k + (N)] : a[k]; a[k] = keep + __shfl_xor(send, (LM)); }
            RSTEP(16, 32) RSTEP(8, 16) RSTEP(4, 8) RSTEP(2, 4) RSTEP(1, 2)
#undef RSTEP
            const float tot = a[0] + __shfl_xor(a[0], 1);
#pragma unroll
            for (int p = 0; p < 4; ++p) {
                float lg[8];
#pragma unroll
                for (int e = 0; e < 8; ++e) lg[e] = __int_as_float(__builtin_amdgcn_readlane(__float_as_int(tot), 2 * (8 * p + e)));
                int e0 = 0; float l0 = lg[0];
#pragma unroll
                for (int e = 1; e < 8; ++e) if (lg[e] > l0) { l0 = lg[e]; e0 = e; }
                int e1 = e0 == 0 ? 1 : 0; float l1 = lg[e0 == 0 ? 1 : 0];
#pragma unroll
                for (int e = 0; e < 8; ++e) if (e != e0 && lg[e] > l1) { l1 = lg[e]; e1 = e; }
                const float g0 = 1.0f / (1.0f + __expf(l1 - l0)), g1 = 1.0f - g0;
                if (lane == 0) { const int tl = tl0 + p; esel[2 * tl] = e0; esel[2 * tl + 1] = e1; rsd[tl] = rstd[p]; unsigned* ti = tokinfo + (size_t)(m0 + p) * 8;
                    ti[0] = (unsigned)e0; ti[2] = __float_as_uint(g0); ti[4] = (unsigned)e1; ti[6] = __float_as_uint(g1); }
            }
        }
        __syncthreads();
        const int me = esel[F.tid]; int myrank = 0;
#pragma unroll
        for (int e = 0; e < 8; ++e) { const unsigned long long mask = __ballot(me == e); if (me == e) myrank = __popcll(mask & ((1ull << lane) - 1ull)); if (lane == 0) wt[F.wave * 8 + e] = __popcll(mask); }
        __syncthreads();
        int off = 0;
        for (int w = 0; w < F.wave; ++w) off += wt[w * 8 + me];
        if (F.tid < 8) { int tot = 0; for (int w = 0; w < 8; ++w) tot += wt[w * 8 + F.tid]; base[F.tid] = (int)__hip_atomic_fetch_add(cntw + 64 * F.tid, (unsigned)tot, RLX_AGENT); }
        __syncthreads();
        const int rank = base[me] + off + myrank, tok = T0 + (F.tid >> 1);
        list[(size_t)me * NTOK + rank] = tok; rsl[(size_t)me * NTOK + rank] = rsd[F.tid >> 1];
        tokinfo[(size_t)tok * 8 + (F.tid & 1) * 4 + 1] = (unsigned)rank;
    }
}
template <bool GATHER, bool FP8 = false>
struct MoeOrder {
    static constexpr size_t A_BLK = GATHER ? 0 : (FP8 ? (size_t)256 * FFE8 : (size_t)256 * FFEP * 2), B_EXP = GATHER ? (FP8 ? (size_t)2 * FFEP * DM : (size_t)2 * FFEP * DM * 2) : (FP8 ? (size_t)DM * FFE8 : (size_t)DM * FFEP * 2),
                            B_TILE = GATHER ? (FP8 ? (size_t)256 * DM : (size_t)256 * DM * 2) : (FP8 ? (size_t)256 * FFE8 : (size_t)256 * FFEP * 2);
    static constexpr int NT = GATHER ? 2 * FFEP / 256 : DM / 256;
    const char* A; const char* B; const int* list; const unsigned* cntw; int G, c, rev; unsigned bs[9];
    __device__ __forceinline__ void init(const unsigned* cntw_, const void* A_, const void* B_, const int* list_, int G_, int c_) {
        A = (const char*)A_; B = (const char*)B_; list = list_; cntw = cntw_; G = G_; c = c_; rev = 0; bs[0] = 0u;
#pragma unroll
        for (int e = 0; e < 8; ++e) { const unsigned ce = rfl(__hip_atomic_load((unsigned*)cntw + 64 * e, RLX_AGENT)); bs[e + 1] = bs[e] + ((ce + 255u) >> 8); }
    }
    __device__ __forceinline__ bool next(int i, pg8::Unit& u) const {
        unsigned blk; int pn;
        if ((G & 7) == 0) {
            const int x = c & 7, cl = c >> 3, q = (int)bs[8] >> 3, r = (int)bs[8] & 7, nbx = q + (x < r ? 1 : 0), b0 = x * q + (x < r ? x : r);
            int U = i * (G >> 3) + cl; const int nwx = nbx * NT; if (U >= nwx) return false;
            if (rev) U = nwx - 1 - U;
            const int nig = pg8::WGM * NT, gid = U / nig, fm = gid * pg8::WGM, gsz = (nbx - fm) < pg8::WGM ? (nbx - fm) : pg8::WGM;
            blk = (unsigned)(b0 + fm + (U % nig) % gsz); pn = (U % nig) / gsz;
        } else {
            long L = (long)i * G + c; if (L >= (long)bs[8] * NT) return false;
            if (rev) L = (long)bs[8] * NT - 1 - L;
            blk = (unsigned)(L / NT); pn = (int)(L % NT);
        }
        unsigned e = 0u, st = 0u;
#pragma unroll
        for (int k = 1; k < 8; ++k) if (blk >= bs[k]) { e = (unsigned)k; st = bs[k]; }
        const unsigned j = blk - st;
        u.b = B + (size_t)e * B_EXP + (size_t)pn * B_TILE; u.orow = (int)(blk * 256u); u.pn = pn; u.aux = (int)e;
        if constexpr (GATHER) { const unsigned ce = rfl(__hip_atomic_load((unsigned*)cntw + 64 * e, RLX_AGENT));
            u.a = A; u.rows = list + (size_t)e * NTOK + (size_t)j * 256; const unsigned rem = ce - j * 256u; u.nrows = rem < 256u ? (int)rem : 256; }
        else { u.a = A + (size_t)blk * A_BLK; u.rows = nullptr; u.nrows = 256; }
        return true;
    }
};
constexpr int NPHASE = 27;
struct Args { const float* in[20]; float* out; unsigned char* ws; int ph_lo, ph_hi, li, pad; };
#ifndef MK_REP_MASK
#define MK_REP_MASK 0
#endif
#ifndef MK_REP_N
#define MK_REP_N 1
#endif
#ifndef MK_REV
#define MK_REV 1
#endif
#ifndef MK_STAG_BF
#define MK_STAG_BF 0u
#define MK_STAG_F8 0u
#endif
constexpr int PT_OFF = LDSCTL_OFF + 512;
__device__ __forceinline__ unsigned long long ptab_u64(LAS unsigned char* L, int i) {
    const volatile LAS unsigned* p = (const volatile LAS unsigned*)(L + PT_OFF + 8 * i); const unsigned lo = rfl(p[0]), hi = rfl(p[1]); return ((unsigned long long)hi << 32) | lo; }
__device__ __forceinline__ const float* ptab(LAS unsigned char* L, int i) { return (const float*)(GAS const float*)ptab_u64(L, i); }
__device__ __forceinline__ Frame make_frame(LAS unsigned char* L) {
    asm volatile("" : "+s"(L));
    Frame F; F.lds = L; F.MISC = (volatile LAS unsigned*)(L + MISC_OFF); F.tid = launder_v((int)threadIdx.x); F.lane = F.tid & 63; F.wave = __builtin_amdgcn_readfirstlane(F.tid >> 6);
    { int g_ = gridDim.x, bx = blockIdx.x; asm volatile("" : "+s"(g_), "+s"(bx)); F.G = g_; F.bx = bx;
      F.vcu = (F.G % 8 == 0) ? (bx % 8) * (F.G / 8) + bx / 8 : bx; }
    F.ws = (unsigned char*)(GAS unsigned char*)ptab_u64(L, 21); F.ctl = (gu32*)(F.ws + WS_CTL); return F;
}
__global__ void __launch_bounds__(NWAVES * 64, 2) fwd(Args args) {
    extern __shared__ __attribute__((aligned(16))) unsigned char lds[];
    LAS unsigned char* L = (LAS unsigned char*)lds;
    { const int tid = threadIdx.x;
      for (int u = tid; u < LDSCTL_BYTES / 4; u += NWAVES * 64) ((LAS unsigned*)(L + LDSCTL_OFF))[u] = 0u;
      __syncthreads();
      if (tid < 20) *(LAS unsigned long long*)(L + PT_OFF + 8 * tid) = (unsigned long long)args.in[tid];
      if (tid == 20) *(LAS unsigned long long*)(L + PT_OFF + 8 * 20) = (unsigned long long)args.out;
      if (tid == 21) *(LAS unsigned long long*)(L + PT_OFF + 8 * 21) = (unsigned long long)args.ws;
      if (tid == 22) *(LAS unsigned long long*)(L + PT_OFF + 8 * 22) = (unsigned long long)args.pad;
      __syncthreads(); }
    const int lo = args.ph_lo, hi = args.ph_hi;
    XcdBarrier bar; { gu32* ctl = (gu32*)(args.ws + WS_CTL); bar.bar = (unsigned*)(ctl + CW_BAR) + args.li * XCD_BAR_WORDS; bar.x = 0; bar.st = nullptr;
      if (threadIdx.x == 0) { const unsigned long long ba = (unsigned long long)((unsigned*)(ctl + CW_BAR) + args.li * XCD_BAR_WORDS); ((volatile LAS unsigned*)(L + MISC_OFF))[10] = (unsigned)ba; ((volatile LAS unsigned*)(L + MISC_OFF))[11] = (unsigned)(ba >> 32); }
      if (hi - lo > 1) bar = xcd_barrier_post((unsigned*)(ctl + CW_BAR) + args.li * XCD_BAR_WORDS, (volatile LAS unsigned*)(L + MISC_OFF) + 8);
      __syncthreads(); }
#ifndef MK_ONLY
#define MK_ONLY (-1)
#endif
#define KIND(k) ((k) == 0 ? 0 : 1 + ((k) - 1) % 13)
#ifndef MK_SKIPMASK
#define MK_SKIPMASK 0
#endif
#define IN(k) ((MK_ONLY < 0 || KIND(k) == MK_ONLY) && !((MK_SKIPMASK >> KIND(k)) & 1) && lo <= (k) && (k) < hi)
#define FORREP(k)
#if MK_REP_MASK
#define LASTREP (ptab_u64(F.lds, 22) == 0ull)
#else
#define LASTREP true
#endif
#ifdef MK_DOUBLE_BAR
#define SEAM(k) do { if ((k) + 1 < hi) { xcd_barrier(bar); xcd_barrier(bar); } } while (0)
#else
#define SEAM(k) do { if ((k) + 1 < hi) xcd_barrier(bar); } while (0)
#endif
#define WSP(off) ((bf16_t*)(F.ws + (off)))
#define SSQ(i) ((ssq_t*)(F.ws + WS_SSQ) + (size_t)(i) * NTOK)
    LAS unsigned char* ring = L + RING_OFF;

    if (IN(0)) FORREP(0) { Frame F = make_frame(L); p0_prologue(F); SEAM(0); }

    for (int lp = 0; lp < 2; ++lp) {
        const int pb = 1 + 13 * lp;
        if (IN(pb + 0)) FORREP(pb + 0) { Frame F = make_frame(L);
            pg8::RegOrder S; S.init(WSP(WS_H), DM * 2, WSP(WS_WDN) + (size_t)lp * NDOWNP * DM, DM * 2, NTOK, NDOWNP, F.G, F.bx);
            pg8::EpiDown E{WSP(WS_DOWN), WSP(WS_KR), SSQ(4 * lp + 0), LASTREP ? SSQ(10 + 2 * lp) : SSQ(9), LASTREP ? SSQ(11 + 2 * lp) : SSQ(9), (const float*)(F.ws + WS_COS), (const float*)(F.ws + WS_SIN)};
            pg8::gemm_phase<pg8::EpiDown, pg8::RegOrder, false>(ring, DM * 2, DM * 2, DM * 2, S, E);
            SEAM(pb + 0);
        }
        if (IN(pb + 1)) FORREP(pb + 1) { Frame F = make_frame(L);
            pg8::RegOrder S; S.init(WSP(WS_DOWN), NDOWNP * 2, WSP(WS_WUQ) + (size_t)lp * NQ * QLR, QLR * 2, NTOK, NQ, F.G, F.bx);
            pg8::EpiQ E{WSP(WS_Q), (const float*)(F.ws + WS_COS), (const float*)(F.ws + WS_SIN), SSQ(10 + 2 * lp)};
            pg8::gemm_phase<pg8::EpiQ, pg8::RegOrder, false>(ring, NDOWNP * 2, QLR * 2, QLR * 2, S, E);
            SEAM(pb + 1);
        }
        if (IN(pb + 2)) FORREP(pb + 2) { Frame F = make_frame(L);
            pg8::RegOrder S; S.init(WSP(WS_DOWN) + QLR, NDOWNP * 2, WSP(WS_WUKV) + (size_t)lp * NKV * KVLR, KVLR * 2, NTOK, NKV, F.G, F.bx);
            pg8::EpiBf16<2> E{WSP(WS_KNV), NKV, SSQ(11 + 2 * lp)};
            pg8::gemm_phase<pg8::EpiBf16<2>, pg8::RegOrder, false>(ring, NDOWNP * 2, KVLR * 2, KVLR * 2, S, E);
            SEAM(pb + 2);
        }
        if (IN(pb + 3)) FORREP(pb + 3) { Frame F = make_frame(L); att::attn_phase((char*)lds + RING_OFF, WSP(WS_Q), WSP(WS_KNV), WSP(WS_KR), WSP(WS_DOWN), F.vcu, F.G); SEAM(pb + 3); }
        if (IN(pb + 4) && lp == 0) FORREP(pb + 4) { Frame F = make_frame(L);
            pg8::RegOrder S; S.init(WSP(WS_DOWN), DM * 2, WSP(WS_WO) + (size_t)lp * DM * DM, DM * 2, NTOK, DM, F.G, F.bx);
            pg8::EpiResidH<false> E{WSP(WS_H), LASTREP ? WSP(WS_H) : WSP(WS_DUMMY), LASTREP ? SSQ(4 * lp + 1) : SSQ(9), nullptr, 1.0f};
            pg8::gemm_phase<pg8::EpiResidH<false>, pg8::RegOrder, false>(ring, DM * 2, DM * 2, DM * 2, S, E);
            SEAM(pb + 4);
        }
        if (IN(pb + 4) && lp == 1) FORREP(pb + 4) { Frame F = make_frame(L);
            pg8::RegOrder S; S.init(WSP(WS_DOWN), DM * 2, WSP(WS_WO) + (size_t)lp * DM * DM, DM * 2, NTOK, DM, F.G, F.bx);
            pg8::EpiResidH<true> E{WSP(WS_H), LASTREP ? WSP(WS_H) : WSP(WS_DUMMY), LASTREP ? SSQ(4 * lp + 1) : SSQ(9), F.ws + WS_H8, 1.0f};
            pg8::gemm_phase<pg8::EpiResidH<true>, pg8::RegOrder, false>(ring, DM * 2, DM * 2, DM * 2, S, E);
            SEAM(pb + 4);
        }
#if defined(MK_EPI_PROBE)
        if (IN(pb + 5) && lp == 0 && !LASTREP) { Frame F = make_frame(L);
            pg8::RegOrder S; S.init(WSP(WS_H), DM * 2, WSP(WS_WGU) + (size_t)lp * 2 * FFD * DM, DM * 2, NTOK, 2 * FFD, F.G, F.bx);
#if MK_EPI_PROBE == 1
            pg8::EpiNull E{(float*)(F.ws + WS_DUMMY)};
            pg8::gemm_phase<pg8::EpiNull, pg8::RegOrder, false>(ring, DM * 2, DM * 2, DM * 2, S, E);
#else
            pg8::EpiBf16<0> E{WSP(WS_HID), FFD, nullptr};
            S.nN = FFD / 256; S.nwg = S.nM * S.nN;
            pg8::gemm_phase<pg8::EpiBf16<0>, pg8::RegOrder, false>(ring, DM * 2, DM * 2, DM * 2, S, E);
#endif
        }
        if (IN(pb + 5) && lp == 0 && LASTREP) FORREP(pb + 5) { Frame F = make_frame(L);
#else
        if (IN(pb + 5) && lp == 0) FORREP(pb + 5) { Frame F = make_frame(L);
#endif
            pg8::RegOrder S; S.init(WSP(WS_H), DM * 2, WSP(WS_WGU) + (size_t)lp * 2 * FFD * DM, DM * 2, NTOK, 2 * FFD, F.G, F.bx);
            pg8::EpiSwiglu<1> E{WSP(WS_HID), FFD, SSQ(4 * lp + 1), nullptr};
            pg8::gemm_phase<pg8::EpiSwiglu<1>, pg8::RegOrder, false>(ring, DM * 2, DM * 2, DM * 2, S, E, MK_STAG_BF);
            SEAM(pb + 5);
        }
        if (IN(pb + 5) && lp == 1) FORREP(pb + 5) { Frame F = make_frame(L);
            pg8::RegOrder S; S.init(F.ws + WS_H8, DM, F.ws + WS_WGU + (size_t)2 * FFD * DM * 2, DM, NTOK, 2 * FFD, F.G, F.bx);
            pg8::EpiSwigluF8<1> E{F.ws + WS_HID, FFD8, 2 * FFD / 256 - 1, SSQ(4 * lp + 1)};
            pg8::gemm_phase<pg8::EpiSwigluF8<1>, pg8::RegOrder, false, true>(ring, DM, DM, DM, S, E, MK_STAG_F8);
            SEAM(pb + 5);
        }
        if (IN(pb + 6) && lp == 0) FORREP(pb + 6) { Frame F = make_frame(L);
            pg8::RegOrder S; S.init(WSP(WS_HID), FFD * 2, WSP(WS_WD) + (size_t)lp * DM * FFD, FFD * 2, NTOK, DM, F.G, F.bx); S.rev = MK_REV;
            pg8::EpiResidH<false> E{WSP(WS_H), LASTREP ? WSP(WS_H) : WSP(WS_DUMMY), LASTREP ? SSQ(4 * lp + 2) : SSQ(9), nullptr, 1.0f};
            pg8::gemm_phase<pg8::EpiResidH<false>, pg8::RegOrder, false>(ring, FFD * 2, FFD * 2, FFD * 2, S, E);
            SEAM(pb + 6);
        }
        if (IN(pb + 6) && lp == 1) FORREP(pb + 6) { Frame F = make_frame(L);
            pg8::RegOrder S; S.init(F.ws + WS_HID, FFD8, F.ws + WS_WD + (size_t)DM * FFD * 2, FFD8, NTOK, DM, F.G, F.bx); S.rev = MK_REV;
            pg8::EpiResidH<false> E{WSP(WS_H), LASTREP ? WSP(WS_H) : WSP(WS_DUMMY), LASTREP ? SSQ(4 * lp + 2) : SSQ(9), nullptr, 1.0f / (pg8::FP8_SH * pg8::FP8_SW)};
            pg8::gemm_phase<pg8::EpiResidH<false>, pg8::RegOrder, false, true>(ring, FFD8, FFD8, FFD8, S, E);
            SEAM(pb + 6);
        }
        if (IN(pb + 7)) FORREP(pb + 7) { Frame F = make_frame(L); pool_phase(F, WSP(WS_H), SSQ(4 * lp + 2), ptab(F.lds, 2) + (size_t)(2 * lp + 1) * DM, WSP(WS_DOWN)); SEAM(pb + 7); }
        if (IN(pb + 8)) FORREP(pb + 8) { Frame F = make_frame(L);
            pg8::RegOrder S; S.init(WSP(WS_DOWN), DM * 2, WSP(WS_WPOOL) + (size_t)lp * 4 * 256 * 256, 256 * 2, NTOK, DM, F.G, F.bx, 256 * 2);
            pg8::EpiResidH<false> E{WSP(WS_H), LASTREP ? WSP(WS_H) : WSP(WS_DUMMY), LASTREP ? SSQ(4 * lp + 3) : SSQ(9), nullptr, 1.0f};
            pg8::gemm_phase<pg8::EpiResidH<false>, pg8::RegOrder, false>(ring, DM * 2, 256 * 2, 256 * 2, S, E);
            SEAM(pb + 8);
        }
        if (IN(pb + 9)) FORREP(pb + 9) { Frame F = make_frame(L);
            router_phase<true>(F, WSP(WS_H), SSQ(4 * lp + 3), ptab(F.lds, 3) + (size_t)(2 * lp + 1) * DM, ptab(F.lds, 15) + (size_t)lp * DM * NEXP, (int*)(F.ws + WS_LIST), (float*)(F.ws + WS_RSL), (unsigned*)(F.ws + WS_TOKINFO), (unsigned*)(F.ctl + CW_CNT) + (LASTREP ? lp : 2 + lp) * 8 * 64, F.ws + WS_H8);
            SEAM(pb + 9); }
#ifndef TEST_NO_F8MOE
        if (IN(pb + 10)) FORREP(pb + 10) { Frame F = make_frame(L);
            MoeOrder<true, true> S; S.init((unsigned*)(F.ctl + CW_CNT) + lp * 8 * 64, F.ws + WS_H8, F.ws + WS_MWGU + (size_t)lp * 8 * 2 * FFEP * DM * 2, (const int*)(F.ws + WS_LIST), F.G, F.bx);
            pg8::EpiSwigluF8<0> E{F.ws + WS_HID, FFE8, 2 * FFEP / 256 - 1, nullptr};
            pg8::gemm_phase<pg8::EpiSwigluF8<0>, MoeOrder<true, true>, true, true>(ring, DM, DM, DM, S, E, MK_STAG_F8);
            SEAM(pb + 10);
        }
#endif
#ifndef TEST_NO_F8MOE
        if (IN(pb + 11)) FORREP(pb + 11) { Frame F = make_frame(L);
            MoeOrder<false, true> S; S.init((unsigned*)(F.ctl + CW_CNT) + lp * 8 * 64, F.ws + WS_HID, F.ws + WS_MWD + (size_t)lp * 8 * DM * FFEP * 2, (const int*)(F.ws + WS_LIST), F.G, F.bx); S.rev = MK_REV;
            pg8::EpiBf16Scaled E{WSP(WS_YB), DM, 1.0f / (pg8::FP8_SH * pg8::FP8_SW)};
            pg8::gemm_phase<pg8::EpiBf16Scaled, MoeOrder<false, true>, false, true>(ring, FFE8, FFE8, FFE8, S, E);
            SEAM(pb + 11);
        }
#endif
        if (IN(pb + 12)) FORREP(pb + 12) { Frame F = make_frame(L);
            if (lp == 0) combine_phase<false>(F, WSP(WS_H), LASTREP ? WSP(WS_H) : WSP(WS_DOWN), WSP(WS_YB), (const unsigned*)(F.ws + WS_TOKINFO), (unsigned*)(F.ctl + CW_CNT), LASTREP ? SSQ(4) : SSQ(9), nullptr, nullptr);
            else combine_phase<true>(F, WSP(WS_H), nullptr, WSP(WS_YB), (const unsigned*)(F.ws + WS_TOKINFO), (unsigned*)(F.ctl + CW_CNT) + 8 * 64, nullptr, ptab(F.lds, 19), (float*)ptab(F.lds, 20));
            SEAM(pb + 12);
        }
    }
#undef IN
#undef SEAM
#undef WSP
#undef SSQ
}

#ifndef MK_PER_PHASE
#define MK_PER_PHASE 0
#endif
extern "C" void kernel_launch(void* const* d_in, const int* in_sizes, int n_in, void* d_out, int out_size, void* d_ws, size_t ws_size, hipStream_t stream) {
    static int grid = 0;
    if (grid == 0) {
        if (n_in != 20 || in_sizes[0] != NTOK * DM || out_size != NTOK * DM || ws_size < WS_END) { fprintf(stderr, "kernel_launch: unexpected shapes (n_in %d, in0 %d, out %d, ws %zu < %zu)\n", n_in, n_in > 0 ? in_sizes[0] : -1, out_size, ws_size, (size_t)WS_END); grid = -1; return; }
        int dev = 0, cus = 0, per_cu = 0;
        if (hipGetDevice(&dev) != hipSuccess || hipDeviceGetAttribute(&cus, hipDeviceAttributeMultiprocessorCount, dev) != hipSuccess) { grid = -1; return; }
        if (hipFuncSetAttribute((const void*)fwd, hipFuncAttributeMaxDynamicSharedMemorySize, LDS_BYTES) != hipSuccess) { fprintf(stderr, "kernel_launch: hipFuncSetAttribute failed\n"); grid = -1; return; }
        if (hipOccupancyMaxActiveBlocksPerMultiprocessor(&per_cu, (const void*)fwd, NWAVES * 64, LDS_BYTES) != hipSuccess || per_cu < 1) fprintf(stderr, "kernel_launch: occupancy query reports %d\n", per_cu);
        (void)hipGetLastError();
        grid = cus < 256 ? cus : 256;
    }
    if (grid < 0) return;
    if (hipMemsetAsync((char*)d_ws + WS_CTL, 0, CTL_ZERO_BYTES, stream) != hipSuccess) return;
    Args a{};
    for (int i = 0; i < 20; ++i) a.in[i] = (const float*)d_in[i];
    a.out = (float*)d_out; a.ws = (unsigned char*)d_ws;
#if MK_PER_PHASE
    for (int p = 0; p < NPHASE; ++p) { a.ph_lo = p; a.ph_hi = p + 1; a.li = 0; hipLaunchKernelGGL(fwd, dim3(grid), dim3(NWAVES * 64), LDS_BYTES, stream, a); }
#elif MK_REP_MASK
    { int cur = 0, li = 0;
      for (int k = 0; k < NPHASE; ++k) if ((MK_REP_MASK >> (k == 0 ? 0 : 1 + (k - 1) % 13)) & 1) {
          if (k > cur) { a.ph_lo = cur; a.ph_hi = k; a.li = li++; a.pad = 0; hipLaunchKernelGGL(fwd, dim3(grid), dim3(NWAVES * 64), LDS_BYTES, stream, a); }
          for (int r = 1; r < MK_REP_N; ++r) { a.ph_lo = k; a.ph_hi = k + 1; a.li = li++; a.pad = 1; hipLaunchKernelGGL(fwd, dim3(grid), dim3(NWAVES * 64), LDS_BYTES, stream, a); }
          cur = k; }
      a.ph_lo = cur; a.ph_hi = NPHASE; a.li = li++; a.pad = 0; hipLaunchKernelGGL(fwd, dim3(grid), dim3(NWAVES * 64), LDS_BYTES, stream, a); }
#elif defined(MK_TWICE)
    a.ph_lo = 0; a.ph_hi = NPHASE; a.li = 0;
    hipLaunchKernelGGL(fwd, dim3(grid), dim3(NWAVES * 64), LDS_BYTES, stream, a);
    (void)hipMemsetAsync((char*)d_ws + WS_CTL, 0, CTL_ZERO_BYTES, stream);
    hipLaunchKernelGGL(fwd, dim3(grid), dim3(NWAVES * 64), LDS_BYTES, stream, a);
#else
    a.ph_lo = 0; a.ph_hi = NPHASE; a.li = 0;
    hipLaunchKernelGGL(fwd, dim3(grid), dim3(NWAVES * 64), LDS_BYTES, stream, a);
#endif
}
```

```cpp
#include <hip/hip_runtime.h>
#include <cstdio>
#include <cstdint>

#define GAS __attribute__((address_space(1)))
#define LAS __attribute__((address_space(3)))
typedef unsigned short bf16_t;
typedef short bf16x8 __attribute__((ext_vector_type(8)));
typedef short s16x4 __attribute__((ext_vector_type(4)));
typedef float f32x2 __attribute__((ext_vector_type(2)));
typedef float f32x4 __attribute__((ext_vector_type(4)));
typedef float f32x16 __attribute__((ext_vector_type(16)));
typedef unsigned u32x2 __attribute__((ext_vector_type(2)));
typedef unsigned u32x4 __attribute__((ext_vector_type(4)));

constexpr int DM = 1024, NBATCH = 32, SEQ = 2048, NTOK = NBATCH * SEQ;
constexpr int NHEAD = 8, DNOPE = 128, DROPE = 64, DVH = 128, DQH = DNOPE + DROPE, QLR = 512, KVLR = 256;
constexpr int NDOWN = QLR + KVLR + DROPE  , NDOWNP = 1024;
constexpr int NQ = NHEAD * DQH  , NKV = NHEAD * (DNOPE + DVH)  ;
constexpr int FFD = 2688, NEXP = 8, FFE = 1344, FFEP = 1408;
constexpr int PSLOT = (NTOK * 2 / 256 + NEXP) * 256;
constexpr float RMS_EPS = 1e-6f;

__device__ __forceinline__ unsigned cvt_pk_bf16(float lo, float hi) { unsigned r; asm volatile("v_cvt_pk_bf16_f32 %0, %1, %2" : "=v"(r) : "v"(lo), "v"(hi)); return r; }
__device__ __forceinline__ int launder_v(int v) { asm volatile("" : "+v"(v)); return v; }
__device__ __forceinline__ float fp8_rt(float x, float s) { const int p = __builtin_amdgcn_cvt_pk_fp8_f32(x * s, 0.f, 0, false); return __builtin_amdgcn_cvt_f32_fp8(p, 0) * (1.0f / s); }
__device__ __forceinline__ float bf2f(unsigned short b) { return __uint_as_float((unsigned)b << 16); }
__device__ __forceinline__ float bflo(unsigned w) { return __uint_as_float(w << 16); }
__device__ __forceinline__ float bfhi(unsigned w) { return __uint_as_float(w & 0xffff0000u); }

typedef unsigned long long ssq_t;
__device__ __forceinline__ ssq_t ssq_fix(float s) { return (ssq_t)(s * 16777216.0f); }
__device__ __forceinline__ float rstd_n(ssq_t q, float invn) { return __builtin_amdgcn_rsqf(((float)(unsigned)(q >> 32) * 4294967296.0f + (float)(unsigned)q) * (1.0f / 16777216.0f) * invn + RMS_EPS); }
__device__ __forceinline__ float rstd_of(ssq_t q) { return rstd_n(q, 1.0f / DM); }
__device__ __forceinline__ float rstd_f(float ssq) { return __builtin_amdgcn_rsqf(ssq * (1.0f / DM) + RMS_EPS); }

namespace pg8 {
constexpr int BM = 256, BK = 64, HALF = 128, HTB = HALF * BK * 2  , STAGE_BYTES = 8 * HTB, NXCD = 8, WGM = 8;
__host__ __device__ __forceinline__ int lds_byte(int r, int c) { const int st = (r >> 4) * 2 + (c >> 5), rr = r & 15, cc = c & 31, ob = rr * 64 + cc * 2; return st * 1024 + (ob ^ (((ob >> 9) & 1) << 5)); }
__host__ __device__ __forceinline__ void stage_rc(int b, int& R, int& C) { const int st = b / 1024, sb = b % 1024, swz = sb ^ (((sb >> 9) & 1) << 5); R = (st >> 1) * 16 + swz / 64; C = (st & 1) * 32 + (swz % 64) / 2; }
__host__ __device__ __forceinline__ int perm32(int rho) { const int n = rho >> 4, i = rho & 15; return 8 * (i >> 2) + 4 * n + (i & 3); }

struct Unit { const char* a; const char* b; const int* rows; int nrows; int orow; int pn; int aux; };

struct RegOrder {
    const char* A; const char* B; unsigned a_tile, b_tile, a_colstep; int nM, nN, nwg, G, c, rev;
    __device__ __forceinline__ void init(const void* A_, size_t lda_b, const void* B_, size_t ldb_b, int M, int N, int G_, int c_, size_t a_colstep_ = 0) {
        A = (const char*)A_; B = (const char*)B_; a_tile = (unsigned)(256 * lda_b); b_tile = (unsigned)(256 * ldb_b); a_colstep = (unsigned)a_colstep_; nM = M / BM; nN = N / BM; nwg = nM * nN; G = G_; c = c_; rev = 0; }
    __device__ __forceinline__ bool next(int i, Unit& u) const {
        long L = (long)i * G + c; if (L >= nwg) return false;
        if (rev) L = nwg - 1 - L;
        int wgid = (int)L; { const int q = nwg / NXCD, r = nwg % NXCD, xcd = wgid % NXCD, off = wgid / NXCD; wgid = (xcd < r ? xcd * (q + 1) : r * (q + 1) + (xcd - r) * q) + off; }
        const int nig = WGM * nN, gid = wgid / nig, fm = gid * WGM, gsz = (nM - fm) < WGM ? (nM - fm) : WGM;
        const int pm = fm + ((wgid % nig) % gsz), pn = (wgid % nig) / gsz;
        u.a = A + (size_t)pm * a_tile + (size_t)pn * a_colstep; u.b = B + (size_t)pn * b_tile; u.rows = nullptr; u.nrows = 256; u.orow = pm * BM; u.pn = pn; u.aux = 0; return true;
    }
};

template <int RS> struct EpiBf16 {
    static constexpr bool PERM = true;
    bf16_t* O; int ldc; const ssq_t* rs;
    __device__ __forceinline__ void operator()(const f32x4 (&acc)[2][2][4][2], const Unit& u, int wr, int wc, int fr, int fq) const {
        const int row0 = u.orow + launder_v(wr * 64 + fr), col0 = u.pn * BM + wc * 32 + 8 * fq;
        float sc[2][4]; ssq_t rq[2][4];
#pragma unroll
        for (int ai = 0; ai < 2; ++ai)
#pragma unroll
            for (int m = 0; m < 4; ++m) { const int row = row0 + ai * HALF + m * 16; if constexpr (RS != 0) rq[ai][m] = rs[row]; }
#pragma unroll
        for (int ai = 0; ai < 2; ++ai)
#pragma unroll
            for (int m = 0; m < 4; ++m) { sc[ai][m] = 1.0f; if constexpr (RS == 1) sc[ai][m] = rstd_of(rq[ai][m]); if constexpr (RS == 2) sc[ai][m] = rstd_n(rq[ai][m], 1.0f / KVLR); }
#pragma unroll
        for (int ai = 0; ai < 2; ++ai)
#pragma unroll
            for (int m = 0; m < 4; ++m) { const int row = row0 + ai * HALF + m * 16; bf16_t* rowp = O + (size_t)row * ldc + col0;
#pragma unroll
                for (int bj = 0; bj < 2; ++bj) { const f32x4 v0 = acc[ai][bj][m][0] * sc[ai][m], v1 = acc[ai][bj][m][1] * sc[ai][m];
                    u32x4 w; w.x = cvt_pk_bf16(v0[0], v0[1]); w.y = cvt_pk_bf16(v0[2], v0[3]); w.z = cvt_pk_bf16(v1[0], v1[1]); w.w = cvt_pk_bf16(v1[2], v1[3]);
                    *(u32x4*)(rowp + bj * HALF) = w; } }
    }
};
__device__ __forceinline__ float silu_mul(float g, float u) { return g * u * __builtin_amdgcn_rcpf(1.0f + __builtin_amdgcn_exp2f(-1.4426950408889634f * g)); }
template <int RS> struct EpiSwiglu {
    static constexpr bool PERM = true;
    bf16_t* H; int ldh; const void* rs; const int* list;
    __device__ __forceinline__ void operator()(const f32x4 (&acc)[2][2][4][2], const Unit& u, int wr, int wc, int fr, int fq) const {
        const int r0 = launder_v(wr * 64 + fr), col0 = u.pn * HALF + wc * 32 + 8 * fq;
        const ssq_t* rsq = (const ssq_t*)rs; const float* rsp = (const float*)rs; if constexpr (RS == 2) rsp = rsp + (u.rows - list);
        float sc[2][4]; ssq_t rq[2][4];
#pragma unroll
        for (int ai = 0; ai < 2; ++ai)
#pragma unroll
            for (int m = 0; m < 4; ++m) { const int r = r0 + ai * HALF + m * 16; if constexpr (RS == 1) rq[ai][m] = rsq[u.orow + r]; else sc[ai][m] = rsp[r]; }
        if constexpr (RS == 1) {
#pragma unroll
            for (int ai = 0; ai < 2; ++ai)
#pragma unroll
                for (int m = 0; m < 4; ++m) sc[ai][m] = rstd_of(rq[ai][m]); }
#pragma unroll
        for (int ai = 0; ai < 2; ++ai)
#pragma unroll
            for (int m = 0; m < 4; ++m) { const int r = r0 + ai * HALF + m * 16; bf16_t* rowp = H + (size_t)(u.orow + r) * ldh + col0; const float s = sc[ai][m];
                const f32x4 g0 = acc[ai][0][m][0] * s, g1 = acc[ai][0][m][1] * s, u0 = acc[ai][1][m][0] * s, u1 = acc[ai][1][m][1] * s;
                u32x4 w; w.x = cvt_pk_bf16(silu_mul(g0[0], u0[0]), silu_mul(g0[1], u0[1])); w.y = cvt_pk_bf16(silu_mul(g0[2], u0[2]), silu_mul(g0[3], u0[3]));
                w.z = cvt_pk_bf16(silu_mul(g1[0], u1[0]), silu_mul(g1[1], u1[1])); w.w = cvt_pk_bf16(silu_mul(g1[2], u1[2]), silu_mul(g1[3], u1[3]));
                __builtin_nontemporal_store(w, (u32x4*)rowp); }
    }
};
constexpr float FP8_SA = 16.0f, FP8_SW = 256.0f, FP8_SH = 16.0f, FP8_SX = 8.0f;
__device__ __forceinline__ unsigned pk4_fp8(float a, float b, float c, float d) { int p = __builtin_amdgcn_cvt_pk_fp8_f32(a, b, 0, false); p = __builtin_amdgcn_cvt_pk_fp8_f32(c, d, p, true); return (unsigned)p; }
template <int RS> struct EpiSwigluF8 {
    static constexpr bool PERM = true;
    unsigned char* H8; int ldh; int pad_tile; const ssq_t* rs;
    __device__ __forceinline__ void operator()(const f32x4 (&acc)[2][2][4][2], const Unit& u, int wr, int wc, int fr, int fq) const {
        const int r0 = launder_v(wr * 64 + fr), col0 = u.pn * HALF + wc * 32 + 8 * fq;
        float sc[2][4]; ssq_t rq[2][4];
#pragma unroll
        for (int ai = 0; ai < 2; ++ai)
#pragma unroll
            for (int m = 0; m < 4; ++m) { if constexpr (RS == 1) rq[ai][m] = rs[u.orow + r0 + ai * HALF + m * 16]; }
#pragma unroll
        for (int ai = 0; ai < 2; ++ai)
#pragma unroll
            for (int m = 0; m < 4; ++m) { if constexpr (RS == 1) sc[ai][m] = rstd_of(rq[ai][m]) * (1.0f / (FP8_SX * FP8_SW)); else sc[ai][m] = 1.0f / (FP8_SA * FP8_SW); }
#pragma unroll
        for (int ai = 0; ai < 2; ++ai)
#pragma unroll
            for (int m = 0; m < 4; ++m) { const int r = r0 + ai * HALF + m * 16; unsigned char* rowp = H8 + (size_t)(u.orow + r) * ldh + col0; const float s = sc[ai][m];
                const f32x4 g0 = acc[ai][0][m][0] * s, g1 = acc[ai][0][m][1] * s, u0 = acc[ai][1][m][0] * s, u1 = acc[ai][1][m][1] * s;
                u32x2 w; w.x = pk4_fp8(silu_mul(g0[0], u0[0]) * FP8_SH, silu_mul(g0[1], u0[1]) * FP8_SH, silu_mul(g0[2], u0[2]) * FP8_SH, silu_mul(g0[3], u0[3]) * FP8_SH);
                w.y = pk4_fp8(silu_mul(g1[0], u1[0]) * FP8_SH, silu_mul(g1[1], u1[1]) * FP8_SH, silu_mul(g1[2], u1[2]) * FP8_SH, silu_mul(g1[3], u1[3]) * FP8_SH);
                __builtin_nontemporal_store(w, (u32x2*)rowp);
                if (u.pn == pad_tile) { u32x2 z; asm volatile("v_mov_b32 %0, 0\n\tv_mov_b32 %1, 0" : "=v"(z.x), "=v"(z.y)); *(u32x2*)(rowp + HALF) = z; } }
    }
};
struct EpiBf16Scaled {
    static constexpr bool PERM = true;
    bf16_t* O; int ldc; float scale;
    __device__ __forceinline__ void operator()(const f32x4 (&acc)[2][2][4][2], const Unit& u, int wr, int wc, int fr, int fq) const {
        const int row0 = u.orow + launder_v(wr * 64 + fr), col0 = u.pn * BM + wc * 32 + 8 * fq;
#pragma unroll
        for (int ai = 0; ai < 2; ++ai)
#pragma unroll
            for (int m = 0; m < 4; ++m) { bf16_t* rowp = O + (size_t)(row0 + ai * HALF + m * 16) * ldc + col0;
#pragma unroll
                for (int bj = 0; bj < 2; ++bj) { const f32x4 v0 = acc[ai][bj][m][0] * scale, v1 = acc[ai][bj][m][1] * scale;
                    u32x4 w; w.x = cvt_pk_bf16(v0[0], v0[1]); w.y = cvt_pk_bf16(v0[2], v0[3]); w.z = cvt_pk_bf16(v1[0], v1[1]); w.w = cvt_pk_bf16(v1[2], v1[3]);
                    *(u32x4*)(rowp + bj * HALF) = w; } }
    }
};
struct EpiNull {
    static constexpr bool PERM = true;
    float* sink;
    __device__ __forceinline__ void operator()(const f32x4 (&acc)[2][2][4][2], const Unit& u, int wr, int wc, int fr, int fq) const {
        float s = 0.f;
#pragma unroll
        for (int ai = 0; ai < 2; ++ai)
#pragma unroll
            for (int bj = 0; bj < 2; ++bj)
#pragma unroll
                for (int m = 0; m < 4; ++m)
#pragma unroll
                    for (int n = 0; n < 2; ++n) s += acc[ai][bj][m][n][0];
        if (s == 12345.678f) sink[0] = s;
    }
};
template <bool W8> struct EpiResidH {
    static constexpr bool PERM = true;
    const bf16_t* hin; bf16_t* hout; ssq_t* ssq; unsigned char* h8; float scale;
    __device__ __forceinline__ void operator()(const f32x4 (&acc)[2][2][4][2], const Unit& u, int wr, int wc, int fr, int fq) const {
        const int row0 = u.orow + launder_v(wr * 64 + fr), col0 = u.pn * BM + wc * 32 + 8 * fq;
        float part[2][4];
        u32x4 hv[2][4][2];
#pragma unroll
        for (int ai = 0; ai < 2; ++ai)
#pragma unroll
            for (int m = 0; m < 4; ++m)
#pragma unroll
                for (int bj = 0; bj < 2; ++bj) hv[ai][m][bj] = *(const u32x4*)(hin + (size_t)(row0 + ai * HALF + m * 16) * DM + col0 + bj * HALF);
#pragma unroll
        for (int ai = 0; ai < 2; ++ai) {
#pragma unroll
            for (int m = 0; m < 4; ++m) { const int row = row0 + ai * HALF + m * 16; const size_t off = (size_t)row * DM + col0; float pt = 0.f;
#pragma unroll
                for (int bj = 0; bj < 2; ++bj) { const u32x4 h4 = hv[ai][m][bj]; const f32x4 a0 = acc[ai][bj][m][0] * scale, a1 = acc[ai][bj][m][1] * scale;
                    const float y0 = bflo(h4.x) + a0[0], y1 = bfhi(h4.x) + a0[1], y2 = bflo(h4.y) + a0[2], y3 = bfhi(h4.y) + a0[3], y4 = bflo(h4.z) + a1[0], y5 = bfhi(h4.z) + a1[1], y6 = bflo(h4.w) + a1[2], y7 = bfhi(h4.w) + a1[3];
                    pt += (y0 * y0 + y1 * y1) + (y2 * y2 + y3 * y3) + (y4 * y4 + y5 * y5) + (y6 * y6 + y7 * y7);
                    u32x4 w; w.x = cvt_pk_bf16(y0, y1); w.y = cvt_pk_bf16(y2, y3); w.z = cvt_pk_bf16(y4, y5); w.w = cvt_pk_bf16(y6, y7);
                    *(u32x4*)(hout + off + bj * HALF) = w;
                    if constexpr (W8) { u32x2 q; q.x = pk4_fp8(y0 * FP8_SX, y1 * FP8_SX, y2 * FP8_SX, y3 * FP8_SX); q.y = pk4_fp8(y4 * FP8_SX, y5 * FP8_SX, y6 * FP8_SX, y7 * FP8_SX); *(u32x2*)(h8 + off + bj * HALF) = q; } }
                pt += __shfl_xor(pt, 16); pt += __shfl_xor(pt, 32); part[ai][m] = pt; }
        }
        if (fq == 0) {
#pragma unroll
            for (int ai = 0; ai < 2; ++ai)
#pragma unroll
                for (int m = 0; m < 4; ++m) atomicAdd(ssq + row0 + ai * HALF + m * 16, ssq_fix(part[ai][m])); }
    }
};
struct EpiDown {
    static constexpr bool PERM = true;
    bf16_t* O; bf16_t* KR; const ssq_t* rs; ssq_t* ssq_q; ssq_t* ssq_kv; const float* cosT; const float* sinT;
    __device__ __forceinline__ void operator()(const f32x4 (&acc)[2][2][4][2], const Unit& u, int wr, int wc, int fr, int fq) const {
        const int row0 = u.orow + launder_v(wr * 64 + fr);
        float sc[2][4]; ssq_t rq[2][4];
#pragma unroll
        for (int ai = 0; ai < 2; ++ai)
#pragma unroll
            for (int m = 0; m < 4; ++m) rq[ai][m] = rs[row0 + ai * HALF + m * 16];
#pragma unroll
        for (int ai = 0; ai < 2; ++ai)
#pragma unroll
            for (int m = 0; m < 4; ++m) sc[ai][m] = rstd_of(rq[ai][m]);
        if (u.pn < 3) {
            ssq_t* sq = u.pn < 2 ? ssq_q : ssq_kv; const int col0 = u.pn * BM + wc * 32 + 8 * fq; float pts[2][4];
#pragma unroll
            for (int ai = 0; ai < 2; ++ai)
#pragma unroll
                for (int m = 0; m < 4; ++m) { const int row = row0 + ai * HALF + m * 16; bf16_t* rowp = O + (size_t)row * NDOWNP + col0; const float s = sc[ai][m]; float part = 0.f;
#pragma unroll
                    for (int bj = 0; bj < 2; ++bj) { const f32x4 v0 = acc[ai][bj][m][0] * s, v1 = acc[ai][bj][m][1] * s;
                        part += (v0[0] * v0[0] + v0[1] * v0[1]) + (v0[2] * v0[2] + v0[3] * v0[3]) + (v1[0] * v1[0] + v1[1] * v1[1]) + (v1[2] * v1[2] + v1[3] * v1[3]);
                        u32x4 w; w.x = cvt_pk_bf16(v0[0], v0[1]); w.y = cvt_pk_bf16(v0[2], v0[3]); w.z = cvt_pk_bf16(v1[0], v1[1]); w.w = cvt_pk_bf16(v1[2], v1[3]);
                        *(u32x4*)(rowp + bj * HALF) = w; }
                    part += __shfl_xor(part, 16); part += __shfl_xor(part, 32); pts[ai][m] = part; }
            if (fq == 0) {
#pragma unroll
                for (int ai = 0; ai < 2; ++ai)
#pragma unroll
                    for (int m = 0; m < 4; ++m) atomicAdd(sq + row0 + ai * HALF + m * 16, ssq_fix(pts[ai][m])); }
        } else if (wc == 0) {
#pragma unroll
            for (int aq = 0; aq < 4; ++aq) { const int ai = aq >> 1, mb = (aq & 1) * 2; f32x4 ct[4][2], st[4][2];
#pragma unroll
                for (int m = mb; m < mb + 2; ++m) { const size_t to = (size_t)(row0 + ai * HALF + m * 16) * 32 + 8 * fq;
                    ct[m][0] = *(const f32x4*)(cosT + to); ct[m][1] = *(const f32x4*)(cosT + to + 4); st[m][0] = *(const f32x4*)(sinT + to); st[m][1] = *(const f32x4*)(sinT + to + 4); }
#pragma unroll
                for (int m = mb; m < mb + 2; ++m) { const int row = row0 + ai * HALF + m * 16; const float s = sc[ai][m];
                    const f32x4 a0 = acc[ai][0][m][0] * s, a1 = acc[ai][0][m][1] * s, b0 = acc[ai][1][m][0] * s, b1 = acc[ai][1][m][1] * s;
                    const f32x4 x0 = a0 * ct[m][0] - b0 * st[m][0], x1 = a1 * ct[m][1] - b1 * st[m][1], y0 = b0 * ct[m][0] + a0 * st[m][0], y1 = b1 * ct[m][1] + a1 * st[m][1];
                    bf16_t* rp = KR + (size_t)row * DROPE + 8 * fq;
                    u32x4 w; w.x = cvt_pk_bf16(x0[0], x0[1]); w.y = cvt_pk_bf16(x0[2], x0[3]); w.z = cvt_pk_bf16(x1[0], x1[1]); w.w = cvt_pk_bf16(x1[2], x1[3]);
                    *(u32x4*)rp = w;
                    w.x = cvt_pk_bf16(y0[0], y0[1]); w.y = cvt_pk_bf16(y0[2], y0[3]); w.z = cvt_pk_bf16(y1[0], y1[1]); w.w = cvt_pk_bf16(y1[2], y1[3]);
                    *(u32x4*)(rp + 32) = w; } }
        }
    }
};
struct EpiQ {
    static constexpr bool PERM = true;
    bf16_t* Q; const float* cosT; const float* sinT; const ssq_t* rs;
    __device__ __forceinline__ void operator()(const f32x4 (&acc)[2][2][4][2], const Unit& u, int wr, int wc, int fr, int fq) const {
        const int row0 = u.orow + launder_v(wr * 64 + fr);
        float sc[2][4]; ssq_t rq[2][4];
#pragma unroll
        for (int ai = 0; ai < 2; ++ai)
#pragma unroll
            for (int m = 0; m < 4; ++m) rq[ai][m] = rs[row0 + ai * HALF + m * 16];
#pragma unroll
        for (int ai = 0; ai < 2; ++ai)
#pragma unroll
            for (int m = 0; m < 4; ++m) sc[ai][m] = rstd_n(rq[ai][m], 1.0f / QLR);
        if (u.pn < 2) {
            const int h = 4 * u.pn + wc;
#pragma unroll
            for (int aq = 0; aq < 4; ++aq) { const int ai = aq >> 1, mb = (aq & 1) * 2; f32x4 ct[4][2], st[4][2];
#pragma unroll
                for (int m = mb; m < mb + 2; ++m) { const size_t to = (size_t)(row0 + ai * HALF + m * 16) * 32 + 8 * fq;
                    ct[m][0] = *(const f32x4*)(cosT + to); ct[m][1] = *(const f32x4*)(cosT + to + 4); st[m][0] = *(const f32x4*)(sinT + to); st[m][1] = *(const f32x4*)(sinT + to + 4); }
#pragma unroll
                for (int m = mb; m < mb + 2; ++m) { const int row = row0 + ai * HALF + m * 16; const float s = sc[ai][m];
                    const f32x4 a0 = acc[ai][0][m][0] * s, a1 = acc[ai][0][m][1] * s, b0 = acc[ai][1][m][0] * s, b1 = acc[ai][1][m][1] * s;
                    const f32x4 x0 = a0 * ct[m][0] - b0 * st[m][0], x1 = a1 * ct[m][1] - b1 * st[m][1], y0 = b0 * ct[m][0] + a0 * st[m][0], y1 = b1 * ct[m][1] + a1 * st[m][1];
                    bf16_t* rp = Q + (size_t)row * NQ + h * DQH + DNOPE + 8 * fq;
                    u32x4 w; w.x = cvt_pk_bf16(x0[0], x0[1]); w.y = cvt_pk_bf16(x0[2], x0[3]); w.z = cvt_pk_bf16(x1[0], x1[1]); w.w = cvt_pk_bf16(x1[2], x1[3]);
                    *(u32x4*)rp = w;
                    w.x = cvt_pk_bf16(y0[0], y0[1]); w.y = cvt_pk_bf16(y0[2], y0[3]); w.z = cvt_pk_bf16(y1[0], y1[1]); w.w = cvt_pk_bf16(y1[2], y1[3]);
                    *(u32x4*)(rp + 32) = w; } }
        } else {
#pragma unroll
            for (int ai = 0; ai < 2; ++ai)
#pragma unroll
                for (int m = 0; m < 4; ++m) { const int row = row0 + ai * HALF + m * 16; const float s = sc[ai][m];
#pragma unroll
                    for (int bj = 0; bj < 2; ++bj) { const int h = 2 * (u.pn - 2) + bj; const f32x4 v0 = acc[ai][bj][m][0] * s, v1 = acc[ai][bj][m][1] * s;
                        u32x4 w; w.x = cvt_pk_bf16(v0[0], v0[1]); w.y = cvt_pk_bf16(v0[2], v0[3]); w.z = cvt_pk_bf16(v1[0], v1[1]); w.w = cvt_pk_bf16(v1[2], v1[3]);
                        *(u32x4*)(Q + (size_t)row * NQ + h * DQH + wc * 32 + 8 * fq) = w; } }
        }
    }
};

__device__ __forceinline__ unsigned gather_off(const Unit& u, int idx, unsigned lda_b, unsigned cb) { const int tok = idx < u.nrows ? u.rows[idx] : 0; return (unsigned)tok * lda_b + cb; }
__device__ __forceinline__ u32x4 gather_offs(const Unit& u, int tid, unsigned lda_b) {
    const int t2 = launder_v(tid); int R0, C0, R1, C1; stage_rc(t2 * 16, R0, C0); stage_rc(t2 * 16 + 8192, R1, C1);
    u32x4 pk; pk.x = gather_off(u, R0, lda_b, (unsigned)C0 * 2u); pk.y = gather_off(u, R1, lda_b, (unsigned)C1 * 2u); pk.z = gather_off(u, HALF + R0, lda_b, (unsigned)C0 * 2u); pk.w = gather_off(u, HALF + R1, lda_b, (unsigned)C1 * 2u);
    return pk;
}
typedef int i32x4 __attribute__((ext_vector_type(4)));
typedef int i32x8 __attribute__((ext_vector_type(8)));
template <class Epi, class Sched, bool GATHER, bool FP8 = false>
__device__ __forceinline__ void gemm_phase(LAS unsigned char* lds, const unsigned lda_b, const unsigned ldb_b, const int Kb, const Sched& S, const Epi& E, const unsigned stag_ticks = 0u) {
    if (stag_ticks) { const unsigned long long t0 = __builtin_amdgcn_s_memrealtime(), dl = (unsigned long long)((blockIdx.x >> 3) & 3u) * stag_ticks;
        while (__builtin_amdgcn_s_memrealtime() - t0 < dl) __builtin_amdgcn_s_sleep(8); }
    const int tid = launder_v((int)threadIdx.x), wid = __builtin_amdgcn_readfirstlane(tid >> 6), lane = tid & 63, wr = wid >> 2, wc = wid & 3, fr = lane & 15, fq = lane >> 4;
    int nt = Kb / (BK * 2); asm volatile("" : "+s"(nt));
    unsigned voffA[2], voffB[2];
#pragma unroll
    for (int i = 0; i < 2; ++i) { int R, C; stage_rc(tid * 16 + i * 8192, R, C); const int Rb = Epi::PERM ? ((R & ~31) + perm32(R & 31)) : R;
        voffA[i] = (unsigned)R * lda_b + (unsigned)C * 2u; voffB[i] = (unsigned)Rb * ldb_b + (unsigned)C * 2u; }
    const size_t kstep = (size_t)(BK * 2);
    const size_t hstepA = (size_t)HALF * lda_b, hstepB = (size_t)HALF * ldb_b;
    const unsigned ldsw = (unsigned)wid * 1024u, ldsbase = (unsigned)__builtin_amdgcn_readfirstlane((int)(unsigned)(size_t)lds);
    const int aoff = lds_byte(wr * 64 + fr, fq * 8), boff = lds_byte(wc * 32 + fr, fq * 8);
    unsigned cv0[2] = {0u, 0u}, cv1[2] = {0u, 0u}, nv0[2] = {0u, 0u}, nv1[2] = {0u, 0u};
#define PG8_SA(b, h) (((b) * 2 + (h)) * HTB)
#define PG8_SB(b, h) ((4 + (b) * 2 + (h)) * HTB)
#define PG8_LOAD16(sbase, voff, ldsoff) do { unsigned _keep; asm volatile("s_mov_b32 %0, m0\n\ts_mov_b32 m0, %3\n\ts_nop 0\n\tglobal_load_lds_dwordx4 %1, %2\n\ts_mov_b32 m0, %0" \
        : "=&s"(_keep) : "v"(voff), "s"(sbase), "s"(ldsbase + (unsigned)(ldsoff)) : "memory"); } while (0)
#define PG8_STAGE_B(bufoff, gbase, h) do { _Pragma("unroll") for (int _i = 0; _i < 2; ++_i) PG8_LOAD16((gbase) + (h) * hstepB, voffB[_i], (bufoff) + ldsw + _i * 8192); } while (0)
#define PG8_STAGE_A(bufoff, gbase, h, usenext) do { _Pragma("unroll") for (int _i = 0; _i < 2; ++_i) { unsigned _vo; \
        if constexpr (GATHER) { _vo = (usenext) ? ((h) ? nv1[_i] : nv0[_i]) : ((h) ? cv1[_i] : cv0[_i]); PG8_LOAD16((gbase), _vo, (bufoff) + ldsw + _i * 8192); } \
        else { PG8_LOAD16((gbase) + (h) * hstepA, voffA[_i], (bufoff) + ldsw + _i * 8192); } } } while (0)
#define PG8_LD32(off) __builtin_shufflevector(*(const LAS i32x4*)(lds + (off)), *(const LAS i32x4*)(lds + (off) + 1024), 0, 1, 2, 3, 4, 5, 6, 7)
#define PG8_LDA(dst, b, h) do { _Pragma("unroll") for (int m = 0; m < 4; ++m) { if constexpr (FP8) { dst##8[m] = PG8_LD32(PG8_SA(b, h) + aoff + m * 2048); } else { _Pragma("unroll") for (int k = 0; k < 2; ++k) dst[m][k] = *(const LAS bf16x8*)(lds + PG8_SA(b, h) + aoff + m * 2048 + k * 1024); } } } while (0)
#define PG8_LDB(dst, b, h) do { _Pragma("unroll") for (int n = 0; n < 2; ++n) { if constexpr (FP8) { dst##8[n] = PG8_LD32(PG8_SB(b, h) + boff + n * 2048); } else { _Pragma("unroll") for (int k = 0; k < 2; ++k) dst[n][k] = *(const LAS bf16x8*)(lds + PG8_SB(b, h) + boff + n * 2048 + k * 1024); } } } while (0)
#define PG8_MMA(ai, bj, At, Bt) do { __builtin_amdgcn_s_setprio(1); _Pragma("unroll") for (int m = 0; m < 4; ++m) _Pragma("unroll") for (int n = 0; n < 2; ++n) { \
        if constexpr (FP8) { asm volatile("v_mfma_f32_16x16x128_f8f6f4 %0, %1, %2, %0" : "+v"(acc[ai][bj][m][n]) : "v"(Bt##8[n]), "v"(At##8[m])); }     \
        else { _Pragma("unroll") for (int k = 0; k < 2; ++k) acc[ai][bj][m][n] = __builtin_amdgcn_mfma_f32_16x16x32_bf16(Bt[n][k], At[m][k], acc[ai][bj][m][n], 0, 0, 0); } } \
        __builtin_amdgcn_s_setprio(0); } while (0)
#define PG8_WAIT_V(n) asm volatile("s_waitcnt vmcnt(" #n ")" ::: "memory")
#define PG8_WAIT_L(n) asm volatile("s_waitcnt lgkmcnt(" #n ")" ::: "memory")
#define PG8_BAR __builtin_amdgcn_s_barrier()
#define PG8_SCHED __builtin_amdgcn_sched_barrier(0)
    Unit cur, nxt; int ui = 0;
    (void)S.next(0, cur);
    f32x4 acc[2][2][4][2];
#pragma unroll
    for (int a = 0; a < 2; ++a)
#pragma unroll
        for (int b = 0; b < 2; ++b)
#pragma unroll
            for (int m = 0; m < 4; ++m)
#pragma unroll
                for (int n = 0; n < 2; ++n) acc[a][b][m][n] = (f32x4){0.f, 0.f, 0.f, 0.f};
    bf16x8 At[4][2], B0[2][2], B1[2][2]; i32x8 At8[4], B08[2], B18[2];
    const char* cA = cur.a; const char* cB = cur.b;
    if constexpr (GATHER) { const u32x4 pk = gather_offs(cur, tid, lda_b); cv0[0] = pk.x; cv0[1] = pk.y; cv1[0] = pk.z; cv1[1] = pk.w; }
    PG8_STAGE_B(PG8_SB(0, 0), cB, 0); PG8_SCHED; PG8_STAGE_B(PG8_SB(0, 1), cB, 1); PG8_SCHED; PG8_STAGE_A(PG8_SA(0, 0), cA, 0, false); PG8_SCHED; PG8_STAGE_A(PG8_SA(0, 1), cA, 1, false);
    if (wr == 1) PG8_BAR;
    PG8_WAIT_V(2); PG8_BAR;
    PG8_STAGE_B(PG8_SB(1, 0), cB + kstep, 0); PG8_SCHED; PG8_STAGE_A(PG8_SA(1, 0), cA + kstep, 0, false); PG8_SCHED; PG8_STAGE_B(PG8_SB(1, 1), cB + kstep, 1);
    PG8_WAIT_V(6); PG8_BAR;
    for (;;) {
        int has_next = 0; const char* nA = cA; const char* nB = cB;
        if constexpr (GATHER) { has_next = __builtin_amdgcn_readfirstlane(S.next(ui + 1, nxt) ? 1 : 0); nA = has_next ? nxt.a : cA; nB = has_next ? nxt.b : cB; }
        if constexpr (GATHER) {
            u32x4 pk = (u32x4){cv0[0], cv0[1], cv1[0], cv1[1]}; if (has_next) pk = gather_offs(nxt, tid, lda_b);
            *(LAS u32x4*)(lds + STAGE_BYTES + 1024 + tid * 16) = pk;
        }
#pragma nounroll
        for (int t = 0; t < nt; t += 2) {
            const bool last = (t == nt - 2);
            if constexpr (!GATHER) { if (last) { int uin = ui + 1; asm volatile("" : "+s"(uin)); has_next = __builtin_amdgcn_readfirstlane(S.next(uin, nxt) ? 1 : 0); nA = has_next ? nxt.a : cA; nB = has_next ? nxt.b : cB; } }
            if constexpr (GATHER) { if (last) { const u32x4 pk = *(const LAS u32x4*)(lds + STAGE_BYTES + 1024 + tid * 16); nv0[0] = pk.x; nv0[1] = pk.y; nv1[0] = pk.z; nv1[1] = pk.w; } }
            const char* a1 = cA + (size_t)(t + 1) * kstep;
            const char* a2 = last ? nA : cA + (size_t)(t + 2) * kstep; const char* b2 = last ? nB : cB + (size_t)(t + 2) * kstep;
            const char* a3 = a2 + kstep; const char* b3 = b2 + kstep;
            PG8_LDB(B0, 0, 0); PG8_LDB(B1, 0, 1); PG8_SCHED; PG8_LDA(At, 0, 0); PG8_STAGE_A(PG8_SA(1, 1), a1, 1, false);
            PG8_WAIT_V(8); PG8_WAIT_L(0); PG8_BAR; PG8_MMA(0, 0, At, B0); PG8_MMA(0, 1, At, B1); PG8_BAR; PG8_SCHED;
            PG8_LDA(At, 0, 1); PG8_STAGE_B(PG8_SB(0, 0), b2, 0); PG8_STAGE_B(PG8_SB(0, 1), b2, 1); PG8_STAGE_A(PG8_SA(0, 0), a2, 0, last);
            PG8_WAIT_V(8); PG8_WAIT_L(0); PG8_BAR; PG8_MMA(1, 0, At, B0); PG8_MMA(1, 1, At, B1); PG8_BAR; PG8_SCHED;
            PG8_LDB(B0, 1, 0); PG8_LDB(B1, 1, 1); PG8_SCHED; PG8_LDA(At, 1, 0); PG8_STAGE_A(PG8_SA(0, 1), a2, 1, last);
            PG8_WAIT_V(8); PG8_WAIT_L(0); PG8_BAR; PG8_MMA(0, 0, At, B0); PG8_MMA(0, 1, At, B1); PG8_BAR; PG8_SCHED;
            PG8_LDA(At, 1, 1); PG8_STAGE_B(PG8_SB(1, 0), b3, 0); PG8_STAGE_B(PG8_SB(1, 1), b3, 1); PG8_STAGE_A(PG8_SA(1, 0), a3, 0, last);
            PG8_WAIT_V(8); PG8_WAIT_L(0); PG8_BAR; PG8_MMA(1, 0, At, B0); PG8_MMA(1, 1, At, B1); PG8_BAR; PG8_SCHED;
        }
        if (wr == 0) PG8_BAR;
        if constexpr (FP8) asm volatile("s_nop 15\n\ts_nop 15" ::: "memory");
        E(acc, cur, wr, wc, fr, fq);
        if (!has_next) break;
#pragma unroll
        for (int a = 0; a < 2; ++a)
#pragma unroll
            for (int b = 0; b < 2; ++b)
#pragma unroll
                for (int m = 0; m < 4; ++m)
#pragma unroll
                    for (int n = 0; n < 2; ++n) acc[a][b][m][n] = (f32x4){0.f, 0.f, 0.f, 0.f};
        cur = nxt; cA = nA; cB = nB; ++ui;
        if constexpr (GATHER) {
#pragma unroll
            for (int i = 0; i < 2; ++i) { cv0[i] = nv0[i]; cv1[i] = nv1[i]; }
        }
        if (wr == 1) PG8_BAR;
    }
    PG8_WAIT_V(0);
    PG8_BAR;
#undef PG8_SA
#undef PG8_SB
#undef PG8_LOAD16
#undef PG8_STAGE_A
#undef PG8_STAGE_B
#undef PG8_LDA
#undef PG8_LDB
#undef PG8_LD32
#undef PG8_MMA
#undef PG8_WAIT_V
#undef PG8_WAIT_L
#undef PG8_BAR
#undef PG8_SCHED
}
}
namespace att {
constexpr int NW = 8, QBLK = 32, KVBLK = 64, QB = NW * QBLK;
constexpr int DQK = 192, DV = 128;
constexpr int QS = NQ, KNS = NKV, KRS = DROPE, OS = DM;
constexpr int SHM_V = KVBLK * DV * 2, SHM_K = KVBLK * DQK * 2;
constexpr int LDS_QR = 2 * SHM_V + 2 * SHM_K + NW * 64 * 4;
constexpr int LDS_BYTES = LDS_QR + NW * 4096;
constexpr float SCALE = 0.07216878364870322f;
constexpr float THR = 8.f;
#define KSWZ(row, ch) ((row) * 384 + ((((ch) ^ (((row) >> 1) & 7))) << 4))
#define SBAR() __builtin_amdgcn_sched_barrier(0)
__device__ __forceinline__ int v_st(int k, int c) { const int kk = (k & ~0xC) | ((k & 4) << 1) | ((k & 8) >> 1); return ((kk >> 3) * 4 + (c >> 5)) * 512 + ((kk & 7) * 32 + (c & 31)) * 2; }
__device__ __forceinline__ int v_rd_base(int lane) { return ((lane & 3) << 3) | (((lane >> 2) & 3) << 6) | (((lane >> 4) & 1) << 5) | (((lane >> 5) & 1) << 8); }
constexpr int v_rd_off(int d0, int ks, int half) { return d0 * 512 + ks * 4096 + half * 2048; }
__device__ __forceinline__ int crow(int r, int hi) { return (r & 3) + 8 * (r >> 2) + 4 * hi; }
__device__ __forceinline__ void mask_tile(f32x16& p0, f32x16& p1, int dq) {
    const float NEG = -__builtin_inff();
#pragma unroll
    for (int r = 0; r < 16; ++r) {
        const int c = (r & 3) + 8 * (r >> 2);
        if (dq - c < 0) p0[r] = NEG;
        if (dq - c - 32 < 0) p1[r] = NEG;
    }
}
__device__ __forceinline__ void partialSM(f32x16& p0, f32x16& p1, float& m_reg, float& mn, float& alpha) {
    float pmax = p0[0]; for (int r = 1; r < 16; ++r) pmax = fmaxf(pmax, p0[r]); for (int r = 0; r < 16; ++r) pmax = fmaxf(pmax, p1[r]);
    { auto rr = __builtin_amdgcn_permlane32_swap(__float_as_uint(pmax), __float_as_uint(pmax), false, false);
      pmax = fmaxf(__uint_as_float(rr[0]), __uint_as_float(rr[1])); }
    constexpr float C2 = 1.4426950408889634f * SCALE;
    if (__builtin_expect(__all((pmax - m_reg) * SCALE <= THR), 1)) { mn = m_reg; alpha = 1.f; }
    else { mn = fmaxf(m_reg, pmax); alpha = __builtin_amdgcn_exp2f((m_reg - mn) * C2); m_reg = mn; }
    const float mnL = -mn * C2;
    for (int r = 0; r < 16; ++r) p0[r] = fmaf(p0[r], C2, mnL); for (int r = 0; r < 16; ++r) p1[r] = fmaf(p1[r], C2, mnL);
    for (int r = 0; r < 16; ++r) p0[r] = __builtin_amdgcn_exp2f(p0[r]);
}
__device__ __forceinline__ void finishSM(f32x16& p0, f32x16& p1, float alpha, float& l_reg, bf16x8& pa0, bf16x8& pa1, bf16x8& pa2, bf16x8& pa3) {
    for (int r = 0; r < 16; ++r) p1[r] = __builtin_amdgcn_exp2f(p1[r]);
    float ps = 0; for (int r = 0; r < 16; ++r) ps += p0[r]; for (int r = 0; r < 16; ++r) ps += p1[r];
    { auto rr = __builtin_amdgcn_permlane32_swap(__float_as_uint(ps), __float_as_uint(ps), false, false);
      ps = __uint_as_float(rr[0]) + __uint_as_float(rr[1]); }
    l_reg = l_reg * alpha + ps;
#define PK4(P, B_, OUT) do { unsigned a0 = cvt_pk_bf16(P[B_+0], P[B_+1]), a1 = cvt_pk_bf16(P[B_+2], P[B_+3]);                          \
        unsigned b0 = cvt_pk_bf16(P[B_+4], P[B_+5]), b1 = cvt_pk_bf16(P[B_+6], P[B_+7]);                                             \
        auto r0 = __builtin_amdgcn_permlane32_swap(a0, b0, false, false); auto r1 = __builtin_amdgcn_permlane32_swap(a1, b1, false, false); \
        u32x4 w = {r0[0], r1[0], r0[1], r1[1]}; OUT = *reinterpret_cast<bf16x8*>(&w); } while (0)
    PK4(p0, 0, pa0); PK4(p0, 8, pa1); PK4(p1, 0, pa2); PK4(p1, 8, pa3);
#undef PK4
}
template <int KB>
__device__ __forceinline__ void qkt(f32x16& p0, f32x16& p1, const char* K_lds, int r32, int hi, const bf16x8* qr, const char* qrl) {
    p0 = f32x16{}; p1 = f32x16{};
    const char* kb[4];
#pragma unroll
    for (int dd = 0; dd < 4; ++dd) kb[dd] = K_lds + KB * SHM_K + KSWZ(r32, dd * 2 + hi);
    bf16x8 k0[3], k1[3], qx[4];
#define QK_LDK(d0_, s_) do { const char* a_ = kb[(d0_) & 3] + ((d0_) >> 2) * 128; k0[s_] = *reinterpret_cast<const bf16x8*>(a_); k1[s_] = *reinterpret_cast<const bf16x8*>(a_ + 32 * 384); } while (0)
    QK_LDK(0, 0); QK_LDK(1, 1);
#pragma unroll
    for (int d0 = 0; d0 < 12; ++d0) {
        if (d0 + 2 < 12) QK_LDK(d0 + 2, (d0 + 2) % 3);
        if (d0 >= 4 && d0 < 8) qx[d0 - 4] = *reinterpret_cast<const bf16x8*>(qrl + (d0 - 4) * 1024);
        SBAR();
        const bf16x8 qf = d0 < 8 ? qr[d0 & 7] : qx[(d0 - 8) & 3];
        p0 = __builtin_amdgcn_mfma_f32_32x32x16_bf16(k0[d0 % 3], qf, p0, 0, 0, 0);
        p1 = __builtin_amdgcn_mfma_f32_32x32x16_bf16(k1[d0 % 3], qf, p1, 0, 0, 0);
        SBAR(); }
#undef QK_LDK
}
template <int VB>
__device__ __forceinline__ void pv_tile(f32x16* o, int vb0, bf16x8 pa0, bf16x8 pa1, bf16x8 pa2, bf16x8 pa3) {
#define TRRD(dst, off) asm volatile("ds_read_b64_tr_b16 %0, %1 offset:%2" : "=&v"(dst) : "v"(vb0), "i"(off) : "memory")
#define PV_D0(d0) do { s16x4 l0, l1, l2, l3, h0, h1, h2, h3; constexpr int b_ = VB * SHM_V + v_rd_off(d0, 0, 0); \
        TRRD(l0, b_); TRRD(h0, b_ + 2048); TRRD(l1, b_ + 4096); TRRD(h1, b_ + 6144); TRRD(l2, b_ + 8192); TRRD(h2, b_ + 10240); TRRD(l3, b_ + 12288); TRRD(h3, b_ + 14336); \
        asm volatile("s_waitcnt lgkmcnt(0)" ::: "memory"); SBAR();   \
        o[d0] = __builtin_amdgcn_mfma_f32_32x32x16_bf16(pa0, (bf16x8){l0[0], l0[1], l0[2], l0[3], h0[0], h0[1], h0[2], h0[3]}, o[d0], 0, 0, 0);   \
        o[d0] = __builtin_amdgcn_mfma_f32_32x32x16_bf16(pa1, (bf16x8){l1[0], l1[1], l1[2], l1[3], h1[0], h1[1], h1[2], h1[3]}, o[d0], 0, 0, 0);   \
        o[d0] = __builtin_amdgcn_mfma_f32_32x32x16_bf16(pa2, (bf16x8){l2[0], l2[1], l2[2], l2[3], h2[0], h2[1], h2[2], h2[3]}, o[d0], 0, 0, 0);   \
        o[d0] = __builtin_amdgcn_mfma_f32_32x32x16_bf16(pa3, (bf16x8){l3[0], l3[1], l3[2], l3[3], h3[0], h3[1], h3[2], h3[3]}, o[d0], 0, 0, 0); } while (0)
    PV_D0(0); PV_D0(1); PV_D0(2); PV_D0(3);
#undef PV_D0
#undef TRRD
}
struct BlockRef { const bf16_t* Q; const bf16_t* Kn; const bf16_t* Kr; const bf16_t* V; bf16_t* O; int P0; };
struct Seam { bf16x8 qr[8]; bf16x8 st_v0, st_v1, st_k0, st_k1, st_k2; };
#define VMW() asm volatile("s_waitcnt vmcnt(0)" ::: "memory")
#define VMWN(n) asm volatile("s_waitcnt vmcnt(%0)" :: "i"(n) : "memory")
#define LD8(p) (*reinterpret_cast<const bf16x8*>(p))
#define SLOAD_H(R_, k0) do { S.st_v0 = LD8((R_).V + (size_t)((k0) + sr) * KNS + sc); S.st_v1 = LD8((R_).V + (size_t)((k0) + 32 + sr) * KNS + sc);              \
                             S.st_k0 = LD8((R_).Kn + (size_t)((k0) + sr) * KNS + sc); S.st_k1 = LD8((R_).Kn + (size_t)((k0) + 32 + sr) * KNS + sc);            \
                             S.st_k2 = LD8((R_).Kr + (size_t)((k0) + rr) * KRS + rc); } while (0)
#define SWRITE_HK(bf) do { *(bf16x8*)(K_lds + (bf) * SHM_K + kws) = S.st_k0; *(bf16x8*)(K_lds + (bf) * SHM_K + kws + 32 * 384) = S.st_k1; *(bf16x8*)(K_lds + (bf) * SHM_K + kws2) = S.st_k2; } while (0)
#define SWRITE_HV(bf) do { *(bf16x8*)(V_lds + (bf) * SHM_V + vst0) = S.st_v0; *(bf16x8*)(V_lds + (bf) * SHM_V + vst1) = S.st_v1; } while (0)
#define SWRITE_H(bf) do { SWRITE_HV(bf); SWRITE_HK(bf); } while (0)
#define ATT_IDX const int tid = launder_v((int)threadIdx.x), wid = __builtin_amdgcn_readfirstlane(tid >> 6), lane = tid & 63, r32 = lane & 31, hi = lane >> 5; \
    const int sr = tid >> 4, sc = (tid & 15) * 8, rr = tid >> 3, rc = (tid & 7) * 8, kws = KSWZ(sr, (tid & 15)), kws2 = KSWZ(rr, 16 + (tid & 7));
__device__ __forceinline__ void attn_block(const BlockRef& cur, char* lds) {
    ATT_IDX;
    Seam S;
    const int NT = cur.P0 / KVBLK + QB / KVBLK;
    const int qlo = cur.P0 + wid * QBLK, qm = qlo + r32 - 4 * hi;
    char* V_lds = lds; char* K_lds = lds + 2 * SHM_V;
    float* ws = (float*)(lds + 2 * SHM_V + 2 * SHM_K) + wid * 64; float* li_l = ws, * al_l = ws + 32;
    float m_reg = -1e30f, l_reg = 0; f32x16 o[4] = {};
    const int vst0 = v_st(sr, sc), vst1 = v_st(32 + sr, sc);
    const int vb0 = (int)(uintptr_t)V_lds + v_rd_base(lane);
    char* qrl = lds + LDS_QR + wid * 4096 + lane * 16;
#define RESC(a) do { if (__any((a) < 1.f)) { if (hi == 0) al_l[r32] = (a); asm volatile("s_waitcnt lgkmcnt(0)" ::: "memory");              \
                     for (int d_ = 0; d_ < 4; ++d_) for (int r = 0; r < 16; ++r) o[d_][r] *= al_l[crow(r, hi)]; } } while (0)
#define KBASE(t) ((t) * KVBLK)
#define MASKT(P0_, P1_, t) do { const int kb_ = KBASE(t); if (kb_ + KVBLK - 1 > qlo) mask_tile(P0_, P1_, qm - kb_); } while (0)
    SLOAD_H(cur, 0);
#pragma unroll
    for (int d0 = 0; d0 < 8; ++d0) S.qr[d0] = LD8(cur.Q + (size_t)(wid * QBLK + r32) * QS + d0 * 16 + hi * 8);
    { bf16x8 t0 = LD8(cur.Q + (size_t)(wid * QBLK + r32) * QS + 128 + hi * 8), t1 = LD8(cur.Q + (size_t)(wid * QBLK + r32) * QS + 144 + hi * 8),
             t2 = LD8(cur.Q + (size_t)(wid * QBLK + r32) * QS + 160 + hi * 8), t3 = LD8(cur.Q + (size_t)(wid * QBLK + r32) * QS + 176 + hi * 8);
      *(bf16x8*)(qrl) = t0; *(bf16x8*)(qrl + 1024) = t1; *(bf16x8*)(qrl + 2048) = t2; *(bf16x8*)(qrl + 3072) = t3; }
    VMW(); SWRITE_H(0);
    __syncthreads();
    f32x16 p0, p1; float mn, al; bf16x8 pa0, pa1, pa2, pa3;
#define TILE_STEP(t, BF) do {                                                                                                 \
        if ((t) + 1 < NT) { SLOAD_H(cur, KBASE((t) + 1)); }                                                                    \
        SBAR();                                                                                                               \
        if (KBASE(t) <= qlo + QBLK - 1) {     \
        qkt<BF>(p0, p1, K_lds, r32, hi, S.qr, qrl);                                                                           \
        MASKT(p0, p1, (t)); partialSM(p0, p1, m_reg, mn, al); RESC(al);                                                        \
        finishSM(p0, p1, al, l_reg, pa0, pa1, pa2, pa3); SBAR();                                                              \
        pv_tile<BF>(o, vb0, pa0, pa1, pa2, pa3); }                                                                            \
        if ((t) + 1 < NT) { VMW(); SWRITE_H(1 - BF); }                                                                         \
        __syncthreads(); } while (0)
    for (int t = 0; t < NT; t += 2) { TILE_STEP(t, 0); TILE_STEP(t + 1, 1); }
    if (hi == 0) li_l[r32] = l_reg; asm volatile("s_waitcnt lgkmcnt(0)" ::: "memory");
    float rli[16];
#pragma unroll
    for (int r = 0; r < 16; ++r) rli[r] = __builtin_amdgcn_rcpf(li_l[crow(r, hi)]);
    bf16_t* Ow = cur.O + (size_t)(wid * QBLK) * OS;
#pragma unroll
    for (int r = 0; r < 16; ++r) { const int orow = crow(r, hi);
#pragma unroll
        for (int d0 = 0; d0 < 4; ++d0) { const float v = o[d0][r] * rli[r];
            const float vn = __shfl_xor(v, 1);
            if ((r32 & 1) == 0) *(unsigned*)(Ow + (size_t)orow * OS + d0 * 32 + r32) = cvt_pk_bf16(v, vn); } }
    __syncthreads();
#undef RESC
#undef KBASE
#undef MASKT
#undef TILE_STEP
}
#undef VMW
#undef VMWN
#undef LD8
#undef SLOAD_H
#undef SWRITE_HK
#undef SWRITE_HV
#undef SWRITE_H
#undef ATT_IDX
#undef KSWZ
#undef SBAR

__device__ __forceinline__ BlockRef make_ref(int L, int pass, const bf16_t* Qb, const bf16_t* KNVb, const bf16_t* KRb, bf16_t* Ob) {
    const int bh = L >> 2, x = L & 3, qb = pass ? 7 - x : x, b = bh >> 3, h = bh & 7; const size_t rb = (size_t)b * SEQ;
    BlockRef r; r.Q = Qb + (rb + (size_t)qb * QB) * QS + h * DQH; r.Kn = KNVb + rb * KNS + h * (DNOPE + DVH); r.Kr = KRb + rb * KRS; r.V = KNVb + rb * KNS + h * (DNOPE + DVH) + DNOPE;
    r.O = Ob + (rb + (size_t)qb * QB) * OS + h * DVH; r.P0 = qb * QB; return r;
}
__device__ __forceinline__ void attn_phase(char* lds, const bf16_t* Qb, const bf16_t* KNVb, const bf16_t* KRb, bf16_t* Ob, int first, int stride) {
    constexpr int total = NBATCH * NHEAD * 4;
    for (int L = first; L < total; L += stride) {
        for (int pass = 0; pass < 2; ++pass) { const BlockRef cur = make_ref(L, pass, Qb, KNVb, KRb, Ob); attn_block(cur, lds); }
    }
}
}
constexpr int NWAVES = 8;
constexpr size_t MiB = 1u << 20;
constexpr size_t WS_CTL = 0, CTL_ZERO_BYTES = 8 * MiB;
constexpr size_t WS_SSQ = 1 * MiB;
constexpr size_t WS_COS = 8 * MiB, WS_SIN = 16 * MiB;
constexpr size_t WS_LIST = 24 * MiB;
constexpr size_t WS_RSL = 26 * MiB;
constexpr size_t WS_TOKINFO = 28 * MiB;
constexpr size_t WS_WDN = 30 * MiB, WS_WUQ = 34 * MiB, WS_WUKV = 37 * MiB, WS_WO = 39 * MiB, WS_WPOOL = 43 * MiB, WS_WGU = 44 * MiB, WS_WD = 65 * MiB, WS_MWGU = 76 * MiB, WS_MWD = 164 * MiB;
constexpr size_t WS_H = 208 * MiB;
constexpr size_t WS_ACT = 336 * MiB;
constexpr size_t WS_DOWN = WS_ACT;
constexpr size_t WS_CQN = WS_ACT + 128 * MiB, WS_CKVN = WS_ACT + 192 * MiB, WS_KR = WS_ACT + 224 * MiB, WS_Q = WS_ACT + 232 * MiB, WS_KNV = WS_ACT + 424 * MiB;
constexpr size_t WS_HID = WS_ACT;
constexpr size_t WS_YB = WS_ACT + 358 * MiB;
constexpr size_t WS_DUMMY = WS_ACT + 424 * MiB;
constexpr size_t WS_H8 = WS_ACT + 618 * MiB;
constexpr int FFD8 = 2816;
constexpr int FFE8 = 1536;
constexpr size_t WS_END = WS_ACT + 682 * MiB;
static_assert(WS_MWD + (size_t)16 * 1024 * FFEP * 2 <= WS_H && WS_MWGU + (size_t)16 * 2 * FFEP * 1024 * 2 <= WS_MWD && WS_WD + (size_t)2 * 1024 * FFD * 2 <= WS_MWGU && WS_WGU + (size_t)2 * 2 * FFD * 1024 * 2 <= WS_WD, "weights map");
static_assert(WS_HID + (size_t)PSLOT * FFEP * 2 <= WS_YB && WS_YB + (size_t)PSLOT * 1024 * 2 <= WS_END && WS_HID + (size_t)NTOK * FFD * 2 <= WS_END && WS_KNV + (size_t)NTOK * NKV * 2 <= WS_END && WS_Q + (size_t)NTOK * NQ * 2 <= WS_KNV, "activation map");
static_assert(WS_SSQ + (size_t)14 * NTOK * 8 <= WS_COS && WS_COS <= CTL_ZERO_BYTES + WS_COS && WS_END <= 1024 * MiB, "map");
constexpr int CW_TMO = 0, CW_CODE = 1, CW_CNT = 1024  , CW_DBG = 2048, CW_BAR = 4096  ;
constexpr int LDSCTL_OFF = 0, LDSCTL_BYTES = 1024, MISC_OFF = LDSCTL_OFF + 320, RING_OFF = LDSCTL_BYTES, RING_BYTES = 131072, LDS_BYTES = 147456;

typedef GAS unsigned gu32;
#define RLX_AGENT __ATOMIC_RELAXED, __HIP_MEMORY_SCOPE_AGENT
#define LDS_WAIT() asm volatile("s_waitcnt lgkmcnt(0)" ::: "memory")
#define VM_WAIT() asm volatile("s_waitcnt vmcnt(0)" ::: "memory")

#define XB_TMO      128
#define XB_XCNT(j)  (256  + 64 * (j))
#define XB_XSUB(j)  (1280 + 64 * (j))
#define XB_XGEN(j)  (2304 + 64 * (j))
#define XB_TOP      3328
#define XB_TOPGEN   3392
#define XCD_BAR_WORDS 3456
#define XB_SPIN_CAP (1u << 18)
__device__ __forceinline__ unsigned xb_ld(unsigned* p)              { return __hip_atomic_load(p, __ATOMIC_RELAXED, __HIP_MEMORY_SCOPE_AGENT); }
__device__ __forceinline__ unsigned xb_add(unsigned* p, unsigned v) { return __hip_atomic_fetch_add(p, v, __ATOMIC_RELAXED, __HIP_MEMORY_SCOPE_AGENT); }
__device__ __forceinline__ unsigned xb_xcc_id() { return (unsigned)__builtin_amdgcn_s_getreg((3 << 11) | 20) & 0xFu; }
#define XB_SPIN(cond, bar) do { unsigned _sp = 0; while (cond) { __builtin_amdgcn_s_sleep(1); \
    if ((++_sp & 255u) == 0u) { if (xb_ld(&(bar)[XB_TMO])) break; if (_sp > XB_SPIN_CAP) { atomicAdd(&(bar)[XB_TMO], 1u); break; } } } } while (0)
__device__ __forceinline__ unsigned rfl(unsigned v);
struct XcdBarrier { unsigned* bar; unsigned x; volatile LAS unsigned* st; };
__device__ __forceinline__ XcdBarrier xcd_barrier_post(unsigned* bar, volatile LAS unsigned* st) {
    XcdBarrier b; b.bar = bar; b.x = xb_xcc_id(); b.st = st;
    if (threadIdx.x == 0) (void)xb_add(&bar[XB_XCNT(b.x)], 1u);
    return b;
}
__device__ __forceinline__ void xcd_barrier_complete(unsigned* bar, unsigned x, unsigned& nloc, unsigned& nx) {
    const unsigned G = gridDim.x * gridDim.y * gridDim.z;
    unsigned sum, cnt, mine, sp = 0u;
    for (;;) {
        sum = 0u; cnt = 0u; mine = 0u;
#pragma unroll
        for (unsigned j = 0; j < 16; ++j) { const unsigned c = xb_ld(&bar[XB_XCNT(j)]); sum += c; cnt += (c > 0u) ? 1u : 0u; mine = (j == x) ? c : mine; }
        if (sum == G) break;
        __builtin_amdgcn_s_sleep(1);
        if ((++sp & 255u) == 0u) { if (xb_ld(&bar[XB_TMO])) break; if (sp > XB_SPIN_CAP) { atomicAdd(&bar[XB_TMO], 1u); break; } }
    }
    nloc = mine > 0u ? mine : 1u; nx = cnt > 0u ? cnt : 1u;
}
__device__ __forceinline__ void xcd_barrier(const XcdBarrier& b) {
    unsigned* bar; { const volatile LAS unsigned* p_ = b.st + 2; const unsigned lo_ = rfl(p_[0]), hi_ = rfl(p_[1]); bar = (unsigned*)(((unsigned long long)hi_ << 32) | lo_); }
    asm volatile("s_waitcnt vmcnt(0)" ::: "memory");
    __syncthreads();
    if (threadIdx.x == 0) {
        __builtin_amdgcn_s_waitcnt(0);
        unsigned nloc = b.st[0], nx = b.st[1];
        if (nloc == 0u) { xcd_barrier_complete(bar, b.x, nloc, nx); b.st[0] = nloc; b.st[1] = nx; }
        const unsigned old = xb_add(&bar[XB_XSUB(b.x)], 1u);
        const unsigned gen = old / nloc;
        if (old + 1u == (gen + 1u) * nloc) {
            __builtin_amdgcn_fence(__ATOMIC_RELEASE, "agent");
            asm volatile("s_waitcnt vmcnt(0)" ::: "memory");
            const unsigned og = xb_add(&bar[XB_TOP], 1u);
            const unsigned tg = og / nx;
            if (og + 1u == (tg + 1u) * nx) xb_add(&bar[XB_TOPGEN], 1u);
            else XB_SPIN(xb_ld(&bar[XB_TOPGEN]) == tg, bar);
            __builtin_amdgcn_fence(__ATOMIC_ACQUIRE, "agent");
            xb_add(&bar[XB_XGEN(b.x)], 1u);
            asm volatile("s_waitcnt vmcnt(0)" ::: "memory");
        } else {
            XB_SPIN(xb_ld(&bar[XB_XGEN(b.x)]) == gen, bar);
            __builtin_amdgcn_fence(__ATOMIC_ACQUIRE, "agent");
            asm volatile("s_waitcnt vmcnt(0)" ::: "memory");
        }
    }
    __syncthreads();
}

__device__ __forceinline__ unsigned rfl(unsigned v);
__device__ __forceinline__ const float* ptab(LAS unsigned char* L, int i);
struct Frame { LAS unsigned char* lds; volatile LAS unsigned* MISC; gu32* ctl; unsigned char* ws; int tid, lane, wave, vcu, G, bx; };

__device__ __forceinline__ float wave_sum(float v) {
#pragma unroll
    for (int o = 1; o < 64; o <<= 1) v += __shfl_xor(v, o);
    return v;
}
__device__ __forceinline__ unsigned rfl(unsigned v) { return (unsigned)__builtin_amdgcn_readfirstlane((int)v); }

__device__ __forceinline__ int rowmap(int mode, int n) {
    if (mode == 0) return n;
    if (mode == 1) return (n >> 7) * 256 + (n & 127);
    if (mode == 2) return (n >> 7) * 256 + 128 + (n & 127);
    if (mode == 4) return n < 800 ? n : 896 + (n - 800);
    const int h = n / DQH, d = n - h * DQH;
    if (d < DNOPE) return 512 + h * DNOPE + d;
    if (d < DNOPE + 32) return (h >> 2) * 256 + (h & 3) * 32 + (d - DNOPE);
    return (h >> 2) * 256 + 128 + (h & 3) * 32 + (d - DNOPE - 32);
}
__device__ __forceinline__ void transpose_item(const float* W, int N, bf16_t* WT, int ldd, int mode, const float* kscale, const float* nscale, int item, int lane) {
    const int nblk = N / 64, kb = item / nblk, nb = item % nblk, k0 = 64 * kb, n = 64 * nb + lane;
    const float sn = nscale ? nscale[n] : 1.0f;
    const int ksv = __float_as_int(kscale ? kscale[k0 + lane] : 1.0f);
    const float* wp = W + (size_t)k0 * N + n;
    bf16_t* op = WT + (size_t)rowmap(mode, n) * ldd + k0;
    float w[64];
#pragma unroll
    for (int i = 0; i < 64; ++i) w[i] = __builtin_nontemporal_load(wp + (size_t)i * N);
#pragma unroll
    for (int kg = 0; kg < 8; ++kg) { float v[8];
#pragma unroll
        for (int i = 0; i < 8; ++i) { const float sk = __int_as_float(__builtin_amdgcn_readlane(ksv, 8 * kg + i)); v[i] = w[8 * kg + i] * (sk * sn); }
        u32x4 o; o.x = cvt_pk_bf16(v[0], v[1]); o.y = cvt_pk_bf16(v[2], v[3]); o.z = cvt_pk_bf16(v[4], v[5]); o.w = cvt_pk_bf16(v[6], v[7]);
        *(GAS u32x4*)(op + 8 * kg) = o; }
}
__device__ __forceinline__ void transpose_item_f8(const float* W, int N, unsigned char* WT, int ldd, int mode, const float* kscale, int item, int lane) {
    const int nblk = N / 64, kb = item / nblk, nb = item % nblk, k0 = 64 * kb, n = 64 * nb + lane;
    const int ksv = __float_as_int(kscale ? kscale[k0 + lane] : 1.0f);
    const float* wp = W + (size_t)k0 * N + n;
    unsigned char* op = WT + (size_t)rowmap(mode, n) * ldd + k0;
    float w[64];
#pragma unroll
    for (int i = 0; i < 64; ++i) w[i] = __builtin_nontemporal_load(wp + (size_t)i * N);
#pragma unroll
    for (int kg = 0; kg < 4; ++kg) { float v[16];
#pragma unroll
        for (int i = 0; i < 16; ++i) { const float sk = __int_as_float(__builtin_amdgcn_readlane(ksv, 16 * kg + i)); v[i] = w[16 * kg + i] * (sk * pg8::FP8_SW); }
        u32x4 o; o.x = pg8::pk4_fp8(v[0], v[1], v[2], v[3]); o.y = pg8::pk4_fp8(v[4], v[5], v[6], v[7]); o.z = pg8::pk4_fp8(v[8], v[9], v[10], v[11]); o.w = pg8::pk4_fp8(v[12], v[13], v[14], v[15]);
        *(GAS u32x4*)(op + 16 * kg) = o; }
}
struct MatDesc { const float* src; bf16_t* dst; const float* kscale; const float* nscale; int K, N, ldd, mode, f8; };
constexpr int N_MATS = 70;
__device__ __forceinline__ MatDesc mat_desc(int m, LAS unsigned char* L, unsigned char* ws) {
    MatDesc d; d.kscale = nullptr; d.nscale = nullptr; d.mode = 0; d.f8 = 0;
    if (m < 2)       { const int a = m;      d.src = ptab(L, 4) + (size_t)a * DM * NDOWN;    d.K = DM;   d.N = NDOWN; d.dst = (bf16_t*)(ws + WS_WDN) + (size_t)a * NDOWNP * DM;  d.ldd = DM; d.mode = 4; d.kscale = ptab(L, 2) + (size_t)(2 * a) * DM; }
    else if (m < 4)  { const int a = m - 2;  d.src = ptab(L, 6) + (size_t)a * QLR * NQ;      d.K = QLR;  d.N = NQ;    d.dst = (bf16_t*)(ws + WS_WUQ) + (size_t)a * NQ * QLR;     d.ldd = QLR; d.mode = 3; d.kscale = ptab(L, 5) + (size_t)a * QLR; }
    else if (m < 6)  { const int a = m - 4;  d.src = ptab(L, 8) + (size_t)a * KVLR * NKV;    d.K = KVLR; d.N = NKV;   d.dst = (bf16_t*)(ws + WS_WUKV) + (size_t)a * NKV * KVLR;  d.ldd = KVLR; d.kscale = ptab(L, 7) + (size_t)a * KVLR; }
    else if (m < 8)  { const int a = m - 6;  d.src = ptab(L, 9) + (size_t)a * DM * DM;       d.K = DM;   d.N = DM;    d.dst = (bf16_t*)(ws + WS_WO) + (size_t)a * DM * DM;       d.ldd = DM; }
    else if (m < 16) { const int i = m - 8;  d.src = ptab(L, 10) + (size_t)i * 256 * 256;    d.K = 256;  d.N = 256;   d.dst = (bf16_t*)(ws + WS_WPOOL) + (size_t)i * 256 * 256;  d.ldd = 256; d.nscale = ptab(L, 11) + i * 256; }
    else if (m < 18) { const int a = m - 16; d.src = ptab(L, 12) + (size_t)a * DM * FFD;     d.K = DM;   d.N = FFD;   d.dst = (bf16_t*)(ws + WS_WGU) + (size_t)a * 2 * FFD * DM; d.ldd = DM; d.mode = 1; d.kscale = ptab(L, 3) + (size_t)(2 * a) * DM; }
    else if (m < 20) { const int a = m - 18; d.src = ptab(L, 13) + (size_t)a * DM * FFD;     d.K = DM;   d.N = FFD;   d.dst = (bf16_t*)(ws + WS_WGU) + (size_t)a * 2 * FFD * DM; d.ldd = DM; d.mode = 2; d.kscale = ptab(L, 3) + (size_t)(2 * a) * DM; }
    else if (m < 22) { const int a = m - 20; d.src = ptab(L, 14) + (size_t)a * FFD * DM;     d.K = FFD;  d.N = DM;    d.dst = (bf16_t*)(ws + WS_WD) + (size_t)a * DM * FFD;      d.ldd = FFD; }
    else if (m < 38) { const int i = m - 22; d.src = ptab(L, 16) + (size_t)i * DM * FFE;     d.K = DM;   d.N = FFE;   d.dst = (bf16_t*)(ws + WS_MWGU) + (size_t)i * 2 * FFEP * DM; d.ldd = DM; d.mode = 1; d.kscale = ptab(L, 3) + (size_t)(2 * (i >> 3) + 1) * DM; }
    else if (m < 54) { const int i = m - 38; d.src = ptab(L, 17) + (size_t)i * DM * FFE;     d.K = DM;   d.N = FFE;   d.dst = (bf16_t*)(ws + WS_MWGU) + (size_t)i * 2 * FFEP * DM; d.ldd = DM; d.mode = 2; d.kscale = ptab(L, 3) + (size_t)(2 * (i >> 3) + 1) * DM; }
    else             { const int i = m - 54; d.src = ptab(L, 18) + (size_t)i * FFE * DM;     d.K = FFE;  d.N = DM;    d.dst = (bf16_t*)(ws + WS_MWD) + (size_t)i * DM * FFEP;    d.ldd = FFEP; }
    if (m == 17 || m == 19) { d.f8 = 1; d.dst = (bf16_t*)(ws + WS_WGU + (size_t)2 * FFD * DM * 2); d.ldd = DM; }
    if (m == 21) { d.f8 = 1; d.dst = (bf16_t*)(ws + WS_WD + (size_t)DM * FFD * 2); d.ldd = FFD8; }
    if (m >= 22) {
        const int e = (m - 22) & 7, lpi = ((m - 22) & 15) >> 3; d.f8 = 1;
        if (m < 54) { d.dst = (bf16_t*)(ws + WS_MWGU + (size_t)lpi * 8 * 2 * FFEP * DM * 2 + (size_t)e * 2 * FFEP * DM); d.ldd = DM; }
        else        { d.dst = (bf16_t*)(ws + WS_MWD + (size_t)lpi * 8 * DM * FFEP * 2 + (size_t)e * DM * FFE8); d.ldd = FFE8; } }
    return d;
}
__device__ __forceinline__ void p0_prologue(Frame& F) {
    const int* positions = (const int*)ptab(F.lds, 1);
    const int gw = F.vcu * NWAVES + F.wave, NGW = F.G * NWAVES;
    int cum = 0;
    for (int m = 0; m < N_MATS; ++m) {
        const MatDesc d = mat_desc(m, F.lds, F.ws);
        const int nitems = (d.K / 64) * (d.N / 64);
        int first = gw - (cum % NGW); if (first < 0) first += NGW;
        if (d.f8) { for (int it = first; it < nitems; it += NGW) transpose_item_f8(d.src, d.N, (unsigned char*)d.dst, d.ldd, d.mode, d.kscale, it, F.lane); }
        else { for (int it = first; it < nitems; it += NGW) transpose_item(d.src, d.N, d.dst, d.ldd, d.mode, d.kscale, d.nscale, it, F.lane); }
        cum += nitems;
    }
    const int gt = gw * 64 + F.lane, NGT = NGW * 64; const u32x4 z4 = (u32x4){0u, 0u, 0u, 0u};
    for (int i = gt; i < 2 * 192 * 128; i += NGT) { const int a = i / (192 * 128), r = (i / 128) % 192, c = i % 128; const int row = r < 96 ? 800 + r : 928 + (r - 96); *(GAS u32x4*)((bf16_t*)(F.ws + WS_WDN) + (size_t)a * NDOWNP * DM + (size_t)row * DM + c * 8) = z4; }
    for (int i = gt; i < 1024 * 8; i += NGT) { const int row = i / 8, c = i % 8; *(GAS u32x4*)(F.ws + WS_WD + (size_t)DM * FFD * 2 + (size_t)row * FFD8 + FFD + c * 16) = z4; }
    for (int i = gt; i < 16 * 128 * 64; i += NGT) { const int lpi = i / (8 * 128 * 64), e = (i / (128 * 64)) & 7, r = (i / 64) % 128, c = i % 64; const int row = 2560 + (r < 64 ? 64 + r : 192 + (r - 64));
        *(GAS u32x4*)(F.ws + WS_MWGU + (size_t)lpi * 8 * 2 * FFEP * DM * 2 + (size_t)e * 2 * FFEP * DM + (size_t)row * DM + c * 16) = z4; }
    for (int i = gt; i < 16 * 1024 * 12; i += NGT) { const int lpi = i / (8 * 1024 * 12), row = (i / 12) % (8 * 1024), c = i % 12; *(GAS u32x4*)(F.ws + WS_MWD + (size_t)lpi * 8 * DM * FFEP * 2 + (size_t)row * FFE8 + FFE + c * 16) = z4; }
    float* cosT = (float*)(F.ws + WS_COS); float* sinT = (float*)(F.ws + WS_SIN);
    { const float inv = powf(10000.0f, -(float)(2 * (gt & 31)) / 64.0f);
      for (int i = gt; i < NTOK * 32; i += NGT) { const float ang = (float)positions[i >> 5] * inv; float sn, cs; sincosf(ang, &sn, &cs); cosT[i] = cs; sinT[i] = sn; } }
    const float* x = ptab(F.lds, 0); bf16_t* H = (bf16_t*)(F.ws + WS_H); ssq_t* ssq0 = (ssq_t*)(F.ws + WS_SSQ);
    for (int m0 = gw * 4; m0 < NTOK; m0 += NGW * 4) {
        f32x4 v[4][4];
#pragma unroll
        for (int r = 0; r < 4; ++r) { const GAS f32x4* xr = (const GAS f32x4*)(x + (size_t)(m0 + r) * DM) + F.lane;
#pragma unroll
            for (int j = 0; j < 4; ++j) v[r][j] = xr[64 * j]; }
#pragma unroll
        for (int r = 0; r < 4; ++r) { GAS u32x2* o8 = (GAS u32x2*)(H + (size_t)(m0 + r) * DM) + F.lane; float s = 0.f;
#pragma unroll
            for (int j = 0; j < 4; ++j) { const f32x4 t = v[r][j]; s += (t.x * t.x + t.y * t.y) + (t.z * t.z + t.w * t.w); u32x2 w; w.x = cvt_pk_bf16(t.x, t.y); w.y = cvt_pk_bf16(t.z, t.w); o8[64 * j] = w; }
            s = wave_sum(s); if (F.lane == 0) ssq0[m0 + r] = ssq_fix(s); }
    }
}

template <bool FINAL>
__device__ __forceinline__ void combine_phase(Frame& F, const bf16_t* H, bf16_t* Hout, const bf16_t* YB, const unsigned* tokinfo, const unsigned* cntw, ssq_t* ssq_next, const float* gain, float* outF) {
    const int gw = F.vcu * NWAVES + F.wave, NGW = F.G * NWAVES;
    f32x4 g[4];
    if constexpr (FINAL) {
#pragma unroll
        for (int j = 0; j < 4; ++j) g[j] = *(const f32x4*)(gain + F.lane * 4 + 256 * j);
    }
    unsigned nb[8];
#pragma unroll
    for (int e = 0; e < 8; ++e) nb[e] = (rfl(__hip_atomic_load((unsigned*)cntw + 64 * e, RLX_AGENT)) + 255u) >> 8;
    for (int m0 = gw * 2; m0 < NTOK; m0 += NGW * 2) {
        u32x4 t0[2], t1[2];
#pragma unroll
        for (int r = 0; r < 2; ++r) { t0[r] = *(const u32x4*)(tokinfo + (size_t)(m0 + r) * 8); t1[r] = *(const u32x4*)(tokinfo + (size_t)(m0 + r) * 8 + 4); }
        u32x2 hh[2][4], ya[2][4], yb[2][4]; float g0[2], g1[2];
#pragma unroll
        for (int r = 0; r < 2; ++r) {
            const unsigned e0 = rfl(t0[r].x), r0 = rfl(t0[r].y), e1 = rfl(t1[r].x), r1 = rfl(t1[r].y); g0[r] = __uint_as_float(rfl(t0[r].z)); g1[r] = __uint_as_float(rfl(t1[r].z));
            unsigned b0 = 0u, b1 = 0u;
#pragma unroll
            for (int e = 0; e < 8; ++e) { b0 += ((unsigned)e < e0) ? nb[e] : 0u; b1 += ((unsigned)e < e1) ? nb[e] : 0u; }
            const GAS u32x2* hr = (const GAS u32x2*)(H + (size_t)(m0 + r) * DM) + F.lane;
            const GAS u32x2* y0 = (const GAS u32x2*)(YB + ((size_t)b0 * 256 + r0) * DM) + F.lane; const GAS u32x2* y1 = (const GAS u32x2*)(YB + ((size_t)b1 * 256 + r1) * DM) + F.lane;
#pragma unroll
            for (int j = 0; j < 4; ++j) { hh[r][j] = hr[64 * j]; ya[r][j] = __builtin_nontemporal_load(y0 + 64 * j); yb[r][j] = __builtin_nontemporal_load(y1 + 64 * j); }
        }
#pragma unroll
        for (int r = 0; r < 2; ++r) { const int m = m0 + r;
            f32x4 v[4]; float s = 0.f;
#pragma unroll
            for (int j = 0; j < 4; ++j) { const u32x2 h2 = hh[r][j], a = ya[r][j], b = yb[r][j];
                v[j].x = bflo(h2.x) + g0[r] * bflo(a.x) + g1[r] * bflo(b.x); v[j].y = bfhi(h2.x) + g0[r] * bfhi(a.x) + g1[r] * bfhi(b.x); v[j].z = bflo(h2.y) + g0[r] * bflo(a.y) + g1[r] * bflo(b.y); v[j].w = bfhi(h2.y) + g0[r] * bfhi(a.y) + g1[r] * bfhi(b.y);
                s += (v[j].x * v[j].x + v[j].y * v[j].y) + (v[j].z * v[j].z + v[j].w * v[j].w); }
            s = wave_sum(s);
            if constexpr (FINAL) { const float rstd = rstd_f(s); GAS f32x4* ho = (GAS f32x4*)(outF + (size_t)m * DM) + F.lane;
#pragma unroll
                for (int j = 0; j < 4; ++j) ho[64 * j] = v[j] * rstd * g[j];
            } else { GAS u32x2* hw = (GAS u32x2*)(Hout + (size_t)m * DM) + F.lane;
#pragma unroll
                for (int j = 0; j < 4; ++j) { u32x2 w; w.x = cvt_pk_bf16(v[j].x, v[j].y); w.y = cvt_pk_bf16(v[j].z, v[j].w); hw[64 * j] = w; }
                if (F.lane == 0) ssq_next[m] = ssq_fix(s); }
        }
    }
}
__device__ __forceinline__ void mid_phase(Frame& F, const bf16_t* DOWN, const float* qn, const float* kvn, const float* cosT, const float* sinT, bf16_t* CQN, bf16_t* CKVN, bf16_t* KR) {
    const int gw = F.vcu * NWAVES + F.wave, NGW = F.G * NWAVES, lane = F.lane;
    const f32x4 q0 = *(const f32x4*)(qn + lane * 8), q1 = *(const f32x4*)(qn + lane * 8 + 4), k0 = *(const f32x4*)(kvn + lane * 4);
    for (int m = gw; m < NTOK; m += NGW) {
        const bf16_t* dr = DOWN + (size_t)m * NDOWNP;
        const u32x4 cq = *(const GAS u32x4*)(dr + lane * 8); const u32x2 ck = *(const GAS u32x2*)(dr + QLR + lane * 4);
        const float x1 = bf2f(dr[QLR + KVLR + (lane & 31)]), x2 = bf2f(dr[QLR + KVLR + 32 + (lane & 31)]);
        const f32x4 a0 = (f32x4){bflo(cq.x), bfhi(cq.x), bflo(cq.y), bfhi(cq.y)}, a1 = (f32x4){bflo(cq.z), bfhi(cq.z), bflo(cq.w), bfhi(cq.w)}, c0 = (f32x4){bflo(ck.x), bfhi(ck.x), bflo(ck.y), bfhi(ck.y)};
        const float sq = wave_sum((a0.x * a0.x + a0.y * a0.y) + (a0.z * a0.z + a0.w * a0.w) + (a1.x * a1.x + a1.y * a1.y) + (a1.z * a1.z + a1.w * a1.w));
        const float sk = wave_sum((c0.x * c0.x + c0.y * c0.y) + (c0.z * c0.z + c0.w * c0.w));
        const float rq = 1.0f / sqrtf(sq * (1.0f / QLR) + RMS_EPS), rk = 1.0f / sqrtf(sk * (1.0f / KVLR) + RMS_EPS);
        const f32x4 y0 = a0 * rq * q0, y1 = a1 * rq * q1, z0 = c0 * rk * k0;
        u32x4 w; w.x = cvt_pk_bf16(y0.x, y0.y); w.y = cvt_pk_bf16(y0.z, y0.w); w.z = cvt_pk_bf16(y1.x, y1.y); w.w = cvt_pk_bf16(y1.z, y1.w);
        *(GAS u32x4*)(CQN + (size_t)m * QLR + lane * 8) = w;
        u32x2 w2; w2.x = cvt_pk_bf16(z0.x, z0.y); w2.y = cvt_pk_bf16(z0.z, z0.w);
        *(GAS u32x2*)(CKVN + (size_t)m * KVLR + lane * 4) = w2;
        const float c = cosT[(size_t)m * 32 + (lane & 31)], s = sinT[(size_t)m * 32 + (lane & 31)];
        const float o = lane < 32 ? x1 * c - x2 * s : x2 * c + x1 * s;
        KR[(size_t)m * DROPE + lane] = (bf16_t)(cvt_pk_bf16(o, o) & 0xffffu);
    }
}
template <int W>
__device__ __forceinline__ void pool_walk(const bf16_t* h, const ssq_t* ssq, const f32x2 g2, bf16_t* Z, size_t rowbase, int t_start, int c0, int nrows, int col) {
    f32x2 ring[W]; f32x2 sum = (f32x2){0.f, 0.f};
#pragma unroll
    for (int j = 0; j < W; ++j) ring[j] = (f32x2){0.f, 0.f};
    unsigned xa[16], xb[16]; ssq_t qa[16], qb[16];
#define PW_LOAD(X, Q, r_) do { _Pragma("unroll") for (int j = 0; j < 16; ++j) { const size_t row = rowbase + t_start + (r_) + j; X[j] = *(const GAS unsigned*)(h + row * DM + col); Q[j] = ssq[row]; } } while (0)
#define PW_PROC(X, Q, r_) do { _Pragma("unroll") for (int j = 0; j < 16; ++j) { const int t = t_start + (r_) + j; const size_t row = rowbase + t; \
            const f32x2 v = (f32x2){bflo(X[j]), bfhi(X[j])} * rstd_of(Q[j]) * g2; \
            sum = sum + (v - ring[j % W]); ring[j % W] = v; \
            if (t >= c0) { const float inv = 1.0f / (float)(t + 1 < W ? t + 1 : W); const f32x2 z = sum * inv - v; *(GAS unsigned*)(Z + row * DM + col) = cvt_pk_bf16(z.x, z.y); } } } while (0)
    PW_LOAD(xa, qa, 0);
    for (int r = 0; r < nrows; r += 32) {
        if (r + 16 < nrows) PW_LOAD(xb, qb, r + 16);
        PW_PROC(xa, qa, r);
        if (r + 32 < nrows) PW_LOAD(xa, qa, r + 32);
        if (r + 16 < nrows) PW_PROC(xb, qb, r + 16);
    }
#undef PW_LOAD
#undef PW_PROC
}
__device__ __forceinline__ void pool_phase(Frame& F, const bf16_t* h, const ssq_t* ssq, const float* gain, bf16_t* Z) {
    const int col = F.tid * 2; const f32x2 g2 = *(const f32x2*)(gain + col);
    for (int chunk = F.vcu; chunk < NBATCH * 16; chunk += F.G) {
        const int b = chunk >> 4, c0 = (chunk & 15) * 128, t_start = c0 ? c0 - 16 : 0, nrows = c0 + 128 - t_start; const size_t rowbase = (size_t)b * SEQ;
        const int grp = F.wave >> 1;
        if (grp == 0) pool_walk<2>(h, ssq, g2, Z, rowbase, t_start, c0, nrows, col);
        else if (grp == 1) pool_walk<4>(h, ssq, g2, Z, rowbase, t_start, c0, nrows, col);
        else if (grp == 2) pool_walk<8>(h, ssq, g2, Z, rowbase, t_start, c0, nrows, col);
        else pool_walk<16>(h, ssq, g2, Z, rowbase, t_start, c0, nrows, col);
    }
}
template <bool WRITE_H8>
__device__ __forceinline__ void router_phase(Frame& F, const bf16_t* h, const ssq_t* ssq, const float* gain, const float* router, int* list, float* rsl, unsigned* tokinfo, unsigned* cntw, unsigned char* H8) {
    LAS float* rt = (LAS float*)(F.lds + RING_OFF);
    LAS int* esel = (LAS int*)(F.lds + RING_OFF + 32768);
    LAS int* wt = (LAS int*)(F.lds + RING_OFF + 32768 + 2048);
    LAS int* base = (LAS int*)(F.lds + RING_OFF + 32768 + 2048 + 256);
    LAS float* rsd = (LAS float*)(F.lds + RING_OFF + 32768 + 2048 + 512);
    const int lane = F.lane;
    for (int idx = F.tid; idx < DM * NEXP; idx += NWAVES * 64) rt[(idx & 7) * DM + (idx >> 3)] = router[idx];
    f32x4 g[4];
#pragma unroll
    for (int j = 0; j < 4; ++j) g[j] = *(const f32x4*)(gain + lane * 4 + 256 * j);
    for (int chunk = F.vcu; chunk < NTOK / 256; chunk += F.G) {
        const int T0 = chunk * 256;
        __syncthreads();
        u32x2 nx[4][4]; ssq_t nq[4];
#pragma unroll
        for (int p = 0; p < 4; ++p) { const GAS u32x2* xr = (const GAS u32x2*)(h + (size_t)(T0 + F.wave * 32 + p) * DM) + lane;
#pragma unroll
          for (int j = 0; j < 4; ++j) nx[p][j] = xr[64 * j];
          nq[p] = ssq[T0 + F.wave * 32 + p]; }
        for (int i4 = 0; i4 < 32; i4 += 4) {
            const int tl0 = F.wave * 32 + i4, m0 = T0 + tl0;
            f32x4 v[4][4]; float rstd[4];
#pragma unroll
            for (int p = 0; p < 4; ++p) { rstd[p] = rstd_of(nq[p]);
#pragma unroll
                for (int j = 0; j < 4; ++j) { const u32x2 w = nx[p][j]; f32x4 xn = (f32x4){bflo(w.x), bfhi(w.x), bflo(w.y), bfhi(w.y)} * rstd[p];
                    if constexpr (WRITE_H8) { const f32x4 q = xn * pg8::FP8_SA; *(GAS unsigned*)(H8 + (size_t)(m0 + p) * DM + lane * 4 + 256 * j) = pg8::pk4_fp8(q.x, q.y, q.z, q.w); }
                    v[p][j] = xn * g[j]; } }
            if (i4 + 4 < 32) {
#pragma unroll
                for (int p = 0; p < 4; ++p) { const GAS u32x2* xr = (const GAS u32x2*)(h + (size_t)(m0 + 4 + p) * DM) + lane;
#pragma unroll
                    for (int j = 0; j < 4; ++j) nx[p][j] = xr[64 * j];
                    nq[p] = ssq[m0 + 4 + p]; } }
            float a[32];
#pragma unroll
            for (int e = 0; e < 8; ++e) {
#pragma unroll
                for (int p = 0; p < 4; ++p) a[8 * p + e] = 0.f;
#pragma unroll
                for (int j = 0; j < 4; ++j) { const f32x4 r4 = *(const LAS f32x4*)(rt + e * DM + lane * 4 + 256 * j);
#pragma unroll
                    for (int p = 0; p < 4; ++p) a[8 * p + e] += (v[p][j].x * r4.x + v[p][j].y * r4.y) + (v[p][j].z * r4.z + v[p][j].w * r4.w); } }
#define RSTEP(N, LM) _Pragma("unroll") for (int k = 0; k < (N); ++k) { const bool up = (lane & (LM)) != 0; const float send = up ? a[k] : a[k + (N)], keep = up ? a[k + (N)] : a[k]; a[k] = keep + __shfl_xor(send, (LM)); }
            RSTEP(16, 32) RSTEP(8, 16) RSTEP(4, 8) RSTEP(2, 4) RSTEP(1, 2)
#undef RSTEP
            const float tot = a[0] + __shfl_xor(a[0], 1);
#pragma unroll
            for (int p = 0; p < 4; ++p) {
                float lg[8];
#pragma unroll
                for (int e = 0; e < 8; ++e) lg[e] = __int_as_float(__builtin_amdgcn_readlane(__float_as_int(tot), 2 * (8 * p + e)));
                int e0 = 0; float l0 = lg[0];
#pragma unroll
                for (int e = 1; e < 8; ++e) if (lg[e] > l0) { l0 = lg[e]; e0 = e; }
                int e1 = e0 == 0 ? 1 : 0; float l1 = lg[e0 == 0 ? 1 : 0];
#pragma unroll
                for (int e = 0; e < 8; ++e) if (e != e0 && lg[e] > l1) { l1 = lg[e]; e1 = e; }
                const float g0 = 1.0f / (1.0f + __expf(l1 - l0)), g1 = 1.0f - g0;
                if (lane == 0) { const int tl = tl0 + p; esel[2 * tl] = e0; esel[2 * tl + 1] = e1; rsd[tl] = rstd[p]; unsigned* ti = tokinfo + (size_t)(m0 + p) * 8;
                    ti[0] = (unsigned)e0; ti[2] = __float_as_uint(g0); ti[4] = (unsigned)e1; ti[6] = __float_as_uint(g1); }
            }
        }
        __syncthreads();
        const int me = esel[F.tid]; int myrank = 0;
#pragma unroll
        for (int e = 0; e < 8; ++e) { const unsigned long long mask = __ballot(me == e); if (me == e) myrank = __popcll(mask & ((1ull << lane) - 1ull)); if (lane == 0) wt[F.wave * 8 + e] = __popcll(mask); }
        __syncthreads();
        int off = 0;
        for (int w = 0; w < F.wave; ++w) off += wt[w * 8 + me];
        if (F.tid < 8) { int tot = 0; for (int w = 0; w < 8; ++w) tot += wt[w * 8 + F.tid]; base[F.tid] = (int)__hip_atomic_fetch_add(cntw + 64 * F.tid, (unsigned)tot, RLX_AGENT); }
        __syncthreads();
        const int rank = base[me] + off + myrank, tok = T0 + (F.tid >> 1);
        list[(size_t)me * NTOK + rank] = tok; rsl[(size_t)me * NTOK + rank] = rsd[F.tid >> 1];
        tokinfo[(size_t)tok * 8 + (F.tid & 1) * 4 + 1] = (unsigned)rank;
    }
}
template <bool GATHER, bool FP8 = false>
struct MoeOrder {
    static constexpr size_t A_BLK = GATHER ? 0 : (FP8 ? (size_t)256 * FFE8 : (size_t)256 * FFEP * 2), B_EXP = GATHER ? (FP8 ? (size_t)2 * FFEP * DM : (size_t)2 * FFEP * DM * 2) : (FP8 ? (size_t)DM * FFE8 : (size_t)DM * FFEP * 2),
                            B_TILE = GATHER ? (FP8 ? (size_t)256 * DM : (size_t)256 * DM * 2) : (FP8 ? (size_t)256 * FFE8 : (size_t)256 * FFEP * 2);
    static constexpr int NT = GATHER ? 2 * FFEP / 256 : DM / 256;
    const char* A; const char* B; const int* list; const unsigned* cntw; int G, c, rev; unsigned bs[9];
    __device__ __forceinline__ void init(const unsigned* cntw_, const void* A_, const void* B_, const int* list_, int G_, int c_) {
        A = (const char*)A_; B = (const char*)B_; list = list_; cntw = cntw_; G = G_; c = c_; rev = 0; bs[0] = 0u;
#pragma unroll
        for (int e = 0; e < 8; ++e) { const unsigned ce = rfl(__hip_atomic_load((unsigned*)cntw + 64 * e, RLX_AGENT)); bs[e + 1] = bs[e] + ((ce + 255u) >> 8); }
    }
    __device__ __forceinline__ bool next(int i, pg8::Unit& u) const {
        unsigned blk; int pn;
        if ((G & 7) == 0) {
            const int x = c & 7, cl = c >> 3, q = (int)bs[8] >> 3, r = (int)bs[8] & 7, nbx = q + (x < r ? 1 : 0), b0 = x * q + (x < r ? x : r);
            int U = i * (G >> 3) + cl; const int nwx = nbx * NT; if (U >= nwx) return false;
            if (rev) U = nwx - 1 - U;
            const int nig = pg8::WGM * NT, gid = U / nig, fm = gid * pg8::WGM, gsz = (nbx - fm) < pg8::WGM ? (nbx - fm) : pg8::WGM;
            blk = (unsigned)(b0 + fm + (U % nig) % gsz); pn = (U % nig) / gsz;
        } else {
            long L = (long)i * G + c; if (L >= (long)bs[8] * NT) return false;
            if (rev) L = (long)bs[8] * NT - 1 - L;
            blk = (unsigned)(L / NT); pn = (int)(L % NT);
        }
        unsigned e = 0u, st = 0u;
#pragma unroll
        for (int k = 1; k < 8; ++k) if (blk >= bs[k]) { e = (unsigned)k; st = bs[k]; }
        const unsigned j = blk - st;
        u.b = B + (size_t)e * B_EXP + (size_t)pn * B_TILE; u.orow = (int)(blk * 256u); u.pn = pn; u.aux = (int)e;
        if constexpr (GATHER) { const unsigned ce = rfl(__hip_atomic_load((unsigned*)cntw + 64 * e, RLX_AGENT));
            u.a = A; u.rows = list + (size_t)e * NTOK + (size_t)j * 256; const unsigned rem = ce - j * 256u; u.nrows = rem < 256u ? (int)rem : 256; }
        else { u.a = A + (size_t)blk * A_BLK; u.rows = nullptr; u.nrows = 256; }
        return true;
    }
};
constexpr int NPHASE = 27;
struct Args { const float* in[20]; float* out; unsigned char* ws; int ph_lo, ph_hi, li, pad; };
#ifndef MK_REP_MASK
#define MK_REP_MASK 0
#endif
#ifndef MK_REP_N
#define MK_REP_N 1
#endif
#ifndef MK_REV
#define MK_REV 1
#endif
#ifndef MK_STAG_BF
#define MK_STAG_BF 0u
#define MK_STAG_F8 0u
#endif
constexpr int PT_OFF = LDSCTL_OFF + 512;
__device__ __forceinline__ unsigned long long ptab_u64(LAS unsigned char* L, int i) {
    const volatile LAS unsigned* p = (const volatile LAS unsigned*)(L + PT_OFF + 8 * i); const unsigned lo = rfl(p[0]), hi = rfl(p[1]); return ((unsigned long long)hi << 32) | lo; }
__device__ __forceinline__ const float* ptab(LAS unsigned char* L, int i) { return (const float*)(GAS const float*)ptab_u64(L, i); }
__device__ __forceinline__ Frame make_frame(LAS unsigned char* L) {
    asm volatile("" : "+s"(L));
    Frame F; F.lds = L; F.MISC = (volatile LAS unsigned*)(L + MISC_OFF); F.tid = launder_v((int)threadIdx.x); F.lane = F.tid & 63; F.wave = __builtin_amdgcn_readfirstlane(F.tid >> 6);
    { int g_ = gridDim.x, bx = blockIdx.x; asm volatile("" : "+s"(g_), "+s"(bx)); F.G = g_; F.bx = bx;
      F.vcu = (F.G % 8 == 0) ? (bx % 8) * (F.G / 8) + bx / 8 : bx; }
    F.ws = (unsigned char*)(GAS unsigned char*)ptab_u64(L, 21); F.ctl = (gu32*)(F.ws + WS_CTL); return F;
}
__global__ void __launch_bounds__(NWAVES * 64, 2) fwd(Args args) {
    extern __shared__ __attribute__((aligned(16))) unsigned char lds[];
    LAS unsigned char* L = (LAS unsigned char*)lds;
    { const int tid = threadIdx.x;
      for (int u = tid; u < LDSCTL_BYTES / 4; u += NWAVES * 64) ((LAS unsigned*)(L + LDSCTL_OFF))[u] = 0u;
      __syncthreads();
      if (tid < 20) *(LAS unsigned long long*)(L + PT_OFF + 8 * tid) = (unsigned long long)args.in[tid];
      if (tid == 20) *(LAS unsigned long long*)(L + PT_OFF + 8 * 20) = (unsigned long long)args.out;
      if (tid == 21) *(LAS unsigned long long*)(L + PT_OFF + 8 * 21) = (unsigned long long)args.ws;
      if (tid == 22) *(LAS unsigned long long*)(L + PT_OFF + 8 * 22) = (unsigned long long)args.pad;
      __syncthreads(); }
    const int lo = args.ph_lo, hi = args.ph_hi;
    XcdBarrier bar; { gu32* ctl = (gu32*)(args.ws + WS_CTL); bar.bar = (unsigned*)(ctl + CW_BAR) + args.li * XCD_BAR_WORDS; bar.x = 0; bar.st = nullptr;
      if (threadIdx.x == 0) { const unsigned long long ba = (unsigned long long)((unsigned*)(ctl + CW_BAR) + args.li * XCD_BAR_WORDS); ((volatile LAS unsigned*)(L + MISC_OFF))[10] = (unsigned)ba; ((volatile LAS unsigned*)(L + MISC_OFF))[11] = (unsigned)(ba >> 32); }
      if (hi - lo > 1) bar = xcd_barrier_post((unsigned*)(ctl + CW_BAR) + args.li * XCD_BAR_WORDS, (volatile LAS unsigned*)(L + MISC_OFF) + 8);
      __syncthreads(); }
#ifndef MK_ONLY
#define MK_ONLY (-1)
#endif
#define KIND(k) ((k) == 0 ? 0 : 1 + ((k) - 1) % 13)
#ifndef MK_SKIPMASK
#define MK_SKIPMASK 0
#endif
#define IN(k) ((MK_ONLY < 0 || KIND(k) == MK_ONLY) && !((MK_SKIPMASK >> KIND(k)) & 1) && lo <= (k) && (k) < hi)
#define FORREP(k)
#if MK_REP_MASK
#define LASTREP (ptab_u64(F.lds, 22) == 0ull)
#else
#define LASTREP true
#endif
#ifdef MK_DOUBLE_BAR
#define SEAM(k) do { if ((k) + 1 < hi) { xcd_barrier(bar); xcd_barrier(bar); } } while (0)
#else
#define SEAM(k) do { if ((k) + 1 < hi) xcd_barrier(bar); } while (0)
#endif
#define WSP(off) ((bf16_t*)(F.ws + (off)))
#define SSQ(i) ((ssq_t*)(F.ws + WS_SSQ) + (size_t)(i) * NTOK)
    LAS unsigned char* ring = L + RING_OFF;

    if (IN(0)) FORREP(0) { Frame F = make_frame(L); p0_prologue(F); SEAM(0); }

    for (int lp = 0; lp < 2; ++lp) {
        const int pb = 1 + 13 * lp;
        if (IN(pb + 0)) FORREP(pb + 0) { Frame F = make_frame(L);
            pg8::RegOrder S; S.init(WSP(WS_H), DM * 2, WSP(WS_WDN) + (size_t)lp * NDOWNP * DM, DM * 2, NTOK, NDOWNP, F.G, F.bx);
            pg8::EpiDown E{WSP(WS_DOWN), WSP(WS_KR), SSQ(4 * lp + 0), LASTREP ? SSQ(10 + 2 * lp) : SSQ(9), LASTREP ? SSQ(11 + 2 * lp) : SSQ(9), (const float*)(F.ws + WS_COS), (const float*)(F.ws + WS_SIN)};
            pg8::gemm_phase<pg8::EpiDown, pg8::RegOrder, false>(ring, DM * 2, DM * 2, DM * 2, S, E);
            SEAM(pb + 0);
        }
        if (IN(pb + 1)) FORREP(pb + 1) { Frame F = make_frame(L);
            pg8::RegOrder S; S.init(WSP(WS_DOWN), NDOWNP * 2, WSP(WS_WUQ) + (size_t)lp * NQ * QLR, QLR * 2, NTOK, NQ, F.G, F.bx);
            pg8::EpiQ E{WSP(WS_Q), (const float*)(F.ws + WS_COS), (const float*)(F.ws + WS_SIN), SSQ(10 + 2 * lp)};
            pg8::gemm_phase<pg8::EpiQ, pg8::RegOrder, false>(ring, NDOWNP * 2, QLR * 2, QLR * 2, S, E);
            SEAM(pb + 1);
        }
        if (IN(pb + 2)) FORREP(pb + 2) { Frame F = make_frame(L);
            pg8::RegOrder S; S.init(WSP(WS_DOWN) + QLR, NDOWNP * 2, WSP(WS_WUKV) + (size_t)lp * NKV * KVLR, KVLR * 2, NTOK, NKV, F.G, F.bx);
            pg8::EpiBf16<2> E{WSP(WS_KNV), NKV, SSQ(11 + 2 * lp)};
            pg8::gemm_phase<pg8::EpiBf16<2>, pg8::RegOrder, false>(ring, NDOWNP * 2, KVLR * 2, KVLR * 2, S, E);
            SEAM(pb + 2);
        }
        if (IN(pb + 3)) FORREP(pb + 3) { Frame F = make_frame(L); att::attn_phase((char*)lds + RING_OFF, WSP(WS_Q), WSP(WS_KNV), WSP(WS_KR), WSP(WS_DOWN), F.vcu, F.G); SEAM(pb + 3); }
        if (IN(pb + 4) && lp == 0) FORREP(pb + 4) { Frame F = make_frame(L);
            pg8::RegOrder S; S.init(WSP(WS_DOWN), DM * 2, WSP(WS_WO) + (size_t)lp * DM * DM, DM * 2, NTOK, DM, F.G, F.bx);
            pg8::EpiResidH<false> E{WSP(WS_H), LASTREP ? WSP(WS_H) : WSP(WS_DUMMY), LASTREP ? SSQ(4 * lp + 1) : SSQ(9), nullptr, 1.0f};
            pg8::gemm_phase<pg8::EpiResidH<false>, pg8::RegOrder, false>(ring, DM * 2, DM * 2, DM * 2, S, E);
            SEAM(pb + 4);
        }
        if (IN(pb + 4) && lp == 1) FORREP(pb + 4) { Frame F = make_frame(L);
            pg8::RegOrder S; S.init(WSP(WS_DOWN), DM * 2, WSP(WS_WO) + (size_t)lp * DM * DM, DM * 2, NTOK, DM, F.G, F.bx);
            pg8::EpiResidH<true> E{WSP(WS_H), LASTREP ? WSP(WS_H) : WSP(WS_DUMMY), LASTREP ? SSQ(4 * lp + 1) : SSQ(9), F.ws + WS_H8, 1.0f};
            pg8::gemm_phase<pg8::EpiResidH<true>, pg8::RegOrder, false>(ring, DM * 2, DM * 2, DM * 2, S, E);
            SEAM(pb + 4);
        }
#if defined(MK_EPI_PROBE)
        if (IN(pb + 5) && lp == 0 && !LASTREP) { Frame F = make_frame(L);
            pg8::RegOrder S; S.init(WSP(WS_H), DM * 2, WSP(WS_WGU) + (size_t)lp * 2 * FFD * DM, DM * 2, NTOK, 2 * FFD, F.G, F.bx);
#if MK_EPI_PROBE == 1
            pg8::EpiNull E{(float*)(F.ws + WS_DUMMY)};
            pg8::gemm_phase<pg8::EpiNull, pg8::RegOrder, false>(ring, DM * 2, DM * 2, DM * 2, S, E);
#else
            pg8::EpiBf16<0> E{WSP(WS_HID), FFD, nullptr};
            S.nN = FFD / 256; S.nwg = S.nM * S.nN;
            pg8::gemm_phase<pg8::EpiBf16<0>, pg8::RegOrder, false>(ring, DM * 2, DM * 2, DM * 2, S, E);
#endif
        }
        if (IN(pb + 5) && lp == 0 && LASTREP) FORREP(pb + 5) { Frame F = make_frame(L);
#else
        if (IN(pb + 5) && lp == 0) FORREP(pb + 5) { Frame F = make_frame(L);
#endif
            pg8::RegOrder S; S.init(WSP(WS_H), DM * 2, WSP(WS_WGU) + (size_t)lp * 2 * FFD * DM, DM * 2, NTOK, 2 * FFD, F.G, F.bx);
            pg8::EpiSwiglu<1> E{WSP(WS_HID), FFD, SSQ(4 * lp + 1), nullptr};
            pg8::gemm_phase<pg8::EpiSwiglu<1>, pg8::RegOrder, false>(ring, DM * 2, DM * 2, DM * 2, S, E, MK_STAG_BF);
            SEAM(pb + 5);
        }
        if (IN(pb + 5) && lp == 1) FORREP(pb + 5) { Frame F = make_frame(L);
            pg8::RegOrder S; S.init(F.ws + WS_H8, DM, F.ws + WS_WGU + (size_t)2 * FFD * DM * 2, DM, NTOK, 2 * FFD, F.G, F.bx);
            pg8::EpiSwigluF8<1> E{F.ws + WS_HID, FFD8, 2 * FFD / 256 - 1, SSQ(4 * lp + 1)};
            pg8::gemm_phase<pg8::EpiSwigluF8<1>, pg8::RegOrder, false, true>(ring, DM, DM, DM, S, E, MK_STAG_F8);
            SEAM(pb + 5);
        }
        if (IN(pb + 6) && lp == 0) FORREP(pb + 6) { Frame F = make_frame(L);
            pg8::RegOrder S; S.init(WSP(WS_HID), FFD * 2, WSP(WS_WD) + (size_t)lp * DM * FFD, FFD * 2, NTOK, DM, F.G, F.bx); S.rev = MK_REV;
            pg8::EpiResidH<false> E{WSP(WS_H), LASTREP ? WSP(WS_H) : WSP(WS_DUMMY), LASTREP ? SSQ(4 * lp + 2) : SSQ(9), nullptr, 1.0f};
            pg8::gemm_phase<pg8::EpiResidH<false>, pg8::RegOrder, false>(ring, FFD * 2, FFD * 2, FFD * 2, S, E);
            SEAM(pb + 6);
        }
        if (IN(pb + 6) && lp == 1) FORREP(pb + 6) { Frame F = make_frame(L);
            pg8::RegOrder S; S.init(F.ws + WS_HID, FFD8, F.ws + WS_WD + (size_t)DM * FFD * 2, FFD8, NTOK, DM, F.G, F.bx); S.rev = MK_REV;
            pg8::EpiResidH<false> E{WSP(WS_H), LASTREP ? WSP(WS_H) : WSP(WS_DUMMY), LASTREP ? SSQ(4 * lp + 2) : SSQ(9), nullptr, 1.0f / (pg8::FP8_SH * pg8::FP8_SW)};
            pg8::gemm_phase<pg8::EpiResidH<false>, pg8::RegOrder, false, true>(ring, FFD8, FFD8, FFD8, S, E);
            SEAM(pb + 6);
        }
        if (IN(pb + 7)) FORREP(pb + 7) { Frame F = make_frame(L); pool_phase(F, WSP(WS_H), SSQ(4 * lp + 2), ptab(F.lds, 2) + (size_t)(2 * lp + 1) * DM, WSP(WS_DOWN)); SEAM(pb + 7); }
        if (IN(pb + 8)) FORREP(pb + 8) { Frame F = make_frame(L);
            pg8::RegOrder S; S.init(WSP(WS_DOWN), DM * 2, WSP(WS_WPOOL) + (size_t)lp * 4 * 256 * 256, 256 * 2, NTOK, DM, F.G, F.bx, 256 * 2);
            pg8::EpiResidH<false> E{WSP(WS_H), LASTREP ? WSP(WS_H) : WSP(WS_DUMMY), LASTREP ? SSQ(4 * lp + 3) : SSQ(9), nullptr, 1.0f};
            pg8::gemm_phase<pg8::EpiResidH<false>, pg8::RegOrder, false>(ring, DM * 2, 256 * 2, 256 * 2, S, E);
            SEAM(pb + 8);
        }
        if (IN(pb + 9)) FORREP(pb + 9) { Frame F = make_frame(L);
            router_phase<true>(F, WSP(WS_H), SSQ(4 * lp + 3), ptab(F.lds, 3) + (size_t)(2 * lp + 1) * DM, ptab(F.lds, 15) + (size_t)lp * DM * NEXP, (int*)(F.ws + WS_LIST), (float*)(F.ws + WS_RSL), (unsigned*)(F.ws + WS_TOKINFO), (unsigned*)(F.ctl + CW_CNT) + (LASTREP ? lp : 2 + lp) * 8 * 64, F.ws + WS_H8);
            SEAM(pb + 9); }
#ifndef TEST_NO_F8MOE
        if (IN(pb + 10)) FORREP(pb + 10) { Frame F = make_frame(L);
            MoeOrder<true, true> S; S.init((unsigned*)(F.ctl + CW_CNT) + lp * 8 * 64, F.ws + WS_H8, F.ws + WS_MWGU + (size_t)lp * 8 * 2 * FFEP * DM * 2, (const int*)(F.ws + WS_LIST), F.G, F.bx);
            pg8::EpiSwigluF8<0> E{F.ws + WS_HID, FFE8, 2 * FFEP / 256 - 1, nullptr};
            pg8::gemm_phase<pg8::EpiSwigluF8<0>, MoeOrder<true, true>, true, true>(ring, DM, DM, DM, S, E, MK_STAG_F8);
            SEAM(pb + 10);
        }
#endif
#ifndef TEST_NO_F8MOE
        if (IN(pb + 11)) FORREP(pb + 11) { Frame F = make_frame(L);
            MoeOrder<false, true> S; S.init((unsigned*)(F.ctl + CW_CNT) + lp * 8 * 64, F.ws + WS_HID, F.ws + WS_MWD + (size_t)lp * 8 * DM * FFEP * 2, (const int*)(F.ws + WS_LIST), F.G, F.bx); S.rev = MK_REV;
            pg8::EpiBf16Scaled E{WSP(WS_YB), DM, 1.0f / (pg8::FP8_SH * pg8::FP8_SW)};
            pg8::gemm_phase<pg8::EpiBf16Scaled, MoeOrder<false, true>, false, true>(ring, FFE8, FFE8, FFE8, S, E);
            SEAM(pb + 11);
        }
#endif
        if (IN(pb + 12)) FORREP(pb + 12) { Frame F = make_frame(L);
            if (lp == 0) combine_phase<false>(F, WSP(WS_H), LASTREP ? WSP(WS_H) : WSP(WS_DOWN), WSP(WS_YB), (const unsigned*)(F.ws + WS_TOKINFO), (unsigned*)(F.ctl + CW_CNT), LASTREP ? SSQ(4) : SSQ(9), nullptr, nullptr);
            else combine_phase<true>(F, WSP(WS_H), nullptr, WSP(WS_YB), (const unsigned*)(F.ws + WS_TOKINFO), (unsigned*)(F.ctl + CW_CNT) + 8 * 64, nullptr, ptab(F.lds, 19), (float*)ptab(F.lds, 20));
            SEAM(pb + 12);
        }
    }
#undef IN
#undef SEAM
#undef WSP
#undef SSQ
}

#ifndef MK_PER_PHASE
#define MK_PER_PHASE 0
#endif
extern "C" void kernel_launch(void* const* d_in, const int* in_sizes, int n_in, void* d_out, int out_size, void* d_ws, size_t ws_size, hipStream_t stream) {
    static int grid = 0;
    if (grid == 0) {
        if (n_in != 20 || in_sizes[0] != NTOK * DM || out_size != NTOK * DM || ws_size < WS_END) { fprintf(stderr, "kernel_launch: unexpected shapes (n_in %d, in0 %d, out %d, ws %zu < %zu)\n", n_in, n_in > 0 ? in_sizes[0] : -1, out_size, ws_size, (size_t)WS_END); grid = -1; return; }
        int dev = 0, cus = 0, per_cu = 0;
        if (hipGetDevice(&dev) != hipSuccess || hipDeviceGetAttribute(&cus, hipDeviceAttributeMultiprocessorCount, dev) != hipSuccess) { grid = -1; return; }
        if (hipFuncSetAttribute((const void*)fwd, hipFuncAttributeMaxDynamicSharedMemorySize, LDS_BYTES) != hipSuccess) { fprintf(stderr, "kernel_launch: hipFuncSetAttribute failed\n"); grid = -1; return; }
        if (hipOccupancyMaxActiveBlocksPerMultiprocessor(&per_cu, (const void*)fwd, NWAVES * 64, LDS_BYTES) != hipSuccess || per_cu < 1) fprintf(stderr, "kernel_launch: occupancy query reports %d\n", per_cu);
        (void)hipGetLastError();
        grid = cus < 256 ? cus : 256;
    }
    if (grid < 0) return;
    if (hipMemsetAsync((char*)d_ws + WS_CTL, 0, CTL_ZERO_BYTES, stream) != hipSuccess) return;
    Args a{};
    for (int i = 0; i < 20; ++i) a.in[i] = (const float*)d_in[i];
    a.out = (float*)d_out; a.ws = (unsigned char*)d_ws;
#if MK_PER_PHASE
    for (int p = 0; p < NPHASE; ++p) { a.ph_lo = p; a.ph_hi = p + 1; a.li = 0; hipLaunchKernelGGL(fwd, dim3(grid), dim3(NWAVES * 64), LDS_BYTES, stream, a); }
#elif MK_REP_MASK
    { int cur = 0, li = 0;
      for (int k = 0; k < NPHASE; ++k) if ((MK_REP_MASK >> (k == 0 ? 0 : 1 + (k - 1) % 13)) & 1) {
          if (k > cur) { a.ph_lo = cur; a.ph_hi = k; a.li = li++; a.pad = 0; hipLaunchKernelGGL(fwd, dim3(grid), dim3(NWAVES * 64), LDS_BYTES, stream, a); }
          for (int r = 1; r < MK_REP_N; ++r) { a.ph_lo = k; a.ph_hi = k + 1; a.li = li++; a.pad = 1; hipLaunchKernelGGL(fwd, dim3(grid), dim3(NWAVES * 64), LDS_BYTES, stream, a); }
          cur = k; }
      a.ph_lo = cur; a.ph_hi = NPHASE; a.li = li++; a.pad = 0; hipLaunchKernelGGL(fwd, dim3(grid), dim3(NWAVES * 64), LDS_BYTES, stream, a); }
#elif defined(MK_TWICE)
    a.ph_lo = 0; a.ph_hi = NPHASE; a.li = 0;
    hipLaunchKernelGGL(fwd, dim3(grid), dim3(NWAVES * 64), LDS_BYTES, stream, a);
    (void)hipMemsetAsync((char*)d_ws + WS_CTL, 0, CTL_ZERO_BYTES, stream);
    hipLaunchKernelGGL(fwd, dim3(grid), dim3(NWAVES * 64), LDS_BYTES, stream, a);
#else
    a.ph_lo = 0; a.ph_hi = NPHASE; a.li = 0;
    hipLaunchKernelGGL(fwd, dim3(grid), dim3(NWAVES * 64), LDS_BYTES, stream, a);
#endif
}
```

```cpp
#include <hip/hip_runtime.h>
#include <cstdio>
#include <cstdint>

#define GAS __attribute__((address_space(1)))
#define LAS __attribute__((address_space(3)))
typedef unsigned short bf16_t;
typedef short bf16x8 __attribute__((ext_vector_type(8)));
typedef short s16x4 __attribute__((ext_vector_type(4)));
typedef float f32x2 __attribute__((ext_vector_type(2)));
typedef float f32x4 __attribute__((ext_vector_type(4)));
typedef float f32x16 __attribute__((ext_vector_type(16)));
typedef unsigned u32x2 __attribute__((ext_vector_type(2)));
typedef unsigned u32x4 __attribute__((ext_vector_type(4)));

constexpr int DM = 1024, NBATCH = 32, SEQ = 2048, NTOK = NBATCH * SEQ;
constexpr int NHEAD = 8, DNOPE = 128, DROPE = 64, DVH = 128, DQH = DNOPE + DROPE, QLR = 512, KVLR = 256;
constexpr int NDOWN = QLR + KVLR + DROPE  , NDOWNP = 1024;
constexpr int NQ = NHEAD * DQH  , NKV = NHEAD * (DNOPE + DVH)  ;
constexpr int FFD = 2688, NEXP = 8, FFE = 1344, FFEP = 1408;
constexpr int PSLOT = (NTOK * 2 / 256 + NEXP) * 256;
constexpr float RMS_EPS = 1e-6f;

__device__ __forceinline__ unsigned cvt_pk_bf16(float lo, float hi) { unsigned r; asm volatile("v_cvt_pk_bf16_f32 %0, %1, %2" : "=v"(r) : "v"(lo), "v"(hi)); return r; }
__device__ __forceinline__ int launder_v(int v) { asm volatile("" : "+v"(v)); return v; }
__device__ __forceinline__ float fp8_rt(float x, float s) { const int p = __builtin_amdgcn_cvt_pk_fp8_f32(x * s, 0.f, 0, false); return __builtin_amdgcn_cvt_f32_fp8(p, 0) * (1.0f / s); }
__device__ __forceinline__ float bf2f(unsigned short b) { return __uint_as_float((unsigned)b << 16); }
__device__ __forceinline__ float bflo(unsigned w) { return __uint_as_float(w << 16); }
__device__ __forceinline__ float bfhi(unsigned w) { return __uint_as_float(w & 0xffff0000u); }

typedef unsigned long long ssq_t;
__device__ __forceinline__ ssq_t ssq_fix(float s) { return (ssq_t)(s * 16777216.0f); }
__device__ __forceinline__ float rstd_n(ssq_t q, float invn) { return __builtin_amdgcn_rsqf(((float)(unsigned)(q >> 32) * 4294967296.0f + (float)(unsigned)q) * (1.0f / 16777216.0f) * invn + RMS_EPS); }
__device__ __forceinline__ float rstd_of(ssq_t q) { return rstd_n(q, 1.0f / DM); }
__device__ __forceinline__ float rstd_f(float ssq) { return __builtin_amdgcn_rsqf(ssq * (1.0f / DM) + RMS_EPS); }

namespace pg8 {
constexpr int BM = 256, BK = 64, HALF = 128, HTB = HALF * BK * 2  , STAGE_BYTES = 8 * HTB, NXCD = 8, WGM = 8;
__host__ __device__ __forceinline__ int lds_byte(int r, int c) { const int st = (r >> 4) * 2 + (c >> 5), rr = r & 15, cc = c & 31, ob = rr * 64 + cc * 2; return st * 1024 + (ob ^ (((ob >> 9) & 1) << 5)); }
__host__ __device__ __forceinline__ void stage_rc(int b, int& R, int& C) { const int st = b / 1024, sb = b % 1024, swz = sb ^ (((sb >> 9) & 1) << 5); R = (st >> 1) * 16 + swz / 64; C = (st & 1) * 32 + (swz % 64) / 2; }
__host__ __device__ __forceinline__ int perm32(int rho) { const int n = rho >> 4, i = rho & 15; return 8 * (i >> 2) + 4 * n + (i & 3); }

struct Unit { const char* a; const char* b; const int* rows; int nrows; int orow; int pn; int aux; };

struct RegOrder {
    const char* A; const char* B; unsigned a_tile, b_tile, a_colstep; int nM, nN, nwg, G, c, rev;
    __device__ __forceinline__ void init(const void* A_, size_t lda_b, const void* B_, size_t ldb_b, int M, int N, int G_, int c_, size_t a_colstep_ = 0) {
        A = (const char*)A_; B = (const char*)B_; a_tile = (unsigned)(256 * lda_b); b_tile = (unsigned)(256 * ldb_b); a_colstep = (unsigned)a_colstep_; nM = M / BM; nN = N / BM; nwg = nM * nN; G = G_; c = c_; rev = 0; }
    __device__ __forceinline__ bool next(int i, Unit& u) const {
        long L = (long)i * G + c; if (L >= nwg) return false;
        if (rev) L = nwg - 1 - L;
        int wgid = (int)L; { const int q = nwg / NXCD, r = nwg % NXCD, xcd = wgid % NXCD, off = wgid / NXCD; wgid = (xcd < r ? xcd * (q + 1) : r * (q + 1) + (xcd - r) * q) + off; }
        const int nig = WGM * nN, gid = wgid / nig, fm = gid * WGM, gsz = (nM - fm) < WGM ? (nM - fm) : WGM;
        const int pm = fm + ((wgid % nig) % gsz), pn = (wgid % nig) / gsz;
        u.a = A + (size_t)pm * a_tile + (size_t)pn * a_colstep; u.b = B + (size_t)pn * b_tile; u.rows = nullptr; u.nrows = 256; u.orow = pm * BM; u.pn = pn; u.aux = 0; return true;
    }
};

template <int RS> struct EpiBf16 {
    static constexpr bool PERM = true;
    bf16_t* O; int ldc; const ssq_t* rs; float scale = 1.0f;
    __device__ __forceinline__ void operator()(const f32x4 (&acc)[2][2][4][2], const Unit& u, int wr, int wc, int fr, int fq) const {
        const int row0 = u.orow + launder_v(wr * 64 + fr), col0 = u.pn * BM + wc * 32 + 8 * fq;
        float sc[2][4]; ssq_t rq[2][4];
#pragma unroll
        for (int ai = 0; ai < 2; ++ai)
#pragma unroll
            for (int m = 0; m < 4; ++m) { const int row = row0 + ai * HALF + m * 16; if constexpr (RS != 0) rq[ai][m] = rs[row]; }
#pragma unroll
        for (int ai = 0; ai < 2; ++ai)
#pragma unroll
            for (int m = 0; m < 4; ++m) { sc[ai][m] = 1.0f; if constexpr (RS == 1) sc[ai][m] = rstd_of(rq[ai][m]); if constexpr (RS == 2) sc[ai][m] = rstd_n(rq[ai][m], 1.0f / KVLR) * scale; }
#pragma unroll
        for (int ai = 0; ai < 2; ++ai)
#pragma unroll
            for (int m = 0; m < 4; ++m) { const int row = row0 + ai * HALF + m * 16; bf16_t* rowp = O + (size_t)row * ldc + col0;
#pragma unroll
                for (int bj = 0; bj < 2; ++bj) { const f32x4 v0 = acc[ai][bj][m][0] * sc[ai][m], v1 = acc[ai][bj][m][1] * sc[ai][m];
                    u32x4 w; w.x = cvt_pk_bf16(v0[0], v0[1]); w.y = cvt_pk_bf16(v0[2], v0[3]); w.z = cvt_pk_bf16(v1[0], v1[1]); w.w = cvt_pk_bf16(v1[2], v1[3]);
                    *(u32x4*)(rowp + bj * HALF) = w; } }
    }
};
__device__ __forceinline__ float silu_mul(float g, float u) { return g * u * __builtin_amdgcn_rcpf(1.0f + __builtin_amdgcn_exp2f(-1.4426950408889634f * g)); }
__device__ __forceinline__ f32x2 silu_mul2(f32x2 ga, f32x2 ua, float sg, float su) {
    const f32x2 g = ga * sg, ea = g * -1.4426950408889634f, u = ua * su;
    f32x2 e; e.x = __builtin_amdgcn_exp2f(ea.x); e.y = __builtin_amdgcn_exp2f(ea.y);
    const f32x2 d = e + 1.0f; f32x2 r; r.x = __builtin_amdgcn_rcpf(d.x); r.y = __builtin_amdgcn_rcpf(d.y);
    return (g * u) * r;
}
#define V2(v, i) __builtin_shufflevector(v, v, i, i + 1)
template <int RS> struct EpiSwiglu {
    static constexpr bool PERM = true;
    bf16_t* H; int ldh; const void* rs; const int* list;
    __device__ __forceinline__ void operator()(const f32x4 (&acc)[2][2][4][2], const Unit& u, int wr, int wc, int fr, int fq) const {
        const int r0 = launder_v(wr * 64 + fr), col0 = u.pn * HALF + wc * 32 + 8 * fq;
        const ssq_t* rsq = (const ssq_t*)rs; const float* rsp = (const float*)rs; if constexpr (RS == 2) rsp = rsp + (u.rows - list);
        float sc[2][4]; ssq_t rq[2][4];
#pragma unroll
        for (int ai = 0; ai < 2; ++ai)
#pragma unroll
            for (int m = 0; m < 4; ++m) { const int r = r0 + ai * HALF + m * 16; if constexpr (RS == 1) rq[ai][m] = rsq[u.orow + r]; else sc[ai][m] = rsp[r]; }
        if constexpr (RS == 1) {
#pragma unroll
            for (int ai = 0; ai < 2; ++ai)
#pragma unroll
                for (int m = 0; m < 4; ++m) sc[ai][m] = rstd_of(rq[ai][m]); }
#pragma unroll
        for (int ai = 0; ai < 2; ++ai)
#pragma unroll
            for (int m = 0; m < 4; ++m) { const int r = r0 + ai * HALF + m * 16; bf16_t* rowp = H + (size_t)(u.orow + r) * ldh + col0; const float s = sc[ai][m];
                const f32x4 g0 = acc[ai][0][m][0] * s, g1 = acc[ai][0][m][1] * s, u0 = acc[ai][1][m][0] * s, u1 = acc[ai][1][m][1] * s;
                u32x4 w; w.x = cvt_pk_bf16(silu_mul(g0[0], u0[0]), silu_mul(g0[1], u0[1])); w.y = cvt_pk_bf16(silu_mul(g0[2], u0[2]), silu_mul(g0[3], u0[3]));
                w.z = cvt_pk_bf16(silu_mul(g1[0], u1[0]), silu_mul(g1[1], u1[1])); w.w = cvt_pk_bf16(silu_mul(g1[2], u1[2]), silu_mul(g1[3], u1[3]));
                __builtin_nontemporal_store(w, (u32x4*)rowp); }
    }
};
constexpr float FP8_SA = 16.0f, FP8_SW = 256.0f, FP8_SH = 16.0f, FP8_SX = 8.0f;
__device__ __forceinline__ unsigned pk4_fp8(float a, float b, float c, float d) { int p = __builtin_amdgcn_cvt_pk_fp8_f32(a, b, 0, false); p = __builtin_amdgcn_cvt_pk_fp8_f32(c, d, p, true); return (unsigned)p; }
template <int RS> struct EpiSwigluF8 {
    static constexpr bool PERM = true;
    unsigned char* H8; int ldh; int pad_tile; const ssq_t* rs;
    __device__ __forceinline__ void operator()(const f32x4 (&acc)[2][2][4][2], const Unit& u, int wr, int wc, int fr, int fq) const {
        const int r0 = launder_v(wr * 64 + fr), col0 = u.pn * HALF + wc * 32 + 8 * fq;
        float sc[2][4]; ssq_t rq[2][4];
#pragma unroll
        for (int ai = 0; ai < 2; ++ai)
#pragma unroll
            for (int m = 0; m < 4; ++m) { if constexpr (RS != 0) rq[ai][m] = rs[u.orow + r0 + ai * HALF + m * 16]; }
#pragma unroll
        for (int ai = 0; ai < 2; ++ai)
#pragma unroll
            for (int m = 0; m < 4; ++m) { if constexpr (RS == 1) sc[ai][m] = rstd_of(rq[ai][m]) * (1.0f / (FP8_SX * FP8_SW)); else if constexpr (RS == 2) sc[ai][m] = rstd_of(rq[ai][m]); else sc[ai][m] = 1.0f / (FP8_SA * FP8_SW); }
#pragma unroll
        for (int ai = 0; ai < 2; ++ai)
#pragma unroll
            for (int m = 0; m < 4; ++m) { const int r = r0 + ai * HALF + m * 16; unsigned char* rowp = H8 + (size_t)(u.orow + r) * ldh + col0; const float s = sc[ai][m], su = s * FP8_SH;
                const f32x4 g0 = acc[ai][0][m][0], g1 = acc[ai][0][m][1], u0 = acc[ai][1][m][0], u1 = acc[ai][1][m][1];
                const f32x2 h0 = silu_mul2(V2(g0, 0), V2(u0, 0), s, su), h1 = silu_mul2(V2(g0, 2), V2(u0, 2), s, su), h2 = silu_mul2(V2(g1, 0), V2(u1, 0), s, su), h3 = silu_mul2(V2(g1, 2), V2(u1, 2), s, su);
                u32x2 w; w.x = pk4_fp8(h0.x, h0.y, h1.x, h1.y); w.y = pk4_fp8(h2.x, h2.y, h3.x, h3.y);
                __builtin_nontemporal_store(w, (u32x2*)rowp); }
        if (u.pn == pad_tile) {
            u32x2 z; asm volatile("v_mov_b32 %0, 0\n\tv_mov_b32 %1, 0" : "=v"(z.x), "=v"(z.y));
#pragma unroll
            for (int ai = 0; ai < 2; ++ai)
#pragma unroll
                for (int m = 0; m < 4; ++m) *(u32x2*)(H8 + (size_t)(u.orow + r0 + ai * HALF + m * 16) * ldh + col0 + HALF) = z; }
    }
};
constexpr float FP8_SY = 32.0f;
struct EpiF8Scaled {
    static constexpr bool PERM = true;
    unsigned char* O; int ldc; float scale;
    __device__ __forceinline__ void operator()(const f32x4 (&acc)[2][2][4][2], const Unit& u, int wr, int wc, int fr, int fq) const {
        const int row0 = u.orow + launder_v(wr * 64 + fr), col0 = u.pn * BM + wc * 32 + 8 * fq;
#pragma unroll
        for (int ai = 0; ai < 2; ++ai)
#pragma unroll
            for (int m = 0; m < 4; ++m) { unsigned char* rowp = O + (size_t)(row0 + ai * HALF + m * 16) * ldc + col0;
#pragma unroll
                for (int bj = 0; bj < 2; ++bj) { const f32x4 v0 = acc[ai][bj][m][0] * scale, v1 = acc[ai][bj][m][1] * scale;
                    u32x2 w; w.x = pk4_fp8(v0[0], v0[1], v0[2], v0[3]); w.y = pk4_fp8(v1[0], v1[1], v1[2], v1[3]);
                    *(u32x2*)(rowp + bj * HALF) = w; } }
    }
};
struct EpiBf16Scaled {
    static constexpr bool PERM = true;
    bf16_t* O; int ldc; float scale;
    __device__ __forceinline__ void operator()(const f32x4 (&acc)[2][2][4][2], const Unit& u, int wr, int wc, int fr, int fq) const {
        const int row0 = u.orow + launder_v(wr * 64 + fr), col0 = u.pn * BM + wc * 32 + 8 * fq;
#pragma unroll
        for (int ai = 0; ai < 2; ++ai)
#pragma unroll
            for (int m = 0; m < 4; ++m) { bf16_t* rowp = O + (size_t)(row0 + ai * HALF + m * 16) * ldc + col0;
#pragma unroll
                for (int bj = 0; bj < 2; ++bj) { const f32x4 v0 = acc[ai][bj][m][0] * scale, v1 = acc[ai][bj][m][1] * scale;
                    u32x4 w; w.x = cvt_pk_bf16(v0[0], v0[1]); w.y = cvt_pk_bf16(v0[2], v0[3]); w.z = cvt_pk_bf16(v1[0], v1[1]); w.w = cvt_pk_bf16(v1[2], v1[3]);
                    *(u32x4*)(rowp + bj * HALF) = w; } }
    }
};
struct EpiNull {
    static constexpr bool PERM = true;
    float* sink;
    __device__ __forceinline__ void operator()(const f32x4 (&acc)[2][2][4][2], const Unit& u, int wr, int wc, int fr, int fq) const {
        float s = 0.f;
#pragma unroll
        for (int ai = 0; ai < 2; ++ai)
#pragma unroll
            for (int bj = 0; bj < 2; ++bj)
#pragma unroll
                for (int m = 0; m < 4; ++m)
#pragma unroll
                    for (int n = 0; n < 2; ++n) s += acc[ai][bj][m][n][0];
        if (s == 12345.678f) sink[0] = s;
    }
};
template <bool W8> struct EpiResidH {
    static constexpr bool PERM = true;
    const bf16_t* hin; bf16_t* hout; ssq_t* ssq; unsigned char* h8; float scale;
    __device__ __forceinline__ void operator()(const f32x4 (&acc)[2][2][4][2], const Unit& u, int wr, int wc, int fr, int fq) const {
        const int row0 = u.orow + launder_v(wr * 64 + fr), col0 = u.pn * BM + wc * 32 + 8 * fq;
        float part[2][4];
        u32x4 hv[W8 ? 1 : 2][4][2];
        if constexpr (!W8) {
#pragma unroll
            for (int ai = 0; ai < 2; ++ai)
#pragma unroll
                for (int m = 0; m < 4; ++m)
#pragma unroll
                    for (int bj = 0; bj < 2; ++bj) hv[ai][m][bj] = *(const u32x4*)(hin + (size_t)(row0 + ai * HALF + m * 16) * DM + col0 + bj * HALF);
        }
#pragma unroll
        for (int ai = 0; ai < 2; ++ai) {
            if constexpr (W8) {
#pragma unroll
                for (int m = 0; m < 4; ++m)
#pragma unroll
                    for (int bj = 0; bj < 2; ++bj) hv[0][m][bj] = *(const u32x4*)(hin + (size_t)(row0 + ai * HALF + m * 16) * DM + col0 + bj * HALF);
            }
#pragma unroll
            for (int m = 0; m < 4; ++m) { const int row = row0 + ai * HALF + m * 16; const size_t off = (size_t)row * DM + col0; float pt = 0.f;
#pragma unroll
                for (int bj = 0; bj < 2; ++bj) { const u32x4 h4 = hv[W8 ? 0 : ai][m][bj]; const f32x4 a0 = acc[ai][bj][m][0] * scale, a1 = acc[ai][bj][m][1] * scale;
                    const float y0 = bflo(h4.x) + a0[0], y1 = bfhi(h4.x) + a0[1], y2 = bflo(h4.y) + a0[2], y3 = bfhi(h4.y) + a0[3], y4 = bflo(h4.z) + a1[0], y5 = bfhi(h4.z) + a1[1], y6 = bflo(h4.w) + a1[2], y7 = bfhi(h4.w) + a1[3];
                    pt += (y0 * y0 + y1 * y1) + (y2 * y2 + y3 * y3) + (y4 * y4 + y5 * y5) + (y6 * y6 + y7 * y7);
                    u32x4 w; w.x = cvt_pk_bf16(y0, y1); w.y = cvt_pk_bf16(y2, y3); w.z = cvt_pk_bf16(y4, y5); w.w = cvt_pk_bf16(y6, y7);
                    *(u32x4*)(hout + off + bj * HALF) = w;
                    if constexpr (W8) { u32x2 q; q.x = pk4_fp8(y0 * FP8_SX, y1 * FP8_SX, y2 * FP8_SX, y3 * FP8_SX); q.y = pk4_fp8(y4 * FP8_SX, y5 * FP8_SX, y6 * FP8_SX, y7 * FP8_SX); *(u32x2*)(h8 + off + bj * HALF) = q; } }
                pt += __shfl_xor(pt, 16); pt += __shfl_xor(pt, 32); part[ai][m] = pt; }
        }
        if (fq == 0) {
#pragma unroll
            for (int ai = 0; ai < 2; ++ai)
#pragma unroll
                for (int m = 0; m < 4; ++m) atomicAdd(ssq + row0 + ai * HALF + m * 16, ssq_fix(part[ai][m])); }
    }
};
constexpr float FP8_SL = 16.0f;
template <bool F8OUT> struct EpiDown {
    static constexpr bool PERM = true;
    bf16_t* O; bf16_t* KR; const ssq_t* rs; ssq_t* ssq_q; ssq_t* ssq_kv; const float* cosT; const float* sinT; float scale;
    __device__ __forceinline__ void operator()(const f32x4 (&acc)[2][2][4][2], const Unit& u, int wr, int wc, int fr, int fq) const {
        const int row0 = u.orow + launder_v(wr * 64 + fr);
        float sc[2][4]; ssq_t rq[2][4];
#pragma unroll
        for (int ai = 0; ai < 2; ++ai)
#pragma unroll
            for (int m = 0; m < 4; ++m) rq[ai][m] = rs[row0 + ai * HALF + m * 16];
#pragma unroll
        for (int ai = 0; ai < 2; ++ai)
#pragma unroll
            for (int m = 0; m < 4; ++m) sc[ai][m] = rstd_of(rq[ai][m]) * scale;
        if (u.pn < 3) {
            ssq_t* sq = u.pn < 2 ? ssq_q : ssq_kv; const int col0 = u.pn * BM + wc * 32 + 8 * fq; float pts[2][4];
#pragma unroll
            for (int ai = 0; ai < 2; ++ai)
#pragma unroll
                for (int m = 0; m < 4; ++m) { const int row = row0 + ai * HALF + m * 16; bf16_t* rowp = O + (size_t)row * NDOWNP + col0; const float s = sc[ai][m]; float part = 0.f;
#pragma unroll
                    for (int bj = 0; bj < 2; ++bj) { const f32x4 v0 = acc[ai][bj][m][0] * s, v1 = acc[ai][bj][m][1] * s;
                        part += (v0[0] * v0[0] + v0[1] * v0[1]) + (v0[2] * v0[2] + v0[3] * v0[3]) + (v1[0] * v1[0] + v1[1] * v1[1]) + (v1[2] * v1[2] + v1[3] * v1[3]);
                        if constexpr (F8OUT) { u32x2 w8; w8.x = pk4_fp8(v0[0] * FP8_SL, v0[1] * FP8_SL, v0[2] * FP8_SL, v0[3] * FP8_SL); w8.y = pk4_fp8(v1[0] * FP8_SL, v1[1] * FP8_SL, v1[2] * FP8_SL, v1[3] * FP8_SL);
                            *(u32x2*)((unsigned char*)O + (size_t)row * NDOWNP + col0 + bj * HALF) = w8; }
                        else { u32x4 w; w.x = cvt_pk_bf16(v0[0], v0[1]); w.y = cvt_pk_bf16(v0[2], v0[3]); w.z = cvt_pk_bf16(v1[0], v1[1]); w.w = cvt_pk_bf16(v1[2], v1[3]);
                        *(u32x4*)(rowp + bj * HALF) = w; } }
                    part += __shfl_xor(part, 16); part += __shfl_xor(part, 32); pts[ai][m] = part; }
            if (fq == 0) {
#pragma unroll
                for (int ai = 0; ai < 2; ++ai)
#pragma unroll
                    for (int m = 0; m < 4; ++m) atomicAdd(sq + row0 + ai * HALF + m * 16, ssq_fix(pts[ai][m])); }
        } else if (wc == 0) {
#pragma unroll
            for (int aq = 0; aq < 4; ++aq) { const int ai = aq >> 1, mb = (aq & 1) * 2; f32x4 ct[4][2], st[4][2];
#pragma unroll
                for (int m = mb; m < mb + 2; ++m) { const size_t to = (size_t)(row0 + ai * HALF + m * 16) * 32 + 8 * fq;
                    ct[m][0] = *(const f32x4*)(cosT + to); ct[m][1] = *(const f32x4*)(cosT + to + 4); st[m][0] = *(const f32x4*)(sinT + to); st[m][1] = *(const f32x4*)(sinT + to + 4); }
#pragma unroll
                for (int m = mb; m < mb + 2; ++m) { const int row = row0 + ai * HALF + m * 16; const float s = sc[ai][m];
                    const f32x4 a0 = acc[ai][0][m][0] * s, a1 = acc[ai][0][m][1] * s, b0 = acc[ai][1][m][0] * s, b1 = acc[ai][1][m][1] * s;
                    const f32x4 x0 = a0 * ct[m][0] - b0 * st[m][0], x1 = a1 * ct[m][1] - b1 * st[m][1], y0 = b0 * ct[m][0] + a0 * st[m][0], y1 = b1 * ct[m][1] + a1 * st[m][1];
                    bf16_t* rp = KR + (size_t)row * DROPE + 8 * fq;
                    u32x4 w; w.x = cvt_pk_bf16(x0[0], x0[1]); w.y = cvt_pk_bf16(x0[2], x0[3]); w.z = cvt_pk_bf16(x1[0], x1[1]); w.w = cvt_pk_bf16(x1[2], x1[3]);
                    *(u32x4*)rp = w;
                    w.x = cvt_pk_bf16(y0[0], y0[1]); w.y = cvt_pk_bf16(y0[2], y0[3]); w.z = cvt_pk_bf16(y1[0], y1[1]); w.w = cvt_pk_bf16(y1[2], y1[3]);
                    *(u32x4*)(rp + 32) = w; } }
        }
    }
};
constexpr float FP8_SQ = 16.0f;
template <bool F8OUT> struct EpiQ {
    static constexpr bool PERM = true;
    bf16_t* Q; const float* cosT; const float* sinT; const ssq_t* rs; float scale = 1.0f;
    __device__ __forceinline__ void operator()(const f32x4 (&acc)[2][2][4][2], const Unit& u, int wr, int wc, int fr, int fq) const {
        const int row0 = u.orow + launder_v(wr * 64 + fr);
        float sc[2][4]; ssq_t rq[2][4];
#pragma unroll
        for (int ai = 0; ai < 2; ++ai)
#pragma unroll
            for (int m = 0; m < 4; ++m) rq[ai][m] = rs[row0 + ai * HALF + m * 16];
#pragma unroll
        for (int ai = 0; ai < 2; ++ai)
#pragma unroll
            for (int m = 0; m < 4; ++m) sc[ai][m] = rstd_n(rq[ai][m], 1.0f / QLR) * scale;
        if (u.pn < 2) {
            const int h = 4 * u.pn + wc;
#pragma unroll
            for (int aq = 0; aq < 4; ++aq) { const int ai = aq >> 1, mb = (aq & 1) * 2; f32x4 ct[4][2], st[4][2];
#pragma unroll
                for (int m = mb; m < mb + 2; ++m) { const size_t to = (size_t)(row0 + ai * HALF + m * 16) * 32 + 8 * fq;
                    ct[m][0] = *(const f32x4*)(cosT + to); ct[m][1] = *(const f32x4*)(cosT + to + 4); st[m][0] = *(const f32x4*)(sinT + to); st[m][1] = *(const f32x4*)(sinT + to + 4); }
#pragma unroll
                for (int m = mb; m < mb + 2; ++m) { const int row = row0 + ai * HALF + m * 16; const float s = sc[ai][m] * (F8OUT ? FP8_SQ : 1.0f);
                    const f32x4 a0 = acc[ai][0][m][0] * s, a1 = acc[ai][0][m][1] * s, b0 = acc[ai][1][m][0] * s, b1 = acc[ai][1][m][1] * s;
                    const f32x4 x0 = a0 * ct[m][0] - b0 * st[m][0], x1 = a1 * ct[m][1] - b1 * st[m][1], y0 = b0 * ct[m][0] + a0 * st[m][0], y1 = b1 * ct[m][1] + a1 * st[m][1];
                    if constexpr (F8OUT) { unsigned char* rp8 = (unsigned char*)Q + (size_t)row * NQ + h * DQH + DNOPE + 8 * fq;
                        u32x2 w8; w8.x = pk4_fp8(x0[0], x0[1], x0[2], x0[3]); w8.y = pk4_fp8(x1[0], x1[1], x1[2], x1[3]); *(u32x2*)rp8 = w8;
                        w8.x = pk4_fp8(y0[0], y0[1], y0[2], y0[3]); w8.y = pk4_fp8(y1[0], y1[1], y1[2], y1[3]); *(u32x2*)(rp8 + 32) = w8; }
                    else {
                    bf16_t* rp = Q + (size_t)row * NQ + h * DQH + DNOPE + 8 * fq;
                    u32x4 w; w.x = cvt_pk_bf16(x0[0], x0[1]); w.y = cvt_pk_bf16(x0[2], x0[3]); w.z = cvt_pk_bf16(x1[0], x1[1]); w.w = cvt_pk_bf16(x1[2], x1[3]);
                    *(u32x4*)rp = w;
                    w.x = cvt_pk_bf16(y0[0], y0[1]); w.y = cvt_pk_bf16(y0[2], y0[3]); w.z = cvt_pk_bf16(y1[0], y1[1]); w.w = cvt_pk_bf16(y1[2], y1[3]);
                    *(u32x4*)(rp + 32) = w; } } }
        } else {
#pragma unroll
            for (int ai = 0; ai < 2; ++ai)
#pragma unroll
                for (int m = 0; m < 4; ++m) { const int row = row0 + ai * HALF + m * 16; const float s = sc[ai][m] * (F8OUT ? FP8_SQ : 1.0f);
#pragma unroll
                    for (int bj = 0; bj < 2; ++bj) { const int h = 2 * (u.pn - 2) + bj; const f32x4 v0 = acc[ai][bj][m][0] * s, v1 = acc[ai][bj][m][1] * s;
                        if constexpr (F8OUT) { u32x2 w8; w8.x = pk4_fp8(v0[0], v0[1], v0[2], v0[3]); w8.y = pk4_fp8(v1[0], v1[1], v1[2], v1[3]); *(u32x2*)((unsigned char*)Q + (size_t)row * NQ + h * DQH + wc * 32 + 8 * fq) = w8; }
                        else { u32x4 w; w.x = cvt_pk_bf16(v0[0], v0[1]); w.y = cvt_pk_bf16(v0[2], v0[3]); w.z = cvt_pk_bf16(v1[0], v1[1]); w.w = cvt_pk_bf16(v1[2], v1[3]);
                        *(u32x4*)(Q + (size_t)row * NQ + h * DQH + wc * 32 + 8 * fq) = w; } } }
        }
    }
};

__device__ __forceinline__ unsigned gather_off(const Unit& u, int idx, unsigned lda_b, unsigned cb) { const int tok = idx < u.nrows ? u.rows[idx] : 0; return (unsigned)tok * lda_b + cb; }
__device__ __forceinline__ u32x4 gather_offs(const Unit& u, int tid, unsigned lda_b) {
    const int t2 = launder_v(tid); int R0, C0, R1, C1; stage_rc(t2 * 16, R0, C0); stage_rc(t2 * 16 + 8192, R1, C1);
    u32x4 pk; pk.x = gather_off(u, R0, lda_b, (unsigned)C0 * 2u); pk.y = gather_off(u, R1, lda_b, (unsigned)C1 * 2u); pk.z = gather_off(u, HALF + R0, lda_b, (unsigned)C0 * 2u); pk.w = gather_off(u, HALF + R1, lda_b, (unsigned)C1 * 2u);
    return pk;
}
typedef int i32x4 __attribute__((ext_vector_type(4)));
typedef int i32x8 __attribute__((ext_vector_type(8)));
template <class Epi, class Sched, bool GATHER, bool FP8 = false>
__device__ __forceinline__ void gemm_phase(LAS unsigned char* lds, const unsigned lda_b, const unsigned ldb_b, const int Kb, const Sched& S, const Epi& E, const unsigned stag_ticks = 0u) {
    if (stag_ticks) { const unsigned long long t0 = __builtin_amdgcn_s_memrealtime(), dl = (unsigned long long)((blockIdx.x >> 3) & 3u) * stag_ticks;
        while (__builtin_amdgcn_s_memrealtime() - t0 < dl) __builtin_amdgcn_s_sleep(8); }
    const int tid = launder_v((int)threadIdx.x), wid = __builtin_amdgcn_readfirstlane(tid >> 6), lane = tid & 63, wr = wid >> 2, wc = wid & 3, fr = lane & 15, fq = lane >> 4;
    int nt = Kb / (BK * 2); asm volatile("" : "+s"(nt));
    unsigned voffA[2], voffB[2];
#pragma unroll
    for (int i = 0; i < 2; ++i) { int R, C; stage_rc(tid * 16 + i * 8192, R, C); const int Rb = Epi::PERM ? ((R & ~31) + perm32(R & 31)) : R;
        voffA[i] = (unsigned)R * lda_b + (unsigned)C * 2u; voffB[i] = (unsigned)Rb * ldb_b + (unsigned)C * 2u; }
    const size_t kstep = (size_t)(BK * 2);
    const size_t hstepA = (size_t)HALF * lda_b, hstepB = (size_t)HALF * ldb_b;
    const unsigned ldsw = (unsigned)wid * 1024u, ldsbase = (unsigned)__builtin_amdgcn_readfirstlane((int)(unsigned)(size_t)lds);
    const int aoff = lds_byte(wr * 64 + fr, fq * 8), boff = lds_byte(wc * 32 + fr, fq * 8);
    unsigned cv0[2] = {0u, 0u}, cv1[2] = {0u, 0u}, nv0[2] = {0u, 0u}, nv1[2] = {0u, 0u};
#define PG8_SA(b, h) (((b) * 2 + (h)) * HTB)
#define PG8_SB(b, h) ((4 + (b) * 2 + (h)) * HTB)
#define PG8_LOAD16(sbase, voff, ldsoff) do { unsigned _keep; asm volatile("s_mov_b32 %0, m0\n\ts_mov_b32 m0, %3\n\ts_nop 0\n\tglobal_load_lds_dwordx4 %1, %2\n\ts_mov_b32 m0, %0" \
        : "=&s"(_keep) : "v"(voff), "s"(sbase), "s"(ldsbase + (unsigned)(ldsoff)) : "memory"); } while (0)
#define PG8_STAGE_B(bufoff, gbase, h) do { _Pragma("unroll") for (int _i = 0; _i < 2; ++_i) PG8_LOAD16((gbase) + (h) * hstepB, voffB[_i], (bufoff) + ldsw + _i * 8192); } while (0)
#define PG8_STAGE_A(bufoff, gbase, h, usenext) do { _Pragma("unroll") for (int _i = 0; _i < 2; ++_i) { unsigned _vo; \
        if constexpr (GATHER) { _vo = (usenext) ? ((h) ? nv1[_i] : nv0[_i]) : ((h) ? cv1[_i] : cv0[_i]); PG8_LOAD16((gbase), _vo, (bufoff) + ldsw + _i * 8192); } \
        else { PG8_LOAD16((gbase) + (h) * hstepA, voffA[_i], (bufoff) + ldsw + _i * 8192); } } } while (0)
#define PG8_LD32(off) __builtin_shufflevector(*(const LAS i32x4*)(lds + (off)), *(const LAS i32x4*)(lds + (off) + 1024), 0, 1, 2, 3, 4, 5, 6, 7)
#define PG8_LDA(dst, b, h) do { _Pragma("unroll") for (int m = 0; m < 4; ++m) { if constexpr (FP8) { dst##8[m] = PG8_LD32(PG8_SA(b, h) + aoff + m * 2048); } else { _Pragma("unroll") for (int k = 0; k < 2; ++k) dst[m][k] = *(const LAS bf16x8*)(lds + PG8_SA(b, h) + aoff + m * 2048 + k * 1024); } } } while (0)
#define PG8_LDB(dst, b, h) do { _Pragma("unroll") for (int n = 0; n < 2; ++n) { if constexpr (FP8) { dst##8[n] = PG8_LD32(PG8_SB(b, h) + boff + n * 2048); } else { _Pragma("unroll") for (int k = 0; k < 2; ++k) dst[n][k] = *(const LAS bf16x8*)(lds + PG8_SB(b, h) + boff + n * 2048 + k * 1024); } } } while (0)
#define PG8_MMA(ai, bj, At, Bt) do { __builtin_amdgcn_s_setprio(1); _Pragma("unroll") for (int m = 0; m < 4; ++m) _Pragma("unroll") for (int n = 0; n < 2; ++n) { \
        if constexpr (FP8) { asm volatile("v_mfma_f32_16x16x128_f8f6f4 %0, %1, %2, %0" : "+v"(acc[ai][bj][m][n]) : "v"(Bt##8[n]), "v"(At##8[m])); }     \
        else { _Pragma("unroll") for (int k = 0; k < 2; ++k) acc[ai][bj][m][n] = __builtin_amdgcn_mfma_f32_16x16x32_bf16(Bt[n][k], At[m][k], acc[ai][bj][m][n], 0, 0, 0); } } \
        __builtin_amdgcn_s_setprio(0); } while (0)
#define PG8_WAIT_V(n) asm volatile("s_waitcnt vmcnt(" #n ")" ::: "memory")
#define PG8_WAIT_L(n) asm volatile("s_waitcnt lgkmcnt(" #n ")" ::: "memory")
#define PG8_BAR __builtin_amdgcn_s_barrier()
#define PG8_SCHED __builtin_amdgcn_sched_barrier(0)
    Unit cur, nxt; int ui = 0;
    (void)S.next(0, cur);
    f32x4 acc[2][2][4][2];
#pragma unroll
    for (int a = 0; a < 2; ++a)
#pragma unroll
        for (int b = 0; b < 2; ++b)
#pragma unroll
            for (int m = 0; m < 4; ++m)
#pragma unroll
                for (int n = 0; n < 2; ++n) acc[a][b][m][n] = (f32x4){0.f, 0.f, 0.f, 0.f};
    bf16x8 At[4][2], B0[2][2], B1[2][2]; i32x8 At8[4], B08[2], B18[2];
    const char* cA = cur.a; const char* cB = cur.b;
    if constexpr (GATHER) { const u32x4 pk = gather_offs(cur, tid, lda_b); cv0[0] = pk.x; cv0[1] = pk.y; cv1[0] = pk.z; cv1[1] = pk.w; }
    PG8_STAGE_B(PG8_SB(0, 0), cB, 0); PG8_SCHED; PG8_STAGE_B(PG8_SB(0, 1), cB, 1); PG8_SCHED; PG8_STAGE_A(PG8_SA(0, 0), cA, 0, false); PG8_SCHED; PG8_STAGE_A(PG8_SA(0, 1), cA, 1, false);
    if (wr == 1) PG8_BAR;
    PG8_WAIT_V(2); PG8_BAR;
    PG8_STAGE_B(PG8_SB(1, 0), cB + kstep, 0); PG8_SCHED; PG8_STAGE_A(PG8_SA(1, 0), cA + kstep, 0, false); PG8_SCHED; PG8_STAGE_B(PG8_SB(1, 1), cB + kstep, 1);
    PG8_WAIT_V(6); PG8_BAR;
    for (;;) {
        int has_next = 0; const char* nA = cA; const char* nB = cB;
        if constexpr (GATHER) { has_next = __builtin_amdgcn_readfirstlane(S.next(ui + 1, nxt) ? 1 : 0); nA = has_next ? nxt.a : cA; nB = has_next ? nxt.b : cB; }
        if constexpr (GATHER) {
            u32x4 pk = (u32x4){cv0[0], cv0[1], cv1[0], cv1[1]}; if (has_next) pk = gather_offs(nxt, tid, lda_b);
            *(LAS u32x4*)(lds + STAGE_BYTES + 1024 + tid * 16) = pk;
        }
#pragma nounroll
        for (int t = 0; t < nt; t += 2) {
            const bool last = (t == nt - 2);
            if constexpr (!GATHER) { if (last) { int uin = ui + 1; asm volatile("" : "+s"(uin)); has_next = __builtin_amdgcn_readfirstlane(S.next(uin, nxt) ? 1 : 0); nA = has_next ? nxt.a : cA; nB = has_next ? nxt.b : cB; } }
            if constexpr (GATHER) { if (last) { const u32x4 pk = *(const LAS u32x4*)(lds + STAGE_BYTES + 1024 + tid * 16); nv0[0] = pk.x; nv0[1] = pk.y; nv1[0] = pk.z; nv1[1] = pk.w; } }
            const char* a1 = cA + (size_t)(t + 1) * kstep;
            const char* a2 = last ? nA : cA + (size_t)(t + 2) * kstep; const char* b2 = last ? nB : cB + (size_t)(t + 2) * kstep;
            const char* a3 = a2 + kstep; const char* b3 = b2 + kstep;
            PG8_LDB(B0, 0, 0); PG8_LDB(B1, 0, 1); PG8_SCHED; PG8_LDA(At, 0, 0); PG8_STAGE_A(PG8_SA(1, 1), a1, 1, false);
            PG8_WAIT_V(8); PG8_WAIT_L(0); PG8_BAR; PG8_MMA(0, 0, At, B0); PG8_MMA(0, 1, At, B1); PG8_BAR; PG8_SCHED;
            PG8_LDA(At, 0, 1); PG8_STAGE_B(PG8_SB(0, 0), b2, 0); PG8_STAGE_B(PG8_SB(0, 1), b2, 1); PG8_STAGE_A(PG8_SA(0, 0), a2, 0, last);
            PG8_WAIT_V(8); PG8_WAIT_L(0); PG8_BAR; PG8_MMA(1, 0, At, B0); PG8_MMA(1, 1, At, B1); PG8_BAR; PG8_SCHED;
            PG8_LDB(B0, 1, 0); PG8_LDB(B1, 1, 1); PG8_SCHED; PG8_LDA(At, 1, 0); PG8_STAGE_A(PG8_SA(0, 1), a2, 1, last);
            PG8_WAIT_V(8); PG8_WAIT_L(0); PG8_BAR; PG8_MMA(0, 0, At, B0); PG8_MMA(0, 1, At, B1); PG8_BAR; PG8_SCHED;
            PG8_LDA(At, 1, 1); PG8_STAGE_B(PG8_SB(1, 0), b3, 0); PG8_STAGE_B(PG8_SB(1, 1), b3, 1); PG8_STAGE_A(PG8_SA(1, 0), a3, 0, last);
            PG8_WAIT_V(8); PG8_WAIT_L(0); PG8_BAR; PG8_MMA(1, 0, At, B0); PG8_MMA(1, 1, At, B1); PG8_BAR; PG8_SCHED;
        }
        if (wr == 0) PG8_BAR;
        if constexpr (FP8) asm volatile("s_nop 15\n\ts_nop 15" ::: "memory");
        E(acc, cur, wr, wc, fr, fq);
        if (!has_next) break;
#pragma unroll
        for (int a = 0; a < 2; ++a)
#pragma unroll
            for (int b = 0; b < 2; ++b)
#pragma unroll
                for (int m = 0; m < 4; ++m)
#pragma unroll
                    for (int n = 0; n < 2; ++n) acc[a][b][m][n] = (f32x4){0.f, 0.f, 0.f, 0.f};
        cur = nxt; cA = nA; cB = nB; ++ui;
        if constexpr (GATHER) {
#pragma unroll
            for (int i = 0; i < 2; ++i) { cv0[i] = nv0[i]; cv1[i] = nv1[i]; }
        }
        if (wr == 1) PG8_BAR;
    }
    PG8_WAIT_V(0);
    PG8_BAR;
#undef PG8_SA
#undef PG8_SB
#undef PG8_LOAD16
#undef PG8_STAGE_A
#undef PG8_STAGE_B
#undef PG8_LDA
#undef PG8_LDB
#undef PG8_LD32
#undef PG8_MMA
#undef PG8_WAIT_V
#undef PG8_WAIT_L
#undef PG8_BAR
#undef PG8_SCHED
}
}
namespace att {
constexpr int NW = 8, QBLK = 32, KVBLK = 64, QB = NW * QBLK;
constexpr int DQK = 192, DV = 128;
constexpr int QS = NQ, KNS = NKV, KRS = DROPE, OS = DM;
constexpr int SHM_V = KVBLK * DV * 2, SHM_K = KVBLK * DQK * 2;
constexpr int LDS_QR = 2 * SHM_V + 2 * SHM_K + NW * 64 * 4;
constexpr int LDS_BYTES = LDS_QR + NW * 4096;
constexpr float SCALE = 0.07216878364870322f;
constexpr float THR = 8.f;
#define KSWZ(row, ch) ((row) * 384 + ((((ch) ^ (((row) >> 1) & 7))) << 4))
#define SBAR() __builtin_amdgcn_sched_barrier(0)
__device__ __forceinline__ int v_st(int k, int c) { const int kk = (k & ~0xC) | ((k & 4) << 1) | ((k & 8) >> 1); return ((kk >> 3) * 4 + (c >> 5)) * 512 + ((kk & 7) * 32 + (c & 31)) * 2; }
__device__ __forceinline__ int v_rd_base(int lane) { return ((lane & 3) << 3) | (((lane >> 2) & 3) << 6) | (((lane >> 4) & 1) << 5) | (((lane >> 5) & 1) << 8); }
constexpr int v_rd_off(int d0, int ks, int half) { return d0 * 512 + ks * 4096 + half * 2048; }
__device__ __forceinline__ int crow(int r, int hi) { return (r & 3) + 8 * (r >> 2) + 4 * hi; }
__device__ __forceinline__ void mask_tile(f32x16& p0, f32x16& p1, int dq) {
    const float NEG = -__builtin_inff();
#pragma unroll
    for (int r = 0; r < 16; ++r) {
        const int c = (r & 3) + 8 * (r >> 2);
        if (dq - c < 0) p0[r] = NEG;
        if (dq - c - 32 < 0) p1[r] = NEG;
    }
}
__device__ __forceinline__ void partialSM(f32x16& p0, f32x16& p1, float& m_reg, float& mn, float& alpha) {
    float pmax = p0[0]; for (int r = 1; r < 16; ++r) pmax = fmaxf(pmax, p0[r]); for (int r = 0; r < 16; ++r) pmax = fmaxf(pmax, p1[r]);
    { auto rr = __builtin_amdgcn_permlane32_swap(__float_as_uint(pmax), __float_as_uint(pmax), false, false);
      pmax = fmaxf(__uint_as_float(rr[0]), __uint_as_float(rr[1])); }
    constexpr float C2 = 1.4426950408889634f * SCALE;
    if (__builtin_expect(__all((pmax - m_reg) * SCALE <= THR), 1)) { mn = m_reg; alpha = 1.f; }
    else { mn = fmaxf(m_reg, pmax); alpha = __builtin_amdgcn_exp2f((m_reg - mn) * C2); m_reg = mn; }
    const float mnL = -mn * C2;
    for (int r = 0; r < 16; ++r) p0[r] = fmaf(p0[r], C2, mnL); for (int r = 0; r < 16; ++r) p1[r] = fmaf(p1[r], C2, mnL);
    for (int r = 0; r < 16; ++r) p0[r] = __builtin_amdgcn_exp2f(p0[r]);
}
__device__ __forceinline__ void finishSM(f32x16& p0, f32x16& p1, float alpha, float& l_reg, bf16x8& pa0, bf16x8& pa1, bf16x8& pa2, bf16x8& pa3) {
    for (int r = 0; r < 16; ++r) p1[r] = __builtin_amdgcn_exp2f(p1[r]);
    float ps = 0; for (int r = 0; r < 16; ++r) ps += p0[r]; for (int r = 0; r < 16; ++r) ps += p1[r];
    { auto rr = __builtin_amdgcn_permlane32_swap(__float_as_uint(ps), __float_as_uint(ps), false, false);
      ps = __uint_as_float(rr[0]) + __uint_as_float(rr[1]); }
    l_reg = l_reg * alpha + ps;
#define PK4(P, B_, OUT) do { unsigned a0 = cvt_pk_bf16(P[B_+0], P[B_+1]), a1 = cvt_pk_bf16(P[B_+2], P[B_+3]);                          \
        unsigned b0 = cvt_pk_bf16(P[B_+4], P[B_+5]), b1 = cvt_pk_bf16(P[B_+6], P[B_+7]);                                             \
        auto r0 = __builtin_amdgcn_permlane32_swap(a0, b0, false, false); auto r1 = __builtin_amdgcn_permlane32_swap(a1, b1, false, false); \
        u32x4 w = {r0[0], r1[0], r0[1], r1[1]}; OUT = *reinterpret_cast<bf16x8*>(&w); } while (0)
    PK4(p0, 0, pa0); PK4(p0, 8, pa1); PK4(p1, 0, pa2); PK4(p1, 8, pa3);
#undef PK4
}
template <int KB>
__device__ __forceinline__ void qkt(f32x16& p0, f32x16& p1, const char* K_lds, int r32, int hi, const bf16x8* qr, const char* qrl) {
    p0 = f32x16{}; p1 = f32x16{};
    const char* kb[4];
#pragma unroll
    for (int dd = 0; dd < 4; ++dd) kb[dd] = K_lds + KB * SHM_K + KSWZ(r32, dd * 2 + hi);
    bf16x8 k0[3], k1[3], qx[4];
#define QK_LDK(d0_, s_) do { const char* a_ = kb[(d0_) & 3] + ((d0_) >> 2) * 128; k0[s_] = *reinterpret_cast<const bf16x8*>(a_); k1[s_] = *reinterpret_cast<const bf16x8*>(a_ + 32 * 384); } while (0)
    QK_LDK(0, 0); QK_LDK(1, 1);
#pragma unroll
    for (int d0 = 0; d0 < 12; ++d0) {
        if (d0 + 2 < 12) QK_LDK(d0 + 2, (d0 + 2) % 3);
        if (d0 >= 4 && d0 < 8) qx[d0 - 4] = *reinterpret_cast<const bf16x8*>(qrl + (d0 - 4) * 1024);
        SBAR();
        const bf16x8 qf = d0 < 8 ? qr[d0 & 7] : qx[(d0 - 8) & 3];
        p0 = __builtin_amdgcn_mfma_f32_32x32x16_bf16(k0[d0 % 3], qf, p0, 0, 0, 0);
        p1 = __builtin_amdgcn_mfma_f32_32x32x16_bf16(k1[d0 % 3], qf, p1, 0, 0, 0);
        SBAR(); }
#undef QK_LDK
}
template <int VB>
__device__ __forceinline__ void pv_tile(f32x16* o, int vb0, bf16x8 pa0, bf16x8 pa1, bf16x8 pa2, bf16x8 pa3) {
#define TRRD(dst, off) asm volatile("ds_read_b64_tr_b16 %0, %1 offset:%2" : "=&v"(dst) : "v"(vb0), "i"(off) : "memory")
#define PV_D0(d0) do { s16x4 l0, l1, l2, l3, h0, h1, h2, h3; constexpr int b_ = VB * SHM_V + v_rd_off(d0, 0, 0); \
        TRRD(l0, b_); TRRD(h0, b_ + 2048); TRRD(l1, b_ + 4096); TRRD(h1, b_ + 6144); TRRD(l2, b_ + 8192); TRRD(h2, b_ + 10240); TRRD(l3, b_ + 12288); TRRD(h3, b_ + 14336); \
        asm volatile("s_waitcnt lgkmcnt(0)" ::: "memory"); SBAR();   \
        o[d0] = __builtin_amdgcn_mfma_f32_32x32x16_bf16(pa0, (bf16x8){l0[0], l0[1], l0[2], l0[3], h0[0], h0[1], h0[2], h0[3]}, o[d0], 0, 0, 0);   \
        o[d0] = __builtin_amdgcn_mfma_f32_32x32x16_bf16(pa1, (bf16x8){l1[0], l1[1], l1[2], l1[3], h1[0], h1[1], h1[2], h1[3]}, o[d0], 0, 0, 0);   \
        o[d0] = __builtin_amdgcn_mfma_f32_32x32x16_bf16(pa2, (bf16x8){l2[0], l2[1], l2[2], l2[3], h2[0], h2[1], h2[2], h2[3]}, o[d0], 0, 0, 0);   \
        o[d0] = __builtin_amdgcn_mfma_f32_32x32x16_bf16(pa3, (bf16x8){l3[0], l3[1], l3[2], l3[3], h3[0], h3[1], h3[2], h3[3]}, o[d0], 0, 0, 0); } while (0)
    PV_D0(0); PV_D0(1); PV_D0(2); PV_D0(3);
#undef PV_D0
#undef TRRD
}
struct BlockRef { const bf16_t* Q; const bf16_t* Kn; const bf16_t* Kr; const bf16_t* V; bf16_t* O; int P0; };
constexpr float SO8 = 16.0f;
struct Seam { bf16x8 qr[8]; bf16x8 st_v0, st_v1, st_k0, st_k1, st_k2; };
#define VMW() asm volatile("s_waitcnt vmcnt(0)" ::: "memory")
#define VMWN(n) asm volatile("s_waitcnt vmcnt(%0)" :: "i"(n) : "memory")
#define LD8(p) (*reinterpret_cast<const bf16x8*>(p))
#define SLOAD_H(R_, k0) do { S.st_v0 = LD8((R_).V + (size_t)((k0) + sr) * KNS + sc); S.st_v1 = LD8((R_).V + (size_t)((k0) + 32 + sr) * KNS + sc);              \
                             S.st_k0 = LD8((R_).Kn + (size_t)((k0) + sr) * KNS + sc); S.st_k1 = LD8((R_).Kn + (size_t)((k0) + 32 + sr) * KNS + sc);            \
                             S.st_k2 = LD8((R_).Kr + (size_t)((k0) + rr) * KRS + rc); } while (0)
#define SWRITE_HK(bf) do { *(bf16x8*)(K_lds + (bf) * SHM_K + kws) = S.st_k0; *(bf16x8*)(K_lds + (bf) * SHM_K + kws + 32 * 384) = S.st_k1; *(bf16x8*)(K_lds + (bf) * SHM_K + kws2) = S.st_k2; } while (0)
#define SWRITE_HV(bf) do { *(bf16x8*)(V_lds + (bf) * SHM_V + vst0) = S.st_v0; *(bf16x8*)(V_lds + (bf) * SHM_V + vst1) = S.st_v1; } while (0)
#define SWRITE_H(bf) do { SWRITE_HV(bf); SWRITE_HK(bf); } while (0)
#define ATT_IDX const int tid = launder_v((int)threadIdx.x), wid = __builtin_amdgcn_readfirstlane(tid >> 6), lane = tid & 63, r32 = lane & 31, hi = lane >> 5; \
    const int sr = tid >> 4, sc = (tid & 15) * 8, rr = tid >> 3, rc = (tid & 7) * 8, kws = KSWZ(sr, (tid & 15)), kws2 = KSWZ(rr, 16 + (tid & 7));
__device__ __forceinline__ void attn_block(const BlockRef& cur, char* lds) {
    ATT_IDX;
    Seam S;
    const int P0_ = cur.P0 & ~1;
    const int NT = P0_ / KVBLK + QB / KVBLK;
    const int qlo = P0_ + wid * QBLK, qm = qlo + r32 - 4 * hi;
    char* V_lds = lds; char* K_lds = lds + 2 * SHM_V;
    float* ws = (float*)(lds + 2 * SHM_V + 2 * SHM_K) + wid * 64; float* li_l = ws, * al_l = ws + 32;
    float m_reg = -1e30f, l_reg = 0; f32x16 o[4] = {};
    const int vst0 = v_st(sr, sc), vst1 = v_st(32 + sr, sc);
    const int vb0 = (int)(uintptr_t)V_lds + v_rd_base(lane);
    char* qrl = lds + LDS_QR + wid * 4096 + lane * 16;
#define RESC(a) do { if (__any((a) < 1.f)) { if (hi == 0) al_l[r32] = (a); asm volatile("s_waitcnt lgkmcnt(0)" ::: "memory");              \
                     for (int d_ = 0; d_ < 4; ++d_) for (int r = 0; r < 16; ++r) o[d_][r] *= al_l[crow(r, hi)]; } } while (0)
#define KBASE(t) ((t) * KVBLK)
#define MASKT(P0_, P1_, t) do { const int kb_ = KBASE(t); if (kb_ + KVBLK - 1 > qlo) mask_tile(P0_, P1_, qm - kb_); } while (0)
    SLOAD_H(cur, 0);
    if (cur.P0 & 1) {
        const unsigned char* q8 = (const unsigned char*)cur.Q + (size_t)(wid * QBLK + r32) * QS + hi * 8; u32x2 qw[12];
#pragma unroll
        for (int d0 = 0; d0 < 12; ++d0) qw[d0] = *(const u32x2*)(q8 + d0 * 16);
#define Q8CVT(w_) ({ const u32x2 w__ = (w_); u32x4 o__; \
            o__.x = cvt_pk_bf16(__builtin_amdgcn_cvt_f32_fp8((int)w__.x, 0) * (1.0f / pg8::FP8_SQ), __builtin_amdgcn_cvt_f32_fp8((int)w__.x, 1) * (1.0f / pg8::FP8_SQ)); o__.y = cvt_pk_bf16(__builtin_amdgcn_cvt_f32_fp8((int)w__.x, 2) * (1.0f / pg8::FP8_SQ), __builtin_amdgcn_cvt_f32_fp8((int)w__.x, 3) * (1.0f / pg8::FP8_SQ)); \
            o__.z = cvt_pk_bf16(__builtin_amdgcn_cvt_f32_fp8((int)w__.y, 0) * (1.0f / pg8::FP8_SQ), __builtin_amdgcn_cvt_f32_fp8((int)w__.y, 1) * (1.0f / pg8::FP8_SQ)); o__.w = cvt_pk_bf16(__builtin_amdgcn_cvt_f32_fp8((int)w__.y, 2) * (1.0f / pg8::FP8_SQ), __builtin_amdgcn_cvt_f32_fp8((int)w__.y, 3) * (1.0f / pg8::FP8_SQ)); \
            *reinterpret_cast<bf16x8*>(&o__); })
#pragma unroll
        for (int d0 = 0; d0 < 8; ++d0) S.qr[d0] = Q8CVT(qw[d0]);
        *(bf16x8*)(qrl) = Q8CVT(qw[8]); *(bf16x8*)(qrl + 1024) = Q8CVT(qw[9]); *(bf16x8*)(qrl + 2048) = Q8CVT(qw[10]); *(bf16x8*)(qrl + 3072) = Q8CVT(qw[11]);
#undef Q8CVT
    } else {
#pragma unroll
    for (int d0 = 0; d0 < 8; ++d0) S.qr[d0] = LD8(cur.Q + (size_t)(wid * QBLK + r32) * QS + d0 * 16 + hi * 8);
    { bf16x8 t0 = LD8(cur.Q + (size_t)(wid * QBLK + r32) * QS + 128 + hi * 8), t1 = LD8(cur.Q + (size_t)(wid * QBLK + r32) * QS + 144 + hi * 8),
             t2 = LD8(cur.Q + (size_t)(wid * QBLK + r32) * QS + 160 + hi * 8), t3 = LD8(cur.Q + (size_t)(wid * QBLK + r32) * QS + 176 + hi * 8);
      *(bf16x8*)(qrl) = t0; *(bf16x8*)(qrl + 1024) = t1; *(bf16x8*)(qrl + 2048) = t2; *(bf16x8*)(qrl + 3072) = t3; }
    }
    VMW(); SWRITE_H(0);
    __syncthreads();
    f32x16 p0, p1; float mn, al; bf16x8 pa0, pa1, pa2, pa3;
#define TILE_STEP(t, BF) do {                                                                                                 \
        if ((t) + 1 < NT) { SLOAD_H(cur, KBASE((t) + 1)); }                                                                    \
        SBAR();                                                                                                               \
        if (KBASE(t) <= qlo + QBLK - 1) {     \
        qkt<BF>(p0, p1, K_lds, r32, hi, S.qr, qrl);                                                                           \
        MASKT(p0, p1, (t)); partialSM(p0, p1, m_reg, mn, al); RESC(al);                                                        \
        finishSM(p0, p1, al, l_reg, pa0, pa1, pa2, pa3); SBAR();                                                              \
        pv_tile<BF>(o, vb0, pa0, pa1, pa2, pa3); }                                                                            \
        if ((t) + 1 < NT) { VMW(); SWRITE_H(1 - BF); }                                                                         \
        __syncthreads(); } while (0)
    for (int t = 0; t < NT; t += 2) { TILE_STEP(t, 0); TILE_STEP(t + 1, 1); }
    if (hi == 0) li_l[r32] = l_reg; asm volatile("s_waitcnt lgkmcnt(0)" ::: "memory");
    float rli[16];
#pragma unroll
    for (int r = 0; r < 16; ++r) rli[r] = __builtin_amdgcn_rcpf(li_l[crow(r, hi)]);
    bf16_t* Ow = cur.O + (size_t)(wid * QBLK) * OS;
    if (cur.P0 & 1) {
        char* tl_ = lds + LDS_QR + wid * 4096;
#pragma unroll
        for (int r = 0; r < 16; ++r) { const int orow = crow(r, hi); const float sc_ = rli[r] * SO8;
#pragma unroll
            for (int d0 = 0; d0 < 4; ++d0) { const float v = o[d0][r] * sc_; *(unsigned char*)(tl_ + orow * 128 + d0 * 32 + r32) = (unsigned char)(__builtin_amdgcn_cvt_pk_fp8_f32(v, v, 0, false) & 0xff); } }
        asm volatile("s_waitcnt lgkmcnt(0)" ::: "memory");
        unsigned char* O8 = (unsigned char*)cur.O + (size_t)(wid * QBLK) * OS;
#pragma unroll
        for (int i = 0; i < 4; ++i) { const u32x4 w_ = *(const u32x4*)(tl_ + i * 1024 + lane * 16); *(u32x4*)(O8 + (size_t)(i * 8 + (lane >> 3)) * OS + (lane & 7) * 16) = w_; }
    } else {
        char* tl_ = lds + LDS_QR + wid * 4096;
#pragma unroll
        for (int hf = 0; hf < 2; ++hf) {
#pragma unroll
            for (int r = 0; r < 16; ++r) { const int orow = crow(r, hi);
#pragma unroll
                for (int dd = 0; dd < 2; ++dd) { const float v = o[hf * 2 + dd][r] * rli[r]; *(unsigned short*)(tl_ + orow * 128 + (dd * 32 + r32) * 2) = (unsigned short)(cvt_pk_bf16(v, v) & 0xffffu); } }
            asm volatile("s_waitcnt lgkmcnt(0)" ::: "memory");
#pragma unroll
            for (int i = 0; i < 4; ++i) { const u32x4 w_ = *(const u32x4*)(tl_ + i * 1024 + lane * 16); *(u32x4*)(Ow + (size_t)(i * 8 + (lane >> 3)) * OS + hf * 64 + (lane & 7) * 8) = w_; }
            asm volatile("s_waitcnt lgkmcnt(0)" ::: "memory");
        }
    }
    __syncthreads();
#undef RESC
#undef KBASE
#undef MASKT
#undef TILE_STEP
}
#undef VMW
#undef VMWN
#undef LD8
#undef SLOAD_H
#undef SWRITE_HK
#undef SWRITE_HV
#undef SWRITE_H
#undef ATT_IDX
#undef KSWZ
#undef SBAR

__device__ __forceinline__ BlockRef make_ref(int L, int pass, const bf16_t* Qb, const bf16_t* KNVb, const bf16_t* KRb, bf16_t* Ob, int o8) {
    const int bh = L >> 2, x = L & 3, qb = pass ? 7 - x : x, b = bh >> 3, h = bh & 7; const size_t rb = (size_t)b * SEQ;
    BlockRef r; { const size_t qe = (rb + (size_t)qb * QB) * QS + h * DQH; r.Q = o8 ? (const bf16_t*)((const unsigned char*)Qb + qe) : Qb + qe; } r.Kn = KNVb + rb * KNS + h * (DNOPE + DVH); r.Kr = KRb + rb * KRS; r.V = KNVb + rb * KNS + h * (DNOPE + DVH) + DNOPE;
    { const size_t oe = (rb + (size_t)qb * QB) * OS + h * DVH; r.O = o8 ? (bf16_t*)((unsigned char*)Ob + oe) : Ob + oe; } r.P0 = qb * QB + o8; return r;
}
__device__ __forceinline__ void attn_phase(char* lds, const bf16_t* Qb, const bf16_t* KNVb, const bf16_t* KRb, bf16_t* Ob, int first, int stride_o8  ) {
    const int stride = stride_o8 & 0x3fffffff;
    constexpr int total = NBATCH * NHEAD * 4;
    for (int L = first; L < total; L += stride) {
        for (int pass = 0; pass < 2; ++pass) { const BlockRef cur = make_ref(L, pass, Qb, KNVb, KRb, Ob, (stride_o8 >> 30) & 1); attn_block(cur, lds); }
    }
}
}
constexpr int NWAVES = 8;
constexpr size_t MiB = 1u << 20;
constexpr size_t WS_CTL = 0, CTL_ZERO_BYTES = 8 * MiB;
constexpr size_t WS_SSQ = 1 * MiB;
constexpr size_t WS_COS = 8 * MiB, WS_SIN = 16 * MiB;
constexpr size_t WS_LIST = 24 * MiB;
constexpr size_t WS_RSL = 26 * MiB;
constexpr size_t WS_TOKINFO = 28 * MiB;
constexpr size_t WS_WDN = 30 * MiB, WS_WUQ = 34 * MiB, WS_WUKV = 37 * MiB, WS_WO = 39 * MiB, WS_WPOOL = 43 * MiB, WS_WGU = 44 * MiB, WS_WD = 65 * MiB, WS_MWGU = 76 * MiB, WS_MWD = 164 * MiB;
constexpr size_t WS_H = 208 * MiB;
constexpr size_t WS_ACT = 336 * MiB;
constexpr size_t WS_DOWN = WS_ACT;
constexpr size_t WS_CQN = WS_ACT + 128 * MiB, WS_CKVN = WS_ACT + 192 * MiB, WS_KR = WS_ACT + 224 * MiB, WS_Q = WS_ACT + 232 * MiB, WS_KNV = WS_ACT + 424 * MiB;
constexpr size_t WS_HID = WS_ACT;
constexpr size_t WS_YB = WS_ACT + 358 * MiB;
constexpr size_t WS_DUMMY = WS_ACT + 424 * MiB;
constexpr size_t WS_H8 = WS_ACT + 618 * MiB;
constexpr int FFD8 = 2816;
constexpr int FFE8 = 1536;
constexpr size_t WS_END = WS_ACT + 682 * MiB;
static_assert(WS_MWD + (size_t)16 * 1024 * FFEP * 2 <= WS_H && WS_MWGU + (size_t)16 * 2 * FFEP * 1024 * 2 <= WS_MWD && WS_WD + (size_t)2 * 1024 * FFD * 2 <= WS_MWGU && WS_WGU + (size_t)2 * 2 * FFD * 1024 * 2 <= WS_WD, "weights map");
static_assert(WS_HID + (size_t)PSLOT * FFEP * 2 <= WS_YB && WS_YB + (size_t)PSLOT * 1024 * 2 <= WS_END && WS_HID + (size_t)NTOK * FFD * 2 <= WS_END && WS_KNV + (size_t)NTOK * NKV * 2 <= WS_END && WS_Q + (size_t)NTOK * NQ * 2 <= WS_KNV, "activation map");
static_assert(WS_SSQ + (size_t)14 * NTOK * 8 <= WS_COS && WS_COS <= CTL_ZERO_BYTES + WS_COS && WS_END <= 1024 * MiB, "map");
constexpr int CW_TMO = 0, CW_CODE = 1, CW_CNT = 1024  , CW_DBG = 2048, CW_BAR = 4096  ;
constexpr int LDSCTL_OFF = 0, LDSCTL_BYTES = 1024, MISC_OFF = LDSCTL_OFF + 320, RING_OFF = LDSCTL_BYTES, RING_BYTES = 131072, LDS_BYTES = 147456;

typedef GAS unsigned gu32;
#define RLX_AGENT __ATOMIC_RELAXED, __HIP_MEMORY_SCOPE_AGENT
#define LDS_WAIT() asm volatile("s_waitcnt lgkmcnt(0)" ::: "memory")
#define VM_WAIT() asm volatile("s_waitcnt vmcnt(0)" ::: "memory")

#define XB_TMO      128
#define XB_XCNT(j)  (256  + 64 * (j))
#define XB_XSUB(j)  (1280 + 64 * (j))
#define XB_XGEN(j)  (2304 + 64 * (j))
#define XB_TOP      3328
#define XB_TOPGEN   3392
#define XCD_BAR_WORDS 3456
#define XB_SPIN_CAP (1u << 18)
__device__ __forceinline__ unsigned xb_ld(unsigned* p)              { return __hip_atomic_load(p, __ATOMIC_RELAXED, __HIP_MEMORY_SCOPE_AGENT); }
__device__ __forceinline__ unsigned xb_add(unsigned* p, unsigned v) { return __hip_atomic_fetch_add(p, v, __ATOMIC_RELAXED, __HIP_MEMORY_SCOPE_AGENT); }
__device__ __forceinline__ unsigned xb_xcc_id() { return (unsigned)__builtin_amdgcn_s_getreg((3 << 11) | 20) & 0xFu; }
#define XB_SPIN(cond, bar) do { unsigned _sp = 0; while (cond) { __builtin_amdgcn_s_sleep(1); \
    if ((++_sp & 255u) == 0u) { if (xb_ld(&(bar)[XB_TMO])) break; if (_sp > XB_SPIN_CAP) { atomicAdd(&(bar)[XB_TMO], 1u); break; } } } } while (0)
__device__ __forceinline__ unsigned rfl(unsigned v);
struct XcdBarrier { unsigned* bar; unsigned x; volatile LAS unsigned* st; };
__device__ __forceinline__ XcdBarrier xcd_barrier_post(unsigned* bar, volatile LAS unsigned* st) {
    XcdBarrier b; b.bar = bar; b.x = xb_xcc_id(); b.st = st;
    if (threadIdx.x == 0) (void)xb_add(&bar[XB_XCNT(b.x)], 1u);
    return b;
}
__device__ __forceinline__ void xcd_barrier_complete(unsigned* bar, unsigned x, unsigned& nloc, unsigned& nx) {
    const unsigned G = gridDim.x * gridDim.y * gridDim.z;
    unsigned sum, cnt, mine, sp = 0u;
    for (;;) {
        sum = 0u; cnt = 0u; mine = 0u;
#pragma unroll
        for (unsigned j = 0; j < 16; ++j) { const unsigned c = xb_ld(&bar[XB_XCNT(j)]); sum += c; cnt += (c > 0u) ? 1u : 0u; mine = (j == x) ? c : mine; }
        if (sum == G) break;
        __builtin_amdgcn_s_sleep(1);
        if ((++sp & 255u) == 0u) { if (xb_ld(&bar[XB_TMO])) break; if (sp > XB_SPIN_CAP) { atomicAdd(&bar[XB_TMO], 1u); break; } }
    }
    nloc = mine > 0u ? mine : 1u; nx = cnt > 0u ? cnt : 1u;
}
__device__ __forceinline__ void xcd_barrier(const XcdBarrier& b) {
    unsigned* bar; { const volatile LAS unsigned* p_ = b.st + 2; const unsigned lo_ = rfl(p_[0]), hi_ = rfl(p_[1]); bar = (unsigned*)(((unsigned long long)hi_ << 32) | lo_); }
    asm volatile("s_waitcnt vmcnt(0)" ::: "memory");
    __syncthreads();
    if (threadIdx.x == 0) {
        __builtin_amdgcn_s_waitcnt(0);
        unsigned nloc = b.st[0], nx = b.st[1];
        if (nloc == 0u) { xcd_barrier_complete(bar, b.x, nloc, nx); b.st[0] = nloc; b.st[1] = nx; }
        const unsigned old = xb_add(&bar[XB_XSUB(b.x)], 1u);
        const unsigned gen = old / nloc;
        if (old + 1u == (gen + 1u) * nloc) {
            __builtin_amdgcn_fence(__ATOMIC_RELEASE, "agent");
            asm volatile("s_waitcnt vmcnt(0)" ::: "memory");
            const unsigned og = xb_add(&bar[XB_TOP], 1u);
            const unsigned tg = og / nx;
            if (og + 1u == (tg + 1u) * nx) xb_add(&bar[XB_TOPGEN], 1u);
            else XB_SPIN(xb_ld(&bar[XB_TOPGEN]) == tg, bar);
            __builtin_amdgcn_fence(__ATOMIC_ACQUIRE, "agent");
            xb_add(&bar[XB_XGEN(b.x)], 1u);
            asm volatile("s_waitcnt vmcnt(0)" ::: "memory");
        } else {
            XB_SPIN(xb_ld(&bar[XB_XGEN(b.x)]) == gen, bar);
            __builtin_amdgcn_fence(__ATOMIC_ACQUIRE, "agent");
            asm volatile("s_waitcnt vmcnt(0)" ::: "memory");
        }
    }
    __syncthreads();
}

__device__ __forceinline__ unsigned rfl(unsigned v);
__device__ __forceinline__ const float* ptab(LAS unsigned char* L, int i);
struct Frame { LAS unsigned char* lds; volatile LAS unsigned* MISC; gu32* ctl; unsigned char* ws; int tid, lane, wave, vcu, G, bx; };

__device__ __forceinline__ float wave_sum(float v) {
#pragma unroll
    for (int o = 1; o < 64; o <<= 1) v += __shfl_xor(v, o);
    return v;
}
__device__ __forceinline__ unsigned rfl(unsigned v) { return (unsigned)__builtin_amdgcn_readfirstlane((int)v); }

__device__ __forceinline__ int rowmap(int mode, int n) {
    if (mode == 0) return n;
    if (mode == 1) return (n >> 7) * 256 + (n & 127);
    if (mode == 2) return (n >> 7) * 256 + 128 + (n & 127);
    if (mode == 4) return n < 800 ? n : 896 + (n - 800);
    const int h = n / DQH, d = n - h * DQH;
    if (d < DNOPE) return 512 + h * DNOPE + d;
    if (d < DNOPE + 32) return (h >> 2) * 256 + (h & 3) * 32 + (d - DNOPE);
    return (h >> 2) * 256 + 128 + (h & 3) * 32 + (d - DNOPE - 32);
}
__device__ __forceinline__ void transpose_item(const float* W, int N, bf16_t* WT, int ldd, int mode, const float* kscale, const float* nscale, int item, int lane) {
    const int nblk = N / 64, kb = item / nblk, nb = item % nblk, k0 = 64 * kb, n = 64 * nb + lane;
    const float sn = nscale ? nscale[n] : 1.0f;
    const int ksv = __float_as_int(kscale ? kscale[k0 + lane] : 1.0f);
    const float* wp = W + (size_t)k0 * N + n;
    bf16_t* op = WT + (size_t)rowmap(mode, n) * ldd + k0;
    float w[64];
#pragma unroll
    for (int i = 0; i < 64; ++i) w[i] = __builtin_nontemporal_load(wp + (size_t)i * N);
#pragma unroll
    for (int kg = 0; kg < 8; ++kg) { float v[8];
#pragma unroll
        for (int i = 0; i < 8; ++i) { const float sk = __int_as_float(__builtin_amdgcn_readlane(ksv, 8 * kg + i)); v[i] = w[8 * kg + i] * (sk * sn); }
        u32x4 o; o.x = cvt_pk_bf16(v[0], v[1]); o.y = cvt_pk_bf16(v[2], v[3]); o.z = cvt_pk_bf16(v[4], v[5]); o.w = cvt_pk_bf16(v[6], v[7]);
        *(GAS u32x4*)(op + 8 * kg) = o; }
}
__device__ __forceinline__ void transpose_item_f8(const float* W, int N, unsigned char* WT, int ldd, int mode, const float* kscale, int item, int lane) {
    const int nblk = N / 64, kb = item / nblk, nb = item % nblk, k0 = 64 * kb, n = 64 * nb + lane;
    const int ksv = __float_as_int(kscale ? kscale[k0 + lane] : 1.0f);
    const float* wp = W + (size_t)k0 * N + n;
    unsigned char* op = WT + (size_t)rowmap(mode, n) * ldd + k0;
    float w[64];
#pragma unroll
    for (int i = 0; i < 64; ++i) w[i] = __builtin_nontemporal_load(wp + (size_t)i * N);
#pragma unroll
    for (int kg = 0; kg < 4; ++kg) { float v[16];
#pragma unroll
        for (int i = 0; i < 16; ++i) { const float sk = __int_as_float(__builtin_amdgcn_readlane(ksv, 16 * kg + i)); v[i] = w[16 * kg + i] * (sk * pg8::FP8_SW); }
        u32x4 o; o.x = pg8::pk4_fp8(v[0], v[1], v[2], v[3]); o.y = pg8::pk4_fp8(v[4], v[5], v[6], v[7]); o.z = pg8::pk4_fp8(v[8], v[9], v[10], v[11]); o.w = pg8::pk4_fp8(v[12], v[13], v[14], v[15]);
        *(GAS u32x4*)(op + 16 * kg) = o; }
}
struct MatDesc { const float* src; bf16_t* dst; const float* kscale; const float* nscale; int K, N, ldd, mode, f8; };
constexpr int N_MATS = 70;
__device__ __forceinline__ MatDesc mat_desc(int m, LAS unsigned char* L, unsigned char* ws) {
    MatDesc d; d.kscale = nullptr; d.nscale = nullptr; d.mode = 0; d.f8 = 0;
    if (m < 2)       { const int a = m;      d.src = ptab(L, 4) + (size_t)a * DM * NDOWN;    d.K = DM;   d.N = NDOWN; d.dst = (bf16_t*)(ws + WS_WDN) + (size_t)a * NDOWNP * DM;  d.ldd = DM; d.mode = 4; d.kscale = ptab(L, 2) + (size_t)(2 * a) * DM; }
    else if (m < 4)  { const int a = m - 2;  d.src = ptab(L, 6) + (size_t)a * QLR * NQ;      d.K = QLR;  d.N = NQ;    d.dst = (bf16_t*)(ws + WS_WUQ) + (size_t)a * NQ * QLR;     d.ldd = QLR; d.mode = 3; d.kscale = ptab(L, 5) + (size_t)a * QLR; }
    else if (m < 6)  { const int a = m - 4;  d.src = ptab(L, 8) + (size_t)a * KVLR * NKV;    d.K = KVLR; d.N = NKV;   d.dst = (bf16_t*)(ws + WS_WUKV) + (size_t)a * NKV * KVLR;  d.ldd = KVLR; d.kscale = ptab(L, 7) + (size_t)a * KVLR; }
    else if (m < 8)  { const int a = m - 6;  d.src = ptab(L, 9) + (size_t)a * DM * DM;       d.K = DM;   d.N = DM;    d.dst = (bf16_t*)(ws + WS_WO) + (size_t)a * DM * DM;       d.ldd = DM; }
    else if (m < 16) { const int i = m - 8;  d.src = ptab(L, 10) + (size_t)i * 256 * 256;    d.K = 256;  d.N = 256;   d.dst = (bf16_t*)(ws + WS_WPOOL) + (size_t)i * 256 * 256;  d.ldd = 256; d.nscale = ptab(L, 11) + i * 256; }
    else if (m < 18) { const int a = m - 16; d.src = ptab(L, 12) + (size_t)a * DM * FFD;     d.K = DM;   d.N = FFD;   d.dst = (bf16_t*)(ws + WS_WGU) + (size_t)a * 2 * FFD * DM; d.ldd = DM; d.mode = 1; d.kscale = ptab(L, 3) + (size_t)(2 * a) * DM; }
    else if (m < 20) { const int a = m - 18; d.src = ptab(L, 13) + (size_t)a * DM * FFD;     d.K = DM;   d.N = FFD;   d.dst = (bf16_t*)(ws + WS_WGU) + (size_t)a * 2 * FFD * DM; d.ldd = DM; d.mode = 2; d.kscale = ptab(L, 3) + (size_t)(2 * a) * DM; }
    else if (m < 22) { const int a = m - 20; d.src = ptab(L, 14) + (size_t)a * FFD * DM;     d.K = FFD;  d.N = DM;    d.dst = (bf16_t*)(ws + WS_WD) + (size_t)a * DM * FFD;      d.ldd = FFD; }
    else if (m < 38) { const int i = m - 22; d.src = ptab(L, 16) + (size_t)i * DM * FFE;     d.K = DM;   d.N = FFE;   d.dst = (bf16_t*)(ws + WS_MWGU) + (size_t)i * 2 * FFEP * DM; d.ldd = DM; d.mode = 1; d.kscale = ptab(L, 3) + (size_t)(2 * (i >> 3) + 1) * DM; }
    else if (m < 54) { const int i = m - 38; d.src = ptab(L, 17) + (size_t)i * DM * FFE;     d.K = DM;   d.N = FFE;   d.dst = (bf16_t*)(ws + WS_MWGU) + (size_t)i * 2 * FFEP * DM; d.ldd = DM; d.mode = 2; d.kscale = ptab(L, 3) + (size_t)(2 * (i >> 3) + 1) * DM; }
    else             { const int i = m - 54; d.src = ptab(L, 18) + (size_t)i * FFE * DM;     d.K = FFE;  d.N = DM;    d.dst = (bf16_t*)(ws + WS_MWD) + (size_t)i * DM * FFEP;    d.ldd = FFEP; }
    if (m == 17 || m == 19) { d.f8 = 1; d.dst = (bf16_t*)(ws + WS_WGU + (size_t)2 * FFD * DM * 2); d.ldd = DM; }
    if (m == 3) { d.f8 = 1; d.dst = (bf16_t*)(ws + WS_WUQ + (size_t)NQ * QLR * 2); d.ldd = QLR; }
    if (m == 5) { d.f8 = 1; d.dst = (bf16_t*)(ws + WS_WUKV + (size_t)NKV * KVLR * 2); d.ldd = KVLR; }
    if (m == 1) { d.f8 = 1; d.dst = (bf16_t*)(ws + WS_WDN + (size_t)NDOWNP * DM * 2); d.ldd = DM; }
    if (m == 7) { d.f8 = 1; d.dst = (bf16_t*)(ws + WS_WO + (size_t)DM * DM * 2); d.ldd = DM; }
    if (m == 20 || m == 21) { d.f8 = 1; d.dst = (bf16_t*)(ws + WS_WD + (size_t)(m - 20) * DM * FFD * 2); d.ldd = FFD8; }
    if (m >= 22) {
        const int e = (m - 22) & 7, lpi = ((m - 22) & 15) >> 3; d.f8 = 1;
        if (m < 54) { d.dst = (bf16_t*)(ws + WS_MWGU + (size_t)lpi * 8 * 2 * FFEP * DM * 2 + (size_t)e * 2 * FFEP * DM); d.ldd = DM; }
        else        { d.dst = (bf16_t*)(ws + WS_MWD + (size_t)lpi * 8 * DM * FFEP * 2 + (size_t)e * DM * FFE8); d.ldd = FFE8; } }
    return d;
}
__device__ __forceinline__ void p0_prologue(Frame& F) {
    const int* positions = (const int*)ptab(F.lds, 1);
    const int gw = F.vcu * NWAVES + F.wave, NGW = F.G * NWAVES;
    int cum = 0;
    for (int m = 0; m < N_MATS; ++m) {
        const MatDesc d = mat_desc(m, F.lds, F.ws);
        const int nitems = (d.K / 64) * (d.N / 64);
        int first = gw - (cum % NGW); if (first < 0) first += NGW;
        if (d.f8) { for (int it = first; it < nitems; it += NGW) transpose_item_f8(d.src, d.N, (unsigned char*)d.dst, d.ldd, d.mode, d.kscale, it, F.lane); }
        else { for (int it = first; it < nitems; it += NGW) transpose_item(d.src, d.N, d.dst, d.ldd, d.mode, d.kscale, d.nscale, it, F.lane); }
        cum += nitems;
    }
    const int gt = gw * 64 + F.lane, NGT = NGW * 64; const u32x4 z4 = (u32x4){0u, 0u, 0u, 0u};
    for (int i = gt; i < 2 * 192 * 128; i += NGT) { const int a = i / (192 * 128), r = (i / 128) % 192, c = i % 128; const int row = r < 96 ? 800 + r : 928 + (r - 96); *(GAS u32x4*)((bf16_t*)(F.ws + WS_WDN) + (size_t)a * NDOWNP * DM + (size_t)row * DM + c * 8) = z4; }
    for (int i = gt; i < 2 * 1024 * 8; i += NGT) { const int a = i / (1024 * 8), row = (i / 8) % 1024, c = i % 8; *(GAS u32x4*)(F.ws + WS_WD + (size_t)a * DM * FFD * 2 + (size_t)row * FFD8 + FFD + c * 16) = z4; }
    for (int i = gt; i < 16 * 128 * 64; i += NGT) { const int lpi = i / (8 * 128 * 64), e = (i / (128 * 64)) & 7, r = (i / 64) % 128, c = i % 64; const int row = 2560 + (r < 64 ? 64 + r : 192 + (r - 64));
        *(GAS u32x4*)(F.ws + WS_MWGU + (size_t)lpi * 8 * 2 * FFEP * DM * 2 + (size_t)e * 2 * FFEP * DM + (size_t)row * DM + c * 16) = z4; }
    for (int i = gt; i < 16 * 1024 * 12; i += NGT) { const int lpi = i / (8 * 1024 * 12), row = (i / 12) % (8 * 1024), c = i % 12; *(GAS u32x4*)(F.ws + WS_MWD + (size_t)lpi * 8 * DM * FFEP * 2 + (size_t)row * FFE8 + FFE + c * 16) = z4; }
    for (int i = gt; i < 192 * 64; i += NGT) { const int r = i / 64, c = i % 64; const int row = r < 96 ? 800 + r : 928 + (r - 96); *(GAS u32x4*)(F.ws + WS_WDN + (size_t)NDOWNP * DM * 2 + (size_t)row * DM + c * 16) = z4; }
    float* cosT = (float*)(F.ws + WS_COS); float* sinT = (float*)(F.ws + WS_SIN);
    { const float inv = powf(10000.0f, -(float)(2 * (gt & 31)) / 64.0f);
      for (int i = gt; i < NTOK * 32; i += NGT) { const float ang = (float)positions[i >> 5] * inv; float sn, cs; sincosf(ang, &sn, &cs); cosT[i] = cs; sinT[i] = sn; } }
    const float* x = ptab(F.lds, 0); bf16_t* H = (bf16_t*)(F.ws + WS_H); ssq_t* ssq0 = (ssq_t*)(F.ws + WS_SSQ);
    for (int m0 = gw * 4; m0 < NTOK; m0 += NGW * 4) {
        f32x4 v[4][4];
#pragma unroll
        for (int r = 0; r < 4; ++r) { const GAS f32x4* xr = (const GAS f32x4*)(x + (size_t)(m0 + r) * DM) + F.lane;
#pragma unroll
            for (int j = 0; j < 4; ++j) v[r][j] = __builtin_nontemporal_load(xr + 64 * j); }
#pragma unroll
        for (int r = 0; r < 4; ++r) { GAS u32x2* o8 = (GAS u32x2*)(H + (size_t)(m0 + r) * DM) + F.lane; float s = 0.f;
#pragma unroll
            for (int j = 0; j < 4; ++j) { const f32x4 t = v[r][j]; s += (t.x * t.x + t.y * t.y) + (t.z * t.z + t.w * t.w); u32x2 w; w.x = cvt_pk_bf16(t.x, t.y); w.y = cvt_pk_bf16(t.z, t.w); o8[64 * j] = w; }
            s = wave_sum(s); if (F.lane == 0) ssq0[m0 + r] = ssq_fix(s); }
    }
}

__device__ __forceinline__ void load_counts8(const unsigned* cntw, unsigned (&c)[8]) {
    const int l_ = launder_v((int)threadIdx.x) & 63; unsigned v_ = 0u;
    if (l_ < 8) v_ = *(const GAS unsigned*)(cntw + 64 * l_);
#pragma unroll
    for (int e = 0; e < 8; ++e) c[e] = (unsigned)__builtin_amdgcn_readlane((int)v_, e);
}
template <bool FINAL>
__device__ __forceinline__ void combine_phase(Frame& F, const bf16_t* H, bf16_t* Hout, const unsigned char* YB, const unsigned* tokinfo, const unsigned* cntw, ssq_t* ssq_next, const float* gain, float* outF, unsigned char* H8 = nullptr) {
    const int gw = F.vcu * NWAVES + F.wave, NGW = F.G * NWAVES;
    f32x4 g[4];
    if constexpr (FINAL) {
#pragma unroll
        for (int j = 0; j < 4; ++j) g[j] = *(const f32x4*)(gain + F.lane * 4 + 256 * j);
    }
    unsigned nb[8]; load_counts8(cntw, nb);
#pragma unroll
    for (int e = 0; e < 8; ++e) nb[e] = (nb[e] + 255u) >> 8;
    for (int m0 = gw * 2; m0 < NTOK; m0 += NGW * 2) {
        u32x4 t0[2], t1[2];
#pragma unroll
        for (int r = 0; r < 2; ++r) { t0[r] = *(const u32x4*)(tokinfo + (size_t)(m0 + r) * 8); t1[r] = *(const u32x4*)(tokinfo + (size_t)(m0 + r) * 8 + 4); }
        u32x2 hh[2][4]; unsigned ya[2][4], yb[2][4]; float g0[2], g1[2];
#pragma unroll
        for (int r = 0; r < 2; ++r) {
            const unsigned e0 = rfl(t0[r].x), r0 = rfl(t0[r].y), e1 = rfl(t1[r].x), r1 = rfl(t1[r].y); g0[r] = __uint_as_float(rfl(t0[r].z)) * (1.0f / pg8::FP8_SY); g1[r] = __uint_as_float(rfl(t1[r].z)) * (1.0f / pg8::FP8_SY);
            unsigned b0 = 0u, b1 = 0u;
#pragma unroll
            for (int e = 0; e < 8; ++e) { b0 += ((unsigned)e < e0) ? nb[e] : 0u; b1 += ((unsigned)e < e1) ? nb[e] : 0u; }
            const GAS u32x2* hr = (const GAS u32x2*)(H + (size_t)(m0 + r) * DM) + F.lane;
            const GAS unsigned* y0 = (const GAS unsigned*)(YB + ((size_t)b0 * 256 + r0) * DM) + F.lane; const GAS unsigned* y1 = (const GAS unsigned*)(YB + ((size_t)b1 * 256 + r1) * DM) + F.lane;
#pragma unroll
            for (int j = 0; j < 4; ++j) { hh[r][j] = hr[64 * j]; ya[r][j] = __builtin_nontemporal_load(y0 + 64 * j); yb[r][j] = __builtin_nontemporal_load(y1 + 64 * j); }
        }
#pragma unroll
        for (int r = 0; r < 2; ++r) { const int m = m0 + r;
            f32x4 v[4]; float s = 0.f;
#pragma unroll
            for (int j = 0; j < 4; ++j) { const u32x2 h2 = hh[r][j]; const int a = (int)ya[r][j], b = (int)yb[r][j];
                v[j].x = bflo(h2.x) + g0[r] * __builtin_amdgcn_cvt_f32_fp8(a, 0) + g1[r] * __builtin_amdgcn_cvt_f32_fp8(b, 0); v[j].y = bfhi(h2.x) + g0[r] * __builtin_amdgcn_cvt_f32_fp8(a, 1) + g1[r] * __builtin_amdgcn_cvt_f32_fp8(b, 1);
                v[j].z = bflo(h2.y) + g0[r] * __builtin_amdgcn_cvt_f32_fp8(a, 2) + g1[r] * __builtin_amdgcn_cvt_f32_fp8(b, 2); v[j].w = bfhi(h2.y) + g0[r] * __builtin_amdgcn_cvt_f32_fp8(a, 3) + g1[r] * __builtin_amdgcn_cvt_f32_fp8(b, 3);
                s += (v[j].x * v[j].x + v[j].y * v[j].y) + (v[j].z * v[j].z + v[j].w * v[j].w); }
            s = wave_sum(s);
            if constexpr (FINAL) { const float rstd = rstd_f(s); GAS f32x4* ho = (GAS f32x4*)(outF + (size_t)m * DM) + F.lane;
#pragma unroll
                for (int j = 0; j < 4; ++j) ho[64 * j] = v[j] * rstd * g[j];
            } else { GAS u32x2* hw = (GAS u32x2*)(Hout + (size_t)m * DM) + F.lane;
#pragma unroll
                for (int j = 0; j < 4; ++j) { u32x2 w; w.x = cvt_pk_bf16(v[j].x, v[j].y); w.y = cvt_pk_bf16(v[j].z, v[j].w); hw[64 * j] = w;
                    *(GAS unsigned*)(H8 + (size_t)m * DM + F.lane * 4 + 256 * j) = pg8::pk4_fp8(v[j].x * pg8::FP8_SX, v[j].y * pg8::FP8_SX, v[j].z * pg8::FP8_SX, v[j].w * pg8::FP8_SX); }
                if (F.lane == 0) ssq_next[m] = ssq_fix(s); }
        }
    }
}
__device__ __forceinline__ void mid_phase(Frame& F, const bf16_t* DOWN, const float* qn, const float* kvn, const float* cosT, const float* sinT, bf16_t* CQN, bf16_t* CKVN, bf16_t* KR) {
    const int gw = F.vcu * NWAVES + F.wave, NGW = F.G * NWAVES, lane = F.lane;
    const f32x4 q0 = *(const f32x4*)(qn + lane * 8), q1 = *(const f32x4*)(qn + lane * 8 + 4), k0 = *(const f32x4*)(kvn + lane * 4);
    for (int m = gw; m < NTOK; m += NGW) {
        const bf16_t* dr = DOWN + (size_t)m * NDOWNP;
        const u32x4 cq = *(const GAS u32x4*)(dr + lane * 8); const u32x2 ck = *(const GAS u32x2*)(dr + QLR + lane * 4);
        const float x1 = bf2f(dr[QLR + KVLR + (lane & 31)]), x2 = bf2f(dr[QLR + KVLR + 32 + (lane & 31)]);
        const f32x4 a0 = (f32x4){bflo(cq.x), bfhi(cq.x), bflo(cq.y), bfhi(cq.y)}, a1 = (f32x4){bflo(cq.z), bfhi(cq.z), bflo(cq.w), bfhi(cq.w)}, c0 = (f32x4){bflo(ck.x), bfhi(ck.x), bflo(ck.y), bfhi(ck.y)};
        const float sq = wave_sum((a0.x * a0.x + a0.y * a0.y) + (a0.z * a0.z + a0.w * a0.w) + (a1.x * a1.x + a1.y * a1.y) + (a1.z * a1.z + a1.w * a1.w));
        const float sk = wave_sum((c0.x * c0.x + c0.y * c0.y) + (c0.z * c0.z + c0.w * c0.w));
        const float rq = 1.0f / sqrtf(sq * (1.0f / QLR) + RMS_EPS), rk = 1.0f / sqrtf(sk * (1.0f / KVLR) + RMS_EPS);
        const f32x4 y0 = a0 * rq * q0, y1 = a1 * rq * q1, z0 = c0 * rk * k0;
        u32x4 w; w.x = cvt_pk_bf16(y0.x, y0.y); w.y = cvt_pk_bf16(y0.z, y0.w); w.z = cvt_pk_bf16(y1.x, y1.y); w.w = cvt_pk_bf16(y1.z, y1.w);
        *(GAS u32x4*)(CQN + (size_t)m * QLR + lane * 8) = w;
        u32x2 w2; w2.x = cvt_pk_bf16(z0.x, z0.y); w2.y = cvt_pk_bf16(z0.z, z0.w);
        *(GAS u32x2*)(CKVN + (size_t)m * KVLR + lane * 4) = w2;
        const float c = cosT[(size_t)m * 32 + (lane & 31)], s = sinT[(size_t)m * 32 + (lane & 31)];
        const float o = lane < 32 ? x1 * c - x2 * s : x2 * c + x1 * s;
        KR[(size_t)m * DROPE + lane] = (bf16_t)(cvt_pk_bf16(o, o) & 0xffffu);
    }
}
template <int W>
__device__ __forceinline__ void pool_walk(const bf16_t* h, const ssq_t* ssq, const f32x2 g2, bf16_t* Z, size_t rowbase, int t_start, int c0, int nrows, int col) {
    f32x2 ring[W]; f32x2 sum = (f32x2){0.f, 0.f};
#pragma unroll
    for (int j = 0; j < W; ++j) ring[j] = (f32x2){0.f, 0.f};
    unsigned xa[16], xb[16]; ssq_t qa[16], qb[16];
#define PW_LOAD(X, Q, r_) do { _Pragma("unroll") for (int j = 0; j < 16; ++j) { const size_t row = rowbase + t_start + (r_) + j; X[j] = *(const GAS unsigned*)(h + row * DM + col); Q[j] = ssq[row]; } } while (0)
#define PW_PROC(X, Q, r_) do { _Pragma("unroll") for (int j = 0; j < 16; ++j) { const int t = t_start + (r_) + j; const size_t row = rowbase + t; \
            const f32x2 v = (f32x2){bflo(X[j]), bfhi(X[j])} * rstd_of(Q[j]) * g2; \
            sum = sum + (v - ring[j % W]); ring[j % W] = v; \
            if (t >= c0) { const float inv = 1.0f / (float)(t + 1 < W ? t + 1 : W); const f32x2 z = sum * inv - v; *(GAS unsigned*)(Z + row * DM + col) = cvt_pk_bf16(z.x, z.y); } } } while (0)
    PW_LOAD(xa, qa, 0);
    for (int r = 0; r < nrows; r += 32) {
        if (r + 16 < nrows) PW_LOAD(xb, qb, r + 16);
        PW_PROC(xa, qa, r);
        if (r + 32 < nrows) PW_LOAD(xa, qa, r + 32);
        if (r + 16 < nrows) PW_PROC(xb, qb, r + 16);
    }
#undef PW_LOAD
#undef PW_PROC
}
__device__ __forceinline__ void pool_phase(Frame& F, const bf16_t* h, const ssq_t* ssq, const float* gain, bf16_t* Z) {
    const int col = F.tid * 2; const f32x2 g2 = *(const f32x2*)(gain + col);
    for (int chunk = F.vcu; chunk < NBATCH * 16; chunk += F.G) {
        const int b = chunk >> 4, c0 = (chunk & 15) * 128, t_start = c0 ? c0 - 16 : 0, nrows = c0 + 128 - t_start; const size_t rowbase = (size_t)b * SEQ;
        const int grp = F.wave >> 1;
        if (grp == 0) pool_walk<2>(h, ssq, g2, Z, rowbase, t_start, c0, nrows, col);
        else if (grp == 1) pool_walk<4>(h, ssq, g2, Z, rowbase, t_start, c0, nrows, col);
        else if (grp == 2) pool_walk<8>(h, ssq, g2, Z, rowbase, t_start, c0, nrows, col);
        else pool_walk<16>(h, ssq, g2, Z, rowbase, t_start, c0, nrows, col);
    }
}
template <bool WRITE_H8>
__device__ __forceinline__ void router_phase(Frame& F, const bf16_t* h, const ssq_t* ssq, const float* gain, const float* router, int* list, float* rsl, unsigned* tokinfo, unsigned* cntw, unsigned char* H8) {
    LAS float* rt = (LAS float*)(F.lds + RING_OFF);
    LAS int* esel = (LAS int*)(F.lds + RING_OFF + 32768);
    LAS int* wt = (LAS int*)(F.lds + RING_OFF + 32768 + 2048);
    LAS int* base = (LAS int*)(F.lds + RING_OFF + 32768 + 2048 + 256);
    LAS float* rsd = (LAS float*)(F.lds + RING_OFF + 32768 + 2048 + 512);
    const int lane = F.lane;
    for (int idx = F.tid; idx < DM * NEXP; idx += NWAVES * 64) rt[(idx & 7) * DM + (idx >> 3)] = router[idx];
    f32x4 g[4];
#pragma unroll
    for (int j = 0; j < 4; ++j) g[j] = *(const f32x4*)(gain + lane * 4 + 256 * j);
    for (int chunk = F.vcu; chunk < NTOK / 256; chunk += F.G) {
        const int T0 = chunk * 256;
        __syncthreads();
        u32x2 nx[4][4]; ssq_t nq[4];
#pragma unroll
        for (int p = 0; p < 4; ++p) { const GAS u32x2* xr = (const GAS u32x2*)(h + (size_t)(T0 + F.wave * 32 + p) * DM) + lane;
#pragma unroll
          for (int j = 0; j < 4; ++j) nx[p][j] = __builtin_nontemporal_load(xr + 64 * j);
          nq[p] = ssq[T0 + F.wave * 32 + p]; }
        for (int i4 = 0; i4 < 32; i4 += 4) {
            const int tl0 = F.wave * 32 + i4, m0 = T0 + tl0;
            f32x4 v[4][4]; float rstd[4];
#pragma unroll
            for (int p = 0; p < 4; ++p) { rstd[p] = rstd_of(nq[p]);
#pragma unroll
                for (int j = 0; j < 4; ++j) { const u32x2 w = nx[p][j]; f32x4 xn = (f32x4){bflo(w.x), bfhi(w.x), bflo(w.y), bfhi(w.y)} * rstd[p];
                    if constexpr (WRITE_H8) { const f32x4 q = xn * pg8::FP8_SA; *(GAS unsigned*)(H8 + (size_t)(m0 + p) * DM + lane * 4 + 256 * j) = pg8::pk4_fp8(q.x, q.y, q.z, q.w); }
                    v[p][j] = xn * g[j]; } }
            if (i4 + 4 < 32) {
#pragma unroll
                for (int p = 0; p < 4; ++p) { const GAS u32x2* xr = (const GAS u32x2*)(h + (size_t)(m0 + 4 + p) * DM) + lane;
#pragma unroll
                    for (int j = 0; j < 4; ++j) nx[p][j] = __builtin_nontemporal_load(xr + 64 * j);
                    nq[p] = ssq[m0 + 4 + p]; } }
            float a[32];
            f32x4 rq[2][4];
#pragma unroll
            for (int j = 0; j < 4; ++j) rq[0][j] = *(const LAS f32x4*)(rt + lane * 4 + 256 * j);
#pragma unroll
            for (int e = 0; e < 8; ++e) {
                if (e < 7) {
#pragma unroll
                    for (int j = 0; j < 4; ++j) rq[(e + 1) & 1][j] = *(const LAS f32x4*)(rt + (e + 1) * DM + lane * 4 + 256 * j); }
                __builtin_amdgcn_sched_barrier(0);
                f32x2 a2[4];
#pragma unroll
                for (int p = 0; p < 4; ++p) a2[p] = (f32x2){0.f, 0.f};
#pragma unroll
                for (int j = 0; j < 4; ++j) { const f32x4 r4 = rq[e & 1][j]; const f32x2 rlo = __builtin_shufflevector(r4, r4, 0, 1), rhi = __builtin_shufflevector(r4, r4, 2, 3);
#pragma unroll
                    for (int p = 0; p < 4; ++p) { const f32x4 vv = v[p][j];
                        a2[p] = __builtin_elementwise_fma(__builtin_shufflevector(vv, vv, 0, 1), rlo, a2[p]);
                        a2[p] = __builtin_elementwise_fma(__builtin_shufflevector(vv, vv, 2, 3), rhi, a2[p]); } }
#pragma unroll
                for (int p = 0; p < 4; ++p) a[8 * p + e] = a2[p].x + a2[p].y;
                __builtin_amdgcn_sched_barrier(0); }
#define RSTEP(N, LM) _Pragma("unroll") for (int k = 0; k < (N); ++k) { const bool up = (lane & (LM)) != 0; const float send = up ? a[k] : a[k + (N)], keep = up ? a[k + (N)] : a[k]; a[k] = keep + __shfl_xor(send, (LM)); }
            RSTEP(16, 32) RSTEP(8, 16) RSTEP(4, 8) RSTEP(2, 4) RSTEP(1, 2)
#undef RSTEP
            const float tot = a[0] + __shfl_xor(a[0], 1);
#pragma unroll
            for (int p = 0; p < 4; ++p) {
                float lg[8];
#pragma unroll
                for (int e = 0; e < 8; ++e) lg[e] = __int_as_float(__builtin_amdgcn_readlane(__float_as_int(tot), 2 * (8 * p + e)));
                int e0 = 0; float l0 = lg[0];
#pragma unroll
                for (int e = 1; e < 8; ++e) if (lg[e] > l0) { l0 = lg[e]; e0 = e; }
                int e1 = e0 == 0 ? 1 : 0; float l1 = lg[e0 == 0 ? 1 : 0];
#pragma unroll
                for (int e = 0; e < 8; ++e) if (e != e0 && lg[e] > l1) { l1 = lg[e]; e1 = e; }
                const float g0 = 1.0f / (1.0f + __expf(l1 - l0)), g1 = 1.0f - g0;
                if (lane == 0) { const int tl = tl0 + p; esel[2 * tl] = e0; esel[2 * tl + 1] = e1; rsd[tl] = rstd[p]; unsigned* ti = tokinfo + (size_t)(m0 + p) * 8;
                    ti[0] = (unsigned)e0; ti[2] = __float_as_uint(g0); ti[4] = (unsigned)e1; ti[6] = __float_as_uint(g1); }
            }
        }
        __syncthreads();
        const int me = esel[F.tid]; int myrank = 0;
#pragma unroll
        for (int e = 0; e < 8; ++e) { const unsigned long long mask = __ballot(me == e); if (me == e) myrank = __popcll(mask & ((1ull << lane) - 1ull)); if (lane == 0) wt[F.wave * 8 + e] = __popcll(mask); }
        __syncthreads();
        int off = 0;
        for (int w = 0; w < F.wave; ++w) off += wt[w * 8 + me];
        if (F.tid < 8) { int tot = 0; for (int w = 0; w < 8; ++w) tot += wt[w * 8 + F.tid]; base[F.tid] = (int)__hip_atomic_fetch_add(cntw + 64 * F.tid, (unsigned)tot, RLX_AGENT); }
        __syncthreads();
        const int rank = base[me] + off + myrank, tok = T0 + (F.tid >> 1);
        list[(size_t)me * NTOK + rank] = tok; rsl[(size_t)me * NTOK + rank] = rsd[F.tid >> 1];
        tokinfo[(size_t)tok * 8 + (F.tid & 1) * 4 + 1] = (unsigned)rank;
    }
}
template <bool GATHER, bool FP8 = false>
struct MoeOrder {
    static constexpr size_t A_BLK = GATHER ? 0 : (FP8 ? (size_t)256 * FFE8 : (size_t)256 * FFEP * 2), B_EXP = GATHER ? (FP8 ? (size_t)2 * FFEP * DM : (size_t)2 * FFEP * DM * 2) : (FP8 ? (size_t)DM * FFE8 : (size_t)DM * FFEP * 2),
                            B_TILE = GATHER ? (FP8 ? (size_t)256 * DM : (size_t)256 * DM * 2) : (FP8 ? (size_t)256 * FFE8 : (size_t)256 * FFEP * 2);
    static constexpr int NT = GATHER ? 2 * FFEP / 256 : DM / 256;
    const char* A; const char* B; const int* list; const unsigned* cntw; int G, c, rev; unsigned bs[9];
    __device__ __forceinline__ void init(const unsigned* cntw_, const void* A_, const void* B_, const int* list_, int G_, int c_) {
        A = (const char*)A_; B = (const char*)B_; list = list_; cntw = cntw_; G = G_; c = c_; rev = 0; bs[0] = 0u;
        unsigned ce8[8]; load_counts8(cntw_, ce8);
#pragma unroll
        for (int e = 0; e < 8; ++e) bs[e + 1] = bs[e] + ((ce8[e] + 255u) >> 8);
    }
    __device__ __forceinline__ bool next(int i, pg8::Unit& u) const {
        unsigned blk; int pn;
        if ((G & 7) == 0) {
            const int x = c & 7, cl = c >> 3, q = (int)bs[8] >> 3, r = (int)bs[8] & 7, nbx = q + (x < r ? 1 : 0), b0 = x * q + (x < r ? x : r);
            int U = i * (G >> 3) + cl; const int nwx = nbx * NT; if (U >= nwx) return false;
            if (rev) U = nwx - 1 - U;
            const int nig = pg8::WGM * NT, gid = U / nig, fm = gid * pg8::WGM, gsz = (nbx - fm) < pg8::WGM ? (nbx - fm) : pg8::WGM;
            blk = (unsigned)(b0 + fm + (U % nig) % gsz); pn = (U % nig) / gsz;
        } else {
            long L = (long)i * G + c; if (L >= (long)bs[8] * NT) return false;
            if (rev) L = (long)bs[8] * NT - 1 - L;
            blk = (unsigned)(L / NT); pn = (int)(L % NT);
        }
        unsigned e = 0u, st = 0u;
#pragma unroll
        for (int k = 1; k < 8; ++k) if (blk >= bs[k]) { e = (unsigned)k; st = bs[k]; }
        const unsigned j = blk - st;
        u.b = B + (size_t)e * B_EXP + (size_t)pn * B_TILE; u.orow = (int)(blk * 256u); u.pn = pn; u.aux = (int)e;
        if constexpr (GATHER) { const unsigned ce = rfl(__hip_atomic_load((unsigned*)cntw + 64 * e, RLX_AGENT));
            u.a = A; u.rows = list + (size_t)e * NTOK + (size_t)j * 256; const unsigned rem = ce - j * 256u; u.nrows = rem < 256u ? (int)rem : 256; }
        else { u.a = A + (size_t)blk * A_BLK; u.rows = nullptr; u.nrows = 256; }
        return true;
    }
};
constexpr int NPHASE = 27;
struct Args { const float* in[20]; float* out; unsigned char* ws; int ph_lo, ph_hi, li, pad; };
#ifndef MK_REP_MASK
#define MK_REP_MASK 0
#endif
#ifndef MK_REP_N
#define MK_REP_N 1
#endif
#ifndef MK_REV
#define MK_REV 1
#endif
#ifndef MK_STAG_BF
#define MK_STAG_BF 0u
#define MK_STAG_F8 0u
#endif
constexpr int PT_OFF = LDSCTL_OFF + 512;
__device__ __forceinline__ unsigned long long ptab_u64(LAS unsigned char* L, int i) {
    const volatile LAS unsigned* p = (const volatile LAS unsigned*)(L + PT_OFF + 8 * i); const unsigned lo = rfl(p[0]), hi = rfl(p[1]); return ((unsigned long long)hi << 32) | lo; }
__device__ __forceinline__ const float* ptab(LAS unsigned char* L, int i) { return (const float*)(GAS const float*)ptab_u64(L, i); }
__device__ __forceinline__ Frame make_frame(LAS unsigned char* L) {
    asm volatile("" : "+s"(L));
    Frame F; F.lds = L; F.MISC = (volatile LAS unsigned*)(L + MISC_OFF); F.tid = launder_v((int)threadIdx.x); F.lane = F.tid & 63; F.wave = __builtin_amdgcn_readfirstlane(F.tid >> 6);
    { int g_ = gridDim.x, bx = blockIdx.x; asm volatile("" : "+s"(g_), "+s"(bx)); F.G = g_; F.bx = bx;
      F.vcu = (F.G % 8 == 0) ? (bx % 8) * (F.G / 8) + bx / 8 : bx; }
    F.ws = (unsigned char*)(GAS unsigned char*)ptab_u64(L, 21); F.ctl = (gu32*)(F.ws + WS_CTL); return F;
}
__global__ void __launch_bounds__(NWAVES * 64, 2) fwd(Args args) {
    extern __shared__ __attribute__((aligned(16))) unsigned char lds[];
    LAS unsigned char* L = (LAS unsigned char*)lds;
    { const int tid = threadIdx.x;
      for (int u = tid; u < LDSCTL_BYTES / 4; u += NWAVES * 64) ((LAS unsigned*)(L + LDSCTL_OFF))[u] = 0u;
      __syncthreads();
      if (tid < 20) *(LAS unsigned long long*)(L + PT_OFF + 8 * tid) = (unsigned long long)args.in[tid];
      if (tid == 20) *(LAS unsigned long long*)(L + PT_OFF + 8 * 20) = (unsigned long long)args.out;
      if (tid == 21) *(LAS unsigned long long*)(L + PT_OFF + 8 * 21) = (unsigned long long)args.ws;
      if (tid == 22) *(LAS unsigned long long*)(L + PT_OFF + 8 * 22) = (unsigned long long)args.pad;
      __syncthreads(); }
    const int lo = args.ph_lo, hi = args.ph_hi;
    XcdBarrier bar; { gu32* ctl = (gu32*)(args.ws + WS_CTL); bar.bar = (unsigned*)(ctl + CW_BAR) + args.li * XCD_BAR_WORDS; bar.x = 0; bar.st = nullptr;
      if (threadIdx.x == 0) { const unsigned long long ba = (unsigned long long)((unsigned*)(ctl + CW_BAR) + args.li * XCD_BAR_WORDS); ((volatile LAS unsigned*)(L + MISC_OFF))[10] = (unsigned)ba; ((volatile LAS unsigned*)(L + MISC_OFF))[11] = (unsigned)(ba >> 32); }
      if (hi - lo > 1) bar = xcd_barrier_post((unsigned*)(ctl + CW_BAR) + args.li * XCD_BAR_WORDS, (volatile LAS unsigned*)(L + MISC_OFF) + 8);
      __syncthreads(); }
#ifndef MK_ONLY
#define MK_ONLY (-1)
#endif
#define KIND(k) ((k) == 0 ? 0 : 1 + ((k) - 1) % 13)
#ifndef MK_SKIPMASK
#define MK_SKIPMASK 0
#endif
#define IN(k) ((MK_ONLY < 0 || KIND(k) == MK_ONLY) && !((MK_SKIPMASK >> KIND(k)) & 1) && lo <= (k) && (k) < hi)
#define FORREP(k)
#if MK_REP_MASK
#define LASTREP (ptab_u64(F.lds, 22) == 0ull)
#else
#define LASTREP true
#endif
#ifdef MK_DOUBLE_BAR
#define SEAM(k) do { if ((k) + 1 < hi) { xcd_barrier(bar); xcd_barrier(bar); } } while (0)
#else
#define SEAM(k) do { if ((k) + 1 < hi) xcd_barrier(bar); } while (0)
#endif
#define WSP(off) ((bf16_t*)(F.ws + (off)))
#define SSQ(i) ((ssq_t*)(F.ws + WS_SSQ) + (size_t)(i) * NTOK)
    LAS unsigned char* ring = L + RING_OFF;

    if (IN(0)) FORREP(0) { Frame F = make_frame(L); p0_prologue(F); SEAM(0); }

    for (int lp = 0; lp < 2; ++lp) {
        const int pb = 1 + 13 * lp;
        if (IN(pb + 0)) FORREP(pb + 0) { Frame F = make_frame(L);
            pg8::RegOrder S; S.init(WSP(WS_H), DM * 2, WSP(WS_WDN) + (size_t)lp * NDOWNP * DM, DM * 2, NTOK, NDOWNP, F.G, F.bx);
            if (lp == 0) { pg8::EpiDown<false> E{WSP(WS_DOWN), WSP(WS_KR), SSQ(4 * lp + 0), LASTREP ? SSQ(10 + 2 * lp) : SSQ(9), LASTREP ? SSQ(11 + 2 * lp) : SSQ(9), (const float*)(F.ws + WS_COS), (const float*)(F.ws + WS_SIN), 1.0f};
                pg8::gemm_phase<pg8::EpiDown<false>, pg8::RegOrder, false>(ring, DM * 2, DM * 2, DM * 2, S, E); }
            else { pg8::EpiDown<true> E{WSP(WS_DOWN), WSP(WS_KR), SSQ(4 * lp + 0), LASTREP ? SSQ(10 + 2 * lp) : SSQ(9), LASTREP ? SSQ(11 + 2 * lp) : SSQ(9), (const float*)(F.ws + WS_COS), (const float*)(F.ws + WS_SIN), 1.0f};
                S.init(F.ws + WS_H8, DM, F.ws + WS_WDN + (size_t)NDOWNP * DM * 2, DM, NTOK, NDOWNP, F.G, F.bx); E.scale = 1.0f / (pg8::FP8_SX * pg8::FP8_SW);
                pg8::gemm_phase<pg8::EpiDown<true>, pg8::RegOrder, false, true>(ring, DM, DM, DM, S, E); }
            SEAM(pb + 0);
        }
        if (IN(pb + 1)) FORREP(pb + 1) { Frame F = make_frame(L);
            pg8::RegOrder S; S.init(WSP(WS_DOWN), NDOWNP * 2, WSP(WS_WUQ) + (size_t)lp * NQ * QLR, QLR * 2, NTOK, NQ, F.G, F.bx);
            if (lp == 0) { pg8::EpiQ<false> E{WSP(WS_Q), (const float*)(F.ws + WS_COS), (const float*)(F.ws + WS_SIN), SSQ(10 + 2 * lp)};
                pg8::gemm_phase<pg8::EpiQ<false>, pg8::RegOrder, false>(ring, NDOWNP * 2, QLR * 2, QLR * 2, S, E); }
            else { pg8::EpiQ<true> E{WSP(WS_Q), (const float*)(F.ws + WS_COS), (const float*)(F.ws + WS_SIN), SSQ(10 + 2 * lp)};
                S.init(F.ws + WS_DOWN, NDOWNP, F.ws + WS_WUQ + (size_t)NQ * QLR * 2, QLR, NTOK, NQ, F.G, F.bx); E.scale = 1.0f / (pg8::FP8_SL * pg8::FP8_SW);
                pg8::gemm_phase<pg8::EpiQ<true>, pg8::RegOrder, false, true>(ring, NDOWNP, QLR, QLR, S, E); }
            SEAM(pb + 1);
        }
        if (IN(pb + 2)) FORREP(pb + 2) { Frame F = make_frame(L);
            pg8::RegOrder S; S.init(WSP(WS_DOWN) + QLR, NDOWNP * 2, WSP(WS_WUKV) + (size_t)lp * NKV * KVLR, KVLR * 2, NTOK, NKV, F.G, F.bx);
            pg8::EpiBf16<2> E{WSP(WS_KNV), NKV, SSQ(11 + 2 * lp)};
            if (lp == 0) { pg8::gemm_phase<pg8::EpiBf16<2>, pg8::RegOrder, false>(ring, NDOWNP * 2, KVLR * 2, KVLR * 2, S, E); }
            else {
                S.init(F.ws + WS_DOWN + QLR, NDOWNP, F.ws + WS_WUKV + (size_t)NKV * KVLR * 2, KVLR, NTOK, NKV, F.G, F.bx); E.scale = 1.0f / (pg8::FP8_SL * pg8::FP8_SW);
                pg8::gemm_phase<pg8::EpiBf16<2>, pg8::RegOrder, false, true>(ring, NDOWNP, KVLR, KVLR, S, E); }
            SEAM(pb + 2);
        }
        if (IN(pb + 3)) FORREP(pb + 3) { Frame F = make_frame(L); att::attn_phase((char*)lds + RING_OFF, WSP(WS_Q), WSP(WS_KNV), WSP(WS_KR), WSP(WS_DOWN), F.vcu, F.G | (lp << 30)); SEAM(pb + 3); }
        if (IN(pb + 4) && lp == 0) FORREP(pb + 4) { Frame F = make_frame(L);
            pg8::RegOrder S; S.init(WSP(WS_DOWN), DM * 2, WSP(WS_WO) + (size_t)lp * DM * DM, DM * 2, NTOK, DM, F.G, F.bx);
            pg8::EpiResidH<false> E{WSP(WS_H), LASTREP ? WSP(WS_H) : WSP(WS_DUMMY), LASTREP ? SSQ(4 * lp + 1) : SSQ(9), nullptr, 1.0f};
            pg8::gemm_phase<pg8::EpiResidH<false>, pg8::RegOrder, false>(ring, DM * 2, DM * 2, DM * 2, S, E);
            SEAM(pb + 4);
        }
        if (IN(pb + 4) && lp == 1) FORREP(pb + 4) { Frame F = make_frame(L);
            pg8::RegOrder S; S.init(F.ws + WS_DOWN, DM, F.ws + WS_WO + (size_t)DM * DM * 2, DM, NTOK, DM, F.G, F.bx);
            pg8::EpiResidH<true> E{WSP(WS_H), LASTREP ? WSP(WS_H) : WSP(WS_DUMMY), LASTREP ? SSQ(4 * lp + 1) : SSQ(9), F.ws + WS_H8, 1.0f / (att::SO8 * pg8::FP8_SW)};
            pg8::gemm_phase<pg8::EpiResidH<true>, pg8::RegOrder, false, true>(ring, DM, DM, DM, S, E);
            SEAM(pb + 4);
        }
#if defined(MK_EPI_PROBE)
        if (IN(pb + 5) && lp == 0 && !LASTREP) { Frame F = make_frame(L);
            pg8::RegOrder S; S.init(WSP(WS_H), DM * 2, WSP(WS_WGU) + (size_t)lp * 2 * FFD * DM, DM * 2, NTOK, 2 * FFD, F.G, F.bx);
#if MK_EPI_PROBE == 1
            pg8::EpiNull E{(float*)(F.ws + WS_DUMMY)};
            pg8::gemm_phase<pg8::EpiNull, pg8::RegOrder, false>(ring, DM * 2, DM * 2, DM * 2, S, E);
#else
            pg8::EpiBf16<0> E{WSP(WS_HID), FFD, nullptr};
            S.nN = FFD / 256; S.nwg = S.nM * S.nN;
            pg8::gemm_phase<pg8::EpiBf16<0>, pg8::RegOrder, false>(ring, DM * 2, DM * 2, DM * 2, S, E);
#endif
        }
        if (IN(pb + 5) && lp == 0 && LASTREP) FORREP(pb + 5) { Frame F = make_frame(L);
#else
        if (IN(pb + 5) && lp == 0) FORREP(pb + 5) { Frame F = make_frame(L);
#endif
            pg8::RegOrder S; S.init(WSP(WS_H), DM * 2, WSP(WS_WGU) + (size_t)lp * 2 * FFD * DM, DM * 2, NTOK, 2 * FFD, F.G, F.bx);
            pg8::EpiSwigluF8<2> E{F.ws + WS_HID, FFD8, 2 * FFD / 256 - 1, SSQ(4 * lp + 1)};
            pg8::gemm_phase<pg8::EpiSwigluF8<2>, pg8::RegOrder, false>(ring, DM * 2, DM * 2, DM * 2, S, E, MK_STAG_BF);
            SEAM(pb + 5);
        }
        if (IN(pb + 5) && lp == 1) FORREP(pb + 5) { Frame F = make_frame(L);
            pg8::RegOrder S; S.init(F.ws + WS_H8, DM, F.ws + WS_WGU + (size_t)2 * FFD * DM * 2, DM, NTOK, 2 * FFD, F.G, F.bx);
            pg8::EpiSwigluF8<1> E{F.ws + WS_HID, FFD8, 2 * FFD / 256 - 1, SSQ(4 * lp + 1)};
            pg8::gemm_phase<pg8::EpiSwigluF8<1>, pg8::RegOrder, false, true>(ring, DM, DM, DM, S, E, MK_STAG_F8);
            SEAM(pb + 5);
        }
        if (IN(pb + 6)) FORREP(pb + 6) { Frame F = make_frame(L);
            pg8::RegOrder S; S.init(F.ws + WS_HID, FFD8, F.ws + WS_WD + (size_t)lp * DM * FFD * 2, FFD8, NTOK, DM, F.G, F.bx); S.rev = MK_REV;
            pg8::EpiResidH<false> E{WSP(WS_H), LASTREP ? WSP(WS_H) : WSP(WS_DUMMY), LASTREP ? SSQ(4 * lp + 2) : SSQ(9), nullptr, 1.0f / (pg8::FP8_SH * pg8::FP8_SW)};
            pg8::gemm_phase<pg8::EpiResidH<false>, pg8::RegOrder, false, true>(ring, FFD8, FFD8, FFD8, S, E);
            SEAM(pb + 6);
        }
        if (IN(pb + 7)) FORREP(pb + 7) { Frame F = make_frame(L); pool_phase(F, WSP(WS_H), SSQ(4 * lp + 2), ptab(F.lds, 2) + (size_t)(2 * lp + 1) * DM, WSP(WS_DOWN)); SEAM(pb + 7); }
        if (IN(pb + 8)) FORREP(pb + 8) { Frame F = make_frame(L);
            pg8::RegOrder S; S.init(WSP(WS_DOWN), DM * 2, WSP(WS_WPOOL) + (size_t)lp * 4 * 256 * 256, 256 * 2, NTOK, DM, F.G, F.bx, 256 * 2);
            pg8::EpiResidH<false> E{WSP(WS_H), LASTREP ? WSP(WS_H) : WSP(WS_DUMMY), LASTREP ? SSQ(4 * lp + 3) : SSQ(9), nullptr, 1.0f};
            pg8::gemm_phase<pg8::EpiResidH<false>, pg8::RegOrder, false>(ring, DM * 2, 256 * 2, 256 * 2, S, E);
            SEAM(pb + 8);
        }
        if (IN(pb + 9)) FORREP(pb + 9) { Frame F = make_frame(L);
            router_phase<true>(F, WSP(WS_H), SSQ(4 * lp + 3), ptab(F.lds, 3) + (size_t)(2 * lp + 1) * DM, ptab(F.lds, 15) + (size_t)lp * DM * NEXP, (int*)(F.ws + WS_LIST), (float*)(F.ws + WS_RSL), (unsigned*)(F.ws + WS_TOKINFO), (unsigned*)(F.ctl + CW_CNT) + (LASTREP ? lp : 2 + lp) * 8 * 64, F.ws + WS_H8);
            SEAM(pb + 9); }
#ifndef TEST_NO_F8MOE
        if (IN(pb + 10)) FORREP(pb + 10) { Frame F = make_frame(L);
            MoeOrder<true, true> S; S.init((unsigned*)(F.ctl + CW_CNT) + lp * 8 * 64, F.ws + WS_H8, F.ws + WS_MWGU + (size_t)lp * 8 * 2 * FFEP * DM * 2, (const int*)(F.ws + WS_LIST), F.G, F.bx);
            pg8::EpiSwigluF8<0> E{F.ws + WS_HID, FFE8, 2 * FFEP / 256 - 1, nullptr};
            pg8::gemm_phase<pg8::EpiSwigluF8<0>, MoeOrder<true, true>, true, true>(ring, DM, DM, DM, S, E, MK_STAG_F8);
            SEAM(pb + 10);
        }
#endif
#ifndef TEST_NO_F8MOE
        if (IN(pb + 11)) FORREP(pb + 11) { Frame F = make_frame(L);
            MoeOrder<false, true> S; S.init((unsigned*)(F.ctl + CW_CNT) + lp * 8 * 64, F.ws + WS_HID, F.ws + WS_MWD + (size_t)lp * 8 * DM * FFEP * 2, (const int*)(F.ws + WS_LIST), F.G, F.bx); S.rev = MK_REV;
            pg8::EpiF8Scaled E{F.ws + WS_YB, DM, pg8::FP8_SY / (pg8::FP8_SH * pg8::FP8_SW)};
            pg8::gemm_phase<pg8::EpiF8Scaled, MoeOrder<false, true>, false, true>(ring, FFE8, FFE8, FFE8, S, E);
            SEAM(pb + 11);
        }
#endif
        if (IN(pb + 12)) FORREP(pb + 12) { Frame F = make_frame(L);
            if (lp == 0) combine_phase<false>(F, WSP(WS_H), LASTREP ? WSP(WS_H) : WSP(WS_DOWN), F.ws + WS_YB, (const unsigned*)(F.ws + WS_TOKINFO), (unsigned*)(F.ctl + CW_CNT), LASTREP ? SSQ(4) : SSQ(9), nullptr, nullptr, F.ws + WS_H8);
            else combine_phase<true>(F, WSP(WS_H), nullptr, F.ws + WS_YB, (const unsigned*)(F.ws + WS_TOKINFO), (unsigned*)(F.ctl + CW_CNT) + 8 * 64, nullptr, ptab(F.lds, 19), (float*)ptab(F.lds, 20));
            SEAM(pb + 12);
        }
    }
#undef IN
#undef SEAM
#undef WSP
#undef SSQ
}

#ifndef MK_PER_PHASE
#define MK_PER_PHASE 0
#endif
extern "C" void kernel_launch(void* const* d_in, const int* in_sizes, int n_in, void* d_out, int out_size, void* d_ws, size_t ws_size, hipStream_t stream) {
    static int grid = 0;
    if (grid == 0) {
        if (n_in != 20 || in_sizes[0] != NTOK * DM || out_size != NTOK * DM || ws_size < WS_END) { fprintf(stderr, "kernel_launch: unexpected shapes (n_in %d, in0 %d, out %d, ws %zu < %zu)\n", n_in, n_in > 0 ? in_sizes[0] : -1, out_size, ws_size, (size_t)WS_END); grid = -1; return; }
        int dev = 0, cus = 0, per_cu = 0;
        if (hipGetDevice(&dev) != hipSuccess || hipDeviceGetAttribute(&cus, hipDeviceAttributeMultiprocessorCount, dev) != hipSuccess) { grid = -1; return; }
        if (hipFuncSetAttribute((const void*)fwd, hipFuncAttributeMaxDynamicSharedMemorySize, LDS_BYTES) != hipSuccess) { fprintf(stderr, "kernel_launch: hipFuncSetAttribute failed\n"); grid = -1; return; }
        if (hipOccupancyMaxActiveBlocksPerMultiprocessor(&per_cu, (const void*)fwd, NWAVES * 64, LDS_BYTES) != hipSuccess || per_cu < 1) fprintf(stderr, "kernel_launch: occupancy query reports %d\n", per_cu);
        (void)hipGetLastError();
        grid = cus < 256 ? cus : 256;
    }
    if (grid < 0) return;
    if (hipMemsetAsync((char*)d_ws + WS_CTL, 0, CTL_ZERO_BYTES, stream) != hipSuccess) return;
    Args a{};
    for (int i = 0; i < 20; ++i) a.in[i] = (const float*)d_in[i];
    a.out = (float*)d_out; a.ws = (unsigned char*)d_ws;
#if MK_PER_PHASE
    for (int p = 0; p < NPHASE; ++p) { a.ph_lo = p; a.ph_hi = p + 1; a.li = 0; hipLaunchKernelGGL(fwd, dim3(grid), dim3(NWAVES * 64), LDS_BYTES, stream, a); }
#elif MK_REP_MASK
    { int cur = 0, li = 0;
      for (int k = 0; k < NPHASE; ++k) if ((MK_REP_MASK >> (k == 0 ? 0 : 1 + (k - 1) % 13)) & 1) {
          if (k > cur) { a.ph_lo = cur; a.ph_hi = k; a.li = li++; a.pad = 0; hipLaunchKernelGGL(fwd, dim3(grid), dim3(NWAVES * 64), LDS_BYTES, stream, a); }
          for (int r = 1; r < MK_REP_N; ++r) { a.ph_lo = k; a.ph_hi = k + 1; a.li = li++; a.pad = 1; hipLaunchKernelGGL(fwd, dim3(grid), dim3(NWAVES * 64), LDS_BYTES, stream, a); }
          cur = k; }
      a.ph_lo = cur; a.ph_hi = NPHASE; a.li = li++; a.pad = 0; hipLaunchKernelGGL(fwd, dim3(grid), dim3(NWAVES * 64), LDS_BYTES, stream, a); }
#elif defined(MK_TWICE)
    a.ph_lo = 0; a.ph_hi = NPHASE; a.li = 0;
    hipLaunchKernelGGL(fwd, dim3(grid), dim3(NWAVES * 64), LDS_BYTES, stream, a);
    (void)hipMemsetAsync((char*)d_ws + WS_CTL, 0, CTL_ZERO_BYTES, stream);
    hipLaunchKernelGGL(fwd, dim3(grid), dim3(NWAVES * 64), LDS_BYTES, stream, a);
#else
    a.ph_lo = 0; a.ph_hi = NPHASE; a.li = 0;
    hipLaunchKernelGGL(fwd, dim3(grid), dim3(NWAVES * 64), LDS_BYTES, stream, a);
#endif
}
```
